# Optimizing an MI355X kernel written in HIP

```python
import math
import jax
import jax.numpy as jnp
from jax import lax
import numpy as np

D_MODEL = 1024
BATCH = 4
SEQ = 4096
DEPTH = 1

GRID_W = 64
CTX_LEN = 256
EPS = 1e-6
POS_BASE = 10000.0
N_MOD = 6

GLA_HEADS = 4
GLA_DK = 64
GLA_DV = 128
GLA_RANK = 16
GLA_GATE_NORM = 16.0
GLA_CHUNK = 64
GLA_QK_W = GLA_HEADS * GLA_DK
GLA_V_W = GLA_HEADS * GLA_DV

HY_WIDTH = D_MODEL - GLA_V_W
HY_ORDER = 2
HY_BANDS = 16
HY_EMB = 2 * HY_BANDS + 1
HY_HIDDEN = 64
HY_SHORT = 3
HY_MIN_DECAY = math.log(1e-2) / 1.5
HY_MAX_DECAY = math.log(1e-2) / 0.3
HY_FILTER_SCALE = 0.02

PROJ_SPLITS = (GLA_QK_W, 2 * GLA_QK_W, 2 * GLA_QK_W + GLA_V_W, 2 * GLA_QK_W + 2 * GLA_V_W,
               2 * GLA_QK_W + 2 * GLA_V_W + GLA_RANK, 2 * GLA_QK_W + 2 * GLA_V_W + 2 * GLA_RANK)
D_IN = 2 * GLA_QK_W + 2 * GLA_V_W + 2 * GLA_RANK + (HY_ORDER + 1) * HY_WIDTH

N_EXPERTS = 16
EC_FACTOR = 2
D_EXPERT = 1024

kernel_name = 'hybrid_gla_hyena_ec_prefix_dit'


def _rmsnorm(x, g):
    xf = x.astype(jnp.float32)
    y = xf * lax.rsqrt(jnp.mean(xf * xf, axis=-1, keepdims=True) + EPS)
    return (y * g.astype(jnp.float32)).astype(x.dtype)


def _modulate(h, shift, scale):
    return h * (1.0 + scale) + shift


def _rev(a):
    return a[:, ::-1]


def _pos_embed_2d(rows):
    r = jnp.repeat(jnp.arange(rows, dtype=jnp.float32), GRID_W)
    col = jnp.tile(jnp.arange(GRID_W, dtype=jnp.float32), rows)
    quarter = D_MODEL // 4
    omega = 1.0 / (POS_BASE ** (jnp.arange(quarter, dtype=jnp.float32) / quarter))
    er = r[:, None] * omega
    ec = col[:, None] * omega
    return jnp.concatenate([jnp.sin(er), jnp.cos(er), jnp.sin(ec), jnp.cos(ec)], axis=-1)


def _chunk(a):
    B, L, H, d = a.shape
    return a.reshape(B, L // GLA_CHUNK, GLA_CHUNK, H, d).transpose(0, 3, 1, 2, 4).astype(jnp.float32)


def _unchunk(o):
    B, H, N, C, d = o.shape
    return o.transpose(0, 2, 3, 1, 4).reshape(B, N * C, H, d)


def _gla_direction(q, k, v, la, s0, with_output):
    kc, vc, lac = _chunk(k), _chunk(v), _chunk(la)
    b = jnp.cumsum(lac, axis=3)
    b_last = b[:, :, :, -1]
    upd = jnp.einsum('bhncd,bhnce->bhnde', kc * jnp.exp(b_last[:, :, :, None] - b), vc)

    def step(s, inp):
        dec, u = inp
        return dec[..., None] * s + u, s

    s_fin, s_prev = lax.scan(step, s0, (jnp.moveaxis(jnp.exp(b_last), 2, 0), jnp.moveaxis(upd, 2, 0)))
    if not with_output:
        return None, s_fin
    s_prev = jnp.moveaxis(s_prev, 0, 2)
    qc = _chunk(q)
    ref = b[:, :, :, GLA_CHUNK // 2:GLA_CHUNK // 2 + 1]
    scores = jnp.einsum('bhncd,bhnsd->bhncs', qc * jnp.exp(b - ref), kc * jnp.exp(ref - b))
    mask = jnp.tril(jnp.ones((GLA_CHUNK, GLA_CHUNK), dtype=bool))
    scores = jnp.where(mask, scores, 0.0)
    o = (jnp.einsum('bhncs,bhnse->bhnce', scores, vc)
         + jnp.einsum('bhncd,bhnde->bhnce', qc * jnp.exp(b), s_prev))
    return _unchunk(o), s_fin


def _gla_bidir(q, k, v, la_f, la_b, s_f, s_b, with_output):
    o_f, sf = _gla_direction(q, k, v, la_f, s_f, with_output)
    o_b, sb = _gla_direction(_rev(q), _rev(k), _rev(v), _rev(la_b), s_b, with_output)
    o = o_f + _rev(o_b) if with_output else None
    return o, sf, sb


def _gla_out(o, g, norm_g):
    B, L = o.shape[:2]
    return _rmsnorm(o, norm_g).reshape(B, L, GLA_V_W) * jax.nn.silu(g)


def _short_conv(u, w, b):
    L = u.shape[1]
    pad = HY_SHORT // 2
    up = jnp.pad(u, ((0, 0), (pad, pad), (0, 0)))
    return sum(up[:, j:j + L] * w[j] for j in range(HY_SHORT)) + b


def _hyena_filters(L, w1, b1, w2, b2, w3, freq):
    t = jnp.linspace(0.0, 1.0, L, dtype=jnp.float32)[:, None]
    w = 2.0 * math.pi * jnp.arange(L, dtype=jnp.float32)[:, None] / L
    f = jnp.linspace(1e-4, HY_BANDS - 1, HY_BANDS, dtype=jnp.float32)[None, :]
    z = jnp.concatenate([t, jnp.cos(f * w), -jnp.sin(f * w)], axis=-1)
    hdn = jnp.sin(freq * (z @ w1 + b1))
    hdn = jnp.sin(freq * (hdn @ w2 + b2))
    h = (hdn @ w3).astype(jnp.float32).reshape(L, HY_ORDER, 2, HY_WIDTH)
    deltas = jnp.abs(jnp.linspace(HY_MIN_DECAY, HY_MAX_DECAY, HY_WIDTH, dtype=jnp.float32))
    h = h * jnp.exp(-t * deltas)[:, None, None, :]
    return jnp.transpose(h, (1, 2, 0, 3))


def _bidir_fftconv(u, hf, hb, bias):
    L = u.shape[1]
    uf = u.astype(jnp.float32)
    kern = jnp.concatenate([hf, jnp.zeros_like(hf[:1]), hb[:0:-1]], axis=0)
    y = jnp.fft.irfft(jnp.fft.rfft(uf, n=2 * L, axis=1) * jnp.fft.rfft(kern, axis=0), n=2 * L, axis=1)[:, :L]
    return (y + uf * bias.astype(jnp.float32)).astype(u.dtype)


def _hyena(hp, conv_w, conv_b, filt, bias):
    u = _short_conv(hp, conv_w, conv_b)
    v, x1, x2 = jnp.split(u, 3, axis=-1)
    z = x1 * _bidir_fftconv(v, filt[0, 0], filt[0, 1], bias[0])
    return x2 * _bidir_fftconv(z, filt[1, 0], filt[1, 1], bias[1])


def _ec_moe(h, w_router, w_gate, w_up, w_down):
    B, L, _ = h.shape
    cap = EC_FACTOR * L // N_EXPERTS
    aff = jax.nn.softmax((h @ w_router).astype(jnp.float32), axis=-1)
    vals, idx = lax.top_k(jnp.swapaxes(aff, 1, 2), cap)
    bidx = jnp.arange(B)[:, None, None]
    xs = h[bidx, idx]
    hid = jax.nn.silu(jnp.einsum('becd,edf->becf', xs, w_gate)) * jnp.einsum('becd,edf->becf', xs, w_up)
    y = jnp.einsum('becf,efd->becd', hid, w_down) * vals[..., None].astype(h.dtype)
    return jnp.zeros_like(h).at[bidx, idx].add(y.astype(h.dtype))


def setup_inputs(seed: int = 0) -> dict:
    key = jax.random.key(seed)
    ks = jax.random.split(key, 29)
    f32 = jnp.float32

    def nrm(i, shape, scale):
        return jax.random.normal(ks[i], shape, f32) * scale

    def gain(i, shape):
        return 1.0 + nrm(i, shape, 0.02)

    Dp = DEPTH
    return {
        'x': nrm(0, (BATCH, SEQ, D_MODEL), 1.0),
        'c': nrm(1, (BATCH, D_MODEL), 1.0),
        'ctx': nrm(2, (BATCH, CTX_LEN, D_MODEL), 1.0),
        'c_ctx': nrm(3, (D_MODEL,), 1.0),
        'w_ada': nrm(4, (Dp, D_MODEL, N_MOD * D_MODEL), 0.5 * D_MODEL ** -0.5),
        'b_ada': nrm(5, (Dp, N_MOD * D_MODEL), 0.02),
        'norm_mix_g': gain(6, (Dp, D_MODEL)),
        'w_in': nrm(7, (Dp, D_MODEL, D_IN), D_MODEL ** -0.5),
        'gla_wa_f': nrm(8, (Dp, GLA_RANK, GLA_QK_W), GLA_RANK ** -0.5),
        'gla_ba_f': nrm(9, (Dp, GLA_QK_W), 0.1),
        'gla_wa_b': nrm(10, (Dp, GLA_RANK, GLA_QK_W), GLA_RANK ** -0.5),
        'gla_ba_b': nrm(11, (Dp, GLA_QK_W), 0.1),
        'gla_norm_g': gain(12, (Dp, GLA_DV)),
        'hy_conv_w': nrm(13, (Dp, HY_SHORT, (HY_ORDER + 1) * HY_WIDTH), HY_SHORT ** -0.5),
        'hy_conv_b': nrm(14, (Dp, (HY_ORDER + 1) * HY_WIDTH), 0.02),
        'hy_w1': nrm(15, (Dp, HY_EMB, HY_HIDDEN), HY_EMB ** -0.5),
        'hy_b1': nrm(16, (Dp, HY_HIDDEN), 0.02),
        'hy_w2': nrm(17, (Dp, HY_HIDDEN, HY_HIDDEN), HY_HIDDEN ** -0.5),
        'hy_b2': nrm(18, (Dp, HY_HIDDEN), 0.02),
        'hy_w3': nrm(19, (Dp, HY_HIDDEN, HY_ORDER * 2 * HY_WIDTH), HY_FILTER_SCALE),
        'hy_freq': gain(20, (Dp, HY_HIDDEN)),
        'hy_bias': nrm(21, (Dp, HY_ORDER, HY_WIDTH), 0.5),
        'w_out': nrm(22, (Dp, D_MODEL, D_MODEL), D_MODEL ** -0.5),
        'norm_ffn_g': gain(23, (Dp, D_MODEL)),
        'w_router': nrm(24, (Dp, D_MODEL, N_EXPERTS), D_MODEL ** -0.5),
        'w_gate': nrm(25, (Dp, N_EXPERTS, D_MODEL, D_EXPERT), D_MODEL ** -0.5),
        'w_up': nrm(26, (Dp, N_EXPERTS, D_MODEL, D_EXPERT), D_MODEL ** -0.5),
        'w_down': nrm(27, (Dp, N_EXPERTS, D_EXPERT, D_MODEL), D_EXPERT ** -0.5),
        'norm_final_g': gain(28, (D_MODEL,)),
    }


def reference(x, c, ctx, c_ctx, w_ada, b_ada, norm_mix_g, w_in, gla_wa_f, gla_ba_f, gla_wa_b, gla_ba_b,
              gla_norm_g, hy_conv_w, hy_conv_b, hy_w1, hy_b1, hy_w2, hy_b2, hy_w3, hy_freq, hy_bias,
              w_out, norm_ffn_g, w_router, w_gate, w_up, w_down, norm_final_g):
    B, n_lat, _ = x.shape
    ROWS = n_lat // GRID_W
    x = x + _pos_embed_2d(ROWS).astype(x.dtype)
    s_zero = jnp.zeros((B, GLA_HEADS, GLA_DK, GLA_DV), jnp.float32)
    for l in range(DEPTH):
        last = l == DEPTH - 1
        mod_x = jnp.split((jax.nn.silu(c) @ w_ada[l] + b_ada[l])[:, None, :], N_MOD, axis=-1)
        mod_c = jnp.split((jax.nn.silu(c_ctx) @ w_ada[l] + b_ada[l])[None, None, :], N_MOD, axis=-1)

        def project(h, mod):
            p = _modulate(_rmsnorm(h, norm_mix_g[l]), mod[0], mod[1]) @ w_in[l]
            q, k, v, g, a_f, a_b, hy = jnp.split(p, PROJ_SPLITS, axis=-1)
            Bh, L, _ = p.shape
            shp = (Bh, L, GLA_HEADS, -1)
            la_f = jax.nn.log_sigmoid((a_f @ gla_wa_f[l] + gla_ba_f[l]).astype(jnp.float32)) / GLA_GATE_NORM
            la_b = jax.nn.log_sigmoid((a_b @ gla_wa_b[l] + gla_ba_b[l]).astype(jnp.float32)) / GLA_GATE_NORM
            gla_in = (q.reshape(shp) * (GLA_DK ** -0.5), k.reshape(shp), v.reshape(shp),
                      la_f.reshape(shp), la_b.reshape(shp))
            return gla_in, g, hy

        def merge(o, g, hy):
            filt = _hyena_filters(hy.shape[1], hy_w1[l], hy_b1[l], hy_w2[l], hy_b2[l], hy_w3[l], hy_freq[l])
            y_gla = _gla_out(o, g, gla_norm_g[l])
            y_hy = _hyena(hy, hy_conv_w[l], hy_conv_b[l], filt, hy_bias[l])
            return jnp.concatenate([y_gla, y_hy], axis=-1) @ w_out[l]

        def channel_mix(h, mod):
            hn = _modulate(_rmsnorm(h, norm_ffn_g[l]), mod[3], mod[4])
            return mod[5] * _ec_moe(hn, w_router[l], w_gate[l], w_up[l], w_down[l])

        gla_c, g_c, hy_c = project(ctx, mod_c)
        gla_x, g_x, hy_x = project(x, mod_x)
        o_c, s_f, s_b = _gla_bidir(*gla_c, s_zero, s_zero, not last)
        o_x, _, _ = _gla_bidir(*gla_x, s_f, s_b, True)
        x = x + mod_x[2] * merge(o_x, g_x, hy_x)
        x = x + channel_mix(x, mod_x)
        if not last:
            ctx = ctx + mod_c[2] * merge(o_c, g_c, hy_c)
            ctx = ctx + channel_mix(ctx, mod_c)
    return _rmsnorm(x, norm_final_g)
```

```cpp
#include <hip/hip_runtime.h>
#include <cstdio>
#include <cstdint>
namespace pg8 {
#define PG8_LAS __attribute__((address_space(3)))
typedef unsigned short bf16_t;
typedef short bf16x8 __attribute__((ext_vector_type(8)));
typedef float f32x4 __attribute__((ext_vector_type(4)));
typedef unsigned u32x4 __attribute__((ext_vector_type(4)));
constexpr int BM = 256, BK = 64, HALF = 128, HTB = HALF * BK * 2  , STAGE_BYTES = 8 * HTB, NXCD = 8, WGM = 8;

__host__ __device__ __forceinline__ int lds_byte(int r, int c) { const int st = (r >> 4) * 2 + (c >> 5), rr = r & 15, cc = c & 31, ob = rr * 64 + cc * 2; return st * 1024 + (ob ^ (((ob >> 9) & 1) << 5)); }
__host__ __device__ __forceinline__ void stage_rc(int b, int& R, int& C) { const int st = b / 1024, sb = b % 1024, swz = sb ^ (((sb >> 9) & 1) << 5); R = (st >> 1) * 16 + swz / 64; C = (st & 1) * 32 + (swz % 64) / 2; }
__host__ __device__ __forceinline__ int perm32(int rho) { const int n = rho >> 4, i = rho & 15; return 8 * (i >> 2) + 4 * n + (i & 3); }

struct Unit { int pm, pn; };
struct Gemm { const bf16_t* A; const bf16_t* Bt; int M, N, K; };

struct StaticOrder {
    int nM, nN, nwg, G, c;
    __host__ __device__ void init(int M, int N, int G_, int c_) { nM = M / BM; nN = N / BM; nwg = nM * nN; G = G_; c = c_; }
    __host__ __device__ bool next(int i, Unit& u) const {
        const long L = (long)i * G + c; if (L >= nwg) return false;
        int wgid = (int)L; { const int q = nwg / NXCD, r = nwg % NXCD, xcd = wgid % NXCD, off = wgid / NXCD; wgid = (xcd < r ? xcd * (q + 1) : r * (q + 1) + (xcd - r) * q) + off; }
        const int nig = WGM * nN, gid = wgid / nig, fm = gid * WGM, gsz = (nM - fm) < WGM ? (nM - fm) : WGM;
        u.pm = fm + ((wgid % nig) % gsz); u.pn = (wgid % nig) / gsz; return true;
    }
    __device__ __forceinline__ void a_ready(const Unit&) const {}
    __device__ __forceinline__ void done(const Unit&) const {}
};

__device__ __forceinline__ unsigned cvt_pk_bf16(float lo, float hi) { unsigned r; asm volatile("v_cvt_pk_bf16_f32 %0, %1, %2" : "=v"(r) : "v"(lo), "v"(hi)); return r; }
template <class Epi, class Sched, bool ALIGN_EPI = false, bool SP2 = false>
__device__ __forceinline__ void gemm_phase(PG8_LAS unsigned char* lds, const Gemm g, const Sched& S, const Epi& E) {
    const int tid = threadIdx.x, wid = __builtin_amdgcn_readfirstlane(tid >> 6), lane = tid & 63, wr = wid >> 2, wc = wid & 3, fr = lane & 15, fq = lane >> 4;
    const int K = g.K, nt = K / BK;
    unsigned voffA[2], voffB[2];
#pragma unroll
    for (int i = 0; i < 2; ++i) { int R, C; stage_rc(tid * 16 + i * 8192, R, C); const int Rb = Epi::PERM ? ((R & ~31) + perm32(R & 31)) : R;
        voffA[i] = (unsigned)(R * K + C) * 2u; voffB[i] = (unsigned)(Rb * K + C) * 2u; }
    const size_t kstep = (size_t)(BK * 2);
    const size_t hstep = (size_t)HALF * K * 2;
    const size_t tstep = 2 * hstep;
    const unsigned ldsw = (unsigned)wid * 1024u;
    const int aoff = lds_byte(wr * 64 + fr, fq * 8), boff = lds_byte(wc * 32 + fr, fq * 8);
#define PG8_SA(b, h) (((b) * 2 + (h)) * HTB)
#define PG8_SB(b, h) ((4 + (b) * 2 + (h)) * HTB)
#define PG8_STAGE(bufoff, gbase, voff) do { _Pragma("unroll") for (int _i = 0; _i < 2; ++_i) \
        __builtin_amdgcn_global_load_lds((const unsigned*)((const char*)(gbase) + (voff)[_i]), (PG8_LAS unsigned*)(lds + (bufoff) + ldsw + _i * 8192), 16, 0, 0); } while (0)
#define PG8_LDA(dst, b, h) do { _Pragma("unroll") for (int m = 0; m < 4; ++m) _Pragma("unroll") for (int k = 0; k < 2; ++k) dst[m][k] = *(const PG8_LAS bf16x8*)(lds + PG8_SA(b, h) + aoff + m * 2048 + k * 1024); } while (0)
#define PG8_LDB(dst, b, h) do { _Pragma("unroll") for (int n = 0; n < 2; ++n) _Pragma("unroll") for (int k = 0; k < 2; ++k) dst[n][k] = *(const PG8_LAS bf16x8*)(lds + PG8_SB(b, h) + boff + n * 2048 + k * 1024); } while (0)
#define PG8_MMA(ai, bj, At, Bt) do { __builtin_amdgcn_s_setprio(1); _Pragma("unroll") for (int m = 0; m < 4; ++m) _Pragma("unroll") for (int n = 0; n < 2; ++n) _Pragma("unroll") for (int k = 0; k < 2; ++k) \
        acc[ai][bj][m][n] = __builtin_amdgcn_mfma_f32_16x16x32_bf16(Bt[n][k], At[m][k], acc[ai][bj][m][n], 0, 0, 0); __builtin_amdgcn_s_setprio(0); } while (0)
#define PG8_WAIT_V(n) asm volatile("s_waitcnt vmcnt(" #n ")" ::: "memory")
#define PG8_WAIT_L(n) asm volatile("s_waitcnt lgkmcnt(" #n ")" ::: "memory")
#define PG8_BAR __builtin_amdgcn_s_barrier()
#define PG8_SCHED __builtin_amdgcn_sched_barrier(0)
    Unit cur, nxt; int ui = 0;
    if (!S.next(0, cur)) return;
    f32x4 acc[2][2][4][2];
#pragma unroll
    for (int a = 0; a < 2; ++a)
#pragma unroll
        for (int b = 0; b < 2; ++b)
#pragma unroll
            for (int m = 0; m < 4; ++m)
#pragma unroll
                for (int n = 0; n < 2; ++n) acc[a][b][m][n] = (f32x4){0.f, 0.f, 0.f, 0.f};
    bf16x8 At[4][2], B0[2][2], B1[2][2];
    const char* cA = (const char*)g.A + (size_t)cur.pm * tstep; const char* cB = (const char*)g.Bt + (size_t)cur.pn * tstep;
    S.a_ready(cur);
    if constexpr (SP2) {
        PG8_STAGE(PG8_SB(0, 0), cB, voffB); PG8_STAGE(PG8_SB(0, 1), cB + hstep, voffB); PG8_STAGE(PG8_SA(0, 0), cA, voffA); PG8_STAGE(PG8_SA(0, 1), cA + hstep, voffA);
        if (wr == 1) PG8_BAR;
        PG8_WAIT_V(2); PG8_BAR;
        PG8_STAGE(PG8_SB(1, 0), cB + kstep, voffB); PG8_STAGE(PG8_SA(1, 0), cA + kstep, voffA); PG8_STAGE(PG8_SB(1, 1), cB + hstep + kstep, voffB);
        PG8_WAIT_V(6); PG8_BAR;
    } else {
        PG8_STAGE(PG8_SB(0, 0), cB, voffB); PG8_STAGE(PG8_SA(0, 0), cA, voffA); PG8_STAGE(PG8_SB(0, 1), cB + hstep, voffB); PG8_STAGE(PG8_SA(0, 1), cA + hstep, voffA);
        if (wr == 1) PG8_BAR;
        PG8_WAIT_V(4); PG8_BAR;
        PG8_STAGE(PG8_SB(1, 0), cB + kstep, voffB); PG8_STAGE(PG8_SA(1, 0), cA + kstep, voffA); PG8_STAGE(PG8_SB(1, 1), cB + hstep + kstep, voffB);
        PG8_WAIT_V(6); PG8_BAR;
    }
    for (;;) {
        const bool has_next = S.next(ui + 1, nxt);
        const char* nA = has_next ? (const char*)g.A + (size_t)nxt.pm * tstep : cA; const char* nB = has_next ? (const char*)g.Bt + (size_t)nxt.pn * tstep : cB;
        for (int t = 0; t < nt; t += 2) {
            const bool last = (t == nt - 2);
            const char* a1 = cA + (size_t)(t + 1) * kstep;
            const char* a2 = last ? nA : cA + (size_t)(t + 2) * kstep; const char* b2 = last ? nB : cB + (size_t)(t + 2) * kstep;
            const char* a3 = a2 + kstep; const char* b3 = b2 + kstep;
            if (last && has_next) S.a_ready(nxt);
            if constexpr (SP2) {
            PG8_LDB(B0, 0, 0); PG8_LDB(B1, 0, 1); PG8_SCHED; PG8_LDA(At, 0, 0); PG8_STAGE(PG8_SA(1, 1), a1 + hstep, voffA);
            PG8_WAIT_V(8); PG8_WAIT_L(0); PG8_BAR; PG8_MMA(0, 0, At, B0); PG8_MMA(0, 1, At, B1); PG8_BAR; PG8_SCHED;
            PG8_LDA(At, 0, 1); PG8_STAGE(PG8_SB(0, 0), b2, voffB); PG8_STAGE(PG8_SB(0, 1), b2 + hstep, voffB); PG8_STAGE(PG8_SA(0, 0), a2, voffA);
            PG8_WAIT_V(8); PG8_WAIT_L(0); PG8_BAR; PG8_MMA(1, 0, At, B0); PG8_MMA(1, 1, At, B1); PG8_BAR; PG8_SCHED;
            PG8_LDB(B0, 1, 0); PG8_LDB(B1, 1, 1); PG8_SCHED; PG8_LDA(At, 1, 0); PG8_STAGE(PG8_SA(0, 1), a2 + hstep, voffA);
            PG8_WAIT_V(8); PG8_WAIT_L(0); PG8_BAR; PG8_MMA(0, 0, At, B0); PG8_MMA(0, 1, At, B1); PG8_BAR; PG8_SCHED;
            PG8_LDA(At, 1, 1); PG8_STAGE(PG8_SB(1, 0), b3, voffB); PG8_STAGE(PG8_SB(1, 1), b3 + hstep, voffB); PG8_STAGE(PG8_SA(1, 0), a3, voffA);
            PG8_WAIT_V(8); PG8_WAIT_L(0); PG8_BAR; PG8_MMA(1, 0, At, B0); PG8_MMA(1, 1, At, B1); PG8_BAR; PG8_SCHED;
            } else {
            PG8_LDB(B0, 0, 0); PG8_SCHED; PG8_LDA(At, 0, 0); PG8_STAGE(PG8_SA(1, 1), a1 + hstep, voffA);
            PG8_WAIT_L(8); PG8_BAR; PG8_WAIT_L(0); PG8_MMA(0, 0, At, B0); PG8_BAR; PG8_SCHED;
            PG8_LDB(B1, 0, 1); PG8_STAGE(PG8_SB(0, 0), b2, voffB);
            PG8_BAR; PG8_WAIT_L(0); PG8_MMA(0, 1, At, B1); PG8_BAR;
            PG8_LDA(At, 0, 1); PG8_STAGE(PG8_SA(0, 0), a2, voffA);
            PG8_BAR; PG8_WAIT_L(0); PG8_MMA(1, 0, At, B0); PG8_BAR; PG8_SCHED;
            PG8_STAGE(PG8_SB(0, 1), b2 + hstep, voffB);
            PG8_WAIT_V(6); PG8_BAR; PG8_MMA(1, 1, At, B1); PG8_BAR;
            PG8_LDB(B0, 1, 0); PG8_SCHED; PG8_LDA(At, 1, 0); PG8_STAGE(PG8_SA(0, 1), a2 + hstep, voffA);
            PG8_WAIT_L(8); PG8_BAR; PG8_WAIT_L(0); PG8_MMA(0, 0, At, B0); PG8_BAR; PG8_SCHED;
            PG8_LDB(B1, 1, 1); PG8_STAGE(PG8_SB(1, 0), b3, voffB);
            PG8_BAR; PG8_WAIT_L(0); PG8_MMA(0, 1, At, B1); PG8_BAR;
            PG8_LDA(At, 1, 1); PG8_STAGE(PG8_SA(1, 0), a3, voffA);
            PG8_BAR; PG8_WAIT_L(0); PG8_MMA(1, 0, At, B0); PG8_BAR; PG8_SCHED;
            PG8_STAGE(PG8_SB(1, 1), b3 + hstep, voffB);
            PG8_WAIT_V(6); PG8_BAR; PG8_MMA(1, 1, At, B1); PG8_BAR;
            }
        }
        if constexpr (ALIGN_EPI) { if (wr == 0) PG8_BAR; }
        if constexpr (!Epi::AFTER_DRAIN) { E(acc, cur, wr, wc, fr, fq); S.done(cur); }
        if (!has_next) break;
#pragma unroll
        for (int a = 0; a < 2; ++a)
#pragma unroll
            for (int b = 0; b < 2; ++b)
#pragma unroll
                for (int m = 0; m < 4; ++m)
#pragma unroll
                    for (int n = 0; n < 2; ++n) acc[a][b][m][n] = (f32x4){0.f, 0.f, 0.f, 0.f};
        cur = nxt; cA = nA; cB = nB; ++ui;
        if constexpr (ALIGN_EPI) { if (wr == 1) PG8_BAR; }
    }
    PG8_WAIT_V(0);
    if constexpr (!ALIGN_EPI) { if (wr == 0) PG8_BAR; }
    PG8_BAR;
    if constexpr (Epi::AFTER_DRAIN) { E.fused(acc, cur, wr, wc, fr, fq, lds, wid, lane); S.done(cur); }
#undef PG8_SA
#undef PG8_SB
#undef PG8_STAGE
#undef PG8_LDA
#undef PG8_LDB
#undef PG8_MMA
#undef PG8_WAIT_V
#undef PG8_WAIT_L
#undef PG8_BAR
#undef PG8_SCHED
}
}

#ifndef DBG_NOMIX
#define DBG_NOMIX 0
#endif
#ifndef DBG_NOMOE
#define DBG_NOMOE 0
#endif
#ifndef DBG_NOPOS
#define DBG_NOPOS 0
#endif
#ifndef DBG_HTCONST
#define DBG_HTCONST 0
#endif
#ifndef MK_SINGLE
#define MK_SINGLE 0
#endif
#define GAS __attribute__((address_space(1)))
#define LAS __attribute__((address_space(3)))
typedef unsigned short bf16;
typedef float f32x4 __attribute__((ext_vector_type(4)));
typedef float f32x16 __attribute__((ext_vector_type(16)));
typedef short bf16x8 __attribute__((ext_vector_type(8)));
typedef unsigned v4u __attribute__((ext_vector_type(4)));
typedef unsigned v2u __attribute__((ext_vector_type(2)));
typedef GAS unsigned gu32;

constexpr int NWAVES = 8, NTHR = 512;
constexpr int NB = 4, SEQ = 4096, DM = 1024, CTXL = 256;
constexpr int MX = NB * SEQ, MC = NB * CTXL, MT = MX + MC;
constexpr int NIN = 3328, NQ = 1536, DIN = 3104;
constexpr int NE = 16, CAP = 512;
constexpr int NCH = 68;
constexpr int NPH = 13;
constexpr float EPS = 1e-6f;

constexpr size_t MiB = 1u << 20;
constexpr size_t WS_CTL = 0, CTL_BYTES = 65536;
constexpr size_t WS_MOD = 1 * MiB, WS_POS = 1 * MiB + 256 * 1024, WS_DEC = 2 * MiB, WS_AFF = 3 * MiB, WS_SLOT = 4 * MiB, WS_SELT = 5 * MiB, WS_SELV = 5 * MiB + 256 * 1024;
constexpr size_t WS_UCTX = 6 * MiB, WS_AFB = 10 * MiB, WS_WIN = 13 * MiB, WS_WOUT = 20 * MiB;
constexpr size_t WS_R1 = 22 * MiB, WS_R2 = 56 * MiB, WS_R3 = 107 * MiB, WS_R4 = 203 * MiB, WS_R5 = 235 * MiB, WS_R6 = 267 * MiB, WS_END = 299 * MiB;
constexpr size_t WS_AIN = WS_R1, WS_ZT = WS_R1, WS_HN = WS_R1, WS_HID = WS_R1;
constexpr size_t WS_QKVG = WS_R2;
constexpr size_t WS_HYT = WS_R3, WS_WGU = WS_R3, WS_WD = 171 * MiB;
constexpr size_t WS_HT = WS_R4, WS_AOUT = WS_R4, WS_XS = WS_R4, WS_YSLAB = WS_R4;
constexpr size_t WS_SPREV = WS_R5, WS_YHYT = WS_R6;
constexpr int LDS_BYTES = 144 * 1024;
constexpr int LDS_MISC = LDS_BYTES - 256;

struct Args { const float* in[29]; float* out; unsigned char* ws; int ph_lo, ph_hi; };

#define LDS_WAIT() asm volatile("s_waitcnt lgkmcnt(0)" ::: "memory")
#define VM_WAIT() asm volatile("s_waitcnt vmcnt(0)" ::: "memory")
__device__ __forceinline__ unsigned f2bf(float f) { unsigned u = __float_as_uint(f); return (u + 0x7fffu + ((u >> 16) & 1u)) >> 16; }
__device__ __forceinline__ unsigned pk2(float lo, float hi) { return pg8::cvt_pk_bf16(lo, hi); }
__device__ __forceinline__ float bflo(unsigned w) { return __uint_as_float(w << 16); }
__device__ __forceinline__ float bfhi(unsigned w) { return __uint_as_float(w & 0xffff0000u); }
__device__ __forceinline__ float wave_sum(float v) {
#pragma unroll
    for (int o = 1; o < 64; o <<= 1) v += __shfl_xor(v, o);
    return v;
}
__device__ __forceinline__ float silu_f(float v) { return v / (1.f + __expf(-v)); }
__device__ __forceinline__ float logsig_f(float x) { return fminf(x, 0.f) - log1pf(__expf(-fabsf(x))); }

#define XB_TMO      128
#define XB_XCNT(j)  (256  + 64 * (j))
#define XB_XSUB(j)  (1280 + 64 * (j))
#define XB_XGEN(j)  (2304 + 64 * (j))
#define XB_TOP      3328
#define XB_TOPGEN   3392
#define XCD_BAR_WORDS 3456
#define XB_SPIN_CAP (1u << 22)
__device__ __forceinline__ unsigned xb_ld(unsigned* p)              { return __hip_atomic_load(p, __ATOMIC_RELAXED, __HIP_MEMORY_SCOPE_AGENT); }
__device__ __forceinline__ unsigned xb_add(unsigned* p, unsigned v) { return __hip_atomic_fetch_add(p, v, __ATOMIC_RELAXED, __HIP_MEMORY_SCOPE_AGENT); }
__device__ __forceinline__ unsigned xb_xcc_id() { return (unsigned)__builtin_amdgcn_s_getreg((3 << 11) | 20) & 0xFu; }
#define XB_SPIN(cond, bar) do { unsigned _sp = 0; while (cond) { __builtin_amdgcn_s_sleep(1); \
    if ((++_sp & 255u) == 0u) { if (xb_ld(&(bar)[XB_TMO])) break; if (_sp > XB_SPIN_CAP) { atomicAdd(&(bar)[XB_TMO], 1u); break; } } } } while (0)
struct XcdBarrier { unsigned* bar; unsigned x; volatile LAS unsigned* st; };
__device__ __forceinline__ XcdBarrier xcd_barrier_post(unsigned* bar, volatile LAS unsigned* st) {
    XcdBarrier b; b.bar = bar; b.x = xb_xcc_id(); b.st = st;
    if (threadIdx.x == 0) (void)xb_add(&bar[XB_XCNT(b.x)], 1u);
    return b;
}
__device__ __forceinline__ void xcd_barrier_complete(unsigned* bar, unsigned x, unsigned& nloc, unsigned& nx) {
    const unsigned G = gridDim.x * gridDim.y * gridDim.z;
    unsigned sum, cnt, mine, sp = 0u;
    for (;;) {
        sum = 0u; cnt = 0u; mine = 0u;
#pragma unroll
        for (unsigned j = 0; j < 16; ++j) { const unsigned c = xb_ld(&bar[XB_XCNT(j)]); sum += c; cnt += (c > 0u) ? 1u : 0u; mine = (j == x) ? c : mine; }
        if (sum == G) break;
        __builtin_amdgcn_s_sleep(1);
        if ((++sp & 255u) == 0u) { if (xb_ld(&bar[XB_TMO])) break; if (sp > XB_SPIN_CAP) { atomicAdd(&bar[XB_TMO], 1u); break; } }
    }
    nloc = mine > 0u ? mine : 1u; nx = cnt > 0u ? cnt : 1u;
}
__device__ __forceinline__ void xcd_barrier(const XcdBarrier& b) {
    asm volatile("s_waitcnt vmcnt(0)" ::: "memory");
    __syncthreads();
    if (threadIdx.x == 0) {
        unsigned* bar = b.bar;
        __builtin_amdgcn_s_waitcnt(0);
        unsigned nloc = b.st[0], nx = b.st[1];
        if (nloc == 0u) { xcd_barrier_complete(bar, b.x, nloc, nx); b.st[0] = nloc; b.st[1] = nx; }
        const unsigned old = xb_add(&bar[XB_XSUB(b.x)], 1u);
        const unsigned gen = old / nloc;
        if (old + 1u == (gen + 1u) * nloc) {
            __builtin_amdgcn_fence(__ATOMIC_RELEASE, "agent");
            asm volatile("s_waitcnt vmcnt(0)" ::: "memory");
            const unsigned og = xb_add(&bar[XB_TOP], 1u);
            const unsigned tg = og / nx;
            if (og + 1u == (tg + 1u) * nx) xb_add(&bar[XB_TOPGEN], 1u);
            else XB_SPIN(xb_ld(&bar[XB_TOPGEN]) == tg, bar);
            __builtin_amdgcn_fence(__ATOMIC_ACQUIRE, "agent");
            xb_add(&bar[XB_XGEN(b.x)], 1u);
            asm volatile("s_waitcnt vmcnt(0)" ::: "memory");
        } else {
            XB_SPIN(xb_ld(&bar[XB_XGEN(b.x)]) == gen, bar);
            __builtin_amdgcn_fence(__ATOMIC_ACQUIRE, "agent");
            asm volatile("s_waitcnt vmcnt(0)" ::: "memory");
        }
    }
    __syncthreads();
}

struct InSched {
    pg8::StaticOrder so; int G, c;
    __device__ void init(int G_, int c_) { so.init(MX, NIN, G_, c_); G = G_; c = c_; }
    __device__ bool next(int i, pg8::Unit& u) const {
        const int L = i * G + c;
        if (L < 832) return so.next(i, u);
        if (L >= 848) return false;
        const int j = L - 832; u.pm = 64 + (j & 3); const int q = j >> 2; u.pn = (q == 3) ? 12 : (1 + q); return true;
    }
    __device__ __forceinline__ void a_ready(const pg8::Unit&) const {}
    __device__ __forceinline__ void done(const pg8::Unit&) const {}
};
template <int NT> struct MoeSched {
    int G, c;
    __device__ void init(int G_, int c_) { G = G_; c = c_; }
    __device__ bool next(int i, pg8::Unit& u) const {
        const int L = i * G + c; if (L >= NE * 8 * NT) return false;
        const int e = L / (8 * NT), l = L % (8 * NT); u.pm = e * 8 + (l & 7); u.pn = e * NT + (l >> 3); return true;
    }
    __device__ __forceinline__ void a_ready(const pg8::Unit&) const {}
    __device__ __forceinline__ void done(const pg8::Unit&) const {}
};

struct EpiIn {
    static constexpr bool PERM = true, AFTER_DRAIN = false;
    bf16* qkvg; float* hyT; float* afb;
    __device__ __forceinline__ void operator()(const f32x4 (&acc)[2][2][4][2], const pg8::Unit& u, int wr, int wc, int fr, int fq) const {
        const int row0 = u.pm * 256 + wr * 64 + fr;
        if (u.pn < 6) {
            const float sc = (u.pn == 0) ? 0.125f : 1.f;
            const int col0 = u.pn * 256 + wc * 32 + 8 * fq;
#pragma unroll
            for (int ai = 0; ai < 2; ++ai)
#pragma unroll
                for (int m = 0; m < 4; ++m) { bf16* rowp = qkvg + (size_t)(row0 + ai * 128 + m * 16) * NQ + col0;
#pragma unroll
                    for (int bj = 0; bj < 2; ++bj) { const f32x4 v0 = acc[ai][bj][m][0] * sc, v1 = acc[ai][bj][m][1] * sc;
                        v4u w; w.x = pk2(v0[0], v0[1]); w.y = pk2(v0[2], v0[3]); w.z = pk2(v1[0], v1[1]); w.w = pk2(v1[2], v1[3]);
                        *(v4u*)(rowp + bj * 128) = w; } }
        } else if (u.pn < 12) {
            if (u.pm >= 64) return;
            const int ch0 = (u.pn - 6) * 256 + wc * 32 + 8 * fq;
#pragma unroll
            for (int ai = 0; ai < 2; ++ai)
#pragma unroll
                for (int m = 0; m < 4; ++m) { const int r = row0 + ai * 128 + m * 16; const int b = r >> 12, t = r & 4095;
                    float* bp = hyT + (size_t)b * 1536 * SEQ + t;
#pragma unroll
                    for (int bj = 0; bj < 2; ++bj)
#pragma unroll
                        for (int n = 0; n < 2; ++n)
#pragma unroll
                            for (int j = 0; j < 4; ++j) bp[(size_t)(ch0 + bj * 128 + 4 * n + j) * SEQ] = acc[ai][bj][m][n][j]; }
        } else {
            if (wc != 0) return;
#pragma unroll
            for (int ai = 0; ai < 2; ++ai)
#pragma unroll
                for (int m = 0; m < 4; ++m) { float* rowp = afb + (size_t)(row0 + ai * 128 + m * 16) * 32 + 8 * fq;
                    *(f32x4*)(rowp) = acc[ai][0][m][0]; *(f32x4*)(rowp + 4) = acc[ai][0][m][1]; }
        }
    }
};
struct EpiOut {
    static constexpr bool PERM = false, AFTER_DRAIN = false;
    const float* x; const float* postab; const float* modr; float* x1;
    __device__ __forceinline__ void operator()(const f32x4 (&acc)[2][2][4][2], const pg8::Unit& u, int wr, int wc, int fr, int fq) const {
        const int row0 = u.pm * 256 + wr * 64 + fr, col0 = u.pn * 256 + wc * 32 + 4 * fq;
#pragma unroll
        for (int ai = 0; ai < 2; ++ai)
#pragma unroll
            for (int m = 0; m < 4; ++m) { const int r = row0 + ai * 128 + m * 16; const int b = r >> 12, t = r & 4095, rr = t >> 6, cc = t & 63;
                const float* gate = modr + b * 6144 + 2048;
#pragma unroll
                for (int bj = 0; bj < 2; ++bj)
#pragma unroll
                    for (int n = 0; n < 2; ++n) { const int c = col0 + bj * 128 + n * 16;
                        const f32x4 xv = *(const f32x4*)(x + (size_t)r * DM + c);
                        const f32x4 pv = (c < 512) ? *(const f32x4*)(postab + rr * 512 + c) : *(const f32x4*)(postab + cc * 512 + c - 512);
                        const f32x4 gv = *(const f32x4*)(gate + c);
                        *(f32x4*)(x1 + (size_t)r * DM + c) = xv + (DBG_NOPOS ? pv * 0.f : pv) + (DBG_NOMIX ? gv * 0.f : gv * acc[ai][bj][m][n]); } }
    }
};
struct EpiGU {
    static constexpr bool PERM = true, AFTER_DRAIN = false;
    bf16* hid;
    __device__ __forceinline__ void operator()(const f32x4 (&acc)[2][2][4][2], const pg8::Unit& u, int wr, int wc, int fr, int fq) const {
        const int row0 = u.pm * 256 + wr * 64 + fr, col0 = (u.pn & 7) * 128 + wc * 32 + 8 * fq;
#pragma unroll
        for (int ai = 0; ai < 2; ++ai)
#pragma unroll
            for (int m = 0; m < 4; ++m) { bf16* rowp = hid + (size_t)(row0 + ai * 128 + m * 16) * DM + col0;
                float o[8];
#pragma unroll
                for (int n = 0; n < 2; ++n)
#pragma unroll
                    for (int j = 0; j < 4; ++j) o[n * 4 + j] = silu_f(acc[ai][0][m][n][j]) * acc[ai][1][m][n][j];
                v4u w; w.x = pk2(o[0], o[1]); w.y = pk2(o[2], o[3]); w.z = pk2(o[4], o[5]); w.w = pk2(o[6], o[7]);
                *(v4u*)rowp = w; }
    }
};
struct EpiDown {
    static constexpr bool PERM = true, AFTER_DRAIN = false;
    bf16* ys; const float* selv;
    __device__ __forceinline__ void operator()(const f32x4 (&acc)[2][2][4][2], const pg8::Unit& u, int wr, int wc, int fr, int fq) const {
        const int row0 = u.pm * 256 + wr * 64 + fr, col0 = (u.pn & 3) * 256 + wc * 32 + 8 * fq;
#pragma unroll
        for (int ai = 0; ai < 2; ++ai)
#pragma unroll
            for (int m = 0; m < 4; ++m) { const int r = row0 + ai * 128 + m * 16; const float sc = selv[r]; bf16* rowp = ys + (size_t)r * DM + col0;
#pragma unroll
                for (int bj = 0; bj < 2; ++bj) { const f32x4 v0 = acc[ai][bj][m][0] * sc, v1 = acc[ai][bj][m][1] * sc;
                    v4u w; w.x = pk2(v0[0], v0[1]); w.y = pk2(v0[2], v0[3]); w.z = pk2(v1[0], v1[1]); w.w = pk2(v1[2], v1[3]);
                    *(v4u*)(rowp + bj * 128) = w; } }
    }
};

__device__ __forceinline__ void transpose_item(const float* W, int ldw, int k0, int nsrc0, bf16* WT, int K, int drow0, LAS float* scr, int lane, bool zero) {
#pragma unroll 8
    for (int i = 0; i < 32; ++i) { const int kk = 2 * i + (lane >> 5); scr[kk * 33 + (lane & 31)] = zero ? 0.f : W[(size_t)(k0 + kk) * ldw + nsrc0 + (lane & 31)]; }
    LDS_WAIT();
    const int c = lane & 7;
#pragma unroll
    for (int j = 0; j < 4; ++j) { const int n = (lane >> 3) + 8 * j; const LAS float* s = scr + (8 * c) * 33 + n;
        v4u o; o.x = pk2(s[0 * 33], s[1 * 33]); o.y = pk2(s[2 * 33], s[3 * 33]); o.z = pk2(s[4 * 33], s[5 * 33]); o.w = pk2(s[6 * 33], s[7 * 33]);
        *(v4u*)(WT + (size_t)(drow0 + n) * K + k0 + 8 * c) = o; }
    LDS_WAIT();
}

__device__ __forceinline__ void phase0(const Args& a, LAS unsigned char* lds) {
    int tid = threadIdx.x; const int wg = blockIdx.x, G = gridDim.x;
    asm volatile("" : "+v"(tid));
    int lane = tid & 63, wave = tid >> 6;
    unsigned char* ws = a.ws;
    for (int it = wg; it < 192; it += G) {
        LAS float* sl = (LAS float*)lds;
        LAS float* red = (LAS float*)(lds + 20480);
        for (int i = tid; i < 5 * 1024; i += NTHR) { const int bb = i >> 10, k = i & 1023; const float v = (bb < 4) ? a.in[1][bb * 1024 + k] : a.in[3][k]; sl[i] = silu_f(v); }
        __syncthreads();
        const int col = it * 32 + (lane & 31), kk = wave * 2 + (lane >> 5);
        float acc[5] = {0.f, 0.f, 0.f, 0.f, 0.f};
        const float* wp = a.in[4] + col;
#pragma unroll 8
        for (int j = 0; j < 64; ++j) { const int k = kk + 16 * j; const float w = wp[(size_t)k * 6144];
#pragma unroll
            for (int bb = 0; bb < 5; ++bb) acc[bb] += sl[bb * 1024 + k] * w; }
#pragma unroll
        for (int bb = 0; bb < 5; ++bb) red[(kk * 5 + bb) * 32 + (lane & 31)] = acc[bb];
        __syncthreads();
        if (tid < 160) { const int bb = tid >> 5, cl = tid & 31; float s = 0.f;
#pragma unroll
            for (int q = 0; q < 16; ++q) s += red[(q * 5 + bb) * 32 + cl];
            ((float*)(ws + WS_MOD))[bb * 6144 + it * 32 + cl] = s + a.in[5][it * 32 + cl]; }
        __syncthreads();
    }
    for (int it = wg; it < 256; it += G) {
        asm volatile("" : "+v"(tid));
        LAS float* zl = (LAS float*)lds;
        LAS float* h1 = (LAS float*)(lds + 4096);
        LAS float* h2 = (LAS float*)(lds + 8192);
        const int i0 = it * 16;
        for (int o = tid; o < 16 * 33; o += NTHR) { const int li = o / 33, j = o % 33; const int i = i0 + li;
            const float ti = (float)i * (1.0f / 4095.0f);
            const float wi = (6.2831855f * (float)i) / 4096.0f;
            float v;
            if (j == 0) v = ti;
            else { const int jj = (j - 1) & 15; const float f = 1e-4f + (float)jj * ((15.0f - 1e-4f) / 15.0f); const float ar = f * wi; v = (j <= 16) ? cosf(ar) : -sinf(ar); }
            zl[li * 36 + j] = v; }
        __syncthreads();
#pragma unroll
        for (int q = 0; q < 2; ++q) { const int o = tid + NTHR * q, li = o >> 6, m = o & 63; float s = a.in[16][m];
            for (int j = 0; j < 33; ++j) s += zl[li * 36 + j] * a.in[15][j * 64 + m];
            h1[li * 64 + m] = sinf(a.in[20][m] * s); }
        __syncthreads();
#pragma unroll
        for (int q = 0; q < 2; ++q) { const int o = tid + NTHR * q, li = o >> 6, m = o & 63; float s = a.in[18][m];
            for (int k = 0; k < 64; ++k) s += h1[li * 64 + k] * a.in[17][k * 64 + m];
            h2[li * 64 + m] = sinf(a.in[20][m] * s); }
        __syncthreads();
        f32x4 acc[16];
#pragma unroll
        for (int li = 0; li < 16; ++li) acc[li] = (f32x4){0.f, 0.f, 0.f, 0.f};
        const float* w3 = a.in[19] + tid * 4;
        for (int k = 0; k < 64; ++k) { const f32x4 w = *(const f32x4*)(w3 + k * 2048);
#pragma unroll
            for (int li = 0; li < 16; ++li) acc[li] += w * h2[li * 64 + k]; }
        float* hT = (float*)(ws + WS_HT);
#pragma unroll
        for (int j = 0; j < 4; ++j) { const int col = tid * 4 + j, od = col >> 9, c = col & 511;
            const float delta = 3.0701134573f + (float)c * ((15.3505672866f - 3.0701134573f) / 511.0f);
            float* dst = hT + ((size_t)od * 512 + c) * SEQ + i0;
#pragma unroll
            for (int q = 0; q < 4; ++q) { f32x4 o;
#pragma unroll
                for (int s = 0; s < 4; ++s) { const int li = q * 4 + s; const float ti = (float)(i0 + li) * (1.0f / 4095.0f); o[s] = DBG_HTCONST == 1 ? 1.0f : DBG_HTCONST == 2 ? zl[li * 36 + (col % 33)] : DBG_HTCONST == 3 ? h1[li * 64 + (col & 63)] : DBG_HTCONST == 4 ? h2[li * 64 + (col & 63)] : DBG_HTCONST == 5 ? acc[li][j] : acc[li][j] * __expf(-ti * delta); }
                *(f32x4*)(dst + q * 4) = o; } }
        __syncthreads();
    }
    {
        asm volatile("" : "+v"(tid)); lane = tid & 63; wave = tid >> 6;
        LAS float* scr = (LAS float*)(lds + wave * 8448);
        const int gw = wg * NWAVES + wave, NGW = G * NWAVES;
        constexpr int I_IN = 104 * 16, I_OUT = 32 * 16;
        for (int it = gw; it < I_IN + I_OUT; it += NGW) {
            if (it < I_IN) { const int nb = it >> 4, kb = it & 15, n0 = nb * 32;
                const int ns = (n0 < 1536) ? n0 : (n0 < 3072 ? n0 + 32 : 1536 + (n0 - 3072));
                transpose_item(a.in[7], DIN, kb * 64, (n0 < DIN) ? ns : 0, (bf16*)(ws + WS_WIN), DM, n0, scr, lane, n0 >= DIN);
            } else { const int r = it - I_IN, nb = r >> 4, kb = r & 15;
                transpose_item(a.in[22], DM, kb * 64, nb * 32, (bf16*)(ws + WS_WOUT), DM, nb * 32, scr, lane, false); }
        }
    }
    for (int e = wg * NTHR + tid; e < 64 * 256; e += G * NTHR) { const int i = e >> 8, j = e & 255;
        const float om = 1.0f / powf(10000.0f, (float)j * (1.0f / 256.0f)); const float er = (float)i * om;
        float* pt = (float*)(ws + WS_POS); pt[i * 512 + j] = sinf(er); pt[i * 512 + 256 + j] = cosf(er); }
}

__device__ __forceinline__ void phase1(const Args& a, LAS unsigned char* lds) {
    const int tid = threadIdx.x, lane = tid & 63, wave = tid >> 6, wg = blockIdx.x, G = gridDim.x;
    unsigned char* ws = a.ws;
    const float* modr = (const float*)(ws + WS_MOD); const float* pt = (const float*)(ws + WS_POS); bf16* ain = (bf16*)(ws + WS_AIN);
    const float* gmix = a.in[6];
    for (int r = wg * NWAVES + wave; r < MT; r += G * NWAVES) {
        const float* src; int bb; int rr = 0, cc = 0; const bool lat = r < MX;
        if (lat) { src = a.in[0] + (size_t)r * DM; bb = r >> 12; const int t = r & 4095; rr = t >> 6; cc = t & 63; }
        else { src = a.in[2] + (size_t)(r - MX) * DM; bb = 4; }
        f32x4 v[4]; float ss = 0.f;
#pragma unroll
        for (int j = 0; j < 4; ++j) { const int col = 4 * lane + 256 * j; v[j] = *(const f32x4*)(src + col);
            if (lat) v[j] += (j < 2) ? *(const f32x4*)(pt + rr * 512 + col) : *(const f32x4*)(pt + cc * 512 + col - 512);
            ss += v[j][0] * v[j][0] + v[j][1] * v[j][1] + v[j][2] * v[j][2] + v[j][3] * v[j][3]; }
        const float rs = rsqrtf(wave_sum(ss) * (1.0f / DM) + EPS);
#pragma unroll
        for (int j = 0; j < 4; ++j) { const int col = 4 * lane + 256 * j;
            const f32x4 g = *(const f32x4*)(gmix + col), sh = *(const f32x4*)(modr + bb * 6144 + col), sc = *(const f32x4*)(modr + bb * 6144 + 1024 + col);
            const f32x4 y = (v[j] * rs * g) * (sc + 1.0f) + sh;
            v2u w; w.x = pk2(y[0], y[1]); w.y = pk2(y[2], y[3]);
            *(v2u*)(ain + (size_t)r * DM + col) = w; }
    }
}

typedef float cpx __attribute__((ext_vector_type(2)));
__device__ __forceinline__ cpx make_cpx(float x, float y) { cpx r; r.x = x; r.y = y; return r; }
__device__ __forceinline__ cpx cmul(cpx a, cpx b) { return make_cpx(a.x * b.x - a.y * b.y, a.x * b.y + a.y * b.x); }
__device__ __forceinline__ cpx cadd(cpx a, cpx b) { return make_cpx(a.x + b.x, a.y + b.y); }
__device__ __forceinline__ cpx csub(cpx a, cpx b) { return make_cpx(a.x - b.x, a.y - b.y); }
__device__ __forceinline__ cpx cconj(cpx a) { return make_cpx(a.x, -a.y); }
__device__ __forceinline__ cpx twid(float turns) { return make_cpx(__builtin_amdgcn_cosf(turns), -__builtin_amdgcn_sinf(turns)); }
__device__ __forceinline__ void dft4(cpx& a0, cpx& a1, cpx& a2, cpx& a3) {
    const cpx t0 = cadd(a0, a2), t1 = csub(a0, a2), t2 = cadd(a1, a3), t3 = csub(a1, a3);
    a0 = cadd(t0, t2); a2 = csub(t0, t2);
    a1 = make_cpx(t1.x + t3.y, t1.y - t3.x);
    a3 = make_cpx(t1.x - t3.y, t1.y + t3.x);
}
__device__ __forceinline__ void dft16(cpx (&v)[16]) {
    cpx t[16];
#pragma unroll
    for (int j = 0; j < 4; ++j) { cpx b0 = v[j], b1 = v[j + 4], b2 = v[j + 8], b3 = v[j + 12]; dft4(b0, b1, b2, b3); t[4 * j] = b0; t[4 * j + 1] = b1; t[4 * j + 2] = b2; t[4 * j + 3] = b3; }
    const float C1 = 0.92387953251f, S1 = 0.38268343236f, R2 = 0.70710678118f;
    const cpx W1 = make_cpx(C1, -S1), W2 = make_cpx(R2, -R2), W3 = make_cpx(S1, -C1), W4 = make_cpx(0.f, -1.f), W6 = make_cpx(-R2, -R2), W9 = make_cpx(-C1, S1);
    {   cpx b0 = t[0], b1 = t[4], b2 = t[8], b3 = t[12]; dft4(b0, b1, b2, b3); v[0] = b0; v[4] = b1; v[8] = b2; v[12] = b3; }
    {   cpx b0 = t[1], b1 = cmul(t[5], W1), b2 = cmul(t[9], W2), b3 = cmul(t[13], W3); dft4(b0, b1, b2, b3); v[1] = b0; v[5] = b1; v[9] = b2; v[13] = b3; }
    {   cpx b0 = t[2], b1 = cmul(t[6], W2), b2 = cmul(t[10], W4), b3 = cmul(t[14], W6); dft4(b0, b1, b2, b3); v[2] = b0; v[6] = b1; v[10] = b2; v[14] = b3; }
    {   cpx b0 = t[3], b1 = cmul(t[7], W3), b2 = cmul(t[11], W6), b3 = cmul(t[15], W9); dft4(b0, b1, b2, b3); v[3] = b0; v[7] = b1; v[11] = b2; v[15] = b3; }
}
#define FPAD(i) ((i) + ((i) >> 4))
constexpr int FFT_STRIDE = 4352;
__device__ __forceinline__ void fft_dual(LAS cpx* buf) {
#pragma unroll
    for (int p = 0; p < 3; ++p) {
        int tid = threadIdx.x; asm volatile("" : "+v"(tid));
        const int j = tid & 255;
        LAS cpx* b = buf + (tid >> 8) * FFT_STRIDE;
        const int Ns = 1 << (4 * p);
        const int k = j & (Ns - 1);
        cpx v[16];
        LAS cpx* rd = b + FPAD(j);
#pragma unroll
        for (int r = 0; r < 16; ++r) v[r] = rd[272 * r];
        if (p > 0) {
            const float ang = (float)k / (float)(Ns * 16);
#pragma unroll
            for (int r = 1; r < 16; ++r) v[r] = cmul(v[r], twid(ang * (float)r));
        }
        dft16(v);
        __syncthreads();
        const int j0 = ((j - k) << 4) + k;
        LAS cpx* wrp = b + FPAD(j0);
        const int ws = (p == 0) ? 1 : (p == 1 ? 17 : 272);
#pragma unroll
        for (int q = 0; q < 16; ++q) wrp[ws * q] = v[q];
        __syncthreads();
    }
}

__device__ __forceinline__ void hyena_item(const Args& a, LAS unsigned char* lds, int c, int stage) {
    int tid = threadIdx.x; asm volatile("" : "+v"(tid));
    unsigned char* ws = a.ws;
    LAS cpx* buf0 = (LAS cpx*)lds;
    LAS cpx* buf1 = (LAS cpx*)(lds + 2 * FFT_STRIDE * 8);
    const float* hT = (const float*)(ws + WS_HT);
    const float* hf = hT + ((size_t)(stage * 2 + 0) * 512 + c) * SEQ;
    const float* hb = hT + ((size_t)(stage * 2 + 1) * 512 + c) * SEQ;
    const float* hyT = (const float*)(ws + WS_HYT);
    const float* zT = (const float*)(ws + WS_ZT);
    float* outp = (float*)(ws + (stage == 0 ? WS_ZT : WS_YHYT));
    const float* cw = a.in[13]; const float* cb = a.in[14];
    const int chu = c, chg = (stage == 0 ? 512 : 1024) + c;
    const float wu0 = cw[chu], wu1 = cw[1536 + chu], wu2 = cw[3072 + chu], bu = cb[chu];
    const float wg0 = cw[chg], wg1 = cw[1536 + chg], wg2 = cw[3072 + chg], bg = cb[chg];
    const float bias = a.in[21][stage * 512 + c];
    int ptid = FPAD(tid);
#pragma unroll
    for (int i = 0; i < 8; ++i) { const int n = tid + NTHR * i; const int pn = ptid + 544 * i; const float f = hf[n]; const float g = n ? hb[SEQ - n] : 0.f;
        const cpx w = twid((float)n * (1.0f / 8192.0f)); const float d = f - g;
        buf1[pn] = make_cpx(f + g, 0.f); buf1[FFT_STRIDE + pn] = make_cpx(d * w.x, d * w.y); }
    __syncthreads();
    fft_dual(buf1);
    for (int bp = 0; bp < 2; ++bp) {
        asm volatile("" : "+v"(tid)); ptid = FPAD(tid);
        const int b0 = 2 * bp, b1 = 2 * bp + 1;
        float u0[8], u1[8];
#pragma unroll
        for (int i = 0; i < 8; ++i) { const int n = tid + NTHR * i; const int pn = ptid + 544 * i;
            if (stage == 0) {
                const float* p0 = hyT + ((size_t)b0 * 1536 + chu) * SEQ + n; const float* p1 = hyT + ((size_t)b1 * 1536 + chu) * SEQ + n;
                const float l0 = n ? p0[-1] : 0.f, r0 = (n < SEQ - 1) ? p0[1] : 0.f, l1 = n ? p1[-1] : 0.f, r1 = (n < SEQ - 1) ? p1[1] : 0.f;
                u0[i] = wu0 * l0 + wu1 * p0[0] + wu2 * r0 + bu; u1[i] = wu0 * l1 + wu1 * p1[0] + wu2 * r1 + bu;
            } else { u0[i] = zT[((size_t)b0 * 512 + c) * SEQ + n]; u1[i] = zT[((size_t)b1 * 512 + c) * SEQ + n]; }
            const cpx x = make_cpx(u0[i], u1[i]); const cpx w = twid((float)n * (1.0f / 8192.0f));
            buf0[pn] = x; buf0[FFT_STRIDE + pn] = cmul(x, w); }
        __syncthreads();
        fft_dual(buf0);
#pragma unroll
        for (int i = 0; i < 8; ++i) { const int n = tid + NTHR * i; const int pn = ptid + 544 * i;
            const cpx ye = cmul(buf0[pn], buf1[pn]), yo = cmul(buf0[FFT_STRIDE + pn], buf1[FFT_STRIDE + pn]);
            buf0[pn] = cconj(ye); buf0[FFT_STRIDE + pn] = cconj(yo); }
        __syncthreads();
        fft_dual(buf0);
#pragma unroll
        for (int i = 0; i < 8; ++i) { const int n = tid + NTHR * i; const int pn = ptid + 544 * i;
            const cpx ye = cconj(buf0[pn]), yo = cconj(buf0[FFT_STRIDE + pn]);
            const cpx w = twid((float)n * (1.0f / 8192.0f));
            const cpx y = cadd(ye, cmul(cconj(w), yo));
            const float y0 = y.x * (1.0f / 8192.0f) + bias * u0[i], y1 = y.y * (1.0f / 8192.0f) + bias * u1[i];
            const float* g0 = hyT + ((size_t)b0 * 1536 + chg) * SEQ + n; const float* g1 = hyT + ((size_t)b1 * 1536 + chg) * SEQ + n;
            const float l0 = n ? g0[-1] : 0.f, r0 = (n < SEQ - 1) ? g0[1] : 0.f, l1 = n ? g1[-1] : 0.f, r1 = (n < SEQ - 1) ? g1[1] : 0.f;
            const float gg0 = wg0 * l0 + wg1 * g0[0] + wg2 * r0 + bg, gg1 = wg0 * l1 + wg1 * g1[0] + wg2 * r1 + bg;
            outp[((size_t)b0 * 512 + c) * SEQ + n] = gg0 * y0; outp[((size_t)b1 * 512 + c) * SEQ + n] = gg1 * y1; }
        __syncthreads();
    }
}

__device__ __forceinline__ f32x16 mfma32(bf16x8 a, bf16x8 b, f32x16 c) { return __builtin_amdgcn_mfma_f32_32x32x16_bf16(a, b, c, 0, 0, 0); }

__device__ __forceinline__ void gla_decay_tables(const Args& a, int h, size_t rowbase, LAS float* P, LAS float* X, LAS float* aL, LAS float* wa) {
    const int tid = threadIdx.x;
    const float* afb = (const float*)(a.ws + WS_AFB);
    { const int s = tid >> 3, q = tid & 7; *(LAS f32x4*)(aL + s * 32 + 4 * q) = *(const f32x4*)(afb + (rowbase + s) * 32 + 4 * q); }
    for (int i = tid; i < 2048; i += NTHR) { const int dir = i >> 10, j = (i >> 6) & 15, d = i & 63; wa[i] = (dir ? a.in[10] : a.in[8])[j * 256 + h * 64 + d]; }
    __syncthreads();
    { const int d = tid & 63, sg = tid >> 6; const float bf = a.in[9][h * 64 + d], bb = a.in[11][h * 64 + d];
#pragma unroll
        for (int q = 0; q < 8; ++q) { const int s = sg * 8 + q; float pf = bf, pb = bb;
#pragma unroll
            for (int j = 0; j < 16; ++j) { pf += aL[s * 32 + j] * wa[j * 64 + d]; pb += aL[s * 32 + 16 + j] * wa[1024 + j * 64 + d]; }
            P[s * 65 + d] = logsig_f(pf) * (1.0f / 16.0f); X[s * 65 + d] = logsig_f(pb) * (1.0f / 16.0f); } }
    __syncthreads();
    if (tid < 64) { float c = 0.f; for (int s = 0; s < 64; ++s) { c += P[s * 65 + tid]; P[s * 65 + tid] = c; } }
    else if (tid < 128) { const int d = tid - 64; float c = 0.f; for (int s = 63; s >= 0; --s) { c += X[s * 65 + d]; X[s * 65 + d] = c; } }
    __syncthreads();
}

__device__ __forceinline__ void gla_upd_item(const Args& a, LAS unsigned char* lds, int bh, int ci) {
    const int tid = threadIdx.x, lane = tid & 63, wave = tid >> 6, b = bh >> 2, h = bh & 3;
    unsigned char* ws = a.ws;
    LAS float* P = (LAS float*)lds; LAS float* X = (LAS float*)(lds + 16640);
    LAS bf16* vT = (LAS bf16*)(lds + 33280);
    LAS bf16* kfT = (LAS bf16*)(lds + 33280 + 18432);
    LAS bf16* kbT = (LAS bf16*)(lds + 33280 + 18432 + 9216);
    LAS float* aL = (LAS float*)(lds + 70144); LAS float* wa = (LAS float*)(lds + 70144 + 8192);
    const size_t rowbase = (ci < 4) ? (size_t)(MX + b * CTXL + ci * 64) : (size_t)(b * SEQ + (ci - 4) * 64);
    const bf16* qkvg = (const bf16*)(ws + WS_QKVG);
    gla_decay_tables(a, h, rowbase, P, X, aL, wa);
    { const int s = tid >> 3, dq = (tid & 7) * 8;
        const v4u kw = *(const v4u*)(qkvg + (rowbase + s) * NQ + 256 + h * 64 + dq);
        float kv[8] = {bflo(kw.x), bfhi(kw.x), bflo(kw.y), bfhi(kw.y), bflo(kw.z), bfhi(kw.z), bflo(kw.w), bfhi(kw.w)};
#pragma unroll
        for (int j = 0; j < 8; ++j) { const int d = dq + j;
            const float kf = kv[j] * __expf(P[63 * 65 + d] - P[s * 65 + d]), kb = kv[j] * __expf(X[d] - X[s * 65 + d]);
            kfT[d * 72 + s] = (bf16)f2bf(kf); kbT[d * 72 + s] = (bf16)f2bf(kb); } }
#pragma unroll
    for (int q = 0; q < 2; ++q) { const int idx = tid + NTHR * q, s = idx >> 4, e8 = (idx & 15) * 8;
        const v4u vw = *(const v4u*)(qkvg + (rowbase + s) * NQ + 512 + h * 128 + e8);
        const unsigned w[4] = {vw.x, vw.y, vw.z, vw.w};
#pragma unroll
        for (int j = 0; j < 4; ++j) { vT[(e8 + 2 * j) * 72 + s] = (bf16)(w[j] & 0xffffu); vT[(e8 + 2 * j + 1) * 72 + s] = (bf16)(w[j] >> 16); } }
    float* dec = (float*)(ws + WS_DEC);
    if (tid < 64) dec[((size_t)(bh * 2 + 0) * NCH + ci) * 64 + tid] = __expf(P[63 * 65 + tid]);
    else if (tid < 128) dec[((size_t)(bh * 2 + 1) * NCH + ci) * 64 + tid - 64] = __expf(X[tid - 64]);
    __syncthreads();
    { const int dir = wave >> 2, e0 = (wave & 3) * 32, l31 = lane & 31, hh = lane >> 5;
        LAS bf16* kT = dir ? kbT : kfT;
        float* U = (ci < 4) ? (float*)(ws + WS_UCTX) + ((size_t)(bh * 2 + dir) * 4 + ci) * 8192 : a.out + ((size_t)(bh * 2 + dir) * 64 + (ci - 4)) * 8192;
#pragma unroll
        for (int dt = 0; dt < 2; ++dt) { const int d0 = dt * 32; f32x16 acc;
#pragma unroll
            for (int i = 0; i < 16; ++i) acc[i] = 0.f;
#pragma unroll
            for (int ks = 0; ks < 4; ++ks) { const bf16x8 A = *(const LAS bf16x8*)(vT + (e0 + l31) * 72 + 16 * ks + 8 * hh), B = *(const LAS bf16x8*)(kT + (d0 + l31) * 72 + 16 * ks + 8 * hh);
                acc = mfma32(A, B, acc); }
#pragma unroll
            for (int r = 0; r < 16; ++r) { const int e = e0 + (r & 3) + 8 * (r >> 2) + 4 * hh; U[e * 64 + d0 + l31] = acc[r]; } } }
    __syncthreads();
}

__device__ __forceinline__ void gla_scan_item(const Args& a, int it) {
    const int tid = threadIdx.x, bd = it >> 4, dir = bd & 1, el = ((it & 15) * 8 + (tid >> 6)) * 64 + (tid & 63), d = tid & 63;
    unsigned char* ws = a.ws;
    const float* dec = (const float*)(ws + WS_DEC) + (size_t)bd * NCH * 64 + d;
    const float* Uc = (const float*)(ws + WS_UCTX) + (size_t)bd * 4 * 8192 + el;
    const float* U = a.out + (size_t)bd * 64 * 8192 + el;
    bf16* Sp = (bf16*)(ws + WS_SPREV) + (size_t)bd * 64 * 8192 + el;
    float S = 0.f;
    if (dir == 0) {
#pragma unroll
        for (int ci = 0; ci < 4; ++ci) S = dec[ci * 64] * S + Uc[(size_t)ci * 8192];
#pragma unroll 8
        for (int n = 0; n < 64; ++n) { Sp[(size_t)n * 8192] = (bf16)f2bf(S); S = dec[(4 + n) * 64] * S + U[(size_t)n * 8192]; }
    } else {
#pragma unroll
        for (int ci = 3; ci >= 0; --ci) S = dec[ci * 64] * S + Uc[(size_t)ci * 8192];
#pragma unroll 8
        for (int n = 63; n >= 0; --n) { Sp[(size_t)n * 8192] = (bf16)f2bf(S); S = dec[(4 + n) * 64] * S + U[(size_t)n * 8192]; }
    }
}

__device__ __forceinline__ void gla_out_item(const Args& a, LAS unsigned char* lds, int bh, int n) {
    const int tid = threadIdx.x, lane = tid & 63, wave = tid >> 6, b = bh >> 2, h = bh & 3, l31 = lane & 31, hh = lane >> 5;
    unsigned char* ws = a.ws;
    LAS float* P = (LAS float*)lds; LAS float* X = (LAS float*)(lds + 16640);
    LAS bf16* Scat = (LAS bf16*)lds;
    LAS bf16* qf = (LAS bf16*)(lds + 33280);
    LAS bf16* qb = qf + 4608; LAS bf16* kf = qf + 2 * 4608; LAS bf16* kb = qf + 3 * 4608;
    LAS float* oS = (LAS float*)(lds + 33280);
    LAS bf16* qS = (LAS bf16*)(lds + 70144);
    LAS float* aL = (LAS float*)(lds + 70144); LAS float* wa = (LAS float*)(lds + 70144 + 8192);
    LAS bf16* vT = (LAS bf16*)(lds + 87552);
    LAS bf16* Sp = (LAS bf16*)(lds + 105984);
    const size_t rowbase = (size_t)b * SEQ + n * 64;
    const bf16* qkvg = (const bf16*)(ws + WS_QKVG);
    gla_decay_tables(a, h, rowbase, P, X, aL, wa);
    { const bf16* spf = (const bf16*)(ws + WS_SPREV) + ((size_t)(bh * 2 + 0) * 64 + n) * 8192; const bf16* spb = (const bf16*)(ws + WS_SPREV) + ((size_t)(bh * 2 + 1) * 64 + n) * 8192;
#pragma unroll
        for (int q = 0; q < 4; ++q) { const int idx = tid + NTHR * q, dir = idx >> 10, e = (idx >> 3) & 127, d8 = (idx & 7) * 8;
            *(LAS v4u*)(Sp + e * 136 + dir * 64 + d8) = *(const v4u*)((dir ? spb : spf) + e * 64 + d8); } }
#pragma unroll
    for (int q = 0; q < 2; ++q) { const int idx = tid + NTHR * q, s = idx >> 4, e8 = (idx & 15) * 8;
        const v4u vw = *(const v4u*)(qkvg + (rowbase + s) * NQ + 512 + h * 128 + e8);
        const unsigned w[4] = {vw.x, vw.y, vw.z, vw.w};
#pragma unroll
        for (int j = 0; j < 4; ++j) { vT[(e8 + 2 * j) * 72 + s] = (bf16)(w[j] & 0xffffu); vT[(e8 + 2 * j + 1) * 72 + s] = (bf16)(w[j] >> 16); } }
    { const int s = tid >> 3, dq = (tid & 7) * 8;
        const v4u qw = *(const v4u*)(qkvg + (rowbase + s) * NQ + h * 64 + dq), kw = *(const v4u*)(qkvg + (rowbase + s) * NQ + 256 + h * 64 + dq);
        const float qv[8] = {bflo(qw.x), bfhi(qw.x), bflo(qw.y), bfhi(qw.y), bflo(qw.z), bfhi(qw.z), bflo(qw.w), bfhi(qw.w)};
        const float kv[8] = {bflo(kw.x), bfhi(kw.x), bflo(kw.y), bfhi(kw.y), bflo(kw.z), bfhi(kw.z), bflo(kw.w), bfhi(kw.w)};
        float o_qf[8], o_qb[8], o_kf[8], o_kb[8], o_sf[8], o_sb[8];
#pragma unroll
        for (int j = 0; j < 8; ++j) { const int d = dq + j; const float Ps = P[s * 65 + d], Pm = P[32 * 65 + d], Xs = X[s * 65 + d], Xm = X[31 * 65 + d];
            o_qf[j] = qv[j] * __expf(Ps - Pm); o_kf[j] = kv[j] * __expf(Pm - Ps); o_sf[j] = qv[j] * __expf(Ps);
            o_qb[j] = qv[j] * __expf(Xs - Xm); o_kb[j] = kv[j] * __expf(Xm - Xs); o_sb[j] = qv[j] * __expf(Xs); }
#define PK8(o) ((v4u){pk2(o[0], o[1]), pk2(o[2], o[3]), pk2(o[4], o[5]), pk2(o[6], o[7])})
        *(LAS v4u*)(qf + s * 72 + dq) = PK8(o_qf); *(LAS v4u*)(qb + s * 72 + dq) = PK8(o_qb); *(LAS v4u*)(kf + s * 72 + dq) = PK8(o_kf); *(LAS v4u*)(kb + s * 72 + dq) = PK8(o_kb);
        *(LAS v4u*)(qS + s * 136 + dq) = PK8(o_sf); *(LAS v4u*)(qS + s * 136 + 64 + dq) = PK8(o_sb);
    }
    __syncthreads();
    { const int dir = wave >> 2, c0 = ((wave >> 1) & 1) * 32, s0 = (wave & 1) * 32;
        LAS bf16* qq = dir ? qb : qf; LAS bf16* kk = dir ? kb : kf;
        f32x16 acc;
#pragma unroll
        for (int i = 0; i < 16; ++i) acc[i] = 0.f;
#pragma unroll
        for (int ks = 0; ks < 4; ++ks) { const bf16x8 A = *(const LAS bf16x8*)(qq + (c0 + l31) * 72 + 16 * ks + 8 * hh), B = *(const LAS bf16x8*)(kk + (s0 + l31) * 72 + 16 * ks + 8 * hh);
            acc = mfma32(A, B, acc); }
        const int s = s0 + l31;
#pragma unroll
        for (int r = 0; r < 16; ++r) { const int c = c0 + (r & 3) + 8 * (r >> 2) + 4 * hh; const bool keep = dir ? (s >= c) : (s <= c);
            Scat[c * 136 + dir * 64 + s] = (bf16)f2bf(keep ? acc[r] : 0.f); } }
    __syncthreads();
    { const int c0 = (wave >> 2) * 32, e0 = (wave & 3) * 32;
        f32x16 acc;
#pragma unroll
        for (int i = 0; i < 16; ++i) acc[i] = 0.f;
#pragma unroll
        for (int ks = 0; ks < 8; ++ks) { const bf16x8 A = *(const LAS bf16x8*)(Scat + (c0 + l31) * 136 + 16 * ks + 8 * hh), B = *(const LAS bf16x8*)(vT + (e0 + l31) * 72 + ((16 * ks + 8 * hh) & 63));
            acc = mfma32(A, B, acc); }
#pragma unroll
        for (int ks = 0; ks < 8; ++ks) { const bf16x8 A = *(const LAS bf16x8*)(qS + (c0 + l31) * 136 + 16 * ks + 8 * hh), B = *(const LAS bf16x8*)(Sp + (e0 + l31) * 136 + 16 * ks + 8 * hh);
            acc = mfma32(A, B, acc); }
#pragma unroll
        for (int r = 0; r < 16; ++r) { const int c = c0 + (r & 3) + 8 * (r >> 2) + 4 * hh; oS[c * 132 + e0 + l31] = acc[r]; } }
    __syncthreads();
    { const int row = tid >> 3, ec = (tid & 7) * 16; float v[16]; float ss = 0.f;
#pragma unroll
        for (int j = 0; j < 16; ++j) { v[j] = oS[row * 132 + ec + j]; ss += v[j] * v[j]; }
        ss += __shfl_xor(ss, 1); ss += __shfl_xor(ss, 2); ss += __shfl_xor(ss, 4);
        const float rs = rsqrtf(ss * (1.0f / 128.0f) + EPS);
        const bf16* gp = qkvg + (rowbase + row) * NQ + 1024 + h * 128 + ec; const v4u g0 = *(const v4u*)gp, g1 = *(const v4u*)(gp + 8);
        const float gv[16] = {bflo(g0.x), bfhi(g0.x), bflo(g0.y), bfhi(g0.y), bflo(g0.z), bfhi(g0.z), bflo(g0.w), bfhi(g0.w), bflo(g1.x), bfhi(g1.x), bflo(g1.y), bfhi(g1.y), bflo(g1.z), bfhi(g1.z), bflo(g1.w), bfhi(g1.w)};
        float o[16];
#pragma unroll
        for (int j = 0; j < 16; ++j) o[j] = v[j] * rs * a.in[12][ec + j] * silu_f(gv[j]);
        bf16* op = (bf16*)(ws + WS_AOUT) + (rowbase + row) * DM + h * 128 + ec;
        *(v4u*)op = (v4u){pk2(o[0], o[1]), pk2(o[2], o[3]), pk2(o[4], o[5]), pk2(o[6], o[7])};
        *(v4u*)(op + 8) = (v4u){pk2(o[8], o[9]), pk2(o[10], o[11]), pk2(o[12], o[13]), pk2(o[14], o[15])}; }
    __syncthreads();
}

__device__ __forceinline__ void hy_transpose_item(const Args& a, LAS unsigned char* lds, int it) {
    const int tid = threadIdx.x, b = it >> 6, t0 = (it & 63) * 64;
    LAS float* tile = (LAS float*)lds;
    const float* src = (const float*)(a.ws + WS_YHYT) + (size_t)b * 512 * SEQ + t0;
    bf16* dst = (bf16*)(a.ws + WS_AOUT) + ((size_t)b * SEQ + t0) * DM + 512;
    for (int half = 0; half < 2; ++half) {
#pragma unroll 8
        for (int q = 0; q < 32; ++q) { const int idx = tid + NTHR * q, c = idx >> 6, tt = idx & 63; tile[c * 65 + tt] = src[(size_t)(half * 256 + c) * SEQ + tt]; }
        __syncthreads();
#pragma unroll
        for (int q = 0; q < 4; ++q) { const int idx = tid + NTHR * q, t = idx >> 5, c8 = (idx & 31) * 8; const LAS float* s = tile + c8 * 65 + t;
            *(v4u*)(dst + (size_t)t * DM + half * 256 + c8) = (v4u){pk2(s[0], s[65]), pk2(s[2 * 65], s[3 * 65]), pk2(s[4 * 65], s[5 * 65]), pk2(s[6 * 65], s[7 * 65])}; }
        __syncthreads();
    }
}

__device__ __forceinline__ void phase_router(const Args& a, LAS unsigned char* lds) {
    const int tid = threadIdx.x, lane = tid & 63, wave = tid >> 6, wg = blockIdx.x, G = gridDim.x;
    unsigned char* ws = a.ws;
    LAS float* wr = (LAS float*)lds;
    for (int i = tid; i < 4096; i += NTHR) *(LAS f32x4*)(wr + 4 * i) = *(const f32x4*)(a.in[24] + 4 * i);
    __syncthreads();
    const float* modr = (const float*)(ws + WS_MOD); const float* gffn = a.in[23];
    bf16* hn = (bf16*)(ws + WS_HN); float* aff = (float*)(ws + WS_AFF);
    for (int r = wg * NWAVES + wave; r < MX; r += G * NWAVES) {
        const int b = r >> 12, t = r & 4095;
        const float* src = a.out + (size_t)r * DM;
        f32x4 v[4]; float ss = 0.f;
#pragma unroll
        for (int j = 0; j < 4; ++j) { v[j] = *(const f32x4*)(src + 4 * lane + 256 * j); ss += v[j][0] * v[j][0] + v[j][1] * v[j][1] + v[j][2] * v[j][2] + v[j][3] * v[j][3]; }
        const float rs = rsqrtf(wave_sum(ss) * (1.0f / DM) + EPS);
        float lg[16];
#pragma unroll
        for (int e = 0; e < 16; ++e) lg[e] = 0.f;
#pragma unroll
        for (int j = 0; j < 4; ++j) { const int col = 4 * lane + 256 * j;
            const f32x4 g = *(const f32x4*)(gffn + col), sh = *(const f32x4*)(modr + b * 6144 + 3072 + col), sc = *(const f32x4*)(modr + b * 6144 + 4096 + col);
            const f32x4 y = (v[j] * rs * g) * (sc + 1.0f) + sh;
            v2u w; w.x = pk2(y[0], y[1]); w.y = pk2(y[2], y[3]);
            *(v2u*)(hn + (size_t)r * DM + col) = w;
#pragma unroll
            for (int q = 0; q < 4; ++q) { const LAS f32x4* wp = (const LAS f32x4*)(wr + (col + q) * 16);
#pragma unroll
                for (int e4 = 0; e4 < 4; ++e4) { const f32x4 ww = wp[e4];
#pragma unroll
                    for (int s = 0; s < 4; ++s) lg[e4 * 4 + s] += y[q] * ww[s]; } } }
#pragma unroll
        for (int e = 0; e < 16; ++e) lg[e] = wave_sum(lg[e]);
        float mx = lg[0];
#pragma unroll
        for (int e = 1; e < 16; ++e) mx = fmaxf(mx, lg[e]);
        float sum = 0.f;
#pragma unroll
        for (int e = 0; e < 16; ++e) { lg[e] = expf(lg[e] - mx); sum += lg[e]; }
        float mine = lg[0];
#pragma unroll
        for (int e = 1; e < 16; ++e) mine = (lane == e) ? lg[e] : mine;
        if (lane < 16) aff[((size_t)b * NE + lane) * SEQ + t] = mine / sum;
    }
}

__device__ __forceinline__ void block_excl_scan2(int& va, int& vb, LAS int* tmp) {
    const int tid = threadIdx.x, lane = tid & 63, wave = tid >> 6;
    int ia = va, ib = vb;
#pragma unroll
    for (int o = 1; o < 64; o <<= 1) { const int ta = __shfl_up(ia, o), tb = __shfl_up(ib, o); if (lane >= o) { ia += ta; ib += tb; } }
    if (lane == 63) { tmp[wave] = ia; tmp[8 + wave] = ib; }
    __syncthreads();
    int oa = 0, ob = 0;
#pragma unroll
    for (int w = 0; w < 8; ++w) { if (w < wave) { oa += tmp[w]; ob += tmp[8 + w]; } }
    va = oa + ia - va; vb = ob + ib - vb;
    __syncthreads();
}
__device__ __forceinline__ void topk_item(const Args& a, LAS unsigned char* lds, int be) {
    const int tid = threadIdx.x, b = be >> 4, e = be & 15;
    unsigned char* ws = a.ws;
    LAS unsigned* keys = (LAS unsigned*)lds;
    LAS unsigned* hist = (LAS unsigned*)(lds + 16384);
    LAS int* ctl = (LAS int*)(lds + 16384 + 1024);
    LAS int* tmp = (LAS int*)(lds + 16384 + 1024 + 64);
    const float* aff = (const float*)(ws + WS_AFF) + (size_t)be * SEQ;
    unsigned my[8];
#pragma unroll
    for (int i = 0; i < 8; ++i) { my[i] = __float_as_uint(aff[tid * 8 + i]); keys[tid * 8 + i] = my[i]; }
    unsigned prefix = 0u, mask = 0u; int need = CAP;
    for (int pass = 0; pass < 4; ++pass) {
        const int shift = 24 - 8 * pass;
        if (tid < 256) hist[tid] = 0u;
        __syncthreads();
#pragma unroll
        for (int i = 0; i < 8; ++i) if ((my[i] & mask) == prefix) atomicAdd((unsigned*)&hist[(my[i] >> shift) & 255u], 1u);
        __syncthreads();
        if (tid == 0) { int cum = 0, bin = 255; for (; bin > 0; --bin) { const int hcnt = (int)hist[bin]; if (cum + hcnt >= need) break; cum += hcnt; } ctl[0] = bin; ctl[1] = need - cum; }
        __syncthreads();
        prefix |= ((unsigned)ctl[0]) << shift; mask |= 255u << shift; need = ctl[1];
        __syncthreads();
    }
    const unsigned T = prefix;
    int cg = 0, ce = 0;
#pragma unroll
    for (int i = 0; i < 8; ++i) { cg += (my[i] > T) ? 1 : 0; ce += (my[i] == T) ? 1 : 0; }
    int pg = cg, pe = ce;
    block_excl_scan2(pg, pe, tmp);
    int* slot_of = (int*)(ws + WS_SLOT) + (size_t)be * SEQ;
    int* selt = (int*)(ws + WS_SELT) + (e * 4 + b) * CAP; float* selv = (float*)(ws + WS_SELV) + (e * 4 + b) * CAP;
#pragma unroll
    for (int i = 0; i < 8; ++i) { const int t = tid * 8 + i; const bool gt = my[i] > T, eq = my[i] == T; const bool sel = gt || (eq && pe < need);
        const int slot = pg + (pe < need ? pe : need);
        slot_of[t] = sel ? slot : -1;
        if (sel) { selt[slot] = t; selv[slot] = __uint_as_float(my[i]); }
        pg += gt ? 1 : 0; pe += eq ? 1 : 0; }
    __syncthreads();
}
__device__ __forceinline__ void phase_topk(const Args& a, LAS unsigned char* lds) {
    const int tid = threadIdx.x, lane = tid & 63, wave = tid >> 6, wg = blockIdx.x, G = gridDim.x;
    unsigned char* ws = a.ws;
    for (int it = wg; it < NB * NE; it += G) topk_item(a, lds, it);
    LAS float* scr = (LAS float*)(lds + 32768 + wave * 8448);
    for (int it = wg * NWAVES + wave; it < 48 * 512; it += G * NWAVES) {
        const int mat = it >> 9, r = it & 511, nb = r >> 4, kb = r & 15, e = mat / 3, kind = mat % 3, n0 = nb * 32;
        if (kind < 2) transpose_item((kind ? a.in[26] : a.in[25]) + (size_t)e * DM * DM, DM, kb * 64, n0, (bf16*)(ws + WS_WGU) + (size_t)e * 2048 * DM, DM, (n0 >> 7) * 256 + kind * 128 + (n0 & 127), scr, lane, false);
        else transpose_item(a.in[27] + (size_t)e * DM * DM, DM, kb * 64, n0, (bf16*)(ws + WS_WD) + (size_t)e * DM * DM, DM, n0, scr, lane, false);
    }
}

__device__ __forceinline__ void phase_gather(const Args& a) {
    const int tid = threadIdx.x, lane = tid & 63, wave = tid >> 6, wg = blockIdx.x, G = gridDim.x;
    unsigned char* ws = a.ws;
    const int* selt = (const int*)(ws + WS_SELT); const bf16* hn = (const bf16*)(ws + WS_HN); bf16* xs = (bf16*)(ws + WS_XS);
    for (int R = wg * NWAVES + wave; R < NE * NB * CAP; R += G * NWAVES) {
        const int b = (R >> 9) & 3, tok = selt[R];
        const v4u* s = (const v4u*)(hn + ((size_t)b * SEQ + tok) * DM); v4u* d = (v4u*)(xs + (size_t)R * DM);
        const v4u x0 = s[lane], x1 = s[lane + 64]; d[lane] = x0; d[lane + 64] = x1;
    }
}

__device__ __forceinline__ void phase_final(const Args& a) {
    const int tid = threadIdx.x, lane = tid & 63, wave = tid >> 6, wg = blockIdx.x, G = gridDim.x;
    unsigned char* ws = a.ws;
    const float* modr = (const float*)(ws + WS_MOD); const int* slot_of = (const int*)(ws + WS_SLOT); const bf16* ys = (const bf16*)(ws + WS_YSLAB);
    for (int r = wg * NWAVES + wave; r < MX; r += G * NWAVES) {
        const int b = r >> 12, t = r & 4095;
        float* row = a.out + (size_t)r * DM;
        f32x4 m[4];
#pragma unroll
        for (int j = 0; j < 4; ++j) m[j] = (f32x4){0.f, 0.f, 0.f, 0.f};
        for (int e = 0; e < NE; ++e) { const int s = slot_of[((size_t)b * NE + e) * SEQ + t];
            if (s >= 0 && !DBG_NOMOE) { const bf16* yp = ys + ((size_t)e * 2048 + b * CAP + s) * DM;
#pragma unroll
                for (int j = 0; j < 4; ++j) { const v2u w = *(const v2u*)(yp + 4 * lane + 256 * j); m[j][0] += bflo(w.x); m[j][1] += bfhi(w.x); m[j][2] += bflo(w.y); m[j][3] += bfhi(w.y); } } }
        f32x4 v[4]; float ss = 0.f;
#pragma unroll
        for (int j = 0; j < 4; ++j) { const int col = 4 * lane + 256 * j; v[j] = *(const f32x4*)(row + col) + *(const f32x4*)(modr + b * 6144 + 5120 + col) * m[j];
            ss += v[j][0] * v[j][0] + v[j][1] * v[j][1] + v[j][2] * v[j][2] + v[j][3] * v[j][3]; }
        const float rs = rsqrtf(wave_sum(ss) * (1.0f / DM) + EPS);
#pragma unroll
        for (int j = 0; j < 4; ++j) { const int col = 4 * lane + 256 * j; *(f32x4*)(row + col) = v[j] * rs * *(const f32x4*)(a.in[28] + col); }
    }
}

__global__ void __launch_bounds__(NTHR, 2) fwd_kernel(Args a) {
    extern __shared__ __attribute__((aligned(16))) unsigned char lds_raw[];
    LAS unsigned char* lds = (LAS unsigned char*)lds_raw;
    const int tid = threadIdx.x, wg = blockIdx.x, G = gridDim.x;
    unsigned char* ws = a.ws;
    volatile LAS unsigned* MISC = (volatile LAS unsigned*)(lds + LDS_MISC);
    if (tid < 64) MISC[tid] = 0u;
    __syncthreads();
    XcdBarrier bar; bar.bar = (unsigned*)(ws + WS_CTL); bar.x = 0; bar.st = nullptr;
    if (a.ph_hi - a.ph_lo > 1) bar = xcd_barrier_post((unsigned*)(ws + WS_CTL), MISC + 8);
#ifndef PH_ONLY
#define PH_ONLY -1
#endif
#define IN(k) ((PH_ONLY < 0 || PH_ONLY == (k)) && a.ph_lo <= (k) && (k) < a.ph_hi)
#define SEAM(k) do { if (IN(k) && IN((k) + 1)) xcd_barrier(bar); } while (0)
    if (IN(0)) { phase0(a, lds); } SEAM(0);
    if (IN(1)) { phase1(a, lds); } SEAM(1);
    if (IN(2)) {
        pg8::Gemm g{(const pg8::bf16_t*)(ws + WS_AIN), (const pg8::bf16_t*)(ws + WS_WIN), MT, NIN, DM}; InSched S; S.init(G, wg);
        EpiIn E{(bf16*)(ws + WS_QKVG), (float*)(ws + WS_HYT), (float*)(ws + WS_AFB)};
        pg8::gemm_phase<EpiIn, InSched, true, true>(lds, g, S, E);
    } SEAM(2);
    if (IN(3)) {
        for (int it = wg; it < 512 + 16 * NCH; it += G) { if (it < 512) hyena_item(a, lds, it, 0); else { const int r = it - 512; gla_upd_item(a, lds, r / NCH, r % NCH); } }
    } SEAM(3);
    if (IN(4)) {
        for (int it = wg; it < 1024; it += G) { if (it < 512) hyena_item(a, lds, it, 1); else gla_scan_item(a, it - 512); }
    } SEAM(4);
    if (IN(5)) {
        for (int it = wg; it < 1280; it += G) { if (it < 1024) gla_out_item(a, lds, it >> 6, it & 63); else hy_transpose_item(a, lds, it - 1024); }
    } SEAM(5);
    if (IN(6)) {
        pg8::Gemm g{(const pg8::bf16_t*)(ws + WS_AOUT), (const pg8::bf16_t*)(ws + WS_WOUT), MX, DM, DM}; pg8::StaticOrder S; S.init(MX, DM, G, wg);
        EpiOut E{a.in[0], (const float*)(ws + WS_POS), (const float*)(ws + WS_MOD), a.out};
        pg8::gemm_phase<EpiOut, pg8::StaticOrder, true, true>(lds, g, S, E);
    } SEAM(6);
    if (IN(7)) { phase_router(a, lds); } SEAM(7);
    if (IN(8)) { phase_topk(a, lds); } SEAM(8);
    if (IN(9)) { phase_gather(a); } SEAM(9);
    if (IN(10)) {
        pg8::Gemm g{(const pg8::bf16_t*)(ws + WS_XS), (const pg8::bf16_t*)(ws + WS_WGU), NE * 2048, NE * 2048, DM}; MoeSched<8> S; S.init(G, wg);
        EpiGU E{(bf16*)(ws + WS_HID)};
        pg8::gemm_phase<EpiGU, MoeSched<8>, true, true>(lds, g, S, E);
    } SEAM(10);
    if (IN(11)) {
        pg8::Gemm g{(const pg8::bf16_t*)(ws + WS_HID), (const pg8::bf16_t*)(ws + WS_WD), NE * 2048, NE * 1024, DM}; MoeSched<4> S; S.init(G, wg);
        EpiDown E{(bf16*)(ws + WS_YSLAB), (const float*)(ws + WS_SELV)};
        pg8::gemm_phase<EpiDown, MoeSched<4>, true, true>(lds, g, S, E);
    } SEAM(11);
    if (IN(12)) { phase_final(a); }
#undef IN
#undef SEAM
}


#ifdef DBG_STATE
__global__ void chk_kernel(const unsigned* p, size_t nwords, unsigned long long* out) {
    unsigned long long s = 0ull;
    for (size_t i = (size_t)blockIdx.x * blockDim.x + threadIdx.x; i < nwords; i += (size_t)gridDim.x * blockDim.x) s += (unsigned long long)p[i] * (2ull * i + 1ull);
    for (int o = 1; o < 64; o <<= 1) s += __shfl_xor(s, o);
    if ((threadIdx.x & 63) == 0) atomicAdd(out, s);
}
__global__ void report_kernel(const unsigned long long* chk, float* out, int n) {
    int bad = -1;
    for (int p = 0; p < 28; ++p) if (chk[p] != chk[32 + p]) { bad = p; break; }
    if (bad < 0) return;
    for (int i = blockIdx.x * blockDim.x + threadIdx.x; i < n; i += gridDim.x * blockDim.x) out[i] = 1000.f * (float)(bad + 1);
}
struct ChkEnt { int ph; size_t off; size_t bytes; };
#endif
extern "C" void kernel_launch(void* const* d_in, const int* in_sizes, int n_in, void* d_out, int out_size, void* d_ws, size_t ws_size, hipStream_t stream) {
    static int grid = 0;
    if (grid == 0) {
        if (n_in != 29 || out_size != MX * DM || ws_size < WS_END) { fprintf(stderr, "kernel_launch: unexpected shapes (n_in %d out %d ws %zu)\n", n_in, out_size, ws_size); grid = -1; return; }
        int dev = 0, cus = 0, per_cu = 0;
        if (hipGetDevice(&dev) != hipSuccess || hipDeviceGetAttribute(&cus, hipDeviceAttributeMultiprocessorCount, dev) != hipSuccess) { grid = -1; return; }
        if (hipFuncSetAttribute((const void*)fwd_kernel, hipFuncAttributeMaxDynamicSharedMemorySize, LDS_BYTES) != hipSuccess) { fprintf(stderr, "kernel_launch: hipFuncSetAttribute failed\n"); grid = -1; return; }
        if (hipOccupancyMaxActiveBlocksPerMultiprocessor(&per_cu, (const void*)fwd_kernel, NTHR, LDS_BYTES) != hipSuccess || per_cu < 1) fprintf(stderr, "kernel_launch: occupancy query reports %d\n", per_cu);
        (void)hipGetLastError();
        grid = cus;
    }
    if (grid < 0) return;
    (void)hipMemsetAsync((char*)d_ws + WS_CTL, 0, CTL_BYTES, stream);
    Args a{};
    for (int i = 0; i < 29; ++i) a.in[i] = (const float*)d_in[i];
    a.out = (float*)d_out; a.ws = (unsigned char*)d_ws;
#if MK_SINGLE
    a.ph_lo = 0; a.ph_hi = NPH;
    hipLaunchKernelGGL(fwd_kernel, dim3(grid), dim3(NTHR), LDS_BYTES, stream, a);
#else
#ifdef DBG_STATE
    static const ChkEnt ents[] = { {0, WS_MOD, 122880}, {0, WS_POS, 131072}, {0, WS_HT, 32 * MiB}, {0, WS_WIN, (size_t)NIN * DM * 2}, {0, WS_WOUT, 2 * MiB},
        {1, WS_AIN, 34 * MiB}, {2, WS_QKVG, (size_t)MX * NQ * 2}, {2, WS_HYT, 96 * MiB}, {2, WS_AFB, (size_t)MT * 128},
        {3, WS_ZT, 32 * MiB}, {3, WS_DEC, (size_t)16 * 2 * NCH * 64 * 4}, {3, WS_UCTX, 4 * MiB}, {3, (size_t)-1, 64 * MiB},
        {4, WS_SPREV, 32 * MiB}, {4, WS_YHYT, 32 * MiB}, {5, WS_AOUT, 32 * MiB}, {6, (size_t)-1, 64 * MiB}, {7, WS_HN, 32 * MiB}, {7, WS_AFF, 1 * MiB},
        {8, WS_SLOT, 1 * MiB}, {8, WS_SELT, 131072}, {8, WS_SELV, 131072}, {8, WS_WGU, 64 * MiB}, {8, WS_WD, 32 * MiB}, {9, WS_XS, 64 * MiB}, {10, WS_HID, 64 * MiB}, {11, WS_YSLAB, 64 * MiB}, {12, (size_t)-1, 64 * MiB} };
    unsigned long long* chk = (unsigned long long*)((char*)d_ws + 32768);
    for (int run = 0; run < 2; ++run)
        for (int p = 0; p < NPH; ++p) { a.ph_lo = p; a.ph_hi = p + 1; hipLaunchKernelGGL(fwd_kernel, dim3(grid), dim3(NTHR), LDS_BYTES, stream, a);
            for (const ChkEnt& e : ents) if (e.ph == p) hipLaunchKernelGGL(chk_kernel, dim3(1024), dim3(256), 0, stream, (const unsigned*)(e.off == (size_t)-1 ? (char*)d_out : (char*)d_ws + e.off), e.bytes / 4, chk + run * 32 + (int)(&e - ents)); }
    hipLaunchKernelGGL(report_kernel, dim3(1024), dim3(256), 0, stream, (const unsigned long long*)chk, (float*)d_out, out_size);
#else
    for (int p = 0; p < NPH; ++p) { a.ph_lo = p; a.ph_hi = p + 1; hipLaunchKernelGGL(fwd_kernel, dim3(grid), dim3(NTHR), LDS_BYTES, stream, a); }
#endif
#endif
}
```

```cpp
#include <hip/hip_runtime.h>
#include <cstdio>
#include <cstdint>
#define MK_SINGLE 1
namespace pg8 {
#define PG8_LAS __attribute__((address_space(3)))
typedef unsigned short bf16_t;
typedef short bf16x8 __attribute__((ext_vector_type(8)));
typedef float f32x4 __attribute__((ext_vector_type(4)));
typedef unsigned u32x4 __attribute__((ext_vector_type(4)));
constexpr int BM = 256, BK = 64, HALF = 128, HTB = HALF * BK * 2  , STAGE_BYTES = 8 * HTB, NXCD = 8, WGM = 8;

__host__ __device__ __forceinline__ int lds_byte(int r, int c) { const int st = (r >> 4) * 2 + (c >> 5), rr = r & 15, cc = c & 31, ob = rr * 64 + cc * 2; return st * 1024 + (ob ^ (((ob >> 9) & 1) << 5)); }
__host__ __device__ __forceinline__ void stage_rc(int b, int& R, int& C) { const int st = b / 1024, sb = b % 1024, swz = sb ^ (((sb >> 9) & 1) << 5); R = (st >> 1) * 16 + swz / 64; C = (st & 1) * 32 + (swz % 64) / 2; }
__host__ __device__ __forceinline__ int perm32(int rho) { const int n = rho >> 4, i = rho & 15; return 8 * (i >> 2) + 4 * n + (i & 3); }

struct Unit { int pm, pn; };
struct Gemm { const bf16_t* A; const bf16_t* Bt; int M, N, K; };

struct StaticOrder {
    int nM, nN, nwg, G, c;
    __host__ __device__ void init(int M, int N, int G_, int c_) { nM = M / BM; nN = N / BM; nwg = nM * nN; G = G_; c = c_; }
    __host__ __device__ bool next(int i, Unit& u) const {
        const long L = (long)i * G + c; if (L >= nwg) return false;
        int wgid = (int)L; { const int q = nwg / NXCD, r = nwg % NXCD, xcd = wgid % NXCD, off = wgid / NXCD; wgid = (xcd < r ? xcd * (q + 1) : r * (q + 1) + (xcd - r) * q) + off; }
        const int nig = WGM * nN, gid = wgid / nig, fm = gid * WGM, gsz = (nM - fm) < WGM ? (nM - fm) : WGM;
        u.pm = fm + ((wgid % nig) % gsz); u.pn = (wgid % nig) / gsz; return true;
    }
    __device__ __forceinline__ void a_ready(const Unit&) const {}
    __device__ __forceinline__ void done(const Unit&) const {}
};

__device__ __forceinline__ unsigned cvt_pk_bf16(float lo, float hi) { unsigned r; asm volatile("v_cvt_pk_bf16_f32 %0, %1, %2" : "=v"(r) : "v"(lo), "v"(hi)); return r; }
template <class Epi, class Sched, bool ALIGN_EPI = false, bool SP2 = false>
__device__ __forceinline__ void gemm_phase(PG8_LAS unsigned char* lds, const Gemm g, const Sched& S, const Epi& E) {
    const int tid = threadIdx.x, wid = __builtin_amdgcn_readfirstlane(tid >> 6), lane = tid & 63, wr = wid >> 2, wc = wid & 3, fr = lane & 15, fq = lane >> 4;
    const int K = g.K, nt = K / BK;
    unsigned voffA[2], voffB[2];
#pragma unroll
    for (int i = 0; i < 2; ++i) { int R, C; stage_rc(tid * 16 + i * 8192, R, C); const int Rb = Epi::PERM ? ((R & ~31) + perm32(R & 31)) : R;
        voffA[i] = (unsigned)(R * K + C) * 2u; voffB[i] = (unsigned)(Rb * K + C) * 2u; }
    const size_t kstep = (size_t)(BK * 2);
    const size_t hstep = (size_t)HALF * K * 2;
    const size_t tstep = 2 * hstep;
    const unsigned ldsw = (unsigned)wid * 1024u;
    const int aoff = lds_byte(wr * 64 + fr, fq * 8), boff = lds_byte(wc * 32 + fr, fq * 8);
#define PG8_SA(b, h) (((b) * 2 + (h)) * HTB)
#define PG8_SB(b, h) ((4 + (b) * 2 + (h)) * HTB)
#define PG8_STAGE(bufoff, gbase, voff) do { _Pragma("unroll") for (int _i = 0; _i < 2; ++_i) \
        __builtin_amdgcn_global_load_lds((const unsigned*)((const char*)(gbase) + (voff)[_i]), (PG8_LAS unsigned*)(lds + (bufoff) + ldsw + _i * 8192), 16, 0, 0); } while (0)
#define PG8_LDA(dst, b, h) do { _Pragma("unroll") for (int m = 0; m < 4; ++m) _Pragma("unroll") for (int k = 0; k < 2; ++k) dst[m][k] = *(const PG8_LAS bf16x8*)(lds + PG8_SA(b, h) + aoff + m * 2048 + k * 1024); } while (0)
#define PG8_LDB(dst, b, h) do { _Pragma("unroll") for (int n = 0; n < 2; ++n) _Pragma("unroll") for (int k = 0; k < 2; ++k) dst[n][k] = *(const PG8_LAS bf16x8*)(lds + PG8_SB(b, h) + boff + n * 2048 + k * 1024); } while (0)
#define PG8_MMA(ai, bj, At, Bt) do { __builtin_amdgcn_s_setprio(1); _Pragma("unroll") for (int m = 0; m < 4; ++m) _Pragma("unroll") for (int n = 0; n < 2; ++n) _Pragma("unroll") for (int k = 0; k < 2; ++k) \
        acc[ai][bj][m][n] = __builtin_amdgcn_mfma_f32_16x16x32_bf16(Bt[n][k], At[m][k], acc[ai][bj][m][n], 0, 0, 0); __builtin_amdgcn_s_setprio(0); } while (0)
#define PG8_WAIT_V(n) asm volatile("s_waitcnt vmcnt(" #n ")" ::: "memory")
#define PG8_WAIT_L(n) asm volatile("s_waitcnt lgkmcnt(" #n ")" ::: "memory")
#define PG8_BAR __builtin_amdgcn_s_barrier()
#define PG8_SCHED __builtin_amdgcn_sched_barrier(0)
    Unit cur, nxt; int ui = 0;
    if (!S.next(0, cur)) return;
    f32x4 acc[2][2][4][2];
#pragma unroll
    for (int a = 0; a < 2; ++a)
#pragma unroll
        for (int b = 0; b < 2; ++b)
#pragma unroll
            for (int m = 0; m < 4; ++m)
#pragma unroll
                for (int n = 0; n < 2; ++n) acc[a][b][m][n] = (f32x4){0.f, 0.f, 0.f, 0.f};
    bf16x8 At[4][2], B0[2][2], B1[2][2];
    const char* cA = (const char*)g.A + (size_t)cur.pm * tstep; const char* cB = (const char*)g.Bt + (size_t)cur.pn * tstep;
    S.a_ready(cur);
    if constexpr (SP2) {
        PG8_STAGE(PG8_SB(0, 0), cB, voffB); PG8_STAGE(PG8_SB(0, 1), cB + hstep, voffB); PG8_STAGE(PG8_SA(0, 0), cA, voffA); PG8_STAGE(PG8_SA(0, 1), cA + hstep, voffA);
        if (wr == 1) PG8_BAR;
        PG8_WAIT_V(2); PG8_BAR;
        PG8_STAGE(PG8_SB(1, 0), cB + kstep, voffB); PG8_STAGE(PG8_SA(1, 0), cA + kstep, voffA); PG8_STAGE(PG8_SB(1, 1), cB + hstep + kstep, voffB);
        PG8_WAIT_V(6); PG8_BAR;
    } else {
        PG8_STAGE(PG8_SB(0, 0), cB, voffB); PG8_STAGE(PG8_SA(0, 0), cA, voffA); PG8_STAGE(PG8_SB(0, 1), cB + hstep, voffB); PG8_STAGE(PG8_SA(0, 1), cA + hstep, voffA);
        if (wr == 1) PG8_BAR;
        PG8_WAIT_V(4); PG8_BAR;
        PG8_STAGE(PG8_SB(1, 0), cB + kstep, voffB); PG8_STAGE(PG8_SA(1, 0), cA + kstep, voffA); PG8_STAGE(PG8_SB(1, 1), cB + hstep + kstep, voffB);
        PG8_WAIT_V(6); PG8_BAR;
    }
    for (;;) {
        const bool has_next = S.next(ui + 1, nxt);
        const char* nA = has_next ? (const char*)g.A + (size_t)nxt.pm * tstep : cA; const char* nB = has_next ? (const char*)g.Bt + (size_t)nxt.pn * tstep : cB;
        for (int t = 0; t < nt; t += 2) {
            const bool last = (t == nt - 2);
            const char* a1 = cA + (size_t)(t + 1) * kstep;
            const char* a2 = last ? nA : cA + (size_t)(t + 2) * kstep; const char* b2 = last ? nB : cB + (size_t)(t + 2) * kstep;
            const char* a3 = a2 + kstep; const char* b3 = b2 + kstep;
            if (last && has_next) S.a_ready(nxt);
            if constexpr (SP2) {
            PG8_LDB(B0, 0, 0); PG8_LDB(B1, 0, 1); PG8_SCHED; PG8_LDA(At, 0, 0); PG8_STAGE(PG8_SA(1, 1), a1 + hstep, voffA);
            PG8_WAIT_V(8); PG8_WAIT_L(0); PG8_BAR; PG8_MMA(0, 0, At, B0); PG8_MMA(0, 1, At, B1); PG8_BAR; PG8_SCHED;
            PG8_LDA(At, 0, 1); PG8_STAGE(PG8_SB(0, 0), b2, voffB); PG8_STAGE(PG8_SB(0, 1), b2 + hstep, voffB); PG8_STAGE(PG8_SA(0, 0), a2, voffA);
            PG8_WAIT_V(8); PG8_WAIT_L(0); PG8_BAR; PG8_MMA(1, 0, At, B0); PG8_MMA(1, 1, At, B1); PG8_BAR; PG8_SCHED;
            PG8_LDB(B0, 1, 0); PG8_LDB(B1, 1, 1); PG8_SCHED; PG8_LDA(At, 1, 0); PG8_STAGE(PG8_SA(0, 1), a2 + hstep, voffA);
            PG8_WAIT_V(8); PG8_WAIT_L(0); PG8_BAR; PG8_MMA(0, 0, At, B0); PG8_MMA(0, 1, At, B1); PG8_BAR; PG8_SCHED;
            PG8_LDA(At, 1, 1); PG8_STAGE(PG8_SB(1, 0), b3, voffB); PG8_STAGE(PG8_SB(1, 1), b3 + hstep, voffB); PG8_STAGE(PG8_SA(1, 0), a3, voffA);
            PG8_WAIT_V(8); PG8_WAIT_L(0); PG8_BAR; PG8_MMA(1, 0, At, B0); PG8_MMA(1, 1, At, B1); PG8_BAR; PG8_SCHED;
            } else {
            PG8_LDB(B0, 0, 0); PG8_SCHED; PG8_LDA(At, 0, 0); PG8_STAGE(PG8_SA(1, 1), a1 + hstep, voffA);
            PG8_WAIT_L(8); PG8_BAR; PG8_WAIT_L(0); PG8_MMA(0, 0, At, B0); PG8_BAR; PG8_SCHED;
            PG8_LDB(B1, 0, 1); PG8_STAGE(PG8_SB(0, 0), b2, voffB);
            PG8_BAR; PG8_WAIT_L(0); PG8_MMA(0, 1, At, B1); PG8_BAR;
            PG8_LDA(At, 0, 1); PG8_STAGE(PG8_SA(0, 0), a2, voffA);
            PG8_BAR; PG8_WAIT_L(0); PG8_MMA(1, 0, At, B0); PG8_BAR; PG8_SCHED;
            PG8_STAGE(PG8_SB(0, 1), b2 + hstep, voffB);
            PG8_WAIT_V(6); PG8_BAR; PG8_MMA(1, 1, At, B1); PG8_BAR;
            PG8_LDB(B0, 1, 0); PG8_SCHED; PG8_LDA(At, 1, 0); PG8_STAGE(PG8_SA(0, 1), a2 + hstep, voffA);
            PG8_WAIT_L(8); PG8_BAR; PG8_WAIT_L(0); PG8_MMA(0, 0, At, B0); PG8_BAR; PG8_SCHED;
            PG8_LDB(B1, 1, 1); PG8_STAGE(PG8_SB(1, 0), b3, voffB);
            PG8_BAR; PG8_WAIT_L(0); PG8_MMA(0, 1, At, B1); PG8_BAR;
            PG8_LDA(At, 1, 1); PG8_STAGE(PG8_SA(1, 0), a3, voffA);
            PG8_BAR; PG8_WAIT_L(0); PG8_MMA(1, 0, At, B0); PG8_BAR; PG8_SCHED;
            PG8_STAGE(PG8_SB(1, 1), b3 + hstep, voffB);
            PG8_WAIT_V(6); PG8_BAR; PG8_MMA(1, 1, At, B1); PG8_BAR;
            }
        }
        if constexpr (ALIGN_EPI) { if (wr == 0) PG8_BAR; }
        if constexpr (!Epi::AFTER_DRAIN) { E(acc, cur, wr, wc, fr, fq); S.done(cur); }
        if (!has_next) break;
#pragma unroll
        for (int a = 0; a < 2; ++a)
#pragma unroll
            for (int b = 0; b < 2; ++b)
#pragma unroll
                for (int m = 0; m < 4; ++m)
#pragma unroll
                    for (int n = 0; n < 2; ++n) acc[a][b][m][n] = (f32x4){0.f, 0.f, 0.f, 0.f};
        cur = nxt; cA = nA; cB = nB; ++ui;
        if constexpr (ALIGN_EPI) { if (wr == 1) PG8_BAR; }
    }
    PG8_WAIT_V(0);
    if constexpr (!ALIGN_EPI) { if (wr == 0) PG8_BAR; }
    PG8_BAR;
    if constexpr (Epi::AFTER_DRAIN) { E.fused(acc, cur, wr, wc, fr, fq, lds, wid, lane); S.done(cur); }
#undef PG8_SA
#undef PG8_SB
#undef PG8_STAGE
#undef PG8_LDA
#undef PG8_LDB
#undef PG8_MMA
#undef PG8_WAIT_V
#undef PG8_WAIT_L
#undef PG8_BAR
#undef PG8_SCHED
}
}

#ifndef DBG_NOMIX
#define DBG_NOMIX 0
#endif
#ifndef DBG_NOMOE
#define DBG_NOMOE 0
#endif
#ifndef DBG_NOPOS
#define DBG_NOPOS 0
#endif
#ifndef DBG_HTCONST
#define DBG_HTCONST 0
#endif
#ifndef MK_SINGLE
#define MK_SINGLE 0
#endif
#define GAS __attribute__((address_space(1)))
#define LAS __attribute__((address_space(3)))
typedef unsigned short bf16;
typedef float f32x4 __attribute__((ext_vector_type(4)));
typedef float f32x16 __attribute__((ext_vector_type(16)));
typedef short bf16x8 __attribute__((ext_vector_type(8)));
typedef unsigned v4u __attribute__((ext_vector_type(4)));
typedef unsigned v2u __attribute__((ext_vector_type(2)));
typedef GAS unsigned gu32;

constexpr int NWAVES = 8, NTHR = 512;
constexpr int NB = 4, SEQ = 4096, DM = 1024, CTXL = 256;
constexpr int MX = NB * SEQ, MC = NB * CTXL, MT = MX + MC;
constexpr int NIN = 3328, NQ = 1536, DIN = 3104;
constexpr int NE = 16, CAP = 512;
constexpr int NCH = 68;
constexpr int NPH = 13;
constexpr float EPS = 1e-6f;

constexpr size_t MiB = 1u << 20;
constexpr size_t WS_CTL = 0, CTL_BYTES = 65536;
constexpr size_t WS_MOD = 1 * MiB, WS_POS = 1 * MiB + 256 * 1024, WS_DEC = 2 * MiB, WS_AFF = 3 * MiB, WS_SLOT = 4 * MiB, WS_SELT = 5 * MiB, WS_SELV = 5 * MiB + 256 * 1024;
constexpr size_t WS_UCTX = 6 * MiB, WS_AFB = 10 * MiB, WS_WIN = 13 * MiB, WS_WOUT = 20 * MiB;
constexpr size_t WS_R1 = 22 * MiB, WS_R2 = 56 * MiB, WS_R3 = 107 * MiB, WS_R4 = 203 * MiB, WS_R5 = 235 * MiB, WS_R6 = 267 * MiB, WS_END = 299 * MiB;
constexpr size_t WS_AIN = WS_R1, WS_ZT = WS_R1, WS_HN = WS_R1, WS_HID = WS_R1;
constexpr size_t WS_QKVG = WS_R2;
constexpr size_t WS_HYT = WS_R3, WS_WGU = WS_R3, WS_WD = 171 * MiB;
constexpr size_t WS_HT = WS_R4, WS_AOUT = WS_R4, WS_XS = WS_R4, WS_YSLAB = WS_R4;
constexpr size_t WS_SPREV = WS_R5, WS_YHYT = WS_R6;
constexpr int LDS_BYTES = 144 * 1024;
constexpr int LDS_MISC = LDS_BYTES - 256;

struct Args { const float* in[29]; float* out; unsigned char* ws; int ph_lo, ph_hi; };

#define LDS_WAIT() asm volatile("s_waitcnt lgkmcnt(0)" ::: "memory")
#define VM_WAIT() asm volatile("s_waitcnt vmcnt(0)" ::: "memory")
__device__ __forceinline__ unsigned f2bf(float f) { unsigned u = __float_as_uint(f); return (u + 0x7fffu + ((u >> 16) & 1u)) >> 16; }
__device__ __forceinline__ unsigned pk2(float lo, float hi) { return pg8::cvt_pk_bf16(lo, hi); }
__device__ __forceinline__ float bflo(unsigned w) { return __uint_as_float(w << 16); }
__device__ __forceinline__ float bfhi(unsigned w) { return __uint_as_float(w & 0xffff0000u); }
__device__ __forceinline__ float wave_sum(float v) {
#pragma unroll
    for (int o = 1; o < 64; o <<= 1) v += __shfl_xor(v, o);
    return v;
}
__device__ __forceinline__ float silu_f(float v) { return v / (1.f + __expf(-v)); }
__device__ __forceinline__ float logsig_f(float x) { return fminf(x, 0.f) - log1pf(__expf(-fabsf(x))); }

#define XB_TMO      128
#define XB_XCNT(j)  (256  + 64 * (j))
#define XB_XSUB(j)  (1280 + 64 * (j))
#define XB_XGEN(j)  (2304 + 64 * (j))
#define XB_TOP      3328
#define XB_TOPGEN   3392
#define XCD_BAR_WORDS 3456
#define XB_SPIN_CAP (1u << 22)
__device__ __forceinline__ unsigned xb_ld(unsigned* p)              { return __hip_atomic_load(p, __ATOMIC_RELAXED, __HIP_MEMORY_SCOPE_AGENT); }
__device__ __forceinline__ unsigned xb_add(unsigned* p, unsigned v) { return __hip_atomic_fetch_add(p, v, __ATOMIC_RELAXED, __HIP_MEMORY_SCOPE_AGENT); }
__device__ __forceinline__ unsigned xb_xcc_id() { return (unsigned)__builtin_amdgcn_s_getreg((3 << 11) | 20) & 0xFu; }
#define XB_SPIN(cond, bar) do { unsigned _sp = 0; while (cond) { __builtin_amdgcn_s_sleep(1); \
    if ((++_sp & 255u) == 0u) { if (xb_ld(&(bar)[XB_TMO])) break; if (_sp > XB_SPIN_CAP) { atomicAdd(&(bar)[XB_TMO], 1u); break; } } } } while (0)
struct XcdBarrier { unsigned* bar; unsigned x; volatile LAS unsigned* st; };
__device__ __forceinline__ XcdBarrier xcd_barrier_post(unsigned* bar, volatile LAS unsigned* st) {
    XcdBarrier b; b.bar = bar; b.x = xb_xcc_id(); b.st = st;
    if (threadIdx.x == 0) (void)xb_add(&bar[XB_XCNT(b.x)], 1u);
    return b;
}
__device__ __forceinline__ void xcd_barrier_complete(unsigned* bar, unsigned x, unsigned& nloc, unsigned& nx) {
    const unsigned G = gridDim.x * gridDim.y * gridDim.z;
    unsigned sum, cnt, mine, sp = 0u;
    for (;;) {
        sum = 0u; cnt = 0u; mine = 0u;
#pragma unroll
        for (unsigned j = 0; j < 16; ++j) { const unsigned c = xb_ld(&bar[XB_XCNT(j)]); sum += c; cnt += (c > 0u) ? 1u : 0u; mine = (j == x) ? c : mine; }
        if (sum == G) break;
        __builtin_amdgcn_s_sleep(1);
        if ((++sp & 255u) == 0u) { if (xb_ld(&bar[XB_TMO])) break; if (sp > XB_SPIN_CAP) { atomicAdd(&bar[XB_TMO], 1u); break; } }
    }
    nloc = mine > 0u ? mine : 1u; nx = cnt > 0u ? cnt : 1u;
}
__device__ __forceinline__ void xcd_barrier(const XcdBarrier& b) {
    asm volatile("s_waitcnt vmcnt(0)" ::: "memory");
    __syncthreads();
    if (threadIdx.x == 0) {
        unsigned* bar = b.bar;
        __builtin_amdgcn_s_waitcnt(0);
        unsigned nloc = b.st[0], nx = b.st[1];
        if (nloc == 0u) { xcd_barrier_complete(bar, b.x, nloc, nx); b.st[0] = nloc; b.st[1] = nx; }
        const unsigned old = xb_add(&bar[XB_XSUB(b.x)], 1u);
        const unsigned gen = old / nloc;
        if (old + 1u == (gen + 1u) * nloc) {
            __builtin_amdgcn_fence(__ATOMIC_RELEASE, "agent");
            asm volatile("s_waitcnt vmcnt(0)" ::: "memory");
            const unsigned og = xb_add(&bar[XB_TOP], 1u);
            const unsigned tg = og / nx;
            if (og + 1u == (tg + 1u) * nx) xb_add(&bar[XB_TOPGEN], 1u);
            else XB_SPIN(xb_ld(&bar[XB_TOPGEN]) == tg, bar);
            __builtin_amdgcn_fence(__ATOMIC_ACQUIRE, "agent");
            xb_add(&bar[XB_XGEN(b.x)], 1u);
            asm volatile("s_waitcnt vmcnt(0)" ::: "memory");
        } else {
            XB_SPIN(xb_ld(&bar[XB_XGEN(b.x)]) == gen, bar);
            __builtin_amdgcn_fence(__ATOMIC_ACQUIRE, "agent");
            asm volatile("s_waitcnt vmcnt(0)" ::: "memory");
        }
    }
    __syncthreads();
}

struct InSched {
    pg8::StaticOrder so; int G, c;
    __device__ void init(int G_, int c_) { so.init(MX, NIN, G_, c_); G = G_; c = c_; }
    __device__ bool next(int i, pg8::Unit& u) const {
        const int L = i * G + c;
        if (L < 832) return so.next(i, u);
        if (L >= 848) return false;
        const int j = L - 832; u.pm = 64 + (j & 3); const int q = j >> 2; u.pn = (q == 3) ? 12 : (1 + q); return true;
    }
    __device__ __forceinline__ void a_ready(const pg8::Unit&) const {}
    __device__ __forceinline__ void done(const pg8::Unit&) const {}
};
template <int NT> struct MoeSched {
    int G, c;
    __device__ void init(int G_, int c_) { G = G_; c = c_; }
    __device__ bool next(int i, pg8::Unit& u) const {
        const int L = i * G + c; if (L >= NE * 8 * NT) return false;
        const int e = L / (8 * NT), l = L % (8 * NT); u.pm = e * 8 + (l & 7); u.pn = e * NT + (l >> 3); return true;
    }
    __device__ __forceinline__ void a_ready(const pg8::Unit&) const {}
    __device__ __forceinline__ void done(const pg8::Unit&) const {}
};

struct EpiIn {
    static constexpr bool PERM = true, AFTER_DRAIN = false;
    bf16* qkvg; float* hyT; float* afb;
    __device__ __forceinline__ void operator()(const f32x4 (&acc)[2][2][4][2], const pg8::Unit& u, int wr, int wc, int fr, int fq) const {
        const int row0 = u.pm * 256 + wr * 64 + fr;
        if (u.pn < 6) {
            const float sc = (u.pn == 0) ? 0.125f : 1.f;
            const int col0 = u.pn * 256 + wc * 32 + 8 * fq;
#pragma unroll
            for (int ai = 0; ai < 2; ++ai)
#pragma unroll
                for (int m = 0; m < 4; ++m) { bf16* rowp = qkvg + (size_t)(row0 + ai * 128 + m * 16) * NQ + col0;
#pragma unroll
                    for (int bj = 0; bj < 2; ++bj) { const f32x4 v0 = acc[ai][bj][m][0] * sc, v1 = acc[ai][bj][m][1] * sc;
                        v4u w; w.x = pk2(v0[0], v0[1]); w.y = pk2(v0[2], v0[3]); w.z = pk2(v1[0], v1[1]); w.w = pk2(v1[2], v1[3]);
                        *(v4u*)(rowp + bj * 128) = w; } }
        } else if (u.pn < 12) {
            if (u.pm >= 64) return;
            const int ch0 = (u.pn - 6) * 256 + wc * 32 + 8 * fq;
#pragma unroll
            for (int ai = 0; ai < 2; ++ai)
#pragma unroll
                for (int m = 0; m < 4; ++m) { const int r = row0 + ai * 128 + m * 16; const int b = r >> 12, t = r & 4095;
                    float* bp = hyT + (size_t)b * 1536 * SEQ + t;
#pragma unroll
                    for (int bj = 0; bj < 2; ++bj)
#pragma unroll
                        for (int n = 0; n < 2; ++n)
#pragma unroll
                            for (int j = 0; j < 4; ++j) bp[(size_t)(ch0 + bj * 128 + 4 * n + j) * SEQ] = acc[ai][bj][m][n][j]; }
        } else {
            if (wc != 0) return;
#pragma unroll
            for (int ai = 0; ai < 2; ++ai)
#pragma unroll
                for (int m = 0; m < 4; ++m) { float* rowp = afb + (size_t)(row0 + ai * 128 + m * 16) * 32 + 8 * fq;
                    *(f32x4*)(rowp) = acc[ai][0][m][0]; *(f32x4*)(rowp + 4) = acc[ai][0][m][1]; }
        }
    }
};
struct EpiOut {
    static constexpr bool PERM = false, AFTER_DRAIN = false;
    const float* x; const float* postab; const float* modr; float* x1;
    __device__ __forceinline__ void operator()(const f32x4 (&acc)[2][2][4][2], const pg8::Unit& u, int wr, int wc, int fr, int fq) const {
        const int row0 = u.pm * 256 + wr * 64 + fr, col0 = u.pn * 256 + wc * 32 + 4 * fq;
#pragma unroll
        for (int ai = 0; ai < 2; ++ai)
#pragma unroll
            for (int m = 0; m < 4; ++m) { const int r = row0 + ai * 128 + m * 16; const int b = r >> 12, t = r & 4095, rr = t >> 6, cc = t & 63;
                const float* gate = modr + b * 6144 + 2048;
#pragma unroll
                for (int bj = 0; bj < 2; ++bj)
#pragma unroll
                    for (int n = 0; n < 2; ++n) { const int c = col0 + bj * 128 + n * 16;
                        const f32x4 xv = *(const f32x4*)(x + (size_t)r * DM + c);
                        const f32x4 pv = (c < 512) ? *(const f32x4*)(postab + rr * 512 + c) : *(const f32x4*)(postab + cc * 512 + c - 512);
                        const f32x4 gv = *(const f32x4*)(gate + c);
                        *(f32x4*)(x1 + (size_t)r * DM + c) = xv + (DBG_NOPOS ? pv * 0.f : pv) + (DBG_NOMIX ? gv * 0.f : gv * acc[ai][bj][m][n]); } }
    }
};
struct EpiGU {
    static constexpr bool PERM = true, AFTER_DRAIN = false;
    bf16* hid;
    __device__ __forceinline__ void operator()(const f32x4 (&acc)[2][2][4][2], const pg8::Unit& u, int wr, int wc, int fr, int fq) const {
        const int row0 = u.pm * 256 + wr * 64 + fr, col0 = (u.pn & 7) * 128 + wc * 32 + 8 * fq;
#pragma unroll
        for (int ai = 0; ai < 2; ++ai)
#pragma unroll
            for (int m = 0; m < 4; ++m) { bf16* rowp = hid + (size_t)(row0 + ai * 128 + m * 16) * DM + col0;
                float o[8];
#pragma unroll
                for (int n = 0; n < 2; ++n)
#pragma unroll
                    for (int j = 0; j < 4; ++j) o[n * 4 + j] = silu_f(acc[ai][0][m][n][j]) * acc[ai][1][m][n][j];
                v4u w; w.x = pk2(o[0], o[1]); w.y = pk2(o[2], o[3]); w.z = pk2(o[4], o[5]); w.w = pk2(o[6], o[7]);
                *(v4u*)rowp = w; }
    }
};
struct EpiDown {
    static constexpr bool PERM = true, AFTER_DRAIN = false;
    bf16* ys; const float* selv;
    __device__ __forceinline__ void operator()(const f32x4 (&acc)[2][2][4][2], const pg8::Unit& u, int wr, int wc, int fr, int fq) const {
        const int row0 = u.pm * 256 + wr * 64 + fr, col0 = (u.pn & 3) * 256 + wc * 32 + 8 * fq;
#pragma unroll
        for (int ai = 0; ai < 2; ++ai)
#pragma unroll
            for (int m = 0; m < 4; ++m) { const int r = row0 + ai * 128 + m * 16; const float sc = selv[r]; bf16* rowp = ys + (size_t)r * DM + col0;
#pragma unroll
                for (int bj = 0; bj < 2; ++bj) { const f32x4 v0 = acc[ai][bj][m][0] * sc, v1 = acc[ai][bj][m][1] * sc;
                    v4u w; w.x = pk2(v0[0], v0[1]); w.y = pk2(v0[2], v0[3]); w.z = pk2(v1[0], v1[1]); w.w = pk2(v1[2], v1[3]);
                    *(v4u*)(rowp + bj * 128) = w; } }
    }
};

__device__ __forceinline__ void transpose_item(const float* W, int ldw, int k0, int nsrc0, bf16* WT, int K, int drow0, LAS float* scr, int lane, bool zero) {
#pragma unroll 8
    for (int i = 0; i < 32; ++i) { const int kk = 2 * i + (lane >> 5); scr[kk * 33 + (lane & 31)] = zero ? 0.f : W[(size_t)(k0 + kk) * ldw + nsrc0 + (lane & 31)]; }
    LDS_WAIT();
    const int c = lane & 7;
#pragma unroll
    for (int j = 0; j < 4; ++j) { const int n = (lane >> 3) + 8 * j; const LAS float* s = scr + (8 * c) * 33 + n;
        v4u o; o.x = pk2(s[0 * 33], s[1 * 33]); o.y = pk2(s[2 * 33], s[3 * 33]); o.z = pk2(s[4 * 33], s[5 * 33]); o.w = pk2(s[6 * 33], s[7 * 33]);
        *(v4u*)(WT + (size_t)(drow0 + n) * K + k0 + 8 * c) = o; }
    LDS_WAIT();
}

__device__ __forceinline__ void phase0(const Args& a, LAS unsigned char* lds) {
    int tid = threadIdx.x; const int wg = blockIdx.x, G = gridDim.x;
    asm volatile("" : "+v"(tid));
    int lane = tid & 63, wave = tid >> 6;
    unsigned char* ws = a.ws;
    for (int it = wg; it < 192; it += G) {
        LAS float* sl = (LAS float*)lds;
        LAS float* red = (LAS float*)(lds + 20480);
        for (int i = tid; i < 5 * 1024; i += NTHR) { const int bb = i >> 10, k = i & 1023; const float v = (bb < 4) ? a.in[1][bb * 1024 + k] : a.in[3][k]; sl[i] = silu_f(v); }
        __syncthreads();
        const int col = it * 32 + (lane & 31), kk = wave * 2 + (lane >> 5);
        float acc[5] = {0.f, 0.f, 0.f, 0.f, 0.f};
        const float* wp = a.in[4] + col;
#pragma unroll 8
        for (int j = 0; j < 64; ++j) { const int k = kk + 16 * j; const float w = wp[(size_t)k * 6144];
#pragma unroll
            for (int bb = 0; bb < 5; ++bb) acc[bb] += sl[bb * 1024 + k] * w; }
#pragma unroll
        for (int bb = 0; bb < 5; ++bb) red[(kk * 5 + bb) * 32 + (lane & 31)] = acc[bb];
        __syncthreads();
        if (tid < 160) { const int bb = tid >> 5, cl = tid & 31; float s = 0.f;
#pragma unroll
            for (int q = 0; q < 16; ++q) s += red[(q * 5 + bb) * 32 + cl];
            ((float*)(ws + WS_MOD))[bb * 6144 + it * 32 + cl] = s + a.in[5][it * 32 + cl]; }
        __syncthreads();
    }
    for (int it = wg; it < 256; it += G) {
        asm volatile("" : "+v"(tid));
        LAS float* zl = (LAS float*)lds;
        LAS float* h1 = (LAS float*)(lds + 4096);
        LAS float* h2 = (LAS float*)(lds + 8192);
        const int i0 = it * 16;
        for (int o = tid; o < 16 * 33; o += NTHR) { const int li = o / 33, j = o % 33; const int i = i0 + li;
            const float ti = (float)i * (1.0f / 4095.0f);
            const float wi = (6.2831855f * (float)i) / 4096.0f;
            float v;
            if (j == 0) v = ti;
            else { const int jj = (j - 1) & 15; const float f = 1e-4f + (float)jj * ((15.0f - 1e-4f) / 15.0f); const float ar = f * wi; v = (j <= 16) ? cosf(ar) : -sinf(ar); }
            zl[li * 36 + j] = v; }
        __syncthreads();
#pragma unroll
        for (int q = 0; q < 2; ++q) { const int o = tid + NTHR * q, li = o >> 6, m = o & 63; float s = a.in[16][m];
            for (int j = 0; j < 33; ++j) s += zl[li * 36 + j] * a.in[15][j * 64 + m];
            h1[li * 64 + m] = sinf(a.in[20][m] * s); }
        __syncthreads();
#pragma unroll
        for (int q = 0; q < 2; ++q) { const int o = tid + NTHR * q, li = o >> 6, m = o & 63; float s = a.in[18][m];
            for (int k = 0; k < 64; ++k) s += h1[li * 64 + k] * a.in[17][k * 64 + m];
            h2[li * 64 + m] = sinf(a.in[20][m] * s); }
        __syncthreads();
        f32x4 acc[16];
#pragma unroll
        for (int li = 0; li < 16; ++li) acc[li] = (f32x4){0.f, 0.f, 0.f, 0.f};
        const float* w3 = a.in[19] + tid * 4;
        for (int k = 0; k < 64; ++k) { const f32x4 w = *(const f32x4*)(w3 + k * 2048);
#pragma unroll
            for (int li = 0; li < 16; ++li) acc[li] += w * h2[li * 64 + k]; }
        float* hT = (float*)(ws + WS_HT);
#pragma unroll
        for (int j = 0; j < 4; ++j) { const int col = tid * 4 + j, od = col >> 9, c = col & 511;
            const float delta = 3.0701134573f + (float)c * ((15.3505672866f - 3.0701134573f) / 511.0f);
            float* dst = hT + ((size_t)od * 512 + c) * SEQ + i0;
#pragma unroll
            for (int q = 0; q < 4; ++q) { f32x4 o;
#pragma unroll
                for (int s = 0; s < 4; ++s) { const int li = q * 4 + s; const float ti = (float)(i0 + li) * (1.0f / 4095.0f); o[s] = DBG_HTCONST == 1 ? 1.0f : DBG_HTCONST == 2 ? zl[li * 36 + (col % 33)] : DBG_HTCONST == 3 ? h1[li * 64 + (col & 63)] : DBG_HTCONST == 4 ? h2[li * 64 + (col & 63)] : DBG_HTCONST == 5 ? acc[li][j] : acc[li][j] * __expf(-ti * delta); }
                *(f32x4*)(dst + q * 4) = o; } }
        __syncthreads();
    }
    {
        asm volatile("" : "+v"(tid)); lane = tid & 63; wave = tid >> 6;
        LAS float* scr = (LAS float*)(lds + wave * 8448);
        const int gw = wg * NWAVES + wave, NGW = G * NWAVES;
        constexpr int I_IN = 104 * 16, I_OUT = 32 * 16;
        for (int it = gw; it < I_IN + I_OUT; it += NGW) {
            if (it < I_IN) { const int nb = it >> 4, kb = it & 15, n0 = nb * 32;
                const int ns = (n0 < 1536) ? n0 : (n0 < 3072 ? n0 + 32 : 1536 + (n0 - 3072));
                transpose_item(a.in[7], DIN, kb * 64, (n0 < DIN) ? ns : 0, (bf16*)(ws + WS_WIN), DM, n0, scr, lane, n0 >= DIN);
            } else { const int r = it - I_IN, nb = r >> 4, kb = r & 15;
                transpose_item(a.in[22], DM, kb * 64, nb * 32, (bf16*)(ws + WS_WOUT), DM, nb * 32, scr, lane, false); }
        }
    }
    for (int e = wg * NTHR + tid; e < 64 * 256; e += G * NTHR) { const int i = e >> 8, j = e & 255;
        const float om = 1.0f / powf(10000.0f, (float)j * (1.0f / 256.0f)); const float er = (float)i * om;
        float* pt = (float*)(ws + WS_POS); pt[i * 512 + j] = sinf(er); pt[i * 512 + 256 + j] = cosf(er); }
}

__device__ __forceinline__ void phase1(const Args& a, LAS unsigned char* lds) {
    const int tid = threadIdx.x, lane = tid & 63, wave = tid >> 6, wg = blockIdx.x, G = gridDim.x;
    unsigned char* ws = a.ws;
    const float* modr = (const float*)(ws + WS_MOD); const float* pt = (const float*)(ws + WS_POS); bf16* ain = (bf16*)(ws + WS_AIN);
    const float* gmix = a.in[6];
    for (int r = wg * NWAVES + wave; r < MT; r += G * NWAVES) {
        const float* src; int bb; int rr = 0, cc = 0; const bool lat = r < MX;
        if (lat) { src = a.in[0] + (size_t)r * DM; bb = r >> 12; const int t = r & 4095; rr = t >> 6; cc = t & 63; }
        else { src = a.in[2] + (size_t)(r - MX) * DM; bb = 4; }
        f32x4 v[4]; float ss = 0.f;
#pragma unroll
        for (int j = 0; j < 4; ++j) { const int col = 4 * lane + 256 * j; v[j] = *(const f32x4*)(src + col);
            if (lat) v[j] += (j < 2) ? *(const f32x4*)(pt + rr * 512 + col) : *(const f32x4*)(pt + cc * 512 + col - 512);
            ss += v[j][0] * v[j][0] + v[j][1] * v[j][1] + v[j][2] * v[j][2] + v[j][3] * v[j][3]; }
        const float rs = rsqrtf(wave_sum(ss) * (1.0f / DM) + EPS);
#pragma unroll
        for (int j = 0; j < 4; ++j) { const int col = 4 * lane + 256 * j;
            const f32x4 g = *(const f32x4*)(gmix + col), sh = *(const f32x4*)(modr + bb * 6144 + col), sc = *(const f32x4*)(modr + bb * 6144 + 1024 + col);
            const f32x4 y = (v[j] * rs * g) * (sc + 1.0f) + sh;
            v2u w; w.x = pk2(y[0], y[1]); w.y = pk2(y[2], y[3]);
            *(v2u*)(ain + (size_t)r * DM + col) = w; }
    }
}

typedef float cpx __attribute__((ext_vector_type(2)));
__device__ __forceinline__ cpx make_cpx(float x, float y) { cpx r; r.x = x; r.y = y; return r; }
__device__ __forceinline__ cpx cmul(cpx a, cpx b) { return make_cpx(a.x * b.x - a.y * b.y, a.x * b.y + a.y * b.x); }
__device__ __forceinline__ cpx cadd(cpx a, cpx b) { return make_cpx(a.x + b.x, a.y + b.y); }
__device__ __forceinline__ cpx csub(cpx a, cpx b) { return make_cpx(a.x - b.x, a.y - b.y); }
__device__ __forceinline__ cpx cconj(cpx a) { return make_cpx(a.x, -a.y); }
__device__ __forceinline__ cpx twid(float turns) { return make_cpx(__builtin_amdgcn_cosf(turns), -__builtin_amdgcn_sinf(turns)); }
__device__ __forceinline__ void dft4(cpx& a0, cpx& a1, cpx& a2, cpx& a3) {
    const cpx t0 = cadd(a0, a2), t1 = csub(a0, a2), t2 = cadd(a1, a3), t3 = csub(a1, a3);
    a0 = cadd(t0, t2); a2 = csub(t0, t2);
    a1 = make_cpx(t1.x + t3.y, t1.y - t3.x);
    a3 = make_cpx(t1.x - t3.y, t1.y + t3.x);
}
__device__ __forceinline__ void dft16(cpx (&v)[16]) {
    cpx t[16];
#pragma unroll
    for (int j = 0; j < 4; ++j) { cpx b0 = v[j], b1 = v[j + 4], b2 = v[j + 8], b3 = v[j + 12]; dft4(b0, b1, b2, b3); t[4 * j] = b0; t[4 * j + 1] = b1; t[4 * j + 2] = b2; t[4 * j + 3] = b3; }
    const float C1 = 0.92387953251f, S1 = 0.38268343236f, R2 = 0.70710678118f;
    const cpx W1 = make_cpx(C1, -S1), W2 = make_cpx(R2, -R2), W3 = make_cpx(S1, -C1), W4 = make_cpx(0.f, -1.f), W6 = make_cpx(-R2, -R2), W9 = make_cpx(-C1, S1);
    {   cpx b0 = t[0], b1 = t[4], b2 = t[8], b3 = t[12]; dft4(b0, b1, b2, b3); v[0] = b0; v[4] = b1; v[8] = b2; v[12] = b3; }
    {   cpx b0 = t[1], b1 = cmul(t[5], W1), b2 = cmul(t[9], W2), b3 = cmul(t[13], W3); dft4(b0, b1, b2, b3); v[1] = b0; v[5] = b1; v[9] = b2; v[13] = b3; }
    {   cpx b0 = t[2], b1 = cmul(t[6], W2), b2 = cmul(t[10], W4), b3 = cmul(t[14], W6); dft4(b0, b1, b2, b3); v[2] = b0; v[6] = b1; v[10] = b2; v[14] = b3; }
    {   cpx b0 = t[3], b1 = cmul(t[7], W3), b2 = cmul(t[11], W6), b3 = cmul(t[15], W9); dft4(b0, b1, b2, b3); v[3] = b0; v[7] = b1; v[11] = b2; v[15] = b3; }
}
#define FPAD(i) ((i) + ((i) >> 4))
constexpr int FFT_STRIDE = 4352;
__device__ __forceinline__ void fft_dual(LAS cpx* buf) {
#pragma unroll
    for (int p = 0; p < 3; ++p) {
        int tid = threadIdx.x; asm volatile("" : "+v"(tid));
        const int j = tid & 255;
        LAS cpx* b = buf + (tid >> 8) * FFT_STRIDE;
        const int Ns = 1 << (4 * p);
        const int k = j & (Ns - 1);
        cpx v[16];
        LAS cpx* rd = b + FPAD(j);
#pragma unroll
        for (int r = 0; r < 16; ++r) v[r] = rd[272 * r];
        if (p > 0) {
            const float ang = (float)k / (float)(Ns * 16);
#pragma unroll
            for (int r = 1; r < 16; ++r) v[r] = cmul(v[r], twid(ang * (float)r));
        }
        dft16(v);
        __syncthreads();
        const int j0 = ((j - k) << 4) + k;
        LAS cpx* wrp = b + FPAD(j0);
        const int ws = (p == 0) ? 1 : (p == 1 ? 17 : 272);
#pragma unroll
        for (int q = 0; q < 16; ++q) wrp[ws * q] = v[q];
        __syncthreads();
    }
}

__device__ __forceinline__ void hyena_item(const Args& a, LAS unsigned char* lds, int c, int stage) {
    int tid = threadIdx.x; asm volatile("" : "+v"(tid));
    unsigned char* ws = a.ws;
    LAS cpx* buf0 = (LAS cpx*)lds;
    LAS cpx* buf1 = (LAS cpx*)(lds + 2 * FFT_STRIDE * 8);
    const float* hT = (const float*)(ws + WS_HT);
    const float* hf = hT + ((size_t)(stage * 2 + 0) * 512 + c) * SEQ;
    const float* hb = hT + ((size_t)(stage * 2 + 1) * 512 + c) * SEQ;
    const float* hyT = (const float*)(ws + WS_HYT);
    const float* zT = (const float*)(ws + WS_ZT);
    float* outp = (float*)(ws + (stage == 0 ? WS_ZT : WS_YHYT));
    const float* cw = a.in[13]; const float* cb = a.in[14];
    const int chu = c, chg = (stage == 0 ? 512 : 1024) + c;
    const float wu0 = cw[chu], wu1 = cw[1536 + chu], wu2 = cw[3072 + chu], bu = cb[chu];
    const float wg0 = cw[chg], wg1 = cw[1536 + chg], wg2 = cw[3072 + chg], bg = cb[chg];
    const float bias = a.in[21][stage * 512 + c];
    int ptid = FPAD(tid);
#pragma unroll
    for (int i = 0; i < 8; ++i) { const int n = tid + NTHR * i; const int pn = ptid + 544 * i; const float f = hf[n]; const float g = n ? hb[SEQ - n] : 0.f;
        const cpx w = twid((float)n * (1.0f / 8192.0f)); const float d = f - g;
        buf1[pn] = make_cpx(f + g, 0.f); buf1[FFT_STRIDE + pn] = make_cpx(d * w.x, d * w.y); }
    __syncthreads();
    fft_dual(buf1);
    for (int bp = 0; bp < 2; ++bp) {
        asm volatile("" : "+v"(tid)); ptid = FPAD(tid);
        const int b0 = 2 * bp, b1 = 2 * bp + 1;
        float u0[8], u1[8];
#pragma unroll
        for (int i = 0; i < 8; ++i) { const int n = tid + NTHR * i; const int pn = ptid + 544 * i;
            if (stage == 0) {
                const float* p0 = hyT + ((size_t)b0 * 1536 + chu) * SEQ + n; const float* p1 = hyT + ((size_t)b1 * 1536 + chu) * SEQ + n;
                const float l0 = n ? p0[-1] : 0.f, r0 = (n < SEQ - 1) ? p0[1] : 0.f, l1 = n ? p1[-1] : 0.f, r1 = (n < SEQ - 1) ? p1[1] : 0.f;
                u0[i] = wu0 * l0 + wu1 * p0[0] + wu2 * r0 + bu; u1[i] = wu0 * l1 + wu1 * p1[0] + wu2 * r1 + bu;
            } else { u0[i] = zT[((size_t)b0 * 512 + c) * SEQ + n]; u1[i] = zT[((size_t)b1 * 512 + c) * SEQ + n]; }
            const cpx x = make_cpx(u0[i], u1[i]); const cpx w = twid((float)n * (1.0f / 8192.0f));
            buf0[pn] = x; buf0[FFT_STRIDE + pn] = cmul(x, w); }
        __syncthreads();
        fft_dual(buf0);
#pragma unroll
        for (int i = 0; i < 8; ++i) { const int n = tid + NTHR * i; const int pn = ptid + 544 * i;
            const cpx ye = cmul(buf0[pn], buf1[pn]), yo = cmul(buf0[FFT_STRIDE + pn], buf1[FFT_STRIDE + pn]);
            buf0[pn] = cconj(ye); buf0[FFT_STRIDE + pn] = cconj(yo); }
        __syncthreads();
        fft_dual(buf0);
#pragma unroll
        for (int i = 0; i < 8; ++i) { const int n = tid + NTHR * i; const int pn = ptid + 544 * i;
            const cpx ye = cconj(buf0[pn]), yo = cconj(buf0[FFT_STRIDE + pn]);
            const cpx w = twid((float)n * (1.0f / 8192.0f));
            const cpx y = cadd(ye, cmul(cconj(w), yo));
            const float y0 = y.x * (1.0f / 8192.0f) + bias * u0[i], y1 = y.y * (1.0f / 8192.0f) + bias * u1[i];
            const float* g0 = hyT + ((size_t)b0 * 1536 + chg) * SEQ + n; const float* g1 = hyT + ((size_t)b1 * 1536 + chg) * SEQ + n;
            const float l0 = n ? g0[-1] : 0.f, r0 = (n < SEQ - 1) ? g0[1] : 0.f, l1 = n ? g1[-1] : 0.f, r1 = (n < SEQ - 1) ? g1[1] : 0.f;
            const float gg0 = wg0 * l0 + wg1 * g0[0] + wg2 * r0 + bg, gg1 = wg0 * l1 + wg1 * g1[0] + wg2 * r1 + bg;
            outp[((size_t)b0 * 512 + c) * SEQ + n] = gg0 * y0; outp[((size_t)b1 * 512 + c) * SEQ + n] = gg1 * y1; }
        __syncthreads();
    }
}

__device__ __forceinline__ f32x16 mfma32(bf16x8 a, bf16x8 b, f32x16 c) { return __builtin_amdgcn_mfma_f32_32x32x16_bf16(a, b, c, 0, 0, 0); }

__device__ __forceinline__ void gla_decay_tables(const Args& a, int h, size_t rowbase, LAS float* P, LAS float* X, LAS float* aL, LAS float* wa) {
    const int tid = threadIdx.x;
    const float* afb = (const float*)(a.ws + WS_AFB);
    { const int s = tid >> 3, q = tid & 7; *(LAS f32x4*)(aL + s * 32 + 4 * q) = *(const f32x4*)(afb + (rowbase + s) * 32 + 4 * q); }
    for (int i = tid; i < 2048; i += NTHR) { const int dir = i >> 10, j = (i >> 6) & 15, d = i & 63; wa[i] = (dir ? a.in[10] : a.in[8])[j * 256 + h * 64 + d]; }
    __syncthreads();
    { const int d = tid & 63, sg = tid >> 6; const float bf = a.in[9][h * 64 + d], bb = a.in[11][h * 64 + d];
#pragma unroll
        for (int q = 0; q < 8; ++q) { const int s = sg * 8 + q; float pf = bf, pb = bb;
#pragma unroll
            for (int j = 0; j < 16; ++j) { pf += aL[s * 32 + j] * wa[j * 64 + d]; pb += aL[s * 32 + 16 + j] * wa[1024 + j * 64 + d]; }
            P[s * 65 + d] = logsig_f(pf) * (1.0f / 16.0f); X[s * 65 + d] = logsig_f(pb) * (1.0f / 16.0f); } }
    __syncthreads();
    if (tid < 64) { float c = 0.f; for (int s = 0; s < 64; ++s) { c += P[s * 65 + tid]; P[s * 65 + tid] = c; } }
    else if (tid < 128) { const int d = tid - 64; float c = 0.f; for (int s = 63; s >= 0; --s) { c += X[s * 65 + d]; X[s * 65 + d] = c; } }
    __syncthreads();
}

__device__ __forceinline__ void gla_upd_item(const Args& a, LAS unsigned char* lds, int bh, int ci) {
    const int tid = threadIdx.x, lane = tid & 63, wave = tid >> 6, b = bh >> 2, h = bh & 3;
    unsigned char* ws = a.ws;
    LAS float* P = (LAS float*)lds; LAS float* X = (LAS float*)(lds + 16640);
    LAS bf16* vT = (LAS bf16*)(lds + 33280);
    LAS bf16* kfT = (LAS bf16*)(lds + 33280 + 18432);
    LAS bf16* kbT = (LAS bf16*)(lds + 33280 + 18432 + 9216);
    LAS float* aL = (LAS float*)(lds + 70144); LAS float* wa = (LAS float*)(lds + 70144 + 8192);
    const size_t rowbase = (ci < 4) ? (size_t)(MX + b * CTXL + ci * 64) : (size_t)(b * SEQ + (ci - 4) * 64);
    const bf16* qkvg = (const bf16*)(ws + WS_QKVG);
    gla_decay_tables(a, h, rowbase, P, X, aL, wa);
    { const int s = tid >> 3, dq = (tid & 7) * 8;
        const v4u kw = *(const v4u*)(qkvg + (rowbase + s) * NQ + 256 + h * 64 + dq);
        float kv[8] = {bflo(kw.x), bfhi(kw.x), bflo(kw.y), bfhi(kw.y), bflo(kw.z), bfhi(kw.z), bflo(kw.w), bfhi(kw.w)};
#pragma unroll
        for (int j = 0; j < 8; ++j) { const int d = dq + j;
            const float kf = kv[j] * __expf(P[63 * 65 + d] - P[s * 65 + d]), kb = kv[j] * __expf(X[d] - X[s * 65 + d]);
            kfT[d * 72 + s] = (bf16)f2bf(kf); kbT[d * 72 + s] = (bf16)f2bf(kb); } }
#pragma unroll
    for (int q = 0; q < 2; ++q) { const int idx = tid + NTHR * q, s = idx >> 4, e8 = (idx & 15) * 8;
        const v4u vw = *(const v4u*)(qkvg + (rowbase + s) * NQ + 512 + h * 128 + e8);
        const unsigned w[4] = {vw.x, vw.y, vw.z, vw.w};
#pragma unroll
        for (int j = 0; j < 4; ++j) { vT[(e8 + 2 * j) * 72 + s] = (bf16)(w[j] & 0xffffu); vT[(e8 + 2 * j + 1) * 72 + s] = (bf16)(w[j] >> 16); } }
    float* dec = (float*)(ws + WS_DEC);
    if (tid < 64) dec[((size_t)(bh * 2 + 0) * NCH + ci) * 64 + tid] = __expf(P[63 * 65 + tid]);
    else if (tid < 128) dec[((size_t)(bh * 2 + 1) * NCH + ci) * 64 + tid - 64] = __expf(X[tid - 64]);
    __syncthreads();
    { const int dir = wave >> 2, e0 = (wave & 3) * 32, l31 = lane & 31, hh = lane >> 5;
        LAS bf16* kT = dir ? kbT : kfT;
        float* U = (ci < 4) ? (float*)(ws + WS_UCTX) + ((size_t)(bh * 2 + dir) * 4 + ci) * 8192 : a.out + ((size_t)(bh * 2 + dir) * 64 + (ci - 4)) * 8192;
#pragma unroll
        for (int dt = 0; dt < 2; ++dt) { const int d0 = dt * 32; f32x16 acc;
#pragma unroll
            for (int i = 0; i < 16; ++i) acc[i] = 0.f;
#pragma unroll
            for (int ks = 0; ks < 4; ++ks) { const bf16x8 A = *(const LAS bf16x8*)(vT + (e0 + l31) * 72 + 16 * ks + 8 * hh), B = *(const LAS bf16x8*)(kT + (d0 + l31) * 72 + 16 * ks + 8 * hh);
                acc = mfma32(A, B, acc); }
#pragma unroll
            for (int r = 0; r < 16; ++r) { const int e = e0 + (r & 3) + 8 * (r >> 2) + 4 * hh; U[e * 64 + d0 + l31] = acc[r]; } } }
    __syncthreads();
}

__device__ __forceinline__ void gla_scan_item(const Args& a, int it) {
    const int tid = threadIdx.x, bd = it >> 4, dir = bd & 1, el = ((it & 15) * 8 + (tid >> 6)) * 64 + (tid & 63), d = tid & 63;
    unsigned char* ws = a.ws;
    const float* dec = (const float*)(ws + WS_DEC) + (size_t)bd * NCH * 64 + d;
    const float* Uc = (const float*)(ws + WS_UCTX) + (size_t)bd * 4 * 8192 + el;
    const float* U = a.out + (size_t)bd * 64 * 8192 + el;
    bf16* Sp = (bf16*)(ws + WS_SPREV) + (size_t)bd * 64 * 8192 + el;
    float S = 0.f;
    if (dir == 0) {
#pragma unroll
        for (int ci = 0; ci < 4; ++ci) S = dec[ci * 64] * S + Uc[(size_t)ci * 8192];
#pragma unroll 8
        for (int n = 0; n < 64; ++n) { Sp[(size_t)n * 8192] = (bf16)f2bf(S); S = dec[(4 + n) * 64] * S + U[(size_t)n * 8192]; }
    } else {
#pragma unroll
        for (int ci = 3; ci >= 0; --ci) S = dec[ci * 64] * S + Uc[(size_t)ci * 8192];
#pragma unroll 8
        for (int n = 63; n >= 0; --n) { Sp[(size_t)n * 8192] = (bf16)f2bf(S); S = dec[(4 + n) * 64] * S + U[(size_t)n * 8192]; }
    }
}

__device__ __forceinline__ void gla_out_item(const Args& a, LAS unsigned char* lds, int bh, int n) {
    const int tid = threadIdx.x, lane = tid & 63, wave = tid >> 6, b = bh >> 2, h = bh & 3, l31 = lane & 31, hh = lane >> 5;
    unsigned char* ws = a.ws;
    LAS float* P = (LAS float*)lds; LAS float* X = (LAS float*)(lds + 16640);
    LAS bf16* Scat = (LAS bf16*)lds;
    LAS bf16* qf = (LAS bf16*)(lds + 33280);
    LAS bf16* qb = qf + 4608; LAS bf16* kf = qf + 2 * 4608; LAS bf16* kb = qf + 3 * 4608;
    LAS float* oS = (LAS float*)(lds + 33280);
    LAS bf16* qS = (LAS bf16*)(lds + 70144);
    LAS float* aL = (LAS float*)(lds + 70144); LAS float* wa = (LAS float*)(lds + 70144 + 8192);
    LAS bf16* vT = (LAS bf16*)(lds + 87552);
    LAS bf16* Sp = (LAS bf16*)(lds + 105984);
    const size_t rowbase = (size_t)b * SEQ + n * 64;
    const bf16* qkvg = (const bf16*)(ws + WS_QKVG);
    gla_decay_tables(a, h, rowbase, P, X, aL, wa);
    { const bf16* spf = (const bf16*)(ws + WS_SPREV) + ((size_t)(bh * 2 + 0) * 64 + n) * 8192; const bf16* spb = (const bf16*)(ws + WS_SPREV) + ((size_t)(bh * 2 + 1) * 64 + n) * 8192;
#pragma unroll
        for (int q = 0; q < 4; ++q) { const int idx = tid + NTHR * q, dir = idx >> 10, e = (idx >> 3) & 127, d8 = (idx & 7) * 8;
            *(LAS v4u*)(Sp + e * 136 + dir * 64 + d8) = *(const v4u*)((dir ? spb : spf) + e * 64 + d8); } }
#pragma unroll
    for (int q = 0; q < 2; ++q) { const int idx = tid + NTHR * q, s = idx >> 4, e8 = (idx & 15) * 8;
        const v4u vw = *(const v4u*)(qkvg + (rowbase + s) * NQ + 512 + h * 128 + e8);
        const unsigned w[4] = {vw.x, vw.y, vw.z, vw.w};
#pragma unroll
        for (int j = 0; j < 4; ++j) { vT[(e8 + 2 * j) * 72 + s] = (bf16)(w[j] & 0xffffu); vT[(e8 + 2 * j + 1) * 72 + s] = (bf16)(w[j] >> 16); } }
    { const int s = tid >> 3, dq = (tid & 7) * 8;
        const v4u qw = *(const v4u*)(qkvg + (rowbase + s) * NQ + h * 64 + dq), kw = *(const v4u*)(qkvg + (rowbase + s) * NQ + 256 + h * 64 + dq);
        const float qv[8] = {bflo(qw.x), bfhi(qw.x), bflo(qw.y), bfhi(qw.y), bflo(qw.z), bfhi(qw.z), bflo(qw.w), bfhi(qw.w)};
        const float kv[8] = {bflo(kw.x), bfhi(kw.x), bflo(kw.y), bfhi(kw.y), bflo(kw.z), bfhi(kw.z), bflo(kw.w), bfhi(kw.w)};
        float o_qf[8], o_qb[8], o_kf[8], o_kb[8], o_sf[8], o_sb[8];
#pragma unroll
        for (int j = 0; j < 8; ++j) { const int d = dq + j; const float Ps = P[s * 65 + d], Pm = P[32 * 65 + d], Xs = X[s * 65 + d], Xm = X[31 * 65 + d];
            o_qf[j] = qv[j] * __expf(Ps - Pm); o_kf[j] = kv[j] * __expf(Pm - Ps); o_sf[j] = qv[j] * __expf(Ps);
            o_qb[j] = qv[j] * __expf(Xs - Xm); o_kb[j] = kv[j] * __expf(Xm - Xs); o_sb[j] = qv[j] * __expf(Xs); }
#define PK8(o) ((v4u){pk2(o[0], o[1]), pk2(o[2], o[3]), pk2(o[4], o[5]), pk2(o[6], o[7])})
        *(LAS v4u*)(qf + s * 72 + dq) = PK8(o_qf); *(LAS v4u*)(qb + s * 72 + dq) = PK8(o_qb); *(LAS v4u*)(kf + s * 72 + dq) = PK8(o_kf); *(LAS v4u*)(kb + s * 72 + dq) = PK8(o_kb);
        *(LAS v4u*)(qS + s * 136 + dq) = PK8(o_sf); *(LAS v4u*)(qS + s * 136 + 64 + dq) = PK8(o_sb);
    }
    __syncthreads();
    { const int dir = wave >> 2, c0 = ((wave >> 1) & 1) * 32, s0 = (wave & 1) * 32;
        LAS bf16* qq = dir ? qb : qf; LAS bf16* kk = dir ? kb : kf;
        f32x16 acc;
#pragma unroll
        for (int i = 0; i < 16; ++i) acc[i] = 0.f;
#pragma unroll
        for (int ks = 0; ks < 4; ++ks) { const bf16x8 A = *(const LAS bf16x8*)(qq + (c0 + l31) * 72 + 16 * ks + 8 * hh), B = *(const LAS bf16x8*)(kk + (s0 + l31) * 72 + 16 * ks + 8 * hh);
            acc = mfma32(A, B, acc); }
        const int s = s0 + l31;
#pragma unroll
        for (int r = 0; r < 16; ++r) { const int c = c0 + (r & 3) + 8 * (r >> 2) + 4 * hh; const bool keep = dir ? (s >= c) : (s <= c);
            Scat[c * 136 + dir * 64 + s] = (bf16)f2bf(keep ? acc[r] : 0.f); } }
    __syncthreads();
    { const int c0 = (wave >> 2) * 32, e0 = (wave & 3) * 32;
        f32x16 acc;
#pragma unroll
        for (int i = 0; i < 16; ++i) acc[i] = 0.f;
#pragma unroll
        for (int ks = 0; ks < 8; ++ks) { const bf16x8 A = *(const LAS bf16x8*)(Scat + (c0 + l31) * 136 + 16 * ks + 8 * hh), B = *(const LAS bf16x8*)(vT + (e0 + l31) * 72 + ((16 * ks + 8 * hh) & 63));
            acc = mfma32(A, B, acc); }
#pragma unroll
        for (int ks = 0; ks < 8; ++ks) { const bf16x8 A = *(const LAS bf16x8*)(qS + (c0 + l31) * 136 + 16 * ks + 8 * hh), B = *(const LAS bf16x8*)(Sp + (e0 + l31) * 136 + 16 * ks + 8 * hh);
            acc = mfma32(A, B, acc); }
#pragma unroll
        for (int r = 0; r < 16; ++r) { const int c = c0 + (r & 3) + 8 * (r >> 2) + 4 * hh; oS[c * 132 + e0 + l31] = acc[r]; } }
    __syncthreads();
    { const int row = tid >> 3, ec = (tid & 7) * 16; float v[16]; float ss = 0.f;
#pragma unroll
        for (int j = 0; j < 16; ++j) { v[j] = oS[row * 132 + ec + j]; ss += v[j] * v[j]; }
        ss += __shfl_xor(ss, 1); ss += __shfl_xor(ss, 2); ss += __shfl_xor(ss, 4);
        const float rs = rsqrtf(ss * (1.0f / 128.0f) + EPS);
        const bf16* gp = qkvg + (rowbase + row) * NQ + 1024 + h * 128 + ec; const v4u g0 = *(const v4u*)gp, g1 = *(const v4u*)(gp + 8);
        const float gv[16] = {bflo(g0.x), bfhi(g0.x), bflo(g0.y), bfhi(g0.y), bflo(g0.z), bfhi(g0.z), bflo(g0.w), bfhi(g0.w), bflo(g1.x), bfhi(g1.x), bflo(g1.y), bfhi(g1.y), bflo(g1.z), bfhi(g1.z), bflo(g1.w), bfhi(g1.w)};
        float o[16];
#pragma unroll
        for (int j = 0; j < 16; ++j) o[j] = v[j] * rs * a.in[12][ec + j] * silu_f(gv[j]);
        bf16* op = (bf16*)(ws + WS_AOUT) + (rowbase + row) * DM + h * 128 + ec;
        *(v4u*)op = (v4u){pk2(o[0], o[1]), pk2(o[2], o[3]), pk2(o[4], o[5]), pk2(o[6], o[7])};
        *(v4u*)(op + 8) = (v4u){pk2(o[8], o[9]), pk2(o[10], o[11]), pk2(o[12], o[13]), pk2(o[14], o[15])}; }
    __syncthreads();
}

__device__ __forceinline__ void hy_transpose_item(const Args& a, LAS unsigned char* lds, int it) {
    const int tid = threadIdx.x, b = it >> 6, t0 = (it & 63) * 64;
    LAS float* tile = (LAS float*)lds;
    const float* src = (const float*)(a.ws + WS_YHYT) + (size_t)b * 512 * SEQ + t0;
    bf16* dst = (bf16*)(a.ws + WS_AOUT) + ((size_t)b * SEQ + t0) * DM + 512;
    for (int half = 0; half < 2; ++half) {
#pragma unroll 8
        for (int q = 0; q < 32; ++q) { const int idx = tid + NTHR * q, c = idx >> 6, tt = idx & 63; tile[c * 65 + tt] = src[(size_t)(half * 256 + c) * SEQ + tt]; }
        __syncthreads();
#pragma unroll
        for (int q = 0; q < 4; ++q) { const int idx = tid + NTHR * q, t = idx >> 5, c8 = (idx & 31) * 8; const LAS float* s = tile + c8 * 65 + t;
            *(v4u*)(dst + (size_t)t * DM + half * 256 + c8) = (v4u){pk2(s[0], s[65]), pk2(s[2 * 65], s[3 * 65]), pk2(s[4 * 65], s[5 * 65]), pk2(s[6 * 65], s[7 * 65])}; }
        __syncthreads();
    }
}

__device__ __forceinline__ void phase_router(const Args& a, LAS unsigned char* lds) {
    const int tid = threadIdx.x, lane = tid & 63, wave = tid >> 6, wg = blockIdx.x, G = gridDim.x;
    unsigned char* ws = a.ws;
    LAS float* wr = (LAS float*)lds;
    for (int i = tid; i < 4096; i += NTHR) *(LAS f32x4*)(wr + 4 * i) = *(const f32x4*)(a.in[24] + 4 * i);
    __syncthreads();
    const float* modr = (const float*)(ws + WS_MOD); const float* gffn = a.in[23];
    bf16* hn = (bf16*)(ws + WS_HN); float* aff = (float*)(ws + WS_AFF);
    for (int r = wg * NWAVES + wave; r < MX; r += G * NWAVES) {
        const int b = r >> 12, t = r & 4095;
        const float* src = a.out + (size_t)r * DM;
        f32x4 v[4]; float ss = 0.f;
#pragma unroll
        for (int j = 0; j < 4; ++j) { v[j] = *(const f32x4*)(src + 4 * lane + 256 * j); ss += v[j][0] * v[j][0] + v[j][1] * v[j][1] + v[j][2] * v[j][2] + v[j][3] * v[j][3]; }
        const float rs = rsqrtf(wave_sum(ss) * (1.0f / DM) + EPS);
        float lg[16];
#pragma unroll
        for (int e = 0; e < 16; ++e) lg[e] = 0.f;
#pragma unroll
        for (int j = 0; j < 4; ++j) { const int col = 4 * lane + 256 * j;
            const f32x4 g = *(const f32x4*)(gffn + col), sh = *(const f32x4*)(modr + b * 6144 + 3072 + col), sc = *(const f32x4*)(modr + b * 6144 + 4096 + col);
            const f32x4 y = (v[j] * rs * g) * (sc + 1.0f) + sh;
            v2u w; w.x = pk2(y[0], y[1]); w.y = pk2(y[2], y[3]);
            *(v2u*)(hn + (size_t)r * DM + col) = w;
#pragma unroll
            for (int q = 0; q < 4; ++q) { const LAS f32x4* wp = (const LAS f32x4*)(wr + (col + q) * 16);
#pragma unroll
                for (int e4 = 0; e4 < 4; ++e4) { const f32x4 ww = wp[e4];
#pragma unroll
                    for (int s = 0; s < 4; ++s) lg[e4 * 4 + s] += y[q] * ww[s]; } } }
#pragma unroll
        for (int e = 0; e < 16; ++e) lg[e] = wave_sum(lg[e]);
        float mx = lg[0];
#pragma unroll
        for (int e = 1; e < 16; ++e) mx = fmaxf(mx, lg[e]);
        float sum = 0.f;
#pragma unroll
        for (int e = 0; e < 16; ++e) { lg[e] = expf(lg[e] - mx); sum += lg[e]; }
        float mine = lg[0];
#pragma unroll
        for (int e = 1; e < 16; ++e) mine = (lane == e) ? lg[e] : mine;
        if (lane < 16) aff[((size_t)b * NE + lane) * SEQ + t] = mine / sum;
    }
}

__device__ __forceinline__ void block_excl_scan2(int& va, int& vb, LAS int* tmp) {
    const int tid = threadIdx.x, lane = tid & 63, wave = tid >> 6;
    int ia = va, ib = vb;
#pragma unroll
    for (int o = 1; o < 64; o <<= 1) { const int ta = __shfl_up(ia, o), tb = __shfl_up(ib, o); if (lane >= o) { ia += ta; ib += tb; } }
    if (lane == 63) { tmp[wave] = ia; tmp[8 + wave] = ib; }
    __syncthreads();
    int oa = 0, ob = 0;
#pragma unroll
    for (int w = 0; w < 8; ++w) { if (w < wave) { oa += tmp[w]; ob += tmp[8 + w]; } }
    va = oa + ia - va; vb = ob + ib - vb;
    __syncthreads();
}
__device__ __forceinline__ void topk_item(const Args& a, LAS unsigned char* lds, int be) {
    const int tid = threadIdx.x, b = be >> 4, e = be & 15;
    unsigned char* ws = a.ws;
    LAS unsigned* keys = (LAS unsigned*)lds;
    LAS unsigned* hist = (LAS unsigned*)(lds + 16384);
    LAS int* ctl = (LAS int*)(lds + 16384 + 1024);
    LAS int* tmp = (LAS int*)(lds + 16384 + 1024 + 64);
    const float* aff = (const float*)(ws + WS_AFF) + (size_t)be * SEQ;
    unsigned my[8];
#pragma unroll
    for (int i = 0; i < 8; ++i) { my[i] = __float_as_uint(aff[tid * 8 + i]); keys[tid * 8 + i] = my[i]; }
    unsigned prefix = 0u, mask = 0u; int need = CAP;
    for (int pass = 0; pass < 4; ++pass) {
        const int shift = 24 - 8 * pass;
        if (tid < 256) hist[tid] = 0u;
        __syncthreads();
#pragma unroll
        for (int i = 0; i < 8; ++i) if ((my[i] & mask) == prefix) atomicAdd((unsigned*)&hist[(my[i] >> shift) & 255u], 1u);
        __syncthreads();
        if (tid == 0) { int cum = 0, bin = 255; for (; bin > 0; --bin) { const int hcnt = (int)hist[bin]; if (cum + hcnt >= need) break; cum += hcnt; } ctl[0] = bin; ctl[1] = need - cum; }
        __syncthreads();
        prefix |= ((unsigned)ctl[0]) << shift; mask |= 255u << shift; need = ctl[1];
        __syncthreads();
    }
    const unsigned T = prefix;
    int cg = 0, ce = 0;
#pragma unroll
    for (int i = 0; i < 8; ++i) { cg += (my[i] > T) ? 1 : 0; ce += (my[i] == T) ? 1 : 0; }
    int pg = cg, pe = ce;
    block_excl_scan2(pg, pe, tmp);
    int* slot_of = (int*)(ws + WS_SLOT) + (size_t)be * SEQ;
    int* selt = (int*)(ws + WS_SELT) + (e * 4 + b) * CAP; float* selv = (float*)(ws + WS_SELV) + (e * 4 + b) * CAP;
#pragma unroll
    for (int i = 0; i < 8; ++i) { const int t = tid * 8 + i; const bool gt = my[i] > T, eq = my[i] == T; const bool sel = gt || (eq && pe < need);
        const int slot = pg + (pe < need ? pe : need);
        slot_of[t] = sel ? slot : -1;
        if (sel) { selt[slot] = t; selv[slot] = __uint_as_float(my[i]); }
        pg += gt ? 1 : 0; pe += eq ? 1 : 0; }
    __syncthreads();
}
__device__ __forceinline__ void phase_topk(const Args& a, LAS unsigned char* lds) {
    const int tid = threadIdx.x, lane = tid & 63, wave = tid >> 6, wg = blockIdx.x, G = gridDim.x;
    unsigned char* ws = a.ws;
    for (int it = wg; it < NB * NE; it += G) topk_item(a, lds, it);
    LAS float* scr = (LAS float*)(lds + 32768 + wave * 8448);
    for (int it = wg * NWAVES + wave; it < 48 * 512; it += G * NWAVES) {
        const int mat = it >> 9, r = it & 511, nb = r >> 4, kb = r & 15, e = mat / 3, kind = mat % 3, n0 = nb * 32;
        if (kind < 2) transpose_item((kind ? a.in[26] : a.in[25]) + (size_t)e * DM * DM, DM, kb * 64, n0, (bf16*)(ws + WS_WGU) + (size_t)e * 2048 * DM, DM, (n0 >> 7) * 256 + kind * 128 + (n0 & 127), scr, lane, false);
        else transpose_item(a.in[27] + (size_t)e * DM * DM, DM, kb * 64, n0, (bf16*)(ws + WS_WD) + (size_t)e * DM * DM, DM, n0, scr, lane, false);
    }
}

__device__ __forceinline__ void phase_gather(const Args& a) {
    const int tid = threadIdx.x, lane = tid & 63, wave = tid >> 6, wg = blockIdx.x, G = gridDim.x;
    unsigned char* ws = a.ws;
    const int* selt = (const int*)(ws + WS_SELT); const bf16* hn = (const bf16*)(ws + WS_HN); bf16* xs = (bf16*)(ws + WS_XS);
    for (int R = wg * NWAVES + wave; R < NE * NB * CAP; R += G * NWAVES) {
        const int b = (R >> 9) & 3, tok = selt[R];
        const v4u* s = (const v4u*)(hn + ((size_t)b * SEQ + tok) * DM); v4u* d = (v4u*)(xs + (size_t)R * DM);
        const v4u x0 = s[lane], x1 = s[lane + 64]; d[lane] = x0; d[lane + 64] = x1;
    }
}

__device__ __forceinline__ void phase_final(const Args& a) {
    const int tid = threadIdx.x, lane = tid & 63, wave = tid >> 6, wg = blockIdx.x, G = gridDim.x;
    unsigned char* ws = a.ws;
    const float* modr = (const float*)(ws + WS_MOD); const int* slot_of = (const int*)(ws + WS_SLOT); const bf16* ys = (const bf16*)(ws + WS_YSLAB);
    for (int r = wg * NWAVES + wave; r < MX; r += G * NWAVES) {
        const int b = r >> 12, t = r & 4095;
        float* row = a.out + (size_t)r * DM;
        f32x4 m[4];
#pragma unroll
        for (int j = 0; j < 4; ++j) m[j] = (f32x4){0.f, 0.f, 0.f, 0.f};
        for (int e = 0; e < NE; ++e) { const int s = slot_of[((size_t)b * NE + e) * SEQ + t];
            if (s >= 0 && !DBG_NOMOE) { const bf16* yp = ys + ((size_t)e * 2048 + b * CAP + s) * DM;
#pragma unroll
                for (int j = 0; j < 4; ++j) { const v2u w = *(const v2u*)(yp + 4 * lane + 256 * j); m[j][0] += bflo(w.x); m[j][1] += bfhi(w.x); m[j][2] += bflo(w.y); m[j][3] += bfhi(w.y); } } }
        f32x4 v[4]; float ss = 0.f;
#pragma unroll
        for (int j = 0; j < 4; ++j) { const int col = 4 * lane + 256 * j; v[j] = *(const f32x4*)(row + col) + *(const f32x4*)(modr + b * 6144 + 5120 + col) * m[j];
            ss += v[j][0] * v[j][0] + v[j][1] * v[j][1] + v[j][2] * v[j][2] + v[j][3] * v[j][3]; }
        const float rs = rsqrtf(wave_sum(ss) * (1.0f / DM) + EPS);
#pragma unroll
        for (int j = 0; j < 4; ++j) { const int col = 4 * lane + 256 * j; *(f32x4*)(row + col) = v[j] * rs * *(const f32x4*)(a.in[28] + col); }
    }
}

__global__ void __launch_bounds__(NTHR, 2) fwd_kernel(Args a) {
    extern __shared__ __attribute__((aligned(16))) unsigned char lds_raw[];
    LAS unsigned char* lds = (LAS unsigned char*)lds_raw;
    const int tid = threadIdx.x, wg = blockIdx.x, G = gridDim.x;
    unsigned char* ws = a.ws;
    volatile LAS unsigned* MISC = (volatile LAS unsigned*)(lds + LDS_MISC);
    if (tid < 64) MISC[tid] = 0u;
    __syncthreads();
    XcdBarrier bar; bar.bar = (unsigned*)(ws + WS_CTL); bar.x = 0; bar.st = nullptr;
    if (a.ph_hi - a.ph_lo > 1) bar = xcd_barrier_post((unsigned*)(ws + WS_CTL), MISC + 8);
#ifndef PH_ONLY
#define PH_ONLY -1
#endif
#define IN(k) ((PH_ONLY < 0 || PH_ONLY == (k)) && a.ph_lo <= (k) && (k) < a.ph_hi)
#define SEAM(k) do { if (IN(k) && IN((k) + 1)) xcd_barrier(bar); } while (0)
    if (IN(0)) { phase0(a, lds); } SEAM(0);
    if (IN(1)) { phase1(a, lds); } SEAM(1);
    if (IN(2)) {
        pg8::Gemm g{(const pg8::bf16_t*)(ws + WS_AIN), (const pg8::bf16_t*)(ws + WS_WIN), MT, NIN, DM}; InSched S; S.init(G, wg);
        EpiIn E{(bf16*)(ws + WS_QKVG), (float*)(ws + WS_HYT), (float*)(ws + WS_AFB)};
        pg8::gemm_phase<EpiIn, InSched, true, true>(lds, g, S, E);
    } SEAM(2);
    if (IN(3)) {
        for (int it = wg; it < 512 + 16 * NCH; it += G) { if (it < 512) hyena_item(a, lds, it, 0); else { const int r = it - 512; gla_upd_item(a, lds, r / NCH, r % NCH); } }
    } SEAM(3);
    if (IN(4)) {
        for (int it = wg; it < 1024; it += G) { if (it < 512) hyena_item(a, lds, it, 1); else gla_scan_item(a, it - 512); }
    } SEAM(4);
    if (IN(5)) {
        for (int it = wg; it < 1280; it += G) { if (it < 1024) gla_out_item(a, lds, it >> 6, it & 63); else hy_transpose_item(a, lds, it - 1024); }
    } SEAM(5);
    if (IN(6)) {
        pg8::Gemm g{(const pg8::bf16_t*)(ws + WS_AOUT), (const pg8::bf16_t*)(ws + WS_WOUT), MX, DM, DM}; pg8::StaticOrder S; S.init(MX, DM, G, wg);
        EpiOut E{a.in[0], (const float*)(ws + WS_POS), (const float*)(ws + WS_MOD), a.out};
        pg8::gemm_phase<EpiOut, pg8::StaticOrder, true, true>(lds, g, S, E);
    } SEAM(6);
    if (IN(7)) { phase_router(a, lds); } SEAM(7);
    if (IN(8)) { phase_topk(a, lds); } SEAM(8);
    if (IN(9)) { phase_gather(a); } SEAM(9);
    if (IN(10)) {
        pg8::Gemm g{(const pg8::bf16_t*)(ws + WS_XS), (const pg8::bf16_t*)(ws + WS_WGU), NE * 2048, NE * 2048, DM}; MoeSched<8> S; S.init(G, wg);
        EpiGU E{(bf16*)(ws + WS_HID)};
        pg8::gemm_phase<EpiGU, MoeSched<8>, true, true>(lds, g, S, E);
    } SEAM(10);
    if (IN(11)) {
        pg8::Gemm g{(const pg8::bf16_t*)(ws + WS_HID), (const pg8::bf16_t*)(ws + WS_WD), NE * 2048, NE * 1024, DM}; MoeSched<4> S; S.init(G, wg);
        EpiDown E{(bf16*)(ws + WS_YSLAB), (const float*)(ws + WS_SELV)};
        pg8::gemm_phase<EpiDown, MoeSched<4>, true, true>(lds, g, S, E);
    } SEAM(11);
    if (IN(12)) { phase_final(a); }
#undef IN
#undef SEAM
}


#ifdef DBG_STATE
__global__ void chk_kernel(const unsigned* p, size_t nwords, unsigned long long* out) {
    unsigned long long s = 0ull;
    for (size_t i = (size_t)blockIdx.x * blockDim.x + threadIdx.x; i < nwords; i += (size_t)gridDim.x * blockDim.x) s += (unsigned long long)p[i] * (2ull * i + 1ull);
    for (int o = 1; o < 64; o <<= 1) s += __shfl_xor(s, o);
    if ((threadIdx.x & 63) == 0) atomicAdd(out, s);
}
__global__ void report_kernel(const unsigned long long* chk, float* out, int n) {
    int bad = -1;
    for (int p = 0; p < 28; ++p) if (chk[p] != chk[32 + p]) { bad = p; break; }
    if (bad < 0) return;
    for (int i = blockIdx.x * blockDim.x + threadIdx.x; i < n; i += gridDim.x * blockDim.x) out[i] = 1000.f * (float)(bad + 1);
}
struct ChkEnt { int ph; size_t off; size_t bytes; };
#endif
extern "C" void kernel_launch(void* const* d_in, const int* in_sizes, int n_in, void* d_out, int out_size, void* d_ws, size_t ws_size, hipStream_t stream) {
    static int grid = 0;
    if (grid == 0) {
        if (n_in != 29 || out_size != MX * DM || ws_size < WS_END) { fprintf(stderr, "kernel_launch: unexpected shapes (n_in %d out %d ws %zu)\n", n_in, out_size, ws_size); grid = -1; return; }
        int dev = 0, cus = 0, per_cu = 0;
        if (hipGetDevice(&dev) != hipSuccess || hipDeviceGetAttribute(&cus, hipDeviceAttributeMultiprocessorCount, dev) != hipSuccess) { grid = -1; return; }
        if (hipFuncSetAttribute((const void*)fwd_kernel, hipFuncAttributeMaxDynamicSharedMemorySize, LDS_BYTES) != hipSuccess) { fprintf(stderr, "kernel_launch: hipFuncSetAttribute failed\n"); grid = -1; return; }
        if (hipOccupancyMaxActiveBlocksPerMultiprocessor(&per_cu, (const void*)fwd_kernel, NTHR, LDS_BYTES) != hipSuccess || per_cu < 1) fprintf(stderr, "kernel_launch: occupancy query reports %d\n", per_cu);
        (void)hipGetLastError();
        grid = cus;
    }
    if (grid < 0) return;
    (void)hipMemsetAsync((char*)d_ws + WS_CTL, 0, CTL_BYTES, stream);
    Args a{};
    for (int i = 0; i < 29; ++i) a.in[i] = (const float*)d_in[i];
    a.out = (float*)d_out; a.ws = (unsigned char*)d_ws;
#if MK_SINGLE
    a.ph_lo = 0; a.ph_hi = NPH;
    hipLaunchKernelGGL(fwd_kernel, dim3(grid), dim3(NTHR), LDS_BYTES, stream, a);
#else
#ifdef DBG_STATE
    static const ChkEnt ents[] = { {0, WS_MOD, 122880}, {0, WS_POS, 131072}, {0, WS_HT, 32 * MiB}, {0, WS_WIN, (size_t)NIN * DM * 2}, {0, WS_WOUT, 2 * MiB},
        {1, WS_AIN, 34 * MiB}, {2, WS_QKVG, (size_t)MX * NQ * 2}, {2, WS_HYT, 96 * MiB}, {2, WS_AFB, (size_t)MT * 128},
        {3, WS_ZT, 32 * MiB}, {3, WS_DEC, (size_t)16 * 2 * NCH * 64 * 4}, {3, WS_UCTX, 4 * MiB}, {3, (size_t)-1, 64 * MiB},
        {4, WS_SPREV, 32 * MiB}, {4, WS_YHYT, 32 * MiB}, {5, WS_AOUT, 32 * MiB}, {6, (size_t)-1, 64 * MiB}, {7, WS_HN, 32 * MiB}, {7, WS_AFF, 1 * MiB},
        {8, WS_SLOT, 1 * MiB}, {8, WS_SELT, 131072}, {8, WS_SELV, 131072}, {8, WS_WGU, 64 * MiB}, {8, WS_WD, 32 * MiB}, {9, WS_XS, 64 * MiB}, {10, WS_HID, 64 * MiB}, {11, WS_YSLAB, 64 * MiB}, {12, (size_t)-1, 64 * MiB} };
    unsigned long long* chk = (unsigned long long*)((char*)d_ws + 32768);
    for (int run = 0; run < 2; ++run)
        for (int p = 0; p < NPH; ++p) { a.ph_lo = p; a.ph_hi = p + 1; hipLaunchKernelGGL(fwd_kernel, dim3(grid), dim3(NTHR), LDS_BYTES, stream, a);
            for (const ChkEnt& e : ents) if (e.ph == p) hipLaunchKernelGGL(chk_kernel, dim3(1024), dim3(256), 0, stream, (const unsigned*)(e.off == (size_t)-1 ? (char*)d_out : (char*)d_ws + e.off), e.bytes / 4, chk + run * 32 + (int)(&e - ents)); }
    hipLaunchKernelGGL(report_kernel, dim3(1024), dim3(256), 0, stream, (const unsigned long long*)chk, (float*)d_out, out_size);
#else
    for (int p = 0; p < NPH; ++p) { a.ph_lo = p; a.ph_hi = p + 1; hipLaunchKernelGGL(fwd_kernel, dim3(grid), dim3(NTHR), LDS_BYTES, stream, a); }
#endif
#endif
}
```

```cpp
#include <hip/hip_runtime.h>
#include <cstdio>
#include <cstdint>
#define MK_SINGLE 1
namespace pg8 {
#define PG8_LAS __attribute__((address_space(3)))
typedef unsigned short bf16_t;
typedef short bf16x8 __attribute__((ext_vector_type(8)));
typedef float f32x4 __attribute__((ext_vector_type(4)));
typedef unsigned u32x4 __attribute__((ext_vector_type(4)));
constexpr int BM = 256, BK = 64, HALF = 128, HTB = HALF * BK * 2  , STAGE_BYTES = 8 * HTB, NXCD = 8, WGM = 8;

__host__ __device__ __forceinline__ int lds_byte(int r, int c) { const int st = (r >> 4) * 2 + (c >> 5), rr = r & 15, cc = c & 31, ob = rr * 64 + cc * 2; return st * 1024 + (ob ^ (((ob >> 9) & 1) << 5)); }
__host__ __device__ __forceinline__ void stage_rc(int b, int& R, int& C) { const int st = b / 1024, sb = b % 1024, swz = sb ^ (((sb >> 9) & 1) << 5); R = (st >> 1) * 16 + swz / 64; C = (st & 1) * 32 + (swz % 64) / 2; }
__host__ __device__ __forceinline__ int perm32(int rho) { const int n = rho >> 4, i = rho & 15; return 8 * (i >> 2) + 4 * n + (i & 3); }

struct Unit { int pm, pn; };
struct Gemm { const bf16_t* A; const bf16_t* Bt; int M, N, K; };

struct StaticOrder {
    int nM, nN, nwg, G, c;
    __host__ __device__ void init(int M, int N, int G_, int c_) { nM = M / BM; nN = N / BM; nwg = nM * nN; G = G_; c = c_; }
    __host__ __device__ bool next(int i, Unit& u) const {
        const long L = (long)i * G + c; if (L >= nwg) return false;
        int wgid = (int)L; { const int q = nwg / NXCD, r = nwg % NXCD, xcd = wgid % NXCD, off = wgid / NXCD; wgid = (xcd < r ? xcd * (q + 1) : r * (q + 1) + (xcd - r) * q) + off; }
        const int nig = WGM * nN, gid = wgid / nig, fm = gid * WGM, gsz = (nM - fm) < WGM ? (nM - fm) : WGM;
        u.pm = fm + ((wgid % nig) % gsz); u.pn = (wgid % nig) / gsz; return true;
    }
    __device__ __forceinline__ void a_ready(const Unit&) const {}
    __device__ __forceinline__ void done(const Unit&) const {}
};

__device__ __forceinline__ unsigned cvt_pk_bf16(float lo, float hi) { unsigned r; asm volatile("v_cvt_pk_bf16_f32 %0, %1, %2" : "=v"(r) : "v"(lo), "v"(hi)); return r; }
template <class Epi, class Sched, bool ALIGN_EPI = false, bool SP2 = false>
__device__ __forceinline__ void gemm_phase(PG8_LAS unsigned char* lds, const Gemm g, const Sched& S, const Epi& E) {
    const int tid = threadIdx.x, wid = __builtin_amdgcn_readfirstlane(tid >> 6), lane = tid & 63, wr = wid >> 2, wc = wid & 3, fr = lane & 15, fq = lane >> 4;
    const int K = g.K, nt = K / BK;
    unsigned voffA[2], voffB[2];
#pragma unroll
    for (int i = 0; i < 2; ++i) { int R, C; stage_rc(tid * 16 + i * 8192, R, C); const int Rb = Epi::PERM ? ((R & ~31) + perm32(R & 31)) : R;
        voffA[i] = (unsigned)(R * K + C) * 2u; voffB[i] = (unsigned)(Rb * K + C) * 2u; }
    const size_t kstep = (size_t)(BK * 2);
    const size_t hstep = (size_t)HALF * K * 2;
    const size_t tstep = 2 * hstep;
    const unsigned ldsw = (unsigned)wid * 1024u;
    const int aoff = lds_byte(wr * 64 + fr, fq * 8), boff = lds_byte(wc * 32 + fr, fq * 8);
#define PG8_SA(b, h) (((b) * 2 + (h)) * HTB)
#define PG8_SB(b, h) ((4 + (b) * 2 + (h)) * HTB)
#define PG8_STAGE(bufoff, gbase, voff) do { _Pragma("unroll") for (int _i = 0; _i < 2; ++_i) \
        __builtin_amdgcn_global_load_lds((const unsigned*)((const char*)(gbase) + (voff)[_i]), (PG8_LAS unsigned*)(lds + (bufoff) + ldsw + _i * 8192), 16, 0, 0); } while (0)
#define PG8_LDA(dst, b, h) do { _Pragma("unroll") for (int m = 0; m < 4; ++m) _Pragma("unroll") for (int k = 0; k < 2; ++k) dst[m][k] = *(const PG8_LAS bf16x8*)(lds + PG8_SA(b, h) + aoff + m * 2048 + k * 1024); } while (0)
#define PG8_LDB(dst, b, h) do { _Pragma("unroll") for (int n = 0; n < 2; ++n) _Pragma("unroll") for (int k = 0; k < 2; ++k) dst[n][k] = *(const PG8_LAS bf16x8*)(lds + PG8_SB(b, h) + boff + n * 2048 + k * 1024); } while (0)
#define PG8_MMA(ai, bj, At, Bt) do { __builtin_amdgcn_s_setprio(1); _Pragma("unroll") for (int m = 0; m < 4; ++m) _Pragma("unroll") for (int n = 0; n < 2; ++n) _Pragma("unroll") for (int k = 0; k < 2; ++k) \
        acc[ai][bj][m][n] = __builtin_amdgcn_mfma_f32_16x16x32_bf16(Bt[n][k], At[m][k], acc[ai][bj][m][n], 0, 0, 0); __builtin_amdgcn_s_setprio(0); } while (0)
#define PG8_WAIT_V(n) asm volatile("s_waitcnt vmcnt(" #n ")" ::: "memory")
#define PG8_WAIT_L(n) asm volatile("s_waitcnt lgkmcnt(" #n ")" ::: "memory")
#define PG8_BAR __builtin_amdgcn_s_barrier()
#define PG8_SCHED __builtin_amdgcn_sched_barrier(0)
    Unit cur, nxt; int ui = 0;
    if (!S.next(0, cur)) return;
    f32x4 acc[2][2][4][2];
#pragma unroll
    for (int a = 0; a < 2; ++a)
#pragma unroll
        for (int b = 0; b < 2; ++b)
#pragma unroll
            for (int m = 0; m < 4; ++m)
#pragma unroll
                for (int n = 0; n < 2; ++n) acc[a][b][m][n] = (f32x4){0.f, 0.f, 0.f, 0.f};
    bf16x8 At[4][2], B0[2][2], B1[2][2];
    const char* cA = (const char*)g.A + (size_t)cur.pm * tstep; const char* cB = (const char*)g.Bt + (size_t)cur.pn * tstep;
    S.a_ready(cur);
    if constexpr (SP2) {
        PG8_STAGE(PG8_SB(0, 0), cB, voffB); PG8_STAGE(PG8_SB(0, 1), cB + hstep, voffB); PG8_STAGE(PG8_SA(0, 0), cA, voffA); PG8_STAGE(PG8_SA(0, 1), cA + hstep, voffA);
        if (wr == 1) PG8_BAR;
        PG8_WAIT_V(2); PG8_BAR;
        PG8_STAGE(PG8_SB(1, 0), cB + kstep, voffB); PG8_STAGE(PG8_SA(1, 0), cA + kstep, voffA); PG8_STAGE(PG8_SB(1, 1), cB + hstep + kstep, voffB);
        PG8_WAIT_V(6); PG8_BAR;
    } else {
        PG8_STAGE(PG8_SB(0, 0), cB, voffB); PG8_STAGE(PG8_SA(0, 0), cA, voffA); PG8_STAGE(PG8_SB(0, 1), cB + hstep, voffB); PG8_STAGE(PG8_SA(0, 1), cA + hstep, voffA);
        if (wr == 1) PG8_BAR;
        PG8_WAIT_V(4); PG8_BAR;
        PG8_STAGE(PG8_SB(1, 0), cB + kstep, voffB); PG8_STAGE(PG8_SA(1, 0), cA + kstep, voffA); PG8_STAGE(PG8_SB(1, 1), cB + hstep + kstep, voffB);
        PG8_WAIT_V(6); PG8_BAR;
    }
    for (;;) {
        const bool has_next = S.next(ui + 1, nxt);
        const char* nA = has_next ? (const char*)g.A + (size_t)nxt.pm * tstep : cA; const char* nB = has_next ? (const char*)g.Bt + (size_t)nxt.pn * tstep : cB;
        for (int t = 0; t < nt; t += 2) {
            const bool last = (t == nt - 2);
            const char* a1 = cA + (size_t)(t + 1) * kstep;
            const char* a2 = last ? nA : cA + (size_t)(t + 2) * kstep; const char* b2 = last ? nB : cB + (size_t)(t + 2) * kstep;
            const char* a3 = a2 + kstep; const char* b3 = b2 + kstep;
            if (last && has_next) S.a_ready(nxt);
            if constexpr (SP2) {
            PG8_LDB(B0, 0, 0); PG8_LDB(B1, 0, 1); PG8_SCHED; PG8_LDA(At, 0, 0); PG8_STAGE(PG8_SA(1, 1), a1 + hstep, voffA);
            PG8_WAIT_V(8); PG8_WAIT_L(0); PG8_BAR; PG8_MMA(0, 0, At, B0); PG8_MMA(0, 1, At, B1); PG8_BAR; PG8_SCHED;
            PG8_LDA(At, 0, 1); PG8_STAGE(PG8_SB(0, 0), b2, voffB); PG8_STAGE(PG8_SB(0, 1), b2 + hstep, voffB); PG8_STAGE(PG8_SA(0, 0), a2, voffA);
            PG8_WAIT_V(8); PG8_WAIT_L(0); PG8_BAR; PG8_MMA(1, 0, At, B0); PG8_MMA(1, 1, At, B1); PG8_BAR; PG8_SCHED;
            PG8_LDB(B0, 1, 0); PG8_LDB(B1, 1, 1); PG8_SCHED; PG8_LDA(At, 1, 0); PG8_STAGE(PG8_SA(0, 1), a2 + hstep, voffA);
            PG8_WAIT_V(8); PG8_WAIT_L(0); PG8_BAR; PG8_MMA(0, 0, At, B0); PG8_MMA(0, 1, At, B1); PG8_BAR; PG8_SCHED;
            PG8_LDA(At, 1, 1); PG8_STAGE(PG8_SB(1, 0), b3, voffB); PG8_STAGE(PG8_SB(1, 1), b3 + hstep, voffB); PG8_STAGE(PG8_SA(1, 0), a3, voffA);
            PG8_WAIT_V(8); PG8_WAIT_L(0); PG8_BAR; PG8_MMA(1, 0, At, B0); PG8_MMA(1, 1, At, B1); PG8_BAR; PG8_SCHED;
            } else {
            PG8_LDB(B0, 0, 0); PG8_SCHED; PG8_LDA(At, 0, 0); PG8_STAGE(PG8_SA(1, 1), a1 + hstep, voffA);
            PG8_WAIT_L(8); PG8_BAR; PG8_WAIT_L(0); PG8_MMA(0, 0, At, B0); PG8_BAR; PG8_SCHED;
            PG8_LDB(B1, 0, 1); PG8_STAGE(PG8_SB(0, 0), b2, voffB);
            PG8_BAR; PG8_WAIT_L(0); PG8_MMA(0, 1, At, B1); PG8_BAR;
            PG8_LDA(At, 0, 1); PG8_STAGE(PG8_SA(0, 0), a2, voffA);
            PG8_BAR; PG8_WAIT_L(0); PG8_MMA(1, 0, At, B0); PG8_BAR; PG8_SCHED;
            PG8_STAGE(PG8_SB(0, 1), b2 + hstep, voffB);
            PG8_WAIT_V(6); PG8_BAR; PG8_MMA(1, 1, At, B1); PG8_BAR;
            PG8_LDB(B0, 1, 0); PG8_SCHED; PG8_LDA(At, 1, 0); PG8_STAGE(PG8_SA(0, 1), a2 + hstep, voffA);
            PG8_WAIT_L(8); PG8_BAR; PG8_WAIT_L(0); PG8_MMA(0, 0, At, B0); PG8_BAR; PG8_SCHED;
            PG8_LDB(B1, 1, 1); PG8_STAGE(PG8_SB(1, 0), b3, voffB);
            PG8_BAR; PG8_WAIT_L(0); PG8_MMA(0, 1, At, B1); PG8_BAR;
            PG8_LDA(At, 1, 1); PG8_STAGE(PG8_SA(1, 0), a3, voffA);
            PG8_BAR; PG8_WAIT_L(0); PG8_MMA(1, 0, At, B0); PG8_BAR; PG8_SCHED;
            PG8_STAGE(PG8_SB(1, 1), b3 + hstep, voffB);
            PG8_WAIT_V(6); PG8_BAR; PG8_MMA(1, 1, At, B1); PG8_BAR;
            }
        }
        if constexpr (ALIGN_EPI) { if (wr == 0) PG8_BAR; }
        if constexpr (!Epi::AFTER_DRAIN) { E(acc, cur, wr, wc, fr, fq); S.done(cur); }
        if (!has_next) break;
#pragma unroll
        for (int a = 0; a < 2; ++a)
#pragma unroll
            for (int b = 0; b < 2; ++b)
#pragma unroll
                for (int m = 0; m < 4; ++m)
#pragma unroll
                    for (int n = 0; n < 2; ++n) acc[a][b][m][n] = (f32x4){0.f, 0.f, 0.f, 0.f};
        cur = nxt; cA = nA; cB = nB; ++ui;
        if constexpr (ALIGN_EPI) { if (wr == 1) PG8_BAR; }
    }
    PG8_WAIT_V(0);
    if constexpr (!ALIGN_EPI) { if (wr == 0) PG8_BAR; }
    PG8_BAR;
    if constexpr (Epi::AFTER_DRAIN) { E.fused(acc, cur, wr, wc, fr, fq, lds, wid, lane); S.done(cur); }
#undef PG8_SA
#undef PG8_SB
#undef PG8_STAGE
#undef PG8_LDA
#undef PG8_LDB
#undef PG8_MMA
#undef PG8_WAIT_V
#undef PG8_WAIT_L
#undef PG8_BAR
#undef PG8_SCHED
}
}

#ifndef DBG_NOMIX
#define DBG_NOMIX 0
#endif
#ifndef DBG_NOMOE
#define DBG_NOMOE 0
#endif
#ifndef DBG_NOPOS
#define DBG_NOPOS 0
#endif
#ifndef DBG_HTCONST
#define DBG_HTCONST 0
#endif
#ifndef DBG_GLA_K
#define DBG_GLA_K 1.0f
#endif
#ifndef DBG_MOE_K
#define DBG_MOE_K 1.0f
#endif
#ifndef MK_SINGLE
#define MK_SINGLE 0
#endif
#define GAS __attribute__((address_space(1)))
#define LAS __attribute__((address_space(3)))
typedef unsigned short bf16;
typedef float f32x4 __attribute__((ext_vector_type(4)));
typedef float f32x16 __attribute__((ext_vector_type(16)));
typedef short bf16x8 __attribute__((ext_vector_type(8)));
typedef unsigned v4u __attribute__((ext_vector_type(4)));
typedef unsigned v2u __attribute__((ext_vector_type(2)));
typedef GAS unsigned gu32;

constexpr int NWAVES = 8, NTHR = 512;
constexpr int NB = 4, SEQ = 4096, DM = 1024, CTXL = 256;
constexpr int MX = NB * SEQ, MC = NB * CTXL, MT = MX + MC;
constexpr int NIN = 3328, NQ = 1536, DIN = 3104;
constexpr int NE = 16, CAP = 512;
constexpr int NCH = 68;
constexpr int NPH = 13;
constexpr float EPS = 1e-6f;

constexpr size_t MiB = 1u << 20;
constexpr size_t WS_CTL = 0, CTL_BYTES = 65536;
constexpr size_t WS_MOD = 1 * MiB, WS_POS = 1 * MiB + 256 * 1024, WS_DEC = 2 * MiB, WS_AFF = 3 * MiB, WS_SLOT = 4 * MiB, WS_SELT = 5 * MiB, WS_SELV = 5 * MiB + 256 * 1024;
constexpr size_t WS_UCTX = 6 * MiB, WS_AFB = 10 * MiB, WS_WIN = 13 * MiB, WS_WOUT = 20 * MiB;
constexpr size_t WS_R1 = 22 * MiB, WS_R2 = 56 * MiB, WS_R3 = 107 * MiB, WS_R4 = 203 * MiB, WS_R5 = 235 * MiB, WS_R6 = 267 * MiB, WS_END = 299 * MiB;
constexpr size_t WS_AIN = WS_R1, WS_ZT = WS_R1, WS_HN = WS_R1, WS_HID = WS_R1;
constexpr size_t WS_QKVG = WS_R2;
constexpr size_t WS_HYT = WS_R3, WS_WGU = WS_R3, WS_WD = 171 * MiB;
constexpr size_t WS_HT = WS_R4, WS_AOUT = WS_R4, WS_XS = WS_R4, WS_YSLAB = WS_R4;
constexpr size_t WS_SPREV = WS_R5, WS_YHYT = WS_R6;
constexpr int LDS_BYTES = 144 * 1024;
constexpr int LDS_MISC = LDS_BYTES - 256;

struct Args { const float* in[29]; float* out; unsigned char* ws; int ph_lo, ph_hi; };

#define LDS_WAIT() asm volatile("s_waitcnt lgkmcnt(0)" ::: "memory")
#define VM_WAIT() asm volatile("s_waitcnt vmcnt(0)" ::: "memory")
__device__ __forceinline__ unsigned f2bf(float f) { unsigned u = __float_as_uint(f); return (u + 0x7fffu + ((u >> 16) & 1u)) >> 16; }
__device__ __forceinline__ unsigned pk2(float lo, float hi) { return pg8::cvt_pk_bf16(lo, hi); }
__device__ __forceinline__ float bflo(unsigned w) { return __uint_as_float(w << 16); }
__device__ __forceinline__ float bfhi(unsigned w) { return __uint_as_float(w & 0xffff0000u); }
__device__ __forceinline__ float wave_sum(float v) {
#pragma unroll
    for (int o = 1; o < 64; o <<= 1) v += __shfl_xor(v, o);
    return v;
}
__device__ __forceinline__ float silu_f(float v) { return v / (1.f + __expf(-v)); }
__device__ __forceinline__ float logsig_f(float x) { return fminf(x, 0.f) - log1pf(__expf(-fabsf(x))); }

#define XB_TMO      128
#define XB_XCNT(j)  (256  + 64 * (j))
#define XB_XSUB(j)  (1280 + 64 * (j))
#define XB_XGEN(j)  (2304 + 64 * (j))
#define XB_TOP      3328
#define XB_TOPGEN   3392
#define XCD_BAR_WORDS 3456
#define XB_SPIN_CAP (1u << 22)
__device__ __forceinline__ unsigned xb_ld(unsigned* p)              { return __hip_atomic_load(p, __ATOMIC_RELAXED, __HIP_MEMORY_SCOPE_AGENT); }
__device__ __forceinline__ unsigned xb_add(unsigned* p, unsigned v) { return __hip_atomic_fetch_add(p, v, __ATOMIC_RELAXED, __HIP_MEMORY_SCOPE_AGENT); }
__device__ __forceinline__ unsigned xb_xcc_id() { return (unsigned)__builtin_amdgcn_s_getreg((3 << 11) | 20) & 0xFu; }
#define XB_SPIN(cond, bar) do { unsigned _sp = 0; while (cond) { __builtin_amdgcn_s_sleep(1); \
    if ((++_sp & 255u) == 0u) { if (xb_ld(&(bar)[XB_TMO])) break; if (_sp > XB_SPIN_CAP) { atomicAdd(&(bar)[XB_TMO], 1u); break; } } } } while (0)
struct XcdBarrier { unsigned* bar; unsigned x; volatile LAS unsigned* st; };
__device__ __forceinline__ XcdBarrier xcd_barrier_post(unsigned* bar, volatile LAS unsigned* st) {
    XcdBarrier b; b.bar = bar; b.x = xb_xcc_id(); b.st = st;
    if (threadIdx.x == 0) (void)xb_add(&bar[XB_XCNT(b.x)], 1u);
    return b;
}
__device__ __forceinline__ void xcd_barrier_complete(unsigned* bar, unsigned x, unsigned& nloc, unsigned& nx) {
    const unsigned G = gridDim.x * gridDim.y * gridDim.z;
    unsigned sum, cnt, mine, sp = 0u;
    for (;;) {
        sum = 0u; cnt = 0u; mine = 0u;
#pragma unroll
        for (unsigned j = 0; j < 16; ++j) { const unsigned c = xb_ld(&bar[XB_XCNT(j)]); sum += c; cnt += (c > 0u) ? 1u : 0u; mine = (j == x) ? c : mine; }
        if (sum == G) break;
        __builtin_amdgcn_s_sleep(1);
        if ((++sp & 255u) == 0u) { if (xb_ld(&bar[XB_TMO])) break; if (sp > XB_SPIN_CAP) { atomicAdd(&bar[XB_TMO], 1u); break; } }
    }
    nloc = mine > 0u ? mine : 1u; nx = cnt > 0u ? cnt : 1u;
}
__device__ __forceinline__ void xcd_barrier(const XcdBarrier& b) {
    asm volatile("s_waitcnt vmcnt(0)" ::: "memory");
    __syncthreads();
    if (threadIdx.x == 0) {
        unsigned* bar = b.bar;
        __builtin_amdgcn_s_waitcnt(0);
        unsigned nloc = b.st[0], nx = b.st[1];
        if (nloc == 0u) { xcd_barrier_complete(bar, b.x, nloc, nx); b.st[0] = nloc; b.st[1] = nx; }
        const unsigned old = xb_add(&bar[XB_XSUB(b.x)], 1u);
        const unsigned gen = old / nloc;
        if (old + 1u == (gen + 1u) * nloc) {
            __builtin_amdgcn_fence(__ATOMIC_RELEASE, "agent");
            asm volatile("s_waitcnt vmcnt(0)" ::: "memory");
            const unsigned og = xb_add(&bar[XB_TOP], 1u);
            const unsigned tg = og / nx;
            if (og + 1u == (tg + 1u) * nx) xb_add(&bar[XB_TOPGEN], 1u);
            else XB_SPIN(xb_ld(&bar[XB_TOPGEN]) == tg, bar);
            __builtin_amdgcn_fence(__ATOMIC_ACQUIRE, "agent");
            xb_add(&bar[XB_XGEN(b.x)], 1u);
            asm volatile("s_waitcnt vmcnt(0)" ::: "memory");
        } else {
            XB_SPIN(xb_ld(&bar[XB_XGEN(b.x)]) == gen, bar);
            __builtin_amdgcn_fence(__ATOMIC_ACQUIRE, "agent");
            asm volatile("s_waitcnt vmcnt(0)" ::: "memory");
        }
    }
    __syncthreads();
}

struct InSched {
    pg8::StaticOrder so; int G, c;
    __device__ void init(int G_, int c_) { so.init(MX, NIN, G_, c_); G = G_; c = c_; }
    __device__ bool next(int i, pg8::Unit& u) const {
        const int L = i * G + c;
        if (L < 832) return so.next(i, u);
        if (L >= 848) return false;
        const int j = L - 832; u.pm = 64 + (j & 3); const int q = j >> 2; u.pn = (q == 3) ? 12 : (1 + q); return true;
    }
    __device__ __forceinline__ void a_ready(const pg8::Unit&) const {}
    __device__ __forceinline__ void done(const pg8::Unit&) const {}
};
template <int NT> struct MoeSched {
    int G, c;
    __device__ void init(int G_, int c_) { G = G_; c = c_; }
    __device__ bool next(int i, pg8::Unit& u) const {
        const int L = i * G + c; if (L >= NE * 8 * NT) return false;
        const int e = L / (8 * NT), l = L % (8 * NT); u.pm = e * 8 + (l & 7); u.pn = e * NT + (l >> 3); return true;
    }
    __device__ __forceinline__ void a_ready(const pg8::Unit&) const {}
    __device__ __forceinline__ void done(const pg8::Unit&) const {}
};

struct EpiIn {
    static constexpr bool PERM = true, AFTER_DRAIN = false;
    bf16* qkvg; float* hyT; float* afb;
    __device__ __forceinline__ void operator()(const f32x4 (&acc)[2][2][4][2], const pg8::Unit& u, int wr, int wc, int fr, int fq) const {
        const int row0 = u.pm * 256 + wr * 64 + fr;
        if (u.pn < 6) {
            const float sc = (u.pn == 0) ? 0.125f : 1.f;
            const int col0 = u.pn * 256 + wc * 32 + 8 * fq;
#pragma unroll
            for (int ai = 0; ai < 2; ++ai)
#pragma unroll
                for (int m = 0; m < 4; ++m) { bf16* rowp = qkvg + (size_t)(row0 + ai * 128 + m * 16) * NQ + col0;
#pragma unroll
                    for (int bj = 0; bj < 2; ++bj) { const f32x4 v0 = acc[ai][bj][m][0] * sc, v1 = acc[ai][bj][m][1] * sc;
                        v4u w; w.x = pk2(v0[0], v0[1]); w.y = pk2(v0[2], v0[3]); w.z = pk2(v1[0], v1[1]); w.w = pk2(v1[2], v1[3]);
                        *(v4u*)(rowp + bj * 128) = w; } }
        } else if (u.pn < 12) {
            if (u.pm >= 64) return;
            const int ch0 = (u.pn - 6) * 256 + wc * 32 + 8 * fq;
#pragma unroll
            for (int ai = 0; ai < 2; ++ai)
#pragma unroll
                for (int m = 0; m < 4; ++m) { const int r = row0 + ai * 128 + m * 16; const int b = r >> 12, t = r & 4095;
                    float* bp = hyT + (size_t)b * 1536 * SEQ + t;
#pragma unroll
                    for (int bj = 0; bj < 2; ++bj)
#pragma unroll
                        for (int n = 0; n < 2; ++n)
#pragma unroll
                            for (int j = 0; j < 4; ++j) bp[(size_t)(ch0 + bj * 128 + 4 * n + j) * SEQ] = acc[ai][bj][m][n][j]; }
        } else {
            if (wc != 0) return;
#pragma unroll
            for (int ai = 0; ai < 2; ++ai)
#pragma unroll
                for (int m = 0; m < 4; ++m) { float* rowp = afb + (size_t)(row0 + ai * 128 + m * 16) * 32 + 8 * fq;
                    *(f32x4*)(rowp) = acc[ai][0][m][0]; *(f32x4*)(rowp + 4) = acc[ai][0][m][1]; }
        }
    }
};
struct EpiOut {
    static constexpr bool PERM = false, AFTER_DRAIN = false;
    const float* x; const float* postab; const float* modr; float* x1;
    __device__ __forceinline__ void operator()(const f32x4 (&acc)[2][2][4][2], const pg8::Unit& u, int wr, int wc, int fr, int fq) const {
        const int row0 = u.pm * 256 + wr * 64 + fr, col0 = u.pn * 256 + wc * 32 + 4 * fq;
#pragma unroll
        for (int ai = 0; ai < 2; ++ai)
#pragma unroll
            for (int m = 0; m < 4; ++m) { const int r = row0 + ai * 128 + m * 16; const int b = r >> 12, t = r & 4095, rr = t >> 6, cc = t & 63;
                const float* gate = modr + b * 6144 + 2048;
#pragma unroll
                for (int bj = 0; bj < 2; ++bj)
#pragma unroll
                    for (int n = 0; n < 2; ++n) { const int c = col0 + bj * 128 + n * 16;
                        const f32x4 xv = *(const f32x4*)(x + (size_t)r * DM + c);
                        const f32x4 pv = (c < 512) ? *(const f32x4*)(postab + rr * 512 + c) : *(const f32x4*)(postab + cc * 512 + c - 512);
                        const f32x4 gv = *(const f32x4*)(gate + c);
                        *(f32x4*)(x1 + (size_t)r * DM + c) = xv + (DBG_NOPOS ? pv * 0.f : pv) + (DBG_NOMIX ? gv * 0.f : gv * acc[ai][bj][m][n]); } }
    }
};
struct EpiGU {
    static constexpr bool PERM = true, AFTER_DRAIN = false;
    bf16* hid;
    __device__ __forceinline__ void operator()(const f32x4 (&acc)[2][2][4][2], const pg8::Unit& u, int wr, int wc, int fr, int fq) const {
        const int row0 = u.pm * 256 + wr * 64 + fr, col0 = (u.pn & 7) * 128 + wc * 32 + 8 * fq;
#pragma unroll
        for (int ai = 0; ai < 2; ++ai)
#pragma unroll
            for (int m = 0; m < 4; ++m) { bf16* rowp = hid + (size_t)(row0 + ai * 128 + m * 16) * DM + col0;
                float o[8];
#pragma unroll
                for (int n = 0; n < 2; ++n)
#pragma unroll
                    for (int j = 0; j < 4; ++j) o[n * 4 + j] = silu_f(acc[ai][0][m][n][j]) * acc[ai][1][m][n][j];
                v4u w; w.x = pk2(o[0], o[1]); w.y = pk2(o[2], o[3]); w.z = pk2(o[4], o[5]); w.w = pk2(o[6], o[7]);
                *(v4u*)rowp = w; }
    }
};
struct EpiDown {
    static constexpr bool PERM = true, AFTER_DRAIN = false;
    bf16* ys; const float* selv;
    __device__ __forceinline__ void operator()(const f32x4 (&acc)[2][2][4][2], const pg8::Unit& u, int wr, int wc, int fr, int fq) const {
        const int row0 = u.pm * 256 + wr * 64 + fr, col0 = (u.pn & 3) * 256 + wc * 32 + 8 * fq;
#pragma unroll
        for (int ai = 0; ai < 2; ++ai)
#pragma unroll
            for (int m = 0; m < 4; ++m) { const int r = row0 + ai * 128 + m * 16; const float sc = selv[r]; bf16* rowp = ys + (size_t)r * DM + col0;
#pragma unroll
                for (int bj = 0; bj < 2; ++bj) { const f32x4 v0 = acc[ai][bj][m][0] * sc, v1 = acc[ai][bj][m][1] * sc;
                    v4u w; w.x = pk2(v0[0], v0[1]); w.y = pk2(v0[2], v0[3]); w.z = pk2(v1[0], v1[1]); w.w = pk2(v1[2], v1[3]);
                    *(v4u*)(rowp + bj * 128) = w; } }
    }
};

__device__ __forceinline__ void transpose_item(const float* W, int ldw, int k0, int nsrc0, bf16* WT, int K, int drow0, LAS float* scr, int lane, bool zero) {
    float tv[32];
#pragma unroll
    for (int i = 0; i < 32; ++i) { const int kk = 2 * i + (lane >> 5); tv[i] = zero ? 0.f : W[(size_t)(k0 + kk) * ldw + nsrc0 + (lane & 31)]; }
#pragma unroll
    for (int i = 0; i < 32; ++i) { const int kk = 2 * i + (lane >> 5); scr[kk * 33 + (lane & 31)] = tv[i]; }
    LDS_WAIT();
    const int c = lane & 7;
#pragma unroll
    for (int j = 0; j < 4; ++j) { const int n = (lane >> 3) + 8 * j; const LAS float* s = scr + (8 * c) * 33 + n;
        v4u o; o.x = pk2(s[0 * 33], s[1 * 33]); o.y = pk2(s[2 * 33], s[3 * 33]); o.z = pk2(s[4 * 33], s[5 * 33]); o.w = pk2(s[6 * 33], s[7 * 33]);
        *(v4u*)(WT + (size_t)(drow0 + n) * K + k0 + 8 * c) = o; }
    LDS_WAIT();
}

__device__ __forceinline__ void phase0(const Args& a, LAS unsigned char* lds) {
    int tid = threadIdx.x; const int wg = blockIdx.x, G = gridDim.x;
    asm volatile("" : "+v"(tid));
    int lane = tid & 63, wave = tid >> 6;
    unsigned char* ws = a.ws;
    for (int it = wg; it < 192; it += G) {
        LAS float* sl = (LAS float*)lds;
        LAS float* red = (LAS float*)(lds + 20480);
        for (int i = tid; i < 5 * 1024; i += NTHR) { const int bb = i >> 10, k = i & 1023; const float v = (bb < 4) ? a.in[1][bb * 1024 + k] : a.in[3][k]; sl[i] = silu_f(v); }
        __syncthreads();
        const int col = it * 32 + (lane & 31), kk = wave * 2 + (lane >> 5);
        float acc[5] = {0.f, 0.f, 0.f, 0.f, 0.f};
        const float* wp = a.in[4] + col;
#pragma unroll 8
        for (int j = 0; j < 64; ++j) { const int k = kk + 16 * j; const float w = wp[(size_t)k * 6144];
#pragma unroll
            for (int bb = 0; bb < 5; ++bb) acc[bb] += sl[bb * 1024 + k] * w; }
#pragma unroll
        for (int bb = 0; bb < 5; ++bb) red[(kk * 5 + bb) * 32 + (lane & 31)] = acc[bb];
        __syncthreads();
        if (tid < 160) { const int bb = tid >> 5, cl = tid & 31; float s = 0.f;
#pragma unroll
            for (int q = 0; q < 16; ++q) s += red[(q * 5 + bb) * 32 + cl];
            ((float*)(ws + WS_MOD))[bb * 6144 + it * 32 + cl] = s + a.in[5][it * 32 + cl]; }
        __syncthreads();
    }
    for (int it = wg; it < 256; it += G) {
        asm volatile("" : "+v"(tid));
        LAS float* zl = (LAS float*)lds;
        LAS float* h1 = (LAS float*)(lds + 4096);
        LAS float* h2 = (LAS float*)(lds + 8192);
        const int i0 = it * 16;
        for (int o = tid; o < 16 * 33; o += NTHR) { const int li = o / 33, j = o % 33; const int i = i0 + li;
            const float ti = (float)i * (1.0f / 4095.0f);
            const float wi = (6.2831855f * (float)i) / 4096.0f;
            float v;
            if (j == 0) v = ti;
            else { const int jj = (j - 1) & 15; const float f = 1e-4f + (float)jj * ((15.0f - 1e-4f) / 15.0f); const float ar = f * wi; v = (j <= 16) ? cosf(ar) : -sinf(ar); }
            zl[li * 36 + j] = v; }
        __syncthreads();
#pragma unroll
        for (int q = 0; q < 2; ++q) { const int o = tid + NTHR * q, li = o >> 6, m = o & 63; float s = a.in[16][m];
            for (int j = 0; j < 33; ++j) s += zl[li * 36 + j] * a.in[15][j * 64 + m];
            h1[li * 64 + m] = sinf(a.in[20][m] * s); }
        __syncthreads();
#pragma unroll
        for (int q = 0; q < 2; ++q) { const int o = tid + NTHR * q, li = o >> 6, m = o & 63; float s = a.in[18][m];
            for (int k = 0; k < 64; ++k) s += h1[li * 64 + k] * a.in[17][k * 64 + m];
            h2[li * 64 + m] = sinf(a.in[20][m] * s); }
        __syncthreads();
        f32x4 acc[16];
#pragma unroll
        for (int li = 0; li < 16; ++li) acc[li] = (f32x4){0.f, 0.f, 0.f, 0.f};
        const float* w3 = a.in[19] + tid * 4;
        for (int k = 0; k < 64; ++k) { const f32x4 w = *(const f32x4*)(w3 + k * 2048);
#pragma unroll
            for (int li = 0; li < 16; ++li) acc[li] += w * h2[li * 64 + k]; }
        float* hT = (float*)(ws + WS_HT);
#pragma unroll
        for (int j = 0; j < 4; ++j) { const int col = tid * 4 + j, od = col >> 9, c = col & 511;
            const float delta = 3.0701134573f + (float)c * ((15.3505672866f - 3.0701134573f) / 511.0f);
            float* dst = hT + ((size_t)od * 512 + c) * SEQ + i0;
#pragma unroll
            for (int q = 0; q < 4; ++q) { f32x4 o;
#pragma unroll
                for (int s = 0; s < 4; ++s) { const int li = q * 4 + s; const float ti = (float)(i0 + li) * (1.0f / 4095.0f); o[s] = DBG_HTCONST == 1 ? 1.0f : DBG_HTCONST == 2 ? zl[li * 36 + (col % 33)] : DBG_HTCONST == 3 ? h1[li * 64 + (col & 63)] : DBG_HTCONST == 4 ? h2[li * 64 + (col & 63)] : DBG_HTCONST == 5 ? acc[li][j] : acc[li][j] * __expf(-ti * delta); }
                *(f32x4*)(dst + q * 4) = o; } }
        __syncthreads();
    }
    {
        asm volatile("" : "+v"(tid)); lane = tid & 63; wave = tid >> 6;
        LAS float* scr = (LAS float*)(lds + wave * 8448);
        const int gw = wg * NWAVES + wave, NGW = G * NWAVES;
        constexpr int I_IN = 104 * 16, I_OUT = 32 * 16;
        for (int it = gw; it < I_IN + I_OUT; it += NGW) {
            if (it < I_IN) { const int nb = it >> 4, kb = it & 15, n0 = nb * 32;
                const int ns = (n0 < 1536) ? n0 : (n0 < 3072 ? n0 + 32 : 1536 + (n0 - 3072));
                transpose_item(a.in[7], DIN, kb * 64, (n0 < DIN) ? ns : 0, (bf16*)(ws + WS_WIN), DM, n0, scr, lane, n0 >= DIN);
            } else { const int r = it - I_IN, nb = r >> 4, kb = r & 15;
                transpose_item(a.in[22], DM, kb * 64, nb * 32, (bf16*)(ws + WS_WOUT), DM, nb * 32, scr, lane, false); }
        }
    }
    for (int e = wg * NTHR + tid; e < 64 * 256; e += G * NTHR) { const int i = e >> 8, j = e & 255;
        const float om = 1.0f / powf(10000.0f, (float)j * (1.0f / 256.0f)); const float er = (float)i * om;
        float* pt = (float*)(ws + WS_POS); pt[i * 512 + j] = sinf(er); pt[i * 512 + 256 + j] = cosf(er); }
}

__device__ __forceinline__ void phase1(const Args& a, LAS unsigned char* lds) {
    const int tid = threadIdx.x, lane = tid & 63, wave = tid >> 6, wg = blockIdx.x, G = gridDim.x;
    unsigned char* ws = a.ws;
    const float* modr = (const float*)(ws + WS_MOD); const float* pt = (const float*)(ws + WS_POS); bf16* ain = (bf16*)(ws + WS_AIN);
    const float* gmix = a.in[6];
    for (int r = wg * NWAVES + wave; r < MT; r += G * NWAVES) {
        const float* src; int bb; int rr = 0, cc = 0; const bool lat = r < MX;
        if (lat) { src = a.in[0] + (size_t)r * DM; bb = r >> 12; const int t = r & 4095; rr = t >> 6; cc = t & 63; }
        else { src = a.in[2] + (size_t)(r - MX) * DM; bb = 4; }
        f32x4 v[4]; float ss = 0.f;
#pragma unroll
        for (int j = 0; j < 4; ++j) { const int col = 4 * lane + 256 * j; v[j] = *(const f32x4*)(src + col);
            if (lat) v[j] += (j < 2) ? *(const f32x4*)(pt + rr * 512 + col) : *(const f32x4*)(pt + cc * 512 + col - 512);
            ss += v[j][0] * v[j][0] + v[j][1] * v[j][1] + v[j][2] * v[j][2] + v[j][3] * v[j][3]; }
        const float rs = rsqrtf(wave_sum(ss) * (1.0f / DM) + EPS);
#pragma unroll
        for (int j = 0; j < 4; ++j) { const int col = 4 * lane + 256 * j;
            const f32x4 g = *(const f32x4*)(gmix + col), sh = *(const f32x4*)(modr + bb * 6144 + col), sc = *(const f32x4*)(modr + bb * 6144 + 1024 + col);
            const f32x4 y = (v[j] * rs * g) * (sc + 1.0f) + sh;
            v2u w; w.x = pk2(y[0], y[1]); w.y = pk2(y[2], y[3]);
            *(v2u*)(ain + (size_t)r * DM + col) = w; }
    }
}

typedef float cpx __attribute__((ext_vector_type(2)));
__device__ __forceinline__ cpx make_cpx(float x, float y) { cpx r; r.x = x; r.y = y; return r; }
__device__ __forceinline__ cpx cmul(cpx a, cpx b) { return make_cpx(a.x * b.x - a.y * b.y, a.x * b.y + a.y * b.x); }
__device__ __forceinline__ cpx cadd(cpx a, cpx b) { return make_cpx(a.x + b.x, a.y + b.y); }
__device__ __forceinline__ cpx csub(cpx a, cpx b) { return make_cpx(a.x - b.x, a.y - b.y); }
__device__ __forceinline__ cpx cconj(cpx a) { return make_cpx(a.x, -a.y); }
__device__ __forceinline__ cpx twid(float turns) { return make_cpx(__builtin_amdgcn_cosf(turns), -__builtin_amdgcn_sinf(turns)); }
__device__ __forceinline__ void dft4(cpx& a0, cpx& a1, cpx& a2, cpx& a3) {
    const cpx t0 = cadd(a0, a2), t1 = csub(a0, a2), t2 = cadd(a1, a3), t3 = csub(a1, a3);
    a0 = cadd(t0, t2); a2 = csub(t0, t2);
    a1 = make_cpx(t1.x + t3.y, t1.y - t3.x);
    a3 = make_cpx(t1.x - t3.y, t1.y + t3.x);
}
__device__ __forceinline__ void dft16(cpx (&v)[16]) {
    cpx t[16];
#pragma unroll
    for (int j = 0; j < 4; ++j) { cpx b0 = v[j], b1 = v[j + 4], b2 = v[j + 8], b3 = v[j + 12]; dft4(b0, b1, b2, b3); t[4 * j] = b0; t[4 * j + 1] = b1; t[4 * j + 2] = b2; t[4 * j + 3] = b3; }
    const float C1 = 0.92387953251f, S1 = 0.38268343236f, R2 = 0.70710678118f;
    const cpx W1 = make_cpx(C1, -S1), W2 = make_cpx(R2, -R2), W3 = make_cpx(S1, -C1), W4 = make_cpx(0.f, -1.f), W6 = make_cpx(-R2, -R2), W9 = make_cpx(-C1, S1);
    {   cpx b0 = t[0], b1 = t[4], b2 = t[8], b3 = t[12]; dft4(b0, b1, b2, b3); v[0] = b0; v[4] = b1; v[8] = b2; v[12] = b3; }
    {   cpx b0 = t[1], b1 = cmul(t[5], W1), b2 = cmul(t[9], W2), b3 = cmul(t[13], W3); dft4(b0, b1, b2, b3); v[1] = b0; v[5] = b1; v[9] = b2; v[13] = b3; }
    {   cpx b0 = t[2], b1 = cmul(t[6], W2), b2 = cmul(t[10], W4), b3 = cmul(t[14], W6); dft4(b0, b1, b2, b3); v[2] = b0; v[6] = b1; v[10] = b2; v[14] = b3; }
    {   cpx b0 = t[3], b1 = cmul(t[7], W3), b2 = cmul(t[11], W6), b3 = cmul(t[15], W9); dft4(b0, b1, b2, b3); v[3] = b0; v[7] = b1; v[11] = b2; v[15] = b3; }
}
#define FPAD(i) ((i) + ((i) >> 4))
constexpr int FFT_STRIDE = 4352;
__device__ __forceinline__ void apply_tw(cpx (&v)[16], cpx w1) {
    asm volatile("" : "+v"(w1.x), "+v"(w1.y));
    cpx w = w1; v[1] = cmul(v[1], w);
#pragma unroll
    for (int q = 2; q < 16; ++q) { w = cmul(w, w1); v[q] = cmul(v[q], w); }
}
__device__ __forceinline__ cpx opaque(cpx w) { asm volatile("" : "+v"(w.x), "+v"(w.y)); return w; }
__device__ __forceinline__ cpx c32(int r) { return make_cpx(__builtin_cosf(0.19634954084936207f * (float)r), -__builtin_sinf(0.19634954084936207f * (float)r)); }

__device__ __forceinline__ void hyena_item(const Args& a, LAS unsigned char* lds, int c, int stage) {
    int tid = threadIdx.x; asm volatile("" : "+v"(tid));
    const int f = tid >> 8, j = tid & 255, blk = j >> 4, jp = j & 15;
    unsigned char* ws = a.ws;
    LAS cpx* buf = (LAS cpx*)lds;
    LAS cpx* bm = buf + f * FFT_STRIDE;
    const int pj = j + blk, p16 = blk * 272 + jp, pc = 17 * j;
    const float* hT = (const float*)(ws + WS_HT);
    const float* hf = hT + ((size_t)(stage * 2 + 0) * 512 + c) * SEQ;
    const float* hb = hT + ((size_t)(stage * 2 + 1) * 512 + c) * SEQ;
    const float* hyT = (const float*)(ws + WS_HYT);
    const float* zT = (const float*)(ws + WS_ZT);
    float* outp = (float*)(ws + (stage == 0 ? WS_ZT : WS_YHYT));
    const float* cw = a.in[13]; const float* cb = a.in[14];
    const int chu = c, chg = (stage == 0 ? 512 : 1024) + c;
    const float wu0 = cw[chu], wu1 = cw[1536 + chu], wu2 = cw[3072 + chu], bu = cb[chu];
    const float wg0 = cw[chg], wg1 = cw[1536 + chg], wg2 = cw[3072 + chg], bg = cb[chg];
    const float bias = a.in[21][stage * 512 + c];
    const cpx wj = twid((float)j * (1.0f / 4096.0f)), wjp = twid((float)jp * (1.0f / 256.0f)), w8_ = twid((float)j * (1.0f / 8192.0f));
    cpx v[16];
    LAS cpx* Hs = buf + 2 * FFT_STRIDE + f * FFT_STRIDE + pc;
    { const cpx w8 = opaque(w8_);
#pragma unroll
    for (int r = 0; r < 16; ++r) { const unsigned n = (unsigned)j + 256u * r; const float fv = hf[n]; const float gq = hb[(SEQ - n) & 4095u]; const float gv = n ? gq : 0.f;
        const cpx wn = cmul(w8, c32(r)); const float d = fv - gv;
        v[r] = f ? make_cpx(d * wn.x, d * wn.y) : make_cpx(fv + gv, 0.f); } }
    dft16(v); apply_tw(v, wj);
#pragma unroll
    for (int q = 0; q < 16; ++q) bm[pj + 272 * q] = v[q];
    __syncthreads();
#pragma unroll
    for (int r = 0; r < 16; ++r) v[r] = bm[p16 + 17 * r];
    dft16(v); apply_tw(v, wjp);
#pragma unroll
    for (int q = 0; q < 16; ++q) bm[p16 + 17 * q] = v[q];
    __syncthreads();
#pragma unroll
    for (int r = 0; r < 16; ++r) v[r] = bm[pc + r];
    dft16(v);
#pragma unroll
    for (int q = 0; q < 16; ++q) Hs[q] = v[q];
    __syncthreads();
#pragma nounroll
    for (int bp = 0; bp < 2; ++bp) {
        const int b0 = 2 * bp, b1 = 2 * bp + 1;
        float uk0[8], uk1[8];
        {   float u0[16], u1[16];
            const unsigned uj = (unsigned)j;
            if (stage == 0) {
                const float* P0 = hyT + ((size_t)b0 * 1536 + chu) * SEQ; const float* P1 = hyT + ((size_t)b1 * 1536 + chu) * SEQ;
#pragma unroll
                for (int r = 0; r < 16; ++r) { const unsigned o = uj + 256u * r; if (r == 4 || r == 8 || r == 12) asm volatile("" ::: "memory");
                    const unsigned ol = (r == 0) ? (j ? uj - 1u : 0u) : o - 1u, orr = (r == 15) ? (j < 255 ? o + 1u : o) : o + 1u;
                    float l0 = P0[ol], l1 = P1[ol], r0 = P0[orr], r1 = P1[orr];
                    if (r == 0) { l0 = j ? l0 : 0.f; l1 = j ? l1 : 0.f; }
                    if (r == 15) { r0 = (j < 255) ? r0 : 0.f; r1 = (j < 255) ? r1 : 0.f; }
                    u0[r] = wu0 * l0 + wu1 * P0[o] + wu2 * r0 + bu; u1[r] = wu0 * l1 + wu1 * P1[o] + wu2 * r1 + bu; }
            } else {
                const float* P0 = zT + ((size_t)b0 * 512 + c) * SEQ; const float* P1 = zT + ((size_t)b1 * 512 + c) * SEQ;
#pragma unroll
                for (int r = 0; r < 16; ++r) { const unsigned o = uj + 256u * r; u0[r] = P0[o]; u1[r] = P1[o]; }
            }
#pragma unroll
            for (int i = 0; i < 8; ++i) { uk0[i] = f ? u0[2 * i + 1] : u0[2 * i]; uk1[i] = f ? u1[2 * i + 1] : u1[2 * i]; }
            const cpx w8 = opaque(w8_);
#pragma unroll
            for (int r = 0; r < 16; ++r) { const cpx x = make_cpx(u0[r], u1[r]); v[r] = f ? cmul(x, cmul(w8, c32(r))) : x; }
        }
        dft16(v); apply_tw(v, wj);
#pragma unroll
        for (int q = 0; q < 16; ++q) bm[pj + 272 * q] = v[q];
        __syncthreads();
#pragma unroll
        for (int r = 0; r < 16; ++r) v[r] = bm[p16 + 17 * r];
        dft16(v); apply_tw(v, wjp);
#pragma unroll
        for (int q = 0; q < 16; ++q) bm[p16 + 17 * q] = v[q];
        __syncthreads();
#pragma unroll
        for (int r = 0; r < 16; ++r) v[r] = bm[pc + r];
        dft16(v);
#pragma unroll
        for (int q = 0; q < 16; ++q) v[q] = cconj(cmul(v[q], Hs[q]));
        dft16(v);
#pragma unroll
        for (int q = 0; q < 16; ++q) bm[pc + q] = v[q];
        __syncthreads();
#pragma unroll
        for (int r = 0; r < 16; ++r) v[r] = bm[p16 + 17 * r];
        apply_tw(v, wjp); dft16(v);
#pragma unroll
        for (int q = 0; q < 16; ++q) bm[p16 + 17 * q] = v[q];
        __syncthreads();
        float gg0[8], gg1[8];
        {   float gt0[8][3], gt1[8][3];
            const float* G0 = hyT + ((size_t)b0 * 1536 + chg) * SEQ; const float* G1 = hyT + ((size_t)b1 * 1536 + chg) * SEQ;
            const unsigned gj = (unsigned)(j + 256 * f);
#pragma unroll
            for (int i = 0; i < 8; ++i) { const unsigned o = gj + 512u * i; if (i == 4) asm volatile("" ::: "memory");
                const unsigned ol = (i == 0) ? (gj ? gj - 1u : 0u) : o - 1u, orr = (i == 7) ? (o < 4095u ? o + 1u : o) : o + 1u;
                gt0[i][0] = G0[ol]; gt0[i][1] = G0[o]; gt0[i][2] = G0[orr]; gt1[i][0] = G1[ol]; gt1[i][1] = G1[o]; gt1[i][2] = G1[orr];
                if (i == 0) { gt0[i][0] = gj ? gt0[i][0] : 0.f; gt1[i][0] = gj ? gt1[i][0] : 0.f; }
                if (i == 7) { gt0[i][2] = (o < 4095u) ? gt0[i][2] : 0.f; gt1[i][2] = (o < 4095u) ? gt1[i][2] : 0.f; } }
#pragma unroll
            for (int r = 0; r < 16; ++r) v[r] = bm[pj + 272 * r];
            apply_tw(v, wj); dft16(v);
#pragma unroll
            for (int q = 0; q < 16; ++q) bm[pj + 272 * q] = v[q];
#pragma unroll
            for (int i = 0; i < 8; ++i) { gg0[i] = wg0 * gt0[i][0] + wg1 * gt0[i][1] + wg2 * gt0[i][2] + bg; gg1[i] = wg0 * gt1[i][0] + wg1 * gt1[i][1] + wg2 * gt1[i][2] + bg; } }
        __syncthreads();
        const cpx w8 = opaque(w8_);
        float* O0 = outp + ((size_t)b0 * 512 + c) * SEQ; float* O1 = outp + ((size_t)b1 * 512 + c) * SEQ;
#pragma unroll
        for (int i = 0; i < 8; ++i) { const int rr = f + 2 * i; const unsigned n = (unsigned)(j + 256 * f) + 512u * i;
            const cpx ye = cconj(buf[pj + 272 * rr]), yo = cconj(buf[FFT_STRIDE + pj + 272 * rr]);
            const cpx wn = cmul(w8, f ? c32(2 * i + 1) : c32(2 * i));
            const cpx y = cadd(ye, cmul(cconj(wn), yo));
            const float y0 = y.x * (1.0f / 8192.0f) + bias * uk0[i], y1 = y.y * (1.0f / 8192.0f) + bias * uk1[i];
                        O0[n] = gg0[i] * y0; O1[n] = gg1[i] * y1; }
        __syncthreads();
    }
}

__device__ __forceinline__ f32x16 mfma32(bf16x8 a, bf16x8 b, f32x16 c) { return __builtin_amdgcn_mfma_f32_32x32x16_bf16(a, b, c, 0, 0, 0); }
typedef short s4v __attribute__((ext_vector_type(4)));
__device__ __forceinline__ bf16x8 tr_frag(const LAS bf16* base, int PT, int k0, int c0, int lane) {
    const int i = lane & 15, q = i >> 2, p = i & 3;
    const LAS bf16* ad = base + (k0 + 8 * (lane >> 5) + q) * PT + c0 + 16 * ((lane >> 4) & 1) + 4 * p;
    const s4v lo = __builtin_amdgcn_ds_read_tr16_b64_v4i16((LAS s4v*)ad);
    const s4v hi = __builtin_amdgcn_ds_read_tr16_b64_v4i16((LAS s4v*)(ad + 4 * PT));
    bf16x8 r; r[0] = lo[0]; r[1] = lo[1]; r[2] = lo[2]; r[3] = lo[3]; r[4] = hi[0]; r[5] = hi[1]; r[6] = hi[2]; r[7] = hi[3]; return r;
}
constexpr int GL_AL = 0, GL_WA = 8192, GL_TOT = 16384, GL_V = 24576, GL_VP = 160;
struct GlaTab { float P[4][2], X[4][2], Ptot[2], Xtot[2], Pref[2], Xref[2]; };
__device__ __forceinline__ void gla_tables(const Args& a, int h, LAS unsigned char* lds, GlaTab& T, int tid) {
    const int d2 = tid & 31, sg = tid >> 5;
    const LAS float* aL = (const LAS float*)(lds + GL_AL); const LAS float* wa = (const LAS float*)(lds + GL_WA); LAS float* tot = (LAS float*)(lds + GL_TOT);
    typedef float f32x2v __attribute__((ext_vector_type(2)));
    const f32x2v bf = *(const f32x2v*)(a.in[9] + h * 64 + 2 * d2), bb = *(const f32x2v*)(a.in[11] + h * 64 + 2 * d2);
    float lf[4][2], lb[4][2];
#pragma unroll
    for (int q = 0; q < 4; ++q) { const int s = sg * 4 + q; float pf0 = bf[0], pf1 = bf[1], pb0 = bb[0], pb1 = bb[1];
#pragma unroll
        for (int j4 = 0; j4 < 4; ++j4) { const f32x4 af = *(const LAS f32x4*)(aL + s * 32 + 4 * j4), ab = *(const LAS f32x4*)(aL + s * 32 + 16 + 4 * j4);
#pragma unroll
            for (int jj = 0; jj < 4; ++jj) { const int j = 4 * j4 + jj; const f32x2v wf = *(const LAS f32x2v*)(wa + j * 64 + 2 * d2), wb = *(const LAS f32x2v*)(wa + 1024 + j * 64 + 2 * d2);
                pf0 += af[jj] * wf[0]; pf1 += af[jj] * wf[1]; pb0 += ab[jj] * wb[0]; pb1 += ab[jj] * wb[1]; } }
        lf[q][0] = logsig_f(pf0) * (1.0f / 16.0f); lf[q][1] = logsig_f(pf1) * (1.0f / 16.0f); lb[q][0] = logsig_f(pb0) * (1.0f / 16.0f); lb[q][1] = logsig_f(pb1) * (1.0f / 16.0f); }
#pragma unroll
    for (int i = 0; i < 2; ++i) { lf[1][i] += lf[0][i]; lf[2][i] += lf[1][i]; lf[3][i] += lf[2][i]; lb[2][i] += lb[3][i]; lb[1][i] += lb[2][i]; lb[0][i] += lb[1][i]; }
    *(LAS f32x2v*)(tot + sg * 64 + 2 * d2) = (f32x2v){lf[3][0], lf[3][1]};
    *(LAS f32x2v*)(tot + 1024 + sg * 64 + 2 * d2) = (f32x2v){lb[0][0], lb[0][1]};
    __syncthreads();
    float of[2] = {0.f, 0.f}, ob[2] = {0.f, 0.f};
    T.Ptot[0] = T.Ptot[1] = T.Xtot[0] = T.Xtot[1] = T.Pref[0] = T.Pref[1] = T.Xref[0] = T.Xref[1] = 0.f;
#pragma unroll
    for (int g = 0; g < 16; ++g) { const f32x2v tf = *(const LAS f32x2v*)(tot + g * 64 + 2 * d2), tb = *(const LAS f32x2v*)(tot + 1024 + g * 64 + 2 * d2);
#pragma unroll
        for (int i = 0; i < 2; ++i) { T.Ptot[i] += tf[i]; T.Xtot[i] += tb[i]; if (g < 8) T.Pref[i] += tf[i]; else T.Xref[i] += tb[i];
            of[i] += (g < sg) ? tf[i] : 0.f; ob[i] += (g > sg) ? tb[i] : 0.f; } }
#pragma unroll
    for (int q = 0; q < 4; ++q)
#pragma unroll
        for (int i = 0; i < 2; ++i) { T.P[q][i] = lf[q][i] + of[i]; T.X[q][i] = lb[q][i] + ob[i]; }
}
__device__ __forceinline__ void gla_stage_common(const Args& a, int h, size_t rowbase, LAS unsigned char* lds, int tid) {
    const float* afb = (const float*)(a.ws + WS_AFB); const bf16* qkvg = (const bf16*)(a.ws + WS_QKVG);
    const f32x4 av = *(const f32x4*)(afb + (rowbase + (tid >> 3)) * 32 + 4 * (tid & 7));
    const int wdir = tid >> 8, wj = (tid >> 4) & 15, wd4 = (tid & 15) * 4;
    const f32x4 wv = *(const f32x4*)((wdir ? a.in[10] : a.in[8]) + wj * 256 + h * 64 + wd4);
    v4u vv[2];
#pragma unroll
    for (int q = 0; q < 2; ++q) { const int idx = tid + NTHR * q; vv[q] = *(const v4u*)(qkvg + (rowbase + (idx >> 4)) * NQ + 512 + h * 128 + (idx & 15) * 8); }
    *(LAS f32x4*)((LAS float*)(lds + GL_AL) + 4 * tid) = av;
    *(LAS f32x4*)((LAS float*)(lds + GL_WA) + wdir * 1024 + wj * 64 + wd4) = wv;
#pragma unroll
    for (int q = 0; q < 2; ++q) { const int idx = tid + NTHR * q; *(LAS v4u*)((LAS bf16*)(lds + GL_V) + (idx >> 4) * GL_VP + (idx & 15) * 8) = vv[q]; }
}

__device__ __forceinline__ void gla_upd_item(const Args& a, LAS unsigned char* lds, int bh, int ci) {
    int tid = threadIdx.x; asm volatile("" : "+v"(tid));
    const int lane = tid & 63, wave = tid >> 6, b = bh >> 2, h = bh & 3, d2 = tid & 31, sg = tid >> 5;
    unsigned char* ws = a.ws;
    constexpr int KP = 96;
    LAS bf16* vN = (LAS bf16*)(lds + GL_V); LAS bf16* kUf = (LAS bf16*)(lds + 45056); LAS bf16* kUb = (LAS bf16*)(lds + 57344);
    const size_t rowbase = (ci < 4) ? (size_t)(MX + b * CTXL + ci * 64) : (size_t)(b * SEQ + (ci - 4) * 64);
    const bf16* qkvg = (const bf16*)(ws + WS_QKVG);
    unsigned kw[4];
#pragma unroll
    for (int q = 0; q < 4; ++q) kw[q] = *(const unsigned*)(qkvg + (rowbase + sg * 4 + q) * NQ + 256 + h * 64 + 2 * d2);
    gla_stage_common(a, h, rowbase, lds, tid);
    __syncthreads();
    GlaTab T; gla_tables(a, h, lds, T, tid);
#pragma unroll
    for (int q = 0; q < 4; ++q) { const int s = sg * 4 + q; const float k0 = bflo(kw[q]), k1 = bfhi(kw[q]);
        *(LAS unsigned*)(kUf + s * KP + 2 * d2) = pk2(k0 * __expf(T.Ptot[0] - T.P[q][0]), k1 * __expf(T.Ptot[1] - T.P[q][1]));
        *(LAS unsigned*)(kUb + s * KP + 2 * d2) = pk2(k0 * __expf(T.Xtot[0] - T.X[q][0]), k1 * __expf(T.Xtot[1] - T.X[q][1])); }
    if (tid < 32) { float* dec = (float*)(ws + WS_DEC);
#pragma unroll
        for (int i = 0; i < 2; ++i) { dec[((size_t)(bh * 2 + 0) * NCH + ci) * 64 + 2 * d2 + i] = __expf(T.Ptot[i]); dec[((size_t)(bh * 2 + 1) * NCH + ci) * 64 + 2 * d2 + i] = __expf(T.Xtot[i]); } }
    __syncthreads();
    { const int dir = wave >> 2, e0 = (wave & 3) * 32, l31 = lane & 31, hh = lane >> 5;
        const LAS bf16* kT = dir ? kUb : kUf;
        float* U = (ci < 4) ? (float*)(ws + WS_UCTX) + ((size_t)(bh * 2 + dir) * 4 + ci) * 8192 : a.out + ((size_t)(bh * 2 + dir) * 64 + (ci - 4)) * 8192;
        bf16x8 A[4];
#pragma unroll
        for (int ks = 0; ks < 4; ++ks) A[ks] = tr_frag(vN, GL_VP, 16 * ks, e0, lane);
#pragma unroll
        for (int dt = 0; dt < 2; ++dt) { const int d0 = dt * 32; f32x16 acc;
#pragma unroll
            for (int i = 0; i < 16; ++i) acc[i] = 0.f;
#pragma unroll
            for (int ks = 0; ks < 4; ++ks) acc = mfma32(A[ks], tr_frag(kT, KP, 16 * ks, d0, lane), acc);
#pragma unroll
            for (int r = 0; r < 16; ++r) { const int e = e0 + (r & 3) + 8 * (r >> 2) + 4 * hh; U[e * 64 + d0 + l31] = acc[r]; } } }
    __syncthreads();
}

__device__ __forceinline__ void gla_scan_item(const Args& a, int it) {
    int tid = threadIdx.x; asm volatile("" : "+v"(tid));
    const int bd = it >> 4, dir = bd & 1, el = ((it & 15) * 8 + (tid >> 6)) * 64 + (tid & 63), d = tid & 63;
    unsigned char* ws = a.ws;
    const float* dec = (const float*)(ws + WS_DEC) + (size_t)bd * NCH * 64 + d;
    const float* Uc = (const float*)(ws + WS_UCTX) + (size_t)bd * 4 * 8192 + el;
    const float* U = a.out + (size_t)bd * 64 * 8192 + el;
    bf16* Sp = (bf16*)(ws + WS_SPREV) + (size_t)bd * 64 * 8192 + el;
    float S = 0.f;
#pragma unroll
    for (int c4 = 0; c4 < 4; ++c4) { const int ci = dir ? 3 - c4 : c4; S = dec[ci * 64] * S + Uc[(size_t)ci * 8192]; }
#pragma unroll
    for (int blk = 0; blk < 2; ++blk) { float uu[32], dd[32];
#pragma unroll
        for (int j = 0; j < 32; ++j) { const int n = dir ? 63 - (blk * 32 + j) : blk * 32 + j; uu[j] = U[(size_t)n * 8192]; dd[j] = dec[(4 + n) * 64]; }
#pragma unroll
        for (int j = 0; j < 32; ++j) { const int n = dir ? 63 - (blk * 32 + j) : blk * 32 + j; Sp[(size_t)n * 8192] = (bf16)f2bf(S); S = dd[j] * S + uu[j]; } }
}

__device__ __forceinline__ void gla_out_item(const Args& a, LAS unsigned char* lds, int bh, int n) {
    int tid = threadIdx.x; asm volatile("" : "+v"(tid));
    const int lane = tid & 63, wave = tid >> 6, b = bh >> 2, h = bh & 3, l31 = lane & 31, hh = lane >> 5, d2 = tid & 31, sg = tid >> 5;
    unsigned char* ws = a.ws;
    LAS bf16* Scat = (LAS bf16*)lds;
    LAS bf16* vN = (LAS bf16*)(lds + GL_V);
    LAS bf16* qf = (LAS bf16*)(lds + 45056); LAS bf16* qb = qf + 4608; LAS bf16* kf = qf + 2 * 4608; LAS bf16* kb = qf + 3 * 4608;
    LAS float* oS = (LAS float*)(lds + 45056);
    LAS bf16* qS = (LAS bf16*)(lds + 81920);
    LAS bf16* Sp = (LAS bf16*)(lds + 99328);
    const size_t rowbase = (size_t)b * SEQ + n * 64;
    const bf16* qkvg = (const bf16*)(ws + WS_QKVG);
    unsigned qw[4], kw[4];
#pragma unroll
    for (int q = 0; q < 4; ++q) { const bf16* rp = qkvg + (rowbase + sg * 4 + q) * NQ + h * 64 + 2 * d2; qw[q] = *(const unsigned*)rp; kw[q] = *(const unsigned*)(rp + 256); }
    { const bf16* spf = (const bf16*)(ws + WS_SPREV) + ((size_t)(bh * 2 + 0) * 64 + n) * 8192; const bf16* spb = (const bf16*)(ws + WS_SPREV) + ((size_t)(bh * 2 + 1) * 64 + n) * 8192;
        v4u sv[4];
#pragma unroll
        for (int q = 0; q < 4; ++q) { const int idx = tid + NTHR * q, dir = idx >> 10, e = (idx >> 3) & 127, d8 = (idx & 7) * 8; sv[q] = *(const v4u*)((dir ? spb : spf) + e * 64 + d8); }
        gla_stage_common(a, h, rowbase, lds, tid);
#pragma unroll
        for (int q = 0; q < 4; ++q) { const int idx = tid + NTHR * q, dir = idx >> 10, e = (idx >> 3) & 127, d8 = (idx & 7) * 8; *(LAS v4u*)(Sp + e * 136 + dir * 64 + d8) = sv[q]; } }
    __syncthreads();
    GlaTab T; gla_tables(a, h, lds, T, tid);
#pragma unroll
    for (int q = 0; q < 4; ++q) { const int s = sg * 4 + q; const float q0 = bflo(qw[q]), q1 = bfhi(qw[q]), k0 = bflo(kw[q]), k1 = bfhi(kw[q]);
        *(LAS unsigned*)(qf + s * 72 + 2 * d2) = pk2(q0 * __expf(T.P[q][0] - T.Pref[0]), q1 * __expf(T.P[q][1] - T.Pref[1]));
        *(LAS unsigned*)(kf + s * 72 + 2 * d2) = pk2(k0 * __expf(T.Pref[0] - T.P[q][0]), k1 * __expf(T.Pref[1] - T.P[q][1]));
        *(LAS unsigned*)(qb + s * 72 + 2 * d2) = pk2(q0 * __expf(T.X[q][0] - T.Xref[0]), q1 * __expf(T.X[q][1] - T.Xref[1]));
        *(LAS unsigned*)(kb + s * 72 + 2 * d2) = pk2(k0 * __expf(T.Xref[0] - T.X[q][0]), k1 * __expf(T.Xref[1] - T.X[q][1]));
        *(LAS unsigned*)(qS + s * 136 + 2 * d2) = pk2(q0 * __expf(T.P[q][0]), q1 * __expf(T.P[q][1]));
        *(LAS unsigned*)(qS + s * 136 + 64 + 2 * d2) = pk2(q0 * __expf(T.X[q][0]), q1 * __expf(T.X[q][1])); }
    __syncthreads();
    { const int dir = wave >> 2, c0 = ((wave >> 1) & 1) * 32, s0 = (wave & 1) * 32;
        const LAS bf16* qq = dir ? qb : qf; const LAS bf16* kk = dir ? kb : kf;
        f32x16 acc;
#pragma unroll
        for (int i = 0; i < 16; ++i) acc[i] = 0.f;
#pragma unroll
        for (int ks = 0; ks < 4; ++ks) { const bf16x8 A = *(const LAS bf16x8*)(qq + (c0 + l31) * 72 + 16 * ks + 8 * hh), B = *(const LAS bf16x8*)(kk + (s0 + l31) * 72 + 16 * ks + 8 * hh);
            acc = mfma32(A, B, acc); }
        const int s = s0 + l31;
#pragma unroll
        for (int r = 0; r < 16; ++r) { const int c = c0 + (r & 3) + 8 * (r >> 2) + 4 * hh; const bool keep = dir ? (s >= c) : (s <= c);
            Scat[c * 136 + dir * 64 + s] = (bf16)f2bf(keep ? acc[r] : 0.f); } }
    __syncthreads();
    { const int c0 = (wave >> 2) * 32, e0 = (wave & 3) * 32;
        f32x16 acc;
#pragma unroll
        for (int i = 0; i < 16; ++i) acc[i] = 0.f;
#pragma unroll
        for (int ks = 0; ks < 8; ++ks) { const bf16x8 A = *(const LAS bf16x8*)(Scat + (c0 + l31) * 136 + 16 * ks + 8 * hh);
            acc = mfma32(A, tr_frag(vN, GL_VP, 16 * (ks & 3), e0, lane), acc); }
#pragma unroll
        for (int ks = 0; ks < 8; ++ks) { const bf16x8 A = *(const LAS bf16x8*)(qS + (c0 + l31) * 136 + 16 * ks + 8 * hh), B = *(const LAS bf16x8*)(Sp + (e0 + l31) * 136 + 16 * ks + 8 * hh);
            acc = mfma32(A, B, acc); }
#pragma unroll
        for (int r = 0; r < 16; ++r) { const int c = c0 + (r & 3) + 8 * (r >> 2) + 4 * hh; oS[c * 132 + e0 + l31] = acc[r]; } }
    __syncthreads();
    { const int row = tid >> 3, ec = (tid & 7) * 16; float v[16]; float ss = 0.f;
#pragma unroll
        for (int j = 0; j < 16; ++j) { v[j] = oS[row * 132 + ec + j]; ss += v[j] * v[j]; }
        ss += __shfl_xor(ss, 1); ss += __shfl_xor(ss, 2); ss += __shfl_xor(ss, 4);
        const float rs = rsqrtf(ss * (1.0f / 128.0f) + EPS);
        const bf16* gp = qkvg + (rowbase + row) * NQ + 1024 + h * 128 + ec; const v4u g0 = *(const v4u*)gp, g1 = *(const v4u*)(gp + 8);
        const float gv[16] = {bflo(g0.x), bfhi(g0.x), bflo(g0.y), bfhi(g0.y), bflo(g0.z), bfhi(g0.z), bflo(g0.w), bfhi(g0.w), bflo(g1.x), bfhi(g1.x), bflo(g1.y), bfhi(g1.y), bflo(g1.z), bfhi(g1.z), bflo(g1.w), bfhi(g1.w)};
        float o[16];
#pragma unroll
        for (int j = 0; j < 16; ++j) o[j] = DBG_GLA_K * v[j] * rs * a.in[12][ec + j] * silu_f(gv[j]);
        bf16* op = (bf16*)(ws + WS_AOUT) + (rowbase + row) * DM + h * 128 + ec;
        *(v4u*)op = (v4u){pk2(o[0], o[1]), pk2(o[2], o[3]), pk2(o[4], o[5]), pk2(o[6], o[7])};
        *(v4u*)(op + 8) = (v4u){pk2(o[8], o[9]), pk2(o[10], o[11]), pk2(o[12], o[13]), pk2(o[14], o[15])}; }
    __syncthreads();
}

__device__ __forceinline__ void hy_transpose_item(const Args& a, LAS unsigned char* lds, int it) {
    const int tid = threadIdx.x, b = it >> 6, t0 = (it & 63) * 64;
    LAS float* tile = (LAS float*)lds;
    const float* src = (const float*)(a.ws + WS_YHYT) + (size_t)b * 512 * SEQ + t0;
    bf16* dst = (bf16*)(a.ws + WS_AOUT) + ((size_t)b * SEQ + t0) * DM + 512;
    for (int half = 0; half < 2; ++half) {
#pragma unroll 8
        for (int q = 0; q < 32; ++q) { const int idx = tid + NTHR * q, c = idx >> 6, tt = idx & 63; tile[c * 65 + tt] = src[(size_t)(half * 256 + c) * SEQ + tt]; }
        __syncthreads();
#pragma unroll
        for (int q = 0; q < 4; ++q) { const int idx = tid + NTHR * q, t = idx >> 5, c8 = (idx & 31) * 8; const LAS float* s = tile + c8 * 65 + t;
            *(v4u*)(dst + (size_t)t * DM + half * 256 + c8) = (v4u){pk2(s[0], s[65]), pk2(s[2 * 65], s[3 * 65]), pk2(s[4 * 65], s[5 * 65]), pk2(s[6 * 65], s[7 * 65])}; }
        __syncthreads();
    }
}

__device__ __forceinline__ void phase_router(const Args& a, LAS unsigned char* lds) {
    const int tid = threadIdx.x, lane = tid & 63, wave = tid >> 6, wg = blockIdx.x, G = gridDim.x;
    unsigned char* ws = a.ws;
    LAS float* wr = (LAS float*)lds;
    for (int i = tid; i < 4096; i += NTHR) { const int l = i & 63, q = (i >> 6) & 3, j = (i >> 8) & 3, e4 = i >> 10;
        *(LAS f32x4*)(wr + 4 * i) = *(const f32x4*)(a.in[24] + (4 * l + 256 * j + q) * 16 + 4 * e4); }
    __syncthreads();
    const float* modr = (const float*)(ws + WS_MOD); const float* gffn = a.in[23];
    bf16* hn = (bf16*)(ws + WS_HN); float* aff = (float*)(ws + WS_AFF);
    for (int r = wg * NWAVES + wave; r < MX; r += G * NWAVES) {
        const int b = r >> 12, t = r & 4095;
        const float* src = a.out + (size_t)r * DM;
        f32x4 v[4]; float ss = 0.f;
#pragma unroll
        for (int j = 0; j < 4; ++j) { v[j] = *(const f32x4*)(src + 4 * lane + 256 * j); ss += v[j][0] * v[j][0] + v[j][1] * v[j][1] + v[j][2] * v[j][2] + v[j][3] * v[j][3]; }
        const float rs = rsqrtf(wave_sum(ss) * (1.0f / DM) + EPS);
        float lg[16];
#pragma unroll
        for (int e = 0; e < 16; ++e) lg[e] = 0.f;
#pragma unroll
        for (int j = 0; j < 4; ++j) { const int col = 4 * lane + 256 * j;
            const f32x4 g = *(const f32x4*)(gffn + col), sh = *(const f32x4*)(modr + b * 6144 + 3072 + col), sc = *(const f32x4*)(modr + b * 6144 + 4096 + col);
            const f32x4 y = (v[j] * rs * g) * (sc + 1.0f) + sh;
            v2u w; w.x = pk2(y[0], y[1]); w.y = pk2(y[2], y[3]);
            *(v2u*)(hn + (size_t)r * DM + col) = w;
#pragma unroll
            for (int q = 0; q < 4; ++q) {
#pragma unroll
                for (int e4 = 0; e4 < 4; ++e4) { const f32x4 ww = *(const LAS f32x4*)(wr + 4 * ((((e4 * 4 + j) * 4 + q) << 6) + lane));
#pragma unroll
                    for (int s = 0; s < 4; ++s) lg[e4 * 4 + s] += y[q] * ww[s]; } } }
#pragma unroll
        for (int e = 0; e < 16; ++e) lg[e] = wave_sum(lg[e]);
        float mx = lg[0];
#pragma unroll
        for (int e = 1; e < 16; ++e) mx = fmaxf(mx, lg[e]);
        float sum = 0.f;
#pragma unroll
        for (int e = 0; e < 16; ++e) { lg[e] = expf(lg[e] - mx); sum += lg[e]; }
        float mine = lg[0];
#pragma unroll
        for (int e = 1; e < 16; ++e) mine = (lane == e) ? lg[e] : mine;
        if (lane < 16) aff[((size_t)b * NE + lane) * SEQ + t] = mine / sum;
    }
}

__device__ __forceinline__ void block_excl_scan2(int& va, int& vb, LAS int* tmp) {
    const int tid = threadIdx.x, lane = tid & 63, wave = tid >> 6;
    int ia = va, ib = vb;
#pragma unroll
    for (int o = 1; o < 64; o <<= 1) { const int ta = __shfl_up(ia, o), tb = __shfl_up(ib, o); if (lane >= o) { ia += ta; ib += tb; } }
    if (lane == 63) { tmp[wave] = ia; tmp[8 + wave] = ib; }
    __syncthreads();
    int oa = 0, ob = 0;
#pragma unroll
    for (int w = 0; w < 8; ++w) { if (w < wave) { oa += tmp[w]; ob += tmp[8 + w]; } }
    va = oa + ia - va; vb = ob + ib - vb;
    __syncthreads();
}
__device__ __forceinline__ void topk_item(const Args& a, LAS unsigned char* lds, int be) {
    const int tid = threadIdx.x, b = be >> 4, e = be & 15;
    unsigned char* ws = a.ws;
    LAS unsigned* keys = (LAS unsigned*)lds;
    LAS unsigned* hist = (LAS unsigned*)(lds + 16384);
    LAS int* ctl = (LAS int*)(lds + 16384 + 1024);
    LAS int* tmp = (LAS int*)(lds + 16384 + 1024 + 64);
    const float* aff = (const float*)(ws + WS_AFF) + (size_t)be * SEQ;
    unsigned my[8];
#pragma unroll
    for (int i = 0; i < 8; ++i) { my[i] = __float_as_uint(aff[tid * 8 + i]); keys[tid * 8 + i] = my[i]; }
    unsigned prefix = 0u, mask = 0u; int need = CAP;
    for (int pass = 0; pass < 4; ++pass) {
        const int shift = 24 - 8 * pass;
        if (tid < 256) hist[tid] = 0u;
        __syncthreads();
#pragma unroll
        for (int i = 0; i < 8; ++i) if ((my[i] & mask) == prefix) atomicAdd((unsigned*)&hist[(my[i] >> shift) & 255u], 1u);
        __syncthreads();
        {
            int hv = (tid < 256) ? (int)hist[255 - tid] : 0, inc = hv;
#pragma unroll
            for (int o = 1; o < 64; o <<= 1) { const int t2 = __shfl_up(inc, o); if ((tid & 63) >= o) inc += t2; }
            if ((tid & 63) == 63) tmp[tid >> 6] = inc;
            __syncthreads();
            int off = 0;
#pragma unroll
            for (int w = 0; w < 4; ++w) if (w < (tid >> 6)) off += tmp[w];
            inc += off;
            if (tid < 256 && inc >= need && inc - hv < need) { ctl[0] = 255 - tid; ctl[1] = need - (inc - hv); }
        }
        __syncthreads();
        prefix |= ((unsigned)ctl[0]) << shift; mask |= 255u << shift; need = ctl[1];
        __syncthreads();
    }
    const unsigned T = prefix;
    int cg = 0, ce = 0;
#pragma unroll
    for (int i = 0; i < 8; ++i) { cg += (my[i] > T) ? 1 : 0; ce += (my[i] == T) ? 1 : 0; }
    int pg = cg, pe = ce;
    block_excl_scan2(pg, pe, tmp);
    int* slot_of = (int*)(ws + WS_SLOT) + (size_t)be * SEQ;
    int* selt = (int*)(ws + WS_SELT) + (e * 4 + b) * CAP; float* selv = (float*)(ws + WS_SELV) + (e * 4 + b) * CAP;
#pragma unroll
    for (int i = 0; i < 8; ++i) { const int t = tid * 8 + i; const bool gt = my[i] > T, eq = my[i] == T; const bool sel = gt || (eq && pe < need);
        const int slot = pg + (pe < need ? pe : need);
        slot_of[t] = sel ? slot : -1;
        if (sel) { selt[slot] = t; selv[slot] = __uint_as_float(my[i]); }
        pg += gt ? 1 : 0; pe += eq ? 1 : 0; }
    __syncthreads();
}
__device__ __forceinline__ void phase_topk(const Args& a, LAS unsigned char* lds) {
    const int tid = threadIdx.x, lane = tid & 63, wave = tid >> 6, wg = blockIdx.x, G = gridDim.x;
    unsigned char* ws = a.ws;
    for (int it = wg; it < NB * NE; it += G) topk_item(a, lds, it);
    LAS float* scr = (LAS float*)(lds + 32768 + wave * 8448);
    for (int it = wg * NWAVES + wave; it < 48 * 512; it += G * NWAVES) {
        const int mat = it >> 9, r = it & 511, nb = r >> 4, kb = r & 15, e = mat / 3, kind = mat % 3, n0 = nb * 32;
        if (kind < 2) transpose_item((kind ? a.in[26] : a.in[25]) + (size_t)e * DM * DM, DM, kb * 64, n0, (bf16*)(ws + WS_WGU) + (size_t)e * 2048 * DM, DM, (n0 >> 7) * 256 + kind * 128 + (n0 & 127), scr, lane, false);
        else transpose_item(a.in[27] + (size_t)e * DM * DM, DM, kb * 64, n0, (bf16*)(ws + WS_WD) + (size_t)e * DM * DM, DM, n0, scr, lane, false);
    }
}

__device__ __forceinline__ void phase_gather(const Args& a) {
    const int tid = threadIdx.x, lane = tid & 63, wave = tid >> 6, wg = blockIdx.x, G = gridDim.x;
    unsigned char* ws = a.ws;
    const int* selt = (const int*)(ws + WS_SELT); const bf16* hn = (const bf16*)(ws + WS_HN); bf16* xs = (bf16*)(ws + WS_XS);
    for (int R = wg * NWAVES + wave; R < NE * NB * CAP; R += G * NWAVES) {
        const int b = (R >> 9) & 3, tok = selt[R];
        const v4u* s = (const v4u*)(hn + ((size_t)b * SEQ + tok) * DM); v4u* d = (v4u*)(xs + (size_t)R * DM);
        const v4u x0 = s[lane], x1 = s[lane + 64]; d[lane] = x0; d[lane + 64] = x1;
    }
}

__device__ __forceinline__ void phase_final(const Args& a) {
    const int tid = threadIdx.x, lane = tid & 63, wave = tid >> 6, wg = blockIdx.x, G = gridDim.x;
    unsigned char* ws = a.ws;
    const float* modr = (const float*)(ws + WS_MOD); const int* slot_of = (const int*)(ws + WS_SLOT); const bf16* ys = (const bf16*)(ws + WS_YSLAB);
    for (int r = wg * NWAVES + wave; r < MX; r += G * NWAVES) {
        const int b = r >> 12, t = r & 4095;
        float* row = a.out + (size_t)r * DM;
        f32x4 m[4];
#pragma unroll
        for (int j = 0; j < 4; ++j) m[j] = (f32x4){0.f, 0.f, 0.f, 0.f};
        for (int e = 0; e < NE; ++e) { const int s = slot_of[((size_t)b * NE + e) * SEQ + t];
            if (s >= 0 && !DBG_NOMOE) { const bf16* yp = ys + ((size_t)e * 2048 + b * CAP + s) * DM;
#pragma unroll
                for (int j = 0; j < 4; ++j) { const v2u w = *(const v2u*)(yp + 4 * lane + 256 * j); m[j][0] += bflo(w.x); m[j][1] += bfhi(w.x); m[j][2] += bflo(w.y); m[j][3] += bfhi(w.y); } } }
        f32x4 v[4]; float ss = 0.f;
#pragma unroll
        for (int j = 0; j < 4; ++j) { const int col = 4 * lane + 256 * j; v[j] = *(const f32x4*)(row + col) + *(const f32x4*)(modr + b * 6144 + 5120 + col) * m[j] * DBG_MOE_K;
            ss += v[j][0] * v[j][0] + v[j][1] * v[j][1] + v[j][2] * v[j][2] + v[j][3] * v[j][3]; }
        const float rs = rsqrtf(wave_sum(ss) * (1.0f / DM) + EPS);
#pragma unroll
        for (int j = 0; j < 4; ++j) { const int col = 4 * lane + 256 * j; *(f32x4*)(row + col) = v[j] * rs * *(const f32x4*)(a.in[28] + col); }
    }
}

__global__ void __launch_bounds__(NTHR, 2) fwd_kernel(Args a) {
    extern __shared__ __attribute__((aligned(16))) unsigned char lds_raw[];
    LAS unsigned char* lds = (LAS unsigned char*)lds_raw;
    const int tid = threadIdx.x, wg = blockIdx.x, G = gridDim.x;
    unsigned char* ws = a.ws;
    volatile LAS unsigned* MISC = (volatile LAS unsigned*)(lds + LDS_MISC);
    if (tid < 64) MISC[tid] = 0u;
    __syncthreads();
    XcdBarrier bar; bar.bar = (unsigned*)(ws + WS_CTL); bar.x = 0; bar.st = nullptr;
    if (a.ph_hi - a.ph_lo > 1) bar = xcd_barrier_post((unsigned*)(ws + WS_CTL), MISC + 8);
#ifndef PH_ONLY
#define PH_ONLY -1
#endif
#define IN(k) ((PH_ONLY < 0 || PH_ONLY == (k)) && a.ph_lo <= (k) && (k) < a.ph_hi)
#define SEAM(k) do { if (IN(k) && IN((k) + 1)) xcd_barrier(bar); } while (0)
#ifndef DBG_DUP
#define DBG_DUP -1
#endif
#define REP(k) for (int _rep = 0; _rep < ((DBG_DUP == (k)) ? 2 : 1); ++_rep, (void)((DBG_DUP == (k) && _rep == 1) ? (xcd_barrier(bar), 0) : 0))
    if (IN(0)) REP(0) { phase0(a, lds); } SEAM(0);
    if (IN(1)) REP(1) { phase1(a, lds); } SEAM(1);
    if (IN(2)) REP(2) {
        pg8::Gemm g{(const pg8::bf16_t*)(ws + WS_AIN), (const pg8::bf16_t*)(ws + WS_WIN), MT, NIN, DM}; InSched S; S.init(G, wg);
        EpiIn E{(bf16*)(ws + WS_QKVG), (float*)(ws + WS_HYT), (float*)(ws + WS_AFB)};
        pg8::gemm_phase<EpiIn, InSched, true, true>(lds, g, S, E);
    } SEAM(2);
    if (IN(3)) REP(3) {
        for (int it = wg; it < 512 + 16 * NCH; it += G) { if (it < 512) hyena_item(a, lds, it, 0); else { const int r = it - 512; gla_upd_item(a, lds, r / NCH, r % NCH); } }
    } SEAM(3);
    if (IN(4)) REP(4) {
        for (int it = wg; it < 1024; it += G) { if (it < 512) hyena_item(a, lds, it, 1); else gla_scan_item(a, it - 512); }
    } SEAM(4);
    if (IN(5)) REP(5) {
        for (int it = wg; it < 1280; it += G) { if (it < 1024) gla_out_item(a, lds, it >> 6, it & 63); else hy_transpose_item(a, lds, it - 1024); }
    } SEAM(5);
    if (IN(6)) REP(6) {
        pg8::Gemm g{(const pg8::bf16_t*)(ws + WS_AOUT), (const pg8::bf16_t*)(ws + WS_WOUT), MX, DM, DM}; pg8::StaticOrder S; S.init(MX, DM, G, wg);
        EpiOut E{a.in[0], (const float*)(ws + WS_POS), (const float*)(ws + WS_MOD), a.out};
        pg8::gemm_phase<EpiOut, pg8::StaticOrder, true, true>(lds, g, S, E);
    } SEAM(6);
    if (IN(7)) REP(7) { phase_router(a, lds); } SEAM(7);
    if (IN(8)) REP(8) { phase_topk(a, lds); } SEAM(8);
    if (IN(9)) REP(9) { phase_gather(a); } SEAM(9);
    if (IN(10)) REP(10) {
        pg8::Gemm g{(const pg8::bf16_t*)(ws + WS_XS), (const pg8::bf16_t*)(ws + WS_WGU), NE * 2048, NE * 2048, DM}; MoeSched<8> S; S.init(G, wg);
        EpiGU E{(bf16*)(ws + WS_HID)};
        pg8::gemm_phase<EpiGU, MoeSched<8>, true, true>(lds, g, S, E);
    } SEAM(10);
    if (IN(11)) REP(11) {
        pg8::Gemm g{(const pg8::bf16_t*)(ws + WS_HID), (const pg8::bf16_t*)(ws + WS_WD), NE * 2048, NE * 1024, DM}; MoeSched<4> S; S.init(G, wg);
        EpiDown E{(bf16*)(ws + WS_YSLAB), (const float*)(ws + WS_SELV)};
        pg8::gemm_phase<EpiDown, MoeSched<4>, true, true>(lds, g, S, E);
    } SEAM(11);
    if (IN(12)) { phase_final(a); }
#undef IN
#undef SEAM
}


#ifdef DBG_STATE
__global__ void chk_kernel(const unsigned* p, size_t nwords, unsigned long long* out) {
    unsigned long long s = 0ull;
    for (size_t i = (size_t)blockIdx.x * blockDim.x + threadIdx.x; i < nwords; i += (size_t)gridDim.x * blockDim.x) s += (unsigned long long)p[i] * (2ull * i + 1ull);
    for (int o = 1; o < 64; o <<= 1) s += __shfl_xor(s, o);
    if ((threadIdx.x & 63) == 0) atomicAdd(out, s);
}
__global__ void report_kernel(const unsigned long long* chk, float* out, int n) {
    int bad = -1;
    for (int p = 0; p < 28; ++p) if (chk[p] != chk[32 + p]) { bad = p; break; }
    if (bad < 0) return;
    for (int i = blockIdx.x * blockDim.x + threadIdx.x; i < n; i += gridDim.x * blockDim.x) out[i] = 1000.f * (float)(bad + 1);
}
struct ChkEnt { int ph; size_t off; size_t bytes; };
#endif
extern "C" void kernel_launch(void* const* d_in, const int* in_sizes, int n_in, void* d_out, int out_size, void* d_ws, size_t ws_size, hipStream_t stream) {
    static int grid = 0;
    if (grid == 0) {
        if (n_in != 29 || out_size != MX * DM || ws_size < WS_END) { fprintf(stderr, "kernel_launch: unexpected shapes (n_in %d out %d ws %zu)\n", n_in, out_size, ws_size); grid = -1; return; }
        int dev = 0, cus = 0, per_cu = 0;
        if (hipGetDevice(&dev) != hipSuccess || hipDeviceGetAttribute(&cus, hipDeviceAttributeMultiprocessorCount, dev) != hipSuccess) { grid = -1; return; }
        if (hipFuncSetAttribute((const void*)fwd_kernel, hipFuncAttributeMaxDynamicSharedMemorySize, LDS_BYTES) != hipSuccess) { fprintf(stderr, "kernel_launch: hipFuncSetAttribute failed\n"); grid = -1; return; }
        if (hipOccupancyMaxActiveBlocksPerMultiprocessor(&per_cu, (const void*)fwd_kernel, NTHR, LDS_BYTES) != hipSuccess || per_cu < 1) fprintf(stderr, "kernel_launch: occupancy query reports %d\n", per_cu);
        (void)hipGetLastError();
        grid = cus;
    }
    if (grid < 0) return;
    (void)hipMemsetAsync((char*)d_ws + WS_CTL, 0, CTL_BYTES, stream);
    Args a{};
    for (int i = 0; i < 29; ++i) a.in[i] = (const float*)d_in[i];
    a.out = (float*)d_out; a.ws = (unsigned char*)d_ws;
#if MK_SINGLE
    a.ph_lo = 0; a.ph_hi = NPH;
    hipLaunchKernelGGL(fwd_kernel, dim3(grid), dim3(NTHR), LDS_BYTES, stream, a);
#else
#ifdef DBG_STATE
    static const ChkEnt ents[] = { {0, WS_MOD, 122880}, {0, WS_POS, 131072}, {0, WS_HT, 32 * MiB}, {0, WS_WIN, (size_t)NIN * DM * 2}, {0, WS_WOUT, 2 * MiB},
        {1, WS_AIN, 34 * MiB}, {2, WS_QKVG, (size_t)MX * NQ * 2}, {2, WS_HYT, 96 * MiB}, {2, WS_AFB, (size_t)MT * 128},
        {3, WS_ZT, 32 * MiB}, {3, WS_DEC, (size_t)16 * 2 * NCH * 64 * 4}, {3, WS_UCTX, 4 * MiB}, {3, (size_t)-1, 64 * MiB},
        {4, WS_SPREV, 32 * MiB}, {4, WS_YHYT, 32 * MiB}, {5, WS_AOUT, 32 * MiB}, {6, (size_t)-1, 64 * MiB}, {7, WS_HN, 32 * MiB}, {7, WS_AFF, 1 * MiB},
        {8, WS_SLOT, 1 * MiB}, {8, WS_SELT, 131072}, {8, WS_SELV, 131072}, {8, WS_WGU, 64 * MiB}, {8, WS_WD, 32 * MiB}, {9, WS_XS, 64 * MiB}, {10, WS_HID, 64 * MiB}, {11, WS_YSLAB, 64 * MiB}, {12, (size_t)-1, 64 * MiB} };
    unsigned long long* chk = (unsigned long long*)((char*)d_ws + 32768);
    for (int run = 0; run < 2; ++run)
        for (int p = 0; p < NPH; ++p) { a.ph_lo = p; a.ph_hi = p + 1; hipLaunchKernelGGL(fwd_kernel, dim3(grid), dim3(NTHR), LDS_BYTES, stream, a);
            for (const ChkEnt& e : ents) if (e.ph == p) hipLaunchKernelGGL(chk_kernel, dim3(1024), dim3(256), 0, stream, (const unsigned*)(e.off == (size_t)-1 ? (char*)d_out : (char*)d_ws + e.off), e.bytes / 4, chk + run * 32 + (int)(&e - ents)); }
    hipLaunchKernelGGL(report_kernel, dim3(1024), dim3(256), 0, stream, (const unsigned long long*)chk, (float*)d_out, out_size);
#else
    for (int p = 0; p < NPH; ++p) { a.ph_lo = p; a.ph_hi = p + 1; hipLaunchKernelGGL(fwd_kernel, dim3(grid), dim3(NTHR), LDS_BYTES, stream, a); }
#endif
#endif
}
```

```cpp
#include <hip/hip_runtime.h>
#include <cstdio>
#include <cstdint>
#define MK_SINGLE 1
namespace pg8 {
#define PG8_LAS __attribute__((address_space(3)))
typedef unsigned short bf16_t;
typedef short bf16x8 __attribute__((ext_vector_type(8)));
typedef float f32x4 __attribute__((ext_vector_type(4)));
typedef unsigned u32x4 __attribute__((ext_vector_type(4)));
constexpr int BM = 256, BK = 64, HALF = 128, HTB = HALF * BK * 2  , STAGE_BYTES = 8 * HTB, NXCD = 8, WGM = 8;

__host__ __device__ __forceinline__ int lds_byte(int r, int c) { const int st = (r >> 4) * 2 + (c >> 5), rr = r & 15, cc = c & 31, ob = rr * 64 + cc * 2; return st * 1024 + (ob ^ (((ob >> 9) & 1) << 5)); }
__host__ __device__ __forceinline__ void stage_rc(int b, int& R, int& C) { const int st = b / 1024, sb = b % 1024, swz = sb ^ (((sb >> 9) & 1) << 5); R = (st >> 1) * 16 + swz / 64; C = (st & 1) * 32 + (swz % 64) / 2; }
__host__ __device__ __forceinline__ int perm32(int rho) { const int n = rho >> 4, i = rho & 15; return 8 * (i >> 2) + 4 * n + (i & 3); }

struct Unit { int pm, pn; };
struct Gemm { const bf16_t* A; const bf16_t* Bt; int M, N, K; };

struct StaticOrder {
    int nM, nN, nwg, G, c;
    __host__ __device__ void init(int M, int N, int G_, int c_) { nM = M / BM; nN = N / BM; nwg = nM * nN; G = G_; c = c_; }
    __host__ __device__ bool next(int i, Unit& u) const {
        const long L = (long)i * G + c; if (L >= nwg) return false;
        int wgid = (int)L; { const int q = nwg / NXCD, r = nwg % NXCD, xcd = wgid % NXCD, off = wgid / NXCD; wgid = (xcd < r ? xcd * (q + 1) : r * (q + 1) + (xcd - r) * q) + off; }
        const int nig = WGM * nN, gid = wgid / nig, fm = gid * WGM, gsz = (nM - fm) < WGM ? (nM - fm) : WGM;
        u.pm = fm + ((wgid % nig) % gsz); u.pn = (wgid % nig) / gsz; return true;
    }
    __device__ __forceinline__ void a_ready(const Unit&) const {}
    __device__ __forceinline__ void done(const Unit&) const {}
};

__device__ __forceinline__ unsigned cvt_pk_bf16(float lo, float hi) { unsigned r; asm volatile("v_cvt_pk_bf16_f32 %0, %1, %2" : "=v"(r) : "v"(lo), "v"(hi)); return r; }
template <class Epi, class Sched, bool ALIGN_EPI = false, bool SP2 = false>
__device__ __forceinline__ void gemm_phase(PG8_LAS unsigned char* lds, const Gemm g, const Sched& S, const Epi& E) {
    const int tid = threadIdx.x, wid = __builtin_amdgcn_readfirstlane(tid >> 6), lane = tid & 63, wr = wid >> 2, wc = wid & 3, fr = lane & 15, fq = lane >> 4;
    const int K = g.K, nt = K / BK;
    unsigned voffA[2], voffB[2];
#pragma unroll
    for (int i = 0; i < 2; ++i) { int R, C; stage_rc(tid * 16 + i * 8192, R, C); const int Rb = Epi::PERM ? ((R & ~31) + perm32(R & 31)) : R;
        voffA[i] = (unsigned)(R * K + C) * 2u; voffB[i] = (unsigned)(Rb * K + C) * 2u; }
    const size_t kstep = (size_t)(BK * 2);
    const size_t hstep = (size_t)HALF * K * 2;
    const size_t tstep = 2 * hstep;
    const unsigned ldsw = (unsigned)wid * 1024u;
    const int aoff = lds_byte(wr * 64 + fr, fq * 8), boff = lds_byte(wc * 32 + fr, fq * 8);
#define PG8_SA(b, h) (((b) * 2 + (h)) * HTB)
#define PG8_SB(b, h) ((4 + (b) * 2 + (h)) * HTB)
#define PG8_STAGE(bufoff, gbase, voff) do { _Pragma("unroll") for (int _i = 0; _i < 2; ++_i) \
        __builtin_amdgcn_global_load_lds((const unsigned*)((const char*)(gbase) + (voff)[_i]), (PG8_LAS unsigned*)(lds + (bufoff) + ldsw + _i * 8192), 16, 0, 0); } while (0)
#define PG8_LDA(dst, b, h) do { _Pragma("unroll") for (int m = 0; m < 4; ++m) _Pragma("unroll") for (int k = 0; k < 2; ++k) dst[m][k] = *(const PG8_LAS bf16x8*)(lds + PG8_SA(b, h) + aoff + m * 2048 + k * 1024); } while (0)
#define PG8_LDB(dst, b, h) do { _Pragma("unroll") for (int n = 0; n < 2; ++n) _Pragma("unroll") for (int k = 0; k < 2; ++k) dst[n][k] = *(const PG8_LAS bf16x8*)(lds + PG8_SB(b, h) + boff + n * 2048 + k * 1024); } while (0)
#define PG8_MMA(ai, bj, At, Bt) do { __builtin_amdgcn_s_setprio(1); _Pragma("unroll") for (int m = 0; m < 4; ++m) _Pragma("unroll") for (int n = 0; n < 2; ++n) _Pragma("unroll") for (int k = 0; k < 2; ++k) \
        acc[ai][bj][m][n] = __builtin_amdgcn_mfma_f32_16x16x32_bf16(Bt[n][k], At[m][k], acc[ai][bj][m][n], 0, 0, 0); __builtin_amdgcn_s_setprio(0); } while (0)
#define PG8_WAIT_V(n) asm volatile("s_waitcnt vmcnt(" #n ")" ::: "memory")
#define PG8_WAIT_L(n) asm volatile("s_waitcnt lgkmcnt(" #n ")" ::: "memory")
#define PG8_BAR __builtin_amdgcn_s_barrier()
#define PG8_SCHED __builtin_amdgcn_sched_barrier(0)
    Unit cur, nxt; int ui = 0;
    if (!S.next(0, cur)) return;
    f32x4 acc[2][2][4][2];
#pragma unroll
    for (int a = 0; a < 2; ++a)
#pragma unroll
        for (int b = 0; b < 2; ++b)
#pragma unroll
            for (int m = 0; m < 4; ++m)
#pragma unroll
                for (int n = 0; n < 2; ++n) acc[a][b][m][n] = (f32x4){0.f, 0.f, 0.f, 0.f};
    bf16x8 At[4][2], B0[2][2], B1[2][2];
    const char* cA = (const char*)g.A + (size_t)cur.pm * tstep; const char* cB = (const char*)g.Bt + (size_t)cur.pn * tstep;
    S.a_ready(cur);
    if constexpr (SP2) {
        PG8_STAGE(PG8_SB(0, 0), cB, voffB); PG8_STAGE(PG8_SB(0, 1), cB + hstep, voffB); PG8_STAGE(PG8_SA(0, 0), cA, voffA); PG8_STAGE(PG8_SA(0, 1), cA + hstep, voffA);
        if (wr == 1) PG8_BAR;
        PG8_WAIT_V(2); PG8_BAR;
        PG8_STAGE(PG8_SB(1, 0), cB + kstep, voffB); PG8_STAGE(PG8_SA(1, 0), cA + kstep, voffA); PG8_STAGE(PG8_SB(1, 1), cB + hstep + kstep, voffB);
        PG8_WAIT_V(6); PG8_BAR;
    } else {
        PG8_STAGE(PG8_SB(0, 0), cB, voffB); PG8_STAGE(PG8_SA(0, 0), cA, voffA); PG8_STAGE(PG8_SB(0, 1), cB + hstep, voffB); PG8_STAGE(PG8_SA(0, 1), cA + hstep, voffA);
        if (wr == 1) PG8_BAR;
        PG8_WAIT_V(4); PG8_BAR;
        PG8_STAGE(PG8_SB(1, 0), cB + kstep, voffB); PG8_STAGE(PG8_SA(1, 0), cA + kstep, voffA); PG8_STAGE(PG8_SB(1, 1), cB + hstep + kstep, voffB);
        PG8_WAIT_V(6); PG8_BAR;
    }
    for (;;) {
        const bool has_next = S.next(ui + 1, nxt);
        const char* nA = has_next ? (const char*)g.A + (size_t)nxt.pm * tstep : cA; const char* nB = has_next ? (const char*)g.Bt + (size_t)nxt.pn * tstep : cB;
        for (int t = 0; t < nt; t += 2) {
            const bool last = (t == nt - 2);
            const char* a1 = cA + (size_t)(t + 1) * kstep;
            const char* a2 = last ? nA : cA + (size_t)(t + 2) * kstep; const char* b2 = last ? nB : cB + (size_t)(t + 2) * kstep;
            const char* a3 = a2 + kstep; const char* b3 = b2 + kstep;
            if (last && has_next) S.a_ready(nxt);
            if constexpr (SP2) {
            PG8_LDB(B0, 0, 0); PG8_LDB(B1, 0, 1); PG8_SCHED; PG8_LDA(At, 0, 0); PG8_STAGE(PG8_SA(1, 1), a1 + hstep, voffA);
            PG8_WAIT_V(8); PG8_WAIT_L(0); PG8_BAR; PG8_MMA(0, 0, At, B0); PG8_MMA(0, 1, At, B1); PG8_BAR; PG8_SCHED;
            PG8_LDA(At, 0, 1); PG8_STAGE(PG8_SB(0, 0), b2, voffB); PG8_STAGE(PG8_SB(0, 1), b2 + hstep, voffB); PG8_STAGE(PG8_SA(0, 0), a2, voffA);
            PG8_WAIT_V(8); PG8_WAIT_L(0); PG8_BAR; PG8_MMA(1, 0, At, B0); PG8_MMA(1, 1, At, B1); PG8_BAR; PG8_SCHED;
            PG8_LDB(B0, 1, 0); PG8_LDB(B1, 1, 1); PG8_SCHED; PG8_LDA(At, 1, 0); PG8_STAGE(PG8_SA(0, 1), a2 + hstep, voffA);
            PG8_WAIT_V(8); PG8_WAIT_L(0); PG8_BAR; PG8_MMA(0, 0, At, B0); PG8_MMA(0, 1, At, B1); PG8_BAR; PG8_SCHED;
            PG8_LDA(At, 1, 1); PG8_STAGE(PG8_SB(1, 0), b3, voffB); PG8_STAGE(PG8_SB(1, 1), b3 + hstep, voffB); PG8_STAGE(PG8_SA(1, 0), a3, voffA);
            PG8_WAIT_V(8); PG8_WAIT_L(0); PG8_BAR; PG8_MMA(1, 0, At, B0); PG8_MMA(1, 1, At, B1); PG8_BAR; PG8_SCHED;
            } else {
            PG8_LDB(B0, 0, 0); PG8_SCHED; PG8_LDA(At, 0, 0); PG8_STAGE(PG8_SA(1, 1), a1 + hstep, voffA);
            PG8_WAIT_L(8); PG8_BAR; PG8_WAIT_L(0); PG8_MMA(0, 0, At, B0); PG8_BAR; PG8_SCHED;
            PG8_LDB(B1, 0, 1); PG8_STAGE(PG8_SB(0, 0), b2, voffB);
            PG8_BAR; PG8_WAIT_L(0); PG8_MMA(0, 1, At, B1); PG8_BAR;
            PG8_LDA(At, 0, 1); PG8_STAGE(PG8_SA(0, 0), a2, voffA);
            PG8_BAR; PG8_WAIT_L(0); PG8_MMA(1, 0, At, B0); PG8_BAR; PG8_SCHED;
            PG8_STAGE(PG8_SB(0, 1), b2 + hstep, voffB);
            PG8_WAIT_V(6); PG8_BAR; PG8_MMA(1, 1, At, B1); PG8_BAR;
            PG8_LDB(B0, 1, 0); PG8_SCHED; PG8_LDA(At, 1, 0); PG8_STAGE(PG8_SA(0, 1), a2 + hstep, voffA);
            PG8_WAIT_L(8); PG8_BAR; PG8_WAIT_L(0); PG8_MMA(0, 0, At, B0); PG8_BAR; PG8_SCHED;
            PG8_LDB(B1, 1, 1); PG8_STAGE(PG8_SB(1, 0), b3, voffB);
            PG8_BAR; PG8_WAIT_L(0); PG8_MMA(0, 1, At, B1); PG8_BAR;
            PG8_LDA(At, 1, 1); PG8_STAGE(PG8_SA(1, 0), a3, voffA);
            PG8_BAR; PG8_WAIT_L(0); PG8_MMA(1, 0, At, B0); PG8_BAR; PG8_SCHED;
            PG8_STAGE(PG8_SB(1, 1), b3 + hstep, voffB);
            PG8_WAIT_V(6); PG8_BAR; PG8_MMA(1, 1, At, B1); PG8_BAR;
            }
        }
        if constexpr (ALIGN_EPI) { if (wr == 0) PG8_BAR; }
        if constexpr (!Epi::AFTER_DRAIN) { E(acc, cur, wr, wc, fr, fq); S.done(cur); }
        if (!has_next) break;
#pragma unroll
        for (int a = 0; a < 2; ++a)
#pragma unroll
            for (int b = 0; b < 2; ++b)
#pragma unroll
                for (int m = 0; m < 4; ++m)
#pragma unroll
                    for (int n = 0; n < 2; ++n) acc[a][b][m][n] = (f32x4){0.f, 0.f, 0.f, 0.f};
        cur = nxt; cA = nA; cB = nB; ++ui;
        if constexpr (ALIGN_EPI) { if (wr == 1) PG8_BAR; }
    }
    PG8_WAIT_V(0);
    if constexpr (!ALIGN_EPI) { if (wr == 0) PG8_BAR; }
    PG8_BAR;
    if constexpr (Epi::AFTER_DRAIN) { E.fused(acc, cur, wr, wc, fr, fq, lds, wid, lane); S.done(cur); }
#undef PG8_SA
#undef PG8_SB
#undef PG8_STAGE
#undef PG8_LDA
#undef PG8_LDB
#undef PG8_MMA
#undef PG8_WAIT_V
#undef PG8_WAIT_L
#undef PG8_BAR
#undef PG8_SCHED
}
}
namespace pg8 {
template <class Epi, class Sched, bool ALIGN_EPI = false, bool SP2 = false>
__device__ __forceinline__ void gemm_phase_gather(PG8_LAS unsigned char* lds, const Gemm g, const Sched& S, const Epi& E, const int* __restrict__ idx) {
    const int tid = threadIdx.x, wid = __builtin_amdgcn_readfirstlane(tid >> 6), lane = tid & 63, wr = wid >> 2, wc = wid & 3, fr = lane & 15, fq = lane >> 4;
    const int K = g.K, nt = K / BK;
    unsigned voffB[2]; int RA[2], CA[2];
#pragma unroll
    for (int i = 0; i < 2; ++i) { int R, C; stage_rc(tid * 16 + i * 8192, R, C); const int Rb = Epi::PERM ? ((R & ~31) + perm32(R & 31)) : R;
        RA[i] = R; CA[i] = C; voffB[i] = (unsigned)(Rb * K + C) * 2u; }
    unsigned vA[2][2], nvA[2][2];
#define PG8_GOFF(dst, pm) do { _Pragma("unroll") for (int _h = 0; _h < 2; ++_h) _Pragma("unroll") for (int _i = 0; _i < 2; ++_i) { const int _r = (pm) * 256 + _h * 128 + RA[_i]; \
        dst[_h][_i] = (unsigned)((((_r >> 9) & 3) * 4096 + idx[_r]) * K + CA[_i]) * 2u; } } while (0)
    const size_t kstep = (size_t)(BK * 2);
    const size_t hstep = (size_t)HALF * K * 2;
    const size_t tstep = 2 * hstep;
    const unsigned ldsw = (unsigned)wid * 1024u;
    const int aoff = lds_byte(wr * 64 + fr, fq * 8), boff = lds_byte(wc * 32 + fr, fq * 8);
#define PG8_SA(b, h) (((b) * 2 + (h)) * HTB)
#define PG8_SB(b, h) ((4 + (b) * 2 + (h)) * HTB)
#define PG8_STAGE(bufoff, gbase, voff) do { _Pragma("unroll") for (int _i = 0; _i < 2; ++_i) \
        __builtin_amdgcn_global_load_lds((const unsigned*)((const char*)(gbase) + (voff)[_i]), (PG8_LAS unsigned*)(lds + (bufoff) + ldsw + _i * 8192), 16, 0, 0); } while (0)
#define PG8_LDA(dst, b, h) do { _Pragma("unroll") for (int m = 0; m < 4; ++m) _Pragma("unroll") for (int k = 0; k < 2; ++k) dst[m][k] = *(const PG8_LAS bf16x8*)(lds + PG8_SA(b, h) + aoff + m * 2048 + k * 1024); } while (0)
#define PG8_LDB(dst, b, h) do { _Pragma("unroll") for (int n = 0; n < 2; ++n) _Pragma("unroll") for (int k = 0; k < 2; ++k) dst[n][k] = *(const PG8_LAS bf16x8*)(lds + PG8_SB(b, h) + boff + n * 2048 + k * 1024); } while (0)
#define PG8_MMA(ai, bj, At, Bt) do { __builtin_amdgcn_s_setprio(1); _Pragma("unroll") for (int m = 0; m < 4; ++m) _Pragma("unroll") for (int n = 0; n < 2; ++n) _Pragma("unroll") for (int k = 0; k < 2; ++k) \
        acc[ai][bj][m][n] = __builtin_amdgcn_mfma_f32_16x16x32_bf16(Bt[n][k], At[m][k], acc[ai][bj][m][n], 0, 0, 0); __builtin_amdgcn_s_setprio(0); } while (0)
#define PG8_WAIT_V(n) asm volatile("s_waitcnt vmcnt(" #n ")" ::: "memory")
#define PG8_WAIT_L(n) asm volatile("s_waitcnt lgkmcnt(" #n ")" ::: "memory")
#define PG8_BAR __builtin_amdgcn_s_barrier()
#define PG8_SCHED __builtin_amdgcn_sched_barrier(0)
    Unit cur, nxt; int ui = 0;
    if (!S.next(0, cur)) return;
    f32x4 acc[2][2][4][2];
#pragma unroll
    for (int a = 0; a < 2; ++a)
#pragma unroll
        for (int b = 0; b < 2; ++b)
#pragma unroll
            for (int m = 0; m < 4; ++m)
#pragma unroll
                for (int n = 0; n < 2; ++n) acc[a][b][m][n] = (f32x4){0.f, 0.f, 0.f, 0.f};
    bf16x8 At[4][2], B0[2][2], B1[2][2];
    const char* cA = (const char*)g.A; PG8_GOFF(vA, cur.pm); const char* cB = (const char*)g.Bt + (size_t)cur.pn * tstep;
    S.a_ready(cur);
    if constexpr (SP2) {
        PG8_STAGE(PG8_SB(0, 0), cB, voffB); PG8_STAGE(PG8_SB(0, 1), cB + hstep, voffB); PG8_STAGE(PG8_SA(0, 0), cA, vA[0]); PG8_STAGE(PG8_SA(0, 1), cA, vA[1]);
        if (wr == 1) PG8_BAR;
        PG8_WAIT_V(2); PG8_BAR;
        PG8_STAGE(PG8_SB(1, 0), cB + kstep, voffB); PG8_STAGE(PG8_SA(1, 0), cA + kstep, vA[0]); PG8_STAGE(PG8_SB(1, 1), cB + hstep + kstep, voffB);
        PG8_WAIT_V(6); PG8_BAR;
    } else {
        PG8_STAGE(PG8_SB(0, 0), cB, voffB); PG8_STAGE(PG8_SA(0, 0), cA, vA[0]); PG8_STAGE(PG8_SB(0, 1), cB + hstep, voffB); PG8_STAGE(PG8_SA(0, 1), cA, vA[1]);
        if (wr == 1) PG8_BAR;
        PG8_WAIT_V(4); PG8_BAR;
        PG8_STAGE(PG8_SB(1, 0), cB + kstep, voffB); PG8_STAGE(PG8_SA(1, 0), cA + kstep, vA[0]); PG8_STAGE(PG8_SB(1, 1), cB + hstep + kstep, voffB);
        PG8_WAIT_V(6); PG8_BAR;
    }
    for (;;) {
        const bool has_next = S.next(ui + 1, nxt);
        if (has_next) { PG8_GOFF(nvA, nxt.pm); } else { nvA[0][0] = vA[0][0]; nvA[0][1] = vA[0][1]; nvA[1][0] = vA[1][0]; nvA[1][1] = vA[1][1]; } const char* nB = has_next ? (const char*)g.Bt + (size_t)nxt.pn * tstep : cB;
        for (int t = 0; t < nt; t += 2) {
            const bool last = (t == nt - 2);
            const char* a1 = cA + (size_t)(t + 1) * kstep;
            const char* a2 = cA + (last ? (size_t)0 : (size_t)(t + 2) * kstep); unsigned w2[2][2]; w2[0][0] = last ? nvA[0][0] : vA[0][0]; w2[0][1] = last ? nvA[0][1] : vA[0][1]; w2[1][0] = last ? nvA[1][0] : vA[1][0]; w2[1][1] = last ? nvA[1][1] : vA[1][1]; const char* b2 = last ? nB : cB + (size_t)(t + 2) * kstep;
            const char* a3 = a2 + kstep; const char* b3 = b2 + kstep;
            if (last && has_next) S.a_ready(nxt);
            if constexpr (SP2) {
            PG8_LDB(B0, 0, 0); PG8_LDB(B1, 0, 1); PG8_SCHED; PG8_LDA(At, 0, 0); PG8_STAGE(PG8_SA(1, 1), a1, vA[1]);
            PG8_WAIT_V(8); PG8_WAIT_L(0); PG8_BAR; PG8_MMA(0, 0, At, B0); PG8_MMA(0, 1, At, B1); PG8_BAR; PG8_SCHED;
            PG8_LDA(At, 0, 1); PG8_STAGE(PG8_SB(0, 0), b2, voffB); PG8_STAGE(PG8_SB(0, 1), b2 + hstep, voffB); PG8_STAGE(PG8_SA(0, 0), a2, w2[0]);
            PG8_WAIT_V(8); PG8_WAIT_L(0); PG8_BAR; PG8_MMA(1, 0, At, B0); PG8_MMA(1, 1, At, B1); PG8_BAR; PG8_SCHED;
            PG8_LDB(B0, 1, 0); PG8_LDB(B1, 1, 1); PG8_SCHED; PG8_LDA(At, 1, 0); PG8_STAGE(PG8_SA(0, 1), a2, w2[1]);
            PG8_WAIT_V(8); PG8_WAIT_L(0); PG8_BAR; PG8_MMA(0, 0, At, B0); PG8_MMA(0, 1, At, B1); PG8_BAR; PG8_SCHED;
            PG8_LDA(At, 1, 1); PG8_STAGE(PG8_SB(1, 0), b3, voffB); PG8_STAGE(PG8_SB(1, 1), b3 + hstep, voffB); PG8_STAGE(PG8_SA(1, 0), a3, w2[0]);
            PG8_WAIT_V(8); PG8_WAIT_L(0); PG8_BAR; PG8_MMA(1, 0, At, B0); PG8_MMA(1, 1, At, B1); PG8_BAR; PG8_SCHED;
            } else {
            PG8_LDB(B0, 0, 0); PG8_SCHED; PG8_LDA(At, 0, 0); PG8_STAGE(PG8_SA(1, 1), a1, vA[1]);
            PG8_WAIT_L(8); PG8_BAR; PG8_WAIT_L(0); PG8_MMA(0, 0, At, B0); PG8_BAR; PG8_SCHED;
            PG8_LDB(B1, 0, 1); PG8_STAGE(PG8_SB(0, 0), b2, voffB);
            PG8_BAR; PG8_WAIT_L(0); PG8_MMA(0, 1, At, B1); PG8_BAR;
            PG8_LDA(At, 0, 1); PG8_STAGE(PG8_SA(0, 0), a2, w2[0]);
            PG8_BAR; PG8_WAIT_L(0); PG8_MMA(1, 0, At, B0); PG8_BAR; PG8_SCHED;
            PG8_STAGE(PG8_SB(0, 1), b2 + hstep, voffB);
            PG8_WAIT_V(6); PG8_BAR; PG8_MMA(1, 1, At, B1); PG8_BAR;
            PG8_LDB(B0, 1, 0); PG8_SCHED; PG8_LDA(At, 1, 0); PG8_STAGE(PG8_SA(0, 1), a2, w2[1]);
            PG8_WAIT_L(8); PG8_BAR; PG8_WAIT_L(0); PG8_MMA(0, 0, At, B0); PG8_BAR; PG8_SCHED;
            PG8_LDB(B1, 1, 1); PG8_STAGE(PG8_SB(1, 0), b3, voffB);
            PG8_BAR; PG8_WAIT_L(0); PG8_MMA(0, 1, At, B1); PG8_BAR;
            PG8_LDA(At, 1, 1); PG8_STAGE(PG8_SA(1, 0), a3, w2[0]);
            PG8_BAR; PG8_WAIT_L(0); PG8_MMA(1, 0, At, B0); PG8_BAR; PG8_SCHED;
            PG8_STAGE(PG8_SB(1, 1), b3 + hstep, voffB);
            PG8_WAIT_V(6); PG8_BAR; PG8_MMA(1, 1, At, B1); PG8_BAR;
            }
        }
        if constexpr (ALIGN_EPI) { if (wr == 0) PG8_BAR; }
        if constexpr (!Epi::AFTER_DRAIN) { E(acc, cur, wr, wc, fr, fq); S.done(cur); }
        if (!has_next) break;
#pragma unroll
        for (int a = 0; a < 2; ++a)
#pragma unroll
            for (int b = 0; b < 2; ++b)
#pragma unroll
                for (int m = 0; m < 4; ++m)
#pragma unroll
                    for (int n = 0; n < 2; ++n) acc[a][b][m][n] = (f32x4){0.f, 0.f, 0.f, 0.f};
        cur = nxt; cB = nB; ++ui; vA[0][0] = nvA[0][0]; vA[0][1] = nvA[0][1]; vA[1][0] = nvA[1][0]; vA[1][1] = nvA[1][1];
        if constexpr (ALIGN_EPI) { if (wr == 1) PG8_BAR; }
    }
    PG8_WAIT_V(0);
    if constexpr (!ALIGN_EPI) { if (wr == 0) PG8_BAR; }
    PG8_BAR;
    if constexpr (Epi::AFTER_DRAIN) { E.fused(acc, cur, wr, wc, fr, fq, lds, wid, lane); S.done(cur); }
#undef PG8_SA
#undef PG8_SB
#undef PG8_STAGE
#undef PG8_LDA
#undef PG8_LDB
#undef PG8_MMA
#undef PG8_WAIT_V
#undef PG8_WAIT_L
#undef PG8_BAR
#undef PG8_SCHED
#undef PG8_GOFF
}
}

#ifndef DBG_NOMIX
#define DBG_NOMIX 0
#endif
#ifndef DBG_NOMOE
#define DBG_NOMOE 0
#endif
#ifndef DBG_NOPOS
#define DBG_NOPOS 0
#endif
#ifndef DBG_HTCONST
#define DBG_HTCONST 0
#endif
#ifndef DBG_GLA_K
#define DBG_GLA_K 1.0f
#endif
#ifndef DBG_MOE_K
#define DBG_MOE_K 1.0f
#endif
#ifndef MK_SINGLE
#define MK_SINGLE 0
#endif
#define GAS __attribute__((address_space(1)))
#define LAS __attribute__((address_space(3)))
typedef unsigned short bf16;
typedef float f32x4 __attribute__((ext_vector_type(4)));
typedef float f32x16 __attribute__((ext_vector_type(16)));
typedef short bf16x8 __attribute__((ext_vector_type(8)));
typedef unsigned v4u __attribute__((ext_vector_type(4)));
typedef unsigned v2u __attribute__((ext_vector_type(2)));
typedef GAS unsigned gu32;

constexpr int NWAVES = 8, NTHR = 512;
constexpr int NB = 4, SEQ = 4096, DM = 1024, CTXL = 256;
constexpr int MX = NB * SEQ, MC = NB * CTXL, MT = MX + MC;
constexpr int NIN = 3328, NQ = 1536, DIN = 3104;
constexpr int NE = 16, CAP = 512;
constexpr int NCH = 68;
constexpr int NPH = 12;
constexpr float EPS = 1e-6f;

constexpr size_t MiB = 1u << 20;
constexpr size_t WS_CTL = 0, CTL_BYTES = 65536;
constexpr size_t WS_MOD = 1 * MiB, WS_POS = 1 * MiB + 256 * 1024, WS_DEC = 2 * MiB, WS_AFF = 3 * MiB, WS_SLOT = 4 * MiB, WS_SELT = 5 * MiB, WS_SELV = 5 * MiB + 256 * 1024;
constexpr size_t WS_UCTX = 6 * MiB, WS_AFB = 10 * MiB, WS_WIN = 13 * MiB, WS_WOUT = 20 * MiB;
constexpr size_t WS_R1 = 22 * MiB, WS_R2 = 56 * MiB, WS_R3 = 107 * MiB, WS_R4 = 203 * MiB, WS_R5 = 235 * MiB, WS_R6 = 267 * MiB, WS_END = 299 * MiB;
constexpr size_t WS_AIN = WS_R1, WS_ZT = WS_R1, WS_HN = WS_R1, WS_YSLAB = WS_R1;
constexpr size_t WS_QKVG = WS_R2;
constexpr size_t WS_HYT = WS_R3, WS_WGU = WS_R3, WS_WD = 171 * MiB;
constexpr size_t WS_HT = WS_R4, WS_AOUT = WS_R4, WS_HID = WS_R4;
constexpr size_t WS_SPREV = WS_R5, WS_YHYT = WS_R6;
constexpr int LDS_BYTES = 144 * 1024;
constexpr int LDS_MISC = LDS_BYTES - 256;

struct Args { const float* in[29]; float* out; unsigned char* ws; int ph_lo, ph_hi; };

#define LDS_WAIT() asm volatile("s_waitcnt lgkmcnt(0)" ::: "memory")
#define VM_WAIT() asm volatile("s_waitcnt vmcnt(0)" ::: "memory")
__device__ __forceinline__ unsigned f2bf(float f) { unsigned u = __float_as_uint(f); return (u + 0x7fffu + ((u >> 16) & 1u)) >> 16; }
__device__ __forceinline__ unsigned pk2(float lo, float hi) { return pg8::cvt_pk_bf16(lo, hi); }
__device__ __forceinline__ float bflo(unsigned w) { return __uint_as_float(w << 16); }
__device__ __forceinline__ float bfhi(unsigned w) { return __uint_as_float(w & 0xffff0000u); }
__device__ __forceinline__ float wave_sum(float v) {
#pragma unroll
    for (int o = 1; o < 64; o <<= 1) v += __shfl_xor(v, o);
    return v;
}
__device__ __forceinline__ float silu_f(float v) { return v / (1.f + __expf(-v)); }
__device__ __forceinline__ float logsig_f(float x) { return fminf(x, 0.f) - __logf(1.0f + __expf(-fabsf(x))); }

#define XB_TMO      128
#define XB_XCNT(j)  (256  + 64 * (j))
#define XB_XSUB(j)  (1280 + 64 * (j))
#define XB_XGEN(j)  (2304 + 64 * (j))
#define XB_TOP      3328
#define XB_TOPGEN   3392
#define XCD_BAR_WORDS 3456
#define XB_SPIN_CAP (1u << 22)
__device__ __forceinline__ unsigned xb_ld(unsigned* p)              { return __hip_atomic_load(p, __ATOMIC_RELAXED, __HIP_MEMORY_SCOPE_AGENT); }
__device__ __forceinline__ unsigned xb_add(unsigned* p, unsigned v) { return __hip_atomic_fetch_add(p, v, __ATOMIC_RELAXED, __HIP_MEMORY_SCOPE_AGENT); }
__device__ __forceinline__ unsigned xb_xcc_id() { return (unsigned)__builtin_amdgcn_s_getreg((3 << 11) | 20) & 0xFu; }
#define XB_SPIN(cond, bar) do { unsigned _sp = 0; while (cond) { __builtin_amdgcn_s_sleep(1); \
    if ((++_sp & 255u) == 0u) { if (xb_ld(&(bar)[XB_TMO])) break; if (_sp > XB_SPIN_CAP) { atomicAdd(&(bar)[XB_TMO], 1u); break; } } } } while (0)
struct XcdBarrier { unsigned* bar; unsigned x; volatile LAS unsigned* st; };
__device__ __forceinline__ XcdBarrier xcd_barrier_post(unsigned* bar, volatile LAS unsigned* st) {
    XcdBarrier b; b.bar = bar; b.x = xb_xcc_id(); b.st = st;
    if (threadIdx.x == 0) (void)xb_add(&bar[XB_XCNT(b.x)], 1u);
    return b;
}
__device__ __forceinline__ void xcd_barrier_complete(unsigned* bar, unsigned x, unsigned& nloc, unsigned& nx) {
    const unsigned G = gridDim.x * gridDim.y * gridDim.z;
    unsigned sum, cnt, mine, sp = 0u;
    for (;;) {
        sum = 0u; cnt = 0u; mine = 0u;
#pragma unroll
        for (unsigned j = 0; j < 16; ++j) { const unsigned c = xb_ld(&bar[XB_XCNT(j)]); sum += c; cnt += (c > 0u) ? 1u : 0u; mine = (j == x) ? c : mine; }
        if (sum == G) break;
        __builtin_amdgcn_s_sleep(1);
        if ((++sp & 255u) == 0u) { if (xb_ld(&bar[XB_TMO])) break; if (sp > XB_SPIN_CAP) { atomicAdd(&bar[XB_TMO], 1u); break; } }
    }
    nloc = mine > 0u ? mine : 1u; nx = cnt > 0u ? cnt : 1u;
}
__device__ __forceinline__ void xcd_barrier(const XcdBarrier& b) {
    asm volatile("s_waitcnt vmcnt(0)" ::: "memory");
    __syncthreads();
    if (threadIdx.x == 0) {
        unsigned* bar = b.bar;
        __builtin_amdgcn_s_waitcnt(0);
        unsigned nloc = b.st[0], nx = b.st[1];
        if (nloc == 0u) { xcd_barrier_complete(bar, b.x, nloc, nx); b.st[0] = nloc; b.st[1] = nx; }
        const unsigned old = xb_add(&bar[XB_XSUB(b.x)], 1u);
        const unsigned gen = old / nloc;
        if (old + 1u == (gen + 1u) * nloc) {
            __builtin_amdgcn_fence(__ATOMIC_RELEASE, "agent");
            asm volatile("s_waitcnt vmcnt(0)" ::: "memory");
            const unsigned og = xb_add(&bar[XB_TOP], 1u);
            const unsigned tg = og / nx;
            if (og + 1u == (tg + 1u) * nx) xb_add(&bar[XB_TOPGEN], 1u);
            else XB_SPIN(xb_ld(&bar[XB_TOPGEN]) == tg, bar);
            __builtin_amdgcn_fence(__ATOMIC_ACQUIRE, "agent");
            xb_add(&bar[XB_XGEN(b.x)], 1u);
            asm volatile("s_waitcnt vmcnt(0)" ::: "memory");
        } else {
            XB_SPIN(xb_ld(&bar[XB_XGEN(b.x)]) == gen, bar);
            __builtin_amdgcn_fence(__ATOMIC_ACQUIRE, "agent");
            asm volatile("s_waitcnt vmcnt(0)" ::: "memory");
        }
    }
    __syncthreads();
}

struct InSched {
    pg8::StaticOrder so; int G, c;
    __device__ void init(int G_, int c_) { so.init(MX, NIN, G_, c_); G = G_; c = c_; }
    __device__ bool next(int i, pg8::Unit& u) const {
        const int L = i * G + c;
        if (L < 832) return so.next(i, u);
        if (L >= 848) return false;
        const int j = L - 832; u.pm = 64 + (j & 3); const int q = j >> 2; u.pn = (q == 3) ? 12 : (1 + q); return true;
    }
    __device__ __forceinline__ void a_ready(const pg8::Unit&) const {}
    __device__ __forceinline__ void done(const pg8::Unit&) const {}
};
template <int NT> struct MoeSched {
    int G, c;
    __device__ void init(int G_, int c_) { G = G_; c = c_; }
    __device__ bool next(int i, pg8::Unit& u) const {
        const int L = i * G + c; if (L >= NE * 8 * NT) return false;
        const int e = L / (8 * NT), l = L % (8 * NT); u.pm = e * 8 + (l & 7); u.pn = e * NT + (l >> 3); return true;
    }
    __device__ __forceinline__ void a_ready(const pg8::Unit&) const {}
    __device__ __forceinline__ void done(const pg8::Unit&) const {}
};

struct EpiIn {
    static constexpr bool PERM = true, AFTER_DRAIN = false;
    bf16* qkvg; float* hyT; float* afb;
    __device__ __forceinline__ void operator()(const f32x4 (&acc)[2][2][4][2], const pg8::Unit& u, int wr, int wc, int fr, int fq) const {
        const int row0 = u.pm * 256 + wr * 64 + fr;
        if (u.pn < 6) {
            const float sc = (u.pn == 0) ? 0.125f : 1.f;
            const int col0 = u.pn * 256 + wc * 32 + 8 * fq;
#pragma unroll
            for (int ai = 0; ai < 2; ++ai)
#pragma unroll
                for (int m = 0; m < 4; ++m) { bf16* rowp = qkvg + (size_t)(row0 + ai * 128 + m * 16) * NQ + col0;
#pragma unroll
                    for (int bj = 0; bj < 2; ++bj) { const f32x4 v0 = acc[ai][bj][m][0] * sc, v1 = acc[ai][bj][m][1] * sc;
                        v4u w; w.x = pk2(v0[0], v0[1]); w.y = pk2(v0[2], v0[3]); w.z = pk2(v1[0], v1[1]); w.w = pk2(v1[2], v1[3]);
                        *(v4u*)(rowp + bj * 128) = w; } }
        } else if (u.pn < 12) {
            if (u.pm >= 64) return;
            const int ch0 = (u.pn - 6) * 256 + wc * 32 + 8 * fq;
#pragma unroll
            for (int ai = 0; ai < 2; ++ai)
#pragma unroll
                for (int m = 0; m < 4; ++m) { const int r = row0 + ai * 128 + m * 16; const int b = r >> 12, t = r & 4095;
                    float* bp = hyT + (size_t)b * 1536 * SEQ + t;
#pragma unroll
                    for (int bj = 0; bj < 2; ++bj)
#pragma unroll
                        for (int n = 0; n < 2; ++n)
#pragma unroll
                            for (int j = 0; j < 4; ++j) bp[(size_t)(ch0 + bj * 128 + 4 * n + j) * SEQ] = acc[ai][bj][m][n][j]; }
        } else {
            if (wc != 0) return;
#pragma unroll
            for (int ai = 0; ai < 2; ++ai)
#pragma unroll
                for (int m = 0; m < 4; ++m) { float* rowp = afb + (size_t)(row0 + ai * 128 + m * 16) * 32 + 8 * fq;
                    *(f32x4*)(rowp) = acc[ai][0][m][0]; *(f32x4*)(rowp + 4) = acc[ai][0][m][1]; }
        }
    }
};
struct EpiOut {
    static constexpr bool PERM = false, AFTER_DRAIN = false;
    const float* x; const float* postab; const float* modr; float* x1;
    __device__ __forceinline__ void operator()(const f32x4 (&acc)[2][2][4][2], const pg8::Unit& u, int wr, int wc, int fr, int fq) const {
        const int row0 = u.pm * 256 + wr * 64 + fr, col0 = u.pn * 256 + wc * 32 + 4 * fq;
#pragma unroll
        for (int ai = 0; ai < 2; ++ai)
#pragma unroll
            for (int m = 0; m < 4; ++m) { const int r = row0 + ai * 128 + m * 16; const int b = r >> 12, t = r & 4095, rr = t >> 6, cc = t & 63;
                const float* gate = modr + b * 6144 + 2048;
#pragma unroll
                for (int bj = 0; bj < 2; ++bj)
#pragma unroll
                    for (int n = 0; n < 2; ++n) { const int c = col0 + bj * 128 + n * 16;
                        const f32x4 xv = *(const f32x4*)(x + (size_t)r * DM + c);
                        const f32x4 pv = (c < 512) ? *(const f32x4*)(postab + rr * 512 + c) : *(const f32x4*)(postab + cc * 512 + c - 512);
                        const f32x4 gv = *(const f32x4*)(gate + c);
                        *(f32x4*)(x1 + (size_t)r * DM + c) = xv + (DBG_NOPOS ? pv * 0.f : pv) + (DBG_NOMIX ? gv * 0.f : gv * acc[ai][bj][m][n]); } }
    }
};
struct EpiGU {
    static constexpr bool PERM = true, AFTER_DRAIN = false;
    bf16* hid;
    __device__ __forceinline__ void operator()(const f32x4 (&acc)[2][2][4][2], const pg8::Unit& u, int wr, int wc, int fr, int fq) const {
        const int row0 = u.pm * 256 + wr * 64 + fr, col0 = (u.pn & 7) * 128 + wc * 32 + 8 * fq;
#pragma unroll
        for (int ai = 0; ai < 2; ++ai)
#pragma unroll
            for (int m = 0; m < 4; ++m) { bf16* rowp = hid + (size_t)(row0 + ai * 128 + m * 16) * DM + col0;
                float o[8];
#pragma unroll
                for (int n = 0; n < 2; ++n)
#pragma unroll
                    for (int j = 0; j < 4; ++j) o[n * 4 + j] = silu_f(acc[ai][0][m][n][j]) * acc[ai][1][m][n][j];
                v4u w; w.x = pk2(o[0], o[1]); w.y = pk2(o[2], o[3]); w.z = pk2(o[4], o[5]); w.w = pk2(o[6], o[7]);
                *(v4u*)rowp = w; }
    }
};
struct EpiDown {
    static constexpr bool PERM = true, AFTER_DRAIN = false;
    bf16* ys; const float* selv;
    __device__ __forceinline__ void operator()(const f32x4 (&acc)[2][2][4][2], const pg8::Unit& u, int wr, int wc, int fr, int fq) const {
        const int row0 = u.pm * 256 + wr * 64 + fr, col0 = (u.pn & 3) * 256 + wc * 32 + 8 * fq;
#pragma unroll
        for (int ai = 0; ai < 2; ++ai)
#pragma unroll
            for (int m = 0; m < 4; ++m) { const int r = row0 + ai * 128 + m * 16; const float sc = selv[r]; bf16* rowp = ys + (size_t)r * DM + col0;
#pragma unroll
                for (int bj = 0; bj < 2; ++bj) { const f32x4 v0 = acc[ai][bj][m][0] * sc, v1 = acc[ai][bj][m][1] * sc;
                    v4u w; w.x = pk2(v0[0], v0[1]); w.y = pk2(v0[2], v0[3]); w.z = pk2(v1[0], v1[1]); w.w = pk2(v1[2], v1[3]);
                    *(v4u*)(rowp + bj * 128) = w; } }
    }
};

__device__ __forceinline__ void transpose_item(const float* W, int ldw, int k0, int nsrc0, bf16* WT, int K, int drow0, LAS float* scr, int lane, bool zero) {
    float tv[32];
#pragma unroll
    for (int i = 0; i < 32; ++i) { const int kk = 2 * i + (lane >> 5); tv[i] = zero ? 0.f : W[(size_t)(k0 + kk) * ldw + nsrc0 + (lane & 31)]; }
#pragma unroll
    for (int i = 0; i < 32; ++i) { const int kk = 2 * i + (lane >> 5); scr[kk * 33 + (lane & 31)] = tv[i]; }
    LDS_WAIT();
    const int c = lane & 7;
#pragma unroll
    for (int j = 0; j < 4; ++j) { const int n = (lane >> 3) + 8 * j; const LAS float* s = scr + (8 * c) * 33 + n;
        v4u o; o.x = pk2(s[0 * 33], s[1 * 33]); o.y = pk2(s[2 * 33], s[3 * 33]); o.z = pk2(s[4 * 33], s[5 * 33]); o.w = pk2(s[6 * 33], s[7 * 33]);
        *(v4u*)(WT + (size_t)(drow0 + n) * K + k0 + 8 * c) = o; }
    LDS_WAIT();
}

__device__ __forceinline__ void phase0(const Args& a, LAS unsigned char* lds) {
    int tid = threadIdx.x; const int wg = blockIdx.x, G = gridDim.x;
    asm volatile("" : "+v"(tid));
    int lane = tid & 63, wave = tid >> 6;
    unsigned char* ws = a.ws;
    for (int it = wg; it < 192; it += G) {
        LAS float* sl = (LAS float*)lds;
        LAS float* red = (LAS float*)(lds + 20480);
        for (int i = tid; i < 5 * 1024; i += NTHR) { const int bb = i >> 10, k = i & 1023; const float v = (bb < 4) ? a.in[1][bb * 1024 + k] : a.in[3][k]; sl[i] = silu_f(v); }
        __syncthreads();
        const int col = it * 32 + (lane & 31), kk = wave * 2 + (lane >> 5);
        float acc[5] = {0.f, 0.f, 0.f, 0.f, 0.f};
        const float* wp = a.in[4] + col;
#pragma unroll 8
        for (int j = 0; j < 64; ++j) { const int k = kk + 16 * j; const float w = wp[(size_t)k * 6144];
#pragma unroll
            for (int bb = 0; bb < 5; ++bb) acc[bb] += sl[bb * 1024 + k] * w; }
#pragma unroll
        for (int bb = 0; bb < 5; ++bb) red[(kk * 5 + bb) * 32 + (lane & 31)] = acc[bb];
        __syncthreads();
        if (tid < 160) { const int bb = tid >> 5, cl = tid & 31; float s = 0.f;
#pragma unroll
            for (int q = 0; q < 16; ++q) s += red[(q * 5 + bb) * 32 + cl];
            ((float*)(ws + WS_MOD))[bb * 6144 + it * 32 + cl] = s + a.in[5][it * 32 + cl]; }
        __syncthreads();
    }
    for (int it = wg; it < 256; it += G) {
        asm volatile("" : "+v"(tid));
        LAS float* zl = (LAS float*)lds;
        LAS float* h1 = (LAS float*)(lds + 4096);
        LAS float* h2 = (LAS float*)(lds + 8192);
        const int i0 = it * 16;
        for (int o = tid; o < 16 * 33; o += NTHR) { const int li = o / 33, j = o % 33; const int i = i0 + li;
            const float ti = (float)i * (1.0f / 4095.0f);
            const float wi = (6.2831855f * (float)i) / 4096.0f;
            float v;
            if (j == 0) v = ti;
            else { const int jj = (j - 1) & 15; const float f = 1e-4f + (float)jj * ((15.0f - 1e-4f) / 15.0f); const float ar = f * wi; v = (j <= 16) ? cosf(ar) : -sinf(ar); }
            zl[li * 36 + j] = v; }
        __syncthreads();
#pragma unroll
        for (int q = 0; q < 2; ++q) { const int o = tid + NTHR * q, li = o >> 6, m = o & 63; float s = a.in[16][m];
            for (int j = 0; j < 33; ++j) s += zl[li * 36 + j] * a.in[15][j * 64 + m];
            h1[li * 64 + m] = sinf(a.in[20][m] * s); }
        __syncthreads();
#pragma unroll
        for (int q = 0; q < 2; ++q) { const int o = tid + NTHR * q, li = o >> 6, m = o & 63; float s = a.in[18][m];
            for (int k = 0; k < 64; ++k) s += h1[li * 64 + k] * a.in[17][k * 64 + m];
            h2[li * 64 + m] = sinf(a.in[20][m] * s); }
        __syncthreads();
        f32x4 acc[16];
#pragma unroll
        for (int li = 0; li < 16; ++li) acc[li] = (f32x4){0.f, 0.f, 0.f, 0.f};
        const float* w3 = a.in[19] + tid * 4;
        for (int k = 0; k < 64; ++k) { const f32x4 w = *(const f32x4*)(w3 + k * 2048);
#pragma unroll
            for (int li = 0; li < 16; ++li) acc[li] += w * h2[li * 64 + k]; }
        float* hT = (float*)(ws + WS_HT);
#pragma unroll
        for (int j = 0; j < 4; ++j) { const int col = tid * 4 + j, od = col >> 9, c = col & 511;
            const float delta = 3.0701134573f + (float)c * ((15.3505672866f - 3.0701134573f) / 511.0f);
            float* dst = hT + ((size_t)od * 512 + c) * SEQ + i0;
#pragma unroll
            for (int q = 0; q < 4; ++q) { f32x4 o;
#pragma unroll
                for (int s = 0; s < 4; ++s) { const int li = q * 4 + s; const float ti = (float)(i0 + li) * (1.0f / 4095.0f); o[s] = DBG_HTCONST == 1 ? 1.0f : DBG_HTCONST == 2 ? zl[li * 36 + (col % 33)] : DBG_HTCONST == 3 ? h1[li * 64 + (col & 63)] : DBG_HTCONST == 4 ? h2[li * 64 + (col & 63)] : DBG_HTCONST == 5 ? acc[li][j] : acc[li][j] * __expf(-ti * delta); }
                *(f32x4*)(dst + q * 4) = o; } }
        __syncthreads();
    }
    {
        asm volatile("" : "+v"(tid)); lane = tid & 63; wave = tid >> 6;
        LAS float* scr = (LAS float*)(lds + wave * 8448);
        const int gw = wg * NWAVES + wave, NGW = G * NWAVES;
        constexpr int I_IN = 104 * 16, I_OUT = 32 * 16;
        for (int it = gw; it < I_IN + I_OUT; it += NGW) {
            if (it < I_IN) { const int nb = it >> 4, kb = it & 15, n0 = nb * 32;
                const int ns = (n0 < 1536) ? n0 : (n0 < 3072 ? n0 + 32 : 1536 + (n0 - 3072));
                transpose_item(a.in[7], DIN, kb * 64, (n0 < DIN) ? ns : 0, (bf16*)(ws + WS_WIN), DM, n0, scr, lane, n0 >= DIN);
            } else { const int r = it - I_IN, nb = r >> 4, kb = r & 15;
                transpose_item(a.in[22], DM, kb * 64, nb * 32, (bf16*)(ws + WS_WOUT), DM, nb * 32, scr, lane, false); }
        }
    }
    for (int e = wg * NTHR + tid; e < 64 * 256; e += G * NTHR) { const int i = e >> 8, j = e & 255;
        const float om = 1.0f / powf(10000.0f, (float)j * (1.0f / 256.0f)); const float er = (float)i * om;
        float* pt = (float*)(ws + WS_POS); pt[i * 512 + j] = sinf(er); pt[i * 512 + 256 + j] = cosf(er); }
}

__device__ __forceinline__ void phase1(const Args& a, LAS unsigned char* lds) {
    const int tid = threadIdx.x, lane = tid & 63, wave = tid >> 6, wg = blockIdx.x, G = gridDim.x;
    unsigned char* ws = a.ws;
    const float* modr = (const float*)(ws + WS_MOD); const float* pt = (const float*)(ws + WS_POS); bf16* ain = (bf16*)(ws + WS_AIN);
    const float* gmix = a.in[6];
    const int NGW = G * NWAVES;
    f32x4 gv[4];
#pragma unroll
    for (int j = 0; j < 4; ++j) gv[j] = *(const f32x4*)(gmix + 4 * lane + 256 * j);
#pragma nounroll
    for (int r0 = wg * NWAVES + wave; r0 < MT; r0 += 4 * NGW) {
        f32x4 v[4][4];
#pragma unroll
        for (int k = 0; k < 4; ++k) { const int r = r0 + k * NGW;
            if (r < MT) { const bool lat = r < MX; const float* src = lat ? a.in[0] + (size_t)r * DM : a.in[2] + (size_t)(r - MX) * DM; const int t = r & 4095, rr = t >> 6, cc = t & 63;
#pragma unroll
                for (int j = 0; j < 4; ++j) { const int col = 4 * lane + 256 * j; v[k][j] = *(const f32x4*)(src + col);
                    if (lat) v[k][j] += (j < 2) ? *(const f32x4*)(pt + rr * 512 + col) : *(const f32x4*)(pt + cc * 512 + col - 512); } } }
#pragma unroll
        for (int k = 0; k < 4; ++k) { const int r = r0 + k * NGW;
            if (r < MT) { const int bb = (r < MX) ? (r >> 12) : 4; float ss = 0.f;
#pragma unroll
                for (int j = 0; j < 4; ++j) ss += v[k][j][0] * v[k][j][0] + v[k][j][1] * v[k][j][1] + v[k][j][2] * v[k][j][2] + v[k][j][3] * v[k][j][3];
                const float rs = rsqrtf(wave_sum(ss) * (1.0f / DM) + EPS);
#pragma unroll
                for (int j = 0; j < 4; ++j) { const int col = 4 * lane + 256 * j;
                    const f32x4 sh = *(const f32x4*)(modr + bb * 6144 + col), sc = *(const f32x4*)(modr + bb * 6144 + 1024 + col);
                    const f32x4 y = (v[k][j] * rs * gv[j]) * (sc + 1.0f) + sh;
                    v2u w; w.x = pk2(y[0], y[1]); w.y = pk2(y[2], y[3]);
                    *(v2u*)(ain + (size_t)r * DM + col) = w; } } }
    }
}

typedef float cpx __attribute__((ext_vector_type(2)));
__device__ __forceinline__ cpx make_cpx(float x, float y) { cpx r; r.x = x; r.y = y; return r; }
__device__ __forceinline__ cpx cmul(cpx a, cpx b) { return make_cpx(a.x * b.x - a.y * b.y, a.x * b.y + a.y * b.x); }
__device__ __forceinline__ cpx cadd(cpx a, cpx b) { return make_cpx(a.x + b.x, a.y + b.y); }
__device__ __forceinline__ cpx csub(cpx a, cpx b) { return make_cpx(a.x - b.x, a.y - b.y); }
__device__ __forceinline__ cpx cconj(cpx a) { return make_cpx(a.x, -a.y); }
__device__ __forceinline__ cpx twid(float turns) { return make_cpx(__builtin_amdgcn_cosf(turns), -__builtin_amdgcn_sinf(turns)); }
__device__ __forceinline__ void dft4(cpx& a0, cpx& a1, cpx& a2, cpx& a3) {
    const cpx t0 = cadd(a0, a2), t1 = csub(a0, a2), t2 = cadd(a1, a3), t3 = csub(a1, a3);
    a0 = cadd(t0, t2); a2 = csub(t0, t2);
    a1 = make_cpx(t1.x + t3.y, t1.y - t3.x);
    a3 = make_cpx(t1.x - t3.y, t1.y + t3.x);
}
__device__ __forceinline__ void dft16(cpx (&v)[16]) {
    cpx t[16];
#pragma unroll
    for (int j = 0; j < 4; ++j) { cpx b0 = v[j], b1 = v[j + 4], b2 = v[j + 8], b3 = v[j + 12]; dft4(b0, b1, b2, b3); t[4 * j] = b0; t[4 * j + 1] = b1; t[4 * j + 2] = b2; t[4 * j + 3] = b3; }
    const float C1 = 0.92387953251f, S1 = 0.38268343236f, R2 = 0.70710678118f;
    const cpx W1 = make_cpx(C1, -S1), W2 = make_cpx(R2, -R2), W3 = make_cpx(S1, -C1), W4 = make_cpx(0.f, -1.f), W6 = make_cpx(-R2, -R2), W9 = make_cpx(-C1, S1);
    {   cpx b0 = t[0], b1 = t[4], b2 = t[8], b3 = t[12]; dft4(b0, b1, b2, b3); v[0] = b0; v[4] = b1; v[8] = b2; v[12] = b3; }
    {   cpx b0 = t[1], b1 = cmul(t[5], W1), b2 = cmul(t[9], W2), b3 = cmul(t[13], W3); dft4(b0, b1, b2, b3); v[1] = b0; v[5] = b1; v[9] = b2; v[13] = b3; }
    {   cpx b0 = t[2], b1 = cmul(t[6], W2), b2 = cmul(t[10], W4), b3 = cmul(t[14], W6); dft4(b0, b1, b2, b3); v[2] = b0; v[6] = b1; v[10] = b2; v[14] = b3; }
    {   cpx b0 = t[3], b1 = cmul(t[7], W3), b2 = cmul(t[11], W6), b3 = cmul(t[15], W9); dft4(b0, b1, b2, b3); v[3] = b0; v[7] = b1; v[11] = b2; v[15] = b3; }
}
#define FPAD(i) ((i) + ((i) >> 4))
constexpr int FFT_STRIDE = 4352;
__device__ __forceinline__ void apply_tw(cpx (&v)[16], cpx w1) {
    asm volatile("" : "+v"(w1.x), "+v"(w1.y));
    cpx w = w1; v[1] = cmul(v[1], w);
#pragma unroll
    for (int q = 2; q < 16; ++q) { w = cmul(w, w1); v[q] = cmul(v[q], w); }
}
__device__ __forceinline__ cpx opaque(cpx w) { asm volatile("" : "+v"(w.x), "+v"(w.y)); return w; }
__device__ __forceinline__ cpx c32(int r) { return make_cpx(__builtin_cosf(0.19634954084936207f * (float)r), -__builtin_sinf(0.19634954084936207f * (float)r)); }

__device__ __forceinline__ void hyena_item(const Args& a, LAS unsigned char* lds, int c, int stage) {
    int tid = threadIdx.x; asm volatile("" : "+v"(tid));
    const int f = tid >> 8, j = tid & 255, blk = j >> 4, jp = j & 15;
    unsigned char* ws = a.ws;
    LAS cpx* buf = (LAS cpx*)lds;
    LAS cpx* bm = buf + f * FFT_STRIDE;
    const int pj = j + blk, p16 = blk * 272 + jp, pc = 17 * j;
    const float* hT = (const float*)(ws + WS_HT);
    const float* hf = hT + ((size_t)(stage * 2 + 0) * 512 + c) * SEQ;
    const float* hb = hT + ((size_t)(stage * 2 + 1) * 512 + c) * SEQ;
    const float* hyT = (const float*)(ws + WS_HYT);
    const float* zT = (const float*)(ws + WS_ZT);
    float* outp = (float*)(ws + (stage == 0 ? WS_ZT : WS_YHYT));
    const float* cw = a.in[13]; const float* cb = a.in[14];
    const int chu = c, chg = (stage == 0 ? 512 : 1024) + c;
    const float wu0 = cw[chu], wu1 = cw[1536 + chu], wu2 = cw[3072 + chu], bu = cb[chu];
    const float wg0 = cw[chg], wg1 = cw[1536 + chg], wg2 = cw[3072 + chg], bg = cb[chg];
    const float bias = a.in[21][stage * 512 + c];
    const cpx wj = twid((float)j * (1.0f / 4096.0f)), wjp = twid((float)jp * (1.0f / 256.0f)), w8_ = twid((float)j * (1.0f / 8192.0f));
    cpx v[16];
    LAS cpx* Hs = buf + 2 * FFT_STRIDE + f * FFT_STRIDE + pc;
    { const cpx w8 = opaque(w8_);
#pragma unroll
    for (int r = 0; r < 16; ++r) { const unsigned n = (unsigned)j + 256u * r; const float fv = hf[n]; const float gq = hb[(SEQ - n) & 4095u]; const float gv = n ? gq : 0.f;
        const cpx wn = cmul(w8, c32(r)); const float d = fv - gv;
        v[r] = f ? make_cpx(d * wn.x, d * wn.y) : make_cpx(fv + gv, 0.f); } }
    dft16(v); apply_tw(v, wj);
#pragma unroll
    for (int q = 0; q < 16; ++q) bm[pj + 272 * q] = v[q];
    __syncthreads();
#pragma unroll
    for (int r = 0; r < 16; ++r) v[r] = bm[p16 + 17 * r];
    dft16(v); apply_tw(v, wjp);
#pragma unroll
    for (int q = 0; q < 16; ++q) bm[p16 + 17 * q] = v[q];
    __syncthreads();
#pragma unroll
    for (int r = 0; r < 16; ++r) v[r] = bm[pc + r];
    dft16(v);
#pragma unroll
    for (int q = 0; q < 16; ++q) Hs[q] = v[q];
    __syncthreads();
#pragma nounroll
    for (int bp = 0; bp < 2; ++bp) {
        const int b0 = 2 * bp, b1 = 2 * bp + 1;
        float uk0[8], uk1[8];
        {   float u0[16], u1[16];
            const unsigned uj = (unsigned)j;
            if (stage == 0) {
                const float* P0 = hyT + ((size_t)b0 * 1536 + chu) * SEQ; const float* P1 = hyT + ((size_t)b1 * 1536 + chu) * SEQ;
#pragma unroll
                for (int r = 0; r < 16; ++r) { const unsigned o = uj + 256u * r; if (r == 4 || r == 8 || r == 12) asm volatile("" ::: "memory");
                    const unsigned ol = (r == 0) ? (j ? uj - 1u : 0u) : o - 1u, orr = (r == 15) ? (j < 255 ? o + 1u : o) : o + 1u;
                    float l0 = P0[ol], l1 = P1[ol], r0 = P0[orr], r1 = P1[orr];
                    if (r == 0) { l0 = j ? l0 : 0.f; l1 = j ? l1 : 0.f; }
                    if (r == 15) { r0 = (j < 255) ? r0 : 0.f; r1 = (j < 255) ? r1 : 0.f; }
                    u0[r] = wu0 * l0 + wu1 * P0[o] + wu2 * r0 + bu; u1[r] = wu0 * l1 + wu1 * P1[o] + wu2 * r1 + bu; }
            } else {
                const float* P0 = zT + ((size_t)b0 * 512 + c) * SEQ; const float* P1 = zT + ((size_t)b1 * 512 + c) * SEQ;
#pragma unroll
                for (int r = 0; r < 16; ++r) { const unsigned o = uj + 256u * r; u0[r] = P0[o]; u1[r] = P1[o]; }
            }
#pragma unroll
            for (int i = 0; i < 8; ++i) { uk0[i] = f ? u0[2 * i + 1] : u0[2 * i]; uk1[i] = f ? u1[2 * i + 1] : u1[2 * i]; }
            const cpx w8 = opaque(w8_);
#pragma unroll
            for (int r = 0; r < 16; ++r) { const cpx x = make_cpx(u0[r], u1[r]); v[r] = f ? cmul(x, cmul(w8, c32(r))) : x; }
        }
        dft16(v); apply_tw(v, wj);
#pragma unroll
        for (int q = 0; q < 16; ++q) bm[pj + 272 * q] = v[q];
        __syncthreads();
#pragma unroll
        for (int r = 0; r < 16; ++r) v[r] = bm[p16 + 17 * r];
        dft16(v); apply_tw(v, wjp);
#pragma unroll
        for (int q = 0; q < 16; ++q) bm[p16 + 17 * q] = v[q];
        __syncthreads();
#pragma unroll
        for (int r = 0; r < 16; ++r) v[r] = bm[pc + r];
        dft16(v);
#pragma unroll
        for (int q = 0; q < 16; ++q) v[q] = cconj(cmul(v[q], Hs[q]));
        dft16(v);
#pragma unroll
        for (int q = 0; q < 16; ++q) bm[pc + q] = v[q];
        __syncthreads();
#pragma unroll
        for (int r = 0; r < 16; ++r) v[r] = bm[p16 + 17 * r];
        apply_tw(v, wjp); dft16(v);
#pragma unroll
        for (int q = 0; q < 16; ++q) bm[p16 + 17 * q] = v[q];
        __syncthreads();
        float gg0[8], gg1[8];
        {   float gt0[8][3], gt1[8][3];
            const float* G0 = hyT + ((size_t)b0 * 1536 + chg) * SEQ; const float* G1 = hyT + ((size_t)b1 * 1536 + chg) * SEQ;
            const unsigned gj = (unsigned)(j + 256 * f);
#pragma unroll
            for (int i = 0; i < 8; ++i) { const unsigned o = gj + 512u * i; if (i == 4) asm volatile("" ::: "memory");
                const unsigned ol = (i == 0) ? (gj ? gj - 1u : 0u) : o - 1u, orr = (i == 7) ? (o < 4095u ? o + 1u : o) : o + 1u;
                gt0[i][0] = G0[ol]; gt0[i][1] = G0[o]; gt0[i][2] = G0[orr]; gt1[i][0] = G1[ol]; gt1[i][1] = G1[o]; gt1[i][2] = G1[orr];
                if (i == 0) { gt0[i][0] = gj ? gt0[i][0] : 0.f; gt1[i][0] = gj ? gt1[i][0] : 0.f; }
                if (i == 7) { gt0[i][2] = (o < 4095u) ? gt0[i][2] : 0.f; gt1[i][2] = (o < 4095u) ? gt1[i][2] : 0.f; } }
#pragma unroll
            for (int r = 0; r < 16; ++r) v[r] = bm[pj + 272 * r];
            apply_tw(v, wj); dft16(v);
#pragma unroll
            for (int q = 0; q < 16; ++q) bm[pj + 272 * q] = v[q];
#pragma unroll
            for (int i = 0; i < 8; ++i) { gg0[i] = wg0 * gt0[i][0] + wg1 * gt0[i][1] + wg2 * gt0[i][2] + bg; gg1[i] = wg0 * gt1[i][0] + wg1 * gt1[i][1] + wg2 * gt1[i][2] + bg; } }
        __syncthreads();
        const cpx w8 = opaque(w8_);
        float* O0 = outp + ((size_t)b0 * 512 + c) * SEQ; float* O1 = outp + ((size_t)b1 * 512 + c) * SEQ;
#pragma unroll
        for (int i = 0; i < 8; ++i) { const int rr = f + 2 * i; const unsigned n = (unsigned)(j + 256 * f) + 512u * i;
            const cpx ye = cconj(buf[pj + 272 * rr]), yo = cconj(buf[FFT_STRIDE + pj + 272 * rr]);
            const cpx wn = cmul(w8, f ? c32(2 * i + 1) : c32(2 * i));
            const cpx y = cadd(ye, cmul(cconj(wn), yo));
            const float y0 = y.x * (1.0f / 8192.0f) + bias * uk0[i], y1 = y.y * (1.0f / 8192.0f) + bias * uk1[i];
                        O0[n] = gg0[i] * y0; O1[n] = gg1[i] * y1; }
        __syncthreads();
    }
}

__device__ __forceinline__ f32x16 mfma32(bf16x8 a, bf16x8 b, f32x16 c) { return __builtin_amdgcn_mfma_f32_32x32x16_bf16(a, b, c, 0, 0, 0); }
typedef short s4v __attribute__((ext_vector_type(4)));
__device__ __forceinline__ bf16x8 tr_frag(const LAS bf16* base, int PT, int k0, int c0, int lane) {
    const int i = lane & 15, q = i >> 2, p = i & 3;
    const LAS bf16* ad = base + (k0 + 8 * (lane >> 5) + q) * PT + c0 + 16 * ((lane >> 4) & 1) + 4 * p;
    const s4v lo = __builtin_amdgcn_ds_read_tr16_b64_v4i16((LAS s4v*)ad);
    const s4v hi = __builtin_amdgcn_ds_read_tr16_b64_v4i16((LAS s4v*)(ad + 4 * PT));
    bf16x8 r; r[0] = lo[0]; r[1] = lo[1]; r[2] = lo[2]; r[3] = lo[3]; r[4] = hi[0]; r[5] = hi[1]; r[6] = hi[2]; r[7] = hi[3]; return r;
}
constexpr int GL_AL = 0, GL_WA = 8192, GL_TOT = 16384, GL_V = 24576, GL_VP = 160;
struct GlaTab { float P[4][2], X[4][2], Ptot[2], Xtot[2], Pref[2], Xref[2]; };
__device__ __forceinline__ void gla_tables(const Args& a, int h, LAS unsigned char* lds, GlaTab& T, int tid) {
    const int d2 = tid & 31, sg = tid >> 5;
    const LAS float* aL = (const LAS float*)(lds + GL_AL); const LAS float* wa = (const LAS float*)(lds + GL_WA); LAS float* tot = (LAS float*)(lds + GL_TOT);
    typedef float f32x2v __attribute__((ext_vector_type(2)));
    const f32x2v bf = *(const f32x2v*)(a.in[9] + h * 64 + 2 * d2), bb = *(const f32x2v*)(a.in[11] + h * 64 + 2 * d2);
    float lf[4][2], lb[4][2];
#pragma unroll
    for (int q = 0; q < 4; ++q) { const int s = sg * 4 + q; float pf0 = bf[0], pf1 = bf[1], pb0 = bb[0], pb1 = bb[1];
#pragma unroll
        for (int j4 = 0; j4 < 4; ++j4) { const f32x4 af = *(const LAS f32x4*)(aL + s * 32 + 4 * j4), ab = *(const LAS f32x4*)(aL + s * 32 + 16 + 4 * j4);
#pragma unroll
            for (int jj = 0; jj < 4; ++jj) { const int j = 4 * j4 + jj; const f32x2v wf = *(const LAS f32x2v*)(wa + j * 64 + 2 * d2), wb = *(const LAS f32x2v*)(wa + 1024 + j * 64 + 2 * d2);
                pf0 += af[jj] * wf[0]; pf1 += af[jj] * wf[1]; pb0 += ab[jj] * wb[0]; pb1 += ab[jj] * wb[1]; } }
        lf[q][0] = logsig_f(pf0) * (1.0f / 16.0f); lf[q][1] = logsig_f(pf1) * (1.0f / 16.0f); lb[q][0] = logsig_f(pb0) * (1.0f / 16.0f); lb[q][1] = logsig_f(pb1) * (1.0f / 16.0f); }
#pragma unroll
    for (int i = 0; i < 2; ++i) { lf[1][i] += lf[0][i]; lf[2][i] += lf[1][i]; lf[3][i] += lf[2][i]; lb[2][i] += lb[3][i]; lb[1][i] += lb[2][i]; lb[0][i] += lb[1][i]; }
    *(LAS f32x2v*)(tot + sg * 64 + 2 * d2) = (f32x2v){lf[3][0], lf[3][1]};
    *(LAS f32x2v*)(tot + 1024 + sg * 64 + 2 * d2) = (f32x2v){lb[0][0], lb[0][1]};
    __syncthreads();
    float of[2] = {0.f, 0.f}, ob[2] = {0.f, 0.f};
    T.Ptot[0] = T.Ptot[1] = T.Xtot[0] = T.Xtot[1] = T.Pref[0] = T.Pref[1] = T.Xref[0] = T.Xref[1] = 0.f;
#pragma unroll
    for (int g = 0; g < 16; ++g) { const f32x2v tf = *(const LAS f32x2v*)(tot + g * 64 + 2 * d2), tb = *(const LAS f32x2v*)(tot + 1024 + g * 64 + 2 * d2);
#pragma unroll
        for (int i = 0; i < 2; ++i) { T.Ptot[i] += tf[i]; T.Xtot[i] += tb[i]; if (g < 8) T.Pref[i] += tf[i]; else T.Xref[i] += tb[i];
            of[i] += (g < sg) ? tf[i] : 0.f; ob[i] += (g > sg) ? tb[i] : 0.f; } }
#pragma unroll
    for (int q = 0; q < 4; ++q)
#pragma unroll
        for (int i = 0; i < 2; ++i) { T.P[q][i] = lf[q][i] + of[i]; T.X[q][i] = lb[q][i] + ob[i]; }
}
__device__ __forceinline__ void gla_stage_common(const Args& a, int h, size_t rowbase, LAS unsigned char* lds, int tid) {
    const float* afb = (const float*)(a.ws + WS_AFB); const bf16* qkvg = (const bf16*)(a.ws + WS_QKVG);
    const f32x4 av = *(const f32x4*)(afb + (rowbase + (tid >> 3)) * 32 + 4 * (tid & 7));
    const int wdir = tid >> 8, wj = (tid >> 4) & 15, wd4 = (tid & 15) * 4;
    const f32x4 wv = *(const f32x4*)((wdir ? a.in[10] : a.in[8]) + wj * 256 + h * 64 + wd4);
    v4u vv[2];
#pragma unroll
    for (int q = 0; q < 2; ++q) { const int idx = tid + NTHR * q; vv[q] = *(const v4u*)(qkvg + (rowbase + (idx >> 4)) * NQ + 512 + h * 128 + (idx & 15) * 8); }
    *(LAS f32x4*)((LAS float*)(lds + GL_AL) + 4 * tid) = av;
    *(LAS f32x4*)((LAS float*)(lds + GL_WA) + wdir * 1024 + wj * 64 + wd4) = wv;
#pragma unroll
    for (int q = 0; q < 2; ++q) { const int idx = tid + NTHR * q; *(LAS v4u*)((LAS bf16*)(lds + GL_V) + (idx >> 4) * GL_VP + (idx & 15) * 8) = vv[q]; }
}

__device__ __forceinline__ void gla_upd_item(const Args& a, LAS unsigned char* lds, int bh, int ci) {
    int tid = threadIdx.x; asm volatile("" : "+v"(tid));
    const int lane = tid & 63, wave = tid >> 6, b = bh >> 2, h = bh & 3, d2 = tid & 31, sg = tid >> 5;
    unsigned char* ws = a.ws;
    constexpr int KP = 96;
    LAS bf16* vN = (LAS bf16*)(lds + GL_V); LAS bf16* kUf = (LAS bf16*)(lds + 45056); LAS bf16* kUb = (LAS bf16*)(lds + 57344);
    const size_t rowbase = (ci < 4) ? (size_t)(MX + b * CTXL + ci * 64) : (size_t)(b * SEQ + (ci - 4) * 64);
    const bf16* qkvg = (const bf16*)(ws + WS_QKVG);
    unsigned kw[4];
#pragma unroll
    for (int q = 0; q < 4; ++q) kw[q] = *(const unsigned*)(qkvg + (rowbase + sg * 4 + q) * NQ + 256 + h * 64 + 2 * d2);
    gla_stage_common(a, h, rowbase, lds, tid);
    __syncthreads();
    GlaTab T; gla_tables(a, h, lds, T, tid);
#pragma unroll
    for (int q = 0; q < 4; ++q) { const int s = sg * 4 + q; const float k0 = bflo(kw[q]), k1 = bfhi(kw[q]);
        *(LAS unsigned*)(kUf + s * KP + 2 * d2) = pk2(k0 * __expf(T.Ptot[0] - T.P[q][0]), k1 * __expf(T.Ptot[1] - T.P[q][1]));
        *(LAS unsigned*)(kUb + s * KP + 2 * d2) = pk2(k0 * __expf(T.Xtot[0] - T.X[q][0]), k1 * __expf(T.Xtot[1] - T.X[q][1])); }
    if (tid < 32) { float* dec = (float*)(ws + WS_DEC);
#pragma unroll
        for (int i = 0; i < 2; ++i) { dec[((size_t)(bh * 2 + 0) * NCH + ci) * 64 + 2 * d2 + i] = __expf(T.Ptot[i]); dec[((size_t)(bh * 2 + 1) * NCH + ci) * 64 + 2 * d2 + i] = __expf(T.Xtot[i]); } }
    __syncthreads();
    { const int dir = wave >> 2, e0 = (wave & 3) * 32, l31 = lane & 31, hh = lane >> 5;
        const LAS bf16* kT = dir ? kUb : kUf;
        float* U = (ci < 4) ? (float*)(ws + WS_UCTX) + ((size_t)(bh * 2 + dir) * 4 + ci) * 8192 : a.out + ((size_t)(bh * 2 + dir) * 64 + (ci - 4)) * 8192;
        bf16x8 A[4];
#pragma unroll
        for (int ks = 0; ks < 4; ++ks) A[ks] = tr_frag(vN, GL_VP, 16 * ks, e0, lane);
#pragma unroll
        for (int dt = 0; dt < 2; ++dt) { const int d0 = dt * 32; f32x16 acc;
#pragma unroll
            for (int i = 0; i < 16; ++i) acc[i] = 0.f;
#pragma unroll
            for (int ks = 0; ks < 4; ++ks) acc = mfma32(A[ks], tr_frag(kT, KP, 16 * ks, d0, lane), acc);
#pragma unroll
            for (int r = 0; r < 16; ++r) { const int e = e0 + (r & 3) + 8 * (r >> 2) + 4 * hh; U[e * 64 + d0 + l31] = acc[r]; } } }
    __syncthreads();
}

__device__ __forceinline__ void gla_scan_item(const Args& a, int it) {
    int tid = threadIdx.x; asm volatile("" : "+v"(tid));
    const int bd = it >> 4, dir = bd & 1, el = ((it & 15) * 8 + (tid >> 6)) * 64 + (tid & 63), d = tid & 63;
    unsigned char* ws = a.ws;
    const float* dec = (const float*)(ws + WS_DEC) + (size_t)bd * NCH * 64 + d;
    const float* Uc = (const float*)(ws + WS_UCTX) + (size_t)bd * 4 * 8192 + el;
    const float* U = a.out + (size_t)bd * 64 * 8192 + el;
    bf16* Sp = (bf16*)(ws + WS_SPREV) + (size_t)bd * 64 * 8192 + el;
    float S = 0.f;
#pragma unroll
    for (int c4 = 0; c4 < 4; ++c4) { const int ci = dir ? 3 - c4 : c4; S = dec[ci * 64] * S + Uc[(size_t)ci * 8192]; }
#pragma unroll
    for (int blk = 0; blk < 2; ++blk) { float uu[32], dd[32];
#pragma unroll
        for (int j = 0; j < 32; ++j) { const int n = dir ? 63 - (blk * 32 + j) : blk * 32 + j; uu[j] = U[(size_t)n * 8192]; dd[j] = dec[(4 + n) * 64]; }
#pragma unroll
        for (int j = 0; j < 32; ++j) { const int n = dir ? 63 - (blk * 32 + j) : blk * 32 + j; Sp[(size_t)n * 8192] = (bf16)f2bf(S); S = dd[j] * S + uu[j]; } }
}

__device__ __forceinline__ void gla_out_item(const Args& a, LAS unsigned char* lds, int bh, int n) {
    int tid = threadIdx.x; asm volatile("" : "+v"(tid));
    const int lane = tid & 63, wave = tid >> 6, b = bh >> 2, h = bh & 3, l31 = lane & 31, hh = lane >> 5, d2 = tid & 31, sg = tid >> 5;
    unsigned char* ws = a.ws;
    LAS bf16* Scat = (LAS bf16*)lds;
    LAS bf16* vN = (LAS bf16*)(lds + GL_V);
    LAS bf16* qf = (LAS bf16*)(lds + 45056); LAS bf16* qb = qf + 4608; LAS bf16* kf = qf + 2 * 4608; LAS bf16* kb = qf + 3 * 4608;
    LAS float* oS = (LAS float*)(lds + 45056);
    LAS bf16* qS = (LAS bf16*)(lds + 81920);
    LAS bf16* Sp = (LAS bf16*)(lds + 99328);
    const size_t rowbase = (size_t)b * SEQ + n * 64;
    const bf16* qkvg = (const bf16*)(ws + WS_QKVG);
    unsigned qw[4], kw[4];
#pragma unroll
    for (int q = 0; q < 4; ++q) { const bf16* rp = qkvg + (rowbase + sg * 4 + q) * NQ + h * 64 + 2 * d2; qw[q] = *(const unsigned*)rp; kw[q] = *(const unsigned*)(rp + 256); }
    { const bf16* spf = (const bf16*)(ws + WS_SPREV) + ((size_t)(bh * 2 + 0) * 64 + n) * 8192; const bf16* spb = (const bf16*)(ws + WS_SPREV) + ((size_t)(bh * 2 + 1) * 64 + n) * 8192;
        v4u sv[4];
#pragma unroll
        for (int q = 0; q < 4; ++q) { const int idx = tid + NTHR * q, dir = idx >> 10, e = (idx >> 3) & 127, d8 = (idx & 7) * 8; sv[q] = *(const v4u*)((dir ? spb : spf) + e * 64 + d8); }
        gla_stage_common(a, h, rowbase, lds, tid);
#pragma unroll
        for (int q = 0; q < 4; ++q) { const int idx = tid + NTHR * q, dir = idx >> 10, e = (idx >> 3) & 127, d8 = (idx & 7) * 8; *(LAS v4u*)(Sp + e * 136 + dir * 64 + d8) = sv[q]; } }
    __syncthreads();
    GlaTab T; gla_tables(a, h, lds, T, tid);
#pragma unroll
    for (int q = 0; q < 4; ++q) { const int s = sg * 4 + q; const float q0 = bflo(qw[q]), q1 = bfhi(qw[q]), k0 = bflo(kw[q]), k1 = bfhi(kw[q]);
        *(LAS unsigned*)(qf + s * 72 + 2 * d2) = pk2(q0 * __expf(T.P[q][0] - T.Pref[0]), q1 * __expf(T.P[q][1] - T.Pref[1]));
        *(LAS unsigned*)(kf + s * 72 + 2 * d2) = pk2(k0 * __expf(T.Pref[0] - T.P[q][0]), k1 * __expf(T.Pref[1] - T.P[q][1]));
        *(LAS unsigned*)(qb + s * 72 + 2 * d2) = pk2(q0 * __expf(T.X[q][0] - T.Xref[0]), q1 * __expf(T.X[q][1] - T.Xref[1]));
        *(LAS unsigned*)(kb + s * 72 + 2 * d2) = pk2(k0 * __expf(T.Xref[0] - T.X[q][0]), k1 * __expf(T.Xref[1] - T.X[q][1]));
        *(LAS unsigned*)(qS + s * 136 + 2 * d2) = pk2(q0 * __expf(T.P[q][0]), q1 * __expf(T.P[q][1]));
        *(LAS unsigned*)(qS + s * 136 + 64 + 2 * d2) = pk2(q0 * __expf(T.X[q][0]), q1 * __expf(T.X[q][1])); }
    __syncthreads();
    { const int dir = wave >> 2, c0 = ((wave >> 1) & 1) * 32, s0 = (wave & 1) * 32;
        const LAS bf16* qq = dir ? qb : qf; const LAS bf16* kk = dir ? kb : kf;
        f32x16 acc;
#pragma unroll
        for (int i = 0; i < 16; ++i) acc[i] = 0.f;
#pragma unroll
        for (int ks = 0; ks < 4; ++ks) { const bf16x8 A = *(const LAS bf16x8*)(qq + (c0 + l31) * 72 + 16 * ks + 8 * hh), B = *(const LAS bf16x8*)(kk + (s0 + l31) * 72 + 16 * ks + 8 * hh);
            acc = mfma32(A, B, acc); }
        const int s = s0 + l31;
#pragma unroll
        for (int r = 0; r < 16; ++r) { const int c = c0 + (r & 3) + 8 * (r >> 2) + 4 * hh; const bool keep = dir ? (s >= c) : (s <= c);
            Scat[c * 136 + dir * 64 + s] = (bf16)f2bf(keep ? acc[r] : 0.f); } }
    __syncthreads();
    { const int c0 = (wave >> 2) * 32, e0 = (wave & 3) * 32;
        f32x16 acc;
#pragma unroll
        for (int i = 0; i < 16; ++i) acc[i] = 0.f;
#pragma unroll
        for (int ks = 0; ks < 8; ++ks) { const bf16x8 A = *(const LAS bf16x8*)(Scat + (c0 + l31) * 136 + 16 * ks + 8 * hh);
            acc = mfma32(A, tr_frag(vN, GL_VP, 16 * (ks & 3), e0, lane), acc); }
#pragma unroll
        for (int ks = 0; ks < 8; ++ks) { const bf16x8 A = *(const LAS bf16x8*)(qS + (c0 + l31) * 136 + 16 * ks + 8 * hh), B = *(const LAS bf16x8*)(Sp + (e0 + l31) * 136 + 16 * ks + 8 * hh);
            acc = mfma32(A, B, acc); }
#pragma unroll
        for (int r = 0; r < 16; ++r) { const int c = c0 + (r & 3) + 8 * (r >> 2) + 4 * hh; oS[c * 132 + e0 + l31] = acc[r]; } }
    __syncthreads();
    { const int row = tid >> 3, ec = (tid & 7) * 16; float v[16]; float ss = 0.f;
#pragma unroll
        for (int j = 0; j < 16; ++j) { v[j] = oS[row * 132 + ec + j]; ss += v[j] * v[j]; }
        ss += __shfl_xor(ss, 1); ss += __shfl_xor(ss, 2); ss += __shfl_xor(ss, 4);
        const float rs = rsqrtf(ss * (1.0f / 128.0f) + EPS);
        const bf16* gp = qkvg + (rowbase + row) * NQ + 1024 + h * 128 + ec; const v4u g0 = *(const v4u*)gp, g1 = *(const v4u*)(gp + 8);
        const float gv[16] = {bflo(g0.x), bfhi(g0.x), bflo(g0.y), bfhi(g0.y), bflo(g0.z), bfhi(g0.z), bflo(g0.w), bfhi(g0.w), bflo(g1.x), bfhi(g1.x), bflo(g1.y), bfhi(g1.y), bflo(g1.z), bfhi(g1.z), bflo(g1.w), bfhi(g1.w)};
        float o[16];
#pragma unroll
        for (int j = 0; j < 16; ++j) o[j] = DBG_GLA_K * v[j] * rs * a.in[12][ec + j] * silu_f(gv[j]);
        bf16* op = (bf16*)(ws + WS_AOUT) + (rowbase + row) * DM + h * 128 + ec;
        *(v4u*)op = (v4u){pk2(o[0], o[1]), pk2(o[2], o[3]), pk2(o[4], o[5]), pk2(o[6], o[7])};
        *(v4u*)(op + 8) = (v4u){pk2(o[8], o[9]), pk2(o[10], o[11]), pk2(o[12], o[13]), pk2(o[14], o[15])}; }
    __syncthreads();
}

__device__ __forceinline__ void hy_transpose_item(const Args& a, LAS unsigned char* lds, int it) {
    const int tid = threadIdx.x, b = it >> 6, t0 = (it & 63) * 64;
    LAS float* tile = (LAS float*)lds;
    const float* src = (const float*)(a.ws + WS_YHYT) + (size_t)b * 512 * SEQ + t0;
    bf16* dst = (bf16*)(a.ws + WS_AOUT) + ((size_t)b * SEQ + t0) * DM + 512;
    for (int half = 0; half < 2; ++half) {
#pragma unroll 8
        for (int q = 0; q < 32; ++q) { const int idx = tid + NTHR * q, c = idx >> 6, tt = idx & 63; tile[c * 65 + tt] = src[(size_t)(half * 256 + c) * SEQ + tt]; }
        __syncthreads();
#pragma unroll
        for (int q = 0; q < 4; ++q) { const int idx = tid + NTHR * q, t = idx >> 5, c8 = (idx & 31) * 8; const LAS float* s = tile + c8 * 65 + t;
            *(v4u*)(dst + (size_t)t * DM + half * 256 + c8) = (v4u){pk2(s[0], s[65]), pk2(s[2 * 65], s[3 * 65]), pk2(s[4 * 65], s[5 * 65]), pk2(s[6 * 65], s[7 * 65])}; }
        __syncthreads();
    }
}

__device__ __forceinline__ void phase_router(const Args& a, LAS unsigned char* lds) {
    const int tid = threadIdx.x, lane = tid & 63, wave = tid >> 6, wg = blockIdx.x, G = gridDim.x;
    unsigned char* ws = a.ws;
    LAS float* wr = (LAS float*)lds;
    for (int i = tid; i < 4096; i += NTHR) { const int l = i & 63, q = (i >> 6) & 3, j = (i >> 8) & 3, e4 = i >> 10;
        *(LAS f32x4*)(wr + 4 * i) = *(const f32x4*)(a.in[24] + (4 * l + 256 * j + q) * 16 + 4 * e4); }
    __syncthreads();
    const float* modr = (const float*)(ws + WS_MOD); const float* gffn = a.in[23];
    bf16* hn = (bf16*)(ws + WS_HN); float* aff = (float*)(ws + WS_AFF);
    const int NGW = G * NWAVES;
    f32x4 gv[4];
#pragma unroll
    for (int j = 0; j < 4; ++j) gv[j] = *(const f32x4*)(gffn + 4 * lane + 256 * j);
#pragma nounroll
    for (int r0 = wg * NWAVES + wave; r0 < MX; r0 += 2 * NGW) {
        const int r1 = r0 + NGW; const bool ok1 = r1 < MX; const int rB = ok1 ? r1 : r0;
        int lane_o = lane; asm volatile("" : "+v"(lane_o));
        f32x4 v[2][4];
#pragma unroll
        for (int j = 0; j < 4; ++j) { v[0][j] = *(const f32x4*)(a.out + (size_t)r0 * DM + 4 * lane + 256 * j); v[1][j] = *(const f32x4*)(a.out + (size_t)rB * DM + 4 * lane + 256 * j); }
        float rs[2];
#pragma unroll
        for (int k = 0; k < 2; ++k) { float ss = 0.f;
#pragma unroll
            for (int j = 0; j < 4; ++j) ss += v[k][j][0] * v[k][j][0] + v[k][j][1] * v[k][j][1] + v[k][j][2] * v[k][j][2] + v[k][j][3] * v[k][j][3];
            rs[k] = rsqrtf(wave_sum(ss) * (1.0f / DM) + EPS); }
        float lg[2][16];
#pragma unroll
        for (int k = 0; k < 2; ++k)
#pragma unroll
            for (int e = 0; e < 16; ++e) lg[k][e] = 0.f;
#pragma unroll
        for (int j = 0; j < 4; ++j) { const int col = 4 * lane + 256 * j; f32x4 y[2];
#pragma unroll
            for (int k = 0; k < 2; ++k) { const int r = k ? rB : r0, b = r >> 12;
                const f32x4 sh = *(const f32x4*)(modr + b * 6144 + 3072 + col), sc = *(const f32x4*)(modr + b * 6144 + 4096 + col);
                y[k] = (v[k][j] * rs[k] * gv[j]) * (sc + 1.0f) + sh;
                v2u w; w.x = pk2(y[k][0], y[k][1]); w.y = pk2(y[k][2], y[k][3]);
                if (k == 0 || ok1) *(v2u*)(hn + (size_t)r * DM + col) = w; }
#pragma unroll
            for (int q = 0; q < 4; ++q) {
#pragma unroll
                for (int e4 = 0; e4 < 4; ++e4) { const f32x4 ww = *(const LAS f32x4*)(wr + 4 * ((((e4 * 4 + j) * 4 + q) << 6) + lane_o));
#pragma unroll
                    for (int s = 0; s < 4; ++s) { lg[0][e4 * 4 + s] += y[0][q] * ww[s]; lg[1][e4 * 4 + s] += y[1][q] * ww[s]; } }
#define PIN16(x) asm volatile("" : "+v"(x[0]), "+v"(x[1]), "+v"(x[2]), "+v"(x[3]), "+v"(x[4]), "+v"(x[5]), "+v"(x[6]), "+v"(x[7]), "+v"(x[8]), "+v"(x[9]), "+v"(x[10]), "+v"(x[11]), "+v"(x[12]), "+v"(x[13]), "+v"(x[14]), "+v"(x[15]) :: "memory")
                PIN16(lg[0]); PIN16(lg[1]); } }
#undef PIN16
        const bool h5 = (lane & 32) != 0, h4 = (lane & 16) != 0, h3 = (lane & 8) != 0, h2 = (lane & 4) != 0;
        const int ex = (h5 ? 8 : 0) + (h4 ? 4 : 0) + (h3 ? 2 : 0) + (h2 ? 1 : 0);
#pragma unroll
        for (int k = 0; k < 2; ++k) { float k8[8], k4[4], k2[2], lgt;
#pragma unroll
            for (int i = 0; i < 8; ++i) { const float snd = h5 ? lg[k][i] : lg[k][8 + i], kp = h5 ? lg[k][8 + i] : lg[k][i]; k8[i] = kp + __shfl_xor(snd, 32); }
#pragma unroll
            for (int i = 0; i < 4; ++i) { const float snd = h4 ? k8[i] : k8[4 + i], kp = h4 ? k8[4 + i] : k8[i]; k4[i] = kp + __shfl_xor(snd, 16); }
#pragma unroll
            for (int i = 0; i < 2; ++i) { const float snd = h3 ? k4[i] : k4[2 + i], kp = h3 ? k4[2 + i] : k4[i]; k2[i] = kp + __shfl_xor(snd, 8); }
            { const float snd = h2 ? k2[0] : k2[1], kp = h2 ? k2[1] : k2[0]; lgt = kp + __shfl_xor(snd, 4); }
            lgt += __shfl_xor(lgt, 2); lgt += __shfl_xor(lgt, 1);
            float mx = lgt;
            mx = fmaxf(mx, __shfl_xor(mx, 4)); mx = fmaxf(mx, __shfl_xor(mx, 8)); mx = fmaxf(mx, __shfl_xor(mx, 16)); mx = fmaxf(mx, __shfl_xor(mx, 32));
            const float pe = expf(lgt - mx);
            float sum = pe;
            sum += __shfl_xor(sum, 4); sum += __shfl_xor(sum, 8); sum += __shfl_xor(sum, 16); sum += __shfl_xor(sum, 32);
            const int r = k ? rB : r0;
            if ((lane & 3) == 0 && (k == 0 || ok1)) aff[((size_t)(r >> 12) * NE + ex) * SEQ + (r & 4095)] = pe / sum; }
    }
}

__device__ __forceinline__ void block_excl_scan2(int& va, int& vb, LAS int* tmp) {
    const int tid = threadIdx.x, lane = tid & 63, wave = tid >> 6;
    int ia = va, ib = vb;
#pragma unroll
    for (int o = 1; o < 64; o <<= 1) { const int ta = __shfl_up(ia, o), tb = __shfl_up(ib, o); if (lane >= o) { ia += ta; ib += tb; } }
    if (lane == 63) { tmp[wave] = ia; tmp[8 + wave] = ib; }
    __syncthreads();
    int oa = 0, ob = 0;
#pragma unroll
    for (int w = 0; w < 8; ++w) { if (w < wave) { oa += tmp[w]; ob += tmp[8 + w]; } }
    va = oa + ia - va; vb = ob + ib - vb;
    __syncthreads();
}
__device__ __forceinline__ void topk_item(const Args& a, LAS unsigned char* lds, int be) {
    const int tid = threadIdx.x, b = be >> 4, e = be & 15;
    unsigned char* ws = a.ws;
    LAS unsigned* keys = (LAS unsigned*)lds;
    LAS unsigned* hist = (LAS unsigned*)(lds + 16384);
    LAS int* ctl = (LAS int*)(lds + 16384 + 1024);
    LAS int* tmp = (LAS int*)(lds + 16384 + 1024 + 64);
    const float* aff = (const float*)(ws + WS_AFF) + (size_t)be * SEQ;
    unsigned my[8];
#pragma unroll
    for (int i = 0; i < 8; ++i) { my[i] = __float_as_uint(aff[tid * 8 + i]); keys[tid * 8 + i] = my[i]; }
    unsigned prefix = 0u, mask = 0u; int need = CAP;
    for (int pass = 0; pass < 4; ++pass) {
        const int shift = 24 - 8 * pass;
        if (tid < 256) hist[tid] = 0u;
        __syncthreads();
#pragma unroll
        for (int i = 0; i < 8; ++i) if ((my[i] & mask) == prefix) atomicAdd((unsigned*)&hist[(my[i] >> shift) & 255u], 1u);
        __syncthreads();
        {
            int hv = (tid < 256) ? (int)hist[255 - tid] : 0, inc = hv;
#pragma unroll
            for (int o = 1; o < 64; o <<= 1) { const int t2 = __shfl_up(inc, o); if ((tid & 63) >= o) inc += t2; }
            if ((tid & 63) == 63) tmp[tid >> 6] = inc;
            __syncthreads();
            int off = 0;
#pragma unroll
            for (int w = 0; w < 4; ++w) if (w < (tid >> 6)) off += tmp[w];
            inc += off;
            if (tid < 256 && inc >= need && inc - hv < need) { ctl[0] = 255 - tid; ctl[1] = need - (inc - hv); }
        }
        __syncthreads();
        prefix |= ((unsigned)ctl[0]) << shift; mask |= 255u << shift; need = ctl[1];
        __syncthreads();
    }
    const unsigned T = prefix;
    int cg = 0, ce = 0;
#pragma unroll
    for (int i = 0; i < 8; ++i) { cg += (my[i] > T) ? 1 : 0; ce += (my[i] == T) ? 1 : 0; }
    int pg = cg, pe = ce;
    block_excl_scan2(pg, pe, tmp);
    int* slot_of = (int*)(ws + WS_SLOT) + (size_t)be * SEQ;
    int* selt = (int*)(ws + WS_SELT) + (e * 4 + b) * CAP; float* selv = (float*)(ws + WS_SELV) + (e * 4 + b) * CAP;
#pragma unroll
    for (int i = 0; i < 8; ++i) { const int t = tid * 8 + i; const bool gt = my[i] > T, eq = my[i] == T; const bool sel = gt || (eq && pe < need);
        const int slot = pg + (pe < need ? pe : need);
        slot_of[t] = sel ? slot : -1;
        if (sel) { selt[slot] = t; selv[slot] = __uint_as_float(my[i]); }
        pg += gt ? 1 : 0; pe += eq ? 1 : 0; }
    __syncthreads();
}
__device__ __forceinline__ void phase_topk(const Args& a, LAS unsigned char* lds) {
    const int tid = threadIdx.x, lane = tid & 63, wave = tid >> 6, wg = blockIdx.x, G = gridDim.x;
    unsigned char* ws = a.ws;
    for (int it = wg; it < NB * NE; it += G) topk_item(a, lds, it);
    LAS float* scr = (LAS float*)(lds + 32768 + wave * 8448);
    for (int it = wg * NWAVES + wave; it < 48 * 512; it += G * NWAVES) {
        const int mat = it >> 9, r = it & 511, nb = r >> 4, kb = r & 15, e = mat / 3, kind = mat % 3, n0 = nb * 32;
        if (kind < 2) transpose_item((kind ? a.in[26] : a.in[25]) + (size_t)e * DM * DM, DM, kb * 64, n0, (bf16*)(ws + WS_WGU) + (size_t)e * 2048 * DM, DM, (n0 >> 7) * 256 + kind * 128 + (n0 & 127), scr, lane, false);
        else transpose_item(a.in[27] + (size_t)e * DM * DM, DM, kb * 64, n0, (bf16*)(ws + WS_WD) + (size_t)e * DM * DM, DM, n0, scr, lane, false);
    }
}

__device__ __forceinline__ void phase_final(const Args& a) {
    const int tid = threadIdx.x, lane = tid & 63, wave = tid >> 6, wg = blockIdx.x, G = gridDim.x;
    unsigned char* ws = a.ws;
    const float* modr = (const float*)(ws + WS_MOD); const int* slot_of = (const int*)(ws + WS_SLOT); const bf16* ys = (const bf16*)(ws + WS_YSLAB);
    const int NGW = G * NWAVES;
    f32x4 gf[4];
#pragma unroll
    for (int j = 0; j < 4; ++j) gf[j] = *(const f32x4*)(a.in[28] + 4 * lane + 256 * j);
#pragma nounroll
    for (int r0 = wg * NWAVES + wave; r0 < MX; r0 += 4 * NGW) {
        int sv[4]; unsigned long long mk[4]; f32x4 v[4][4], m[4][4];
#pragma unroll
        for (int k = 0; k < 4; ++k) { const int r = r0 + k * NGW; const bool ok = r < MX; const int rc = ok ? r : r0, b = rc >> 12, t = rc & 4095;
            sv[k] = (lane < NE) ? slot_of[((size_t)b * NE + lane) * SEQ + t] : -1;
#pragma unroll
            for (int j = 0; j < 4; ++j) { v[k][j] = *(const f32x4*)(a.out + (size_t)rc * DM + 4 * lane + 256 * j); m[k][j] = (f32x4){0.f, 0.f, 0.f, 0.f}; }
            mk[k] = (ok && !DBG_NOMOE) ? __ballot(sv[k] >= 0) : 0ull; }
        while (mk[0] | mk[1] | mk[2] | mk[3]) {
            v2u w[4][4]; float wt[4];
#pragma unroll
            for (int k = 0; k < 4; ++k) { const bool has = mk[k] != 0ull; const int e = has ? (int)__ffsll((long long)mk[k]) - 1 : 0; mk[k] &= mk[k] - 1ull;
                const int rc = (r0 + k * NGW < MX) ? r0 + k * NGW : r0; const int sl = has ? __builtin_amdgcn_readlane(sv[k], e) : 0;
                const bf16* yp = ys + ((size_t)e * 2048 + (rc >> 12) * CAP + sl) * DM; wt[k] = has ? 1.f : 0.f;
#pragma unroll
                for (int j = 0; j < 4; ++j) w[k][j] = *(const v2u*)(yp + 4 * lane + 256 * j); }
#pragma unroll
            for (int k = 0; k < 4; ++k)
#pragma unroll
                for (int j = 0; j < 4; ++j) { m[k][j][0] += wt[k] * bflo(w[k][j].x); m[k][j][1] += wt[k] * bfhi(w[k][j].x); m[k][j][2] += wt[k] * bflo(w[k][j].y); m[k][j][3] += wt[k] * bfhi(w[k][j].y); }
        }
#pragma unroll
        for (int k = 0; k < 4; ++k) { const int r = r0 + k * NGW;
            if (r < MX) { const int b = r >> 12; float ss = 0.f; float* row = a.out + (size_t)r * DM;
#pragma unroll
                for (int j = 0; j < 4; ++j) { const int col = 4 * lane + 256 * j; v[k][j] = v[k][j] + *(const f32x4*)(modr + b * 6144 + 5120 + col) * m[k][j] * DBG_MOE_K;
                    ss += v[k][j][0] * v[k][j][0] + v[k][j][1] * v[k][j][1] + v[k][j][2] * v[k][j][2] + v[k][j][3] * v[k][j][3]; }
                const float rs = rsqrtf(wave_sum(ss) * (1.0f / DM) + EPS);
#pragma unroll
                for (int j = 0; j < 4; ++j) *(f32x4*)(row + 4 * lane + 256 * j) = v[k][j] * rs * gf[j]; } }
    }
}

__global__ void __launch_bounds__(NTHR, 2) fwd_kernel(Args a) {
    extern __shared__ __attribute__((aligned(16))) unsigned char lds_raw[];
    LAS unsigned char* lds = (LAS unsigned char*)lds_raw;
    const int tid = threadIdx.x, wg = blockIdx.x, G = gridDim.x;
    unsigned char* ws = a.ws;
    volatile LAS unsigned* MISC = (volatile LAS unsigned*)(lds + LDS_MISC);
    if (tid < 64) MISC[tid] = 0u;
    __syncthreads();
    XcdBarrier bar; bar.bar = (unsigned*)(ws + WS_CTL); bar.x = 0; bar.st = nullptr;
    if (a.ph_hi - a.ph_lo > 1) bar = xcd_barrier_post((unsigned*)(ws + WS_CTL), MISC + 8);
#ifndef PH_ONLY
#define PH_ONLY -1
#endif
#define IN(k) ((PH_ONLY < 0 || PH_ONLY == (k)) && a.ph_lo <= (k) && (k) < a.ph_hi)
#define SEAM(k) do { if (IN(k) && IN((k) + 1)) xcd_barrier(bar); } while (0)
#ifndef DBG_DUP
#define DBG_DUP -1
#endif
#define REP(k) for (int _rep = 0; _rep < ((DBG_DUP == (k)) ? 2 : 1); ++_rep, (void)((DBG_DUP == (k) && _rep == 1) ? (xcd_barrier(bar), 0) : 0))
    if (IN(0)) REP(0) { phase0(a, lds); } SEAM(0);
    if (IN(1)) REP(1) { phase1(a, lds); } SEAM(1);
    if (IN(2)) REP(2) {
        pg8::Gemm g{(const pg8::bf16_t*)(ws + WS_AIN), (const pg8::bf16_t*)(ws + WS_WIN), MT, NIN, DM}; InSched S; S.init(G, wg);
        EpiIn E{(bf16*)(ws + WS_QKVG), (float*)(ws + WS_HYT), (float*)(ws + WS_AFB)};
        pg8::gemm_phase<EpiIn, InSched, true, true>(lds, g, S, E);
    } SEAM(2);
    if (IN(3)) REP(3) {
        for (int it = wg; it < 512 + 16 * NCH; it += G) { if (it < 512) hyena_item(a, lds, it, 0); else { const int r = it - 512; gla_upd_item(a, lds, r / NCH, r % NCH); } }
    } SEAM(3);
    if (IN(4)) REP(4) {
        for (int it = wg; it < 1024; it += G) { if (it < 512) hyena_item(a, lds, it, 1); else gla_scan_item(a, it - 512); }
    } SEAM(4);
    if (IN(5)) REP(5) {
        for (int it = wg; it < 1280; it += G) { if (it < 1024) gla_out_item(a, lds, it >> 6, it & 63); else hy_transpose_item(a, lds, it - 1024); }
    } SEAM(5);
    if (IN(6)) REP(6) {
        pg8::Gemm g{(const pg8::bf16_t*)(ws + WS_AOUT), (const pg8::bf16_t*)(ws + WS_WOUT), MX, DM, DM}; pg8::StaticOrder S; S.init(MX, DM, G, wg);
        EpiOut E{a.in[0], (const float*)(ws + WS_POS), (const float*)(ws + WS_MOD), a.out};
        pg8::gemm_phase<EpiOut, pg8::StaticOrder, true, true>(lds, g, S, E);
    } SEAM(6);
    if (IN(7)) REP(7) { phase_router(a, lds); } SEAM(7);
    if (IN(8)) REP(8) { phase_topk(a, lds); } SEAM(8);
    if (IN(9)) REP(9) {
        pg8::Gemm g{(const pg8::bf16_t*)(ws + WS_HN), (const pg8::bf16_t*)(ws + WS_WGU), NE * 2048, NE * 2048, DM}; MoeSched<8> S; S.init(G, wg);
        EpiGU E{(bf16*)(ws + WS_HID)};
        pg8::gemm_phase_gather<EpiGU, MoeSched<8>, true, true>(lds, g, S, E, (const int*)(ws + WS_SELT));
    } SEAM(9);
    if (IN(10)) REP(10) {
        pg8::Gemm g{(const pg8::bf16_t*)(ws + WS_HID), (const pg8::bf16_t*)(ws + WS_WD), NE * 2048, NE * 1024, DM}; MoeSched<4> S; S.init(G, wg);
        EpiDown E{(bf16*)(ws + WS_YSLAB), (const float*)(ws + WS_SELV)};
        pg8::gemm_phase<EpiDown, MoeSched<4>, true, true>(lds, g, S, E);
    } SEAM(10);
    if (IN(11)) { phase_final(a); }
#undef IN
#undef SEAM
}


#ifdef DBG_STATE
__global__ void chk_kernel(const unsigned* p, size_t nwords, unsigned long long* out) {
    unsigned long long s = 0ull;
    for (size_t i = (size_t)blockIdx.x * blockDim.x + threadIdx.x; i < nwords; i += (size_t)gridDim.x * blockDim.x) s += (unsigned long long)p[i] * (2ull * i + 1ull);
    for (int o = 1; o < 64; o <<= 1) s += __shfl_xor(s, o);
    if ((threadIdx.x & 63) == 0) atomicAdd(out, s);
}
__global__ void report_kernel(const unsigned long long* chk, float* out, int n) {
    int bad = -1;
    for (int p = 0; p < 27; ++p) if (chk[p] != chk[32 + p]) { bad = p; break; }
    if (bad < 0) return;
    for (int i = blockIdx.x * blockDim.x + threadIdx.x; i < n; i += gridDim.x * blockDim.x) out[i] = 1000.f * (float)(bad + 1);
}
struct ChkEnt { int ph; size_t off; size_t bytes; };
#endif
extern "C" void kernel_launch(void* const* d_in, const int* in_sizes, int n_in, void* d_out, int out_size, void* d_ws, size_t ws_size, hipStream_t stream) {
    static int grid = 0;
    if (grid == 0) {
        if (n_in != 29 || out_size != MX * DM || ws_size < WS_END) { fprintf(stderr, "kernel_launch: unexpected shapes (n_in %d out %d ws %zu)\n", n_in, out_size, ws_size); grid = -1; return; }
        int dev = 0, cus = 0, per_cu = 0;
        if (hipGetDevice(&dev) != hipSuccess || hipDeviceGetAttribute(&cus, hipDeviceAttributeMultiprocessorCount, dev) != hipSuccess) { grid = -1; return; }
        if (hipFuncSetAttribute((const void*)fwd_kernel, hipFuncAttributeMaxDynamicSharedMemorySize, LDS_BYTES) != hipSuccess) { fprintf(stderr, "kernel_launch: hipFuncSetAttribute failed\n"); grid = -1; return; }
        if (hipOccupancyMaxActiveBlocksPerMultiprocessor(&per_cu, (const void*)fwd_kernel, NTHR, LDS_BYTES) != hipSuccess || per_cu < 1) fprintf(stderr, "kernel_launch: occupancy query reports %d\n", per_cu);
        (void)hipGetLastError();
        grid = cus;
    }
    if (grid < 0) return;
    (void)hipMemsetAsync((char*)d_ws + WS_CTL, 0, CTL_BYTES, stream);
    Args a{};
    for (int i = 0; i < 29; ++i) a.in[i] = (const float*)d_in[i];
    a.out = (float*)d_out; a.ws = (unsigned char*)d_ws;
#if MK_SINGLE
    a.ph_lo = 0; a.ph_hi = NPH;
    hipLaunchKernelGGL(fwd_kernel, dim3(grid), dim3(NTHR), LDS_BYTES, stream, a);
#else
#ifdef DBG_STATE
    static const ChkEnt ents[] = { {0, WS_MOD, 122880}, {0, WS_POS, 131072}, {0, WS_HT, 32 * MiB}, {0, WS_WIN, (size_t)NIN * DM * 2}, {0, WS_WOUT, 2 * MiB},
        {1, WS_AIN, 34 * MiB}, {2, WS_QKVG, (size_t)MX * NQ * 2}, {2, WS_HYT, 96 * MiB}, {2, WS_AFB, (size_t)MT * 128},
        {3, WS_ZT, 32 * MiB}, {3, WS_DEC, (size_t)16 * 2 * NCH * 64 * 4}, {3, WS_UCTX, 4 * MiB}, {3, (size_t)-1, 64 * MiB},
        {4, WS_SPREV, 32 * MiB}, {4, WS_YHYT, 32 * MiB}, {5, WS_AOUT, 32 * MiB}, {6, (size_t)-1, 64 * MiB}, {7, WS_HN, 32 * MiB}, {7, WS_AFF, 1 * MiB},
        {8, WS_SLOT, 1 * MiB}, {8, WS_SELT, 131072}, {8, WS_SELV, 131072}, {8, WS_WGU, 64 * MiB}, {8, WS_WD, 32 * MiB}, {9, WS_HID, 64 * MiB}, {10, WS_YSLAB, 64 * MiB}, {11, (size_t)-1, 64 * MiB} };
    unsigned long long* chk = (unsigned long long*)((char*)d_ws + 32768);
    for (int run = 0; run < 2; ++run)
        for (int p = 0; p < NPH; ++p) { a.ph_lo = p; a.ph_hi = p + 1; hipLaunchKernelGGL(fwd_kernel, dim3(grid), dim3(NTHR), LDS_BYTES, stream, a);
            for (const ChkEnt& e : ents) if (e.ph == p) hipLaunchKernelGGL(chk_kernel, dim3(1024), dim3(256), 0, stream, (const unsigned*)(e.off == (size_t)-1 ? (char*)d_out : (char*)d_ws + e.off), e.bytes / 4, chk + run * 32 + (int)(&e - ents)); }
    hipLaunchKernelGGL(report_kernel, dim3(1024), dim3(256), 0, stream, (const unsigned long long*)chk, (float*)d_out, out_size);
#else
    for (int p = 0; p < NPH; ++p) { a.ph_lo = p; a.ph_hi = p + 1; hipLaunchKernelGGL(fwd_kernel, dim3(grid), dim3(NTHR), LDS_BYTES, stream, a); }
#endif
#endif
}
```

```cpp
#include <hip/hip_runtime.h>
#include <cstdio>
#include <cstdint>
#define MK_SINGLE 1
namespace pg8 {
#define PG8_LAS __attribute__((address_space(3)))
typedef unsigned short bf16_t;
typedef short bf16x8 __attribute__((ext_vector_type(8)));
typedef float f32x4 __attribute__((ext_vector_type(4)));
typedef unsigned u32x4 __attribute__((ext_vector_type(4)));
constexpr int BM = 256, BK = 64, HALF = 128, HTB = HALF * BK * 2  , STAGE_BYTES = 8 * HTB, NXCD = 8, WGM = 8;

__host__ __device__ __forceinline__ int lds_byte(int r, int c) { const int st = (r >> 4) * 2 + (c >> 5), rr = r & 15, cc = c & 31, ob = rr * 64 + cc * 2; return st * 1024 + (ob ^ (((ob >> 9) & 1) << 5)); }
__host__ __device__ __forceinline__ void stage_rc(int b, int& R, int& C) { const int st = b / 1024, sb = b % 1024, swz = sb ^ (((sb >> 9) & 1) << 5); R = (st >> 1) * 16 + swz / 64; C = (st & 1) * 32 + (swz % 64) / 2; }
__host__ __device__ __forceinline__ int perm32(int rho) { const int n = rho >> 4, i = rho & 15; return 8 * (i >> 2) + 4 * n + (i & 3); }

struct Unit { int pm, pn; };
struct Gemm { const bf16_t* A; const bf16_t* Bt; int M, N, K; };

struct StaticOrder {
    int nM, nN, nwg, G, c;
    __host__ __device__ void init(int M, int N, int G_, int c_) { nM = M / BM; nN = N / BM; nwg = nM * nN; G = G_; c = c_; }
    __host__ __device__ bool next(int i, Unit& u) const {
        const long L = (long)i * G + c; if (L >= nwg) return false;
        int wgid = (int)L; { const int q = nwg / NXCD, r = nwg % NXCD, xcd = wgid % NXCD, off = wgid / NXCD; wgid = (xcd < r ? xcd * (q + 1) : r * (q + 1) + (xcd - r) * q) + off; }
        const int nig = WGM * nN, gid = wgid / nig, fm = gid * WGM, gsz = (nM - fm) < WGM ? (nM - fm) : WGM;
        u.pm = fm + ((wgid % nig) % gsz); u.pn = (wgid % nig) / gsz; return true;
    }
    __device__ __forceinline__ void a_ready(const Unit&) const {}
    __device__ __forceinline__ void done(const Unit&) const {}
};

__device__ __forceinline__ unsigned cvt_pk_bf16(float lo, float hi) { unsigned r; asm volatile("v_cvt_pk_bf16_f32 %0, %1, %2" : "=v"(r) : "v"(lo), "v"(hi)); return r; }
template <class Epi, class Sched, bool ALIGN_EPI = false, bool SP2 = false>
__device__ __forceinline__ void gemm_phase(PG8_LAS unsigned char* lds, const Gemm g, const Sched& S, const Epi& E) {
    const int tid = threadIdx.x, wid = __builtin_amdgcn_readfirstlane(tid >> 6), lane = tid & 63, wr = wid >> 2, wc = wid & 3, fr = lane & 15, fq = lane >> 4;
    const int K = g.K, nt = K / BK;
    unsigned voffA[2], voffB[2];
#pragma unroll
    for (int i = 0; i < 2; ++i) { int R, C; stage_rc(tid * 16 + i * 8192, R, C); const int Rb = Epi::PERM ? ((R & ~31) + perm32(R & 31)) : R;
        voffA[i] = (unsigned)(R * K + C) * 2u; voffB[i] = (unsigned)(Rb * K + C) * 2u; }
    const size_t kstep = (size_t)(BK * 2);
    const size_t hstep = (size_t)HALF * K * 2;
    const size_t tstep = 2 * hstep;
    const unsigned ldsw = (unsigned)wid * 1024u;
    const int aoff = lds_byte(wr * 64 + fr, fq * 8), boff = lds_byte(wc * 32 + fr, fq * 8);
#define PG8_SA(b, h) (((b) * 2 + (h)) * HTB)
#define PG8_SB(b, h) ((4 + (b) * 2 + (h)) * HTB)
#define PG8_STAGE(bufoff, gbase, voff) do { _Pragma("unroll") for (int _i = 0; _i < 2; ++_i) \
        __builtin_amdgcn_global_load_lds((const unsigned*)((const char*)(gbase) + (voff)[_i]), (PG8_LAS unsigned*)(lds + (bufoff) + ldsw + _i * 8192), 16, 0, 0); } while (0)
#define PG8_LDA(dst, b, h) do { _Pragma("unroll") for (int m = 0; m < 4; ++m) _Pragma("unroll") for (int k = 0; k < 2; ++k) dst[m][k] = *(const PG8_LAS bf16x8*)(lds + PG8_SA(b, h) + aoff + m * 2048 + k * 1024); } while (0)
#define PG8_LDB(dst, b, h) do { _Pragma("unroll") for (int n = 0; n < 2; ++n) _Pragma("unroll") for (int k = 0; k < 2; ++k) dst[n][k] = *(const PG8_LAS bf16x8*)(lds + PG8_SB(b, h) + boff + n * 2048 + k * 1024); } while (0)
#define PG8_MMA(ai, bj, At, Bt) do { __builtin_amdgcn_s_setprio(1); _Pragma("unroll") for (int m = 0; m < 4; ++m) _Pragma("unroll") for (int n = 0; n < 2; ++n) _Pragma("unroll") for (int k = 0; k < 2; ++k) \
        acc[ai][bj][m][n] = __builtin_amdgcn_mfma_f32_16x16x32_bf16(Bt[n][k], At[m][k], acc[ai][bj][m][n], 0, 0, 0); __builtin_amdgcn_s_setprio(0); } while (0)
#define PG8_WAIT_V(n) asm volatile("s_waitcnt vmcnt(" #n ")" ::: "memory")
#define PG8_WAIT_L(n) asm volatile("s_waitcnt lgkmcnt(" #n ")" ::: "memory")
#define PG8_BAR __builtin_amdgcn_s_barrier()
#define PG8_SCHED __builtin_amdgcn_sched_barrier(0)
    Unit cur, nxt; int ui = 0;
    if (!S.next(0, cur)) return;
    f32x4 acc[2][2][4][2];
#pragma unroll
    for (int a = 0; a < 2; ++a)
#pragma unroll
        for (int b = 0; b < 2; ++b)
#pragma unroll
            for (int m = 0; m < 4; ++m)
#pragma unroll
                for (int n = 0; n < 2; ++n) acc[a][b][m][n] = (f32x4){0.f, 0.f, 0.f, 0.f};
    bf16x8 At[4][2], B0[2][2], B1[2][2];
    const char* cA = (const char*)g.A + (size_t)cur.pm * tstep; const char* cB = (const char*)g.Bt + (size_t)cur.pn * tstep;
    S.a_ready(cur);
    if constexpr (SP2) {
        PG8_STAGE(PG8_SB(0, 0), cB, voffB); PG8_STAGE(PG8_SB(0, 1), cB + hstep, voffB); PG8_STAGE(PG8_SA(0, 0), cA, voffA); PG8_STAGE(PG8_SA(0, 1), cA + hstep, voffA);
        if (wr == 1) PG8_BAR;
        PG8_WAIT_V(2); PG8_BAR;
        PG8_STAGE(PG8_SB(1, 0), cB + kstep, voffB); PG8_STAGE(PG8_SA(1, 0), cA + kstep, voffA); PG8_STAGE(PG8_SB(1, 1), cB + hstep + kstep, voffB);
        PG8_WAIT_V(6); PG8_BAR;
    } else {
        PG8_STAGE(PG8_SB(0, 0), cB, voffB); PG8_STAGE(PG8_SA(0, 0), cA, voffA); PG8_STAGE(PG8_SB(0, 1), cB + hstep, voffB); PG8_STAGE(PG8_SA(0, 1), cA + hstep, voffA);
        if (wr == 1) PG8_BAR;
        PG8_WAIT_V(4); PG8_BAR;
        PG8_STAGE(PG8_SB(1, 0), cB + kstep, voffB); PG8_STAGE(PG8_SA(1, 0), cA + kstep, voffA); PG8_STAGE(PG8_SB(1, 1), cB + hstep + kstep, voffB);
        PG8_WAIT_V(6); PG8_BAR;
    }
    for (;;) {
        const bool has_next = S.next(ui + 1, nxt);
        const char* nA = has_next ? (const char*)g.A + (size_t)nxt.pm * tstep : cA; const char* nB = has_next ? (const char*)g.Bt + (size_t)nxt.pn * tstep : cB;
        for (int t = 0; t < nt; t += 2) {
            const bool last = (t == nt - 2);
            const char* a1 = cA + (size_t)(t + 1) * kstep;
            const char* a2 = last ? nA : cA + (size_t)(t + 2) * kstep; const char* b2 = last ? nB : cB + (size_t)(t + 2) * kstep;
            const char* a3 = a2 + kstep; const char* b3 = b2 + kstep;
            if (last && has_next) S.a_ready(nxt);
            if constexpr (SP2) {
            PG8_LDB(B0, 0, 0); PG8_LDB(B1, 0, 1); PG8_SCHED; PG8_LDA(At, 0, 0); PG8_STAGE(PG8_SA(1, 1), a1 + hstep, voffA);
            PG8_WAIT_V(8); PG8_WAIT_L(0); PG8_BAR; PG8_MMA(0, 0, At, B0); PG8_MMA(0, 1, At, B1); PG8_BAR; PG8_SCHED;
            PG8_LDA(At, 0, 1); PG8_STAGE(PG8_SB(0, 0), b2, voffB); PG8_STAGE(PG8_SB(0, 1), b2 + hstep, voffB); PG8_STAGE(PG8_SA(0, 0), a2, voffA);
            PG8_WAIT_V(8); PG8_WAIT_L(0); PG8_BAR; PG8_MMA(1, 0, At, B0); PG8_MMA(1, 1, At, B1); PG8_BAR; PG8_SCHED;
            PG8_LDB(B0, 1, 0); PG8_LDB(B1, 1, 1); PG8_SCHED; PG8_LDA(At, 1, 0); PG8_STAGE(PG8_SA(0, 1), a2 + hstep, voffA);
            PG8_WAIT_V(8); PG8_WAIT_L(0); PG8_BAR; PG8_MMA(0, 0, At, B0); PG8_MMA(0, 1, At, B1); PG8_BAR; PG8_SCHED;
            PG8_LDA(At, 1, 1); PG8_STAGE(PG8_SB(1, 0), b3, voffB); PG8_STAGE(PG8_SB(1, 1), b3 + hstep, voffB); PG8_STAGE(PG8_SA(1, 0), a3, voffA);
            PG8_WAIT_V(8); PG8_WAIT_L(0); PG8_BAR; PG8_MMA(1, 0, At, B0); PG8_MMA(1, 1, At, B1); PG8_BAR; PG8_SCHED;
            } else {
            PG8_LDB(B0, 0, 0); PG8_SCHED; PG8_LDA(At, 0, 0); PG8_STAGE(PG8_SA(1, 1), a1 + hstep, voffA);
            PG8_WAIT_L(8); PG8_BAR; PG8_WAIT_L(0); PG8_MMA(0, 0, At, B0); PG8_BAR; PG8_SCHED;
            PG8_LDB(B1, 0, 1); PG8_STAGE(PG8_SB(0, 0), b2, voffB);
            PG8_BAR; PG8_WAIT_L(0); PG8_MMA(0, 1, At, B1); PG8_BAR;
            PG8_LDA(At, 0, 1); PG8_STAGE(PG8_SA(0, 0), a2, voffA);
            PG8_BAR; PG8_WAIT_L(0); PG8_MMA(1, 0, At, B0); PG8_BAR; PG8_SCHED;
            PG8_STAGE(PG8_SB(0, 1), b2 + hstep, voffB);
            PG8_WAIT_V(6); PG8_BAR; PG8_MMA(1, 1, At, B1); PG8_BAR;
            PG8_LDB(B0, 1, 0); PG8_SCHED; PG8_LDA(At, 1, 0); PG8_STAGE(PG8_SA(0, 1), a2 + hstep, voffA);
            PG8_WAIT_L(8); PG8_BAR; PG8_WAIT_L(0); PG8_MMA(0, 0, At, B0); PG8_BAR; PG8_SCHED;
            PG8_LDB(B1, 1, 1); PG8_STAGE(PG8_SB(1, 0), b3, voffB);
            PG8_BAR; PG8_WAIT_L(0); PG8_MMA(0, 1, At, B1); PG8_BAR;
            PG8_LDA(At, 1, 1); PG8_STAGE(PG8_SA(1, 0), a3, voffA);
            PG8_BAR; PG8_WAIT_L(0); PG8_MMA(1, 0, At, B0); PG8_BAR; PG8_SCHED;
            PG8_STAGE(PG8_SB(1, 1), b3 + hstep, voffB);
            PG8_WAIT_V(6); PG8_BAR; PG8_MMA(1, 1, At, B1); PG8_BAR;
            }
        }
        if constexpr (ALIGN_EPI) { if (wr == 0) PG8_BAR; }
        if constexpr (!Epi::AFTER_DRAIN) { E(acc, cur, wr, wc, fr, fq); S.done(cur); }
        if (!has_next) break;
#pragma unroll
        for (int a = 0; a < 2; ++a)
#pragma unroll
            for (int b = 0; b < 2; ++b)
#pragma unroll
                for (int m = 0; m < 4; ++m)
#pragma unroll
                    for (int n = 0; n < 2; ++n) acc[a][b][m][n] = (f32x4){0.f, 0.f, 0.f, 0.f};
        cur = nxt; cA = nA; cB = nB; ++ui;
        if constexpr (ALIGN_EPI) { if (wr == 1) PG8_BAR; }
    }
    PG8_WAIT_V(0);
    if constexpr (!ALIGN_EPI) { if (wr == 0) PG8_BAR; }
    PG8_BAR;
    if constexpr (Epi::AFTER_DRAIN) { E.fused(acc, cur, wr, wc, fr, fq, lds, wid, lane); S.done(cur); }
#undef PG8_SA
#undef PG8_SB
#undef PG8_STAGE
#undef PG8_LDA
#undef PG8_LDB
#undef PG8_MMA
#undef PG8_WAIT_V
#undef PG8_WAIT_L
#undef PG8_BAR
#undef PG8_SCHED
}
}
namespace pg8 {
template <class Epi, class Sched, bool ALIGN_EPI = false, bool SP2 = false>
__device__ __forceinline__ void gemm_phase_gather(PG8_LAS unsigned char* lds, const Gemm g, const Sched& S, const Epi& E, const int* __restrict__ idx) {
    const int tid = threadIdx.x, wid = __builtin_amdgcn_readfirstlane(tid >> 6), lane = tid & 63, wr = wid >> 2, wc = wid & 3, fr = lane & 15, fq = lane >> 4;
    const int K = g.K, nt = K / BK;
    unsigned voffB[2]; int RA[2], CA[2];
#pragma unroll
    for (int i = 0; i < 2; ++i) { int R, C; stage_rc(tid * 16 + i * 8192, R, C); const int Rb = Epi::PERM ? ((R & ~31) + perm32(R & 31)) : R;
        RA[i] = R; CA[i] = C; voffB[i] = (unsigned)(Rb * K + C) * 2u; }
    unsigned vA[2][2], nvA[2][2];
#define PG8_GOFF(dst, pm) do { _Pragma("unroll") for (int _h = 0; _h < 2; ++_h) _Pragma("unroll") for (int _i = 0; _i < 2; ++_i) { const int _r = (pm) * 256 + _h * 128 + RA[_i]; \
        dst[_h][_i] = (unsigned)((((_r >> 9) & 3) * 4096 + idx[_r]) * K + CA[_i]) * 2u; } } while (0)
    const size_t kstep = (size_t)(BK * 2);
    const size_t hstep = (size_t)HALF * K * 2;
    const size_t tstep = 2 * hstep;
    const unsigned ldsw = (unsigned)wid * 1024u;
    const int aoff = lds_byte(wr * 64 + fr, fq * 8), boff = lds_byte(wc * 32 + fr, fq * 8);
#define PG8_SA(b, h) (((b) * 2 + (h)) * HTB)
#define PG8_SB(b, h) ((4 + (b) * 2 + (h)) * HTB)
#define PG8_STAGE(bufoff, gbase, voff) do { _Pragma("unroll") for (int _i = 0; _i < 2; ++_i) \
        __builtin_amdgcn_global_load_lds((const unsigned*)((const char*)(gbase) + (voff)[_i]), (PG8_LAS unsigned*)(lds + (bufoff) + ldsw + _i * 8192), 16, 0, 0); } while (0)
#define PG8_LDA(dst, b, h) do { _Pragma("unroll") for (int m = 0; m < 4; ++m) _Pragma("unroll") for (int k = 0; k < 2; ++k) dst[m][k] = *(const PG8_LAS bf16x8*)(lds + PG8_SA(b, h) + aoff + m * 2048 + k * 1024); } while (0)
#define PG8_LDB(dst, b, h) do { _Pragma("unroll") for (int n = 0; n < 2; ++n) _Pragma("unroll") for (int k = 0; k < 2; ++k) dst[n][k] = *(const PG8_LAS bf16x8*)(lds + PG8_SB(b, h) + boff + n * 2048 + k * 1024); } while (0)
#define PG8_MMA(ai, bj, At, Bt) do { __builtin_amdgcn_s_setprio(1); _Pragma("unroll") for (int m = 0; m < 4; ++m) _Pragma("unroll") for (int n = 0; n < 2; ++n) _Pragma("unroll") for (int k = 0; k < 2; ++k) \
        acc[ai][bj][m][n] = __builtin_amdgcn_mfma_f32_16x16x32_bf16(Bt[n][k], At[m][k], acc[ai][bj][m][n], 0, 0, 0); __builtin_amdgcn_s_setprio(0); } while (0)
#define PG8_WAIT_V(n) asm volatile("s_waitcnt vmcnt(" #n ")" ::: "memory")
#define PG8_WAIT_L(n) asm volatile("s_waitcnt lgkmcnt(" #n ")" ::: "memory")
#define PG8_BAR __builtin_amdgcn_s_barrier()
#define PG8_SCHED __builtin_amdgcn_sched_barrier(0)
    Unit cur, nxt; int ui = 0;
    if (!S.next(0, cur)) return;
    f32x4 acc[2][2][4][2];
#pragma unroll
    for (int a = 0; a < 2; ++a)
#pragma unroll
        for (int b = 0; b < 2; ++b)
#pragma unroll
            for (int m = 0; m < 4; ++m)
#pragma unroll
                for (int n = 0; n < 2; ++n) acc[a][b][m][n] = (f32x4){0.f, 0.f, 0.f, 0.f};
    bf16x8 At[4][2], B0[2][2], B1[2][2];
    const char* cA = (const char*)g.A; PG8_GOFF(vA, cur.pm); const char* cB = (const char*)g.Bt + (size_t)cur.pn * tstep;
    S.a_ready(cur);
    if constexpr (SP2) {
        PG8_STAGE(PG8_SB(0, 0), cB, voffB); PG8_STAGE(PG8_SB(0, 1), cB + hstep, voffB); PG8_STAGE(PG8_SA(0, 0), cA, vA[0]); PG8_STAGE(PG8_SA(0, 1), cA, vA[1]);
        if (wr == 1) PG8_BAR;
        PG8_WAIT_V(2); PG8_BAR;
        PG8_STAGE(PG8_SB(1, 0), cB + kstep, voffB); PG8_STAGE(PG8_SA(1, 0), cA + kstep, vA[0]); PG8_STAGE(PG8_SB(1, 1), cB + hstep + kstep, voffB);
        PG8_WAIT_V(6); PG8_BAR;
    } else {
        PG8_STAGE(PG8_SB(0, 0), cB, voffB); PG8_STAGE(PG8_SA(0, 0), cA, vA[0]); PG8_STAGE(PG8_SB(0, 1), cB + hstep, voffB); PG8_STAGE(PG8_SA(0, 1), cA, vA[1]);
        if (wr == 1) PG8_BAR;
        PG8_WAIT_V(4); PG8_BAR;
        PG8_STAGE(PG8_SB(1, 0), cB + kstep, voffB); PG8_STAGE(PG8_SA(1, 0), cA + kstep, vA[0]); PG8_STAGE(PG8_SB(1, 1), cB + hstep + kstep, voffB);
        PG8_WAIT_V(6); PG8_BAR;
    }
    for (;;) {
        const bool has_next = S.next(ui + 1, nxt);
        if (has_next) { PG8_GOFF(nvA, nxt.pm); } else { nvA[0][0] = vA[0][0]; nvA[0][1] = vA[0][1]; nvA[1][0] = vA[1][0]; nvA[1][1] = vA[1][1]; } const char* nB = has_next ? (const char*)g.Bt + (size_t)nxt.pn * tstep : cB;
        for (int t = 0; t < nt; t += 2) {
            const bool last = (t == nt - 2);
            const char* a1 = cA + (size_t)(t + 1) * kstep;
            const char* a2 = cA + (last ? (size_t)0 : (size_t)(t + 2) * kstep); unsigned w2[2][2]; w2[0][0] = last ? nvA[0][0] : vA[0][0]; w2[0][1] = last ? nvA[0][1] : vA[0][1]; w2[1][0] = last ? nvA[1][0] : vA[1][0]; w2[1][1] = last ? nvA[1][1] : vA[1][1]; const char* b2 = last ? nB : cB + (size_t)(t + 2) * kstep;
            const char* a3 = a2 + kstep; const char* b3 = b2 + kstep;
            if (last && has_next) S.a_ready(nxt);
            if constexpr (SP2) {
            PG8_LDB(B0, 0, 0); PG8_LDB(B1, 0, 1); PG8_SCHED; PG8_LDA(At, 0, 0); PG8_STAGE(PG8_SA(1, 1), a1, vA[1]);
            PG8_WAIT_V(8); PG8_WAIT_L(0); PG8_BAR; PG8_MMA(0, 0, At, B0); PG8_MMA(0, 1, At, B1); PG8_BAR; PG8_SCHED;
            PG8_LDA(At, 0, 1); PG8_STAGE(PG8_SB(0, 0), b2, voffB); PG8_STAGE(PG8_SB(0, 1), b2 + hstep, voffB); PG8_STAGE(PG8_SA(0, 0), a2, w2[0]);
            PG8_WAIT_V(8); PG8_WAIT_L(0); PG8_BAR; PG8_MMA(1, 0, At, B0); PG8_MMA(1, 1, At, B1); PG8_BAR; PG8_SCHED;
            PG8_LDB(B0, 1, 0); PG8_LDB(B1, 1, 1); PG8_SCHED; PG8_LDA(At, 1, 0); PG8_STAGE(PG8_SA(0, 1), a2, w2[1]);
            PG8_WAIT_V(8); PG8_WAIT_L(0); PG8_BAR; PG8_MMA(0, 0, At, B0); PG8_MMA(0, 1, At, B1); PG8_BAR; PG8_SCHED;
            PG8_LDA(At, 1, 1); PG8_STAGE(PG8_SB(1, 0), b3, voffB); PG8_STAGE(PG8_SB(1, 1), b3 + hstep, voffB); PG8_STAGE(PG8_SA(1, 0), a3, w2[0]);
            PG8_WAIT_V(8); PG8_WAIT_L(0); PG8_BAR; PG8_MMA(1, 0, At, B0); PG8_MMA(1, 1, At, B1); PG8_BAR; PG8_SCHED;
            } else {
            PG8_LDB(B0, 0, 0); PG8_SCHED; PG8_LDA(At, 0, 0); PG8_STAGE(PG8_SA(1, 1), a1, vA[1]);
            PG8_WAIT_L(8); PG8_BAR; PG8_WAIT_L(0); PG8_MMA(0, 0, At, B0); PG8_BAR; PG8_SCHED;
            PG8_LDB(B1, 0, 1); PG8_STAGE(PG8_SB(0, 0), b2, voffB);
            PG8_BAR; PG8_WAIT_L(0); PG8_MMA(0, 1, At, B1); PG8_BAR;
            PG8_LDA(At, 0, 1); PG8_STAGE(PG8_SA(0, 0), a2, w2[0]);
            PG8_BAR; PG8_WAIT_L(0); PG8_MMA(1, 0, At, B0); PG8_BAR; PG8_SCHED;
            PG8_STAGE(PG8_SB(0, 1), b2 + hstep, voffB);
            PG8_WAIT_V(6); PG8_BAR; PG8_MMA(1, 1, At, B1); PG8_BAR;
            PG8_LDB(B0, 1, 0); PG8_SCHED; PG8_LDA(At, 1, 0); PG8_STAGE(PG8_SA(0, 1), a2, w2[1]);
            PG8_WAIT_L(8); PG8_BAR; PG8_WAIT_L(0); PG8_MMA(0, 0, At, B0); PG8_BAR; PG8_SCHED;
            PG8_LDB(B1, 1, 1); PG8_STAGE(PG8_SB(1, 0), b3, voffB);
            PG8_BAR; PG8_WAIT_L(0); PG8_MMA(0, 1, At, B1); PG8_BAR;
            PG8_LDA(At, 1, 1); PG8_STAGE(PG8_SA(1, 0), a3, w2[0]);
            PG8_BAR; PG8_WAIT_L(0); PG8_MMA(1, 0, At, B0); PG8_BAR; PG8_SCHED;
            PG8_STAGE(PG8_SB(1, 1), b3 + hstep, voffB);
            PG8_WAIT_V(6); PG8_BAR; PG8_MMA(1, 1, At, B1); PG8_BAR;
            }
        }
        if constexpr (ALIGN_EPI) { if (wr == 0) PG8_BAR; }
        if constexpr (!Epi::AFTER_DRAIN) { E(acc, cur, wr, wc, fr, fq); S.done(cur); }
        if (!has_next) break;
#pragma unroll
        for (int a = 0; a < 2; ++a)
#pragma unroll
            for (int b = 0; b < 2; ++b)
#pragma unroll
                for (int m = 0; m < 4; ++m)
#pragma unroll
                    for (int n = 0; n < 2; ++n) acc[a][b][m][n] = (f32x4){0.f, 0.f, 0.f, 0.f};
        cur = nxt; cB = nB; ++ui; vA[0][0] = nvA[0][0]; vA[0][1] = nvA[0][1]; vA[1][0] = nvA[1][0]; vA[1][1] = nvA[1][1];
        if constexpr (ALIGN_EPI) { if (wr == 1) PG8_BAR; }
    }
    PG8_WAIT_V(0);
    if constexpr (!ALIGN_EPI) { if (wr == 0) PG8_BAR; }
    PG8_BAR;
    if constexpr (Epi::AFTER_DRAIN) { E.fused(acc, cur, wr, wc, fr, fq, lds, wid, lane); S.done(cur); }
#undef PG8_SA
#undef PG8_SB
#undef PG8_STAGE
#undef PG8_LDA
#undef PG8_LDB
#undef PG8_MMA
#undef PG8_WAIT_V
#undef PG8_WAIT_L
#undef PG8_BAR
#undef PG8_SCHED
#undef PG8_GOFF
}
}

#ifndef DBG_NOMIX
#define DBG_NOMIX 0
#endif
#ifndef DBG_NOMOE
#define DBG_NOMOE 0
#endif
#ifndef DBG_NOPOS
#define DBG_NOPOS 0
#endif
#ifndef DBG_HTCONST
#define DBG_HTCONST 0
#endif
#ifndef DBG_GLA_K
#define DBG_GLA_K 1.0f
#endif
#ifndef DBG_MOE_K
#define DBG_MOE_K 1.0f
#endif
#ifndef MK_SINGLE
#define MK_SINGLE 0
#endif
#define GAS __attribute__((address_space(1)))
#define LAS __attribute__((address_space(3)))
typedef unsigned short bf16;
typedef float f32x4 __attribute__((ext_vector_type(4)));
typedef float f32x16 __attribute__((ext_vector_type(16)));
typedef short bf16x8 __attribute__((ext_vector_type(8)));
typedef unsigned v4u __attribute__((ext_vector_type(4)));
typedef unsigned v2u __attribute__((ext_vector_type(2)));
typedef GAS unsigned gu32;

constexpr int NWAVES = 8, NTHR = 512;
constexpr int NB = 4, SEQ = 4096, DM = 1024, CTXL = 256;
constexpr int MX = NB * SEQ, MC = NB * CTXL, MT = MX + MC;
constexpr int NIN = 3328, NQ = 1536, DIN = 3104;
constexpr int NE = 16, CAP = 512;
constexpr int NCH = 68;
constexpr int NPH = 12;
constexpr float EPS = 1e-6f;

constexpr size_t MiB = 1u << 20;
constexpr size_t WS_CTL = 0, CTL_BYTES = 65536;
constexpr int CW_CNT_D = 8192, CW_CNT_GU = 8192 + 64;
constexpr size_t WS_MOD = 1 * MiB, WS_POS = 1 * MiB + 256 * 1024, WS_DEC = 2 * MiB, WS_AFF = 3 * MiB, WS_SLOT = 4 * MiB, WS_SELT = 5 * MiB, WS_SELV = 5 * MiB + 256 * 1024;
constexpr size_t WS_UCTX = 6 * MiB, WS_AFB = 10 * MiB, WS_WIN = 13 * MiB, WS_WOUT = 20 * MiB;
constexpr size_t WS_R1 = 22 * MiB, WS_R2 = 56 * MiB, WS_R3 = 107 * MiB, WS_R4 = 203 * MiB, WS_R5 = 235 * MiB, WS_R6 = 267 * MiB, WS_END = 299 * MiB;
constexpr size_t WS_AIN = WS_R1, WS_ZT = WS_R1, WS_HN = WS_R1;
constexpr size_t WS_QKVG = WS_R2;
constexpr size_t WS_HYT = WS_R3, WS_WD = 171 * MiB;
constexpr size_t WS_WGU = WS_R5;
constexpr size_t WS_HID = WS_R2, WS_YSLAB = WS_R4;
constexpr size_t WS_HT = WS_R4, WS_AOUT = WS_R4;
constexpr size_t WS_SPREV = WS_R5, WS_YHYT = WS_R6;
constexpr int LDS_BYTES = 144 * 1024;
constexpr int LDS_MISC = LDS_BYTES - 256;

struct Args { const float* in[29]; float* out; unsigned char* ws; int ph_lo, ph_hi; };

#define LDS_WAIT() asm volatile("s_waitcnt lgkmcnt(0)" ::: "memory")
#define VM_WAIT() asm volatile("s_waitcnt vmcnt(0)" ::: "memory")
__device__ __forceinline__ unsigned f2bf(float f) { unsigned u = __float_as_uint(f); return (u + 0x7fffu + ((u >> 16) & 1u)) >> 16; }
__device__ __forceinline__ unsigned pk2(float lo, float hi) { return pg8::cvt_pk_bf16(lo, hi); }
__device__ __forceinline__ float bflo(unsigned w) { return __uint_as_float(w << 16); }
__device__ __forceinline__ float bfhi(unsigned w) { return __uint_as_float(w & 0xffff0000u); }
__device__ __forceinline__ float wave_sum(float v) {
#pragma unroll
    for (int o = 1; o < 64; o <<= 1) v += __shfl_xor(v, o);
    return v;
}
__device__ __forceinline__ float silu_f(float v) { return v / (1.f + __expf(-v)); }
__device__ __forceinline__ float logsig_f(float x) { return fminf(x, 0.f) - __logf(1.0f + __expf(-fabsf(x))); }

#define XB_TMO      128
#define XB_XCNT(j)  (256  + 64 * (j))
#define XB_XSUB(j)  (1280 + 64 * (j))
#define XB_XGEN(j)  (2304 + 64 * (j))
#define XB_TOP      3328
#define XB_TOPGEN   3392
#define XCD_BAR_WORDS 3456
#define XB_SPIN_CAP (1u << 22)
__device__ __forceinline__ unsigned xb_ld(unsigned* p)              { return __hip_atomic_load(p, __ATOMIC_RELAXED, __HIP_MEMORY_SCOPE_AGENT); }
__device__ __forceinline__ unsigned xb_add(unsigned* p, unsigned v) { return __hip_atomic_fetch_add(p, v, __ATOMIC_RELAXED, __HIP_MEMORY_SCOPE_AGENT); }
__device__ __forceinline__ unsigned xb_xcc_id() { return (unsigned)__builtin_amdgcn_s_getreg((3 << 11) | 20) & 0xFu; }
#define XB_SPIN(cond, bar) do { unsigned _sp = 0; while (cond) { __builtin_amdgcn_s_sleep(1); \
    if ((++_sp & 255u) == 0u) { if (xb_ld(&(bar)[XB_TMO])) break; if (_sp > XB_SPIN_CAP) { atomicAdd(&(bar)[XB_TMO], 1u); break; } } } } while (0)
struct XcdBarrier { unsigned* bar; unsigned x; volatile LAS unsigned* st; };
__device__ __forceinline__ XcdBarrier xcd_barrier_post(unsigned* bar, volatile LAS unsigned* st) {
    XcdBarrier b; b.bar = bar; b.x = xb_xcc_id(); b.st = st;
    if (threadIdx.x == 0) (void)xb_add(&bar[XB_XCNT(b.x)], 1u);
    return b;
}
__device__ __forceinline__ void xcd_barrier_complete(unsigned* bar, unsigned x, unsigned& nloc, unsigned& nx) {
    const unsigned G = gridDim.x * gridDim.y * gridDim.z;
    unsigned sum, cnt, mine, sp = 0u;
    for (;;) {
        sum = 0u; cnt = 0u; mine = 0u;
#pragma unroll
        for (unsigned j = 0; j < 16; ++j) { const unsigned c = xb_ld(&bar[XB_XCNT(j)]); sum += c; cnt += (c > 0u) ? 1u : 0u; mine = (j == x) ? c : mine; }
        if (sum == G) break;
        __builtin_amdgcn_s_sleep(1);
        if ((++sp & 255u) == 0u) { if (xb_ld(&bar[XB_TMO])) break; if (sp > XB_SPIN_CAP) { atomicAdd(&bar[XB_TMO], 1u); break; } }
    }
    nloc = mine > 0u ? mine : 1u; nx = cnt > 0u ? cnt : 1u;
}
__device__ __forceinline__ void xcd_barrier(const XcdBarrier& b) {
    asm volatile("s_waitcnt vmcnt(0)" ::: "memory");
    __syncthreads();
    if (threadIdx.x == 0) {
        unsigned* bar = b.bar;
        __builtin_amdgcn_s_waitcnt(0);
        unsigned nloc = b.st[0], nx = b.st[1];
        if (nloc == 0u) { xcd_barrier_complete(bar, b.x, nloc, nx); b.st[0] = nloc; b.st[1] = nx; }
        const unsigned old = xb_add(&bar[XB_XSUB(b.x)], 1u);
        const unsigned gen = old / nloc;
        if (old + 1u == (gen + 1u) * nloc) {
            __builtin_amdgcn_fence(__ATOMIC_RELEASE, "agent");
            asm volatile("s_waitcnt vmcnt(0)" ::: "memory");
            const unsigned og = xb_add(&bar[XB_TOP], 1u);
            const unsigned tg = og / nx;
            if (og + 1u == (tg + 1u) * nx) xb_add(&bar[XB_TOPGEN], 1u);
            else XB_SPIN(xb_ld(&bar[XB_TOPGEN]) == tg, bar);
            __builtin_amdgcn_fence(__ATOMIC_ACQUIRE, "agent");
            xb_add(&bar[XB_XGEN(b.x)], 1u);
            asm volatile("s_waitcnt vmcnt(0)" ::: "memory");
        } else {
            XB_SPIN(xb_ld(&bar[XB_XGEN(b.x)]) == gen, bar);
            __builtin_amdgcn_fence(__ATOMIC_ACQUIRE, "agent");
            asm volatile("s_waitcnt vmcnt(0)" ::: "memory");
        }
    }
    __syncthreads();
}

constexpr int TILE_AIN = (int)(WS_AIN / (512 * 1024)), TILE_WIN = (int)(WS_WIN / (512 * 1024));
struct InSched {
    int G, c;
    __device__ void init(int G_, int c_) { G = G_; c = c_; }
    __device__ bool next(int i, pg8::Unit& u) const {
        const int L = i * G + c;
        if (L < 384) { u.pm = TILE_WIN + 6 + (L >> 6); u.pn = TILE_AIN + (L & 63); return true; }
        if (L < 832) { const int l = L - 384, q = l >> 6; u.pm = TILE_AIN + (l & 63); u.pn = TILE_WIN + ((q == 6) ? 12 : q); return true; }
        if (L >= 848) return false;
        const int jx = L - 832, q = jx >> 2; u.pm = TILE_AIN + 64 + (jx & 3); u.pn = TILE_WIN + ((q == 3) ? 12 : (1 + q)); return true;
    }
    __device__ __forceinline__ void a_ready(const pg8::Unit&) const {}
    __device__ __forceinline__ void done(const pg8::Unit&) const {}
};
template <int NT> struct MoeSched {
    int G, c;
    __device__ void init(int G_, int c_) { G = G_; c = c_; }
    __device__ bool next(int i, pg8::Unit& u) const {
        const int L = i * G + c; if (L >= NE * 8 * NT) return false;
        const int e = L / (8 * NT), l = L % (8 * NT); u.pm = e * 8 + (l & 7); u.pn = e * NT + (l >> 3); return true;
    }
    __device__ __forceinline__ void a_ready(const pg8::Unit&) const {}
    __device__ __forceinline__ void done(const pg8::Unit&) const {}
};

struct EpiIn {
    static constexpr bool PERM = true, AFTER_DRAIN = false;
    bf16* qkvg; bf16* hyT; float* afb;
    __device__ __forceinline__ void operator()(const f32x4 (&acc)[2][2][4][2], const pg8::Unit& u, int wr, int wc, int fr, int fq) const {
        if (u.pm < TILE_AIN) {
            const int ch0 = (u.pm - TILE_WIN - 6) * 256 + wr * 64 + fr, mt = u.pn - TILE_AIN, b = mt >> 4, t0 = (mt & 15) * 256 + wc * 32 + 8 * fq;
#pragma unroll
            for (int ai = 0; ai < 2; ++ai)
#pragma unroll
                for (int m = 0; m < 4; ++m) { bf16* rowp = hyT + ((size_t)b * 1536 + ch0 + ai * 128 + m * 16) * SEQ + t0;
#pragma unroll
                    for (int bj = 0; bj < 2; ++bj) { const f32x4 v0 = acc[ai][bj][m][0], v1 = acc[ai][bj][m][1];
                        v4u w; w.x = pk2(v0[0], v0[1]); w.y = pk2(v0[2], v0[3]); w.z = pk2(v1[0], v1[1]); w.w = pk2(v1[2], v1[3]);
                        *(v4u*)(rowp + bj * 128) = w; } }
            return;
        }
        const int pm = u.pm - TILE_AIN, pn = u.pn - TILE_WIN;
        const int row0 = pm * 256 + wr * 64 + fr;
        if (pn < 6) {
            const float sc = (pn == 0) ? 0.125f : 1.f;
            const int col0 = pn * 256 + wc * 32 + 8 * fq;
#pragma unroll
            for (int ai = 0; ai < 2; ++ai)
#pragma unroll
                for (int m = 0; m < 4; ++m) { bf16* rowp = qkvg + (size_t)(row0 + ai * 128 + m * 16) * NQ + col0;
#pragma unroll
                    for (int bj = 0; bj < 2; ++bj) { const f32x4 v0 = acc[ai][bj][m][0] * sc, v1 = acc[ai][bj][m][1] * sc;
                        v4u w; w.x = pk2(v0[0], v0[1]); w.y = pk2(v0[2], v0[3]); w.z = pk2(v1[0], v1[1]); w.w = pk2(v1[2], v1[3]);
                        *(v4u*)(rowp + bj * 128) = w; } }
        } else {
            if (wc != 0) return;
#pragma unroll
            for (int ai = 0; ai < 2; ++ai)
#pragma unroll
                for (int m = 0; m < 4; ++m) { float* rowp = afb + (size_t)(row0 + ai * 128 + m * 16) * 32 + 8 * fq;
                    *(f32x4*)(rowp) = acc[ai][0][m][0]; *(f32x4*)(rowp + 4) = acc[ai][0][m][1]; }
        }
    }
};
struct EpiOut {
    static constexpr bool PERM = false, AFTER_DRAIN = false;
    const float* x; const float* postab; const float* modr; float* x1;
    __device__ __forceinline__ void operator()(const f32x4 (&acc)[2][2][4][2], const pg8::Unit& u, int wr, int wc, int fr, int fq) const {
        const int row0 = u.pm * 256 + wr * 64 + fr, col0 = u.pn * 256 + wc * 32 + 4 * fq;
#pragma unroll
        for (int ai = 0; ai < 2; ++ai)
#pragma unroll
            for (int m = 0; m < 4; ++m) { const int r = row0 + ai * 128 + m * 16; const int b = r >> 12, t = r & 4095, rr = t >> 6, cc = t & 63;
                const float* gate = modr + b * 6144 + 2048;
#pragma unroll
                for (int bj = 0; bj < 2; ++bj)
#pragma unroll
                    for (int n = 0; n < 2; ++n) { const int c = col0 + bj * 128 + n * 16;
                        const f32x4 xv = *(const f32x4*)(x + (size_t)r * DM + c);
                        const f32x4 pv = (c < 512) ? *(const f32x4*)(postab + rr * 512 + c) : *(const f32x4*)(postab + cc * 512 + c - 512);
                        const f32x4 gv = *(const f32x4*)(gate + c);
                        *(f32x4*)(x1 + (size_t)r * DM + c) = xv + (DBG_NOPOS ? pv * 0.f : pv) + (DBG_NOMIX ? gv * 0.f : gv * acc[ai][bj][m][n]); } }
    }
};
struct EpiGU {
    static constexpr bool PERM = true, AFTER_DRAIN = false;
    bf16* hid;
    __device__ __forceinline__ void operator()(const f32x4 (&acc)[2][2][4][2], const pg8::Unit& u, int wr, int wc, int fr, int fq) const {
        const int row0 = u.pm * 256 + wr * 64 + fr, col0 = (u.pn & 7) * 128 + wc * 32 + 8 * fq;
#pragma unroll
        for (int ai = 0; ai < 2; ++ai)
#pragma unroll
            for (int m = 0; m < 4; ++m) { bf16* rowp = hid + (size_t)(row0 + ai * 128 + m * 16) * DM + col0;
                float o[8];
#pragma unroll
                for (int n = 0; n < 2; ++n)
#pragma unroll
                    for (int j = 0; j < 4; ++j) o[n * 4 + j] = silu_f(acc[ai][0][m][n][j]) * acc[ai][1][m][n][j];
                v4u w; w.x = pk2(o[0], o[1]); w.y = pk2(o[2], o[3]); w.z = pk2(o[4], o[5]); w.w = pk2(o[6], o[7]);
                *(v4u*)rowp = w; }
    }
};
struct EpiDown {
    static constexpr bool PERM = true, AFTER_DRAIN = false;
    bf16* ys; const float* selv;
    __device__ __forceinline__ void operator()(const f32x4 (&acc)[2][2][4][2], const pg8::Unit& u, int wr, int wc, int fr, int fq) const {
        const int row0 = u.pm * 256 + wr * 64 + fr, col0 = (u.pn & 3) * 256 + wc * 32 + 8 * fq;
#pragma unroll
        for (int ai = 0; ai < 2; ++ai)
#pragma unroll
            for (int m = 0; m < 4; ++m) { const int r = row0 + ai * 128 + m * 16; const float sc = selv[r]; bf16* rowp = ys + (size_t)r * DM + col0;
#pragma unroll
                for (int bj = 0; bj < 2; ++bj) { const f32x4 v0 = acc[ai][bj][m][0] * sc, v1 = acc[ai][bj][m][1] * sc;
                    v4u w; w.x = pk2(v0[0], v0[1]); w.y = pk2(v0[2], v0[3]); w.z = pk2(v1[0], v1[1]); w.w = pk2(v1[2], v1[3]);
                    *(v4u*)(rowp + bj * 128) = w; } }
    }
};

__device__ __forceinline__ void transpose_item(const float* W, int ldw, int k0, int nsrc0, bf16* WT, int K, int drow0, LAS float* scr, int lane, bool zero) {
    float tv[32];
#pragma unroll
    for (int i = 0; i < 32; ++i) { const int kk = 2 * i + (lane >> 5); tv[i] = zero ? 0.f : W[(size_t)(k0 + kk) * ldw + nsrc0 + (lane & 31)]; }
#pragma unroll
    for (int i = 0; i < 32; ++i) { const int kk = 2 * i + (lane >> 5); scr[kk * 33 + (lane & 31)] = tv[i]; }
    LDS_WAIT();
    const int c = lane & 7;
#pragma unroll
    for (int j = 0; j < 4; ++j) { const int n = (lane >> 3) + 8 * j; const LAS float* s = scr + (8 * c) * 33 + n;
        v4u o; o.x = pk2(s[0 * 33], s[1 * 33]); o.y = pk2(s[2 * 33], s[3 * 33]); o.z = pk2(s[4 * 33], s[5 * 33]); o.w = pk2(s[6 * 33], s[7 * 33]);
        *(v4u*)(WT + (size_t)(drow0 + n) * K + k0 + 8 * c) = o; }
    LDS_WAIT();
}

__device__ __forceinline__ void phase0(const Args& a, LAS unsigned char* lds) {
    int tid = threadIdx.x; const int wg = blockIdx.x, G = gridDim.x;
    asm volatile("" : "+v"(tid));
    int lane = tid & 63, wave = tid >> 6;
    unsigned char* ws = a.ws;
    for (int it = wg; it < 192; it += G) {
        LAS float* sl = (LAS float*)lds;
        LAS float* red = (LAS float*)(lds + 20480);
        for (int i = tid; i < 5 * 1024; i += NTHR) { const int bb = i >> 10, k = i & 1023; const float v = (bb < 4) ? a.in[1][bb * 1024 + k] : a.in[3][k]; sl[i] = silu_f(v); }
        __syncthreads();
        const int col = it * 32 + (lane & 31), kk = wave * 2 + (lane >> 5);
        float acc[5] = {0.f, 0.f, 0.f, 0.f, 0.f};
        const float* wp = a.in[4] + col;
#pragma unroll 8
        for (int j = 0; j < 64; ++j) { const int k = kk + 16 * j; const float w = wp[(size_t)k * 6144];
#pragma unroll
            for (int bb = 0; bb < 5; ++bb) acc[bb] += sl[bb * 1024 + k] * w; }
#pragma unroll
        for (int bb = 0; bb < 5; ++bb) red[(kk * 5 + bb) * 32 + (lane & 31)] = acc[bb];
        __syncthreads();
        if (tid < 160) { const int bb = tid >> 5, cl = tid & 31; float s = 0.f;
#pragma unroll
            for (int q = 0; q < 16; ++q) s += red[(q * 5 + bb) * 32 + cl];
            ((float*)(ws + WS_MOD))[bb * 6144 + it * 32 + cl] = s + a.in[5][it * 32 + cl]; }
        __syncthreads();
    }
    for (int it = wg; it < 256; it += G) {
        asm volatile("" : "+v"(tid));
        LAS float* zl = (LAS float*)lds;
        LAS float* h1 = (LAS float*)(lds + 4096);
        LAS float* h2 = (LAS float*)(lds + 8192);
        const int i0 = it * 16;
        for (int o = tid; o < 16 * 33; o += NTHR) { const int li = o / 33, j = o % 33; const int i = i0 + li;
            const float ti = (float)i * (1.0f / 4095.0f);
            const float wi = (6.2831855f * (float)i) / 4096.0f;
            float v;
            if (j == 0) v = ti;
            else { const int jj = (j - 1) & 15; const float f = 1e-4f + (float)jj * ((15.0f - 1e-4f) / 15.0f); const float ar = f * wi; v = (j <= 16) ? cosf(ar) : -sinf(ar); }
            zl[li * 36 + j] = v; }
        __syncthreads();
#pragma unroll
        for (int q = 0; q < 2; ++q) { const int o = tid + NTHR * q, li = o >> 6, m = o & 63; float s = a.in[16][m];
            for (int j = 0; j < 33; ++j) s += zl[li * 36 + j] * a.in[15][j * 64 + m];
            h1[li * 64 + m] = sinf(a.in[20][m] * s); }
        __syncthreads();
#pragma unroll
        for (int q = 0; q < 2; ++q) { const int o = tid + NTHR * q, li = o >> 6, m = o & 63; float s = a.in[18][m];
            for (int k = 0; k < 64; ++k) s += h1[li * 64 + k] * a.in[17][k * 64 + m];
            h2[li * 64 + m] = sinf(a.in[20][m] * s); }
        __syncthreads();
        f32x4 acc[16];
#pragma unroll
        for (int li = 0; li < 16; ++li) acc[li] = (f32x4){0.f, 0.f, 0.f, 0.f};
        const float* w3 = a.in[19] + tid * 4;
        for (int k = 0; k < 64; ++k) { const f32x4 w = *(const f32x4*)(w3 + k * 2048);
#pragma unroll
            for (int li = 0; li < 16; ++li) acc[li] += w * h2[li * 64 + k]; }
        float* hT = (float*)(ws + WS_HT);
#pragma unroll
        for (int j = 0; j < 4; ++j) { const int col = tid * 4 + j, od = col >> 9, c = col & 511;
            const float delta = 3.0701134573f + (float)c * ((15.3505672866f - 3.0701134573f) / 511.0f);
            float* dst = hT + ((size_t)od * 512 + c) * SEQ + i0;
#pragma unroll
            for (int q = 0; q < 4; ++q) { f32x4 o;
#pragma unroll
                for (int s = 0; s < 4; ++s) { const int li = q * 4 + s; const float ti = (float)(i0 + li) * (1.0f / 4095.0f); o[s] = DBG_HTCONST == 1 ? 1.0f : DBG_HTCONST == 2 ? zl[li * 36 + (col % 33)] : DBG_HTCONST == 3 ? h1[li * 64 + (col & 63)] : DBG_HTCONST == 4 ? h2[li * 64 + (col & 63)] : DBG_HTCONST == 5 ? acc[li][j] : acc[li][j] * __expf(-ti * delta); }
                *(f32x4*)(dst + q * 4) = o; } }
        __syncthreads();
    }
    {
        asm volatile("" : "+v"(tid)); lane = tid & 63; wave = tid >> 6;
        LAS float* scr = (LAS float*)(lds + wave * 8448);
        const int gw = wg * NWAVES + wave, NGW = G * NWAVES;
        constexpr int I_IN = 104 * 16, I_OUT = 32 * 16;
        for (int it = gw; it < I_IN + I_OUT; it += NGW) {
            if (it < I_IN) { const int nb = it >> 4, kb = it & 15, n0 = nb * 32;
                const int ns = (n0 < 1536) ? n0 : (n0 < 3072 ? n0 + 32 : 1536 + (n0 - 3072));
                transpose_item(a.in[7], DIN, kb * 64, (n0 < DIN) ? ns : 0, (bf16*)(ws + WS_WIN), DM, n0, scr, lane, n0 >= DIN);
            } else { const int r = it - I_IN, nb = r >> 4, kb = r & 15;
                transpose_item(a.in[22], DM, kb * 64, nb * 32, (bf16*)(ws + WS_WOUT), DM, nb * 32, scr, lane, false); }
        }
    }
    for (int e = wg * NTHR + tid; e < 64 * 256; e += G * NTHR) { const int i = e >> 8, j = e & 255;
        const float om = 1.0f / powf(10000.0f, (float)j * (1.0f / 256.0f)); const float er = (float)i * om;
        float* pt = (float*)(ws + WS_POS); pt[i * 512 + j] = sinf(er); pt[i * 512 + 256 + j] = cosf(er); }
}

__device__ __forceinline__ void phase1(const Args& a, LAS unsigned char* lds) {
    const int tid = threadIdx.x, lane = tid & 63, wave = tid >> 6, wg = blockIdx.x, G = gridDim.x;
    unsigned char* ws = a.ws;
    const float* modr = (const float*)(ws + WS_MOD); const float* pt = (const float*)(ws + WS_POS); bf16* ain = (bf16*)(ws + WS_AIN);
    const float* gmix = a.in[6];
    const int NGW = G * NWAVES;
    f32x4 gv[4];
#pragma unroll
    for (int j = 0; j < 4; ++j) gv[j] = *(const f32x4*)(gmix + 4 * lane + 256 * j);
#pragma nounroll
    for (int r0 = wg * NWAVES + wave; r0 < MT; r0 += 4 * NGW) {
        f32x4 v[4][4];
#pragma unroll
        for (int k = 0; k < 4; ++k) { const int r = r0 + k * NGW;
            if (r < MT) { const bool lat = r < MX; const float* src = lat ? a.in[0] + (size_t)r * DM : a.in[2] + (size_t)(r - MX) * DM; const int t = r & 4095, rr = t >> 6, cc = t & 63;
#pragma unroll
                for (int j = 0; j < 4; ++j) { const int col = 4 * lane + 256 * j; v[k][j] = *(const f32x4*)(src + col);
                    if (lat) v[k][j] += (j < 2) ? *(const f32x4*)(pt + rr * 512 + col) : *(const f32x4*)(pt + cc * 512 + col - 512); } } }
#pragma unroll
        for (int k = 0; k < 4; ++k) { const int r = r0 + k * NGW;
            if (r < MT) { const int bb = (r < MX) ? (r >> 12) : 4; float ss = 0.f;
#pragma unroll
                for (int j = 0; j < 4; ++j) ss += v[k][j][0] * v[k][j][0] + v[k][j][1] * v[k][j][1] + v[k][j][2] * v[k][j][2] + v[k][j][3] * v[k][j][3];
                const float rs = rsqrtf(wave_sum(ss) * (1.0f / DM) + EPS);
#pragma unroll
                for (int j = 0; j < 4; ++j) { const int col = 4 * lane + 256 * j;
                    const f32x4 sh = *(const f32x4*)(modr + bb * 6144 + col), sc = *(const f32x4*)(modr + bb * 6144 + 1024 + col);
                    const f32x4 y = (v[k][j] * rs * gv[j]) * (sc + 1.0f) + sh;
                    v2u w; w.x = pk2(y[0], y[1]); w.y = pk2(y[2], y[3]);
                    *(v2u*)(ain + (size_t)r * DM + col) = w; } } }
    }
}

typedef float cpx __attribute__((ext_vector_type(2)));
__device__ __forceinline__ cpx make_cpx(float x, float y) { cpx r; r.x = x; r.y = y; return r; }
__device__ __forceinline__ cpx cmul(cpx a, cpx b) { return make_cpx(a.x * b.x - a.y * b.y, a.x * b.y + a.y * b.x); }
__device__ __forceinline__ cpx cadd(cpx a, cpx b) { return make_cpx(a.x + b.x, a.y + b.y); }
__device__ __forceinline__ cpx csub(cpx a, cpx b) { return make_cpx(a.x - b.x, a.y - b.y); }
__device__ __forceinline__ cpx cconj(cpx a) { return make_cpx(a.x, -a.y); }
__device__ __forceinline__ cpx twid(float turns) { return make_cpx(__builtin_amdgcn_cosf(turns), -__builtin_amdgcn_sinf(turns)); }
__device__ __forceinline__ void dft4(cpx& a0, cpx& a1, cpx& a2, cpx& a3) {
    const cpx t0 = cadd(a0, a2), t1 = csub(a0, a2), t2 = cadd(a1, a3), t3 = csub(a1, a3);
    a0 = cadd(t0, t2); a2 = csub(t0, t2);
    a1 = make_cpx(t1.x + t3.y, t1.y - t3.x);
    a3 = make_cpx(t1.x - t3.y, t1.y + t3.x);
}
__device__ __forceinline__ void dft16(cpx (&v)[16]) {
    cpx t[16];
#pragma unroll
    for (int j = 0; j < 4; ++j) { cpx b0 = v[j], b1 = v[j + 4], b2 = v[j + 8], b3 = v[j + 12]; dft4(b0, b1, b2, b3); t[4 * j] = b0; t[4 * j + 1] = b1; t[4 * j + 2] = b2; t[4 * j + 3] = b3; }
    const float C1 = 0.92387953251f, S1 = 0.38268343236f, R2 = 0.70710678118f;
    const cpx W1 = make_cpx(C1, -S1), W2 = make_cpx(R2, -R2), W3 = make_cpx(S1, -C1), W4 = make_cpx(0.f, -1.f), W6 = make_cpx(-R2, -R2), W9 = make_cpx(-C1, S1);
    {   cpx b0 = t[0], b1 = t[4], b2 = t[8], b3 = t[12]; dft4(b0, b1, b2, b3); v[0] = b0; v[4] = b1; v[8] = b2; v[12] = b3; }
    {   cpx b0 = t[1], b1 = cmul(t[5], W1), b2 = cmul(t[9], W2), b3 = cmul(t[13], W3); dft4(b0, b1, b2, b3); v[1] = b0; v[5] = b1; v[9] = b2; v[13] = b3; }
    {   cpx b0 = t[2], b1 = cmul(t[6], W2), b2 = cmul(t[10], W4), b3 = cmul(t[14], W6); dft4(b0, b1, b2, b3); v[2] = b0; v[6] = b1; v[10] = b2; v[14] = b3; }
    {   cpx b0 = t[3], b1 = cmul(t[7], W3), b2 = cmul(t[11], W6), b3 = cmul(t[15], W9); dft4(b0, b1, b2, b3); v[3] = b0; v[7] = b1; v[11] = b2; v[15] = b3; }
}
#define FPAD(i) ((i) + ((i) >> 4))
constexpr int FFT_STRIDE = 4352;
__device__ __forceinline__ void apply_tw(cpx (&v)[16], cpx w1) {
    asm volatile("" : "+v"(w1.x), "+v"(w1.y));
    cpx w = w1; v[1] = cmul(v[1], w);
#pragma unroll
    for (int q = 2; q < 16; ++q) { w = cmul(w, w1); v[q] = cmul(v[q], w); }
}
__device__ __forceinline__ cpx opaque(cpx w) { asm volatile("" : "+v"(w.x), "+v"(w.y)); return w; }
__device__ __forceinline__ cpx c32(int r) { return make_cpx(__builtin_cosf(0.19634954084936207f * (float)r), -__builtin_sinf(0.19634954084936207f * (float)r)); }

#define HB(x) __uint_as_float(((unsigned)(x)) << 16)
__device__ __forceinline__ void hyena_item(const Args& a, LAS unsigned char* lds, int c, int stage) {
    int tid = threadIdx.x; asm volatile("" : "+v"(tid));
    const int f = tid >> 8, j = tid & 255, blk = j >> 4, jp = j & 15;
    unsigned char* ws = a.ws;
    LAS cpx* buf = (LAS cpx*)lds;
    LAS cpx* bm = buf + f * FFT_STRIDE;
    const int pj = j + blk, p16 = blk * 272 + jp, pc = 17 * j;
    const float* hT = (const float*)(ws + WS_HT);
    const float* hf = hT + ((size_t)(stage * 2 + 0) * 512 + c) * SEQ;
    const float* hb = hT + ((size_t)(stage * 2 + 1) * 512 + c) * SEQ;
    const bf16* hyT = (const bf16*)(ws + WS_HYT);
    const float* zT = (const float*)(ws + WS_ZT);
    float* outp = (float*)(ws + (stage == 0 ? WS_ZT : WS_YHYT));
    const float* cw = a.in[13]; const float* cb = a.in[14];
    const int chu = c, chg = (stage == 0 ? 512 : 1024) + c;
    const float wu0 = cw[chu], wu1 = cw[1536 + chu], wu2 = cw[3072 + chu], bu = cb[chu];
    const float wg0 = cw[chg], wg1 = cw[1536 + chg], wg2 = cw[3072 + chg], bg = cb[chg];
    const float bias = a.in[21][stage * 512 + c];
    const cpx wj = twid((float)j * (1.0f / 4096.0f)), wjp = twid((float)jp * (1.0f / 256.0f)), w8_ = twid((float)j * (1.0f / 8192.0f));
    cpx v[16];
    LAS cpx* Hs = buf + 2 * FFT_STRIDE + f * FFT_STRIDE + pc;
    { const cpx w8 = opaque(w8_);
#pragma unroll
    for (int r = 0; r < 16; ++r) { const unsigned n = (unsigned)j + 256u * r; const float fv = hf[n]; const float gq = hb[(SEQ - n) & 4095u]; const float gv = n ? gq : 0.f;
        const cpx wn = cmul(w8, c32(r)); const float d = fv - gv;
        v[r] = f ? make_cpx(d * wn.x, d * wn.y) : make_cpx(fv + gv, 0.f); } }
    dft16(v); apply_tw(v, wj);
#pragma unroll
    for (int q = 0; q < 16; ++q) bm[pj + 272 * q] = v[q];
    __syncthreads();
#pragma unroll
    for (int r = 0; r < 16; ++r) v[r] = bm[p16 + 17 * r];
    dft16(v); apply_tw(v, wjp);
#pragma unroll
    for (int q = 0; q < 16; ++q) bm[p16 + 17 * q] = v[q];
    __syncthreads();
#pragma unroll
    for (int r = 0; r < 16; ++r) v[r] = bm[pc + r];
    dft16(v);
#pragma unroll
    for (int q = 0; q < 16; ++q) Hs[q] = v[q];
    __syncthreads();
#pragma nounroll
    for (int bp = 0; bp < 2; ++bp) {
        const int b0 = 2 * bp, b1 = 2 * bp + 1;
        float uk0[8], uk1[8];
        {   float u0[16], u1[16];
            const unsigned uj = (unsigned)j;
            if (stage == 0) {
                const bf16* P0 = hyT + ((size_t)b0 * 1536 + chu) * SEQ; const bf16* P1 = hyT + ((size_t)b1 * 1536 + chu) * SEQ;
#pragma unroll
                for (int r = 0; r < 16; ++r) { const unsigned o = uj + 256u * r; if (r == 4 || r == 8 || r == 12) asm volatile("" ::: "memory");
                    const unsigned ol = (r == 0) ? (j ? uj - 1u : 0u) : o - 1u, orr = (r == 15) ? (j < 255 ? o + 1u : o) : o + 1u;
                    float l0 = HB(P0[ol]), l1 = HB(P1[ol]), r0 = HB(P0[orr]), r1 = HB(P1[orr]);
                    if (r == 0) { l0 = j ? l0 : 0.f; l1 = j ? l1 : 0.f; }
                    if (r == 15) { r0 = (j < 255) ? r0 : 0.f; r1 = (j < 255) ? r1 : 0.f; }
                    u0[r] = wu0 * l0 + wu1 * HB(P0[o]) + wu2 * r0 + bu; u1[r] = wu0 * l1 + wu1 * HB(P1[o]) + wu2 * r1 + bu; }
            } else {
                const float* P0 = zT + ((size_t)b0 * 512 + c) * SEQ; const float* P1 = zT + ((size_t)b1 * 512 + c) * SEQ;
#pragma unroll
                for (int r = 0; r < 16; ++r) { const unsigned o = uj + 256u * r; u0[r] = P0[o]; u1[r] = P1[o]; }
            }
#pragma unroll
            for (int i = 0; i < 8; ++i) { uk0[i] = f ? u0[2 * i + 1] : u0[2 * i]; uk1[i] = f ? u1[2 * i + 1] : u1[2 * i]; }
            const cpx w8 = opaque(w8_);
#pragma unroll
            for (int r = 0; r < 16; ++r) { const cpx x = make_cpx(u0[r], u1[r]); v[r] = f ? cmul(x, cmul(w8, c32(r))) : x; }
        }
        dft16(v); apply_tw(v, wj);
#pragma unroll
        for (int q = 0; q < 16; ++q) bm[pj + 272 * q] = v[q];
        __syncthreads();
#pragma unroll
        for (int r = 0; r < 16; ++r) v[r] = bm[p16 + 17 * r];
        dft16(v); apply_tw(v, wjp);
#pragma unroll
        for (int q = 0; q < 16; ++q) bm[p16 + 17 * q] = v[q];
        __syncthreads();
#pragma unroll
        for (int r = 0; r < 16; ++r) v[r] = bm[pc + r];
        dft16(v);
#pragma unroll
        for (int q = 0; q < 16; ++q) v[q] = cconj(cmul(v[q], Hs[q]));
        dft16(v);
#pragma unroll
        for (int q = 0; q < 16; ++q) bm[pc + q] = v[q];
        __syncthreads();
#pragma unroll
        for (int r = 0; r < 16; ++r) v[r] = bm[p16 + 17 * r];
        apply_tw(v, wjp); dft16(v);
#pragma unroll
        for (int q = 0; q < 16; ++q) bm[p16 + 17 * q] = v[q];
        __syncthreads();
        float gg0[8], gg1[8];
        {   float gt0[8][3], gt1[8][3];
            const bf16* G0 = hyT + ((size_t)b0 * 1536 + chg) * SEQ; const bf16* G1 = hyT + ((size_t)b1 * 1536 + chg) * SEQ;
            const unsigned gj = (unsigned)(j + 256 * f);
#pragma unroll
            for (int i = 0; i < 8; ++i) { const unsigned o = gj + 512u * i; if (i == 4) asm volatile("" ::: "memory");
                const unsigned ol = (i == 0) ? (gj ? gj - 1u : 0u) : o - 1u, orr = (i == 7) ? (o < 4095u ? o + 1u : o) : o + 1u;
                gt0[i][0] = HB(G0[ol]); gt0[i][1] = HB(G0[o]); gt0[i][2] = HB(G0[orr]); gt1[i][0] = HB(G1[ol]); gt1[i][1] = HB(G1[o]); gt1[i][2] = HB(G1[orr]);
                if (i == 0) { gt0[i][0] = gj ? gt0[i][0] : 0.f; gt1[i][0] = gj ? gt1[i][0] : 0.f; }
                if (i == 7) { gt0[i][2] = (o < 4095u) ? gt0[i][2] : 0.f; gt1[i][2] = (o < 4095u) ? gt1[i][2] : 0.f; } }
#pragma unroll
            for (int r = 0; r < 16; ++r) v[r] = bm[pj + 272 * r];
            apply_tw(v, wj); dft16(v);
#pragma unroll
            for (int q = 0; q < 16; ++q) bm[pj + 272 * q] = v[q];
#pragma unroll
            for (int i = 0; i < 8; ++i) { gg0[i] = wg0 * gt0[i][0] + wg1 * gt0[i][1] + wg2 * gt0[i][2] + bg; gg1[i] = wg0 * gt1[i][0] + wg1 * gt1[i][1] + wg2 * gt1[i][2] + bg; } }
        __syncthreads();
        const cpx w8 = opaque(w8_);
        float* O0 = outp + ((size_t)b0 * 512 + c) * SEQ; float* O1 = outp + ((size_t)b1 * 512 + c) * SEQ;
#pragma unroll
        for (int i = 0; i < 8; ++i) { const int rr = f + 2 * i; const unsigned n = (unsigned)(j + 256 * f) + 512u * i;
            const cpx ye = cconj(buf[pj + 272 * rr]), yo = cconj(buf[FFT_STRIDE + pj + 272 * rr]);
            const cpx wn = cmul(w8, f ? c32(2 * i + 1) : c32(2 * i));
            const cpx y = cadd(ye, cmul(cconj(wn), yo));
            const float y0 = y.x * (1.0f / 8192.0f) + bias * uk0[i], y1 = y.y * (1.0f / 8192.0f) + bias * uk1[i];
                        O0[n] = gg0[i] * y0; O1[n] = gg1[i] * y1; }
        __syncthreads();
    }
}

__device__ __forceinline__ f32x16 mfma32(bf16x8 a, bf16x8 b, f32x16 c) { return __builtin_amdgcn_mfma_f32_32x32x16_bf16(a, b, c, 0, 0, 0); }
typedef short s4v __attribute__((ext_vector_type(4)));
__device__ __forceinline__ bf16x8 tr_frag(const LAS bf16* base, int PT, int k0, int c0, int lane) {
    const int i = lane & 15, q = i >> 2, p = i & 3;
    const LAS bf16* ad = base + (k0 + 8 * (lane >> 5) + q) * PT + c0 + 16 * ((lane >> 4) & 1) + 4 * p;
    const s4v lo = __builtin_amdgcn_ds_read_tr16_b64_v4i16((LAS s4v*)ad);
    const s4v hi = __builtin_amdgcn_ds_read_tr16_b64_v4i16((LAS s4v*)(ad + 4 * PT));
    bf16x8 r; r[0] = lo[0]; r[1] = lo[1]; r[2] = lo[2]; r[3] = lo[3]; r[4] = hi[0]; r[5] = hi[1]; r[6] = hi[2]; r[7] = hi[3]; return r;
}
constexpr int GL_AL = 0, GL_WA = 8192, GL_TOT = 16384, GL_V = 24576, GL_VP = 160;
struct GlaTab { float P[4][2], X[4][2], Ptot[2], Xtot[2], Pref[2], Xref[2]; };
__device__ __forceinline__ void gla_tables(const Args& a, int h, LAS unsigned char* lds, GlaTab& T, int tid) {
    const int d2 = tid & 31, sg = tid >> 5;
    const LAS float* aL = (const LAS float*)(lds + GL_AL); const LAS float* wa = (const LAS float*)(lds + GL_WA); LAS float* tot = (LAS float*)(lds + GL_TOT);
    typedef float f32x2v __attribute__((ext_vector_type(2)));
    const f32x2v bf = *(const f32x2v*)(a.in[9] + h * 64 + 2 * d2), bb = *(const f32x2v*)(a.in[11] + h * 64 + 2 * d2);
    float lf[4][2], lb[4][2];
#pragma unroll
    for (int q = 0; q < 4; ++q) { const int s = sg * 4 + q; float pf0 = bf[0], pf1 = bf[1], pb0 = bb[0], pb1 = bb[1];
#pragma unroll
        for (int j4 = 0; j4 < 4; ++j4) { const f32x4 af = *(const LAS f32x4*)(aL + s * 32 + 4 * j4), ab = *(const LAS f32x4*)(aL + s * 32 + 16 + 4 * j4);
#pragma unroll
            for (int jj = 0; jj < 4; ++jj) { const int j = 4 * j4 + jj; const f32x2v wf = *(const LAS f32x2v*)(wa + j * 64 + 2 * d2), wb = *(const LAS f32x2v*)(wa + 1024 + j * 64 + 2 * d2);
                pf0 += af[jj] * wf[0]; pf1 += af[jj] * wf[1]; pb0 += ab[jj] * wb[0]; pb1 += ab[jj] * wb[1]; } }
        lf[q][0] = logsig_f(pf0) * (1.0f / 16.0f); lf[q][1] = logsig_f(pf1) * (1.0f / 16.0f); lb[q][0] = logsig_f(pb0) * (1.0f / 16.0f); lb[q][1] = logsig_f(pb1) * (1.0f / 16.0f); }
#pragma unroll
    for (int i = 0; i < 2; ++i) { lf[1][i] += lf[0][i]; lf[2][i] += lf[1][i]; lf[3][i] += lf[2][i]; lb[2][i] += lb[3][i]; lb[1][i] += lb[2][i]; lb[0][i] += lb[1][i]; }
    *(LAS f32x2v*)(tot + sg * 64 + 2 * d2) = (f32x2v){lf[3][0], lf[3][1]};
    *(LAS f32x2v*)(tot + 1024 + sg * 64 + 2 * d2) = (f32x2v){lb[0][0], lb[0][1]};
    __syncthreads();
    float of[2] = {0.f, 0.f}, ob[2] = {0.f, 0.f};
    T.Ptot[0] = T.Ptot[1] = T.Xtot[0] = T.Xtot[1] = T.Pref[0] = T.Pref[1] = T.Xref[0] = T.Xref[1] = 0.f;
#pragma unroll
    for (int g = 0; g < 16; ++g) { const f32x2v tf = *(const LAS f32x2v*)(tot + g * 64 + 2 * d2), tb = *(const LAS f32x2v*)(tot + 1024 + g * 64 + 2 * d2);
#pragma unroll
        for (int i = 0; i < 2; ++i) { T.Ptot[i] += tf[i]; T.Xtot[i] += tb[i]; if (g < 8) T.Pref[i] += tf[i]; else T.Xref[i] += tb[i];
            of[i] += (g < sg) ? tf[i] : 0.f; ob[i] += (g > sg) ? tb[i] : 0.f; } }
#pragma unroll
    for (int q = 0; q < 4; ++q)
#pragma unroll
        for (int i = 0; i < 2; ++i) { T.P[q][i] = lf[q][i] + of[i]; T.X[q][i] = lb[q][i] + ob[i]; }
}
struct GlaIn { f32x4 av, wv; unsigned kw[4], qw[4]; };
template <bool OUT>
__device__ __forceinline__ void gla_load(const Args& a, int tid, int bh, int ci, GlaIn& I) {
    const int b = bh >> 2, h = bh & 3, d2 = tid & 31, sg = tid >> 5;
    const size_t rowbase = OUT ? (size_t)b * SEQ + ci * 64 : ((ci < 4) ? (size_t)(MX + b * CTXL + ci * 64) : (size_t)(b * SEQ + (ci - 4) * 64));
    const float* afb = (const float*)(a.ws + WS_AFB); const bf16* qkvg = (const bf16*)(a.ws + WS_QKVG);
    I.av = *(const f32x4*)(afb + (rowbase + (tid >> 3)) * 32 + 4 * (tid & 7));
    const int wdir = tid >> 8, wj = (tid >> 4) & 15, wd4 = (tid & 15) * 4;
    I.wv = *(const f32x4*)((wdir ? a.in[10] : a.in[8]) + wj * 256 + h * 64 + wd4);
#pragma unroll
    for (int q = 0; q < 4; ++q) { const bf16* rp = qkvg + (rowbase + sg * 4 + q) * NQ + h * 64 + 2 * d2; I.kw[q] = *(const unsigned*)(rp + 256); if (OUT) I.qw[q] = *(const unsigned*)rp; }
}
__device__ __forceinline__ void gla_stage_common(const GlaIn& I, LAS unsigned char* lds, int tid) {
    const int wdir = tid >> 8, wj = (tid >> 4) & 15, wd4 = (tid & 15) * 4;
    *(LAS f32x4*)((LAS float*)(lds + GL_AL) + 4 * tid) = I.av;
    *(LAS f32x4*)((LAS float*)(lds + GL_WA) + wdir * 1024 + wj * 64 + wd4) = I.wv;
}

template <bool HASN>
__device__ __forceinline__ void gla_upd_item(const Args& a, LAS unsigned char* lds, int bh, int ci, const GlaIn& I, int nbh, int nci, GlaIn& N) {
    int tid = threadIdx.x; asm volatile("" : "+v"(tid));
    const int lane = tid & 63, wave = tid >> 6, h = bh & 3, d2 = tid & 31, sg = tid >> 5;
    unsigned char* ws = a.ws;
    constexpr int KP = 96;
    LAS bf16* vN = (LAS bf16*)(lds + GL_V); LAS bf16* kUf = (LAS bf16*)(lds + 45056); LAS bf16* kUb = (LAS bf16*)(lds + 57344);
    unsigned kw[4];
#pragma unroll
    for (int q = 0; q < 4; ++q) kw[q] = I.kw[q];
    v4u vv[2];
    { const int b = bh >> 2; const size_t rowbase = (ci < 4) ? (size_t)(MX + b * CTXL + ci * 64) : (size_t)(b * SEQ + (ci - 4) * 64); const bf16* qkvg = (const bf16*)(ws + WS_QKVG);
#pragma unroll
        for (int q = 0; q < 2; ++q) { const int idx = tid + NTHR * q; vv[q] = *(const v4u*)(qkvg + (rowbase + (idx >> 4)) * NQ + 512 + h * 128 + (idx & 15) * 8); } }
    gla_stage_common(I, lds, tid);
    __syncthreads();
    if (HASN) gla_load<false>(a, tid, nbh, nci, N);
    GlaTab T; gla_tables(a, h, lds, T, tid);
#pragma unroll
    for (int q = 0; q < 4; ++q) { const int s = sg * 4 + q; const float k0 = bflo(kw[q]), k1 = bfhi(kw[q]);
        *(LAS unsigned*)(kUf + s * KP + 2 * d2) = pk2(k0 * __expf(T.Ptot[0] - T.P[q][0]), k1 * __expf(T.Ptot[1] - T.P[q][1]));
        *(LAS unsigned*)(kUb + s * KP + 2 * d2) = pk2(k0 * __expf(T.Xtot[0] - T.X[q][0]), k1 * __expf(T.Xtot[1] - T.X[q][1])); }
#pragma unroll
    for (int q = 0; q < 2; ++q) { const int idx = tid + NTHR * q; *(LAS v4u*)(vN + (idx >> 4) * GL_VP + (idx & 15) * 8) = vv[q]; }
    if (tid < 32) { float* dec = (float*)(ws + WS_DEC);
#pragma unroll
        for (int i = 0; i < 2; ++i) { dec[((size_t)(bh * 2 + 0) * NCH + ci) * 64 + 2 * d2 + i] = __expf(T.Ptot[i]); dec[((size_t)(bh * 2 + 1) * NCH + ci) * 64 + 2 * d2 + i] = __expf(T.Xtot[i]); } }
    __syncthreads();
    { const int dir = wave >> 2, e0 = (wave & 3) * 32, l31 = lane & 31, hh = lane >> 5;
        const LAS bf16* kT = dir ? kUb : kUf;
        float* U = (ci < 4) ? (float*)(ws + WS_UCTX) + ((size_t)(bh * 2 + dir) * 4 + ci) * 8192 : a.out + ((size_t)(bh * 2 + dir) * 64 + (ci - 4)) * 8192;
        bf16x8 A[4];
#pragma unroll
        for (int ks = 0; ks < 4; ++ks) A[ks] = tr_frag(vN, GL_VP, 16 * ks, e0, lane);
#pragma unroll
        for (int dt = 0; dt < 2; ++dt) { const int d0 = dt * 32; f32x16 acc;
#pragma unroll
            for (int i = 0; i < 16; ++i) acc[i] = 0.f;
#pragma unroll
            for (int ks = 0; ks < 4; ++ks) acc = mfma32(A[ks], tr_frag(kT, KP, 16 * ks, d0, lane), acc);
#pragma unroll
            for (int r = 0; r < 16; ++r) { const int e = e0 + (r & 3) + 8 * (r >> 2) + 4 * hh; U[e * 64 + d0 + l31] = acc[r]; } } }
    __syncthreads();
}

__device__ __forceinline__ void gla_scan_item(const Args& a, int it) {
    int tid = threadIdx.x; asm volatile("" : "+v"(tid));
    const int bd = it >> 4, dir = bd & 1, el = ((it & 15) * 8 + (tid >> 6)) * 64 + (tid & 63), d = tid & 63;
    unsigned char* ws = a.ws;
    const float* dec = (const float*)(ws + WS_DEC) + (size_t)bd * NCH * 64 + d;
    const float* Uc = (const float*)(ws + WS_UCTX) + (size_t)bd * 4 * 8192 + el;
    const float* U = a.out + (size_t)bd * 64 * 8192 + el;
    bf16* Sp = (bf16*)(ws + WS_SPREV) + (size_t)bd * 64 * 8192 + el;
    float S = 0.f;
#pragma unroll
    for (int c4 = 0; c4 < 4; ++c4) { const int ci = dir ? 3 - c4 : c4; S = dec[ci * 64] * S + Uc[(size_t)ci * 8192]; }
#pragma unroll
    for (int blk = 0; blk < 2; ++blk) { float uu[32], dd[32];
#pragma unroll
        for (int j = 0; j < 32; ++j) { const int n = dir ? 63 - (blk * 32 + j) : blk * 32 + j; uu[j] = U[(size_t)n * 8192]; dd[j] = dec[(4 + n) * 64]; }
#pragma unroll
        for (int j = 0; j < 32; ++j) { const int n = dir ? 63 - (blk * 32 + j) : blk * 32 + j; Sp[(size_t)n * 8192] = (bf16)f2bf(S); S = dd[j] * S + uu[j]; } }
}

template <bool HASN>
__device__ __forceinline__ void gla_out_item(const Args& a, LAS unsigned char* lds, int bh, int n, const GlaIn& I, int nbh, int nn, GlaIn& N) {
    int tid = threadIdx.x; asm volatile("" : "+v"(tid));
    const int lane = tid & 63, wave = tid >> 6, b = bh >> 2, h = bh & 3, l31 = lane & 31, hh = lane >> 5, d2 = tid & 31, sg = tid >> 5;
    unsigned char* ws = a.ws;
    LAS bf16* Scat = (LAS bf16*)lds;
    LAS bf16* vN = (LAS bf16*)(lds + GL_V);
    LAS bf16* qf = (LAS bf16*)(lds + 45056); LAS bf16* qb = qf + 4608; LAS bf16* kf = qf + 2 * 4608; LAS bf16* kb = qf + 3 * 4608;
    LAS float* oS = (LAS float*)(lds + 45056);
    LAS bf16* qS = (LAS bf16*)(lds + 81920);
    LAS bf16* Sp = (LAS bf16*)(lds + 99328);
    const size_t rowbase = (size_t)b * SEQ + n * 64;
    unsigned qw[4], kw[4];
#pragma unroll
    for (int q = 0; q < 4; ++q) { qw[q] = I.qw[q]; kw[q] = I.kw[q]; }
    v4u vv[2], sv[4], g0, g1;
    { const bf16* qkvg = (const bf16*)(ws + WS_QKVG);
        { const bf16* gp = qkvg + (rowbase + (tid >> 3)) * NQ + 1024 + h * 128 + (tid & 7) * 16; g0 = *(const v4u*)gp; g1 = *(const v4u*)(gp + 8); }
#pragma unroll
        for (int q = 0; q < 2; ++q) { const int idx = tid + NTHR * q; vv[q] = *(const v4u*)(qkvg + (rowbase + (idx >> 4)) * NQ + 512 + h * 128 + (idx & 15) * 8); }
        const bf16* spf = (const bf16*)(ws + WS_SPREV) + ((size_t)(bh * 2 + 0) * 64 + n) * 8192; const bf16* spb = (const bf16*)(ws + WS_SPREV) + ((size_t)(bh * 2 + 1) * 64 + n) * 8192;
#pragma unroll
        for (int q = 0; q < 4; ++q) { const int idx = tid + NTHR * q, dir = idx >> 10, e = (idx >> 3) & 127, d8 = (idx & 7) * 8; sv[q] = *(const v4u*)((dir ? spb : spf) + e * 64 + d8); } }
    gla_stage_common(I, lds, tid);
    __syncthreads();
    if (HASN) gla_load<true>(a, tid, nbh, nn, N);
    GlaTab T; gla_tables(a, h, lds, T, tid);
#pragma unroll
    for (int q = 0; q < 4; ++q) { const int s = sg * 4 + q; const float q0 = bflo(qw[q]), q1 = bfhi(qw[q]), k0 = bflo(kw[q]), k1 = bfhi(kw[q]);
        *(LAS unsigned*)(qf + s * 72 + 2 * d2) = pk2(q0 * __expf(T.P[q][0] - T.Pref[0]), q1 * __expf(T.P[q][1] - T.Pref[1]));
        *(LAS unsigned*)(kf + s * 72 + 2 * d2) = pk2(k0 * __expf(T.Pref[0] - T.P[q][0]), k1 * __expf(T.Pref[1] - T.P[q][1]));
        *(LAS unsigned*)(qb + s * 72 + 2 * d2) = pk2(q0 * __expf(T.X[q][0] - T.Xref[0]), q1 * __expf(T.X[q][1] - T.Xref[1]));
        *(LAS unsigned*)(kb + s * 72 + 2 * d2) = pk2(k0 * __expf(T.Xref[0] - T.X[q][0]), k1 * __expf(T.Xref[1] - T.X[q][1]));
        *(LAS unsigned*)(qS + s * 136 + 2 * d2) = pk2(q0 * __expf(T.P[q][0]), q1 * __expf(T.P[q][1]));
        *(LAS unsigned*)(qS + s * 136 + 64 + 2 * d2) = pk2(q0 * __expf(T.X[q][0]), q1 * __expf(T.X[q][1])); }
#pragma unroll
    for (int q = 0; q < 2; ++q) { const int idx = tid + NTHR * q; *(LAS v4u*)(vN + (idx >> 4) * GL_VP + (idx & 15) * 8) = vv[q]; }
#pragma unroll
    for (int q = 0; q < 4; ++q) { const int idx = tid + NTHR * q, dir = idx >> 10, e = (idx >> 3) & 127, d8 = (idx & 7) * 8; *(LAS v4u*)(Sp + e * 136 + dir * 64 + d8) = sv[q]; }
    __syncthreads();
    { const int dir = wave >> 2, c0 = ((wave >> 1) & 1) * 32, s0 = (wave & 1) * 32;
        const LAS bf16* qq = dir ? qb : qf; const LAS bf16* kk = dir ? kb : kf;
        f32x16 acc;
#pragma unroll
        for (int i = 0; i < 16; ++i) acc[i] = 0.f;
#pragma unroll
        for (int ks = 0; ks < 4; ++ks) { const bf16x8 A = *(const LAS bf16x8*)(qq + (c0 + l31) * 72 + 16 * ks + 8 * hh), B = *(const LAS bf16x8*)(kk + (s0 + l31) * 72 + 16 * ks + 8 * hh);
            acc = mfma32(A, B, acc); }
        const int s = s0 + l31;
#pragma unroll
        for (int r = 0; r < 16; ++r) { const int c = c0 + (r & 3) + 8 * (r >> 2) + 4 * hh; const bool keep = dir ? (s >= c) : (s <= c);
            Scat[c * 136 + dir * 64 + s] = (bf16)f2bf(keep ? acc[r] : 0.f); } }
    __syncthreads();
    { const int c0 = (wave >> 2) * 32, e0 = (wave & 3) * 32;
        f32x16 acc;
#pragma unroll
        for (int i = 0; i < 16; ++i) acc[i] = 0.f;
#pragma unroll
        for (int ks = 0; ks < 8; ++ks) { const bf16x8 A = *(const LAS bf16x8*)(Scat + (c0 + l31) * 136 + 16 * ks + 8 * hh);
            acc = mfma32(A, tr_frag(vN, GL_VP, 16 * (ks & 3), e0, lane), acc); }
#pragma unroll
        for (int ks = 0; ks < 8; ++ks) { const bf16x8 A = *(const LAS bf16x8*)(qS + (c0 + l31) * 136 + 16 * ks + 8 * hh), B = *(const LAS bf16x8*)(Sp + (e0 + l31) * 136 + 16 * ks + 8 * hh);
            acc = mfma32(A, B, acc); }
#pragma unroll
        for (int r = 0; r < 16; ++r) { const int c = c0 + (r & 3) + 8 * (r >> 2) + 4 * hh; oS[c * 132 + e0 + l31] = acc[r]; } }
    __syncthreads();
    { const int row = tid >> 3, ec = (tid & 7) * 16; float v[16]; float ss = 0.f;
#pragma unroll
        for (int j = 0; j < 16; ++j) { v[j] = oS[row * 132 + ec + j]; ss += v[j] * v[j]; }
        ss += __shfl_xor(ss, 1); ss += __shfl_xor(ss, 2); ss += __shfl_xor(ss, 4);
        const float rs = rsqrtf(ss * (1.0f / 128.0f) + EPS);
        const float gv[16] = {bflo(g0.x), bfhi(g0.x), bflo(g0.y), bfhi(g0.y), bflo(g0.z), bfhi(g0.z), bflo(g0.w), bfhi(g0.w), bflo(g1.x), bfhi(g1.x), bflo(g1.y), bfhi(g1.y), bflo(g1.z), bfhi(g1.z), bflo(g1.w), bfhi(g1.w)};
        float o[16];
#pragma unroll
        for (int j = 0; j < 16; ++j) o[j] = DBG_GLA_K * v[j] * rs * a.in[12][ec + j] * silu_f(gv[j]);
        bf16* op = (bf16*)(ws + WS_AOUT) + (rowbase + row) * DM + h * 128 + ec;
        *(v4u*)op = (v4u){pk2(o[0], o[1]), pk2(o[2], o[3]), pk2(o[4], o[5]), pk2(o[6], o[7])};
        *(v4u*)(op + 8) = (v4u){pk2(o[8], o[9]), pk2(o[10], o[11]), pk2(o[12], o[13]), pk2(o[14], o[15])}; }
    __syncthreads();
}

__device__ __forceinline__ void hy_transpose_item(const Args& a, LAS unsigned char* lds, int it) {
    const int tid = threadIdx.x, b = it >> 6, t0 = (it & 63) * 64;
    LAS float* tile = (LAS float*)lds;
    const float* src = (const float*)(a.ws + WS_YHYT) + (size_t)b * 512 * SEQ + t0;
    bf16* dst = (bf16*)(a.ws + WS_AOUT) + ((size_t)b * SEQ + t0) * DM + 512;
    for (int half = 0; half < 2; ++half) {
#pragma unroll 8
        for (int q = 0; q < 32; ++q) { const int idx = tid + NTHR * q, c = idx >> 6, tt = idx & 63; tile[c * 65 + tt] = src[(size_t)(half * 256 + c) * SEQ + tt]; }
        __syncthreads();
#pragma unroll
        for (int q = 0; q < 4; ++q) { const int idx = tid + NTHR * q, t = idx >> 5, c8 = (idx & 31) * 8; const LAS float* s = tile + c8 * 65 + t;
            *(v4u*)(dst + (size_t)t * DM + half * 256 + c8) = (v4u){pk2(s[0], s[65]), pk2(s[2 * 65], s[3 * 65]), pk2(s[4 * 65], s[5 * 65]), pk2(s[6 * 65], s[7 * 65])}; }
        __syncthreads();
    }
}

__device__ __forceinline__ void phase_router(const Args& a, LAS unsigned char* lds) {
    const int tid = threadIdx.x, lane = tid & 63, wave = tid >> 6, wg = blockIdx.x, G = gridDim.x;
    unsigned char* ws = a.ws;
    LAS float* wr = (LAS float*)lds;
    for (int i = tid; i < 4096; i += NTHR) { const int l = i & 63, q = (i >> 6) & 3, j = (i >> 8) & 3, e4 = i >> 10;
        *(LAS f32x4*)(wr + 4 * i) = *(const f32x4*)(a.in[24] + (4 * l + 256 * j + q) * 16 + 4 * e4); }
    __syncthreads();
    const float* modr = (const float*)(ws + WS_MOD); const float* gffn = a.in[23];
    bf16* hn = (bf16*)(ws + WS_HN); float* aff = (float*)(ws + WS_AFF);
    const int NGW = G * NWAVES;
    f32x4 gv[4];
#pragma unroll
    for (int j = 0; j < 4; ++j) gv[j] = *(const f32x4*)(gffn + 4 * lane + 256 * j);
#pragma nounroll
    for (int r0 = wg * NWAVES + wave; r0 < MX; r0 += 2 * NGW) {
        const int r1 = r0 + NGW; const bool ok1 = r1 < MX; const int rB = ok1 ? r1 : r0;
        int lane_o = lane; asm volatile("" : "+v"(lane_o));
        f32x4 v[2][4];
#pragma unroll
        for (int j = 0; j < 4; ++j) { v[0][j] = *(const f32x4*)(a.out + (size_t)r0 * DM + 4 * lane + 256 * j); v[1][j] = *(const f32x4*)(a.out + (size_t)rB * DM + 4 * lane + 256 * j); }
        float rs[2];
#pragma unroll
        for (int k = 0; k < 2; ++k) { float ss = 0.f;
#pragma unroll
            for (int j = 0; j < 4; ++j) ss += v[k][j][0] * v[k][j][0] + v[k][j][1] * v[k][j][1] + v[k][j][2] * v[k][j][2] + v[k][j][3] * v[k][j][3];
            rs[k] = rsqrtf(wave_sum(ss) * (1.0f / DM) + EPS); }
        float lg[2][16];
#pragma unroll
        for (int k = 0; k < 2; ++k)
#pragma unroll
            for (int e = 0; e < 16; ++e) lg[k][e] = 0.f;
#pragma unroll
        for (int j = 0; j < 4; ++j) { const int col = 4 * lane + 256 * j; f32x4 y[2];
#pragma unroll
            for (int k = 0; k < 2; ++k) { const int r = k ? rB : r0, b = r >> 12;
                const f32x4 sh = *(const f32x4*)(modr + b * 6144 + 3072 + col), sc = *(const f32x4*)(modr + b * 6144 + 4096 + col);
                y[k] = (v[k][j] * rs[k] * gv[j]) * (sc + 1.0f) + sh;
                v2u w; w.x = pk2(y[k][0], y[k][1]); w.y = pk2(y[k][2], y[k][3]);
                if (k == 0 || ok1) *(v2u*)(hn + (size_t)r * DM + col) = w; }
#pragma unroll
            for (int q = 0; q < 4; ++q) {
#pragma unroll
                for (int e4 = 0; e4 < 4; ++e4) { const f32x4 ww = *(const LAS f32x4*)(wr + 4 * ((((e4 * 4 + j) * 4 + q) << 6) + lane_o));
#pragma unroll
                    for (int s = 0; s < 4; ++s) { lg[0][e4 * 4 + s] += y[0][q] * ww[s]; lg[1][e4 * 4 + s] += y[1][q] * ww[s]; } }
#define PIN16(x) asm volatile("" : "+v"(x[0]), "+v"(x[1]), "+v"(x[2]), "+v"(x[3]), "+v"(x[4]), "+v"(x[5]), "+v"(x[6]), "+v"(x[7]), "+v"(x[8]), "+v"(x[9]), "+v"(x[10]), "+v"(x[11]), "+v"(x[12]), "+v"(x[13]), "+v"(x[14]), "+v"(x[15]) :: "memory")
                PIN16(lg[0]); PIN16(lg[1]); } }
#undef PIN16
        const bool h5 = (lane & 32) != 0, h4 = (lane & 16) != 0, h3 = (lane & 8) != 0, h2 = (lane & 4) != 0;
        const int ex = (h5 ? 8 : 0) + (h4 ? 4 : 0) + (h3 ? 2 : 0) + (h2 ? 1 : 0);
#pragma unroll
        for (int k = 0; k < 2; ++k) { float k8[8], k4[4], k2[2], lgt;
#pragma unroll
            for (int i = 0; i < 8; ++i) { const float snd = h5 ? lg[k][i] : lg[k][8 + i], kp = h5 ? lg[k][8 + i] : lg[k][i]; k8[i] = kp + __shfl_xor(snd, 32); }
#pragma unroll
            for (int i = 0; i < 4; ++i) { const float snd = h4 ? k8[i] : k8[4 + i], kp = h4 ? k8[4 + i] : k8[i]; k4[i] = kp + __shfl_xor(snd, 16); }
#pragma unroll
            for (int i = 0; i < 2; ++i) { const float snd = h3 ? k4[i] : k4[2 + i], kp = h3 ? k4[2 + i] : k4[i]; k2[i] = kp + __shfl_xor(snd, 8); }
            { const float snd = h2 ? k2[0] : k2[1], kp = h2 ? k2[1] : k2[0]; lgt = kp + __shfl_xor(snd, 4); }
            lgt += __shfl_xor(lgt, 2); lgt += __shfl_xor(lgt, 1);
            float mx = lgt;
            mx = fmaxf(mx, __shfl_xor(mx, 4)); mx = fmaxf(mx, __shfl_xor(mx, 8)); mx = fmaxf(mx, __shfl_xor(mx, 16)); mx = fmaxf(mx, __shfl_xor(mx, 32));
            const float pe = expf(lgt - mx);
            float sum = pe;
            sum += __shfl_xor(sum, 4); sum += __shfl_xor(sum, 8); sum += __shfl_xor(sum, 16); sum += __shfl_xor(sum, 32);
            const int r = k ? rB : r0;
            if ((lane & 3) == 0 && (k == 0 || ok1)) aff[((size_t)(r >> 12) * NE + ex) * SEQ + (r & 4095)] = pe / sum; }
    }
}

__device__ __forceinline__ void conv_item(const Args& a, LAS float* scr, int lane, bool gu, int it) {
    unsigned char* ws = a.ws;
    if (gu) { const int mat = it >> 9, r = it & 511, nb = r >> 4, kb = r & 15, e = mat >> 1, kind = mat & 1, n0 = nb * 32;
        transpose_item((kind ? a.in[26] : a.in[25]) + (size_t)e * DM * DM, DM, kb * 64, n0, (bf16*)(ws + WS_WGU) + (size_t)e * 2048 * DM, DM, (n0 >> 7) * 256 + kind * 128 + (n0 & 127), scr, lane, false);
    } else { const int e = it >> 9, r = it & 511, nb = r >> 4, kb = r & 15;
        transpose_item(a.in[27] + (size_t)e * DM * DM, DM, kb * 64, nb * 32, (bf16*)(ws + WS_WD) + (size_t)e * DM * DM, DM, nb * 32, scr, lane, false); }
}
__device__ __forceinline__ bool conv_try(const Args& a, LAS unsigned char* lds, bool allow_gu, unsigned& cur) {
    const int lane = threadIdx.x & 63, wave = threadIdx.x >> 6;
    const int gw = blockIdx.x * NWAVES + wave, NGW = gridDim.x * NWAVES;
    LAS float* scr = (LAS float*)(lds + wave * 8448);
    const int itD = gw + (int)(cur & 0xffffu) * NGW;
    if (itD < NE * 512) { conv_item(a, scr, lane, false, itD); cur += 1u; return true; }
    if (!allow_gu) return false;
    const int itG = gw + (int)(cur >> 16) * NGW;
    if (itG < NE * 1024) { conv_item(a, scr, lane, true, itG); cur += 0x10000u; return true; }
    return false;
}
#ifndef DBG_NOSHADOW
#define DBG_NOSHADOW 0
#endif
__device__ __forceinline__ void seam_barrier(const XcdBarrier& b, const Args& a, LAS unsigned char* lds, volatile LAS unsigned* MISC, unsigned& gen, bool allow_gu, unsigned& cdone) {
    asm volatile("s_waitcnt vmcnt(0)" ::: "memory");
    __syncthreads();
    ++gen;
    if (threadIdx.x < 64) {
        if (threadIdx.x == 0) {
            unsigned* bar = b.bar;
            __builtin_amdgcn_s_waitcnt(0);
            unsigned nloc = b.st[0], nx = b.st[1];
            if (nloc == 0u) { xcd_barrier_complete(bar, b.x, nloc, nx); b.st[0] = nloc; b.st[1] = nx; }
            const unsigned old = xb_add(&bar[XB_XSUB(b.x)], 1u);
            const unsigned g2 = old / nloc;
            if (old + 1u == (g2 + 1u) * nloc) {
                __builtin_amdgcn_fence(__ATOMIC_RELEASE, "agent");
                asm volatile("s_waitcnt vmcnt(0)" ::: "memory");
                const unsigned og = xb_add(&bar[XB_TOP], 1u);
                const unsigned tg = og / nx;
                if (og + 1u == (tg + 1u) * nx) xb_add(&bar[XB_TOPGEN], 1u);
                else XB_SPIN(xb_ld(&bar[XB_TOPGEN]) == tg, bar);
                __builtin_amdgcn_fence(__ATOMIC_ACQUIRE, "agent");
                xb_add(&bar[XB_XGEN(b.x)], 1u);
                asm volatile("s_waitcnt vmcnt(0)" ::: "memory");
            } else {
                XB_SPIN(xb_ld(&bar[XB_XGEN(b.x)]) == g2, bar);
                __builtin_amdgcn_fence(__ATOMIC_ACQUIRE, "agent");
                asm volatile("s_waitcnt vmcnt(0)" ::: "memory");
            }
            MISC[16] = gen;
        }
    } else {
        unsigned spins = 0;
        while (MISC[16] != gen) { if (DBG_NOSHADOW || !conv_try(a, lds, allow_gu, cdone)) { __builtin_amdgcn_s_sleep(4); if (++spins > (1u << 22)) break; } }
    }
    __syncthreads();
}

__device__ __forceinline__ void block_excl_scan2(int& va, int& vb, LAS int* tmp) {
    const int tid = threadIdx.x, lane = tid & 63, wave = tid >> 6;
    int ia = va, ib = vb;
#pragma unroll
    for (int o = 1; o < 64; o <<= 1) { const int ta = __shfl_up(ia, o), tb = __shfl_up(ib, o); if (lane >= o) { ia += ta; ib += tb; } }
    if (lane == 63) { tmp[wave] = ia; tmp[8 + wave] = ib; }
    __syncthreads();
    int oa = 0, ob = 0;
#pragma unroll
    for (int w = 0; w < 8; ++w) { if (w < wave) { oa += tmp[w]; ob += tmp[8 + w]; } }
    va = oa + ia - va; vb = ob + ib - vb;
    __syncthreads();
}
__device__ __forceinline__ void topk_item(const Args& a, LAS unsigned char* lds, int be) {
    const int tid = threadIdx.x, b = be >> 4, e = be & 15;
    unsigned char* ws = a.ws;
    LAS unsigned* keys = (LAS unsigned*)lds;
    LAS unsigned* hist = (LAS unsigned*)(lds + 16384);
    LAS int* ctl = (LAS int*)(lds + 16384 + 1024);
    LAS int* tmp = (LAS int*)(lds + 16384 + 1024 + 64);
    const float* aff = (const float*)(ws + WS_AFF) + (size_t)be * SEQ;
    unsigned my[8];
#pragma unroll
    for (int i = 0; i < 8; ++i) { my[i] = __float_as_uint(aff[tid * 8 + i]); keys[tid * 8 + i] = my[i]; }
    unsigned prefix = 0u, mask = 0u; int need = CAP;
    for (int pass = 0; pass < 4; ++pass) {
        const int shift = 24 - 8 * pass;
        if (tid < 256) hist[tid] = 0u;
        __syncthreads();
#pragma unroll
        for (int i = 0; i < 8; ++i) if ((my[i] & mask) == prefix) atomicAdd((unsigned*)&hist[(my[i] >> shift) & 255u], 1u);
        __syncthreads();
        {
            int hv = (tid < 256) ? (int)hist[255 - tid] : 0, inc = hv;
#pragma unroll
            for (int o = 1; o < 64; o <<= 1) { const int t2 = __shfl_up(inc, o); if ((tid & 63) >= o) inc += t2; }
            if ((tid & 63) == 63) tmp[tid >> 6] = inc;
            __syncthreads();
            int off = 0;
#pragma unroll
            for (int w = 0; w < 4; ++w) if (w < (tid >> 6)) off += tmp[w];
            inc += off;
            if (tid < 256 && inc >= need && inc - hv < need) { ctl[0] = 255 - tid; ctl[1] = need - (inc - hv); }
        }
        __syncthreads();
        prefix |= ((unsigned)ctl[0]) << shift; mask |= 255u << shift; need = ctl[1];
        __syncthreads();
    }
    const unsigned T = prefix;
    int cg = 0, ce = 0;
#pragma unroll
    for (int i = 0; i < 8; ++i) { cg += (my[i] > T) ? 1 : 0; ce += (my[i] == T) ? 1 : 0; }
    int pg = cg, pe = ce;
    block_excl_scan2(pg, pe, tmp);
    int* slot_of = (int*)(ws + WS_SLOT) + (size_t)be * SEQ;
    int* selt = (int*)(ws + WS_SELT) + (e * 4 + b) * CAP; float* selv = (float*)(ws + WS_SELV) + (e * 4 + b) * CAP;
#pragma unroll
    for (int i = 0; i < 8; ++i) { const int t = tid * 8 + i; const bool gt = my[i] > T, eq = my[i] == T; const bool sel = gt || (eq && pe < need);
        const int slot = pg + (pe < need ? pe : need);
        slot_of[t] = sel ? slot : -1;
        if (sel) { selt[slot] = t; selv[slot] = __uint_as_float(my[i]); }
        pg += gt ? 1 : 0; pe += eq ? 1 : 0; }
    __syncthreads();
}
__device__ __forceinline__ void phase_topk(const Args& a, LAS unsigned char* lds, unsigned& cdone) {
    const int tid = threadIdx.x, lane = tid & 63, wave = tid >> 6, wg = blockIdx.x, G = gridDim.x;
    unsigned char* ws = a.ws;
    for (int it = wg; it < NB * NE; it += G) topk_item(a, lds, it);
    __syncthreads();
    while (conv_try(a, lds, true, cdone)) {}
}

__device__ __forceinline__ void phase_final(const Args& a) {
    const int tid = threadIdx.x, lane = tid & 63, wave = tid >> 6, wg = blockIdx.x, G = gridDim.x;
    unsigned char* ws = a.ws;
    const float* modr = (const float*)(ws + WS_MOD); const int* slot_of = (const int*)(ws + WS_SLOT); const bf16* ys = (const bf16*)(ws + WS_YSLAB);
    const int NGW = G * NWAVES;
    f32x4 gf[4];
#pragma unroll
    for (int j = 0; j < 4; ++j) gf[j] = *(const f32x4*)(a.in[28] + 4 * lane + 256 * j);
#pragma nounroll
    for (int r0 = wg * NWAVES + wave; r0 < MX; r0 += 4 * NGW) {
        int sv[4]; unsigned long long mk[4]; f32x4 v[4][4], m[4][4];
#pragma unroll
        for (int k = 0; k < 4; ++k) { const int r = r0 + k * NGW; const bool ok = r < MX; const int rc = ok ? r : r0, b = rc >> 12, t = rc & 4095;
            sv[k] = (lane < NE) ? slot_of[((size_t)b * NE + lane) * SEQ + t] : -1;
#pragma unroll
            for (int j = 0; j < 4; ++j) { v[k][j] = *(const f32x4*)(a.out + (size_t)rc * DM + 4 * lane + 256 * j); m[k][j] = (f32x4){0.f, 0.f, 0.f, 0.f}; }
            mk[k] = (ok && !DBG_NOMOE) ? __ballot(sv[k] >= 0) : 0ull; }
        while (mk[0] | mk[1] | mk[2] | mk[3]) {
            v2u w[4][4]; float wt[4];
#pragma unroll
            for (int k = 0; k < 4; ++k) { const bool has = mk[k] != 0ull; const int e = has ? (int)__ffsll((long long)mk[k]) - 1 : 0; mk[k] &= mk[k] - 1ull;
                const int rc = (r0 + k * NGW < MX) ? r0 + k * NGW : r0; const int sl = has ? __builtin_amdgcn_readlane(sv[k], e) : 0;
                const bf16* yp = ys + ((size_t)e * 2048 + (rc >> 12) * CAP + sl) * DM; wt[k] = has ? 1.f : 0.f;
#pragma unroll
                for (int j = 0; j < 4; ++j) w[k][j] = *(const v2u*)(yp + 4 * lane + 256 * j); }
#pragma unroll
            for (int k = 0; k < 4; ++k)
#pragma unroll
                for (int j = 0; j < 4; ++j) { m[k][j][0] += wt[k] * bflo(w[k][j].x); m[k][j][1] += wt[k] * bfhi(w[k][j].x); m[k][j][2] += wt[k] * bflo(w[k][j].y); m[k][j][3] += wt[k] * bfhi(w[k][j].y); }
        }
#pragma unroll
        for (int k = 0; k < 4; ++k) { const int r = r0 + k * NGW;
            if (r < MX) { const int b = r >> 12; float ss = 0.f; float* row = a.out + (size_t)r * DM;
#pragma unroll
                for (int j = 0; j < 4; ++j) { const int col = 4 * lane + 256 * j; v[k][j] = v[k][j] + *(const f32x4*)(modr + b * 6144 + 5120 + col) * m[k][j] * DBG_MOE_K;
                    ss += v[k][j][0] * v[k][j][0] + v[k][j][1] * v[k][j][1] + v[k][j][2] * v[k][j][2] + v[k][j][3] * v[k][j][3]; }
                const float rs = rsqrtf(wave_sum(ss) * (1.0f / DM) + EPS);
#pragma unroll
                for (int j = 0; j < 4; ++j) *(f32x4*)(row + 4 * lane + 256 * j) = v[k][j] * rs * gf[j]; } }
    }
}

__global__ void __launch_bounds__(NTHR, 2) fwd_kernel(Args a) {
    extern __shared__ __attribute__((aligned(16))) unsigned char lds_raw[];
    LAS unsigned char* lds = (LAS unsigned char*)lds_raw;
    const int tid = threadIdx.x, wg = blockIdx.x, G = gridDim.x;
    unsigned char* ws = a.ws;
    volatile LAS unsigned* MISC = (volatile LAS unsigned*)(lds + LDS_MISC);
    if (tid < 64) MISC[tid] = 0u;
    __syncthreads();
    unsigned bgen = 0u, cdone = 0u;
    XcdBarrier bar; bar.bar = (unsigned*)(ws + WS_CTL); bar.x = 0; bar.st = nullptr;
    if (a.ph_hi - a.ph_lo > 1) bar = xcd_barrier_post((unsigned*)(ws + WS_CTL), MISC + 8);
#ifndef PH_ONLY
#define PH_ONLY -1
#endif
#define IN(k) ((PH_ONLY < 0 || PH_ONLY == (k)) && a.ph_lo <= (k) && (k) < a.ph_hi)
#ifndef DBG_BAR2
#define DBG_BAR2 0
#endif
#define SEAM(k) do { if (IN(k) && IN((k) + 1)) { seam_barrier(bar, a, lds, MISC, bgen, (k) >= 6, cdone); if (DBG_BAR2) xcd_barrier(bar); } } while (0)
#ifndef DBG_DUP
#define DBG_DUP -1
#endif
#define REP(k) _Pragma("nounroll") for (int _rep = 0; _rep < ((DBG_DUP == (k)) ? 2 : 1); ++_rep, (void)((DBG_DUP == (k) && _rep == 1) ? (xcd_barrier(bar), 0) : 0))
    if (IN(0)) REP(0) { phase0(a, lds); } SEAM(0);
    if (IN(1)) REP(1) { phase1(a, lds); } SEAM(1);
    if (IN(2)) REP(2) {
        pg8::Gemm g{(const pg8::bf16_t*)ws, (const pg8::bf16_t*)ws, MT, NIN, DM}; InSched S; S.init(G, wg);
        EpiIn E{(bf16*)(ws + WS_QKVG), (bf16*)(ws + WS_HYT), (float*)(ws + WS_AFB)};
        pg8::gemm_phase<EpiIn, InSched, true, true>(lds, g, S, E);
    } SEAM(2);
    if (IN(3)) REP(3) {
        for (int it = wg; it < 512; it += G) hyena_item(a, lds, it, 0);
        {   GlaIn I, N; bool have = false;
            for (int r = wg + ((512 - wg + G - 1) / G) * G - 512; r < 16 * NCH; r += G) {
                const int nr = r + G; const bool hasn = nr < 16 * NCH;
                if (!have) { int t0 = threadIdx.x; asm volatile("" : "+v"(t0)); gla_load<false>(a, t0, r / NCH, r % NCH, I); have = true; }
                if (hasn) gla_upd_item<true>(a, lds, r / NCH, r % NCH, I, nr / NCH, nr % NCH, N); else gla_upd_item<false>(a, lds, r / NCH, r % NCH, I, 0, 0, N);
                I = N; } }
    } SEAM(3);
    if (IN(4)) REP(4) {
        for (int it = wg; it < 1024; it += G) { if (it < 512) hyena_item(a, lds, it, 1); else gla_scan_item(a, it - 512); }
    } SEAM(4);
    if (IN(5)) REP(5) {
        GlaIn I, N; bool have = false;
        for (int it = wg; it < 1280; it += G) {
            if (it >= 1024) { hy_transpose_item(a, lds, it - 1024); continue; }
            const int nr = it + G; const bool hasn = nr < 1024;
            if (!have) { int t0 = threadIdx.x; asm volatile("" : "+v"(t0)); gla_load<true>(a, t0, it >> 6, it & 63, I); have = true; }
            if (hasn) gla_out_item<true>(a, lds, it >> 6, it & 63, I, nr >> 6, nr & 63, N); else gla_out_item<false>(a, lds, it >> 6, it & 63, I, 0, 0, N);
            I = N; }
    } SEAM(5);
    if (IN(6)) REP(6) {
        pg8::Gemm g{(const pg8::bf16_t*)(ws + WS_AOUT), (const pg8::bf16_t*)(ws + WS_WOUT), MX, DM, DM}; pg8::StaticOrder S; S.init(MX, DM, G, wg);
        EpiOut E{a.in[0], (const float*)(ws + WS_POS), (const float*)(ws + WS_MOD), a.out};
        pg8::gemm_phase<EpiOut, pg8::StaticOrder, true, true>(lds, g, S, E);
    } SEAM(6);
    if (IN(7)) REP(7) { phase_router(a, lds); } SEAM(7);
    if (IN(8)) REP(8) { phase_topk(a, lds, cdone); } SEAM(8);
    if (IN(9)) REP(9) {
        pg8::Gemm g{(const pg8::bf16_t*)(ws + WS_HN), (const pg8::bf16_t*)(ws + WS_WGU), NE * 2048, NE * 2048, DM}; MoeSched<8> S; S.init(G, wg);
        EpiGU E{(bf16*)(ws + WS_HID)};
        pg8::gemm_phase_gather<EpiGU, MoeSched<8>, true, true>(lds, g, S, E, (const int*)(ws + WS_SELT));
    } SEAM(9);
    if (IN(10)) REP(10) {
        pg8::Gemm g{(const pg8::bf16_t*)(ws + WS_HID), (const pg8::bf16_t*)(ws + WS_WD), NE * 2048, NE * 1024, DM}; MoeSched<4> S; S.init(G, wg);
        EpiDown E{(bf16*)(ws + WS_YSLAB), (const float*)(ws + WS_SELV)};
        pg8::gemm_phase<EpiDown, MoeSched<4>, true, true>(lds, g, S, E);
    } SEAM(10);
    if (IN(11)) { phase_final(a); }
#undef IN
#undef SEAM
}


#ifdef DBG_STATE
__global__ void chk_kernel(const unsigned* p, size_t nwords, unsigned long long* out) {
    unsigned long long s = 0ull;
    for (size_t i = (size_t)blockIdx.x * blockDim.x + threadIdx.x; i < nwords; i += (size_t)gridDim.x * blockDim.x) s += (unsigned long long)p[i] * (2ull * i + 1ull);
    for (int o = 1; o < 64; o <<= 1) s += __shfl_xor(s, o);
    if ((threadIdx.x & 63) == 0) atomicAdd(out, s);
}
__global__ void report_kernel(const unsigned long long* chk, float* out, int n) {
    int bad = -1;
    for (int p = 0; p < 27; ++p) if (chk[p] != chk[32 + p]) { bad = p; break; }
    if (bad < 0) return;
    for (int i = blockIdx.x * blockDim.x + threadIdx.x; i < n; i += gridDim.x * blockDim.x) out[i] = 1000.f * (float)(bad + 1);
}
struct ChkEnt { int ph; size_t off; size_t bytes; };
#endif
extern "C" void kernel_launch(void* const* d_in, const int* in_sizes, int n_in, void* d_out, int out_size, void* d_ws, size_t ws_size, hipStream_t stream) {
    static int grid = 0;
    if (grid == 0) {
        if (n_in != 29 || out_size != MX * DM || ws_size < WS_END) { fprintf(stderr, "kernel_launch: unexpected shapes (n_in %d out %d ws %zu)\n", n_in, out_size, ws_size); grid = -1; return; }
        int dev = 0, cus = 0, per_cu = 0;
        if (hipGetDevice(&dev) != hipSuccess || hipDeviceGetAttribute(&cus, hipDeviceAttributeMultiprocessorCount, dev) != hipSuccess) { grid = -1; return; }
        if (hipFuncSetAttribute((const void*)fwd_kernel, hipFuncAttributeMaxDynamicSharedMemorySize, LDS_BYTES) != hipSuccess) { fprintf(stderr, "kernel_launch: hipFuncSetAttribute failed\n"); grid = -1; return; }
        if (hipOccupancyMaxActiveBlocksPerMultiprocessor(&per_cu, (const void*)fwd_kernel, NTHR, LDS_BYTES) != hipSuccess || per_cu < 1) fprintf(stderr, "kernel_launch: occupancy query reports %d\n", per_cu);
        (void)hipGetLastError();
        grid = cus;
    }
    if (grid < 0) return;
    (void)hipMemsetAsync((char*)d_ws + WS_CTL, 0, CTL_BYTES, stream);
    Args a{};
    for (int i = 0; i < 29; ++i) a.in[i] = (const float*)d_in[i];
    a.out = (float*)d_out; a.ws = (unsigned char*)d_ws;
#if MK_SINGLE
    a.ph_lo = 0; a.ph_hi = NPH;
    hipLaunchKernelGGL(fwd_kernel, dim3(grid), dim3(NTHR), LDS_BYTES, stream, a);
#else
#ifdef DBG_STATE
    static const ChkEnt ents[] = { {0, WS_MOD, 122880}, {0, WS_POS, 131072}, {0, WS_HT, 32 * MiB}, {0, WS_WIN, (size_t)NIN * DM * 2}, {0, WS_WOUT, 2 * MiB},
        {1, WS_AIN, 34 * MiB}, {2, WS_QKVG, (size_t)MX * NQ * 2}, {2, WS_HYT, 48 * MiB}, {2, WS_AFB, (size_t)MT * 128},
        {3, WS_ZT, 32 * MiB}, {3, WS_DEC, (size_t)16 * 2 * NCH * 64 * 4}, {3, WS_UCTX, 4 * MiB}, {3, (size_t)-1, 64 * MiB},
        {4, WS_SPREV, 32 * MiB}, {4, WS_YHYT, 32 * MiB}, {5, WS_AOUT, 32 * MiB}, {6, (size_t)-1, 64 * MiB}, {7, WS_HN, 32 * MiB}, {7, WS_AFF, 1 * MiB},
        {8, WS_SLOT, 1 * MiB}, {8, WS_SELT, 131072}, {8, WS_SELV, 131072}, {8, WS_WGU, 64 * MiB}, {8, WS_WD, 32 * MiB}, {9, WS_HID, 64 * MiB}, {10, WS_YSLAB, 64 * MiB}, {11, (size_t)-1, 64 * MiB} };
    unsigned long long* chk = (unsigned long long*)((char*)d_ws + 32768);
    for (int run = 0; run < 2; ++run)
        for (int p = 0; p < NPH; ++p) { a.ph_lo = p; a.ph_hi = p + 1; hipLaunchKernelGGL(fwd_kernel, dim3(grid), dim3(NTHR), LDS_BYTES, stream, a);
            for (const ChkEnt& e : ents) if (e.ph == p) hipLaunchKernelGGL(chk_kernel, dim3(1024), dim3(256), 0, stream, (const unsigned*)(e.off == (size_t)-1 ? (char*)d_out : (char*)d_ws + e.off), e.bytes / 4, chk + run * 32 + (int)(&e - ents)); }
    hipLaunchKernelGGL(report_kernel, dim3(1024), dim3(256), 0, stream, (const unsigned long long*)chk, (float*)d_out, out_size);
#else
    for (int p = 0; p < NPH; ++p) { a.ph_lo = p; a.ph_hi = p + 1; hipLaunchKernelGGL(fwd_kernel, dim3(grid), dim3(NTHR), LDS_BYTES, stream, a); }
#endif
#endif
}
```

```cpp
#include <hip/hip_runtime.h>
#include <cstdio>
#include <cstdint>
#define MK_SINGLE 1
namespace pg8 {
#define PG8_LAS __attribute__((address_space(3)))
typedef unsigned short bf16_t;
typedef short bf16x8 __attribute__((ext_vector_type(8)));
typedef float f32x4 __attribute__((ext_vector_type(4)));
typedef unsigned u32x4 __attribute__((ext_vector_type(4)));
constexpr int BM = 256, BK = 64, HALF = 128, HTB = HALF * BK * 2  , STAGE_BYTES = 8 * HTB, NXCD = 8, WGM = 8;

__host__ __device__ __forceinline__ int lds_byte(int r, int c) { const int st = (r >> 4) * 2 + (c >> 5), rr = r & 15, cc = c & 31, ob = rr * 64 + cc * 2; return st * 1024 + (ob ^ (((ob >> 9) & 1) << 5)); }
__host__ __device__ __forceinline__ void stage_rc(int b, int& R, int& C) { const int st = b / 1024, sb = b % 1024, swz = sb ^ (((sb >> 9) & 1) << 5); R = (st >> 1) * 16 + swz / 64; C = (st & 1) * 32 + (swz % 64) / 2; }
__host__ __device__ __forceinline__ int perm32(int rho) { const int n = rho >> 4, i = rho & 15; return 8 * (i >> 2) + 4 * n + (i & 3); }

struct Unit { int pm, pn; };
struct Gemm { const bf16_t* A; const bf16_t* Bt; int M, N, K; };

struct StaticOrder {
    int nM, nN, nwg, G, c;
    __host__ __device__ void init(int M, int N, int G_, int c_) { nM = M / BM; nN = N / BM; nwg = nM * nN; G = G_; c = c_; }
    __host__ __device__ bool next(int i, Unit& u) const {
        const long L = (long)i * G + c; if (L >= nwg) return false;
        int wgid = (int)L; { const int q = nwg / NXCD, r = nwg % NXCD, xcd = wgid % NXCD, off = wgid / NXCD; wgid = (xcd < r ? xcd * (q + 1) : r * (q + 1) + (xcd - r) * q) + off; }
        const int nig = WGM * nN, gid = wgid / nig, fm = gid * WGM, gsz = (nM - fm) < WGM ? (nM - fm) : WGM;
        u.pm = fm + ((wgid % nig) % gsz); u.pn = (wgid % nig) / gsz; return true;
    }
    __device__ __forceinline__ void a_ready(const Unit&) const {}
    __device__ __forceinline__ void done(const Unit&) const {}
};

__device__ __forceinline__ unsigned cvt_pk_bf16(float lo, float hi) { unsigned r; asm volatile("v_cvt_pk_bf16_f32 %0, %1, %2" : "=v"(r) : "v"(lo), "v"(hi)); return r; }
template <class Epi, class Sched, bool ALIGN_EPI = false, bool SP2 = false>
__device__ __forceinline__ void gemm_phase(PG8_LAS unsigned char* lds, const Gemm g, const Sched& S, const Epi& E) {
    const int tid = threadIdx.x, wid = __builtin_amdgcn_readfirstlane(tid >> 6), lane = tid & 63, wr = wid >> 2, wc = wid & 3, fr = lane & 15, fq = lane >> 4;
    const int K = g.K, nt = K / BK;
    unsigned voffA[2], voffB[2];
#pragma unroll
    for (int i = 0; i < 2; ++i) { int R, C; stage_rc(tid * 16 + i * 8192, R, C); const int Rb = Epi::PERM ? ((R & ~31) + perm32(R & 31)) : R;
        voffA[i] = (unsigned)(R * K + C) * 2u; voffB[i] = (unsigned)(Rb * K + C) * 2u; }
    const size_t kstep = (size_t)(BK * 2);
    const size_t hstep = (size_t)HALF * K * 2;
    const size_t tstep = 2 * hstep;
    const unsigned ldsw = (unsigned)wid * 1024u;
    const int aoff = lds_byte(wr * 64 + fr, fq * 8), boff = lds_byte(wc * 32 + fr, fq * 8);
#define PG8_SA(b, h) (((b) * 2 + (h)) * HTB)
#define PG8_SB(b, h) ((4 + (b) * 2 + (h)) * HTB)
#define PG8_STAGE(bufoff, gbase, voff) do { _Pragma("unroll") for (int _i = 0; _i < 2; ++_i) \
        __builtin_amdgcn_global_load_lds((const unsigned*)((const char*)(gbase) + (voff)[_i]), (PG8_LAS unsigned*)(lds + (bufoff) + ldsw + _i * 8192), 16, 0, 0); } while (0)
#define PG8_LDA(dst, b, h) do { _Pragma("unroll") for (int m = 0; m < 4; ++m) _Pragma("unroll") for (int k = 0; k < 2; ++k) dst[m][k] = *(const PG8_LAS bf16x8*)(lds + PG8_SA(b, h) + aoff + m * 2048 + k * 1024); } while (0)
#define PG8_LDB(dst, b, h) do { _Pragma("unroll") for (int n = 0; n < 2; ++n) _Pragma("unroll") for (int k = 0; k < 2; ++k) dst[n][k] = *(const PG8_LAS bf16x8*)(lds + PG8_SB(b, h) + boff + n * 2048 + k * 1024); } while (0)
#define PG8_MMA(ai, bj, At, Bt) do { __builtin_amdgcn_s_setprio(1); _Pragma("unroll") for (int m = 0; m < 4; ++m) _Pragma("unroll") for (int n = 0; n < 2; ++n) _Pragma("unroll") for (int k = 0; k < 2; ++k) \
        acc[ai][bj][m][n] = __builtin_amdgcn_mfma_f32_16x16x32_bf16(Bt[n][k], At[m][k], acc[ai][bj][m][n], 0, 0, 0); __builtin_amdgcn_s_setprio(0); } while (0)
#define PG8_WAIT_V(n) asm volatile("s_waitcnt vmcnt(" #n ")" ::: "memory")
#define PG8_WAIT_L(n) asm volatile("s_waitcnt lgkmcnt(" #n ")" ::: "memory")
#define PG8_BAR __builtin_amdgcn_s_barrier()
#define PG8_SCHED __builtin_amdgcn_sched_barrier(0)
    Unit cur, nxt; int ui = 0;
    if (!S.next(0, cur)) return;
    f32x4 acc[2][2][4][2];
#pragma unroll
    for (int a = 0; a < 2; ++a)
#pragma unroll
        for (int b = 0; b < 2; ++b)
#pragma unroll
            for (int m = 0; m < 4; ++m)
#pragma unroll
                for (int n = 0; n < 2; ++n) acc[a][b][m][n] = (f32x4){0.f, 0.f, 0.f, 0.f};
    bf16x8 At[4][2], B0[2][2], B1[2][2];
    const char* cA = (const char*)g.A + (size_t)cur.pm * tstep; const char* cB = (const char*)g.Bt + (size_t)cur.pn * tstep;
    S.a_ready(cur);
    if constexpr (SP2) {
        PG8_STAGE(PG8_SB(0, 0), cB, voffB); PG8_STAGE(PG8_SB(0, 1), cB + hstep, voffB); PG8_STAGE(PG8_SA(0, 0), cA, voffA); PG8_STAGE(PG8_SA(0, 1), cA + hstep, voffA);
        if (wr == 1) PG8_BAR;
        PG8_WAIT_V(2); PG8_BAR;
        PG8_STAGE(PG8_SB(1, 0), cB + kstep, voffB); PG8_STAGE(PG8_SA(1, 0), cA + kstep, voffA); PG8_STAGE(PG8_SB(1, 1), cB + hstep + kstep, voffB);
        PG8_WAIT_V(6); PG8_BAR;
    } else {
        PG8_STAGE(PG8_SB(0, 0), cB, voffB); PG8_STAGE(PG8_SA(0, 0), cA, voffA); PG8_STAGE(PG8_SB(0, 1), cB + hstep, voffB); PG8_STAGE(PG8_SA(0, 1), cA + hstep, voffA);
        if (wr == 1) PG8_BAR;
        PG8_WAIT_V(4); PG8_BAR;
        PG8_STAGE(PG8_SB(1, 0), cB + kstep, voffB); PG8_STAGE(PG8_SA(1, 0), cA + kstep, voffA); PG8_STAGE(PG8_SB(1, 1), cB + hstep + kstep, voffB);
        PG8_WAIT_V(6); PG8_BAR;
    }
    for (;;) {
        const bool has_next = S.next(ui + 1, nxt);
        const char* nA = has_next ? (const char*)g.A + (size_t)nxt.pm * tstep : cA; const char* nB = has_next ? (const char*)g.Bt + (size_t)nxt.pn * tstep : cB;
        for (int t = 0; t < nt; t += 2) {
            const bool last = (t == nt - 2);
            const char* a1 = cA + (size_t)(t + 1) * kstep;
            const char* a2 = last ? nA : cA + (size_t)(t + 2) * kstep; const char* b2 = last ? nB : cB + (size_t)(t + 2) * kstep;
            const char* a3 = a2 + kstep; const char* b3 = b2 + kstep;
            if (last && has_next) S.a_ready(nxt);
            if constexpr (SP2) {
            PG8_LDB(B0, 0, 0); PG8_LDB(B1, 0, 1); PG8_SCHED; PG8_LDA(At, 0, 0); PG8_STAGE(PG8_SA(1, 1), a1 + hstep, voffA);
            PG8_WAIT_V(8); PG8_WAIT_L(0); PG8_BAR; PG8_MMA(0, 0, At, B0); PG8_MMA(0, 1, At, B1); PG8_BAR; PG8_SCHED;
            PG8_LDA(At, 0, 1); PG8_STAGE(PG8_SB(0, 0), b2, voffB); PG8_STAGE(PG8_SB(0, 1), b2 + hstep, voffB); PG8_STAGE(PG8_SA(0, 0), a2, voffA);
            PG8_WAIT_V(8); PG8_WAIT_L(0); PG8_BAR; PG8_MMA(1, 0, At, B0); PG8_MMA(1, 1, At, B1); PG8_BAR; PG8_SCHED;
            PG8_LDB(B0, 1, 0); PG8_LDB(B1, 1, 1); PG8_SCHED; PG8_LDA(At, 1, 0); PG8_STAGE(PG8_SA(0, 1), a2 + hstep, voffA);
            PG8_WAIT_V(8); PG8_WAIT_L(0); PG8_BAR; PG8_MMA(0, 0, At, B0); PG8_MMA(0, 1, At, B1); PG8_BAR; PG8_SCHED;
            PG8_LDA(At, 1, 1); PG8_STAGE(PG8_SB(1, 0), b3, voffB); PG8_STAGE(PG8_SB(1, 1), b3 + hstep, voffB); PG8_STAGE(PG8_SA(1, 0), a3, voffA);
            PG8_WAIT_V(8); PG8_WAIT_L(0); PG8_BAR; PG8_MMA(1, 0, At, B0); PG8_MMA(1, 1, At, B1); PG8_BAR; PG8_SCHED;
            } else {
            PG8_LDB(B0, 0, 0); PG8_SCHED; PG8_LDA(At, 0, 0); PG8_STAGE(PG8_SA(1, 1), a1 + hstep, voffA);
            PG8_WAIT_L(8); PG8_BAR; PG8_WAIT_L(0); PG8_MMA(0, 0, At, B0); PG8_BAR; PG8_SCHED;
            PG8_LDB(B1, 0, 1); PG8_STAGE(PG8_SB(0, 0), b2, voffB);
            PG8_BAR; PG8_WAIT_L(0); PG8_MMA(0, 1, At, B1); PG8_BAR;
            PG8_LDA(At, 0, 1); PG8_STAGE(PG8_SA(0, 0), a2, voffA);
            PG8_BAR; PG8_WAIT_L(0); PG8_MMA(1, 0, At, B0); PG8_BAR; PG8_SCHED;
            PG8_STAGE(PG8_SB(0, 1), b2 + hstep, voffB);
            PG8_WAIT_V(6); PG8_BAR; PG8_MMA(1, 1, At, B1); PG8_BAR;
            PG8_LDB(B0, 1, 0); PG8_SCHED; PG8_LDA(At, 1, 0); PG8_STAGE(PG8_SA(0, 1), a2 + hstep, voffA);
            PG8_WAIT_L(8); PG8_BAR; PG8_WAIT_L(0); PG8_MMA(0, 0, At, B0); PG8_BAR; PG8_SCHED;
            PG8_LDB(B1, 1, 1); PG8_STAGE(PG8_SB(1, 0), b3, voffB);
            PG8_BAR; PG8_WAIT_L(0); PG8_MMA(0, 1, At, B1); PG8_BAR;
            PG8_LDA(At, 1, 1); PG8_STAGE(PG8_SA(1, 0), a3, voffA);
            PG8_BAR; PG8_WAIT_L(0); PG8_MMA(1, 0, At, B0); PG8_BAR; PG8_SCHED;
            PG8_STAGE(PG8_SB(1, 1), b3 + hstep, voffB);
            PG8_WAIT_V(6); PG8_BAR; PG8_MMA(1, 1, At, B1); PG8_BAR;
            }
        }
        if constexpr (ALIGN_EPI) { if (wr == 0) PG8_BAR; }
        if constexpr (!Epi::AFTER_DRAIN) { E(acc, cur, wr, wc, fr, fq); S.done(cur); }
        if (!has_next) break;
#pragma unroll
        for (int a = 0; a < 2; ++a)
#pragma unroll
            for (int b = 0; b < 2; ++b)
#pragma unroll
                for (int m = 0; m < 4; ++m)
#pragma unroll
                    for (int n = 0; n < 2; ++n) acc[a][b][m][n] = (f32x4){0.f, 0.f, 0.f, 0.f};
        cur = nxt; cA = nA; cB = nB; ++ui;
        if constexpr (ALIGN_EPI) { if (wr == 1) PG8_BAR; }
    }
    PG8_WAIT_V(0);
    if constexpr (!ALIGN_EPI) { if (wr == 0) PG8_BAR; }
    PG8_BAR;
    if constexpr (Epi::AFTER_DRAIN) { E.fused(acc, cur, wr, wc, fr, fq, lds, wid, lane); S.done(cur); }
#undef PG8_SA
#undef PG8_SB
#undef PG8_STAGE
#undef PG8_LDA
#undef PG8_LDB
#undef PG8_MMA
#undef PG8_WAIT_V
#undef PG8_WAIT_L
#undef PG8_BAR
#undef PG8_SCHED
}
}
namespace pg8 {
template <class Epi, class Sched, bool ALIGN_EPI = false, bool SP2 = false>
__device__ __forceinline__ void gemm_phase_gather(PG8_LAS unsigned char* lds, const Gemm g, const Sched& S, const Epi& E, const int* __restrict__ idx) {
    const int tid = threadIdx.x, wid = __builtin_amdgcn_readfirstlane(tid >> 6), lane = tid & 63, wr = wid >> 2, wc = wid & 3, fr = lane & 15, fq = lane >> 4;
    const int K = g.K, nt = K / BK;
    unsigned voffB[2]; int RA[2], CA[2];
#pragma unroll
    for (int i = 0; i < 2; ++i) { int R, C; stage_rc(tid * 16 + i * 8192, R, C); const int Rb = Epi::PERM ? ((R & ~31) + perm32(R & 31)) : R;
        RA[i] = R; CA[i] = C; voffB[i] = (unsigned)(Rb * K + C) * 2u; }
    unsigned vA[2][2], nvA[2][2];
#define PG8_GOFF(dst, pm) do { _Pragma("unroll") for (int _h = 0; _h < 2; ++_h) _Pragma("unroll") for (int _i = 0; _i < 2; ++_i) { const int _r = (pm) * 256 + _h * 128 + RA[_i]; \
        dst[_h][_i] = (unsigned)((((_r >> 9) & 3) * 4096 + idx[_r]) * K + CA[_i]) * 2u; } } while (0)
    const size_t kstep = (size_t)(BK * 2);
    const size_t hstep = (size_t)HALF * K * 2;
    const size_t tstep = 2 * hstep;
    const unsigned ldsw = (unsigned)wid * 1024u;
    const int aoff = lds_byte(wr * 64 + fr, fq * 8), boff = lds_byte(wc * 32 + fr, fq * 8);
#define PG8_SA(b, h) (((b) * 2 + (h)) * HTB)
#define PG8_SB(b, h) ((4 + (b) * 2 + (h)) * HTB)
#define PG8_STAGE(bufoff, gbase, voff) do { _Pragma("unroll") for (int _i = 0; _i < 2; ++_i) \
        __builtin_amdgcn_global_load_lds((const unsigned*)((const char*)(gbase) + (voff)[_i]), (PG8_LAS unsigned*)(lds + (bufoff) + ldsw + _i * 8192), 16, 0, 0); } while (0)
#define PG8_LDA(dst, b, h) do { _Pragma("unroll") for (int m = 0; m < 4; ++m) _Pragma("unroll") for (int k = 0; k < 2; ++k) dst[m][k] = *(const PG8_LAS bf16x8*)(lds + PG8_SA(b, h) + aoff + m * 2048 + k * 1024); } while (0)
#define PG8_LDB(dst, b, h) do { _Pragma("unroll") for (int n = 0; n < 2; ++n) _Pragma("unroll") for (int k = 0; k < 2; ++k) dst[n][k] = *(const PG8_LAS bf16x8*)(lds + PG8_SB(b, h) + boff + n * 2048 + k * 1024); } while (0)
#define PG8_MMA(ai, bj, At, Bt) do { __builtin_amdgcn_s_setprio(1); _Pragma("unroll") for (int m = 0; m < 4; ++m) _Pragma("unroll") for (int n = 0; n < 2; ++n) _Pragma("unroll") for (int k = 0; k < 2; ++k) \
        acc[ai][bj][m][n] = __builtin_amdgcn_mfma_f32_16x16x32_bf16(Bt[n][k], At[m][k], acc[ai][bj][m][n], 0, 0, 0); __builtin_amdgcn_s_setprio(0); } while (0)
#define PG8_WAIT_V(n) asm volatile("s_waitcnt vmcnt(" #n ")" ::: "memory")
#define PG8_WAIT_L(n) asm volatile("s_waitcnt lgkmcnt(" #n ")" ::: "memory")
#define PG8_BAR __builtin_amdgcn_s_barrier()
#define PG8_SCHED __builtin_amdgcn_sched_barrier(0)
    Unit cur, nxt; int ui = 0;
    if (!S.next(0, cur)) return;
    f32x4 acc[2][2][4][2];
#pragma unroll
    for (int a = 0; a < 2; ++a)
#pragma unroll
        for (int b = 0; b < 2; ++b)
#pragma unroll
            for (int m = 0; m < 4; ++m)
#pragma unroll
                for (int n = 0; n < 2; ++n) acc[a][b][m][n] = (f32x4){0.f, 0.f, 0.f, 0.f};
    bf16x8 At[4][2], B0[2][2], B1[2][2];
    const char* cA = (const char*)g.A; PG8_GOFF(vA, cur.pm); const char* cB = (const char*)g.Bt + (size_t)cur.pn * tstep;
    S.a_ready(cur);
    if constexpr (SP2) {
        PG8_STAGE(PG8_SB(0, 0), cB, voffB); PG8_STAGE(PG8_SB(0, 1), cB + hstep, voffB); PG8_STAGE(PG8_SA(0, 0), cA, vA[0]); PG8_STAGE(PG8_SA(0, 1), cA, vA[1]);
        if (wr == 1) PG8_BAR;
        PG8_WAIT_V(2); PG8_BAR;
        PG8_STAGE(PG8_SB(1, 0), cB + kstep, voffB); PG8_STAGE(PG8_SA(1, 0), cA + kstep, vA[0]); PG8_STAGE(PG8_SB(1, 1), cB + hstep + kstep, voffB);
        PG8_WAIT_V(6); PG8_BAR;
    } else {
        PG8_STAGE(PG8_SB(0, 0), cB, voffB); PG8_STAGE(PG8_SA(0, 0), cA, vA[0]); PG8_STAGE(PG8_SB(0, 1), cB + hstep, voffB); PG8_STAGE(PG8_SA(0, 1), cA, vA[1]);
        if (wr == 1) PG8_BAR;
        PG8_WAIT_V(4); PG8_BAR;
        PG8_STAGE(PG8_SB(1, 0), cB + kstep, voffB); PG8_STAGE(PG8_SA(1, 0), cA + kstep, vA[0]); PG8_STAGE(PG8_SB(1, 1), cB + hstep + kstep, voffB);
        PG8_WAIT_V(6); PG8_BAR;
    }
    for (;;) {
        const bool has_next = S.next(ui + 1, nxt);
        if (has_next) { PG8_GOFF(nvA, nxt.pm); } else { nvA[0][0] = vA[0][0]; nvA[0][1] = vA[0][1]; nvA[1][0] = vA[1][0]; nvA[1][1] = vA[1][1]; } const char* nB = has_next ? (const char*)g.Bt + (size_t)nxt.pn * tstep : cB;
        for (int t = 0; t < nt; t += 2) {
            const bool last = (t == nt - 2);
            const char* a1 = cA + (size_t)(t + 1) * kstep;
            const char* a2 = cA + (last ? (size_t)0 : (size_t)(t + 2) * kstep); unsigned w2[2][2]; w2[0][0] = last ? nvA[0][0] : vA[0][0]; w2[0][1] = last ? nvA[0][1] : vA[0][1]; w2[1][0] = last ? nvA[1][0] : vA[1][0]; w2[1][1] = last ? nvA[1][1] : vA[1][1]; const char* b2 = last ? nB : cB + (size_t)(t + 2) * kstep;
            const char* a3 = a2 + kstep; const char* b3 = b2 + kstep;
            if (last && has_next) S.a_ready(nxt);
            if constexpr (SP2) {
            PG8_LDB(B0, 0, 0); PG8_LDB(B1, 0, 1); PG8_SCHED; PG8_LDA(At, 0, 0); PG8_STAGE(PG8_SA(1, 1), a1, vA[1]);
            PG8_WAIT_V(8); PG8_WAIT_L(0); PG8_BAR; PG8_MMA(0, 0, At, B0); PG8_MMA(0, 1, At, B1); PG8_BAR; PG8_SCHED;
            PG8_LDA(At, 0, 1); PG8_STAGE(PG8_SB(0, 0), b2, voffB); PG8_STAGE(PG8_SB(0, 1), b2 + hstep, voffB); PG8_STAGE(PG8_SA(0, 0), a2, w2[0]);
            PG8_WAIT_V(8); PG8_WAIT_L(0); PG8_BAR; PG8_MMA(1, 0, At, B0); PG8_MMA(1, 1, At, B1); PG8_BAR; PG8_SCHED;
            PG8_LDB(B0, 1, 0); PG8_LDB(B1, 1, 1); PG8_SCHED; PG8_LDA(At, 1, 0); PG8_STAGE(PG8_SA(0, 1), a2, w2[1]);
            PG8_WAIT_V(8); PG8_WAIT_L(0); PG8_BAR; PG8_MMA(0, 0, At, B0); PG8_MMA(0, 1, At, B1); PG8_BAR; PG8_SCHED;
            PG8_LDA(At, 1, 1); PG8_STAGE(PG8_SB(1, 0), b3, voffB); PG8_STAGE(PG8_SB(1, 1), b3 + hstep, voffB); PG8_STAGE(PG8_SA(1, 0), a3, w2[0]);
            PG8_WAIT_V(8); PG8_WAIT_L(0); PG8_BAR; PG8_MMA(1, 0, At, B0); PG8_MMA(1, 1, At, B1); PG8_BAR; PG8_SCHED;
            } else {
            PG8_LDB(B0, 0, 0); PG8_SCHED; PG8_LDA(At, 0, 0); PG8_STAGE(PG8_SA(1, 1), a1, vA[1]);
            PG8_WAIT_L(8); PG8_BAR; PG8_WAIT_L(0); PG8_MMA(0, 0, At, B0); PG8_BAR; PG8_SCHED;
            PG8_LDB(B1, 0, 1); PG8_STAGE(PG8_SB(0, 0), b2, voffB);
            PG8_BAR; PG8_WAIT_L(0); PG8_MMA(0, 1, At, B1); PG8_BAR;
            PG8_LDA(At, 0, 1); PG8_STAGE(PG8_SA(0, 0), a2, w2[0]);
            PG8_BAR; PG8_WAIT_L(0); PG8_MMA(1, 0, At, B0); PG8_BAR; PG8_SCHED;
            PG8_STAGE(PG8_SB(0, 1), b2 + hstep, voffB);
            PG8_WAIT_V(6); PG8_BAR; PG8_MMA(1, 1, At, B1); PG8_BAR;
            PG8_LDB(B0, 1, 0); PG8_SCHED; PG8_LDA(At, 1, 0); PG8_STAGE(PG8_SA(0, 1), a2, w2[1]);
            PG8_WAIT_L(8); PG8_BAR; PG8_WAIT_L(0); PG8_MMA(0, 0, At, B0); PG8_BAR; PG8_SCHED;
            PG8_LDB(B1, 1, 1); PG8_STAGE(PG8_SB(1, 0), b3, voffB);
            PG8_BAR; PG8_WAIT_L(0); PG8_MMA(0, 1, At, B1); PG8_BAR;
            PG8_LDA(At, 1, 1); PG8_STAGE(PG8_SA(1, 0), a3, w2[0]);
            PG8_BAR; PG8_WAIT_L(0); PG8_MMA(1, 0, At, B0); PG8_BAR; PG8_SCHED;
            PG8_STAGE(PG8_SB(1, 1), b3 + hstep, voffB);
            PG8_WAIT_V(6); PG8_BAR; PG8_MMA(1, 1, At, B1); PG8_BAR;
            }
        }
        if constexpr (ALIGN_EPI) { if (wr == 0) PG8_BAR; }
        if constexpr (!Epi::AFTER_DRAIN) { E(acc, cur, wr, wc, fr, fq); S.done(cur); }
        if (!has_next) break;
#pragma unroll
        for (int a = 0; a < 2; ++a)
#pragma unroll
            for (int b = 0; b < 2; ++b)
#pragma unroll
                for (int m = 0; m < 4; ++m)
#pragma unroll
                    for (int n = 0; n < 2; ++n) acc[a][b][m][n] = (f32x4){0.f, 0.f, 0.f, 0.f};
        cur = nxt; cB = nB; ++ui; vA[0][0] = nvA[0][0]; vA[0][1] = nvA[0][1]; vA[1][0] = nvA[1][0]; vA[1][1] = nvA[1][1];
        if constexpr (ALIGN_EPI) { if (wr == 1) PG8_BAR; }
    }
    PG8_WAIT_V(0);
    if constexpr (!ALIGN_EPI) { if (wr == 0) PG8_BAR; }
    PG8_BAR;
    if constexpr (Epi::AFTER_DRAIN) { E.fused(acc, cur, wr, wc, fr, fq, lds, wid, lane); S.done(cur); }
#undef PG8_SA
#undef PG8_SB
#undef PG8_STAGE
#undef PG8_LDA
#undef PG8_LDB
#undef PG8_MMA
#undef PG8_WAIT_V
#undef PG8_WAIT_L
#undef PG8_BAR
#undef PG8_SCHED
#undef PG8_GOFF
}
}

#ifndef DBG_NOMIX
#define DBG_NOMIX 0
#endif
#ifndef DBG_NOMOE
#define DBG_NOMOE 0
#endif
#ifndef DBG_NOPOS
#define DBG_NOPOS 0
#endif
#ifndef DBG_HTCONST
#define DBG_HTCONST 0
#endif
#ifndef DBG_GLA_K
#define DBG_GLA_K 1.0f
#endif
#ifndef DBG_MOE_K
#define DBG_MOE_K 1.0f
#endif
#ifndef MK_SINGLE
#define MK_SINGLE 0
#endif
#define GAS __attribute__((address_space(1)))
#define LAS __attribute__((address_space(3)))
typedef unsigned short bf16;
typedef float f32x4 __attribute__((ext_vector_type(4)));
typedef float f32x16 __attribute__((ext_vector_type(16)));
typedef short bf16x8 __attribute__((ext_vector_type(8)));
typedef unsigned v4u __attribute__((ext_vector_type(4)));
typedef unsigned v2u __attribute__((ext_vector_type(2)));
typedef GAS unsigned gu32;

constexpr int NWAVES = 8, NTHR = 512;
constexpr int NB = 4, SEQ = 4096, DM = 1024, CTXL = 256;
constexpr int MX = NB * SEQ, MC = NB * CTXL, MT = MX + MC;
constexpr int NIN = 3328, NQ = 1536, DIN = 3104;
constexpr int NE = 16, CAP = 512;
constexpr int NCH = 68;
constexpr int NPH = 12;
constexpr float EPS = 1e-6f;

constexpr size_t MiB = 1u << 20;
constexpr size_t WS_CTL = 0, CTL_BYTES = 65536;
constexpr int CW_CNT_D = 8192, CW_CNT_GU = 8192 + 64;
constexpr size_t WS_MOD = 1 * MiB, WS_POS = 1 * MiB + 256 * 1024, WS_DEC = 2 * MiB, WS_AFF = 3 * MiB, WS_SLOT = 4 * MiB, WS_SELT = 5 * MiB, WS_SELV = 5 * MiB + 256 * 1024;
constexpr size_t WS_UCTX = 6 * MiB, WS_AFB = 10 * MiB, WS_WIN = 13 * MiB, WS_WOUT = 20 * MiB;
constexpr size_t WS_R1 = 22 * MiB, WS_R2 = 56 * MiB, WS_R3 = 107 * MiB, WS_R4 = 203 * MiB, WS_R5 = 235 * MiB, WS_R6 = 267 * MiB, WS_END = 299 * MiB;
constexpr size_t WS_AIN = WS_R1, WS_ZT = 155 * MiB, WS_HN = WS_R1;
constexpr size_t WS_QKVG = WS_R2;
constexpr size_t WS_HYT = WS_R3, WS_WD = 171 * MiB;
constexpr size_t WS_WGU = WS_R5;
constexpr size_t WS_HID = WS_R2, WS_YSLAB = WS_R4;
constexpr size_t WS_HT = WS_R4, WS_AOUT = WS_R4;
constexpr size_t WS_SPREV = WS_R5, WS_YHYT = WS_R6;
constexpr int LDS_BYTES = 144 * 1024;
constexpr int LDS_MISC = LDS_BYTES - 256;

struct Args { const float* in[29]; float* out; unsigned char* ws; int ph_lo, ph_hi; };

#define LDS_WAIT() asm volatile("s_waitcnt lgkmcnt(0)" ::: "memory")
#define VM_WAIT() asm volatile("s_waitcnt vmcnt(0)" ::: "memory")
__device__ __forceinline__ unsigned f2bf(float f) { unsigned u = __float_as_uint(f); return (u + 0x7fffu + ((u >> 16) & 1u)) >> 16; }
__device__ __forceinline__ unsigned pk2(float lo, float hi) { return pg8::cvt_pk_bf16(lo, hi); }
__device__ __forceinline__ float bflo(unsigned w) { return __uint_as_float(w << 16); }
__device__ __forceinline__ float bfhi(unsigned w) { return __uint_as_float(w & 0xffff0000u); }
__device__ __forceinline__ float wave_sum(float v) {
#pragma unroll
    for (int o = 1; o < 64; o <<= 1) v += __shfl_xor(v, o);
    return v;
}
__device__ __forceinline__ float silu_f(float v) { return v * __builtin_amdgcn_rcpf(1.f + __expf(-v)); }
__device__ __forceinline__ float logsig_f(float x) { return fminf(x, 0.f) - __logf(1.0f + __expf(-fabsf(x))); }

#define XB_TMO      128
#define XB_XCNT(j)  (256  + 64 * (j))
#define XB_XSUB(j)  (1280 + 64 * (j))
#define XB_XGEN(j)  (2304 + 64 * (j))
#define XB_TOP      3328
#define XB_TOPGEN   3392
#define XCD_BAR_WORDS 3456
#define XB_SPIN_CAP (1u << 22)
__device__ __forceinline__ unsigned xb_ld(unsigned* p)              { return __hip_atomic_load(p, __ATOMIC_RELAXED, __HIP_MEMORY_SCOPE_AGENT); }
__device__ __forceinline__ unsigned xb_add(unsigned* p, unsigned v) { return __hip_atomic_fetch_add(p, v, __ATOMIC_RELAXED, __HIP_MEMORY_SCOPE_AGENT); }
__device__ __forceinline__ unsigned xb_xcc_id() { return (unsigned)__builtin_amdgcn_s_getreg((3 << 11) | 20) & 0xFu; }
#define XB_SPIN(cond, bar) do { unsigned _sp = 0; while (cond) { __builtin_amdgcn_s_sleep(1); \
    if ((++_sp & 255u) == 0u) { if (xb_ld(&(bar)[XB_TMO])) break; if (_sp > XB_SPIN_CAP) { atomicAdd(&(bar)[XB_TMO], 1u); break; } } } } while (0)
struct XcdBarrier { unsigned* bar; unsigned x; volatile LAS unsigned* st; };
__device__ __forceinline__ XcdBarrier xcd_barrier_post(unsigned* bar, volatile LAS unsigned* st) {
    XcdBarrier b; b.bar = bar; b.x = xb_xcc_id(); b.st = st;
    if (threadIdx.x == 0) (void)xb_add(&bar[XB_XCNT(b.x)], 1u);
    return b;
}
__device__ __forceinline__ void xcd_barrier_complete(unsigned* bar, unsigned x, unsigned& nloc, unsigned& nx) {
    const unsigned G = gridDim.x * gridDim.y * gridDim.z;
    unsigned sum, cnt, mine, sp = 0u;
    for (;;) {
        sum = 0u; cnt = 0u; mine = 0u;
#pragma unroll
        for (unsigned j = 0; j < 16; ++j) { const unsigned c = xb_ld(&bar[XB_XCNT(j)]); sum += c; cnt += (c > 0u) ? 1u : 0u; mine = (j == x) ? c : mine; }
        if (sum == G) break;
        __builtin_amdgcn_s_sleep(1);
        if ((++sp & 255u) == 0u) { if (xb_ld(&bar[XB_TMO])) break; if (sp > XB_SPIN_CAP) { atomicAdd(&bar[XB_TMO], 1u); break; } }
    }
    nloc = mine > 0u ? mine : 1u; nx = cnt > 0u ? cnt : 1u;
}
__device__ __forceinline__ void xcd_barrier(const XcdBarrier& b) {
    asm volatile("s_waitcnt vmcnt(0)" ::: "memory");
    __syncthreads();
    if (threadIdx.x == 0) {
        unsigned* bar = b.bar;
        __builtin_amdgcn_s_waitcnt(0);
        unsigned nloc = b.st[0], nx = b.st[1];
        if (nloc == 0u) { xcd_barrier_complete(bar, b.x, nloc, nx); b.st[0] = nloc; b.st[1] = nx; }
        const unsigned old = xb_add(&bar[XB_XSUB(b.x)], 1u);
        const unsigned gen = old / nloc;
        if (old + 1u == (gen + 1u) * nloc) {
            __builtin_amdgcn_fence(__ATOMIC_RELEASE, "agent");
            asm volatile("s_waitcnt vmcnt(0)" ::: "memory");
            const unsigned og = xb_add(&bar[XB_TOP], 1u);
            const unsigned tg = og / nx;
            if (og + 1u == (tg + 1u) * nx) xb_add(&bar[XB_TOPGEN], 1u);
            else XB_SPIN(xb_ld(&bar[XB_TOPGEN]) == tg, bar);
            __builtin_amdgcn_fence(__ATOMIC_ACQUIRE, "agent");
            xb_add(&bar[XB_XGEN(b.x)], 1u);
            asm volatile("s_waitcnt vmcnt(0)" ::: "memory");
        } else {
            XB_SPIN(xb_ld(&bar[XB_XGEN(b.x)]) == gen, bar);
            __builtin_amdgcn_fence(__ATOMIC_ACQUIRE, "agent");
            asm volatile("s_waitcnt vmcnt(0)" ::: "memory");
        }
    }
    __syncthreads();
}

constexpr int TILE_AIN = (int)(WS_AIN / (512 * 1024)), TILE_WIN = (int)(WS_WIN / (512 * 1024));
struct InSched {
    int G, c, part;
    __device__ void init(int G_, int c_, int part_) { G = G_; c = c_; part = part_; }
    __device__ static void qg_unit(int qg, pg8::Unit& u) { const int t = qg >> 6; u.pm = TILE_AIN + (qg & 63); u.pn = TILE_WIN + ((t == 0) ? 0 : 3 + t); }
    __device__ bool next(int i, pg8::Unit& u) const {
        const int L = i * G + c;
        if (part) { if (i > 0 || c >= 80) return false; qg_unit(112 + c, u); return true; }
        if (L < 384) { u.pm = TILE_WIN + 6 + (L >> 6); u.pn = TILE_AIN + (L & 63); return true; }
        if (L < 640) { const int l = L - 384, q = l >> 6; u.pm = TILE_AIN + (l & 63); u.pn = TILE_WIN + ((q == 3) ? 12 : (1 + q)); return true; }
        if (L < 656) { const int jx = L - 640, q = jx >> 2; u.pm = TILE_AIN + 64 + (jx & 3); u.pn = TILE_WIN + ((q == 3) ? 12 : (1 + q)); return true; }
        if (L >= 768) return false;
        qg_unit(L - 656, u); return true;
    }
    __device__ __forceinline__ void a_ready(const pg8::Unit&) const {}
    __device__ __forceinline__ void done(const pg8::Unit&) const {}
};
template <int NT> struct MoeSched {
    int G, c;
    __device__ void init(int G_, int c_) { G = G_; c = c_; }
    __device__ bool next(int i, pg8::Unit& u) const {
        const int L = i * G + c; if (L >= NE * 8 * NT) return false;
        const int e = L / (8 * NT), l = L % (8 * NT), x = l & 7, y = l >> 3;
        constexpr int HN = NT / 2;
        const int pm = 2 * (x >> 1) + (y / HN), pn = HN * (x & 1) + (y % HN);
        u.pm = e * 8 + pm; u.pn = e * NT + pn; return true;
    }
    __device__ __forceinline__ void a_ready(const pg8::Unit&) const {}
    __device__ __forceinline__ void done(const pg8::Unit&) const {}
};

struct EpiIn {
    static constexpr bool PERM = true, AFTER_DRAIN = false;
    bf16* qkvg; bf16* hyT; float* afb;
    __device__ __forceinline__ void operator()(const f32x4 (&acc)[2][2][4][2], const pg8::Unit& u, int wr, int wc, int fr, int fq) const {
        if (u.pm < TILE_AIN) {
            const int ch0 = (u.pm - TILE_WIN - 6) * 256 + wr * 64 + fr, mt = u.pn - TILE_AIN, b = mt >> 4, t0 = (mt & 15) * 256 + wc * 32 + 8 * fq;
#pragma unroll
            for (int ai = 0; ai < 2; ++ai)
#pragma unroll
                for (int m = 0; m < 4; ++m) { bf16* rowp = hyT + ((size_t)b * 1536 + ch0 + ai * 128 + m * 16) * SEQ + t0;
#pragma unroll
                    for (int bj = 0; bj < 2; ++bj) { const f32x4 v0 = acc[ai][bj][m][0], v1 = acc[ai][bj][m][1];
                        v4u w; w.x = pk2(v0[0], v0[1]); w.y = pk2(v0[2], v0[3]); w.z = pk2(v1[0], v1[1]); w.w = pk2(v1[2], v1[3]);
                        *(v4u*)(rowp + bj * 128) = w; } }
            return;
        }
        const int pm = u.pm - TILE_AIN, pn = u.pn - TILE_WIN;
        const int row0 = pm * 256 + wr * 64 + fr;
        if (pn < 6) {
            const float sc = (pn == 0) ? 0.125f : 1.f;
            const int col0 = pn * 256 + wc * 32 + 8 * fq;
#pragma unroll
            for (int ai = 0; ai < 2; ++ai)
#pragma unroll
                for (int m = 0; m < 4; ++m) { bf16* rowp = qkvg + (size_t)(row0 + ai * 128 + m * 16) * NQ + col0;
#pragma unroll
                    for (int bj = 0; bj < 2; ++bj) { const f32x4 v0 = acc[ai][bj][m][0] * sc, v1 = acc[ai][bj][m][1] * sc;
                        v4u w; w.x = pk2(v0[0], v0[1]); w.y = pk2(v0[2], v0[3]); w.z = pk2(v1[0], v1[1]); w.w = pk2(v1[2], v1[3]);
                        *(v4u*)(rowp + bj * 128) = w; } }
        } else {
            if (wc != 0) return;
#pragma unroll
            for (int ai = 0; ai < 2; ++ai)
#pragma unroll
                for (int m = 0; m < 4; ++m) { float* rowp = afb + (size_t)(row0 + ai * 128 + m * 16) * 32 + 8 * fq;
                    *(f32x4*)(rowp) = acc[ai][0][m][0]; *(f32x4*)(rowp + 4) = acc[ai][0][m][1]; }
        }
    }
};
struct EpiOut {
    static constexpr bool PERM = false, AFTER_DRAIN = false;
    const float* __restrict__ x; const float* __restrict__ postab; const float* __restrict__ modr; float* __restrict__ x1;
    __device__ __forceinline__ void operator()(const f32x4 (&acc)[2][2][4][2], const pg8::Unit& u, int wr, int wc, int fr, int fq) const {
        const int row0 = u.pm * 256 + wr * 64 + fr, col0 = u.pn * 256 + wc * 32 + 4 * fq;
        const int b = row0 >> 12;
        f32x4 gv[2][2];
#pragma unroll
        for (int bj = 0; bj < 2; ++bj)
#pragma unroll
            for (int n = 0; n < 2; ++n) gv[bj][n] = *(const f32x4*)(modr + b * 6144 + 2048 + col0 + bj * 128 + n * 16);
#pragma unroll
        for (int ai = 0; ai < 2; ++ai)
#pragma unroll
            for (int m = 0; m < 4; ++m) { const int r = row0 + ai * 128 + m * 16; const int t = r & 4095, rr = t >> 6, cc = t & 63;
                f32x4 xv[2][2], pv[2][2];
#pragma unroll
                for (int bj = 0; bj < 2; ++bj)
#pragma unroll
                    for (int n = 0; n < 2; ++n) { const int c = col0 + bj * 128 + n * 16;
                        xv[bj][n] = *(const f32x4*)(x + (size_t)r * DM + c);
                        pv[bj][n] = *(const f32x4*)(postab + ((c < 512) ? rr * 512 + c : cc * 512 + c - 512)); }
#pragma unroll
                for (int bj = 0; bj < 2; ++bj)
#pragma unroll
                    for (int n = 0; n < 2; ++n) { const int c = col0 + bj * 128 + n * 16;
                        *(f32x4*)(x1 + (size_t)r * DM + c) = xv[bj][n] + (DBG_NOPOS ? pv[bj][n] * 0.f : pv[bj][n]) + (DBG_NOMIX ? gv[bj][n] * 0.f : gv[bj][n] * acc[ai][bj][m][n]); } }
    }
};
struct EpiGU {
    static constexpr bool PERM = true, AFTER_DRAIN = false;
    bf16* hid;
    __device__ __forceinline__ void operator()(const f32x4 (&acc)[2][2][4][2], const pg8::Unit& u, int wr, int wc, int fr, int fq) const {
        const int row0 = u.pm * 256 + wr * 64 + fr, col0 = (u.pn & 7) * 128 + wc * 32 + 8 * fq;
#pragma unroll
        for (int ai = 0; ai < 2; ++ai)
#pragma unroll
            for (int m = 0; m < 4; ++m) { bf16* rowp = hid + (size_t)(row0 + ai * 128 + m * 16) * DM + col0;
                float o[8];
#pragma unroll
                for (int n = 0; n < 2; ++n)
#pragma unroll
                    for (int j = 0; j < 4; ++j) o[n * 4 + j] = silu_f(acc[ai][0][m][n][j]) * acc[ai][1][m][n][j];
                v4u w; w.x = pk2(o[0], o[1]); w.y = pk2(o[2], o[3]); w.z = pk2(o[4], o[5]); w.w = pk2(o[6], o[7]);
                *(v4u*)rowp = w; }
    }
};
struct EpiDown {
    static constexpr bool PERM = true, AFTER_DRAIN = false;
    bf16* __restrict__ ys; const float* __restrict__ selv;
    __device__ __forceinline__ void operator()(const f32x4 (&acc)[2][2][4][2], const pg8::Unit& u, int wr, int wc, int fr, int fq) const {
        const int row0 = u.pm * 256 + wr * 64 + fr, col0 = (u.pn & 3) * 256 + wc * 32 + 8 * fq;
        float scv[2][4];
#pragma unroll
        for (int ai = 0; ai < 2; ++ai)
#pragma unroll
            for (int m = 0; m < 4; ++m) scv[ai][m] = selv[row0 + ai * 128 + m * 16];
#pragma unroll
        for (int ai = 0; ai < 2; ++ai)
#pragma unroll
            for (int m = 0; m < 4; ++m) { const int r = row0 + ai * 128 + m * 16; const float sc = scv[ai][m]; bf16* rowp = ys + (size_t)r * DM + col0;
#pragma unroll
                for (int bj = 0; bj < 2; ++bj) { const f32x4 v0 = acc[ai][bj][m][0] * sc, v1 = acc[ai][bj][m][1] * sc;
                    v4u w; w.x = pk2(v0[0], v0[1]); w.y = pk2(v0[2], v0[3]); w.z = pk2(v1[0], v1[1]); w.w = pk2(v1[2], v1[3]);
                    *(v4u*)(rowp + bj * 128) = w; } }
    }
};

__device__ __forceinline__ void transpose_item(const float* W, int ldw, int k0, int nsrc0, bf16* WT, int K, int drow0, LAS float* scr, int lane, bool zero) {
    float tv[32];
#pragma unroll
    for (int i = 0; i < 32; ++i) { const int kk = 2 * i + (lane >> 5); tv[i] = zero ? 0.f : W[(size_t)(k0 + kk) * ldw + nsrc0 + (lane & 31)]; }
#pragma unroll
    for (int i = 0; i < 32; ++i) { const int kk = 2 * i + (lane >> 5); scr[kk * 33 + (lane & 31)] = tv[i]; }
    LDS_WAIT();
    const int c = lane & 7;
#pragma unroll
    for (int j = 0; j < 4; ++j) { const int n = (lane >> 3) + 8 * j; const LAS float* s = scr + (8 * c) * 33 + n;
        v4u o; o.x = pk2(s[0 * 33], s[1 * 33]); o.y = pk2(s[2 * 33], s[3 * 33]); o.z = pk2(s[4 * 33], s[5 * 33]); o.w = pk2(s[6 * 33], s[7 * 33]);
        *(v4u*)(WT + (size_t)(drow0 + n) * K + k0 + 8 * c) = o; }
    LDS_WAIT();
}

__device__ __forceinline__ void phase0(const Args& a, LAS unsigned char* lds) {
    int tid = threadIdx.x; const int wg = blockIdx.x, G = gridDim.x;
    asm volatile("" : "+v"(tid));
    int lane = tid & 63, wave = tid >> 6;
    unsigned char* ws = a.ws;
    for (int it = wg; it < 192; it += G) {
        LAS float* sl = (LAS float*)lds;
        LAS float* red = (LAS float*)(lds + 20480);
        for (int i = tid; i < 5 * 1024; i += NTHR) { const int bb = i >> 10, k = i & 1023; const float v = (bb < 4) ? a.in[1][bb * 1024 + k] : a.in[3][k]; sl[i] = silu_f(v); }
        __syncthreads();
        const int col = it * 32 + (lane & 31), kk = wave * 2 + (lane >> 5);
        float acc[5] = {0.f, 0.f, 0.f, 0.f, 0.f};
        const float* wp = a.in[4] + col;
        float wv[64];
#pragma unroll
        for (int j = 0; j < 64; ++j) wv[j] = wp[(size_t)(kk + 16 * j) * 6144];
#pragma unroll
        for (int j = 0; j < 64; ++j) { const int k = kk + 16 * j;
#pragma unroll
            for (int bb = 0; bb < 5; ++bb) acc[bb] += sl[bb * 1024 + k] * wv[j]; }
#pragma unroll
        for (int bb = 0; bb < 5; ++bb) red[(kk * 5 + bb) * 32 + (lane & 31)] = acc[bb];
        __syncthreads();
        if (tid < 160) { const int bb = tid >> 5, cl = tid & 31; float s = 0.f;
#pragma unroll
            for (int q = 0; q < 16; ++q) s += red[(q * 5 + bb) * 32 + cl];
            ((float*)(ws + WS_MOD))[bb * 6144 + it * 32 + cl] = s + a.in[5][it * 32 + cl]; }
        __syncthreads();
    }
    for (int it = wg; it < 256; it += G) {
        asm volatile("" : "+v"(tid));
        LAS float* zl = (LAS float*)lds;
        LAS float* h1 = (LAS float*)(lds + 4096);
        LAS float* h2 = (LAS float*)(lds + 8192);
        const int i0 = it * 16;
        LAS float* w1l = (LAS float*)(lds + 12288);
        LAS float* w2l = (LAS float*)(lds + 12288 + 8448);
        for (int o = tid; o < 33 * 64; o += NTHR) w1l[o] = a.in[15][o];
        for (int o = tid; o < 64 * 64; o += NTHR) w2l[o] = a.in[17][o];
        for (int o = tid; o < 16 * 33; o += NTHR) { const int li = o / 33, j = o % 33; const int i = i0 + li;
            const float ti = (float)i * (1.0f / 4095.0f);
            const float wi = (6.2831855f * (float)i) / 4096.0f;
            float v;
            if (j == 0) v = ti;
            else { const int jj = (j - 1) & 15; const float f = 1e-4f + (float)jj * ((15.0f - 1e-4f) / 15.0f); const float ar = f * wi; v = (j <= 16) ? cosf(ar) : -sinf(ar); }
            zl[li * 36 + j] = v; }
        __syncthreads();
#pragma unroll
        for (int q = 0; q < 2; ++q) { const int o = tid + NTHR * q, li = o >> 6, m = o & 63; float s = a.in[16][m];
#pragma unroll
            for (int j = 0; j < 33; ++j) s += zl[li * 36 + j] * w1l[j * 64 + m];
            h1[li * 64 + m] = sinf(a.in[20][m] * s); }
        __syncthreads();
#pragma unroll
        for (int q = 0; q < 2; ++q) { const int o = tid + NTHR * q, li = o >> 6, m = o & 63; float s = a.in[18][m];
#pragma unroll 16
            for (int k = 0; k < 64; ++k) s += h1[li * 64 + k] * w2l[k * 64 + m];
            h2[li * 64 + m] = sinf(a.in[20][m] * s); }
        __syncthreads();
        f32x4 acc[16];
#pragma unroll
        for (int li = 0; li < 16; ++li) acc[li] = (f32x4){0.f, 0.f, 0.f, 0.f};
        const float* w3 = a.in[19] + tid * 4;
#pragma nounroll
        for (int k0 = 0; k0 < 64; k0 += 16) { f32x4 w[16];
#pragma unroll
            for (int kk = 0; kk < 16; ++kk) w[kk] = *(const f32x4*)(w3 + (k0 + kk) * 2048);
#pragma unroll
            for (int kk = 0; kk < 16; ++kk)
#pragma unroll
                for (int li = 0; li < 16; ++li) acc[li] += w[kk] * h2[li * 64 + k0 + kk]; }
        float* hT = (float*)(ws + WS_HT);
#pragma unroll
        for (int j = 0; j < 4; ++j) { const int col = tid * 4 + j, od = col >> 9, c = col & 511;
            const float delta = 3.0701134573f + (float)c * ((15.3505672866f - 3.0701134573f) / 511.0f);
            float* dst = hT + ((size_t)od * 512 + c) * SEQ + i0;
#pragma unroll
            for (int q = 0; q < 4; ++q) { f32x4 o;
#pragma unroll
                for (int s = 0; s < 4; ++s) { const int li = q * 4 + s; const float ti = (float)(i0 + li) * (1.0f / 4095.0f); o[s] = DBG_HTCONST == 1 ? 1.0f : DBG_HTCONST == 2 ? zl[li * 36 + (col % 33)] : DBG_HTCONST == 3 ? h1[li * 64 + (col & 63)] : DBG_HTCONST == 4 ? h2[li * 64 + (col & 63)] : DBG_HTCONST == 5 ? acc[li][j] : acc[li][j] * __expf(-ti * delta); }
                *(f32x4*)(dst + q * 4) = o; } }
        __syncthreads();
    }
    {
        asm volatile("" : "+v"(tid)); lane = tid & 63; wave = tid >> 6;
        LAS float* scr = (LAS float*)(lds + wave * 8448);
        const int gw = wg * NWAVES + wave, NGW = G * NWAVES;
        constexpr int I_IN = 104 * 16, I_OUT = 32 * 16;
        for (int it = gw; it < I_IN + I_OUT; it += NGW) {
            if (it < I_IN) { const int nb = it >> 4, kb = it & 15, n0 = nb * 32;
                const int ns = (n0 < 1536) ? n0 : (n0 < 3072 ? n0 + 32 : 1536 + (n0 - 3072));
                transpose_item(a.in[7], DIN, kb * 64, (n0 < DIN) ? ns : 0, (bf16*)(ws + WS_WIN), DM, n0, scr, lane, n0 >= DIN);
            } else { const int r = it - I_IN, nb = r >> 4, kb = r & 15;
                transpose_item(a.in[22], DM, kb * 64, nb * 32, (bf16*)(ws + WS_WOUT), DM, nb * 32, scr, lane, false); }
        }
    }
    for (int e = wg * NTHR + tid; e < 64 * 256; e += G * NTHR) { const int i = e >> 8, j = e & 255;
        const float om = 1.0f / powf(10000.0f, (float)j * (1.0f / 256.0f)); const float er = (float)i * om;
        float* pt = (float*)(ws + WS_POS); pt[i * 512 + j] = sinf(er); pt[i * 512 + 256 + j] = cosf(er); }
}

__device__ __forceinline__ void phase1(const Args& a, LAS unsigned char* lds) {
    const int tid = threadIdx.x, lane = tid & 63, wave = tid >> 6, wg = blockIdx.x, G = gridDim.x;
    unsigned char* ws = a.ws;
    const float* modr = (const float*)(ws + WS_MOD); const float* pt = (const float*)(ws + WS_POS); bf16* ain = (bf16*)(ws + WS_AIN);
    const float* gmix = a.in[6];
    const int NGW = G * NWAVES;
    f32x4 gv[4];
#pragma unroll
    for (int j = 0; j < 4; ++j) gv[j] = *(const f32x4*)(gmix + 4 * lane + 256 * j);
#pragma nounroll
    for (int r0 = wg * NWAVES + wave; r0 < MT; r0 += 4 * NGW) {
        f32x4 v[4][4];
#pragma unroll
        for (int k = 0; k < 4; ++k) { const int r = r0 + k * NGW;
            if (r < MT) { const bool lat = r < MX; const float* src = lat ? a.in[0] + (size_t)r * DM : a.in[2] + (size_t)(r - MX) * DM; const int t = r & 4095, rr = t >> 6, cc = t & 63;
#pragma unroll
                for (int j = 0; j < 4; ++j) { const int col = 4 * lane + 256 * j; v[k][j] = *(const f32x4*)(src + col);
                    const f32x4 pv = *(const f32x4*)(pt + ((j < 2) ? rr * 512 + col : cc * 512 + col - 512));
                    v[k][j] += pv * (lat ? 1.0f : 0.0f); } } }
#pragma unroll
        for (int k = 0; k < 4; ++k) { const int r = r0 + k * NGW;
            if (r < MT) { const int bb = (r < MX) ? (r >> 12) : 4; float ss = 0.f;
                f32x4 shv[4], scv[4];
#pragma unroll
                for (int j = 0; j < 4; ++j) { const int col = 4 * lane + 256 * j; shv[j] = *(const f32x4*)(modr + bb * 6144 + col); scv[j] = *(const f32x4*)(modr + bb * 6144 + 1024 + col); }
#pragma unroll
                for (int j = 0; j < 4; ++j) ss += v[k][j][0] * v[k][j][0] + v[k][j][1] * v[k][j][1] + v[k][j][2] * v[k][j][2] + v[k][j][3] * v[k][j][3];
                const float rs = rsqrtf(wave_sum(ss) * (1.0f / DM) + EPS);
#pragma unroll
                for (int j = 0; j < 4; ++j) { const int col = 4 * lane + 256 * j;
                    const f32x4 sh = shv[j], sc = scv[j];
                    const f32x4 y = (v[k][j] * rs * gv[j]) * (sc + 1.0f) + sh;
                    v2u w; w.x = pk2(y[0], y[1]); w.y = pk2(y[2], y[3]);
                    *(v2u*)(ain + (size_t)r * DM + col) = w; } } }
    }
}

typedef float cpx __attribute__((ext_vector_type(2)));
__device__ __forceinline__ cpx make_cpx(float x, float y) { cpx r; r.x = x; r.y = y; return r; }
__device__ __forceinline__ cpx cmul(cpx a, cpx b) { return make_cpx(a.x * b.x - a.y * b.y, a.x * b.y + a.y * b.x); }
__device__ __forceinline__ cpx cadd(cpx a, cpx b) { return make_cpx(a.x + b.x, a.y + b.y); }
__device__ __forceinline__ cpx csub(cpx a, cpx b) { return make_cpx(a.x - b.x, a.y - b.y); }
__device__ __forceinline__ cpx cconj(cpx a) { return make_cpx(a.x, -a.y); }
__device__ __forceinline__ cpx twid(float turns) { return make_cpx(__builtin_amdgcn_cosf(turns), -__builtin_amdgcn_sinf(turns)); }
__device__ __forceinline__ void dft4(cpx& a0, cpx& a1, cpx& a2, cpx& a3) {
    const cpx t0 = cadd(a0, a2), t1 = csub(a0, a2), t2 = cadd(a1, a3), t3 = csub(a1, a3);
    a0 = cadd(t0, t2); a2 = csub(t0, t2);
    a1 = make_cpx(t1.x + t3.y, t1.y - t3.x);
    a3 = make_cpx(t1.x - t3.y, t1.y + t3.x);
}
__device__ __forceinline__ void dft16(cpx (&v)[16]) {
    cpx t[16];
#pragma unroll
    for (int j = 0; j < 4; ++j) { cpx b0 = v[j], b1 = v[j + 4], b2 = v[j + 8], b3 = v[j + 12]; dft4(b0, b1, b2, b3); t[4 * j] = b0; t[4 * j + 1] = b1; t[4 * j + 2] = b2; t[4 * j + 3] = b3; }
    const float C1 = 0.92387953251f, S1 = 0.38268343236f, R2 = 0.70710678118f;
    const cpx W1 = make_cpx(C1, -S1), W2 = make_cpx(R2, -R2), W3 = make_cpx(S1, -C1), W4 = make_cpx(0.f, -1.f), W6 = make_cpx(-R2, -R2), W9 = make_cpx(-C1, S1);
    {   cpx b0 = t[0], b1 = t[4], b2 = t[8], b3 = t[12]; dft4(b0, b1, b2, b3); v[0] = b0; v[4] = b1; v[8] = b2; v[12] = b3; }
    {   cpx b0 = t[1], b1 = cmul(t[5], W1), b2 = cmul(t[9], W2), b3 = cmul(t[13], W3); dft4(b0, b1, b2, b3); v[1] = b0; v[5] = b1; v[9] = b2; v[13] = b3; }
    {   cpx b0 = t[2], b1 = cmul(t[6], W2), b2 = cmul(t[10], W4), b3 = cmul(t[14], W6); dft4(b0, b1, b2, b3); v[2] = b0; v[6] = b1; v[10] = b2; v[14] = b3; }
    {   cpx b0 = t[3], b1 = cmul(t[7], W3), b2 = cmul(t[11], W6), b3 = cmul(t[15], W9); dft4(b0, b1, b2, b3); v[3] = b0; v[7] = b1; v[11] = b2; v[15] = b3; }
}
#define FPAD(i) ((i) + ((i) >> 4))
constexpr int FFT_STRIDE = 4352;
__device__ __forceinline__ void apply_tw(cpx (&v)[16], cpx w1) {
    asm volatile("" : "+v"(w1.x), "+v"(w1.y));
    cpx w = w1; v[1] = cmul(v[1], w);
#pragma unroll
    for (int q = 2; q < 16; ++q) { w = cmul(w, w1); v[q] = cmul(v[q], w); }
}
__device__ __forceinline__ cpx opaque(cpx w) { asm volatile("" : "+v"(w.x), "+v"(w.y)); return w; }
__device__ __forceinline__ cpx c32(int r) { return make_cpx(__builtin_cosf(0.19634954084936207f * (float)r), -__builtin_sinf(0.19634954084936207f * (float)r)); }

#define HB(x) __uint_as_float(((unsigned)(x)) << 16)
__device__ __forceinline__ void hyena_item(const Args& a, LAS unsigned char* lds, int c, int stage) {
    int tid = threadIdx.x; asm volatile("" : "+v"(tid));
    const int f = tid >> 8, j = tid & 255, blk = j >> 4, jp = j & 15;
    unsigned char* ws = a.ws;
    LAS cpx* buf = (LAS cpx*)lds;
    LAS cpx* bm = buf + f * FFT_STRIDE;
    const int pj = j + blk, p16 = blk * 272 + jp, pc = 17 * j;
    const float* hT = (const float*)(ws + WS_HT);
    const float* hf = hT + ((size_t)(stage * 2 + 0) * 512 + c) * SEQ;
    const float* hb = hT + ((size_t)(stage * 2 + 1) * 512 + c) * SEQ;
    const bf16* hyT = (const bf16*)(ws + WS_HYT);
    const bf16* zT = (const bf16*)(ws + WS_ZT);
    float* outp = (float*)(ws + WS_YHYT);
    const float* cw = a.in[13]; const float* cb = a.in[14];
    const int chu = c, chg = (stage == 0 ? 512 : 1024) + c;
    const float wu0 = cw[chu], wu1 = cw[1536 + chu], wu2 = cw[3072 + chu], bu = cb[chu];
    const float wg0 = cw[chg], wg1 = cw[1536 + chg], wg2 = cw[3072 + chg], bg = cb[chg];
    const float bias = a.in[21][stage * 512 + c];
    const cpx wj = twid((float)j * (1.0f / 4096.0f)), wjp = twid((float)jp * (1.0f / 256.0f)), w8_ = twid((float)j * (1.0f / 8192.0f));
    cpx v[16];
    LAS cpx* Hs = buf + 2 * FFT_STRIDE + f * FFT_STRIDE + pc;
    { const cpx w8 = opaque(w8_);
    float fraw[16], graw[16];
#pragma unroll
    for (int r = 0; r < 16; ++r) { const unsigned n = (unsigned)j + 256u * r; fraw[r] = hf[n]; graw[r] = hb[(SEQ - n) & 4095u]; }
    asm volatile("" : "+v"(fraw[0]), "+v"(fraw[1]), "+v"(fraw[2]), "+v"(fraw[3]), "+v"(fraw[4]), "+v"(fraw[5]), "+v"(fraw[6]), "+v"(fraw[7]), "+v"(fraw[8]), "+v"(fraw[9]), "+v"(fraw[10]), "+v"(fraw[11]), "+v"(fraw[12]), "+v"(fraw[13]), "+v"(fraw[14]), "+v"(fraw[15]));
    asm volatile("" : "+v"(graw[0]), "+v"(graw[1]), "+v"(graw[2]), "+v"(graw[3]), "+v"(graw[4]), "+v"(graw[5]), "+v"(graw[6]), "+v"(graw[7]), "+v"(graw[8]), "+v"(graw[9]), "+v"(graw[10]), "+v"(graw[11]), "+v"(graw[12]), "+v"(graw[13]), "+v"(graw[14]), "+v"(graw[15]));
#pragma unroll
    for (int r = 0; r < 16; ++r) { const unsigned n = (unsigned)j + 256u * r; const float fv = fraw[r]; const float gv = n ? graw[r] : 0.f;
        const cpx wn = cmul(w8, c32(r)); const float d = fv - gv;
        v[r] = f ? make_cpx(d * wn.x, d * wn.y) : make_cpx(fv + gv, 0.f); } }
    dft16(v); apply_tw(v, wj);
#pragma unroll
    for (int q = 0; q < 16; ++q) bm[pj + 272 * q] = v[q];
    __syncthreads();
#pragma unroll
    for (int r = 0; r < 16; ++r) v[r] = bm[p16 + 17 * r];
    dft16(v); apply_tw(v, wjp);
#pragma unroll
    for (int q = 0; q < 16; ++q) bm[p16 + 17 * q] = v[q];
    __syncthreads();
#pragma unroll
    for (int r = 0; r < 16; ++r) v[r] = bm[pc + r];
    dft16(v);
#pragma unroll
    for (int q = 0; q < 16; ++q) Hs[q] = v[q];
    __syncthreads();
#pragma nounroll
    for (int bp = 0; bp < 2; ++bp) {
        const int b0 = 2 * bp, b1 = 2 * bp + 1;
        float uk0[8], uk1[8];
        {   float u0[16], u1[16];
            const unsigned uj = (unsigned)j;
            if (stage == 0) {
                const bf16* P0 = hyT + ((size_t)b0 * 1536 + chu) * SEQ; const bf16* P1 = hyT + ((size_t)b1 * 1536 + chu) * SEQ;
#pragma unroll
                for (int r = 0; r < 16; ++r) { const unsigned o = uj + 256u * r; if (r == 4 || r == 8 || r == 12) asm volatile("" ::: "memory");
                    const unsigned ol = (r == 0) ? (j ? uj - 1u : 0u) : o - 1u, orr = (r == 15) ? (j < 255 ? o + 1u : o) : o + 1u;
                    float l0 = HB(P0[ol]), l1 = HB(P1[ol]), r0 = HB(P0[orr]), r1 = HB(P1[orr]);
                    if (r == 0) { l0 = j ? l0 : 0.f; l1 = j ? l1 : 0.f; }
                    if (r == 15) { r0 = (j < 255) ? r0 : 0.f; r1 = (j < 255) ? r1 : 0.f; }
                    u0[r] = wu0 * l0 + wu1 * HB(P0[o]) + wu2 * r0 + bu; u1[r] = wu0 * l1 + wu1 * HB(P1[o]) + wu2 * r1 + bu; }
            } else {
                const bf16* P0 = zT + ((size_t)b0 * 512 + c) * SEQ; const bf16* P1 = zT + ((size_t)b1 * 512 + c) * SEQ;
                unsigned short z0[16], z1[16];
#pragma unroll
                for (int r = 0; r < 16; ++r) { const unsigned o = uj + 256u * r; z0[r] = P0[o]; z1[r] = P1[o]; }
                asm volatile("" :: "v"(z0[0]), "v"(z0[1]), "v"(z0[2]), "v"(z0[3]), "v"(z0[4]), "v"(z0[5]), "v"(z0[6]), "v"(z0[7]), "v"(z0[8]), "v"(z0[9]), "v"(z0[10]), "v"(z0[11]), "v"(z0[12]), "v"(z0[13]), "v"(z0[14]), "v"(z0[15]));
                asm volatile("" :: "v"(z1[0]), "v"(z1[1]), "v"(z1[2]), "v"(z1[3]), "v"(z1[4]), "v"(z1[5]), "v"(z1[6]), "v"(z1[7]), "v"(z1[8]), "v"(z1[9]), "v"(z1[10]), "v"(z1[11]), "v"(z1[12]), "v"(z1[13]), "v"(z1[14]), "v"(z1[15]));
#pragma unroll
                for (int r = 0; r < 16; ++r) { u0[r] = HB(z0[r]); u1[r] = HB(z1[r]); }
            }
#pragma unroll
            for (int i = 0; i < 8; ++i) { uk0[i] = f ? u0[2 * i + 1] : u0[2 * i]; uk1[i] = f ? u1[2 * i + 1] : u1[2 * i]; }
            const cpx w8 = opaque(w8_);
#pragma unroll
            for (int r = 0; r < 16; ++r) { const cpx x = make_cpx(u0[r], u1[r]); v[r] = f ? cmul(x, cmul(w8, c32(r))) : x; }
        }
        dft16(v); apply_tw(v, wj);
#pragma unroll
        for (int q = 0; q < 16; ++q) bm[pj + 272 * q] = v[q];
        __syncthreads();
#pragma unroll
        for (int r = 0; r < 16; ++r) v[r] = bm[p16 + 17 * r];
        dft16(v); apply_tw(v, wjp);
#pragma unroll
        for (int q = 0; q < 16; ++q) bm[p16 + 17 * q] = v[q];
        __syncthreads();
#pragma unroll
        for (int r = 0; r < 16; ++r) v[r] = bm[pc + r];
        dft16(v);
#pragma unroll
        for (int q = 0; q < 16; ++q) v[q] = cconj(cmul(v[q], Hs[q]));
        dft16(v);
#pragma unroll
        for (int q = 0; q < 16; ++q) bm[pc + q] = v[q];
        __syncthreads();
#pragma unroll
        for (int r = 0; r < 16; ++r) v[r] = bm[p16 + 17 * r];
        apply_tw(v, wjp); dft16(v);
#pragma unroll
        for (int q = 0; q < 16; ++q) bm[p16 + 17 * q] = v[q];
        __syncthreads();
        float gg0[8], gg1[8];
        {   unsigned short rg0[8][3], rg1[8][3];
            const bf16* G0 = hyT + ((size_t)b0 * 1536 + chg) * SEQ; const bf16* G1 = hyT + ((size_t)b1 * 1536 + chg) * SEQ;
            const unsigned gj = (unsigned)(j + 256 * f);
#pragma unroll
            for (int i = 0; i < 8; ++i) { const unsigned o = gj + 512u * i;
                const unsigned ol = (i == 0) ? (gj ? gj - 1u : 0u) : o - 1u, orr = (i == 7) ? (o < 4095u ? o + 1u : o) : o + 1u;
                rg0[i][0] = G0[ol]; rg0[i][1] = G0[o]; rg0[i][2] = G0[orr]; rg1[i][0] = G1[ol]; rg1[i][1] = G1[o]; rg1[i][2] = G1[orr]; }
#pragma unroll
            for (int r = 0; r < 16; ++r) v[r] = bm[pj + 272 * r];
            apply_tw(v, wj); dft16(v);
#pragma unroll
            for (int q = 0; q < 16; ++q) bm[pj + 272 * q] = v[q];
#pragma unroll
            for (int i = 0; i < 8; ++i) asm volatile("" :: "v"(rg0[i][0]), "v"(rg0[i][1]), "v"(rg0[i][2]), "v"(rg1[i][0]), "v"(rg1[i][1]), "v"(rg1[i][2]));
#pragma unroll
            for (int i = 0; i < 8; ++i) { const unsigned o = gj + 512u * i;
                float a0 = HB(rg0[i][0]), a1 = HB(rg0[i][1]), a2 = HB(rg0[i][2]), c0 = HB(rg1[i][0]), c1 = HB(rg1[i][1]), c2 = HB(rg1[i][2]);
                if (i == 0) { a0 = gj ? a0 : 0.f; c0 = gj ? c0 : 0.f; }
                if (i == 7) { a2 = (o < 4095u) ? a2 : 0.f; c2 = (o < 4095u) ? c2 : 0.f; }
                gg0[i] = wg0 * a0 + wg1 * a1 + wg2 * a2 + bg; gg1[i] = wg0 * c0 + wg1 * c1 + wg2 * c2 + bg; } }
        __syncthreads();
        const cpx w8f = cmul(opaque(w8_), f ? c32(1) : c32(0));
        float* O0 = outp + ((size_t)b0 * 512 + c) * SEQ; float* O1 = outp + ((size_t)b1 * 512 + c) * SEQ;
        bf16* Z0 = (bf16*)(ws + WS_ZT) + ((size_t)b0 * 512 + c) * SEQ; bf16* Z1 = (bf16*)(ws + WS_ZT) + ((size_t)b1 * 512 + c) * SEQ;
#pragma unroll
        for (int i = 0; i < 8; ++i) { const int rr = f + 2 * i; const unsigned n = (unsigned)(j + 256 * f) + 512u * i;
            const cpx ye = cconj(buf[pj + 272 * rr]), yo = cconj(buf[FFT_STRIDE + pj + 272 * rr]);
            const cpx wn = cmul(w8f, c32(2 * i));
            const cpx y = cadd(ye, cmul(cconj(wn), yo));
            const float y0 = y.x * (1.0f / 8192.0f) + bias * uk0[i], y1 = y.y * (1.0f / 8192.0f) + bias * uk1[i];
                        if (stage == 0) { Z0[n] = (bf16)f2bf(gg0[i] * y0); Z1[n] = (bf16)f2bf(gg1[i] * y1); } else { O0[n] = gg0[i] * y0; O1[n] = gg1[i] * y1; } }
        __syncthreads();
    }
}

__device__ __forceinline__ f32x16 mfma32(bf16x8 a, bf16x8 b, f32x16 c) { return __builtin_amdgcn_mfma_f32_32x32x16_bf16(a, b, c, 0, 0, 0); }
typedef short s4v __attribute__((ext_vector_type(4)));
__device__ __forceinline__ bf16x8 tr_frag(const LAS bf16* base, int PT, int k0, int c0, int lane) {
    const int i = lane & 15, q = i >> 2, p = i & 3;
    const LAS bf16* ad = base + (k0 + 8 * (lane >> 5) + q) * PT + c0 + 16 * ((lane >> 4) & 1) + 4 * p;
    const s4v lo = __builtin_amdgcn_ds_read_tr16_b64_v4i16((LAS s4v*)ad);
    const s4v hi = __builtin_amdgcn_ds_read_tr16_b64_v4i16((LAS s4v*)(ad + 4 * PT));
    bf16x8 r; r[0] = lo[0]; r[1] = lo[1]; r[2] = lo[2]; r[3] = lo[3]; r[4] = hi[0]; r[5] = hi[1]; r[6] = hi[2]; r[7] = hi[3]; return r;
}
constexpr int GL_AL = 0, GL_WA = 8192, GL_TOT = 16384, GL_V = 24576, GL_VP = 160;
struct GlaTab { float P[4][2], X[4][2], Ptot[2], Xtot[2], Pref[2], Xref[2]; };
__device__ __forceinline__ void gla_tables(const Args& a, int h, LAS unsigned char* lds, GlaTab& T, int tid) {
    const int d2 = tid & 31, sg = tid >> 5;
    const LAS float* aL = (const LAS float*)(lds + GL_AL); const LAS float* wa = (const LAS float*)(lds + GL_WA); LAS float* tot = (LAS float*)(lds + GL_TOT);
    typedef float f32x2v __attribute__((ext_vector_type(2)));
    const f32x2v bf = *(const f32x2v*)(a.in[9] + h * 64 + 2 * d2), bb = *(const f32x2v*)(a.in[11] + h * 64 + 2 * d2);
    float lf[4][2], lb[4][2];
#pragma unroll
    for (int q = 0; q < 4; ++q) { const int s = sg * 4 + q; float pf0 = bf[0], pf1 = bf[1], pb0 = bb[0], pb1 = bb[1];
#pragma unroll
        for (int j4 = 0; j4 < 4; ++j4) { const f32x4 af = *(const LAS f32x4*)(aL + s * 32 + 4 * j4), ab = *(const LAS f32x4*)(aL + s * 32 + 16 + 4 * j4);
#pragma unroll
            for (int jj = 0; jj < 4; ++jj) { const int j = 4 * j4 + jj; const f32x2v wf = *(const LAS f32x2v*)(wa + j * 64 + 2 * d2), wb = *(const LAS f32x2v*)(wa + 1024 + j * 64 + 2 * d2);
                pf0 += af[jj] * wf[0]; pf1 += af[jj] * wf[1]; pb0 += ab[jj] * wb[0]; pb1 += ab[jj] * wb[1]; } }
        lf[q][0] = logsig_f(pf0) * (1.0f / 16.0f); lf[q][1] = logsig_f(pf1) * (1.0f / 16.0f); lb[q][0] = logsig_f(pb0) * (1.0f / 16.0f); lb[q][1] = logsig_f(pb1) * (1.0f / 16.0f); }
#pragma unroll
    for (int i = 0; i < 2; ++i) { lf[1][i] += lf[0][i]; lf[2][i] += lf[1][i]; lf[3][i] += lf[2][i]; lb[2][i] += lb[3][i]; lb[1][i] += lb[2][i]; lb[0][i] += lb[1][i]; }
    *(LAS f32x2v*)(tot + sg * 64 + 2 * d2) = (f32x2v){lf[3][0], lf[3][1]};
    *(LAS f32x2v*)(tot + 1024 + sg * 64 + 2 * d2) = (f32x2v){lb[0][0], lb[0][1]};
    __syncthreads();
    float of[2] = {0.f, 0.f}, ob[2] = {0.f, 0.f};
    T.Ptot[0] = T.Ptot[1] = T.Xtot[0] = T.Xtot[1] = T.Pref[0] = T.Pref[1] = T.Xref[0] = T.Xref[1] = 0.f;
#pragma unroll
    for (int g = 0; g < 16; ++g) { const f32x2v tf = *(const LAS f32x2v*)(tot + g * 64 + 2 * d2), tb = *(const LAS f32x2v*)(tot + 1024 + g * 64 + 2 * d2);
#pragma unroll
        for (int i = 0; i < 2; ++i) { T.Ptot[i] += tf[i]; T.Xtot[i] += tb[i]; if (g < 8) T.Pref[i] += tf[i]; else T.Xref[i] += tb[i];
            of[i] += (g < sg) ? tf[i] : 0.f; ob[i] += (g > sg) ? tb[i] : 0.f; } }
#pragma unroll
    for (int q = 0; q < 4; ++q)
#pragma unroll
        for (int i = 0; i < 2; ++i) { T.P[q][i] = lf[q][i] + of[i]; T.X[q][i] = lb[q][i] + ob[i]; }
}
struct GlaIn { f32x4 av, wv; unsigned kw[4], qw[4]; };
template <bool OUT>
__device__ __forceinline__ void gla_load(const Args& a, int tid, int bh, int ci, GlaIn& I) {
    const int b = bh >> 2, h = bh & 3, d2 = tid & 31, sg = tid >> 5;
    const size_t rowbase = OUT ? (size_t)b * SEQ + ci * 64 : ((ci < 4) ? (size_t)(MX + b * CTXL + ci * 64) : (size_t)(b * SEQ + (ci - 4) * 64));
    const float* afb = (const float*)(a.ws + WS_AFB); const bf16* qkvg = (const bf16*)(a.ws + WS_QKVG);
    I.av = *(const f32x4*)(afb + (rowbase + (tid >> 3)) * 32 + 4 * (tid & 7));
    const int wdir = tid >> 8, wj = (tid >> 4) & 15, wd4 = (tid & 15) * 4;
    I.wv = *(const f32x4*)((wdir ? a.in[10] : a.in[8]) + wj * 256 + h * 64 + wd4);
#pragma unroll
    for (int q = 0; q < 4; ++q) { const bf16* rp = qkvg + (rowbase + sg * 4 + q) * NQ + h * 64 + 2 * d2; I.kw[q] = *(const unsigned*)(rp + 256); if (OUT) I.qw[q] = *(const unsigned*)rp; }
}
__device__ __forceinline__ void gla_stage_common(const GlaIn& I, LAS unsigned char* lds, int tid) {
    const int wdir = tid >> 8, wj = (tid >> 4) & 15, wd4 = (tid & 15) * 4;
    *(LAS f32x4*)((LAS float*)(lds + GL_AL) + 4 * tid) = I.av;
    *(LAS f32x4*)((LAS float*)(lds + GL_WA) + wdir * 1024 + wj * 64 + wd4) = I.wv;
}

template <bool HASN>
__device__ __forceinline__ void gla_upd_item(const Args& a, LAS unsigned char* lds, int bh, int ci, const GlaIn& I, int nbh, int nci, GlaIn& N) {
    int tid = threadIdx.x; asm volatile("" : "+v"(tid));
    const int lane = tid & 63, wave = tid >> 6, h = bh & 3, d2 = tid & 31, sg = tid >> 5;
    unsigned char* ws = a.ws;
    constexpr int KP = 96;
    LAS bf16* vN = (LAS bf16*)(lds + GL_V); LAS bf16* kUf = (LAS bf16*)(lds + 45056); LAS bf16* kUb = (LAS bf16*)(lds + 57344);
    unsigned kw[4];
#pragma unroll
    for (int q = 0; q < 4; ++q) kw[q] = I.kw[q];
    v4u vv[2];
    { const int b = bh >> 2; const size_t rowbase = (ci < 4) ? (size_t)(MX + b * CTXL + ci * 64) : (size_t)(b * SEQ + (ci - 4) * 64); const bf16* qkvg = (const bf16*)(ws + WS_QKVG);
#pragma unroll
        for (int q = 0; q < 2; ++q) { const int idx = tid + NTHR * q; vv[q] = *(const v4u*)(qkvg + (rowbase + (idx >> 4)) * NQ + 512 + h * 128 + (idx & 15) * 8); } }
    gla_stage_common(I, lds, tid);
    __syncthreads();
    if (HASN) gla_load<false>(a, tid, nbh, nci, N);
    GlaTab T; gla_tables(a, h, lds, T, tid);
#pragma unroll
    for (int q = 0; q < 4; ++q) { const int s = sg * 4 + q; const float k0 = bflo(kw[q]), k1 = bfhi(kw[q]);
        *(LAS unsigned*)(kUf + s * KP + 2 * d2) = pk2(k0 * __expf(T.Ptot[0] - T.P[q][0]), k1 * __expf(T.Ptot[1] - T.P[q][1]));
        *(LAS unsigned*)(kUb + s * KP + 2 * d2) = pk2(k0 * __expf(T.Xtot[0] - T.X[q][0]), k1 * __expf(T.Xtot[1] - T.X[q][1])); }
#pragma unroll
    for (int q = 0; q < 2; ++q) { const int idx = tid + NTHR * q; *(LAS v4u*)(vN + (idx >> 4) * GL_VP + (idx & 15) * 8) = vv[q]; }
    if (tid < 32) { float* dec = (float*)(ws + WS_DEC);
#pragma unroll
        for (int i = 0; i < 2; ++i) { dec[((size_t)(bh * 2 + 0) * NCH + ci) * 64 + 2 * d2 + i] = __expf(T.Ptot[i]); dec[((size_t)(bh * 2 + 1) * NCH + ci) * 64 + 2 * d2 + i] = __expf(T.Xtot[i]); } }
    __syncthreads();
    { const int dir = wave >> 2, e0 = (wave & 3) * 32, l31 = lane & 31, hh = lane >> 5;
        const LAS bf16* kT = dir ? kUb : kUf;
        float* U = (ci < 4) ? (float*)(ws + WS_UCTX) + ((size_t)(bh * 2 + dir) * 4 + ci) * 8192 : a.out + ((size_t)(bh * 2 + dir) * 64 + (ci - 4)) * 8192;
        bf16x8 A[4];
#pragma unroll
        for (int ks = 0; ks < 4; ++ks) A[ks] = tr_frag(vN, GL_VP, 16 * ks, e0, lane);
#pragma unroll
        for (int dt = 0; dt < 2; ++dt) { const int d0 = dt * 32; f32x16 acc;
#pragma unroll
            for (int i = 0; i < 16; ++i) acc[i] = 0.f;
#pragma unroll
            for (int ks = 0; ks < 4; ++ks) acc = mfma32(A[ks], tr_frag(kT, KP, 16 * ks, d0, lane), acc);
#pragma unroll
            for (int r = 0; r < 16; ++r) { const int e = e0 + (r & 3) + 8 * (r >> 2) + 4 * hh; U[e * 64 + d0 + l31] = acc[r]; } } }
    __syncthreads();
}

__device__ __forceinline__ void gla_scan_item(const Args& a, int it) {
    int tid = threadIdx.x; asm volatile("" : "+v"(tid));
    const int bd = it >> 4, dir = bd & 1, el = ((it & 15) * 8 + (tid >> 6)) * 64 + (tid & 63), d = tid & 63;
    unsigned char* ws = a.ws;
    const float* dec = (const float*)(ws + WS_DEC) + (size_t)bd * NCH * 64 + d;
    const float* Uc = (const float*)(ws + WS_UCTX) + (size_t)bd * 4 * 8192 + el;
    const float* U = a.out + (size_t)bd * 64 * 8192 + el;
    bf16* Sp = (bf16*)(ws + WS_SPREV) + (size_t)bd * 64 * 8192 + el;
    float S = 0.f;
#pragma unroll
    for (int c4 = 0; c4 < 4; ++c4) { const int ci = dir ? 3 - c4 : c4; S = dec[ci * 64] * S + Uc[(size_t)ci * 8192]; }
#pragma unroll
    for (int blk = 0; blk < 2; ++blk) { float uu[32], dd[32];
#pragma unroll
        for (int j = 0; j < 32; ++j) { const int n = dir ? 63 - (blk * 32 + j) : blk * 32 + j; uu[j] = U[(size_t)n * 8192]; dd[j] = dec[(4 + n) * 64]; }
#pragma unroll
        for (int j = 0; j < 32; ++j) { const int n = dir ? 63 - (blk * 32 + j) : blk * 32 + j; Sp[(size_t)n * 8192] = (bf16)f2bf(S); S = dd[j] * S + uu[j]; } }
}

template <bool HASN>
__device__ __forceinline__ void gla_out_item(const Args& a, LAS unsigned char* lds, int bh, int n, const GlaIn& I, int nbh, int nn, GlaIn& N) {
    int tid = threadIdx.x; asm volatile("" : "+v"(tid));
    const int lane = tid & 63, wave = tid >> 6, b = bh >> 2, h = bh & 3, l31 = lane & 31, hh = lane >> 5, d2 = tid & 31, sg = tid >> 5;
    unsigned char* ws = a.ws;
    LAS bf16* Scat = (LAS bf16*)lds;
    LAS bf16* vN = (LAS bf16*)(lds + GL_V);
    LAS bf16* qf = (LAS bf16*)(lds + 45056); LAS bf16* qb = qf + 4608; LAS bf16* kf = qf + 2 * 4608; LAS bf16* kb = qf + 3 * 4608;
    LAS float* oS = (LAS float*)(lds + 45056);
    LAS bf16* qS = (LAS bf16*)(lds + 81920);
    LAS bf16* Sp = (LAS bf16*)(lds + 99328);
    const size_t rowbase = (size_t)b * SEQ + n * 64;
    unsigned qw[4], kw[4];
#pragma unroll
    for (int q = 0; q < 4; ++q) { qw[q] = I.qw[q]; kw[q] = I.kw[q]; }
    v4u vv[2], sv[4], g0, g1;
    { const bf16* qkvg = (const bf16*)(ws + WS_QKVG);
        { const bf16* gp = qkvg + (rowbase + (tid >> 3)) * NQ + 1024 + h * 128 + (tid & 7) * 16; g0 = *(const v4u*)gp; g1 = *(const v4u*)(gp + 8); }
#pragma unroll
        for (int q = 0; q < 2; ++q) { const int idx = tid + NTHR * q; vv[q] = *(const v4u*)(qkvg + (rowbase + (idx >> 4)) * NQ + 512 + h * 128 + (idx & 15) * 8); }
        const bf16* spf = (const bf16*)(ws + WS_SPREV) + ((size_t)(bh * 2 + 0) * 64 + n) * 8192; const bf16* spb = (const bf16*)(ws + WS_SPREV) + ((size_t)(bh * 2 + 1) * 64 + n) * 8192;
#pragma unroll
        for (int q = 0; q < 4; ++q) { const int idx = tid + NTHR * q, dir = idx >> 10, e = (idx >> 3) & 127, d8 = (idx & 7) * 8; sv[q] = *(const v4u*)((dir ? spb : spf) + e * 64 + d8); } }
    gla_stage_common(I, lds, tid);
    __syncthreads();
    if (HASN) gla_load<true>(a, tid, nbh, nn, N);
    GlaTab T; gla_tables(a, h, lds, T, tid);
#pragma unroll
    for (int q = 0; q < 4; ++q) { const int s = sg * 4 + q; const float q0 = bflo(qw[q]), q1 = bfhi(qw[q]), k0 = bflo(kw[q]), k1 = bfhi(kw[q]);
        *(LAS unsigned*)(qf + s * 72 + 2 * d2) = pk2(q0 * __expf(T.P[q][0] - T.Pref[0]), q1 * __expf(T.P[q][1] - T.Pref[1]));
        *(LAS unsigned*)(kf + s * 72 + 2 * d2) = pk2(k0 * __expf(T.Pref[0] - T.P[q][0]), k1 * __expf(T.Pref[1] - T.P[q][1]));
        *(LAS unsigned*)(qb + s * 72 + 2 * d2) = pk2(q0 * __expf(T.X[q][0] - T.Xref[0]), q1 * __expf(T.X[q][1] - T.Xref[1]));
        *(LAS unsigned*)(kb + s * 72 + 2 * d2) = pk2(k0 * __expf(T.Xref[0] - T.X[q][0]), k1 * __expf(T.Xref[1] - T.X[q][1]));
        *(LAS unsigned*)(qS + s * 136 + 2 * d2) = pk2(q0 * __expf(T.P[q][0]), q1 * __expf(T.P[q][1]));
        *(LAS unsigned*)(qS + s * 136 + 64 + 2 * d2) = pk2(q0 * __expf(T.X[q][0]), q1 * __expf(T.X[q][1])); }
#pragma unroll
    for (int q = 0; q < 2; ++q) { const int idx = tid + NTHR * q; *(LAS v4u*)(vN + (idx >> 4) * GL_VP + (idx & 15) * 8) = vv[q]; }
#pragma unroll
    for (int q = 0; q < 4; ++q) { const int idx = tid + NTHR * q, dir = idx >> 10, e = (idx >> 3) & 127, d8 = (idx & 7) * 8; *(LAS v4u*)(Sp + e * 136 + dir * 64 + d8) = sv[q]; }
    __syncthreads();
    { const int dir = wave >> 2, c0 = ((wave >> 1) & 1) * 32, s0 = (wave & 1) * 32;
        const LAS bf16* qq = dir ? qb : qf; const LAS bf16* kk = dir ? kb : kf;
        f32x16 acc;
#pragma unroll
        for (int i = 0; i < 16; ++i) acc[i] = 0.f;
#pragma unroll
        for (int ks = 0; ks < 4; ++ks) { const bf16x8 A = *(const LAS bf16x8*)(qq + (c0 + l31) * 72 + 16 * ks + 8 * hh), B = *(const LAS bf16x8*)(kk + (s0 + l31) * 72 + 16 * ks + 8 * hh);
            acc = mfma32(A, B, acc); }
        const int s = s0 + l31;
#pragma unroll
        for (int r = 0; r < 16; ++r) { const int c = c0 + (r & 3) + 8 * (r >> 2) + 4 * hh; const bool keep = dir ? (s >= c) : (s <= c);
            Scat[c * 136 + dir * 64 + s] = (bf16)f2bf(keep ? acc[r] : 0.f); } }
    __syncthreads();
    { const int c0 = (wave >> 2) * 32, e0 = (wave & 3) * 32;
        f32x16 acc;
#pragma unroll
        for (int i = 0; i < 16; ++i) acc[i] = 0.f;
#pragma unroll
        for (int ks = 0; ks < 8; ++ks) { const bf16x8 A = *(const LAS bf16x8*)(Scat + (c0 + l31) * 136 + 16 * ks + 8 * hh);
            acc = mfma32(A, tr_frag(vN, GL_VP, 16 * (ks & 3), e0, lane), acc); }
#pragma unroll
        for (int ks = 0; ks < 8; ++ks) { const bf16x8 A = *(const LAS bf16x8*)(qS + (c0 + l31) * 136 + 16 * ks + 8 * hh), B = *(const LAS bf16x8*)(Sp + (e0 + l31) * 136 + 16 * ks + 8 * hh);
            acc = mfma32(A, B, acc); }
#pragma unroll
        for (int r = 0; r < 16; ++r) { const int c = c0 + (r & 3) + 8 * (r >> 2) + 4 * hh; oS[c * 132 + e0 + l31] = acc[r]; } }
    __syncthreads();
    { const int row = tid >> 3, ec = (tid & 7) * 16; float v[16]; float ss = 0.f;
#pragma unroll
        for (int j = 0; j < 16; ++j) { v[j] = oS[row * 132 + ec + j]; ss += v[j] * v[j]; }
        ss += __shfl_xor(ss, 1); ss += __shfl_xor(ss, 2); ss += __shfl_xor(ss, 4);
        const float rs = rsqrtf(ss * (1.0f / 128.0f) + EPS);
        const float gv[16] = {bflo(g0.x), bfhi(g0.x), bflo(g0.y), bfhi(g0.y), bflo(g0.z), bfhi(g0.z), bflo(g0.w), bfhi(g0.w), bflo(g1.x), bfhi(g1.x), bflo(g1.y), bfhi(g1.y), bflo(g1.z), bfhi(g1.z), bflo(g1.w), bfhi(g1.w)};
        float o[16];
#pragma unroll
        for (int j = 0; j < 16; ++j) o[j] = DBG_GLA_K * v[j] * rs * a.in[12][ec + j] * silu_f(gv[j]);
        bf16* op = (bf16*)(ws + WS_AOUT) + (rowbase + row) * DM + h * 128 + ec;
        *(v4u*)op = (v4u){pk2(o[0], o[1]), pk2(o[2], o[3]), pk2(o[4], o[5]), pk2(o[6], o[7])};
        *(v4u*)(op + 8) = (v4u){pk2(o[8], o[9]), pk2(o[10], o[11]), pk2(o[12], o[13]), pk2(o[14], o[15])}; }
    __syncthreads();
}

__device__ __forceinline__ void hy_transpose_item(const Args& a, LAS unsigned char* lds, int it) {
    const int tid = threadIdx.x, b = it >> 6, t0 = (it & 63) * 64;
    LAS float* tile = (LAS float*)lds;
    const float* src = (const float*)(a.ws + WS_YHYT) + (size_t)b * 512 * SEQ + t0;
    bf16* dst = (bf16*)(a.ws + WS_AOUT) + ((size_t)b * SEQ + t0) * DM + 512;
    for (int half = 0; half < 2; ++half) {
#pragma unroll 8
        for (int q = 0; q < 32; ++q) { const int idx = tid + NTHR * q, c = idx >> 6, tt = idx & 63; tile[c * 65 + tt] = src[(size_t)(half * 256 + c) * SEQ + tt]; }
        __syncthreads();
#pragma unroll
        for (int q = 0; q < 4; ++q) { const int idx = tid + NTHR * q, t = idx >> 5, c8 = (idx & 31) * 8; const LAS float* s = tile + c8 * 65 + t;
            *(v4u*)(dst + (size_t)t * DM + half * 256 + c8) = (v4u){pk2(s[0], s[65]), pk2(s[2 * 65], s[3 * 65]), pk2(s[4 * 65], s[5 * 65]), pk2(s[6 * 65], s[7 * 65])}; }
        __syncthreads();
    }
}

__device__ __forceinline__ void phase_router(const Args& a, LAS unsigned char* lds) {
    const int tid = threadIdx.x, lane = tid & 63, wave = tid >> 6, wg = blockIdx.x, G = gridDim.x;
    unsigned char* ws = a.ws;
    LAS float* wr = (LAS float*)lds;
    for (int i = tid; i < 4096; i += NTHR) { const int l = i & 63, q = (i >> 6) & 3, j = (i >> 8) & 3, e4 = i >> 10;
        *(LAS f32x4*)(wr + 4 * i) = *(const f32x4*)(a.in[24] + (4 * l + 256 * j + q) * 16 + 4 * e4); }
    __syncthreads();
    const float* modr = (const float*)(ws + WS_MOD); const float* gffn = a.in[23];
    bf16* hn = (bf16*)(ws + WS_HN); float* aff = (float*)(ws + WS_AFF);
    const int NGW = G * NWAVES;
    f32x4 gv[4];
#pragma unroll
    for (int j = 0; j < 4; ++j) gv[j] = *(const f32x4*)(gffn + 4 * lane + 256 * j);
#pragma nounroll
    for (int r0 = wg * NWAVES + wave; r0 < MX; r0 += 2 * NGW) {
        const int r1 = r0 + NGW; const bool ok1 = r1 < MX; const int rB = ok1 ? r1 : r0;
        int lane_o = lane; asm volatile("" : "+v"(lane_o));
        f32x4 v[2][4];
#pragma unroll
        for (int j = 0; j < 4; ++j) { v[0][j] = *(const f32x4*)(a.out + (size_t)r0 * DM + 4 * lane + 256 * j); v[1][j] = *(const f32x4*)(a.out + (size_t)rB * DM + 4 * lane + 256 * j); }
        float rs[2];
#pragma unroll
        for (int k = 0; k < 2; ++k) { float ss = 0.f;
#pragma unroll
            for (int j = 0; j < 4; ++j) ss += v[k][j][0] * v[k][j][0] + v[k][j][1] * v[k][j][1] + v[k][j][2] * v[k][j][2] + v[k][j][3] * v[k][j][3];
            rs[k] = rsqrtf(wave_sum(ss) * (1.0f / DM) + EPS); }
        float lg[2][16];
#pragma unroll
        for (int k = 0; k < 2; ++k)
#pragma unroll
            for (int e = 0; e < 16; ++e) lg[k][e] = 0.f;
        f32x4 shv[2][4], scv[2][4];
#pragma unroll
        for (int k = 0; k < 2; ++k)
#pragma unroll
            for (int j = 0; j < 4; ++j) { const int b = (k ? rB : r0) >> 12, col = 4 * lane + 256 * j; shv[k][j] = *(const f32x4*)(modr + b * 6144 + 3072 + col); scv[k][j] = *(const f32x4*)(modr + b * 6144 + 4096 + col); }
#pragma unroll
        for (int j = 0; j < 4; ++j) { const int col = 4 * lane + 256 * j; f32x4 y[2];
#pragma unroll
            for (int k = 0; k < 2; ++k) { const int r = k ? rB : r0;
                const f32x4 sh = shv[k][j], sc = scv[k][j];
                y[k] = (v[k][j] * rs[k] * gv[j]) * (sc + 1.0f) + sh;
                v2u w; w.x = pk2(y[k][0], y[k][1]); w.y = pk2(y[k][2], y[k][3]);
                if (k == 0 || ok1) *(v2u*)(hn + (size_t)r * DM + col) = w; }
#pragma unroll
            for (int q = 0; q < 4; ++q) {
#pragma unroll
                for (int e4 = 0; e4 < 4; ++e4) { const f32x4 ww = *(const LAS f32x4*)(wr + 4 * ((((e4 * 4 + j) * 4 + q) << 6) + lane_o));
#pragma unroll
                    for (int s = 0; s < 4; ++s) { lg[0][e4 * 4 + s] += y[0][q] * ww[s]; lg[1][e4 * 4 + s] += y[1][q] * ww[s]; } }
#define PIN16(x) asm volatile("" : "+v"(x[0]), "+v"(x[1]), "+v"(x[2]), "+v"(x[3]), "+v"(x[4]), "+v"(x[5]), "+v"(x[6]), "+v"(x[7]), "+v"(x[8]), "+v"(x[9]), "+v"(x[10]), "+v"(x[11]), "+v"(x[12]), "+v"(x[13]), "+v"(x[14]), "+v"(x[15]) :: "memory")
                PIN16(lg[0]); PIN16(lg[1]); } }
#undef PIN16
        const bool h5 = (lane & 32) != 0, h4 = (lane & 16) != 0, h3 = (lane & 8) != 0, h2 = (lane & 4) != 0;
        const int ex = (h5 ? 8 : 0) + (h4 ? 4 : 0) + (h3 ? 2 : 0) + (h2 ? 1 : 0);
#pragma unroll
        for (int k = 0; k < 2; ++k) { float k8[8], k4[4], k2[2], lgt;
#pragma unroll
            for (int i = 0; i < 8; ++i) { const float snd = h5 ? lg[k][i] : lg[k][8 + i], kp = h5 ? lg[k][8 + i] : lg[k][i]; k8[i] = kp + __shfl_xor(snd, 32); }
#pragma unroll
            for (int i = 0; i < 4; ++i) { const float snd = h4 ? k8[i] : k8[4 + i], kp = h4 ? k8[4 + i] : k8[i]; k4[i] = kp + __shfl_xor(snd, 16); }
#pragma unroll
            for (int i = 0; i < 2; ++i) { const float snd = h3 ? k4[i] : k4[2 + i], kp = h3 ? k4[2 + i] : k4[i]; k2[i] = kp + __shfl_xor(snd, 8); }
            { const float snd = h2 ? k2[0] : k2[1], kp = h2 ? k2[1] : k2[0]; lgt = kp + __shfl_xor(snd, 4); }
            lgt += __shfl_xor(lgt, 2); lgt += __shfl_xor(lgt, 1);
            float mx = lgt;
            mx = fmaxf(mx, __shfl_xor(mx, 4)); mx = fmaxf(mx, __shfl_xor(mx, 8)); mx = fmaxf(mx, __shfl_xor(mx, 16)); mx = fmaxf(mx, __shfl_xor(mx, 32));
            const float pe = expf(lgt - mx);
            float sum = pe;
            sum += __shfl_xor(sum, 4); sum += __shfl_xor(sum, 8); sum += __shfl_xor(sum, 16); sum += __shfl_xor(sum, 32);
            const int r = k ? rB : r0;
            if ((lane & 3) == 0 && (k == 0 || ok1)) aff[((size_t)(r >> 12) * NE + ex) * SEQ + (r & 4095)] = pe / sum; }
    }
}

__device__ __forceinline__ void conv_item(const Args& a, LAS float* scr, int lane, bool gu, int it) {
    unsigned char* ws = a.ws;
    if (gu) { const int mat = it >> 9, r = it & 511, nb = r >> 4, kb = r & 15, e = mat >> 1, kind = mat & 1, n0 = nb * 32;
        transpose_item((kind ? a.in[26] : a.in[25]) + (size_t)e * DM * DM, DM, kb * 64, n0, (bf16*)(ws + WS_WGU) + (size_t)e * 2048 * DM, DM, (n0 >> 7) * 256 + kind * 128 + (n0 & 127), scr, lane, false);
    } else { const int e = it >> 9, r = it & 511, nb = r >> 4, kb = r & 15;
        transpose_item(a.in[27] + (size_t)e * DM * DM, DM, kb * 64, nb * 32, (bf16*)(ws + WS_WD) + (size_t)e * DM * DM, DM, nb * 32, scr, lane, false); }
}
__device__ __forceinline__ bool conv_try(const Args& a, LAS unsigned char* lds, bool allow_gu, unsigned& cur) {
    const int lane = threadIdx.x & 63, wave = threadIdx.x >> 6;
    const int gw = blockIdx.x * NWAVES + wave, NGW = gridDim.x * NWAVES;
    LAS float* scr = (LAS float*)(lds + wave * 8448);
    const int itD = gw + (int)(cur & 0xffffu) * NGW;
    if (itD < NE * 512) { conv_item(a, scr, lane, false, itD); cur += 1u; return true; }
    if (!allow_gu) return false;
    const int itG = gw + (int)(cur >> 16) * NGW;
    if (itG < NE * 1024) { conv_item(a, scr, lane, true, itG); cur += 0x10000u; return true; }
    return false;
}
#ifndef DBG_NOSHADOW
#define DBG_NOSHADOW 0
#endif
__device__ __forceinline__ void seam_barrier(const XcdBarrier& b, const Args& a, LAS unsigned char* lds, volatile LAS unsigned* MISC, unsigned& gen, bool allow_gu, unsigned& cdone) {
    asm volatile("s_waitcnt vmcnt(0)" ::: "memory");
    __syncthreads();
    ++gen;
    if (threadIdx.x < 64) {
        if (threadIdx.x == 0) {
            unsigned* bar = b.bar;
            __builtin_amdgcn_s_waitcnt(0);
            unsigned nloc = b.st[0], nx = b.st[1];
            if (nloc == 0u) { xcd_barrier_complete(bar, b.x, nloc, nx); b.st[0] = nloc; b.st[1] = nx; }
            const unsigned old = xb_add(&bar[XB_XSUB(b.x)], 1u);
            const unsigned g2 = old / nloc;
            if (old + 1u == (g2 + 1u) * nloc) {
                __builtin_amdgcn_fence(__ATOMIC_RELEASE, "agent");
                asm volatile("s_waitcnt vmcnt(0)" ::: "memory");
                const unsigned og = xb_add(&bar[XB_TOP], 1u);
                const unsigned tg = og / nx;
                if (og + 1u == (tg + 1u) * nx) xb_add(&bar[XB_TOPGEN], 1u);
                else XB_SPIN(xb_ld(&bar[XB_TOPGEN]) == tg, bar);
                __builtin_amdgcn_fence(__ATOMIC_ACQUIRE, "agent");
                xb_add(&bar[XB_XGEN(b.x)], 1u);
                asm volatile("s_waitcnt vmcnt(0)" ::: "memory");
            } else {
                XB_SPIN(xb_ld(&bar[XB_XGEN(b.x)]) == g2, bar);
                __builtin_amdgcn_fence(__ATOMIC_ACQUIRE, "agent");
                asm volatile("s_waitcnt vmcnt(0)" ::: "memory");
            }
            MISC[16] = gen;
        }
    } else {
        unsigned spins = 0;
        while (MISC[16] != gen) { if (DBG_NOSHADOW || !conv_try(a, lds, allow_gu, cdone)) { __builtin_amdgcn_s_sleep(4); if (++spins > (1u << 22)) break; } }
    }
    __syncthreads();
}

__device__ __forceinline__ void block_excl_scan2(int& va, int& vb, LAS int* tmp) {
    const int tid = threadIdx.x, lane = tid & 63, wave = tid >> 6;
    int ia = va, ib = vb;
#pragma unroll
    for (int o = 1; o < 64; o <<= 1) { const int ta = __shfl_up(ia, o), tb = __shfl_up(ib, o); if (lane >= o) { ia += ta; ib += tb; } }
    if (lane == 63) { tmp[wave] = ia; tmp[8 + wave] = ib; }
    __syncthreads();
    int oa = 0, ob = 0;
#pragma unroll
    for (int w = 0; w < 8; ++w) { if (w < wave) { oa += tmp[w]; ob += tmp[8 + w]; } }
    va = oa + ia - va; vb = ob + ib - vb;
    __syncthreads();
}
__device__ __forceinline__ void topk_item(const Args& a, LAS unsigned char* lds, int be) {
    const int tid = threadIdx.x, b = be >> 4, e = be & 15;
    unsigned char* ws = a.ws;
    LAS unsigned* keys = (LAS unsigned*)lds;
    LAS unsigned* hist = (LAS unsigned*)(lds + 16384);
    LAS int* ctl = (LAS int*)(lds + 16384 + 1024);
    LAS int* tmp = (LAS int*)(lds + 16384 + 1024 + 64);
    const float* aff = (const float*)(ws + WS_AFF) + (size_t)be * SEQ;
    unsigned my[8];
#pragma unroll
    for (int i = 0; i < 8; ++i) { my[i] = __float_as_uint(aff[tid * 8 + i]); keys[tid * 8 + i] = my[i]; }
    unsigned prefix = 0u, mask = 0u; int need = CAP;
    for (int pass = 0; pass < 4; ++pass) {
        const int shift = 24 - 8 * pass;
        if (tid < 256) hist[tid] = 0u;
        __syncthreads();
#pragma unroll
        for (int i = 0; i < 8; ++i) if ((my[i] & mask) == prefix) atomicAdd((unsigned*)&hist[(my[i] >> shift) & 255u], 1u);
        __syncthreads();
        {
            int hv = (tid < 256) ? (int)hist[255 - tid] : 0, inc = hv;
#pragma unroll
            for (int o = 1; o < 64; o <<= 1) { const int t2 = __shfl_up(inc, o); if ((tid & 63) >= o) inc += t2; }
            if ((tid & 63) == 63) tmp[tid >> 6] = inc;
            __syncthreads();
            int off = 0;
#pragma unroll
            for (int w = 0; w < 4; ++w) if (w < (tid >> 6)) off += tmp[w];
            inc += off;
            if (tid < 256 && inc >= need && inc - hv < need) { ctl[0] = 255 - tid; ctl[1] = need - (inc - hv); }
        }
        __syncthreads();
        prefix |= ((unsigned)ctl[0]) << shift; mask |= 255u << shift; need = ctl[1];
        __syncthreads();
    }
    const unsigned T = prefix;
    int cg = 0, ce = 0;
#pragma unroll
    for (int i = 0; i < 8; ++i) { cg += (my[i] > T) ? 1 : 0; ce += (my[i] == T) ? 1 : 0; }
    int pg = cg, pe = ce;
    block_excl_scan2(pg, pe, tmp);
    int* slot_of = (int*)(ws + WS_SLOT) + (size_t)be * SEQ;
    int* selt = (int*)(ws + WS_SELT) + (e * 4 + b) * CAP; float* selv = (float*)(ws + WS_SELV) + (e * 4 + b) * CAP;
#pragma unroll
    for (int i = 0; i < 8; ++i) { const int t = tid * 8 + i; const bool gt = my[i] > T, eq = my[i] == T; const bool sel = gt || (eq && pe < need);
        const int slot = pg + (pe < need ? pe : need);
        slot_of[t] = sel ? slot : -1;
        if (sel) { selt[slot] = t; selv[slot] = __uint_as_float(my[i]); }
        pg += gt ? 1 : 0; pe += eq ? 1 : 0; }
    __syncthreads();
}
__device__ __forceinline__ void phase_topk(const Args& a, LAS unsigned char* lds, unsigned& cdone) {
    const int tid = threadIdx.x, lane = tid & 63, wave = tid >> 6, wg = blockIdx.x, G = gridDim.x;
    unsigned char* ws = a.ws;
    for (int it = wg; it < NB * NE; it += G) topk_item(a, lds, it);
    __syncthreads();
    while (conv_try(a, lds, true, cdone)) {}
}

__device__ __forceinline__ void phase_final(const Args& a) {
    const int tid = threadIdx.x, lane = tid & 63, wave = tid >> 6, wg = blockIdx.x, G = gridDim.x;
    unsigned char* ws = a.ws;
    const float* modr = (const float*)(ws + WS_MOD); const int* slot_of = (const int*)(ws + WS_SLOT); const bf16* ys = (const bf16*)(ws + WS_YSLAB);
    const int NGW = G * NWAVES;
    f32x4 gf[4];
#pragma unroll
    for (int j = 0; j < 4; ++j) gf[j] = *(const f32x4*)(a.in[28] + 4 * lane + 256 * j);
#pragma nounroll
    for (int r0 = wg * NWAVES + wave; r0 < MX; r0 += 4 * NGW) {
        int sv[4]; unsigned long long mk[4]; f32x4 v[4][4], m[4][4];
#pragma unroll
        for (int k = 0; k < 4; ++k) { const int r = r0 + k * NGW; const bool ok = r < MX; const int rc = ok ? r : r0, b = rc >> 12, t = rc & 4095;
            sv[k] = (lane < NE) ? slot_of[((size_t)b * NE + lane) * SEQ + t] : -1;
#pragma unroll
            for (int j = 0; j < 4; ++j) { v[k][j] = *(const f32x4*)(a.out + (size_t)rc * DM + 4 * lane + 256 * j); m[k][j] = (f32x4){0.f, 0.f, 0.f, 0.f}; }
            mk[k] = (ok && !DBG_NOMOE) ? __ballot(sv[k] >= 0) : 0ull; }
        while (mk[0] | mk[1] | mk[2] | mk[3]) {
            v2u w[4][4]; float wt[4];
#pragma unroll
            for (int k = 0; k < 4; ++k) { const bool has = mk[k] != 0ull; const int e = has ? (int)__ffsll((long long)mk[k]) - 1 : 0; mk[k] &= mk[k] - 1ull;
                const int rc = (r0 + k * NGW < MX) ? r0 + k * NGW : r0; const int sl = has ? __builtin_amdgcn_readlane(sv[k], e) : 0;
                const bf16* yp = ys + ((size_t)e * 2048 + (rc >> 12) * CAP + sl) * DM; wt[k] = has ? 1.f : 0.f;
#pragma unroll
                for (int j = 0; j < 4; ++j) w[k][j] = *(const v2u*)(yp + 4 * lane + 256 * j); }
#pragma unroll
            for (int k = 0; k < 4; ++k)
#pragma unroll
                for (int j = 0; j < 4; ++j) { m[k][j][0] += wt[k] * bflo(w[k][j].x); m[k][j][1] += wt[k] * bfhi(w[k][j].x); m[k][j][2] += wt[k] * bflo(w[k][j].y); m[k][j][3] += wt[k] * bfhi(w[k][j].y); }
        }
        f32x4 gt[4][4];
#pragma unroll
        for (int k = 0; k < 4; ++k) { const int r = r0 + k * NGW, b = ((r < MX) ? r : r0) >> 12;
#pragma unroll
            for (int j = 0; j < 4; ++j) gt[k][j] = *(const f32x4*)(modr + b * 6144 + 5120 + 4 * lane + 256 * j); }
#pragma unroll
        for (int k = 0; k < 4; ++k) { const int r = r0 + k * NGW;
            if (r < MX) { float ss = 0.f; float* row = a.out + (size_t)r * DM;
#pragma unroll
                for (int j = 0; j < 4; ++j) { v[k][j] = v[k][j] + gt[k][j] * m[k][j] * DBG_MOE_K;
                    ss += v[k][j][0] * v[k][j][0] + v[k][j][1] * v[k][j][1] + v[k][j][2] * v[k][j][2] + v[k][j][3] * v[k][j][3]; }
                const float rs = rsqrtf(wave_sum(ss) * (1.0f / DM) + EPS);
#pragma unroll
                for (int j = 0; j < 4; ++j) *(f32x4*)(row + 4 * lane + 256 * j) = v[k][j] * rs * gf[j]; } }
    }
}

__global__ void __launch_bounds__(NTHR, 2) fwd_kernel(Args a) {
    extern __shared__ __attribute__((aligned(16))) unsigned char lds_raw[];
    LAS unsigned char* lds = (LAS unsigned char*)lds_raw;
    const int tid = threadIdx.x, wg = blockIdx.x, G = gridDim.x;
    unsigned char* ws = a.ws;
    volatile LAS unsigned* MISC = (volatile LAS unsigned*)(lds + LDS_MISC);
    if (tid < 64) MISC[tid] = 0u;
    __syncthreads();
    unsigned bgen = 0u, cdone = 0u;
    XcdBarrier bar; bar.bar = (unsigned*)(ws + WS_CTL); bar.x = 0; bar.st = nullptr;
    if (a.ph_hi - a.ph_lo > 1) bar = xcd_barrier_post((unsigned*)(ws + WS_CTL), MISC + 8);
#ifndef PH_ONLY
#define PH_ONLY -1
#endif
#define IN(k) ((PH_ONLY < 0 || PH_ONLY == (k)) && a.ph_lo <= (k) && (k) < a.ph_hi)
#ifndef DBG_BAR2
#define DBG_BAR2 0
#endif
#ifndef DBG_TSA
#define DBG_TSA -1
#endif
#ifndef DBG_TSB
#define DBG_TSB -1
#endif
#define STAMP(k) do { if (DBG_TSA >= 0 && wg == 0 && tid == 0) ((unsigned long long*)(ws + WS_CTL + 49152))[k] = __builtin_amdgcn_s_memrealtime(); } while (0)
#define SEAM(k) do { if (IN(k) && IN((k) + 1)) { seam_barrier(bar, a, lds, MISC, bgen, (k) >= 6, cdone); if (DBG_BAR2) xcd_barrier(bar); } STAMP((k) + 1); } while (0)
#ifndef DBG_DUP
#define DBG_DUP -1
#endif
#define REP(k) _Pragma("nounroll") for (int _rep = 0; _rep < ((DBG_DUP == (k)) ? 2 : 1); ++_rep, (void)((DBG_DUP == (k) && _rep == 1) ? (xcd_barrier(bar), 0) : 0))
    STAMP(0);
    if (IN(0)) REP(0) { phase0(a, lds); } SEAM(0);
    if (IN(1)) REP(1) { phase1(a, lds); } SEAM(1);
    if (IN(2)) REP(2) {
        pg8::Gemm g{(const pg8::bf16_t*)ws, (const pg8::bf16_t*)ws, MT, NIN, DM}; InSched S; S.init(G, wg, 0);
        EpiIn E{(bf16*)(ws + WS_QKVG), (bf16*)(ws + WS_HYT), (float*)(ws + WS_AFB)};
        pg8::gemm_phase<EpiIn, InSched, true, true>(lds, g, S, E);
    } SEAM(2);
    if (IN(3)) REP(3) {
        {   pg8::Gemm g{(const pg8::bf16_t*)ws, (const pg8::bf16_t*)ws, MT, NIN, DM}; InSched S; S.init(G, wg, 1);
            EpiIn E{(bf16*)(ws + WS_QKVG), (bf16*)(ws + WS_HYT), (float*)(ws + WS_AFB)};
            pg8::gemm_phase<EpiIn, InSched, true, true>(lds, g, S, E); }
        for (int it = wg; it < 512; it += G) hyena_item(a, lds, it, 0);
        {   GlaIn I, N; bool have = false;
            const bool split = (G == 256);
            const int first = split ? ((wg < 80) ? wg : 80 + wg) : wg, stride = split ? ((wg < 80) ? 80 : 176) : G, limit = split ? ((wg < 80) ? 160 : 16 * NCH) : 16 * NCH;
            for (int r = first; r < limit; r += stride) {
                const int nr = r + stride; const bool hasn = nr < limit;
                if (!have) { int t0 = threadIdx.x; asm volatile("" : "+v"(t0)); gla_load<false>(a, t0, r / NCH, r % NCH, I); have = true; }
                if (hasn) gla_upd_item<true>(a, lds, r / NCH, r % NCH, I, nr / NCH, nr % NCH, N); else gla_upd_item<false>(a, lds, r / NCH, r % NCH, I, 0, 0, N);
                I = N; } }
    } SEAM(3);
    if (IN(4)) REP(4) {
        for (int it = wg; it < 1024; it += G) { if (it < 512) hyena_item(a, lds, it, 1); else gla_scan_item(a, it - 512); }
    } SEAM(4);
    if (IN(5)) REP(5) {
        GlaIn I, N; bool have = false;
        for (int it = wg; it < 1280; it += G) {
            if (it >= 1024) { hy_transpose_item(a, lds, it - 1024); continue; }
            const int nr = it + G; const bool hasn = nr < 1024;
            if (!have) { int t0 = threadIdx.x; asm volatile("" : "+v"(t0)); gla_load<true>(a, t0, it >> 6, it & 63, I); have = true; }
            if (hasn) gla_out_item<true>(a, lds, it >> 6, it & 63, I, nr >> 6, nr & 63, N); else gla_out_item<false>(a, lds, it >> 6, it & 63, I, 0, 0, N);
            I = N; }
    } SEAM(5);
    if (IN(6)) REP(6) {
        pg8::Gemm g{(const pg8::bf16_t*)(ws + WS_AOUT), (const pg8::bf16_t*)(ws + WS_WOUT), MX, DM, DM}; pg8::StaticOrder S; S.init(MX, DM, G, wg);
        EpiOut E{a.in[0], (const float*)(ws + WS_POS), (const float*)(ws + WS_MOD), a.out};
        pg8::gemm_phase<EpiOut, pg8::StaticOrder, false, true>(lds, g, S, E);
    } SEAM(6);
    if (IN(7)) REP(7) { phase_router(a, lds); } SEAM(7);
    if (IN(8)) REP(8) { phase_topk(a, lds, cdone); } SEAM(8);
    if (IN(9)) REP(9) {
        pg8::Gemm g{(const pg8::bf16_t*)(ws + WS_HN), (const pg8::bf16_t*)(ws + WS_WGU), NE * 2048, NE * 2048, DM}; MoeSched<8> S; S.init(G, wg);
        EpiGU E{(bf16*)(ws + WS_HID)};
        pg8::gemm_phase_gather<EpiGU, MoeSched<8>, true, true>(lds, g, S, E, (const int*)(ws + WS_SELT));
    } SEAM(9);
    if (IN(10)) REP(10) {
        pg8::Gemm g{(const pg8::bf16_t*)(ws + WS_HID), (const pg8::bf16_t*)(ws + WS_WD), NE * 2048, NE * 1024, DM}; MoeSched<4> S; S.init(G, wg);
        EpiDown E{(bf16*)(ws + WS_YSLAB), (const float*)(ws + WS_SELV)};
        pg8::gemm_phase<EpiDown, MoeSched<4>, true, true>(lds, g, S, E);
    } SEAM(10);
    if (IN(11)) { phase_final(a); }
    if (DBG_TSA >= 0) {
        xcd_barrier(bar); STAMP(12); xcd_barrier(bar);
        const unsigned long long* ts = (const unsigned long long*)(ws + WS_CTL + 49152);
        const float da = (DBG_TSA == 12) ? (float)(ts[12] - ts[0]) * 0.01f : (float)(ts[DBG_TSA + 1] - ts[DBG_TSA]) * 0.01f;
        const float db = (DBG_TSB == 12) ? (float)(ts[12] - ts[0]) * 0.01f : (float)(ts[DBG_TSB + 1] - ts[DBG_TSB]) * 0.01f;
        for (size_t i = (size_t)wg * NTHR + tid; i < (size_t)MX * DM; i += (size_t)G * NTHR) a.out[i] = (i < (size_t)MX * DM / 2) ? da : db;
    }
#undef IN
#undef SEAM
}


#ifdef DBG_STATE
__global__ void chk_kernel(const unsigned* p, size_t nwords, unsigned long long* out) {
    unsigned long long s = 0ull;
    for (size_t i = (size_t)blockIdx.x * blockDim.x + threadIdx.x; i < nwords; i += (size_t)gridDim.x * blockDim.x) s += (unsigned long long)p[i] * (2ull * i + 1ull);
    for (int o = 1; o < 64; o <<= 1) s += __shfl_xor(s, o);
    if ((threadIdx.x & 63) == 0) atomicAdd(out, s);
}
__global__ void report_kernel(const unsigned long long* chk, float* out, int n) {
    int bad = -1;
    for (int p = 0; p < 27; ++p) if (chk[p] != chk[32 + p]) { bad = p; break; }
    if (bad < 0) return;
    for (int i = blockIdx.x * blockDim.x + threadIdx.x; i < n; i += gridDim.x * blockDim.x) out[i] = 1000.f * (float)(bad + 1);
}
struct ChkEnt { int ph; size_t off; size_t bytes; };
#endif
extern "C" void kernel_launch(void* const* d_in, const int* in_sizes, int n_in, void* d_out, int out_size, void* d_ws, size_t ws_size, hipStream_t stream) {
    static int grid = 0;
    if (grid == 0) {
        if (n_in != 29 || out_size != MX * DM || ws_size < WS_END) { fprintf(stderr, "kernel_launch: unexpected shapes (n_in %d out %d ws %zu)\n", n_in, out_size, ws_size); grid = -1; return; }
        int dev = 0, cus = 0, per_cu = 0;
        if (hipGetDevice(&dev) != hipSuccess || hipDeviceGetAttribute(&cus, hipDeviceAttributeMultiprocessorCount, dev) != hipSuccess) { grid = -1; return; }
        if (hipFuncSetAttribute((const void*)fwd_kernel, hipFuncAttributeMaxDynamicSharedMemorySize, LDS_BYTES) != hipSuccess) { fprintf(stderr, "kernel_launch: hipFuncSetAttribute failed\n"); grid = -1; return; }
        if (hipOccupancyMaxActiveBlocksPerMultiprocessor(&per_cu, (const void*)fwd_kernel, NTHR, LDS_BYTES) != hipSuccess || per_cu < 1) fprintf(stderr, "kernel_launch: occupancy query reports %d\n", per_cu);
        (void)hipGetLastError();
        grid = cus;
    }
    if (grid < 0) return;
    (void)hipMemsetAsync((char*)d_ws + WS_CTL, 0, CTL_BYTES, stream);
    Args a{};
    for (int i = 0; i < 29; ++i) a.in[i] = (const float*)d_in[i];
    a.out = (float*)d_out; a.ws = (unsigned char*)d_ws;
#if MK_SINGLE
#ifdef DBG_TWICE
    a.ph_lo = 0; a.ph_hi = NPH - 1;
    hipLaunchKernelGGL(fwd_kernel, dim3(grid), dim3(NTHR), LDS_BYTES, stream, a);
    (void)hipMemsetAsync((char*)d_ws + WS_CTL, 0, CTL_BYTES, stream);
#endif
    a.ph_lo = 0; a.ph_hi = NPH;
    hipLaunchKernelGGL(fwd_kernel, dim3(grid), dim3(NTHR), LDS_BYTES, stream, a);
#else
#ifdef DBG_STATE
    static const ChkEnt ents[] = { {0, WS_MOD, 122880}, {0, WS_POS, 131072}, {0, WS_HT, 32 * MiB}, {0, WS_WIN, (size_t)NIN * DM * 2}, {0, WS_WOUT, 2 * MiB},
        {1, WS_AIN, 34 * MiB}, {2, WS_QKVG, (size_t)MX * NQ * 2}, {2, WS_HYT, 48 * MiB}, {2, WS_AFB, (size_t)MT * 128},
        {3, WS_ZT, 32 * MiB}, {3, WS_DEC, (size_t)16 * 2 * NCH * 64 * 4}, {3, WS_UCTX, 4 * MiB}, {3, (size_t)-1, 64 * MiB},
        {4, WS_SPREV, 32 * MiB}, {4, WS_YHYT, 32 * MiB}, {5, WS_AOUT, 32 * MiB}, {6, (size_t)-1, 64 * MiB}, {7, WS_HN, 32 * MiB}, {7, WS_AFF, 1 * MiB},
        {8, WS_SLOT, 1 * MiB}, {8, WS_SELT, 131072}, {8, WS_SELV, 131072}, {8, WS_WGU, 64 * MiB}, {8, WS_WD, 32 * MiB}, {9, WS_HID, 64 * MiB}, {10, WS_YSLAB, 64 * MiB}, {11, (size_t)-1, 64 * MiB} };
    unsigned long long* chk = (unsigned long long*)((char*)d_ws + 32768);
    for (int run = 0; run < 2; ++run)
        for (int p = 0; p < NPH; ++p) { a.ph_lo = p; a.ph_hi = p + 1; hipLaunchKernelGGL(fwd_kernel, dim3(grid), dim3(NTHR), LDS_BYTES, stream, a);
            for (const ChkEnt& e : ents) if (e.ph == p) hipLaunchKernelGGL(chk_kernel, dim3(1024), dim3(256), 0, stream, (const unsigned*)(e.off == (size_t)-1 ? (char*)d_out : (char*)d_ws + e.off), e.bytes / 4, chk + run * 32 + (int)(&e - ents)); }
    hipLaunchKernelGGL(report_kernel, dim3(1024), dim3(256), 0, stream, (const unsigned long long*)chk, (float*)d_out, out_size);
#else
    for (int p = 0; p < NPH; ++p) { a.ph_lo = p; a.ph_hi = p + 1; hipLaunchKernelGGL(fwd_kernel, dim3(grid), dim3(NTHR), LDS_BYTES, stream, a); }
#endif
#endif
}
```

```cpp
#include <hip/hip_runtime.h>
#include <cstdio>
#include <cstdint>
#define MK_SINGLE 1
namespace pg8 {
#define PG8_LAS __attribute__((address_space(3)))
typedef unsigned short bf16_t;
typedef short bf16x8 __attribute__((ext_vector_type(8)));
typedef float f32x4 __attribute__((ext_vector_type(4)));
typedef unsigned u32x4 __attribute__((ext_vector_type(4)));
constexpr int BM = 256, BK = 64, HALF = 128, HTB = HALF * BK * 2  , STAGE_BYTES = 8 * HTB, NXCD = 8, WGM = 8;

__host__ __device__ __forceinline__ int lds_byte(int r, int c) { const int st = (r >> 4) * 2 + (c >> 5), rr = r & 15, cc = c & 31, ob = rr * 64 + cc * 2; return st * 1024 + (ob ^ (((ob >> 9) & 1) << 5)); }
__host__ __device__ __forceinline__ void stage_rc(int b, int& R, int& C) { const int st = b / 1024, sb = b % 1024, swz = sb ^ (((sb >> 9) & 1) << 5); R = (st >> 1) * 16 + swz / 64; C = (st & 1) * 32 + (swz % 64) / 2; }
__host__ __device__ __forceinline__ int perm32(int rho) { const int n = rho >> 4, i = rho & 15; return 8 * (i >> 2) + 4 * n + (i & 3); }

struct Unit { int pm, pn; };
struct Gemm { const bf16_t* A; const bf16_t* Bt; int M, N, K; };

struct StaticOrder {
    int nM, nN, nwg, G, c;
    __host__ __device__ void init(int M, int N, int G_, int c_) { nM = M / BM; nN = N / BM; nwg = nM * nN; G = G_; c = c_; }
    __host__ __device__ bool next(int i, Unit& u) const {
        const long L = (long)i * G + c; if (L >= nwg) return false;
        int wgid = (int)L; { const int q = nwg / NXCD, r = nwg % NXCD, xcd = wgid % NXCD, off = wgid / NXCD; wgid = (xcd < r ? xcd * (q + 1) : r * (q + 1) + (xcd - r) * q) + off; }
        const int nig = WGM * nN, gid = wgid / nig, fm = gid * WGM, gsz = (nM - fm) < WGM ? (nM - fm) : WGM;
        u.pm = fm + ((wgid % nig) % gsz); u.pn = (wgid % nig) / gsz; return true;
    }
    __device__ __forceinline__ void a_ready(const Unit&) const {}
    __device__ __forceinline__ void done(const Unit&) const {}
};

__device__ __forceinline__ unsigned cvt_pk_bf16(float lo, float hi) { unsigned r; asm volatile("v_cvt_pk_bf16_f32 %0, %1, %2" : "=v"(r) : "v"(lo), "v"(hi)); return r; }
template <class Epi, class Sched, bool ALIGN_EPI = false, bool SP2 = false>
__device__ __forceinline__ void gemm_phase(PG8_LAS unsigned char* lds, const Gemm g, const Sched& S, const Epi& E) {
    const int tid = threadIdx.x, wid = __builtin_amdgcn_readfirstlane(tid >> 6), lane = tid & 63, wr = wid >> 2, wc = wid & 3, fr = lane & 15, fq = lane >> 4;
    const int K = g.K, nt = K / BK;
    unsigned voffA[2], voffB[2];
#pragma unroll
    for (int i = 0; i < 2; ++i) { int R, C; stage_rc(tid * 16 + i * 8192, R, C); const int Rb = Epi::PERM ? ((R & ~31) + perm32(R & 31)) : R;
        voffA[i] = (unsigned)(R * K + C) * 2u; voffB[i] = (unsigned)(Rb * K + C) * 2u; }
    const size_t kstep = (size_t)(BK * 2);
    const size_t hstep = (size_t)HALF * K * 2;
    const size_t tstep = 2 * hstep;
    const unsigned ldsw = (unsigned)wid * 1024u;
    const int aoff = lds_byte(wr * 64 + fr, fq * 8), boff = lds_byte(wc * 32 + fr, fq * 8);
#define PG8_SA(b, h) (((b) * 2 + (h)) * HTB)
#define PG8_SB(b, h) ((4 + (b) * 2 + (h)) * HTB)
#define PG8_STAGE(bufoff, gbase, voff) do { _Pragma("unroll") for (int _i = 0; _i < 2; ++_i) \
        __builtin_amdgcn_global_load_lds((const unsigned*)((const char*)(gbase) + (voff)[_i]), (PG8_LAS unsigned*)(lds + (bufoff) + ldsw + _i * 8192), 16, 0, 0); } while (0)
#define PG8_LDA(dst, b, h) do { _Pragma("unroll") for (int m = 0; m < 4; ++m) _Pragma("unroll") for (int k = 0; k < 2; ++k) dst[m][k] = *(const PG8_LAS bf16x8*)(lds + PG8_SA(b, h) + aoff + m * 2048 + k * 1024); } while (0)
#define PG8_LDB(dst, b, h) do { _Pragma("unroll") for (int n = 0; n < 2; ++n) _Pragma("unroll") for (int k = 0; k < 2; ++k) dst[n][k] = *(const PG8_LAS bf16x8*)(lds + PG8_SB(b, h) + boff + n * 2048 + k * 1024); } while (0)
#define PG8_MMA(ai, bj, At, Bt) do { __builtin_amdgcn_s_setprio(1); _Pragma("unroll") for (int m = 0; m < 4; ++m) _Pragma("unroll") for (int n = 0; n < 2; ++n) _Pragma("unroll") for (int k = 0; k < 2; ++k) \
        acc[ai][bj][m][n] = __builtin_amdgcn_mfma_f32_16x16x32_bf16(Bt[n][k], At[m][k], acc[ai][bj][m][n], 0, 0, 0); __builtin_amdgcn_s_setprio(0); } while (0)
#define PG8_WAIT_V(n) asm volatile("s_waitcnt vmcnt(" #n ")" ::: "memory")
#define PG8_WAIT_L(n) asm volatile("s_waitcnt lgkmcnt(" #n ")" ::: "memory")
#define PG8_BAR __builtin_amdgcn_s_barrier()
#define PG8_SCHED __builtin_amdgcn_sched_barrier(0)
    Unit cur, nxt; int ui = 0;
    if (!S.next(0, cur)) return;
    f32x4 acc[2][2][4][2];
#pragma unroll
    for (int a = 0; a < 2; ++a)
#pragma unroll
        for (int b = 0; b < 2; ++b)
#pragma unroll
            for (int m = 0; m < 4; ++m)
#pragma unroll
                for (int n = 0; n < 2; ++n) acc[a][b][m][n] = (f32x4){0.f, 0.f, 0.f, 0.f};
    bf16x8 At[4][2], B0[2][2], B1[2][2];
    const char* cA = (const char*)g.A + (size_t)cur.pm * tstep; const char* cB = (const char*)g.Bt + (size_t)cur.pn * tstep;
    S.a_ready(cur);
    if constexpr (SP2) {
        PG8_STAGE(PG8_SB(0, 0), cB, voffB); PG8_STAGE(PG8_SB(0, 1), cB + hstep, voffB); PG8_STAGE(PG8_SA(0, 0), cA, voffA); PG8_STAGE(PG8_SA(0, 1), cA + hstep, voffA);
        if (wr == 1) PG8_BAR;
        PG8_WAIT_V(2); PG8_BAR;
        PG8_STAGE(PG8_SB(1, 0), cB + kstep, voffB); PG8_STAGE(PG8_SA(1, 0), cA + kstep, voffA); PG8_STAGE(PG8_SB(1, 1), cB + hstep + kstep, voffB);
        PG8_WAIT_V(6); PG8_BAR;
    } else {
        PG8_STAGE(PG8_SB(0, 0), cB, voffB); PG8_STAGE(PG8_SA(0, 0), cA, voffA); PG8_STAGE(PG8_SB(0, 1), cB + hstep, voffB); PG8_STAGE(PG8_SA(0, 1), cA + hstep, voffA);
        if (wr == 1) PG8_BAR;
        PG8_WAIT_V(4); PG8_BAR;
        PG8_STAGE(PG8_SB(1, 0), cB + kstep, voffB); PG8_STAGE(PG8_SA(1, 0), cA + kstep, voffA); PG8_STAGE(PG8_SB(1, 1), cB + hstep + kstep, voffB);
        PG8_WAIT_V(6); PG8_BAR;
    }
    for (;;) {
        const bool has_next = S.next(ui + 1, nxt);
        const char* nA = has_next ? (const char*)g.A + (size_t)nxt.pm * tstep : cA; const char* nB = has_next ? (const char*)g.Bt + (size_t)nxt.pn * tstep : cB;
        for (int t = 0; t < nt; t += 2) {
            const bool last = (t == nt - 2);
            const char* a1 = cA + (size_t)(t + 1) * kstep;
            const char* a2 = last ? nA : cA + (size_t)(t + 2) * kstep; const char* b2 = last ? nB : cB + (size_t)(t + 2) * kstep;
            const char* a3 = a2 + kstep; const char* b3 = b2 + kstep;
            if (last && has_next) S.a_ready(nxt);
            if constexpr (SP2) {
            PG8_LDB(B0, 0, 0); PG8_LDB(B1, 0, 1); PG8_SCHED; PG8_LDA(At, 0, 0); PG8_STAGE(PG8_SA(1, 1), a1 + hstep, voffA);
            PG8_WAIT_V(8); PG8_WAIT_L(0); PG8_BAR; PG8_MMA(0, 0, At, B0); PG8_MMA(0, 1, At, B1); PG8_BAR; PG8_SCHED;
            PG8_LDA(At, 0, 1); PG8_STAGE(PG8_SB(0, 0), b2, voffB); PG8_STAGE(PG8_SB(0, 1), b2 + hstep, voffB); PG8_STAGE(PG8_SA(0, 0), a2, voffA);
            PG8_WAIT_V(8); PG8_WAIT_L(0); PG8_BAR; PG8_MMA(1, 0, At, B0); PG8_MMA(1, 1, At, B1); PG8_BAR; PG8_SCHED;
            PG8_LDB(B0, 1, 0); PG8_LDB(B1, 1, 1); PG8_SCHED; PG8_LDA(At, 1, 0); PG8_STAGE(PG8_SA(0, 1), a2 + hstep, voffA);
            PG8_WAIT_V(8); PG8_WAIT_L(0); PG8_BAR; PG8_MMA(0, 0, At, B0); PG8_MMA(0, 1, At, B1); PG8_BAR; PG8_SCHED;
            PG8_LDA(At, 1, 1); PG8_STAGE(PG8_SB(1, 0), b3, voffB); PG8_STAGE(PG8_SB(1, 1), b3 + hstep, voffB); PG8_STAGE(PG8_SA(1, 0), a3, voffA);
            PG8_WAIT_V(8); PG8_WAIT_L(0); PG8_BAR; PG8_MMA(1, 0, At, B0); PG8_MMA(1, 1, At, B1); PG8_BAR; PG8_SCHED;
            } else {
            PG8_LDB(B0, 0, 0); PG8_SCHED; PG8_LDA(At, 0, 0); PG8_STAGE(PG8_SA(1, 1), a1 + hstep, voffA);
            PG8_WAIT_L(8); PG8_BAR; PG8_WAIT_L(0); PG8_MMA(0, 0, At, B0); PG8_BAR; PG8_SCHED;
            PG8_LDB(B1, 0, 1); PG8_STAGE(PG8_SB(0, 0), b2, voffB);
            PG8_BAR; PG8_WAIT_L(0); PG8_MMA(0, 1, At, B1); PG8_BAR;
            PG8_LDA(At, 0, 1); PG8_STAGE(PG8_SA(0, 0), a2, voffA);
            PG8_BAR; PG8_WAIT_L(0); PG8_MMA(1, 0, At, B0); PG8_BAR; PG8_SCHED;
            PG8_STAGE(PG8_SB(0, 1), b2 + hstep, voffB);
            PG8_WAIT_V(6); PG8_BAR; PG8_MMA(1, 1, At, B1); PG8_BAR;
            PG8_LDB(B0, 1, 0); PG8_SCHED; PG8_LDA(At, 1, 0); PG8_STAGE(PG8_SA(0, 1), a2 + hstep, voffA);
            PG8_WAIT_L(8); PG8_BAR; PG8_WAIT_L(0); PG8_MMA(0, 0, At, B0); PG8_BAR; PG8_SCHED;
            PG8_LDB(B1, 1, 1); PG8_STAGE(PG8_SB(1, 0), b3, voffB);
            PG8_BAR; PG8_WAIT_L(0); PG8_MMA(0, 1, At, B1); PG8_BAR;
            PG8_LDA(At, 1, 1); PG8_STAGE(PG8_SA(1, 0), a3, voffA);
            PG8_BAR; PG8_WAIT_L(0); PG8_MMA(1, 0, At, B0); PG8_BAR; PG8_SCHED;
            PG8_STAGE(PG8_SB(1, 1), b3 + hstep, voffB);
            PG8_WAIT_V(6); PG8_BAR; PG8_MMA(1, 1, At, B1); PG8_BAR;
            }
        }
        if constexpr (ALIGN_EPI) { if (wr == 0) PG8_BAR; }
        if constexpr (!Epi::AFTER_DRAIN) { E(acc, cur, wr, wc, fr, fq); S.done(cur); }
        if (!has_next) break;
#pragma unroll
        for (int a = 0; a < 2; ++a)
#pragma unroll
            for (int b = 0; b < 2; ++b)
#pragma unroll
                for (int m = 0; m < 4; ++m)
#pragma unroll
                    for (int n = 0; n < 2; ++n) acc[a][b][m][n] = (f32x4){0.f, 0.f, 0.f, 0.f};
        cur = nxt; cA = nA; cB = nB; ++ui;
        if constexpr (ALIGN_EPI) { if (wr == 1) PG8_BAR; }
    }
    PG8_WAIT_V(0);
    if constexpr (!ALIGN_EPI) { if (wr == 0) PG8_BAR; }
    PG8_BAR;
    if constexpr (Epi::AFTER_DRAIN) { E.fused(acc, cur, wr, wc, fr, fq, lds, wid, lane); S.done(cur); }
#undef PG8_SA
#undef PG8_SB
#undef PG8_STAGE
#undef PG8_LDA
#undef PG8_LDB
#undef PG8_MMA
#undef PG8_WAIT_V
#undef PG8_WAIT_L
#undef PG8_BAR
#undef PG8_SCHED
}
}
namespace pg8 {
template <class Epi, class Sched, bool ALIGN_EPI = false, bool SP2 = false>
__device__ __forceinline__ void gemm_phase_gather(PG8_LAS unsigned char* lds, const Gemm g, const Sched& S, const Epi& E, const int* __restrict__ idx) {
    const int tid = threadIdx.x, wid = __builtin_amdgcn_readfirstlane(tid >> 6), lane = tid & 63, wr = wid >> 2, wc = wid & 3, fr = lane & 15, fq = lane >> 4;
    const int K = g.K, nt = K / BK;
    unsigned voffB[2]; int RA[2], CA[2];
#pragma unroll
    for (int i = 0; i < 2; ++i) { int R, C; stage_rc(tid * 16 + i * 8192, R, C); const int Rb = Epi::PERM ? ((R & ~31) + perm32(R & 31)) : R;
        RA[i] = R; CA[i] = C; voffB[i] = (unsigned)(Rb * K + C) * 2u; }
    unsigned vA[2][2], nvA[2][2];
#define PG8_GOFF(dst, pm) do { _Pragma("unroll") for (int _h = 0; _h < 2; ++_h) _Pragma("unroll") for (int _i = 0; _i < 2; ++_i) { const int _r = (pm) * 256 + _h * 128 + RA[_i]; \
        dst[_h][_i] = (unsigned)((((_r >> 9) & 3) * 4096 + idx[_r]) * K + CA[_i]) * 2u; } } while (0)
    const size_t kstep = (size_t)(BK * 2);
    const size_t hstep = (size_t)HALF * K * 2;
    const size_t tstep = 2 * hstep;
    const unsigned ldsw = (unsigned)wid * 1024u;
    const int aoff = lds_byte(wr * 64 + fr, fq * 8), boff = lds_byte(wc * 32 + fr, fq * 8);
#define PG8_SA(b, h) (((b) * 2 + (h)) * HTB)
#define PG8_SB(b, h) ((4 + (b) * 2 + (h)) * HTB)
#define PG8_STAGE(bufoff, gbase, voff) do { _Pragma("unroll") for (int _i = 0; _i < 2; ++_i) \
        __builtin_amdgcn_global_load_lds((const unsigned*)((const char*)(gbase) + (voff)[_i]), (PG8_LAS unsigned*)(lds + (bufoff) + ldsw + _i * 8192), 16, 0, 0); } while (0)
#define PG8_LDA(dst, b, h) do { _Pragma("unroll") for (int m = 0; m < 4; ++m) _Pragma("unroll") for (int k = 0; k < 2; ++k) dst[m][k] = *(const PG8_LAS bf16x8*)(lds + PG8_SA(b, h) + aoff + m * 2048 + k * 1024); } while (0)
#define PG8_LDB(dst, b, h) do { _Pragma("unroll") for (int n = 0; n < 2; ++n) _Pragma("unroll") for (int k = 0; k < 2; ++k) dst[n][k] = *(const PG8_LAS bf16x8*)(lds + PG8_SB(b, h) + boff + n * 2048 + k * 1024); } while (0)
#define PG8_MMA(ai, bj, At, Bt) do { __builtin_amdgcn_s_setprio(1); _Pragma("unroll") for (int m = 0; m < 4; ++m) _Pragma("unroll") for (int n = 0; n < 2; ++n) _Pragma("unroll") for (int k = 0; k < 2; ++k) \
        acc[ai][bj][m][n] = __builtin_amdgcn_mfma_f32_16x16x32_bf16(Bt[n][k], At[m][k], acc[ai][bj][m][n], 0, 0, 0); __builtin_amdgcn_s_setprio(0); } while (0)
#define PG8_WAIT_V(n) asm volatile("s_waitcnt vmcnt(" #n ")" ::: "memory")
#define PG8_WAIT_L(n) asm volatile("s_waitcnt lgkmcnt(" #n ")" ::: "memory")
#define PG8_BAR __builtin_amdgcn_s_barrier()
#define PG8_SCHED __builtin_amdgcn_sched_barrier(0)
    Unit cur, nxt; int ui = 0;
    if (!S.next(0, cur)) return;
    f32x4 acc[2][2][4][2];
#pragma unroll
    for (int a = 0; a < 2; ++a)
#pragma unroll
        for (int b = 0; b < 2; ++b)
#pragma unroll
            for (int m = 0; m < 4; ++m)
#pragma unroll
                for (int n = 0; n < 2; ++n) acc[a][b][m][n] = (f32x4){0.f, 0.f, 0.f, 0.f};
    bf16x8 At[4][2], B0[2][2], B1[2][2];
    const char* cA = (const char*)g.A; PG8_GOFF(vA, cur.pm); const char* cB = (const char*)g.Bt + (size_t)cur.pn * tstep;
    S.a_ready(cur);
    if constexpr (SP2) {
        PG8_STAGE(PG8_SB(0, 0), cB, voffB); PG8_STAGE(PG8_SB(0, 1), cB + hstep, voffB); PG8_STAGE(PG8_SA(0, 0), cA, vA[0]); PG8_STAGE(PG8_SA(0, 1), cA, vA[1]);
        if (wr == 1) PG8_BAR;
        PG8_WAIT_V(2); PG8_BAR;
        PG8_STAGE(PG8_SB(1, 0), cB + kstep, voffB); PG8_STAGE(PG8_SA(1, 0), cA + kstep, vA[0]); PG8_STAGE(PG8_SB(1, 1), cB + hstep + kstep, voffB);
        PG8_WAIT_V(6); PG8_BAR;
    } else {
        PG8_STAGE(PG8_SB(0, 0), cB, voffB); PG8_STAGE(PG8_SA(0, 0), cA, vA[0]); PG8_STAGE(PG8_SB(0, 1), cB + hstep, voffB); PG8_STAGE(PG8_SA(0, 1), cA, vA[1]);
        if (wr == 1) PG8_BAR;
        PG8_WAIT_V(4); PG8_BAR;
        PG8_STAGE(PG8_SB(1, 0), cB + kstep, voffB); PG8_STAGE(PG8_SA(1, 0), cA + kstep, vA[0]); PG8_STAGE(PG8_SB(1, 1), cB + hstep + kstep, voffB);
        PG8_WAIT_V(6); PG8_BAR;
    }
    for (;;) {
        const bool has_next = S.next(ui + 1, nxt);
        if (has_next) { PG8_GOFF(nvA, nxt.pm); } else { nvA[0][0] = vA[0][0]; nvA[0][1] = vA[0][1]; nvA[1][0] = vA[1][0]; nvA[1][1] = vA[1][1]; } const char* nB = has_next ? (const char*)g.Bt + (size_t)nxt.pn * tstep : cB;
        for (int t = 0; t < nt; t += 2) {
            const bool last = (t == nt - 2);
            const char* a1 = cA + (size_t)(t + 1) * kstep;
            const char* a2 = cA + (last ? (size_t)0 : (size_t)(t + 2) * kstep); unsigned w2[2][2]; w2[0][0] = last ? nvA[0][0] : vA[0][0]; w2[0][1] = last ? nvA[0][1] : vA[0][1]; w2[1][0] = last ? nvA[1][0] : vA[1][0]; w2[1][1] = last ? nvA[1][1] : vA[1][1]; const char* b2 = last ? nB : cB + (size_t)(t + 2) * kstep;
            const char* a3 = a2 + kstep; const char* b3 = b2 + kstep;
            if (last && has_next) S.a_ready(nxt);
            if constexpr (SP2) {
            PG8_LDB(B0, 0, 0); PG8_LDB(B1, 0, 1); PG8_SCHED; PG8_LDA(At, 0, 0); PG8_STAGE(PG8_SA(1, 1), a1, vA[1]);
            PG8_WAIT_V(8); PG8_WAIT_L(0); PG8_BAR; PG8_MMA(0, 0, At, B0); PG8_MMA(0, 1, At, B1); PG8_BAR; PG8_SCHED;
            PG8_LDA(At, 0, 1); PG8_STAGE(PG8_SB(0, 0), b2, voffB); PG8_STAGE(PG8_SB(0, 1), b2 + hstep, voffB); PG8_STAGE(PG8_SA(0, 0), a2, w2[0]);
            PG8_WAIT_V(8); PG8_WAIT_L(0); PG8_BAR; PG8_MMA(1, 0, At, B0); PG8_MMA(1, 1, At, B1); PG8_BAR; PG8_SCHED;
            PG8_LDB(B0, 1, 0); PG8_LDB(B1, 1, 1); PG8_SCHED; PG8_LDA(At, 1, 0); PG8_STAGE(PG8_SA(0, 1), a2, w2[1]);
            PG8_WAIT_V(8); PG8_WAIT_L(0); PG8_BAR; PG8_MMA(0, 0, At, B0); PG8_MMA(0, 1, At, B1); PG8_BAR; PG8_SCHED;
            PG8_LDA(At, 1, 1); PG8_STAGE(PG8_SB(1, 0), b3, voffB); PG8_STAGE(PG8_SB(1, 1), b3 + hstep, voffB); PG8_STAGE(PG8_SA(1, 0), a3, w2[0]);
            PG8_WAIT_V(8); PG8_WAIT_L(0); PG8_BAR; PG8_MMA(1, 0, At, B0); PG8_MMA(1, 1, At, B1); PG8_BAR; PG8_SCHED;
            } else {
            PG8_LDB(B0, 0, 0); PG8_SCHED; PG8_LDA(At, 0, 0); PG8_STAGE(PG8_SA(1, 1), a1, vA[1]);
            PG8_WAIT_L(8); PG8_BAR; PG8_WAIT_L(0); PG8_MMA(0, 0, At, B0); PG8_BAR; PG8_SCHED;
            PG8_LDB(B1, 0, 1); PG8_STAGE(PG8_SB(0, 0), b2, voffB);
            PG8_BAR; PG8_WAIT_L(0); PG8_MMA(0, 1, At, B1); PG8_BAR;
            PG8_LDA(At, 0, 1); PG8_STAGE(PG8_SA(0, 0), a2, w2[0]);
            PG8_BAR; PG8_WAIT_L(0); PG8_MMA(1, 0, At, B0); PG8_BAR; PG8_SCHED;
            PG8_STAGE(PG8_SB(0, 1), b2 + hstep, voffB);
            PG8_WAIT_V(6); PG8_BAR; PG8_MMA(1, 1, At, B1); PG8_BAR;
            PG8_LDB(B0, 1, 0); PG8_SCHED; PG8_LDA(At, 1, 0); PG8_STAGE(PG8_SA(0, 1), a2, w2[1]);
            PG8_WAIT_L(8); PG8_BAR; PG8_WAIT_L(0); PG8_MMA(0, 0, At, B0); PG8_BAR; PG8_SCHED;
            PG8_LDB(B1, 1, 1); PG8_STAGE(PG8_SB(1, 0), b3, voffB);
            PG8_BAR; PG8_WAIT_L(0); PG8_MMA(0, 1, At, B1); PG8_BAR;
            PG8_LDA(At, 1, 1); PG8_STAGE(PG8_SA(1, 0), a3, w2[0]);
            PG8_BAR; PG8_WAIT_L(0); PG8_MMA(1, 0, At, B0); PG8_BAR; PG8_SCHED;
            PG8_STAGE(PG8_SB(1, 1), b3 + hstep, voffB);
            PG8_WAIT_V(6); PG8_BAR; PG8_MMA(1, 1, At, B1); PG8_BAR;
            }
        }
        if constexpr (ALIGN_EPI) { if (wr == 0) PG8_BAR; }
        if constexpr (!Epi::AFTER_DRAIN) { E(acc, cur, wr, wc, fr, fq); S.done(cur); }
        if (!has_next) break;
#pragma unroll
        for (int a = 0; a < 2; ++a)
#pragma unroll
            for (int b = 0; b < 2; ++b)
#pragma unroll
                for (int m = 0; m < 4; ++m)
#pragma unroll
                    for (int n = 0; n < 2; ++n) acc[a][b][m][n] = (f32x4){0.f, 0.f, 0.f, 0.f};
        cur = nxt; cB = nB; ++ui; vA[0][0] = nvA[0][0]; vA[0][1] = nvA[0][1]; vA[1][0] = nvA[1][0]; vA[1][1] = nvA[1][1];
        if constexpr (ALIGN_EPI) { if (wr == 1) PG8_BAR; }
    }
    PG8_WAIT_V(0);
    if constexpr (!ALIGN_EPI) { if (wr == 0) PG8_BAR; }
    PG8_BAR;
    if constexpr (Epi::AFTER_DRAIN) { E.fused(acc, cur, wr, wc, fr, fq, lds, wid, lane); S.done(cur); }
#undef PG8_SA
#undef PG8_SB
#undef PG8_STAGE
#undef PG8_LDA
#undef PG8_LDB
#undef PG8_MMA
#undef PG8_WAIT_V
#undef PG8_WAIT_L
#undef PG8_BAR
#undef PG8_SCHED
#undef PG8_GOFF
}
}

#ifndef DBG_NOMIX
#define DBG_NOMIX 0
#endif
#ifndef DBG_NOMOE
#define DBG_NOMOE 0
#endif
#ifndef DBG_NOPOS
#define DBG_NOPOS 0
#endif
#ifndef DBG_HTCONST
#define DBG_HTCONST 0
#endif
#ifndef DBG_GLA_K
#define DBG_GLA_K 1.0f
#endif
#ifndef DBG_MOE_K
#define DBG_MOE_K 1.0f
#endif
#ifndef MK_SINGLE
#define MK_SINGLE 0
#endif
#define GAS __attribute__((address_space(1)))
#define LAS __attribute__((address_space(3)))
typedef unsigned short bf16;
typedef float f32x4 __attribute__((ext_vector_type(4)));
typedef float f32x16 __attribute__((ext_vector_type(16)));
typedef short bf16x8 __attribute__((ext_vector_type(8)));
typedef unsigned v4u __attribute__((ext_vector_type(4)));
typedef unsigned v2u __attribute__((ext_vector_type(2)));
typedef GAS unsigned gu32;

constexpr int NWAVES = 8, NTHR = 512;
constexpr int NB = 4, SEQ = 4096, DM = 1024, CTXL = 256;
constexpr int MX = NB * SEQ, MC = NB * CTXL, MT = MX + MC;
constexpr int NIN = 3328, NQ = 1536, DIN = 3104;
constexpr int NE = 16, CAP = 512;
constexpr int NCH = 68;
constexpr int NPH = 12;
constexpr float EPS = 1e-6f;

constexpr size_t MiB = 1u << 20;
constexpr size_t WS_CTL = 0, CTL_BYTES = 65536;
constexpr int CW_CNT_D = 8192, CW_CNT_GU = 8192 + 64;
constexpr size_t WS_MOD = 1 * MiB, WS_POS = 1 * MiB + 256 * 1024, WS_DEC = 2 * MiB, WS_AFF = 3 * MiB, WS_SLOT = 4 * MiB, WS_SELT = 5 * MiB, WS_SELV = 5 * MiB + 256 * 1024;
constexpr size_t WS_UCTX = 6 * MiB, WS_AFB = 10 * MiB, WS_WIN = 13 * MiB, WS_WOUT = 20 * MiB;
constexpr size_t WS_R1 = 22 * MiB, WS_R2 = 56 * MiB, WS_R3 = 107 * MiB, WS_R4 = 203 * MiB, WS_R5 = 235 * MiB, WS_R6 = 267 * MiB, WS_END = 299 * MiB;
constexpr size_t WS_AIN = WS_R1, WS_ZT = 155 * MiB, WS_HN = WS_R1;
constexpr size_t WS_QKVG = WS_R2;
constexpr size_t WS_HYT = WS_R3, WS_WD = 171 * MiB;
constexpr size_t WS_WGU = WS_R5;
constexpr size_t WS_HID = WS_R2, WS_YSLAB = WS_R4;
constexpr size_t WS_HT = WS_R4, WS_AOUT = WS_R4;
constexpr size_t WS_SPREV = WS_R5, WS_YHYT = WS_R6;
constexpr int LDS_BYTES = 144 * 1024;
constexpr int LDS_MISC = LDS_BYTES - 256;

struct Args { const float* in[29]; float* out; unsigned char* ws; int ph_lo, ph_hi; };

#define LDS_WAIT() asm volatile("s_waitcnt lgkmcnt(0)" ::: "memory")
#define VM_WAIT() asm volatile("s_waitcnt vmcnt(0)" ::: "memory")
__device__ __forceinline__ unsigned f2bf(float f) { unsigned u = __float_as_uint(f); return (u + 0x7fffu + ((u >> 16) & 1u)) >> 16; }
__device__ __forceinline__ unsigned pk2(float lo, float hi) { return pg8::cvt_pk_bf16(lo, hi); }
__device__ __forceinline__ float bflo(unsigned w) { return __uint_as_float(w << 16); }
__device__ __forceinline__ float bfhi(unsigned w) { return __uint_as_float(w & 0xffff0000u); }
__device__ __forceinline__ float wave_sum(float v) {
#pragma unroll
    for (int o = 1; o < 64; o <<= 1) v += __shfl_xor(v, o);
    return v;
}
__device__ __forceinline__ float silu_f(float v) { return v * __builtin_amdgcn_rcpf(1.f + __expf(-v)); }
__device__ __forceinline__ float logsig_f(float x) { return fminf(x, 0.f) - __logf(1.0f + __expf(-fabsf(x))); }

#define XB_TMO      128
#define XB_XCNT(j)  (256  + 64 * (j))
#define XB_XSUB(j)  (1280 + 64 * (j))
#define XB_XGEN(j)  (2304 + 64 * (j))
#define XB_TOP      3328
#define XB_TOPGEN   3392
#define XCD_BAR_WORDS 3456
#define XB_SPIN_CAP (1u << 22)
__device__ __forceinline__ unsigned xb_ld(unsigned* p)              { return __hip_atomic_load(p, __ATOMIC_RELAXED, __HIP_MEMORY_SCOPE_AGENT); }
__device__ __forceinline__ unsigned xb_add(unsigned* p, unsigned v) { return __hip_atomic_fetch_add(p, v, __ATOMIC_RELAXED, __HIP_MEMORY_SCOPE_AGENT); }
__device__ __forceinline__ unsigned xb_xcc_id() { return (unsigned)__builtin_amdgcn_s_getreg((3 << 11) | 20) & 0xFu; }
#define XB_SPIN(cond, bar) do { unsigned _sp = 0; while (cond) { __builtin_amdgcn_s_sleep(1); \
    if ((++_sp & 255u) == 0u) { if (xb_ld(&(bar)[XB_TMO])) break; if (_sp > XB_SPIN_CAP) { atomicAdd(&(bar)[XB_TMO], 1u); break; } } } } while (0)
struct XcdBarrier { unsigned* bar; unsigned x; volatile LAS unsigned* st; };
__device__ __forceinline__ XcdBarrier xcd_barrier_post(unsigned* bar, volatile LAS unsigned* st) {
    XcdBarrier b; b.bar = bar; b.x = xb_xcc_id(); b.st = st;
    if (threadIdx.x == 0) (void)xb_add(&bar[XB_XCNT(b.x)], 1u);
    return b;
}
__device__ __forceinline__ void xcd_barrier_complete(unsigned* bar, unsigned x, unsigned& nloc, unsigned& nx) {
    const unsigned G = gridDim.x * gridDim.y * gridDim.z;
    unsigned sum, cnt, mine, sp = 0u;
    for (;;) {
        sum = 0u; cnt = 0u; mine = 0u;
#pragma unroll
        for (unsigned j = 0; j < 16; ++j) { const unsigned c = xb_ld(&bar[XB_XCNT(j)]); sum += c; cnt += (c > 0u) ? 1u : 0u; mine = (j == x) ? c : mine; }
        if (sum == G) break;
        __builtin_amdgcn_s_sleep(1);
        if ((++sp & 255u) == 0u) { if (xb_ld(&bar[XB_TMO])) break; if (sp > XB_SPIN_CAP) { atomicAdd(&bar[XB_TMO], 1u); break; } }
    }
    nloc = mine > 0u ? mine : 1u; nx = cnt > 0u ? cnt : 1u;
}
__device__ __forceinline__ void xcd_barrier(const XcdBarrier& b) {
    asm volatile("s_waitcnt vmcnt(0)" ::: "memory");
    __syncthreads();
    if (threadIdx.x == 0) {
        unsigned* bar = b.bar;
        __builtin_amdgcn_s_waitcnt(0);
        unsigned nloc = b.st[0], nx = b.st[1];
        if (nloc == 0u) { xcd_barrier_complete(bar, b.x, nloc, nx); b.st[0] = nloc; b.st[1] = nx; }
        const unsigned old = xb_add(&bar[XB_XSUB(b.x)], 1u);
        const unsigned gen = old / nloc;
        if (old + 1u == (gen + 1u) * nloc) {
            __builtin_amdgcn_fence(__ATOMIC_RELEASE, "agent");
            asm volatile("s_waitcnt vmcnt(0)" ::: "memory");
            const unsigned og = xb_add(&bar[XB_TOP], 1u);
            const unsigned tg = og / nx;
            if (og + 1u == (tg + 1u) * nx) xb_add(&bar[XB_TOPGEN], 1u);
            else XB_SPIN(xb_ld(&bar[XB_TOPGEN]) == tg, bar);
            __builtin_amdgcn_fence(__ATOMIC_ACQUIRE, "agent");
            xb_add(&bar[XB_XGEN(b.x)], 1u);
            asm volatile("s_waitcnt vmcnt(0)" ::: "memory");
        } else {
            XB_SPIN(xb_ld(&bar[XB_XGEN(b.x)]) == gen, bar);
            __builtin_amdgcn_fence(__ATOMIC_ACQUIRE, "agent");
            asm volatile("s_waitcnt vmcnt(0)" ::: "memory");
        }
    }
    __syncthreads();
}

constexpr int TILE_AIN = (int)(WS_AIN / (512 * 1024)), TILE_WIN = (int)(WS_WIN / (512 * 1024));
struct InSched {
    int G, c, part;
    __device__ void init(int G_, int c_, int part_) { G = G_; c = c_; part = part_; }
    __device__ static void qg_unit(int qg, pg8::Unit& u) { const int t = qg >> 6; u.pm = TILE_AIN + (qg & 63); u.pn = TILE_WIN + ((t == 0) ? 0 : 3 + t); }
    __device__ bool next(int i, pg8::Unit& u) const {
        const int L = i * G + c;
        if (part) { const int qg = 112 + L; if (qg >= 192) return false; qg_unit(qg, u); return true; }
        if (L < 384) { u.pm = TILE_WIN + 6 + (L >> 6); u.pn = TILE_AIN + (L & 63); return true; }
        if (L < 640) { const int l = L - 384, q = l >> 6; u.pm = TILE_AIN + (l & 63); u.pn = TILE_WIN + ((q == 3) ? 12 : (1 + q)); return true; }
        if (L < 656) { const int jx = L - 640, q = jx >> 2; u.pm = TILE_AIN + 64 + (jx & 3); u.pn = TILE_WIN + ((q == 3) ? 12 : (1 + q)); return true; }
        if (L >= 768) return false;
        qg_unit(L - 656, u); return true;
    }
    __device__ __forceinline__ void a_ready(const pg8::Unit&) const {}
    __device__ __forceinline__ void done(const pg8::Unit&) const {}
};
template <int NT> struct MoeSched {
    int G, c;
    __device__ void init(int G_, int c_) { G = G_; c = c_; }
    __device__ bool next(int i, pg8::Unit& u) const {
        const int L = i * G + c; if (L >= NE * 8 * NT) return false;
        const int e = L / (8 * NT), l = L % (8 * NT), x = l & 7, y = l >> 3;
        constexpr int HN = NT / 2;
        const int pm = 2 * (x >> 1) + (y / HN), pn = HN * (x & 1) + (y % HN);
        u.pm = e * 8 + pm; u.pn = e * NT + pn; return true;
    }
    __device__ __forceinline__ void a_ready(const pg8::Unit&) const {}
    __device__ __forceinline__ void done(const pg8::Unit&) const {}
};

struct EpiIn {
    static constexpr bool PERM = true, AFTER_DRAIN = false;
    bf16* qkvg; bf16* hyT; float* afb;
    __device__ __forceinline__ void operator()(const f32x4 (&acc)[2][2][4][2], const pg8::Unit& u, int wr, int wc, int fr, int fq) const {
        if (u.pm < TILE_AIN) {
            const int ch0 = (u.pm - TILE_WIN - 6) * 256 + wr * 64 + fr, mt = u.pn - TILE_AIN, b = mt >> 4, t0 = (mt & 15) * 256 + wc * 32 + 8 * fq;
#pragma unroll
            for (int ai = 0; ai < 2; ++ai)
#pragma unroll
                for (int m = 0; m < 4; ++m) { bf16* rowp = hyT + ((size_t)b * 1536 + ch0 + ai * 128 + m * 16) * SEQ + t0;
#pragma unroll
                    for (int bj = 0; bj < 2; ++bj) { const f32x4 v0 = acc[ai][bj][m][0], v1 = acc[ai][bj][m][1];
                        v4u w; w.x = pk2(v0[0], v0[1]); w.y = pk2(v0[2], v0[3]); w.z = pk2(v1[0], v1[1]); w.w = pk2(v1[2], v1[3]);
                        *(v4u*)(rowp + bj * 128) = w; } }
            return;
        }
        const int pm = u.pm - TILE_AIN, pn = u.pn - TILE_WIN;
        const int row0 = pm * 256 + wr * 64 + fr;
        if (pn < 6) {
            const float sc = (pn == 0) ? 0.125f : 1.f;
            const int col0 = pn * 256 + wc * 32 + 8 * fq;
#pragma unroll
            for (int ai = 0; ai < 2; ++ai)
#pragma unroll
                for (int m = 0; m < 4; ++m) { bf16* rowp = qkvg + (size_t)(row0 + ai * 128 + m * 16) * NQ + col0;
#pragma unroll
                    for (int bj = 0; bj < 2; ++bj) { const f32x4 v0 = acc[ai][bj][m][0] * sc, v1 = acc[ai][bj][m][1] * sc;
                        v4u w; w.x = pk2(v0[0], v0[1]); w.y = pk2(v0[2], v0[3]); w.z = pk2(v1[0], v1[1]); w.w = pk2(v1[2], v1[3]);
                        *(v4u*)(rowp + bj * 128) = w; } }
        } else {
            if (wc != 0) return;
#pragma unroll
            for (int ai = 0; ai < 2; ++ai)
#pragma unroll
                for (int m = 0; m < 4; ++m) { float* rowp = afb + (size_t)(row0 + ai * 128 + m * 16) * 32 + 8 * fq;
                    *(f32x4*)(rowp) = acc[ai][0][m][0]; *(f32x4*)(rowp + 4) = acc[ai][0][m][1]; }
        }
    }
};
struct EpiOut {
    static constexpr bool PERM = false, AFTER_DRAIN = false;
    const float* __restrict__ x; const float* __restrict__ postab; const float* __restrict__ modr; float* __restrict__ x1;
    __device__ __forceinline__ void operator()(const f32x4 (&acc)[2][2][4][2], const pg8::Unit& u, int wr, int wc, int fr, int fq) const {
        const int row0 = u.pm * 256 + wr * 64 + fr, col0 = u.pn * 256 + wc * 32 + 4 * fq;
        const int b = row0 >> 12;
        f32x4 gv[2][2];
#pragma unroll
        for (int bj = 0; bj < 2; ++bj)
#pragma unroll
            for (int n = 0; n < 2; ++n) gv[bj][n] = *(const f32x4*)(modr + b * 6144 + 2048 + col0 + bj * 128 + n * 16);
#pragma unroll
        for (int ai = 0; ai < 2; ++ai)
#pragma unroll
            for (int m = 0; m < 4; ++m) { const int r = row0 + ai * 128 + m * 16; const int t = r & 4095, rr = t >> 6, cc = t & 63;
                f32x4 xv[2][2], pv[2][2];
#pragma unroll
                for (int bj = 0; bj < 2; ++bj)
#pragma unroll
                    for (int n = 0; n < 2; ++n) { const int c = col0 + bj * 128 + n * 16;
                        xv[bj][n] = *(const f32x4*)(x + (size_t)r * DM + c);
                        pv[bj][n] = *(const f32x4*)(postab + ((c < 512) ? rr * 512 + c : cc * 512 + c - 512)); }
#pragma unroll
                for (int bj = 0; bj < 2; ++bj)
#pragma unroll
                    for (int n = 0; n < 2; ++n) { const int c = col0 + bj * 128 + n * 16;
                        *(f32x4*)(x1 + (size_t)r * DM + c) = xv[bj][n] + (DBG_NOPOS ? pv[bj][n] * 0.f : pv[bj][n]) + (DBG_NOMIX ? gv[bj][n] * 0.f : gv[bj][n] * acc[ai][bj][m][n]); } }
    }
};
struct EpiGU {
    static constexpr bool PERM = true, AFTER_DRAIN = false;
    bf16* hid;
    __device__ __forceinline__ void operator()(const f32x4 (&acc)[2][2][4][2], const pg8::Unit& u, int wr, int wc, int fr, int fq) const {
        const int row0 = u.pm * 256 + wr * 64 + fr, col0 = (u.pn & 7) * 128 + wc * 32 + 8 * fq;
#pragma unroll
        for (int ai = 0; ai < 2; ++ai)
#pragma unroll
            for (int m = 0; m < 4; ++m) { bf16* rowp = hid + (size_t)(row0 + ai * 128 + m * 16) * DM + col0;
                float o[8];
#pragma unroll
                for (int n = 0; n < 2; ++n)
#pragma unroll
                    for (int j = 0; j < 4; ++j) o[n * 4 + j] = silu_f(acc[ai][0][m][n][j]) * acc[ai][1][m][n][j];
                v4u w; w.x = pk2(o[0], o[1]); w.y = pk2(o[2], o[3]); w.z = pk2(o[4], o[5]); w.w = pk2(o[6], o[7]);
                *(v4u*)rowp = w; }
    }
};
struct EpiDown {
    static constexpr bool PERM = true, AFTER_DRAIN = false;
    bf16* __restrict__ ys; const float* __restrict__ selv;
    __device__ __forceinline__ void operator()(const f32x4 (&acc)[2][2][4][2], const pg8::Unit& u, int wr, int wc, int fr, int fq) const {
        const int row0 = u.pm * 256 + wr * 64 + fr, col0 = (u.pn & 3) * 256 + wc * 32 + 8 * fq;
        float scv[2][4];
#pragma unroll
        for (int ai = 0; ai < 2; ++ai)
#pragma unroll
            for (int m = 0; m < 4; ++m) scv[ai][m] = selv[row0 + ai * 128 + m * 16];
#pragma unroll
        for (int ai = 0; ai < 2; ++ai)
#pragma unroll
            for (int m = 0; m < 4; ++m) { const int r = row0 + ai * 128 + m * 16; const float sc = scv[ai][m]; bf16* rowp = ys + (size_t)r * DM + col0;
#pragma unroll
                for (int bj = 0; bj < 2; ++bj) { const f32x4 v0 = acc[ai][bj][m][0] * sc, v1 = acc[ai][bj][m][1] * sc;
                    v4u w; w.x = pk2(v0[0], v0[1]); w.y = pk2(v0[2], v0[3]); w.z = pk2(v1[0], v1[1]); w.w = pk2(v1[2], v1[3]);
                    *(v4u*)(rowp + bj * 128) = w; } }
    }
};

__device__ __forceinline__ void transpose_item(const float* W, int ldw, int k0, int nsrc0, bf16* WT, int K, int drow0, LAS float* scr, int lane, bool zero) {
    float tv[32];
#pragma unroll
    for (int i = 0; i < 32; ++i) { const int kk = 2 * i + (lane >> 5); tv[i] = zero ? 0.f : W[(size_t)(k0 + kk) * ldw + nsrc0 + (lane & 31)]; }
#pragma unroll
    for (int i = 0; i < 32; ++i) { const int kk = 2 * i + (lane >> 5); scr[kk * 33 + (lane & 31)] = tv[i]; }
    LDS_WAIT();
    const int c = lane & 7;
#pragma unroll
    for (int j = 0; j < 4; ++j) { const int n = (lane >> 3) + 8 * j; const LAS float* s = scr + (8 * c) * 33 + n;
        v4u o; o.x = pk2(s[0 * 33], s[1 * 33]); o.y = pk2(s[2 * 33], s[3 * 33]); o.z = pk2(s[4 * 33], s[5 * 33]); o.w = pk2(s[6 * 33], s[7 * 33]);
        *(v4u*)(WT + (size_t)(drow0 + n) * K + k0 + 8 * c) = o; }
    LDS_WAIT();
}

__device__ __forceinline__ void phase0(const Args& a, LAS unsigned char* lds) {
    int tid = threadIdx.x; const int wg = blockIdx.x, G = gridDim.x;
    asm volatile("" : "+v"(tid));
    int lane = tid & 63, wave = tid >> 6;
    unsigned char* ws = a.ws;
    for (int it = wg; it < 192; it += G) {
        LAS float* sl = (LAS float*)lds;
        LAS float* red = (LAS float*)(lds + 20480);
        for (int i = tid; i < 5 * 1024; i += NTHR) { const int bb = i >> 10, k = i & 1023; const float v = (bb < 4) ? a.in[1][bb * 1024 + k] : a.in[3][k]; sl[i] = silu_f(v); }
        __syncthreads();
        const int col = it * 32 + (lane & 31), kk = wave * 2 + (lane >> 5);
        float acc[5] = {0.f, 0.f, 0.f, 0.f, 0.f};
        const float* wp = a.in[4] + col;
        float wv[64];
#pragma unroll
        for (int j = 0; j < 64; ++j) wv[j] = wp[(size_t)(kk + 16 * j) * 6144];
#pragma unroll
        for (int j = 0; j < 64; ++j) { const int k = kk + 16 * j;
#pragma unroll
            for (int bb = 0; bb < 5; ++bb) acc[bb] += sl[bb * 1024 + k] * wv[j]; }
#pragma unroll
        for (int bb = 0; bb < 5; ++bb) red[(kk * 5 + bb) * 32 + (lane & 31)] = acc[bb];
        __syncthreads();
        if (tid < 160) { const int bb = tid >> 5, cl = tid & 31; float s = 0.f;
#pragma unroll
            for (int q = 0; q < 16; ++q) s += red[(q * 5 + bb) * 32 + cl];
            ((float*)(ws + WS_MOD))[bb * 6144 + it * 32 + cl] = s + a.in[5][it * 32 + cl]; }
        __syncthreads();
    }
    for (int it = wg; it < 256; it += G) {
        asm volatile("" : "+v"(tid));
        LAS float* zl = (LAS float*)lds;
        LAS float* h1 = (LAS float*)(lds + 4096);
        LAS float* h2 = (LAS float*)(lds + 8192);
        const int i0 = it * 16;
        LAS float* w1l = (LAS float*)(lds + 12288);
        LAS float* w2l = (LAS float*)(lds + 12288 + 8448);
        for (int o = tid; o < 33 * 64; o += NTHR) w1l[o] = a.in[15][o];
        for (int o = tid; o < 64 * 64; o += NTHR) w2l[o] = a.in[17][o];
        for (int o = tid; o < 16 * 33; o += NTHR) { const int li = o / 33, j = o % 33; const int i = i0 + li;
            const float ti = (float)i * (1.0f / 4095.0f);
            const float wi = (6.2831855f * (float)i) / 4096.0f;
            float v;
            if (j == 0) v = ti;
            else { const int jj = (j - 1) & 15; const float f = 1e-4f + (float)jj * ((15.0f - 1e-4f) / 15.0f); const float ar = f * wi; v = (j <= 16) ? cosf(ar) : -sinf(ar); }
            zl[li * 36 + j] = v; }
        __syncthreads();
#pragma unroll
        for (int q = 0; q < 2; ++q) { const int o = tid + NTHR * q, li = o >> 6, m = o & 63; float s = a.in[16][m];
#pragma unroll
            for (int j = 0; j < 33; ++j) s += zl[li * 36 + j] * w1l[j * 64 + m];
            h1[li * 64 + m] = sinf(a.in[20][m] * s); }
        __syncthreads();
#pragma unroll
        for (int q = 0; q < 2; ++q) { const int o = tid + NTHR * q, li = o >> 6, m = o & 63; float s = a.in[18][m];
#pragma unroll 16
            for (int k = 0; k < 64; ++k) s += h1[li * 64 + k] * w2l[k * 64 + m];
            h2[li * 64 + m] = sinf(a.in[20][m] * s); }
        __syncthreads();
        f32x4 acc[16];
#pragma unroll
        for (int li = 0; li < 16; ++li) acc[li] = (f32x4){0.f, 0.f, 0.f, 0.f};
        const float* w3 = a.in[19] + tid * 4;
#pragma nounroll
        for (int k0 = 0; k0 < 64; k0 += 16) { f32x4 w[16];
#pragma unroll
            for (int kk = 0; kk < 16; ++kk) w[kk] = *(const f32x4*)(w3 + (k0 + kk) * 2048);
#pragma unroll
            for (int kk = 0; kk < 16; ++kk)
#pragma unroll
                for (int li = 0; li < 16; ++li) acc[li] += w[kk] * h2[li * 64 + k0 + kk]; }
        float* hT = (float*)(ws + WS_HT);
#pragma unroll
        for (int j = 0; j < 4; ++j) { const int col = tid * 4 + j, od = col >> 9, c = col & 511;
            const float delta = 3.0701134573f + (float)c * ((15.3505672866f - 3.0701134573f) / 511.0f);
            float* dst = hT + ((size_t)od * 512 + c) * SEQ + i0;
#pragma unroll
            for (int q = 0; q < 4; ++q) { f32x4 o;
#pragma unroll
                for (int s = 0; s < 4; ++s) { const int li = q * 4 + s; const float ti = (float)(i0 + li) * (1.0f / 4095.0f); o[s] = DBG_HTCONST == 1 ? 1.0f : DBG_HTCONST == 2 ? zl[li * 36 + (col % 33)] : DBG_HTCONST == 3 ? h1[li * 64 + (col & 63)] : DBG_HTCONST == 4 ? h2[li * 64 + (col & 63)] : DBG_HTCONST == 5 ? acc[li][j] : acc[li][j] * __expf(-ti * delta); }
                *(f32x4*)(dst + q * 4) = o; } }
        __syncthreads();
    }
    {
        asm volatile("" : "+v"(tid)); lane = tid & 63; wave = tid >> 6;
        LAS float* scr = (LAS float*)(lds + wave * 8448);
        const int gw = wg * NWAVES + wave, NGW = G * NWAVES;
        constexpr int I_IN = 104 * 16, I_OUT = 32 * 16;
        for (int it = gw; it < I_IN + I_OUT; it += NGW) {
            if (it < I_IN) { const int nb = it >> 4, kb = it & 15, n0 = nb * 32;
                const int ns = (n0 < 1536) ? n0 : (n0 < 3072 ? n0 + 32 : 1536 + (n0 - 3072));
                transpose_item(a.in[7], DIN, kb * 64, (n0 < DIN) ? ns : 0, (bf16*)(ws + WS_WIN), DM, n0, scr, lane, n0 >= DIN);
            } else { const int r = it - I_IN, nb = r >> 4, kb = r & 15;
                transpose_item(a.in[22], DM, kb * 64, nb * 32, (bf16*)(ws + WS_WOUT), DM, nb * 32, scr, lane, false); }
        }
    }
    for (int e = wg * NTHR + tid; e < 64 * 256; e += G * NTHR) { const int i = e >> 8, j = e & 255;
        const float om = 1.0f / powf(10000.0f, (float)j * (1.0f / 256.0f)); const float er = (float)i * om;
        float* pt = (float*)(ws + WS_POS); pt[i * 512 + j] = sinf(er); pt[i * 512 + 256 + j] = cosf(er); }
}

__device__ __forceinline__ void phase1(const Args& a, LAS unsigned char* lds) {
    const int tid = threadIdx.x, lane = tid & 63, wave = tid >> 6, wg = blockIdx.x, G = gridDim.x;
    unsigned char* ws = a.ws;
    const float* modr = (const float*)(ws + WS_MOD); const float* pt = (const float*)(ws + WS_POS); bf16* ain = (bf16*)(ws + WS_AIN);
    const float* gmix = a.in[6];
    const int NGW = G * NWAVES;
    f32x4 gv[4];
#pragma unroll
    for (int j = 0; j < 4; ++j) gv[j] = *(const f32x4*)(gmix + 4 * lane + 256 * j);
#pragma nounroll
    for (int r0 = wg * NWAVES + wave; r0 < MT; r0 += 4 * NGW) {
        f32x4 v[4][4];
#pragma unroll
        for (int k = 0; k < 4; ++k) { const int r = r0 + k * NGW;
            if (r < MT) { const bool lat = r < MX; const float* src = lat ? a.in[0] + (size_t)r * DM : a.in[2] + (size_t)(r - MX) * DM; const int t = r & 4095, rr = t >> 6, cc = t & 63;
#pragma unroll
                for (int j = 0; j < 4; ++j) { const int col = 4 * lane + 256 * j; v[k][j] = *(const f32x4*)(src + col);
                    const f32x4 pv = *(const f32x4*)(pt + ((j < 2) ? rr * 512 + col : cc * 512 + col - 512));
                    v[k][j] += pv * (lat ? 1.0f : 0.0f); } } }
#pragma unroll
        for (int k = 0; k < 4; ++k) { const int r = r0 + k * NGW;
            if (r < MT) { const int bb = (r < MX) ? (r >> 12) : 4; float ss = 0.f;
                f32x4 shv[4], scv[4];
#pragma unroll
                for (int j = 0; j < 4; ++j) { const int col = 4 * lane + 256 * j; shv[j] = *(const f32x4*)(modr + bb * 6144 + col); scv[j] = *(const f32x4*)(modr + bb * 6144 + 1024 + col); }
#pragma unroll
                for (int j = 0; j < 4; ++j) ss += v[k][j][0] * v[k][j][0] + v[k][j][1] * v[k][j][1] + v[k][j][2] * v[k][j][2] + v[k][j][3] * v[k][j][3];
                const float rs = rsqrtf(wave_sum(ss) * (1.0f / DM) + EPS);
#pragma unroll
                for (int j = 0; j < 4; ++j) { const int col = 4 * lane + 256 * j;
                    const f32x4 sh = shv[j], sc = scv[j];
                    const f32x4 y = (v[k][j] * rs * gv[j]) * (sc + 1.0f) + sh;
                    v2u w; w.x = pk2(y[0], y[1]); w.y = pk2(y[2], y[3]);
                    *(v2u*)(ain + (size_t)r * DM + col) = w; } } }
    }
}

typedef float cpx __attribute__((ext_vector_type(2)));
__device__ __forceinline__ cpx make_cpx(float x, float y) { cpx r; r.x = x; r.y = y; return r; }
__device__ __forceinline__ cpx cmul(cpx a, cpx b) { return make_cpx(a.x * b.x - a.y * b.y, a.x * b.y + a.y * b.x); }
__device__ __forceinline__ cpx cadd(cpx a, cpx b) { return make_cpx(a.x + b.x, a.y + b.y); }
__device__ __forceinline__ cpx csub(cpx a, cpx b) { return make_cpx(a.x - b.x, a.y - b.y); }
__device__ __forceinline__ cpx cconj(cpx a) { return make_cpx(a.x, -a.y); }
__device__ __forceinline__ cpx twid(float turns) { return make_cpx(__builtin_amdgcn_cosf(turns), -__builtin_amdgcn_sinf(turns)); }
__device__ __forceinline__ void dft4(cpx& a0, cpx& a1, cpx& a2, cpx& a3) {
    const cpx t0 = cadd(a0, a2), t1 = csub(a0, a2), t2 = cadd(a1, a3), t3 = csub(a1, a3);
    a0 = cadd(t0, t2); a2 = csub(t0, t2);
    a1 = make_cpx(t1.x + t3.y, t1.y - t3.x);
    a3 = make_cpx(t1.x - t3.y, t1.y + t3.x);
}
__device__ __forceinline__ void dft16(cpx (&v)[16]) {
    cpx t[16];
#pragma unroll
    for (int j = 0; j < 4; ++j) { cpx b0 = v[j], b1 = v[j + 4], b2 = v[j + 8], b3 = v[j + 12]; dft4(b0, b1, b2, b3); t[4 * j] = b0; t[4 * j + 1] = b1; t[4 * j + 2] = b2; t[4 * j + 3] = b3; }
    const float C1 = 0.92387953251f, S1 = 0.38268343236f, R2 = 0.70710678118f;
    const cpx W1 = make_cpx(C1, -S1), W2 = make_cpx(R2, -R2), W3 = make_cpx(S1, -C1), W4 = make_cpx(0.f, -1.f), W6 = make_cpx(-R2, -R2), W9 = make_cpx(-C1, S1);
    {   cpx b0 = t[0], b1 = t[4], b2 = t[8], b3 = t[12]; dft4(b0, b1, b2, b3); v[0] = b0; v[4] = b1; v[8] = b2; v[12] = b3; }
    {   cpx b0 = t[1], b1 = cmul(t[5], W1), b2 = cmul(t[9], W2), b3 = cmul(t[13], W3); dft4(b0, b1, b2, b3); v[1] = b0; v[5] = b1; v[9] = b2; v[13] = b3; }
    {   cpx b0 = t[2], b1 = cmul(t[6], W2), b2 = cmul(t[10], W4), b3 = cmul(t[14], W6); dft4(b0, b1, b2, b3); v[2] = b0; v[6] = b1; v[10] = b2; v[14] = b3; }
    {   cpx b0 = t[3], b1 = cmul(t[7], W3), b2 = cmul(t[11], W6), b3 = cmul(t[15], W9); dft4(b0, b1, b2, b3); v[3] = b0; v[7] = b1; v[11] = b2; v[15] = b3; }
}
#define FPAD(i) ((i) + ((i) >> 4))
constexpr int FFT_STRIDE = 4352;
__device__ __forceinline__ void apply_tw(cpx (&v)[16], cpx w1) {
    asm volatile("" : "+v"(w1.x), "+v"(w1.y));
    cpx w = w1; v[1] = cmul(v[1], w);
#pragma unroll
    for (int q = 2; q < 16; ++q) { w = cmul(w, w1); v[q] = cmul(v[q], w); }
}
__device__ __forceinline__ cpx opaque(cpx w) { asm volatile("" : "+v"(w.x), "+v"(w.y)); return w; }
__device__ __forceinline__ cpx c32(int r) { return make_cpx(__builtin_cosf(0.19634954084936207f * (float)r), -__builtin_sinf(0.19634954084936207f * (float)r)); }

#define HB(x) __uint_as_float(((unsigned)(x)) << 16)
__device__ __forceinline__ void hyena_item(const Args& a, LAS unsigned char* lds, int c, int stage) {
    int tid = threadIdx.x; asm volatile("" : "+v"(tid));
    const int f = tid >> 8, j = tid & 255, blk = j >> 4, jp = j & 15;
    unsigned char* ws = a.ws;
    LAS cpx* buf = (LAS cpx*)lds;
    LAS cpx* bm = buf + f * FFT_STRIDE;
    const int pj = j + blk, p16 = blk * 272 + jp, pc = 17 * j;
    const float* hT = (const float*)(ws + WS_HT);
    const float* hf = hT + ((size_t)(stage * 2 + 0) * 512 + c) * SEQ;
    const float* hb = hT + ((size_t)(stage * 2 + 1) * 512 + c) * SEQ;
    const bf16* hyT = (const bf16*)(ws + WS_HYT);
    const bf16* zT = (const bf16*)(ws + WS_ZT);
    float* outp = (float*)(ws + WS_YHYT);
    const float* cw = a.in[13]; const float* cb = a.in[14];
    const int chu = c, chg = (stage == 0 ? 512 : 1024) + c;
    const float wu0 = cw[chu], wu1 = cw[1536 + chu], wu2 = cw[3072 + chu], bu = cb[chu];
    const float wg0 = cw[chg], wg1 = cw[1536 + chg], wg2 = cw[3072 + chg], bg = cb[chg];
    const float bias = a.in[21][stage * 512 + c];
    const cpx wj = twid((float)j * (1.0f / 4096.0f)), wjp = twid((float)jp * (1.0f / 256.0f)), w8_ = twid((float)j * (1.0f / 8192.0f));
    cpx v[16];
    LAS cpx* Hs = buf + 2 * FFT_STRIDE + f * FFT_STRIDE + pc;
    { const cpx w8 = opaque(w8_);
    float fraw[16], graw[16];
#pragma unroll
    for (int r = 0; r < 16; ++r) { const unsigned n = (unsigned)j + 256u * r; fraw[r] = hf[n]; graw[r] = hb[(SEQ - n) & 4095u]; }
    asm volatile("" : "+v"(fraw[0]), "+v"(fraw[1]), "+v"(fraw[2]), "+v"(fraw[3]), "+v"(fraw[4]), "+v"(fraw[5]), "+v"(fraw[6]), "+v"(fraw[7]), "+v"(fraw[8]), "+v"(fraw[9]), "+v"(fraw[10]), "+v"(fraw[11]), "+v"(fraw[12]), "+v"(fraw[13]), "+v"(fraw[14]), "+v"(fraw[15]));
    asm volatile("" : "+v"(graw[0]), "+v"(graw[1]), "+v"(graw[2]), "+v"(graw[3]), "+v"(graw[4]), "+v"(graw[5]), "+v"(graw[6]), "+v"(graw[7]), "+v"(graw[8]), "+v"(graw[9]), "+v"(graw[10]), "+v"(graw[11]), "+v"(graw[12]), "+v"(graw[13]), "+v"(graw[14]), "+v"(graw[15]));
#pragma unroll
    for (int r = 0; r < 16; ++r) { const unsigned n = (unsigned)j + 256u * r; const float fv = fraw[r]; const float gv = n ? graw[r] : 0.f;
        const cpx wn = cmul(w8, c32(r)); const float d = fv - gv;
        v[r] = f ? make_cpx(d * wn.x, d * wn.y) : make_cpx(fv + gv, 0.f); } }
    dft16(v); apply_tw(v, wj);
#pragma unroll
    for (int q = 0; q < 16; ++q) bm[pj + 272 * q] = v[q];
    __syncthreads();
#pragma unroll
    for (int r = 0; r < 16; ++r) v[r] = bm[p16 + 17 * r];
    dft16(v); apply_tw(v, wjp);
#pragma unroll
    for (int q = 0; q < 16; ++q) bm[p16 + 17 * q] = v[q];
    __syncthreads();
#pragma unroll
    for (int r = 0; r < 16; ++r) v[r] = bm[pc + r];
    dft16(v);
#pragma unroll
    for (int q = 0; q < 16; ++q) Hs[q] = v[q];
    __syncthreads();
#pragma nounroll
    for (int bp = 0; bp < 2; ++bp) {
        const int b0 = 2 * bp, b1 = 2 * bp + 1;
        float uk0[8], uk1[8];
        {   float u0[16], u1[16];
            const unsigned uj = (unsigned)j;
            if (stage == 0) {
                const bf16* P0 = hyT + ((size_t)b0 * 1536 + chu) * SEQ; const bf16* P1 = hyT + ((size_t)b1 * 1536 + chu) * SEQ;
#pragma unroll
                for (int r = 0; r < 16; ++r) { const unsigned o = uj + 256u * r; if (r == 4 || r == 8 || r == 12) asm volatile("" ::: "memory");
                    const unsigned ol = (r == 0) ? (j ? uj - 1u : 0u) : o - 1u, orr = (r == 15) ? (j < 255 ? o + 1u : o) : o + 1u;
                    float l0 = HB(P0[ol]), l1 = HB(P1[ol]), r0 = HB(P0[orr]), r1 = HB(P1[orr]);
                    if (r == 0) { l0 = j ? l0 : 0.f; l1 = j ? l1 : 0.f; }
                    if (r == 15) { r0 = (j < 255) ? r0 : 0.f; r1 = (j < 255) ? r1 : 0.f; }
                    u0[r] = wu0 * l0 + wu1 * HB(P0[o]) + wu2 * r0 + bu; u1[r] = wu0 * l1 + wu1 * HB(P1[o]) + wu2 * r1 + bu; }
            } else {
                const bf16* P0 = zT + ((size_t)b0 * 512 + c) * SEQ; const bf16* P1 = zT + ((size_t)b1 * 512 + c) * SEQ;
                unsigned short z0[16], z1[16];
#pragma unroll
                for (int r = 0; r < 16; ++r) { const unsigned o = uj + 256u * r; z0[r] = P0[o]; z1[r] = P1[o]; }
                asm volatile("" :: "v"(z0[0]), "v"(z0[1]), "v"(z0[2]), "v"(z0[3]), "v"(z0[4]), "v"(z0[5]), "v"(z0[6]), "v"(z0[7]), "v"(z0[8]), "v"(z0[9]), "v"(z0[10]), "v"(z0[11]), "v"(z0[12]), "v"(z0[13]), "v"(z0[14]), "v"(z0[15]));
                asm volatile("" :: "v"(z1[0]), "v"(z1[1]), "v"(z1[2]), "v"(z1[3]), "v"(z1[4]), "v"(z1[5]), "v"(z1[6]), "v"(z1[7]), "v"(z1[8]), "v"(z1[9]), "v"(z1[10]), "v"(z1[11]), "v"(z1[12]), "v"(z1[13]), "v"(z1[14]), "v"(z1[15]));
#pragma unroll
                for (int r = 0; r < 16; ++r) { u0[r] = HB(z0[r]); u1[r] = HB(z1[r]); }
            }
#pragma unroll
            for (int i = 0; i < 8; ++i) { uk0[i] = f ? u0[2 * i + 1] : u0[2 * i]; uk1[i] = f ? u1[2 * i + 1] : u1[2 * i]; }
            const cpx w8 = opaque(w8_);
#pragma unroll
            for (int r = 0; r < 16; ++r) { const cpx x = make_cpx(u0[r], u1[r]); v[r] = f ? cmul(x, cmul(w8, c32(r))) : x; }
        }
        dft16(v); apply_tw(v, wj);
#pragma unroll
        for (int q = 0; q < 16; ++q) bm[pj + 272 * q] = v[q];
        __syncthreads();
#pragma unroll
        for (int r = 0; r < 16; ++r) v[r] = bm[p16 + 17 * r];
        dft16(v); apply_tw(v, wjp);
#pragma unroll
        for (int q = 0; q < 16; ++q) bm[p16 + 17 * q] = v[q];
        __syncthreads();
#pragma unroll
        for (int r = 0; r < 16; ++r) v[r] = bm[pc + r];
        dft16(v);
#pragma unroll
        for (int q = 0; q < 16; ++q) v[q] = cconj(cmul(v[q], Hs[q]));
        dft16(v);
#pragma unroll
        for (int q = 0; q < 16; ++q) bm[pc + q] = v[q];
        __syncthreads();
#pragma unroll
        for (int r = 0; r < 16; ++r) v[r] = bm[p16 + 17 * r];
        apply_tw(v, wjp); dft16(v);
#pragma unroll
        for (int q = 0; q < 16; ++q) bm[p16 + 17 * q] = v[q];
        __syncthreads();
        float gg0[8], gg1[8];
        {   unsigned short rg0[8][3], rg1[8][3];
            const bf16* G0 = hyT + ((size_t)b0 * 1536 + chg) * SEQ; const bf16* G1 = hyT + ((size_t)b1 * 1536 + chg) * SEQ;
            const unsigned gj = (unsigned)(j + 256 * f);
#pragma unroll
            for (int i = 0; i < 8; ++i) { const unsigned o = gj + 512u * i;
                const unsigned ol = (i == 0) ? (gj ? gj - 1u : 0u) : o - 1u, orr = (i == 7) ? (o < 4095u ? o + 1u : o) : o + 1u;
                rg0[i][0] = G0[ol]; rg0[i][1] = G0[o]; rg0[i][2] = G0[orr]; rg1[i][0] = G1[ol]; rg1[i][1] = G1[o]; rg1[i][2] = G1[orr]; }
#pragma unroll
            for (int r = 0; r < 16; ++r) v[r] = bm[pj + 272 * r];
            apply_tw(v, wj); dft16(v);
#pragma unroll
            for (int q = 0; q < 16; ++q) bm[pj + 272 * q] = v[q];
#pragma unroll
            for (int i = 0; i < 8; ++i) asm volatile("" :: "v"(rg0[i][0]), "v"(rg0[i][1]), "v"(rg0[i][2]), "v"(rg1[i][0]), "v"(rg1[i][1]), "v"(rg1[i][2]));
#pragma unroll
            for (int i = 0; i < 8; ++i) { const unsigned o = gj + 512u * i;
                float a0 = HB(rg0[i][0]), a1 = HB(rg0[i][1]), a2 = HB(rg0[i][2]), c0 = HB(rg1[i][0]), c1 = HB(rg1[i][1]), c2 = HB(rg1[i][2]);
                if (i == 0) { a0 = gj ? a0 : 0.f; c0 = gj ? c0 : 0.f; }
                if (i == 7) { a2 = (o < 4095u) ? a2 : 0.f; c2 = (o < 4095u) ? c2 : 0.f; }
                gg0[i] = wg0 * a0 + wg1 * a1 + wg2 * a2 + bg; gg1[i] = wg0 * c0 + wg1 * c1 + wg2 * c2 + bg; } }
        __syncthreads();
        const cpx w8f = cmul(opaque(w8_), f ? c32(1) : c32(0));
        float* O0 = outp + ((size_t)b0 * 512 + c) * SEQ; float* O1 = outp + ((size_t)b1 * 512 + c) * SEQ;
        bf16* Z0 = (bf16*)(ws + WS_ZT) + ((size_t)b0 * 512 + c) * SEQ; bf16* Z1 = (bf16*)(ws + WS_ZT) + ((size_t)b1 * 512 + c) * SEQ;
#pragma unroll
        for (int i = 0; i < 8; ++i) { const int rr = f + 2 * i; const unsigned n = (unsigned)(j + 256 * f) + 512u * i;
            const cpx ye = cconj(buf[pj + 272 * rr]), yo = cconj(buf[FFT_STRIDE + pj + 272 * rr]);
            const cpx wn = cmul(w8f, c32(2 * i));
            const cpx y = cadd(ye, cmul(cconj(wn), yo));
            const float y0 = y.x * (1.0f / 8192.0f) + bias * uk0[i], y1 = y.y * (1.0f / 8192.0f) + bias * uk1[i];
                        if (stage == 0) { Z0[n] = (bf16)f2bf(gg0[i] * y0); Z1[n] = (bf16)f2bf(gg1[i] * y1); } else { O0[n] = gg0[i] * y0; O1[n] = gg1[i] * y1; } }
        __syncthreads();
    }
}

__device__ __forceinline__ f32x16 mfma32(bf16x8 a, bf16x8 b, f32x16 c) { return __builtin_amdgcn_mfma_f32_32x32x16_bf16(a, b, c, 0, 0, 0); }
typedef short s4v __attribute__((ext_vector_type(4)));
__device__ __forceinline__ bf16x8 tr_frag(const LAS bf16* base, int PT, int k0, int c0, int lane) {
    const int i = lane & 15, q = i >> 2, p = i & 3;
    const LAS bf16* ad = base + (k0 + 8 * (lane >> 5) + q) * PT + c0 + 16 * ((lane >> 4) & 1) + 4 * p;
    const s4v lo = __builtin_amdgcn_ds_read_tr16_b64_v4i16((LAS s4v*)ad);
    const s4v hi = __builtin_amdgcn_ds_read_tr16_b64_v4i16((LAS s4v*)(ad + 4 * PT));
    bf16x8 r; r[0] = lo[0]; r[1] = lo[1]; r[2] = lo[2]; r[3] = lo[3]; r[4] = hi[0]; r[5] = hi[1]; r[6] = hi[2]; r[7] = hi[3]; return r;
}
constexpr int GL_AL = 0, GL_WA = 8192, GL_TOT = 16384, GL_V = 24576, GL_VP = 160;
struct GlaTab { float P[4][2], X[4][2], Ptot[2], Xtot[2], Pref[2], Xref[2]; };
__device__ __forceinline__ void gla_tables(const Args& a, int h, LAS unsigned char* lds, GlaTab& T, int tid) {
    const int d2 = tid & 31, sg = tid >> 5;
    const LAS float* aL = (const LAS float*)(lds + GL_AL); const LAS float* wa = (const LAS float*)(lds + GL_WA); LAS float* tot = (LAS float*)(lds + GL_TOT);
    typedef float f32x2v __attribute__((ext_vector_type(2)));
    const f32x2v bf = *(const f32x2v*)(a.in[9] + h * 64 + 2 * d2), bb = *(const f32x2v*)(a.in[11] + h * 64 + 2 * d2);
    float lf[4][2], lb[4][2];
#pragma unroll
    for (int q = 0; q < 4; ++q) { const int s = sg * 4 + q; float pf0 = bf[0], pf1 = bf[1], pb0 = bb[0], pb1 = bb[1];
#pragma unroll
        for (int j4 = 0; j4 < 4; ++j4) { const f32x4 af = *(const LAS f32x4*)(aL + s * 32 + 4 * j4), ab = *(const LAS f32x4*)(aL + s * 32 + 16 + 4 * j4);
#pragma unroll
            for (int jj = 0; jj < 4; ++jj) { const int j = 4 * j4 + jj; const f32x2v wf = *(const LAS f32x2v*)(wa + j * 64 + 2 * d2), wb = *(const LAS f32x2v*)(wa + 1024 + j * 64 + 2 * d2);
                pf0 += af[jj] * wf[0]; pf1 += af[jj] * wf[1]; pb0 += ab[jj] * wb[0]; pb1 += ab[jj] * wb[1]; } }
        lf[q][0] = logsig_f(pf0) * (1.0f / 16.0f); lf[q][1] = logsig_f(pf1) * (1.0f / 16.0f); lb[q][0] = logsig_f(pb0) * (1.0f / 16.0f); lb[q][1] = logsig_f(pb1) * (1.0f / 16.0f); }
#pragma unroll
    for (int i = 0; i < 2; ++i) { lf[1][i] += lf[0][i]; lf[2][i] += lf[1][i]; lf[3][i] += lf[2][i]; lb[2][i] += lb[3][i]; lb[1][i] += lb[2][i]; lb[0][i] += lb[1][i]; }
    *(LAS f32x2v*)(tot + sg * 64 + 2 * d2) = (f32x2v){lf[3][0], lf[3][1]};
    *(LAS f32x2v*)(tot + 1024 + sg * 64 + 2 * d2) = (f32x2v){lb[0][0], lb[0][1]};
    __syncthreads();
    float of[2] = {0.f, 0.f}, ob[2] = {0.f, 0.f};
    T.Ptot[0] = T.Ptot[1] = T.Xtot[0] = T.Xtot[1] = T.Pref[0] = T.Pref[1] = T.Xref[0] = T.Xref[1] = 0.f;
#pragma unroll
    for (int g = 0; g < 16; ++g) { const f32x2v tf = *(const LAS f32x2v*)(tot + g * 64 + 2 * d2), tb = *(const LAS f32x2v*)(tot + 1024 + g * 64 + 2 * d2);
#pragma unroll
        for (int i = 0; i < 2; ++i) { T.Ptot[i] += tf[i]; T.Xtot[i] += tb[i]; if (g < 8) T.Pref[i] += tf[i]; else T.Xref[i] += tb[i];
            of[i] += (g < sg) ? tf[i] : 0.f; ob[i] += (g > sg) ? tb[i] : 0.f; } }
#pragma unroll
    for (int q = 0; q < 4; ++q)
#pragma unroll
        for (int i = 0; i < 2; ++i) { T.P[q][i] = lf[q][i] + of[i]; T.X[q][i] = lb[q][i] + ob[i]; }
}
struct GlaIn { f32x4 av, wv; unsigned kw[4], qw[4]; };
template <bool OUT>
__device__ __forceinline__ void gla_load(const Args& a, int tid, int bh, int ci, GlaIn& I) {
    const int b = bh >> 2, h = bh & 3, d2 = tid & 31, sg = tid >> 5;
    const size_t rowbase = OUT ? (size_t)b * SEQ + ci * 64 : ((ci < 4) ? (size_t)(MX + b * CTXL + ci * 64) : (size_t)(b * SEQ + (ci - 4) * 64));
    const float* afb = (const float*)(a.ws + WS_AFB); const bf16* qkvg = (const bf16*)(a.ws + WS_QKVG);
    I.av = *(const f32x4*)(afb + (rowbase + (tid >> 3)) * 32 + 4 * (tid & 7));
    const int wdir = tid >> 8, wj = (tid >> 4) & 15, wd4 = (tid & 15) * 4;
    I.wv = *(const f32x4*)((wdir ? a.in[10] : a.in[8]) + wj * 256 + h * 64 + wd4);
#pragma unroll
    for (int q = 0; q < 4; ++q) { const bf16* rp = qkvg + (rowbase + sg * 4 + q) * NQ + h * 64 + 2 * d2; I.kw[q] = *(const unsigned*)(rp + 256); if (OUT) I.qw[q] = *(const unsigned*)rp; }
}
__device__ __forceinline__ void gla_stage_common(const GlaIn& I, LAS unsigned char* lds, int tid) {
    const int wdir = tid >> 8, wj = (tid >> 4) & 15, wd4 = (tid & 15) * 4;
    *(LAS f32x4*)((LAS float*)(lds + GL_AL) + 4 * tid) = I.av;
    *(LAS f32x4*)((LAS float*)(lds + GL_WA) + wdir * 1024 + wj * 64 + wd4) = I.wv;
}

template <bool HASN>
__device__ __forceinline__ void gla_upd_item(const Args& a, LAS unsigned char* lds, int bh, int ci, const GlaIn& I, int nbh, int nci, GlaIn& N) {
    int tid = threadIdx.x; asm volatile("" : "+v"(tid));
    const int lane = tid & 63, wave = tid >> 6, h = bh & 3, d2 = tid & 31, sg = tid >> 5;
    unsigned char* ws = a.ws;
    constexpr int KP = 96;
    LAS bf16* vN = (LAS bf16*)(lds + GL_V); LAS bf16* kUf = (LAS bf16*)(lds + 45056); LAS bf16* kUb = (LAS bf16*)(lds + 57344);
    unsigned kw[4];
#pragma unroll
    for (int q = 0; q < 4; ++q) kw[q] = I.kw[q];
    v4u vv[2];
    { const int b = bh >> 2; const size_t rowbase = (ci < 4) ? (size_t)(MX + b * CTXL + ci * 64) : (size_t)(b * SEQ + (ci - 4) * 64); const bf16* qkvg = (const bf16*)(ws + WS_QKVG);
#pragma unroll
        for (int q = 0; q < 2; ++q) { const int idx = tid + NTHR * q; vv[q] = *(const v4u*)(qkvg + (rowbase + (idx >> 4)) * NQ + 512 + h * 128 + (idx & 15) * 8); } }
    gla_stage_common(I, lds, tid);
    __syncthreads();
    if (HASN) gla_load<false>(a, tid, nbh, nci, N);
    GlaTab T; gla_tables(a, h, lds, T, tid);
#pragma unroll
    for (int q = 0; q < 4; ++q) { const int s = sg * 4 + q; const float k0 = bflo(kw[q]), k1 = bfhi(kw[q]);
        *(LAS unsigned*)(kUf + s * KP + 2 * d2) = pk2(k0 * __expf(T.Ptot[0] - T.P[q][0]), k1 * __expf(T.Ptot[1] - T.P[q][1]));
        *(LAS unsigned*)(kUb + s * KP + 2 * d2) = pk2(k0 * __expf(T.Xtot[0] - T.X[q][0]), k1 * __expf(T.Xtot[1] - T.X[q][1])); }
#pragma unroll
    for (int q = 0; q < 2; ++q) { const int idx = tid + NTHR * q; *(LAS v4u*)(vN + (idx >> 4) * GL_VP + (idx & 15) * 8) = vv[q]; }
    if (tid < 32) { float* dec = (float*)(ws + WS_DEC);
#pragma unroll
        for (int i = 0; i < 2; ++i) { dec[((size_t)(bh * 2 + 0) * NCH + ci) * 64 + 2 * d2 + i] = __expf(T.Ptot[i]); dec[((size_t)(bh * 2 + 1) * NCH + ci) * 64 + 2 * d2 + i] = __expf(T.Xtot[i]); } }
    __syncthreads();
    { const int dir = wave >> 2, e0 = (wave & 3) * 32, l31 = lane & 31, hh = lane >> 5;
        const LAS bf16* kT = dir ? kUb : kUf;
        float* U = (ci < 4) ? (float*)(ws + WS_UCTX) + ((size_t)(bh * 2 + dir) * 4 + ci) * 8192 : a.out + ((size_t)(bh * 2 + dir) * 64 + (ci - 4)) * 8192;
        bf16x8 A[4];
#pragma unroll
        for (int ks = 0; ks < 4; ++ks) A[ks] = tr_frag(vN, GL_VP, 16 * ks, e0, lane);
#pragma unroll
        for (int dt = 0; dt < 2; ++dt) { const int d0 = dt * 32; f32x16 acc;
#pragma unroll
            for (int i = 0; i < 16; ++i) acc[i] = 0.f;
#pragma unroll
            for (int ks = 0; ks < 4; ++ks) acc = mfma32(A[ks], tr_frag(kT, KP, 16 * ks, d0, lane), acc);
#pragma unroll
            for (int r = 0; r < 16; ++r) { const int e = e0 + (r & 3) + 8 * (r >> 2) + 4 * hh; U[e * 64 + d0 + l31] = acc[r]; } } }
    __syncthreads();
}

__device__ __forceinline__ void gla_scan_item(const Args& a, int it) {
    int tid = threadIdx.x; asm volatile("" : "+v"(tid));
    const int bd = it >> 4, dir = bd & 1, el = ((it & 15) * 8 + (tid >> 6)) * 64 + (tid & 63), d = tid & 63;
    unsigned char* ws = a.ws;
    const float* dec = (const float*)(ws + WS_DEC) + (size_t)bd * NCH * 64 + d;
    const float* Uc = (const float*)(ws + WS_UCTX) + (size_t)bd * 4 * 8192 + el;
    const float* U = a.out + (size_t)bd * 64 * 8192 + el;
    bf16* Sp = (bf16*)(ws + WS_SPREV) + (size_t)bd * 64 * 8192 + el;
    float S = 0.f;
#pragma unroll
    for (int c4 = 0; c4 < 4; ++c4) { const int ci = dir ? 3 - c4 : c4; S = dec[ci * 64] * S + Uc[(size_t)ci * 8192]; }
#pragma unroll
    for (int blk = 0; blk < 2; ++blk) { float uu[32], dd[32];
#pragma unroll
        for (int j = 0; j < 32; ++j) { const int n = dir ? 63 - (blk * 32 + j) : blk * 32 + j; uu[j] = U[(size_t)n * 8192]; dd[j] = dec[(4 + n) * 64]; }
#pragma unroll
        for (int j = 0; j < 32; ++j) { const int n = dir ? 63 - (blk * 32 + j) : blk * 32 + j; Sp[(size_t)n * 8192] = (bf16)f2bf(S); S = dd[j] * S + uu[j]; } }
}

template <bool HASN>
__device__ __forceinline__ void gla_out_item(const Args& a, LAS unsigned char* lds, int bh, int n, const GlaIn& I, int nbh, int nn, GlaIn& N) {
    int tid = threadIdx.x; asm volatile("" : "+v"(tid));
    const int lane = tid & 63, wave = tid >> 6, b = bh >> 2, h = bh & 3, l31 = lane & 31, hh = lane >> 5, d2 = tid & 31, sg = tid >> 5;
    unsigned char* ws = a.ws;
    LAS bf16* Scat = (LAS bf16*)lds;
    LAS bf16* vN = (LAS bf16*)(lds + GL_V);
    LAS bf16* qf = (LAS bf16*)(lds + 45056); LAS bf16* qb = qf + 4608; LAS bf16* kf = qf + 2 * 4608; LAS bf16* kb = qf + 3 * 4608;
    LAS float* oS = (LAS float*)(lds + 45056);
    LAS bf16* qS = (LAS bf16*)(lds + 81920);
    LAS bf16* Sp = (LAS bf16*)(lds + 99328);
    const size_t rowbase = (size_t)b * SEQ + n * 64;
    unsigned qw[4], kw[4];
#pragma unroll
    for (int q = 0; q < 4; ++q) { qw[q] = I.qw[q]; kw[q] = I.kw[q]; }
    v4u vv[2], sv[4], g0, g1;
    { const bf16* qkvg = (const bf16*)(ws + WS_QKVG);
        { const bf16* gp = qkvg + (rowbase + (tid >> 3)) * NQ + 1024 + h * 128 + (tid & 7) * 16; g0 = *(const v4u*)gp; g1 = *(const v4u*)(gp + 8); }
#pragma unroll
        for (int q = 0; q < 2; ++q) { const int idx = tid + NTHR * q; vv[q] = *(const v4u*)(qkvg + (rowbase + (idx >> 4)) * NQ + 512 + h * 128 + (idx & 15) * 8); }
        const bf16* spf = (const bf16*)(ws + WS_SPREV) + ((size_t)(bh * 2 + 0) * 64 + n) * 8192; const bf16* spb = (const bf16*)(ws + WS_SPREV) + ((size_t)(bh * 2 + 1) * 64 + n) * 8192;
#pragma unroll
        for (int q = 0; q < 4; ++q) { const int idx = tid + NTHR * q, dir = idx >> 10, e = (idx >> 3) & 127, d8 = (idx & 7) * 8; sv[q] = *(const v4u*)((dir ? spb : spf) + e * 64 + d8); } }
    gla_stage_common(I, lds, tid);
    __syncthreads();
    if (HASN) gla_load<true>(a, tid, nbh, nn, N);
    GlaTab T; gla_tables(a, h, lds, T, tid);
#pragma unroll
    for (int q = 0; q < 4; ++q) { const int s = sg * 4 + q; const float q0 = bflo(qw[q]), q1 = bfhi(qw[q]), k0 = bflo(kw[q]), k1 = bfhi(kw[q]);
        *(LAS unsigned*)(qf + s * 72 + 2 * d2) = pk2(q0 * __expf(T.P[q][0] - T.Pref[0]), q1 * __expf(T.P[q][1] - T.Pref[1]));
        *(LAS unsigned*)(kf + s * 72 + 2 * d2) = pk2(k0 * __expf(T.Pref[0] - T.P[q][0]), k1 * __expf(T.Pref[1] - T.P[q][1]));
        *(LAS unsigned*)(qb + s * 72 + 2 * d2) = pk2(q0 * __expf(T.X[q][0] - T.Xref[0]), q1 * __expf(T.X[q][1] - T.Xref[1]));
        *(LAS unsigned*)(kb + s * 72 + 2 * d2) = pk2(k0 * __expf(T.Xref[0] - T.X[q][0]), k1 * __expf(T.Xref[1] - T.X[q][1]));
        *(LAS unsigned*)(qS + s * 136 + 2 * d2) = pk2(q0 * __expf(T.P[q][0]), q1 * __expf(T.P[q][1]));
        *(LAS unsigned*)(qS + s * 136 + 64 + 2 * d2) = pk2(q0 * __expf(T.X[q][0]), q1 * __expf(T.X[q][1])); }
#pragma unroll
    for (int q = 0; q < 2; ++q) { const int idx = tid + NTHR * q; *(LAS v4u*)(vN + (idx >> 4) * GL_VP + (idx & 15) * 8) = vv[q]; }
#pragma unroll
    for (int q = 0; q < 4; ++q) { const int idx = tid + NTHR * q, dir = idx >> 10, e = (idx >> 3) & 127, d8 = (idx & 7) * 8; *(LAS v4u*)(Sp + e * 136 + dir * 64 + d8) = sv[q]; }
    __syncthreads();
    { const int dir = wave >> 2, c0 = ((wave >> 1) & 1) * 32, s0 = (wave & 1) * 32;
        const LAS bf16* qq = dir ? qb : qf; const LAS bf16* kk = dir ? kb : kf;
        f32x16 acc;
#pragma unroll
        for (int i = 0; i < 16; ++i) acc[i] = 0.f;
#pragma unroll
        for (int ks = 0; ks < 4; ++ks) { const bf16x8 A = *(const LAS bf16x8*)(qq + (c0 + l31) * 72 + 16 * ks + 8 * hh), B = *(const LAS bf16x8*)(kk + (s0 + l31) * 72 + 16 * ks + 8 * hh);
            acc = mfma32(A, B, acc); }
        const int s = s0 + l31;
#pragma unroll
        for (int r = 0; r < 16; ++r) { const int c = c0 + (r & 3) + 8 * (r >> 2) + 4 * hh; const bool keep = dir ? (s >= c) : (s <= c);
            Scat[c * 136 + dir * 64 + s] = (bf16)f2bf(keep ? acc[r] : 0.f); } }
    __syncthreads();
    { const int c0 = (wave >> 2) * 32, e0 = (wave & 3) * 32;
        f32x16 acc;
#pragma unroll
        for (int i = 0; i < 16; ++i) acc[i] = 0.f;
#pragma unroll
        for (int ks = 0; ks < 8; ++ks) { const bf16x8 A = *(const LAS bf16x8*)(Scat + (c0 + l31) * 136 + 16 * ks + 8 * hh);
            acc = mfma32(A, tr_frag(vN, GL_VP, 16 * (ks & 3), e0, lane), acc); }
#pragma unroll
        for (int ks = 0; ks < 8; ++ks) { const bf16x8 A = *(const LAS bf16x8*)(qS + (c0 + l31) * 136 + 16 * ks + 8 * hh), B = *(const LAS bf16x8*)(Sp + (e0 + l31) * 136 + 16 * ks + 8 * hh);
            acc = mfma32(A, B, acc); }
#pragma unroll
        for (int r = 0; r < 16; ++r) { const int c = c0 + (r & 3) + 8 * (r >> 2) + 4 * hh; oS[c * 132 + e0 + l31] = acc[r]; } }
    __syncthreads();
    { const int row = tid >> 3, ec = (tid & 7) * 16; float v[16]; float ss = 0.f;
#pragma unroll
        for (int j = 0; j < 16; ++j) { v[j] = oS[row * 132 + ec + j]; ss += v[j] * v[j]; }
        ss += __shfl_xor(ss, 1); ss += __shfl_xor(ss, 2); ss += __shfl_xor(ss, 4);
        const float rs = rsqrtf(ss * (1.0f / 128.0f) + EPS);
        const float gv[16] = {bflo(g0.x), bfhi(g0.x), bflo(g0.y), bfhi(g0.y), bflo(g0.z), bfhi(g0.z), bflo(g0.w), bfhi(g0.w), bflo(g1.x), bfhi(g1.x), bflo(g1.y), bfhi(g1.y), bflo(g1.z), bfhi(g1.z), bflo(g1.w), bfhi(g1.w)};
        float o[16];
#pragma unroll
        for (int j = 0; j < 16; ++j) o[j] = DBG_GLA_K * v[j] * rs * a.in[12][ec + j] * silu_f(gv[j]);
        bf16* op = (bf16*)(ws + WS_AOUT) + (rowbase + row) * DM + h * 128 + ec;
        *(v4u*)op = (v4u){pk2(o[0], o[1]), pk2(o[2], o[3]), pk2(o[4], o[5]), pk2(o[6], o[7])};
        *(v4u*)(op + 8) = (v4u){pk2(o[8], o[9]), pk2(o[10], o[11]), pk2(o[12], o[13]), pk2(o[14], o[15])}; }
    __syncthreads();
}

__device__ __forceinline__ void hy_transpose_item(const Args& a, LAS unsigned char* lds, int it) {
    const int tid = threadIdx.x, b = it >> 6, t0 = (it & 63) * 64;
    LAS float* tile = (LAS float*)lds;
    const float* src = (const float*)(a.ws + WS_YHYT) + (size_t)b * 512 * SEQ + t0;
    bf16* dst = (bf16*)(a.ws + WS_AOUT) + ((size_t)b * SEQ + t0) * DM + 512;
    for (int half = 0; half < 2; ++half) {
#pragma unroll 8
        for (int q = 0; q < 32; ++q) { const int idx = tid + NTHR * q, c = idx >> 6, tt = idx & 63; tile[c * 65 + tt] = src[(size_t)(half * 256 + c) * SEQ + tt]; }
        __syncthreads();
#pragma unroll
        for (int q = 0; q < 4; ++q) { const int idx = tid + NTHR * q, t = idx >> 5, c8 = (idx & 31) * 8; const LAS float* s = tile + c8 * 65 + t;
            *(v4u*)(dst + (size_t)t * DM + half * 256 + c8) = (v4u){pk2(s[0], s[65]), pk2(s[2 * 65], s[3 * 65]), pk2(s[4 * 65], s[5 * 65]), pk2(s[6 * 65], s[7 * 65])}; }
        __syncthreads();
    }
}

__device__ __forceinline__ void phase_router(const Args& a, LAS unsigned char* lds) {
    const int tid = threadIdx.x, lane = tid & 63, wave = tid >> 6, wg = blockIdx.x, G = gridDim.x;
    unsigned char* ws = a.ws;
    LAS float* wr = (LAS float*)lds;
    for (int i = tid; i < 4096; i += NTHR) { const int l = i & 63, q = (i >> 6) & 3, j = (i >> 8) & 3, e4 = i >> 10;
        *(LAS f32x4*)(wr + 4 * i) = *(const f32x4*)(a.in[24] + (4 * l + 256 * j + q) * 16 + 4 * e4); }
    __syncthreads();
    const float* modr = (const float*)(ws + WS_MOD); const float* gffn = a.in[23];
    bf16* hn = (bf16*)(ws + WS_HN); float* aff = (float*)(ws + WS_AFF);
    const int NGW = G * NWAVES;
    f32x4 gv[4];
#pragma unroll
    for (int j = 0; j < 4; ++j) gv[j] = *(const f32x4*)(gffn + 4 * lane + 256 * j);
#pragma nounroll
    for (int r0 = wg * NWAVES + wave; r0 < MX; r0 += 2 * NGW) {
        const int r1 = r0 + NGW; const bool ok1 = r1 < MX; const int rB = ok1 ? r1 : r0;
        int lane_o = lane; asm volatile("" : "+v"(lane_o));
        f32x4 v[2][4];
#pragma unroll
        for (int j = 0; j < 4; ++j) { v[0][j] = *(const f32x4*)(a.out + (size_t)r0 * DM + 4 * lane + 256 * j); v[1][j] = *(const f32x4*)(a.out + (size_t)rB * DM + 4 * lane + 256 * j); }
        float rs[2];
#pragma unroll
        for (int k = 0; k < 2; ++k) { float ss = 0.f;
#pragma unroll
            for (int j = 0; j < 4; ++j) ss += v[k][j][0] * v[k][j][0] + v[k][j][1] * v[k][j][1] + v[k][j][2] * v[k][j][2] + v[k][j][3] * v[k][j][3];
            rs[k] = rsqrtf(wave_sum(ss) * (1.0f / DM) + EPS); }
        float lg[2][16];
#pragma unroll
        for (int k = 0; k < 2; ++k)
#pragma unroll
            for (int e = 0; e < 16; ++e) lg[k][e] = 0.f;
        f32x4 shv[2][4], scv[2][4];
#pragma unroll
        for (int k = 0; k < 2; ++k)
#pragma unroll
            for (int j = 0; j < 4; ++j) { const int b = (k ? rB : r0) >> 12, col = 4 * lane + 256 * j; shv[k][j] = *(const f32x4*)(modr + b * 6144 + 3072 + col); scv[k][j] = *(const f32x4*)(modr + b * 6144 + 4096 + col); }
#pragma unroll
        for (int j = 0; j < 4; ++j) { const int col = 4 * lane + 256 * j; f32x4 y[2];
#pragma unroll
            for (int k = 0; k < 2; ++k) { const int r = k ? rB : r0;
                const f32x4 sh = shv[k][j], sc = scv[k][j];
                y[k] = (v[k][j] * rs[k] * gv[j]) * (sc + 1.0f) + sh;
                v2u w; w.x = pk2(y[k][0], y[k][1]); w.y = pk2(y[k][2], y[k][3]);
                if (k == 0 || ok1) *(v2u*)(hn + (size_t)r * DM + col) = w; }
#pragma unroll
            for (int q = 0; q < 4; ++q) {
#pragma unroll
                for (int e4 = 0; e4 < 4; ++e4) { const f32x4 ww = *(const LAS f32x4*)(wr + 4 * ((((e4 * 4 + j) * 4 + q) << 6) + lane_o));
#pragma unroll
                    for (int s = 0; s < 4; ++s) { lg[0][e4 * 4 + s] += y[0][q] * ww[s]; lg[1][e4 * 4 + s] += y[1][q] * ww[s]; } }
#define PIN16(x) asm volatile("" : "+v"(x[0]), "+v"(x[1]), "+v"(x[2]), "+v"(x[3]), "+v"(x[4]), "+v"(x[5]), "+v"(x[6]), "+v"(x[7]), "+v"(x[8]), "+v"(x[9]), "+v"(x[10]), "+v"(x[11]), "+v"(x[12]), "+v"(x[13]), "+v"(x[14]), "+v"(x[15]) :: "memory")
                PIN16(lg[0]); PIN16(lg[1]); } }
#undef PIN16
        const bool h5 = (lane & 32) != 0, h4 = (lane & 16) != 0, h3 = (lane & 8) != 0, h2 = (lane & 4) != 0;
        const int ex = (h5 ? 8 : 0) + (h4 ? 4 : 0) + (h3 ? 2 : 0) + (h2 ? 1 : 0);
#pragma unroll
        for (int k = 0; k < 2; ++k) { float k8[8], k4[4], k2[2], lgt;
#pragma unroll
            for (int i = 0; i < 8; ++i) { const float snd = h5 ? lg[k][i] : lg[k][8 + i], kp = h5 ? lg[k][8 + i] : lg[k][i]; k8[i] = kp + __shfl_xor(snd, 32); }
#pragma unroll
            for (int i = 0; i < 4; ++i) { const float snd = h4 ? k8[i] : k8[4 + i], kp = h4 ? k8[4 + i] : k8[i]; k4[i] = kp + __shfl_xor(snd, 16); }
#pragma unroll
            for (int i = 0; i < 2; ++i) { const float snd = h3 ? k4[i] : k4[2 + i], kp = h3 ? k4[2 + i] : k4[i]; k2[i] = kp + __shfl_xor(snd, 8); }
            { const float snd = h2 ? k2[0] : k2[1], kp = h2 ? k2[1] : k2[0]; lgt = kp + __shfl_xor(snd, 4); }
            lgt += __shfl_xor(lgt, 2); lgt += __shfl_xor(lgt, 1);
            float mx = lgt;
            mx = fmaxf(mx, __shfl_xor(mx, 4)); mx = fmaxf(mx, __shfl_xor(mx, 8)); mx = fmaxf(mx, __shfl_xor(mx, 16)); mx = fmaxf(mx, __shfl_xor(mx, 32));
            const float pe = expf(lgt - mx);
            float sum = pe;
            sum += __shfl_xor(sum, 4); sum += __shfl_xor(sum, 8); sum += __shfl_xor(sum, 16); sum += __shfl_xor(sum, 32);
            const int r = k ? rB : r0;
            if ((lane & 3) == 0 && (k == 0 || ok1)) aff[((size_t)(r >> 12) * NE + ex) * SEQ + (r & 4095)] = pe / sum; }
    }
}

__device__ __forceinline__ void conv_item(const Args& a, LAS float* scr, int lane, bool gu, int it) {
    unsigned char* ws = a.ws;
    if (gu) { const int mat = it >> 9, r = it & 511, nb = r >> 4, kb = r & 15, e = mat >> 1, kind = mat & 1, n0 = nb * 32;
        transpose_item((kind ? a.in[26] : a.in[25]) + (size_t)e * DM * DM, DM, kb * 64, n0, (bf16*)(ws + WS_WGU) + (size_t)e * 2048 * DM, DM, (n0 >> 7) * 256 + kind * 128 + (n0 & 127), scr, lane, false);
    } else { const int e = it >> 9, r = it & 511, nb = r >> 4, kb = r & 15;
        transpose_item(a.in[27] + (size_t)e * DM * DM, DM, kb * 64, nb * 32, (bf16*)(ws + WS_WD) + (size_t)e * DM * DM, DM, nb * 32, scr, lane, false); }
}
__device__ __forceinline__ bool conv_try(const Args& a, LAS unsigned char* lds, bool allow_gu, unsigned& cur) {
    const int lane = threadIdx.x & 63, wave = threadIdx.x >> 6;
    const int gw = blockIdx.x * NWAVES + wave, NGW = gridDim.x * NWAVES;
    LAS float* scr = (LAS float*)(lds + wave * 8448);
    const int itD = gw + (int)(cur & 0xffffu) * NGW;
    if (itD < NE * 512) { conv_item(a, scr, lane, false, itD); cur += 1u; return true; }
    if (!allow_gu) return false;
    const int itG = gw + (int)(cur >> 16) * NGW;
    if (itG < NE * 1024) { conv_item(a, scr, lane, true, itG); cur += 0x10000u; return true; }
    return false;
}
#ifndef DBG_NOSHADOW
#define DBG_NOSHADOW 0
#endif
__device__ __forceinline__ void seam_barrier(const XcdBarrier& b, const Args& a, LAS unsigned char* lds, volatile LAS unsigned* MISC, unsigned& gen, bool allow_gu, unsigned& cdone) {
    asm volatile("s_waitcnt vmcnt(0)" ::: "memory");
    __syncthreads();
    ++gen;
    if (threadIdx.x < 64) {
        if (threadIdx.x == 0) {
            unsigned* bar = b.bar;
            __builtin_amdgcn_s_waitcnt(0);
            unsigned nloc = b.st[0], nx = b.st[1];
            if (nloc == 0u) { xcd_barrier_complete(bar, b.x, nloc, nx); b.st[0] = nloc; b.st[1] = nx; }
            const unsigned old = xb_add(&bar[XB_XSUB(b.x)], 1u);
            const unsigned g2 = old / nloc;
            if (old + 1u == (g2 + 1u) * nloc) {
                __builtin_amdgcn_fence(__ATOMIC_RELEASE, "agent");
                asm volatile("s_waitcnt vmcnt(0)" ::: "memory");
                const unsigned og = xb_add(&bar[XB_TOP], 1u);
                const unsigned tg = og / nx;
                if (og + 1u == (tg + 1u) * nx) xb_add(&bar[XB_TOPGEN], 1u);
                else XB_SPIN(xb_ld(&bar[XB_TOPGEN]) == tg, bar);
                __builtin_amdgcn_fence(__ATOMIC_ACQUIRE, "agent");
                xb_add(&bar[XB_XGEN(b.x)], 1u);
                asm volatile("s_waitcnt vmcnt(0)" ::: "memory");
            } else {
                XB_SPIN(xb_ld(&bar[XB_XGEN(b.x)]) == g2, bar);
                __builtin_amdgcn_fence(__ATOMIC_ACQUIRE, "agent");
                asm volatile("s_waitcnt vmcnt(0)" ::: "memory");
            }
            MISC[16] = gen;
        }
    } else {
        unsigned spins = 0;
        while (MISC[16] != gen) { if (DBG_NOSHADOW || !conv_try(a, lds, allow_gu, cdone)) { __builtin_amdgcn_s_sleep(4); if (++spins > (1u << 22)) break; } }
    }
    __syncthreads();
}

__device__ __forceinline__ void block_excl_scan2(int& va, int& vb, LAS int* tmp) {
    const int tid = threadIdx.x, lane = tid & 63, wave = tid >> 6;
    int ia = va, ib = vb;
#pragma unroll
    for (int o = 1; o < 64; o <<= 1) { const int ta = __shfl_up(ia, o), tb = __shfl_up(ib, o); if (lane >= o) { ia += ta; ib += tb; } }
    if (lane == 63) { tmp[wave] = ia; tmp[8 + wave] = ib; }
    __syncthreads();
    int oa = 0, ob = 0;
#pragma unroll
    for (int w = 0; w < 8; ++w) { if (w < wave) { oa += tmp[w]; ob += tmp[8 + w]; } }
    va = oa + ia - va; vb = ob + ib - vb;
    __syncthreads();
}
__device__ __forceinline__ void topk_item(const Args& a, LAS unsigned char* lds, int be) {
    const int tid = threadIdx.x, b = be >> 4, e = be & 15;
    unsigned char* ws = a.ws;
    LAS unsigned* keys = (LAS unsigned*)lds;
    LAS unsigned* hist = (LAS unsigned*)(lds + 16384);
    LAS int* ctl = (LAS int*)(lds + 16384 + 1024);
    LAS int* tmp = (LAS int*)(lds + 16384 + 1024 + 64);
    const float* aff = (const float*)(ws + WS_AFF) + (size_t)be * SEQ;
    unsigned my[8];
#pragma unroll
    for (int i = 0; i < 8; ++i) { my[i] = __float_as_uint(aff[tid * 8 + i]); keys[tid * 8 + i] = my[i]; }
    unsigned prefix = 0u, mask = 0u; int need = CAP;
    for (int pass = 0; pass < 4; ++pass) {
        const int shift = 24 - 8 * pass;
        if (tid < 256) hist[tid] = 0u;
        __syncthreads();
#pragma unroll
        for (int i = 0; i < 8; ++i) if ((my[i] & mask) == prefix) atomicAdd((unsigned*)&hist[(my[i] >> shift) & 255u], 1u);
        __syncthreads();
        {
            int hv = (tid < 256) ? (int)hist[255 - tid] : 0, inc = hv;
#pragma unroll
            for (int o = 1; o < 64; o <<= 1) { const int t2 = __shfl_up(inc, o); if ((tid & 63) >= o) inc += t2; }
            if ((tid & 63) == 63) tmp[tid >> 6] = inc;
            __syncthreads();
            int off = 0;
#pragma unroll
            for (int w = 0; w < 4; ++w) if (w < (tid >> 6)) off += tmp[w];
            inc += off;
            if (tid < 256 && inc >= need && inc - hv < need) { ctl[0] = 255 - tid; ctl[1] = need - (inc - hv); }
        }
        __syncthreads();
        prefix |= ((unsigned)ctl[0]) << shift; mask |= 255u << shift; need = ctl[1];
        __syncthreads();
    }
    const unsigned T = prefix;
    int cg = 0, ce = 0;
#pragma unroll
    for (int i = 0; i < 8; ++i) { cg += (my[i] > T) ? 1 : 0; ce += (my[i] == T) ? 1 : 0; }
    int pg = cg, pe = ce;
    block_excl_scan2(pg, pe, tmp);
    int* slot_of = (int*)(ws + WS_SLOT) + (size_t)be * SEQ;
    int* selt = (int*)(ws + WS_SELT) + (e * 4 + b) * CAP; float* selv = (float*)(ws + WS_SELV) + (e * 4 + b) * CAP;
#pragma unroll
    for (int i = 0; i < 8; ++i) { const int t = tid * 8 + i; const bool gt = my[i] > T, eq = my[i] == T; const bool sel = gt || (eq && pe < need);
        const int slot = pg + (pe < need ? pe : need);
        slot_of[t] = sel ? slot : -1;
        if (sel) { selt[slot] = t; selv[slot] = __uint_as_float(my[i]); }
        pg += gt ? 1 : 0; pe += eq ? 1 : 0; }
    __syncthreads();
}
__device__ __forceinline__ void phase_topk(const Args& a, LAS unsigned char* lds, unsigned& cdone) {
    const int tid = threadIdx.x, lane = tid & 63, wave = tid >> 6, wg = blockIdx.x, G = gridDim.x;
    unsigned char* ws = a.ws;
    for (int it = wg; it < NB * NE; it += G) topk_item(a, lds, it);
    __syncthreads();
    while (conv_try(a, lds, true, cdone)) {}
}

__device__ __forceinline__ void phase_final(const Args& a) {
    const int tid = threadIdx.x, lane = tid & 63, wave = tid >> 6, wg = blockIdx.x, G = gridDim.x;
    unsigned char* ws = a.ws;
    const float* modr = (const float*)(ws + WS_MOD); const int* slot_of = (const int*)(ws + WS_SLOT); const bf16* ys = (const bf16*)(ws + WS_YSLAB);
    const int NGW = G * NWAVES;
    f32x4 gf[4];
#pragma unroll
    for (int j = 0; j < 4; ++j) gf[j] = *(const f32x4*)(a.in[28] + 4 * lane + 256 * j);
#pragma nounroll
    for (int r0 = wg * NWAVES + wave; r0 < MX; r0 += 4 * NGW) {
        int sv[4]; unsigned long long mk[4]; f32x4 v[4][4], m[4][4];
#pragma unroll
        for (int k = 0; k < 4; ++k) { const int r = r0 + k * NGW; const bool ok = r < MX; const int rc = ok ? r : r0, b = rc >> 12, t = rc & 4095;
            sv[k] = (lane < NE) ? slot_of[((size_t)b * NE + lane) * SEQ + t] : -1;
#pragma unroll
            for (int j = 0; j < 4; ++j) { v[k][j] = *(const f32x4*)(a.out + (size_t)rc * DM + 4 * lane + 256 * j); m[k][j] = (f32x4){0.f, 0.f, 0.f, 0.f}; }
            mk[k] = (ok && !DBG_NOMOE) ? __ballot(sv[k] >= 0) : 0ull; }
        while (mk[0] | mk[1] | mk[2] | mk[3]) {
            v2u w[4][4]; float wt[4];
#pragma unroll
            for (int k = 0; k < 4; ++k) { const bool has = mk[k] != 0ull; const int e = has ? (int)__ffsll((long long)mk[k]) - 1 : 0; mk[k] &= mk[k] - 1ull;
                const int rc = (r0 + k * NGW < MX) ? r0 + k * NGW : r0; const int sl = has ? __builtin_amdgcn_readlane(sv[k], e) : 0;
                const bf16* yp = ys + ((size_t)e * 2048 + (rc >> 12) * CAP + sl) * DM; wt[k] = has ? 1.f : 0.f;
#pragma unroll
                for (int j = 0; j < 4; ++j) w[k][j] = *(const v2u*)(yp + 4 * lane + 256 * j); }
#pragma unroll
            for (int k = 0; k < 4; ++k)
#pragma unroll
                for (int j = 0; j < 4; ++j) { m[k][j][0] += wt[k] * bflo(w[k][j].x); m[k][j][1] += wt[k] * bfhi(w[k][j].x); m[k][j][2] += wt[k] * bflo(w[k][j].y); m[k][j][3] += wt[k] * bfhi(w[k][j].y); }
        }
        f32x4 gt[4][4];
#pragma unroll
        for (int k = 0; k < 4; ++k) { const int r = r0 + k * NGW, b = ((r < MX) ? r : r0) >> 12;
#pragma unroll
            for (int j = 0; j < 4; ++j) gt[k][j] = *(const f32x4*)(modr + b * 6144 + 5120 + 4 * lane + 256 * j); }
#pragma unroll
        for (int k = 0; k < 4; ++k) { const int r = r0 + k * NGW;
            if (r < MX) { float ss = 0.f; float* row = a.out + (size_t)r * DM;
#pragma unroll
                for (int j = 0; j < 4; ++j) { v[k][j] = v[k][j] + gt[k][j] * m[k][j] * DBG_MOE_K;
                    ss += v[k][j][0] * v[k][j][0] + v[k][j][1] * v[k][j][1] + v[k][j][2] * v[k][j][2] + v[k][j][3] * v[k][j][3]; }
                const float rs = rsqrtf(wave_sum(ss) * (1.0f / DM) + EPS);
#pragma unroll
                for (int j = 0; j < 4; ++j) *(f32x4*)(row + 4 * lane + 256 * j) = v[k][j] * rs * gf[j]; } }
    }
}

__global__ void __launch_bounds__(NTHR, 2) fwd_kernel(Args a) {
    extern __shared__ __attribute__((aligned(16))) unsigned char lds_raw[];
    LAS unsigned char* lds = (LAS unsigned char*)lds_raw;
    const int tid = threadIdx.x, wg = blockIdx.x, G = gridDim.x;
    unsigned char* ws = a.ws;
    volatile LAS unsigned* MISC = (volatile LAS unsigned*)(lds + LDS_MISC);
    if (tid < 64) MISC[tid] = 0u;
    __syncthreads();
    unsigned bgen = 0u, cdone = 0u;
    XcdBarrier bar; bar.bar = (unsigned*)(ws + WS_CTL); bar.x = 0; bar.st = nullptr;
    if (a.ph_hi - a.ph_lo > 1) bar = xcd_barrier_post((unsigned*)(ws + WS_CTL), MISC + 8);
#ifndef PH_ONLY
#define PH_ONLY -1
#endif
#define IN(k) ((PH_ONLY < 0 || PH_ONLY == (k)) && a.ph_lo <= (k) && (k) < a.ph_hi)
#ifndef DBG_BAR2
#define DBG_BAR2 0
#endif
#ifndef DBG_TSA
#define DBG_TSA -1
#endif
#ifndef DBG_TSB
#define DBG_TSB -1
#endif
#define STAMP(k) do { if (DBG_TSA >= 0 && wg == 0 && tid == 0) ((unsigned long long*)(ws + WS_CTL + 49152))[k] = __builtin_amdgcn_s_memrealtime(); } while (0)
#define SEAM(k) do { if (IN(k) && IN((k) + 1)) { seam_barrier(bar, a, lds, MISC, bgen, (k) >= 6, cdone); if (DBG_BAR2) xcd_barrier(bar); } STAMP((k) + 1); } while (0)
#ifndef DBG_DUP
#define DBG_DUP -1
#endif
#define REP(k) _Pragma("nounroll") for (int _rep = 0; _rep < ((DBG_DUP == (k)) ? 2 : 1); ++_rep, (void)((DBG_DUP == (k) && _rep == 1) ? (xcd_barrier(bar), 0) : 0))
    STAMP(0);
    if (IN(0)) REP(0) { phase0(a, lds); } SEAM(0);
    if (IN(1)) REP(1) { phase1(a, lds); } SEAM(1);
    if (IN(2)) REP(2) {
        pg8::Gemm g{(const pg8::bf16_t*)ws, (const pg8::bf16_t*)ws, MT, NIN, DM}; InSched S; S.init(G, wg, 0);
        EpiIn E{(bf16*)(ws + WS_QKVG), (bf16*)(ws + WS_HYT), (float*)(ws + WS_AFB)};
        pg8::gemm_phase<EpiIn, InSched, true, true>(lds, g, S, E);
    } SEAM(2);
    if (IN(3)) REP(3) {
        {   pg8::Gemm g{(const pg8::bf16_t*)ws, (const pg8::bf16_t*)ws, MT, NIN, DM}; InSched S; S.init(G, wg, 1);
            EpiIn E{(bf16*)(ws + WS_QKVG), (bf16*)(ws + WS_HYT), (float*)(ws + WS_AFB)};
            pg8::gemm_phase<EpiIn, InSched, true, true>(lds, g, S, E); }
        for (int it = wg; it < 512; it += G) hyena_item(a, lds, it, 0);
        {   GlaIn I, N; bool have = false;
            const bool split = (G == 256);
            const int first = split ? ((wg < 80) ? wg : 80 + wg) : wg, stride = split ? ((wg < 80) ? 80 : 176) : G, limit = split ? ((wg < 80) ? 160 : 16 * NCH) : 16 * NCH;
            for (int r = first; r < limit; r += stride) {
                const int nr = r + stride; const bool hasn = nr < limit;
                if (!have) { int t0 = threadIdx.x; asm volatile("" : "+v"(t0)); gla_load<false>(a, t0, r / NCH, r % NCH, I); have = true; }
                if (hasn) gla_upd_item<true>(a, lds, r / NCH, r % NCH, I, nr / NCH, nr % NCH, N); else gla_upd_item<false>(a, lds, r / NCH, r % NCH, I, 0, 0, N);
                I = N; } }
    } SEAM(3);
    if (IN(4)) REP(4) {
        for (int it = wg; it < 1024; it += G) { if (it < 512) hyena_item(a, lds, it, 1); else gla_scan_item(a, it - 512); }
    } SEAM(4);
    if (IN(5)) REP(5) {
        GlaIn I, N; bool have = false;
        for (int it = wg; it < 1280; it += G) {
            if (it >= 1024) { hy_transpose_item(a, lds, it - 1024); continue; }
            const int nr = it + G; const bool hasn = nr < 1024;
            if (!have) { int t0 = threadIdx.x; asm volatile("" : "+v"(t0)); gla_load<true>(a, t0, it >> 6, it & 63, I); have = true; }
            if (hasn) gla_out_item<true>(a, lds, it >> 6, it & 63, I, nr >> 6, nr & 63, N); else gla_out_item<false>(a, lds, it >> 6, it & 63, I, 0, 0, N);
            I = N; }
    } SEAM(5);
    if (IN(6)) REP(6) {
        pg8::Gemm g{(const pg8::bf16_t*)(ws + WS_AOUT), (const pg8::bf16_t*)(ws + WS_WOUT), MX, DM, DM}; pg8::StaticOrder S; S.init(MX, DM, G, wg);
        EpiOut E{a.in[0], (const float*)(ws + WS_POS), (const float*)(ws + WS_MOD), a.out};
        pg8::gemm_phase<EpiOut, pg8::StaticOrder, false, true>(lds, g, S, E);
    } SEAM(6);
    if (IN(7)) REP(7) { phase_router(a, lds); } SEAM(7);
    if (IN(8)) REP(8) { phase_topk(a, lds, cdone); } SEAM(8);
    if (IN(9)) REP(9) {
        pg8::Gemm g{(const pg8::bf16_t*)(ws + WS_HN), (const pg8::bf16_t*)(ws + WS_WGU), NE * 2048, NE * 2048, DM}; MoeSched<8> S; S.init(G, wg);
        EpiGU E{(bf16*)(ws + WS_HID)};
        pg8::gemm_phase_gather<EpiGU, MoeSched<8>, true, true>(lds, g, S, E, (const int*)(ws + WS_SELT));
    } SEAM(9);
    if (IN(10)) REP(10) {
        pg8::Gemm g{(const pg8::bf16_t*)(ws + WS_HID), (const pg8::bf16_t*)(ws + WS_WD), NE * 2048, NE * 1024, DM}; MoeSched<4> S; S.init(G, wg);
        EpiDown E{(bf16*)(ws + WS_YSLAB), (const float*)(ws + WS_SELV)};
        pg8::gemm_phase<EpiDown, MoeSched<4>, true, true>(lds, g, S, E);
    } SEAM(10);
    if (IN(11)) { phase_final(a); }
    if (DBG_TSA >= 0) {
        xcd_barrier(bar); STAMP(12); xcd_barrier(bar);
        const unsigned long long* ts = (const unsigned long long*)(ws + WS_CTL + 49152);
        const float da = (DBG_TSA == 12) ? (float)(ts[12] - ts[0]) * 0.01f : (float)(ts[DBG_TSA + 1] - ts[DBG_TSA]) * 0.01f;
        const float db = (DBG_TSB == 12) ? (float)(ts[12] - ts[0]) * 0.01f : (float)(ts[DBG_TSB + 1] - ts[DBG_TSB]) * 0.01f;
        for (size_t i = (size_t)wg * NTHR + tid; i < (size_t)MX * DM; i += (size_t)G * NTHR) a.out[i] = (i < (size_t)MX * DM / 2) ? da : db;
    }
#undef IN
#undef SEAM
}


#ifdef DBG_STATE
__global__ void chk_kernel(const unsigned* p, size_t nwords, unsigned long long* out) {
    unsigned long long s = 0ull;
    for (size_t i = (size_t)blockIdx.x * blockDim.x + threadIdx.x; i < nwords; i += (size_t)gridDim.x * blockDim.x) s += (unsigned long long)p[i] * (2ull * i + 1ull);
    for (int o = 1; o < 64; o <<= 1) s += __shfl_xor(s, o);
    if ((threadIdx.x & 63) == 0) atomicAdd(out, s);
}
__global__ void report_kernel(const unsigned long long* chk, float* out, int n) {
    int bad = -1;
    for (int p = 0; p < 27; ++p) if (chk[p] != chk[32 + p]) { bad = p; break; }
    if (bad < 0) return;
    for (int i = blockIdx.x * blockDim.x + threadIdx.x; i < n; i += gridDim.x * blockDim.x) out[i] = 1000.f * (float)(bad + 1);
}
struct ChkEnt { int ph; size_t off; size_t bytes; };
#endif
extern "C" void kernel_launch(void* const* d_in, const int* in_sizes, int n_in, void* d_out, int out_size, void* d_ws, size_t ws_size, hipStream_t stream) {
    static int grid = 0;
    if (grid == 0) {
        if (n_in != 29 || out_size != MX * DM || ws_size < WS_END) { fprintf(stderr, "kernel_launch: unexpected shapes (n_in %d out %d ws %zu)\n", n_in, out_size, ws_size); grid = -1; return; }
        int dev = 0, cus = 0, per_cu = 0;
        if (hipGetDevice(&dev) != hipSuccess || hipDeviceGetAttribute(&cus, hipDeviceAttributeMultiprocessorCount, dev) != hipSuccess) { grid = -1; return; }
        if (hipFuncSetAttribute((const void*)fwd_kernel, hipFuncAttributeMaxDynamicSharedMemorySize, LDS_BYTES) != hipSuccess) { fprintf(stderr, "kernel_launch: hipFuncSetAttribute failed\n"); grid = -1; return; }
        if (hipOccupancyMaxActiveBlocksPerMultiprocessor(&per_cu, (const void*)fwd_kernel, NTHR, LDS_BYTES) != hipSuccess || per_cu < 1) fprintf(stderr, "kernel_launch: occupancy query reports %d\n", per_cu);
        (void)hipGetLastError();
        grid = cus;
    }
    if (grid < 0) return;
    (void)hipMemsetAsync((char*)d_ws + WS_CTL, 0, CTL_BYTES, stream);
    Args a{};
    for (int i = 0; i < 29; ++i) a.in[i] = (const float*)d_in[i];
    a.out = (float*)d_out; a.ws = (unsigned char*)d_ws;
#if MK_SINGLE
#ifdef DBG_TWICE
    a.ph_lo = 0; a.ph_hi = NPH - 1;
    hipLaunchKernelGGL(fwd_kernel, dim3(grid), dim3(NTHR), LDS_BYTES, stream, a);
    (void)hipMemsetAsync((char*)d_ws + WS_CTL, 0, CTL_BYTES, stream);
#endif
    a.ph_lo = 0; a.ph_hi = NPH;
    hipLaunchKernelGGL(fwd_kernel, dim3(grid), dim3(NTHR), LDS_BYTES, stream, a);
#else
#ifdef DBG_STATE
    static const ChkEnt ents[] = { {0, WS_MOD, 122880}, {0, WS_POS, 131072}, {0, WS_HT, 32 * MiB}, {0, WS_WIN, (size_t)NIN * DM * 2}, {0, WS_WOUT, 2 * MiB},
        {1, WS_AIN, 34 * MiB}, {2, WS_QKVG, (size_t)MX * NQ * 2}, {2, WS_HYT, 48 * MiB}, {2, WS_AFB, (size_t)MT * 128},
        {3, WS_ZT, 32 * MiB}, {3, WS_DEC, (size_t)16 * 2 * NCH * 64 * 4}, {3, WS_UCTX, 4 * MiB}, {3, (size_t)-1, 64 * MiB},
        {4, WS_SPREV, 32 * MiB}, {4, WS_YHYT, 32 * MiB}, {5, WS_AOUT, 32 * MiB}, {6, (size_t)-1, 64 * MiB}, {7, WS_HN, 32 * MiB}, {7, WS_AFF, 1 * MiB},
        {8, WS_SLOT, 1 * MiB}, {8, WS_SELT, 131072}, {8, WS_SELV, 131072}, {8, WS_WGU, 64 * MiB}, {8, WS_WD, 32 * MiB}, {9, WS_HID, 64 * MiB}, {10, WS_YSLAB, 64 * MiB}, {11, (size_t)-1, 64 * MiB} };
    unsigned long long* chk = (unsigned long long*)((char*)d_ws + 32768);
    for (int run = 0; run < 2; ++run)
        for (int p = 0; p < NPH; ++p) { a.ph_lo = p; a.ph_hi = p + 1; hipLaunchKernelGGL(fwd_kernel, dim3(grid), dim3(NTHR), LDS_BYTES, stream, a);
            for (const ChkEnt& e : ents) if (e.ph == p) hipLaunchKernelGGL(chk_kernel, dim3(1024), dim3(256), 0, stream, (const unsigned*)(e.off == (size_t)-1 ? (char*)d_out : (char*)d_ws + e.off), e.bytes / 4, chk + run * 32 + (int)(&e - ents)); }
    hipLaunchKernelGGL(report_kernel, dim3(1024), dim3(256), 0, stream, (const unsigned long long*)chk, (float*)d_out, out_size);
#else
    for (int p = 0; p < NPH; ++p) { a.ph_lo = p; a.ph_hi = p + 1; hipLaunchKernelGGL(fwd_kernel, dim3(grid), dim3(NTHR), LDS_BYTES, stream, a); }
#endif
#endif
}
```

```cpp
#include <hip/hip_runtime.h>
#include <cstdio>
#include <cstdint>
#define MK_SINGLE 1
namespace pg8 {
#define PG8_LAS __attribute__((address_space(3)))
typedef unsigned short bf16_t;
typedef short bf16x8 __attribute__((ext_vector_type(8)));
typedef float f32x4 __attribute__((ext_vector_type(4)));
typedef unsigned u32x4 __attribute__((ext_vector_type(4)));
constexpr int BM = 256, BK = 64, HALF = 128, HTB = HALF * BK * 2  , STAGE_BYTES = 8 * HTB, NXCD = 8, WGM = 8;

__host__ __device__ __forceinline__ int lds_byte(int r, int c) { const int st = (r >> 4) * 2 + (c >> 5), rr = r & 15, cc = c & 31, ob = rr * 64 + cc * 2; return st * 1024 + (ob ^ (((ob >> 9) & 1) << 5)); }
__host__ __device__ __forceinline__ void stage_rc(int b, int& R, int& C) { const int st = b / 1024, sb = b % 1024, swz = sb ^ (((sb >> 9) & 1) << 5); R = (st >> 1) * 16 + swz / 64; C = (st & 1) * 32 + (swz % 64) / 2; }
__host__ __device__ __forceinline__ int perm32(int rho) { const int n = rho >> 4, i = rho & 15; return 8 * (i >> 2) + 4 * n + (i & 3); }

struct Unit { int pm, pn; };
struct Gemm { const bf16_t* A; const bf16_t* Bt; int M, N, K; };

struct StaticOrder {
    int nM, nN, nwg, G, c;
    __host__ __device__ void init(int M, int N, int G_, int c_) { nM = M / BM; nN = N / BM; nwg = nM * nN; G = G_; c = c_; }
    __host__ __device__ bool next(int i, Unit& u) const {
        const long L = (long)i * G + c; if (L >= nwg) return false;
        int wgid = (int)L; { const int q = nwg / NXCD, r = nwg % NXCD, xcd = wgid % NXCD, off = wgid / NXCD; wgid = (xcd < r ? xcd * (q + 1) : r * (q + 1) + (xcd - r) * q) + off; }
        const int nig = WGM * nN, gid = wgid / nig, fm = gid * WGM, gsz = (nM - fm) < WGM ? (nM - fm) : WGM;
        u.pm = fm + ((wgid % nig) % gsz); u.pn = (wgid % nig) / gsz; return true;
    }
    __device__ __forceinline__ void a_ready(const Unit&) const {}
    __device__ __forceinline__ void done(const Unit&) const {}
};

__device__ __forceinline__ unsigned cvt_pk_bf16(float lo, float hi) { unsigned r; asm volatile("v_cvt_pk_bf16_f32 %0, %1, %2" : "=v"(r) : "v"(lo), "v"(hi)); return r; }
template <class Epi, class Sched, bool ALIGN_EPI = false, bool SP2 = false>
__device__ __forceinline__ void gemm_phase(PG8_LAS unsigned char* lds, const Gemm g, const Sched& S, const Epi& E) {
    const int tid = threadIdx.x, wid = __builtin_amdgcn_readfirstlane(tid >> 6), lane = tid & 63, wr = wid >> 2, wc = wid & 3, fr = lane & 15, fq = lane >> 4;
    const int K = g.K, nt = K / BK;
    unsigned voffA[2], voffB[2];
#pragma unroll
    for (int i = 0; i < 2; ++i) { int R, C; stage_rc(tid * 16 + i * 8192, R, C); const int Rb = Epi::PERM ? ((R & ~31) + perm32(R & 31)) : R;
        voffA[i] = (unsigned)(R * K + C) * 2u; voffB[i] = (unsigned)(Rb * K + C) * 2u; }
    const size_t kstep = (size_t)(BK * 2);
    const size_t hstep = (size_t)HALF * K * 2;
    const size_t tstep = 2 * hstep;
    const unsigned ldsw = (unsigned)wid * 1024u;
    const int aoff = lds_byte(wr * 64 + fr, fq * 8), boff = lds_byte(wc * 32 + fr, fq * 8);
#define PG8_SA(b, h) (((b) * 2 + (h)) * HTB)
#define PG8_SB(b, h) ((4 + (b) * 2 + (h)) * HTB)
#define PG8_STAGE(bufoff, gbase, voff) do { _Pragma("unroll") for (int _i = 0; _i < 2; ++_i) \
        __builtin_amdgcn_global_load_lds((const unsigned*)((const char*)(gbase) + (voff)[_i]), (PG8_LAS unsigned*)(lds + (bufoff) + ldsw + _i * 8192), 16, 0, 0); } while (0)
#define PG8_LDA(dst, b, h) do { _Pragma("unroll") for (int m = 0; m < 4; ++m) _Pragma("unroll") for (int k = 0; k < 2; ++k) dst[m][k] = *(const PG8_LAS bf16x8*)(lds + PG8_SA(b, h) + aoff + m * 2048 + k * 1024); } while (0)
#define PG8_LDB(dst, b, h) do { _Pragma("unroll") for (int n = 0; n < 2; ++n) _Pragma("unroll") for (int k = 0; k < 2; ++k) dst[n][k] = *(const PG8_LAS bf16x8*)(lds + PG8_SB(b, h) + boff + n * 2048 + k * 1024); } while (0)
#define PG8_MMA(ai, bj, At, Bt) do { __builtin_amdgcn_s_setprio(1); _Pragma("unroll") for (int m = 0; m < 4; ++m) _Pragma("unroll") for (int n = 0; n < 2; ++n) _Pragma("unroll") for (int k = 0; k < 2; ++k) \
        acc[ai][bj][m][n] = __builtin_amdgcn_mfma_f32_16x16x32_bf16(Bt[n][k], At[m][k], acc[ai][bj][m][n], 0, 0, 0); __builtin_amdgcn_s_setprio(0); } while (0)
#define PG8_WAIT_V(n) asm volatile("s_waitcnt vmcnt(" #n ")" ::: "memory")
#define PG8_WAIT_L(n) asm volatile("s_waitcnt lgkmcnt(" #n ")" ::: "memory")
#define PG8_BAR __builtin_amdgcn_s_barrier()
#define PG8_SCHED __builtin_amdgcn_sched_barrier(0)
    Unit cur, nxt; int ui = 0;
    if (!S.next(0, cur)) return;
    f32x4 acc[2][2][4][2];
#pragma unroll
    for (int a = 0; a < 2; ++a)
#pragma unroll
        for (int b = 0; b < 2; ++b)
#pragma unroll
            for (int m = 0; m < 4; ++m)
#pragma unroll
                for (int n = 0; n < 2; ++n) acc[a][b][m][n] = (f32x4){0.f, 0.f, 0.f, 0.f};
    bf16x8 At[4][2], B0[2][2], B1[2][2];
    const char* cA = (const char*)g.A + (size_t)cur.pm * tstep; const char* cB = (const char*)g.Bt + (size_t)cur.pn * tstep;
    S.a_ready(cur);
    if constexpr (SP2) {
        PG8_STAGE(PG8_SB(0, 0), cB, voffB); PG8_STAGE(PG8_SB(0, 1), cB + hstep, voffB); PG8_STAGE(PG8_SA(0, 0), cA, voffA); PG8_STAGE(PG8_SA(0, 1), cA + hstep, voffA);
        if (wr == 1) PG8_BAR;
        PG8_WAIT_V(2); PG8_BAR;
        PG8_STAGE(PG8_SB(1, 0), cB + kstep, voffB); PG8_STAGE(PG8_SA(1, 0), cA + kstep, voffA); PG8_STAGE(PG8_SB(1, 1), cB + hstep + kstep, voffB);
        PG8_WAIT_V(6); PG8_BAR;
    } else {
        PG8_STAGE(PG8_SB(0, 0), cB, voffB); PG8_STAGE(PG8_SA(0, 0), cA, voffA); PG8_STAGE(PG8_SB(0, 1), cB + hstep, voffB); PG8_STAGE(PG8_SA(0, 1), cA + hstep, voffA);
        if (wr == 1) PG8_BAR;
        PG8_WAIT_V(4); PG8_BAR;
        PG8_STAGE(PG8_SB(1, 0), cB + kstep, voffB); PG8_STAGE(PG8_SA(1, 0), cA + kstep, voffA); PG8_STAGE(PG8_SB(1, 1), cB + hstep + kstep, voffB);
        PG8_WAIT_V(6); PG8_BAR;
    }
    for (;;) {
        const bool has_next = S.next(ui + 1, nxt);
        const char* nA = has_next ? (const char*)g.A + (size_t)nxt.pm * tstep : cA; const char* nB = has_next ? (const char*)g.Bt + (size_t)nxt.pn * tstep : cB;
        for (int t = 0; t < nt; t += 2) {
            const bool last = (t == nt - 2);
            const char* a1 = cA + (size_t)(t + 1) * kstep;
            const char* a2 = last ? nA : cA + (size_t)(t + 2) * kstep; const char* b2 = last ? nB : cB + (size_t)(t + 2) * kstep;
            const char* a3 = a2 + kstep; const char* b3 = b2 + kstep;
            if (last && has_next) S.a_ready(nxt);
            if constexpr (SP2) {
            PG8_LDB(B0, 0, 0); PG8_LDB(B1, 0, 1); PG8_SCHED; PG8_LDA(At, 0, 0); PG8_STAGE(PG8_SA(1, 1), a1 + hstep, voffA);
            PG8_WAIT_V(8); PG8_WAIT_L(0); PG8_BAR; PG8_MMA(0, 0, At, B0); PG8_MMA(0, 1, At, B1); PG8_BAR; PG8_SCHED;
            PG8_LDA(At, 0, 1); PG8_STAGE(PG8_SB(0, 0), b2, voffB); PG8_STAGE(PG8_SB(0, 1), b2 + hstep, voffB); PG8_STAGE(PG8_SA(0, 0), a2, voffA);
            PG8_WAIT_V(8); PG8_WAIT_L(0); PG8_BAR; PG8_MMA(1, 0, At, B0); PG8_MMA(1, 1, At, B1); PG8_BAR; PG8_SCHED;
            PG8_LDB(B0, 1, 0); PG8_LDB(B1, 1, 1); PG8_SCHED; PG8_LDA(At, 1, 0); PG8_STAGE(PG8_SA(0, 1), a2 + hstep, voffA);
            PG8_WAIT_V(8); PG8_WAIT_L(0); PG8_BAR; PG8_MMA(0, 0, At, B0); PG8_MMA(0, 1, At, B1); PG8_BAR; PG8_SCHED;
            PG8_LDA(At, 1, 1); PG8_STAGE(PG8_SB(1, 0), b3, voffB); PG8_STAGE(PG8_SB(1, 1), b3 + hstep, voffB); PG8_STAGE(PG8_SA(1, 0), a3, voffA);
            PG8_WAIT_V(8); PG8_WAIT_L(0); PG8_BAR; PG8_MMA(1, 0, At, B0); PG8_MMA(1, 1, At, B1); PG8_BAR; PG8_SCHED;
            } else {
            PG8_LDB(B0, 0, 0); PG8_SCHED; PG8_LDA(At, 0, 0); PG8_STAGE(PG8_SA(1, 1), a1 + hstep, voffA);
            PG8_WAIT_L(8); PG8_BAR; PG8_WAIT_L(0); PG8_MMA(0, 0, At, B0); PG8_BAR; PG8_SCHED;
            PG8_LDB(B1, 0, 1); PG8_STAGE(PG8_SB(0, 0), b2, voffB);
            PG8_BAR; PG8_WAIT_L(0); PG8_MMA(0, 1, At, B1); PG8_BAR;
            PG8_LDA(At, 0, 1); PG8_STAGE(PG8_SA(0, 0), a2, voffA);
            PG8_BAR; PG8_WAIT_L(0); PG8_MMA(1, 0, At, B0); PG8_BAR; PG8_SCHED;
            PG8_STAGE(PG8_SB(0, 1), b2 + hstep, voffB);
            PG8_WAIT_V(6); PG8_BAR; PG8_MMA(1, 1, At, B1); PG8_BAR;
            PG8_LDB(B0, 1, 0); PG8_SCHED; PG8_LDA(At, 1, 0); PG8_STAGE(PG8_SA(0, 1), a2 + hstep, voffA);
            PG8_WAIT_L(8); PG8_BAR; PG8_WAIT_L(0); PG8_MMA(0, 0, At, B0); PG8_BAR; PG8_SCHED;
            PG8_LDB(B1, 1, 1); PG8_STAGE(PG8_SB(1, 0), b3, voffB);
            PG8_BAR; PG8_WAIT_L(0); PG8_MMA(0, 1, At, B1); PG8_BAR;
            PG8_LDA(At, 1, 1); PG8_STAGE(PG8_SA(1, 0), a3, voffA);
            PG8_BAR; PG8_WAIT_L(0); PG8_MMA(1, 0, At, B0); PG8_BAR; PG8_SCHED;
            PG8_STAGE(PG8_SB(1, 1), b3 + hstep, voffB);
            PG8_WAIT_V(6); PG8_BAR; PG8_MMA(1, 1, At, B1); PG8_BAR;
            }
        }
        if constexpr (ALIGN_EPI) { if (wr == 0) PG8_BAR; }
        if constexpr (!Epi::AFTER_DRAIN) { E(acc, cur, wr, wc, fr, fq); S.done(cur); }
        if (!has_next) break;
#pragma unroll
        for (int a = 0; a < 2; ++a)
#pragma unroll
            for (int b = 0; b < 2; ++b)
#pragma unroll
                for (int m = 0; m < 4; ++m)
#pragma unroll
                    for (int n = 0; n < 2; ++n) acc[a][b][m][n] = (f32x4){0.f, 0.f, 0.f, 0.f};
        cur = nxt; cA = nA; cB = nB; ++ui;
        if constexpr (ALIGN_EPI) { if (wr == 1) PG8_BAR; }
    }
    PG8_WAIT_V(0);
    if constexpr (!ALIGN_EPI) { if (wr == 0) PG8_BAR; }
    PG8_BAR;
    if constexpr (Epi::AFTER_DRAIN) { E.fused(acc, cur, wr, wc, fr, fq, lds, wid, lane); S.done(cur); }
#undef PG8_SA
#undef PG8_SB
#undef PG8_STAGE
#undef PG8_LDA
#undef PG8_LDB
#undef PG8_MMA
#undef PG8_WAIT_V
#undef PG8_WAIT_L
#undef PG8_BAR
#undef PG8_SCHED
}
}
namespace pg8 {
template <class Epi, class Sched, bool ALIGN_EPI = false, bool SP2 = false>
__device__ __forceinline__ void gemm_phase_gather(PG8_LAS unsigned char* lds, const Gemm g, const Sched& S, const Epi& E, const int* __restrict__ idx) {
    const int tid = threadIdx.x, wid = __builtin_amdgcn_readfirstlane(tid >> 6), lane = tid & 63, wr = wid >> 2, wc = wid & 3, fr = lane & 15, fq = lane >> 4;
    const int K = g.K, nt = K / BK;
    unsigned voffB[2]; int RA[2], CA[2];
#pragma unroll
    for (int i = 0; i < 2; ++i) { int R, C; stage_rc(tid * 16 + i * 8192, R, C); const int Rb = Epi::PERM ? ((R & ~31) + perm32(R & 31)) : R;
        RA[i] = R; CA[i] = C; voffB[i] = (unsigned)(Rb * K + C) * 2u; }
    unsigned vA[2][2], nvA[2][2];
#define PG8_GOFF(dst, pm) do { _Pragma("unroll") for (int _h = 0; _h < 2; ++_h) _Pragma("unroll") for (int _i = 0; _i < 2; ++_i) { const int _r = (pm) * 256 + _h * 128 + RA[_i]; \
        dst[_h][_i] = (unsigned)((((_r >> 9) & 3) * 4096 + idx[_r]) * K + CA[_i]) * 2u; } } while (0)
    const size_t kstep = (size_t)(BK * 2);
    const size_t hstep = (size_t)HALF * K * 2;
    const size_t tstep = 2 * hstep;
    const unsigned ldsw = (unsigned)wid * 1024u;
    const int aoff = lds_byte(wr * 64 + fr, fq * 8), boff = lds_byte(wc * 32 + fr, fq * 8);
#define PG8_SA(b, h) (((b) * 2 + (h)) * HTB)
#define PG8_SB(b, h) ((4 + (b) * 2 + (h)) * HTB)
#define PG8_STAGE(bufoff, gbase, voff) do { _Pragma("unroll") for (int _i = 0; _i < 2; ++_i) \
        __builtin_amdgcn_global_load_lds((const unsigned*)((const char*)(gbase) + (voff)[_i]), (PG8_LAS unsigned*)(lds + (bufoff) + ldsw + _i * 8192), 16, 0, 0); } while (0)
#define PG8_LDA(dst, b, h) do { _Pragma("unroll") for (int m = 0; m < 4; ++m) _Pragma("unroll") for (int k = 0; k < 2; ++k) dst[m][k] = *(const PG8_LAS bf16x8*)(lds + PG8_SA(b, h) + aoff + m * 2048 + k * 1024); } while (0)
#define PG8_LDB(dst, b, h) do { _Pragma("unroll") for (int n = 0; n < 2; ++n) _Pragma("unroll") for (int k = 0; k < 2; ++k) dst[n][k] = *(const PG8_LAS bf16x8*)(lds + PG8_SB(b, h) + boff + n * 2048 + k * 1024); } while (0)
#define PG8_MMA(ai, bj, At, Bt) do { __builtin_amdgcn_s_setprio(1); _Pragma("unroll") for (int m = 0; m < 4; ++m) _Pragma("unroll") for (int n = 0; n < 2; ++n) _Pragma("unroll") for (int k = 0; k < 2; ++k) \
        acc[ai][bj][m][n] = __builtin_amdgcn_mfma_f32_16x16x32_bf16(Bt[n][k], At[m][k], acc[ai][bj][m][n], 0, 0, 0); __builtin_amdgcn_s_setprio(0); } while (0)
#define PG8_WAIT_V(n) asm volatile("s_waitcnt vmcnt(" #n ")" ::: "memory")
#define PG8_WAIT_L(n) asm volatile("s_waitcnt lgkmcnt(" #n ")" ::: "memory")
#define PG8_BAR __builtin_amdgcn_s_barrier()
#define PG8_SCHED __builtin_amdgcn_sched_barrier(0)
    Unit cur, nxt; int ui = 0;
    if (!S.next(0, cur)) return;
    f32x4 acc[2][2][4][2];
#pragma unroll
    for (int a = 0; a < 2; ++a)
#pragma unroll
        for (int b = 0; b < 2; ++b)
#pragma unroll
            for (int m = 0; m < 4; ++m)
#pragma unroll
                for (int n = 0; n < 2; ++n) acc[a][b][m][n] = (f32x4){0.f, 0.f, 0.f, 0.f};
    bf16x8 At[4][2], B0[2][2], B1[2][2];
    const char* cA = (const char*)g.A; PG8_GOFF(vA, cur.pm); const char* cB = (const char*)g.Bt + (size_t)cur.pn * tstep;
    S.a_ready(cur);
    if constexpr (SP2) {
        PG8_STAGE(PG8_SB(0, 0), cB, voffB); PG8_STAGE(PG8_SB(0, 1), cB + hstep, voffB); PG8_STAGE(PG8_SA(0, 0), cA, vA[0]); PG8_STAGE(PG8_SA(0, 1), cA, vA[1]);
        if (wr == 1) PG8_BAR;
        PG8_WAIT_V(2); PG8_BAR;
        PG8_STAGE(PG8_SB(1, 0), cB + kstep, voffB); PG8_STAGE(PG8_SA(1, 0), cA + kstep, vA[0]); PG8_STAGE(PG8_SB(1, 1), cB + hstep + kstep, voffB);
        PG8_WAIT_V(6); PG8_BAR;
    } else {
        PG8_STAGE(PG8_SB(0, 0), cB, voffB); PG8_STAGE(PG8_SA(0, 0), cA, vA[0]); PG8_STAGE(PG8_SB(0, 1), cB + hstep, voffB); PG8_STAGE(PG8_SA(0, 1), cA, vA[1]);
        if (wr == 1) PG8_BAR;
        PG8_WAIT_V(4); PG8_BAR;
        PG8_STAGE(PG8_SB(1, 0), cB + kstep, voffB); PG8_STAGE(PG8_SA(1, 0), cA + kstep, vA[0]); PG8_STAGE(PG8_SB(1, 1), cB + hstep + kstep, voffB);
        PG8_WAIT_V(6); PG8_BAR;
    }
    for (;;) {
        const bool has_next = S.next(ui + 1, nxt);
        if (has_next) { PG8_GOFF(nvA, nxt.pm); } else { nvA[0][0] = vA[0][0]; nvA[0][1] = vA[0][1]; nvA[1][0] = vA[1][0]; nvA[1][1] = vA[1][1]; } const char* nB = has_next ? (const char*)g.Bt + (size_t)nxt.pn * tstep : cB;
        for (int t = 0; t < nt; t += 2) {
            const bool last = (t == nt - 2);
            const char* a1 = cA + (size_t)(t + 1) * kstep;
            const char* a2 = cA + (last ? (size_t)0 : (size_t)(t + 2) * kstep); unsigned w2[2][2]; w2[0][0] = last ? nvA[0][0] : vA[0][0]; w2[0][1] = last ? nvA[0][1] : vA[0][1]; w2[1][0] = last ? nvA[1][0] : vA[1][0]; w2[1][1] = last ? nvA[1][1] : vA[1][1]; const char* b2 = last ? nB : cB + (size_t)(t + 2) * kstep;
            const char* a3 = a2 + kstep; const char* b3 = b2 + kstep;
            if (last && has_next) S.a_ready(nxt);
            if constexpr (SP2) {
            PG8_LDB(B0, 0, 0); PG8_LDB(B1, 0, 1); PG8_SCHED; PG8_LDA(At, 0, 0); PG8_STAGE(PG8_SA(1, 1), a1, vA[1]);
            PG8_WAIT_V(8); PG8_WAIT_L(0); PG8_BAR; PG8_MMA(0, 0, At, B0); PG8_MMA(0, 1, At, B1); PG8_BAR; PG8_SCHED;
            PG8_LDA(At, 0, 1); PG8_STAGE(PG8_SB(0, 0), b2, voffB); PG8_STAGE(PG8_SB(0, 1), b2 + hstep, voffB); PG8_STAGE(PG8_SA(0, 0), a2, w2[0]);
            PG8_WAIT_V(8); PG8_WAIT_L(0); PG8_BAR; PG8_MMA(1, 0, At, B0); PG8_MMA(1, 1, At, B1); PG8_BAR; PG8_SCHED;
            PG8_LDB(B0, 1, 0); PG8_LDB(B1, 1, 1); PG8_SCHED; PG8_LDA(At, 1, 0); PG8_STAGE(PG8_SA(0, 1), a2, w2[1]);
            PG8_WAIT_V(8); PG8_WAIT_L(0); PG8_BAR; PG8_MMA(0, 0, At, B0); PG8_MMA(0, 1, At, B1); PG8_BAR; PG8_SCHED;
            PG8_LDA(At, 1, 1); PG8_STAGE(PG8_SB(1, 0), b3, voffB); PG8_STAGE(PG8_SB(1, 1), b3 + hstep, voffB); PG8_STAGE(PG8_SA(1, 0), a3, w2[0]);
            PG8_WAIT_V(8); PG8_WAIT_L(0); PG8_BAR; PG8_MMA(1, 0, At, B0); PG8_MMA(1, 1, At, B1); PG8_BAR; PG8_SCHED;
            } else {
            PG8_LDB(B0, 0, 0); PG8_SCHED; PG8_LDA(At, 0, 0); PG8_STAGE(PG8_SA(1, 1), a1, vA[1]);
            PG8_WAIT_L(8); PG8_BAR; PG8_WAIT_L(0); PG8_MMA(0, 0, At, B0); PG8_BAR; PG8_SCHED;
            PG8_LDB(B1, 0, 1); PG8_STAGE(PG8_SB(0, 0), b2, voffB);
            PG8_BAR; PG8_WAIT_L(0); PG8_MMA(0, 1, At, B1); PG8_BAR;
            PG8_LDA(At, 0, 1); PG8_STAGE(PG8_SA(0, 0), a2, w2[0]);
            PG8_BAR; PG8_WAIT_L(0); PG8_MMA(1, 0, At, B0); PG8_BAR; PG8_SCHED;
            PG8_STAGE(PG8_SB(0, 1), b2 + hstep, voffB);
            PG8_WAIT_V(6); PG8_BAR; PG8_MMA(1, 1, At, B1); PG8_BAR;
            PG8_LDB(B0, 1, 0); PG8_SCHED; PG8_LDA(At, 1, 0); PG8_STAGE(PG8_SA(0, 1), a2, w2[1]);
            PG8_WAIT_L(8); PG8_BAR; PG8_WAIT_L(0); PG8_MMA(0, 0, At, B0); PG8_BAR; PG8_SCHED;
            PG8_LDB(B1, 1, 1); PG8_STAGE(PG8_SB(1, 0), b3, voffB);
            PG8_BAR; PG8_WAIT_L(0); PG8_MMA(0, 1, At, B1); PG8_BAR;
            PG8_LDA(At, 1, 1); PG8_STAGE(PG8_SA(1, 0), a3, w2[0]);
            PG8_BAR; PG8_WAIT_L(0); PG8_MMA(1, 0, At, B0); PG8_BAR; PG8_SCHED;
            PG8_STAGE(PG8_SB(1, 1), b3 + hstep, voffB);
            PG8_WAIT_V(6); PG8_BAR; PG8_MMA(1, 1, At, B1); PG8_BAR;
            }
        }
        if constexpr (ALIGN_EPI) { if (wr == 0) PG8_BAR; }
        if constexpr (!Epi::AFTER_DRAIN) { E(acc, cur, wr, wc, fr, fq); S.done(cur); }
        if (!has_next) break;
#pragma unroll
        for (int a = 0; a < 2; ++a)
#pragma unroll
            for (int b = 0; b < 2; ++b)
#pragma unroll
                for (int m = 0; m < 4; ++m)
#pragma unroll
                    for (int n = 0; n < 2; ++n) acc[a][b][m][n] = (f32x4){0.f, 0.f, 0.f, 0.f};
        cur = nxt; cB = nB; ++ui; vA[0][0] = nvA[0][0]; vA[0][1] = nvA[0][1]; vA[1][0] = nvA[1][0]; vA[1][1] = nvA[1][1];
        if constexpr (ALIGN_EPI) { if (wr == 1) PG8_BAR; }
    }
    PG8_WAIT_V(0);
    if constexpr (!ALIGN_EPI) { if (wr == 0) PG8_BAR; }
    PG8_BAR;
    if constexpr (Epi::AFTER_DRAIN) { E.fused(acc, cur, wr, wc, fr, fq, lds, wid, lane); S.done(cur); }
#undef PG8_SA
#undef PG8_SB
#undef PG8_STAGE
#undef PG8_LDA
#undef PG8_LDB
#undef PG8_MMA
#undef PG8_WAIT_V
#undef PG8_WAIT_L
#undef PG8_BAR
#undef PG8_SCHED
#undef PG8_GOFF
}
}

#ifndef DBG_NOMIX
#define DBG_NOMIX 0
#endif
#ifndef DBG_NOMOE
#define DBG_NOMOE 0
#endif
#ifndef DBG_NOPOS
#define DBG_NOPOS 0
#endif
#ifndef DBG_HTCONST
#define DBG_HTCONST 0
#endif
#ifndef DBG_GLA_K
#define DBG_GLA_K 1.0f
#endif
#ifndef DBG_MOE_K
#define DBG_MOE_K 1.0f
#endif
#ifndef MK_SINGLE
#define MK_SINGLE 0
#endif
#define GAS __attribute__((address_space(1)))
#define LAS __attribute__((address_space(3)))
typedef unsigned short bf16;
typedef float f32x4 __attribute__((ext_vector_type(4)));
typedef float f32x16 __attribute__((ext_vector_type(16)));
typedef short bf16x8 __attribute__((ext_vector_type(8)));
typedef unsigned v4u __attribute__((ext_vector_type(4)));
typedef unsigned v2u __attribute__((ext_vector_type(2)));
typedef GAS unsigned gu32;

constexpr int NWAVES = 8, NTHR = 512;
constexpr int NB = 4, SEQ = 4096, DM = 1024, CTXL = 256;
constexpr int MX = NB * SEQ, MC = NB * CTXL, MT = MX + MC;
constexpr int NIN = 3328, NQ = 1536, DIN = 3104;
constexpr int NE = 16, CAP = 512;
constexpr int NCH = 68;
constexpr int NPH = 12;
constexpr float EPS = 1e-6f;

constexpr size_t MiB = 1u << 20;
constexpr size_t WS_CTL = 0, CTL_BYTES = 65536;
constexpr int CW_CNT_D = 8192, CW_CNT_GU = 8192 + 64;
constexpr size_t WS_MOD = 1 * MiB, WS_POS = 1 * MiB + 256 * 1024, WS_DEC = 2 * MiB, WS_AFF = 3 * MiB, WS_SLOT = 4 * MiB, WS_SELT = 5 * MiB, WS_SELV = 5 * MiB + 256 * 1024;
constexpr size_t WS_UCTX = 6 * MiB, WS_AFB = 10 * MiB, WS_WIN = 13 * MiB, WS_WOUT = 20 * MiB;
constexpr size_t WS_R1 = 22 * MiB, WS_R2 = 56 * MiB, WS_R3 = 107 * MiB, WS_R4 = 203 * MiB, WS_R5 = 235 * MiB, WS_R6 = 267 * MiB, WS_END = 299 * MiB;
constexpr size_t WS_AIN = WS_R1, WS_ZT = 155 * MiB, WS_HN = WS_R1;
constexpr size_t WS_QKVG = WS_R2;
constexpr size_t WS_HYT = WS_R3, WS_WD = 171 * MiB;
constexpr size_t WS_WGU = WS_R5;
constexpr size_t WS_HID = WS_R2, WS_YSLAB = WS_R4;
constexpr size_t WS_HT = WS_R4, WS_AOUT = WS_R4;
constexpr size_t WS_SPREV = WS_R5, WS_YHYT = WS_R6;
constexpr int LDS_BYTES = 144 * 1024;
constexpr int LDS_MISC = LDS_BYTES - 256;

struct Args { const float* in[29]; float* out; unsigned char* ws; int ph_lo, ph_hi; };

#define LDS_WAIT() asm volatile("s_waitcnt lgkmcnt(0)" ::: "memory")
#define VM_WAIT() asm volatile("s_waitcnt vmcnt(0)" ::: "memory")
__device__ __forceinline__ unsigned f2bf(float f) { unsigned u = __float_as_uint(f); return (u + 0x7fffu + ((u >> 16) & 1u)) >> 16; }
__device__ __forceinline__ unsigned pk2(float lo, float hi) { return pg8::cvt_pk_bf16(lo, hi); }
__device__ __forceinline__ float bflo(unsigned w) { return __uint_as_float(w << 16); }
__device__ __forceinline__ float bfhi(unsigned w) { return __uint_as_float(w & 0xffff0000u); }
__device__ __forceinline__ float wave_sum(float v) {
#pragma unroll
    for (int o = 1; o < 64; o <<= 1) v += __shfl_xor(v, o);
    return v;
}
__device__ __forceinline__ float silu_f(float v) { return v * __builtin_amdgcn_rcpf(1.f + __expf(-v)); }
__device__ __forceinline__ float logsig_f(float x) { return fminf(x, 0.f) - __logf(1.0f + __expf(-fabsf(x))); }

#define XB_TMO      128
#define XB_XCNT(j)  (256  + 64 * (j))
#define XB_XSUB(j)  (1280 + 64 * (j))
#define XB_XGEN(j)  (2304 + 64 * (j))
#define XB_TOP      3328
#define XB_TOPGEN   3392
#define XCD_BAR_WORDS 3456
#define XB_SPIN_CAP (1u << 22)
__device__ __forceinline__ unsigned xb_ld(unsigned* p)              { return __hip_atomic_load(p, __ATOMIC_RELAXED, __HIP_MEMORY_SCOPE_AGENT); }
__device__ __forceinline__ unsigned xb_add(unsigned* p, unsigned v) { return __hip_atomic_fetch_add(p, v, __ATOMIC_RELAXED, __HIP_MEMORY_SCOPE_AGENT); }
__device__ __forceinline__ unsigned xb_xcc_id() { return (unsigned)__builtin_amdgcn_s_getreg((3 << 11) | 20) & 0xFu; }
#define XB_SPIN(cond, bar) do { unsigned _sp = 0; while (cond) { __builtin_amdgcn_s_sleep(1); \
    if ((++_sp & 255u) == 0u) { if (xb_ld(&(bar)[XB_TMO])) break; if (_sp > XB_SPIN_CAP) { atomicAdd(&(bar)[XB_TMO], 1u); break; } } } } while (0)
struct XcdBarrier { unsigned* bar; unsigned x; volatile LAS unsigned* st; };
__device__ __forceinline__ XcdBarrier xcd_barrier_post(unsigned* bar, volatile LAS unsigned* st) {
    XcdBarrier b; b.bar = bar; b.x = xb_xcc_id(); b.st = st;
    if (threadIdx.x == 0) (void)xb_add(&bar[XB_XCNT(b.x)], 1u);
    return b;
}
__device__ __forceinline__ void xcd_barrier_complete(unsigned* bar, unsigned x, unsigned& nloc, unsigned& nx) {
    const unsigned G = gridDim.x * gridDim.y * gridDim.z;
    unsigned sum, cnt, mine, sp = 0u;
    for (;;) {
        sum = 0u; cnt = 0u; mine = 0u;
#pragma unroll
        for (unsigned j = 0; j < 16; ++j) { const unsigned c = xb_ld(&bar[XB_XCNT(j)]); sum += c; cnt += (c > 0u) ? 1u : 0u; mine = (j == x) ? c : mine; }
        if (sum == G) break;
        __builtin_amdgcn_s_sleep(1);
        if ((++sp & 255u) == 0u) { if (xb_ld(&bar[XB_TMO])) break; if (sp > XB_SPIN_CAP) { atomicAdd(&bar[XB_TMO], 1u); break; } }
    }
    nloc = mine > 0u ? mine : 1u; nx = cnt > 0u ? cnt : 1u;
}
__device__ __forceinline__ void xcd_barrier(const XcdBarrier& b) {
    asm volatile("s_waitcnt vmcnt(0)" ::: "memory");
    __syncthreads();
    if (threadIdx.x == 0) {
        unsigned* bar = b.bar;
        __builtin_amdgcn_s_waitcnt(0);
        unsigned nloc = b.st[0], nx = b.st[1];
        if (nloc == 0u) { xcd_barrier_complete(bar, b.x, nloc, nx); b.st[0] = nloc; b.st[1] = nx; }
        const unsigned old = xb_add(&bar[XB_XSUB(b.x)], 1u);
        const unsigned gen = old / nloc;
        if (old + 1u == (gen + 1u) * nloc) {
            __builtin_amdgcn_fence(__ATOMIC_RELEASE, "agent");
            asm volatile("s_waitcnt vmcnt(0)" ::: "memory");
            const unsigned og = xb_add(&bar[XB_TOP], 1u);
            const unsigned tg = og / nx;
            if (og + 1u == (tg + 1u) * nx) xb_add(&bar[XB_TOPGEN], 1u);
            else XB_SPIN(xb_ld(&bar[XB_TOPGEN]) == tg, bar);
            __builtin_amdgcn_fence(__ATOMIC_ACQUIRE, "agent");
            xb_add(&bar[XB_XGEN(b.x)], 1u);
            asm volatile("s_waitcnt vmcnt(0)" ::: "memory");
        } else {
            XB_SPIN(xb_ld(&bar[XB_XGEN(b.x)]) == gen, bar);
            __builtin_amdgcn_fence(__ATOMIC_ACQUIRE, "agent");
            asm volatile("s_waitcnt vmcnt(0)" ::: "memory");
        }
    }
    __syncthreads();
}

constexpr int TILE_AIN = (int)(WS_AIN / (512 * 1024)), TILE_WIN = (int)(WS_WIN / (512 * 1024));
struct InSched {
    int G, c, part;
    __device__ void init(int G_, int c_, int part_) { G = G_; c = c_; part = part_; }
    __device__ static void qg_unit(int qg, pg8::Unit& u) { const int t = qg >> 6; u.pm = TILE_AIN + (qg & 63); u.pn = TILE_WIN + ((t == 0) ? 0 : 3 + t); }
    __device__ bool next(int i, pg8::Unit& u) const {
        const int L = i * G + c;
        if (part) { const int qg = 112 + L; if (qg >= 192) return false; qg_unit(qg, u); return true; }
        if (L < 384) { u.pm = TILE_WIN + 6 + (L >> 6); u.pn = TILE_AIN + (L & 63); return true; }
        if (L < 640) { const int l = L - 384, q = l >> 6; u.pm = TILE_AIN + (l & 63); u.pn = TILE_WIN + ((q == 3) ? 12 : (1 + q)); return true; }
        if (L < 656) { const int jx = L - 640, q = jx >> 2; u.pm = TILE_AIN + 64 + (jx & 3); u.pn = TILE_WIN + ((q == 3) ? 12 : (1 + q)); return true; }
        if (L >= 768) return false;
        qg_unit(L - 656, u); return true;
    }
    __device__ __forceinline__ void a_ready(const pg8::Unit&) const {}
    __device__ __forceinline__ void done(const pg8::Unit&) const {}
};
template <int NT> struct MoeSched {
    int G, c;
    __device__ void init(int G_, int c_) { G = G_; c = c_; }
    __device__ bool next(int i, pg8::Unit& u) const {
        const int L = i * G + c; if (L >= NE * 8 * NT) return false;
        const int e = L / (8 * NT), l = L % (8 * NT), x = l & 7, y = l >> 3;
        constexpr int HN = NT / 2;
        const int pm = 2 * (x >> 1) + (y / HN), pn = HN * (x & 1) + (y % HN);
        u.pm = e * 8 + pm; u.pn = e * NT + pn; return true;
    }
    __device__ __forceinline__ void a_ready(const pg8::Unit&) const {}
    __device__ __forceinline__ void done(const pg8::Unit&) const {}
};

struct EpiIn {
    static constexpr bool PERM = true, AFTER_DRAIN = false;
    bf16* qkvg; bf16* hyT; float* afb;
    __device__ __forceinline__ void operator()(const f32x4 (&acc)[2][2][4][2], const pg8::Unit& u, int wr, int wc, int fr, int fq) const {
        if (u.pm < TILE_AIN) {
            const int ch0 = (u.pm - TILE_WIN - 6) * 256 + wr * 64 + fr, mt = u.pn - TILE_AIN, b = mt >> 4, t0 = (mt & 15) * 256 + wc * 32 + 8 * fq;
#pragma unroll
            for (int ai = 0; ai < 2; ++ai)
#pragma unroll
                for (int m = 0; m < 4; ++m) { bf16* rowp = hyT + ((size_t)b * 1536 + ch0 + ai * 128 + m * 16) * SEQ + t0;
#pragma unroll
                    for (int bj = 0; bj < 2; ++bj) { const f32x4 v0 = acc[ai][bj][m][0], v1 = acc[ai][bj][m][1];
                        v4u w; w.x = pk2(v0[0], v0[1]); w.y = pk2(v0[2], v0[3]); w.z = pk2(v1[0], v1[1]); w.w = pk2(v1[2], v1[3]);
                        *(v4u*)(rowp + bj * 128) = w; } }
            return;
        }
        const int pm = u.pm - TILE_AIN, pn = u.pn - TILE_WIN;
        const int row0 = pm * 256 + wr * 64 + fr;
        if (pn < 6) {
            const float sc = (pn == 0) ? 0.125f : 1.f;
            const int col0 = pn * 256 + wc * 32 + 8 * fq;
#pragma unroll
            for (int ai = 0; ai < 2; ++ai)
#pragma unroll
                for (int m = 0; m < 4; ++m) { bf16* rowp = qkvg + (size_t)(row0 + ai * 128 + m * 16) * NQ + col0;
#pragma unroll
                    for (int bj = 0; bj < 2; ++bj) { const f32x4 v0 = acc[ai][bj][m][0] * sc, v1 = acc[ai][bj][m][1] * sc;
                        v4u w; w.x = pk2(v0[0], v0[1]); w.y = pk2(v0[2], v0[3]); w.z = pk2(v1[0], v1[1]); w.w = pk2(v1[2], v1[3]);
                        *(v4u*)(rowp + bj * 128) = w; } }
        } else {
            if (wc != 0) return;
#pragma unroll
            for (int ai = 0; ai < 2; ++ai)
#pragma unroll
                for (int m = 0; m < 4; ++m) { float* rowp = afb + (size_t)(row0 + ai * 128 + m * 16) * 32 + 8 * fq;
                    *(f32x4*)(rowp) = acc[ai][0][m][0]; *(f32x4*)(rowp + 4) = acc[ai][0][m][1]; }
        }
    }
};
struct EpiOut {
    static constexpr bool PERM = false, AFTER_DRAIN = false;
    const float* __restrict__ x; const float* __restrict__ postab; const float* __restrict__ modr; float* __restrict__ x1;
    __device__ __forceinline__ void operator()(const f32x4 (&acc)[2][2][4][2], const pg8::Unit& u, int wr, int wc, int fr, int fq) const {
        const int row0 = u.pm * 256 + wr * 64 + fr, col0 = u.pn * 256 + wc * 32 + 4 * fq;
        const int b = row0 >> 12;
        f32x4 gv[2][2];
#pragma unroll
        for (int bj = 0; bj < 2; ++bj)
#pragma unroll
            for (int n = 0; n < 2; ++n) gv[bj][n] = *(const f32x4*)(modr + b * 6144 + 2048 + col0 + bj * 128 + n * 16);
#pragma unroll
        for (int ai = 0; ai < 2; ++ai)
#pragma unroll
            for (int m = 0; m < 4; ++m) { const int r = row0 + ai * 128 + m * 16; const int t = r & 4095, rr = t >> 6, cc = t & 63;
                f32x4 xv[2][2], pv[2][2];
#pragma unroll
                for (int bj = 0; bj < 2; ++bj)
#pragma unroll
                    for (int n = 0; n < 2; ++n) { const int c = col0 + bj * 128 + n * 16;
                        xv[bj][n] = *(const f32x4*)(x + (size_t)r * DM + c);
                        pv[bj][n] = *(const f32x4*)(postab + ((c < 512) ? rr * 512 + c : cc * 512 + c - 512)); }
#pragma unroll
                for (int bj = 0; bj < 2; ++bj)
#pragma unroll
                    for (int n = 0; n < 2; ++n) { const int c = col0 + bj * 128 + n * 16;
                        *(f32x4*)(x1 + (size_t)r * DM + c) = xv[bj][n] + (DBG_NOPOS ? pv[bj][n] * 0.f : pv[bj][n]) + (DBG_NOMIX ? gv[bj][n] * 0.f : gv[bj][n] * acc[ai][bj][m][n]); } }
    }
};
struct EpiGU {
    static constexpr bool PERM = true, AFTER_DRAIN = false;
    bf16* hid;
    __device__ __forceinline__ void operator()(const f32x4 (&acc)[2][2][4][2], const pg8::Unit& u, int wr, int wc, int fr, int fq) const {
        const int row0 = u.pm * 256 + wr * 64 + fr, col0 = (u.pn & 7) * 128 + wc * 32 + 8 * fq;
#pragma unroll
        for (int ai = 0; ai < 2; ++ai)
#pragma unroll
            for (int m = 0; m < 4; ++m) { bf16* rowp = hid + (size_t)(row0 + ai * 128 + m * 16) * DM + col0;
                float o[8];
#pragma unroll
                for (int n = 0; n < 2; ++n)
#pragma unroll
                    for (int j = 0; j < 4; ++j) o[n * 4 + j] = silu_f(acc[ai][0][m][n][j]) * acc[ai][1][m][n][j];
                v4u w; w.x = pk2(o[0], o[1]); w.y = pk2(o[2], o[3]); w.z = pk2(o[4], o[5]); w.w = pk2(o[6], o[7]);
                *(v4u*)rowp = w; }
    }
};
struct EpiDown {
    static constexpr bool PERM = true, AFTER_DRAIN = false;
    bf16* __restrict__ ys; const float* __restrict__ selv;
    __device__ __forceinline__ void operator()(const f32x4 (&acc)[2][2][4][2], const pg8::Unit& u, int wr, int wc, int fr, int fq) const {
        const int row0 = u.pm * 256 + wr * 64 + fr, col0 = (u.pn & 3) * 256 + wc * 32 + 8 * fq;
        float scv[2][4];
#pragma unroll
        for (int ai = 0; ai < 2; ++ai)
#pragma unroll
            for (int m = 0; m < 4; ++m) scv[ai][m] = selv[row0 + ai * 128 + m * 16];
#pragma unroll
        for (int ai = 0; ai < 2; ++ai)
#pragma unroll
            for (int m = 0; m < 4; ++m) { const int r = row0 + ai * 128 + m * 16; const float sc = scv[ai][m]; bf16* rowp = ys + (size_t)r * DM + col0;
#pragma unroll
                for (int bj = 0; bj < 2; ++bj) { const f32x4 v0 = acc[ai][bj][m][0] * sc, v1 = acc[ai][bj][m][1] * sc;
                    v4u w; w.x = pk2(v0[0], v0[1]); w.y = pk2(v0[2], v0[3]); w.z = pk2(v1[0], v1[1]); w.w = pk2(v1[2], v1[3]);
                    *(v4u*)(rowp + bj * 128) = w; } }
    }
};

__device__ __forceinline__ void transpose_item(const float* W, int ldw, int k0, int nsrc0, bf16* WT, int K, int drow0, LAS float* scr, int lane, bool zero) {
    float tv[32];
#pragma unroll
    for (int i = 0; i < 32; ++i) { const int kk = 2 * i + (lane >> 5); tv[i] = zero ? 0.f : W[(size_t)(k0 + kk) * ldw + nsrc0 + (lane & 31)]; }
#pragma unroll
    for (int i = 0; i < 32; ++i) { const int kk = 2 * i + (lane >> 5); scr[kk * 33 + (lane & 31)] = tv[i]; }
    LDS_WAIT();
    const int c = lane & 7;
#pragma unroll
    for (int j = 0; j < 4; ++j) { const int n = (lane >> 3) + 8 * j; const LAS float* s = scr + (8 * c) * 33 + n;
        v4u o; o.x = pk2(s[0 * 33], s[1 * 33]); o.y = pk2(s[2 * 33], s[3 * 33]); o.z = pk2(s[4 * 33], s[5 * 33]); o.w = pk2(s[6 * 33], s[7 * 33]);
        *(v4u*)(WT + (size_t)(drow0 + n) * K + k0 + 8 * c) = o; }
    LDS_WAIT();
}

__device__ __forceinline__ void phase0(const Args& a, LAS unsigned char* lds) {
    int tid = threadIdx.x; const int wg = blockIdx.x, G = gridDim.x;
    asm volatile("" : "+v"(tid));
    int lane = tid & 63, wave = tid >> 6;
    unsigned char* ws = a.ws;
    for (int it = wg; it < 192; it += G) {
        LAS float* sl = (LAS float*)lds;
        LAS float* red = (LAS float*)(lds + 20480);
        for (int i = tid; i < 5 * 1024; i += NTHR) { const int bb = i >> 10, k = i & 1023; const float v = (bb < 4) ? a.in[1][bb * 1024 + k] : a.in[3][k]; sl[i] = silu_f(v); }
        __syncthreads();
        const int col = it * 32 + (lane & 31), kk = wave * 2 + (lane >> 5);
        float acc[5] = {0.f, 0.f, 0.f, 0.f, 0.f};
        const float* wp = a.in[4] + col;
        float wv[64];
#pragma unroll
        for (int j = 0; j < 64; ++j) wv[j] = wp[(size_t)(kk + 16 * j) * 6144];
#pragma unroll
        for (int j = 0; j < 64; ++j) { const int k = kk + 16 * j;
#pragma unroll
            for (int bb = 0; bb < 5; ++bb) acc[bb] += sl[bb * 1024 + k] * wv[j]; }
#pragma unroll
        for (int bb = 0; bb < 5; ++bb) red[(kk * 5 + bb) * 32 + (lane & 31)] = acc[bb];
        __syncthreads();
        if (tid < 160) { const int bb = tid >> 5, cl = tid & 31; float s = 0.f;
#pragma unroll
            for (int q = 0; q < 16; ++q) s += red[(q * 5 + bb) * 32 + cl];
            ((float*)(ws + WS_MOD))[bb * 6144 + it * 32 + cl] = s + a.in[5][it * 32 + cl]; }
        __syncthreads();
    }
    for (int it = wg; it < 256; it += G) {
        asm volatile("" : "+v"(tid));
        LAS float* zl = (LAS float*)lds;
        LAS float* h1 = (LAS float*)(lds + 4096);
        LAS float* h2 = (LAS float*)(lds + 8192);
        const int i0 = it * 16;
        LAS float* w1l = (LAS float*)(lds + 12288);
        LAS float* w2l = (LAS float*)(lds + 12288 + 8448);
        for (int o = tid; o < 33 * 64; o += NTHR) w1l[o] = a.in[15][o];
        for (int o = tid; o < 64 * 64; o += NTHR) w2l[o] = a.in[17][o];
        for (int o = tid; o < 16 * 33; o += NTHR) { const int li = o / 33, j = o % 33; const int i = i0 + li;
            const float ti = (float)i * (1.0f / 4095.0f);
            const float wi = (6.2831855f * (float)i) / 4096.0f;
            float v;
            if (j == 0) v = ti;
            else { const int jj = (j - 1) & 15; const float f = 1e-4f + (float)jj * ((15.0f - 1e-4f) / 15.0f); const float ar = f * wi; v = (j <= 16) ? cosf(ar) : -sinf(ar); }
            zl[li * 36 + j] = v; }
        __syncthreads();
#pragma unroll
        for (int q = 0; q < 2; ++q) { const int o = tid + NTHR * q, li = o >> 6, m = o & 63; float s = a.in[16][m];
#pragma unroll
            for (int j = 0; j < 33; ++j) s += zl[li * 36 + j] * w1l[j * 64 + m];
            h1[li * 64 + m] = sinf(a.in[20][m] * s); }
        __syncthreads();
#pragma unroll
        for (int q = 0; q < 2; ++q) { const int o = tid + NTHR * q, li = o >> 6, m = o & 63; float s = a.in[18][m];
#pragma unroll 16
            for (int k = 0; k < 64; ++k) s += h1[li * 64 + k] * w2l[k * 64 + m];
            h2[li * 64 + m] = sinf(a.in[20][m] * s); }
        __syncthreads();
        f32x4 acc[16];
#pragma unroll
        for (int li = 0; li < 16; ++li) acc[li] = (f32x4){0.f, 0.f, 0.f, 0.f};
        const float* w3 = a.in[19] + tid * 4;
#pragma nounroll
        for (int k0 = 0; k0 < 64; k0 += 16) { f32x4 w[16];
#pragma unroll
            for (int kk = 0; kk < 16; ++kk) w[kk] = *(const f32x4*)(w3 + (k0 + kk) * 2048);
#pragma unroll
            for (int kk = 0; kk < 16; ++kk)
#pragma unroll
                for (int li = 0; li < 16; ++li) acc[li] += w[kk] * h2[li * 64 + k0 + kk]; }
        float* hT = (float*)(ws + WS_HT);
#pragma unroll
        for (int j = 0; j < 4; ++j) { const int col = tid * 4 + j, od = col >> 9, c = col & 511;
            const float delta = 3.0701134573f + (float)c * ((15.3505672866f - 3.0701134573f) / 511.0f);
            float* dst = hT + ((size_t)od * 512 + c) * SEQ + i0;
#pragma unroll
            for (int q = 0; q < 4; ++q) { f32x4 o;
#pragma unroll
                for (int s = 0; s < 4; ++s) { const int li = q * 4 + s; const float ti = (float)(i0 + li) * (1.0f / 4095.0f); o[s] = DBG_HTCONST == 1 ? 1.0f : DBG_HTCONST == 2 ? zl[li * 36 + (col % 33)] : DBG_HTCONST == 3 ? h1[li * 64 + (col & 63)] : DBG_HTCONST == 4 ? h2[li * 64 + (col & 63)] : DBG_HTCONST == 5 ? acc[li][j] : acc[li][j] * __expf(-ti * delta); }
                *(f32x4*)(dst + q * 4) = o; } }
        __syncthreads();
    }
    {
        asm volatile("" : "+v"(tid)); lane = tid & 63; wave = tid >> 6;
        LAS float* scr = (LAS float*)(lds + wave * 8448);
        const int gw = wg * NWAVES + wave, NGW = G * NWAVES;
        constexpr int I_IN = 104 * 16, I_OUT = 32 * 16;
        for (int it = gw; it < I_IN + I_OUT; it += NGW) {
            if (it < I_IN) { const int nb = it >> 4, kb = it & 15, n0 = nb * 32;
                const int ns = (n0 < 1536) ? n0 : (n0 < 3072 ? n0 + 32 : 1536 + (n0 - 3072));
                transpose_item(a.in[7], DIN, kb * 64, (n0 < DIN) ? ns : 0, (bf16*)(ws + WS_WIN), DM, n0, scr, lane, n0 >= DIN);
            } else { const int r = it - I_IN, nb = r >> 4, kb = r & 15;
                transpose_item(a.in[22], DM, kb * 64, nb * 32, (bf16*)(ws + WS_WOUT), DM, nb * 32, scr, lane, false); }
        }
    }
    for (int e = wg * NTHR + tid; e < 64 * 256; e += G * NTHR) { const int i = e >> 8, j = e & 255;
        const float om = 1.0f / powf(10000.0f, (float)j * (1.0f / 256.0f)); const float er = (float)i * om;
        float* pt = (float*)(ws + WS_POS); pt[i * 512 + j] = sinf(er); pt[i * 512 + 256 + j] = cosf(er); }
}

__device__ __forceinline__ void phase1(const Args& a, LAS unsigned char* lds) {
    const int tid = threadIdx.x, lane = tid & 63, wave = tid >> 6, wg = blockIdx.x, G = gridDim.x;
    unsigned char* ws = a.ws;
    const float* modr = (const float*)(ws + WS_MOD); const float* pt = (const float*)(ws + WS_POS); bf16* ain = (bf16*)(ws + WS_AIN);
    const float* gmix = a.in[6];
    const int NGW = G * NWAVES;
    f32x4 gv[4];
#pragma unroll
    for (int j = 0; j < 4; ++j) gv[j] = *(const f32x4*)(gmix + 4 * lane + 256 * j);
#pragma nounroll
    for (int r0 = wg * NWAVES + wave; r0 < MT; r0 += 4 * NGW) {
        f32x4 v[4][4];
#pragma unroll
        for (int k = 0; k < 4; ++k) { const int r = r0 + k * NGW;
            if (r < MT) { const bool lat = r < MX; const float* src = lat ? a.in[0] + (size_t)r * DM : a.in[2] + (size_t)(r - MX) * DM; const int t = r & 4095, rr = t >> 6, cc = t & 63;
#pragma unroll
                for (int j = 0; j < 4; ++j) { const int col = 4 * lane + 256 * j; v[k][j] = *(const f32x4*)(src + col);
                    const f32x4 pv = *(const f32x4*)(pt + ((j < 2) ? rr * 512 + col : cc * 512 + col - 512));
                    v[k][j] += pv * (lat ? 1.0f : 0.0f); } } }
#pragma unroll
        for (int k = 0; k < 4; ++k) { const int r = r0 + k * NGW;
            if (r < MT) { const int bb = (r < MX) ? (r >> 12) : 4; float ss = 0.f;
                f32x4 shv[4], scv[4];
#pragma unroll
                for (int j = 0; j < 4; ++j) { const int col = 4 * lane + 256 * j; shv[j] = *(const f32x4*)(modr + bb * 6144 + col); scv[j] = *(const f32x4*)(modr + bb * 6144 + 1024 + col); }
#pragma unroll
                for (int j = 0; j < 4; ++j) ss += v[k][j][0] * v[k][j][0] + v[k][j][1] * v[k][j][1] + v[k][j][2] * v[k][j][2] + v[k][j][3] * v[k][j][3];
                const float rs = rsqrtf(wave_sum(ss) * (1.0f / DM) + EPS);
#pragma unroll
                for (int j = 0; j < 4; ++j) { const int col = 4 * lane + 256 * j;
                    const f32x4 sh = shv[j], sc = scv[j];
                    const f32x4 y = (v[k][j] * rs * gv[j]) * (sc + 1.0f) + sh;
                    v2u w; w.x = pk2(y[0], y[1]); w.y = pk2(y[2], y[3]);
                    *(v2u*)(ain + (size_t)r * DM + col) = w; } } }
    }
}

typedef float cpx __attribute__((ext_vector_type(2)));
__device__ __forceinline__ cpx make_cpx(float x, float y) { cpx r; r.x = x; r.y = y; return r; }
__device__ __forceinline__ cpx cmul(cpx a, cpx b) { cpx t, r;
    asm("v_pk_mul_f32 %0, %1, %2 op_sel_hi:[1,0]" : "=v"(t) : "v"(a), "v"(b));
    asm("v_pk_fma_f32 %0, %1, %2, %3 op_sel:[1,1,0] op_sel_hi:[0,1,1] neg_lo:[1,0,0]" : "=v"(r) : "v"(a), "v"(b), "v"(t));
    return r; }
__device__ __forceinline__ cpx cmul_s(cpx a, cpx b) { cpx t, r;
    asm("v_pk_mul_f32 %0, %1, %2 op_sel_hi:[1,0]" : "=v"(t) : "v"(a), "s"(b));
    asm("v_pk_fma_f32 %0, %1, %2, %3 op_sel:[1,1,0] op_sel_hi:[0,1,1] neg_lo:[1,0,0]" : "=v"(r) : "v"(a), "s"(b), "v"(t));
    return r; }
__device__ __forceinline__ cpx cmulc(cpx a, cpx b) { cpx t, r;
    asm("v_pk_mul_f32 %0, %1, %2 op_sel_hi:[1,0] neg_hi:[1,0]" : "=v"(t) : "v"(a), "v"(b));
    asm("v_pk_fma_f32 %0, %1, %2, %3 op_sel:[1,1,0] op_sel_hi:[0,1,1] neg_lo:[1,0,0] neg_hi:[1,0,0]" : "=v"(r) : "v"(a), "v"(b), "v"(t));
    return r; }
__device__ __forceinline__ cpx cfma(cpx a, cpx b, cpx c) { cpx t, r;
    asm("v_pk_fma_f32 %0, %1, %2, %3 op_sel_hi:[1,0,1]" : "=v"(t) : "v"(a), "v"(b), "v"(c));
    asm("v_pk_fma_f32 %0, %1, %2, %3 op_sel:[1,1,0] op_sel_hi:[0,1,1] neg_lo:[1,0,0]" : "=v"(r) : "v"(a), "v"(b), "v"(t));
    return r; }
__device__ __forceinline__ cpx cadd(cpx a, cpx b) { return a + b; }
__device__ __forceinline__ cpx csub(cpx a, cpx b) { return a - b; }
__device__ __forceinline__ cpx add_mi(cpx a, cpx b) { cpx r; asm("v_pk_add_f32 %0, %1, %2 op_sel:[0,1] op_sel_hi:[1,0] neg_hi:[0,1]" : "=v"(r) : "v"(a), "v"(b)); return r; }
__device__ __forceinline__ cpx add_pi(cpx a, cpx b) { cpx r; asm("v_pk_add_f32 %0, %1, %2 op_sel:[0,1] op_sel_hi:[1,0] neg_lo:[0,1]" : "=v"(r) : "v"(a), "v"(b)); return r; }
__device__ __forceinline__ cpx cconj(cpx a) { return make_cpx(a.x, -a.y); }
__device__ __forceinline__ cpx twid(float turns) { return make_cpx(__builtin_amdgcn_cosf(turns), -__builtin_amdgcn_sinf(turns)); }
__device__ __forceinline__ void dft4(cpx& a0, cpx& a1, cpx& a2, cpx& a3) {
    const cpx t0 = cadd(a0, a2), t1 = csub(a0, a2), t2 = cadd(a1, a3), t3 = csub(a1, a3);
    a0 = cadd(t0, t2); a2 = csub(t0, t2); a1 = add_mi(t1, t3); a3 = add_pi(t1, t3);
}
__device__ __forceinline__ void dft4_r2(cpx& a0, cpx& a1, cpx& a2, cpx& a3) {
    const cpx t0 = add_mi(a0, a2), t1 = add_pi(a0, a2), t2 = cadd(a1, a3), t3 = csub(a1, a3);
    a0 = cadd(t0, t2); a2 = csub(t0, t2); a1 = add_mi(t1, t3); a3 = add_pi(t1, t3);
}
__device__ __forceinline__ void dft16(cpx (&v)[16]) {
    cpx t[16];
#pragma unroll
    for (int j = 0; j < 4; ++j) { cpx b0 = v[j], b1 = v[j + 4], b2 = v[j + 8], b3 = v[j + 12]; dft4(b0, b1, b2, b3); t[4 * j] = b0; t[4 * j + 1] = b1; t[4 * j + 2] = b2; t[4 * j + 3] = b3; }
    const float C1 = 0.92387953251f, S1 = 0.38268343236f, R2 = 0.70710678118f;
    const cpx W1 = make_cpx(C1, -S1), W2 = make_cpx(R2, -R2), W3 = make_cpx(S1, -C1), W6 = make_cpx(-R2, -R2), W9 = make_cpx(-C1, S1);
    {   cpx b0 = t[0], b1 = t[4], b2 = t[8], b3 = t[12]; dft4(b0, b1, b2, b3); v[0] = b0; v[4] = b1; v[8] = b2; v[12] = b3; }
    {   cpx b0 = t[1], b1 = cmul_s(t[5], W1), b2 = cmul_s(t[9], W2), b3 = cmul_s(t[13], W3); dft4(b0, b1, b2, b3); v[1] = b0; v[5] = b1; v[9] = b2; v[13] = b3; }
    {   cpx b0 = t[2], b1 = cmul_s(t[6], W2), b2 = t[10], b3 = cmul_s(t[14], W6); dft4_r2(b0, b1, b2, b3); v[2] = b0; v[6] = b1; v[10] = b2; v[14] = b3; }
    {   cpx b0 = t[3], b1 = cmul_s(t[7], W3), b2 = cmul_s(t[11], W6), b3 = cmul_s(t[15], W9); dft4(b0, b1, b2, b3); v[3] = b0; v[7] = b1; v[11] = b2; v[15] = b3; }
}
#define FPAD(i) ((i) + ((i) >> 4))
constexpr int FFT_STRIDE = 4352;
__device__ __forceinline__ void apply_tw(cpx (&v)[16], cpx w1) {
    asm volatile("" : "+v"(w1.x), "+v"(w1.y));
    cpx w = w1; v[1] = cmul(v[1], w);
#pragma unroll
    for (int q = 2; q < 16; ++q) { w = cmul(w, w1); v[q] = cmul(v[q], w); }
}
__device__ __forceinline__ cpx opaque(cpx w) { asm volatile("" : "+v"(w.x), "+v"(w.y)); return w; }
__device__ __forceinline__ cpx c32(int r) { return make_cpx(__builtin_cosf(0.19634954084936207f * (float)r), -__builtin_sinf(0.19634954084936207f * (float)r)); }

#define HB(x) __uint_as_float(((unsigned)(x)) << 16)
__device__ __forceinline__ void hyena_item(const Args& a, LAS unsigned char* lds, int c, int stage) {
    int tid = threadIdx.x; asm volatile("" : "+v"(tid));
    const int f = tid >> 8, j = tid & 255, blk = j >> 4, jp = j & 15;
    unsigned char* ws = a.ws;
    LAS cpx* buf = (LAS cpx*)lds;
    LAS cpx* bm = buf + f * FFT_STRIDE;
    const int pj = j + blk, p16 = blk * 272 + jp, pc = 17 * j;
    const float* hT = (const float*)(ws + WS_HT);
    const float* hf = hT + ((size_t)(stage * 2 + 0) * 512 + c) * SEQ;
    const float* hb = hT + ((size_t)(stage * 2 + 1) * 512 + c) * SEQ;
    const bf16* hyT = (const bf16*)(ws + WS_HYT);
    const bf16* zT = (const bf16*)(ws + WS_ZT);
    float* outp = (float*)(ws + WS_YHYT);
    const float* cw = a.in[13]; const float* cb = a.in[14];
    const int chu = c, chg = (stage == 0 ? 512 : 1024) + c;
    const float wu0 = cw[chu], wu1 = cw[1536 + chu], wu2 = cw[3072 + chu], bu = cb[chu];
    const float wg0 = cw[chg], wg1 = cw[1536 + chg], wg2 = cw[3072 + chg], bg = cb[chg];
    const float bias = a.in[21][stage * 512 + c];
    const cpx wj = twid((float)j * (1.0f / 4096.0f)), wjp = twid((float)jp * (1.0f / 256.0f)), w8_ = twid((float)j * (1.0f / 8192.0f));
    cpx v[16];
    LAS cpx* Hs = buf + 2 * FFT_STRIDE + f * FFT_STRIDE + pc;
    { const cpx w8 = opaque(w8_);
    float fraw[16], graw[16];
#pragma unroll
    for (int r = 0; r < 16; ++r) { const unsigned n = (unsigned)j + 256u * r; fraw[r] = hf[n]; graw[r] = hb[(SEQ - n) & 4095u]; }
    asm volatile("" : "+v"(fraw[0]), "+v"(fraw[1]), "+v"(fraw[2]), "+v"(fraw[3]), "+v"(fraw[4]), "+v"(fraw[5]), "+v"(fraw[6]), "+v"(fraw[7]), "+v"(fraw[8]), "+v"(fraw[9]), "+v"(fraw[10]), "+v"(fraw[11]), "+v"(fraw[12]), "+v"(fraw[13]), "+v"(fraw[14]), "+v"(fraw[15]));
    asm volatile("" : "+v"(graw[0]), "+v"(graw[1]), "+v"(graw[2]), "+v"(graw[3]), "+v"(graw[4]), "+v"(graw[5]), "+v"(graw[6]), "+v"(graw[7]), "+v"(graw[8]), "+v"(graw[9]), "+v"(graw[10]), "+v"(graw[11]), "+v"(graw[12]), "+v"(graw[13]), "+v"(graw[14]), "+v"(graw[15]));
#pragma unroll
    for (int r = 0; r < 16; ++r) { const unsigned n = (unsigned)j + 256u * r; const float fv = fraw[r]; const float gv = n ? graw[r] : 0.f;
        const cpx wn = cmul_s(w8, c32(r)); const float d = fv - gv;
        v[r] = f ? make_cpx(d * wn.x, d * wn.y) : make_cpx(fv + gv, 0.f); } }
    dft16(v); apply_tw(v, wj);
#pragma unroll
    for (int q = 0; q < 16; ++q) bm[pj + 272 * q] = v[q];
    __syncthreads();
#pragma unroll
    for (int r = 0; r < 16; ++r) v[r] = bm[p16 + 17 * r];
    dft16(v); apply_tw(v, wjp);
#pragma unroll
    for (int q = 0; q < 16; ++q) bm[p16 + 17 * q] = v[q];
    __syncthreads();
#pragma unroll
    for (int r = 0; r < 16; ++r) v[r] = bm[pc + r];
    dft16(v);
#pragma unroll
    for (int q = 0; q < 16; ++q) Hs[q] = v[q];
    __syncthreads();
#pragma nounroll
    for (int bp = 0; bp < 2; ++bp) {
        const int b0 = 2 * bp, b1 = 2 * bp + 1;
        float uk0[8], uk1[8];
        {   float u0[16], u1[16];
            const unsigned uj = (unsigned)j;
            if (stage == 0) {
                const bf16* P0 = hyT + ((size_t)b0 * 1536 + chu) * SEQ; const bf16* P1 = hyT + ((size_t)b1 * 1536 + chu) * SEQ;
#pragma unroll
                for (int r = 0; r < 16; ++r) { const unsigned o = uj + 256u * r; if (r == 4 || r == 8 || r == 12) asm volatile("" ::: "memory");
                    const unsigned ol = (r == 0) ? (j ? uj - 1u : 0u) : o - 1u, orr = (r == 15) ? (j < 255 ? o + 1u : o) : o + 1u;
                    float l0 = HB(P0[ol]), l1 = HB(P1[ol]), r0 = HB(P0[orr]), r1 = HB(P1[orr]);
                    if (r == 0) { l0 = j ? l0 : 0.f; l1 = j ? l1 : 0.f; }
                    if (r == 15) { r0 = (j < 255) ? r0 : 0.f; r1 = (j < 255) ? r1 : 0.f; }
                    u0[r] = wu0 * l0 + wu1 * HB(P0[o]) + wu2 * r0 + bu; u1[r] = wu0 * l1 + wu1 * HB(P1[o]) + wu2 * r1 + bu; }
            } else {
                const bf16* P0 = zT + ((size_t)b0 * 512 + c) * SEQ; const bf16* P1 = zT + ((size_t)b1 * 512 + c) * SEQ;
                unsigned short z0[16], z1[16];
#pragma unroll
                for (int r = 0; r < 16; ++r) { const unsigned o = uj + 256u * r; z0[r] = P0[o]; z1[r] = P1[o]; }
                asm volatile("" :: "v"(z0[0]), "v"(z0[1]), "v"(z0[2]), "v"(z0[3]), "v"(z0[4]), "v"(z0[5]), "v"(z0[6]), "v"(z0[7]), "v"(z0[8]), "v"(z0[9]), "v"(z0[10]), "v"(z0[11]), "v"(z0[12]), "v"(z0[13]), "v"(z0[14]), "v"(z0[15]));
                asm volatile("" :: "v"(z1[0]), "v"(z1[1]), "v"(z1[2]), "v"(z1[3]), "v"(z1[4]), "v"(z1[5]), "v"(z1[6]), "v"(z1[7]), "v"(z1[8]), "v"(z1[9]), "v"(z1[10]), "v"(z1[11]), "v"(z1[12]), "v"(z1[13]), "v"(z1[14]), "v"(z1[15]));
#pragma unroll
                for (int r = 0; r < 16; ++r) { u0[r] = HB(z0[r]); u1[r] = HB(z1[r]); }
            }
#pragma unroll
            for (int i = 0; i < 8; ++i) { uk0[i] = f ? u0[2 * i + 1] : u0[2 * i]; uk1[i] = f ? u1[2 * i + 1] : u1[2 * i]; }
            const cpx w8 = opaque(w8_);
#pragma unroll
            for (int r = 0; r < 16; ++r) { const cpx x = make_cpx(u0[r], u1[r]); v[r] = f ? cmul(x, cmul_s(w8, c32(r))) : x; }
        }
        dft16(v); apply_tw(v, wj);
#pragma unroll
        for (int q = 0; q < 16; ++q) bm[pj + 272 * q] = v[q];
        __syncthreads();
#pragma unroll
        for (int r = 0; r < 16; ++r) v[r] = bm[p16 + 17 * r];
        dft16(v); apply_tw(v, wjp);
#pragma unroll
        for (int q = 0; q < 16; ++q) bm[p16 + 17 * q] = v[q];
        __syncthreads();
#pragma unroll
        for (int r = 0; r < 16; ++r) v[r] = bm[pc + r];
        dft16(v);
#pragma unroll
        for (int q = 0; q < 16; ++q) v[q] = cmulc(v[q], Hs[q]);
        dft16(v);
#pragma unroll
        for (int q = 0; q < 16; ++q) bm[pc + q] = v[q];
        __syncthreads();
#pragma unroll
        for (int r = 0; r < 16; ++r) v[r] = bm[p16 + 17 * r];
        apply_tw(v, wjp); dft16(v);
#pragma unroll
        for (int q = 0; q < 16; ++q) bm[p16 + 17 * q] = v[q];
        __syncthreads();
        float gg0[8], gg1[8];
        {   unsigned short rg0[8][3], rg1[8][3];
            const bf16* G0 = hyT + ((size_t)b0 * 1536 + chg) * SEQ; const bf16* G1 = hyT + ((size_t)b1 * 1536 + chg) * SEQ;
            const unsigned gj = (unsigned)(j + 256 * f);
#pragma unroll
            for (int i = 0; i < 8; ++i) { const unsigned o = gj + 512u * i;
                const unsigned ol = (i == 0) ? (gj ? gj - 1u : 0u) : o - 1u, orr = (i == 7) ? (o < 4095u ? o + 1u : o) : o + 1u;
                rg0[i][0] = G0[ol]; rg0[i][1] = G0[o]; rg0[i][2] = G0[orr]; rg1[i][0] = G1[ol]; rg1[i][1] = G1[o]; rg1[i][2] = G1[orr]; }
#pragma unroll
            for (int r = 0; r < 16; ++r) v[r] = bm[pj + 272 * r];
            apply_tw(v, wj); dft16(v);
#pragma unroll
            for (int q = 0; q < 16; ++q) bm[pj + 272 * q] = v[q];
#pragma unroll
            for (int i = 0; i < 8; ++i) asm volatile("" :: "v"(rg0[i][0]), "v"(rg0[i][1]), "v"(rg0[i][2]), "v"(rg1[i][0]), "v"(rg1[i][1]), "v"(rg1[i][2]));
#pragma unroll
            for (int i = 0; i < 8; ++i) { const unsigned o = gj + 512u * i;
                float a0 = HB(rg0[i][0]), a1 = HB(rg0[i][1]), a2 = HB(rg0[i][2]), c0 = HB(rg1[i][0]), c1 = HB(rg1[i][1]), c2 = HB(rg1[i][2]);
                if (i == 0) { a0 = gj ? a0 : 0.f; c0 = gj ? c0 : 0.f; }
                if (i == 7) { a2 = (o < 4095u) ? a2 : 0.f; c2 = (o < 4095u) ? c2 : 0.f; }
                gg0[i] = wg0 * a0 + wg1 * a1 + wg2 * a2 + bg; gg1[i] = wg0 * c0 + wg1 * c1 + wg2 * c2 + bg; } }
        __syncthreads();
        const cpx w8f = cmul(opaque(w8_), f ? c32(1) : c32(0));
        float* O0 = outp + ((size_t)b0 * 512 + c) * SEQ; float* O1 = outp + ((size_t)b1 * 512 + c) * SEQ;
        bf16* Z0 = (bf16*)(ws + WS_ZT) + ((size_t)b0 * 512 + c) * SEQ; bf16* Z1 = (bf16*)(ws + WS_ZT) + ((size_t)b1 * 512 + c) * SEQ;
#pragma unroll
        for (int i = 0; i < 8; ++i) { const int rr = f + 2 * i; const unsigned n = (unsigned)(j + 256 * f) + 512u * i;
            const cpx be = buf[pj + 272 * rr], bo = buf[FFT_STRIDE + pj + 272 * rr];
            const cpx wn = cmul_s(w8f, c32(2 * i));
            const cpx z = cfma(bo, wn, be);
            const float y0 = z.x * (1.0f / 8192.0f) + bias * uk0[i], y1 = bias * uk1[i] - z.y * (1.0f / 8192.0f);
                        if (stage == 0) { Z0[n] = (bf16)f2bf(gg0[i] * y0); Z1[n] = (bf16)f2bf(gg1[i] * y1); } else { O0[n] = gg0[i] * y0; O1[n] = gg1[i] * y1; } }
        __syncthreads();
    }
}

__device__ __forceinline__ f32x16 mfma32(bf16x8 a, bf16x8 b, f32x16 c) { return __builtin_amdgcn_mfma_f32_32x32x16_bf16(a, b, c, 0, 0, 0); }
typedef short s4v __attribute__((ext_vector_type(4)));
__device__ __forceinline__ bf16x8 tr_frag(const LAS bf16* base, int PT, int k0, int c0, int lane) {
    const int i = lane & 15, q = i >> 2, p = i & 3;
    const LAS bf16* ad = base + (k0 + 8 * (lane >> 5) + q) * PT + c0 + 16 * ((lane >> 4) & 1) + 4 * p;
    const s4v lo = __builtin_amdgcn_ds_read_tr16_b64_v4i16((LAS s4v*)ad);
    const s4v hi = __builtin_amdgcn_ds_read_tr16_b64_v4i16((LAS s4v*)(ad + 4 * PT));
    bf16x8 r; r[0] = lo[0]; r[1] = lo[1]; r[2] = lo[2]; r[3] = lo[3]; r[4] = hi[0]; r[5] = hi[1]; r[6] = hi[2]; r[7] = hi[3]; return r;
}
constexpr int GL_AL = 0, GL_WA = 8192, GL_TOT = 16384, GL_V = 24576, GL_VP = 160;
struct GlaTab { float P[4][2], X[4][2], Ptot[2], Xtot[2], Pref[2], Xref[2]; };
__device__ __forceinline__ void gla_tables(const Args& a, int h, LAS unsigned char* lds, GlaTab& T, int tid) {
    const int d2 = tid & 31, sg = tid >> 5;
    const LAS float* aL = (const LAS float*)(lds + GL_AL); const LAS float* wa = (const LAS float*)(lds + GL_WA); LAS float* tot = (LAS float*)(lds + GL_TOT);
    typedef float f32x2v __attribute__((ext_vector_type(2)));
    const f32x2v bf = *(const f32x2v*)(a.in[9] + h * 64 + 2 * d2), bb = *(const f32x2v*)(a.in[11] + h * 64 + 2 * d2);
    float lf[4][2], lb[4][2];
#pragma unroll
    for (int q = 0; q < 4; ++q) { const int s = sg * 4 + q; float pf0 = bf[0], pf1 = bf[1], pb0 = bb[0], pb1 = bb[1];
#pragma unroll
        for (int j4 = 0; j4 < 4; ++j4) { const f32x4 af = *(const LAS f32x4*)(aL + s * 32 + 4 * j4), ab = *(const LAS f32x4*)(aL + s * 32 + 16 + 4 * j4);
#pragma unroll
            for (int jj = 0; jj < 4; ++jj) { const int j = 4 * j4 + jj; const f32x2v wf = *(const LAS f32x2v*)(wa + j * 64 + 2 * d2), wb = *(const LAS f32x2v*)(wa + 1024 + j * 64 + 2 * d2);
                pf0 += af[jj] * wf[0]; pf1 += af[jj] * wf[1]; pb0 += ab[jj] * wb[0]; pb1 += ab[jj] * wb[1]; } }
        lf[q][0] = logsig_f(pf0) * (1.0f / 16.0f); lf[q][1] = logsig_f(pf1) * (1.0f / 16.0f); lb[q][0] = logsig_f(pb0) * (1.0f / 16.0f); lb[q][1] = logsig_f(pb1) * (1.0f / 16.0f); }
#pragma unroll
    for (int i = 0; i < 2; ++i) { lf[1][i] += lf[0][i]; lf[2][i] += lf[1][i]; lf[3][i] += lf[2][i]; lb[2][i] += lb[3][i]; lb[1][i] += lb[2][i]; lb[0][i] += lb[1][i]; }
    *(LAS f32x2v*)(tot + sg * 64 + 2 * d2) = (f32x2v){lf[3][0], lf[3][1]};
    *(LAS f32x2v*)(tot + 1024 + sg * 64 + 2 * d2) = (f32x2v){lb[0][0], lb[0][1]};
    __syncthreads();
    float of[2] = {0.f, 0.f}, ob[2] = {0.f, 0.f};
    T.Ptot[0] = T.Ptot[1] = T.Xtot[0] = T.Xtot[1] = T.Pref[0] = T.Pref[1] = T.Xref[0] = T.Xref[1] = 0.f;
#pragma unroll
    for (int g = 0; g < 16; ++g) { const f32x2v tf = *(const LAS f32x2v*)(tot + g * 64 + 2 * d2), tb = *(const LAS f32x2v*)(tot + 1024 + g * 64 + 2 * d2);
#pragma unroll
        for (int i = 0; i < 2; ++i) { T.Ptot[i] += tf[i]; T.Xtot[i] += tb[i]; if (g < 8) T.Pref[i] += tf[i]; else T.Xref[i] += tb[i];
            of[i] += (g < sg) ? tf[i] : 0.f; ob[i] += (g > sg) ? tb[i] : 0.f; } }
#pragma unroll
    for (int q = 0; q < 4; ++q)
#pragma unroll
        for (int i = 0; i < 2; ++i) { T.P[q][i] = lf[q][i] + of[i]; T.X[q][i] = lb[q][i] + ob[i]; }
}
struct GlaIn { f32x4 av, wv; unsigned kw[4], qw[4]; };
template <bool OUT>
__device__ __forceinline__ void gla_load(const Args& a, int tid, int bh, int ci, GlaIn& I) {
    const int b = bh >> 2, h = bh & 3, d2 = tid & 31, sg = tid >> 5;
    const size_t rowbase = OUT ? (size_t)b * SEQ + ci * 64 : ((ci < 4) ? (size_t)(MX + b * CTXL + ci * 64) : (size_t)(b * SEQ + (ci - 4) * 64));
    const float* afb = (const float*)(a.ws + WS_AFB); const bf16* qkvg = (const bf16*)(a.ws + WS_QKVG);
    I.av = *(const f32x4*)(afb + (rowbase + (tid >> 3)) * 32 + 4 * (tid & 7));
    const int wdir = tid >> 8, wj = (tid >> 4) & 15, wd4 = (tid & 15) * 4;
    I.wv = *(const f32x4*)((wdir ? a.in[10] : a.in[8]) + wj * 256 + h * 64 + wd4);
#pragma unroll
    for (int q = 0; q < 4; ++q) { const bf16* rp = qkvg + (rowbase + sg * 4 + q) * NQ + h * 64 + 2 * d2; I.kw[q] = *(const unsigned*)(rp + 256); if (OUT) I.qw[q] = *(const unsigned*)rp; }
}
__device__ __forceinline__ void gla_stage_common(const GlaIn& I, LAS unsigned char* lds, int tid) {
    const int wdir = tid >> 8, wj = (tid >> 4) & 15, wd4 = (tid & 15) * 4;
    *(LAS f32x4*)((LAS float*)(lds + GL_AL) + 4 * tid) = I.av;
    *(LAS f32x4*)((LAS float*)(lds + GL_WA) + wdir * 1024 + wj * 64 + wd4) = I.wv;
}

template <bool HASN>
__device__ __forceinline__ void gla_upd_item(const Args& a, LAS unsigned char* lds, int bh, int ci, const GlaIn& I, int nbh, int nci, GlaIn& N) {
    int tid = threadIdx.x; asm volatile("" : "+v"(tid));
    const int lane = tid & 63, wave = tid >> 6, h = bh & 3, d2 = tid & 31, sg = tid >> 5;
    unsigned char* ws = a.ws;
    constexpr int KP = 96;
    LAS bf16* vN = (LAS bf16*)(lds + GL_V); LAS bf16* kUf = (LAS bf16*)(lds + 45056); LAS bf16* kUb = (LAS bf16*)(lds + 57344);
    unsigned kw[4];
#pragma unroll
    for (int q = 0; q < 4; ++q) kw[q] = I.kw[q];
    v4u vv[2];
    { const int b = bh >> 2; const size_t rowbase = (ci < 4) ? (size_t)(MX + b * CTXL + ci * 64) : (size_t)(b * SEQ + (ci - 4) * 64); const bf16* qkvg = (const bf16*)(ws + WS_QKVG);
#pragma unroll
        for (int q = 0; q < 2; ++q) { const int idx = tid + NTHR * q; vv[q] = *(const v4u*)(qkvg + (rowbase + (idx >> 4)) * NQ + 512 + h * 128 + (idx & 15) * 8); } }
    gla_stage_common(I, lds, tid);
    __syncthreads();
    if (HASN) gla_load<false>(a, tid, nbh, nci, N);
    GlaTab T; gla_tables(a, h, lds, T, tid);
#pragma unroll
    for (int q = 0; q < 4; ++q) { const int s = sg * 4 + q; const float k0 = bflo(kw[q]), k1 = bfhi(kw[q]);
        *(LAS unsigned*)(kUf + s * KP + 2 * d2) = pk2(k0 * __expf(T.Ptot[0] - T.P[q][0]), k1 * __expf(T.Ptot[1] - T.P[q][1]));
        *(LAS unsigned*)(kUb + s * KP + 2 * d2) = pk2(k0 * __expf(T.Xtot[0] - T.X[q][0]), k1 * __expf(T.Xtot[1] - T.X[q][1])); }
#pragma unroll
    for (int q = 0; q < 2; ++q) { const int idx = tid + NTHR * q; *(LAS v4u*)(vN + (idx >> 4) * GL_VP + (idx & 15) * 8) = vv[q]; }
    if (tid < 32) { float* dec = (float*)(ws + WS_DEC);
#pragma unroll
        for (int i = 0; i < 2; ++i) { dec[((size_t)(bh * 2 + 0) * NCH + ci) * 64 + 2 * d2 + i] = __expf(T.Ptot[i]); dec[((size_t)(bh * 2 + 1) * NCH + ci) * 64 + 2 * d2 + i] = __expf(T.Xtot[i]); } }
    __syncthreads();
    { const int dir = wave >> 2, e0 = (wave & 3) * 32, l31 = lane & 31, hh = lane >> 5;
        const LAS bf16* kT = dir ? kUb : kUf;
        float* U = (ci < 4) ? (float*)(ws + WS_UCTX) + ((size_t)(bh * 2 + dir) * 4 + ci) * 8192 : a.out + ((size_t)(bh * 2 + dir) * 64 + (ci - 4)) * 8192;
        bf16x8 A[4];
#pragma unroll
        for (int ks = 0; ks < 4; ++ks) A[ks] = tr_frag(vN, GL_VP, 16 * ks, e0, lane);
#pragma unroll
        for (int dt = 0; dt < 2; ++dt) { const int d0 = dt * 32; f32x16 acc;
#pragma unroll
            for (int i = 0; i < 16; ++i) acc[i] = 0.f;
#pragma unroll
            for (int ks = 0; ks < 4; ++ks) acc = mfma32(A[ks], tr_frag(kT, KP, 16 * ks, d0, lane), acc);
#pragma unroll
            for (int r = 0; r < 16; ++r) { const int e = e0 + (r & 3) + 8 * (r >> 2) + 4 * hh; U[e * 64 + d0 + l31] = acc[r]; } } }
    __syncthreads();
}

__device__ __forceinline__ void gla_scan_item(const Args& a, int it) {
    int tid = threadIdx.x; asm volatile("" : "+v"(tid));
    const int bd = it >> 4, dir = bd & 1, el = ((it & 15) * 8 + (tid >> 6)) * 64 + (tid & 63), d = tid & 63;
    unsigned char* ws = a.ws;
    const float* dec = (const float*)(ws + WS_DEC) + (size_t)bd * NCH * 64 + d;
    const float* Uc = (const float*)(ws + WS_UCTX) + (size_t)bd * 4 * 8192 + el;
    const float* U = a.out + (size_t)bd * 64 * 8192 + el;
    bf16* Sp = (bf16*)(ws + WS_SPREV) + (size_t)bd * 64 * 8192 + el;
    float S = 0.f;
#pragma unroll
    for (int c4 = 0; c4 < 4; ++c4) { const int ci = dir ? 3 - c4 : c4; S = dec[ci * 64] * S + Uc[(size_t)ci * 8192]; }
#pragma unroll
    for (int blk = 0; blk < 2; ++blk) { float uu[32], dd[32];
#pragma unroll
        for (int j = 0; j < 32; ++j) { const int n = dir ? 63 - (blk * 32 + j) : blk * 32 + j; uu[j] = U[(size_t)n * 8192]; dd[j] = dec[(4 + n) * 64]; }
#pragma unroll
        for (int j = 0; j < 32; ++j) { const int n = dir ? 63 - (blk * 32 + j) : blk * 32 + j; Sp[(size_t)n * 8192] = (bf16)f2bf(S); S = dd[j] * S + uu[j]; } }
}

template <bool HASN>
__device__ __forceinline__ void gla_out_item(const Args& a, LAS unsigned char* lds, int bh, int n, const GlaIn& I, int nbh, int nn, GlaIn& N) {
    int tid = threadIdx.x; asm volatile("" : "+v"(tid));
    const int lane = tid & 63, wave = tid >> 6, b = bh >> 2, h = bh & 3, l31 = lane & 31, hh = lane >> 5, d2 = tid & 31, sg = tid >> 5;
    unsigned char* ws = a.ws;
    LAS bf16* Scat = (LAS bf16*)lds;
    LAS bf16* vN = (LAS bf16*)(lds + GL_V);
    LAS bf16* qf = (LAS bf16*)(lds + 45056); LAS bf16* qb = qf + 4608; LAS bf16* kf = qf + 2 * 4608; LAS bf16* kb = qf + 3 * 4608;
    LAS float* oS = (LAS float*)(lds + 45056);
    LAS bf16* qS = (LAS bf16*)(lds + 81920);
    LAS bf16* Sp = (LAS bf16*)(lds + 99328);
    const size_t rowbase = (size_t)b * SEQ + n * 64;
    unsigned qw[4], kw[4];
#pragma unroll
    for (int q = 0; q < 4; ++q) { qw[q] = I.qw[q]; kw[q] = I.kw[q]; }
    v4u vv[2], sv[4], g0, g1;
    { const bf16* qkvg = (const bf16*)(ws + WS_QKVG);
        { const bf16* gp = qkvg + (rowbase + (tid >> 3)) * NQ + 1024 + h * 128 + (tid & 7) * 16; g0 = *(const v4u*)gp; g1 = *(const v4u*)(gp + 8); }
#pragma unroll
        for (int q = 0; q < 2; ++q) { const int idx = tid + NTHR * q; vv[q] = *(const v4u*)(qkvg + (rowbase + (idx >> 4)) * NQ + 512 + h * 128 + (idx & 15) * 8); }
        const bf16* spf = (const bf16*)(ws + WS_SPREV) + ((size_t)(bh * 2 + 0) * 64 + n) * 8192; const bf16* spb = (const bf16*)(ws + WS_SPREV) + ((size_t)(bh * 2 + 1) * 64 + n) * 8192;
#pragma unroll
        for (int q = 0; q < 4; ++q) { const int idx = tid + NTHR * q, dir = idx >> 10, e = (idx >> 3) & 127, d8 = (idx & 7) * 8; sv[q] = *(const v4u*)((dir ? spb : spf) + e * 64 + d8); } }
    gla_stage_common(I, lds, tid);
    __syncthreads();
    if (HASN) gla_load<true>(a, tid, nbh, nn, N);
    GlaTab T; gla_tables(a, h, lds, T, tid);
#pragma unroll
    for (int q = 0; q < 4; ++q) { const int s = sg * 4 + q; const float q0 = bflo(qw[q]), q1 = bfhi(qw[q]), k0 = bflo(kw[q]), k1 = bfhi(kw[q]);
        *(LAS unsigned*)(qf + s * 72 + 2 * d2) = pk2(q0 * __expf(T.P[q][0] - T.Pref[0]), q1 * __expf(T.P[q][1] - T.Pref[1]));
        *(LAS unsigned*)(kf + s * 72 + 2 * d2) = pk2(k0 * __expf(T.Pref[0] - T.P[q][0]), k1 * __expf(T.Pref[1] - T.P[q][1]));
        *(LAS unsigned*)(qb + s * 72 + 2 * d2) = pk2(q0 * __expf(T.X[q][0] - T.Xref[0]), q1 * __expf(T.X[q][1] - T.Xref[1]));
        *(LAS unsigned*)(kb + s * 72 + 2 * d2) = pk2(k0 * __expf(T.Xref[0] - T.X[q][0]), k1 * __expf(T.Xref[1] - T.X[q][1]));
        *(LAS unsigned*)(qS + s * 136 + 2 * d2) = pk2(q0 * __expf(T.P[q][0]), q1 * __expf(T.P[q][1]));
        *(LAS unsigned*)(qS + s * 136 + 64 + 2 * d2) = pk2(q0 * __expf(T.X[q][0]), q1 * __expf(T.X[q][1])); }
#pragma unroll
    for (int q = 0; q < 2; ++q) { const int idx = tid + NTHR * q; *(LAS v4u*)(vN + (idx >> 4) * GL_VP + (idx & 15) * 8) = vv[q]; }
#pragma unroll
    for (int q = 0; q < 4; ++q) { const int idx = tid + NTHR * q, dir = idx >> 10, e = (idx >> 3) & 127, d8 = (idx & 7) * 8; *(LAS v4u*)(Sp + e * 136 + dir * 64 + d8) = sv[q]; }
    __syncthreads();
    { const int dir = wave >> 2, c0 = ((wave >> 1) & 1) * 32, s0 = (wave & 1) * 32;
        const LAS bf16* qq = dir ? qb : qf; const LAS bf16* kk = dir ? kb : kf;
        f32x16 acc;
#pragma unroll
        for (int i = 0; i < 16; ++i) acc[i] = 0.f;
#pragma unroll
        for (int ks = 0; ks < 4; ++ks) { const bf16x8 A = *(const LAS bf16x8*)(qq + (c0 + l31) * 72 + 16 * ks + 8 * hh), B = *(const LAS bf16x8*)(kk + (s0 + l31) * 72 + 16 * ks + 8 * hh);
            acc = mfma32(A, B, acc); }
        const int s = s0 + l31;
#pragma unroll
        for (int r = 0; r < 16; ++r) { const int c = c0 + (r & 3) + 8 * (r >> 2) + 4 * hh; const bool keep = dir ? (s >= c) : (s <= c);
            Scat[c * 136 + dir * 64 + s] = (bf16)f2bf(keep ? acc[r] : 0.f); } }
    __syncthreads();
    { const int c0 = (wave >> 2) * 32, e0 = (wave & 3) * 32;
        f32x16 acc;
#pragma unroll
        for (int i = 0; i < 16; ++i) acc[i] = 0.f;
#pragma unroll
        for (int ks = 0; ks < 8; ++ks) { const bf16x8 A = *(const LAS bf16x8*)(Scat + (c0 + l31) * 136 + 16 * ks + 8 * hh);
            acc = mfma32(A, tr_frag(vN, GL_VP, 16 * (ks & 3), e0, lane), acc); }
#pragma unroll
        for (int ks = 0; ks < 8; ++ks) { const bf16x8 A = *(const LAS bf16x8*)(qS + (c0 + l31) * 136 + 16 * ks + 8 * hh), B = *(const LAS bf16x8*)(Sp + (e0 + l31) * 136 + 16 * ks + 8 * hh);
            acc = mfma32(A, B, acc); }
#pragma unroll
        for (int r = 0; r < 16; ++r) { const int c = c0 + (r & 3) + 8 * (r >> 2) + 4 * hh; oS[c * 132 + e0 + l31] = acc[r]; } }
    __syncthreads();
    { const int row = tid >> 3, ec = (tid & 7) * 16; float v[16]; float ss = 0.f;
#pragma unroll
        for (int j = 0; j < 16; ++j) { v[j] = oS[row * 132 + ec + j]; ss += v[j] * v[j]; }
        ss += __shfl_xor(ss, 1); ss += __shfl_xor(ss, 2); ss += __shfl_xor(ss, 4);
        const float rs = rsqrtf(ss * (1.0f / 128.0f) + EPS);
        const float gv[16] = {bflo(g0.x), bfhi(g0.x), bflo(g0.y), bfhi(g0.y), bflo(g0.z), bfhi(g0.z), bflo(g0.w), bfhi(g0.w), bflo(g1.x), bfhi(g1.x), bflo(g1.y), bfhi(g1.y), bflo(g1.z), bfhi(g1.z), bflo(g1.w), bfhi(g1.w)};
        float o[16];
#pragma unroll
        for (int j = 0; j < 16; ++j) o[j] = DBG_GLA_K * v[j] * rs * a.in[12][ec + j] * silu_f(gv[j]);
        bf16* op = (bf16*)(ws + WS_AOUT) + (rowbase + row) * DM + h * 128 + ec;
        *(v4u*)op = (v4u){pk2(o[0], o[1]), pk2(o[2], o[3]), pk2(o[4], o[5]), pk2(o[6], o[7])};
        *(v4u*)(op + 8) = (v4u){pk2(o[8], o[9]), pk2(o[10], o[11]), pk2(o[12], o[13]), pk2(o[14], o[15])}; }
    __syncthreads();
}

__device__ __forceinline__ void hy_transpose_item(const Args& a, LAS unsigned char* lds, int it) {
    const int tid = threadIdx.x, b = it >> 6, t0 = (it & 63) * 64;
    LAS float* tile = (LAS float*)lds;
    const float* src = (const float*)(a.ws + WS_YHYT) + (size_t)b * 512 * SEQ + t0;
    bf16* dst = (bf16*)(a.ws + WS_AOUT) + ((size_t)b * SEQ + t0) * DM + 512;
    for (int half = 0; half < 2; ++half) {
#pragma unroll 8
        for (int q = 0; q < 32; ++q) { const int idx = tid + NTHR * q, c = idx >> 6, tt = idx & 63; tile[c * 65 + tt] = src[(size_t)(half * 256 + c) * SEQ + tt]; }
        __syncthreads();
#pragma unroll
        for (int q = 0; q < 4; ++q) { const int idx = tid + NTHR * q, t = idx >> 5, c8 = (idx & 31) * 8; const LAS float* s = tile + c8 * 65 + t;
            *(v4u*)(dst + (size_t)t * DM + half * 256 + c8) = (v4u){pk2(s[0], s[65]), pk2(s[2 * 65], s[3 * 65]), pk2(s[4 * 65], s[5 * 65]), pk2(s[6 * 65], s[7 * 65])}; }
        __syncthreads();
    }
}

__device__ __forceinline__ void phase_router(const Args& a, LAS unsigned char* lds) {
    const int tid = threadIdx.x, lane = tid & 63, wave = tid >> 6, wg = blockIdx.x, G = gridDim.x;
    unsigned char* ws = a.ws;
    LAS float* wr = (LAS float*)lds;
    for (int i = tid; i < 4096; i += NTHR) { const int l = i & 63, q = (i >> 6) & 3, j = (i >> 8) & 3, e4 = i >> 10;
        *(LAS f32x4*)(wr + 4 * i) = *(const f32x4*)(a.in[24] + (4 * l + 256 * j + q) * 16 + 4 * e4); }
    __syncthreads();
    const float* modr = (const float*)(ws + WS_MOD); const float* gffn = a.in[23];
    bf16* hn = (bf16*)(ws + WS_HN); float* aff = (float*)(ws + WS_AFF);
    const int NGW = G * NWAVES;
    f32x4 gv[4];
#pragma unroll
    for (int j = 0; j < 4; ++j) gv[j] = *(const f32x4*)(gffn + 4 * lane + 256 * j);
#pragma nounroll
    for (int r0 = wg * NWAVES + wave; r0 < MX; r0 += 2 * NGW) {
        const int r1 = r0 + NGW; const bool ok1 = r1 < MX; const int rB = ok1 ? r1 : r0;
        int lane_o = lane; asm volatile("" : "+v"(lane_o));
        f32x4 v[2][4];
#pragma unroll
        for (int j = 0; j < 4; ++j) { v[0][j] = *(const f32x4*)(a.out + (size_t)r0 * DM + 4 * lane + 256 * j); v[1][j] = *(const f32x4*)(a.out + (size_t)rB * DM + 4 * lane + 256 * j); }
        float rs[2];
#pragma unroll
        for (int k = 0; k < 2; ++k) { float ss = 0.f;
#pragma unroll
            for (int j = 0; j < 4; ++j) ss += v[k][j][0] * v[k][j][0] + v[k][j][1] * v[k][j][1] + v[k][j][2] * v[k][j][2] + v[k][j][3] * v[k][j][3];
            rs[k] = rsqrtf(wave_sum(ss) * (1.0f / DM) + EPS); }
        float lg[2][16];
#pragma unroll
        for (int k = 0; k < 2; ++k)
#pragma unroll
            for (int e = 0; e < 16; ++e) lg[k][e] = 0.f;
        f32x4 shv[2][4], scv[2][4];
#pragma unroll
        for (int k = 0; k < 2; ++k)
#pragma unroll
            for (int j = 0; j < 4; ++j) { const int b = (k ? rB : r0) >> 12, col = 4 * lane + 256 * j; shv[k][j] = *(const f32x4*)(modr + b * 6144 + 3072 + col); scv[k][j] = *(const f32x4*)(modr + b * 6144 + 4096 + col); }
#pragma unroll
        for (int j = 0; j < 4; ++j) { const int col = 4 * lane + 256 * j; f32x4 y[2];
#pragma unroll
            for (int k = 0; k < 2; ++k) { const int r = k ? rB : r0;
                const f32x4 sh = shv[k][j], sc = scv[k][j];
                y[k] = (v[k][j] * rs[k] * gv[j]) * (sc + 1.0f) + sh;
                v2u w; w.x = pk2(y[k][0], y[k][1]); w.y = pk2(y[k][2], y[k][3]);
                if (k == 0 || ok1) *(v2u*)(hn + (size_t)r * DM + col) = w; }
#pragma unroll
            for (int q = 0; q < 4; ++q) {
#pragma unroll
                for (int e4 = 0; e4 < 4; ++e4) { const f32x4 ww = *(const LAS f32x4*)(wr + 4 * ((((e4 * 4 + j) * 4 + q) << 6) + lane_o));
#pragma unroll
                    for (int s = 0; s < 4; ++s) { lg[0][e4 * 4 + s] += y[0][q] * ww[s]; lg[1][e4 * 4 + s] += y[1][q] * ww[s]; } }
#define PIN16(x) asm volatile("" : "+v"(x[0]), "+v"(x[1]), "+v"(x[2]), "+v"(x[3]), "+v"(x[4]), "+v"(x[5]), "+v"(x[6]), "+v"(x[7]), "+v"(x[8]), "+v"(x[9]), "+v"(x[10]), "+v"(x[11]), "+v"(x[12]), "+v"(x[13]), "+v"(x[14]), "+v"(x[15]) :: "memory")
                PIN16(lg[0]); PIN16(lg[1]); } }
#undef PIN16
        const bool h5 = (lane & 32) != 0, h4 = (lane & 16) != 0, h3 = (lane & 8) != 0, h2 = (lane & 4) != 0;
        const int ex = (h5 ? 8 : 0) + (h4 ? 4 : 0) + (h3 ? 2 : 0) + (h2 ? 1 : 0);
#pragma unroll
        for (int k = 0; k < 2; ++k) { float k8[8], k4[4], k2[2], lgt;
#pragma unroll
            for (int i = 0; i < 8; ++i) { const float snd = h5 ? lg[k][i] : lg[k][8 + i], kp = h5 ? lg[k][8 + i] : lg[k][i]; k8[i] = kp + __shfl_xor(snd, 32); }
#pragma unroll
            for (int i = 0; i < 4; ++i) { const float snd = h4 ? k8[i] : k8[4 + i], kp = h4 ? k8[4 + i] : k8[i]; k4[i] = kp + __shfl_xor(snd, 16); }
#pragma unroll
            for (int i = 0; i < 2; ++i) { const float snd = h3 ? k4[i] : k4[2 + i], kp = h3 ? k4[2 + i] : k4[i]; k2[i] = kp + __shfl_xor(snd, 8); }
            { const float snd = h2 ? k2[0] : k2[1], kp = h2 ? k2[1] : k2[0]; lgt = kp + __shfl_xor(snd, 4); }
            lgt += __shfl_xor(lgt, 2); lgt += __shfl_xor(lgt, 1);
            float mx = lgt;
            mx = fmaxf(mx, __shfl_xor(mx, 4)); mx = fmaxf(mx, __shfl_xor(mx, 8)); mx = fmaxf(mx, __shfl_xor(mx, 16)); mx = fmaxf(mx, __shfl_xor(mx, 32));
            const float pe = expf(lgt - mx);
            float sum = pe;
            sum += __shfl_xor(sum, 4); sum += __shfl_xor(sum, 8); sum += __shfl_xor(sum, 16); sum += __shfl_xor(sum, 32);
            const int r = k ? rB : r0;
            if ((lane & 3) == 0 && (k == 0 || ok1)) aff[((size_t)(r >> 12) * NE + ex) * SEQ + (r & 4095)] = pe / sum; }
    }
}

__device__ __forceinline__ void conv_item(const Args& a, LAS float* scr, int lane, bool gu, int it) {
    unsigned char* ws = a.ws;
    if (gu) { const int mat = it >> 9, r = it & 511, nb = r >> 4, kb = r & 15, e = mat >> 1, kind = mat & 1, n0 = nb * 32;
        transpose_item((kind ? a.in[26] : a.in[25]) + (size_t)e * DM * DM, DM, kb * 64, n0, (bf16*)(ws + WS_WGU) + (size_t)e * 2048 * DM, DM, (n0 >> 7) * 256 + kind * 128 + (n0 & 127), scr, lane, false);
    } else { const int e = it >> 9, r = it & 511, nb = r >> 4, kb = r & 15;
        transpose_item(a.in[27] + (size_t)e * DM * DM, DM, kb * 64, nb * 32, (bf16*)(ws + WS_WD) + (size_t)e * DM * DM, DM, nb * 32, scr, lane, false); }
}
__device__ __forceinline__ bool conv_try(const Args& a, LAS unsigned char* lds, bool allow_gu, unsigned& cur) {
    const int lane = threadIdx.x & 63, wave = threadIdx.x >> 6;
    const int gw = blockIdx.x * NWAVES + wave, NGW = gridDim.x * NWAVES;
    LAS float* scr = (LAS float*)(lds + wave * 8448);
    const int itD = gw + (int)(cur & 0xffffu) * NGW;
    if (itD < NE * 512) { conv_item(a, scr, lane, false, itD); cur += 1u; return true; }
    if (!allow_gu) return false;
    const int itG = gw + (int)(cur >> 16) * NGW;
    if (itG < NE * 1024) { conv_item(a, scr, lane, true, itG); cur += 0x10000u; return true; }
    return false;
}
#ifndef DBG_NOSHADOW
#define DBG_NOSHADOW 0
#endif
__device__ __forceinline__ void seam_barrier(const XcdBarrier& b, const Args& a, LAS unsigned char* lds, volatile LAS unsigned* MISC, unsigned& gen, bool allow_gu, unsigned& cdone) {
    asm volatile("s_waitcnt vmcnt(0)" ::: "memory");
    __syncthreads();
    ++gen;
    if (threadIdx.x < 64) {
        if (threadIdx.x == 0) {
            unsigned* bar = b.bar;
            __builtin_amdgcn_s_waitcnt(0);
            unsigned nloc = b.st[0], nx = b.st[1];
            if (nloc == 0u) { xcd_barrier_complete(bar, b.x, nloc, nx); b.st[0] = nloc; b.st[1] = nx; }
            const unsigned old = xb_add(&bar[XB_XSUB(b.x)], 1u);
            const unsigned g2 = old / nloc;
            if (old + 1u == (g2 + 1u) * nloc) {
                __builtin_amdgcn_fence(__ATOMIC_RELEASE, "agent");
                asm volatile("s_waitcnt vmcnt(0)" ::: "memory");
                const unsigned og = xb_add(&bar[XB_TOP], 1u);
                const unsigned tg = og / nx;
                if (og + 1u == (tg + 1u) * nx) xb_add(&bar[XB_TOPGEN], 1u);
                else XB_SPIN(xb_ld(&bar[XB_TOPGEN]) == tg, bar);
                __builtin_amdgcn_fence(__ATOMIC_ACQUIRE, "agent");
                xb_add(&bar[XB_XGEN(b.x)], 1u);
                asm volatile("s_waitcnt vmcnt(0)" ::: "memory");
            } else {
                XB_SPIN(xb_ld(&bar[XB_XGEN(b.x)]) == g2, bar);
                __builtin_amdgcn_fence(__ATOMIC_ACQUIRE, "agent");
                asm volatile("s_waitcnt vmcnt(0)" ::: "memory");
            }
            MISC[16] = gen;
        }
    } else {
        unsigned spins = 0;
        while (MISC[16] != gen) { if (DBG_NOSHADOW || !conv_try(a, lds, allow_gu, cdone)) { __builtin_amdgcn_s_sleep(4); if (++spins > (1u << 22)) break; } }
    }
    __syncthreads();
}

__device__ __forceinline__ void block_excl_scan2(int& va, int& vb, LAS int* tmp) {
    const int tid = threadIdx.x, lane = tid & 63, wave = tid >> 6;
    int ia = va, ib = vb;
#pragma unroll
    for (int o = 1; o < 64; o <<= 1) { const int ta = __shfl_up(ia, o), tb = __shfl_up(ib, o); if (lane >= o) { ia += ta; ib += tb; } }
    if (lane == 63) { tmp[wave] = ia; tmp[8 + wave] = ib; }
    __syncthreads();
    int oa = 0, ob = 0;
#pragma unroll
    for (int w = 0; w < 8; ++w) { if (w < wave) { oa += tmp[w]; ob += tmp[8 + w]; } }
    va = oa + ia - va; vb = ob + ib - vb;
    __syncthreads();
}
__device__ __forceinline__ void topk_item(const Args& a, LAS unsigned char* lds, int be) {
    const int tid = threadIdx.x, b = be >> 4, e = be & 15;
    unsigned char* ws = a.ws;
    LAS unsigned* keys = (LAS unsigned*)lds;
    LAS unsigned* hist = (LAS unsigned*)(lds + 16384);
    LAS int* ctl = (LAS int*)(lds + 16384 + 1024);
    LAS int* tmp = (LAS int*)(lds + 16384 + 1024 + 64);
    const float* aff = (const float*)(ws + WS_AFF) + (size_t)be * SEQ;
    unsigned my[8];
#pragma unroll
    for (int i = 0; i < 8; ++i) { my[i] = __float_as_uint(aff[tid * 8 + i]); keys[tid * 8 + i] = my[i]; }
    unsigned prefix = 0u, mask = 0u; int need = CAP;
    for (int pass = 0; pass < 4; ++pass) {
        const int shift = 24 - 8 * pass;
        if (tid < 256) hist[tid] = 0u;
        __syncthreads();
#pragma unroll
        for (int i = 0; i < 8; ++i) if ((my[i] & mask) == prefix) atomicAdd((unsigned*)&hist[(my[i] >> shift) & 255u], 1u);
        __syncthreads();
        {
            int hv = (tid < 256) ? (int)hist[255 - tid] : 0, inc = hv;
#pragma unroll
            for (int o = 1; o < 64; o <<= 1) { const int t2 = __shfl_up(inc, o); if ((tid & 63) >= o) inc += t2; }
            if ((tid & 63) == 63) tmp[tid >> 6] = inc;
            __syncthreads();
            int off = 0;
#pragma unroll
            for (int w = 0; w < 4; ++w) if (w < (tid >> 6)) off += tmp[w];
            inc += off;
            if (tid < 256 && inc >= need && inc - hv < need) { ctl[0] = 255 - tid; ctl[1] = need - (inc - hv); }
        }
        __syncthreads();
        prefix |= ((unsigned)ctl[0]) << shift; mask |= 255u << shift; need = ctl[1];
        __syncthreads();
    }
    const unsigned T = prefix;
    int cg = 0, ce = 0;
#pragma unroll
    for (int i = 0; i < 8; ++i) { cg += (my[i] > T) ? 1 : 0; ce += (my[i] == T) ? 1 : 0; }
    int pg = cg, pe = ce;
    block_excl_scan2(pg, pe, tmp);
    int* slot_of = (int*)(ws + WS_SLOT) + (size_t)be * SEQ;
    int* selt = (int*)(ws + WS_SELT) + (e * 4 + b) * CAP; float* selv = (float*)(ws + WS_SELV) + (e * 4 + b) * CAP;
#pragma unroll
    for (int i = 0; i < 8; ++i) { const int t = tid * 8 + i; const bool gt = my[i] > T, eq = my[i] == T; const bool sel = gt || (eq && pe < need);
        const int slot = pg + (pe < need ? pe : need);
        slot_of[t] = sel ? slot : -1;
        if (sel) { selt[slot] = t; selv[slot] = __uint_as_float(my[i]); }
        pg += gt ? 1 : 0; pe += eq ? 1 : 0; }
    __syncthreads();
}
__device__ __forceinline__ void phase_topk(const Args& a, LAS unsigned char* lds, unsigned& cdone) {
    const int tid = threadIdx.x, lane = tid & 63, wave = tid >> 6, wg = blockIdx.x, G = gridDim.x;
    unsigned char* ws = a.ws;
    for (int it = wg; it < NB * NE; it += G) topk_item(a, lds, it);
    __syncthreads();
    while (conv_try(a, lds, true, cdone)) {}
}

__device__ __forceinline__ void phase_final(const Args& a) {
    const int tid = threadIdx.x, lane = tid & 63, wave = tid >> 6, wg = blockIdx.x, G = gridDim.x;
    unsigned char* ws = a.ws;
    const float* modr = (const float*)(ws + WS_MOD); const int* slot_of = (const int*)(ws + WS_SLOT); const bf16* ys = (const bf16*)(ws + WS_YSLAB);
    const int NGW = G * NWAVES;
    f32x4 gf[4];
#pragma unroll
    for (int j = 0; j < 4; ++j) gf[j] = *(const f32x4*)(a.in[28] + 4 * lane + 256 * j);
#pragma nounroll
    for (int r0 = wg * NWAVES + wave; r0 < MX; r0 += 4 * NGW) {
        int sv[4]; unsigned long long mk[4]; f32x4 v[4][4], m[4][4];
#pragma unroll
        for (int k = 0; k < 4; ++k) { const int r = r0 + k * NGW; const bool ok = r < MX; const int rc = ok ? r : r0, b = rc >> 12, t = rc & 4095;
            sv[k] = (lane < NE) ? slot_of[((size_t)b * NE + lane) * SEQ + t] : -1;
#pragma unroll
            for (int j = 0; j < 4; ++j) { v[k][j] = *(const f32x4*)(a.out + (size_t)rc * DM + 4 * lane + 256 * j); m[k][j] = (f32x4){0.f, 0.f, 0.f, 0.f}; }
            mk[k] = (ok && !DBG_NOMOE) ? __ballot(sv[k] >= 0) : 0ull; }
        while (mk[0] | mk[1] | mk[2] | mk[3]) {
            v2u w[4][4]; float wt[4];
#pragma unroll
            for (int k = 0; k < 4; ++k) { const bool has = mk[k] != 0ull; const int e = has ? (int)__ffsll((long long)mk[k]) - 1 : 0; mk[k] &= mk[k] - 1ull;
                const int rc = (r0 + k * NGW < MX) ? r0 + k * NGW : r0; const int sl = has ? __builtin_amdgcn_readlane(sv[k], e) : 0;
                const bf16* yp = ys + ((size_t)e * 2048 + (rc >> 12) * CAP + sl) * DM; wt[k] = has ? 1.f : 0.f;
#pragma unroll
                for (int j = 0; j < 4; ++j) w[k][j] = *(const v2u*)(yp + 4 * lane + 256 * j); }
#pragma unroll
            for (int k = 0; k < 4; ++k)
#pragma unroll
                for (int j = 0; j < 4; ++j) { m[k][j][0] += wt[k] * bflo(w[k][j].x); m[k][j][1] += wt[k] * bfhi(w[k][j].x); m[k][j][2] += wt[k] * bflo(w[k][j].y); m[k][j][3] += wt[k] * bfhi(w[k][j].y); }
        }
        f32x4 gt[4][4];
#pragma unroll
        for (int k = 0; k < 4; ++k) { const int r = r0 + k * NGW, b = ((r < MX) ? r : r0) >> 12;
#pragma unroll
            for (int j = 0; j < 4; ++j) gt[k][j] = *(const f32x4*)(modr + b * 6144 + 5120 + 4 * lane + 256 * j); }
#pragma unroll
        for (int k = 0; k < 4; ++k) { const int r = r0 + k * NGW;
            if (r < MX) { float ss = 0.f; float* row = a.out + (size_t)r * DM;
#pragma unroll
                for (int j = 0; j < 4; ++j) { v[k][j] = v[k][j] + gt[k][j] * m[k][j] * DBG_MOE_K;
                    ss += v[k][j][0] * v[k][j][0] + v[k][j][1] * v[k][j][1] + v[k][j][2] * v[k][j][2] + v[k][j][3] * v[k][j][3]; }
                const float rs = rsqrtf(wave_sum(ss) * (1.0f / DM) + EPS);
#pragma unroll
                for (int j = 0; j < 4; ++j) *(f32x4*)(row + 4 * lane + 256 * j) = v[k][j] * rs * gf[j]; } }
    }
}

__global__ void __launch_bounds__(NTHR, 2) fwd_kernel(Args a) {
    extern __shared__ __attribute__((aligned(16))) unsigned char lds_raw[];
    LAS unsigned char* lds = (LAS unsigned char*)lds_raw;
    const int tid = threadIdx.x, wg = blockIdx.x, G = gridDim.x;
    unsigned char* ws = a.ws;
    volatile LAS unsigned* MISC = (volatile LAS unsigned*)(lds + LDS_MISC);
    if (tid < 64) MISC[tid] = 0u;
    __syncthreads();
    unsigned bgen = 0u, cdone = 0u;
    XcdBarrier bar; bar.bar = (unsigned*)(ws + WS_CTL); bar.x = 0; bar.st = nullptr;
    if (a.ph_hi - a.ph_lo > 1) bar = xcd_barrier_post((unsigned*)(ws + WS_CTL), MISC + 8);
#ifndef PH_ONLY
#define PH_ONLY -1
#endif
#define IN(k) ((PH_ONLY < 0 || PH_ONLY == (k)) && a.ph_lo <= (k) && (k) < a.ph_hi)
#ifndef DBG_BAR2
#define DBG_BAR2 0
#endif
#ifndef DBG_TSA
#define DBG_TSA -1
#endif
#ifndef DBG_TSB
#define DBG_TSB -1
#endif
#define STAMP(k) do { if (DBG_TSA >= 0 && wg == 0 && tid == 0) ((unsigned long long*)(ws + WS_CTL + 49152))[k] = __builtin_amdgcn_s_memrealtime(); } while (0)
#define SEAM(k) do { if (IN(k) && IN((k) + 1)) { seam_barrier(bar, a, lds, MISC, bgen, (k) >= 6, cdone); if (DBG_BAR2) xcd_barrier(bar); } STAMP((k) + 1); } while (0)
#ifndef DBG_DUP
#define DBG_DUP -1
#endif
#define REP(k) _Pragma("nounroll") for (int _rep = 0; _rep < ((DBG_DUP == (k)) ? 2 : 1); ++_rep, (void)((DBG_DUP == (k) && _rep == 1) ? (xcd_barrier(bar), 0) : 0))
    STAMP(0);
    if (IN(0)) REP(0) { phase0(a, lds); } SEAM(0);
    if (IN(1)) REP(1) { phase1(a, lds); } SEAM(1);
    if (IN(2)) REP(2) {
        pg8::Gemm g{(const pg8::bf16_t*)ws, (const pg8::bf16_t*)ws, MT, NIN, DM}; InSched S; S.init(G, wg, 0);
        EpiIn E{(bf16*)(ws + WS_QKVG), (bf16*)(ws + WS_HYT), (float*)(ws + WS_AFB)};
        pg8::gemm_phase<EpiIn, InSched, true, true>(lds, g, S, E);
    } SEAM(2);
    if (IN(3)) REP(3) {
        {   pg8::Gemm g{(const pg8::bf16_t*)ws, (const pg8::bf16_t*)ws, MT, NIN, DM}; InSched S; S.init(G, wg, 1);
            EpiIn E{(bf16*)(ws + WS_QKVG), (bf16*)(ws + WS_HYT), (float*)(ws + WS_AFB)};
            pg8::gemm_phase<EpiIn, InSched, true, true>(lds, g, S, E); }
        for (int it = wg; it < 512; it += G) hyena_item(a, lds, it, 0);
        {   GlaIn I, N; bool have = false;
            const bool split = (G == 256);
            const int first = split ? ((wg < 80) ? wg : 80 + wg) : wg, stride = split ? ((wg < 80) ? 80 : 176) : G, limit = split ? ((wg < 80) ? 160 : 16 * NCH) : 16 * NCH;
            for (int r = first; r < limit; r += stride) {
                const int nr = r + stride; const bool hasn = nr < limit;
                if (!have) { int t0 = threadIdx.x; asm volatile("" : "+v"(t0)); gla_load<false>(a, t0, r / NCH, r % NCH, I); have = true; }
                if (hasn) gla_upd_item<true>(a, lds, r / NCH, r % NCH, I, nr / NCH, nr % NCH, N); else gla_upd_item<false>(a, lds, r / NCH, r % NCH, I, 0, 0, N);
                I = N; } }
    } SEAM(3);
    if (IN(4)) REP(4) {
        for (int it = wg; it < 1024; it += G) { if (it < 512) hyena_item(a, lds, it, 1); else gla_scan_item(a, it - 512); }
    } SEAM(4);
    if (IN(5)) REP(5) {
        GlaIn I, N; bool have = false;
        for (int it = wg; it < 1280; it += G) {
            if (it >= 1024) { hy_transpose_item(a, lds, it - 1024); continue; }
            const int nr = it + G; const bool hasn = nr < 1024;
            if (!have) { int t0 = threadIdx.x; asm volatile("" : "+v"(t0)); gla_load<true>(a, t0, it >> 6, it & 63, I); have = true; }
            if (hasn) gla_out_item<true>(a, lds, it >> 6, it & 63, I, nr >> 6, nr & 63, N); else gla_out_item<false>(a, lds, it >> 6, it & 63, I, 0, 0, N);
            I = N; }
    } SEAM(5);
    if (IN(6)) REP(6) {
        pg8::Gemm g{(const pg8::bf16_t*)(ws + WS_AOUT), (const pg8::bf16_t*)(ws + WS_WOUT), MX, DM, DM}; pg8::StaticOrder S; S.init(MX, DM, G, wg);
        EpiOut E{a.in[0], (const float*)(ws + WS_POS), (const float*)(ws + WS_MOD), a.out};
        pg8::gemm_phase<EpiOut, pg8::StaticOrder, false, true>(lds, g, S, E);
    } SEAM(6);
    if (IN(7)) REP(7) { phase_router(a, lds); } SEAM(7);
    if (IN(8)) REP(8) { phase_topk(a, lds, cdone); } SEAM(8);
    if (IN(9)) REP(9) {
        pg8::Gemm g{(const pg8::bf16_t*)(ws + WS_HN), (const pg8::bf16_t*)(ws + WS_WGU), NE * 2048, NE * 2048, DM}; MoeSched<8> S; S.init(G, wg);
        EpiGU E{(bf16*)(ws + WS_HID)};
        pg8::gemm_phase_gather<EpiGU, MoeSched<8>, true, true>(lds, g, S, E, (const int*)(ws + WS_SELT));
    } SEAM(9);
    if (IN(10)) REP(10) {
        pg8::Gemm g{(const pg8::bf16_t*)(ws + WS_HID), (const pg8::bf16_t*)(ws + WS_WD), NE * 2048, NE * 1024, DM}; MoeSched<4> S; S.init(G, wg);
        EpiDown E{(bf16*)(ws + WS_YSLAB), (const float*)(ws + WS_SELV)};
        pg8::gemm_phase<EpiDown, MoeSched<4>, true, true>(lds, g, S, E);
    } SEAM(10);
    if (IN(11)) { phase_final(a); }
    if (DBG_TSA >= 0) {
        xcd_barrier(bar); STAMP(12); xcd_barrier(bar);
        const unsigned long long* ts = (const unsigned long long*)(ws + WS_CTL + 49152);
        const float da = (DBG_TSA == 12) ? (float)(ts[12] - ts[0]) * 0.01f : (float)(ts[DBG_TSA + 1] - ts[DBG_TSA]) * 0.01f;
        const float db = (DBG_TSB == 12) ? (float)(ts[12] - ts[0]) * 0.01f : (float)(ts[DBG_TSB + 1] - ts[DBG_TSB]) * 0.01f;
        for (size_t i = (size_t)wg * NTHR + tid; i < (size_t)MX * DM; i += (size_t)G * NTHR) a.out[i] = (i < (size_t)MX * DM / 2) ? da : db;
    }
#undef IN
#undef SEAM
}


#ifdef DBG_STATE
__global__ void chk_kernel(const unsigned* p, size_t nwords, unsigned long long* out) {
    unsigned long long s = 0ull;
    for (size_t i = (size_t)blockIdx.x * blockDim.x + threadIdx.x; i < nwords; i += (size_t)gridDim.x * blockDim.x) s += (unsigned long long)p[i] * (2ull * i + 1ull);
    for (int o = 1; o < 64; o <<= 1) s += __shfl_xor(s, o);
    if ((threadIdx.x & 63) == 0) atomicAdd(out, s);
}
__global__ void report_kernel(const unsigned long long* chk, float* out, int n) {
    int bad = -1;
    for (int p = 0; p < 27; ++p) if (chk[p] != chk[32 + p]) { bad = p; break; }
    if (bad < 0) return;
    for (int i = blockIdx.x * blockDim.x + threadIdx.x; i < n; i += gridDim.x * blockDim.x) out[i] = 1000.f * (float)(bad + 1);
}
struct ChkEnt { int ph; size_t off; size_t bytes; };
#endif
extern "C" void kernel_launch(void* const* d_in, const int* in_sizes, int n_in, void* d_out, int out_size, void* d_ws, size_t ws_size, hipStream_t stream) {
    static int grid = 0;
    if (grid == 0) {
        if (n_in != 29 || out_size != MX * DM || ws_size < WS_END) { fprintf(stderr, "kernel_launch: unexpected shapes (n_in %d out %d ws %zu)\n", n_in, out_size, ws_size); grid = -1; return; }
        int dev = 0, cus = 0, per_cu = 0;
        if (hipGetDevice(&dev) != hipSuccess || hipDeviceGetAttribute(&cus, hipDeviceAttributeMultiprocessorCount, dev) != hipSuccess) { grid = -1; return; }
        if (hipFuncSetAttribute((const void*)fwd_kernel, hipFuncAttributeMaxDynamicSharedMemorySize, LDS_BYTES) != hipSuccess) { fprintf(stderr, "kernel_launch: hipFuncSetAttribute failed\n"); grid = -1; return; }
        if (hipOccupancyMaxActiveBlocksPerMultiprocessor(&per_cu, (const void*)fwd_kernel, NTHR, LDS_BYTES) != hipSuccess || per_cu < 1) fprintf(stderr, "kernel_launch: occupancy query reports %d\n", per_cu);
        (void)hipGetLastError();
        grid = cus;
    }
    if (grid < 0) return;
    (void)hipMemsetAsync((char*)d_ws + WS_CTL, 0, CTL_BYTES, stream);
    Args a{};
    for (int i = 0; i < 29; ++i) a.in[i] = (const float*)d_in[i];
    a.out = (float*)d_out; a.ws = (unsigned char*)d_ws;
#if MK_SINGLE
#ifdef DBG_TWICE
    a.ph_lo = 0; a.ph_hi = NPH - 1;
    hipLaunchKernelGGL(fwd_kernel, dim3(grid), dim3(NTHR), LDS_BYTES, stream, a);
    (void)hipMemsetAsync((char*)d_ws + WS_CTL, 0, CTL_BYTES, stream);
#endif
    a.ph_lo = 0; a.ph_hi = NPH;
    hipLaunchKernelGGL(fwd_kernel, dim3(grid), dim3(NTHR), LDS_BYTES, stream, a);
#else
#ifdef DBG_STATE
    static const ChkEnt ents[] = { {0, WS_MOD, 122880}, {0, WS_POS, 131072}, {0, WS_HT, 32 * MiB}, {0, WS_WIN, (size_t)NIN * DM * 2}, {0, WS_WOUT, 2 * MiB},
        {1, WS_AIN, 34 * MiB}, {2, WS_QKVG, (size_t)MX * NQ * 2}, {2, WS_HYT, 48 * MiB}, {2, WS_AFB, (size_t)MT * 128},
        {3, WS_ZT, 32 * MiB}, {3, WS_DEC, (size_t)16 * 2 * NCH * 64 * 4}, {3, WS_UCTX, 4 * MiB}, {3, (size_t)-1, 64 * MiB},
        {4, WS_SPREV, 32 * MiB}, {4, WS_YHYT, 32 * MiB}, {5, WS_AOUT, 32 * MiB}, {6, (size_t)-1, 64 * MiB}, {7, WS_HN, 32 * MiB}, {7, WS_AFF, 1 * MiB},
        {8, WS_SLOT, 1 * MiB}, {8, WS_SELT, 131072}, {8, WS_SELV, 131072}, {8, WS_WGU, 64 * MiB}, {8, WS_WD, 32 * MiB}, {9, WS_HID, 64 * MiB}, {10, WS_YSLAB, 64 * MiB}, {11, (size_t)-1, 64 * MiB} };
    unsigned long long* chk = (unsigned long long*)((char*)d_ws + 32768);
    for (int run = 0; run < 2; ++run)
        for (int p = 0; p < NPH; ++p) { a.ph_lo = p; a.ph_hi = p + 1; hipLaunchKernelGGL(fwd_kernel, dim3(grid), dim3(NTHR), LDS_BYTES, stream, a);
            for (const ChkEnt& e : ents) if (e.ph == p) hipLaunchKernelGGL(chk_kernel, dim3(1024), dim3(256), 0, stream, (const unsigned*)(e.off == (size_t)-1 ? (char*)d_out : (char*)d_ws + e.off), e.bytes / 4, chk + run * 32 + (int)(&e - ents)); }
    hipLaunchKernelGGL(report_kernel, dim3(1024), dim3(256), 0, stream, (const unsigned long long*)chk, (float*)d_out, out_size);
#else
    for (int p = 0; p < NPH; ++p) { a.ph_lo = p; a.ph_hi = p + 1; hipLaunchKernelGGL(fwd_kernel, dim3(grid), dim3(NTHR), LDS_BYTES, stream, a); }
#endif
#endif
}
```

```cpp
#include <hip/hip_runtime.h>
#include <cstdio>
#include <cstdint>
#define MK_SINGLE 1
namespace pg8 {
#define PG8_LAS __attribute__((address_space(3)))
typedef unsigned short bf16_t;
typedef short bf16x8 __attribute__((ext_vector_type(8)));
typedef float f32x4 __attribute__((ext_vector_type(4)));
typedef unsigned u32x4 __attribute__((ext_vector_type(4)));
constexpr int BM = 256, BK = 64, HALF = 128, HTB = HALF * BK * 2  , STAGE_BYTES = 8 * HTB, NXCD = 8, WGM = 8;

__host__ __device__ __forceinline__ int lds_byte(int r, int c) { const int st = (r >> 4) * 2 + (c >> 5), rr = r & 15, cc = c & 31, ob = rr * 64 + cc * 2; return st * 1024 + (ob ^ (((ob >> 9) & 1) << 5)); }
__host__ __device__ __forceinline__ void stage_rc(int b, int& R, int& C) { const int st = b / 1024, sb = b % 1024, swz = sb ^ (((sb >> 9) & 1) << 5); R = (st >> 1) * 16 + swz / 64; C = (st & 1) * 32 + (swz % 64) / 2; }
__host__ __device__ __forceinline__ int perm32(int rho) { const int n = rho >> 4, i = rho & 15; return 8 * (i >> 2) + 4 * n + (i & 3); }

struct Unit { int pm, pn; };
struct Gemm { const bf16_t* A; const bf16_t* Bt; int M, N, K; };

struct StaticOrder {
    int nM, nN, nwg, G, c;
    __host__ __device__ void init(int M, int N, int G_, int c_) { nM = M / BM; nN = N / BM; nwg = nM * nN; G = G_; c = c_; }
    __host__ __device__ bool next(int i, Unit& u) const {
        const long L = (long)i * G + c; if (L >= nwg) return false;
        int wgid = (int)L; { const int q = nwg / NXCD, r = nwg % NXCD, xcd = wgid % NXCD, off = wgid / NXCD; wgid = (xcd < r ? xcd * (q + 1) : r * (q + 1) + (xcd - r) * q) + off; }
        const int nig = WGM * nN, gid = wgid / nig, fm = gid * WGM, gsz = (nM - fm) < WGM ? (nM - fm) : WGM;
        u.pm = fm + ((wgid % nig) % gsz); u.pn = (wgid % nig) / gsz; return true;
    }
    __device__ __forceinline__ void a_ready(const Unit&) const {}
    __device__ __forceinline__ void done(const Unit&) const {}
};

__device__ __forceinline__ unsigned cvt_pk_bf16(float lo, float hi) { unsigned r; asm volatile("v_cvt_pk_bf16_f32 %0, %1, %2" : "=v"(r) : "v"(lo), "v"(hi)); return r; }
template <class Epi, class Sched, bool ALIGN_EPI = false, bool SP2 = false>
__device__ __forceinline__ void gemm_phase(PG8_LAS unsigned char* lds, const Gemm g, const Sched& S, const Epi& E) {
    const int tid = threadIdx.x, wid = __builtin_amdgcn_readfirstlane(tid >> 6), lane = tid & 63, wr = wid >> 2, wc = wid & 3, fr = lane & 15, fq = lane >> 4;
    const int K = g.K, nt = K / BK;
    unsigned voffA[2], voffB[2];
#pragma unroll
    for (int i = 0; i < 2; ++i) { int R, C; stage_rc(tid * 16 + i * 8192, R, C); const int Rb = Epi::PERM ? ((R & ~31) + perm32(R & 31)) : R;
        voffA[i] = (unsigned)(R * K + C) * 2u; voffB[i] = (unsigned)(Rb * K + C) * 2u; }
    const size_t kstep = (size_t)(BK * 2);
    const size_t hstep = (size_t)HALF * K * 2;
    const size_t tstep = 2 * hstep;
    const unsigned ldsw = (unsigned)wid * 1024u;
    const int aoff = lds_byte(wr * 64 + fr, fq * 8), boff = lds_byte(wc * 32 + fr, fq * 8);
#define PG8_SA(b, h) (((b) * 2 + (h)) * HTB)
#define PG8_SB(b, h) ((4 + (b) * 2 + (h)) * HTB)
#define PG8_STAGE(bufoff, gbase, voff) do { _Pragma("unroll") for (int _i = 0; _i < 2; ++_i) \
        __builtin_amdgcn_global_load_lds((const unsigned*)((const char*)(gbase) + (voff)[_i]), (PG8_LAS unsigned*)(lds + (bufoff) + ldsw + _i * 8192), 16, 0, 0); } while (0)
#define PG8_LDA(dst, b, h) do { _Pragma("unroll") for (int m = 0; m < 4; ++m) _Pragma("unroll") for (int k = 0; k < 2; ++k) dst[m][k] = *(const PG8_LAS bf16x8*)(lds + PG8_SA(b, h) + aoff + m * 2048 + k * 1024); } while (0)
#define PG8_LDB(dst, b, h) do { _Pragma("unroll") for (int n = 0; n < 2; ++n) _Pragma("unroll") for (int k = 0; k < 2; ++k) dst[n][k] = *(const PG8_LAS bf16x8*)(lds + PG8_SB(b, h) + boff + n * 2048 + k * 1024); } while (0)
#define PG8_MMA(ai, bj, At, Bt) do { __builtin_amdgcn_s_setprio(1); _Pragma("unroll") for (int m = 0; m < 4; ++m) _Pragma("unroll") for (int n = 0; n < 2; ++n) _Pragma("unroll") for (int k = 0; k < 2; ++k) \
        acc[ai][bj][m][n] = __builtin_amdgcn_mfma_f32_16x16x32_bf16(Bt[n][k], At[m][k], acc[ai][bj][m][n], 0, 0, 0); __builtin_amdgcn_s_setprio(0); } while (0)
#define PG8_WAIT_V(n) asm volatile("s_waitcnt vmcnt(" #n ")" ::: "memory")
#define PG8_WAIT_L(n) asm volatile("s_waitcnt lgkmcnt(" #n ")" ::: "memory")
#define PG8_BAR __builtin_amdgcn_s_barrier()
#define PG8_SCHED __builtin_amdgcn_sched_barrier(0)
    Unit cur, nxt; int ui = 0;
    if (!S.next(0, cur)) return;
    f32x4 acc[2][2][4][2];
#pragma unroll
    for (int a = 0; a < 2; ++a)
#pragma unroll
        for (int b = 0; b < 2; ++b)
#pragma unroll
            for (int m = 0; m < 4; ++m)
#pragma unroll
                for (int n = 0; n < 2; ++n) acc[a][b][m][n] = (f32x4){0.f, 0.f, 0.f, 0.f};
    bf16x8 At[4][2], B0[2][2], B1[2][2];
    const char* cA = (const char*)g.A + (size_t)cur.pm * tstep; const char* cB = (const char*)g.Bt + (size_t)cur.pn * tstep;
    S.a_ready(cur);
    if constexpr (SP2) {
        PG8_STAGE(PG8_SB(0, 0), cB, voffB); PG8_STAGE(PG8_SB(0, 1), cB + hstep, voffB); PG8_STAGE(PG8_SA(0, 0), cA, voffA); PG8_STAGE(PG8_SA(0, 1), cA + hstep, voffA);
        if (wr == 1) PG8_BAR;
        PG8_WAIT_V(2); PG8_BAR;
        PG8_STAGE(PG8_SB(1, 0), cB + kstep, voffB); PG8_STAGE(PG8_SA(1, 0), cA + kstep, voffA); PG8_STAGE(PG8_SB(1, 1), cB + hstep + kstep, voffB);
        PG8_WAIT_V(6); PG8_BAR;
    } else {
        PG8_STAGE(PG8_SB(0, 0), cB, voffB); PG8_STAGE(PG8_SA(0, 0), cA, voffA); PG8_STAGE(PG8_SB(0, 1), cB + hstep, voffB); PG8_STAGE(PG8_SA(0, 1), cA + hstep, voffA);
        if (wr == 1) PG8_BAR;
        PG8_WAIT_V(4); PG8_BAR;
        PG8_STAGE(PG8_SB(1, 0), cB + kstep, voffB); PG8_STAGE(PG8_SA(1, 0), cA + kstep, voffA); PG8_STAGE(PG8_SB(1, 1), cB + hstep + kstep, voffB);
        PG8_WAIT_V(6); PG8_BAR;
    }
    for (;;) {
        const bool has_next = S.next(ui + 1, nxt);
        const char* nA = has_next ? (const char*)g.A + (size_t)nxt.pm * tstep : cA; const char* nB = has_next ? (const char*)g.Bt + (size_t)nxt.pn * tstep : cB;
        for (int t = 0; t < nt; t += 2) {
            const bool last = (t == nt - 2);
            const char* a1 = cA + (size_t)(t + 1) * kstep;
            const char* a2 = last ? nA : cA + (size_t)(t + 2) * kstep; const char* b2 = last ? nB : cB + (size_t)(t + 2) * kstep;
            const char* a3 = a2 + kstep; const char* b3 = b2 + kstep;
            if (last && has_next) S.a_ready(nxt);
            if constexpr (SP2) {
            PG8_LDB(B0, 0, 0); PG8_LDB(B1, 0, 1); PG8_SCHED; PG8_LDA(At, 0, 0); PG8_STAGE(PG8_SA(1, 1), a1 + hstep, voffA);
            PG8_WAIT_V(8); PG8_WAIT_L(0); PG8_BAR; PG8_MMA(0, 0, At, B0); PG8_MMA(0, 1, At, B1); PG8_BAR; PG8_SCHED;
            PG8_LDA(At, 0, 1); PG8_STAGE(PG8_SB(0, 0), b2, voffB); PG8_STAGE(PG8_SB(0, 1), b2 + hstep, voffB); PG8_STAGE(PG8_SA(0, 0), a2, voffA);
            PG8_WAIT_V(8); PG8_WAIT_L(0); PG8_BAR; PG8_MMA(1, 0, At, B0); PG8_MMA(1, 1, At, B1); PG8_BAR; PG8_SCHED;
            PG8_LDB(B0, 1, 0); PG8_LDB(B1, 1, 1); PG8_SCHED; PG8_LDA(At, 1, 0); PG8_STAGE(PG8_SA(0, 1), a2 + hstep, voffA);
            PG8_WAIT_V(8); PG8_WAIT_L(0); PG8_BAR; PG8_MMA(0, 0, At, B0); PG8_MMA(0, 1, At, B1); PG8_BAR; PG8_SCHED;
            PG8_LDA(At, 1, 1); PG8_STAGE(PG8_SB(1, 0), b3, voffB); PG8_STAGE(PG8_SB(1, 1), b3 + hstep, voffB); PG8_STAGE(PG8_SA(1, 0), a3, voffA);
            PG8_WAIT_V(8); PG8_WAIT_L(0); PG8_BAR; PG8_MMA(1, 0, At, B0); PG8_MMA(1, 1, At, B1); PG8_BAR; PG8_SCHED;
            } else {
            PG8_LDB(B0, 0, 0); PG8_SCHED; PG8_LDA(At, 0, 0); PG8_STAGE(PG8_SA(1, 1), a1 + hstep, voffA);
            PG8_WAIT_L(8); PG8_BAR; PG8_WAIT_L(0); PG8_MMA(0, 0, At, B0); PG8_BAR; PG8_SCHED;
            PG8_LDB(B1, 0, 1); PG8_STAGE(PG8_SB(0, 0), b2, voffB);
            PG8_BAR; PG8_WAIT_L(0); PG8_MMA(0, 1, At, B1); PG8_BAR;
            PG8_LDA(At, 0, 1); PG8_STAGE(PG8_SA(0, 0), a2, voffA);
            PG8_BAR; PG8_WAIT_L(0); PG8_MMA(1, 0, At, B0); PG8_BAR; PG8_SCHED;
            PG8_STAGE(PG8_SB(0, 1), b2 + hstep, voffB);
            PG8_WAIT_V(6); PG8_BAR; PG8_MMA(1, 1, At, B1); PG8_BAR;
            PG8_LDB(B0, 1, 0); PG8_SCHED; PG8_LDA(At, 1, 0); PG8_STAGE(PG8_SA(0, 1), a2 + hstep, voffA);
            PG8_WAIT_L(8); PG8_BAR; PG8_WAIT_L(0); PG8_MMA(0, 0, At, B0); PG8_BAR; PG8_SCHED;
            PG8_LDB(B1, 1, 1); PG8_STAGE(PG8_SB(1, 0), b3, voffB);
            PG8_BAR; PG8_WAIT_L(0); PG8_MMA(0, 1, At, B1); PG8_BAR;
            PG8_LDA(At, 1, 1); PG8_STAGE(PG8_SA(1, 0), a3, voffA);
            PG8_BAR; PG8_WAIT_L(0); PG8_MMA(1, 0, At, B0); PG8_BAR; PG8_SCHED;
            PG8_STAGE(PG8_SB(1, 1), b3 + hstep, voffB);
            PG8_WAIT_V(6); PG8_BAR; PG8_MMA(1, 1, At, B1); PG8_BAR;
            }
        }
        if constexpr (ALIGN_EPI) { if (wr == 0) PG8_BAR; }
        if constexpr (!Epi::AFTER_DRAIN) { E(acc, cur, wr, wc, fr, fq); S.done(cur); }
        if (!has_next) break;
#pragma unroll
        for (int a = 0; a < 2; ++a)
#pragma unroll
            for (int b = 0; b < 2; ++b)
#pragma unroll
                for (int m = 0; m < 4; ++m)
#pragma unroll
                    for (int n = 0; n < 2; ++n) acc[a][b][m][n] = (f32x4){0.f, 0.f, 0.f, 0.f};
        cur = nxt; cA = nA; cB = nB; ++ui;
        if constexpr (ALIGN_EPI) { if (wr == 1) PG8_BAR; }
    }
    PG8_WAIT_V(0);
    if constexpr (!ALIGN_EPI) { if (wr == 0) PG8_BAR; }
    PG8_BAR;
    if constexpr (Epi::AFTER_DRAIN) { E.fused(acc, cur, wr, wc, fr, fq, lds, wid, lane); S.done(cur); }
#undef PG8_SA
#undef PG8_SB
#undef PG8_STAGE
#undef PG8_LDA
#undef PG8_LDB
#undef PG8_MMA
#undef PG8_WAIT_V
#undef PG8_WAIT_L
#undef PG8_BAR
#undef PG8_SCHED
}
}
namespace pg8 {
template <class Epi, class Sched, bool ALIGN_EPI = false, bool SP2 = false>
__device__ __forceinline__ void gemm_phase_gather(PG8_LAS unsigned char* lds, const Gemm g, const Sched& S, const Epi& E, const int* __restrict__ idx) {
    const int tid = threadIdx.x, wid = __builtin_amdgcn_readfirstlane(tid >> 6), lane = tid & 63, wr = wid >> 2, wc = wid & 3, fr = lane & 15, fq = lane >> 4;
    const int K = g.K, nt = K / BK;
    unsigned voffB[2]; int RA[2], CA[2];
#pragma unroll
    for (int i = 0; i < 2; ++i) { int R, C; stage_rc(tid * 16 + i * 8192, R, C); const int Rb = Epi::PERM ? ((R & ~31) + perm32(R & 31)) : R;
        RA[i] = R; CA[i] = C; voffB[i] = (unsigned)(Rb * K + C) * 2u; }
    unsigned vA[2][2], nvA[2][2];
#define PG8_GOFF(dst, pm) do { _Pragma("unroll") for (int _h = 0; _h < 2; ++_h) _Pragma("unroll") for (int _i = 0; _i < 2; ++_i) { const int _r = (pm) * 256 + _h * 128 + RA[_i]; \
        dst[_h][_i] = (unsigned)((((_r >> 9) & 3) * 4096 + idx[_r]) * K + CA[_i]) * 2u; } } while (0)
    const size_t kstep = (size_t)(BK * 2);
    const size_t hstep = (size_t)HALF * K * 2;
    const size_t tstep = 2 * hstep;
    const unsigned ldsw = (unsigned)wid * 1024u;
    const int aoff = lds_byte(wr * 64 + fr, fq * 8), boff = lds_byte(wc * 32 + fr, fq * 8);
#define PG8_SA(b, h) (((b) * 2 + (h)) * HTB)
#define PG8_SB(b, h) ((4 + (b) * 2 + (h)) * HTB)
#define PG8_STAGE(bufoff, gbase, voff) do { _Pragma("unroll") for (int _i = 0; _i < 2; ++_i) \
        __builtin_amdgcn_global_load_lds((const unsigned*)((const char*)(gbase) + (voff)[_i]), (PG8_LAS unsigned*)(lds + (bufoff) + ldsw + _i * 8192), 16, 0, 0); } while (0)
#define PG8_LDA(dst, b, h) do { _Pragma("unroll") for (int m = 0; m < 4; ++m) _Pragma("unroll") for (int k = 0; k < 2; ++k) dst[m][k] = *(const PG8_LAS bf16x8*)(lds + PG8_SA(b, h) + aoff + m * 2048 + k * 1024); } while (0)
#define PG8_LDB(dst, b, h) do { _Pragma("unroll") for (int n = 0; n < 2; ++n) _Pragma("unroll") for (int k = 0; k < 2; ++k) dst[n][k] = *(const PG8_LAS bf16x8*)(lds + PG8_SB(b, h) + boff + n * 2048 + k * 1024); } while (0)
#define PG8_MMA(ai, bj, At, Bt) do { __builtin_amdgcn_s_setprio(1); _Pragma("unroll") for (int m = 0; m < 4; ++m) _Pragma("unroll") for (int n = 0; n < 2; ++n) _Pragma("unroll") for (int k = 0; k < 2; ++k) \
        acc[ai][bj][m][n] = __builtin_amdgcn_mfma_f32_16x16x32_bf16(Bt[n][k], At[m][k], acc[ai][bj][m][n], 0, 0, 0); __builtin_amdgcn_s_setprio(0); } while (0)
#define PG8_WAIT_V(n) asm volatile("s_waitcnt vmcnt(" #n ")" ::: "memory")
#define PG8_WAIT_L(n) asm volatile("s_waitcnt lgkmcnt(" #n ")" ::: "memory")
#define PG8_BAR __builtin_amdgcn_s_barrier()
#define PG8_SCHED __builtin_amdgcn_sched_barrier(0)
    Unit cur, nxt; int ui = 0;
    if (!S.next(0, cur)) return;
    f32x4 acc[2][2][4][2];
#pragma unroll
    for (int a = 0; a < 2; ++a)
#pragma unroll
        for (int b = 0; b < 2; ++b)
#pragma unroll
            for (int m = 0; m < 4; ++m)
#pragma unroll
                for (int n = 0; n < 2; ++n) acc[a][b][m][n] = (f32x4){0.f, 0.f, 0.f, 0.f};
    bf16x8 At[4][2], B0[2][2], B1[2][2];
    const char* cA = (const char*)g.A; PG8_GOFF(vA, cur.pm); const char* cB = (const char*)g.Bt + (size_t)cur.pn * tstep;
    S.a_ready(cur);
    if constexpr (SP2) {
        PG8_STAGE(PG8_SB(0, 0), cB, voffB); PG8_STAGE(PG8_SB(0, 1), cB + hstep, voffB); PG8_STAGE(PG8_SA(0, 0), cA, vA[0]); PG8_STAGE(PG8_SA(0, 1), cA, vA[1]);
        if (wr == 1) PG8_BAR;
        PG8_WAIT_V(2); PG8_BAR;
        PG8_STAGE(PG8_SB(1, 0), cB + kstep, voffB); PG8_STAGE(PG8_SA(1, 0), cA + kstep, vA[0]); PG8_STAGE(PG8_SB(1, 1), cB + hstep + kstep, voffB);
        PG8_WAIT_V(6); PG8_BAR;
    } else {
        PG8_STAGE(PG8_SB(0, 0), cB, voffB); PG8_STAGE(PG8_SA(0, 0), cA, vA[0]); PG8_STAGE(PG8_SB(0, 1), cB + hstep, voffB); PG8_STAGE(PG8_SA(0, 1), cA, vA[1]);
        if (wr == 1) PG8_BAR;
        PG8_WAIT_V(4); PG8_BAR;
        PG8_STAGE(PG8_SB(1, 0), cB + kstep, voffB); PG8_STAGE(PG8_SA(1, 0), cA + kstep, vA[0]); PG8_STAGE(PG8_SB(1, 1), cB + hstep + kstep, voffB);
        PG8_WAIT_V(6); PG8_BAR;
    }
    for (;;) {
        const bool has_next = S.next(ui + 1, nxt);
        if (has_next) { PG8_GOFF(nvA, nxt.pm); } else { nvA[0][0] = vA[0][0]; nvA[0][1] = vA[0][1]; nvA[1][0] = vA[1][0]; nvA[1][1] = vA[1][1]; } const char* nB = has_next ? (const char*)g.Bt + (size_t)nxt.pn * tstep : cB;
        for (int t = 0; t < nt; t += 2) {
            const bool last = (t == nt - 2);
            const char* a1 = cA + (size_t)(t + 1) * kstep;
            const char* a2 = cA + (last ? (size_t)0 : (size_t)(t + 2) * kstep); unsigned w2[2][2]; w2[0][0] = last ? nvA[0][0] : vA[0][0]; w2[0][1] = last ? nvA[0][1] : vA[0][1]; w2[1][0] = last ? nvA[1][0] : vA[1][0]; w2[1][1] = last ? nvA[1][1] : vA[1][1]; const char* b2 = last ? nB : cB + (size_t)(t + 2) * kstep;
            const char* a3 = a2 + kstep; const char* b3 = b2 + kstep;
            if (last && has_next) S.a_ready(nxt);
            if constexpr (SP2) {
            PG8_LDB(B0, 0, 0); PG8_LDB(B1, 0, 1); PG8_SCHED; PG8_LDA(At, 0, 0); PG8_STAGE(PG8_SA(1, 1), a1, vA[1]);
            PG8_WAIT_V(8); PG8_WAIT_L(0); PG8_BAR; PG8_MMA(0, 0, At, B0); PG8_MMA(0, 1, At, B1); PG8_BAR; PG8_SCHED;
            PG8_LDA(At, 0, 1); PG8_STAGE(PG8_SB(0, 0), b2, voffB); PG8_STAGE(PG8_SB(0, 1), b2 + hstep, voffB); PG8_STAGE(PG8_SA(0, 0), a2, w2[0]);
            PG8_WAIT_V(8); PG8_WAIT_L(0); PG8_BAR; PG8_MMA(1, 0, At, B0); PG8_MMA(1, 1, At, B1); PG8_BAR; PG8_SCHED;
            PG8_LDB(B0, 1, 0); PG8_LDB(B1, 1, 1); PG8_SCHED; PG8_LDA(At, 1, 0); PG8_STAGE(PG8_SA(0, 1), a2, w2[1]);
            PG8_WAIT_V(8); PG8_WAIT_L(0); PG8_BAR; PG8_MMA(0, 0, At, B0); PG8_MMA(0, 1, At, B1); PG8_BAR; PG8_SCHED;
            PG8_LDA(At, 1, 1); PG8_STAGE(PG8_SB(1, 0), b3, voffB); PG8_STAGE(PG8_SB(1, 1), b3 + hstep, voffB); PG8_STAGE(PG8_SA(1, 0), a3, w2[0]);
            PG8_WAIT_V(8); PG8_WAIT_L(0); PG8_BAR; PG8_MMA(1, 0, At, B0); PG8_MMA(1, 1, At, B1); PG8_BAR; PG8_SCHED;
            } else {
            PG8_LDB(B0, 0, 0); PG8_SCHED; PG8_LDA(At, 0, 0); PG8_STAGE(PG8_SA(1, 1), a1, vA[1]);
            PG8_WAIT_L(8); PG8_BAR; PG8_WAIT_L(0); PG8_MMA(0, 0, At, B0); PG8_BAR; PG8_SCHED;
            PG8_LDB(B1, 0, 1); PG8_STAGE(PG8_SB(0, 0), b2, voffB);
            PG8_BAR; PG8_WAIT_L(0); PG8_MMA(0, 1, At, B1); PG8_BAR;
            PG8_LDA(At, 0, 1); PG8_STAGE(PG8_SA(0, 0), a2, w2[0]);
            PG8_BAR; PG8_WAIT_L(0); PG8_MMA(1, 0, At, B0); PG8_BAR; PG8_SCHED;
            PG8_STAGE(PG8_SB(0, 1), b2 + hstep, voffB);
            PG8_WAIT_V(6); PG8_BAR; PG8_MMA(1, 1, At, B1); PG8_BAR;
            PG8_LDB(B0, 1, 0); PG8_SCHED; PG8_LDA(At, 1, 0); PG8_STAGE(PG8_SA(0, 1), a2, w2[1]);
            PG8_WAIT_L(8); PG8_BAR; PG8_WAIT_L(0); PG8_MMA(0, 0, At, B0); PG8_BAR; PG8_SCHED;
            PG8_LDB(B1, 1, 1); PG8_STAGE(PG8_SB(1, 0), b3, voffB);
            PG8_BAR; PG8_WAIT_L(0); PG8_MMA(0, 1, At, B1); PG8_BAR;
            PG8_LDA(At, 1, 1); PG8_STAGE(PG8_SA(1, 0), a3, w2[0]);
            PG8_BAR; PG8_WAIT_L(0); PG8_MMA(1, 0, At, B0); PG8_BAR; PG8_SCHED;
            PG8_STAGE(PG8_SB(1, 1), b3 + hstep, voffB);
            PG8_WAIT_V(6); PG8_BAR; PG8_MMA(1, 1, At, B1); PG8_BAR;
            }
        }
        if constexpr (ALIGN_EPI) { if (wr == 0) PG8_BAR; }
        if constexpr (!Epi::AFTER_DRAIN) { E(acc, cur, wr, wc, fr, fq); S.done(cur); }
        if (!has_next) break;
#pragma unroll
        for (int a = 0; a < 2; ++a)
#pragma unroll
            for (int b = 0; b < 2; ++b)
#pragma unroll
                for (int m = 0; m < 4; ++m)
#pragma unroll
                    for (int n = 0; n < 2; ++n) acc[a][b][m][n] = (f32x4){0.f, 0.f, 0.f, 0.f};
        cur = nxt; cB = nB; ++ui; vA[0][0] = nvA[0][0]; vA[0][1] = nvA[0][1]; vA[1][0] = nvA[1][0]; vA[1][1] = nvA[1][1];
        if constexpr (ALIGN_EPI) { if (wr == 1) PG8_BAR; }
    }
    PG8_WAIT_V(0);
    if constexpr (!ALIGN_EPI) { if (wr == 0) PG8_BAR; }
    PG8_BAR;
    if constexpr (Epi::AFTER_DRAIN) { E.fused(acc, cur, wr, wc, fr, fq, lds, wid, lane); S.done(cur); }
#undef PG8_SA
#undef PG8_SB
#undef PG8_STAGE
#undef PG8_LDA
#undef PG8_LDB
#undef PG8_MMA
#undef PG8_WAIT_V
#undef PG8_WAIT_L
#undef PG8_BAR
#undef PG8_SCHED
#undef PG8_GOFF
}
}

#ifndef DBG_NOMIX
#define DBG_NOMIX 0
#endif
#ifndef DBG_NOMOE
#define DBG_NOMOE 0
#endif
#ifndef DBG_NOPOS
#define DBG_NOPOS 0
#endif
#ifndef DBG_HTCONST
#define DBG_HTCONST 0
#endif
#ifndef DBG_GLA_K
#define DBG_GLA_K 1.0f
#endif
#ifndef DBG_MOE_K
#define DBG_MOE_K 1.0f
#endif
#ifndef MK_SINGLE
#define MK_SINGLE 0
#endif
#define GAS __attribute__((address_space(1)))
#define LAS __attribute__((address_space(3)))
typedef unsigned short bf16;
typedef float f32x4 __attribute__((ext_vector_type(4)));
typedef float f32x16 __attribute__((ext_vector_type(16)));
typedef short bf16x8 __attribute__((ext_vector_type(8)));
typedef unsigned v4u __attribute__((ext_vector_type(4)));
typedef unsigned v2u __attribute__((ext_vector_type(2)));
typedef GAS unsigned gu32;

constexpr int NWAVES = 8, NTHR = 512;
constexpr int NB = 4, SEQ = 4096, DM = 1024, CTXL = 256;
constexpr int MX = NB * SEQ, MC = NB * CTXL, MT = MX + MC;
constexpr int NIN = 3328, NQ = 1536, DIN = 3104;
constexpr int NE = 16, CAP = 512;
constexpr int NCH = 68;
constexpr int NPH = 12;
constexpr float EPS = 1e-6f;

constexpr size_t MiB = 1u << 20;
constexpr size_t WS_CTL = 0, CTL_BYTES = 65536;
constexpr int CW_CNT_D = 8192, CW_CNT_GU = 8192 + 64;
constexpr size_t WS_MOD = 1 * MiB, WS_POS = 1 * MiB + 256 * 1024, WS_DEC = 2 * MiB, WS_AFF = 3 * MiB, WS_SLOT = 4 * MiB, WS_SELT = 5 * MiB, WS_SELV = 5 * MiB + 256 * 1024;
constexpr size_t WS_UCTX = 6 * MiB, WS_AFB = 10 * MiB, WS_WIN = 13 * MiB, WS_WOUT = 20 * MiB;
constexpr size_t WS_R1 = 22 * MiB, WS_R2 = 56 * MiB, WS_R3 = 107 * MiB, WS_R4 = 203 * MiB, WS_R5 = 235 * MiB, WS_R6 = 267 * MiB, WS_END = 299 * MiB;
constexpr size_t WS_AIN = WS_R1, WS_ZT = 155 * MiB, WS_HN = WS_R1;
constexpr size_t WS_QKVG = WS_R2;
constexpr size_t WS_HYT = WS_R3, WS_WD = 171 * MiB;
constexpr size_t WS_WGU = WS_R5;
constexpr size_t WS_HID = WS_R2, WS_YSLAB = WS_R4;
constexpr size_t WS_HT = WS_R4, WS_AOUT = WS_R4;
constexpr size_t WS_SPREV = WS_R1;
constexpr int LDS_BYTES = 144 * 1024;
constexpr int LDS_MISC = LDS_BYTES - 256;

struct Args { const float* in[29]; float* out; unsigned char* ws; int ph_lo, ph_hi; };

#define LDS_WAIT() asm volatile("s_waitcnt lgkmcnt(0)" ::: "memory")
#define VM_WAIT() asm volatile("s_waitcnt vmcnt(0)" ::: "memory")
__device__ __forceinline__ unsigned f2bf(float f) { unsigned u = __float_as_uint(f); return (u + 0x7fffu + ((u >> 16) & 1u)) >> 16; }
__device__ __forceinline__ unsigned pk2(float lo, float hi) { return pg8::cvt_pk_bf16(lo, hi); }
__device__ __forceinline__ float bflo(unsigned w) { return __uint_as_float(w << 16); }
__device__ __forceinline__ float bfhi(unsigned w) { return __uint_as_float(w & 0xffff0000u); }
template <int CTRL> __device__ __forceinline__ float dpp_f(float v) { return __builtin_bit_cast(float, __builtin_amdgcn_update_dpp(0, __builtin_bit_cast(int, v), CTRL, 0xf, 0xf, false)); }
__device__ __forceinline__ void swap16(float& a, float& b) { asm("v_nop\n\tv_nop\n\tv_permlane16_swap_b32 %0, %1" : "+v"(a), "+v"(b)); }
__device__ __forceinline__ void swap32(float& a, float& b) { asm("v_nop\n\tv_nop\n\tv_permlane32_swap_b32 %0, %1" : "+v"(a), "+v"(b)); }
__device__ __forceinline__ float row_allsum(float v) { v += dpp_f<0x128>(v); v += dpp_f<0x124>(v); v += dpp_f<0x122>(v); v += dpp_f<0x121>(v); return v; }
__device__ __forceinline__ float x16_sum(float v) { float a = v, b = v; swap16(a, b); return a + b; }
__device__ __forceinline__ float x32_sum(float v) { float a = v, b = v; swap32(a, b); return a + b; }
__device__ __forceinline__ float x16_max(float v) { float a = v, b = v; swap16(a, b); return fmaxf(a, b); }
__device__ __forceinline__ float x32_max(float v) { float a = v, b = v; swap32(a, b); return fmaxf(a, b); }
__device__ __forceinline__ float wave_sum(float v) { return x32_sum(x16_sum(row_allsum(v))); }
__device__ __forceinline__ float silu_f(float v) { return v * __builtin_amdgcn_rcpf(1.f + __expf(-v)); }
__device__ __forceinline__ float logsig_f(float x) { return fminf(x, 0.f) - __logf(1.0f + __expf(-fabsf(x))); }

#define XB_TMO      128
#define XB_XCNT(j)  (256  + 64 * (j))
#define XB_XSUB(j)  (1280 + 64 * (j))
#define XB_XGEN(j)  (2304 + 64 * (j))
#define XB_TOP      3328
#define XB_TOPGEN   3392
#define XCD_BAR_WORDS 3456
#define XB_SPIN_CAP (1u << 22)
__device__ __forceinline__ unsigned xb_ld(unsigned* p)              { return __hip_atomic_load(p, __ATOMIC_RELAXED, __HIP_MEMORY_SCOPE_AGENT); }
__device__ __forceinline__ unsigned xb_add(unsigned* p, unsigned v) { return __hip_atomic_fetch_add(p, v, __ATOMIC_RELAXED, __HIP_MEMORY_SCOPE_AGENT); }
__device__ __forceinline__ unsigned xb_xcc_id() { return (unsigned)__builtin_amdgcn_s_getreg((3 << 11) | 20) & 0xFu; }
#define XB_SPIN(cond, bar) do { unsigned _sp = 0; while (cond) { __builtin_amdgcn_s_sleep(1); \
    if ((++_sp & 255u) == 0u) { if (xb_ld(&(bar)[XB_TMO])) break; if (_sp > XB_SPIN_CAP) { atomicAdd(&(bar)[XB_TMO], 1u); break; } } } } while (0)
struct XcdBarrier { unsigned* bar; unsigned x; volatile LAS unsigned* st; };
__device__ __forceinline__ XcdBarrier xcd_barrier_post(unsigned* bar, volatile LAS unsigned* st) {
    XcdBarrier b; b.bar = bar; b.x = xb_xcc_id(); b.st = st;
    if (threadIdx.x == 0) (void)xb_add(&bar[XB_XCNT(b.x)], 1u);
    return b;
}
__device__ __forceinline__ void xcd_barrier_complete(unsigned* bar, unsigned x, unsigned& nloc, unsigned& nx) {
    const unsigned G = gridDim.x * gridDim.y * gridDim.z;
    unsigned sum, cnt, mine, sp = 0u;
    for (;;) {
        sum = 0u; cnt = 0u; mine = 0u;
#pragma unroll
        for (unsigned j = 0; j < 16; ++j) { const unsigned c = xb_ld(&bar[XB_XCNT(j)]); sum += c; cnt += (c > 0u) ? 1u : 0u; mine = (j == x) ? c : mine; }
        if (sum == G) break;
        __builtin_amdgcn_s_sleep(1);
        if ((++sp & 255u) == 0u) { if (xb_ld(&bar[XB_TMO])) break; if (sp > XB_SPIN_CAP) { atomicAdd(&bar[XB_TMO], 1u); break; } }
    }
    nloc = mine > 0u ? mine : 1u; nx = cnt > 0u ? cnt : 1u;
}
__device__ __forceinline__ void xcd_barrier(const XcdBarrier& b) {
    asm volatile("s_waitcnt vmcnt(0)" ::: "memory");
    __syncthreads();
    if (threadIdx.x == 0) {
        unsigned* bar = b.bar;
        __builtin_amdgcn_s_waitcnt(0);
        unsigned nloc = b.st[0], nx = b.st[1];
        if (nloc == 0u) { xcd_barrier_complete(bar, b.x, nloc, nx); b.st[0] = nloc; b.st[1] = nx; }
        const unsigned old = xb_add(&bar[XB_XSUB(b.x)], 1u);
        const unsigned gen = old / nloc;
        if (old + 1u == (gen + 1u) * nloc) {
            __builtin_amdgcn_fence(__ATOMIC_RELEASE, "agent");
            asm volatile("s_waitcnt vmcnt(0)" ::: "memory");
            const unsigned og = xb_add(&bar[XB_TOP], 1u);
            const unsigned tg = og / nx;
            if (og + 1u == (tg + 1u) * nx) xb_add(&bar[XB_TOPGEN], 1u);
            else XB_SPIN(xb_ld(&bar[XB_TOPGEN]) == tg, bar);
            __builtin_amdgcn_fence(__ATOMIC_ACQUIRE, "agent");
            xb_add(&bar[XB_XGEN(b.x)], 1u);
            asm volatile("s_waitcnt vmcnt(0)" ::: "memory");
        } else {
            XB_SPIN(xb_ld(&bar[XB_XGEN(b.x)]) == gen, bar);
            __builtin_amdgcn_fence(__ATOMIC_ACQUIRE, "agent");
            asm volatile("s_waitcnt vmcnt(0)" ::: "memory");
        }
    }
    __syncthreads();
}

constexpr int TILE_AIN = (int)(WS_AIN / (512 * 1024)), TILE_WIN = (int)(WS_WIN / (512 * 1024));
struct InSched {
    int G, c, part;
    __device__ void init(int G_, int c_, int part_) { G = G_; c = c_; part = part_; }
    __device__ static void qg_unit(int qg, pg8::Unit& u) { const int t = qg >> 6; u.pm = TILE_AIN + (qg & 63); u.pn = TILE_WIN + ((t == 0) ? 0 : 3 + t); }
    __device__ bool next(int i, pg8::Unit& u) const {
        const int L = i * G + c;
        if (part) { const int qg = 112 + L; if (qg >= 192) return false; qg_unit(qg, u); return true; }
        if (L < 384) { u.pm = TILE_WIN + 6 + (L >> 6); u.pn = TILE_AIN + (L & 63); return true; }
        if (L < 640) { const int l = L - 384, q = l >> 6; u.pm = TILE_AIN + (l & 63); u.pn = TILE_WIN + ((q == 3) ? 12 : (1 + q)); return true; }
        if (L < 656) { const int jx = L - 640, q = jx >> 2; u.pm = TILE_AIN + 64 + (jx & 3); u.pn = TILE_WIN + ((q == 3) ? 12 : (1 + q)); return true; }
        if (L >= 768) return false;
        qg_unit(L - 656, u); return true;
    }
    __device__ __forceinline__ void a_ready(const pg8::Unit&) const {}
    __device__ __forceinline__ void done(const pg8::Unit&) const {}
};
template <int NT> struct MoeSched {
    int G, c;
    __device__ void init(int G_, int c_) { G = G_; c = c_; }
    __device__ bool next(int i, pg8::Unit& u) const {
        const int L = i * G + c; if (L >= NE * 8 * NT) return false;
        const int e = L / (8 * NT), l = L % (8 * NT), x = l & 7, y = l >> 3;
        constexpr int HN = NT / 2;
        const int pm = 2 * (x >> 1) + (y / HN), pn = HN * (x & 1) + (y % HN);
        u.pm = e * 8 + pm; u.pn = e * NT + pn; return true;
    }
    __device__ __forceinline__ void a_ready(const pg8::Unit&) const {}
    __device__ __forceinline__ void done(const pg8::Unit&) const {}
};

struct EpiIn {
    static constexpr bool PERM = true, AFTER_DRAIN = false;
    bf16* qkvg; bf16* hyT; float* afb;
    __device__ __forceinline__ void operator()(const f32x4 (&acc)[2][2][4][2], const pg8::Unit& u, int wr, int wc, int fr, int fq) const {
        if (u.pm < TILE_AIN) {
            const int ch0 = (u.pm - TILE_WIN - 6) * 256 + wr * 64 + fr, mt = u.pn - TILE_AIN, b = mt >> 4, t0 = (mt & 15) * 256 + wc * 32 + 8 * fq;
#pragma unroll
            for (int ai = 0; ai < 2; ++ai)
#pragma unroll
                for (int m = 0; m < 4; ++m) { bf16* rowp = hyT + ((size_t)b * 1536 + ch0 + ai * 128 + m * 16) * SEQ + t0;
#pragma unroll
                    for (int bj = 0; bj < 2; ++bj) { const f32x4 v0 = acc[ai][bj][m][0], v1 = acc[ai][bj][m][1];
                        v4u w; w.x = pk2(v0[0], v0[1]); w.y = pk2(v0[2], v0[3]); w.z = pk2(v1[0], v1[1]); w.w = pk2(v1[2], v1[3]);
                        *(v4u*)(rowp + bj * 128) = w; } }
            return;
        }
        const int pm = u.pm - TILE_AIN, pn = u.pn - TILE_WIN;
        const int row0 = pm * 256 + wr * 64 + fr;
        if (pn < 6) {
            const float sc = (pn == 0) ? 0.125f : 1.f;
            const int col0 = pn * 256 + wc * 32 + 8 * fq;
#pragma unroll
            for (int ai = 0; ai < 2; ++ai)
#pragma unroll
                for (int m = 0; m < 4; ++m) { bf16* rowp = qkvg + (size_t)(row0 + ai * 128 + m * 16) * NQ + col0;
#pragma unroll
                    for (int bj = 0; bj < 2; ++bj) { const f32x4 v0 = acc[ai][bj][m][0] * sc, v1 = acc[ai][bj][m][1] * sc;
                        v4u w; w.x = pk2(v0[0], v0[1]); w.y = pk2(v0[2], v0[3]); w.z = pk2(v1[0], v1[1]); w.w = pk2(v1[2], v1[3]);
                        *(v4u*)(rowp + bj * 128) = w; } }
        } else {
            if (wc != 0) return;
#pragma unroll
            for (int ai = 0; ai < 2; ++ai)
#pragma unroll
                for (int m = 0; m < 4; ++m) { float* rowp = afb + (size_t)(row0 + ai * 128 + m * 16) * 32 + 8 * fq;
                    *(f32x4*)(rowp) = acc[ai][0][m][0]; *(f32x4*)(rowp + 4) = acc[ai][0][m][1]; }
        }
    }
};
struct EpiOut {
    static constexpr bool PERM = false, AFTER_DRAIN = false;
    const float* __restrict__ x; const float* __restrict__ postab; const float* __restrict__ modr; float* __restrict__ x1;
    __device__ __forceinline__ void operator()(const f32x4 (&acc)[2][2][4][2], const pg8::Unit& u, int wr, int wc, int fr, int fq) const {
        const int row0 = u.pm * 256 + wr * 64 + fr, col0 = u.pn * 256 + wc * 32 + 4 * fq;
        const int b = row0 >> 12;
        f32x4 gv[2][2];
#pragma unroll
        for (int bj = 0; bj < 2; ++bj)
#pragma unroll
            for (int n = 0; n < 2; ++n) gv[bj][n] = *(const f32x4*)(modr + b * 6144 + 2048 + col0 + bj * 128 + n * 16);
#pragma unroll
        for (int ai = 0; ai < 2; ++ai)
#pragma unroll
            for (int m = 0; m < 4; ++m) { const int r = row0 + ai * 128 + m * 16; const int t = r & 4095, rr = t >> 6, cc = t & 63;
                f32x4 xv[2][2], pv[2][2];
#pragma unroll
                for (int bj = 0; bj < 2; ++bj)
#pragma unroll
                    for (int n = 0; n < 2; ++n) { const int c = col0 + bj * 128 + n * 16;
                        xv[bj][n] = *(const f32x4*)(x + (size_t)r * DM + c);
                        pv[bj][n] = *(const f32x4*)(postab + ((c < 512) ? rr * 512 + c : cc * 512 + c - 512)); }
#pragma unroll
                for (int bj = 0; bj < 2; ++bj)
#pragma unroll
                    for (int n = 0; n < 2; ++n) { const int c = col0 + bj * 128 + n * 16;
                        *(f32x4*)(x1 + (size_t)r * DM + c) = xv[bj][n] + (DBG_NOPOS ? pv[bj][n] * 0.f : pv[bj][n]) + (DBG_NOMIX ? gv[bj][n] * 0.f : gv[bj][n] * acc[ai][bj][m][n]); } }
    }
};
struct EpiGU {
    static constexpr bool PERM = true, AFTER_DRAIN = false;
    bf16* hid;
    __device__ __forceinline__ void operator()(const f32x4 (&acc)[2][2][4][2], const pg8::Unit& u, int wr, int wc, int fr, int fq) const {
        const int row0 = u.pm * 256 + wr * 64 + fr, col0 = (u.pn & 7) * 128 + wc * 32 + 8 * fq;
#pragma unroll
        for (int ai = 0; ai < 2; ++ai)
#pragma unroll
            for (int m = 0; m < 4; ++m) { bf16* rowp = hid + (size_t)(row0 + ai * 128 + m * 16) * DM + col0;
                float o[8];
#pragma unroll
                for (int n = 0; n < 2; ++n)
#pragma unroll
                    for (int j = 0; j < 4; ++j) o[n * 4 + j] = silu_f(acc[ai][0][m][n][j]) * acc[ai][1][m][n][j];
                v4u w; w.x = pk2(o[0], o[1]); w.y = pk2(o[2], o[3]); w.z = pk2(o[4], o[5]); w.w = pk2(o[6], o[7]);
                *(v4u*)rowp = w; }
    }
};
struct EpiDown {
    static constexpr bool PERM = true, AFTER_DRAIN = false;
    bf16* __restrict__ ys; const float* __restrict__ selv;
    __device__ __forceinline__ void operator()(const f32x4 (&acc)[2][2][4][2], const pg8::Unit& u, int wr, int wc, int fr, int fq) const {
        const int row0 = u.pm * 256 + wr * 64 + fr, col0 = (u.pn & 3) * 256 + wc * 32 + 8 * fq;
        float scv[2][4];
#pragma unroll
        for (int ai = 0; ai < 2; ++ai)
#pragma unroll
            for (int m = 0; m < 4; ++m) scv[ai][m] = selv[row0 + ai * 128 + m * 16];
#pragma unroll
        for (int ai = 0; ai < 2; ++ai)
#pragma unroll
            for (int m = 0; m < 4; ++m) { const int r = row0 + ai * 128 + m * 16; const float sc = scv[ai][m]; bf16* rowp = ys + (size_t)r * DM + col0;
#pragma unroll
                for (int bj = 0; bj < 2; ++bj) { const f32x4 v0 = acc[ai][bj][m][0] * sc, v1 = acc[ai][bj][m][1] * sc;
                    v4u w; w.x = pk2(v0[0], v0[1]); w.y = pk2(v0[2], v0[3]); w.z = pk2(v1[0], v1[1]); w.w = pk2(v1[2], v1[3]);
                    *(v4u*)(rowp + bj * 128) = w; } }
    }
};

__device__ __forceinline__ void transpose_item(const float* W, int ldw, int k0, int nsrc0, bf16* WT, int K, int drow0, LAS float* scr, int lane, bool zero) {
    float tv[32];
#pragma unroll
    for (int i = 0; i < 32; ++i) { const int kk = 2 * i + (lane >> 5); tv[i] = zero ? 0.f : W[(size_t)(k0 + kk) * ldw + nsrc0 + (lane & 31)]; }
#pragma unroll
    for (int i = 0; i < 32; ++i) { const int kk = 2 * i + (lane >> 5); scr[kk * 33 + (lane & 31)] = tv[i]; }
    LDS_WAIT();
    const int c = lane & 7;
#pragma unroll
    for (int j = 0; j < 4; ++j) { const int n = (lane >> 3) + 8 * j; const LAS float* s = scr + (8 * c) * 33 + n;
        v4u o; o.x = pk2(s[0 * 33], s[1 * 33]); o.y = pk2(s[2 * 33], s[3 * 33]); o.z = pk2(s[4 * 33], s[5 * 33]); o.w = pk2(s[6 * 33], s[7 * 33]);
        *(v4u*)(WT + (size_t)(drow0 + n) * K + k0 + 8 * c) = o; }
    LDS_WAIT();
}

__device__ __forceinline__ void phase0(const Args& a, LAS unsigned char* lds) {
    int tid = threadIdx.x; const int wg = blockIdx.x, G = gridDim.x;
    asm volatile("" : "+v"(tid));
    int lane = tid & 63, wave = tid >> 6;
    unsigned char* ws = a.ws;
    for (int it = wg; it < 192; it += G) {
        LAS float* sl = (LAS float*)lds;
        LAS float* red = (LAS float*)(lds + 20480);
        for (int i = tid; i < 5 * 1024; i += NTHR) { const int bb = i >> 10, k = i & 1023; const float v = (bb < 4) ? a.in[1][bb * 1024 + k] : a.in[3][k]; sl[i] = silu_f(v); }
        __syncthreads();
        const int col = it * 32 + (lane & 31), kk = wave * 2 + (lane >> 5);
        float acc[5] = {0.f, 0.f, 0.f, 0.f, 0.f};
        const float* wp = a.in[4] + col;
        float wv[64];
#pragma unroll
        for (int j = 0; j < 64; ++j) wv[j] = wp[(size_t)(kk + 16 * j) * 6144];
#pragma unroll
        for (int j = 0; j < 64; ++j) { const int k = kk + 16 * j;
#pragma unroll
            for (int bb = 0; bb < 5; ++bb) acc[bb] += sl[bb * 1024 + k] * wv[j]; }
#pragma unroll
        for (int bb = 0; bb < 5; ++bb) red[(kk * 5 + bb) * 32 + (lane & 31)] = acc[bb];
        __syncthreads();
        if (tid < 160) { const int bb = tid >> 5, cl = tid & 31; float s = 0.f;
#pragma unroll
            for (int q = 0; q < 16; ++q) s += red[(q * 5 + bb) * 32 + cl];
            ((float*)(ws + WS_MOD))[bb * 6144 + it * 32 + cl] = s + a.in[5][it * 32 + cl]; }
        __syncthreads();
    }
    for (int it = wg; it < 256; it += G) {
        asm volatile("" : "+v"(tid));
        LAS float* zl = (LAS float*)lds;
        LAS float* h1 = (LAS float*)(lds + 4096);
        LAS float* h2 = (LAS float*)(lds + 8192);
        const int i0 = it * 16;
        LAS float* w1l = (LAS float*)(lds + 12288);
        LAS float* w2l = (LAS float*)(lds + 12288 + 8448);
        for (int o = tid; o < 33 * 64; o += NTHR) w1l[o] = a.in[15][o];
        for (int o = tid; o < 64 * 64; o += NTHR) w2l[o] = a.in[17][o];
        for (int o = tid; o < 16 * 33; o += NTHR) { const int li = o / 33, j = o % 33; const int i = i0 + li;
            const float ti = (float)i * (1.0f / 4095.0f);
            const float wi = (6.2831855f * (float)i) / 4096.0f;
            float v;
            if (j == 0) v = ti;
            else { const int jj = (j - 1) & 15; const float f = 1e-4f + (float)jj * ((15.0f - 1e-4f) / 15.0f); const float ar = f * wi; v = (j <= 16) ? cosf(ar) : -sinf(ar); }
            zl[li * 36 + j] = v; }
        __syncthreads();
#pragma unroll
        for (int q = 0; q < 2; ++q) { const int o = tid + NTHR * q, li = o >> 6, m = o & 63; float s = a.in[16][m];
#pragma unroll
            for (int j = 0; j < 33; ++j) s += zl[li * 36 + j] * w1l[j * 64 + m];
            h1[li * 64 + m] = sinf(a.in[20][m] * s); }
        __syncthreads();
#pragma unroll
        for (int q = 0; q < 2; ++q) { const int o = tid + NTHR * q, li = o >> 6, m = o & 63; float s = a.in[18][m];
#pragma unroll 16
            for (int k = 0; k < 64; ++k) s += h1[li * 64 + k] * w2l[k * 64 + m];
            h2[li * 64 + m] = sinf(a.in[20][m] * s); }
        __syncthreads();
        f32x4 acc[16];
#pragma unroll
        for (int li = 0; li < 16; ++li) acc[li] = (f32x4){0.f, 0.f, 0.f, 0.f};
        const float* w3 = a.in[19] + tid * 4;
#pragma nounroll
        for (int k0 = 0; k0 < 64; k0 += 16) { f32x4 w[16];
#pragma unroll
            for (int kk = 0; kk < 16; ++kk) w[kk] = *(const f32x4*)(w3 + (k0 + kk) * 2048);
#pragma unroll
            for (int kk = 0; kk < 16; ++kk)
#pragma unroll
                for (int li = 0; li < 16; ++li) acc[li] += w[kk] * h2[li * 64 + k0 + kk]; }
        float* hT = (float*)(ws + WS_HT);
#pragma unroll
        for (int j = 0; j < 4; ++j) { const int col = tid * 4 + j, od = col >> 9, c = col & 511;
            const float delta = 3.0701134573f + (float)c * ((15.3505672866f - 3.0701134573f) / 511.0f);
            float* dst = hT + ((size_t)od * 512 + c) * SEQ + i0;
#pragma unroll
            for (int q = 0; q < 4; ++q) { f32x4 o;
#pragma unroll
                for (int s = 0; s < 4; ++s) { const int li = q * 4 + s; const float ti = (float)(i0 + li) * (1.0f / 4095.0f); o[s] = DBG_HTCONST == 1 ? 1.0f : DBG_HTCONST == 2 ? zl[li * 36 + (col % 33)] : DBG_HTCONST == 3 ? h1[li * 64 + (col & 63)] : DBG_HTCONST == 4 ? h2[li * 64 + (col & 63)] : DBG_HTCONST == 5 ? acc[li][j] : acc[li][j] * __expf(-ti * delta); }
                *(f32x4*)(dst + q * 4) = o; } }
        __syncthreads();
    }
    {
        asm volatile("" : "+v"(tid)); lane = tid & 63; wave = tid >> 6;
        LAS float* scr = (LAS float*)(lds + wave * 8448);
        const int gw = wg * NWAVES + wave, NGW = G * NWAVES;
        constexpr int I_IN = 104 * 16, I_OUT = 32 * 16;
        for (int it = gw; it < I_IN + I_OUT; it += NGW) {
            if (it < I_IN) { const int nb = it >> 4, kb = it & 15, n0 = nb * 32;
                const int ns = (n0 < 1536) ? n0 : (n0 < 3072 ? n0 + 32 : 1536 + (n0 - 3072));
                transpose_item(a.in[7], DIN, kb * 64, (n0 < DIN) ? ns : 0, (bf16*)(ws + WS_WIN), DM, n0, scr, lane, n0 >= DIN);
            } else { const int r = it - I_IN, nb = r >> 4, kb = r & 15;
                transpose_item(a.in[22], DM, kb * 64, nb * 32, (bf16*)(ws + WS_WOUT), DM, nb * 32, scr, lane, false); }
        }
    }
    for (int e = wg * NTHR + tid; e < 64 * 256; e += G * NTHR) { const int i = e >> 8, j = e & 255;
        const float om = 1.0f / powf(10000.0f, (float)j * (1.0f / 256.0f)); const float er = (float)i * om;
        float* pt = (float*)(ws + WS_POS); pt[i * 512 + j] = sinf(er); pt[i * 512 + 256 + j] = cosf(er); }
}

__device__ __forceinline__ void phase1(const Args& a, LAS unsigned char* lds) {
    const int tid = threadIdx.x, lane = tid & 63, wave = tid >> 6, wg = blockIdx.x, G = gridDim.x;
    unsigned char* ws = a.ws;
    const float* modr = (const float*)(ws + WS_MOD); const float* pt = (const float*)(ws + WS_POS); bf16* ain = (bf16*)(ws + WS_AIN);
    const float* gmix = a.in[6];
    const int NGW = G * NWAVES;
    f32x4 gv[4];
#pragma unroll
    for (int j = 0; j < 4; ++j) gv[j] = *(const f32x4*)(gmix + 4 * lane + 256 * j);
#pragma nounroll
    for (int r0 = wg * NWAVES + wave; r0 < MT; r0 += 4 * NGW) {
        f32x4 v[4][4];
#pragma unroll
        for (int k = 0; k < 4; ++k) { const int r = r0 + k * NGW;
            if (r < MT) { const bool lat = r < MX; const float* src = lat ? a.in[0] + (size_t)r * DM : a.in[2] + (size_t)(r - MX) * DM; const int t = r & 4095, rr = t >> 6, cc = t & 63;
#pragma unroll
                for (int j = 0; j < 4; ++j) { const int col = 4 * lane + 256 * j; v[k][j] = *(const f32x4*)(src + col);
                    const f32x4 pv = *(const f32x4*)(pt + ((j < 2) ? rr * 512 + col : cc * 512 + col - 512));
                    v[k][j] += pv * (lat ? 1.0f : 0.0f); } } }
#pragma unroll
        for (int k = 0; k < 4; ++k) { const int r = r0 + k * NGW;
            if (r < MT) { const int bb = (r < MX) ? (r >> 12) : 4; float ss = 0.f;
                f32x4 shv[4], scv[4];
#pragma unroll
                for (int j = 0; j < 4; ++j) { const int col = 4 * lane + 256 * j; shv[j] = *(const f32x4*)(modr + bb * 6144 + col); scv[j] = *(const f32x4*)(modr + bb * 6144 + 1024 + col); }
#pragma unroll
                for (int j = 0; j < 4; ++j) ss += v[k][j][0] * v[k][j][0] + v[k][j][1] * v[k][j][1] + v[k][j][2] * v[k][j][2] + v[k][j][3] * v[k][j][3];
                const float rs = rsqrtf(wave_sum(ss) * (1.0f / DM) + EPS);
#pragma unroll
                for (int j = 0; j < 4; ++j) { const int col = 4 * lane + 256 * j;
                    const f32x4 sh = shv[j], sc = scv[j];
                    const f32x4 y = (v[k][j] * rs * gv[j]) * (sc + 1.0f) + sh;
                    v2u w; w.x = pk2(y[0], y[1]); w.y = pk2(y[2], y[3]);
                    *(v2u*)(ain + (size_t)r * DM + col) = w; } } }
    }
}

typedef float cpx __attribute__((ext_vector_type(2)));
__device__ __forceinline__ cpx make_cpx(float x, float y) { cpx r; r.x = x; r.y = y; return r; }
__device__ __forceinline__ cpx cmul(cpx a, cpx b) { cpx t, r;
    asm("v_pk_mul_f32 %0, %1, %2 op_sel_hi:[1,0]" : "=v"(t) : "v"(a), "v"(b));
    asm("v_pk_fma_f32 %0, %1, %2, %3 op_sel:[1,1,0] op_sel_hi:[0,1,1] neg_lo:[1,0,0]" : "=v"(r) : "v"(a), "v"(b), "v"(t));
    return r; }
__device__ __forceinline__ cpx cmul_s(cpx a, cpx b) { cpx t, r;
    asm("v_pk_mul_f32 %0, %1, %2 op_sel_hi:[1,0]" : "=v"(t) : "v"(a), "s"(b));
    asm("v_pk_fma_f32 %0, %1, %2, %3 op_sel:[1,1,0] op_sel_hi:[0,1,1] neg_lo:[1,0,0]" : "=v"(r) : "v"(a), "s"(b), "v"(t));
    return r; }
__device__ __forceinline__ cpx cmulc(cpx a, cpx b) { cpx t, r;
    asm("v_pk_mul_f32 %0, %1, %2 op_sel_hi:[1,0] neg_hi:[1,0]" : "=v"(t) : "v"(a), "v"(b));
    asm("v_pk_fma_f32 %0, %1, %2, %3 op_sel:[1,1,0] op_sel_hi:[0,1,1] neg_lo:[1,0,0] neg_hi:[1,0,0]" : "=v"(r) : "v"(a), "v"(b), "v"(t));
    return r; }
__device__ __forceinline__ cpx cfma(cpx a, cpx b, cpx c) { cpx t, r;
    asm("v_pk_fma_f32 %0, %1, %2, %3 op_sel_hi:[1,0,1]" : "=v"(t) : "v"(a), "v"(b), "v"(c));
    asm("v_pk_fma_f32 %0, %1, %2, %3 op_sel:[1,1,0] op_sel_hi:[0,1,1] neg_lo:[1,0,0]" : "=v"(r) : "v"(a), "v"(b), "v"(t));
    return r; }
__device__ __forceinline__ cpx cadd(cpx a, cpx b) { return a + b; }
__device__ __forceinline__ cpx csub(cpx a, cpx b) { return a - b; }
__device__ __forceinline__ cpx add_mi(cpx a, cpx b) { cpx r; asm("v_pk_add_f32 %0, %1, %2 op_sel:[0,1] op_sel_hi:[1,0] neg_hi:[0,1]" : "=v"(r) : "v"(a), "v"(b)); return r; }
__device__ __forceinline__ cpx add_pi(cpx a, cpx b) { cpx r; asm("v_pk_add_f32 %0, %1, %2 op_sel:[0,1] op_sel_hi:[1,0] neg_lo:[0,1]" : "=v"(r) : "v"(a), "v"(b)); return r; }
__device__ __forceinline__ cpx cconj(cpx a) { return make_cpx(a.x, -a.y); }
__device__ __forceinline__ cpx twid(float turns) { return make_cpx(__builtin_amdgcn_cosf(turns), -__builtin_amdgcn_sinf(turns)); }
__device__ __forceinline__ void dft4(cpx& a0, cpx& a1, cpx& a2, cpx& a3) {
    const cpx t0 = cadd(a0, a2), t1 = csub(a0, a2), t2 = cadd(a1, a3), t3 = csub(a1, a3);
    a0 = cadd(t0, t2); a2 = csub(t0, t2); a1 = add_mi(t1, t3); a3 = add_pi(t1, t3);
}
__device__ __forceinline__ void dft4_r2(cpx& a0, cpx& a1, cpx& a2, cpx& a3) {
    const cpx t0 = add_mi(a0, a2), t1 = add_pi(a0, a2), t2 = cadd(a1, a3), t3 = csub(a1, a3);
    a0 = cadd(t0, t2); a2 = csub(t0, t2); a1 = add_mi(t1, t3); a3 = add_pi(t1, t3);
}
__device__ __forceinline__ void dft16(cpx (&v)[16]) {
    cpx t[16];
#pragma unroll
    for (int j = 0; j < 4; ++j) { cpx b0 = v[j], b1 = v[j + 4], b2 = v[j + 8], b3 = v[j + 12]; dft4(b0, b1, b2, b3); t[4 * j] = b0; t[4 * j + 1] = b1; t[4 * j + 2] = b2; t[4 * j + 3] = b3; }
    const float C1 = 0.92387953251f, S1 = 0.38268343236f, R2 = 0.70710678118f;
    const cpx W1 = make_cpx(C1, -S1), W2 = make_cpx(R2, -R2), W3 = make_cpx(S1, -C1), W6 = make_cpx(-R2, -R2), W9 = make_cpx(-C1, S1);
    {   cpx b0 = t[0], b1 = t[4], b2 = t[8], b3 = t[12]; dft4(b0, b1, b2, b3); v[0] = b0; v[4] = b1; v[8] = b2; v[12] = b3; }
    {   cpx b0 = t[1], b1 = cmul_s(t[5], W1), b2 = cmul_s(t[9], W2), b3 = cmul_s(t[13], W3); dft4(b0, b1, b2, b3); v[1] = b0; v[5] = b1; v[9] = b2; v[13] = b3; }
    {   cpx b0 = t[2], b1 = cmul_s(t[6], W2), b2 = t[10], b3 = cmul_s(t[14], W6); dft4_r2(b0, b1, b2, b3); v[2] = b0; v[6] = b1; v[10] = b2; v[14] = b3; }
    {   cpx b0 = t[3], b1 = cmul_s(t[7], W3), b2 = cmul_s(t[11], W6), b3 = cmul_s(t[15], W9); dft4(b0, b1, b2, b3); v[3] = b0; v[7] = b1; v[11] = b2; v[15] = b3; }
}
#define FPAD(i) ((i) + ((i) >> 4))
constexpr int FFT_STRIDE = 4352;
__device__ __forceinline__ void apply_tw(cpx (&v)[16], cpx w1) {
    asm volatile("" : "+v"(w1.x), "+v"(w1.y));
    cpx w = w1; v[1] = cmul(v[1], w);
#pragma unroll
    for (int q = 2; q < 16; ++q) { w = cmul(w, w1); v[q] = cmul(v[q], w); }
}
__device__ __forceinline__ cpx opaque(cpx w) { asm volatile("" : "+v"(w.x), "+v"(w.y)); return w; }
__device__ __forceinline__ cpx c32(int r) { return make_cpx(__builtin_cosf(0.19634954084936207f * (float)r), -__builtin_sinf(0.19634954084936207f * (float)r)); }

#define HB(x) __uint_as_float(((unsigned)(x)) << 16)
__device__ __forceinline__ void hyena_item(const Args& a, LAS unsigned char* lds, int c, int stage) {
    int tid = threadIdx.x; asm volatile("" : "+v"(tid));
    const int f = tid >> 8, j = tid & 255, blk = j >> 4, jp = j & 15;
    unsigned char* ws = a.ws;
    LAS cpx* buf = (LAS cpx*)lds;
    LAS cpx* bm = buf + f * FFT_STRIDE;
    const int pj = j + blk, p16 = blk * 272 + jp, pc = 17 * j;
    const float* hT = (const float*)(ws + WS_HT);
    const float* hf = hT + ((size_t)(stage * 2 + 0) * 512 + c) * SEQ;
    const float* hb = hT + ((size_t)(stage * 2 + 1) * 512 + c) * SEQ;
    const bf16* hyT = (const bf16*)(ws + WS_HYT);
    const bf16* zT = (const bf16*)(ws + WS_ZT);
    bf16* outp = (bf16*)(ws + WS_HYT);
    const float* cw = a.in[13]; const float* cb = a.in[14];
    const int chu = c, chg = (stage == 0 ? 512 : 1024) + c;
    const float wu0 = cw[chu], wu1 = cw[1536 + chu], wu2 = cw[3072 + chu], bu = cb[chu];
    const float wg0 = cw[chg], wg1 = cw[1536 + chg], wg2 = cw[3072 + chg], bg = cb[chg];
    const float bias = a.in[21][stage * 512 + c];
    const cpx wj = twid((float)j * (1.0f / 4096.0f)), wjp = twid((float)jp * (1.0f / 256.0f)), w8_ = twid((float)j * (1.0f / 8192.0f));
    cpx v[16];
    LAS cpx* Hs = buf + 2 * FFT_STRIDE + f * FFT_STRIDE + pc;
    { const cpx w8 = opaque(w8_);
    float fraw[16], graw[16];
#pragma unroll
    for (int r = 0; r < 16; ++r) { const unsigned n = (unsigned)j + 256u * r; fraw[r] = hf[n]; graw[r] = hb[(SEQ - n) & 4095u]; }
    asm volatile("" : "+v"(fraw[0]), "+v"(fraw[1]), "+v"(fraw[2]), "+v"(fraw[3]), "+v"(fraw[4]), "+v"(fraw[5]), "+v"(fraw[6]), "+v"(fraw[7]), "+v"(fraw[8]), "+v"(fraw[9]), "+v"(fraw[10]), "+v"(fraw[11]), "+v"(fraw[12]), "+v"(fraw[13]), "+v"(fraw[14]), "+v"(fraw[15]));
    asm volatile("" : "+v"(graw[0]), "+v"(graw[1]), "+v"(graw[2]), "+v"(graw[3]), "+v"(graw[4]), "+v"(graw[5]), "+v"(graw[6]), "+v"(graw[7]), "+v"(graw[8]), "+v"(graw[9]), "+v"(graw[10]), "+v"(graw[11]), "+v"(graw[12]), "+v"(graw[13]), "+v"(graw[14]), "+v"(graw[15]));
#pragma unroll
    for (int r = 0; r < 16; ++r) { const unsigned n = (unsigned)j + 256u * r; const float fv = fraw[r]; const float gv = n ? graw[r] : 0.f;
        const cpx wn = cmul_s(w8, c32(r)); const float d = fv - gv;
        v[r] = f ? make_cpx(d * wn.x, d * wn.y) : make_cpx(fv + gv, 0.f); } }
    dft16(v); apply_tw(v, wj);
#pragma unroll
    for (int q = 0; q < 16; ++q) bm[pj + 272 * q] = v[q];
    __syncthreads();
#pragma unroll
    for (int r = 0; r < 16; ++r) v[r] = bm[p16 + 17 * r];
    dft16(v); apply_tw(v, wjp);
#pragma unroll
    for (int q = 0; q < 16; ++q) bm[p16 + 17 * q] = v[q];
    __syncthreads();
#pragma unroll
    for (int r = 0; r < 16; ++r) v[r] = bm[pc + r];
    dft16(v);
#pragma unroll
    for (int q = 0; q < 16; ++q) Hs[q] = v[q];
    __syncthreads();
#pragma nounroll
    for (int bp = 0; bp < 2; ++bp) {
        const int b0 = 2 * bp, b1 = 2 * bp + 1;
        float uk0[8], uk1[8];
        {   float u0[16], u1[16];
            const unsigned uj = (unsigned)j;
            if (stage == 0) {
                const bf16* P0 = hyT + ((size_t)b0 * 1536 + chu) * SEQ; const bf16* P1 = hyT + ((size_t)b1 * 1536 + chu) * SEQ;
#pragma unroll
                for (int r = 0; r < 16; ++r) { const unsigned o = uj + 256u * r; if (r == 4 || r == 8 || r == 12) asm volatile("" ::: "memory");
                    const unsigned ol = (r == 0) ? (j ? uj - 1u : 0u) : o - 1u, orr = (r == 15) ? (j < 255 ? o + 1u : o) : o + 1u;
                    float l0 = HB(P0[ol]), l1 = HB(P1[ol]), r0 = HB(P0[orr]), r1 = HB(P1[orr]);
                    if (r == 0) { l0 = j ? l0 : 0.f; l1 = j ? l1 : 0.f; }
                    if (r == 15) { r0 = (j < 255) ? r0 : 0.f; r1 = (j < 255) ? r1 : 0.f; }
                    u0[r] = wu0 * l0 + wu1 * HB(P0[o]) + wu2 * r0 + bu; u1[r] = wu0 * l1 + wu1 * HB(P1[o]) + wu2 * r1 + bu; }
            } else {
                const bf16* P0 = zT + ((size_t)b0 * 512 + c) * SEQ; const bf16* P1 = zT + ((size_t)b1 * 512 + c) * SEQ;
                unsigned short z0[16], z1[16];
#pragma unroll
                for (int r = 0; r < 16; ++r) { const unsigned o = uj + 256u * r; z0[r] = P0[o]; z1[r] = P1[o]; }
                asm volatile("" :: "v"(z0[0]), "v"(z0[1]), "v"(z0[2]), "v"(z0[3]), "v"(z0[4]), "v"(z0[5]), "v"(z0[6]), "v"(z0[7]), "v"(z0[8]), "v"(z0[9]), "v"(z0[10]), "v"(z0[11]), "v"(z0[12]), "v"(z0[13]), "v"(z0[14]), "v"(z0[15]));
                asm volatile("" :: "v"(z1[0]), "v"(z1[1]), "v"(z1[2]), "v"(z1[3]), "v"(z1[4]), "v"(z1[5]), "v"(z1[6]), "v"(z1[7]), "v"(z1[8]), "v"(z1[9]), "v"(z1[10]), "v"(z1[11]), "v"(z1[12]), "v"(z1[13]), "v"(z1[14]), "v"(z1[15]));
#pragma unroll
                for (int r = 0; r < 16; ++r) { u0[r] = HB(z0[r]); u1[r] = HB(z1[r]); }
            }
#pragma unroll
            for (int i = 0; i < 8; ++i) { uk0[i] = f ? u0[2 * i + 1] : u0[2 * i]; uk1[i] = f ? u1[2 * i + 1] : u1[2 * i]; }
            const cpx w8 = opaque(w8_);
#pragma unroll
            for (int r = 0; r < 16; ++r) { const cpx x = make_cpx(u0[r], u1[r]); v[r] = f ? cmul(x, cmul_s(w8, c32(r))) : x; }
        }
        dft16(v); apply_tw(v, wj);
#pragma unroll
        for (int q = 0; q < 16; ++q) bm[pj + 272 * q] = v[q];
        __syncthreads();
#pragma unroll
        for (int r = 0; r < 16; ++r) v[r] = bm[p16 + 17 * r];
        dft16(v); apply_tw(v, wjp);
#pragma unroll
        for (int q = 0; q < 16; ++q) bm[p16 + 17 * q] = v[q];
        __syncthreads();
#pragma unroll
        for (int r = 0; r < 16; ++r) v[r] = bm[pc + r];
        dft16(v);
#pragma unroll
        for (int q = 0; q < 16; ++q) v[q] = cmulc(v[q], Hs[q]);
        dft16(v);
#pragma unroll
        for (int q = 0; q < 16; ++q) bm[pc + q] = v[q];
        __syncthreads();
#pragma unroll
        for (int r = 0; r < 16; ++r) v[r] = bm[p16 + 17 * r];
        apply_tw(v, wjp); dft16(v);
#pragma unroll
        for (int q = 0; q < 16; ++q) bm[p16 + 17 * q] = v[q];
        __syncthreads();
        float gg0[8], gg1[8];
        {   unsigned short rg0[8][3], rg1[8][3];
            const bf16* G0 = hyT + ((size_t)b0 * 1536 + chg) * SEQ; const bf16* G1 = hyT + ((size_t)b1 * 1536 + chg) * SEQ;
            const unsigned gj = (unsigned)(j + 256 * f);
#pragma unroll
            for (int i = 0; i < 8; ++i) { const unsigned o = gj + 512u * i;
                const unsigned ol = (i == 0) ? (gj ? gj - 1u : 0u) : o - 1u, orr = (i == 7) ? (o < 4095u ? o + 1u : o) : o + 1u;
                rg0[i][0] = G0[ol]; rg0[i][1] = G0[o]; rg0[i][2] = G0[orr]; rg1[i][0] = G1[ol]; rg1[i][1] = G1[o]; rg1[i][2] = G1[orr]; }
#pragma unroll
            for (int r = 0; r < 16; ++r) v[r] = bm[pj + 272 * r];
            apply_tw(v, wj); dft16(v);
#pragma unroll
            for (int q = 0; q < 16; ++q) bm[pj + 272 * q] = v[q];
#pragma unroll
            for (int i = 0; i < 8; ++i) asm volatile("" :: "v"(rg0[i][0]), "v"(rg0[i][1]), "v"(rg0[i][2]), "v"(rg1[i][0]), "v"(rg1[i][1]), "v"(rg1[i][2]));
#pragma unroll
            for (int i = 0; i < 8; ++i) { const unsigned o = gj + 512u * i;
                float a0 = HB(rg0[i][0]), a1 = HB(rg0[i][1]), a2 = HB(rg0[i][2]), c0 = HB(rg1[i][0]), c1 = HB(rg1[i][1]), c2 = HB(rg1[i][2]);
                if (i == 0) { a0 = gj ? a0 : 0.f; c0 = gj ? c0 : 0.f; }
                if (i == 7) { a2 = (o < 4095u) ? a2 : 0.f; c2 = (o < 4095u) ? c2 : 0.f; }
                gg0[i] = wg0 * a0 + wg1 * a1 + wg2 * a2 + bg; gg1[i] = wg0 * c0 + wg1 * c1 + wg2 * c2 + bg; } }
        __syncthreads();
        const cpx w8f = cmul(opaque(w8_), f ? c32(1) : c32(0));
        bf16* O0 = outp + ((size_t)b0 * 1536 + c) * SEQ; bf16* O1 = outp + ((size_t)b1 * 1536 + c) * SEQ;
        bf16* Z0 = (bf16*)(ws + WS_ZT) + ((size_t)b0 * 512 + c) * SEQ; bf16* Z1 = (bf16*)(ws + WS_ZT) + ((size_t)b1 * 512 + c) * SEQ;
#pragma unroll
        for (int i = 0; i < 8; ++i) { const int rr = f + 2 * i; const unsigned n = (unsigned)(j + 256 * f) + 512u * i;
            const cpx be = buf[pj + 272 * rr], bo = buf[FFT_STRIDE + pj + 272 * rr];
            const cpx wn = cmul_s(w8f, c32(2 * i));
            const cpx z = cfma(bo, wn, be);
            const float y0 = z.x * (1.0f / 8192.0f) + bias * uk0[i], y1 = bias * uk1[i] - z.y * (1.0f / 8192.0f);
                        if (stage == 0) { Z0[n] = (bf16)f2bf(gg0[i] * y0); Z1[n] = (bf16)f2bf(gg1[i] * y1); } else { O0[n] = (bf16)f2bf(gg0[i] * y0); O1[n] = (bf16)f2bf(gg1[i] * y1); } }
        __syncthreads();
    }
}

__device__ __forceinline__ f32x16 mfma32(bf16x8 a, bf16x8 b, f32x16 c) { return __builtin_amdgcn_mfma_f32_32x32x16_bf16(a, b, c, 0, 0, 0); }
typedef short s4v __attribute__((ext_vector_type(4)));
__device__ __forceinline__ bf16x8 tr_frag(const LAS bf16* base, int PT, int k0, int c0, int lane) {
    const int i = lane & 15, q = i >> 2, p = i & 3;
    const LAS bf16* ad = base + (k0 + 8 * (lane >> 5) + q) * PT + c0 + 16 * ((lane >> 4) & 1) + 4 * p;
    const s4v lo = __builtin_amdgcn_ds_read_tr16_b64_v4i16((LAS s4v*)ad);
    const s4v hi = __builtin_amdgcn_ds_read_tr16_b64_v4i16((LAS s4v*)(ad + 4 * PT));
    bf16x8 r; r[0] = lo[0]; r[1] = lo[1]; r[2] = lo[2]; r[3] = lo[3]; r[4] = hi[0]; r[5] = hi[1]; r[6] = hi[2]; r[7] = hi[3]; return r;
}
constexpr int GL_AL = 0, GL_WA = 8192, GL_TOT = 16384, GL_V = 24576, GL_VP = 160;
struct GlaTab { float P[4][2], X[4][2], Ptot[2], Xtot[2], Pref[2], Xref[2]; };
__device__ __forceinline__ void gla_tables(const Args& a, int h, LAS unsigned char* lds, GlaTab& T, int tid) {
    const int d2 = tid & 31, sg = tid >> 5;
    const LAS float* aL = (const LAS float*)(lds + GL_AL); const LAS float* wa = (const LAS float*)(lds + GL_WA); LAS float* tot = (LAS float*)(lds + GL_TOT);
    typedef float f32x2v __attribute__((ext_vector_type(2)));
    const f32x2v bf = *(const f32x2v*)(a.in[9] + h * 64 + 2 * d2), bb = *(const f32x2v*)(a.in[11] + h * 64 + 2 * d2);
    float lf[4][2], lb[4][2];
#pragma unroll
    for (int q = 0; q < 4; ++q) { const int s = sg * 4 + q; float pf0 = bf[0], pf1 = bf[1], pb0 = bb[0], pb1 = bb[1];
#pragma unroll
        for (int j4 = 0; j4 < 4; ++j4) { const f32x4 af = *(const LAS f32x4*)(aL + s * 32 + 4 * j4), ab = *(const LAS f32x4*)(aL + s * 32 + 16 + 4 * j4);
#pragma unroll
            for (int jj = 0; jj < 4; ++jj) { const int j = 4 * j4 + jj; const f32x2v wf = *(const LAS f32x2v*)(wa + j * 64 + 2 * d2), wb = *(const LAS f32x2v*)(wa + 1024 + j * 64 + 2 * d2);
                pf0 += af[jj] * wf[0]; pf1 += af[jj] * wf[1]; pb0 += ab[jj] * wb[0]; pb1 += ab[jj] * wb[1]; } }
        lf[q][0] = logsig_f(pf0) * (1.0f / 16.0f); lf[q][1] = logsig_f(pf1) * (1.0f / 16.0f); lb[q][0] = logsig_f(pb0) * (1.0f / 16.0f); lb[q][1] = logsig_f(pb1) * (1.0f / 16.0f); }
#pragma unroll
    for (int i = 0; i < 2; ++i) { lf[1][i] += lf[0][i]; lf[2][i] += lf[1][i]; lf[3][i] += lf[2][i]; lb[2][i] += lb[3][i]; lb[1][i] += lb[2][i]; lb[0][i] += lb[1][i]; }
    *(LAS f32x2v*)(tot + sg * 64 + 2 * d2) = (f32x2v){lf[3][0], lf[3][1]};
    *(LAS f32x2v*)(tot + 1024 + sg * 64 + 2 * d2) = (f32x2v){lb[0][0], lb[0][1]};
    __syncthreads();
    float of[2] = {0.f, 0.f}, ob[2] = {0.f, 0.f};
    T.Ptot[0] = T.Ptot[1] = T.Xtot[0] = T.Xtot[1] = T.Pref[0] = T.Pref[1] = T.Xref[0] = T.Xref[1] = 0.f;
#pragma unroll
    for (int g = 0; g < 16; ++g) { const f32x2v tf = *(const LAS f32x2v*)(tot + g * 64 + 2 * d2), tb = *(const LAS f32x2v*)(tot + 1024 + g * 64 + 2 * d2);
#pragma unroll
        for (int i = 0; i < 2; ++i) { T.Ptot[i] += tf[i]; T.Xtot[i] += tb[i]; if (g < 8) T.Pref[i] += tf[i]; else T.Xref[i] += tb[i];
            of[i] += (g < sg) ? tf[i] : 0.f; ob[i] += (g > sg) ? tb[i] : 0.f; } }
#pragma unroll
    for (int q = 0; q < 4; ++q)
#pragma unroll
        for (int i = 0; i < 2; ++i) { T.P[q][i] = lf[q][i] + of[i]; T.X[q][i] = lb[q][i] + ob[i]; }
}
struct GlaIn { f32x4 av, wv; unsigned kw[4], qw[4]; };
template <bool OUT>
__device__ __forceinline__ void gla_load(const Args& a, int tid, int bh, int ci, GlaIn& I) {
    const int b = bh >> 2, h = bh & 3, d2 = tid & 31, sg = tid >> 5;
    const size_t rowbase = OUT ? (size_t)b * SEQ + ci * 64 : ((ci < 4) ? (size_t)(MX + b * CTXL + ci * 64) : (size_t)(b * SEQ + (ci - 4) * 64));
    const float* afb = (const float*)(a.ws + WS_AFB); const bf16* qkvg = (const bf16*)(a.ws + WS_QKVG);
    I.av = *(const f32x4*)(afb + (rowbase + (tid >> 3)) * 32 + 4 * (tid & 7));
    const int wdir = tid >> 8, wj = (tid >> 4) & 15, wd4 = (tid & 15) * 4;
    I.wv = *(const f32x4*)((wdir ? a.in[10] : a.in[8]) + wj * 256 + h * 64 + wd4);
#pragma unroll
    for (int q = 0; q < 4; ++q) { const bf16* rp = qkvg + (rowbase + sg * 4 + q) * NQ + h * 64 + 2 * d2; I.kw[q] = *(const unsigned*)(rp + 256); if (OUT) I.qw[q] = *(const unsigned*)rp; }
}
__device__ __forceinline__ void gla_stage_common(const GlaIn& I, LAS unsigned char* lds, int tid) {
    const int wdir = tid >> 8, wj = (tid >> 4) & 15, wd4 = (tid & 15) * 4;
    *(LAS f32x4*)((LAS float*)(lds + GL_AL) + 4 * tid) = I.av;
    *(LAS f32x4*)((LAS float*)(lds + GL_WA) + wdir * 1024 + wj * 64 + wd4) = I.wv;
}

template <bool HASN>
__device__ __forceinline__ void gla_upd_item(const Args& a, LAS unsigned char* lds, int bh, int ci, const GlaIn& I, int nbh, int nci, GlaIn& N) {
    int tid = threadIdx.x; asm volatile("" : "+v"(tid));
    const int lane = tid & 63, wave = tid >> 6, h = bh & 3, d2 = tid & 31, sg = tid >> 5;
    unsigned char* ws = a.ws;
    constexpr int KP = 96;
    LAS bf16* vN = (LAS bf16*)(lds + GL_V); LAS bf16* kUf = (LAS bf16*)(lds + 45056); LAS bf16* kUb = (LAS bf16*)(lds + 57344);
    unsigned kw[4];
#pragma unroll
    for (int q = 0; q < 4; ++q) kw[q] = I.kw[q];
    v4u vv[2];
    { const int b = bh >> 2; const size_t rowbase = (ci < 4) ? (size_t)(MX + b * CTXL + ci * 64) : (size_t)(b * SEQ + (ci - 4) * 64); const bf16* qkvg = (const bf16*)(ws + WS_QKVG);
#pragma unroll
        for (int q = 0; q < 2; ++q) { const int idx = tid + NTHR * q; vv[q] = *(const v4u*)(qkvg + (rowbase + (idx >> 4)) * NQ + 512 + h * 128 + (idx & 15) * 8); } }
    gla_stage_common(I, lds, tid);
    __syncthreads();
    if (HASN) gla_load<false>(a, tid, nbh, nci, N);
    GlaTab T; gla_tables(a, h, lds, T, tid);
#pragma unroll
    for (int q = 0; q < 4; ++q) { const int s = sg * 4 + q; const float k0 = bflo(kw[q]), k1 = bfhi(kw[q]);
        *(LAS unsigned*)(kUf + s * KP + 2 * d2) = pk2(k0 * __expf(T.Ptot[0] - T.P[q][0]), k1 * __expf(T.Ptot[1] - T.P[q][1]));
        *(LAS unsigned*)(kUb + s * KP + 2 * d2) = pk2(k0 * __expf(T.Xtot[0] - T.X[q][0]), k1 * __expf(T.Xtot[1] - T.X[q][1])); }
#pragma unroll
    for (int q = 0; q < 2; ++q) { const int idx = tid + NTHR * q; *(LAS v4u*)(vN + (idx >> 4) * GL_VP + (idx & 15) * 8) = vv[q]; }
    if (tid < 32) { float* dec = (float*)(ws + WS_DEC);
#pragma unroll
        for (int i = 0; i < 2; ++i) { dec[((size_t)(bh * 2 + 0) * NCH + ci) * 64 + 2 * d2 + i] = __expf(T.Ptot[i]); dec[((size_t)(bh * 2 + 1) * NCH + ci) * 64 + 2 * d2 + i] = __expf(T.Xtot[i]); } }
    __syncthreads();
    { const int dir = wave >> 2, e0 = (wave & 3) * 32, l31 = lane & 31, hh = lane >> 5;
        const LAS bf16* kT = dir ? kUb : kUf;
        float* U = (ci < 4) ? (float*)(ws + WS_UCTX) + ((size_t)(bh * 2 + dir) * 4 + ci) * 8192 : a.out + ((size_t)(bh * 2 + dir) * 64 + (ci - 4)) * 8192;
        bf16x8 A[4];
#pragma unroll
        for (int ks = 0; ks < 4; ++ks) A[ks] = tr_frag(vN, GL_VP, 16 * ks, e0, lane);
#pragma unroll
        for (int dt = 0; dt < 2; ++dt) { const int d0 = dt * 32; f32x16 acc;
#pragma unroll
            for (int i = 0; i < 16; ++i) acc[i] = 0.f;
#pragma unroll
            for (int ks = 0; ks < 4; ++ks) acc = mfma32(A[ks], tr_frag(kT, KP, 16 * ks, d0, lane), acc);
#pragma unroll
            for (int r = 0; r < 16; ++r) { const int e = e0 + (r & 3) + 8 * (r >> 2) + 4 * hh; U[e * 64 + d0 + l31] = acc[r]; } } }
    __syncthreads();
}

__device__ __forceinline__ void gla_scan_item(const Args& a, int it) {
    int tid = threadIdx.x; asm volatile("" : "+v"(tid));
    const int bd = it >> 4, dir = bd & 1, el = ((it & 15) * 8 + (tid >> 6)) * 64 + (tid & 63), d = tid & 63;
    unsigned char* ws = a.ws;
    const float* dec = (const float*)(ws + WS_DEC) + (size_t)bd * NCH * 64 + d;
    const float* Uc = (const float*)(ws + WS_UCTX) + (size_t)bd * 4 * 8192 + el;
    const float* U = a.out + (size_t)bd * 64 * 8192 + el;
    bf16* Sp = (bf16*)(ws + WS_SPREV) + (size_t)bd * 64 * 8192 + el;
    float S = 0.f;
#pragma unroll
    for (int c4 = 0; c4 < 4; ++c4) { const int ci = dir ? 3 - c4 : c4; S = dec[ci * 64] * S + Uc[(size_t)ci * 8192]; }
#pragma unroll
    for (int blk = 0; blk < 2; ++blk) { float uu[32], dd[32];
#pragma unroll
        for (int j = 0; j < 32; ++j) { const int n = dir ? 63 - (blk * 32 + j) : blk * 32 + j; uu[j] = U[(size_t)n * 8192]; dd[j] = dec[(4 + n) * 64]; }
#pragma unroll
        for (int j = 0; j < 32; ++j) { const int n = dir ? 63 - (blk * 32 + j) : blk * 32 + j; Sp[(size_t)n * 8192] = (bf16)f2bf(S); S = dd[j] * S + uu[j]; } }
}

template <bool HASN>
__device__ __forceinline__ void gla_out_item(const Args& a, LAS unsigned char* lds, int bh, int n, const GlaIn& I, int nbh, int nn, GlaIn& N) {
    int tid = threadIdx.x; asm volatile("" : "+v"(tid));
    const int lane = tid & 63, wave = tid >> 6, b = bh >> 2, h = bh & 3, l31 = lane & 31, hh = lane >> 5, d2 = tid & 31, sg = tid >> 5;
    unsigned char* ws = a.ws;
    LAS bf16* Scat = (LAS bf16*)lds;
    LAS bf16* vN = (LAS bf16*)(lds + GL_V);
    LAS bf16* qf = (LAS bf16*)(lds + 45056); LAS bf16* qb = qf + 4608; LAS bf16* kf = qf + 2 * 4608; LAS bf16* kb = qf + 3 * 4608;
    LAS float* oS = (LAS float*)(lds + 45056);
    LAS bf16* qS = (LAS bf16*)(lds + 81920);
    LAS bf16* Sp = (LAS bf16*)(lds + 99328);
    const size_t rowbase = (size_t)b * SEQ + n * 64;
    unsigned qw[4], kw[4];
#pragma unroll
    for (int q = 0; q < 4; ++q) { qw[q] = I.qw[q]; kw[q] = I.kw[q]; }
    v4u vv[2], sv[4], g0, g1;
    { const bf16* qkvg = (const bf16*)(ws + WS_QKVG);
        { const bf16* gp = qkvg + (rowbase + (tid >> 3)) * NQ + 1024 + h * 128 + (tid & 7) * 16; g0 = *(const v4u*)gp; g1 = *(const v4u*)(gp + 8); }
#pragma unroll
        for (int q = 0; q < 2; ++q) { const int idx = tid + NTHR * q; vv[q] = *(const v4u*)(qkvg + (rowbase + (idx >> 4)) * NQ + 512 + h * 128 + (idx & 15) * 8); }
        const bf16* spf = (const bf16*)(ws + WS_SPREV) + ((size_t)(bh * 2 + 0) * 64 + n) * 8192; const bf16* spb = (const bf16*)(ws + WS_SPREV) + ((size_t)(bh * 2 + 1) * 64 + n) * 8192;
#pragma unroll
        for (int q = 0; q < 4; ++q) { const int idx = tid + NTHR * q, dir = idx >> 10, e = (idx >> 3) & 127, d8 = (idx & 7) * 8; sv[q] = *(const v4u*)((dir ? spb : spf) + e * 64 + d8); } }
    gla_stage_common(I, lds, tid);
    __syncthreads();
    if (HASN) gla_load<true>(a, tid, nbh, nn, N);
    GlaTab T; gla_tables(a, h, lds, T, tid);
#pragma unroll
    for (int q = 0; q < 4; ++q) { const int s = sg * 4 + q; const float q0 = bflo(qw[q]), q1 = bfhi(qw[q]), k0 = bflo(kw[q]), k1 = bfhi(kw[q]);
        *(LAS unsigned*)(qf + s * 72 + 2 * d2) = pk2(q0 * __expf(T.P[q][0] - T.Pref[0]), q1 * __expf(T.P[q][1] - T.Pref[1]));
        *(LAS unsigned*)(kf + s * 72 + 2 * d2) = pk2(k0 * __expf(T.Pref[0] - T.P[q][0]), k1 * __expf(T.Pref[1] - T.P[q][1]));
        *(LAS unsigned*)(qb + s * 72 + 2 * d2) = pk2(q0 * __expf(T.X[q][0] - T.Xref[0]), q1 * __expf(T.X[q][1] - T.Xref[1]));
        *(LAS unsigned*)(kb + s * 72 + 2 * d2) = pk2(k0 * __expf(T.Xref[0] - T.X[q][0]), k1 * __expf(T.Xref[1] - T.X[q][1]));
        *(LAS unsigned*)(qS + s * 136 + 2 * d2) = pk2(q0 * __expf(T.P[q][0]), q1 * __expf(T.P[q][1]));
        *(LAS unsigned*)(qS + s * 136 + 64 + 2 * d2) = pk2(q0 * __expf(T.X[q][0]), q1 * __expf(T.X[q][1])); }
#pragma unroll
    for (int q = 0; q < 2; ++q) { const int idx = tid + NTHR * q; *(LAS v4u*)(vN + (idx >> 4) * GL_VP + (idx & 15) * 8) = vv[q]; }
#pragma unroll
    for (int q = 0; q < 4; ++q) { const int idx = tid + NTHR * q, dir = idx >> 10, e = (idx >> 3) & 127, d8 = (idx & 7) * 8; *(LAS v4u*)(Sp + e * 136 + dir * 64 + d8) = sv[q]; }
    __syncthreads();
    { const int dir = wave >> 2, c0 = ((wave >> 1) & 1) * 32, s0 = (wave & 1) * 32;
        const LAS bf16* qq = dir ? qb : qf; const LAS bf16* kk = dir ? kb : kf;
        f32x16 acc;
#pragma unroll
        for (int i = 0; i < 16; ++i) acc[i] = 0.f;
#pragma unroll
        for (int ks = 0; ks < 4; ++ks) { const bf16x8 A = *(const LAS bf16x8*)(qq + (c0 + l31) * 72 + 16 * ks + 8 * hh), B = *(const LAS bf16x8*)(kk + (s0 + l31) * 72 + 16 * ks + 8 * hh);
            acc = mfma32(A, B, acc); }
        const int s = s0 + l31;
#pragma unroll
        for (int r = 0; r < 16; ++r) { const int c = c0 + (r & 3) + 8 * (r >> 2) + 4 * hh; const bool keep = dir ? (s >= c) : (s <= c);
            Scat[c * 136 + dir * 64 + s] = (bf16)f2bf(keep ? acc[r] : 0.f); } }
    __syncthreads();
    { const int c0 = (wave >> 2) * 32, e0 = (wave & 3) * 32;
        f32x16 acc;
#pragma unroll
        for (int i = 0; i < 16; ++i) acc[i] = 0.f;
#pragma unroll
        for (int ks = 0; ks < 8; ++ks) { const bf16x8 A = *(const LAS bf16x8*)(Scat + (c0 + l31) * 136 + 16 * ks + 8 * hh);
            acc = mfma32(A, tr_frag(vN, GL_VP, 16 * (ks & 3), e0, lane), acc); }
#pragma unroll
        for (int ks = 0; ks < 8; ++ks) { const bf16x8 A = *(const LAS bf16x8*)(qS + (c0 + l31) * 136 + 16 * ks + 8 * hh), B = *(const LAS bf16x8*)(Sp + (e0 + l31) * 136 + 16 * ks + 8 * hh);
            acc = mfma32(A, B, acc); }
#pragma unroll
        for (int r = 0; r < 16; ++r) { const int c = c0 + (r & 3) + 8 * (r >> 2) + 4 * hh; oS[c * 132 + e0 + l31] = acc[r]; } }
    __syncthreads();
    { const int row = tid >> 3, ec = (tid & 7) * 16; float v[16]; float ss = 0.f;
#pragma unroll
        for (int j = 0; j < 16; ++j) { v[j] = oS[row * 132 + ec + j]; ss += v[j] * v[j]; }
        ss += __shfl_xor(ss, 1); ss += __shfl_xor(ss, 2); ss += __shfl_xor(ss, 4);
        const float rs = rsqrtf(ss * (1.0f / 128.0f) + EPS);
        const float gv[16] = {bflo(g0.x), bfhi(g0.x), bflo(g0.y), bfhi(g0.y), bflo(g0.z), bfhi(g0.z), bflo(g0.w), bfhi(g0.w), bflo(g1.x), bfhi(g1.x), bflo(g1.y), bfhi(g1.y), bflo(g1.z), bfhi(g1.z), bflo(g1.w), bfhi(g1.w)};
        float o[16];
#pragma unroll
        for (int j = 0; j < 16; ++j) o[j] = DBG_GLA_K * v[j] * rs * a.in[12][ec + j] * silu_f(gv[j]);
        bf16* op = (bf16*)(ws + WS_AOUT) + (rowbase + row) * DM + h * 128 + ec;
        *(v4u*)op = (v4u){pk2(o[0], o[1]), pk2(o[2], o[3]), pk2(o[4], o[5]), pk2(o[6], o[7])};
        *(v4u*)(op + 8) = (v4u){pk2(o[8], o[9]), pk2(o[10], o[11]), pk2(o[12], o[13]), pk2(o[14], o[15])}; }
    __syncthreads();
}

__device__ __forceinline__ void hy_transpose_item(const Args& a, LAS unsigned char* lds, int it) {
    const int tid = threadIdx.x, b = it >> 6, t0 = (it & 63) * 64;
    LAS float* tile = (LAS float*)lds;
    const bf16* src = (const bf16*)(a.ws + WS_HYT) + (size_t)b * 1536 * SEQ + t0;
    bf16* dst = (bf16*)(a.ws + WS_AOUT) + ((size_t)b * SEQ + t0) * DM + 512;
    for (int half = 0; half < 2; ++half) {
#pragma unroll 8
        for (int q = 0; q < 32; ++q) { const int idx = tid + NTHR * q, c = idx >> 6, tt = idx & 63; tile[c * 65 + tt] = HB(src[(size_t)(half * 256 + c) * SEQ + tt]); }
        __syncthreads();
#pragma unroll
        for (int q = 0; q < 4; ++q) { const int idx = tid + NTHR * q, t = idx >> 5, c8 = (idx & 31) * 8; const LAS float* s = tile + c8 * 65 + t;
            *(v4u*)(dst + (size_t)t * DM + half * 256 + c8) = (v4u){pk2(s[0], s[65]), pk2(s[2 * 65], s[3 * 65]), pk2(s[4 * 65], s[5 * 65]), pk2(s[6 * 65], s[7 * 65])}; }
        __syncthreads();
    }
}

__device__ __forceinline__ void phase_router(const Args& a, LAS unsigned char* lds) {
    const int tid = threadIdx.x, lane = tid & 63, wave = tid >> 6, wg = blockIdx.x, G = gridDim.x;
    unsigned char* ws = a.ws;
    LAS float* wr = (LAS float*)lds;
    {   f32x4 t[8];
#pragma unroll
        for (int it = 0; it < 8; ++it) t[it] = *(const f32x4*)(a.in[24] + 4 * (tid + NTHR * it));
#pragma unroll
        for (int it = 0; it < 8; ++it) { const int i4 = tid + NTHR * it, c = i4 >> 2, e4 = i4 & 3, l = (c >> 2) & 63, q = c & 3, j = c >> 8;
            *(LAS f32x4*)(wr + 4 * ((((j * 4 + q) * 4 + e4) * 65) + l)) = t[it]; } }
    __syncthreads();
    const float* modr = (const float*)(ws + WS_MOD); const float* gffn = a.in[23];
    bf16* hn = (bf16*)(ws + WS_HN); float* aff = (float*)(ws + WS_AFF);
    const int NGW = G * NWAVES;
    f32x4 gv[4];
#pragma unroll
    for (int j = 0; j < 4; ++j) gv[j] = *(const f32x4*)(gffn + 4 * lane + 256 * j);
#pragma nounroll
    for (int r0 = wg * NWAVES + wave; r0 < MX; r0 += 2 * NGW) {
        const int r1 = r0 + NGW; const bool ok1 = r1 < MX; const int rB = ok1 ? r1 : r0;
        int lane_o = lane; asm volatile("" : "+v"(lane_o));
        f32x4 v[2][4];
#pragma unroll
        for (int j = 0; j < 4; ++j) { v[0][j] = *(const f32x4*)(a.out + (size_t)r0 * DM + 4 * lane + 256 * j); v[1][j] = *(const f32x4*)(a.out + (size_t)rB * DM + 4 * lane + 256 * j); }
        float rs[2];
#pragma unroll
        for (int k = 0; k < 2; ++k) { float ss = 0.f;
#pragma unroll
            for (int j = 0; j < 4; ++j) ss += v[k][j][0] * v[k][j][0] + v[k][j][1] * v[k][j][1] + v[k][j][2] * v[k][j][2] + v[k][j][3] * v[k][j][3];
            rs[k] = rsqrtf(wave_sum(ss) * (1.0f / DM) + EPS); }
        float lg[2][16];
#pragma unroll
        for (int k = 0; k < 2; ++k)
#pragma unroll
            for (int e = 0; e < 16; ++e) lg[k][e] = 0.f;
        f32x4 shv[2][4], scv[2][4];
#pragma unroll
        for (int k = 0; k < 2; ++k)
#pragma unroll
            for (int j = 0; j < 4; ++j) { const int b = (k ? rB : r0) >> 12, col = 4 * lane + 256 * j; shv[k][j] = *(const f32x4*)(modr + b * 6144 + 3072 + col); scv[k][j] = *(const f32x4*)(modr + b * 6144 + 4096 + col); }
#pragma unroll
        for (int j = 0; j < 4; ++j) { const int col = 4 * lane + 256 * j; f32x4 y[2];
#pragma unroll
            for (int k = 0; k < 2; ++k) { const int r = k ? rB : r0;
                const f32x4 sh = shv[k][j], sc = scv[k][j];
                y[k] = (v[k][j] * rs[k] * gv[j]) * (sc + 1.0f) + sh;
                v2u w; w.x = pk2(y[k][0], y[k][1]); w.y = pk2(y[k][2], y[k][3]);
                if (k == 0 || ok1) *(v2u*)(hn + (size_t)r * DM + col) = w; }
#pragma unroll
            for (int q = 0; q < 4; ++q) {
#pragma unroll
                for (int e4 = 0; e4 < 4; ++e4) { const f32x4 ww = *(const LAS f32x4*)(wr + 4 * ((((j * 4 + q) * 4 + e4) * 65) + lane_o));
#pragma unroll
                    for (int s = 0; s < 4; ++s) { lg[0][e4 * 4 + s] += y[0][q] * ww[s]; lg[1][e4 * 4 + s] += y[1][q] * ww[s]; } }
#define PIN16(x) asm volatile("" : "+v"(x[0]), "+v"(x[1]), "+v"(x[2]), "+v"(x[3]), "+v"(x[4]), "+v"(x[5]), "+v"(x[6]), "+v"(x[7]), "+v"(x[8]), "+v"(x[9]), "+v"(x[10]), "+v"(x[11]), "+v"(x[12]), "+v"(x[13]), "+v"(x[14]), "+v"(x[15]) :: "memory")
                PIN16(lg[0]); PIN16(lg[1]); } }
#undef PIN16
        const int exb = ((lane >> 5) & 1) * 8 + ((lane >> 4) & 1) * 4, esel = lane & 3;
#pragma unroll
        for (int k = 0; k < 2; ++k) { float k8[8], k4[4];
#pragma unroll
            for (int i = 0; i < 8; ++i) { float x = lg[k][i], y = lg[k][8 + i]; swap32(x, y); k8[i] = x + y; }
#pragma unroll
            for (int i = 0; i < 4; ++i) { float x = k8[i], y = k8[4 + i]; swap16(x, y); k4[i] = row_allsum(x + y); }
            const float mx = x32_max(x16_max(fmaxf(fmaxf(k4[0], k4[1]), fmaxf(k4[2], k4[3]))));
            float pe[4];
#pragma unroll
            for (int i = 0; i < 4; ++i) pe[i] = __expf(k4[i] - mx);
            const float sum = x32_sum(x16_sum((pe[0] + pe[1]) + (pe[2] + pe[3])));
            const float mine = (esel == 0) ? pe[0] : (esel == 1) ? pe[1] : (esel == 2) ? pe[2] : pe[3];
            const int r = k ? rB : r0;
            if ((lane & 12) == 0 && (k == 0 || ok1)) aff[((size_t)(r >> 12) * NE + exb + esel) * SEQ + (r & 4095)] = mine * __builtin_amdgcn_rcpf(sum); }
    }
}

__device__ __forceinline__ void conv_item(const Args& a, LAS float* scr, int lane, bool gu, int it) {
    unsigned char* ws = a.ws;
    if (gu) { const int mat = it >> 9, r = it & 511, nb = r >> 4, kb = r & 15, e = mat >> 1, kind = mat & 1, n0 = nb * 32;
        transpose_item((kind ? a.in[26] : a.in[25]) + (size_t)e * DM * DM, DM, kb * 64, n0, (bf16*)(ws + WS_WGU) + (size_t)e * 2048 * DM, DM, (n0 >> 7) * 256 + kind * 128 + (n0 & 127), scr, lane, false);
    } else { const int e = it >> 9, r = it & 511, nb = r >> 4, kb = r & 15;
        transpose_item(a.in[27] + (size_t)e * DM * DM, DM, kb * 64, nb * 32, (bf16*)(ws + WS_WD) + (size_t)e * DM * DM, DM, nb * 32, scr, lane, false); }
}
__device__ __forceinline__ bool conv_try(const Args& a, LAS unsigned char* lds, bool allow_gu, unsigned& cur) {
    const int lane = threadIdx.x & 63, wave = threadIdx.x >> 6;
    if (wave == 0) return false;
    const int gw = blockIdx.x * (NWAVES - 1) + wave - 1, NGW = gridDim.x * (NWAVES - 1);
    LAS float* scr = (LAS float*)(lds + wave * 8448);
    const int itD = gw + (int)(cur & 0xffffu) * NGW;
    if (itD < NE * 512) { conv_item(a, scr, lane, false, itD); cur += 1u; return true; }
    if (!allow_gu) return false;
    const int itG = gw + (int)(cur >> 16) * NGW;
    if (itG < NE * 1024) { conv_item(a, scr, lane, true, itG); cur += 0x10000u; return true; }
    return false;
}
#ifndef DBG_NOSHADOW
#define DBG_NOSHADOW 0
#endif
__device__ __forceinline__ void seam_barrier(const XcdBarrier& b, const Args& a, LAS unsigned char* lds, volatile LAS unsigned* MISC, unsigned& gen, bool allow_gu, unsigned& cdone) {
    asm volatile("s_waitcnt vmcnt(0)" ::: "memory");
    __syncthreads();
    ++gen;
    if (threadIdx.x < 64) {
        if (threadIdx.x == 0) {
            unsigned* bar = b.bar;
            __builtin_amdgcn_s_waitcnt(0);
            unsigned nloc = b.st[0], nx = b.st[1];
            if (nloc == 0u) { xcd_barrier_complete(bar, b.x, nloc, nx); b.st[0] = nloc; b.st[1] = nx; }
            const unsigned old = xb_add(&bar[XB_XSUB(b.x)], 1u);
            const unsigned g2 = old / nloc;
            if (old + 1u == (g2 + 1u) * nloc) {
                __builtin_amdgcn_fence(__ATOMIC_RELEASE, "agent");
                asm volatile("s_waitcnt vmcnt(0)" ::: "memory");
                const unsigned og = xb_add(&bar[XB_TOP], 1u);
                const unsigned tg = og / nx;
                if (og + 1u == (tg + 1u) * nx) xb_add(&bar[XB_TOPGEN], 1u);
                else XB_SPIN(xb_ld(&bar[XB_TOPGEN]) == tg, bar);
                __builtin_amdgcn_fence(__ATOMIC_ACQUIRE, "agent");
                xb_add(&bar[XB_XGEN(b.x)], 1u);
                asm volatile("s_waitcnt vmcnt(0)" ::: "memory");
            } else {
                XB_SPIN(xb_ld(&bar[XB_XGEN(b.x)]) == g2, bar);
                __builtin_amdgcn_fence(__ATOMIC_ACQUIRE, "agent");
                asm volatile("s_waitcnt vmcnt(0)" ::: "memory");
            }
            MISC[16] = gen;
        }
    } else {
        unsigned spins = 0;
        while (MISC[16] != gen) { if (DBG_NOSHADOW || !conv_try(a, lds, allow_gu, cdone)) { __builtin_amdgcn_s_sleep(4); if (++spins > (1u << 22)) break; } }
    }
    __syncthreads();
}

__device__ __forceinline__ void block_excl_scan2(int& va, int& vb, LAS int* tmp) {
    const int tid = threadIdx.x, lane = tid & 63, wave = tid >> 6;
    int ia = va, ib = vb;
#pragma unroll
    for (int o = 1; o < 64; o <<= 1) { const int ta = __shfl_up(ia, o), tb = __shfl_up(ib, o); if (lane >= o) { ia += ta; ib += tb; } }
    if (lane == 63) { tmp[wave] = ia; tmp[8 + wave] = ib; }
    __syncthreads();
    int oa = 0, ob = 0;
#pragma unroll
    for (int w = 0; w < 8; ++w) { if (w < wave) { oa += tmp[w]; ob += tmp[8 + w]; } }
    va = oa + ia - va; vb = ob + ib - vb;
    __syncthreads();
}
__device__ __forceinline__ void topk_item(const Args& a, LAS unsigned char* lds, int be) {
    const int tid = threadIdx.x, b = be >> 4, e = be & 15;
    unsigned char* ws = a.ws;
    LAS unsigned* keys = (LAS unsigned*)lds;
    LAS unsigned* hist = (LAS unsigned*)(lds + 16384);
    LAS int* ctl = (LAS int*)(lds + 16384 + 1024);
    LAS int* tmp = (LAS int*)(lds + 16384 + 1024 + 64);
    const float* aff = (const float*)(ws + WS_AFF) + (size_t)be * SEQ;
    unsigned my[8];
#pragma unroll
    for (int i = 0; i < 8; ++i) { my[i] = __float_as_uint(aff[tid * 8 + i]); keys[tid * 8 + i] = my[i]; }
    unsigned prefix = 0u, mask = 0u; int need = CAP;
    for (int pass = 0; pass < 4; ++pass) {
        const int shift = 24 - 8 * pass;
        if (tid < 256) hist[tid] = 0u;
        __syncthreads();
#pragma unroll
        for (int i = 0; i < 8; ++i) if ((my[i] & mask) == prefix) atomicAdd((unsigned*)&hist[(my[i] >> shift) & 255u], 1u);
        __syncthreads();
        {
            int hv = (tid < 256) ? (int)hist[255 - tid] : 0, inc = hv;
#pragma unroll
            for (int o = 1; o < 64; o <<= 1) { const int t2 = __shfl_up(inc, o); if ((tid & 63) >= o) inc += t2; }
            if ((tid & 63) == 63) tmp[tid >> 6] = inc;
            __syncthreads();
            int off = 0;
#pragma unroll
            for (int w = 0; w < 4; ++w) if (w < (tid >> 6)) off += tmp[w];
            inc += off;
            if (tid < 256 && inc >= need && inc - hv < need) { ctl[0] = 255 - tid; ctl[1] = need - (inc - hv); }
        }
        __syncthreads();
        prefix |= ((unsigned)ctl[0]) << shift; mask |= 255u << shift; need = ctl[1];
        __syncthreads();
    }
    const unsigned T = prefix;
    int cg = 0, ce = 0;
#pragma unroll
    for (int i = 0; i < 8; ++i) { cg += (my[i] > T) ? 1 : 0; ce += (my[i] == T) ? 1 : 0; }
    int pg = cg, pe = ce;
    block_excl_scan2(pg, pe, tmp);
    int* slot_of = (int*)(ws + WS_SLOT) + (size_t)be * SEQ;
    int* selt = (int*)(ws + WS_SELT) + (e * 4 + b) * CAP; float* selv = (float*)(ws + WS_SELV) + (e * 4 + b) * CAP;
#pragma unroll
    for (int i = 0; i < 8; ++i) { const int t = tid * 8 + i; const bool gt = my[i] > T, eq = my[i] == T; const bool sel = gt || (eq && pe < need);
        const int slot = pg + (pe < need ? pe : need);
        slot_of[t] = sel ? slot : -1;
        if (sel) { selt[slot] = t; selv[slot] = __uint_as_float(my[i]); }
        pg += gt ? 1 : 0; pe += eq ? 1 : 0; }
    __syncthreads();
}
__device__ __forceinline__ void phase_topk(const Args& a, LAS unsigned char* lds, unsigned& cdone) {
    const int tid = threadIdx.x, lane = tid & 63, wave = tid >> 6, wg = blockIdx.x, G = gridDim.x;
    unsigned char* ws = a.ws;
    for (int it = wg; it < NB * NE; it += G) topk_item(a, lds, it);
    __syncthreads();
    while (conv_try(a, lds, true, cdone)) {}
}

__device__ __forceinline__ void phase_final(const Args& a) {
    const int tid = threadIdx.x, lane = tid & 63, wave = tid >> 6, wg = blockIdx.x, G = gridDim.x;
    unsigned char* ws = a.ws;
    const float* modr = (const float*)(ws + WS_MOD); const int* slot_of = (const int*)(ws + WS_SLOT); const bf16* ys = (const bf16*)(ws + WS_YSLAB);
    const int NGW = G * NWAVES;
    f32x4 gf[4];
#pragma unroll
    for (int j = 0; j < 4; ++j) gf[j] = *(const f32x4*)(a.in[28] + 4 * lane + 256 * j);
#pragma nounroll
    for (int r0 = wg * NWAVES + wave; r0 < MX; r0 += 4 * NGW) {
        int sv[4]; unsigned long long mk[4]; f32x4 v[4][4], m[4][4];
#pragma unroll
        for (int k = 0; k < 4; ++k) { const int r = r0 + k * NGW; const bool ok = r < MX; const int rc = ok ? r : r0, b = rc >> 12, t = rc & 4095;
            sv[k] = (lane < NE) ? slot_of[((size_t)b * NE + lane) * SEQ + t] : -1;
#pragma unroll
            for (int j = 0; j < 4; ++j) { v[k][j] = *(const f32x4*)(a.out + (size_t)rc * DM + 4 * lane + 256 * j); m[k][j] = (f32x4){0.f, 0.f, 0.f, 0.f}; }
            mk[k] = (ok && !DBG_NOMOE) ? __ballot(sv[k] >= 0) : 0ull; }
        while (mk[0] | mk[1] | mk[2] | mk[3]) {
            v2u w[4][4]; float wt[4];
#pragma unroll
            for (int k = 0; k < 4; ++k) { const bool has = mk[k] != 0ull; const int e = has ? (int)__ffsll((long long)mk[k]) - 1 : 0; mk[k] &= mk[k] - 1ull;
                const int rc = (r0 + k * NGW < MX) ? r0 + k * NGW : r0; const int sl = has ? __builtin_amdgcn_readlane(sv[k], e) : 0;
                const bf16* yp = ys + ((size_t)e * 2048 + (rc >> 12) * CAP + sl) * DM; wt[k] = has ? 1.f : 0.f;
#pragma unroll
                for (int j = 0; j < 4; ++j) w[k][j] = *(const v2u*)(yp + 4 * lane + 256 * j); }
#pragma unroll
            for (int k = 0; k < 4; ++k)
#pragma unroll
                for (int j = 0; j < 4; ++j) { m[k][j][0] += wt[k] * bflo(w[k][j].x); m[k][j][1] += wt[k] * bfhi(w[k][j].x); m[k][j][2] += wt[k] * bflo(w[k][j].y); m[k][j][3] += wt[k] * bfhi(w[k][j].y); }
        }
        f32x4 gt[4][4];
#pragma unroll
        for (int k = 0; k < 4; ++k) { const int r = r0 + k * NGW, b = ((r < MX) ? r : r0) >> 12;
#pragma unroll
            for (int j = 0; j < 4; ++j) gt[k][j] = *(const f32x4*)(modr + b * 6144 + 5120 + 4 * lane + 256 * j); }
#pragma unroll
        for (int k = 0; k < 4; ++k) { const int r = r0 + k * NGW;
            if (r < MX) { float ss = 0.f; float* row = a.out + (size_t)r * DM;
#pragma unroll
                for (int j = 0; j < 4; ++j) { v[k][j] = v[k][j] + gt[k][j] * m[k][j] * DBG_MOE_K;
                    ss += v[k][j][0] * v[k][j][0] + v[k][j][1] * v[k][j][1] + v[k][j][2] * v[k][j][2] + v[k][j][3] * v[k][j][3]; }
                const float rs = rsqrtf(wave_sum(ss) * (1.0f / DM) + EPS);
#pragma unroll
                for (int j = 0; j < 4; ++j) *(f32x4*)(row + 4 * lane + 256 * j) = v[k][j] * rs * gf[j]; } }
    }
}

__global__ void __launch_bounds__(NTHR, 2) fwd_kernel(Args a) {
    extern __shared__ __attribute__((aligned(16))) unsigned char lds_raw[];
    LAS unsigned char* lds = (LAS unsigned char*)lds_raw;
    const int tid = threadIdx.x, wg = blockIdx.x, G = gridDim.x;
    unsigned char* ws = a.ws;
    volatile LAS unsigned* MISC = (volatile LAS unsigned*)(lds + LDS_MISC);
    if (tid < 64) MISC[tid] = 0u;
    __syncthreads();
    unsigned bgen = 0u, cdone = 0u;
    XcdBarrier bar; bar.bar = (unsigned*)(ws + WS_CTL); bar.x = 0; bar.st = nullptr;
    if (a.ph_hi - a.ph_lo > 1) bar = xcd_barrier_post((unsigned*)(ws + WS_CTL), MISC + 8);
#ifndef PH_ONLY
#define PH_ONLY -1
#endif
#define IN(k) ((PH_ONLY < 0 || PH_ONLY == (k)) && a.ph_lo <= (k) && (k) < a.ph_hi)
#ifndef DBG_BAR2
#define DBG_BAR2 0
#endif
#ifndef DBG_TSA
#define DBG_TSA -1
#endif
#ifndef DBG_TSB
#define DBG_TSB -1
#endif
#define STAMP(k) do { if (DBG_TSA >= 0 && wg == 0 && tid == 0) ((unsigned long long*)(ws + WS_CTL + 49152))[k] = __builtin_amdgcn_s_memrealtime(); } while (0)
#define SEAM(k) do { if (IN(k) && IN((k) + 1)) { seam_barrier(bar, a, lds, MISC, bgen, true, cdone); if (DBG_BAR2) xcd_barrier(bar); } STAMP((k) + 1); } while (0)
#ifndef DBG_DUP
#define DBG_DUP -1
#endif
#define REP(k) _Pragma("nounroll") for (int _rep = 0; _rep < ((DBG_DUP == (k)) ? 2 : 1); ++_rep, (void)((DBG_DUP == (k) && _rep == 1) ? (xcd_barrier(bar), 0) : 0))
    STAMP(0);
    if (IN(0)) REP(0) { phase0(a, lds); } SEAM(0);
    if (IN(1)) REP(1) { phase1(a, lds); } SEAM(1);
    if (IN(2)) REP(2) {
        pg8::Gemm g{(const pg8::bf16_t*)ws, (const pg8::bf16_t*)ws, MT, NIN, DM}; InSched S; S.init(G, wg, 0);
        EpiIn E{(bf16*)(ws + WS_QKVG), (bf16*)(ws + WS_HYT), (float*)(ws + WS_AFB)};
        pg8::gemm_phase<EpiIn, InSched, true, true>(lds, g, S, E);
    } SEAM(2);
    if (IN(3)) REP(3) {
        {   pg8::Gemm g{(const pg8::bf16_t*)ws, (const pg8::bf16_t*)ws, MT, NIN, DM}; InSched S; S.init(G, wg, 1);
            EpiIn E{(bf16*)(ws + WS_QKVG), (bf16*)(ws + WS_HYT), (float*)(ws + WS_AFB)};
            pg8::gemm_phase<EpiIn, InSched, true, true>(lds, g, S, E); }
        for (int it = wg; it < 512; it += G) hyena_item(a, lds, it, 0);
        {   GlaIn I, N; bool have = false;
            const bool split = (G == 256);
            const int first = split ? ((wg < 80) ? wg : 80 + wg) : wg, stride = split ? ((wg < 80) ? 80 : 176) : G, limit = split ? ((wg < 80) ? 160 : 16 * NCH) : 16 * NCH;
            for (int r = first; r < limit; r += stride) {
                const int nr = r + stride; const bool hasn = nr < limit;
                if (!have) { int t0 = threadIdx.x; asm volatile("" : "+v"(t0)); gla_load<false>(a, t0, r / NCH, r % NCH, I); have = true; }
                if (hasn) gla_upd_item<true>(a, lds, r / NCH, r % NCH, I, nr / NCH, nr % NCH, N); else gla_upd_item<false>(a, lds, r / NCH, r % NCH, I, 0, 0, N);
                I = N; } }
    } SEAM(3);
    if (IN(4)) REP(4) {
        for (int it = wg; it < 1024; it += G) { if (it < 512) hyena_item(a, lds, it, 1); else gla_scan_item(a, it - 512); }
    } SEAM(4);
    if (IN(5)) REP(5) {
        GlaIn I, N; bool have = false;
        for (int it = wg; it < 1280; it += G) {
            if (it >= 1024) { hy_transpose_item(a, lds, it - 1024); continue; }
            const int nr = it + G; const bool hasn = nr < 1024;
            if (!have) { int t0 = threadIdx.x; asm volatile("" : "+v"(t0)); gla_load<true>(a, t0, it >> 6, it & 63, I); have = true; }
            if (hasn) gla_out_item<true>(a, lds, it >> 6, it & 63, I, nr >> 6, nr & 63, N); else gla_out_item<false>(a, lds, it >> 6, it & 63, I, 0, 0, N);
            I = N; }
    } SEAM(5);
    if (IN(6)) REP(6) {
        pg8::Gemm g{(const pg8::bf16_t*)(ws + WS_AOUT), (const pg8::bf16_t*)(ws + WS_WOUT), MX, DM, DM}; pg8::StaticOrder S; S.init(MX, DM, G, wg);
        EpiOut E{a.in[0], (const float*)(ws + WS_POS), (const float*)(ws + WS_MOD), a.out};
        pg8::gemm_phase<EpiOut, pg8::StaticOrder, false, true>(lds, g, S, E);
    } SEAM(6);
    if (IN(7)) REP(7) { phase_router(a, lds); } SEAM(7);
    if (IN(8)) REP(8) { phase_topk(a, lds, cdone); } SEAM(8);
    if (IN(9)) REP(9) {
        pg8::Gemm g{(const pg8::bf16_t*)(ws + WS_HN), (const pg8::bf16_t*)(ws + WS_WGU), NE * 2048, NE * 2048, DM}; MoeSched<8> S; S.init(G, wg);
        EpiGU E{(bf16*)(ws + WS_HID)};
        pg8::gemm_phase_gather<EpiGU, MoeSched<8>, true, true>(lds, g, S, E, (const int*)(ws + WS_SELT));
    } SEAM(9);
    if (IN(10)) REP(10) {
        pg8::Gemm g{(const pg8::bf16_t*)(ws + WS_HID), (const pg8::bf16_t*)(ws + WS_WD), NE * 2048, NE * 1024, DM}; MoeSched<4> S; S.init(G, wg);
        EpiDown E{(bf16*)(ws + WS_YSLAB), (const float*)(ws + WS_SELV)};
        pg8::gemm_phase<EpiDown, MoeSched<4>, true, true>(lds, g, S, E);
    } SEAM(10);
    if (IN(11)) { phase_final(a); }
    if (DBG_TSA >= 0) {
        xcd_barrier(bar); STAMP(12); xcd_barrier(bar);
        const unsigned long long* ts = (const unsigned long long*)(ws + WS_CTL + 49152);
        const float da = (DBG_TSA == 12) ? (float)(ts[12] - ts[0]) * 0.01f : (float)(ts[DBG_TSA + 1] - ts[DBG_TSA]) * 0.01f;
        const float db = (DBG_TSB == 12) ? (float)(ts[12] - ts[0]) * 0.01f : (float)(ts[DBG_TSB + 1] - ts[DBG_TSB]) * 0.01f;
        for (size_t i = (size_t)wg * NTHR + tid; i < (size_t)MX * DM; i += (size_t)G * NTHR) a.out[i] = (i < (size_t)MX * DM / 2) ? da : db;
    }
#undef IN
#undef SEAM
}


#ifdef DBG_STATE
__global__ void chk_kernel(const unsigned* p, size_t nwords, unsigned long long* out) {
    unsigned long long s = 0ull;
    for (size_t i = (size_t)blockIdx.x * blockDim.x + threadIdx.x; i < nwords; i += (size_t)gridDim.x * blockDim.x) s += (unsigned long long)p[i] * (2ull * i + 1ull);
    for (int o = 1; o < 64; o <<= 1) s += __shfl_xor(s, o);
    if ((threadIdx.x & 63) == 0) atomicAdd(out, s);
}
__global__ void report_kernel(const unsigned long long* chk, float* out, int n) {
    int bad = -1;
    for (int p = 0; p < 27; ++p) if (chk[p] != chk[32 + p]) { bad = p; break; }
    if (bad < 0) return;
    for (int i = blockIdx.x * blockDim.x + threadIdx.x; i < n; i += gridDim.x * blockDim.x) out[i] = 1000.f * (float)(bad + 1);
}
struct ChkEnt { int ph; size_t off; size_t bytes; };
#endif
extern "C" void kernel_launch(void* const* d_in, const int* in_sizes, int n_in, void* d_out, int out_size, void* d_ws, size_t ws_size, hipStream_t stream) {
    static int grid = 0;
    if (grid == 0) {
        if (n_in != 29 || out_size != MX * DM || ws_size < WS_END) { fprintf(stderr, "kernel_launch: unexpected shapes (n_in %d out %d ws %zu)\n", n_in, out_size, ws_size); grid = -1; return; }
        int dev = 0, cus = 0, per_cu = 0;
        if (hipGetDevice(&dev) != hipSuccess || hipDeviceGetAttribute(&cus, hipDeviceAttributeMultiprocessorCount, dev) != hipSuccess) { grid = -1; return; }
        if (hipFuncSetAttribute((const void*)fwd_kernel, hipFuncAttributeMaxDynamicSharedMemorySize, LDS_BYTES) != hipSuccess) { fprintf(stderr, "kernel_launch: hipFuncSetAttribute failed\n"); grid = -1; return; }
        if (hipOccupancyMaxActiveBlocksPerMultiprocessor(&per_cu, (const void*)fwd_kernel, NTHR, LDS_BYTES) != hipSuccess || per_cu < 1) fprintf(stderr, "kernel_launch: occupancy query reports %d\n", per_cu);
        (void)hipGetLastError();
        grid = cus;
    }
    if (grid < 0) return;
    (void)hipMemsetAsync((char*)d_ws + WS_CTL, 0, CTL_BYTES, stream);
    Args a{};
    for (int i = 0; i < 29; ++i) a.in[i] = (const float*)d_in[i];
    a.out = (float*)d_out; a.ws = (unsigned char*)d_ws;
#if MK_SINGLE
#ifdef DBG_TWICE
    a.ph_lo = 0; a.ph_hi = NPH - 1;
    hipLaunchKernelGGL(fwd_kernel, dim3(grid), dim3(NTHR), LDS_BYTES, stream, a);
    (void)hipMemsetAsync((char*)d_ws + WS_CTL, 0, CTL_BYTES, stream);
#endif
    a.ph_lo = 0; a.ph_hi = NPH;
    hipLaunchKernelGGL(fwd_kernel, dim3(grid), dim3(NTHR), LDS_BYTES, stream, a);
#else
#ifdef DBG_STATE
    static const ChkEnt ents[] = { {0, WS_MOD, 122880}, {0, WS_POS, 131072}, {0, WS_HT, 32 * MiB}, {0, WS_WIN, (size_t)NIN * DM * 2}, {0, WS_WOUT, 2 * MiB},
        {1, WS_AIN, 34 * MiB}, {2, WS_QKVG, (size_t)MX * NQ * 2}, {2, WS_HYT, 48 * MiB}, {2, WS_AFB, (size_t)MT * 128},
        {3, WS_ZT, 32 * MiB}, {3, WS_DEC, (size_t)16 * 2 * NCH * 64 * 4}, {3, WS_UCTX, 4 * MiB}, {3, (size_t)-1, 64 * MiB},
        {4, WS_SPREV, 32 * MiB}, {4, WS_YHYT, 32 * MiB}, {5, WS_AOUT, 32 * MiB}, {6, (size_t)-1, 64 * MiB}, {7, WS_HN, 32 * MiB}, {7, WS_AFF, 1 * MiB},
        {8, WS_SLOT, 1 * MiB}, {8, WS_SELT, 131072}, {8, WS_SELV, 131072}, {8, WS_WGU, 64 * MiB}, {8, WS_WD, 32 * MiB}, {9, WS_HID, 64 * MiB}, {10, WS_YSLAB, 64 * MiB}, {11, (size_t)-1, 64 * MiB} };
    unsigned long long* chk = (unsigned long long*)((char*)d_ws + 32768);
    for (int run = 0; run < 2; ++run)
        for (int p = 0; p < NPH; ++p) { a.ph_lo = p; a.ph_hi = p + 1; hipLaunchKernelGGL(fwd_kernel, dim3(grid), dim3(NTHR), LDS_BYTES, stream, a);
            for (const ChkEnt& e : ents) if (e.ph == p) hipLaunchKernelGGL(chk_kernel, dim3(1024), dim3(256), 0, stream, (const unsigned*)(e.off == (size_t)-1 ? (char*)d_out : (char*)d_ws + e.off), e.bytes / 4, chk + run * 32 + (int)(&e - ents)); }
    hipLaunchKernelGGL(report_kernel, dim3(1024), dim3(256), 0, stream, (const unsigned long long*)chk, (float*)d_out, out_size);
#else
    for (int p = 0; p < NPH; ++p) { a.ph_lo = p; a.ph_hi = p + 1; hipLaunchKernelGGL(fwd_kernel, dim3(grid), dim3(NTHR), LDS_BYTES, stream, a); }
#endif
#endif
}
```

```cpp
#include <hip/hip_runtime.h>
#include <cstdio>
#include <cstdint>
#define MK_SINGLE 1
namespace pg8 {
#define PG8_LAS __attribute__((address_space(3)))
typedef unsigned short bf16_t;
typedef short bf16x8 __attribute__((ext_vector_type(8)));
typedef float f32x4 __attribute__((ext_vector_type(4)));
typedef unsigned u32x4 __attribute__((ext_vector_type(4)));
constexpr int BM = 256, BK = 64, HALF = 128, HTB = HALF * BK * 2  , STAGE_BYTES = 8 * HTB, NXCD = 8, WGM = 8;

__host__ __device__ __forceinline__ int lds_byte(int r, int c) { const int st = (r >> 4) * 2 + (c >> 5), rr = r & 15, cc = c & 31, ob = rr * 64 + cc * 2; return st * 1024 + (ob ^ (((ob >> 9) & 1) << 5)); }
__host__ __device__ __forceinline__ void stage_rc(int b, int& R, int& C) { const int st = b / 1024, sb = b % 1024, swz = sb ^ (((sb >> 9) & 1) << 5); R = (st >> 1) * 16 + swz / 64; C = (st & 1) * 32 + (swz % 64) / 2; }
__host__ __device__ __forceinline__ int perm32(int rho) { const int n = rho >> 4, i = rho & 15; return 8 * (i >> 2) + 4 * n + (i & 3); }

struct Unit { int pm, pn; };
struct Gemm { const bf16_t* A; const bf16_t* Bt; int M, N, K; };

struct StaticOrder {
    int nM, nN, nwg, G, c;
    __host__ __device__ void init(int M, int N, int G_, int c_) { nM = M / BM; nN = N / BM; nwg = nM * nN; G = G_; c = c_; }
    __host__ __device__ bool next(int i, Unit& u) const {
        const long L = (long)i * G + c; if (L >= nwg) return false;
        int wgid = (int)L; { const int q = nwg / NXCD, r = nwg % NXCD, xcd = wgid % NXCD, off = wgid / NXCD; wgid = (xcd < r ? xcd * (q + 1) : r * (q + 1) + (xcd - r) * q) + off; }
        const int nig = WGM * nN, gid = wgid / nig, fm = gid * WGM, gsz = (nM - fm) < WGM ? (nM - fm) : WGM;
        u.pm = fm + ((wgid % nig) % gsz); u.pn = (wgid % nig) / gsz; return true;
    }
    __device__ __forceinline__ void a_ready(const Unit&) const {}
    __device__ __forceinline__ void done(const Unit&) const {}
};

__device__ __forceinline__ unsigned cvt_pk_bf16(float lo, float hi) { unsigned r; asm volatile("v_cvt_pk_bf16_f32 %0, %1, %2" : "=v"(r) : "v"(lo), "v"(hi)); return r; }
template <class Epi, class Sched, bool ALIGN_EPI = false, bool SP2 = false>
__device__ __forceinline__ void gemm_phase(PG8_LAS unsigned char* lds, const Gemm g, const Sched& S, const Epi& E) {
    const int tid = threadIdx.x, wid = __builtin_amdgcn_readfirstlane(tid >> 6), lane = tid & 63, wr = wid >> 2, wc = wid & 3, fr = lane & 15, fq = lane >> 4;
    const int K = g.K, nt = K / BK;
    unsigned voffA[2], voffB[2];
#pragma unroll
    for (int i = 0; i < 2; ++i) { int R, C; stage_rc(tid * 16 + i * 8192, R, C); const int Rb = Epi::PERM ? ((R & ~31) + perm32(R & 31)) : R;
        voffA[i] = (unsigned)(R * K + C) * 2u; voffB[i] = (unsigned)(Rb * K + C) * 2u; }
    const size_t kstep = (size_t)(BK * 2);
    const size_t hstep = (size_t)HALF * K * 2;
    const size_t tstep = 2 * hstep;
    const unsigned ldsw = (unsigned)wid * 1024u;
    const int aoff = lds_byte(wr * 64 + fr, fq * 8), boff = lds_byte(wc * 32 + fr, fq * 8);
#define PG8_SA(b, h) (((b) * 2 + (h)) * HTB)
#define PG8_SB(b, h) ((4 + (b) * 2 + (h)) * HTB)
#define PG8_STAGE(bufoff, gbase, voff) do { _Pragma("unroll") for (int _i = 0; _i < 2; ++_i) \
        __builtin_amdgcn_global_load_lds((const unsigned*)((const char*)(gbase) + (voff)[_i]), (PG8_LAS unsigned*)(lds + (bufoff) + ldsw + _i * 8192), 16, 0, 0); } while (0)
#define PG8_LDA(dst, b, h) do { _Pragma("unroll") for (int m = 0; m < 4; ++m) _Pragma("unroll") for (int k = 0; k < 2; ++k) dst[m][k] = *(const PG8_LAS bf16x8*)(lds + PG8_SA(b, h) + aoff + m * 2048 + k * 1024); } while (0)
#define PG8_LDB(dst, b, h) do { _Pragma("unroll") for (int n = 0; n < 2; ++n) _Pragma("unroll") for (int k = 0; k < 2; ++k) dst[n][k] = *(const PG8_LAS bf16x8*)(lds + PG8_SB(b, h) + boff + n * 2048 + k * 1024); } while (0)
#define PG8_MMA(ai, bj, At, Bt) do { __builtin_amdgcn_s_setprio(1); _Pragma("unroll") for (int m = 0; m < 4; ++m) _Pragma("unroll") for (int n = 0; n < 2; ++n) _Pragma("unroll") for (int k = 0; k < 2; ++k) \
        acc[ai][bj][m][n] = __builtin_amdgcn_mfma_f32_16x16x32_bf16(Bt[n][k], At[m][k], acc[ai][bj][m][n], 0, 0, 0); __builtin_amdgcn_s_setprio(0); } while (0)
#define PG8_WAIT_V(n) asm volatile("s_waitcnt vmcnt(" #n ")" ::: "memory")
#define PG8_WAIT_L(n) asm volatile("s_waitcnt lgkmcnt(" #n ")" ::: "memory")
#define PG8_BAR __builtin_amdgcn_s_barrier()
#define PG8_SCHED __builtin_amdgcn_sched_barrier(0)
    Unit cur, nxt; int ui = 0;
    if (!S.next(0, cur)) return;
    f32x4 acc[2][2][4][2];
#pragma unroll
    for (int a = 0; a < 2; ++a)
#pragma unroll
        for (int b = 0; b < 2; ++b)
#pragma unroll
            for (int m = 0; m < 4; ++m)
#pragma unroll
                for (int n = 0; n < 2; ++n) acc[a][b][m][n] = (f32x4){0.f, 0.f, 0.f, 0.f};
    bf16x8 At[4][2], B0[2][2], B1[2][2];
    const char* cA = (const char*)g.A + (size_t)cur.pm * tstep; const char* cB = (const char*)g.Bt + (size_t)cur.pn * tstep;
    S.a_ready(cur);
    if constexpr (SP2) {
        PG8_STAGE(PG8_SB(0, 0), cB, voffB); PG8_STAGE(PG8_SB(0, 1), cB + hstep, voffB); PG8_STAGE(PG8_SA(0, 0), cA, voffA); PG8_STAGE(PG8_SA(0, 1), cA + hstep, voffA);
        if (wr == 1) PG8_BAR;
        PG8_WAIT_V(2); PG8_BAR;
        PG8_STAGE(PG8_SB(1, 0), cB + kstep, voffB); PG8_STAGE(PG8_SA(1, 0), cA + kstep, voffA); PG8_STAGE(PG8_SB(1, 1), cB + hstep + kstep, voffB);
        PG8_WAIT_V(6); PG8_BAR;
    } else {
        PG8_STAGE(PG8_SB(0, 0), cB, voffB); PG8_STAGE(PG8_SA(0, 0), cA, voffA); PG8_STAGE(PG8_SB(0, 1), cB + hstep, voffB); PG8_STAGE(PG8_SA(0, 1), cA + hstep, voffA);
        if (wr == 1) PG8_BAR;
        PG8_WAIT_V(4); PG8_BAR;
        PG8_STAGE(PG8_SB(1, 0), cB + kstep, voffB); PG8_STAGE(PG8_SA(1, 0), cA + kstep, voffA); PG8_STAGE(PG8_SB(1, 1), cB + hstep + kstep, voffB);
        PG8_WAIT_V(6); PG8_BAR;
    }
    for (;;) {
        const bool has_next = S.next(ui + 1, nxt);
        const char* nA = has_next ? (const char*)g.A + (size_t)nxt.pm * tstep : cA; const char* nB = has_next ? (const char*)g.Bt + (size_t)nxt.pn * tstep : cB;
        for (int t = 0; t < nt; t += 2) {
            const bool last = (t == nt - 2);
            const char* a1 = cA + (size_t)(t + 1) * kstep;
            const char* a2 = last ? nA : cA + (size_t)(t + 2) * kstep; const char* b2 = last ? nB : cB + (size_t)(t + 2) * kstep;
            const char* a3 = a2 + kstep; const char* b3 = b2 + kstep;
            if (last && has_next) S.a_ready(nxt);
            if constexpr (SP2) {
            PG8_LDB(B0, 0, 0); PG8_LDB(B1, 0, 1); PG8_SCHED; PG8_LDA(At, 0, 0); PG8_STAGE(PG8_SA(1, 1), a1 + hstep, voffA);
            PG8_WAIT_V(8); PG8_WAIT_L(0); PG8_BAR; PG8_MMA(0, 0, At, B0); PG8_MMA(0, 1, At, B1); PG8_BAR; PG8_SCHED;
            PG8_LDA(At, 0, 1); PG8_STAGE(PG8_SB(0, 0), b2, voffB); PG8_STAGE(PG8_SB(0, 1), b2 + hstep, voffB); PG8_STAGE(PG8_SA(0, 0), a2, voffA);
            PG8_WAIT_V(8); PG8_WAIT_L(0); PG8_BAR; PG8_MMA(1, 0, At, B0); PG8_MMA(1, 1, At, B1); PG8_BAR; PG8_SCHED;
            PG8_LDB(B0, 1, 0); PG8_LDB(B1, 1, 1); PG8_SCHED; PG8_LDA(At, 1, 0); PG8_STAGE(PG8_SA(0, 1), a2 + hstep, voffA);
            PG8_WAIT_V(8); PG8_WAIT_L(0); PG8_BAR; PG8_MMA(0, 0, At, B0); PG8_MMA(0, 1, At, B1); PG8_BAR; PG8_SCHED;
            PG8_LDA(At, 1, 1); PG8_STAGE(PG8_SB(1, 0), b3, voffB); PG8_STAGE(PG8_SB(1, 1), b3 + hstep, voffB); PG8_STAGE(PG8_SA(1, 0), a3, voffA);
            PG8_WAIT_V(8); PG8_WAIT_L(0); PG8_BAR; PG8_MMA(1, 0, At, B0); PG8_MMA(1, 1, At, B1); PG8_BAR; PG8_SCHED;
            } else {
            PG8_LDB(B0, 0, 0); PG8_SCHED; PG8_LDA(At, 0, 0); PG8_STAGE(PG8_SA(1, 1), a1 + hstep, voffA);
            PG8_WAIT_L(8); PG8_BAR; PG8_WAIT_L(0); PG8_MMA(0, 0, At, B0); PG8_BAR; PG8_SCHED;
            PG8_LDB(B1, 0, 1); PG8_STAGE(PG8_SB(0, 0), b2, voffB);
            PG8_BAR; PG8_WAIT_L(0); PG8_MMA(0, 1, At, B1); PG8_BAR;
            PG8_LDA(At, 0, 1); PG8_STAGE(PG8_SA(0, 0), a2, voffA);
            PG8_BAR; PG8_WAIT_L(0); PG8_MMA(1, 0, At, B0); PG8_BAR; PG8_SCHED;
            PG8_STAGE(PG8_SB(0, 1), b2 + hstep, voffB);
            PG8_WAIT_V(6); PG8_BAR; PG8_MMA(1, 1, At, B1); PG8_BAR;
            PG8_LDB(B0, 1, 0); PG8_SCHED; PG8_LDA(At, 1, 0); PG8_STAGE(PG8_SA(0, 1), a2 + hstep, voffA);
            PG8_WAIT_L(8); PG8_BAR; PG8_WAIT_L(0); PG8_MMA(0, 0, At, B0); PG8_BAR; PG8_SCHED;
            PG8_LDB(B1, 1, 1); PG8_STAGE(PG8_SB(1, 0), b3, voffB);
            PG8_BAR; PG8_WAIT_L(0); PG8_MMA(0, 1, At, B1); PG8_BAR;
            PG8_LDA(At, 1, 1); PG8_STAGE(PG8_SA(1, 0), a3, voffA);
            PG8_BAR; PG8_WAIT_L(0); PG8_MMA(1, 0, At, B0); PG8_BAR; PG8_SCHED;
            PG8_STAGE(PG8_SB(1, 1), b3 + hstep, voffB);
            PG8_WAIT_V(6); PG8_BAR; PG8_MMA(1, 1, At, B1); PG8_BAR;
            }
        }
        if constexpr (ALIGN_EPI) { if (wr == 0) PG8_BAR; }
        if constexpr (!Epi::AFTER_DRAIN) { E(acc, cur, wr, wc, fr, fq); S.done(cur); }
        if (!has_next) break;
#pragma unroll
        for (int a = 0; a < 2; ++a)
#pragma unroll
            for (int b = 0; b < 2; ++b)
#pragma unroll
                for (int m = 0; m < 4; ++m)
#pragma unroll
                    for (int n = 0; n < 2; ++n) acc[a][b][m][n] = (f32x4){0.f, 0.f, 0.f, 0.f};
        cur = nxt; cA = nA; cB = nB; ++ui;
        if constexpr (ALIGN_EPI) { if (wr == 1) PG8_BAR; }
    }
    PG8_WAIT_V(0);
    if constexpr (!ALIGN_EPI) { if (wr == 0) PG8_BAR; }
    PG8_BAR;
    if constexpr (Epi::AFTER_DRAIN) { E.fused(acc, cur, wr, wc, fr, fq, lds, wid, lane); S.done(cur); }
#undef PG8_SA
#undef PG8_SB
#undef PG8_STAGE
#undef PG8_LDA
#undef PG8_LDB
#undef PG8_MMA
#undef PG8_WAIT_V
#undef PG8_WAIT_L
#undef PG8_BAR
#undef PG8_SCHED
}
}
namespace pg8 {
template <class Epi, class Sched, bool ALIGN_EPI = false, bool SP2 = false>
__device__ __forceinline__ void gemm_phase_gather(PG8_LAS unsigned char* lds, const Gemm g, const Sched& S, const Epi& E, const int* __restrict__ idx) {
    const int tid = threadIdx.x, wid = __builtin_amdgcn_readfirstlane(tid >> 6), lane = tid & 63, wr = wid >> 2, wc = wid & 3, fr = lane & 15, fq = lane >> 4;
    const int K = g.K, nt = K / BK;
    unsigned voffB[2]; int RA[2], CA[2];
#pragma unroll
    for (int i = 0; i < 2; ++i) { int R, C; stage_rc(tid * 16 + i * 8192, R, C); const int Rb = Epi::PERM ? ((R & ~31) + perm32(R & 31)) : R;
        RA[i] = R; CA[i] = C; voffB[i] = (unsigned)(Rb * K + C) * 2u; }
    unsigned vA[2][2], nvA[2][2];
#define PG8_GOFF(dst, pm) do { _Pragma("unroll") for (int _h = 0; _h < 2; ++_h) _Pragma("unroll") for (int _i = 0; _i < 2; ++_i) { const int _r = (pm) * 256 + _h * 128 + RA[_i]; \
        dst[_h][_i] = (unsigned)((((_r >> 9) & 3) * 4096 + idx[_r]) * K + CA[_i]) * 2u; } } while (0)
    const size_t kstep = (size_t)(BK * 2);
    const size_t hstep = (size_t)HALF * K * 2;
    const size_t tstep = 2 * hstep;
    const unsigned ldsw = (unsigned)wid * 1024u;
    const int aoff = lds_byte(wr * 64 + fr, fq * 8), boff = lds_byte(wc * 32 + fr, fq * 8);
#define PG8_SA(b, h) (((b) * 2 + (h)) * HTB)
#define PG8_SB(b, h) ((4 + (b) * 2 + (h)) * HTB)
#define PG8_STAGE(bufoff, gbase, voff) do { _Pragma("unroll") for (int _i = 0; _i < 2; ++_i) \
        __builtin_amdgcn_global_load_lds((const unsigned*)((const char*)(gbase) + (voff)[_i]), (PG8_LAS unsigned*)(lds + (bufoff) + ldsw + _i * 8192), 16, 0, 0); } while (0)
#define PG8_LDA(dst, b, h) do { _Pragma("unroll") for (int m = 0; m < 4; ++m) _Pragma("unroll") for (int k = 0; k < 2; ++k) dst[m][k] = *(const PG8_LAS bf16x8*)(lds + PG8_SA(b, h) + aoff + m * 2048 + k * 1024); } while (0)
#define PG8_LDB(dst, b, h) do { _Pragma("unroll") for (int n = 0; n < 2; ++n) _Pragma("unroll") for (int k = 0; k < 2; ++k) dst[n][k] = *(const PG8_LAS bf16x8*)(lds + PG8_SB(b, h) + boff + n * 2048 + k * 1024); } while (0)
#define PG8_MMA(ai, bj, At, Bt) do { __builtin_amdgcn_s_setprio(1); _Pragma("unroll") for (int m = 0; m < 4; ++m) _Pragma("unroll") for (int n = 0; n < 2; ++n) _Pragma("unroll") for (int k = 0; k < 2; ++k) \
        acc[ai][bj][m][n] = __builtin_amdgcn_mfma_f32_16x16x32_bf16(Bt[n][k], At[m][k], acc[ai][bj][m][n], 0, 0, 0); __builtin_amdgcn_s_setprio(0); } while (0)
#define PG8_WAIT_V(n) asm volatile("s_waitcnt vmcnt(" #n ")" ::: "memory")
#define PG8_WAIT_L(n) asm volatile("s_waitcnt lgkmcnt(" #n ")" ::: "memory")
#define PG8_BAR __builtin_amdgcn_s_barrier()
#define PG8_SCHED __builtin_amdgcn_sched_barrier(0)
    Unit cur, nxt; int ui = 0;
    if (!S.next(0, cur)) return;
    f32x4 acc[2][2][4][2];
#pragma unroll
    for (int a = 0; a < 2; ++a)
#pragma unroll
        for (int b = 0; b < 2; ++b)
#pragma unroll
            for (int m = 0; m < 4; ++m)
#pragma unroll
                for (int n = 0; n < 2; ++n) acc[a][b][m][n] = (f32x4){0.f, 0.f, 0.f, 0.f};
    bf16x8 At[4][2], B0[2][2], B1[2][2];
    const char* cA = (const char*)g.A; PG8_GOFF(vA, cur.pm); const char* cB = (const char*)g.Bt + (size_t)cur.pn * tstep;
    S.a_ready(cur);
    if constexpr (SP2) {
        PG8_STAGE(PG8_SB(0, 0), cB, voffB); PG8_STAGE(PG8_SB(0, 1), cB + hstep, voffB); PG8_STAGE(PG8_SA(0, 0), cA, vA[0]); PG8_STAGE(PG8_SA(0, 1), cA, vA[1]);
        if (wr == 1) PG8_BAR;
        PG8_WAIT_V(2); PG8_BAR;
        PG8_STAGE(PG8_SB(1, 0), cB + kstep, voffB); PG8_STAGE(PG8_SA(1, 0), cA + kstep, vA[0]); PG8_STAGE(PG8_SB(1, 1), cB + hstep + kstep, voffB);
        PG8_WAIT_V(6); PG8_BAR;
    } else {
        PG8_STAGE(PG8_SB(0, 0), cB, voffB); PG8_STAGE(PG8_SA(0, 0), cA, vA[0]); PG8_STAGE(PG8_SB(0, 1), cB + hstep, voffB); PG8_STAGE(PG8_SA(0, 1), cA, vA[1]);
        if (wr == 1) PG8_BAR;
        PG8_WAIT_V(4); PG8_BAR;
        PG8_STAGE(PG8_SB(1, 0), cB + kstep, voffB); PG8_STAGE(PG8_SA(1, 0), cA + kstep, vA[0]); PG8_STAGE(PG8_SB(1, 1), cB + hstep + kstep, voffB);
        PG8_WAIT_V(6); PG8_BAR;
    }
    for (;;) {
        const bool has_next = S.next(ui + 1, nxt);
        if (has_next) { PG8_GOFF(nvA, nxt.pm); } else { nvA[0][0] = vA[0][0]; nvA[0][1] = vA[0][1]; nvA[1][0] = vA[1][0]; nvA[1][1] = vA[1][1]; } const char* nB = has_next ? (const char*)g.Bt + (size_t)nxt.pn * tstep : cB;
        for (int t = 0; t < nt; t += 2) {
            const bool last = (t == nt - 2);
            const char* a1 = cA + (size_t)(t + 1) * kstep;
            const char* a2 = cA + (last ? (size_t)0 : (size_t)(t + 2) * kstep); unsigned w2[2][2]; w2[0][0] = last ? nvA[0][0] : vA[0][0]; w2[0][1] = last ? nvA[0][1] : vA[0][1]; w2[1][0] = last ? nvA[1][0] : vA[1][0]; w2[1][1] = last ? nvA[1][1] : vA[1][1]; const char* b2 = last ? nB : cB + (size_t)(t + 2) * kstep;
            const char* a3 = a2 + kstep; const char* b3 = b2 + kstep;
            if (last && has_next) S.a_ready(nxt);
            if constexpr (SP2) {
            PG8_LDB(B0, 0, 0); PG8_LDB(B1, 0, 1); PG8_SCHED; PG8_LDA(At, 0, 0); PG8_STAGE(PG8_SA(1, 1), a1, vA[1]);
            PG8_WAIT_V(8); PG8_WAIT_L(0); PG8_BAR; PG8_MMA(0, 0, At, B0); PG8_MMA(0, 1, At, B1); PG8_BAR; PG8_SCHED;
            PG8_LDA(At, 0, 1); PG8_STAGE(PG8_SB(0, 0), b2, voffB); PG8_STAGE(PG8_SB(0, 1), b2 + hstep, voffB); PG8_STAGE(PG8_SA(0, 0), a2, w2[0]);
            PG8_WAIT_V(8); PG8_WAIT_L(0); PG8_BAR; PG8_MMA(1, 0, At, B0); PG8_MMA(1, 1, At, B1); PG8_BAR; PG8_SCHED;
            PG8_LDB(B0, 1, 0); PG8_LDB(B1, 1, 1); PG8_SCHED; PG8_LDA(At, 1, 0); PG8_STAGE(PG8_SA(0, 1), a2, w2[1]);
            PG8_WAIT_V(8); PG8_WAIT_L(0); PG8_BAR; PG8_MMA(0, 0, At, B0); PG8_MMA(0, 1, At, B1); PG8_BAR; PG8_SCHED;
            PG8_LDA(At, 1, 1); PG8_STAGE(PG8_SB(1, 0), b3, voffB); PG8_STAGE(PG8_SB(1, 1), b3 + hstep, voffB); PG8_STAGE(PG8_SA(1, 0), a3, w2[0]);
            PG8_WAIT_V(8); PG8_WAIT_L(0); PG8_BAR; PG8_MMA(1, 0, At, B0); PG8_MMA(1, 1, At, B1); PG8_BAR; PG8_SCHED;
            } else {
            PG8_LDB(B0, 0, 0); PG8_SCHED; PG8_LDA(At, 0, 0); PG8_STAGE(PG8_SA(1, 1), a1, vA[1]);
            PG8_WAIT_L(8); PG8_BAR; PG8_WAIT_L(0); PG8_MMA(0, 0, At, B0); PG8_BAR; PG8_SCHED;
            PG8_LDB(B1, 0, 1); PG8_STAGE(PG8_SB(0, 0), b2, voffB);
            PG8_BAR; PG8_WAIT_L(0); PG8_MMA(0, 1, At, B1); PG8_BAR;
            PG8_LDA(At, 0, 1); PG8_STAGE(PG8_SA(0, 0), a2, w2[0]);
            PG8_BAR; PG8_WAIT_L(0); PG8_MMA(1, 0, At, B0); PG8_BAR; PG8_SCHED;
            PG8_STAGE(PG8_SB(0, 1), b2 + hstep, voffB);
            PG8_WAIT_V(6); PG8_BAR; PG8_MMA(1, 1, At, B1); PG8_BAR;
            PG8_LDB(B0, 1, 0); PG8_SCHED; PG8_LDA(At, 1, 0); PG8_STAGE(PG8_SA(0, 1), a2, w2[1]);
            PG8_WAIT_L(8); PG8_BAR; PG8_WAIT_L(0); PG8_MMA(0, 0, At, B0); PG8_BAR; PG8_SCHED;
            PG8_LDB(B1, 1, 1); PG8_STAGE(PG8_SB(1, 0), b3, voffB);
            PG8_BAR; PG8_WAIT_L(0); PG8_MMA(0, 1, At, B1); PG8_BAR;
            PG8_LDA(At, 1, 1); PG8_STAGE(PG8_SA(1, 0), a3, w2[0]);
            PG8_BAR; PG8_WAIT_L(0); PG8_MMA(1, 0, At, B0); PG8_BAR; PG8_SCHED;
            PG8_STAGE(PG8_SB(1, 1), b3 + hstep, voffB);
            PG8_WAIT_V(6); PG8_BAR; PG8_MMA(1, 1, At, B1); PG8_BAR;
            }
        }
        if constexpr (ALIGN_EPI) { if (wr == 0) PG8_BAR; }
        if constexpr (!Epi::AFTER_DRAIN) { E(acc, cur, wr, wc, fr, fq); S.done(cur); }
        if (!has_next) break;
#pragma unroll
        for (int a = 0; a < 2; ++a)
#pragma unroll
            for (int b = 0; b < 2; ++b)
#pragma unroll
                for (int m = 0; m < 4; ++m)
#pragma unroll
                    for (int n = 0; n < 2; ++n) acc[a][b][m][n] = (f32x4){0.f, 0.f, 0.f, 0.f};
        cur = nxt; cB = nB; ++ui; vA[0][0] = nvA[0][0]; vA[0][1] = nvA[0][1]; vA[1][0] = nvA[1][0]; vA[1][1] = nvA[1][1];
        if constexpr (ALIGN_EPI) { if (wr == 1) PG8_BAR; }
    }
    PG8_WAIT_V(0);
    if constexpr (!ALIGN_EPI) { if (wr == 0) PG8_BAR; }
    PG8_BAR;
    if constexpr (Epi::AFTER_DRAIN) { E.fused(acc, cur, wr, wc, fr, fq, lds, wid, lane); S.done(cur); }
#undef PG8_SA
#undef PG8_SB
#undef PG8_STAGE
#undef PG8_LDA
#undef PG8_LDB
#undef PG8_MMA
#undef PG8_WAIT_V
#undef PG8_WAIT_L
#undef PG8_BAR
#undef PG8_SCHED
#undef PG8_GOFF
}
}

#ifndef DBG_NOMIX
#define DBG_NOMIX 0
#endif
#ifndef DBG_NOMOE
#define DBG_NOMOE 0
#endif
#ifndef DBG_NOPOS
#define DBG_NOPOS 0
#endif
#ifndef DBG_HTCONST
#define DBG_HTCONST 0
#endif
#ifndef DBG_GLA_K
#define DBG_GLA_K 1.0f
#endif
#ifndef DBG_MOE_K
#define DBG_MOE_K 1.0f
#endif
#ifndef MK_SINGLE
#define MK_SINGLE 0
#endif
#define GAS __attribute__((address_space(1)))
#define LAS __attribute__((address_space(3)))
typedef unsigned short bf16;
typedef float f32x4 __attribute__((ext_vector_type(4)));
typedef float f32x16 __attribute__((ext_vector_type(16)));
typedef short bf16x8 __attribute__((ext_vector_type(8)));
typedef unsigned v4u __attribute__((ext_vector_type(4)));
typedef unsigned v2u __attribute__((ext_vector_type(2)));
typedef GAS unsigned gu32;

constexpr int NWAVES = 8, NTHR = 512;
constexpr int NB = 4, SEQ = 4096, DM = 1024, CTXL = 256;
constexpr int MX = NB * SEQ, MC = NB * CTXL, MT = MX + MC;
constexpr int NIN = 3328, NQ = 1536, DIN = 3104;
constexpr int NE = 16, CAP = 512;
constexpr int NCH = 68;
constexpr int NPH = 12;
constexpr float EPS = 1e-6f;

constexpr size_t MiB = 1u << 20;
constexpr size_t WS_CTL = 0, CTL_BYTES = 65536;
constexpr int CW_CNT_D = 8192, CW_CNT_GU = 8192 + 64;
constexpr size_t WS_MOD = 1 * MiB, WS_POS = 1 * MiB + 256 * 1024, WS_DEC = 2 * MiB, WS_AFF = 3 * MiB, WS_SLOT = 4 * MiB, WS_SELT = 5 * MiB, WS_SELV = 5 * MiB + 256 * 1024;
constexpr size_t WS_UCTX = 6 * MiB, WS_AFB = 10 * MiB, WS_WIN = 13 * MiB, WS_WOUT = 20 * MiB;
constexpr size_t WS_R1 = 22 * MiB, WS_R2 = 56 * MiB, WS_R3 = 107 * MiB, WS_R4 = 203 * MiB, WS_R5 = 235 * MiB, WS_R6 = 267 * MiB, WS_END = 299 * MiB;
constexpr size_t WS_AIN = WS_R1, WS_ZT = 155 * MiB, WS_HN = WS_R1;
constexpr size_t WS_QKVG = WS_R2;
constexpr size_t WS_HYT = WS_R3, WS_WD = 171 * MiB;
constexpr size_t WS_WGU = WS_R5;
constexpr size_t WS_HID = WS_R2, WS_YSLAB = WS_R4;
constexpr size_t WS_HT = WS_R4, WS_AOUT = WS_R4;
constexpr size_t WS_SPREV = WS_R1;
constexpr int LDS_BYTES = 144 * 1024;
constexpr int LDS_MISC = LDS_BYTES - 256;

struct Args { const float* in[29]; float* out; unsigned char* ws; int ph_lo, ph_hi; };

#define LDS_WAIT() asm volatile("s_waitcnt lgkmcnt(0)" ::: "memory")
#define VM_WAIT() asm volatile("s_waitcnt vmcnt(0)" ::: "memory")
__device__ __forceinline__ unsigned f2bf(float f) { unsigned u = __float_as_uint(f); return (u + 0x7fffu + ((u >> 16) & 1u)) >> 16; }
__device__ __forceinline__ unsigned pk2(float lo, float hi) { return pg8::cvt_pk_bf16(lo, hi); }
__device__ __forceinline__ float bflo(unsigned w) { return __uint_as_float(w << 16); }
__device__ __forceinline__ float bfhi(unsigned w) { return __uint_as_float(w & 0xffff0000u); }
template <int CTRL> __device__ __forceinline__ float dpp_f(float v) { return __builtin_bit_cast(float, __builtin_amdgcn_update_dpp(0, __builtin_bit_cast(int, v), CTRL, 0xf, 0xf, false)); }
__device__ __forceinline__ void swap16(float& a, float& b) { asm("v_nop\n\tv_nop\n\tv_permlane16_swap_b32 %0, %1" : "+v"(a), "+v"(b)); }
__device__ __forceinline__ void swap32(float& a, float& b) { asm("v_nop\n\tv_nop\n\tv_permlane32_swap_b32 %0, %1" : "+v"(a), "+v"(b)); }
__device__ __forceinline__ float row_allsum(float v) { v += dpp_f<0x128>(v); v += dpp_f<0x124>(v); v += dpp_f<0x122>(v); v += dpp_f<0x121>(v); return v; }
__device__ __forceinline__ float x16_sum(float v) { float a = v, b = v; swap16(a, b); return a + b; }
__device__ __forceinline__ float x32_sum(float v) { float a = v, b = v; swap32(a, b); return a + b; }
__device__ __forceinline__ float x16_max(float v) { float a = v, b = v; swap16(a, b); return fmaxf(a, b); }
__device__ __forceinline__ float x32_max(float v) { float a = v, b = v; swap32(a, b); return fmaxf(a, b); }
__device__ __forceinline__ float wave_sum(float v) { return x32_sum(x16_sum(row_allsum(v))); }
__device__ __forceinline__ float silu_f(float v) { return v * __builtin_amdgcn_rcpf(1.f + __expf(-v)); }
__device__ __forceinline__ float logsig_f(float x) { return fminf(x, 0.f) - __logf(1.0f + __expf(-fabsf(x))); }

#define XB_TMO      128
#define XB_XCNT(j)  (256  + 64 * (j))
#define XB_XSUB(j)  (1280 + 64 * (j))
#define XB_XGEN(j)  (2304 + 64 * (j))
#define XB_TOP      3328
#define XB_TOPGEN   3392
#define XCD_BAR_WORDS 3456
#define XB_SPIN_CAP (1u << 22)
__device__ __forceinline__ unsigned xb_ld(unsigned* p)              { return __hip_atomic_load(p, __ATOMIC_RELAXED, __HIP_MEMORY_SCOPE_AGENT); }
__device__ __forceinline__ unsigned xb_add(unsigned* p, unsigned v) { return __hip_atomic_fetch_add(p, v, __ATOMIC_RELAXED, __HIP_MEMORY_SCOPE_AGENT); }
__device__ __forceinline__ unsigned xb_xcc_id() { return (unsigned)__builtin_amdgcn_s_getreg((3 << 11) | 20) & 0xFu; }
#define XB_SPIN(cond, bar) do { unsigned _sp = 0; while (cond) { __builtin_amdgcn_s_sleep(1); \
    if ((++_sp & 255u) == 0u) { if (xb_ld(&(bar)[XB_TMO])) break; if (_sp > XB_SPIN_CAP) { atomicAdd(&(bar)[XB_TMO], 1u); break; } } } } while (0)
struct XcdBarrier { unsigned* bar; unsigned x; volatile LAS unsigned* st; };
__device__ __forceinline__ XcdBarrier xcd_barrier_post(unsigned* bar, volatile LAS unsigned* st) {
    XcdBarrier b; b.bar = bar; b.x = xb_xcc_id(); b.st = st;
    if (threadIdx.x == 0) (void)xb_add(&bar[XB_XCNT(b.x)], 1u);
    return b;
}
__device__ __forceinline__ void xcd_barrier_complete(unsigned* bar, unsigned x, unsigned& nloc, unsigned& nx) {
    const unsigned G = gridDim.x * gridDim.y * gridDim.z;
    unsigned sum, cnt, mine, sp = 0u;
    for (;;) {
        sum = 0u; cnt = 0u; mine = 0u;
#pragma unroll
        for (unsigned j = 0; j < 16; ++j) { const unsigned c = xb_ld(&bar[XB_XCNT(j)]); sum += c; cnt += (c > 0u) ? 1u : 0u; mine = (j == x) ? c : mine; }
        if (sum == G) break;
        __builtin_amdgcn_s_sleep(1);
        if ((++sp & 255u) == 0u) { if (xb_ld(&bar[XB_TMO])) break; if (sp > XB_SPIN_CAP) { atomicAdd(&bar[XB_TMO], 1u); break; } }
    }
    nloc = mine > 0u ? mine : 1u; nx = cnt > 0u ? cnt : 1u;
}
__device__ __forceinline__ void xcd_barrier(const XcdBarrier& b) {
    asm volatile("s_waitcnt vmcnt(0)" ::: "memory");
    __syncthreads();
    if (threadIdx.x == 0) {
        unsigned* bar = b.bar;
        __builtin_amdgcn_s_waitcnt(0);
        unsigned nloc = b.st[0], nx = b.st[1];
        if (nloc == 0u) { xcd_barrier_complete(bar, b.x, nloc, nx); b.st[0] = nloc; b.st[1] = nx; }
        const unsigned old = xb_add(&bar[XB_XSUB(b.x)], 1u);
        const unsigned gen = old / nloc;
        if (old + 1u == (gen + 1u) * nloc) {
            __builtin_amdgcn_fence(__ATOMIC_RELEASE, "agent");
            asm volatile("s_waitcnt vmcnt(0)" ::: "memory");
            const unsigned og = xb_add(&bar[XB_TOP], 1u);
            const unsigned tg = og / nx;
            if (og + 1u == (tg + 1u) * nx) xb_add(&bar[XB_TOPGEN], 1u);
            else XB_SPIN(xb_ld(&bar[XB_TOPGEN]) == tg, bar);
            __builtin_amdgcn_fence(__ATOMIC_ACQUIRE, "agent");
            xb_add(&bar[XB_XGEN(b.x)], 1u);
            asm volatile("s_waitcnt vmcnt(0)" ::: "memory");
        } else {
            XB_SPIN(xb_ld(&bar[XB_XGEN(b.x)]) == gen, bar);
            __builtin_amdgcn_fence(__ATOMIC_ACQUIRE, "agent");
            asm volatile("s_waitcnt vmcnt(0)" ::: "memory");
        }
    }
    __syncthreads();
}

constexpr int TILE_AIN = (int)(WS_AIN / (512 * 1024)), TILE_WIN = (int)(WS_WIN / (512 * 1024));
struct InSched {
    int G, c, part;
    __device__ void init(int G_, int c_, int part_) { G = G_; c = c_; part = part_; }
    __device__ static void qg_unit(int qg, pg8::Unit& u) { const int t = qg >> 6; u.pm = TILE_AIN + (qg & 63); u.pn = TILE_WIN + ((t == 0) ? 0 : 3 + t); }
    __device__ bool next(int i, pg8::Unit& u) const {
        const int L = i * G + c;
        if (part) { const int qg = 112 + L; if (qg >= 192) return false; qg_unit(qg, u); return true; }
        if (L < 384) { u.pm = TILE_WIN + 6 + (L >> 6); u.pn = TILE_AIN + (L & 63); return true; }
        if (L < 640) { const int l = L - 384, q = l >> 6; u.pm = TILE_AIN + (l & 63); u.pn = TILE_WIN + ((q == 3) ? 12 : (1 + q)); return true; }
        if (L < 656) { const int jx = L - 640, q = jx >> 2; u.pm = TILE_AIN + 64 + (jx & 3); u.pn = TILE_WIN + ((q == 3) ? 12 : (1 + q)); return true; }
        if (L >= 768) return false;
        qg_unit(L - 656, u); return true;
    }
    __device__ __forceinline__ void a_ready(const pg8::Unit&) const {}
    __device__ __forceinline__ void done(const pg8::Unit&) const {}
};
template <int NT> struct MoeSched {
    int G, c;
    __device__ void init(int G_, int c_) { G = G_; c = c_; }
    __device__ bool next(int i, pg8::Unit& u) const {
        const int L = i * G + c; if (L >= NE * 8 * NT) return false;
        const int e = L / (8 * NT), l = L % (8 * NT), x = l & 7, y = l >> 3;
        constexpr int HN = NT / 2;
        const int pm = 2 * (x >> 1) + (y / HN), pn = HN * (x & 1) + (y % HN);
        u.pm = e * 8 + pm; u.pn = e * NT + pn; return true;
    }
    __device__ __forceinline__ void a_ready(const pg8::Unit&) const {}
    __device__ __forceinline__ void done(const pg8::Unit&) const {}
};

struct EpiIn {
    static constexpr bool PERM = true, AFTER_DRAIN = false;
    bf16* qkvg; bf16* hyT; float* afb;
    __device__ __forceinline__ void operator()(const f32x4 (&acc)[2][2][4][2], const pg8::Unit& u, int wr, int wc, int fr, int fq) const {
        if (u.pm < TILE_AIN) {
            const int ch0 = (u.pm - TILE_WIN - 6) * 256 + wr * 64 + fr, mt = u.pn - TILE_AIN, b = mt >> 4, t0 = (mt & 15) * 256 + wc * 32 + 8 * fq;
#pragma unroll
            for (int ai = 0; ai < 2; ++ai)
#pragma unroll
                for (int m = 0; m < 4; ++m) { bf16* rowp = hyT + ((size_t)b * 1536 + ch0 + ai * 128 + m * 16) * SEQ + t0;
#pragma unroll
                    for (int bj = 0; bj < 2; ++bj) { const f32x4 v0 = acc[ai][bj][m][0], v1 = acc[ai][bj][m][1];
                        v4u w; w.x = pk2(v0[0], v0[1]); w.y = pk2(v0[2], v0[3]); w.z = pk2(v1[0], v1[1]); w.w = pk2(v1[2], v1[3]);
                        *(v4u*)(rowp + bj * 128) = w; } }
            return;
        }
        const int pm = u.pm - TILE_AIN, pn = u.pn - TILE_WIN;
        const int row0 = pm * 256 + wr * 64 + fr;
        if (pn < 6) {
            const float sc = (pn == 0) ? 0.125f : 1.f;
            const int col0 = pn * 256 + wc * 32 + 8 * fq;
#pragma unroll
            for (int ai = 0; ai < 2; ++ai)
#pragma unroll
                for (int m = 0; m < 4; ++m) { bf16* rowp = qkvg + (size_t)(row0 + ai * 128 + m * 16) * NQ + col0;
#pragma unroll
                    for (int bj = 0; bj < 2; ++bj) { const f32x4 v0 = acc[ai][bj][m][0] * sc, v1 = acc[ai][bj][m][1] * sc;
                        v4u w; w.x = pk2(v0[0], v0[1]); w.y = pk2(v0[2], v0[3]); w.z = pk2(v1[0], v1[1]); w.w = pk2(v1[2], v1[3]);
                        *(v4u*)(rowp + bj * 128) = w; } }
        } else {
            if (wc != 0) return;
#pragma unroll
            for (int ai = 0; ai < 2; ++ai)
#pragma unroll
                for (int m = 0; m < 4; ++m) { float* rowp = afb + (size_t)(row0 + ai * 128 + m * 16) * 32 + 8 * fq;
                    *(f32x4*)(rowp) = acc[ai][0][m][0]; *(f32x4*)(rowp + 4) = acc[ai][0][m][1]; }
        }
    }
};
struct EpiOut {
    static constexpr bool PERM = false, AFTER_DRAIN = false;
    const float* __restrict__ x; const float* __restrict__ postab; const float* __restrict__ modr; float* __restrict__ x1;
    __device__ __forceinline__ void operator()(const f32x4 (&acc)[2][2][4][2], const pg8::Unit& u, int wr, int wc, int fr, int fq) const {
        const int row0 = u.pm * 256 + wr * 64 + fr, col0 = u.pn * 256 + wc * 32 + 4 * fq;
        const int b = row0 >> 12;
        f32x4 gv[2][2];
#pragma unroll
        for (int bj = 0; bj < 2; ++bj)
#pragma unroll
            for (int n = 0; n < 2; ++n) gv[bj][n] = *(const f32x4*)(modr + b * 6144 + 2048 + col0 + bj * 128 + n * 16);
#pragma unroll
        for (int ai = 0; ai < 2; ++ai)
#pragma unroll
            for (int m = 0; m < 4; ++m) { const int r = row0 + ai * 128 + m * 16; const int t = r & 4095, rr = t >> 6, cc = t & 63;
                f32x4 xv[2][2], pv[2][2];
#pragma unroll
                for (int bj = 0; bj < 2; ++bj)
#pragma unroll
                    for (int n = 0; n < 2; ++n) { const int c = col0 + bj * 128 + n * 16;
                        xv[bj][n] = *(const f32x4*)(x + (size_t)r * DM + c);
                        pv[bj][n] = *(const f32x4*)(postab + ((c < 512) ? rr * 512 + c : cc * 512 + c - 512)); }
#pragma unroll
                for (int bj = 0; bj < 2; ++bj)
#pragma unroll
                    for (int n = 0; n < 2; ++n) { const int c = col0 + bj * 128 + n * 16;
                        *(f32x4*)(x1 + (size_t)r * DM + c) = xv[bj][n] + (DBG_NOPOS ? pv[bj][n] * 0.f : pv[bj][n]) + (DBG_NOMIX ? gv[bj][n] * 0.f : gv[bj][n] * acc[ai][bj][m][n]); } }
    }
};
struct EpiGU {
    static constexpr bool PERM = true, AFTER_DRAIN = false;
    bf16* hid;
    __device__ __forceinline__ void operator()(const f32x4 (&acc)[2][2][4][2], const pg8::Unit& u, int wr, int wc, int fr, int fq) const {
        const int row0 = u.pm * 256 + wr * 64 + fr, col0 = (u.pn & 7) * 128 + wc * 32 + 8 * fq;
#pragma unroll
        for (int ai = 0; ai < 2; ++ai)
#pragma unroll
            for (int m = 0; m < 4; ++m) { bf16* rowp = hid + (size_t)(row0 + ai * 128 + m * 16) * DM + col0;
                float o[8];
#pragma unroll
                for (int n = 0; n < 2; ++n)
#pragma unroll
                    for (int j = 0; j < 4; ++j) o[n * 4 + j] = silu_f(acc[ai][0][m][n][j]) * acc[ai][1][m][n][j];
                v4u w; w.x = pk2(o[0], o[1]); w.y = pk2(o[2], o[3]); w.z = pk2(o[4], o[5]); w.w = pk2(o[6], o[7]);
                *(v4u*)rowp = w; }
    }
};
struct EpiDown {
    static constexpr bool PERM = true, AFTER_DRAIN = false;
    bf16* __restrict__ ys; const float* __restrict__ selv;
    __device__ __forceinline__ void operator()(const f32x4 (&acc)[2][2][4][2], const pg8::Unit& u, int wr, int wc, int fr, int fq) const {
        const int row0 = u.pm * 256 + wr * 64 + fr, col0 = (u.pn & 3) * 256 + wc * 32 + 8 * fq;
        float scv[2][4];
#pragma unroll
        for (int ai = 0; ai < 2; ++ai)
#pragma unroll
            for (int m = 0; m < 4; ++m) scv[ai][m] = selv[row0 + ai * 128 + m * 16];
#pragma unroll
        for (int ai = 0; ai < 2; ++ai)
#pragma unroll
            for (int m = 0; m < 4; ++m) { const int r = row0 + ai * 128 + m * 16; const float sc = scv[ai][m]; bf16* rowp = ys + (size_t)r * DM + col0;
#pragma unroll
                for (int bj = 0; bj < 2; ++bj) { const f32x4 v0 = acc[ai][bj][m][0] * sc, v1 = acc[ai][bj][m][1] * sc;
                    v4u w; w.x = pk2(v0[0], v0[1]); w.y = pk2(v0[2], v0[3]); w.z = pk2(v1[0], v1[1]); w.w = pk2(v1[2], v1[3]);
                    *(v4u*)(rowp + bj * 128) = w; } }
    }
};

__device__ __forceinline__ void transpose_item(const float* W, int ldw, int k0, int nsrc0, bf16* WT, int K, int drow0, LAS float* scr, int lane, bool zero) {
    float tv[32];
#pragma unroll
    for (int i = 0; i < 32; ++i) { const int kk = 2 * i + (lane >> 5); tv[i] = zero ? 0.f : W[(size_t)(k0 + kk) * ldw + nsrc0 + (lane & 31)]; }
#pragma unroll
    for (int i = 0; i < 32; ++i) { const int kk = 2 * i + (lane >> 5); scr[kk * 33 + (lane & 31)] = tv[i]; }
    LDS_WAIT();
    const int c = lane & 7;
#pragma unroll
    for (int j = 0; j < 4; ++j) { const int n = (lane >> 3) + 8 * j; const LAS float* s = scr + (8 * c) * 33 + n;
        v4u o; o.x = pk2(s[0 * 33], s[1 * 33]); o.y = pk2(s[2 * 33], s[3 * 33]); o.z = pk2(s[4 * 33], s[5 * 33]); o.w = pk2(s[6 * 33], s[7 * 33]);
        *(v4u*)(WT + (size_t)(drow0 + n) * K + k0 + 8 * c) = o; }
    LDS_WAIT();
}

__device__ __forceinline__ void split8(const float (&x)[8], pg8::bf16x8& hi, pg8::bf16x8& lo) {
    v4u h, l;
#pragma unroll
    for (int e = 0; e < 4; ++e) { const unsigned w = pk2(x[2 * e], x[2 * e + 1]); h[e] = w; l[e] = pk2(x[2 * e] - bflo(w), x[2 * e + 1] - bfhi(w)); }
    hi = __builtin_bit_cast(pg8::bf16x8, h); lo = __builtin_bit_cast(pg8::bf16x8, l);
}
__device__ __forceinline__ f32x4 mfma3(pg8::bf16x8 ah, pg8::bf16x8 al, pg8::bf16x8 bh, pg8::bf16x8 bl, f32x4 acc) {
    acc = __builtin_amdgcn_mfma_f32_16x16x32_bf16(al, bh, acc, 0, 0, 0);
    acc = __builtin_amdgcn_mfma_f32_16x16x32_bf16(ah, bl, acc, 0, 0, 0);
    return __builtin_amdgcn_mfma_f32_16x16x32_bf16(ah, bh, acc, 0, 0, 0);
}
__device__ __forceinline__ void sine_layer(const LAS float* in, const LAS float* w, LAS float* out, const float* bias, const float* freq, int wave, int lane) {
    const int m16 = lane & 15, kg = lane >> 4, mt = wave >> 1, nt0 = (wave & 1) * 2;
    pg8::bf16x8 Ah[2], Al[2];
#pragma unroll
    for (int s = 0; s < 2; ++s) { const LAS float* hp = in + (16 * mt + m16) * 68 + 32 * s + 8 * kg; const f32x4 x = *(const LAS f32x4*)hp, y = *(const LAS f32x4*)(hp + 4);
        const float v[8] = {x[0], x[1], x[2], x[3], y[0], y[1], y[2], y[3]}; split8(v, Ah[s], Al[s]); }
#pragma unroll
    for (int t = 0; t < 2; ++t) { const int n = (nt0 + t) * 16 + m16; f32x4 acc = (f32x4){0.f, 0.f, 0.f, 0.f};
#pragma unroll
        for (int s = 0; s < 2; ++s) { float v[8];
#pragma unroll
            for (int jj = 0; jj < 8; ++jj) v[jj] = w[(32 * s + 8 * kg + jj) * 64 + n];
            pg8::bf16x8 Bh, Bl; split8(v, Bh, Bl); acc = mfma3(Ah[s], Al[s], Bh, Bl, acc); }
        const float bn = bias[n], fn = freq[n] * 0.15915494309f;
#pragma unroll
        for (int r = 0; r < 4; ++r) out[(16 * mt + 4 * kg + r) * 68 + n] = __builtin_amdgcn_sinf(fn * (acc[r] + bn)); }
}

__device__ __forceinline__ void phase0(const Args& a, LAS unsigned char* lds) {
    int tid = threadIdx.x; const int wg = blockIdx.x, G = gridDim.x;
    asm volatile("" : "+v"(tid));
    int lane = tid & 63, wave = tid >> 6;
    unsigned char* ws = a.ws;
    for (int it = wg; it < 192; it += G) {
        LAS float* sl = (LAS float*)lds;
        LAS float* red = (LAS float*)(lds + 20480);
        const int col = it * 32 + (lane & 31), kk = wave * 2 + (lane >> 5);
        float acc[5] = {0.f, 0.f, 0.f, 0.f, 0.f};
        const float* wp = a.in[4] + col;
        float wv[64];
#pragma unroll
        for (int j = 0; j < 64; ++j) wv[j] = wp[(size_t)(kk + 16 * j) * 6144];
        for (int i = tid; i < 5 * 1024; i += NTHR) { const int bb = i >> 10, k = i & 1023; const float v = (bb < 4) ? a.in[1][bb * 1024 + k] : a.in[3][k]; sl[i] = silu_f(v); }
        __syncthreads();
#pragma unroll
        for (int j = 0; j < 64; ++j) { const int k = kk + 16 * j;
#pragma unroll
            for (int bb = 0; bb < 5; ++bb) acc[bb] += sl[bb * 1024 + k] * wv[j]; }
#pragma unroll
        for (int bb = 0; bb < 5; ++bb) red[(kk * 5 + bb) * 32 + (lane & 31)] = acc[bb];
        __syncthreads();
        if (tid < 160) { const int bb = tid >> 5, cl = tid & 31; float s = 0.f;
#pragma unroll
            for (int q = 0; q < 16; ++q) s += red[(q * 5 + bb) * 32 + cl];
            ((float*)(ws + WS_MOD))[bb * 6144 + it * 32 + cl] = s + a.in[5][it * 32 + cl]; }
        __syncthreads();
    }
    for (int it = wg; it < 256; it += G) {
        asm volatile("" : "+v"(tid)); lane = tid & 63; wave = tid >> 6;
        const int cg = it >> 6, i0 = (it & 63) * 64, m16 = lane & 15, kg = lane >> 4;
        LAS float* zl = (LAS float*)lds;
        LAS float* h1 = (LAS float*)(lds + 17408);
        LAS float* h2 = (LAS float*)(lds + 2 * 17408);
        LAS float* w1l = (LAS float*)(lds + 3 * 17408);
        LAS float* w2l = (LAS float*)(lds + 3 * 17408 + 16384);
        float braw[4][2][8];
        {   const float* w3 = a.in[19] + cg * 512 + wave * 64 + m16;
#pragma unroll
            for (int nt = 0; nt < 4; ++nt)
#pragma unroll
                for (int s = 0; s < 2; ++s)
#pragma unroll
                    for (int jj = 0; jj < 8; ++jj) braw[nt][s][jj] = w3[(32 * s + 8 * kg + jj) * 2048 + nt * 16]; }
        {   float t1[8], t2[8];
#pragma unroll
            for (int q = 0; q < 8; ++q) { const int o = tid + NTHR * q; t1[q] = (o < 33 * 64) ? a.in[15][o] : 0.f; t2[q] = a.in[17][o]; }
#pragma unroll
            for (int q = 0; q < 8; ++q) { const int o = tid + NTHR * q; w1l[o] = t1[q]; w2l[o] = t2[q]; } }
#pragma unroll
        for (int q = 0; q < 8; ++q) { const int o = tid + NTHR * q, li = o >> 6, j = o & 63; const int i = i0 + li;
            const int jj = (j - 1) & 15; const float f = 1e-4f + (float)jj * ((15.0f - 1e-4f) / 15.0f); const float turns = f * ((float)i * (1.0f / 4096.0f));
            const float v = (j == 0) ? (float)i * (1.0f / 4095.0f) : (j <= 16) ? __builtin_amdgcn_cosf(turns) : (j <= 32) ? -__builtin_amdgcn_sinf(turns) : 0.f;
            zl[li * 68 + j] = v; }
        __syncthreads();
        sine_layer(zl, w1l, h1, a.in[16], a.in[20], wave, lane);
        __syncthreads();
        sine_layer(h1, w2l, h2, a.in[18], a.in[20], wave, lane);
        __syncthreads();
        {
            pg8::bf16x8 Bh[4][2], Bl[4][2];
#pragma unroll
            for (int nt = 0; nt < 4; ++nt)
#pragma unroll
                for (int s = 0; s < 2; ++s) split8(braw[nt][s], Bh[nt][s], Bl[nt][s]);
            float* hT = (float*)(ws + WS_HT);
#pragma unroll
            for (int mt = 0; mt < 4; ++mt) {
                pg8::bf16x8 Ah[2], Al[2];
#pragma unroll
                for (int s = 0; s < 2; ++s) { const LAS float* hp = h2 + (16 * mt + m16) * 68 + 32 * s + 8 * kg; const f32x4 x = *(const LAS f32x4*)hp, y = *(const LAS f32x4*)(hp + 4);
                    const float v[8] = {x[0], x[1], x[2], x[3], y[0], y[1], y[2], y[3]}; split8(v, Ah[s], Al[s]); }
#pragma unroll
                for (int nt = 0; nt < 4; ++nt) { f32x4 acc = (f32x4){0.f, 0.f, 0.f, 0.f};
#pragma unroll
                    for (int s = 0; s < 2; ++s) acc = mfma3(Ah[s], Al[s], Bh[nt][s], Bl[nt][s], acc);
                    const int c = wave * 64 + nt * 16 + m16;
                    const float delta = 3.0701134573f + (float)c * ((15.3505672866f - 3.0701134573f) / 511.0f);
                    f32x4 o;
#pragma unroll
                    for (int r = 0; r < 4; ++r) { const float ti = (float)(i0 + 16 * mt + 4 * kg + r) * (1.0f / 4095.0f); o[r] = acc[r] * __expf(-ti * delta); }
                    *(f32x4*)(hT + ((size_t)cg * 512 + c) * SEQ + i0 + 16 * mt + 4 * kg) = o; } } }
        __syncthreads();
    }
    {
        asm volatile("" : "+v"(tid)); lane = tid & 63; wave = tid >> 6;
        LAS float* scr = (LAS float*)(lds + wave * 8448);
        const int gw = wg * NWAVES + wave, NGW = G * NWAVES;
        constexpr int I_IN = 104 * 16, I_OUT = 32 * 16;
        for (int it = gw; it < I_IN + I_OUT; it += NGW) {
            if (it < I_IN) { const int nb = it >> 4, kb = it & 15, n0 = nb * 32;
                const int ns = (n0 < 1536) ? n0 : (n0 < 3072 ? n0 + 32 : 1536 + (n0 - 3072));
                transpose_item(a.in[7], DIN, kb * 64, (n0 < DIN) ? ns : 0, (bf16*)(ws + WS_WIN), DM, n0, scr, lane, n0 >= DIN);
            } else { const int r = it - I_IN, nb = r >> 4, kb = r & 15;
                transpose_item(a.in[22], DM, kb * 64, nb * 32, (bf16*)(ws + WS_WOUT), DM, nb * 32, scr, lane, false); }
        }
    }
    for (int e = wg * NTHR + tid; e < 64 * 256; e += G * NTHR) { const int i = e >> 8, j = e & 255;
        const float om = 1.0f / powf(10000.0f, (float)j * (1.0f / 256.0f)); const float er = (float)i * om;
        float* pt = (float*)(ws + WS_POS); pt[i * 512 + j] = sinf(er); pt[i * 512 + 256 + j] = cosf(er); }
}

__device__ __forceinline__ void phase1(const Args& a, LAS unsigned char* lds) {
    const int tid = threadIdx.x, lane = tid & 63, wave = tid >> 6, wg = blockIdx.x, G = gridDim.x;
    unsigned char* ws = a.ws;
    const float* modr = (const float*)(ws + WS_MOD); const float* pt = (const float*)(ws + WS_POS); bf16* ain = (bf16*)(ws + WS_AIN);
    const float* gmix = a.in[6];
    const int NGW = G * NWAVES;
    f32x4 gv[4];
#pragma unroll
    for (int j = 0; j < 4; ++j) gv[j] = *(const f32x4*)(gmix + 4 * lane + 256 * j);
#pragma nounroll
    for (int r0 = wg * NWAVES + wave; r0 < MT; r0 += 4 * NGW) {
        f32x4 v[4][4];
#pragma unroll
        for (int k = 0; k < 4; ++k) { const int r = r0 + k * NGW;
            if (r < MT) { const bool lat = r < MX; const float* src = lat ? a.in[0] + (size_t)r * DM : a.in[2] + (size_t)(r - MX) * DM; const int t = r & 4095, rr = t >> 6, cc = t & 63;
#pragma unroll
                for (int j = 0; j < 4; ++j) { const int col = 4 * lane + 256 * j; v[k][j] = *(const f32x4*)(src + col);
                    const f32x4 pv = *(const f32x4*)(pt + ((j < 2) ? rr * 512 + col : cc * 512 + col - 512));
                    v[k][j] += pv * (lat ? 1.0f : 0.0f); } } }
#pragma unroll
        for (int k = 0; k < 4; ++k) { const int r = r0 + k * NGW;
            if (r < MT) { const int bb = (r < MX) ? (r >> 12) : 4; float ss = 0.f;
                f32x4 shv[4], scv[4];
#pragma unroll
                for (int j = 0; j < 4; ++j) { const int col = 4 * lane + 256 * j; shv[j] = *(const f32x4*)(modr + bb * 6144 + col); scv[j] = *(const f32x4*)(modr + bb * 6144 + 1024 + col); }
#pragma unroll
                for (int j = 0; j < 4; ++j) ss += v[k][j][0] * v[k][j][0] + v[k][j][1] * v[k][j][1] + v[k][j][2] * v[k][j][2] + v[k][j][3] * v[k][j][3];
                const float rs = rsqrtf(wave_sum(ss) * (1.0f / DM) + EPS);
#pragma unroll
                for (int j = 0; j < 4; ++j) { const int col = 4 * lane + 256 * j;
                    const f32x4 sh = shv[j], sc = scv[j];
                    const f32x4 y = (v[k][j] * rs * gv[j]) * (sc + 1.0f) + sh;
                    v2u w; w.x = pk2(y[0], y[1]); w.y = pk2(y[2], y[3]);
                    *(v2u*)(ain + (size_t)r * DM + col) = w; } } }
    }
}

typedef float cpx __attribute__((ext_vector_type(2)));
__device__ __forceinline__ cpx make_cpx(float x, float y) { cpx r; r.x = x; r.y = y; return r; }
__device__ __forceinline__ cpx cmul(cpx a, cpx b) { cpx t, r;
    asm("v_pk_mul_f32 %0, %1, %2 op_sel_hi:[1,0]" : "=v"(t) : "v"(a), "v"(b));
    asm("v_pk_fma_f32 %0, %1, %2, %3 op_sel:[1,1,0] op_sel_hi:[0,1,1] neg_lo:[1,0,0]" : "=v"(r) : "v"(a), "v"(b), "v"(t));
    return r; }
__device__ __forceinline__ cpx cmul_s(cpx a, cpx b) { cpx t, r;
    asm("v_pk_mul_f32 %0, %1, %2 op_sel_hi:[1,0]" : "=v"(t) : "v"(a), "s"(b));
    asm("v_pk_fma_f32 %0, %1, %2, %3 op_sel:[1,1,0] op_sel_hi:[0,1,1] neg_lo:[1,0,0]" : "=v"(r) : "v"(a), "s"(b), "v"(t));
    return r; }
__device__ __forceinline__ cpx cmulc(cpx a, cpx b) { cpx t, r;
    asm("v_pk_mul_f32 %0, %1, %2 op_sel_hi:[1,0] neg_hi:[1,0]" : "=v"(t) : "v"(a), "v"(b));
    asm("v_pk_fma_f32 %0, %1, %2, %3 op_sel:[1,1,0] op_sel_hi:[0,1,1] neg_lo:[1,0,0] neg_hi:[1,0,0]" : "=v"(r) : "v"(a), "v"(b), "v"(t));
    return r; }
__device__ __forceinline__ cpx cfma(cpx a, cpx b, cpx c) { cpx t, r;
    asm("v_pk_fma_f32 %0, %1, %2, %3 op_sel_hi:[1,0,1]" : "=v"(t) : "v"(a), "v"(b), "v"(c));
    asm("v_pk_fma_f32 %0, %1, %2, %3 op_sel:[1,1,0] op_sel_hi:[0,1,1] neg_lo:[1,0,0]" : "=v"(r) : "v"(a), "v"(b), "v"(t));
    return r; }
__device__ __forceinline__ cpx cadd(cpx a, cpx b) { return a + b; }
__device__ __forceinline__ cpx csub(cpx a, cpx b) { return a - b; }
__device__ __forceinline__ cpx add_mi(cpx a, cpx b) { cpx r; asm("v_pk_add_f32 %0, %1, %2 op_sel:[0,1] op_sel_hi:[1,0] neg_hi:[0,1]" : "=v"(r) : "v"(a), "v"(b)); return r; }
__device__ __forceinline__ cpx add_pi(cpx a, cpx b) { cpx r; asm("v_pk_add_f32 %0, %1, %2 op_sel:[0,1] op_sel_hi:[1,0] neg_lo:[0,1]" : "=v"(r) : "v"(a), "v"(b)); return r; }
__device__ __forceinline__ cpx cconj(cpx a) { return make_cpx(a.x, -a.y); }
__device__ __forceinline__ cpx twid(float turns) { return make_cpx(__builtin_amdgcn_cosf(turns), -__builtin_amdgcn_sinf(turns)); }
__device__ __forceinline__ void dft4(cpx& a0, cpx& a1, cpx& a2, cpx& a3) {
    const cpx t0 = cadd(a0, a2), t1 = csub(a0, a2), t2 = cadd(a1, a3), t3 = csub(a1, a3);
    a0 = cadd(t0, t2); a2 = csub(t0, t2); a1 = add_mi(t1, t3); a3 = add_pi(t1, t3);
}
__device__ __forceinline__ void dft4_r2(cpx& a0, cpx& a1, cpx& a2, cpx& a3) {
    const cpx t0 = add_mi(a0, a2), t1 = add_pi(a0, a2), t2 = cadd(a1, a3), t3 = csub(a1, a3);
    a0 = cadd(t0, t2); a2 = csub(t0, t2); a1 = add_mi(t1, t3); a3 = add_pi(t1, t3);
}
__device__ __forceinline__ void dft16(cpx (&v)[16]) {
    cpx t[16];
#pragma unroll
    for (int j = 0; j < 4; ++j) { cpx b0 = v[j], b1 = v[j + 4], b2 = v[j + 8], b3 = v[j + 12]; dft4(b0, b1, b2, b3); t[4 * j] = b0; t[4 * j + 1] = b1; t[4 * j + 2] = b2; t[4 * j + 3] = b3; }
    const float C1 = 0.92387953251f, S1 = 0.38268343236f, R2 = 0.70710678118f;
    const cpx W1 = make_cpx(C1, -S1), W2 = make_cpx(R2, -R2), W3 = make_cpx(S1, -C1), W6 = make_cpx(-R2, -R2), W9 = make_cpx(-C1, S1);
    {   cpx b0 = t[0], b1 = t[4], b2 = t[8], b3 = t[12]; dft4(b0, b1, b2, b3); v[0] = b0; v[4] = b1; v[8] = b2; v[12] = b3; }
    {   cpx b0 = t[1], b1 = cmul_s(t[5], W1), b2 = cmul_s(t[9], W2), b3 = cmul_s(t[13], W3); dft4(b0, b1, b2, b3); v[1] = b0; v[5] = b1; v[9] = b2; v[13] = b3; }
    {   cpx b0 = t[2], b1 = cmul_s(t[6], W2), b2 = t[10], b3 = cmul_s(t[14], W6); dft4_r2(b0, b1, b2, b3); v[2] = b0; v[6] = b1; v[10] = b2; v[14] = b3; }
    {   cpx b0 = t[3], b1 = cmul_s(t[7], W3), b2 = cmul_s(t[11], W6), b3 = cmul_s(t[15], W9); dft4(b0, b1, b2, b3); v[3] = b0; v[7] = b1; v[11] = b2; v[15] = b3; }
}
#define FPAD(i) ((i) + ((i) >> 4))
constexpr int FFT_STRIDE = 4352;
__device__ __forceinline__ void apply_tw(cpx (&v)[16], cpx w1) {
    asm volatile("" : "+v"(w1.x), "+v"(w1.y));
    cpx w = w1; v[1] = cmul(v[1], w);
#pragma unroll
    for (int q = 2; q < 16; ++q) { w = cmul(w, w1); v[q] = cmul(v[q], w); }
}
__device__ __forceinline__ cpx opaque(cpx w) { asm volatile("" : "+v"(w.x), "+v"(w.y)); return w; }
__device__ __forceinline__ cpx c32(int r) { return make_cpx(__builtin_cosf(0.19634954084936207f * (float)r), -__builtin_sinf(0.19634954084936207f * (float)r)); }

#define HB(x) __uint_as_float(((unsigned)(x)) << 16)
__device__ __forceinline__ void hyena_item(const Args& a, LAS unsigned char* lds, int c, int stage) {
    int tid = threadIdx.x; asm volatile("" : "+v"(tid));
    const int f = tid >> 8, j = tid & 255, blk = j >> 4, jp = j & 15;
    unsigned char* ws = a.ws;
    LAS cpx* buf = (LAS cpx*)lds;
    LAS cpx* bm = buf + f * FFT_STRIDE;
    const int pj = j + blk, p16 = blk * 272 + jp, pc = 17 * j;
    const float* hT = (const float*)(ws + WS_HT);
    const float* hf = hT + ((size_t)(stage * 2 + 0) * 512 + c) * SEQ;
    const float* hb = hT + ((size_t)(stage * 2 + 1) * 512 + c) * SEQ;
    const bf16* hyT = (const bf16*)(ws + WS_HYT);
    const bf16* zT = (const bf16*)(ws + WS_ZT);
    bf16* outp = (bf16*)(ws + WS_HYT);
    const float* cw = a.in[13]; const float* cb = a.in[14];
    const int chu = c, chg = (stage == 0 ? 512 : 1024) + c;
    const float wu0 = cw[chu], wu1 = cw[1536 + chu], wu2 = cw[3072 + chu], bu = cb[chu];
    const float wg0 = cw[chg], wg1 = cw[1536 + chg], wg2 = cw[3072 + chg], bg = cb[chg];
    const float bias = a.in[21][stage * 512 + c];
    const cpx wj = twid((float)j * (1.0f / 4096.0f)), wjp = twid((float)jp * (1.0f / 256.0f)), w8_ = twid((float)j * (1.0f / 8192.0f));
    cpx v[16];
    LAS cpx* Hs = buf + 2 * FFT_STRIDE + f * FFT_STRIDE + pc;
    { const cpx w8 = opaque(w8_);
    float fraw[16], graw[16];
#pragma unroll
    for (int r = 0; r < 16; ++r) { const unsigned n = (unsigned)j + 256u * r; fraw[r] = hf[n]; graw[r] = hb[(SEQ - n) & 4095u]; }
    asm volatile("" : "+v"(fraw[0]), "+v"(fraw[1]), "+v"(fraw[2]), "+v"(fraw[3]), "+v"(fraw[4]), "+v"(fraw[5]), "+v"(fraw[6]), "+v"(fraw[7]), "+v"(fraw[8]), "+v"(fraw[9]), "+v"(fraw[10]), "+v"(fraw[11]), "+v"(fraw[12]), "+v"(fraw[13]), "+v"(fraw[14]), "+v"(fraw[15]));
    asm volatile("" : "+v"(graw[0]), "+v"(graw[1]), "+v"(graw[2]), "+v"(graw[3]), "+v"(graw[4]), "+v"(graw[5]), "+v"(graw[6]), "+v"(graw[7]), "+v"(graw[8]), "+v"(graw[9]), "+v"(graw[10]), "+v"(graw[11]), "+v"(graw[12]), "+v"(graw[13]), "+v"(graw[14]), "+v"(graw[15]));
#pragma unroll
    for (int r = 0; r < 16; ++r) { const unsigned n = (unsigned)j + 256u * r; const float fv = fraw[r]; const float gv = n ? graw[r] : 0.f;
        const cpx wn = cmul_s(w8, c32(r)); const float d = fv - gv;
        v[r] = f ? make_cpx(d * wn.x, d * wn.y) : make_cpx(fv + gv, 0.f); } }
    dft16(v); apply_tw(v, wj);
#pragma unroll
    for (int q = 0; q < 16; ++q) bm[pj + 272 * q] = v[q];
    __syncthreads();
#pragma unroll
    for (int r = 0; r < 16; ++r) v[r] = bm[p16 + 17 * r];
    dft16(v); apply_tw(v, wjp);
#pragma unroll
    for (int q = 0; q < 16; ++q) bm[p16 + 17 * q] = v[q];
    __syncthreads();
#pragma unroll
    for (int r = 0; r < 16; ++r) v[r] = bm[pc + r];
    dft16(v);
#pragma unroll
    for (int q = 0; q < 16; ++q) Hs[q] = v[q];
    __syncthreads();
#pragma nounroll
    for (int bp = 0; bp < 2; ++bp) {
        const int b0 = 2 * bp, b1 = 2 * bp + 1;
        float uk0[8], uk1[8];
        {   float u0[16], u1[16];
            const unsigned uj = (unsigned)j;
            if (stage == 0) {
                const bf16* P0 = hyT + ((size_t)b0 * 1536 + chu) * SEQ; const bf16* P1 = hyT + ((size_t)b1 * 1536 + chu) * SEQ;
#pragma unroll
                for (int r = 0; r < 16; ++r) { const unsigned o = uj + 256u * r; if (r == 4 || r == 8 || r == 12) asm volatile("" ::: "memory");
                    const unsigned ol = (r == 0) ? (j ? uj - 1u : 0u) : o - 1u, orr = (r == 15) ? (j < 255 ? o + 1u : o) : o + 1u;
                    float l0 = HB(P0[ol]), l1 = HB(P1[ol]), r0 = HB(P0[orr]), r1 = HB(P1[orr]);
                    if (r == 0) { l0 = j ? l0 : 0.f; l1 = j ? l1 : 0.f; }
                    if (r == 15) { r0 = (j < 255) ? r0 : 0.f; r1 = (j < 255) ? r1 : 0.f; }
                    u0[r] = wu0 * l0 + wu1 * HB(P0[o]) + wu2 * r0 + bu; u1[r] = wu0 * l1 + wu1 * HB(P1[o]) + wu2 * r1 + bu; }
            } else {
                const bf16* P0 = zT + ((size_t)b0 * 512 + c) * SEQ; const bf16* P1 = zT + ((size_t)b1 * 512 + c) * SEQ;
                unsigned short z0[16], z1[16];
#pragma unroll
                for (int r = 0; r < 16; ++r) { const unsigned o = uj + 256u * r; z0[r] = P0[o]; z1[r] = P1[o]; }
                asm volatile("" :: "v"(z0[0]), "v"(z0[1]), "v"(z0[2]), "v"(z0[3]), "v"(z0[4]), "v"(z0[5]), "v"(z0[6]), "v"(z0[7]), "v"(z0[8]), "v"(z0[9]), "v"(z0[10]), "v"(z0[11]), "v"(z0[12]), "v"(z0[13]), "v"(z0[14]), "v"(z0[15]));
                asm volatile("" :: "v"(z1[0]), "v"(z1[1]), "v"(z1[2]), "v"(z1[3]), "v"(z1[4]), "v"(z1[5]), "v"(z1[6]), "v"(z1[7]), "v"(z1[8]), "v"(z1[9]), "v"(z1[10]), "v"(z1[11]), "v"(z1[12]), "v"(z1[13]), "v"(z1[14]), "v"(z1[15]));
#pragma unroll
                for (int r = 0; r < 16; ++r) { u0[r] = HB(z0[r]); u1[r] = HB(z1[r]); }
            }
#pragma unroll
            for (int i = 0; i < 8; ++i) { uk0[i] = f ? u0[2 * i + 1] : u0[2 * i]; uk1[i] = f ? u1[2 * i + 1] : u1[2 * i]; }
            const cpx w8 = opaque(w8_);
#pragma unroll
            for (int r = 0; r < 16; ++r) { const cpx x = make_cpx(u0[r], u1[r]); v[r] = f ? cmul(x, cmul_s(w8, c32(r))) : x; }
        }
        dft16(v); apply_tw(v, wj);
#pragma unroll
        for (int q = 0; q < 16; ++q) bm[pj + 272 * q] = v[q];
        __syncthreads();
#pragma unroll
        for (int r = 0; r < 16; ++r) v[r] = bm[p16 + 17 * r];
        dft16(v); apply_tw(v, wjp);
#pragma unroll
        for (int q = 0; q < 16; ++q) bm[p16 + 17 * q] = v[q];
        __syncthreads();
#pragma unroll
        for (int r = 0; r < 16; ++r) v[r] = bm[pc + r];
        dft16(v);
#pragma unroll
        for (int q = 0; q < 16; ++q) v[q] = cmulc(v[q], Hs[q]);
        dft16(v);
#pragma unroll
        for (int q = 0; q < 16; ++q) bm[pc + q] = v[q];
        __syncthreads();
#pragma unroll
        for (int r = 0; r < 16; ++r) v[r] = bm[p16 + 17 * r];
        apply_tw(v, wjp); dft16(v);
#pragma unroll
        for (int q = 0; q < 16; ++q) bm[p16 + 17 * q] = v[q];
        __syncthreads();
        float gg0[8], gg1[8];
        {   unsigned short rg0[8][3], rg1[8][3];
            const bf16* G0 = hyT + ((size_t)b0 * 1536 + chg) * SEQ; const bf16* G1 = hyT + ((size_t)b1 * 1536 + chg) * SEQ;
            const unsigned gj = (unsigned)(j + 256 * f);
#pragma unroll
            for (int i = 0; i < 8; ++i) { const unsigned o = gj + 512u * i;
                const unsigned ol = (i == 0) ? (gj ? gj - 1u : 0u) : o - 1u, orr = (i == 7) ? (o < 4095u ? o + 1u : o) : o + 1u;
                rg0[i][0] = G0[ol]; rg0[i][1] = G0[o]; rg0[i][2] = G0[orr]; rg1[i][0] = G1[ol]; rg1[i][1] = G1[o]; rg1[i][2] = G1[orr]; }
#pragma unroll
            for (int r = 0; r < 16; ++r) v[r] = bm[pj + 272 * r];
            apply_tw(v, wj); dft16(v);
#pragma unroll
            for (int q = 0; q < 16; ++q) bm[pj + 272 * q] = v[q];
#pragma unroll
            for (int i = 0; i < 8; ++i) asm volatile("" :: "v"(rg0[i][0]), "v"(rg0[i][1]), "v"(rg0[i][2]), "v"(rg1[i][0]), "v"(rg1[i][1]), "v"(rg1[i][2]));
#pragma unroll
            for (int i = 0; i < 8; ++i) { const unsigned o = gj + 512u * i;
                float a0 = HB(rg0[i][0]), a1 = HB(rg0[i][1]), a2 = HB(rg0[i][2]), c0 = HB(rg1[i][0]), c1 = HB(rg1[i][1]), c2 = HB(rg1[i][2]);
                if (i == 0) { a0 = gj ? a0 : 0.f; c0 = gj ? c0 : 0.f; }
                if (i == 7) { a2 = (o < 4095u) ? a2 : 0.f; c2 = (o < 4095u) ? c2 : 0.f; }
                gg0[i] = wg0 * a0 + wg1 * a1 + wg2 * a2 + bg; gg1[i] = wg0 * c0 + wg1 * c1 + wg2 * c2 + bg; } }
        __syncthreads();
        const cpx w8f = cmul(opaque(w8_), f ? c32(1) : c32(0));
        bf16* O0 = outp + ((size_t)b0 * 1536 + c) * SEQ; bf16* O1 = outp + ((size_t)b1 * 1536 + c) * SEQ;
        bf16* Z0 = (bf16*)(ws + WS_ZT) + ((size_t)b0 * 512 + c) * SEQ; bf16* Z1 = (bf16*)(ws + WS_ZT) + ((size_t)b1 * 512 + c) * SEQ;
#pragma unroll
        for (int i = 0; i < 8; ++i) { const int rr = f + 2 * i; const unsigned n = (unsigned)(j + 256 * f) + 512u * i;
            const cpx be = buf[pj + 272 * rr], bo = buf[FFT_STRIDE + pj + 272 * rr];
            const cpx wn = cmul_s(w8f, c32(2 * i));
            const cpx z = cfma(bo, wn, be);
            const float y0 = z.x * (1.0f / 8192.0f) + bias * uk0[i], y1 = bias * uk1[i] - z.y * (1.0f / 8192.0f);
                        if (stage == 0) { Z0[n] = (bf16)f2bf(gg0[i] * y0); Z1[n] = (bf16)f2bf(gg1[i] * y1); } else { O0[n] = (bf16)f2bf(gg0[i] * y0); O1[n] = (bf16)f2bf(gg1[i] * y1); } }
        __syncthreads();
    }
}

__device__ __forceinline__ f32x16 mfma32(bf16x8 a, bf16x8 b, f32x16 c) { return __builtin_amdgcn_mfma_f32_32x32x16_bf16(a, b, c, 0, 0, 0); }
typedef short s4v __attribute__((ext_vector_type(4)));
__device__ __forceinline__ bf16x8 tr_frag(const LAS bf16* base, int PT, int k0, int c0, int lane) {
    const int i = lane & 15, q = i >> 2, p = i & 3;
    const LAS bf16* ad = base + (k0 + 8 * (lane >> 5) + q) * PT + c0 + 16 * ((lane >> 4) & 1) + 4 * p;
    const s4v lo = __builtin_amdgcn_ds_read_tr16_b64_v4i16((LAS s4v*)ad);
    const s4v hi = __builtin_amdgcn_ds_read_tr16_b64_v4i16((LAS s4v*)(ad + 4 * PT));
    bf16x8 r; r[0] = lo[0]; r[1] = lo[1]; r[2] = lo[2]; r[3] = lo[3]; r[4] = hi[0]; r[5] = hi[1]; r[6] = hi[2]; r[7] = hi[3]; return r;
}
constexpr int GL_AL = 0, GL_WA = 8192, GL_TOT = 16384, GL_V = 24576, GL_VP = 160;
struct GlaTab { float P[4][2], X[4][2], Ptot[2], Xtot[2], Pref[2], Xref[2]; };
__device__ __forceinline__ void gla_tables(const Args& a, int h, LAS unsigned char* lds, GlaTab& T, int tid) {
    const int d2 = tid & 31, sg = tid >> 5;
    const LAS float* aL = (const LAS float*)(lds + GL_AL); const LAS float* wa = (const LAS float*)(lds + GL_WA); LAS float* tot = (LAS float*)(lds + GL_TOT);
    typedef float f32x2v __attribute__((ext_vector_type(2)));
    const f32x2v bf = *(const f32x2v*)(a.in[9] + h * 64 + 2 * d2), bb = *(const f32x2v*)(a.in[11] + h * 64 + 2 * d2);
    float lf[4][2], lb[4][2];
#pragma unroll
    for (int q = 0; q < 4; ++q) { const int s = sg * 4 + q; float pf0 = bf[0], pf1 = bf[1], pb0 = bb[0], pb1 = bb[1];
#pragma unroll
        for (int j4 = 0; j4 < 4; ++j4) { const f32x4 af = *(const LAS f32x4*)(aL + s * 32 + 4 * j4), ab = *(const LAS f32x4*)(aL + s * 32 + 16 + 4 * j4);
#pragma unroll
            for (int jj = 0; jj < 4; ++jj) { const int j = 4 * j4 + jj; const f32x2v wf = *(const LAS f32x2v*)(wa + j * 64 + 2 * d2), wb = *(const LAS f32x2v*)(wa + 1024 + j * 64 + 2 * d2);
                pf0 += af[jj] * wf[0]; pf1 += af[jj] * wf[1]; pb0 += ab[jj] * wb[0]; pb1 += ab[jj] * wb[1]; } }
        lf[q][0] = logsig_f(pf0) * (1.0f / 16.0f); lf[q][1] = logsig_f(pf1) * (1.0f / 16.0f); lb[q][0] = logsig_f(pb0) * (1.0f / 16.0f); lb[q][1] = logsig_f(pb1) * (1.0f / 16.0f); }
#pragma unroll
    for (int i = 0; i < 2; ++i) { lf[1][i] += lf[0][i]; lf[2][i] += lf[1][i]; lf[3][i] += lf[2][i]; lb[2][i] += lb[3][i]; lb[1][i] += lb[2][i]; lb[0][i] += lb[1][i]; }
    *(LAS f32x2v*)(tot + sg * 64 + 2 * d2) = (f32x2v){lf[3][0], lf[3][1]};
    *(LAS f32x2v*)(tot + 1024 + sg * 64 + 2 * d2) = (f32x2v){lb[0][0], lb[0][1]};
    __syncthreads();
    float of[2] = {0.f, 0.f}, ob[2] = {0.f, 0.f};
    T.Ptot[0] = T.Ptot[1] = T.Xtot[0] = T.Xtot[1] = T.Pref[0] = T.Pref[1] = T.Xref[0] = T.Xref[1] = 0.f;
#pragma unroll
    for (int g = 0; g < 16; ++g) { const f32x2v tf = *(const LAS f32x2v*)(tot + g * 64 + 2 * d2), tb = *(const LAS f32x2v*)(tot + 1024 + g * 64 + 2 * d2);
#pragma unroll
        for (int i = 0; i < 2; ++i) { T.Ptot[i] += tf[i]; T.Xtot[i] += tb[i]; if (g < 8) T.Pref[i] += tf[i]; else T.Xref[i] += tb[i];
            of[i] += (g < sg) ? tf[i] : 0.f; ob[i] += (g > sg) ? tb[i] : 0.f; } }
#pragma unroll
    for (int q = 0; q < 4; ++q)
#pragma unroll
        for (int i = 0; i < 2; ++i) { T.P[q][i] = lf[q][i] + of[i]; T.X[q][i] = lb[q][i] + ob[i]; }
}
struct GlaIn { f32x4 av, wv; unsigned kw[4], qw[4]; };
template <bool OUT>
__device__ __forceinline__ void gla_load(const Args& a, int tid, int bh, int ci, GlaIn& I) {
    const int b = bh >> 2, h = bh & 3, d2 = tid & 31, sg = tid >> 5;
    const size_t rowbase = OUT ? (size_t)b * SEQ + ci * 64 : ((ci < 4) ? (size_t)(MX + b * CTXL + ci * 64) : (size_t)(b * SEQ + (ci - 4) * 64));
    const float* afb = (const float*)(a.ws + WS_AFB); const bf16* qkvg = (const bf16*)(a.ws + WS_QKVG);
    I.av = *(const f32x4*)(afb + (rowbase + (tid >> 3)) * 32 + 4 * (tid & 7));
    const int wdir = tid >> 8, wj = (tid >> 4) & 15, wd4 = (tid & 15) * 4;
    I.wv = *(const f32x4*)((wdir ? a.in[10] : a.in[8]) + wj * 256 + h * 64 + wd4);
#pragma unroll
    for (int q = 0; q < 4; ++q) { const bf16* rp = qkvg + (rowbase + sg * 4 + q) * NQ + h * 64 + 2 * d2; I.kw[q] = *(const unsigned*)(rp + 256); if (OUT) I.qw[q] = *(const unsigned*)rp; }
}
__device__ __forceinline__ void gla_stage_common(const GlaIn& I, LAS unsigned char* lds, int tid) {
    const int wdir = tid >> 8, wj = (tid >> 4) & 15, wd4 = (tid & 15) * 4;
    *(LAS f32x4*)((LAS float*)(lds + GL_AL) + 4 * tid) = I.av;
    *(LAS f32x4*)((LAS float*)(lds + GL_WA) + wdir * 1024 + wj * 64 + wd4) = I.wv;
}

template <bool HASN>
__device__ __forceinline__ void gla_upd_item(const Args& a, LAS unsigned char* lds, int bh, int ci, const GlaIn& I, int nbh, int nci, GlaIn& N) {
    int tid = threadIdx.x; asm volatile("" : "+v"(tid));
    const int lane = tid & 63, wave = tid >> 6, h = bh & 3, d2 = tid & 31, sg = tid >> 5;
    unsigned char* ws = a.ws;
    constexpr int KP = 96;
    LAS bf16* vN = (LAS bf16*)(lds + GL_V); LAS bf16* kUf = (LAS bf16*)(lds + 45056); LAS bf16* kUb = (LAS bf16*)(lds + 57344);
    unsigned kw[4];
#pragma unroll
    for (int q = 0; q < 4; ++q) kw[q] = I.kw[q];
    v4u vv[2];
    { const int b = bh >> 2; const size_t rowbase = (ci < 4) ? (size_t)(MX + b * CTXL + ci * 64) : (size_t)(b * SEQ + (ci - 4) * 64); const bf16* qkvg = (const bf16*)(ws + WS_QKVG);
#pragma unroll
        for (int q = 0; q < 2; ++q) { const int idx = tid + NTHR * q; vv[q] = *(const v4u*)(qkvg + (rowbase + (idx >> 4)) * NQ + 512 + h * 128 + (idx & 15) * 8); } }
    gla_stage_common(I, lds, tid);
    __syncthreads();
    if (HASN) gla_load<false>(a, tid, nbh, nci, N);
    GlaTab T; gla_tables(a, h, lds, T, tid);
#pragma unroll
    for (int q = 0; q < 4; ++q) { const int s = sg * 4 + q; const float k0 = bflo(kw[q]), k1 = bfhi(kw[q]);
        *(LAS unsigned*)(kUf + s * KP + 2 * d2) = pk2(k0 * __expf(T.Ptot[0] - T.P[q][0]), k1 * __expf(T.Ptot[1] - T.P[q][1]));
        *(LAS unsigned*)(kUb + s * KP + 2 * d2) = pk2(k0 * __expf(T.Xtot[0] - T.X[q][0]), k1 * __expf(T.Xtot[1] - T.X[q][1])); }
#pragma unroll
    for (int q = 0; q < 2; ++q) { const int idx = tid + NTHR * q; *(LAS v4u*)(vN + (idx >> 4) * GL_VP + (idx & 15) * 8) = vv[q]; }
    if (tid < 32) { float* dec = (float*)(ws + WS_DEC);
#pragma unroll
        for (int i = 0; i < 2; ++i) { dec[((size_t)(bh * 2 + 0) * NCH + ci) * 64 + 2 * d2 + i] = __expf(T.Ptot[i]); dec[((size_t)(bh * 2 + 1) * NCH + ci) * 64 + 2 * d2 + i] = __expf(T.Xtot[i]); } }
    __syncthreads();
    { const int dir = wave >> 2, e0 = (wave & 3) * 32, l31 = lane & 31, hh = lane >> 5;
        const LAS bf16* kT = dir ? kUb : kUf;
        float* U = (ci < 4) ? (float*)(ws + WS_UCTX) + ((size_t)(bh * 2 + dir) * 4 + ci) * 8192 : a.out + ((size_t)(bh * 2 + dir) * 64 + (ci - 4)) * 8192;
        bf16x8 A[4];
#pragma unroll
        for (int ks = 0; ks < 4; ++ks) A[ks] = tr_frag(vN, GL_VP, 16 * ks, e0, lane);
#pragma unroll
        for (int dt = 0; dt < 2; ++dt) { const int d0 = dt * 32; f32x16 acc;
#pragma unroll
            for (int i = 0; i < 16; ++i) acc[i] = 0.f;
#pragma unroll
            for (int ks = 0; ks < 4; ++ks) acc = mfma32(A[ks], tr_frag(kT, KP, 16 * ks, d0, lane), acc);
#pragma unroll
            for (int r = 0; r < 16; ++r) { const int e = e0 + (r & 3) + 8 * (r >> 2) + 4 * hh; U[e * 64 + d0 + l31] = acc[r]; } } }
    __syncthreads();
}

__device__ __forceinline__ void gla_scan_item(const Args& a, int it) {
    int tid = threadIdx.x; asm volatile("" : "+v"(tid));
    const int bd = it >> 4, dir = bd & 1, el = ((it & 15) * 8 + (tid >> 6)) * 64 + (tid & 63), d = tid & 63;
    unsigned char* ws = a.ws;
    const float* dec = (const float*)(ws + WS_DEC) + (size_t)bd * NCH * 64 + d;
    const float* Uc = (const float*)(ws + WS_UCTX) + (size_t)bd * 4 * 8192 + el;
    const float* U = a.out + (size_t)bd * 64 * 8192 + el;
    bf16* Sp = (bf16*)(ws + WS_SPREV) + (size_t)bd * 64 * 8192 + el;
    float S = 0.f;
#pragma unroll
    for (int c4 = 0; c4 < 4; ++c4) { const int ci = dir ? 3 - c4 : c4; S = dec[ci * 64] * S + Uc[(size_t)ci * 8192]; }
#pragma unroll
    for (int blk = 0; blk < 2; ++blk) { float uu[32], dd[32];
#pragma unroll
        for (int j = 0; j < 32; ++j) { const int n = dir ? 63 - (blk * 32 + j) : blk * 32 + j; uu[j] = U[(size_t)n * 8192]; dd[j] = dec[(4 + n) * 64]; }
#pragma unroll
        for (int j = 0; j < 32; ++j) { const int n = dir ? 63 - (blk * 32 + j) : blk * 32 + j; Sp[(size_t)n * 8192] = (bf16)f2bf(S); S = dd[j] * S + uu[j]; } }
}

template <bool HASN>
__device__ __forceinline__ void gla_out_item(const Args& a, LAS unsigned char* lds, int bh, int n, const GlaIn& I, int nbh, int nn, GlaIn& N) {
    int tid = threadIdx.x; asm volatile("" : "+v"(tid));
    const int lane = tid & 63, wave = tid >> 6, b = bh >> 2, h = bh & 3, l31 = lane & 31, hh = lane >> 5, d2 = tid & 31, sg = tid >> 5;
    unsigned char* ws = a.ws;
    LAS bf16* Scat = (LAS bf16*)lds;
    LAS bf16* vN = (LAS bf16*)(lds + GL_V);
    LAS bf16* qf = (LAS bf16*)(lds + 45056); LAS bf16* qb = qf + 4608; LAS bf16* kf = qf + 2 * 4608; LAS bf16* kb = qf + 3 * 4608;
    LAS float* oS = (LAS float*)(lds + 45056);
    LAS bf16* qS = (LAS bf16*)(lds + 81920);
    LAS bf16* Sp = (LAS bf16*)(lds + 99328);
    const size_t rowbase = (size_t)b * SEQ + n * 64;
    unsigned qw[4], kw[4];
#pragma unroll
    for (int q = 0; q < 4; ++q) { qw[q] = I.qw[q]; kw[q] = I.kw[q]; }
    v4u vv[2], sv[4], g0, g1;
    { const bf16* qkvg = (const bf16*)(ws + WS_QKVG);
        { const bf16* gp = qkvg + (rowbase + (tid >> 3)) * NQ + 1024 + h * 128 + (tid & 7) * 16; g0 = *(const v4u*)gp; g1 = *(const v4u*)(gp + 8); }
#pragma unroll
        for (int q = 0; q < 2; ++q) { const int idx = tid + NTHR * q; vv[q] = *(const v4u*)(qkvg + (rowbase + (idx >> 4)) * NQ + 512 + h * 128 + (idx & 15) * 8); }
        const bf16* spf = (const bf16*)(ws + WS_SPREV) + ((size_t)(bh * 2 + 0) * 64 + n) * 8192; const bf16* spb = (const bf16*)(ws + WS_SPREV) + ((size_t)(bh * 2 + 1) * 64 + n) * 8192;
#pragma unroll
        for (int q = 0; q < 4; ++q) { const int idx = tid + NTHR * q, dir = idx >> 10, e = (idx >> 3) & 127, d8 = (idx & 7) * 8; sv[q] = *(const v4u*)((dir ? spb : spf) + e * 64 + d8); } }
    gla_stage_common(I, lds, tid);
    __syncthreads();
    if (HASN) gla_load<true>(a, tid, nbh, nn, N);
    GlaTab T; gla_tables(a, h, lds, T, tid);
#pragma unroll
    for (int q = 0; q < 4; ++q) { const int s = sg * 4 + q; const float q0 = bflo(qw[q]), q1 = bfhi(qw[q]), k0 = bflo(kw[q]), k1 = bfhi(kw[q]);
        *(LAS unsigned*)(qf + s * 72 + 2 * d2) = pk2(q0 * __expf(T.P[q][0] - T.Pref[0]), q1 * __expf(T.P[q][1] - T.Pref[1]));
        *(LAS unsigned*)(kf + s * 72 + 2 * d2) = pk2(k0 * __expf(T.Pref[0] - T.P[q][0]), k1 * __expf(T.Pref[1] - T.P[q][1]));
        *(LAS unsigned*)(qb + s * 72 + 2 * d2) = pk2(q0 * __expf(T.X[q][0] - T.Xref[0]), q1 * __expf(T.X[q][1] - T.Xref[1]));
        *(LAS unsigned*)(kb + s * 72 + 2 * d2) = pk2(k0 * __expf(T.Xref[0] - T.X[q][0]), k1 * __expf(T.Xref[1] - T.X[q][1]));
        *(LAS unsigned*)(qS + s * 136 + 2 * d2) = pk2(q0 * __expf(T.P[q][0]), q1 * __expf(T.P[q][1]));
        *(LAS unsigned*)(qS + s * 136 + 64 + 2 * d2) = pk2(q0 * __expf(T.X[q][0]), q1 * __expf(T.X[q][1])); }
#pragma unroll
    for (int q = 0; q < 2; ++q) { const int idx = tid + NTHR * q; *(LAS v4u*)(vN + (idx >> 4) * GL_VP + (idx & 15) * 8) = vv[q]; }
#pragma unroll
    for (int q = 0; q < 4; ++q) { const int idx = tid + NTHR * q, dir = idx >> 10, e = (idx >> 3) & 127, d8 = (idx & 7) * 8; *(LAS v4u*)(Sp + e * 136 + dir * 64 + d8) = sv[q]; }
    __syncthreads();
    { const int dir = wave >> 2, c0 = ((wave >> 1) & 1) * 32, s0 = (wave & 1) * 32;
        const LAS bf16* qq = dir ? qb : qf; const LAS bf16* kk = dir ? kb : kf;
        f32x16 acc;
#pragma unroll
        for (int i = 0; i < 16; ++i) acc[i] = 0.f;
#pragma unroll
        for (int ks = 0; ks < 4; ++ks) { const bf16x8 A = *(const LAS bf16x8*)(qq + (c0 + l31) * 72 + 16 * ks + 8 * hh), B = *(const LAS bf16x8*)(kk + (s0 + l31) * 72 + 16 * ks + 8 * hh);
            acc = mfma32(A, B, acc); }
        const int s = s0 + l31;
#pragma unroll
        for (int r = 0; r < 16; ++r) { const int c = c0 + (r & 3) + 8 * (r >> 2) + 4 * hh; const bool keep = dir ? (s >= c) : (s <= c);
            Scat[c * 136 + dir * 64 + s] = (bf16)f2bf(keep ? acc[r] : 0.f); } }
    __syncthreads();
    { const int c0 = (wave >> 2) * 32, e0 = (wave & 3) * 32;
        f32x16 acc;
#pragma unroll
        for (int i = 0; i < 16; ++i) acc[i] = 0.f;
#pragma unroll
        for (int ks = 0; ks < 8; ++ks) { const bf16x8 A = *(const LAS bf16x8*)(Scat + (c0 + l31) * 136 + 16 * ks + 8 * hh);
            acc = mfma32(A, tr_frag(vN, GL_VP, 16 * (ks & 3), e0, lane), acc); }
#pragma unroll
        for (int ks = 0; ks < 8; ++ks) { const bf16x8 A = *(const LAS bf16x8*)(qS + (c0 + l31) * 136 + 16 * ks + 8 * hh), B = *(const LAS bf16x8*)(Sp + (e0 + l31) * 136 + 16 * ks + 8 * hh);
            acc = mfma32(A, B, acc); }
#pragma unroll
        for (int r = 0; r < 16; ++r) { const int c = c0 + (r & 3) + 8 * (r >> 2) + 4 * hh; oS[c * 132 + e0 + l31] = acc[r]; } }
    __syncthreads();
    { const int row = tid >> 3, ec = (tid & 7) * 16; float v[16]; float ss = 0.f;
#pragma unroll
        for (int j = 0; j < 16; ++j) { v[j] = oS[row * 132 + ec + j]; ss += v[j] * v[j]; }
        ss += __shfl_xor(ss, 1); ss += __shfl_xor(ss, 2); ss += __shfl_xor(ss, 4);
        const float rs = rsqrtf(ss * (1.0f / 128.0f) + EPS);
        const float gv[16] = {bflo(g0.x), bfhi(g0.x), bflo(g0.y), bfhi(g0.y), bflo(g0.z), bfhi(g0.z), bflo(g0.w), bfhi(g0.w), bflo(g1.x), bfhi(g1.x), bflo(g1.y), bfhi(g1.y), bflo(g1.z), bfhi(g1.z), bflo(g1.w), bfhi(g1.w)};
        float o[16];
#pragma unroll
        for (int j = 0; j < 16; ++j) o[j] = DBG_GLA_K * v[j] * rs * a.in[12][ec + j] * silu_f(gv[j]);
        bf16* op = (bf16*)(ws + WS_AOUT) + (rowbase + row) * DM + h * 128 + ec;
        *(v4u*)op = (v4u){pk2(o[0], o[1]), pk2(o[2], o[3]), pk2(o[4], o[5]), pk2(o[6], o[7])};
        *(v4u*)(op + 8) = (v4u){pk2(o[8], o[9]), pk2(o[10], o[11]), pk2(o[12], o[13]), pk2(o[14], o[15])}; }
    __syncthreads();
}

__device__ __forceinline__ void hy_transpose_item(const Args& a, LAS unsigned char* lds, int it) {
    const int tid = threadIdx.x, b = it >> 6, t0 = (it & 63) * 64;
    LAS float* tile = (LAS float*)lds;
    const bf16* src = (const bf16*)(a.ws + WS_HYT) + (size_t)b * 1536 * SEQ + t0;
    bf16* dst = (bf16*)(a.ws + WS_AOUT) + ((size_t)b * SEQ + t0) * DM + 512;
    for (int half = 0; half < 2; ++half) {
#pragma unroll 8
        for (int q = 0; q < 32; ++q) { const int idx = tid + NTHR * q, c = idx >> 6, tt = idx & 63; tile[c * 65 + tt] = HB(src[(size_t)(half * 256 + c) * SEQ + tt]); }
        __syncthreads();
#pragma unroll
        for (int q = 0; q < 4; ++q) { const int idx = tid + NTHR * q, t = idx >> 5, c8 = (idx & 31) * 8; const LAS float* s = tile + c8 * 65 + t;
            *(v4u*)(dst + (size_t)t * DM + half * 256 + c8) = (v4u){pk2(s[0], s[65]), pk2(s[2 * 65], s[3 * 65]), pk2(s[4 * 65], s[5 * 65]), pk2(s[6 * 65], s[7 * 65])}; }
        __syncthreads();
    }
}

__device__ __forceinline__ void phase_router(const Args& a, LAS unsigned char* lds) {
    const int tid = threadIdx.x, lane = tid & 63, wave = tid >> 6, wg = blockIdx.x, G = gridDim.x;
    unsigned char* ws = a.ws;
    LAS float* wr = (LAS float*)lds;
    {   f32x4 t[8];
#pragma unroll
        for (int it = 0; it < 8; ++it) t[it] = *(const f32x4*)(a.in[24] + 4 * (tid + NTHR * it));
#pragma unroll
        for (int it = 0; it < 8; ++it) { const int i4 = tid + NTHR * it, c = i4 >> 2, e4 = i4 & 3, l = (c >> 2) & 63, q = c & 3, j = c >> 8;
            *(LAS f32x4*)(wr + 4 * ((((j * 4 + q) * 4 + e4) * 65) + l)) = t[it]; } }
    __syncthreads();
    const float* modr = (const float*)(ws + WS_MOD); const float* gffn = a.in[23];
    bf16* hn = (bf16*)(ws + WS_HN); float* aff = (float*)(ws + WS_AFF);
    const int NGW = G * NWAVES;
    f32x4 gv[4];
#pragma unroll
    for (int j = 0; j < 4; ++j) gv[j] = *(const f32x4*)(gffn + 4 * lane + 256 * j);
#pragma nounroll
    for (int r0 = wg * NWAVES + wave; r0 < MX; r0 += 2 * NGW) {
        const int r1 = r0 + NGW; const bool ok1 = r1 < MX; const int rB = ok1 ? r1 : r0;
        int lane_o = lane; asm volatile("" : "+v"(lane_o));
        f32x4 v[2][4];
#pragma unroll
        for (int j = 0; j < 4; ++j) { v[0][j] = *(const f32x4*)(a.out + (size_t)r0 * DM + 4 * lane + 256 * j); v[1][j] = *(const f32x4*)(a.out + (size_t)rB * DM + 4 * lane + 256 * j); }
        float rs[2];
#pragma unroll
        for (int k = 0; k < 2; ++k) { float ss = 0.f;
#pragma unroll
            for (int j = 0; j < 4; ++j) ss += v[k][j][0] * v[k][j][0] + v[k][j][1] * v[k][j][1] + v[k][j][2] * v[k][j][2] + v[k][j][3] * v[k][j][3];
            rs[k] = rsqrtf(wave_sum(ss) * (1.0f / DM) + EPS); }
        float lg[2][16];
#pragma unroll
        for (int k = 0; k < 2; ++k)
#pragma unroll
            for (int e = 0; e < 16; ++e) lg[k][e] = 0.f;
        f32x4 shv[2][4], scv[2][4];
#pragma unroll
        for (int k = 0; k < 2; ++k)
#pragma unroll
            for (int j = 0; j < 4; ++j) { const int b = (k ? rB : r0) >> 12, col = 4 * lane + 256 * j; shv[k][j] = *(const f32x4*)(modr + b * 6144 + 3072 + col); scv[k][j] = *(const f32x4*)(modr + b * 6144 + 4096 + col); }
#pragma unroll
        for (int j = 0; j < 4; ++j) { const int col = 4 * lane + 256 * j; f32x4 y[2];
#pragma unroll
            for (int k = 0; k < 2; ++k) { const int r = k ? rB : r0;
                const f32x4 sh = shv[k][j], sc = scv[k][j];
                y[k] = (v[k][j] * rs[k] * gv[j]) * (sc + 1.0f) + sh;
                v2u w; w.x = pk2(y[k][0], y[k][1]); w.y = pk2(y[k][2], y[k][3]);
                if (k == 0 || ok1) *(v2u*)(hn + (size_t)r * DM + col) = w; }
#pragma unroll
            for (int q = 0; q < 4; ++q) {
#pragma unroll
                for (int e4 = 0; e4 < 4; ++e4) { const f32x4 ww = *(const LAS f32x4*)(wr + 4 * ((((j * 4 + q) * 4 + e4) * 65) + lane_o));
#pragma unroll
                    for (int s = 0; s < 4; ++s) { lg[0][e4 * 4 + s] += y[0][q] * ww[s]; lg[1][e4 * 4 + s] += y[1][q] * ww[s]; } }
#define PIN16(x) asm volatile("" : "+v"(x[0]), "+v"(x[1]), "+v"(x[2]), "+v"(x[3]), "+v"(x[4]), "+v"(x[5]), "+v"(x[6]), "+v"(x[7]), "+v"(x[8]), "+v"(x[9]), "+v"(x[10]), "+v"(x[11]), "+v"(x[12]), "+v"(x[13]), "+v"(x[14]), "+v"(x[15]) :: "memory")
                PIN16(lg[0]); PIN16(lg[1]); } }
#undef PIN16
        const int exb = ((lane >> 5) & 1) * 8 + ((lane >> 4) & 1) * 4, esel = lane & 3;
#pragma unroll
        for (int k = 0; k < 2; ++k) { float k8[8], k4[4];
#pragma unroll
            for (int i = 0; i < 8; ++i) { float x = lg[k][i], y = lg[k][8 + i]; swap32(x, y); k8[i] = x + y; }
#pragma unroll
            for (int i = 0; i < 4; ++i) { float x = k8[i], y = k8[4 + i]; swap16(x, y); k4[i] = row_allsum(x + y); }
            const float mx = x32_max(x16_max(fmaxf(fmaxf(k4[0], k4[1]), fmaxf(k4[2], k4[3]))));
            float pe[4];
#pragma unroll
            for (int i = 0; i < 4; ++i) pe[i] = __expf(k4[i] - mx);
            const float sum = x32_sum(x16_sum((pe[0] + pe[1]) + (pe[2] + pe[3])));
            const float mine = (esel == 0) ? pe[0] : (esel == 1) ? pe[1] : (esel == 2) ? pe[2] : pe[3];
            const int r = k ? rB : r0;
            if ((lane & 12) == 0 && (k == 0 || ok1)) aff[((size_t)(r >> 12) * NE + exb + esel) * SEQ + (r & 4095)] = mine * __builtin_amdgcn_rcpf(sum); }
    }
}

__device__ __forceinline__ void conv_item(const Args& a, LAS float* scr, int lane, bool gu, int it) {
    unsigned char* ws = a.ws;
    if (gu) { const int mat = it >> 9, r = it & 511, nb = r >> 4, kb = r & 15, e = mat >> 1, kind = mat & 1, n0 = nb * 32;
        transpose_item((kind ? a.in[26] : a.in[25]) + (size_t)e * DM * DM, DM, kb * 64, n0, (bf16*)(ws + WS_WGU) + (size_t)e * 2048 * DM, DM, (n0 >> 7) * 256 + kind * 128 + (n0 & 127), scr, lane, false);
    } else { const int e = it >> 9, r = it & 511, nb = r >> 4, kb = r & 15;
        transpose_item(a.in[27] + (size_t)e * DM * DM, DM, kb * 64, nb * 32, (bf16*)(ws + WS_WD) + (size_t)e * DM * DM, DM, nb * 32, scr, lane, false); }
}
__device__ __forceinline__ bool conv_try(const Args& a, LAS unsigned char* lds, bool allow_gu, unsigned& cur) {
    const int lane = threadIdx.x & 63, wave = threadIdx.x >> 6;
    if (wave == 0) return false;
    const int gw = blockIdx.x * (NWAVES - 1) + wave - 1, NGW = gridDim.x * (NWAVES - 1);
    LAS float* scr = (LAS float*)(lds + wave * 8448);
    const int itD = gw + (int)(cur & 0xffffu) * NGW;
    if (itD < NE * 512) { conv_item(a, scr, lane, false, itD); cur += 1u; return true; }
    if (!allow_gu) return false;
    const int itG = gw + (int)(cur >> 16) * NGW;
    if (itG < NE * 1024) { conv_item(a, scr, lane, true, itG); cur += 0x10000u; return true; }
    return false;
}
#ifndef DBG_NOSHADOW
#define DBG_NOSHADOW 0
#endif
#ifndef SHADOW_LIM
#define SHADOW_LIM 2
#endif
__device__ __forceinline__ void seam_barrier(const XcdBarrier& b, const Args& a, LAS unsigned char* lds, volatile LAS unsigned* MISC, unsigned& gen, bool allow_gu, unsigned& cdone) {
    asm volatile("s_waitcnt vmcnt(0)" ::: "memory");
    __syncthreads();
    ++gen;
    if (threadIdx.x < 64) {
        if (threadIdx.x == 0) {
            unsigned* bar = b.bar;
            __builtin_amdgcn_s_waitcnt(0);
            unsigned nloc = b.st[0], nx = b.st[1];
            if (nloc == 0u) { xcd_barrier_complete(bar, b.x, nloc, nx); b.st[0] = nloc; b.st[1] = nx; }
            const unsigned old = xb_add(&bar[XB_XSUB(b.x)], 1u);
            const unsigned g2 = old / nloc;
            if (old + 1u == (g2 + 1u) * nloc) {
                __builtin_amdgcn_fence(__ATOMIC_RELEASE, "agent");
                asm volatile("s_waitcnt vmcnt(0)" ::: "memory");
                const unsigned og = xb_add(&bar[XB_TOP], 1u);
                const unsigned tg = og / nx;
                if (og + 1u == (tg + 1u) * nx) xb_add(&bar[XB_TOPGEN], 1u);
                else XB_SPIN(xb_ld(&bar[XB_TOPGEN]) == tg, bar);
                __builtin_amdgcn_fence(__ATOMIC_ACQUIRE, "agent");
                xb_add(&bar[XB_XGEN(b.x)], 1u);
                asm volatile("s_waitcnt vmcnt(0)" ::: "memory");
            } else {
                XB_SPIN(xb_ld(&bar[XB_XGEN(b.x)]) == g2, bar);
                __builtin_amdgcn_fence(__ATOMIC_ACQUIRE, "agent");
                asm volatile("s_waitcnt vmcnt(0)" ::: "memory");
            }
            MISC[16] = gen;
        }
    } else {
        unsigned spins = 0; int ndone = 0;
        while (MISC[16] != gen) { if (DBG_NOSHADOW || ndone >= SHADOW_LIM || !conv_try(a, lds, allow_gu, cdone)) { __builtin_amdgcn_s_sleep(4); if (++spins > (1u << 22)) break; } else ++ndone; }
    }
    __syncthreads();
}

__device__ __forceinline__ void block_excl_scan2(int& va, int& vb, LAS int* tmp) {
    const int tid = threadIdx.x, lane = tid & 63, wave = tid >> 6;
    int ia = va, ib = vb;
#pragma unroll
    for (int o = 1; o < 64; o <<= 1) { const int ta = __shfl_up(ia, o), tb = __shfl_up(ib, o); if (lane >= o) { ia += ta; ib += tb; } }
    if (lane == 63) { tmp[wave] = ia; tmp[8 + wave] = ib; }
    __syncthreads();
    int oa = 0, ob = 0;
#pragma unroll
    for (int w = 0; w < 8; ++w) { if (w < wave) { oa += tmp[w]; ob += tmp[8 + w]; } }
    va = oa + ia - va; vb = ob + ib - vb;
    __syncthreads();
}
__device__ __forceinline__ void topk_item(const Args& a, LAS unsigned char* lds, int be) {
    const int tid = threadIdx.x, b = be >> 4, e = be & 15;
    unsigned char* ws = a.ws;
    LAS unsigned* keys = (LAS unsigned*)lds;
    LAS unsigned* hist = (LAS unsigned*)(lds + 16384);
    LAS int* ctl = (LAS int*)(lds + 16384 + 1024);
    LAS int* tmp = (LAS int*)(lds + 16384 + 1024 + 64);
    const float* aff = (const float*)(ws + WS_AFF) + (size_t)be * SEQ;
    unsigned my[8];
#pragma unroll
    for (int i = 0; i < 8; ++i) { my[i] = __float_as_uint(aff[tid * 8 + i]); keys[tid * 8 + i] = my[i]; }
    unsigned prefix = 0u, mask = 0u; int need = CAP;
    for (int pass = 0; pass < 4; ++pass) {
        const int shift = 24 - 8 * pass;
        if (tid < 256) hist[tid] = 0u;
        __syncthreads();
#pragma unroll
        for (int i = 0; i < 8; ++i) if ((my[i] & mask) == prefix) atomicAdd((unsigned*)&hist[(my[i] >> shift) & 255u], 1u);
        __syncthreads();
        {
            int hv = (tid < 256) ? (int)hist[255 - tid] : 0, inc = hv;
#pragma unroll
            for (int o = 1; o < 64; o <<= 1) { const int t2 = __shfl_up(inc, o); if ((tid & 63) >= o) inc += t2; }
            if ((tid & 63) == 63) tmp[tid >> 6] = inc;
            __syncthreads();
            int off = 0;
#pragma unroll
            for (int w = 0; w < 4; ++w) if (w < (tid >> 6)) off += tmp[w];
            inc += off;
            if (tid < 256 && inc >= need && inc - hv < need) { ctl[0] = 255 - tid; ctl[1] = need - (inc - hv); }
        }
        __syncthreads();
        prefix |= ((unsigned)ctl[0]) << shift; mask |= 255u << shift; need = ctl[1];
        __syncthreads();
    }
    const unsigned T = prefix;
    int cg = 0, ce = 0;
#pragma unroll
    for (int i = 0; i < 8; ++i) { cg += (my[i] > T) ? 1 : 0; ce += (my[i] == T) ? 1 : 0; }
    int pg = cg, pe = ce;
    block_excl_scan2(pg, pe, tmp);
    int* slot_of = (int*)(ws + WS_SLOT) + (size_t)be * SEQ;
    int* selt = (int*)(ws + WS_SELT) + (e * 4 + b) * CAP; float* selv = (float*)(ws + WS_SELV) + (e * 4 + b) * CAP;
#pragma unroll
    for (int i = 0; i < 8; ++i) { const int t = tid * 8 + i; const bool gt = my[i] > T, eq = my[i] == T; const bool sel = gt || (eq && pe < need);
        const int slot = pg + (pe < need ? pe : need);
        slot_of[t] = sel ? slot : -1;
        if (sel) { selt[slot] = t; selv[slot] = __uint_as_float(my[i]); }
        pg += gt ? 1 : 0; pe += eq ? 1 : 0; }
    __syncthreads();
}
__device__ __forceinline__ void phase_topk(const Args& a, LAS unsigned char* lds, unsigned& cdone) {
    const int tid = threadIdx.x, lane = tid & 63, wave = tid >> 6, wg = blockIdx.x, G = gridDim.x;
    unsigned char* ws = a.ws;
    for (int it = wg; it < NB * NE; it += G) topk_item(a, lds, it);
    __syncthreads();
    while (conv_try(a, lds, true, cdone)) {}
}

__device__ __forceinline__ void phase_final(const Args& a) {
    const int tid = threadIdx.x, lane = tid & 63, wave = tid >> 6, wg = blockIdx.x, G = gridDim.x;
    unsigned char* ws = a.ws;
    const float* modr = (const float*)(ws + WS_MOD); const int* slot_of = (const int*)(ws + WS_SLOT); const bf16* ys = (const bf16*)(ws + WS_YSLAB);
    const int NGW = G * NWAVES;
    f32x4 gf[4];
#pragma unroll
    for (int j = 0; j < 4; ++j) gf[j] = *(const f32x4*)(a.in[28] + 4 * lane + 256 * j);
#pragma nounroll
    for (int r0 = wg * NWAVES + wave; r0 < MX; r0 += 4 * NGW) {
        int sv[4]; unsigned long long mk[4]; f32x4 v[4][4], m[4][4];
#pragma unroll
        for (int k = 0; k < 4; ++k) { const int r = r0 + k * NGW; const bool ok = r < MX; const int rc = ok ? r : r0, b = rc >> 12, t = rc & 4095;
            sv[k] = (lane < NE) ? slot_of[((size_t)b * NE + lane) * SEQ + t] : -1;
#pragma unroll
            for (int j = 0; j < 4; ++j) { v[k][j] = *(const f32x4*)(a.out + (size_t)rc * DM + 4 * lane + 256 * j); m[k][j] = (f32x4){0.f, 0.f, 0.f, 0.f}; }
            mk[k] = (ok && !DBG_NOMOE) ? __ballot(sv[k] >= 0) : 0ull; }
        while (mk[0] | mk[1] | mk[2] | mk[3]) {
            v2u w[4][4]; float wt[4];
#pragma unroll
            for (int k = 0; k < 4; ++k) { const bool has = mk[k] != 0ull; const int e = has ? (int)__ffsll((long long)mk[k]) - 1 : 0; mk[k] &= mk[k] - 1ull;
                const int rc = (r0 + k * NGW < MX) ? r0 + k * NGW : r0; const int sl = has ? __builtin_amdgcn_readlane(sv[k], e) : 0;
                const bf16* yp = ys + ((size_t)e * 2048 + (rc >> 12) * CAP + sl) * DM; wt[k] = has ? 1.f : 0.f;
#pragma unroll
                for (int j = 0; j < 4; ++j) w[k][j] = *(const v2u*)(yp + 4 * lane + 256 * j); }
#pragma unroll
            for (int k = 0; k < 4; ++k)
#pragma unroll
                for (int j = 0; j < 4; ++j) { m[k][j][0] += wt[k] * bflo(w[k][j].x); m[k][j][1] += wt[k] * bfhi(w[k][j].x); m[k][j][2] += wt[k] * bflo(w[k][j].y); m[k][j][3] += wt[k] * bfhi(w[k][j].y); }
        }
        f32x4 gt[4][4];
#pragma unroll
        for (int k = 0; k < 4; ++k) { const int r = r0 + k * NGW, b = ((r < MX) ? r : r0) >> 12;
#pragma unroll
            for (int j = 0; j < 4; ++j) gt[k][j] = *(const f32x4*)(modr + b * 6144 + 5120 + 4 * lane + 256 * j); }
#pragma unroll
        for (int k = 0; k < 4; ++k) { const int r = r0 + k * NGW;
            if (r < MX) { float ss = 0.f; float* row = a.out + (size_t)r * DM;
#pragma unroll
                for (int j = 0; j < 4; ++j) { v[k][j] = v[k][j] + gt[k][j] * m[k][j] * DBG_MOE_K;
                    ss += v[k][j][0] * v[k][j][0] + v[k][j][1] * v[k][j][1] + v[k][j][2] * v[k][j][2] + v[k][j][3] * v[k][j][3]; }
                const float rs = rsqrtf(wave_sum(ss) * (1.0f / DM) + EPS);
#pragma unroll
                for (int j = 0; j < 4; ++j) *(f32x4*)(row + 4 * lane + 256 * j) = v[k][j] * rs * gf[j]; } }
    }
}

__global__ void __launch_bounds__(NTHR, 2) fwd_kernel(Args a) {
    extern __shared__ __attribute__((aligned(16))) unsigned char lds_raw[];
    LAS unsigned char* lds = (LAS unsigned char*)lds_raw;
    const int tid = threadIdx.x, wg = blockIdx.x, G = gridDim.x;
    unsigned char* ws = a.ws;
    volatile LAS unsigned* MISC = (volatile LAS unsigned*)(lds + LDS_MISC);
    if (tid < 64) MISC[tid] = 0u;
    __syncthreads();
    unsigned bgen = 0u, cdone = 0u;
    XcdBarrier bar; bar.bar = (unsigned*)(ws + WS_CTL); bar.x = 0; bar.st = nullptr;
    if (a.ph_hi - a.ph_lo > 1) bar = xcd_barrier_post((unsigned*)(ws + WS_CTL), MISC + 8);
#ifndef PH_ONLY
#define PH_ONLY -1
#endif
#define IN(k) ((PH_ONLY < 0 || PH_ONLY == (k)) && a.ph_lo <= (k) && (k) < a.ph_hi)
#ifndef DBG_BAR2
#define DBG_BAR2 0
#endif
#ifndef DBG_TSA
#define DBG_TSA -1
#endif
#ifndef DBG_TSB
#define DBG_TSB -1
#endif
#define STAMP(k) do { if (DBG_TSA >= 0 && wg == 0 && tid == 0) ((unsigned long long*)(ws + WS_CTL + 49152))[k] = __builtin_amdgcn_s_memrealtime(); } while (0)
#define SEAM(k) do { if (IN(k) && IN((k) + 1)) { seam_barrier(bar, a, lds, MISC, bgen, true, cdone); if (DBG_BAR2) xcd_barrier(bar); } STAMP((k) + 1); } while (0)
#ifndef DBG_DUP
#define DBG_DUP -1
#endif
#define REP(k) _Pragma("nounroll") for (int _rep = 0; _rep < ((DBG_DUP == (k)) ? 2 : 1); ++_rep, (void)((DBG_DUP == (k) && _rep == 1) ? (xcd_barrier(bar), 0) : 0))
    STAMP(0);
    if (IN(0)) REP(0) { phase0(a, lds); } SEAM(0);
    if (IN(1)) REP(1) { phase1(a, lds); } SEAM(1);
    if (IN(2)) REP(2) {
        pg8::Gemm g{(const pg8::bf16_t*)ws, (const pg8::bf16_t*)ws, MT, NIN, DM}; InSched S; S.init(G, wg, 0);
        EpiIn E{(bf16*)(ws + WS_QKVG), (bf16*)(ws + WS_HYT), (float*)(ws + WS_AFB)};
        pg8::gemm_phase<EpiIn, InSched, true, true>(lds, g, S, E);
    } SEAM(2);
    if (IN(3)) REP(3) {
        {   pg8::Gemm g{(const pg8::bf16_t*)ws, (const pg8::bf16_t*)ws, MT, NIN, DM}; InSched S; S.init(G, wg, 1);
            EpiIn E{(bf16*)(ws + WS_QKVG), (bf16*)(ws + WS_HYT), (float*)(ws + WS_AFB)};
            pg8::gemm_phase<EpiIn, InSched, true, true>(lds, g, S, E); }
        for (int it = wg; it < 512; it += G) hyena_item(a, lds, it, 0);
        {   GlaIn I, N; bool have = false;
            const bool split = (G == 256);
            const int first = split ? ((wg < 80) ? wg : 80 + wg) : wg, stride = split ? ((wg < 80) ? 80 : 176) : G, limit = split ? ((wg < 80) ? 160 : 16 * NCH) : 16 * NCH;
            for (int r = first; r < limit; r += stride) {
                const int nr = r + stride; const bool hasn = nr < limit;
                if (!have) { int t0 = threadIdx.x; asm volatile("" : "+v"(t0)); gla_load<false>(a, t0, r / NCH, r % NCH, I); have = true; }
                if (hasn) gla_upd_item<true>(a, lds, r / NCH, r % NCH, I, nr / NCH, nr % NCH, N); else gla_upd_item<false>(a, lds, r / NCH, r % NCH, I, 0, 0, N);
                I = N; } }
    } SEAM(3);
    if (IN(4)) REP(4) {
        for (int it = wg; it < 1024; it += G) { if (it < 512) hyena_item(a, lds, it, 1); else gla_scan_item(a, it - 512); }
    } SEAM(4);
    if (IN(5)) REP(5) {
        GlaIn I, N; bool have = false;
        for (int it = wg; it < 1280; it += G) {
            if (it >= 1024) { hy_transpose_item(a, lds, it - 1024); continue; }
            const int nr = it + G; const bool hasn = nr < 1024;
            if (!have) { int t0 = threadIdx.x; asm volatile("" : "+v"(t0)); gla_load<true>(a, t0, it >> 6, it & 63, I); have = true; }
            if (hasn) gla_out_item<true>(a, lds, it >> 6, it & 63, I, nr >> 6, nr & 63, N); else gla_out_item<false>(a, lds, it >> 6, it & 63, I, 0, 0, N);
            I = N; }
    } SEAM(5);
    if (IN(6)) REP(6) {
        pg8::Gemm g{(const pg8::bf16_t*)(ws + WS_AOUT), (const pg8::bf16_t*)(ws + WS_WOUT), MX, DM, DM}; pg8::StaticOrder S; S.init(MX, DM, G, wg);
        EpiOut E{a.in[0], (const float*)(ws + WS_POS), (const float*)(ws + WS_MOD), a.out};
        pg8::gemm_phase<EpiOut, pg8::StaticOrder, false, true>(lds, g, S, E);
    } SEAM(6);
    if (IN(7)) REP(7) { phase_router(a, lds); } SEAM(7);
    if (IN(8)) REP(8) { phase_topk(a, lds, cdone); } SEAM(8);
    if (IN(9)) REP(9) {
        pg8::Gemm g{(const pg8::bf16_t*)(ws + WS_HN), (const pg8::bf16_t*)(ws + WS_WGU), NE * 2048, NE * 2048, DM}; MoeSched<8> S; S.init(G, wg);
        EpiGU E{(bf16*)(ws + WS_HID)};
        pg8::gemm_phase_gather<EpiGU, MoeSched<8>, true, true>(lds, g, S, E, (const int*)(ws + WS_SELT));
    } SEAM(9);
    if (IN(10)) REP(10) {
        pg8::Gemm g{(const pg8::bf16_t*)(ws + WS_HID), (const pg8::bf16_t*)(ws + WS_WD), NE * 2048, NE * 1024, DM}; MoeSched<4> S; S.init(G, wg);
        EpiDown E{(bf16*)(ws + WS_YSLAB), (const float*)(ws + WS_SELV)};
        pg8::gemm_phase<EpiDown, MoeSched<4>, true, true>(lds, g, S, E);
    } SEAM(10);
    if (IN(11)) { phase_final(a); }
    if (DBG_TSA >= 0) {
        xcd_barrier(bar); STAMP(12); xcd_barrier(bar);
        const unsigned long long* ts = (const unsigned long long*)(ws + WS_CTL + 49152);
        const float da = (DBG_TSA == 12) ? (float)(ts[12] - ts[0]) * 0.01f : (float)(ts[DBG_TSA + 1] - ts[DBG_TSA]) * 0.01f;
        const float db = (DBG_TSB == 12) ? (float)(ts[12] - ts[0]) * 0.01f : (float)(ts[DBG_TSB + 1] - ts[DBG_TSB]) * 0.01f;
        for (size_t i = (size_t)wg * NTHR + tid; i < (size_t)MX * DM; i += (size_t)G * NTHR) a.out[i] = (i < (size_t)MX * DM / 2) ? da : db;
    }
#undef IN
#undef SEAM
}


#ifdef DBG_STATE
__global__ void chk_kernel(const unsigned* p, size_t nwords, unsigned long long* out) {
    unsigned long long s = 0ull;
    for (size_t i = (size_t)blockIdx.x * blockDim.x + threadIdx.x; i < nwords; i += (size_t)gridDim.x * blockDim.x) s += (unsigned long long)p[i] * (2ull * i + 1ull);
    for (int o = 1; o < 64; o <<= 1) s += __shfl_xor(s, o);
    if ((threadIdx.x & 63) == 0) atomicAdd(out, s);
}
__global__ void report_kernel(const unsigned long long* chk, float* out, int n) {
    int bad = -1;
    for (int p = 0; p < 27; ++p) if (chk[p] != chk[32 + p]) { bad = p; break; }
    if (bad < 0) return;
    for (int i = blockIdx.x * blockDim.x + threadIdx.x; i < n; i += gridDim.x * blockDim.x) out[i] = 1000.f * (float)(bad + 1);
}
struct ChkEnt { int ph; size_t off; size_t bytes; };
#endif
extern "C" void kernel_launch(void* const* d_in, const int* in_sizes, int n_in, void* d_out, int out_size, void* d_ws, size_t ws_size, hipStream_t stream) {
    static int grid = 0;
    if (grid == 0) {
        if (n_in != 29 || out_size != MX * DM || ws_size < WS_END) { fprintf(stderr, "kernel_launch: unexpected shapes (n_in %d out %d ws %zu)\n", n_in, out_size, ws_size); grid = -1; return; }
        int dev = 0, cus = 0, per_cu = 0;
        if (hipGetDevice(&dev) != hipSuccess || hipDeviceGetAttribute(&cus, hipDeviceAttributeMultiprocessorCount, dev) != hipSuccess) { grid = -1; return; }
        if (hipFuncSetAttribute((const void*)fwd_kernel, hipFuncAttributeMaxDynamicSharedMemorySize, LDS_BYTES) != hipSuccess) { fprintf(stderr, "kernel_launch: hipFuncSetAttribute failed\n"); grid = -1; return; }
        if (hipOccupancyMaxActiveBlocksPerMultiprocessor(&per_cu, (const void*)fwd_kernel, NTHR, LDS_BYTES) != hipSuccess || per_cu < 1) fprintf(stderr, "kernel_launch: occupancy query reports %d\n", per_cu);
        (void)hipGetLastError();
        grid = cus;
    }
    if (grid < 0) return;
    (void)hipMemsetAsync((char*)d_ws + WS_CTL, 0, CTL_BYTES, stream);
    Args a{};
    for (int i = 0; i < 29; ++i) a.in[i] = (const float*)d_in[i];
    a.out = (float*)d_out; a.ws = (unsigned char*)d_ws;
#if MK_SINGLE
#ifdef DBG_TWICE
    a.ph_lo = 0; a.ph_hi = NPH - 1;
    hipLaunchKernelGGL(fwd_kernel, dim3(grid), dim3(NTHR), LDS_BYTES, stream, a);
    (void)hipMemsetAsync((char*)d_ws + WS_CTL, 0, CTL_BYTES, stream);
#endif
    a.ph_lo = 0; a.ph_hi = NPH;
    hipLaunchKernelGGL(fwd_kernel, dim3(grid), dim3(NTHR), LDS_BYTES, stream, a);
#else
#ifdef DBG_STATE
    static const ChkEnt ents[] = { {0, WS_MOD, 122880}, {0, WS_POS, 131072}, {0, WS_HT, 32 * MiB}, {0, WS_WIN, (size_t)NIN * DM * 2}, {0, WS_WOUT, 2 * MiB},
        {1, WS_AIN, 34 * MiB}, {2, WS_QKVG, (size_t)MX * NQ * 2}, {2, WS_HYT, 48 * MiB}, {2, WS_AFB, (size_t)MT * 128},
        {3, WS_ZT, 32 * MiB}, {3, WS_DEC, (size_t)16 * 2 * NCH * 64 * 4}, {3, WS_UCTX, 4 * MiB}, {3, (size_t)-1, 64 * MiB},
        {4, WS_SPREV, 32 * MiB}, {4, WS_YHYT, 32 * MiB}, {5, WS_AOUT, 32 * MiB}, {6, (size_t)-1, 64 * MiB}, {7, WS_HN, 32 * MiB}, {7, WS_AFF, 1 * MiB},
        {8, WS_SLOT, 1 * MiB}, {8, WS_SELT, 131072}, {8, WS_SELV, 131072}, {8, WS_WGU, 64 * MiB}, {8, WS_WD, 32 * MiB}, {9, WS_HID, 64 * MiB}, {10, WS_YSLAB, 64 * MiB}, {11, (size_t)-1, 64 * MiB} };
    unsigned long long* chk = (unsigned long long*)((char*)d_ws + 32768);
    for (int run = 0; run < 2; ++run)
        for (int p = 0; p < NPH; ++p) { a.ph_lo = p; a.ph_hi = p + 1; hipLaunchKernelGGL(fwd_kernel, dim3(grid), dim3(NTHR), LDS_BYTES, stream, a);
            for (const ChkEnt& e : ents) if (e.ph == p) hipLaunchKernelGGL(chk_kernel, dim3(1024), dim3(256), 0, stream, (const unsigned*)(e.off == (size_t)-1 ? (char*)d_out : (char*)d_ws + e.off), e.bytes / 4, chk + run * 32 + (int)(&e - ents)); }
    hipLaunchKernelGGL(report_kernel, dim3(1024), dim3(256), 0, stream, (const unsigned long long*)chk, (float*)d_out, out_size);
#else
    for (int p = 0; p < NPH; ++p) { a.ph_lo = p; a.ph_hi = p + 1; hipLaunchKernelGGL(fwd_kernel, dim3(grid), dim3(NTHR), LDS_BYTES, stream, a); }
#endif
#endif
}
```

```cpp
#include <hip/hip_runtime.h>
#include <cstdio>
#include <cstdint>
#define MK_SINGLE 1
namespace pg8 {
#define PG8_LAS __attribute__((address_space(3)))
typedef unsigned short bf16_t;
typedef short bf16x8 __attribute__((ext_vector_type(8)));
typedef float f32x4 __attribute__((ext_vector_type(4)));
typedef unsigned u32x4 __attribute__((ext_vector_type(4)));
constexpr int BM = 256, BK = 64, HALF = 128, HTB = HALF * BK * 2  , STAGE_BYTES = 8 * HTB, NXCD = 8, WGM = 8;

__host__ __device__ __forceinline__ int lds_byte(int r, int c) { const int st = (r >> 4) * 2 + (c >> 5), rr = r & 15, cc = c & 31, ob = rr * 64 + cc * 2; return st * 1024 + (ob ^ (((ob >> 9) & 1) << 5)); }
__host__ __device__ __forceinline__ void stage_rc(int b, int& R, int& C) { const int st = b / 1024, sb = b % 1024, swz = sb ^ (((sb >> 9) & 1) << 5); R = (st >> 1) * 16 + swz / 64; C = (st & 1) * 32 + (swz % 64) / 2; }
__host__ __device__ __forceinline__ int perm32(int rho) { const int n = rho >> 4, i = rho & 15; return 8 * (i >> 2) + 4 * n + (i & 3); }

struct Unit { int pm, pn; };
struct Gemm { const bf16_t* A; const bf16_t* Bt; int M, N, K; };

struct StaticOrder {
    int nM, nN, nwg, G, c;
    __host__ __device__ void init(int M, int N, int G_, int c_) { nM = M / BM; nN = N / BM; nwg = nM * nN; G = G_; c = c_; }
    __host__ __device__ bool next(int i, Unit& u) const {
        const long L = (long)i * G + c; if (L >= nwg) return false;
        int wgid = (int)L; { const int q = nwg / NXCD, r = nwg % NXCD, xcd = wgid % NXCD, off = wgid / NXCD; wgid = (xcd < r ? xcd * (q + 1) : r * (q + 1) + (xcd - r) * q) + off; }
        const int nig = WGM * nN, gid = wgid / nig, fm = gid * WGM, gsz = (nM - fm) < WGM ? (nM - fm) : WGM;
        u.pm = fm + ((wgid % nig) % gsz); u.pn = (wgid % nig) / gsz; return true;
    }
    __device__ __forceinline__ void a_ready(const Unit&) const {}
    __device__ __forceinline__ void done(const Unit&) const {}
};

__device__ __forceinline__ unsigned cvt_pk_bf16(float lo, float hi) { unsigned r; asm volatile("v_cvt_pk_bf16_f32 %0, %1, %2" : "=v"(r) : "v"(lo), "v"(hi)); return r; }
template <class Epi, class Sched, bool ALIGN_EPI = false, bool SP2 = false>
__device__ __forceinline__ void gemm_phase(PG8_LAS unsigned char* lds, const Gemm g, const Sched& S, const Epi& E) {
    const int tid = threadIdx.x, wid = __builtin_amdgcn_readfirstlane(tid >> 6), lane = tid & 63, wr = wid >> 2, wc = wid & 3, fr = lane & 15, fq = lane >> 4;
    const int K = g.K, nt = K / BK;
    unsigned voffA[2], voffB[2];
#pragma unroll
    for (int i = 0; i < 2; ++i) { int R, C; stage_rc(tid * 16 + i * 8192, R, C); const int Rb = Epi::PERM ? ((R & ~31) + perm32(R & 31)) : R;
        voffA[i] = (unsigned)(R * K + C) * 2u; voffB[i] = (unsigned)(Rb * K + C) * 2u; }
    const size_t kstep = (size_t)(BK * 2);
    const size_t hstep = (size_t)HALF * K * 2;
    const size_t tstep = 2 * hstep;
    const unsigned ldsw = (unsigned)wid * 1024u;
    const int aoff = lds_byte(wr * 64 + fr, fq * 8), boff = lds_byte(wc * 32 + fr, fq * 8);
#define PG8_SA(b, h) (((b) * 2 + (h)) * HTB)
#define PG8_SB(b, h) ((4 + (b) * 2 + (h)) * HTB)
#define PG8_STAGE(bufoff, gbase, voff) do { _Pragma("unroll") for (int _i = 0; _i < 2; ++_i) \
        __builtin_amdgcn_global_load_lds((const unsigned*)((const char*)(gbase) + (voff)[_i]), (PG8_LAS unsigned*)(lds + (bufoff) + ldsw + _i * 8192), 16, 0, 0); } while (0)
#define PG8_LDA(dst, b, h) do { _Pragma("unroll") for (int m = 0; m < 4; ++m) _Pragma("unroll") for (int k = 0; k < 2; ++k) dst[m][k] = *(const PG8_LAS bf16x8*)(lds + PG8_SA(b, h) + aoff + m * 2048 + k * 1024); } while (0)
#define PG8_LDB(dst, b, h) do { _Pragma("unroll") for (int n = 0; n < 2; ++n) _Pragma("unroll") for (int k = 0; k < 2; ++k) dst[n][k] = *(const PG8_LAS bf16x8*)(lds + PG8_SB(b, h) + boff + n * 2048 + k * 1024); } while (0)
#define PG8_MMA(ai, bj, At, Bt) do { __builtin_amdgcn_s_setprio(1); _Pragma("unroll") for (int m = 0; m < 4; ++m) _Pragma("unroll") for (int n = 0; n < 2; ++n) _Pragma("unroll") for (int k = 0; k < 2; ++k) \
        acc[ai][bj][m][n] = __builtin_amdgcn_mfma_f32_16x16x32_bf16(Bt[n][k], At[m][k], acc[ai][bj][m][n], 0, 0, 0); __builtin_amdgcn_s_setprio(0); } while (0)
#define PG8_WAIT_V(n) asm volatile("s_waitcnt vmcnt(" #n ")" ::: "memory")
#define PG8_WAIT_L(n) asm volatile("s_waitcnt lgkmcnt(" #n ")" ::: "memory")
#define PG8_BAR __builtin_amdgcn_s_barrier()
#define PG8_SCHED __builtin_amdgcn_sched_barrier(0)
    Unit cur, nxt; int ui = 0;
    if (!S.next(0, cur)) return;
    f32x4 acc[2][2][4][2];
#pragma unroll
    for (int a = 0; a < 2; ++a)
#pragma unroll
        for (int b = 0; b < 2; ++b)
#pragma unroll
            for (int m = 0; m < 4; ++m)
#pragma unroll
                for (int n = 0; n < 2; ++n) acc[a][b][m][n] = (f32x4){0.f, 0.f, 0.f, 0.f};
    bf16x8 At[4][2], B0[2][2], B1[2][2];
    const char* cA = (const char*)g.A + (size_t)cur.pm * tstep; const char* cB = (const char*)g.Bt + (size_t)cur.pn * tstep;
    S.a_ready(cur);
    if constexpr (SP2) {
        PG8_STAGE(PG8_SB(0, 0), cB, voffB); PG8_STAGE(PG8_SB(0, 1), cB + hstep, voffB); PG8_STAGE(PG8_SA(0, 0), cA, voffA); PG8_STAGE(PG8_SA(0, 1), cA + hstep, voffA);
        if (wr == 1) PG8_BAR;
        PG8_WAIT_V(2); PG8_BAR;
        PG8_STAGE(PG8_SB(1, 0), cB + kstep, voffB); PG8_STAGE(PG8_SA(1, 0), cA + kstep, voffA); PG8_STAGE(PG8_SB(1, 1), cB + hstep + kstep, voffB);
        PG8_WAIT_V(6); PG8_BAR;
    } else {
        PG8_STAGE(PG8_SB(0, 0), cB, voffB); PG8_STAGE(PG8_SA(0, 0), cA, voffA); PG8_STAGE(PG8_SB(0, 1), cB + hstep, voffB); PG8_STAGE(PG8_SA(0, 1), cA + hstep, voffA);
        if (wr == 1) PG8_BAR;
        PG8_WAIT_V(4); PG8_BAR;
        PG8_STAGE(PG8_SB(1, 0), cB + kstep, voffB); PG8_STAGE(PG8_SA(1, 0), cA + kstep, voffA); PG8_STAGE(PG8_SB(1, 1), cB + hstep + kstep, voffB);
        PG8_WAIT_V(6); PG8_BAR;
    }
    for (;;) {
        const bool has_next = S.next(ui + 1, nxt);
        const char* nA = has_next ? (const char*)g.A + (size_t)nxt.pm * tstep : cA; const char* nB = has_next ? (const char*)g.Bt + (size_t)nxt.pn * tstep : cB;
        for (int t = 0; t < nt; t += 2) {
            const bool last = (t == nt - 2);
            const char* a1 = cA + (size_t)(t + 1) * kstep;
            const char* a2 = last ? nA : cA + (size_t)(t + 2) * kstep; const char* b2 = last ? nB : cB + (size_t)(t + 2) * kstep;
            const char* a3 = a2 + kstep; const char* b3 = b2 + kstep;
            if (last && has_next) S.a_ready(nxt);
            if constexpr (SP2) {
            PG8_LDB(B0, 0, 0); PG8_LDB(B1, 0, 1); PG8_SCHED; PG8_LDA(At, 0, 0); PG8_STAGE(PG8_SA(1, 1), a1 + hstep, voffA);
            PG8_WAIT_V(8); PG8_WAIT_L(0); PG8_BAR; PG8_MMA(0, 0, At, B0); PG8_MMA(0, 1, At, B1); PG8_BAR; PG8_SCHED;
            PG8_LDA(At, 0, 1); PG8_STAGE(PG8_SB(0, 0), b2, voffB); PG8_STAGE(PG8_SB(0, 1), b2 + hstep, voffB); PG8_STAGE(PG8_SA(0, 0), a2, voffA);
            PG8_WAIT_V(8); PG8_WAIT_L(0); PG8_BAR; PG8_MMA(1, 0, At, B0); PG8_MMA(1, 1, At, B1); PG8_BAR; PG8_SCHED;
            PG8_LDB(B0, 1, 0); PG8_LDB(B1, 1, 1); PG8_SCHED; PG8_LDA(At, 1, 0); PG8_STAGE(PG8_SA(0, 1), a2 + hstep, voffA);
            PG8_WAIT_V(8); PG8_WAIT_L(0); PG8_BAR; PG8_MMA(0, 0, At, B0); PG8_MMA(0, 1, At, B1); PG8_BAR; PG8_SCHED;
            PG8_LDA(At, 1, 1); PG8_STAGE(PG8_SB(1, 0), b3, voffB); PG8_STAGE(PG8_SB(1, 1), b3 + hstep, voffB); PG8_STAGE(PG8_SA(1, 0), a3, voffA);
            PG8_WAIT_V(8); PG8_WAIT_L(0); PG8_BAR; PG8_MMA(1, 0, At, B0); PG8_MMA(1, 1, At, B1); PG8_BAR; PG8_SCHED;
            } else {
            PG8_LDB(B0, 0, 0); PG8_SCHED; PG8_LDA(At, 0, 0); PG8_STAGE(PG8_SA(1, 1), a1 + hstep, voffA);
            PG8_WAIT_L(8); PG8_BAR; PG8_WAIT_L(0); PG8_MMA(0, 0, At, B0); PG8_BAR; PG8_SCHED;
            PG8_LDB(B1, 0, 1); PG8_STAGE(PG8_SB(0, 0), b2, voffB);
            PG8_BAR; PG8_WAIT_L(0); PG8_MMA(0, 1, At, B1); PG8_BAR;
            PG8_LDA(At, 0, 1); PG8_STAGE(PG8_SA(0, 0), a2, voffA);
            PG8_BAR; PG8_WAIT_L(0); PG8_MMA(1, 0, At, B0); PG8_BAR; PG8_SCHED;
            PG8_STAGE(PG8_SB(0, 1), b2 + hstep, voffB);
            PG8_WAIT_V(6); PG8_BAR; PG8_MMA(1, 1, At, B1); PG8_BAR;
            PG8_LDB(B0, 1, 0); PG8_SCHED; PG8_LDA(At, 1, 0); PG8_STAGE(PG8_SA(0, 1), a2 + hstep, voffA);
            PG8_WAIT_L(8); PG8_BAR; PG8_WAIT_L(0); PG8_MMA(0, 0, At, B0); PG8_BAR; PG8_SCHED;
            PG8_LDB(B1, 1, 1); PG8_STAGE(PG8_SB(1, 0), b3, voffB);
            PG8_BAR; PG8_WAIT_L(0); PG8_MMA(0, 1, At, B1); PG8_BAR;
            PG8_LDA(At, 1, 1); PG8_STAGE(PG8_SA(1, 0), a3, voffA);
            PG8_BAR; PG8_WAIT_L(0); PG8_MMA(1, 0, At, B0); PG8_BAR; PG8_SCHED;
            PG8_STAGE(PG8_SB(1, 1), b3 + hstep, voffB);
            PG8_WAIT_V(6); PG8_BAR; PG8_MMA(1, 1, At, B1); PG8_BAR;
            }
        }
        if constexpr (ALIGN_EPI) { if (wr == 0) PG8_BAR; }
        if constexpr (!Epi::AFTER_DRAIN) { E(acc, cur, wr, wc, fr, fq); S.done(cur); }
        if (!has_next) break;
#pragma unroll
        for (int a = 0; a < 2; ++a)
#pragma unroll
            for (int b = 0; b < 2; ++b)
#pragma unroll
                for (int m = 0; m < 4; ++m)
#pragma unroll
                    for (int n = 0; n < 2; ++n) acc[a][b][m][n] = (f32x4){0.f, 0.f, 0.f, 0.f};
        cur = nxt; cA = nA; cB = nB; ++ui;
        if constexpr (ALIGN_EPI) { if (wr == 1) PG8_BAR; }
    }
    PG8_WAIT_V(0);
    if constexpr (!ALIGN_EPI) { if (wr == 0) PG8_BAR; }
    PG8_BAR;
    if constexpr (Epi::AFTER_DRAIN) { E.fused(acc, cur, wr, wc, fr, fq, lds, wid, lane); S.done(cur); }
#undef PG8_SA
#undef PG8_SB
#undef PG8_STAGE
#undef PG8_LDA
#undef PG8_LDB
#undef PG8_MMA
#undef PG8_WAIT_V
#undef PG8_WAIT_L
#undef PG8_BAR
#undef PG8_SCHED
}
}
namespace pg8 {
template <class Epi, class Sched, bool ALIGN_EPI = false, bool SP2 = false>
__device__ __forceinline__ void gemm_phase_gather(PG8_LAS unsigned char* lds, const Gemm g, const Sched& S, const Epi& E, const int* __restrict__ idx) {
    const int tid = threadIdx.x, wid = __builtin_amdgcn_readfirstlane(tid >> 6), lane = tid & 63, wr = wid >> 2, wc = wid & 3, fr = lane & 15, fq = lane >> 4;
    const int K = g.K, nt = K / BK;
    unsigned voffB[2]; int RA[2], CA[2];
#pragma unroll
    for (int i = 0; i < 2; ++i) { int R, C; stage_rc(tid * 16 + i * 8192, R, C); const int Rb = Epi::PERM ? ((R & ~31) + perm32(R & 31)) : R;
        RA[i] = R; CA[i] = C; voffB[i] = (unsigned)(Rb * K + C) * 2u; }
    unsigned vA[2][2], nvA[2][2];
#define PG8_GOFF(dst, pm) do { _Pragma("unroll") for (int _h = 0; _h < 2; ++_h) _Pragma("unroll") for (int _i = 0; _i < 2; ++_i) { const int _r = (pm) * 256 + _h * 128 + RA[_i]; \
        dst[_h][_i] = (unsigned)((((_r >> 9) & 3) * 4096 + idx[_r]) * K + CA[_i]) * 2u; } } while (0)
    const size_t kstep = (size_t)(BK * 2);
    const size_t hstep = (size_t)HALF * K * 2;
    const size_t tstep = 2 * hstep;
    const unsigned ldsw = (unsigned)wid * 1024u;
    const int aoff = lds_byte(wr * 64 + fr, fq * 8), boff = lds_byte(wc * 32 + fr, fq * 8);
#define PG8_SA(b, h) (((b) * 2 + (h)) * HTB)
#define PG8_SB(b, h) ((4 + (b) * 2 + (h)) * HTB)
#define PG8_STAGE(bufoff, gbase, voff) do { _Pragma("unroll") for (int _i = 0; _i < 2; ++_i) \
        __builtin_amdgcn_global_load_lds((const unsigned*)((const char*)(gbase) + (voff)[_i]), (PG8_LAS unsigned*)(lds + (bufoff) + ldsw + _i * 8192), 16, 0, 0); } while (0)
#define PG8_LDA(dst, b, h) do { _Pragma("unroll") for (int m = 0; m < 4; ++m) _Pragma("unroll") for (int k = 0; k < 2; ++k) dst[m][k] = *(const PG8_LAS bf16x8*)(lds + PG8_SA(b, h) + aoff + m * 2048 + k * 1024); } while (0)
#define PG8_LDB(dst, b, h) do { _Pragma("unroll") for (int n = 0; n < 2; ++n) _Pragma("unroll") for (int k = 0; k < 2; ++k) dst[n][k] = *(const PG8_LAS bf16x8*)(lds + PG8_SB(b, h) + boff + n * 2048 + k * 1024); } while (0)
#define PG8_MMA(ai, bj, At, Bt) do { __builtin_amdgcn_s_setprio(1); _Pragma("unroll") for (int m = 0; m < 4; ++m) _Pragma("unroll") for (int n = 0; n < 2; ++n) _Pragma("unroll") for (int k = 0; k < 2; ++k) \
        acc[ai][bj][m][n] = __builtin_amdgcn_mfma_f32_16x16x32_bf16(Bt[n][k], At[m][k], acc[ai][bj][m][n], 0, 0, 0); __builtin_amdgcn_s_setprio(0); } while (0)
#define PG8_WAIT_V(n) asm volatile("s_waitcnt vmcnt(" #n ")" ::: "memory")
#define PG8_WAIT_L(n) asm volatile("s_waitcnt lgkmcnt(" #n ")" ::: "memory")
#define PG8_BAR __builtin_amdgcn_s_barrier()
#define PG8_SCHED __builtin_amdgcn_sched_barrier(0)
    Unit cur, nxt; int ui = 0;
    if (!S.next(0, cur)) return;
    f32x4 acc[2][2][4][2];
#pragma unroll
    for (int a = 0; a < 2; ++a)
#pragma unroll
        for (int b = 0; b < 2; ++b)
#pragma unroll
            for (int m = 0; m < 4; ++m)
#pragma unroll
                for (int n = 0; n < 2; ++n) acc[a][b][m][n] = (f32x4){0.f, 0.f, 0.f, 0.f};
    bf16x8 At[4][2], B0[2][2], B1[2][2];
    const char* cA = (const char*)g.A; PG8_GOFF(vA, cur.pm); const char* cB = (const char*)g.Bt + (size_t)cur.pn * tstep;
    S.a_ready(cur);
    if constexpr (SP2) {
        PG8_STAGE(PG8_SB(0, 0), cB, voffB); PG8_STAGE(PG8_SB(0, 1), cB + hstep, voffB); PG8_STAGE(PG8_SA(0, 0), cA, vA[0]); PG8_STAGE(PG8_SA(0, 1), cA, vA[1]);
        if (wr == 1) PG8_BAR;
        PG8_WAIT_V(2); PG8_BAR;
        PG8_STAGE(PG8_SB(1, 0), cB + kstep, voffB); PG8_STAGE(PG8_SA(1, 0), cA + kstep, vA[0]); PG8_STAGE(PG8_SB(1, 1), cB + hstep + kstep, voffB);
        PG8_WAIT_V(6); PG8_BAR;
    } else {
        PG8_STAGE(PG8_SB(0, 0), cB, voffB); PG8_STAGE(PG8_SA(0, 0), cA, vA[0]); PG8_STAGE(PG8_SB(0, 1), cB + hstep, voffB); PG8_STAGE(PG8_SA(0, 1), cA, vA[1]);
        if (wr == 1) PG8_BAR;
        PG8_WAIT_V(4); PG8_BAR;
        PG8_STAGE(PG8_SB(1, 0), cB + kstep, voffB); PG8_STAGE(PG8_SA(1, 0), cA + kstep, vA[0]); PG8_STAGE(PG8_SB(1, 1), cB + hstep + kstep, voffB);
        PG8_WAIT_V(6); PG8_BAR;
    }
    for (;;) {
        const bool has_next = S.next(ui + 1, nxt);
        if (has_next) { PG8_GOFF(nvA, nxt.pm); } else { nvA[0][0] = vA[0][0]; nvA[0][1] = vA[0][1]; nvA[1][0] = vA[1][0]; nvA[1][1] = vA[1][1]; } const char* nB = has_next ? (const char*)g.Bt + (size_t)nxt.pn * tstep : cB;
        for (int t = 0; t < nt; t += 2) {
            const bool last = (t == nt - 2);
            const char* a1 = cA + (size_t)(t + 1) * kstep;
            const char* a2 = cA + (last ? (size_t)0 : (size_t)(t + 2) * kstep); unsigned w2[2][2]; w2[0][0] = last ? nvA[0][0] : vA[0][0]; w2[0][1] = last ? nvA[0][1] : vA[0][1]; w2[1][0] = last ? nvA[1][0] : vA[1][0]; w2[1][1] = last ? nvA[1][1] : vA[1][1]; const char* b2 = last ? nB : cB + (size_t)(t + 2) * kstep;
            const char* a3 = a2 + kstep; const char* b3 = b2 + kstep;
            if (last && has_next) S.a_ready(nxt);
            if constexpr (SP2) {
            PG8_LDB(B0, 0, 0); PG8_LDB(B1, 0, 1); PG8_SCHED; PG8_LDA(At, 0, 0); PG8_STAGE(PG8_SA(1, 1), a1, vA[1]);
            PG8_WAIT_V(8); PG8_WAIT_L(0); PG8_BAR; PG8_MMA(0, 0, At, B0); PG8_MMA(0, 1, At, B1); PG8_BAR; PG8_SCHED;
            PG8_LDA(At, 0, 1); PG8_STAGE(PG8_SB(0, 0), b2, voffB); PG8_STAGE(PG8_SB(0, 1), b2 + hstep, voffB); PG8_STAGE(PG8_SA(0, 0), a2, w2[0]);
            PG8_WAIT_V(8); PG8_WAIT_L(0); PG8_BAR; PG8_MMA(1, 0, At, B0); PG8_MMA(1, 1, At, B1); PG8_BAR; PG8_SCHED;
            PG8_LDB(B0, 1, 0); PG8_LDB(B1, 1, 1); PG8_SCHED; PG8_LDA(At, 1, 0); PG8_STAGE(PG8_SA(0, 1), a2, w2[1]);
            PG8_WAIT_V(8); PG8_WAIT_L(0); PG8_BAR; PG8_MMA(0, 0, At, B0); PG8_MMA(0, 1, At, B1); PG8_BAR; PG8_SCHED;
            PG8_LDA(At, 1, 1); PG8_STAGE(PG8_SB(1, 0), b3, voffB); PG8_STAGE(PG8_SB(1, 1), b3 + hstep, voffB); PG8_STAGE(PG8_SA(1, 0), a3, w2[0]);
            PG8_WAIT_V(8); PG8_WAIT_L(0); PG8_BAR; PG8_MMA(1, 0, At, B0); PG8_MMA(1, 1, At, B1); PG8_BAR; PG8_SCHED;
            } else {
            PG8_LDB(B0, 0, 0); PG8_SCHED; PG8_LDA(At, 0, 0); PG8_STAGE(PG8_SA(1, 1), a1, vA[1]);
            PG8_WAIT_L(8); PG8_BAR; PG8_WAIT_L(0); PG8_MMA(0, 0, At, B0); PG8_BAR; PG8_SCHED;
            PG8_LDB(B1, 0, 1); PG8_STAGE(PG8_SB(0, 0), b2, voffB);
            PG8_BAR; PG8_WAIT_L(0); PG8_MMA(0, 1, At, B1); PG8_BAR;
            PG8_LDA(At, 0, 1); PG8_STAGE(PG8_SA(0, 0), a2, w2[0]);
            PG8_BAR; PG8_WAIT_L(0); PG8_MMA(1, 0, At, B0); PG8_BAR; PG8_SCHED;
            PG8_STAGE(PG8_SB(0, 1), b2 + hstep, voffB);
            PG8_WAIT_V(6); PG8_BAR; PG8_MMA(1, 1, At, B1); PG8_BAR;
            PG8_LDB(B0, 1, 0); PG8_SCHED; PG8_LDA(At, 1, 0); PG8_STAGE(PG8_SA(0, 1), a2, w2[1]);
            PG8_WAIT_L(8); PG8_BAR; PG8_WAIT_L(0); PG8_MMA(0, 0, At, B0); PG8_BAR; PG8_SCHED;
            PG8_LDB(B1, 1, 1); PG8_STAGE(PG8_SB(1, 0), b3, voffB);
            PG8_BAR; PG8_WAIT_L(0); PG8_MMA(0, 1, At, B1); PG8_BAR;
            PG8_LDA(At, 1, 1); PG8_STAGE(PG8_SA(1, 0), a3, w2[0]);
            PG8_BAR; PG8_WAIT_L(0); PG8_MMA(1, 0, At, B0); PG8_BAR; PG8_SCHED;
            PG8_STAGE(PG8_SB(1, 1), b3 + hstep, voffB);
            PG8_WAIT_V(6); PG8_BAR; PG8_MMA(1, 1, At, B1); PG8_BAR;
            }
        }
        if constexpr (ALIGN_EPI) { if (wr == 0) PG8_BAR; }
        if constexpr (!Epi::AFTER_DRAIN) { E(acc, cur, wr, wc, fr, fq); S.done(cur); }
        if (!has_next) break;
#pragma unroll
        for (int a = 0; a < 2; ++a)
#pragma unroll
            for (int b = 0; b < 2; ++b)
#pragma unroll
                for (int m = 0; m < 4; ++m)
#pragma unroll
                    for (int n = 0; n < 2; ++n) acc[a][b][m][n] = (f32x4){0.f, 0.f, 0.f, 0.f};
        cur = nxt; cB = nB; ++ui; vA[0][0] = nvA[0][0]; vA[0][1] = nvA[0][1]; vA[1][0] = nvA[1][0]; vA[1][1] = nvA[1][1];
        if constexpr (ALIGN_EPI) { if (wr == 1) PG8_BAR; }
    }
    PG8_WAIT_V(0);
    if constexpr (!ALIGN_EPI) { if (wr == 0) PG8_BAR; }
    PG8_BAR;
    if constexpr (Epi::AFTER_DRAIN) { E.fused(acc, cur, wr, wc, fr, fq, lds, wid, lane); S.done(cur); }
#undef PG8_SA
#undef PG8_SB
#undef PG8_STAGE
#undef PG8_LDA
#undef PG8_LDB
#undef PG8_MMA
#undef PG8_WAIT_V
#undef PG8_WAIT_L
#undef PG8_BAR
#undef PG8_SCHED
#undef PG8_GOFF
}
}

#ifndef DBG_NOMIX
#define DBG_NOMIX 0
#endif
#ifndef DBG_NOMOE
#define DBG_NOMOE 0
#endif
#ifndef DBG_NOPOS
#define DBG_NOPOS 0
#endif
#ifndef DBG_HTCONST
#define DBG_HTCONST 0
#endif
#ifndef DBG_GLA_K
#define DBG_GLA_K 1.0f
#endif
#ifndef DBG_MOE_K
#define DBG_MOE_K 1.0f
#endif
#ifndef MK_SINGLE
#define MK_SINGLE 0
#endif
#define GAS __attribute__((address_space(1)))
#define LAS __attribute__((address_space(3)))
typedef unsigned short bf16;
typedef float f32x4 __attribute__((ext_vector_type(4)));
typedef float f32x16 __attribute__((ext_vector_type(16)));
typedef short bf16x8 __attribute__((ext_vector_type(8)));
typedef unsigned v4u __attribute__((ext_vector_type(4)));
typedef unsigned v2u __attribute__((ext_vector_type(2)));
typedef GAS unsigned gu32;

constexpr int NWAVES = 8, NTHR = 512;
constexpr int NB = 4, SEQ = 4096, DM = 1024, CTXL = 256;
constexpr int MX = NB * SEQ, MC = NB * CTXL, MT = MX + MC;
constexpr int NIN = 3328, NQ = 1536, DIN = 3104;
constexpr int NE = 16, CAP = 512;
constexpr int NCH = 68;
constexpr int NPH = 12;
constexpr float EPS = 1e-6f;

constexpr size_t MiB = 1u << 20;
constexpr size_t WS_CTL = 0, CTL_BYTES = 65536;
constexpr int CW_CNT_D = 8192, CW_CNT_GU = 8192 + 64;
constexpr size_t WS_MOD = 1 * MiB, WS_POS = 1 * MiB + 256 * 1024, WS_DEC = 2 * MiB, WS_AFF = 3 * MiB, WS_SLOT = 4 * MiB, WS_SELT = 5 * MiB, WS_SELV = 5 * MiB + 256 * 1024;
constexpr size_t WS_UCTX = 6 * MiB, WS_AFB = 10 * MiB, WS_WIN = 13 * MiB, WS_WOUT = 20 * MiB;
constexpr size_t WS_R1 = 22 * MiB, WS_R2 = 56 * MiB, WS_R3 = 107 * MiB, WS_R4 = 203 * MiB, WS_R5 = 235 * MiB, WS_R6 = 267 * MiB, WS_END = 299 * MiB;
constexpr size_t WS_AIN = WS_R1, WS_ZT = 155 * MiB, WS_HN = WS_R1;
constexpr size_t WS_QKVG = WS_R2;
constexpr size_t WS_HYT = WS_R3, WS_WD = 171 * MiB;
constexpr size_t WS_WGU = WS_R5;
constexpr size_t WS_HID = WS_R2, WS_YSLAB = WS_R4;
constexpr size_t WS_HT = WS_R4, WS_AOUT = WS_R4;
constexpr size_t WS_SPREV = WS_R1;
constexpr int LDS_BYTES = 144 * 1024;
constexpr int LDS_MISC = LDS_BYTES - 256;

struct Args { const float* in[29]; float* out; unsigned char* ws; int ph_lo, ph_hi; };

#define LDS_WAIT() asm volatile("s_waitcnt lgkmcnt(0)" ::: "memory")
#define VM_WAIT() asm volatile("s_waitcnt vmcnt(0)" ::: "memory")
__device__ __forceinline__ unsigned f2bf(float f) { unsigned u = __float_as_uint(f); return (u + 0x7fffu + ((u >> 16) & 1u)) >> 16; }
__device__ __forceinline__ unsigned pk2(float lo, float hi) { return pg8::cvt_pk_bf16(lo, hi); }
__device__ __forceinline__ float bflo(unsigned w) { return __uint_as_float(w << 16); }
__device__ __forceinline__ float bfhi(unsigned w) { return __uint_as_float(w & 0xffff0000u); }
template <int CTRL> __device__ __forceinline__ float dpp_f(float v) { return __builtin_bit_cast(float, __builtin_amdgcn_update_dpp(0, __builtin_bit_cast(int, v), CTRL, 0xf, 0xf, false)); }
__device__ __forceinline__ void swap16(float& a, float& b) { asm("v_nop\n\tv_nop\n\tv_permlane16_swap_b32 %0, %1" : "+v"(a), "+v"(b)); }
__device__ __forceinline__ void swap32(float& a, float& b) { asm("v_nop\n\tv_nop\n\tv_permlane32_swap_b32 %0, %1" : "+v"(a), "+v"(b)); }
__device__ __forceinline__ float row_allsum(float v) { v += dpp_f<0x128>(v); v += dpp_f<0x124>(v); v += dpp_f<0x122>(v); v += dpp_f<0x121>(v); return v; }
__device__ __forceinline__ float x16_sum(float v) { float a = v, b = v; swap16(a, b); return a + b; }
__device__ __forceinline__ float x32_sum(float v) { float a = v, b = v; swap32(a, b); return a + b; }
__device__ __forceinline__ float x16_max(float v) { float a = v, b = v; swap16(a, b); return fmaxf(a, b); }
__device__ __forceinline__ float x32_max(float v) { float a = v, b = v; swap32(a, b); return fmaxf(a, b); }
__device__ __forceinline__ float wave_sum(float v) { return x32_sum(x16_sum(row_allsum(v))); }
__device__ __forceinline__ float silu_f(float v) { return v * __builtin_amdgcn_rcpf(1.f + __expf(-v)); }
__device__ __forceinline__ float logsig_f(float x) { return fminf(x, 0.f) - __logf(1.0f + __expf(-fabsf(x))); }

#define XB_TMO      128
#define XB_XCNT(j)  (256  + 64 * (j))
#define XB_XSUB(j)  (1280 + 64 * (j))
#define XB_XGEN(j)  (2304 + 64 * (j))
#define XB_TOP      3328
#define XB_TOPGEN   3392
#define XCD_BAR_WORDS 3456
#define XB_SPIN_CAP (1u << 22)
__device__ __forceinline__ unsigned xb_ld(unsigned* p)              { return __hip_atomic_load(p, __ATOMIC_RELAXED, __HIP_MEMORY_SCOPE_AGENT); }
__device__ __forceinline__ unsigned xb_add(unsigned* p, unsigned v) { return __hip_atomic_fetch_add(p, v, __ATOMIC_RELAXED, __HIP_MEMORY_SCOPE_AGENT); }
__device__ __forceinline__ unsigned xb_xcc_id() { return (unsigned)__builtin_amdgcn_s_getreg((3 << 11) | 20) & 0xFu; }
#define XB_SPIN(cond, bar) do { unsigned _sp = 0; while (cond) { __builtin_amdgcn_s_sleep(1); \
    if ((++_sp & 255u) == 0u) { if (xb_ld(&(bar)[XB_TMO])) break; if (_sp > XB_SPIN_CAP) { atomicAdd(&(bar)[XB_TMO], 1u); break; } } } } while (0)
struct XcdBarrier { unsigned* bar; unsigned x; volatile LAS unsigned* st; };
__device__ __forceinline__ XcdBarrier xcd_barrier_post(unsigned* bar, volatile LAS unsigned* st) {
    XcdBarrier b; b.bar = bar; b.x = xb_xcc_id(); b.st = st;
    if (threadIdx.x == 0) (void)xb_add(&bar[XB_XCNT(b.x)], 1u);
    return b;
}
__device__ __forceinline__ void xcd_barrier_complete(unsigned* bar, unsigned x, unsigned& nloc, unsigned& nx) {
    const unsigned G = gridDim.x * gridDim.y * gridDim.z;
    unsigned sum, cnt, mine, sp = 0u;
    for (;;) {
        sum = 0u; cnt = 0u; mine = 0u;
#pragma unroll
        for (unsigned j = 0; j < 16; ++j) { const unsigned c = xb_ld(&bar[XB_XCNT(j)]); sum += c; cnt += (c > 0u) ? 1u : 0u; mine = (j == x) ? c : mine; }
        if (sum == G) break;
        __builtin_amdgcn_s_sleep(1);
        if ((++sp & 255u) == 0u) { if (xb_ld(&bar[XB_TMO])) break; if (sp > XB_SPIN_CAP) { atomicAdd(&bar[XB_TMO], 1u); break; } }
    }
    nloc = mine > 0u ? mine : 1u; nx = cnt > 0u ? cnt : 1u;
}
__device__ __forceinline__ void xcd_barrier(const XcdBarrier& b) {
    asm volatile("s_waitcnt vmcnt(0)" ::: "memory");
    __syncthreads();
    if (threadIdx.x == 0) {
        unsigned* bar = b.bar;
        __builtin_amdgcn_s_waitcnt(0);
        unsigned nloc = b.st[0], nx = b.st[1];
        if (nloc == 0u) { xcd_barrier_complete(bar, b.x, nloc, nx); b.st[0] = nloc; b.st[1] = nx; }
        const unsigned old = xb_add(&bar[XB_XSUB(b.x)], 1u);
        const unsigned gen = old / nloc;
        if (old + 1u == (gen + 1u) * nloc) {
            __builtin_amdgcn_fence(__ATOMIC_RELEASE, "agent");
            asm volatile("s_waitcnt vmcnt(0)" ::: "memory");
            const unsigned og = xb_add(&bar[XB_TOP], 1u);
            const unsigned tg = og / nx;
            if (og + 1u == (tg + 1u) * nx) xb_add(&bar[XB_TOPGEN], 1u);
            else XB_SPIN(xb_ld(&bar[XB_TOPGEN]) == tg, bar);
            __builtin_amdgcn_fence(__ATOMIC_ACQUIRE, "agent");
            xb_add(&bar[XB_XGEN(b.x)], 1u);
            asm volatile("s_waitcnt vmcnt(0)" ::: "memory");
        } else {
            XB_SPIN(xb_ld(&bar[XB_XGEN(b.x)]) == gen, bar);
            __builtin_amdgcn_fence(__ATOMIC_ACQUIRE, "agent");
            asm volatile("s_waitcnt vmcnt(0)" ::: "memory");
        }
    }
    __syncthreads();
}

constexpr int TILE_AIN = (int)(WS_AIN / (512 * 1024)), TILE_WIN = (int)(WS_WIN / (512 * 1024));
struct InSched {
    int G, c, part;
    __device__ void init(int G_, int c_, int part_) { G = G_; c = c_; part = part_; }
    __device__ static void qg_unit(int qg, pg8::Unit& u) { const int t = qg >> 6; u.pm = TILE_AIN + (qg & 63); u.pn = TILE_WIN + ((t == 0) ? 0 : 3 + t); }
    __device__ bool next(int i, pg8::Unit& u) const {
        const int L = i * G + c;
        if (part) { const int qg = 112 + L; if (qg >= 192) return false; qg_unit(qg, u); return true; }
        if (L < 384) { u.pm = TILE_WIN + 6 + (L >> 6); u.pn = TILE_AIN + (L & 63); return true; }
        if (L < 640) { const int l = L - 384, q = l >> 6; u.pm = TILE_AIN + (l & 63); u.pn = TILE_WIN + ((q == 3) ? 12 : (1 + q)); return true; }
        if (L < 656) { const int jx = L - 640, q = jx >> 2; u.pm = TILE_AIN + 64 + (jx & 3); u.pn = TILE_WIN + ((q == 3) ? 12 : (1 + q)); return true; }
        if (L >= 768) return false;
        qg_unit(L - 656, u); return true;
    }
    __device__ __forceinline__ void a_ready(const pg8::Unit&) const {}
    __device__ __forceinline__ void done(const pg8::Unit&) const {}
};
template <int NT> struct MoeSched {
    int G, c;
    __device__ void init(int G_, int c_) { G = G_; c = c_; }
    __device__ bool next(int i, pg8::Unit& u) const {
        const int L = i * G + c; if (L >= NE * 8 * NT) return false;
        const int e = L / (8 * NT), l = L % (8 * NT), x = l & 7, y = l >> 3;
        constexpr int HN = NT / 2;
        const int pm = 2 * (x >> 1) + (y / HN), pn = HN * (x & 1) + (y % HN);
        u.pm = e * 8 + pm; u.pn = e * NT + pn; return true;
    }
    __device__ __forceinline__ void a_ready(const pg8::Unit&) const {}
    __device__ __forceinline__ void done(const pg8::Unit&) const {}
};

struct EpiIn {
    static constexpr bool PERM = true, AFTER_DRAIN = false;
    bf16* qkvg; bf16* hyT; float* afb;
    __device__ __forceinline__ void operator()(const f32x4 (&acc)[2][2][4][2], const pg8::Unit& u, int wr, int wc, int fr, int fq) const {
        if (u.pm < TILE_AIN) {
            const int ch0 = (u.pm - TILE_WIN - 6) * 256 + wr * 64 + fr, mt = u.pn - TILE_AIN, b = mt >> 4, t0 = (mt & 15) * 256 + wc * 32 + 8 * fq;
#pragma unroll
            for (int ai = 0; ai < 2; ++ai)
#pragma unroll
                for (int m = 0; m < 4; ++m) { bf16* rowp = hyT + ((size_t)b * 1536 + ch0 + ai * 128 + m * 16) * SEQ + t0;
#pragma unroll
                    for (int bj = 0; bj < 2; ++bj) { const f32x4 v0 = acc[ai][bj][m][0], v1 = acc[ai][bj][m][1];
                        v4u w; w.x = pk2(v0[0], v0[1]); w.y = pk2(v0[2], v0[3]); w.z = pk2(v1[0], v1[1]); w.w = pk2(v1[2], v1[3]);
                        *(v4u*)(rowp + bj * 128) = w; } }
            return;
        }
        const int pm = u.pm - TILE_AIN, pn = u.pn - TILE_WIN;
        const int row0 = pm * 256 + wr * 64 + fr;
        if (pn < 6) {
            const float sc = (pn == 0) ? 0.125f : 1.f;
            const int col0 = pn * 256 + wc * 32 + 8 * fq;
#pragma unroll
            for (int ai = 0; ai < 2; ++ai)
#pragma unroll
                for (int m = 0; m < 4; ++m) { bf16* rowp = qkvg + (size_t)(row0 + ai * 128 + m * 16) * NQ + col0;
#pragma unroll
                    for (int bj = 0; bj < 2; ++bj) { const f32x4 v0 = acc[ai][bj][m][0] * sc, v1 = acc[ai][bj][m][1] * sc;
                        v4u w; w.x = pk2(v0[0], v0[1]); w.y = pk2(v0[2], v0[3]); w.z = pk2(v1[0], v1[1]); w.w = pk2(v1[2], v1[3]);
                        *(v4u*)(rowp + bj * 128) = w; } }
        } else {
            if (wc != 0) return;
#pragma unroll
            for (int ai = 0; ai < 2; ++ai)
#pragma unroll
                for (int m = 0; m < 4; ++m) { float* rowp = afb + (size_t)(row0 + ai * 128 + m * 16) * 32 + 8 * fq;
                    *(f32x4*)(rowp) = acc[ai][0][m][0]; *(f32x4*)(rowp + 4) = acc[ai][0][m][1]; }
        }
    }
};
struct EpiOut {
    static constexpr bool PERM = false, AFTER_DRAIN = false;
    const float* __restrict__ x; const float* __restrict__ postab; const float* __restrict__ modr; float* __restrict__ x1;
    __device__ __forceinline__ void operator()(const f32x4 (&acc)[2][2][4][2], const pg8::Unit& u, int wr, int wc, int fr, int fq) const {
        const int row0 = u.pm * 256 + wr * 64 + fr, col0 = u.pn * 256 + wc * 32 + 4 * fq;
        const int b = row0 >> 12;
        f32x4 gv[2][2];
#pragma unroll
        for (int bj = 0; bj < 2; ++bj)
#pragma unroll
            for (int n = 0; n < 2; ++n) gv[bj][n] = *(const f32x4*)(modr + b * 6144 + 2048 + col0 + bj * 128 + n * 16);
#pragma unroll
        for (int ai = 0; ai < 2; ++ai)
#pragma unroll
            for (int m = 0; m < 4; ++m) { const int r = row0 + ai * 128 + m * 16; const int t = r & 4095, rr = t >> 6, cc = t & 63;
                f32x4 xv[2][2], pv[2][2];
#pragma unroll
                for (int bj = 0; bj < 2; ++bj)
#pragma unroll
                    for (int n = 0; n < 2; ++n) { const int c = col0 + bj * 128 + n * 16;
                        xv[bj][n] = *(const f32x4*)(x + (size_t)r * DM + c);
                        pv[bj][n] = *(const f32x4*)(postab + ((c < 512) ? rr * 512 + c : cc * 512 + c - 512)); }
#pragma unroll
                for (int bj = 0; bj < 2; ++bj)
#pragma unroll
                    for (int n = 0; n < 2; ++n) { const int c = col0 + bj * 128 + n * 16;
                        *(f32x4*)(x1 + (size_t)r * DM + c) = xv[bj][n] + (DBG_NOPOS ? pv[bj][n] * 0.f : pv[bj][n]) + (DBG_NOMIX ? gv[bj][n] * 0.f : gv[bj][n] * acc[ai][bj][m][n]); } }
    }
};
struct EpiGU {
    static constexpr bool PERM = true, AFTER_DRAIN = false;
    bf16* hid;
    __device__ __forceinline__ void operator()(const f32x4 (&acc)[2][2][4][2], const pg8::Unit& u, int wr, int wc, int fr, int fq) const {
        const int row0 = u.pm * 256 + wr * 64 + fr, col0 = (u.pn & 7) * 128 + wc * 32 + 8 * fq;
#pragma unroll
        for (int ai = 0; ai < 2; ++ai)
#pragma unroll
            for (int m = 0; m < 4; ++m) { bf16* rowp = hid + (size_t)(row0 + ai * 128 + m * 16) * DM + col0;
                float o[8];
#pragma unroll
                for (int n = 0; n < 2; ++n)
#pragma unroll
                    for (int j = 0; j < 4; ++j) o[n * 4 + j] = silu_f(acc[ai][0][m][n][j]) * acc[ai][1][m][n][j];
                v4u w; w.x = pk2(o[0], o[1]); w.y = pk2(o[2], o[3]); w.z = pk2(o[4], o[5]); w.w = pk2(o[6], o[7]);
                *(v4u*)rowp = w; }
    }
};
struct EpiDown {
    static constexpr bool PERM = true, AFTER_DRAIN = false;
    bf16* __restrict__ ys; const float* __restrict__ selv;
    __device__ __forceinline__ void operator()(const f32x4 (&acc)[2][2][4][2], const pg8::Unit& u, int wr, int wc, int fr, int fq) const {
        const int row0 = u.pm * 256 + wr * 64 + fr, col0 = (u.pn & 3) * 256 + wc * 32 + 8 * fq;
        float scv[2][4];
#pragma unroll
        for (int ai = 0; ai < 2; ++ai)
#pragma unroll
            for (int m = 0; m < 4; ++m) scv[ai][m] = selv[row0 + ai * 128 + m * 16];
#pragma unroll
        for (int ai = 0; ai < 2; ++ai)
#pragma unroll
            for (int m = 0; m < 4; ++m) { const int r = row0 + ai * 128 + m * 16; const float sc = scv[ai][m]; bf16* rowp = ys + (size_t)r * DM + col0;
#pragma unroll
                for (int bj = 0; bj < 2; ++bj) { const f32x4 v0 = acc[ai][bj][m][0] * sc, v1 = acc[ai][bj][m][1] * sc;
                    v4u w; w.x = pk2(v0[0], v0[1]); w.y = pk2(v0[2], v0[3]); w.z = pk2(v1[0], v1[1]); w.w = pk2(v1[2], v1[3]);
                    *(v4u*)(rowp + bj * 128) = w; } }
    }
};

__device__ __forceinline__ void transpose_item(const float* W, int ldw, int k0, int nsrc0, bf16* WT, int K, int drow0, LAS float* scr, int lane, bool zero) {
    float tv[32];
#pragma unroll
    for (int i = 0; i < 32; ++i) { const int kk = 2 * i + (lane >> 5); tv[i] = zero ? 0.f : W[(size_t)(k0 + kk) * ldw + nsrc0 + (lane & 31)]; }
#pragma unroll
    for (int i = 0; i < 32; ++i) { const int kk = 2 * i + (lane >> 5); scr[kk * 33 + (lane & 31)] = tv[i]; }
    LDS_WAIT();
    const int c = lane & 7;
#pragma unroll
    for (int j = 0; j < 4; ++j) { const int n = (lane >> 3) + 8 * j; const LAS float* s = scr + (8 * c) * 33 + n;
        v4u o; o.x = pk2(s[0 * 33], s[1 * 33]); o.y = pk2(s[2 * 33], s[3 * 33]); o.z = pk2(s[4 * 33], s[5 * 33]); o.w = pk2(s[6 * 33], s[7 * 33]);
        *(v4u*)(WT + (size_t)(drow0 + n) * K + k0 + 8 * c) = o; }
    LDS_WAIT();
}

__device__ __forceinline__ void split8(const float (&x)[8], pg8::bf16x8& hi, pg8::bf16x8& lo) {
    v4u h, l;
#pragma unroll
    for (int e = 0; e < 4; ++e) { const unsigned w = pk2(x[2 * e], x[2 * e + 1]); h[e] = w; l[e] = pk2(x[2 * e] - bflo(w), x[2 * e + 1] - bfhi(w)); }
    hi = __builtin_bit_cast(pg8::bf16x8, h); lo = __builtin_bit_cast(pg8::bf16x8, l);
}
__device__ __forceinline__ f32x4 mfma3(pg8::bf16x8 ah, pg8::bf16x8 al, pg8::bf16x8 bh, pg8::bf16x8 bl, f32x4 acc) {
    acc = __builtin_amdgcn_mfma_f32_16x16x32_bf16(al, bh, acc, 0, 0, 0);
    acc = __builtin_amdgcn_mfma_f32_16x16x32_bf16(ah, bl, acc, 0, 0, 0);
    return __builtin_amdgcn_mfma_f32_16x16x32_bf16(ah, bh, acc, 0, 0, 0);
}
__device__ __forceinline__ void sine_layer(const LAS float* in, const LAS float* w, LAS float* out, const float* bias, const float* freq, int wave, int lane) {
    const int m16 = lane & 15, kg = lane >> 4, mt = wave >> 1, nt0 = (wave & 1) * 2;
    pg8::bf16x8 Ah[2], Al[2];
#pragma unroll
    for (int s = 0; s < 2; ++s) { const LAS float* hp = in + (16 * mt + m16) * 68 + 32 * s + 8 * kg; const f32x4 x = *(const LAS f32x4*)hp, y = *(const LAS f32x4*)(hp + 4);
        const float v[8] = {x[0], x[1], x[2], x[3], y[0], y[1], y[2], y[3]}; split8(v, Ah[s], Al[s]); }
#pragma unroll
    for (int t = 0; t < 2; ++t) { const int n = (nt0 + t) * 16 + m16; f32x4 acc = (f32x4){0.f, 0.f, 0.f, 0.f};
#pragma unroll
        for (int s = 0; s < 2; ++s) { float v[8];
#pragma unroll
            for (int jj = 0; jj < 8; ++jj) v[jj] = w[(32 * s + 8 * kg + jj) * 64 + n];
            pg8::bf16x8 Bh, Bl; split8(v, Bh, Bl); acc = mfma3(Ah[s], Al[s], Bh, Bl, acc); }
        const float bn = bias[n], fn = freq[n] * 0.15915494309f;
#pragma unroll
        for (int r = 0; r < 4; ++r) out[(16 * mt + 4 * kg + r) * 68 + n] = __builtin_amdgcn_sinf(fn * (acc[r] + bn)); }
}

__device__ __forceinline__ void phase0(const Args& a, LAS unsigned char* lds) {
    int tid = threadIdx.x; const int wg = blockIdx.x, G = gridDim.x;
    asm volatile("" : "+v"(tid));
    int lane = tid & 63, wave = tid >> 6;
    unsigned char* ws = a.ws;
    for (int it = wg; it < 192; it += G) {
        LAS float* sl = (LAS float*)lds;
        LAS float* red = (LAS float*)(lds + 20480);
        const int col = it * 32 + (lane & 31), kk = wave * 2 + (lane >> 5);
        float acc[5] = {0.f, 0.f, 0.f, 0.f, 0.f};
        const float* wp = a.in[4] + col;
        float wv[64];
#pragma unroll
        for (int j = 0; j < 64; ++j) wv[j] = wp[(size_t)(kk + 16 * j) * 6144];
        for (int i = tid; i < 5 * 1024; i += NTHR) { const int bb = i >> 10, k = i & 1023; const float v = (bb < 4) ? a.in[1][bb * 1024 + k] : a.in[3][k]; sl[i] = silu_f(v); }
        __syncthreads();
#pragma unroll
        for (int j = 0; j < 64; ++j) { const int k = kk + 16 * j;
#pragma unroll
            for (int bb = 0; bb < 5; ++bb) acc[bb] += sl[bb * 1024 + k] * wv[j]; }
#pragma unroll
        for (int bb = 0; bb < 5; ++bb) red[(kk * 5 + bb) * 32 + (lane & 31)] = acc[bb];
        __syncthreads();
        if (tid < 160) { const int bb = tid >> 5, cl = tid & 31; float s = 0.f;
#pragma unroll
            for (int q = 0; q < 16; ++q) s += red[(q * 5 + bb) * 32 + cl];
            ((float*)(ws + WS_MOD))[bb * 6144 + it * 32 + cl] = s + a.in[5][it * 32 + cl]; }
        __syncthreads();
    }
    for (int it = wg; it < 256; it += G) {
        asm volatile("" : "+v"(tid)); lane = tid & 63; wave = tid >> 6;
        const int cg = it >> 6, i0 = (it & 63) * 64, m16 = lane & 15, kg = lane >> 4;
        LAS float* zl = (LAS float*)lds;
        LAS float* h1 = (LAS float*)(lds + 17408);
        LAS float* h2 = (LAS float*)(lds + 2 * 17408);
        LAS float* w1l = (LAS float*)(lds + 3 * 17408);
        LAS float* w2l = (LAS float*)(lds + 3 * 17408 + 16384);
        float braw[4][2][8];
        {   const float* w3 = a.in[19] + cg * 512 + wave * 64 + m16;
#pragma unroll
            for (int nt = 0; nt < 4; ++nt)
#pragma unroll
                for (int s = 0; s < 2; ++s)
#pragma unroll
                    for (int jj = 0; jj < 8; ++jj) braw[nt][s][jj] = w3[(32 * s + 8 * kg + jj) * 2048 + nt * 16]; }
        {   float t1[8], t2[8];
#pragma unroll
            for (int q = 0; q < 8; ++q) { const int o = tid + NTHR * q; t1[q] = (o < 33 * 64) ? a.in[15][o] : 0.f; t2[q] = a.in[17][o]; }
#pragma unroll
            for (int q = 0; q < 8; ++q) { const int o = tid + NTHR * q; w1l[o] = t1[q]; w2l[o] = t2[q]; } }
#pragma unroll
        for (int q = 0; q < 8; ++q) { const int o = tid + NTHR * q, li = o >> 6, j = o & 63; const int i = i0 + li;
            const int jj = (j - 1) & 15; const float f = 1e-4f + (float)jj * ((15.0f - 1e-4f) / 15.0f); const float turns = f * ((float)i * (1.0f / 4096.0f));
            const float v = (j == 0) ? (float)i * (1.0f / 4095.0f) : (j <= 16) ? __builtin_amdgcn_cosf(turns) : (j <= 32) ? -__builtin_amdgcn_sinf(turns) : 0.f;
            zl[li * 68 + j] = v; }
        __syncthreads();
        sine_layer(zl, w1l, h1, a.in[16], a.in[20], wave, lane);
        __syncthreads();
        sine_layer(h1, w2l, h2, a.in[18], a.in[20], wave, lane);
        __syncthreads();
        {
            pg8::bf16x8 Bh[4][2], Bl[4][2];
#pragma unroll
            for (int nt = 0; nt < 4; ++nt)
#pragma unroll
                for (int s = 0; s < 2; ++s) split8(braw[nt][s], Bh[nt][s], Bl[nt][s]);
            float* hT = (float*)(ws + WS_HT);
#pragma unroll
            for (int mt = 0; mt < 4; ++mt) {
                pg8::bf16x8 Ah[2], Al[2];
#pragma unroll
                for (int s = 0; s < 2; ++s) { const LAS float* hp = h2 + (16 * mt + m16) * 68 + 32 * s + 8 * kg; const f32x4 x = *(const LAS f32x4*)hp, y = *(const LAS f32x4*)(hp + 4);
                    const float v[8] = {x[0], x[1], x[2], x[3], y[0], y[1], y[2], y[3]}; split8(v, Ah[s], Al[s]); }
#pragma unroll
                for (int nt = 0; nt < 4; ++nt) { f32x4 acc = (f32x4){0.f, 0.f, 0.f, 0.f};
#pragma unroll
                    for (int s = 0; s < 2; ++s) acc = mfma3(Ah[s], Al[s], Bh[nt][s], Bl[nt][s], acc);
                    const int c = wave * 64 + nt * 16 + m16;
                    const float delta = 3.0701134573f + (float)c * ((15.3505672866f - 3.0701134573f) / 511.0f);
                    f32x4 o;
#pragma unroll
                    for (int r = 0; r < 4; ++r) { const float ti = (float)(i0 + 16 * mt + 4 * kg + r) * (1.0f / 4095.0f); o[r] = acc[r] * __expf(-ti * delta); }
                    *(f32x4*)(hT + ((size_t)cg * 512 + c) * SEQ + i0 + 16 * mt + 4 * kg) = o; } } }
        __syncthreads();
    }
    {
        asm volatile("" : "+v"(tid)); lane = tid & 63; wave = tid >> 6;
        LAS float* scr = (LAS float*)(lds + wave * 8448);
        const int gw = wg * NWAVES + wave, NGW = G * NWAVES;
        constexpr int I_IN = 104 * 16, I_OUT = 32 * 16;
        for (int it = gw; it < I_IN + I_OUT; it += NGW) {
            if (it < I_IN) { const int nb = it >> 4, kb = it & 15, n0 = nb * 32;
                const int ns = (n0 < 1536) ? n0 : (n0 < 3072 ? n0 + 32 : 1536 + (n0 - 3072));
                transpose_item(a.in[7], DIN, kb * 64, (n0 < DIN) ? ns : 0, (bf16*)(ws + WS_WIN), DM, n0, scr, lane, n0 >= DIN);
            } else { const int r = it - I_IN, nb = r >> 4, kb = r & 15;
                transpose_item(a.in[22], DM, kb * 64, nb * 32, (bf16*)(ws + WS_WOUT), DM, nb * 32, scr, lane, false); }
        }
    }
    for (int e = wg * NTHR + tid; e < 64 * 256; e += G * NTHR) { const int i = e >> 8, j = e & 255;
        const float om = 1.0f / powf(10000.0f, (float)j * (1.0f / 256.0f)); const float er = (float)i * om;
        float* pt = (float*)(ws + WS_POS); pt[i * 512 + j] = sinf(er); pt[i * 512 + 256 + j] = cosf(er); }
}

__device__ __forceinline__ void phase1(const Args& a, LAS unsigned char* lds) {
    const int tid = threadIdx.x, lane = tid & 63, wave = tid >> 6, wg = blockIdx.x, G = gridDim.x;
    unsigned char* ws = a.ws;
    const float* modr = (const float*)(ws + WS_MOD); const float* pt = (const float*)(ws + WS_POS); bf16* ain = (bf16*)(ws + WS_AIN);
    const float* gmix = a.in[6];
    const int NGW = G * NWAVES;
    f32x4 gv[4];
#pragma unroll
    for (int j = 0; j < 4; ++j) gv[j] = *(const f32x4*)(gmix + 4 * lane + 256 * j);
#pragma nounroll
    for (int r0 = wg * NWAVES + wave; r0 < MT; r0 += 4 * NGW) {
        f32x4 v[4][4];
#pragma unroll
        for (int k = 0; k < 4; ++k) { const int r = r0 + k * NGW;
            if (r < MT) { const bool lat = r < MX; const float* src = lat ? a.in[0] + (size_t)r * DM : a.in[2] + (size_t)(r - MX) * DM; const int t = r & 4095, rr = t >> 6, cc = t & 63;
#pragma unroll
                for (int j = 0; j < 4; ++j) { const int col = 4 * lane + 256 * j; v[k][j] = *(const f32x4*)(src + col);
                    const f32x4 pv = *(const f32x4*)(pt + ((j < 2) ? rr * 512 + col : cc * 512 + col - 512));
                    v[k][j] += pv * (lat ? 1.0f : 0.0f); } } }
#pragma unroll
        for (int k = 0; k < 4; ++k) { const int r = r0 + k * NGW;
            if (r < MT) { const int bb = (r < MX) ? (r >> 12) : 4; float ss = 0.f;
                f32x4 shv[4], scv[4];
#pragma unroll
                for (int j = 0; j < 4; ++j) { const int col = 4 * lane + 256 * j; shv[j] = *(const f32x4*)(modr + bb * 6144 + col); scv[j] = *(const f32x4*)(modr + bb * 6144 + 1024 + col); }
#pragma unroll
                for (int j = 0; j < 4; ++j) ss += v[k][j][0] * v[k][j][0] + v[k][j][1] * v[k][j][1] + v[k][j][2] * v[k][j][2] + v[k][j][3] * v[k][j][3];
                const float rs = rsqrtf(wave_sum(ss) * (1.0f / DM) + EPS);
#pragma unroll
                for (int j = 0; j < 4; ++j) { const int col = 4 * lane + 256 * j;
                    const f32x4 sh = shv[j], sc = scv[j];
                    const f32x4 y = (v[k][j] * rs * gv[j]) * (sc + 1.0f) + sh;
                    v2u w; w.x = pk2(y[0], y[1]); w.y = pk2(y[2], y[3]);
                    *(v2u*)(ain + (size_t)r * DM + col) = w; } } }
    }
}

typedef float cpx __attribute__((ext_vector_type(2)));
__device__ __forceinline__ cpx make_cpx(float x, float y) { cpx r; r.x = x; r.y = y; return r; }
__device__ __forceinline__ cpx cmul(cpx a, cpx b) { cpx r;
    asm("v_pk_mul_f32 %0, %1, %2 op_sel_hi:[1,0]\n\tv_pk_fma_f32 %0, %1, %2, %0 op_sel:[1,1,0] op_sel_hi:[0,1,1] neg_lo:[1,0,0]" : "=&v"(r) : "v"(a), "v"(b));
    return r; }
__device__ __forceinline__ cpx cmul_s(cpx a, cpx b) { cpx r;
    asm("v_pk_mul_f32 %0, %1, %2 op_sel_hi:[1,0]\n\tv_pk_fma_f32 %0, %1, %2, %0 op_sel:[1,1,0] op_sel_hi:[0,1,1] neg_lo:[1,0,0]" : "=&v"(r) : "v"(a), "s"(b));
    return r; }
__device__ __forceinline__ cpx cmulc(cpx a, cpx b) { cpx r;
    asm("v_pk_mul_f32 %0, %1, %2 op_sel_hi:[1,0] neg_hi:[1,0]\n\tv_pk_fma_f32 %0, %1, %2, %0 op_sel:[1,1,0] op_sel_hi:[0,1,1] neg_lo:[1,0,0] neg_hi:[1,0,0]" : "=&v"(r) : "v"(a), "v"(b));
    return r; }
__device__ __forceinline__ cpx cfma(cpx a, cpx b, cpx c) { cpx r;
    asm("v_pk_fma_f32 %0, %1, %2, %3 op_sel_hi:[1,0,1]\n\tv_pk_fma_f32 %0, %1, %2, %0 op_sel:[1,1,0] op_sel_hi:[0,1,1] neg_lo:[1,0,0]" : "=&v"(r) : "v"(a), "v"(b), "v"(c));
    return r; }
__device__ __forceinline__ cpx cadd(cpx a, cpx b) { return a + b; }
__device__ __forceinline__ cpx csub(cpx a, cpx b) { return a - b; }
__device__ __forceinline__ cpx add_mi(cpx a, cpx b) { cpx r; asm("v_pk_add_f32 %0, %1, %2 op_sel:[0,1] op_sel_hi:[1,0] neg_hi:[0,1]" : "=v"(r) : "v"(a), "v"(b)); return r; }
__device__ __forceinline__ cpx add_pi(cpx a, cpx b) { cpx r; asm("v_pk_add_f32 %0, %1, %2 op_sel:[0,1] op_sel_hi:[1,0] neg_lo:[0,1]" : "=v"(r) : "v"(a), "v"(b)); return r; }
__device__ __forceinline__ cpx cconj(cpx a) { return make_cpx(a.x, -a.y); }
__device__ __forceinline__ cpx twid(float turns) { return make_cpx(__builtin_amdgcn_cosf(turns), -__builtin_amdgcn_sinf(turns)); }
__device__ __forceinline__ void dft4(cpx& a0, cpx& a1, cpx& a2, cpx& a3) {
    const cpx t0 = cadd(a0, a2), t1 = csub(a0, a2), t2 = cadd(a1, a3), t3 = csub(a1, a3);
    a0 = cadd(t0, t2); a2 = csub(t0, t2); a1 = add_mi(t1, t3); a3 = add_pi(t1, t3);
}
__device__ __forceinline__ void dft4_r2(cpx& a0, cpx& a1, cpx& a2, cpx& a3) {
    const cpx t0 = add_mi(a0, a2), t1 = add_pi(a0, a2), t2 = cadd(a1, a3), t3 = csub(a1, a3);
    a0 = cadd(t0, t2); a2 = csub(t0, t2); a1 = add_mi(t1, t3); a3 = add_pi(t1, t3);
}
__device__ __forceinline__ void dft16(cpx (&v)[16]) {
    cpx t[16];
#pragma unroll
    for (int j = 0; j < 4; ++j) { cpx b0 = v[j], b1 = v[j + 4], b2 = v[j + 8], b3 = v[j + 12]; dft4(b0, b1, b2, b3); t[4 * j] = b0; t[4 * j + 1] = b1; t[4 * j + 2] = b2; t[4 * j + 3] = b3; }
    const float C1 = 0.92387953251f, S1 = 0.38268343236f, R2 = 0.70710678118f;
    const cpx W1 = make_cpx(C1, -S1), W2 = make_cpx(R2, -R2), W3 = make_cpx(S1, -C1), W6 = make_cpx(-R2, -R2), W9 = make_cpx(-C1, S1);
    {   cpx b0 = t[0], b1 = t[4], b2 = t[8], b3 = t[12]; dft4(b0, b1, b2, b3); v[0] = b0; v[4] = b1; v[8] = b2; v[12] = b3; }
    {   cpx b0 = t[1], b1 = cmul_s(t[5], W1), b2 = cmul_s(t[9], W2), b3 = cmul_s(t[13], W3); dft4(b0, b1, b2, b3); v[1] = b0; v[5] = b1; v[9] = b2; v[13] = b3; }
    {   cpx b0 = t[2], b1 = cmul_s(t[6], W2), b2 = t[10], b3 = cmul_s(t[14], W6); dft4_r2(b0, b1, b2, b3); v[2] = b0; v[6] = b1; v[10] = b2; v[14] = b3; }
    {   cpx b0 = t[3], b1 = cmul_s(t[7], W3), b2 = cmul_s(t[11], W6), b3 = cmul_s(t[15], W9); dft4(b0, b1, b2, b3); v[3] = b0; v[7] = b1; v[11] = b2; v[15] = b3; }
}
#define FPAD(i) ((i) + ((i) >> 4))
constexpr int FFT_STRIDE = 4352;
__device__ __forceinline__ void apply_tw(cpx (&v)[16], cpx w1) {
    asm volatile("" : "+v"(w1.x), "+v"(w1.y));
    cpx w = w1; v[1] = cmul(v[1], w);
#pragma unroll
    for (int q = 2; q < 16; ++q) { w = cmul(w, w1); v[q] = cmul(v[q], w); }
}
__device__ __forceinline__ cpx opaque(cpx w) { asm volatile("" : "+v"(w.x), "+v"(w.y)); return w; }
__device__ __forceinline__ cpx c32(int r) { return make_cpx(__builtin_cosf(0.19634954084936207f * (float)r), -__builtin_sinf(0.19634954084936207f * (float)r)); }

#define HB(x) __uint_as_float(((unsigned)(x)) << 16)
__device__ __forceinline__ void hyena_item(const Args& a, LAS unsigned char* lds, int c, int stage) {
    int tid = threadIdx.x; asm volatile("" : "+v"(tid));
    const int f = tid >> 8, j = tid & 255, blk = j >> 4, jp = j & 15;
    const int fu = __builtin_amdgcn_readfirstlane(f);
    unsigned char* ws = a.ws;
    LAS cpx* buf = (LAS cpx*)lds;
    LAS cpx* bm = buf + f * FFT_STRIDE;
    const int pj = j + blk, p16 = blk * 272 + jp, pc = 17 * j;
    const float* hT = (const float*)(ws + WS_HT);
    const float* hf = hT + ((size_t)(stage * 2 + 0) * 512 + c) * SEQ;
    const float* hb = hT + ((size_t)(stage * 2 + 1) * 512 + c) * SEQ;
    const bf16* hyT = (const bf16*)(ws + WS_HYT);
    const bf16* zT = (const bf16*)(ws + WS_ZT);
    bf16* outp = (bf16*)(ws + WS_HYT);
    const float* cw = a.in[13]; const float* cb = a.in[14];
    const int chu = c, chg = (stage == 0 ? 512 : 1024) + c;
    const float wu0 = cw[chu], wu1 = cw[1536 + chu], wu2 = cw[3072 + chu], bu = cb[chu];
    const float wg0 = cw[chg], wg1 = cw[1536 + chg], wg2 = cw[3072 + chg], bg = cb[chg];
    const float bias = a.in[21][stage * 512 + c];
    const cpx wj = twid((float)j * (1.0f / 4096.0f)), wjp = twid((float)jp * (1.0f / 256.0f)), w8_ = twid((float)j * (1.0f / 8192.0f));
    cpx v[16];
    LAS cpx* Hs = buf + 2 * FFT_STRIDE + f * FFT_STRIDE + pc;
    { const cpx w8 = opaque(w8_);
    float fraw[16], graw[16];
#pragma unroll
    for (int r = 0; r < 16; ++r) { const unsigned n = (unsigned)j + 256u * r; fraw[r] = hf[n]; graw[r] = hb[(SEQ - n) & 4095u]; }
    asm volatile("" : "+v"(fraw[0]), "+v"(fraw[1]), "+v"(fraw[2]), "+v"(fraw[3]), "+v"(fraw[4]), "+v"(fraw[5]), "+v"(fraw[6]), "+v"(fraw[7]), "+v"(fraw[8]), "+v"(fraw[9]), "+v"(fraw[10]), "+v"(fraw[11]), "+v"(fraw[12]), "+v"(fraw[13]), "+v"(fraw[14]), "+v"(fraw[15]));
    asm volatile("" : "+v"(graw[0]), "+v"(graw[1]), "+v"(graw[2]), "+v"(graw[3]), "+v"(graw[4]), "+v"(graw[5]), "+v"(graw[6]), "+v"(graw[7]), "+v"(graw[8]), "+v"(graw[9]), "+v"(graw[10]), "+v"(graw[11]), "+v"(graw[12]), "+v"(graw[13]), "+v"(graw[14]), "+v"(graw[15]));
    if (fu) {
#pragma unroll
        for (int r = 0; r < 16; ++r) { const unsigned n = (unsigned)j + 256u * r; const float gv = n ? graw[r] : 0.f; const cpx wn = cmul_s(w8, c32(r)); const float d = fraw[r] - gv; v[r] = make_cpx(d * wn.x, d * wn.y); }
    } else {
#pragma unroll
        for (int r = 0; r < 16; ++r) { const unsigned n = (unsigned)j + 256u * r; const float gv = n ? graw[r] : 0.f; v[r] = make_cpx(fraw[r] + gv, 0.f); }
    } }
    dft16(v); apply_tw(v, wj);
#pragma unroll
    for (int q = 0; q < 16; ++q) bm[pj + 272 * q] = v[q];
    __syncthreads();
#pragma unroll
    for (int r = 0; r < 16; ++r) v[r] = bm[p16 + 17 * r];
    dft16(v); apply_tw(v, wjp);
#pragma unroll
    for (int q = 0; q < 16; ++q) bm[p16 + 17 * q] = v[q];
    __syncthreads();
#pragma unroll
    for (int r = 0; r < 16; ++r) v[r] = bm[pc + r];
    dft16(v);
#pragma unroll
    for (int q = 0; q < 16; ++q) Hs[q] = v[q];
    __syncthreads();
#pragma nounroll
    for (int bp = 0; bp < 2; ++bp) {
        const int b0 = 2 * bp, b1 = 2 * bp + 1;
        float uk0[8], uk1[8];
        {   float u0[16], u1[16];
            const unsigned uj = (unsigned)j;
            if (stage == 0) {
                const bf16* P0 = hyT + ((size_t)b0 * 1536 + chu) * SEQ; const bf16* P1 = hyT + ((size_t)b1 * 1536 + chu) * SEQ;
#pragma unroll
                for (int r = 0; r < 16; ++r) { const unsigned o = uj + 256u * r; if (r == 4 || r == 8 || r == 12) asm volatile("" ::: "memory");
                    const unsigned ol = (r == 0) ? (j ? uj - 1u : 0u) : o - 1u, orr = (r == 15) ? (j < 255 ? o + 1u : o) : o + 1u;
                    float l0 = HB(P0[ol]), l1 = HB(P1[ol]), r0 = HB(P0[orr]), r1 = HB(P1[orr]);
                    if (r == 0) { l0 = j ? l0 : 0.f; l1 = j ? l1 : 0.f; }
                    if (r == 15) { r0 = (j < 255) ? r0 : 0.f; r1 = (j < 255) ? r1 : 0.f; }
                    u0[r] = wu0 * l0 + wu1 * HB(P0[o]) + wu2 * r0 + bu; u1[r] = wu0 * l1 + wu1 * HB(P1[o]) + wu2 * r1 + bu; }
            } else {
                const bf16* P0 = zT + ((size_t)b0 * 512 + c) * SEQ; const bf16* P1 = zT + ((size_t)b1 * 512 + c) * SEQ;
                unsigned short z0[16], z1[16];
#pragma unroll
                for (int r = 0; r < 16; ++r) { const unsigned o = uj + 256u * r; z0[r] = P0[o]; z1[r] = P1[o]; }
                asm volatile("" :: "v"(z0[0]), "v"(z0[1]), "v"(z0[2]), "v"(z0[3]), "v"(z0[4]), "v"(z0[5]), "v"(z0[6]), "v"(z0[7]), "v"(z0[8]), "v"(z0[9]), "v"(z0[10]), "v"(z0[11]), "v"(z0[12]), "v"(z0[13]), "v"(z0[14]), "v"(z0[15]));
                asm volatile("" :: "v"(z1[0]), "v"(z1[1]), "v"(z1[2]), "v"(z1[3]), "v"(z1[4]), "v"(z1[5]), "v"(z1[6]), "v"(z1[7]), "v"(z1[8]), "v"(z1[9]), "v"(z1[10]), "v"(z1[11]), "v"(z1[12]), "v"(z1[13]), "v"(z1[14]), "v"(z1[15]));
#pragma unroll
                for (int r = 0; r < 16; ++r) { u0[r] = HB(z0[r]); u1[r] = HB(z1[r]); }
            }
#pragma unroll
            for (int i = 0; i < 8; ++i) { uk0[i] = f ? u0[2 * i + 1] : u0[2 * i]; uk1[i] = f ? u1[2 * i + 1] : u1[2 * i]; }
            const cpx w8 = opaque(w8_);
            if (fu) {
#pragma unroll
                for (int r = 0; r < 16; ++r) v[r] = cmul(make_cpx(u0[r], u1[r]), cmul_s(w8, c32(r)));
            } else {
#pragma unroll
                for (int r = 0; r < 16; ++r) v[r] = make_cpx(u0[r], u1[r]);
            }
        }
        dft16(v); apply_tw(v, wj);
#pragma unroll
        for (int q = 0; q < 16; ++q) bm[pj + 272 * q] = v[q];
        __syncthreads();
#pragma unroll
        for (int r = 0; r < 16; ++r) v[r] = bm[p16 + 17 * r];
        dft16(v); apply_tw(v, wjp);
#pragma unroll
        for (int q = 0; q < 16; ++q) bm[p16 + 17 * q] = v[q];
        __syncthreads();
#pragma unroll
        for (int r = 0; r < 16; ++r) v[r] = bm[pc + r];
        dft16(v);
#pragma unroll
        for (int q = 0; q < 16; ++q) v[q] = cmulc(v[q], Hs[q]);
        dft16(v);
#pragma unroll
        for (int q = 0; q < 16; ++q) bm[pc + q] = v[q];
        __syncthreads();
#pragma unroll
        for (int r = 0; r < 16; ++r) v[r] = bm[p16 + 17 * r];
        apply_tw(v, wjp); dft16(v);
#pragma unroll
        for (int q = 0; q < 16; ++q) bm[p16 + 17 * q] = v[q];
        __syncthreads();
        float gg0[8], gg1[8];
        {   unsigned short rg0[8][3], rg1[8][3];
            const bf16* G0 = hyT + ((size_t)b0 * 1536 + chg) * SEQ; const bf16* G1 = hyT + ((size_t)b1 * 1536 + chg) * SEQ;
            const unsigned gj = (unsigned)(j + 256 * f);
#pragma unroll
            for (int i = 0; i < 8; ++i) { const unsigned o = gj + 512u * i;
                const unsigned ol = (i == 0) ? (gj ? gj - 1u : 0u) : o - 1u, orr = (i == 7) ? (o < 4095u ? o + 1u : o) : o + 1u;
                rg0[i][0] = G0[ol]; rg0[i][1] = G0[o]; rg0[i][2] = G0[orr]; rg1[i][0] = G1[ol]; rg1[i][1] = G1[o]; rg1[i][2] = G1[orr]; }
#pragma unroll
            for (int r = 0; r < 16; ++r) v[r] = bm[pj + 272 * r];
            apply_tw(v, wj); dft16(v);
#pragma unroll
            for (int q = 0; q < 16; ++q) bm[pj + 272 * q] = v[q];
#pragma unroll
            for (int i = 0; i < 8; ++i) asm volatile("" :: "v"(rg0[i][0]), "v"(rg0[i][1]), "v"(rg0[i][2]), "v"(rg1[i][0]), "v"(rg1[i][1]), "v"(rg1[i][2]));
#pragma unroll
            for (int i = 0; i < 8; ++i) { const unsigned o = gj + 512u * i;
                float a0 = HB(rg0[i][0]), a1 = HB(rg0[i][1]), a2 = HB(rg0[i][2]), c0 = HB(rg1[i][0]), c1 = HB(rg1[i][1]), c2 = HB(rg1[i][2]);
                if (i == 0) { a0 = gj ? a0 : 0.f; c0 = gj ? c0 : 0.f; }
                if (i == 7) { a2 = (o < 4095u) ? a2 : 0.f; c2 = (o < 4095u) ? c2 : 0.f; }
                gg0[i] = wg0 * a0 + wg1 * a1 + wg2 * a2 + bg; gg1[i] = wg0 * c0 + wg1 * c1 + wg2 * c2 + bg; } }
        __syncthreads();
        const cpx w8f = cmul(opaque(w8_), f ? c32(1) : c32(0));
        bf16* O0 = outp + ((size_t)b0 * 1536 + c) * SEQ; bf16* O1 = outp + ((size_t)b1 * 1536 + c) * SEQ;
        bf16* Z0 = (bf16*)(ws + WS_ZT) + ((size_t)b0 * 512 + c) * SEQ; bf16* Z1 = (bf16*)(ws + WS_ZT) + ((size_t)b1 * 512 + c) * SEQ;
#pragma unroll
        for (int i = 0; i < 8; ++i) { const int rr = f + 2 * i; const unsigned n = (unsigned)(j + 256 * f) + 512u * i;
            const cpx be = buf[pj + 272 * rr], bo = buf[FFT_STRIDE + pj + 272 * rr];
            const cpx wn = cmul_s(w8f, c32(2 * i));
            const cpx z = cfma(bo, wn, be);
            const float y0 = z.x * (1.0f / 8192.0f) + bias * uk0[i], y1 = bias * uk1[i] - z.y * (1.0f / 8192.0f);
                        if (stage == 0) { Z0[n] = (bf16)f2bf(gg0[i] * y0); Z1[n] = (bf16)f2bf(gg1[i] * y1); } else { O0[n] = (bf16)f2bf(gg0[i] * y0); O1[n] = (bf16)f2bf(gg1[i] * y1); } }
        __syncthreads();
    }
}

__device__ __forceinline__ f32x16 mfma32(bf16x8 a, bf16x8 b, f32x16 c) { return __builtin_amdgcn_mfma_f32_32x32x16_bf16(a, b, c, 0, 0, 0); }
typedef short s4v __attribute__((ext_vector_type(4)));
__device__ __forceinline__ bf16x8 tr_frag(const LAS bf16* base, int PT, int k0, int c0, int lane) {
    const int i = lane & 15, q = i >> 2, p = i & 3;
    const LAS bf16* ad = base + (k0 + 8 * (lane >> 5) + q) * PT + c0 + 16 * ((lane >> 4) & 1) + 4 * p;
    const s4v lo = __builtin_amdgcn_ds_read_tr16_b64_v4i16((LAS s4v*)ad);
    const s4v hi = __builtin_amdgcn_ds_read_tr16_b64_v4i16((LAS s4v*)(ad + 4 * PT));
    bf16x8 r; r[0] = lo[0]; r[1] = lo[1]; r[2] = lo[2]; r[3] = lo[3]; r[4] = hi[0]; r[5] = hi[1]; r[6] = hi[2]; r[7] = hi[3]; return r;
}
constexpr int GL_AL = 0, GL_WA = 8192, GL_TOT = 16384, GL_V = 24576, GL_VP = 160;
struct GlaTab { float P[4][2], X[4][2], Ptot[2], Xtot[2], Pref[2], Xref[2]; };
__device__ __forceinline__ void gla_tables(const Args& a, int h, LAS unsigned char* lds, GlaTab& T, int tid) {
    const int d2 = tid & 31, sg = tid >> 5;
    const LAS float* aL = (const LAS float*)(lds + GL_AL); const LAS float* wa = (const LAS float*)(lds + GL_WA); LAS float* tot = (LAS float*)(lds + GL_TOT);
    typedef float f32x2v __attribute__((ext_vector_type(2)));
    const f32x2v bf = *(const f32x2v*)(a.in[9] + h * 64 + 2 * d2), bb = *(const f32x2v*)(a.in[11] + h * 64 + 2 * d2);
    float lf[4][2], lb[4][2];
#pragma unroll
    for (int q = 0; q < 4; ++q) { const int s = sg * 4 + q; float pf0 = bf[0], pf1 = bf[1], pb0 = bb[0], pb1 = bb[1];
#pragma unroll
        for (int j4 = 0; j4 < 4; ++j4) { const f32x4 af = *(const LAS f32x4*)(aL + s * 32 + 4 * j4), ab = *(const LAS f32x4*)(aL + s * 32 + 16 + 4 * j4);
#pragma unroll
            for (int jj = 0; jj < 4; ++jj) { const int j = 4 * j4 + jj; const f32x2v wf = *(const LAS f32x2v*)(wa + j * 64 + 2 * d2), wb = *(const LAS f32x2v*)(wa + 1024 + j * 64 + 2 * d2);
                pf0 += af[jj] * wf[0]; pf1 += af[jj] * wf[1]; pb0 += ab[jj] * wb[0]; pb1 += ab[jj] * wb[1]; } }
        lf[q][0] = logsig_f(pf0) * (1.0f / 16.0f); lf[q][1] = logsig_f(pf1) * (1.0f / 16.0f); lb[q][0] = logsig_f(pb0) * (1.0f / 16.0f); lb[q][1] = logsig_f(pb1) * (1.0f / 16.0f); }
#pragma unroll
    for (int i = 0; i < 2; ++i) { lf[1][i] += lf[0][i]; lf[2][i] += lf[1][i]; lf[3][i] += lf[2][i]; lb[2][i] += lb[3][i]; lb[1][i] += lb[2][i]; lb[0][i] += lb[1][i]; }
    *(LAS f32x2v*)(tot + sg * 64 + 2 * d2) = (f32x2v){lf[3][0], lf[3][1]};
    *(LAS f32x2v*)(tot + 1024 + sg * 64 + 2 * d2) = (f32x2v){lb[0][0], lb[0][1]};
    __syncthreads();
    float of[2] = {0.f, 0.f}, ob[2] = {0.f, 0.f};
    T.Ptot[0] = T.Ptot[1] = T.Xtot[0] = T.Xtot[1] = T.Pref[0] = T.Pref[1] = T.Xref[0] = T.Xref[1] = 0.f;
#pragma unroll
    for (int g = 0; g < 16; ++g) { const f32x2v tf = *(const LAS f32x2v*)(tot + g * 64 + 2 * d2), tb = *(const LAS f32x2v*)(tot + 1024 + g * 64 + 2 * d2);
#pragma unroll
        for (int i = 0; i < 2; ++i) { T.Ptot[i] += tf[i]; T.Xtot[i] += tb[i]; if (g < 8) T.Pref[i] += tf[i]; else T.Xref[i] += tb[i];
            of[i] += (g < sg) ? tf[i] : 0.f; ob[i] += (g > sg) ? tb[i] : 0.f; } }
#pragma unroll
    for (int q = 0; q < 4; ++q)
#pragma unroll
        for (int i = 0; i < 2; ++i) { T.P[q][i] = lf[q][i] + of[i]; T.X[q][i] = lb[q][i] + ob[i]; }
}
struct GlaIn { f32x4 av, wv; unsigned kw[4], qw[4]; };
template <bool OUT>
__device__ __forceinline__ void gla_load(const Args& a, int tid, int bh, int ci, GlaIn& I) {
    const int b = bh >> 2, h = bh & 3, d2 = tid & 31, sg = tid >> 5;
    const size_t rowbase = OUT ? (size_t)b * SEQ + ci * 64 : ((ci < 4) ? (size_t)(MX + b * CTXL + ci * 64) : (size_t)(b * SEQ + (ci - 4) * 64));
    const float* afb = (const float*)(a.ws + WS_AFB); const bf16* qkvg = (const bf16*)(a.ws + WS_QKVG);
    I.av = *(const f32x4*)(afb + (rowbase + (tid >> 3)) * 32 + 4 * (tid & 7));
    const int wdir = tid >> 8, wj = (tid >> 4) & 15, wd4 = (tid & 15) * 4;
    I.wv = *(const f32x4*)((wdir ? a.in[10] : a.in[8]) + wj * 256 + h * 64 + wd4);
#pragma unroll
    for (int q = 0; q < 4; ++q) { const bf16* rp = qkvg + (rowbase + sg * 4 + q) * NQ + h * 64 + 2 * d2; I.kw[q] = *(const unsigned*)(rp + 256); if (OUT) I.qw[q] = *(const unsigned*)rp; }
}
__device__ __forceinline__ void gla_stage_common(const GlaIn& I, LAS unsigned char* lds, int tid) {
    const int wdir = tid >> 8, wj = (tid >> 4) & 15, wd4 = (tid & 15) * 4;
    *(LAS f32x4*)((LAS float*)(lds + GL_AL) + 4 * tid) = I.av;
    *(LAS f32x4*)((LAS float*)(lds + GL_WA) + wdir * 1024 + wj * 64 + wd4) = I.wv;
}

template <bool HASN>
__device__ __forceinline__ void gla_upd_item(const Args& a, LAS unsigned char* lds, int bh, int ci, const GlaIn& I, int nbh, int nci, GlaIn& N) {
    int tid = threadIdx.x; asm volatile("" : "+v"(tid));
    const int lane = tid & 63, wave = tid >> 6, h = bh & 3, d2 = tid & 31, sg = tid >> 5;
    unsigned char* ws = a.ws;
    constexpr int KP = 96;
    LAS bf16* vN = (LAS bf16*)(lds + GL_V); LAS bf16* kUf = (LAS bf16*)(lds + 45056); LAS bf16* kUb = (LAS bf16*)(lds + 57344);
    unsigned kw[4];
#pragma unroll
    for (int q = 0; q < 4; ++q) kw[q] = I.kw[q];
    v4u vv[2];
    { const int b = bh >> 2; const size_t rowbase = (ci < 4) ? (size_t)(MX + b * CTXL + ci * 64) : (size_t)(b * SEQ + (ci - 4) * 64); const bf16* qkvg = (const bf16*)(ws + WS_QKVG);
#pragma unroll
        for (int q = 0; q < 2; ++q) { const int idx = tid + NTHR * q; vv[q] = *(const v4u*)(qkvg + (rowbase + (idx >> 4)) * NQ + 512 + h * 128 + (idx & 15) * 8); } }
    gla_stage_common(I, lds, tid);
    __syncthreads();
    if (HASN) gla_load<false>(a, tid, nbh, nci, N);
    GlaTab T; gla_tables(a, h, lds, T, tid);
#pragma unroll
    for (int q = 0; q < 4; ++q) { const int s = sg * 4 + q; const float k0 = bflo(kw[q]), k1 = bfhi(kw[q]);
        *(LAS unsigned*)(kUf + s * KP + 2 * d2) = pk2(k0 * __expf(T.Ptot[0] - T.P[q][0]), k1 * __expf(T.Ptot[1] - T.P[q][1]));
        *(LAS unsigned*)(kUb + s * KP + 2 * d2) = pk2(k0 * __expf(T.Xtot[0] - T.X[q][0]), k1 * __expf(T.Xtot[1] - T.X[q][1])); }
#pragma unroll
    for (int q = 0; q < 2; ++q) { const int idx = tid + NTHR * q; *(LAS v4u*)(vN + (idx >> 4) * GL_VP + (idx & 15) * 8) = vv[q]; }
    if (tid < 32) { float* dec = (float*)(ws + WS_DEC);
#pragma unroll
        for (int i = 0; i < 2; ++i) { dec[((size_t)(bh * 2 + 0) * NCH + ci) * 64 + 2 * d2 + i] = __expf(T.Ptot[i]); dec[((size_t)(bh * 2 + 1) * NCH + ci) * 64 + 2 * d2 + i] = __expf(T.Xtot[i]); } }
    __syncthreads();
    { const int dir = wave >> 2, e0 = (wave & 3) * 32, l31 = lane & 31, hh = lane >> 5;
        const LAS bf16* kT = dir ? kUb : kUf;
        float* U = (ci < 4) ? (float*)(ws + WS_UCTX) + ((size_t)(bh * 2 + dir) * 4 + ci) * 8192 : a.out + ((size_t)(bh * 2 + dir) * 64 + (ci - 4)) * 8192;
        bf16x8 A[4];
#pragma unroll
        for (int ks = 0; ks < 4; ++ks) A[ks] = tr_frag(vN, GL_VP, 16 * ks, e0, lane);
#pragma unroll
        for (int dt = 0; dt < 2; ++dt) { const int d0 = dt * 32; f32x16 acc;
#pragma unroll
            for (int i = 0; i < 16; ++i) acc[i] = 0.f;
#pragma unroll
            for (int ks = 0; ks < 4; ++ks) acc = mfma32(A[ks], tr_frag(kT, KP, 16 * ks, d0, lane), acc);
#pragma unroll
            for (int r = 0; r < 16; ++r) { const int e = e0 + (r & 3) + 8 * (r >> 2) + 4 * hh; U[e * 64 + d0 + l31] = acc[r]; } } }
    __syncthreads();
}

__device__ __forceinline__ void gla_scan_item(const Args& a, int it) {
    int tid = threadIdx.x; asm volatile("" : "+v"(tid));
    const int bd = it >> 4, dir = bd & 1, el = ((it & 15) * 8 + (tid >> 6)) * 64 + (tid & 63), d = tid & 63;
    unsigned char* ws = a.ws;
    const float* dec = (const float*)(ws + WS_DEC) + (size_t)bd * NCH * 64 + d;
    const float* Uc = (const float*)(ws + WS_UCTX) + (size_t)bd * 4 * 8192 + el;
    const float* U = a.out + (size_t)bd * 64 * 8192 + el;
    bf16* Sp = (bf16*)(ws + WS_SPREV) + (size_t)bd * 64 * 8192 + el;
    float S = 0.f;
#pragma unroll
    for (int c4 = 0; c4 < 4; ++c4) { const int ci = dir ? 3 - c4 : c4; S = dec[ci * 64] * S + Uc[(size_t)ci * 8192]; }
#pragma unroll
    for (int blk = 0; blk < 2; ++blk) { float uu[32], dd[32];
#pragma unroll
        for (int j = 0; j < 32; ++j) { const int n = dir ? 63 - (blk * 32 + j) : blk * 32 + j; uu[j] = U[(size_t)n * 8192]; dd[j] = dec[(4 + n) * 64]; }
#pragma unroll
        for (int j = 0; j < 32; ++j) { const int n = dir ? 63 - (blk * 32 + j) : blk * 32 + j; Sp[(size_t)n * 8192] = (bf16)f2bf(S); S = dd[j] * S + uu[j]; } }
}

template <bool HASN>
__device__ __forceinline__ void gla_out_item(const Args& a, LAS unsigned char* lds, int bh, int n, const GlaIn& I, int nbh, int nn, GlaIn& N) {
    int tid = threadIdx.x; asm volatile("" : "+v"(tid));
    const int lane = tid & 63, wave = tid >> 6, b = bh >> 2, h = bh & 3, l31 = lane & 31, hh = lane >> 5, d2 = tid & 31, sg = tid >> 5;
    unsigned char* ws = a.ws;
    LAS bf16* Scat = (LAS bf16*)lds;
    LAS bf16* vN = (LAS bf16*)(lds + GL_V);
    LAS bf16* qf = (LAS bf16*)(lds + 45056); LAS bf16* qb = qf + 4608; LAS bf16* kf = qf + 2 * 4608; LAS bf16* kb = qf + 3 * 4608;
    LAS float* oS = (LAS float*)(lds + 45056);
    LAS bf16* qS = (LAS bf16*)(lds + 81920);
    LAS bf16* Sp = (LAS bf16*)(lds + 99328);
    const size_t rowbase = (size_t)b * SEQ + n * 64;
    unsigned qw[4], kw[4];
#pragma unroll
    for (int q = 0; q < 4; ++q) { qw[q] = I.qw[q]; kw[q] = I.kw[q]; }
    v4u vv[2], sv[4], g0, g1;
    { const bf16* qkvg = (const bf16*)(ws + WS_QKVG);
        { const bf16* gp = qkvg + (rowbase + (tid >> 3)) * NQ + 1024 + h * 128 + (tid & 7) * 16; g0 = *(const v4u*)gp; g1 = *(const v4u*)(gp + 8); }
#pragma unroll
        for (int q = 0; q < 2; ++q) { const int idx = tid + NTHR * q; vv[q] = *(const v4u*)(qkvg + (rowbase + (idx >> 4)) * NQ + 512 + h * 128 + (idx & 15) * 8); }
        const bf16* spf = (const bf16*)(ws + WS_SPREV) + ((size_t)(bh * 2 + 0) * 64 + n) * 8192; const bf16* spb = (const bf16*)(ws + WS_SPREV) + ((size_t)(bh * 2 + 1) * 64 + n) * 8192;
#pragma unroll
        for (int q = 0; q < 4; ++q) { const int idx = tid + NTHR * q, dir = idx >> 10, e = (idx >> 3) & 127, d8 = (idx & 7) * 8; sv[q] = *(const v4u*)((dir ? spb : spf) + e * 64 + d8); } }
    gla_stage_common(I, lds, tid);
    __syncthreads();
    if (HASN) gla_load<true>(a, tid, nbh, nn, N);
    GlaTab T; gla_tables(a, h, lds, T, tid);
#pragma unroll
    for (int q = 0; q < 4; ++q) { const int s = sg * 4 + q; const float q0 = bflo(qw[q]), q1 = bfhi(qw[q]), k0 = bflo(kw[q]), k1 = bfhi(kw[q]);
        *(LAS unsigned*)(qf + s * 72 + 2 * d2) = pk2(q0 * __expf(T.P[q][0] - T.Pref[0]), q1 * __expf(T.P[q][1] - T.Pref[1]));
        *(LAS unsigned*)(kf + s * 72 + 2 * d2) = pk2(k0 * __expf(T.Pref[0] - T.P[q][0]), k1 * __expf(T.Pref[1] - T.P[q][1]));
        *(LAS unsigned*)(qb + s * 72 + 2 * d2) = pk2(q0 * __expf(T.X[q][0] - T.Xref[0]), q1 * __expf(T.X[q][1] - T.Xref[1]));
        *(LAS unsigned*)(kb + s * 72 + 2 * d2) = pk2(k0 * __expf(T.Xref[0] - T.X[q][0]), k1 * __expf(T.Xref[1] - T.X[q][1]));
        *(LAS unsigned*)(qS + s * 136 + 2 * d2) = pk2(q0 * __expf(T.P[q][0]), q1 * __expf(T.P[q][1]));
        *(LAS unsigned*)(qS + s * 136 + 64 + 2 * d2) = pk2(q0 * __expf(T.X[q][0]), q1 * __expf(T.X[q][1])); }
#pragma unroll
    for (int q = 0; q < 2; ++q) { const int idx = tid + NTHR * q; *(LAS v4u*)(vN + (idx >> 4) * GL_VP + (idx & 15) * 8) = vv[q]; }
#pragma unroll
    for (int q = 0; q < 4; ++q) { const int idx = tid + NTHR * q, dir = idx >> 10, e = (idx >> 3) & 127, d8 = (idx & 7) * 8; *(LAS v4u*)(Sp + e * 136 + dir * 64 + d8) = sv[q]; }
    __syncthreads();
    { const int dir = wave >> 2, c0 = ((wave >> 1) & 1) * 32, s0 = (wave & 1) * 32;
        const LAS bf16* qq = dir ? qb : qf; const LAS bf16* kk = dir ? kb : kf;
        f32x16 acc;
#pragma unroll
        for (int i = 0; i < 16; ++i) acc[i] = 0.f;
#pragma unroll
        for (int ks = 0; ks < 4; ++ks) { const bf16x8 A = *(const LAS bf16x8*)(qq + (c0 + l31) * 72 + 16 * ks + 8 * hh), B = *(const LAS bf16x8*)(kk + (s0 + l31) * 72 + 16 * ks + 8 * hh);
            acc = mfma32(A, B, acc); }
        const int s = s0 + l31;
#pragma unroll
        for (int r = 0; r < 16; ++r) { const int c = c0 + (r & 3) + 8 * (r >> 2) + 4 * hh; const bool keep = dir ? (s >= c) : (s <= c);
            Scat[c * 136 + dir * 64 + s] = (bf16)f2bf(keep ? acc[r] : 0.f); } }
    __syncthreads();
    { const int c0 = (wave >> 2) * 32, e0 = (wave & 3) * 32;
        f32x16 acc;
#pragma unroll
        for (int i = 0; i < 16; ++i) acc[i] = 0.f;
#pragma unroll
        for (int ks = 0; ks < 8; ++ks) { const bf16x8 A = *(const LAS bf16x8*)(Scat + (c0 + l31) * 136 + 16 * ks + 8 * hh);
            acc = mfma32(A, tr_frag(vN, GL_VP, 16 * (ks & 3), e0, lane), acc); }
#pragma unroll
        for (int ks = 0; ks < 8; ++ks) { const bf16x8 A = *(const LAS bf16x8*)(qS + (c0 + l31) * 136 + 16 * ks + 8 * hh), B = *(const LAS bf16x8*)(Sp + (e0 + l31) * 136 + 16 * ks + 8 * hh);
            acc = mfma32(A, B, acc); }
#pragma unroll
        for (int r = 0; r < 16; ++r) { const int c = c0 + (r & 3) + 8 * (r >> 2) + 4 * hh; oS[c * 132 + e0 + l31] = acc[r]; } }
    __syncthreads();
    { const int row = tid >> 3, ec = (tid & 7) * 16; float v[16]; float ss = 0.f;
#pragma unroll
        for (int j = 0; j < 16; ++j) { v[j] = oS[row * 132 + ec + j]; ss += v[j] * v[j]; }
        ss += __shfl_xor(ss, 1); ss += __shfl_xor(ss, 2); ss += __shfl_xor(ss, 4);
        const float rs = rsqrtf(ss * (1.0f / 128.0f) + EPS);
        const float gv[16] = {bflo(g0.x), bfhi(g0.x), bflo(g0.y), bfhi(g0.y), bflo(g0.z), bfhi(g0.z), bflo(g0.w), bfhi(g0.w), bflo(g1.x), bfhi(g1.x), bflo(g1.y), bfhi(g1.y), bflo(g1.z), bfhi(g1.z), bflo(g1.w), bfhi(g1.w)};
        float o[16];
#pragma unroll
        for (int j = 0; j < 16; ++j) o[j] = DBG_GLA_K * v[j] * rs * a.in[12][ec + j] * silu_f(gv[j]);
        bf16* op = (bf16*)(ws + WS_AOUT) + (rowbase + row) * DM + h * 128 + ec;
        *(v4u*)op = (v4u){pk2(o[0], o[1]), pk2(o[2], o[3]), pk2(o[4], o[5]), pk2(o[6], o[7])};
        *(v4u*)(op + 8) = (v4u){pk2(o[8], o[9]), pk2(o[10], o[11]), pk2(o[12], o[13]), pk2(o[14], o[15])}; }
    __syncthreads();
}

__device__ __forceinline__ void hy_transpose_item(const Args& a, LAS unsigned char* lds, int it) {
    const int tid = threadIdx.x, b = it >> 6, t0 = (it & 63) * 64;
    LAS float* tile = (LAS float*)lds;
    const bf16* src = (const bf16*)(a.ws + WS_HYT) + (size_t)b * 1536 * SEQ + t0;
    bf16* dst = (bf16*)(a.ws + WS_AOUT) + ((size_t)b * SEQ + t0) * DM + 512;
    for (int half = 0; half < 2; ++half) {
#pragma unroll 8
        for (int q = 0; q < 32; ++q) { const int idx = tid + NTHR * q, c = idx >> 6, tt = idx & 63; tile[c * 65 + tt] = HB(src[(size_t)(half * 256 + c) * SEQ + tt]); }
        __syncthreads();
#pragma unroll
        for (int q = 0; q < 4; ++q) { const int idx = tid + NTHR * q, t = idx >> 5, c8 = (idx & 31) * 8; const LAS float* s = tile + c8 * 65 + t;
            *(v4u*)(dst + (size_t)t * DM + half * 256 + c8) = (v4u){pk2(s[0], s[65]), pk2(s[2 * 65], s[3 * 65]), pk2(s[4 * 65], s[5 * 65]), pk2(s[6 * 65], s[7 * 65])}; }
        __syncthreads();
    }
}

__device__ __forceinline__ void phase_router(const Args& a, LAS unsigned char* lds) {
    const int tid = threadIdx.x, lane = tid & 63, wave = tid >> 6, wg = blockIdx.x, G = gridDim.x;
    unsigned char* ws = a.ws;
    LAS float* wr = (LAS float*)lds;
    {   f32x4 t[8];
#pragma unroll
        for (int it = 0; it < 8; ++it) t[it] = *(const f32x4*)(a.in[24] + 4 * (tid + NTHR * it));
#pragma unroll
        for (int it = 0; it < 8; ++it) { const int i4 = tid + NTHR * it, c = i4 >> 2, e4 = i4 & 3, l = (c >> 2) & 63, q = c & 3, j = c >> 8;
            *(LAS f32x4*)(wr + 4 * ((((j * 4 + q) * 4 + e4) * 65) + l)) = t[it]; } }
    __syncthreads();
    const float* modr = (const float*)(ws + WS_MOD); const float* gffn = a.in[23];
    bf16* hn = (bf16*)(ws + WS_HN); float* aff = (float*)(ws + WS_AFF);
    const int NGW = G * NWAVES;
    f32x4 gv[4];
#pragma unroll
    for (int j = 0; j < 4; ++j) gv[j] = *(const f32x4*)(gffn + 4 * lane + 256 * j);
#pragma nounroll
    for (int r0 = wg * NWAVES + wave; r0 < MX; r0 += 2 * NGW) {
        const int r1 = r0 + NGW; const bool ok1 = r1 < MX; const int rB = ok1 ? r1 : r0;
        int lane_o = lane; asm volatile("" : "+v"(lane_o));
        f32x4 v[2][4];
#pragma unroll
        for (int j = 0; j < 4; ++j) { v[0][j] = *(const f32x4*)(a.out + (size_t)r0 * DM + 4 * lane + 256 * j); v[1][j] = *(const f32x4*)(a.out + (size_t)rB * DM + 4 * lane + 256 * j); }
        float rs[2];
#pragma unroll
        for (int k = 0; k < 2; ++k) { float ss = 0.f;
#pragma unroll
            for (int j = 0; j < 4; ++j) ss += v[k][j][0] * v[k][j][0] + v[k][j][1] * v[k][j][1] + v[k][j][2] * v[k][j][2] + v[k][j][3] * v[k][j][3];
            rs[k] = rsqrtf(wave_sum(ss) * (1.0f / DM) + EPS); }
        float lg[2][16];
#pragma unroll
        for (int k = 0; k < 2; ++k)
#pragma unroll
            for (int e = 0; e < 16; ++e) lg[k][e] = 0.f;
        f32x4 shv[2][4], scv[2][4];
#pragma unroll
        for (int k = 0; k < 2; ++k)
#pragma unroll
            for (int j = 0; j < 4; ++j) { const int b = (k ? rB : r0) >> 12, col = 4 * lane + 256 * j; shv[k][j] = *(const f32x4*)(modr + b * 6144 + 3072 + col); scv[k][j] = *(const f32x4*)(modr + b * 6144 + 4096 + col); }
#pragma unroll
        for (int j = 0; j < 4; ++j) { const int col = 4 * lane + 256 * j; f32x4 y[2];
#pragma unroll
            for (int k = 0; k < 2; ++k) { const int r = k ? rB : r0;
                const f32x4 sh = shv[k][j], sc = scv[k][j];
                y[k] = (v[k][j] * rs[k] * gv[j]) * (sc + 1.0f) + sh;
                v2u w; w.x = pk2(y[k][0], y[k][1]); w.y = pk2(y[k][2], y[k][3]);
                if (k == 0 || ok1) *(v2u*)(hn + (size_t)r * DM + col) = w; }
#pragma unroll
            for (int q = 0; q < 4; ++q) {
#pragma unroll
                for (int e4 = 0; e4 < 4; ++e4) { const f32x4 ww = *(const LAS f32x4*)(wr + 4 * ((((j * 4 + q) * 4 + e4) * 65) + lane_o));
#pragma unroll
                    for (int s = 0; s < 4; ++s) { lg[0][e4 * 4 + s] += y[0][q] * ww[s]; lg[1][e4 * 4 + s] += y[1][q] * ww[s]; } }
#define PIN16(x) asm volatile("" : "+v"(x[0]), "+v"(x[1]), "+v"(x[2]), "+v"(x[3]), "+v"(x[4]), "+v"(x[5]), "+v"(x[6]), "+v"(x[7]), "+v"(x[8]), "+v"(x[9]), "+v"(x[10]), "+v"(x[11]), "+v"(x[12]), "+v"(x[13]), "+v"(x[14]), "+v"(x[15]) :: "memory")
                PIN16(lg[0]); PIN16(lg[1]); } }
#undef PIN16
        const int exb = ((lane >> 5) & 1) * 8 + ((lane >> 4) & 1) * 4, esel = lane & 3;
#pragma unroll
        for (int k = 0; k < 2; ++k) { float k8[8], k4[4];
#pragma unroll
            for (int i = 0; i < 8; ++i) { float x = lg[k][i], y = lg[k][8 + i]; swap32(x, y); k8[i] = x + y; }
#pragma unroll
            for (int i = 0; i < 4; ++i) { float x = k8[i], y = k8[4 + i]; swap16(x, y); k4[i] = row_allsum(x + y); }
            const float mx = x32_max(x16_max(fmaxf(fmaxf(k4[0], k4[1]), fmaxf(k4[2], k4[3]))));
            float pe[4];
#pragma unroll
            for (int i = 0; i < 4; ++i) pe[i] = __expf(k4[i] - mx);
            const float sum = x32_sum(x16_sum((pe[0] + pe[1]) + (pe[2] + pe[3])));
            const float mine = (esel == 0) ? pe[0] : (esel == 1) ? pe[1] : (esel == 2) ? pe[2] : pe[3];
            const int r = k ? rB : r0;
            if ((lane & 12) == 0 && (k == 0 || ok1)) aff[((size_t)(r >> 12) * NE + exb + esel) * SEQ + (r & 4095)] = mine * __builtin_amdgcn_rcpf(sum); }
    }
}

__device__ __forceinline__ void conv_item(const Args& a, LAS float* scr, int lane, bool gu, int it) {
    unsigned char* ws = a.ws;
    if (gu) { const int mat = it >> 9, r = it & 511, nb = r >> 4, kb = r & 15, e = mat >> 1, kind = mat & 1, n0 = nb * 32;
        transpose_item((kind ? a.in[26] : a.in[25]) + (size_t)e * DM * DM, DM, kb * 64, n0, (bf16*)(ws + WS_WGU) + (size_t)e * 2048 * DM, DM, (n0 >> 7) * 256 + kind * 128 + (n0 & 127), scr, lane, false);
    } else { const int e = it >> 9, r = it & 511, nb = r >> 4, kb = r & 15;
        transpose_item(a.in[27] + (size_t)e * DM * DM, DM, kb * 64, nb * 32, (bf16*)(ws + WS_WD) + (size_t)e * DM * DM, DM, nb * 32, scr, lane, false); }
}
__device__ __forceinline__ bool conv_try(const Args& a, LAS unsigned char* lds, bool allow_gu, unsigned& cur) {
    const int lane = threadIdx.x & 63, wave = threadIdx.x >> 6;
    if (wave == 0) return false;
    const int gw = blockIdx.x * (NWAVES - 1) + wave - 1, NGW = gridDim.x * (NWAVES - 1);
    LAS float* scr = (LAS float*)(lds + wave * 8448);
    const int itD = gw + (int)(cur & 0xffffu) * NGW;
    if (itD < NE * 512) { conv_item(a, scr, lane, false, itD); cur += 1u; return true; }
    if (!allow_gu) return false;
    const int itG = gw + (int)(cur >> 16) * NGW;
    if (itG < NE * 1024) { conv_item(a, scr, lane, true, itG); cur += 0x10000u; return true; }
    return false;
}
#ifndef DBG_NOSHADOW
#define DBG_NOSHADOW 0
#endif
#ifndef SHADOW_LIM
#define SHADOW_LIM 2
#endif
__device__ __forceinline__ void seam_barrier(const XcdBarrier& b, const Args& a, LAS unsigned char* lds, volatile LAS unsigned* MISC, unsigned& gen, bool allow_gu, unsigned& cdone) {
    asm volatile("s_waitcnt vmcnt(0)" ::: "memory");
    __syncthreads();
    ++gen;
    if (threadIdx.x < 64) {
        if (threadIdx.x == 0) {
            unsigned* bar = b.bar;
            __builtin_amdgcn_s_waitcnt(0);
            unsigned nloc = b.st[0], nx = b.st[1];
            if (nloc == 0u) { xcd_barrier_complete(bar, b.x, nloc, nx); b.st[0] = nloc; b.st[1] = nx; }
            const unsigned old = xb_add(&bar[XB_XSUB(b.x)], 1u);
            const unsigned g2 = old / nloc;
            if (old + 1u == (g2 + 1u) * nloc) {
                __builtin_amdgcn_fence(__ATOMIC_RELEASE, "agent");
                asm volatile("s_waitcnt vmcnt(0)" ::: "memory");
                const unsigned og = xb_add(&bar[XB_TOP], 1u);
                const unsigned tg = og / nx;
                if (og + 1u == (tg + 1u) * nx) xb_add(&bar[XB_TOPGEN], 1u);
                else XB_SPIN(xb_ld(&bar[XB_TOPGEN]) == tg, bar);
                __builtin_amdgcn_fence(__ATOMIC_ACQUIRE, "agent");
                xb_add(&bar[XB_XGEN(b.x)], 1u);
                asm volatile("s_waitcnt vmcnt(0)" ::: "memory");
            } else {
                XB_SPIN(xb_ld(&bar[XB_XGEN(b.x)]) == g2, bar);
                __builtin_amdgcn_fence(__ATOMIC_ACQUIRE, "agent");
                asm volatile("s_waitcnt vmcnt(0)" ::: "memory");
            }
            MISC[16] = gen;
        }
    } else {
        unsigned spins = 0; int ndone = 0;
        while (MISC[16] != gen) { if (DBG_NOSHADOW || ndone >= SHADOW_LIM || !conv_try(a, lds, allow_gu, cdone)) { __builtin_amdgcn_s_sleep(4); if (++spins > (1u << 22)) break; } else ++ndone; }
    }
    __syncthreads();
}

__device__ __forceinline__ void block_excl_scan2(int& va, int& vb, LAS int* tmp) {
    const int tid = threadIdx.x, lane = tid & 63, wave = tid >> 6;
    int ia = va, ib = vb;
#pragma unroll
    for (int o = 1; o < 64; o <<= 1) { const int ta = __shfl_up(ia, o), tb = __shfl_up(ib, o); if (lane >= o) { ia += ta; ib += tb; } }
    if (lane == 63) { tmp[wave] = ia; tmp[8 + wave] = ib; }
    __syncthreads();
    int oa = 0, ob = 0;
#pragma unroll
    for (int w = 0; w < 8; ++w) { if (w < wave) { oa += tmp[w]; ob += tmp[8 + w]; } }
    va = oa + ia - va; vb = ob + ib - vb;
    __syncthreads();
}
__device__ __forceinline__ void topk_item(const Args& a, LAS unsigned char* lds, int be) {
    const int tid = threadIdx.x, b = be >> 4, e = be & 15;
    unsigned char* ws = a.ws;
    LAS unsigned* keys = (LAS unsigned*)lds;
    LAS unsigned* hist = (LAS unsigned*)(lds + 16384);
    LAS int* ctl = (LAS int*)(lds + 16384 + 1024);
    LAS int* tmp = (LAS int*)(lds + 16384 + 1024 + 64);
    const float* aff = (const float*)(ws + WS_AFF) + (size_t)be * SEQ;
    unsigned my[8];
#pragma unroll
    for (int i = 0; i < 8; ++i) { my[i] = __float_as_uint(aff[tid * 8 + i]); keys[tid * 8 + i] = my[i]; }
    unsigned prefix = 0u, mask = 0u; int need = CAP;
    for (int pass = 0; pass < 4; ++pass) {
        const int shift = 24 - 8 * pass;
        if (tid < 256) hist[tid] = 0u;
        __syncthreads();
#pragma unroll
        for (int i = 0; i < 8; ++i) if ((my[i] & mask) == prefix) atomicAdd((unsigned*)&hist[(my[i] >> shift) & 255u], 1u);
        __syncthreads();
        {
            int hv = (tid < 256) ? (int)hist[255 - tid] : 0, inc = hv;
#pragma unroll
            for (int o = 1; o < 64; o <<= 1) { const int t2 = __shfl_up(inc, o); if ((tid & 63) >= o) inc += t2; }
            if ((tid & 63) == 63) tmp[tid >> 6] = inc;
            __syncthreads();
            int off = 0;
#pragma unroll
            for (int w = 0; w < 4; ++w) if (w < (tid >> 6)) off += tmp[w];
            inc += off;
            if (tid < 256 && inc >= need && inc - hv < need) { ctl[0] = 255 - tid; ctl[1] = need - (inc - hv); }
        }
        __syncthreads();
        prefix |= ((unsigned)ctl[0]) << shift; mask |= 255u << shift; need = ctl[1];
        __syncthreads();
    }
    const unsigned T = prefix;
    int cg = 0, ce = 0;
#pragma unroll
    for (int i = 0; i < 8; ++i) { cg += (my[i] > T) ? 1 : 0; ce += (my[i] == T) ? 1 : 0; }
    int pg = cg, pe = ce;
    block_excl_scan2(pg, pe, tmp);
    int* slot_of = (int*)(ws + WS_SLOT) + (size_t)be * SEQ;
    int* selt = (int*)(ws + WS_SELT) + (e * 4 + b) * CAP; float* selv = (float*)(ws + WS_SELV) + (e * 4 + b) * CAP;
#pragma unroll
    for (int i = 0; i < 8; ++i) { const int t = tid * 8 + i; const bool gt = my[i] > T, eq = my[i] == T; const bool sel = gt || (eq && pe < need);
        const int slot = pg + (pe < need ? pe : need);
        slot_of[t] = sel ? slot : -1;
        if (sel) { selt[slot] = t; selv[slot] = __uint_as_float(my[i]); }
        pg += gt ? 1 : 0; pe += eq ? 1 : 0; }
    __syncthreads();
}
__device__ __forceinline__ void phase_topk(const Args& a, LAS unsigned char* lds, unsigned& cdone) {
    const int tid = threadIdx.x, lane = tid & 63, wave = tid >> 6, wg = blockIdx.x, G = gridDim.x;
    unsigned char* ws = a.ws;
    for (int it = wg; it < NB * NE; it += G) topk_item(a, lds, it);
    __syncthreads();
    while (conv_try(a, lds, true, cdone)) {}
}

__device__ __forceinline__ void phase_final(const Args& a) {
    const int tid = threadIdx.x, lane = tid & 63, wave = tid >> 6, wg = blockIdx.x, G = gridDim.x;
    unsigned char* ws = a.ws;
    const float* modr = (const float*)(ws + WS_MOD); const int* slot_of = (const int*)(ws + WS_SLOT); const bf16* ys = (const bf16*)(ws + WS_YSLAB);
    const int NGW = G * NWAVES;
    f32x4 gf[4];
#pragma unroll
    for (int j = 0; j < 4; ++j) gf[j] = *(const f32x4*)(a.in[28] + 4 * lane + 256 * j);
#pragma nounroll
    for (int r0 = wg * NWAVES + wave; r0 < MX; r0 += 4 * NGW) {
        int sv[4]; unsigned long long mk[4]; f32x4 v[4][4], m[4][4];
#pragma unroll
        for (int k = 0; k < 4; ++k) { const int r = r0 + k * NGW; const bool ok = r < MX; const int rc = ok ? r : r0, b = rc >> 12, t = rc & 4095;
            sv[k] = (lane < NE) ? slot_of[((size_t)b * NE + lane) * SEQ + t] : -1;
#pragma unroll
            for (int j = 0; j < 4; ++j) { v[k][j] = *(const f32x4*)(a.out + (size_t)rc * DM + 4 * lane + 256 * j); m[k][j] = (f32x4){0.f, 0.f, 0.f, 0.f}; }
            mk[k] = (ok && !DBG_NOMOE) ? __ballot(sv[k] >= 0) : 0ull; }
        while (mk[0] | mk[1] | mk[2] | mk[3]) {
            v2u w[4][4]; float wt[4];
#pragma unroll
            for (int k = 0; k < 4; ++k) { const bool has = mk[k] != 0ull; const int e = has ? (int)__ffsll((long long)mk[k]) - 1 : 0; mk[k] &= mk[k] - 1ull;
                const int rc = (r0 + k * NGW < MX) ? r0 + k * NGW : r0; const int sl = has ? __builtin_amdgcn_readlane(sv[k], e) : 0;
                const bf16* yp = ys + ((size_t)e * 2048 + (rc >> 12) * CAP + sl) * DM; wt[k] = has ? 1.f : 0.f;
#pragma unroll
                for (int j = 0; j < 4; ++j) w[k][j] = *(const v2u*)(yp + 4 * lane + 256 * j); }
#pragma unroll
            for (int k = 0; k < 4; ++k)
#pragma unroll
                for (int j = 0; j < 4; ++j) { m[k][j][0] += wt[k] * bflo(w[k][j].x); m[k][j][1] += wt[k] * bfhi(w[k][j].x); m[k][j][2] += wt[k] * bflo(w[k][j].y); m[k][j][3] += wt[k] * bfhi(w[k][j].y); }
        }
        f32x4 gt[4][4];
#pragma unroll
        for (int k = 0; k < 4; ++k) { const int r = r0 + k * NGW, b = ((r < MX) ? r : r0) >> 12;
#pragma unroll
            for (int j = 0; j < 4; ++j) gt[k][j] = *(const f32x4*)(modr + b * 6144 + 5120 + 4 * lane + 256 * j); }
#pragma unroll
        for (int k = 0; k < 4; ++k) { const int r = r0 + k * NGW;
            if (r < MX) { float ss = 0.f; float* row = a.out + (size_t)r * DM;
#pragma unroll
                for (int j = 0; j < 4; ++j) { v[k][j] = v[k][j] + gt[k][j] * m[k][j] * DBG_MOE_K;
                    ss += v[k][j][0] * v[k][j][0] + v[k][j][1] * v[k][j][1] + v[k][j][2] * v[k][j][2] + v[k][j][3] * v[k][j][3]; }
                const float rs = rsqrtf(wave_sum(ss) * (1.0f / DM) + EPS);
#pragma unroll
                for (int j = 0; j < 4; ++j) *(f32x4*)(row + 4 * lane + 256 * j) = v[k][j] * rs * gf[j]; } }
    }
}

__global__ void __launch_bounds__(NTHR, 2) fwd_kernel(Args a) {
    extern __shared__ __attribute__((aligned(16))) unsigned char lds_raw[];
    LAS unsigned char* lds = (LAS unsigned char*)lds_raw;
    const int tid = threadIdx.x, wg = blockIdx.x, G = gridDim.x;
    unsigned char* ws = a.ws;
    volatile LAS unsigned* MISC = (volatile LAS unsigned*)(lds + LDS_MISC);
    if (tid < 64) MISC[tid] = 0u;
    __syncthreads();
    unsigned bgen = 0u, cdone = 0u;
    XcdBarrier bar; bar.bar = (unsigned*)(ws + WS_CTL); bar.x = 0; bar.st = nullptr;
    if (a.ph_hi - a.ph_lo > 1) bar = xcd_barrier_post((unsigned*)(ws + WS_CTL), MISC + 8);
#ifndef PH_ONLY
#define PH_ONLY -1
#endif
#define IN(k) ((PH_ONLY < 0 || PH_ONLY == (k)) && a.ph_lo <= (k) && (k) < a.ph_hi)
#ifndef DBG_BAR2
#define DBG_BAR2 0
#endif
#ifndef DBG_TSA
#define DBG_TSA -1
#endif
#ifndef DBG_TSB
#define DBG_TSB -1
#endif
#define STAMP(k) do { if (DBG_TSA >= 0 && wg == 0 && tid == 0) ((unsigned long long*)(ws + WS_CTL + 49152))[k] = __builtin_amdgcn_s_memrealtime(); } while (0)
#define SEAM(k) do { if (IN(k) && IN((k) + 1)) { seam_barrier(bar, a, lds, MISC, bgen, true, cdone); if (DBG_BAR2) xcd_barrier(bar); } STAMP((k) + 1); } while (0)
#ifndef DBG_DUP
#define DBG_DUP -1
#endif
#define REP(k) _Pragma("nounroll") for (int _rep = 0; _rep < ((DBG_DUP == (k)) ? 2 : 1); ++_rep, (void)((DBG_DUP == (k) && _rep == 1) ? (xcd_barrier(bar), 0) : 0))
    STAMP(0);
    if (IN(0)) REP(0) { phase0(a, lds); } SEAM(0);
    if (IN(1)) REP(1) { phase1(a, lds); } SEAM(1);
    if (IN(2)) REP(2) {
        pg8::Gemm g{(const pg8::bf16_t*)ws, (const pg8::bf16_t*)ws, MT, NIN, DM}; InSched S; S.init(G, wg, 0);
        EpiIn E{(bf16*)(ws + WS_QKVG), (bf16*)(ws + WS_HYT), (float*)(ws + WS_AFB)};
        pg8::gemm_phase<EpiIn, InSched, true, true>(lds, g, S, E);
    } SEAM(2);
    if (IN(3)) REP(3) {
        {   pg8::Gemm g{(const pg8::bf16_t*)ws, (const pg8::bf16_t*)ws, MT, NIN, DM}; InSched S; S.init(G, wg, 1);
            EpiIn E{(bf16*)(ws + WS_QKVG), (bf16*)(ws + WS_HYT), (float*)(ws + WS_AFB)};
            pg8::gemm_phase<EpiIn, InSched, true, true>(lds, g, S, E); }
        for (int it = wg; it < 512; it += G) hyena_item(a, lds, it, 0);
        {   GlaIn I, N; bool have = false;
            const bool split = (G == 256);
            const int first = split ? ((wg < 80) ? wg : 80 + wg) : wg, stride = split ? ((wg < 80) ? 80 : 176) : G, limit = split ? ((wg < 80) ? 160 : 16 * NCH) : 16 * NCH;
            for (int r = first; r < limit; r += stride) {
                const int nr = r + stride; const bool hasn = nr < limit;
                if (!have) { int t0 = threadIdx.x; asm volatile("" : "+v"(t0)); gla_load<false>(a, t0, r / NCH, r % NCH, I); have = true; }
                if (hasn) gla_upd_item<true>(a, lds, r / NCH, r % NCH, I, nr / NCH, nr % NCH, N); else gla_upd_item<false>(a, lds, r / NCH, r % NCH, I, 0, 0, N);
                I = N; } }
    } SEAM(3);
    if (IN(4)) REP(4) {
        for (int it = wg; it < 1024; it += G) { if (it < 512) hyena_item(a, lds, it, 1); else gla_scan_item(a, it - 512); }
    } SEAM(4);
    if (IN(5)) REP(5) {
        GlaIn I, N; bool have = false;
        for (int it = wg; it < 1280; it += G) {
            if (it >= 1024) { hy_transpose_item(a, lds, it - 1024); continue; }
            const int nr = it + G; const bool hasn = nr < 1024;
            if (!have) { int t0 = threadIdx.x; asm volatile("" : "+v"(t0)); gla_load<true>(a, t0, it >> 6, it & 63, I); have = true; }
            if (hasn) gla_out_item<true>(a, lds, it >> 6, it & 63, I, nr >> 6, nr & 63, N); else gla_out_item<false>(a, lds, it >> 6, it & 63, I, 0, 0, N);
            I = N; }
    } SEAM(5);
    if (IN(6)) REP(6) {
        pg8::Gemm g{(const pg8::bf16_t*)(ws + WS_AOUT), (const pg8::bf16_t*)(ws + WS_WOUT), MX, DM, DM}; pg8::StaticOrder S; S.init(MX, DM, G, wg);
        EpiOut E{a.in[0], (const float*)(ws + WS_POS), (const float*)(ws + WS_MOD), a.out};
        pg8::gemm_phase<EpiOut, pg8::StaticOrder, false, true>(lds, g, S, E);
    } SEAM(6);
    if (IN(7)) REP(7) { phase_router(a, lds); } SEAM(7);
    if (IN(8)) REP(8) { phase_topk(a, lds, cdone); } SEAM(8);
    if (IN(9)) REP(9) {
        pg8::Gemm g{(const pg8::bf16_t*)(ws + WS_HN), (const pg8::bf16_t*)(ws + WS_WGU), NE * 2048, NE * 2048, DM}; MoeSched<8> S; S.init(G, wg);
        EpiGU E{(bf16*)(ws + WS_HID)};
        pg8::gemm_phase_gather<EpiGU, MoeSched<8>, true, true>(lds, g, S, E, (const int*)(ws + WS_SELT));
    } SEAM(9);
    if (IN(10)) REP(10) {
        pg8::Gemm g{(const pg8::bf16_t*)(ws + WS_HID), (const pg8::bf16_t*)(ws + WS_WD), NE * 2048, NE * 1024, DM}; MoeSched<4> S; S.init(G, wg);
        EpiDown E{(bf16*)(ws + WS_YSLAB), (const float*)(ws + WS_SELV)};
        pg8::gemm_phase<EpiDown, MoeSched<4>, true, true>(lds, g, S, E);
    } SEAM(10);
    if (IN(11)) { phase_final(a); }
    if (DBG_TSA >= 0) {
        xcd_barrier(bar); STAMP(12); xcd_barrier(bar);
        const unsigned long long* ts = (const unsigned long long*)(ws + WS_CTL + 49152);
        const float da = (DBG_TSA == 12) ? (float)(ts[12] - ts[0]) * 0.01f : (float)(ts[DBG_TSA + 1] - ts[DBG_TSA]) * 0.01f;
        const float db = (DBG_TSB == 12) ? (float)(ts[12] - ts[0]) * 0.01f : (float)(ts[DBG_TSB + 1] - ts[DBG_TSB]) * 0.01f;
        for (size_t i = (size_t)wg * NTHR + tid; i < (size_t)MX * DM; i += (size_t)G * NTHR) a.out[i] = (i < (size_t)MX * DM / 2) ? da : db;
    }
#undef IN
#undef SEAM
}


#ifdef DBG_STATE
__global__ void chk_kernel(const unsigned* p, size_t nwords, unsigned long long* out) {
    unsigned long long s = 0ull;
    for (size_t i = (size_t)blockIdx.x * blockDim.x + threadIdx.x; i < nwords; i += (size_t)gridDim.x * blockDim.x) s += (unsigned long long)p[i] * (2ull * i + 1ull);
    for (int o = 1; o < 64; o <<= 1) s += __shfl_xor(s, o);
    if ((threadIdx.x & 63) == 0) atomicAdd(out, s);
}
__global__ void report_kernel(const unsigned long long* chk, float* out, int n) {
    int bad = -1;
    for (int p = 0; p < 27; ++p) if (chk[p] != chk[32 + p]) { bad = p; break; }
    if (bad < 0) return;
    for (int i = blockIdx.x * blockDim.x + threadIdx.x; i < n; i += gridDim.x * blockDim.x) out[i] = 1000.f * (float)(bad + 1);
}
struct ChkEnt { int ph; size_t off; size_t bytes; };
#endif
extern "C" void kernel_launch(void* const* d_in, const int* in_sizes, int n_in, void* d_out, int out_size, void* d_ws, size_t ws_size, hipStream_t stream) {
    static int grid = 0;
    if (grid == 0) {
        if (n_in != 29 || out_size != MX * DM || ws_size < WS_END) { fprintf(stderr, "kernel_launch: unexpected shapes (n_in %d out %d ws %zu)\n", n_in, out_size, ws_size); grid = -1; return; }
        int dev = 0, cus = 0, per_cu = 0;
        if (hipGetDevice(&dev) != hipSuccess || hipDeviceGetAttribute(&cus, hipDeviceAttributeMultiprocessorCount, dev) != hipSuccess) { grid = -1; return; }
        if (hipFuncSetAttribute((const void*)fwd_kernel, hipFuncAttributeMaxDynamicSharedMemorySize, LDS_BYTES) != hipSuccess) { fprintf(stderr, "kernel_launch: hipFuncSetAttribute failed\n"); grid = -1; return; }
        if (hipOccupancyMaxActiveBlocksPerMultiprocessor(&per_cu, (const void*)fwd_kernel, NTHR, LDS_BYTES) != hipSuccess || per_cu < 1) fprintf(stderr, "kernel_launch: occupancy query reports %d\n", per_cu);
        (void)hipGetLastError();
        grid = cus;
    }
    if (grid < 0) return;
    (void)hipMemsetAsync((char*)d_ws + WS_CTL, 0, CTL_BYTES, stream);
    Args a{};
    for (int i = 0; i < 29; ++i) a.in[i] = (const float*)d_in[i];
    a.out = (float*)d_out; a.ws = (unsigned char*)d_ws;
#if MK_SINGLE
#ifdef DBG_TWICE
    a.ph_lo = 0; a.ph_hi = NPH - 1;
    hipLaunchKernelGGL(fwd_kernel, dim3(grid), dim3(NTHR), LDS_BYTES, stream, a);
    (void)hipMemsetAsync((char*)d_ws + WS_CTL, 0, CTL_BYTES, stream);
#endif
    a.ph_lo = 0; a.ph_hi = NPH;
    hipLaunchKernelGGL(fwd_kernel, dim3(grid), dim3(NTHR), LDS_BYTES, stream, a);
#else
#ifdef DBG_STATE
    static const ChkEnt ents[] = { {0, WS_MOD, 122880}, {0, WS_POS, 131072}, {0, WS_HT, 32 * MiB}, {0, WS_WIN, (size_t)NIN * DM * 2}, {0, WS_WOUT, 2 * MiB},
        {1, WS_AIN, 34 * MiB}, {2, WS_QKVG, (size_t)MX * NQ * 2}, {2, WS_HYT, 48 * MiB}, {2, WS_AFB, (size_t)MT * 128},
        {3, WS_ZT, 32 * MiB}, {3, WS_DEC, (size_t)16 * 2 * NCH * 64 * 4}, {3, WS_UCTX, 4 * MiB}, {3, (size_t)-1, 64 * MiB},
        {4, WS_SPREV, 32 * MiB}, {4, WS_YHYT, 32 * MiB}, {5, WS_AOUT, 32 * MiB}, {6, (size_t)-1, 64 * MiB}, {7, WS_HN, 32 * MiB}, {7, WS_AFF, 1 * MiB},
        {8, WS_SLOT, 1 * MiB}, {8, WS_SELT, 131072}, {8, WS_SELV, 131072}, {8, WS_WGU, 64 * MiB}, {8, WS_WD, 32 * MiB}, {9, WS_HID, 64 * MiB}, {10, WS_YSLAB, 64 * MiB}, {11, (size_t)-1, 64 * MiB} };
    unsigned long long* chk = (unsigned long long*)((char*)d_ws + 32768);
    for (int run = 0; run < 2; ++run)
        for (int p = 0; p < NPH; ++p) { a.ph_lo = p; a.ph_hi = p + 1; hipLaunchKernelGGL(fwd_kernel, dim3(grid), dim3(NTHR), LDS_BYTES, stream, a);
            for (const ChkEnt& e : ents) if (e.ph == p) hipLaunchKernelGGL(chk_kernel, dim3(1024), dim3(256), 0, stream, (const unsigned*)(e.off == (size_t)-1 ? (char*)d_out : (char*)d_ws + e.off), e.bytes / 4, chk + run * 32 + (int)(&e - ents)); }
    hipLaunchKernelGGL(report_kernel, dim3(1024), dim3(256), 0, stream, (const unsigned long long*)chk, (float*)d_out, out_size);
#else
    for (int p = 0; p < NPH; ++p) { a.ph_lo = p; a.ph_hi = p + 1; hipLaunchKernelGGL(fwd_kernel, dim3(grid), dim3(NTHR), LDS_BYTES, stream, a); }
#endif
#endif
}
```

```cpp
#include <hip/hip_runtime.h>
#include <cstdio>
#include <cstdint>
#define MK_SINGLE 1
namespace pg8 {
#define PG8_LAS __attribute__((address_space(3)))
typedef unsigned short bf16_t;
typedef short bf16x8 __attribute__((ext_vector_type(8)));
typedef float f32x4 __attribute__((ext_vector_type(4)));
typedef unsigned u32x4 __attribute__((ext_vector_type(4)));
constexpr int BM = 256, BK = 64, HALF = 128, HTB = HALF * BK * 2  , STAGE_BYTES = 8 * HTB, NXCD = 8, WGM = 8;

__host__ __device__ __forceinline__ int lds_byte(int r, int c) { const int st = (r >> 4) * 2 + (c >> 5), rr = r & 15, cc = c & 31, ob = rr * 64 + cc * 2; return st * 1024 + (ob ^ (((ob >> 9) & 1) << 5)); }
__host__ __device__ __forceinline__ void stage_rc(int b, int& R, int& C) { const int st = b / 1024, sb = b % 1024, swz = sb ^ (((sb >> 9) & 1) << 5); R = (st >> 1) * 16 + swz / 64; C = (st & 1) * 32 + (swz % 64) / 2; }
__host__ __device__ __forceinline__ int perm32(int rho) { const int n = rho >> 4, i = rho & 15; return 8 * (i >> 2) + 4 * n + (i & 3); }

struct Unit { int pm, pn; };
struct Gemm { const bf16_t* A; const bf16_t* Bt; int M, N, K; };

struct StaticOrder {
    int nM, nN, nwg, G, c;
    __host__ __device__ void init(int M, int N, int G_, int c_) { nM = M / BM; nN = N / BM; nwg = nM * nN; G = G_; c = c_; }
    __host__ __device__ bool next(int i, Unit& u) const {
        const long L = (long)i * G + c; if (L >= nwg) return false;
        int wgid = (int)L; { const int q = nwg / NXCD, r = nwg % NXCD, xcd = wgid % NXCD, off = wgid / NXCD; wgid = (xcd < r ? xcd * (q + 1) : r * (q + 1) + (xcd - r) * q) + off; }
        const int nig = WGM * nN, gid = wgid / nig, fm = gid * WGM, gsz = (nM - fm) < WGM ? (nM - fm) : WGM;
        u.pm = fm + ((wgid % nig) % gsz); u.pn = (wgid % nig) / gsz; return true;
    }
    __device__ __forceinline__ void a_ready(const Unit&) const {}
    __device__ __forceinline__ void done(const Unit&) const {}
};

__device__ __forceinline__ unsigned cvt_pk_bf16(float lo, float hi) { unsigned r; asm volatile("v_cvt_pk_bf16_f32 %0, %1, %2" : "=v"(r) : "v"(lo), "v"(hi)); return r; }
template <class Epi, class Sched, bool ALIGN_EPI = false, bool SP2 = false>
__device__ __forceinline__ void gemm_phase(PG8_LAS unsigned char* lds, const Gemm g, const Sched& S, const Epi& E) {
    const int tid = threadIdx.x, wid = __builtin_amdgcn_readfirstlane(tid >> 6), lane = tid & 63, wr = wid >> 2, wc = wid & 3, fr = lane & 15, fq = lane >> 4;
    const int K = g.K, nt = K / BK;
    unsigned voffA[2], voffB[2];
#pragma unroll
    for (int i = 0; i < 2; ++i) { int R, C; stage_rc(tid * 16 + i * 8192, R, C); const int Rb = Epi::PERM ? ((R & ~31) + perm32(R & 31)) : R;
        voffA[i] = (unsigned)(R * K + C) * 2u; voffB[i] = (unsigned)(Rb * K + C) * 2u; }
    const size_t kstep = (size_t)(BK * 2);
    const size_t hstep = (size_t)HALF * K * 2;
    const size_t tstep = 2 * hstep;
    const unsigned ldsw = (unsigned)wid * 1024u;
    const int aoff = lds_byte(wr * 64 + fr, fq * 8), boff = lds_byte(wc * 32 + fr, fq * 8);
#define PG8_SA(b, h) (((b) * 2 + (h)) * HTB)
#define PG8_SB(b, h) ((4 + (b) * 2 + (h)) * HTB)
#define PG8_STAGE(bufoff, gbase, voff) do { _Pragma("unroll") for (int _i = 0; _i < 2; ++_i) \
        __builtin_amdgcn_global_load_lds((const unsigned*)((const char*)(gbase) + (voff)[_i]), (PG8_LAS unsigned*)(lds + (bufoff) + ldsw + _i * 8192), 16, 0, 0); } while (0)
#define PG8_LDA(dst, b, h) do { _Pragma("unroll") for (int m = 0; m < 4; ++m) _Pragma("unroll") for (int k = 0; k < 2; ++k) dst[m][k] = *(const PG8_LAS bf16x8*)(lds + PG8_SA(b, h) + aoff + m * 2048 + k * 1024); } while (0)
#define PG8_LDB(dst, b, h) do { _Pragma("unroll") for (int n = 0; n < 2; ++n) _Pragma("unroll") for (int k = 0; k < 2; ++k) dst[n][k] = *(const PG8_LAS bf16x8*)(lds + PG8_SB(b, h) + boff + n * 2048 + k * 1024); } while (0)
#define PG8_MMA(ai, bj, At, Bt) do { __builtin_amdgcn_s_setprio(1); _Pragma("unroll") for (int m = 0; m < 4; ++m) _Pragma("unroll") for (int n = 0; n < 2; ++n) _Pragma("unroll") for (int k = 0; k < 2; ++k) \
        acc[ai][bj][m][n] = __builtin_amdgcn_mfma_f32_16x16x32_bf16(Bt[n][k], At[m][k], acc[ai][bj][m][n], 0, 0, 0); __builtin_amdgcn_s_setprio(0); } while (0)
#define PG8_WAIT_V(n) asm volatile("s_waitcnt vmcnt(" #n ")" ::: "memory")
#define PG8_WAIT_L(n) asm volatile("s_waitcnt lgkmcnt(" #n ")" ::: "memory")
#define PG8_BAR __builtin_amdgcn_s_barrier()
#define PG8_SCHED __builtin_amdgcn_sched_barrier(0)
    Unit cur, nxt; int ui = 0;
    if (!S.next(0, cur)) return;
    f32x4 acc[2][2][4][2];
#pragma unroll
    for (int a = 0; a < 2; ++a)
#pragma unroll
        for (int b = 0; b < 2; ++b)
#pragma unroll
            for (int m = 0; m < 4; ++m)
#pragma unroll
                for (int n = 0; n < 2; ++n) acc[a][b][m][n] = (f32x4){0.f, 0.f, 0.f, 0.f};
    bf16x8 At[4][2], B0[2][2], B1[2][2];
    const char* cA = (const char*)g.A + (size_t)cur.pm * tstep; const char* cB = (const char*)g.Bt + (size_t)cur.pn * tstep;
    S.a_ready(cur);
    if constexpr (SP2) {
        PG8_STAGE(PG8_SB(0, 0), cB, voffB); PG8_STAGE(PG8_SB(0, 1), cB + hstep, voffB); PG8_STAGE(PG8_SA(0, 0), cA, voffA); PG8_STAGE(PG8_SA(0, 1), cA + hstep, voffA);
        if (wr == 1) PG8_BAR;
        PG8_WAIT_V(2); PG8_BAR;
        PG8_STAGE(PG8_SB(1, 0), cB + kstep, voffB); PG8_STAGE(PG8_SA(1, 0), cA + kstep, voffA); PG8_STAGE(PG8_SB(1, 1), cB + hstep + kstep, voffB);
        PG8_WAIT_V(6); PG8_BAR;
    } else {
        PG8_STAGE(PG8_SB(0, 0), cB, voffB); PG8_STAGE(PG8_SA(0, 0), cA, voffA); PG8_STAGE(PG8_SB(0, 1), cB + hstep, voffB); PG8_STAGE(PG8_SA(0, 1), cA + hstep, voffA);
        if (wr == 1) PG8_BAR;
        PG8_WAIT_V(4); PG8_BAR;
        PG8_STAGE(PG8_SB(1, 0), cB + kstep, voffB); PG8_STAGE(PG8_SA(1, 0), cA + kstep, voffA); PG8_STAGE(PG8_SB(1, 1), cB + hstep + kstep, voffB);
        PG8_WAIT_V(6); PG8_BAR;
    }
    for (;;) {
        const bool has_next = S.next(ui + 1, nxt);
        const char* nA = has_next ? (const char*)g.A + (size_t)nxt.pm * tstep : cA; const char* nB = has_next ? (const char*)g.Bt + (size_t)nxt.pn * tstep : cB;
        for (int t = 0; t < nt; t += 2) {
            const bool last = (t == nt - 2);
            const char* a1 = cA + (size_t)(t + 1) * kstep;
            const char* a2 = last ? nA : cA + (size_t)(t + 2) * kstep; const char* b2 = last ? nB : cB + (size_t)(t + 2) * kstep;
            const char* a3 = a2 + kstep; const char* b3 = b2 + kstep;
            if (last && has_next) S.a_ready(nxt);
            if constexpr (SP2) {
            PG8_LDB(B0, 0, 0); PG8_LDB(B1, 0, 1); PG8_SCHED; PG8_LDA(At, 0, 0); PG8_STAGE(PG8_SA(1, 1), a1 + hstep, voffA);
            PG8_WAIT_V(8); PG8_WAIT_L(0); PG8_BAR; PG8_MMA(0, 0, At, B0); PG8_MMA(0, 1, At, B1); PG8_BAR; PG8_SCHED;
            PG8_LDA(At, 0, 1); PG8_STAGE(PG8_SB(0, 0), b2, voffB); PG8_STAGE(PG8_SB(0, 1), b2 + hstep, voffB); PG8_STAGE(PG8_SA(0, 0), a2, voffA);
            PG8_WAIT_V(8); PG8_WAIT_L(0); PG8_BAR; PG8_MMA(1, 0, At, B0); PG8_MMA(1, 1, At, B1); PG8_BAR; PG8_SCHED;
            PG8_LDB(B0, 1, 0); PG8_LDB(B1, 1, 1); PG8_SCHED; PG8_LDA(At, 1, 0); PG8_STAGE(PG8_SA(0, 1), a2 + hstep, voffA);
            PG8_WAIT_V(8); PG8_WAIT_L(0); PG8_BAR; PG8_MMA(0, 0, At, B0); PG8_MMA(0, 1, At, B1); PG8_BAR; PG8_SCHED;
            PG8_LDA(At, 1, 1); PG8_STAGE(PG8_SB(1, 0), b3, voffB); PG8_STAGE(PG8_SB(1, 1), b3 + hstep, voffB); PG8_STAGE(PG8_SA(1, 0), a3, voffA);
            PG8_WAIT_V(8); PG8_WAIT_L(0); PG8_BAR; PG8_MMA(1, 0, At, B0); PG8_MMA(1, 1, At, B1); PG8_BAR; PG8_SCHED;
            } else {
            PG8_LDB(B0, 0, 0); PG8_SCHED; PG8_LDA(At, 0, 0); PG8_STAGE(PG8_SA(1, 1), a1 + hstep, voffA);
            PG8_WAIT_L(8); PG8_BAR; PG8_WAIT_L(0); PG8_MMA(0, 0, At, B0); PG8_BAR; PG8_SCHED;
            PG8_LDB(B1, 0, 1); PG8_STAGE(PG8_SB(0, 0), b2, voffB);
            PG8_BAR; PG8_WAIT_L(0); PG8_MMA(0, 1, At, B1); PG8_BAR;
            PG8_LDA(At, 0, 1); PG8_STAGE(PG8_SA(0, 0), a2, voffA);
            PG8_BAR; PG8_WAIT_L(0); PG8_MMA(1, 0, At, B0); PG8_BAR; PG8_SCHED;
            PG8_STAGE(PG8_SB(0, 1), b2 + hstep, voffB);
            PG8_WAIT_V(6); PG8_BAR; PG8_MMA(1, 1, At, B1); PG8_BAR;
            PG8_LDB(B0, 1, 0); PG8_SCHED; PG8_LDA(At, 1, 0); PG8_STAGE(PG8_SA(0, 1), a2 + hstep, voffA);
            PG8_WAIT_L(8); PG8_BAR; PG8_WAIT_L(0); PG8_MMA(0, 0, At, B0); PG8_BAR; PG8_SCHED;
            PG8_LDB(B1, 1, 1); PG8_STAGE(PG8_SB(1, 0), b3, voffB);
            PG8_BAR; PG8_WAIT_L(0); PG8_MMA(0, 1, At, B1); PG8_BAR;
            PG8_LDA(At, 1, 1); PG8_STAGE(PG8_SA(1, 0), a3, voffA);
            PG8_BAR; PG8_WAIT_L(0); PG8_MMA(1, 0, At, B0); PG8_BAR; PG8_SCHED;
            PG8_STAGE(PG8_SB(1, 1), b3 + hstep, voffB);
            PG8_WAIT_V(6); PG8_BAR; PG8_MMA(1, 1, At, B1); PG8_BAR;
            }
        }
        if constexpr (ALIGN_EPI) { if (wr == 0) PG8_BAR; }
        if constexpr (!Epi::AFTER_DRAIN) { E(acc, cur, wr, wc, fr, fq); S.done(cur); }
        if (!has_next) break;
#pragma unroll
        for (int a = 0; a < 2; ++a)
#pragma unroll
            for (int b = 0; b < 2; ++b)
#pragma unroll
                for (int m = 0; m < 4; ++m)
#pragma unroll
                    for (int n = 0; n < 2; ++n) acc[a][b][m][n] = (f32x4){0.f, 0.f, 0.f, 0.f};
        cur = nxt; cA = nA; cB = nB; ++ui;
        if constexpr (ALIGN_EPI) { if (wr == 1) PG8_BAR; }
    }
    PG8_WAIT_V(0);
    if constexpr (!ALIGN_EPI) { if (wr == 0) PG8_BAR; }
    PG8_BAR;
    if constexpr (Epi::AFTER_DRAIN) { E.fused(acc, cur, wr, wc, fr, fq, lds, wid, lane); S.done(cur); }
#undef PG8_SA
#undef PG8_SB
#undef PG8_STAGE
#undef PG8_LDA
#undef PG8_LDB
#undef PG8_MMA
#undef PG8_WAIT_V
#undef PG8_WAIT_L
#undef PG8_BAR
#undef PG8_SCHED
}
}
namespace pg8 {
template <class Epi, class Sched, bool ALIGN_EPI = false, bool SP2 = false>
__device__ __forceinline__ void gemm_phase_gather(PG8_LAS unsigned char* lds, const Gemm g, const Sched& S, const Epi& E, const int* __restrict__ idx) {
    const int tid = threadIdx.x, wid = __builtin_amdgcn_readfirstlane(tid >> 6), lane = tid & 63, wr = wid >> 2, wc = wid & 3, fr = lane & 15, fq = lane >> 4;
    const int K = g.K, nt = K / BK;
    unsigned voffB[2]; int RA[2], CA[2];
#pragma unroll
    for (int i = 0; i < 2; ++i) { int R, C; stage_rc(tid * 16 + i * 8192, R, C); const int Rb = Epi::PERM ? ((R & ~31) + perm32(R & 31)) : R;
        RA[i] = R; CA[i] = C; voffB[i] = (unsigned)(Rb * K + C) * 2u; }
    unsigned vA[2][2], nvA[2][2];
#define PG8_GOFF(dst, pm) do { _Pragma("unroll") for (int _h = 0; _h < 2; ++_h) _Pragma("unroll") for (int _i = 0; _i < 2; ++_i) { const int _r = (pm) * 256 + _h * 128 + RA[_i]; \
        dst[_h][_i] = (unsigned)((((_r >> 9) & 3) * 4096 + idx[_r]) * K + CA[_i]) * 2u; } } while (0)
    const size_t kstep = (size_t)(BK * 2);
    const size_t hstep = (size_t)HALF * K * 2;
    const size_t tstep = 2 * hstep;
    const unsigned ldsw = (unsigned)wid * 1024u;
    const int aoff = lds_byte(wr * 64 + fr, fq * 8), boff = lds_byte(wc * 32 + fr, fq * 8);
#define PG8_SA(b, h) (((b) * 2 + (h)) * HTB)
#define PG8_SB(b, h) ((4 + (b) * 2 + (h)) * HTB)
#define PG8_STAGE(bufoff, gbase, voff) do { _Pragma("unroll") for (int _i = 0; _i < 2; ++_i) \
        __builtin_amdgcn_global_load_lds((const unsigned*)((const char*)(gbase) + (voff)[_i]), (PG8_LAS unsigned*)(lds + (bufoff) + ldsw + _i * 8192), 16, 0, 0); } while (0)
#define PG8_LDA(dst, b, h) do { _Pragma("unroll") for (int m = 0; m < 4; ++m) _Pragma("unroll") for (int k = 0; k < 2; ++k) dst[m][k] = *(const PG8_LAS bf16x8*)(lds + PG8_SA(b, h) + aoff + m * 2048 + k * 1024); } while (0)
#define PG8_LDB(dst, b, h) do { _Pragma("unroll") for (int n = 0; n < 2; ++n) _Pragma("unroll") for (int k = 0; k < 2; ++k) dst[n][k] = *(const PG8_LAS bf16x8*)(lds + PG8_SB(b, h) + boff + n * 2048 + k * 1024); } while (0)
#define PG8_MMA(ai, bj, At, Bt) do { __builtin_amdgcn_s_setprio(1); _Pragma("unroll") for (int m = 0; m < 4; ++m) _Pragma("unroll") for (int n = 0; n < 2; ++n) _Pragma("unroll") for (int k = 0; k < 2; ++k) \
        acc[ai][bj][m][n] = __builtin_amdgcn_mfma_f32_16x16x32_bf16(Bt[n][k], At[m][k], acc[ai][bj][m][n], 0, 0, 0); __builtin_amdgcn_s_setprio(0); } while (0)
#define PG8_WAIT_V(n) asm volatile("s_waitcnt vmcnt(" #n ")" ::: "memory")
#define PG8_WAIT_L(n) asm volatile("s_waitcnt lgkmcnt(" #n ")" ::: "memory")
#define PG8_BAR __builtin_amdgcn_s_barrier()
#define PG8_SCHED __builtin_amdgcn_sched_barrier(0)
    Unit cur, nxt; int ui = 0;
    if (!S.next(0, cur)) return;
    f32x4 acc[2][2][4][2];
#pragma unroll
    for (int a = 0; a < 2; ++a)
#pragma unroll
        for (int b = 0; b < 2; ++b)
#pragma unroll
            for (int m = 0; m < 4; ++m)
#pragma unroll
                for (int n = 0; n < 2; ++n) acc[a][b][m][n] = (f32x4){0.f, 0.f, 0.f, 0.f};
    bf16x8 At[4][2], B0[2][2], B1[2][2];
    const char* cA = (const char*)g.A; PG8_GOFF(vA, cur.pm); const char* cB = (const char*)g.Bt + (size_t)cur.pn * tstep;
    S.a_ready(cur);
    if constexpr (SP2) {
        PG8_STAGE(PG8_SB(0, 0), cB, voffB); PG8_STAGE(PG8_SB(0, 1), cB + hstep, voffB); PG8_STAGE(PG8_SA(0, 0), cA, vA[0]); PG8_STAGE(PG8_SA(0, 1), cA, vA[1]);
        if (wr == 1) PG8_BAR;
        PG8_WAIT_V(2); PG8_BAR;
        PG8_STAGE(PG8_SB(1, 0), cB + kstep, voffB); PG8_STAGE(PG8_SA(1, 0), cA + kstep, vA[0]); PG8_STAGE(PG8_SB(1, 1), cB + hstep + kstep, voffB);
        PG8_WAIT_V(6); PG8_BAR;
    } else {
        PG8_STAGE(PG8_SB(0, 0), cB, voffB); PG8_STAGE(PG8_SA(0, 0), cA, vA[0]); PG8_STAGE(PG8_SB(0, 1), cB + hstep, voffB); PG8_STAGE(PG8_SA(0, 1), cA, vA[1]);
        if (wr == 1) PG8_BAR;
        PG8_WAIT_V(4); PG8_BAR;
        PG8_STAGE(PG8_SB(1, 0), cB + kstep, voffB); PG8_STAGE(PG8_SA(1, 0), cA + kstep, vA[0]); PG8_STAGE(PG8_SB(1, 1), cB + hstep + kstep, voffB);
        PG8_WAIT_V(6); PG8_BAR;
    }
    for (;;) {
        const bool has_next = S.next(ui + 1, nxt);
        if (has_next) { PG8_GOFF(nvA, nxt.pm); } else { nvA[0][0] = vA[0][0]; nvA[0][1] = vA[0][1]; nvA[1][0] = vA[1][0]; nvA[1][1] = vA[1][1]; } const char* nB = has_next ? (const char*)g.Bt + (size_t)nxt.pn * tstep : cB;
        for (int t = 0; t < nt; t += 2) {
            const bool last = (t == nt - 2);
            const char* a1 = cA + (size_t)(t + 1) * kstep;
            const char* a2 = cA + (last ? (size_t)0 : (size_t)(t + 2) * kstep); unsigned w2[2][2]; w2[0][0] = last ? nvA[0][0] : vA[0][0]; w2[0][1] = last ? nvA[0][1] : vA[0][1]; w2[1][0] = last ? nvA[1][0] : vA[1][0]; w2[1][1] = last ? nvA[1][1] : vA[1][1]; const char* b2 = last ? nB : cB + (size_t)(t + 2) * kstep;
            const char* a3 = a2 + kstep; const char* b3 = b2 + kstep;
            if (last && has_next) S.a_ready(nxt);
            if constexpr (SP2) {
            PG8_LDB(B0, 0, 0); PG8_LDB(B1, 0, 1); PG8_SCHED; PG8_LDA(At, 0, 0); PG8_STAGE(PG8_SA(1, 1), a1, vA[1]);
            PG8_WAIT_V(8); PG8_WAIT_L(0); PG8_BAR; PG8_MMA(0, 0, At, B0); PG8_MMA(0, 1, At, B1); PG8_BAR; PG8_SCHED;
            PG8_LDA(At, 0, 1); PG8_STAGE(PG8_SB(0, 0), b2, voffB); PG8_STAGE(PG8_SB(0, 1), b2 + hstep, voffB); PG8_STAGE(PG8_SA(0, 0), a2, w2[0]);
            PG8_WAIT_V(8); PG8_WAIT_L(0); PG8_BAR; PG8_MMA(1, 0, At, B0); PG8_MMA(1, 1, At, B1); PG8_BAR; PG8_SCHED;
            PG8_LDB(B0, 1, 0); PG8_LDB(B1, 1, 1); PG8_SCHED; PG8_LDA(At, 1, 0); PG8_STAGE(PG8_SA(0, 1), a2, w2[1]);
            PG8_WAIT_V(8); PG8_WAIT_L(0); PG8_BAR; PG8_MMA(0, 0, At, B0); PG8_MMA(0, 1, At, B1); PG8_BAR; PG8_SCHED;
            PG8_LDA(At, 1, 1); PG8_STAGE(PG8_SB(1, 0), b3, voffB); PG8_STAGE(PG8_SB(1, 1), b3 + hstep, voffB); PG8_STAGE(PG8_SA(1, 0), a3, w2[0]);
            PG8_WAIT_V(8); PG8_WAIT_L(0); PG8_BAR; PG8_MMA(1, 0, At, B0); PG8_MMA(1, 1, At, B1); PG8_BAR; PG8_SCHED;
            } else {
            PG8_LDB(B0, 0, 0); PG8_SCHED; PG8_LDA(At, 0, 0); PG8_STAGE(PG8_SA(1, 1), a1, vA[1]);
            PG8_WAIT_L(8); PG8_BAR; PG8_WAIT_L(0); PG8_MMA(0, 0, At, B0); PG8_BAR; PG8_SCHED;
            PG8_LDB(B1, 0, 1); PG8_STAGE(PG8_SB(0, 0), b2, voffB);
            PG8_BAR; PG8_WAIT_L(0); PG8_MMA(0, 1, At, B1); PG8_BAR;
            PG8_LDA(At, 0, 1); PG8_STAGE(PG8_SA(0, 0), a2, w2[0]);
            PG8_BAR; PG8_WAIT_L(0); PG8_MMA(1, 0, At, B0); PG8_BAR; PG8_SCHED;
            PG8_STAGE(PG8_SB(0, 1), b2 + hstep, voffB);
            PG8_WAIT_V(6); PG8_BAR; PG8_MMA(1, 1, At, B1); PG8_BAR;
            PG8_LDB(B0, 1, 0); PG8_SCHED; PG8_LDA(At, 1, 0); PG8_STAGE(PG8_SA(0, 1), a2, w2[1]);
            PG8_WAIT_L(8); PG8_BAR; PG8_WAIT_L(0); PG8_MMA(0, 0, At, B0); PG8_BAR; PG8_SCHED;
            PG8_LDB(B1, 1, 1); PG8_STAGE(PG8_SB(1, 0), b3, voffB);
            PG8_BAR; PG8_WAIT_L(0); PG8_MMA(0, 1, At, B1); PG8_BAR;
            PG8_LDA(At, 1, 1); PG8_STAGE(PG8_SA(1, 0), a3, w2[0]);
            PG8_BAR; PG8_WAIT_L(0); PG8_MMA(1, 0, At, B0); PG8_BAR; PG8_SCHED;
            PG8_STAGE(PG8_SB(1, 1), b3 + hstep, voffB);
            PG8_WAIT_V(6); PG8_BAR; PG8_MMA(1, 1, At, B1); PG8_BAR;
            }
        }
        if constexpr (ALIGN_EPI) { if (wr == 0) PG8_BAR; }
        if constexpr (!Epi::AFTER_DRAIN) { E(acc, cur, wr, wc, fr, fq); S.done(cur); }
        if (!has_next) break;
#pragma unroll
        for (int a = 0; a < 2; ++a)
#pragma unroll
            for (int b = 0; b < 2; ++b)
#pragma unroll
                for (int m = 0; m < 4; ++m)
#pragma unroll
                    for (int n = 0; n < 2; ++n) acc[a][b][m][n] = (f32x4){0.f, 0.f, 0.f, 0.f};
        cur = nxt; cB = nB; ++ui; vA[0][0] = nvA[0][0]; vA[0][1] = nvA[0][1]; vA[1][0] = nvA[1][0]; vA[1][1] = nvA[1][1];
        if constexpr (ALIGN_EPI) { if (wr == 1) PG8_BAR; }
    }
    PG8_WAIT_V(0);
    if constexpr (!ALIGN_EPI) { if (wr == 0) PG8_BAR; }
    PG8_BAR;
    if constexpr (Epi::AFTER_DRAIN) { E.fused(acc, cur, wr, wc, fr, fq, lds, wid, lane); S.done(cur); }
#undef PG8_SA
#undef PG8_SB
#undef PG8_STAGE
#undef PG8_LDA
#undef PG8_LDB
#undef PG8_MMA
#undef PG8_WAIT_V
#undef PG8_WAIT_L
#undef PG8_BAR
#undef PG8_SCHED
#undef PG8_GOFF
}
}

#ifndef DBG_NOMIX
#define DBG_NOMIX 0
#endif
#ifndef DBG_NOMOE
#define DBG_NOMOE 0
#endif
#ifndef DBG_NOPOS
#define DBG_NOPOS 0
#endif
#ifndef DBG_HTCONST
#define DBG_HTCONST 0
#endif
#ifndef DBG_GLA_K
#define DBG_GLA_K 1.0f
#endif
#ifndef DBG_MOE_K
#define DBG_MOE_K 1.0f
#endif
#ifndef MK_SINGLE
#define MK_SINGLE 0
#endif
#define GAS __attribute__((address_space(1)))
#define LAS __attribute__((address_space(3)))
typedef unsigned short bf16;
typedef float f32x4 __attribute__((ext_vector_type(4)));
typedef float f32x16 __attribute__((ext_vector_type(16)));
typedef short bf16x8 __attribute__((ext_vector_type(8)));
typedef unsigned v4u __attribute__((ext_vector_type(4)));
typedef unsigned v2u __attribute__((ext_vector_type(2)));
typedef GAS unsigned gu32;

constexpr int NWAVES = 8, NTHR = 512;
constexpr int NB = 4, SEQ = 4096, DM = 1024, CTXL = 256;
constexpr int MX = NB * SEQ, MC = NB * CTXL, MT = MX + MC;
constexpr int NIN = 3328, NQ = 1536, DIN = 3104;
constexpr int NE = 16, CAP = 512;
constexpr int NCH = 68;
constexpr int NPH = 12;
constexpr float EPS = 1e-6f;

constexpr size_t MiB = 1u << 20;
constexpr size_t WS_CTL = 0, CTL_BYTES = 65536;
constexpr int CW_CNT_D = 8192, CW_CNT_GU = 8192 + 64;
constexpr size_t WS_MOD = 1 * MiB, WS_POS = 1 * MiB + 256 * 1024, WS_DEC = 2 * MiB, WS_AFF = 3 * MiB, WS_SLOT = 4 * MiB, WS_SELT = 5 * MiB, WS_SELV = 5 * MiB + 256 * 1024;
constexpr size_t WS_UCTX = 6 * MiB, WS_AFB = 10 * MiB, WS_WIN = 13 * MiB, WS_WOUT = 20 * MiB;
constexpr size_t WS_R1 = 22 * MiB, WS_R2 = 56 * MiB, WS_R3 = 107 * MiB, WS_R4 = 203 * MiB, WS_R5 = 235 * MiB, WS_R6 = 267 * MiB, WS_END = 299 * MiB;
constexpr size_t WS_AIN = WS_R1, WS_ZT = 155 * MiB, WS_HN = WS_R1;
constexpr size_t WS_QKVG = WS_R2;
constexpr size_t WS_HYT = WS_R3, WS_WD = 171 * MiB;
constexpr size_t WS_WGU = WS_R5;
constexpr size_t WS_HID = WS_R2, WS_YSLAB = WS_R4;
constexpr size_t WS_HT = WS_R4, WS_AOUT = WS_R4;
constexpr size_t WS_X1B = 120 * MiB;
constexpr size_t WS_SPREV = WS_R1;
constexpr int LDS_BYTES = 144 * 1024;
constexpr int LDS_MISC = LDS_BYTES - 256;

struct Args { const float* in[29]; float* out; unsigned char* ws; int ph_lo, ph_hi; };

#define LDS_WAIT() asm volatile("s_waitcnt lgkmcnt(0)" ::: "memory")
#define VM_WAIT() asm volatile("s_waitcnt vmcnt(0)" ::: "memory")
__device__ __forceinline__ unsigned f2bf(float f) { unsigned u = __float_as_uint(f); return (u + 0x7fffu + ((u >> 16) & 1u)) >> 16; }
__device__ __forceinline__ unsigned pk2(float lo, float hi) { return pg8::cvt_pk_bf16(lo, hi); }
__device__ __forceinline__ float bflo(unsigned w) { return __uint_as_float(w << 16); }
__device__ __forceinline__ float bfhi(unsigned w) { return __uint_as_float(w & 0xffff0000u); }
template <int CTRL> __device__ __forceinline__ float dpp_f(float v) { return __builtin_bit_cast(float, __builtin_amdgcn_update_dpp(0, __builtin_bit_cast(int, v), CTRL, 0xf, 0xf, false)); }
__device__ __forceinline__ void swap16(float& a, float& b) { asm("v_nop\n\tv_nop\n\tv_permlane16_swap_b32 %0, %1" : "+v"(a), "+v"(b)); }
__device__ __forceinline__ void swap32(float& a, float& b) { asm("v_nop\n\tv_nop\n\tv_permlane32_swap_b32 %0, %1" : "+v"(a), "+v"(b)); }
__device__ __forceinline__ float row_allsum(float v) { v += dpp_f<0x128>(v); v += dpp_f<0x124>(v); v += dpp_f<0x122>(v); v += dpp_f<0x121>(v); return v; }
__device__ __forceinline__ float x16_sum(float v) { float a = v, b = v; swap16(a, b); return a + b; }
__device__ __forceinline__ float x32_sum(float v) { float a = v, b = v; swap32(a, b); return a + b; }
__device__ __forceinline__ float x16_max(float v) { float a = v, b = v; swap16(a, b); return fmaxf(a, b); }
__device__ __forceinline__ float x32_max(float v) { float a = v, b = v; swap32(a, b); return fmaxf(a, b); }
__device__ __forceinline__ float wave_sum(float v) { return x32_sum(x16_sum(row_allsum(v))); }
__device__ __forceinline__ float silu_f(float v) { return v * __builtin_amdgcn_rcpf(1.f + __expf(-v)); }
__device__ __forceinline__ float logsig_f(float x) { return fminf(x, 0.f) - __logf(1.0f + __expf(-fabsf(x))); }

#define XB_TMO      128
#define XB_XCNT(j)  (256  + 64 * (j))
#define XB_XSUB(j)  (1280 + 64 * (j))
#define XB_XGEN(j)  (2304 + 64 * (j))
#define XB_TOP      3328
#define XB_TOPGEN   3392
#define XCD_BAR_WORDS 3456
#define XB_SPIN_CAP (1u << 22)
__device__ __forceinline__ unsigned xb_ld(unsigned* p)              { return __hip_atomic_load(p, __ATOMIC_RELAXED, __HIP_MEMORY_SCOPE_AGENT); }
__device__ __forceinline__ unsigned xb_add(unsigned* p, unsigned v) { return __hip_atomic_fetch_add(p, v, __ATOMIC_RELAXED, __HIP_MEMORY_SCOPE_AGENT); }
__device__ __forceinline__ unsigned xb_xcc_id() { return (unsigned)__builtin_amdgcn_s_getreg((3 << 11) | 20) & 0xFu; }
#define XB_SPIN(cond, bar) do { unsigned _sp = 0; while (cond) { __builtin_amdgcn_s_sleep(1); \
    if ((++_sp & 255u) == 0u) { if (xb_ld(&(bar)[XB_TMO])) break; if (_sp > XB_SPIN_CAP) { atomicAdd(&(bar)[XB_TMO], 1u); break; } } } } while (0)
struct XcdBarrier { unsigned* bar; unsigned x; volatile LAS unsigned* st; };
__device__ __forceinline__ XcdBarrier xcd_barrier_post(unsigned* bar, volatile LAS unsigned* st) {
    XcdBarrier b; b.bar = bar; b.x = xb_xcc_id(); b.st = st;
    if (threadIdx.x == 0) (void)xb_add(&bar[XB_XCNT(b.x)], 1u);
    return b;
}
__device__ __forceinline__ void xcd_barrier_complete(unsigned* bar, unsigned x, unsigned& nloc, unsigned& nx) {
    const unsigned G = gridDim.x * gridDim.y * gridDim.z;
    unsigned sum, cnt, mine, sp = 0u;
    for (;;) {
        sum = 0u; cnt = 0u; mine = 0u;
#pragma unroll
        for (unsigned j = 0; j < 16; ++j) { const unsigned c = xb_ld(&bar[XB_XCNT(j)]); sum += c; cnt += (c > 0u) ? 1u : 0u; mine = (j == x) ? c : mine; }
        if (sum == G) break;
        __builtin_amdgcn_s_sleep(1);
        if ((++sp & 255u) == 0u) { if (xb_ld(&bar[XB_TMO])) break; if (sp > XB_SPIN_CAP) { atomicAdd(&bar[XB_TMO], 1u); break; } }
    }
    nloc = mine > 0u ? mine : 1u; nx = cnt > 0u ? cnt : 1u;
}
__device__ __forceinline__ void xcd_barrier(const XcdBarrier& b) {
    asm volatile("s_waitcnt vmcnt(0)" ::: "memory");
    __syncthreads();
    if (threadIdx.x == 0) {
        unsigned* bar = b.bar;
        __builtin_amdgcn_s_waitcnt(0);
        unsigned nloc = b.st[0], nx = b.st[1];
        if (nloc == 0u) { xcd_barrier_complete(bar, b.x, nloc, nx); b.st[0] = nloc; b.st[1] = nx; }
        const unsigned old = xb_add(&bar[XB_XSUB(b.x)], 1u);
        const unsigned gen = old / nloc;
        if (old + 1u == (gen + 1u) * nloc) {
            __builtin_amdgcn_fence(__ATOMIC_RELEASE, "agent");
            asm volatile("s_waitcnt vmcnt(0)" ::: "memory");
            const unsigned og = xb_add(&bar[XB_TOP], 1u);
            const unsigned tg = og / nx;
            if (og + 1u == (tg + 1u) * nx) xb_add(&bar[XB_TOPGEN], 1u);
            else XB_SPIN(xb_ld(&bar[XB_TOPGEN]) == tg, bar);
            __builtin_amdgcn_fence(__ATOMIC_ACQUIRE, "agent");
            xb_add(&bar[XB_XGEN(b.x)], 1u);
            asm volatile("s_waitcnt vmcnt(0)" ::: "memory");
        } else {
            XB_SPIN(xb_ld(&bar[XB_XGEN(b.x)]) == gen, bar);
            __builtin_amdgcn_fence(__ATOMIC_ACQUIRE, "agent");
            asm volatile("s_waitcnt vmcnt(0)" ::: "memory");
        }
    }
    __syncthreads();
}

constexpr int TILE_AIN = (int)(WS_AIN / (512 * 1024)), TILE_WIN = (int)(WS_WIN / (512 * 1024));
struct InSched {
    int G, c, part;
    __device__ void init(int G_, int c_, int part_) { G = G_; c = c_; part = part_; }
    __device__ static void qg_unit(int qg, pg8::Unit& u) { const int t = qg >> 6; u.pm = TILE_AIN + (qg & 63); u.pn = TILE_WIN + ((t == 0) ? 0 : 3 + t); }
    __device__ bool next(int i, pg8::Unit& u) const {
        const int L = i * G + c;
        if (part) { const int qg = 112 + L; if (qg >= 192) return false; qg_unit(qg, u); return true; }
        if (L < 384) { u.pm = TILE_WIN + 6 + (L >> 6); u.pn = TILE_AIN + (L & 63); return true; }
        if (L < 640) { const int l = L - 384, q = l >> 6; u.pm = TILE_AIN + (l & 63); u.pn = TILE_WIN + ((q == 3) ? 12 : (1 + q)); return true; }
        if (L < 656) { const int jx = L - 640, q = jx >> 2; u.pm = TILE_AIN + 64 + (jx & 3); u.pn = TILE_WIN + ((q == 3) ? 12 : (1 + q)); return true; }
        if (L >= 768) return false;
        qg_unit(L - 656, u); return true;
    }
    __device__ __forceinline__ void a_ready(const pg8::Unit&) const {}
    __device__ __forceinline__ void done(const pg8::Unit&) const {}
};
template <int NT> struct MoeSched {
    int G, c;
    __device__ void init(int G_, int c_) { G = G_; c = c_; }
    __device__ bool next(int i, pg8::Unit& u) const {
        const int L = i * G + c; if (L >= NE * 8 * NT) return false;
        const int e = L / (8 * NT), l = L % (8 * NT), x = l & 7, y = l >> 3;
        constexpr int HN = NT / 2;
        const int pm = 2 * (x >> 1) + (y / HN), pn = HN * (x & 1) + (y % HN);
        u.pm = e * 8 + pm; u.pn = e * NT + pn; return true;
    }
    __device__ __forceinline__ void a_ready(const pg8::Unit&) const {}
    __device__ __forceinline__ void done(const pg8::Unit&) const {}
};

struct EpiIn {
    static constexpr bool PERM = true, AFTER_DRAIN = false;
    bf16* qkvg; bf16* hyT; float* afb;
    __device__ __forceinline__ void operator()(const f32x4 (&acc)[2][2][4][2], const pg8::Unit& u, int wr, int wc, int fr, int fq) const {
        if (u.pm < TILE_AIN) {
            const int ch0 = (u.pm - TILE_WIN - 6) * 256 + wr * 64 + fr, mt = u.pn - TILE_AIN, b = mt >> 4, t0 = (mt & 15) * 256 + wc * 32 + 8 * fq;
#pragma unroll
            for (int ai = 0; ai < 2; ++ai)
#pragma unroll
                for (int m = 0; m < 4; ++m) { bf16* rowp = hyT + ((size_t)b * 1536 + ch0 + ai * 128 + m * 16) * SEQ + t0;
#pragma unroll
                    for (int bj = 0; bj < 2; ++bj) { const f32x4 v0 = acc[ai][bj][m][0], v1 = acc[ai][bj][m][1];
                        v4u w; w.x = pk2(v0[0], v0[1]); w.y = pk2(v0[2], v0[3]); w.z = pk2(v1[0], v1[1]); w.w = pk2(v1[2], v1[3]);
                        *(v4u*)(rowp + bj * 128) = w; } }
            return;
        }
        const int pm = u.pm - TILE_AIN, pn = u.pn - TILE_WIN;
        const int row0 = pm * 256 + wr * 64 + fr;
        if (pn < 6) {
            const float sc = (pn == 0) ? 0.125f : 1.f;
            const int col0 = pn * 256 + wc * 32 + 8 * fq;
#pragma unroll
            for (int ai = 0; ai < 2; ++ai)
#pragma unroll
                for (int m = 0; m < 4; ++m) { bf16* rowp = qkvg + (size_t)(row0 + ai * 128 + m * 16) * NQ + col0;
#pragma unroll
                    for (int bj = 0; bj < 2; ++bj) { const f32x4 v0 = acc[ai][bj][m][0] * sc, v1 = acc[ai][bj][m][1] * sc;
                        v4u w; w.x = pk2(v0[0], v0[1]); w.y = pk2(v0[2], v0[3]); w.z = pk2(v1[0], v1[1]); w.w = pk2(v1[2], v1[3]);
                        *(v4u*)(rowp + bj * 128) = w; } }
        } else {
            if (wc != 0) return;
#pragma unroll
            for (int ai = 0; ai < 2; ++ai)
#pragma unroll
                for (int m = 0; m < 4; ++m) { float* rowp = afb + (size_t)(row0 + ai * 128 + m * 16) * 32 + 8 * fq;
                    *(f32x4*)(rowp) = acc[ai][0][m][0]; *(f32x4*)(rowp + 4) = acc[ai][0][m][1]; }
        }
    }
};
struct EpiOut {
    static constexpr bool PERM = false, AFTER_DRAIN = false;
    const float* __restrict__ x; const float* __restrict__ postab; const float* __restrict__ modr; bf16* __restrict__ x1;
    __device__ __forceinline__ void operator()(const f32x4 (&acc)[2][2][4][2], const pg8::Unit& u, int wr, int wc, int fr, int fq) const {
        const int row0 = u.pm * 256 + wr * 64 + fr, col0 = u.pn * 256 + wc * 32 + 4 * fq;
        const int b = row0 >> 12;
        f32x4 gv[2][2];
#pragma unroll
        for (int bj = 0; bj < 2; ++bj)
#pragma unroll
            for (int n = 0; n < 2; ++n) gv[bj][n] = *(const f32x4*)(modr + b * 6144 + 2048 + col0 + bj * 128 + n * 16);
#pragma unroll
        for (int ai = 0; ai < 2; ++ai)
#pragma unroll
            for (int m = 0; m < 4; ++m) { const int r = row0 + ai * 128 + m * 16; const int t = r & 4095, rr = t >> 6, cc = t & 63;
                f32x4 xv[2][2], pv[2][2];
#pragma unroll
                for (int bj = 0; bj < 2; ++bj)
#pragma unroll
                    for (int n = 0; n < 2; ++n) { const int c = col0 + bj * 128 + n * 16;
                        xv[bj][n] = *(const f32x4*)(x + (size_t)r * DM + c);
                        pv[bj][n] = *(const f32x4*)(postab + ((c < 512) ? rr * 512 + c : cc * 512 + c - 512)); }
#pragma unroll
                for (int bj = 0; bj < 2; ++bj)
#pragma unroll
                    for (int n = 0; n < 2; ++n) { const int c = col0 + bj * 128 + n * 16;
                        const f32x4 y = xv[bj][n] + (DBG_NOPOS ? pv[bj][n] * 0.f : pv[bj][n]) + (DBG_NOMIX ? gv[bj][n] * 0.f : gv[bj][n] * acc[ai][bj][m][n]);
                        v2u w; w.x = pk2(y[0], y[1]); w.y = pk2(y[2], y[3]);
                        *(v2u*)(x1 + (size_t)r * DM + c) = w; } }
    }
};
struct EpiGU {
    static constexpr bool PERM = true, AFTER_DRAIN = false;
    bf16* hid;
    __device__ __forceinline__ void operator()(const f32x4 (&acc)[2][2][4][2], const pg8::Unit& u, int wr, int wc, int fr, int fq) const {
        const int row0 = u.pm * 256 + wr * 64 + fr, col0 = (u.pn & 7) * 128 + wc * 32 + 8 * fq;
#pragma unroll
        for (int ai = 0; ai < 2; ++ai)
#pragma unroll
            for (int m = 0; m < 4; ++m) { bf16* rowp = hid + (size_t)(row0 + ai * 128 + m * 16) * DM + col0;
                float o[8];
#pragma unroll
                for (int n = 0; n < 2; ++n)
#pragma unroll
                    for (int j = 0; j < 4; ++j) o[n * 4 + j] = silu_f(acc[ai][0][m][n][j]) * acc[ai][1][m][n][j];
                v4u w; w.x = pk2(o[0], o[1]); w.y = pk2(o[2], o[3]); w.z = pk2(o[4], o[5]); w.w = pk2(o[6], o[7]);
                *(v4u*)rowp = w; }
    }
};
struct EpiDown {
    static constexpr bool PERM = true, AFTER_DRAIN = false;
    bf16* __restrict__ ys; const float* __restrict__ selv;
    __device__ __forceinline__ void operator()(const f32x4 (&acc)[2][2][4][2], const pg8::Unit& u, int wr, int wc, int fr, int fq) const {
        const int row0 = u.pm * 256 + wr * 64 + fr, col0 = (u.pn & 3) * 256 + wc * 32 + 8 * fq;
        float scv[2][4];
#pragma unroll
        for (int ai = 0; ai < 2; ++ai)
#pragma unroll
            for (int m = 0; m < 4; ++m) scv[ai][m] = selv[row0 + ai * 128 + m * 16];
#pragma unroll
        for (int ai = 0; ai < 2; ++ai)
#pragma unroll
            for (int m = 0; m < 4; ++m) { const int r = row0 + ai * 128 + m * 16; const float sc = scv[ai][m]; bf16* rowp = ys + (size_t)r * DM + col0;
#pragma unroll
                for (int bj = 0; bj < 2; ++bj) { const f32x4 v0 = acc[ai][bj][m][0] * sc, v1 = acc[ai][bj][m][1] * sc;
                    v4u w; w.x = pk2(v0[0], v0[1]); w.y = pk2(v0[2], v0[3]); w.z = pk2(v1[0], v1[1]); w.w = pk2(v1[2], v1[3]);
                    *(v4u*)(rowp + bj * 128) = w; } }
    }
};

__device__ __forceinline__ void transpose_item(const float* W, int ldw, int k0, int nsrc0, bf16* WT, int K, int drow0, LAS float* scr, int lane, bool zero) {
    float tv[32];
#pragma unroll
    for (int i = 0; i < 32; ++i) { const int kk = 2 * i + (lane >> 5); tv[i] = zero ? 0.f : W[(size_t)(k0 + kk) * ldw + nsrc0 + (lane & 31)]; }
#pragma unroll
    for (int i = 0; i < 32; ++i) { const int kk = 2 * i + (lane >> 5); scr[kk * 33 + (lane & 31)] = tv[i]; }
    LDS_WAIT();
    const int c = lane & 7;
#pragma unroll
    for (int j = 0; j < 4; ++j) { const int n = (lane >> 3) + 8 * j; const LAS float* s = scr + (8 * c) * 33 + n;
        v4u o; o.x = pk2(s[0 * 33], s[1 * 33]); o.y = pk2(s[2 * 33], s[3 * 33]); o.z = pk2(s[4 * 33], s[5 * 33]); o.w = pk2(s[6 * 33], s[7 * 33]);
        *(v4u*)(WT + (size_t)(drow0 + n) * K + k0 + 8 * c) = o; }
    LDS_WAIT();
}

__device__ __forceinline__ void split8(const float (&x)[8], pg8::bf16x8& hi, pg8::bf16x8& lo) {
    v4u h, l;
#pragma unroll
    for (int e = 0; e < 4; ++e) { const unsigned w = pk2(x[2 * e], x[2 * e + 1]); h[e] = w; l[e] = pk2(x[2 * e] - bflo(w), x[2 * e + 1] - bfhi(w)); }
    hi = __builtin_bit_cast(pg8::bf16x8, h); lo = __builtin_bit_cast(pg8::bf16x8, l);
}
__device__ __forceinline__ f32x4 mfma3(pg8::bf16x8 ah, pg8::bf16x8 al, pg8::bf16x8 bh, pg8::bf16x8 bl, f32x4 acc) {
    acc = __builtin_amdgcn_mfma_f32_16x16x32_bf16(al, bh, acc, 0, 0, 0);
    acc = __builtin_amdgcn_mfma_f32_16x16x32_bf16(ah, bl, acc, 0, 0, 0);
    return __builtin_amdgcn_mfma_f32_16x16x32_bf16(ah, bh, acc, 0, 0, 0);
}
__device__ __forceinline__ void sine_layer(const LAS float* in, const LAS float* w, LAS float* out, const float* bias, const float* freq, int wave, int lane) {
    const int m16 = lane & 15, kg = lane >> 4, mt = wave >> 1, nt0 = (wave & 1) * 2;
    pg8::bf16x8 Ah[2], Al[2];
#pragma unroll
    for (int s = 0; s < 2; ++s) { const LAS float* hp = in + (16 * mt + m16) * 68 + 32 * s + 8 * kg; const f32x4 x = *(const LAS f32x4*)hp, y = *(const LAS f32x4*)(hp + 4);
        const float v[8] = {x[0], x[1], x[2], x[3], y[0], y[1], y[2], y[3]}; split8(v, Ah[s], Al[s]); }
#pragma unroll
    for (int t = 0; t < 2; ++t) { const int n = (nt0 + t) * 16 + m16; f32x4 acc = (f32x4){0.f, 0.f, 0.f, 0.f};
#pragma unroll
        for (int s = 0; s < 2; ++s) { float v[8];
#pragma unroll
            for (int jj = 0; jj < 8; ++jj) v[jj] = w[(32 * s + 8 * kg + jj) * 64 + n];
            pg8::bf16x8 Bh, Bl; split8(v, Bh, Bl); acc = mfma3(Ah[s], Al[s], Bh, Bl, acc); }
        const float bn = bias[n], fn = freq[n] * 0.15915494309f;
#pragma unroll
        for (int r = 0; r < 4; ++r) out[(16 * mt + 4 * kg + r) * 68 + n] = __builtin_amdgcn_sinf(fn * (acc[r] + bn)); }
}

__device__ __forceinline__ void phase0(const Args& a, LAS unsigned char* lds) {
    int tid = threadIdx.x; const int wg = blockIdx.x, G = gridDim.x;
    asm volatile("" : "+v"(tid));
    int lane = tid & 63, wave = tid >> 6;
    unsigned char* ws = a.ws;
    for (int it = wg; it < 192; it += G) {
        LAS float* sl = (LAS float*)lds;
        LAS float* red = (LAS float*)(lds + 20480);
        const int col = it * 32 + (lane & 31), kk = wave * 2 + (lane >> 5);
        float acc[5] = {0.f, 0.f, 0.f, 0.f, 0.f};
        const float* wp = a.in[4] + col;
        float wv[64];
#pragma unroll
        for (int j = 0; j < 64; ++j) wv[j] = wp[(size_t)(kk + 16 * j) * 6144];
        for (int i = tid; i < 5 * 1024; i += NTHR) { const int bb = i >> 10, k = i & 1023; const float v = (bb < 4) ? a.in[1][bb * 1024 + k] : a.in[3][k]; sl[i] = silu_f(v); }
        __syncthreads();
#pragma unroll
        for (int j = 0; j < 64; ++j) { const int k = kk + 16 * j;
#pragma unroll
            for (int bb = 0; bb < 5; ++bb) acc[bb] += sl[bb * 1024 + k] * wv[j]; }
#pragma unroll
        for (int bb = 0; bb < 5; ++bb) red[(kk * 5 + bb) * 32 + (lane & 31)] = acc[bb];
        __syncthreads();
        if (tid < 160) { const int bb = tid >> 5, cl = tid & 31; float s = 0.f;
#pragma unroll
            for (int q = 0; q < 16; ++q) s += red[(q * 5 + bb) * 32 + cl];
            ((float*)(ws + WS_MOD))[bb * 6144 + it * 32 + cl] = s + a.in[5][it * 32 + cl]; }
        __syncthreads();
    }
    for (int it = wg; it < 256; it += G) {
        asm volatile("" : "+v"(tid)); lane = tid & 63; wave = tid >> 6;
        const int cg = it >> 6, i0 = (it & 63) * 64, m16 = lane & 15, kg = lane >> 4;
        LAS float* zl = (LAS float*)lds;
        LAS float* h1 = (LAS float*)(lds + 17408);
        LAS float* h2 = (LAS float*)(lds + 2 * 17408);
        LAS float* w1l = (LAS float*)(lds + 3 * 17408);
        LAS float* w2l = (LAS float*)(lds + 3 * 17408 + 16384);
        float braw[4][2][8];
        {   const float* w3 = a.in[19] + cg * 512 + wave * 64 + m16;
#pragma unroll
            for (int nt = 0; nt < 4; ++nt)
#pragma unroll
                for (int s = 0; s < 2; ++s)
#pragma unroll
                    for (int jj = 0; jj < 8; ++jj) braw[nt][s][jj] = w3[(32 * s + 8 * kg + jj) * 2048 + nt * 16]; }
        {   float t1[8], t2[8];
#pragma unroll
            for (int q = 0; q < 8; ++q) { const int o = tid + NTHR * q; t1[q] = (o < 33 * 64) ? a.in[15][o] : 0.f; t2[q] = a.in[17][o]; }
#pragma unroll
            for (int q = 0; q < 8; ++q) { const int o = tid + NTHR * q; w1l[o] = t1[q]; w2l[o] = t2[q]; } }
#pragma unroll
        for (int q = 0; q < 8; ++q) { const int o = tid + NTHR * q, li = o >> 6, j = o & 63; const int i = i0 + li;
            const int jj = (j - 1) & 15; const float f = 1e-4f + (float)jj * ((15.0f - 1e-4f) / 15.0f); const float turns = f * ((float)i * (1.0f / 4096.0f));
            const float v = (j == 0) ? (float)i * (1.0f / 4095.0f) : (j <= 16) ? __builtin_amdgcn_cosf(turns) : (j <= 32) ? -__builtin_amdgcn_sinf(turns) : 0.f;
            zl[li * 68 + j] = v; }
        __syncthreads();
        sine_layer(zl, w1l, h1, a.in[16], a.in[20], wave, lane);
        __syncthreads();
        sine_layer(h1, w2l, h2, a.in[18], a.in[20], wave, lane);
        __syncthreads();
        {
            pg8::bf16x8 Bh[4][2], Bl[4][2];
#pragma unroll
            for (int nt = 0; nt < 4; ++nt)
#pragma unroll
                for (int s = 0; s < 2; ++s) split8(braw[nt][s], Bh[nt][s], Bl[nt][s]);
            float* hT = (float*)(ws + WS_HT);
#pragma unroll
            for (int mt = 0; mt < 4; ++mt) {
                pg8::bf16x8 Ah[2], Al[2];
#pragma unroll
                for (int s = 0; s < 2; ++s) { const LAS float* hp = h2 + (16 * mt + m16) * 68 + 32 * s + 8 * kg; const f32x4 x = *(const LAS f32x4*)hp, y = *(const LAS f32x4*)(hp + 4);
                    const float v[8] = {x[0], x[1], x[2], x[3], y[0], y[1], y[2], y[3]}; split8(v, Ah[s], Al[s]); }
#pragma unroll
                for (int nt = 0; nt < 4; ++nt) { f32x4 acc = (f32x4){0.f, 0.f, 0.f, 0.f};
#pragma unroll
                    for (int s = 0; s < 2; ++s) acc = mfma3(Ah[s], Al[s], Bh[nt][s], Bl[nt][s], acc);
                    const int c = wave * 64 + nt * 16 + m16;
                    const float delta = 3.0701134573f + (float)c * ((15.3505672866f - 3.0701134573f) / 511.0f);
                    f32x4 o;
#pragma unroll
                    for (int r = 0; r < 4; ++r) { const float ti = (float)(i0 + 16 * mt + 4 * kg + r) * (1.0f / 4095.0f); o[r] = acc[r] * __expf(-ti * delta); }
                    *(f32x4*)(hT + ((size_t)cg * 512 + c) * SEQ + i0 + 16 * mt + 4 * kg) = o; } } }
        __syncthreads();
    }
    {
        asm volatile("" : "+v"(tid)); lane = tid & 63; wave = tid >> 6;
        LAS float* scr = (LAS float*)(lds + wave * 8448);
        const int gw = wg * NWAVES + wave, NGW = G * NWAVES;
        constexpr int I_IN = 104 * 16, I_OUT = 32 * 16;
        for (int it = gw; it < I_IN + I_OUT; it += NGW) {
            if (it < I_IN) { const int nb = it >> 4, kb = it & 15, n0 = nb * 32;
                const int ns = (n0 < 1536) ? n0 : (n0 < 3072 ? n0 + 32 : 1536 + (n0 - 3072));
                transpose_item(a.in[7], DIN, kb * 64, (n0 < DIN) ? ns : 0, (bf16*)(ws + WS_WIN), DM, n0, scr, lane, n0 >= DIN);
            } else { const int r = it - I_IN, nb = r >> 4, kb = r & 15;
                transpose_item(a.in[22], DM, kb * 64, nb * 32, (bf16*)(ws + WS_WOUT), DM, nb * 32, scr, lane, false); }
        }
    }
    for (int e = wg * NTHR + tid; e < 64 * 256; e += G * NTHR) { const int i = e >> 8, j = e & 255;
        const float om = 1.0f / powf(10000.0f, (float)j * (1.0f / 256.0f)); const float er = (float)i * om;
        float* pt = (float*)(ws + WS_POS); pt[i * 512 + j] = sinf(er); pt[i * 512 + 256 + j] = cosf(er); }
}

__device__ __forceinline__ void phase1(const Args& a, LAS unsigned char* lds) {
    const int tid = threadIdx.x, lane = tid & 63, wave = tid >> 6, wg = blockIdx.x, G = gridDim.x;
    unsigned char* ws = a.ws;
    const float* modr = (const float*)(ws + WS_MOD); const float* pt = (const float*)(ws + WS_POS); bf16* ain = (bf16*)(ws + WS_AIN);
    const float* gmix = a.in[6];
    const int NGW = G * NWAVES;
    f32x4 gv[4];
#pragma unroll
    for (int j = 0; j < 4; ++j) gv[j] = *(const f32x4*)(gmix + 4 * lane + 256 * j);
#pragma nounroll
    for (int r0 = wg * NWAVES + wave; r0 < MT; r0 += 4 * NGW) {
        f32x4 v[4][4], pv[4][4], shv[2][4], scv[2][4];
#pragma unroll
        for (int k = 0; k < 4; ++k) { const int r = r0 + k * NGW, rc = (r < MT) ? r : r0; const bool lat = rc < MX;
            const float* src = lat ? a.in[0] + (size_t)rc * DM : a.in[2] + (size_t)(rc - MX) * DM; const int t = rc & 4095, rr = t >> 6, cc = t & 63;
#pragma unroll
            for (int j = 0; j < 4; ++j) { const int col = 4 * lane + 256 * j; v[k][j] = *(const f32x4*)(src + col);
                pv[k][j] = *(const f32x4*)(pt + ((j < 2) ? rr * 512 + col : cc * 512 + col - 512)); } }
#pragma unroll
        for (int g = 0; g < 2; ++g) { const int r = r0 + 2 * g * NGW, rc = (r < MT) ? r : r0; const int bb = (rc < MX) ? (rc >> 12) : 4;
#pragma unroll
            for (int j = 0; j < 4; ++j) { const int col = 4 * lane + 256 * j; shv[g][j] = *(const f32x4*)(modr + bb * 6144 + col); scv[g][j] = *(const f32x4*)(modr + bb * 6144 + 1024 + col); } }
#pragma unroll
        for (int k = 0; k < 4; ++k) { const int r = r0 + k * NGW, rc = (r < MT) ? r : r0; const float lat = (rc < MX) ? 1.0f : 0.0f; float ss = 0.f;
#pragma unroll
            for (int j = 0; j < 4; ++j) { v[k][j] += pv[k][j] * lat; ss += v[k][j][0] * v[k][j][0] + v[k][j][1] * v[k][j][1] + v[k][j][2] * v[k][j][2] + v[k][j][3] * v[k][j][3]; }
            const float rs = rsqrtf(wave_sum(ss) * (1.0f / DM) + EPS);
#pragma unroll
            for (int j = 0; j < 4; ++j) { const int col = 4 * lane + 256 * j;
                const f32x4 y = (v[k][j] * rs * gv[j]) * (scv[k >> 1][j] + 1.0f) + shv[k >> 1][j];
                v2u w; w.x = pk2(y[0], y[1]); w.y = pk2(y[2], y[3]);
                if (r < MT) *(v2u*)(ain + (size_t)r * DM + col) = w; } }
    }
}

typedef float cpx __attribute__((ext_vector_type(2)));
__device__ __forceinline__ cpx make_cpx(float x, float y) { cpx r; r.x = x; r.y = y; return r; }
__device__ __forceinline__ cpx cmul(cpx a, cpx b) { cpx r;
    asm("v_pk_mul_f32 %0, %1, %2 op_sel_hi:[1,0]\n\tv_pk_fma_f32 %0, %1, %2, %0 op_sel:[1,1,0] op_sel_hi:[0,1,1] neg_lo:[1,0,0]" : "=&v"(r) : "v"(a), "v"(b));
    return r; }
__device__ __forceinline__ cpx cmul_s(cpx a, cpx b) { cpx r;
    asm("v_pk_mul_f32 %0, %1, %2 op_sel_hi:[1,0]\n\tv_pk_fma_f32 %0, %1, %2, %0 op_sel:[1,1,0] op_sel_hi:[0,1,1] neg_lo:[1,0,0]" : "=&v"(r) : "v"(a), "s"(b));
    return r; }
__device__ __forceinline__ cpx cmulc(cpx a, cpx b) { cpx r;
    asm("v_pk_mul_f32 %0, %1, %2 op_sel_hi:[1,0] neg_hi:[1,0]\n\tv_pk_fma_f32 %0, %1, %2, %0 op_sel:[1,1,0] op_sel_hi:[0,1,1] neg_lo:[1,0,0] neg_hi:[1,0,0]" : "=&v"(r) : "v"(a), "v"(b));
    return r; }
__device__ __forceinline__ cpx cfma(cpx a, cpx b, cpx c) { cpx r;
    asm("v_pk_fma_f32 %0, %1, %2, %3 op_sel_hi:[1,0,1]\n\tv_pk_fma_f32 %0, %1, %2, %0 op_sel:[1,1,0] op_sel_hi:[0,1,1] neg_lo:[1,0,0]" : "=&v"(r) : "v"(a), "v"(b), "v"(c));
    return r; }
__device__ __forceinline__ cpx cadd(cpx a, cpx b) { return a + b; }
__device__ __forceinline__ cpx csub(cpx a, cpx b) { return a - b; }
__device__ __forceinline__ cpx add_mi(cpx a, cpx b) { cpx r; asm("v_pk_add_f32 %0, %1, %2 op_sel:[0,1] op_sel_hi:[1,0] neg_hi:[0,1]" : "=v"(r) : "v"(a), "v"(b)); return r; }
__device__ __forceinline__ cpx add_pi(cpx a, cpx b) { cpx r; asm("v_pk_add_f32 %0, %1, %2 op_sel:[0,1] op_sel_hi:[1,0] neg_lo:[0,1]" : "=v"(r) : "v"(a), "v"(b)); return r; }
__device__ __forceinline__ cpx cconj(cpx a) { return make_cpx(a.x, -a.y); }
__device__ __forceinline__ cpx twid(float turns) { return make_cpx(__builtin_amdgcn_cosf(turns), -__builtin_amdgcn_sinf(turns)); }
__device__ __forceinline__ void dft4(cpx& a0, cpx& a1, cpx& a2, cpx& a3) {
    const cpx t0 = cadd(a0, a2), t1 = csub(a0, a2), t2 = cadd(a1, a3), t3 = csub(a1, a3);
    a0 = cadd(t0, t2); a2 = csub(t0, t2); a1 = add_mi(t1, t3); a3 = add_pi(t1, t3);
}
__device__ __forceinline__ void dft4_r2(cpx& a0, cpx& a1, cpx& a2, cpx& a3) {
    const cpx t0 = add_mi(a0, a2), t1 = add_pi(a0, a2), t2 = cadd(a1, a3), t3 = csub(a1, a3);
    a0 = cadd(t0, t2); a2 = csub(t0, t2); a1 = add_mi(t1, t3); a3 = add_pi(t1, t3);
}
__device__ __forceinline__ void dft16(cpx (&v)[16]) {
    cpx t[16];
#pragma unroll
    for (int j = 0; j < 4; ++j) { cpx b0 = v[j], b1 = v[j + 4], b2 = v[j + 8], b3 = v[j + 12]; dft4(b0, b1, b2, b3); t[4 * j] = b0; t[4 * j + 1] = b1; t[4 * j + 2] = b2; t[4 * j + 3] = b3; }
    const float C1 = 0.92387953251f, S1 = 0.38268343236f, R2 = 0.70710678118f;
    const cpx W1 = make_cpx(C1, -S1), W2 = make_cpx(R2, -R2), W3 = make_cpx(S1, -C1), W6 = make_cpx(-R2, -R2), W9 = make_cpx(-C1, S1);
    {   cpx b0 = t[0], b1 = t[4], b2 = t[8], b3 = t[12]; dft4(b0, b1, b2, b3); v[0] = b0; v[4] = b1; v[8] = b2; v[12] = b3; }
    {   cpx b0 = t[1], b1 = cmul_s(t[5], W1), b2 = cmul_s(t[9], W2), b3 = cmul_s(t[13], W3); dft4(b0, b1, b2, b3); v[1] = b0; v[5] = b1; v[9] = b2; v[13] = b3; }
    {   cpx b0 = t[2], b1 = cmul_s(t[6], W2), b2 = t[10], b3 = cmul_s(t[14], W6); dft4_r2(b0, b1, b2, b3); v[2] = b0; v[6] = b1; v[10] = b2; v[14] = b3; }
    {   cpx b0 = t[3], b1 = cmul_s(t[7], W3), b2 = cmul_s(t[11], W6), b3 = cmul_s(t[15], W9); dft4(b0, b1, b2, b3); v[3] = b0; v[7] = b1; v[11] = b2; v[15] = b3; }
}
#define FPAD(i) ((i) + ((i) >> 4))
constexpr int FFT_STRIDE = 4352;
__device__ __forceinline__ void apply_tw(cpx (&v)[16], cpx w1) {
    asm volatile("" : "+v"(w1.x), "+v"(w1.y));
    cpx w = w1; v[1] = cmul(v[1], w);
#pragma unroll
    for (int q = 2; q < 16; ++q) { w = cmul(w, w1); v[q] = cmul(v[q], w); }
}
__device__ __forceinline__ cpx opaque(cpx w) { asm volatile("" : "+v"(w.x), "+v"(w.y)); return w; }
__device__ __forceinline__ cpx c32(int r) { return make_cpx(__builtin_cosf(0.19634954084936207f * (float)r), -__builtin_sinf(0.19634954084936207f * (float)r)); }

#define HB(x) __uint_as_float(((unsigned)(x)) << 16)
__device__ __forceinline__ void hyena_item(const Args& a, LAS unsigned char* lds, int c, int stage) {
    int tid = threadIdx.x; asm volatile("" : "+v"(tid));
    const int f = tid >> 8, j = tid & 255, blk = j >> 4, jp = j & 15;
    const int fu = __builtin_amdgcn_readfirstlane(f);
    unsigned char* ws = a.ws;
    LAS cpx* buf = (LAS cpx*)lds;
    LAS cpx* bm = buf + f * FFT_STRIDE;
    const int pj = j + blk, p16 = blk * 272 + jp, pc = 17 * j;
    const float* hT = (const float*)(ws + WS_HT);
    const float* hf = hT + ((size_t)(stage * 2 + 0) * 512 + c) * SEQ;
    const float* hb = hT + ((size_t)(stage * 2 + 1) * 512 + c) * SEQ;
    const bf16* hyT = (const bf16*)(ws + WS_HYT);
    const bf16* zT = (const bf16*)(ws + WS_ZT);
    bf16* outp = (bf16*)(ws + WS_HYT);
    const float* cw = a.in[13]; const float* cb = a.in[14];
    const int chu = c, chg = (stage == 0 ? 512 : 1024) + c;
    const float wu0 = cw[chu], wu1 = cw[1536 + chu], wu2 = cw[3072 + chu], bu = cb[chu];
    const float wg0 = cw[chg], wg1 = cw[1536 + chg], wg2 = cw[3072 + chg], bg = cb[chg];
    const float bias = a.in[21][stage * 512 + c];
    const cpx wj = twid((float)j * (1.0f / 4096.0f)), wjp = twid((float)jp * (1.0f / 256.0f)), w8_ = twid((float)j * (1.0f / 8192.0f));
    cpx v[16];
    LAS cpx* Hs = buf + 2 * FFT_STRIDE + f * FFT_STRIDE + pc;
    { const cpx w8 = opaque(w8_);
    float fraw[16], graw[16];
#pragma unroll
    for (int r = 0; r < 16; ++r) { const unsigned n = (unsigned)j + 256u * r; fraw[r] = hf[n]; graw[r] = hb[(SEQ - n) & 4095u]; }
    asm volatile("" : "+v"(fraw[0]), "+v"(fraw[1]), "+v"(fraw[2]), "+v"(fraw[3]), "+v"(fraw[4]), "+v"(fraw[5]), "+v"(fraw[6]), "+v"(fraw[7]), "+v"(fraw[8]), "+v"(fraw[9]), "+v"(fraw[10]), "+v"(fraw[11]), "+v"(fraw[12]), "+v"(fraw[13]), "+v"(fraw[14]), "+v"(fraw[15]));
    asm volatile("" : "+v"(graw[0]), "+v"(graw[1]), "+v"(graw[2]), "+v"(graw[3]), "+v"(graw[4]), "+v"(graw[5]), "+v"(graw[6]), "+v"(graw[7]), "+v"(graw[8]), "+v"(graw[9]), "+v"(graw[10]), "+v"(graw[11]), "+v"(graw[12]), "+v"(graw[13]), "+v"(graw[14]), "+v"(graw[15]));
    if (fu) {
#pragma unroll
        for (int r = 0; r < 16; ++r) { const unsigned n = (unsigned)j + 256u * r; const float gv = n ? graw[r] : 0.f; const cpx wn = cmul_s(w8, c32(r)); const float d = fraw[r] - gv; v[r] = make_cpx(d * wn.x, d * wn.y); }
    } else {
#pragma unroll
        for (int r = 0; r < 16; ++r) { const unsigned n = (unsigned)j + 256u * r; const float gv = n ? graw[r] : 0.f; v[r] = make_cpx(fraw[r] + gv, 0.f); }
    } }
    dft16(v); apply_tw(v, wj);
#pragma unroll
    for (int q = 0; q < 16; ++q) bm[pj + 272 * q] = v[q];
    __syncthreads();
#pragma unroll
    for (int r = 0; r < 16; ++r) v[r] = bm[p16 + 17 * r];
    dft16(v); apply_tw(v, wjp);
#pragma unroll
    for (int q = 0; q < 16; ++q) bm[p16 + 17 * q] = v[q];
    __syncthreads();
#pragma unroll
    for (int r = 0; r < 16; ++r) v[r] = bm[pc + r];
    dft16(v);
#pragma unroll
    for (int q = 0; q < 16; ++q) Hs[q] = v[q];
    __syncthreads();
#pragma nounroll
    for (int bp = 0; bp < 2; ++bp) {
        const int b0 = 2 * bp, b1 = 2 * bp + 1;
        float uk0[8], uk1[8];
        {   float u0[16], u1[16];
            const unsigned uj = (unsigned)j;
            if (stage == 0) {
                const bf16* P0 = hyT + ((size_t)b0 * 1536 + chu) * SEQ; const bf16* P1 = hyT + ((size_t)b1 * 1536 + chu) * SEQ;
#pragma unroll
                for (int r = 0; r < 16; ++r) { const unsigned o = uj + 256u * r; if (r == 4 || r == 8 || r == 12) asm volatile("" ::: "memory");
                    const unsigned ol = (r == 0) ? (j ? uj - 1u : 0u) : o - 1u, orr = (r == 15) ? (j < 255 ? o + 1u : o) : o + 1u;
                    float l0 = HB(P0[ol]), l1 = HB(P1[ol]), r0 = HB(P0[orr]), r1 = HB(P1[orr]);
                    if (r == 0) { l0 = j ? l0 : 0.f; l1 = j ? l1 : 0.f; }
                    if (r == 15) { r0 = (j < 255) ? r0 : 0.f; r1 = (j < 255) ? r1 : 0.f; }
                    u0[r] = wu0 * l0 + wu1 * HB(P0[o]) + wu2 * r0 + bu; u1[r] = wu0 * l1 + wu1 * HB(P1[o]) + wu2 * r1 + bu; }
            } else {
                const bf16* P0 = zT + ((size_t)b0 * 512 + c) * SEQ; const bf16* P1 = zT + ((size_t)b1 * 512 + c) * SEQ;
                unsigned short z0[16], z1[16];
#pragma unroll
                for (int r = 0; r < 16; ++r) { const unsigned o = uj + 256u * r; z0[r] = P0[o]; z1[r] = P1[o]; }
                asm volatile("" :: "v"(z0[0]), "v"(z0[1]), "v"(z0[2]), "v"(z0[3]), "v"(z0[4]), "v"(z0[5]), "v"(z0[6]), "v"(z0[7]), "v"(z0[8]), "v"(z0[9]), "v"(z0[10]), "v"(z0[11]), "v"(z0[12]), "v"(z0[13]), "v"(z0[14]), "v"(z0[15]));
                asm volatile("" :: "v"(z1[0]), "v"(z1[1]), "v"(z1[2]), "v"(z1[3]), "v"(z1[4]), "v"(z1[5]), "v"(z1[6]), "v"(z1[7]), "v"(z1[8]), "v"(z1[9]), "v"(z1[10]), "v"(z1[11]), "v"(z1[12]), "v"(z1[13]), "v"(z1[14]), "v"(z1[15]));
#pragma unroll
                for (int r = 0; r < 16; ++r) { u0[r] = HB(z0[r]); u1[r] = HB(z1[r]); }
            }
#pragma unroll
            for (int i = 0; i < 8; ++i) { uk0[i] = f ? u0[2 * i + 1] : u0[2 * i]; uk1[i] = f ? u1[2 * i + 1] : u1[2 * i]; }
            const cpx w8 = opaque(w8_);
            if (fu) {
#pragma unroll
                for (int r = 0; r < 16; ++r) v[r] = cmul(make_cpx(u0[r], u1[r]), cmul_s(w8, c32(r)));
            } else {
#pragma unroll
                for (int r = 0; r < 16; ++r) v[r] = make_cpx(u0[r], u1[r]);
            }
        }
        dft16(v); apply_tw(v, wj);
#pragma unroll
        for (int q = 0; q < 16; ++q) bm[pj + 272 * q] = v[q];
        __syncthreads();
#pragma unroll
        for (int r = 0; r < 16; ++r) v[r] = bm[p16 + 17 * r];
        dft16(v); apply_tw(v, wjp);
#pragma unroll
        for (int q = 0; q < 16; ++q) bm[p16 + 17 * q] = v[q];
        __syncthreads();
#pragma unroll
        for (int r = 0; r < 16; ++r) v[r] = bm[pc + r];
        dft16(v);
#pragma unroll
        for (int q = 0; q < 16; ++q) v[q] = cmulc(v[q], Hs[q]);
        dft16(v);
#pragma unroll
        for (int q = 0; q < 16; ++q) bm[pc + q] = v[q];
        __syncthreads();
#pragma unroll
        for (int r = 0; r < 16; ++r) v[r] = bm[p16 + 17 * r];
        apply_tw(v, wjp); dft16(v);
#pragma unroll
        for (int q = 0; q < 16; ++q) bm[p16 + 17 * q] = v[q];
        __syncthreads();
        float gg0[8], gg1[8];
        {   unsigned short rg0[8][3], rg1[8][3];
            const bf16* G0 = hyT + ((size_t)b0 * 1536 + chg) * SEQ; const bf16* G1 = hyT + ((size_t)b1 * 1536 + chg) * SEQ;
            const unsigned gj = (unsigned)(j + 256 * f);
#pragma unroll
            for (int i = 0; i < 8; ++i) { const unsigned o = gj + 512u * i;
                const unsigned ol = (i == 0) ? (gj ? gj - 1u : 0u) : o - 1u, orr = (i == 7) ? (o < 4095u ? o + 1u : o) : o + 1u;
                rg0[i][0] = G0[ol]; rg0[i][1] = G0[o]; rg0[i][2] = G0[orr]; rg1[i][0] = G1[ol]; rg1[i][1] = G1[o]; rg1[i][2] = G1[orr]; }
#pragma unroll
            for (int r = 0; r < 16; ++r) v[r] = bm[pj + 272 * r];
            apply_tw(v, wj); dft16(v);
#pragma unroll
            for (int q = 0; q < 16; ++q) bm[pj + 272 * q] = v[q];
#pragma unroll
            for (int i = 0; i < 8; ++i) asm volatile("" :: "v"(rg0[i][0]), "v"(rg0[i][1]), "v"(rg0[i][2]), "v"(rg1[i][0]), "v"(rg1[i][1]), "v"(rg1[i][2]));
#pragma unroll
            for (int i = 0; i < 8; ++i) { const unsigned o = gj + 512u * i;
                float a0 = HB(rg0[i][0]), a1 = HB(rg0[i][1]), a2 = HB(rg0[i][2]), c0 = HB(rg1[i][0]), c1 = HB(rg1[i][1]), c2 = HB(rg1[i][2]);
                if (i == 0) { a0 = gj ? a0 : 0.f; c0 = gj ? c0 : 0.f; }
                if (i == 7) { a2 = (o < 4095u) ? a2 : 0.f; c2 = (o < 4095u) ? c2 : 0.f; }
                gg0[i] = wg0 * a0 + wg1 * a1 + wg2 * a2 + bg; gg1[i] = wg0 * c0 + wg1 * c1 + wg2 * c2 + bg; } }
        __syncthreads();
        const cpx w8f = cmul(opaque(w8_), f ? c32(1) : c32(0));
        bf16* O0 = outp + ((size_t)b0 * 1536 + c) * SEQ; bf16* O1 = outp + ((size_t)b1 * 1536 + c) * SEQ;
        bf16* Z0 = (bf16*)(ws + WS_ZT) + ((size_t)b0 * 512 + c) * SEQ; bf16* Z1 = (bf16*)(ws + WS_ZT) + ((size_t)b1 * 512 + c) * SEQ;
#pragma unroll
        for (int i = 0; i < 8; ++i) { const int rr = f + 2 * i; const unsigned n = (unsigned)(j + 256 * f) + 512u * i;
            const cpx be = buf[pj + 272 * rr], bo = buf[FFT_STRIDE + pj + 272 * rr];
            const cpx wn = cmul_s(w8f, c32(2 * i));
            const cpx z = cfma(bo, wn, be);
            const float y0 = z.x * (1.0f / 8192.0f) + bias * uk0[i], y1 = bias * uk1[i] - z.y * (1.0f / 8192.0f);
                        if (stage == 0) { Z0[n] = (bf16)f2bf(gg0[i] * y0); Z1[n] = (bf16)f2bf(gg1[i] * y1); } else { O0[n] = (bf16)f2bf(gg0[i] * y0); O1[n] = (bf16)f2bf(gg1[i] * y1); } }
        __syncthreads();
    }
}

__device__ __forceinline__ f32x16 mfma32(bf16x8 a, bf16x8 b, f32x16 c) { return __builtin_amdgcn_mfma_f32_32x32x16_bf16(a, b, c, 0, 0, 0); }
typedef short s4v __attribute__((ext_vector_type(4)));
__device__ __forceinline__ bf16x8 tr_frag(const LAS bf16* base, int PT, int k0, int c0, int lane) {
    const int i = lane & 15, q = i >> 2, p = i & 3;
    const LAS bf16* ad = base + (k0 + 8 * (lane >> 5) + q) * PT + c0 + 16 * ((lane >> 4) & 1) + 4 * p;
    const s4v lo = __builtin_amdgcn_ds_read_tr16_b64_v4i16((LAS s4v*)ad);
    const s4v hi = __builtin_amdgcn_ds_read_tr16_b64_v4i16((LAS s4v*)(ad + 4 * PT));
    bf16x8 r; r[0] = lo[0]; r[1] = lo[1]; r[2] = lo[2]; r[3] = lo[3]; r[4] = hi[0]; r[5] = hi[1]; r[6] = hi[2]; r[7] = hi[3]; return r;
}
constexpr int GL_AL = 0, GL_WA = 8192, GL_TOT = 16384, GL_V = 24576, GL_VP = 160;
struct GlaTab { float P[4][2], X[4][2], Ptot[2], Xtot[2], Pref[2], Xref[2]; };
__device__ __forceinline__ void gla_tables(const Args& a, int h, LAS unsigned char* lds, GlaTab& T, int tid) {
    const int d2 = tid & 31, sg = tid >> 5;
    const LAS float* aL = (const LAS float*)(lds + GL_AL); const LAS float* wa = (const LAS float*)(lds + GL_WA); LAS float* tot = (LAS float*)(lds + GL_TOT);
    typedef float f32x2v __attribute__((ext_vector_type(2)));
    const f32x2v bf = *(const f32x2v*)(a.in[9] + h * 64 + 2 * d2), bb = *(const f32x2v*)(a.in[11] + h * 64 + 2 * d2);
    float lf[4][2], lb[4][2];
#pragma unroll
    for (int q = 0; q < 4; ++q) { const int s = sg * 4 + q; float pf0 = bf[0], pf1 = bf[1], pb0 = bb[0], pb1 = bb[1];
#pragma unroll
        for (int j4 = 0; j4 < 4; ++j4) { const f32x4 af = *(const LAS f32x4*)(aL + s * 32 + 4 * j4), ab = *(const LAS f32x4*)(aL + s * 32 + 16 + 4 * j4);
#pragma unroll
            for (int jj = 0; jj < 4; ++jj) { const int j = 4 * j4 + jj; const f32x2v wf = *(const LAS f32x2v*)(wa + j * 64 + 2 * d2), wb = *(const LAS f32x2v*)(wa + 1024 + j * 64 + 2 * d2);
                pf0 += af[jj] * wf[0]; pf1 += af[jj] * wf[1]; pb0 += ab[jj] * wb[0]; pb1 += ab[jj] * wb[1]; } }
        lf[q][0] = logsig_f(pf0) * (1.0f / 16.0f); lf[q][1] = logsig_f(pf1) * (1.0f / 16.0f); lb[q][0] = logsig_f(pb0) * (1.0f / 16.0f); lb[q][1] = logsig_f(pb1) * (1.0f / 16.0f); }
#pragma unroll
    for (int i = 0; i < 2; ++i) { lf[1][i] += lf[0][i]; lf[2][i] += lf[1][i]; lf[3][i] += lf[2][i]; lb[2][i] += lb[3][i]; lb[1][i] += lb[2][i]; lb[0][i] += lb[1][i]; }
    *(LAS f32x2v*)(tot + sg * 64 + 2 * d2) = (f32x2v){lf[3][0], lf[3][1]};
    *(LAS f32x2v*)(tot + 1024 + sg * 64 + 2 * d2) = (f32x2v){lb[0][0], lb[0][1]};
    __syncthreads();
    float of[2] = {0.f, 0.f}, ob[2] = {0.f, 0.f};
    T.Ptot[0] = T.Ptot[1] = T.Xtot[0] = T.Xtot[1] = T.Pref[0] = T.Pref[1] = T.Xref[0] = T.Xref[1] = 0.f;
#pragma unroll
    for (int g = 0; g < 16; ++g) { const f32x2v tf = *(const LAS f32x2v*)(tot + g * 64 + 2 * d2), tb = *(const LAS f32x2v*)(tot + 1024 + g * 64 + 2 * d2);
#pragma unroll
        for (int i = 0; i < 2; ++i) { T.Ptot[i] += tf[i]; T.Xtot[i] += tb[i]; if (g < 8) T.Pref[i] += tf[i]; else T.Xref[i] += tb[i];
            of[i] += (g < sg) ? tf[i] : 0.f; ob[i] += (g > sg) ? tb[i] : 0.f; } }
#pragma unroll
    for (int q = 0; q < 4; ++q)
#pragma unroll
        for (int i = 0; i < 2; ++i) { T.P[q][i] = lf[q][i] + of[i]; T.X[q][i] = lb[q][i] + ob[i]; }
}
struct GlaIn { f32x4 av, wv; unsigned kw[4], qw[4]; };
template <bool OUT>
__device__ __forceinline__ void gla_load(const Args& a, int tid, int bh, int ci, GlaIn& I) {
    const int b = bh >> 2, h = bh & 3, d2 = tid & 31, sg = tid >> 5;
    const size_t rowbase = OUT ? (size_t)b * SEQ + ci * 64 : ((ci < 4) ? (size_t)(MX + b * CTXL + ci * 64) : (size_t)(b * SEQ + (ci - 4) * 64));
    const float* afb = (const float*)(a.ws + WS_AFB); const bf16* qkvg = (const bf16*)(a.ws + WS_QKVG);
    I.av = *(const f32x4*)(afb + (rowbase + (tid >> 3)) * 32 + 4 * (tid & 7));
    const int wdir = tid >> 8, wj = (tid >> 4) & 15, wd4 = (tid & 15) * 4;
    I.wv = *(const f32x4*)((wdir ? a.in[10] : a.in[8]) + wj * 256 + h * 64 + wd4);
#pragma unroll
    for (int q = 0; q < 4; ++q) { const bf16* rp = qkvg + (rowbase + sg * 4 + q) * NQ + h * 64 + 2 * d2; I.kw[q] = *(const unsigned*)(rp + 256); if (OUT) I.qw[q] = *(const unsigned*)rp; }
}
__device__ __forceinline__ void gla_stage_common(const GlaIn& I, LAS unsigned char* lds, int tid) {
    const int wdir = tid >> 8, wj = (tid >> 4) & 15, wd4 = (tid & 15) * 4;
    *(LAS f32x4*)((LAS float*)(lds + GL_AL) + 4 * tid) = I.av;
    *(LAS f32x4*)((LAS float*)(lds + GL_WA) + wdir * 1024 + wj * 64 + wd4) = I.wv;
}

template <bool HASN>
__device__ __forceinline__ void gla_upd_item(const Args& a, LAS unsigned char* lds, int bh, int ci, const GlaIn& I, int nbh, int nci, GlaIn& N) {
    int tid = threadIdx.x; asm volatile("" : "+v"(tid));
    const int lane = tid & 63, wave = tid >> 6, h = bh & 3, d2 = tid & 31, sg = tid >> 5;
    unsigned char* ws = a.ws;
    constexpr int KP = 96;
    LAS bf16* vN = (LAS bf16*)(lds + GL_V); LAS bf16* kUf = (LAS bf16*)(lds + 45056); LAS bf16* kUb = (LAS bf16*)(lds + 57344);
    unsigned kw[4];
#pragma unroll
    for (int q = 0; q < 4; ++q) kw[q] = I.kw[q];
    v4u vv[2];
    { const int b = bh >> 2; const size_t rowbase = (ci < 4) ? (size_t)(MX + b * CTXL + ci * 64) : (size_t)(b * SEQ + (ci - 4) * 64); const bf16* qkvg = (const bf16*)(ws + WS_QKVG);
#pragma unroll
        for (int q = 0; q < 2; ++q) { const int idx = tid + NTHR * q; vv[q] = *(const v4u*)(qkvg + (rowbase + (idx >> 4)) * NQ + 512 + h * 128 + (idx & 15) * 8); } }
    gla_stage_common(I, lds, tid);
    __syncthreads();
    if (HASN) gla_load<false>(a, tid, nbh, nci, N);
    GlaTab T; gla_tables(a, h, lds, T, tid);
#pragma unroll
    for (int q = 0; q < 4; ++q) { const int s = sg * 4 + q; const float k0 = bflo(kw[q]), k1 = bfhi(kw[q]);
        *(LAS unsigned*)(kUf + s * KP + 2 * d2) = pk2(k0 * __expf(T.Ptot[0] - T.P[q][0]), k1 * __expf(T.Ptot[1] - T.P[q][1]));
        *(LAS unsigned*)(kUb + s * KP + 2 * d2) = pk2(k0 * __expf(T.Xtot[0] - T.X[q][0]), k1 * __expf(T.Xtot[1] - T.X[q][1])); }
#pragma unroll
    for (int q = 0; q < 2; ++q) { const int idx = tid + NTHR * q; *(LAS v4u*)(vN + (idx >> 4) * GL_VP + (idx & 15) * 8) = vv[q]; }
    if (tid < 32) { float* dec = (float*)(ws + WS_DEC);
#pragma unroll
        for (int i = 0; i < 2; ++i) { dec[((size_t)(bh * 2 + 0) * NCH + ci) * 64 + 2 * d2 + i] = __expf(T.Ptot[i]); dec[((size_t)(bh * 2 + 1) * NCH + ci) * 64 + 2 * d2 + i] = __expf(T.Xtot[i]); } }
    __syncthreads();
    { const int dir = wave >> 2, e0 = (wave & 3) * 32, l31 = lane & 31, hh = lane >> 5;
        const LAS bf16* kT = dir ? kUb : kUf;
        float* U = (ci < 4) ? (float*)(ws + WS_UCTX) + ((size_t)(bh * 2 + dir) * 4 + ci) * 8192 : a.out + ((size_t)(bh * 2 + dir) * 64 + (ci - 4)) * 8192;
        bf16x8 A[4];
#pragma unroll
        for (int ks = 0; ks < 4; ++ks) A[ks] = tr_frag(vN, GL_VP, 16 * ks, e0, lane);
#pragma unroll
        for (int dt = 0; dt < 2; ++dt) { const int d0 = dt * 32; f32x16 acc;
#pragma unroll
            for (int i = 0; i < 16; ++i) acc[i] = 0.f;
#pragma unroll
            for (int ks = 0; ks < 4; ++ks) acc = mfma32(A[ks], tr_frag(kT, KP, 16 * ks, d0, lane), acc);
#pragma unroll
            for (int r = 0; r < 16; ++r) { const int e = e0 + (r & 3) + 8 * (r >> 2) + 4 * hh; U[e * 64 + d0 + l31] = acc[r]; } } }
    __syncthreads();
}

__device__ __forceinline__ void gla_scan_item(const Args& a, int it) {
    int tid = threadIdx.x; asm volatile("" : "+v"(tid));
    const int bd = it >> 4, dir = bd & 1, el = ((it & 15) * 8 + (tid >> 6)) * 64 + (tid & 63), d = tid & 63;
    unsigned char* ws = a.ws;
    const float* dec = (const float*)(ws + WS_DEC) + (size_t)bd * NCH * 64 + d;
    const float* Uc = (const float*)(ws + WS_UCTX) + (size_t)bd * 4 * 8192 + el;
    const float* U = a.out + (size_t)bd * 64 * 8192 + el;
    bf16* Sp = (bf16*)(ws + WS_SPREV) + (size_t)bd * 64 * 8192 + el;
    float S = 0.f;
#pragma unroll
    for (int c4 = 0; c4 < 4; ++c4) { const int ci = dir ? 3 - c4 : c4; S = dec[ci * 64] * S + Uc[(size_t)ci * 8192]; }
#pragma unroll
    for (int blk = 0; blk < 2; ++blk) { float uu[32], dd[32];
#pragma unroll
        for (int j = 0; j < 32; ++j) { const int n = dir ? 63 - (blk * 32 + j) : blk * 32 + j; uu[j] = U[(size_t)n * 8192]; dd[j] = dec[(4 + n) * 64]; }
#pragma unroll
        for (int j = 0; j < 32; ++j) { const int n = dir ? 63 - (blk * 32 + j) : blk * 32 + j; Sp[(size_t)n * 8192] = (bf16)f2bf(S); S = dd[j] * S + uu[j]; } }
}

template <bool HASN>
__device__ __forceinline__ void gla_out_item(const Args& a, LAS unsigned char* lds, int bh, int n, const GlaIn& I, int nbh, int nn, GlaIn& N) {
    int tid = threadIdx.x; asm volatile("" : "+v"(tid));
    const int lane = tid & 63, wave = tid >> 6, b = bh >> 2, h = bh & 3, l31 = lane & 31, hh = lane >> 5, d2 = tid & 31, sg = tid >> 5;
    unsigned char* ws = a.ws;
    LAS bf16* Scat = (LAS bf16*)lds;
    LAS bf16* vN = (LAS bf16*)(lds + GL_V);
    LAS bf16* qf = (LAS bf16*)(lds + 45056); LAS bf16* qb = qf + 4608; LAS bf16* kf = qf + 2 * 4608; LAS bf16* kb = qf + 3 * 4608;
    LAS float* oS = (LAS float*)(lds + 45056);
    LAS bf16* qS = (LAS bf16*)(lds + 81920);
    LAS bf16* Sp = (LAS bf16*)(lds + 99328);
    const size_t rowbase = (size_t)b * SEQ + n * 64;
    unsigned qw[4], kw[4];
#pragma unroll
    for (int q = 0; q < 4; ++q) { qw[q] = I.qw[q]; kw[q] = I.kw[q]; }
    v4u vv[2], sv[4], g0, g1;
    { const bf16* qkvg = (const bf16*)(ws + WS_QKVG);
        { const bf16* gp = qkvg + (rowbase + (tid >> 3)) * NQ + 1024 + h * 128 + (tid & 7) * 16; g0 = *(const v4u*)gp; g1 = *(const v4u*)(gp + 8); }
#pragma unroll
        for (int q = 0; q < 2; ++q) { const int idx = tid + NTHR * q; vv[q] = *(const v4u*)(qkvg + (rowbase + (idx >> 4)) * NQ + 512 + h * 128 + (idx & 15) * 8); }
        const bf16* spf = (const bf16*)(ws + WS_SPREV) + ((size_t)(bh * 2 + 0) * 64 + n) * 8192; const bf16* spb = (const bf16*)(ws + WS_SPREV) + ((size_t)(bh * 2 + 1) * 64 + n) * 8192;
#pragma unroll
        for (int q = 0; q < 4; ++q) { const int idx = tid + NTHR * q, dir = idx >> 10, e = (idx >> 3) & 127, d8 = (idx & 7) * 8; sv[q] = *(const v4u*)((dir ? spb : spf) + e * 64 + d8); } }
    gla_stage_common(I, lds, tid);
    __syncthreads();
    if (HASN) gla_load<true>(a, tid, nbh, nn, N);
    GlaTab T; gla_tables(a, h, lds, T, tid);
#pragma unroll
    for (int q = 0; q < 4; ++q) { const int s = sg * 4 + q; const float q0 = bflo(qw[q]), q1 = bfhi(qw[q]), k0 = bflo(kw[q]), k1 = bfhi(kw[q]);
        *(LAS unsigned*)(qf + s * 72 + 2 * d2) = pk2(q0 * __expf(T.P[q][0] - T.Pref[0]), q1 * __expf(T.P[q][1] - T.Pref[1]));
        *(LAS unsigned*)(kf + s * 72 + 2 * d2) = pk2(k0 * __expf(T.Pref[0] - T.P[q][0]), k1 * __expf(T.Pref[1] - T.P[q][1]));
        *(LAS unsigned*)(qb + s * 72 + 2 * d2) = pk2(q0 * __expf(T.X[q][0] - T.Xref[0]), q1 * __expf(T.X[q][1] - T.Xref[1]));
        *(LAS unsigned*)(kb + s * 72 + 2 * d2) = pk2(k0 * __expf(T.Xref[0] - T.X[q][0]), k1 * __expf(T.Xref[1] - T.X[q][1]));
        *(LAS unsigned*)(qS + s * 136 + 2 * d2) = pk2(q0 * __expf(T.P[q][0]), q1 * __expf(T.P[q][1]));
        *(LAS unsigned*)(qS + s * 136 + 64 + 2 * d2) = pk2(q0 * __expf(T.X[q][0]), q1 * __expf(T.X[q][1])); }
#pragma unroll
    for (int q = 0; q < 2; ++q) { const int idx = tid + NTHR * q; *(LAS v4u*)(vN + (idx >> 4) * GL_VP + (idx & 15) * 8) = vv[q]; }
#pragma unroll
    for (int q = 0; q < 4; ++q) { const int idx = tid + NTHR * q, dir = idx >> 10, e = (idx >> 3) & 127, d8 = (idx & 7) * 8; *(LAS v4u*)(Sp + e * 136 + dir * 64 + d8) = sv[q]; }
    __syncthreads();
    { const int dir = wave >> 2, c0 = ((wave >> 1) & 1) * 32, s0 = (wave & 1) * 32;
        const LAS bf16* qq = dir ? qb : qf; const LAS bf16* kk = dir ? kb : kf;
        f32x16 acc;
#pragma unroll
        for (int i = 0; i < 16; ++i) acc[i] = 0.f;
#pragma unroll
        for (int ks = 0; ks < 4; ++ks) { const bf16x8 A = *(const LAS bf16x8*)(qq + (c0 + l31) * 72 + 16 * ks + 8 * hh), B = *(const LAS bf16x8*)(kk + (s0 + l31) * 72 + 16 * ks + 8 * hh);
            acc = mfma32(A, B, acc); }
        const int s = s0 + l31;
#pragma unroll
        for (int r = 0; r < 16; ++r) { const int c = c0 + (r & 3) + 8 * (r >> 2) + 4 * hh; const bool keep = dir ? (s >= c) : (s <= c);
            Scat[c * 136 + dir * 64 + s] = (bf16)f2bf(keep ? acc[r] : 0.f); } }
    __syncthreads();
    { const int c0 = (wave >> 2) * 32, e0 = (wave & 3) * 32;
        f32x16 acc;
#pragma unroll
        for (int i = 0; i < 16; ++i) acc[i] = 0.f;
#pragma unroll
        for (int ks = 0; ks < 8; ++ks) { const bf16x8 A = *(const LAS bf16x8*)(Scat + (c0 + l31) * 136 + 16 * ks + 8 * hh);
            acc = mfma32(A, tr_frag(vN, GL_VP, 16 * (ks & 3), e0, lane), acc); }
#pragma unroll
        for (int ks = 0; ks < 8; ++ks) { const bf16x8 A = *(const LAS bf16x8*)(qS + (c0 + l31) * 136 + 16 * ks + 8 * hh), B = *(const LAS bf16x8*)(Sp + (e0 + l31) * 136 + 16 * ks + 8 * hh);
            acc = mfma32(A, B, acc); }
#pragma unroll
        for (int r = 0; r < 16; ++r) { const int c = c0 + (r & 3) + 8 * (r >> 2) + 4 * hh; oS[c * 132 + e0 + l31] = acc[r]; } }
    __syncthreads();
    { const int row = tid >> 3, ec = (tid & 7) * 16; float v[16]; float ss = 0.f;
#pragma unroll
        for (int j = 0; j < 16; ++j) { v[j] = oS[row * 132 + ec + j]; ss += v[j] * v[j]; }
        ss += __shfl_xor(ss, 1); ss += __shfl_xor(ss, 2); ss += __shfl_xor(ss, 4);
        const float rs = rsqrtf(ss * (1.0f / 128.0f) + EPS);
        const float gv[16] = {bflo(g0.x), bfhi(g0.x), bflo(g0.y), bfhi(g0.y), bflo(g0.z), bfhi(g0.z), bflo(g0.w), bfhi(g0.w), bflo(g1.x), bfhi(g1.x), bflo(g1.y), bfhi(g1.y), bflo(g1.z), bfhi(g1.z), bflo(g1.w), bfhi(g1.w)};
        float o[16];
#pragma unroll
        for (int j = 0; j < 16; ++j) o[j] = DBG_GLA_K * v[j] * rs * a.in[12][ec + j] * silu_f(gv[j]);
        bf16* op = (bf16*)(ws + WS_AOUT) + (rowbase + row) * DM + h * 128 + ec;
        *(v4u*)op = (v4u){pk2(o[0], o[1]), pk2(o[2], o[3]), pk2(o[4], o[5]), pk2(o[6], o[7])};
        *(v4u*)(op + 8) = (v4u){pk2(o[8], o[9]), pk2(o[10], o[11]), pk2(o[12], o[13]), pk2(o[14], o[15])}; }
    __syncthreads();
}

__device__ __forceinline__ void hy_transpose_item(const Args& a, LAS unsigned char* lds, int it) {
    const int tid = threadIdx.x, b = it >> 6, t0 = (it & 63) * 64;
    LAS float* tile = (LAS float*)lds;
    const bf16* src = (const bf16*)(a.ws + WS_HYT) + (size_t)b * 1536 * SEQ + t0;
    bf16* dst = (bf16*)(a.ws + WS_AOUT) + ((size_t)b * SEQ + t0) * DM + 512;
    for (int half = 0; half < 2; ++half) {
#pragma unroll 8
        for (int q = 0; q < 32; ++q) { const int idx = tid + NTHR * q, c = idx >> 6, tt = idx & 63; tile[c * 65 + tt] = HB(src[(size_t)(half * 256 + c) * SEQ + tt]); }
        __syncthreads();
#pragma unroll
        for (int q = 0; q < 4; ++q) { const int idx = tid + NTHR * q, t = idx >> 5, c8 = (idx & 31) * 8; const LAS float* s = tile + c8 * 65 + t;
            *(v4u*)(dst + (size_t)t * DM + half * 256 + c8) = (v4u){pk2(s[0], s[65]), pk2(s[2 * 65], s[3 * 65]), pk2(s[4 * 65], s[5 * 65]), pk2(s[6 * 65], s[7 * 65])}; }
        __syncthreads();
    }
}

__device__ __forceinline__ void phase_router(const Args& a, LAS unsigned char* lds) {
    const int tid = threadIdx.x, lane = tid & 63, wave = tid >> 6, wg = blockIdx.x, G = gridDim.x;
    unsigned char* ws = a.ws;
    LAS float* wr = (LAS float*)lds;
    {   f32x4 t[8];
#pragma unroll
        for (int it = 0; it < 8; ++it) t[it] = *(const f32x4*)(a.in[24] + 4 * (tid + NTHR * it));
#pragma unroll
        for (int it = 0; it < 8; ++it) { const int i4 = tid + NTHR * it, c = i4 >> 2, e4 = i4 & 3, l = (c >> 2) & 63, q = c & 3, j = c >> 8;
            *(LAS f32x4*)(wr + 4 * ((((j * 4 + q) * 4 + e4) * 65) + l)) = t[it]; } }
    __syncthreads();
    const float* modr = (const float*)(ws + WS_MOD); const float* gffn = a.in[23];
    bf16* hn = (bf16*)(ws + WS_HN); float* aff = (float*)(ws + WS_AFF); const bf16* x1b = (const bf16*)(ws + WS_X1B);
    const int NGW = G * NWAVES;
    f32x4 gv[4];
#pragma unroll
    for (int j = 0; j < 4; ++j) gv[j] = *(const f32x4*)(gffn + 4 * lane + 256 * j);
#pragma nounroll
    for (int r0 = wg * NWAVES + wave; r0 < MX; r0 += 2 * NGW) {
        const int r1 = r0 + NGW; const bool ok1 = r1 < MX; const int rB = ok1 ? r1 : r0;
        int lane_o = lane; asm volatile("" : "+v"(lane_o));
        f32x4 v[2][4];
#pragma unroll
        for (int j = 0; j < 4; ++j) { const v2u w0 = *(const v2u*)(x1b + (size_t)r0 * DM + 4 * lane + 256 * j), w1 = *(const v2u*)(x1b + (size_t)rB * DM + 4 * lane + 256 * j);
            v[0][j] = (f32x4){bflo(w0.x), bfhi(w0.x), bflo(w0.y), bfhi(w0.y)}; v[1][j] = (f32x4){bflo(w1.x), bfhi(w1.x), bflo(w1.y), bfhi(w1.y)}; }
        float rs[2];
#pragma unroll
        for (int k = 0; k < 2; ++k) { float ss = 0.f;
#pragma unroll
            for (int j = 0; j < 4; ++j) ss += v[k][j][0] * v[k][j][0] + v[k][j][1] * v[k][j][1] + v[k][j][2] * v[k][j][2] + v[k][j][3] * v[k][j][3];
            rs[k] = rsqrtf(wave_sum(ss) * (1.0f / DM) + EPS); }
        float lg[2][16];
#pragma unroll
        for (int k = 0; k < 2; ++k)
#pragma unroll
            for (int e = 0; e < 16; ++e) lg[k][e] = 0.f;
        f32x4 shv[2][4], scv[2][4];
#pragma unroll
        for (int k = 0; k < 2; ++k)
#pragma unroll
            for (int j = 0; j < 4; ++j) { const int b = (k ? rB : r0) >> 12, col = 4 * lane + 256 * j; shv[k][j] = *(const f32x4*)(modr + b * 6144 + 3072 + col); scv[k][j] = *(const f32x4*)(modr + b * 6144 + 4096 + col); }
#pragma unroll
        for (int j = 0; j < 4; ++j) { const int col = 4 * lane + 256 * j; f32x4 y[2];
#pragma unroll
            for (int k = 0; k < 2; ++k) { const int r = k ? rB : r0;
                const f32x4 sh = shv[k][j], sc = scv[k][j];
                y[k] = (v[k][j] * rs[k] * gv[j]) * (sc + 1.0f) + sh;
                v2u w; w.x = pk2(y[k][0], y[k][1]); w.y = pk2(y[k][2], y[k][3]);
                if (k == 0 || ok1) *(v2u*)(hn + (size_t)r * DM + col) = w; }
#pragma unroll
            for (int q = 0; q < 4; ++q) {
#pragma unroll
                for (int e4 = 0; e4 < 4; ++e4) { const f32x4 ww = *(const LAS f32x4*)(wr + 4 * ((((j * 4 + q) * 4 + e4) * 65) + lane_o));
#pragma unroll
                    for (int s = 0; s < 4; ++s) { lg[0][e4 * 4 + s] += y[0][q] * ww[s]; lg[1][e4 * 4 + s] += y[1][q] * ww[s]; } }
#define PIN16(x) asm volatile("" : "+v"(x[0]), "+v"(x[1]), "+v"(x[2]), "+v"(x[3]), "+v"(x[4]), "+v"(x[5]), "+v"(x[6]), "+v"(x[7]), "+v"(x[8]), "+v"(x[9]), "+v"(x[10]), "+v"(x[11]), "+v"(x[12]), "+v"(x[13]), "+v"(x[14]), "+v"(x[15]) :: "memory")
                PIN16(lg[0]); PIN16(lg[1]); } }
#undef PIN16
        const int exb = ((lane >> 5) & 1) * 8 + ((lane >> 4) & 1) * 4, esel = lane & 3;
#pragma unroll
        for (int k = 0; k < 2; ++k) { float k8[8], k4[4];
#pragma unroll
            for (int i = 0; i < 8; ++i) { float x = lg[k][i], y = lg[k][8 + i]; swap32(x, y); k8[i] = x + y; }
#pragma unroll
            for (int i = 0; i < 4; ++i) { float x = k8[i], y = k8[4 + i]; swap16(x, y); k4[i] = row_allsum(x + y); }
            const float mx = x32_max(x16_max(fmaxf(fmaxf(k4[0], k4[1]), fmaxf(k4[2], k4[3]))));
            float pe[4];
#pragma unroll
            for (int i = 0; i < 4; ++i) pe[i] = __expf(k4[i] - mx);
            const float sum = x32_sum(x16_sum((pe[0] + pe[1]) + (pe[2] + pe[3])));
            const float mine = (esel == 0) ? pe[0] : (esel == 1) ? pe[1] : (esel == 2) ? pe[2] : pe[3];
            const int r = k ? rB : r0;
            if ((lane & 12) == 0 && (k == 0 || ok1)) aff[((size_t)(r >> 12) * NE + exb + esel) * SEQ + (r & 4095)] = mine * __builtin_amdgcn_rcpf(sum); }
    }
}

__device__ __forceinline__ void conv_item(const Args& a, LAS float* scr, int lane, bool gu, int it) {
    unsigned char* ws = a.ws;
    if (gu) { const int mat = it >> 9, r = it & 511, nb = r >> 4, kb = r & 15, e = mat >> 1, kind = mat & 1, n0 = nb * 32;
        transpose_item((kind ? a.in[26] : a.in[25]) + (size_t)e * DM * DM, DM, kb * 64, n0, (bf16*)(ws + WS_WGU) + (size_t)e * 2048 * DM, DM, (n0 >> 7) * 256 + kind * 128 + (n0 & 127), scr, lane, false);
    } else { const int e = it >> 9, r = it & 511, nb = r >> 4, kb = r & 15;
        transpose_item(a.in[27] + (size_t)e * DM * DM, DM, kb * 64, nb * 32, (bf16*)(ws + WS_WD) + (size_t)e * DM * DM, DM, nb * 32, scr, lane, false); }
}
__device__ __forceinline__ bool conv_try(const Args& a, LAS unsigned char* lds, bool allow_gu, unsigned& cur) {
    const int lane = threadIdx.x & 63, wave = threadIdx.x >> 6;
    if (wave == 0) return false;
    const int gw = blockIdx.x * (NWAVES - 1) + wave - 1, NGW = gridDim.x * (NWAVES - 1);
    LAS float* scr = (LAS float*)(lds + wave * 8448);
    const int itD = gw + (int)(cur & 0xffffu) * NGW;
    if (itD < NE * 512) { conv_item(a, scr, lane, false, itD); cur += 1u; return true; }
    if (!allow_gu) return false;
    const int itG = gw + (int)(cur >> 16) * NGW;
    if (itG < NE * 1024) { conv_item(a, scr, lane, true, itG); cur += 0x10000u; return true; }
    return false;
}
#ifndef DBG_NOSHADOW
#define DBG_NOSHADOW 0
#endif
#ifndef SHADOW_LIM
#define SHADOW_LIM 2
#endif
__device__ __forceinline__ void seam_barrier(const XcdBarrier& b, const Args& a, LAS unsigned char* lds, volatile LAS unsigned* MISC, unsigned& gen, bool allow_gu, unsigned& cdone) {
    asm volatile("s_waitcnt vmcnt(0)" ::: "memory");
    __syncthreads();
    ++gen;
    if (threadIdx.x < 64) {
        if (threadIdx.x == 0) {
            unsigned* bar = b.bar;
            __builtin_amdgcn_s_waitcnt(0);
            unsigned nloc = b.st[0], nx = b.st[1];
            if (nloc == 0u) { xcd_barrier_complete(bar, b.x, nloc, nx); b.st[0] = nloc; b.st[1] = nx; }
            const unsigned old = xb_add(&bar[XB_XSUB(b.x)], 1u);
            const unsigned g2 = old / nloc;
            if (old + 1u == (g2 + 1u) * nloc) {
                __builtin_amdgcn_fence(__ATOMIC_RELEASE, "agent");
                asm volatile("s_waitcnt vmcnt(0)" ::: "memory");
                const unsigned og = xb_add(&bar[XB_TOP], 1u);
                const unsigned tg = og / nx;
                if (og + 1u == (tg + 1u) * nx) xb_add(&bar[XB_TOPGEN], 1u);
                else XB_SPIN(xb_ld(&bar[XB_TOPGEN]) == tg, bar);
                __builtin_amdgcn_fence(__ATOMIC_ACQUIRE, "agent");
                xb_add(&bar[XB_XGEN(b.x)], 1u);
                asm volatile("s_waitcnt vmcnt(0)" ::: "memory");
            } else {
                XB_SPIN(xb_ld(&bar[XB_XGEN(b.x)]) == g2, bar);
                __builtin_amdgcn_fence(__ATOMIC_ACQUIRE, "agent");
                asm volatile("s_waitcnt vmcnt(0)" ::: "memory");
            }
            MISC[16] = gen;
        }
    } else {
        unsigned spins = 0; int ndone = 0;
        while (MISC[16] != gen) { if (DBG_NOSHADOW || ndone >= SHADOW_LIM || !conv_try(a, lds, allow_gu, cdone)) { __builtin_amdgcn_s_sleep(4); if (++spins > (1u << 22)) break; } else ++ndone; }
    }
    __syncthreads();
}

__device__ __forceinline__ void block_excl_scan2(int& va, int& vb, LAS int* tmp) {
    const int tid = threadIdx.x, lane = tid & 63, wave = tid >> 6;
    int ia = va, ib = vb;
#pragma unroll
    for (int o = 1; o < 64; o <<= 1) { const int ta = __shfl_up(ia, o), tb = __shfl_up(ib, o); if (lane >= o) { ia += ta; ib += tb; } }
    if (lane == 63) { tmp[wave] = ia; tmp[8 + wave] = ib; }
    __syncthreads();
    int oa = 0, ob = 0;
#pragma unroll
    for (int w = 0; w < 8; ++w) { if (w < wave) { oa += tmp[w]; ob += tmp[8 + w]; } }
    va = oa + ia - va; vb = ob + ib - vb;
    __syncthreads();
}
__device__ __forceinline__ void topk_item(const Args& a, LAS unsigned char* lds, int be) {
    const int tid = threadIdx.x, b = be >> 4, e = be & 15;
    unsigned char* ws = a.ws;
    LAS unsigned* keys = (LAS unsigned*)lds;
    LAS unsigned* hist = (LAS unsigned*)(lds + 16384);
    LAS int* ctl = (LAS int*)(lds + 16384 + 1024);
    LAS int* tmp = (LAS int*)(lds + 16384 + 1024 + 64);
    const float* aff = (const float*)(ws + WS_AFF) + (size_t)be * SEQ;
    unsigned my[8];
#pragma unroll
    for (int i = 0; i < 8; ++i) { my[i] = __float_as_uint(aff[tid * 8 + i]); keys[tid * 8 + i] = my[i]; }
    unsigned prefix = 0u, mask = 0u; int need = CAP;
    for (int pass = 0; pass < 4; ++pass) {
        const int shift = 24 - 8 * pass;
        if (tid < 256) hist[tid] = 0u;
        __syncthreads();
#pragma unroll
        for (int i = 0; i < 8; ++i) if ((my[i] & mask) == prefix) atomicAdd((unsigned*)&hist[(my[i] >> shift) & 255u], 1u);
        __syncthreads();
        {
            int hv = (tid < 256) ? (int)hist[255 - tid] : 0, inc = hv;
#pragma unroll
            for (int o = 1; o < 64; o <<= 1) { const int t2 = __shfl_up(inc, o); if ((tid & 63) >= o) inc += t2; }
            if ((tid & 63) == 63) tmp[tid >> 6] = inc;
            __syncthreads();
            int off = 0;
#pragma unroll
            for (int w = 0; w < 4; ++w) if (w < (tid >> 6)) off += tmp[w];
            inc += off;
            if (tid < 256 && inc >= need && inc - hv < need) { ctl[0] = 255 - tid; ctl[1] = need - (inc - hv); }
        }
        __syncthreads();
        prefix |= ((unsigned)ctl[0]) << shift; mask |= 255u << shift; need = ctl[1];
        __syncthreads();
    }
    const unsigned T = prefix;
    int cg = 0, ce = 0;
#pragma unroll
    for (int i = 0; i < 8; ++i) { cg += (my[i] > T) ? 1 : 0; ce += (my[i] == T) ? 1 : 0; }
    int pg = cg, pe = ce;
    block_excl_scan2(pg, pe, tmp);
    int* slot_of = (int*)(ws + WS_SLOT) + (size_t)be * SEQ;
    int* selt = (int*)(ws + WS_SELT) + (e * 4 + b) * CAP; float* selv = (float*)(ws + WS_SELV) + (e * 4 + b) * CAP;
#pragma unroll
    for (int i = 0; i < 8; ++i) { const int t = tid * 8 + i; const bool gt = my[i] > T, eq = my[i] == T; const bool sel = gt || (eq && pe < need);
        const int slot = pg + (pe < need ? pe : need);
        slot_of[t] = sel ? slot : -1;
        if (sel) { selt[slot] = t; selv[slot] = __uint_as_float(my[i]); }
        pg += gt ? 1 : 0; pe += eq ? 1 : 0; }
    __syncthreads();
}
__device__ __forceinline__ void phase_topk(const Args& a, LAS unsigned char* lds, unsigned& cdone) {
    const int tid = threadIdx.x, lane = tid & 63, wave = tid >> 6, wg = blockIdx.x, G = gridDim.x;
    unsigned char* ws = a.ws;
    for (int it = wg; it < NB * NE; it += G) topk_item(a, lds, it);
    __syncthreads();
    while (conv_try(a, lds, true, cdone)) {}
}

__device__ __forceinline__ void phase_final(const Args& a) {
    const int tid = threadIdx.x, lane = tid & 63, wave = tid >> 6, wg = blockIdx.x, G = gridDim.x;
    unsigned char* ws = a.ws;
    const float* modr = (const float*)(ws + WS_MOD); const int* slot_of = (const int*)(ws + WS_SLOT); const bf16* ys = (const bf16*)(ws + WS_YSLAB); const bf16* x1b = (const bf16*)(ws + WS_X1B);
    const int NGW = G * NWAVES;
    f32x4 gf[4];
#pragma unroll
    for (int j = 0; j < 4; ++j) gf[j] = *(const f32x4*)(a.in[28] + 4 * lane + 256 * j);
#pragma nounroll
    for (int r0 = wg * NWAVES + wave; r0 < MX; r0 += 4 * NGW) {
        int sv[4]; unsigned long long mk[4]; f32x4 v[4][4], m[4][4];
#pragma unroll
        for (int k = 0; k < 4; ++k) { const int r = r0 + k * NGW; const bool ok = r < MX; const int rc = ok ? r : r0, b = rc >> 12, t = rc & 4095;
            sv[k] = (lane < NE) ? slot_of[((size_t)b * NE + lane) * SEQ + t] : -1;
#pragma unroll
            for (int j = 0; j < 4; ++j) { const v2u w0 = *(const v2u*)(x1b + (size_t)rc * DM + 4 * lane + 256 * j); v[k][j] = (f32x4){bflo(w0.x), bfhi(w0.x), bflo(w0.y), bfhi(w0.y)}; m[k][j] = (f32x4){0.f, 0.f, 0.f, 0.f}; }
            mk[k] = (ok && !DBG_NOMOE) ? __ballot(sv[k] >= 0) : 0ull; }
        while (mk[0] | mk[1] | mk[2] | mk[3]) {
            v2u w[4][4]; float wt[4];
#pragma unroll
            for (int k = 0; k < 4; ++k) { const bool has = mk[k] != 0ull; const int e = has ? (int)__ffsll((long long)mk[k]) - 1 : 0; mk[k] &= mk[k] - 1ull;
                const int rc = (r0 + k * NGW < MX) ? r0 + k * NGW : r0; const int sl = has ? __builtin_amdgcn_readlane(sv[k], e) : 0;
                const bf16* yp = ys + ((size_t)e * 2048 + (rc >> 12) * CAP + sl) * DM; wt[k] = has ? 1.f : 0.f;
#pragma unroll
                for (int j = 0; j < 4; ++j) w[k][j] = *(const v2u*)(yp + 4 * lane + 256 * j); }
#pragma unroll
            for (int k = 0; k < 4; ++k)
#pragma unroll
                for (int j = 0; j < 4; ++j) { m[k][j][0] += wt[k] * bflo(w[k][j].x); m[k][j][1] += wt[k] * bfhi(w[k][j].x); m[k][j][2] += wt[k] * bflo(w[k][j].y); m[k][j][3] += wt[k] * bfhi(w[k][j].y); }
        }
        f32x4 gt[4][4];
#pragma unroll
        for (int k = 0; k < 4; ++k) { const int r = r0 + k * NGW, b = ((r < MX) ? r : r0) >> 12;
#pragma unroll
            for (int j = 0; j < 4; ++j) gt[k][j] = *(const f32x4*)(modr + b * 6144 + 5120 + 4 * lane + 256 * j); }
#pragma unroll
        for (int k = 0; k < 4; ++k) { const int r = r0 + k * NGW;
            if (r < MX) { float ss = 0.f; float* row = a.out + (size_t)r * DM;
#pragma unroll
                for (int j = 0; j < 4; ++j) { v[k][j] = v[k][j] + gt[k][j] * m[k][j] * DBG_MOE_K;
                    ss += v[k][j][0] * v[k][j][0] + v[k][j][1] * v[k][j][1] + v[k][j][2] * v[k][j][2] + v[k][j][3] * v[k][j][3]; }
                const float rs = rsqrtf(wave_sum(ss) * (1.0f / DM) + EPS);
#pragma unroll
                for (int j = 0; j < 4; ++j) *(f32x4*)(row + 4 * lane + 256 * j) = v[k][j] * rs * gf[j]; } }
    }
}

__global__ void __launch_bounds__(NTHR, 2) fwd_kernel(Args a) {
    extern __shared__ __attribute__((aligned(16))) unsigned char lds_raw[];
    LAS unsigned char* lds = (LAS unsigned char*)lds_raw;
    const int tid = threadIdx.x, wg = blockIdx.x, G = gridDim.x;
    unsigned char* ws = a.ws;
    volatile LAS unsigned* MISC = (volatile LAS unsigned*)(lds + LDS_MISC);
    if (tid < 64) MISC[tid] = 0u;
    __syncthreads();
    unsigned bgen = 0u, cdone = 0u;
    XcdBarrier bar; bar.bar = (unsigned*)(ws + WS_CTL); bar.x = 0; bar.st = nullptr;
    if (a.ph_hi - a.ph_lo > 1) bar = xcd_barrier_post((unsigned*)(ws + WS_CTL), MISC + 8);
#ifndef PH_ONLY
#define PH_ONLY -1
#endif
#define IN(k) ((PH_ONLY < 0 || PH_ONLY == (k)) && a.ph_lo <= (k) && (k) < a.ph_hi)
#ifndef DBG_BAR2
#define DBG_BAR2 0
#endif
#ifndef DBG_TSA
#define DBG_TSA -1
#endif
#ifndef DBG_TSB
#define DBG_TSB -1
#endif
#define STAMP(k) do { if (DBG_TSA >= 0 && wg == 0 && tid == 0) ((unsigned long long*)(ws + WS_CTL + 49152))[k] = __builtin_amdgcn_s_memrealtime(); } while (0)
#define SEAM(k) do { if (IN(k) && IN((k) + 1)) { seam_barrier(bar, a, lds, MISC, bgen, true, cdone); if (DBG_BAR2) xcd_barrier(bar); } STAMP((k) + 1); } while (0)
#ifndef DBG_DUP
#define DBG_DUP -1
#endif
#define REP(k) _Pragma("nounroll") for (int _rep = 0; _rep < ((DBG_DUP == (k)) ? 2 : 1); ++_rep, (void)((DBG_DUP == (k) && _rep == 1) ? (xcd_barrier(bar), 0) : 0))
    STAMP(0);
    if (IN(0)) REP(0) { phase0(a, lds); } SEAM(0);
    if (IN(1)) REP(1) { phase1(a, lds); } SEAM(1);
    if (IN(2)) REP(2) {
        pg8::Gemm g{(const pg8::bf16_t*)ws, (const pg8::bf16_t*)ws, MT, NIN, DM}; InSched S; S.init(G, wg, 0);
        EpiIn E{(bf16*)(ws + WS_QKVG), (bf16*)(ws + WS_HYT), (float*)(ws + WS_AFB)};
        pg8::gemm_phase<EpiIn, InSched, true, true>(lds, g, S, E);
    } SEAM(2);
    if (IN(3)) REP(3) {
        {   pg8::Gemm g{(const pg8::bf16_t*)ws, (const pg8::bf16_t*)ws, MT, NIN, DM}; InSched S; S.init(G, wg, 1);
            EpiIn E{(bf16*)(ws + WS_QKVG), (bf16*)(ws + WS_HYT), (float*)(ws + WS_AFB)};
            pg8::gemm_phase<EpiIn, InSched, true, true>(lds, g, S, E); }
        for (int it = wg; it < 512; it += G) hyena_item(a, lds, it, 0);
        {   GlaIn I, N; bool have = false;
            const bool split = (G == 256);
            const int first = split ? ((wg < 80) ? wg : 80 + wg) : wg, stride = split ? ((wg < 80) ? 80 : 176) : G, limit = split ? ((wg < 80) ? 160 : 16 * NCH) : 16 * NCH;
            for (int r = first; r < limit; r += stride) {
                const int nr = r + stride; const bool hasn = nr < limit;
                if (!have) { int t0 = threadIdx.x; asm volatile("" : "+v"(t0)); gla_load<false>(a, t0, r / NCH, r % NCH, I); have = true; }
                if (hasn) gla_upd_item<true>(a, lds, r / NCH, r % NCH, I, nr / NCH, nr % NCH, N); else gla_upd_item<false>(a, lds, r / NCH, r % NCH, I, 0, 0, N);
                I = N; } }
    } SEAM(3);
    if (IN(4)) REP(4) {
        for (int it = wg; it < 1024; it += G) { if (it < 512) hyena_item(a, lds, it, 1); else gla_scan_item(a, it - 512); }
    } SEAM(4);
    if (IN(5)) REP(5) {
        GlaIn I, N; bool have = false;
        for (int it = wg; it < 1280; it += G) {
            if (it >= 1024) { hy_transpose_item(a, lds, it - 1024); continue; }
            const int nr = it + G; const bool hasn = nr < 1024;
            if (!have) { int t0 = threadIdx.x; asm volatile("" : "+v"(t0)); gla_load<true>(a, t0, it >> 6, it & 63, I); have = true; }
            if (hasn) gla_out_item<true>(a, lds, it >> 6, it & 63, I, nr >> 6, nr & 63, N); else gla_out_item<false>(a, lds, it >> 6, it & 63, I, 0, 0, N);
            I = N; }
    } SEAM(5);
    if (IN(6)) REP(6) {
        pg8::Gemm g{(const pg8::bf16_t*)(ws + WS_AOUT), (const pg8::bf16_t*)(ws + WS_WOUT), MX, DM, DM}; pg8::StaticOrder S; S.init(MX, DM, G, wg);
        EpiOut E{a.in[0], (const float*)(ws + WS_POS), (const float*)(ws + WS_MOD), (bf16*)(ws + WS_X1B)};
        pg8::gemm_phase<EpiOut, pg8::StaticOrder, false, true>(lds, g, S, E);
    } SEAM(6);
    if (IN(7)) REP(7) { phase_router(a, lds); } SEAM(7);
    if (IN(8)) REP(8) { phase_topk(a, lds, cdone); } SEAM(8);
    if (IN(9)) REP(9) {
        pg8::Gemm g{(const pg8::bf16_t*)(ws + WS_HN), (const pg8::bf16_t*)(ws + WS_WGU), NE * 2048, NE * 2048, DM}; MoeSched<8> S; S.init(G, wg);
        EpiGU E{(bf16*)(ws + WS_HID)};
        pg8::gemm_phase_gather<EpiGU, MoeSched<8>, true, true>(lds, g, S, E, (const int*)(ws + WS_SELT));
    } SEAM(9);
    if (IN(10)) REP(10) {
        pg8::Gemm g{(const pg8::bf16_t*)(ws + WS_HID), (const pg8::bf16_t*)(ws + WS_WD), NE * 2048, NE * 1024, DM}; MoeSched<4> S; S.init(G, wg);
        EpiDown E{(bf16*)(ws + WS_YSLAB), (const float*)(ws + WS_SELV)};
        pg8::gemm_phase<EpiDown, MoeSched<4>, true, true>(lds, g, S, E);
    } SEAM(10);
    if (IN(11)) { phase_final(a); }
    if (DBG_TSA >= 0) {
        xcd_barrier(bar); STAMP(12); xcd_barrier(bar);
        const unsigned long long* ts = (const unsigned long long*)(ws + WS_CTL + 49152);
        const float da = (DBG_TSA == 12) ? (float)(ts[12] - ts[0]) * 0.01f : (float)(ts[DBG_TSA + 1] - ts[DBG_TSA]) * 0.01f;
        const float db = (DBG_TSB == 12) ? (float)(ts[12] - ts[0]) * 0.01f : (float)(ts[DBG_TSB + 1] - ts[DBG_TSB]) * 0.01f;
        for (size_t i = (size_t)wg * NTHR + tid; i < (size_t)MX * DM; i += (size_t)G * NTHR) a.out[i] = (i < (size_t)MX * DM / 2) ? da : db;
    }
#undef IN
#undef SEAM
}


#ifdef DBG_STATE
__global__ void chk_kernel(const unsigned* p, size_t nwords, unsigned long long* out) {
    unsigned long long s = 0ull;
    for (size_t i = (size_t)blockIdx.x * blockDim.x + threadIdx.x; i < nwords; i += (size_t)gridDim.x * blockDim.x) s += (unsigned long long)p[i] * (2ull * i + 1ull);
    for (int o = 1; o < 64; o <<= 1) s += __shfl_xor(s, o);
    if ((threadIdx.x & 63) == 0) atomicAdd(out, s);
}
__global__ void report_kernel(const unsigned long long* chk, float* out, int n) {
    int bad = -1;
    for (int p = 0; p < 27; ++p) if (chk[p] != chk[32 + p]) { bad = p; break; }
    if (bad < 0) return;
    for (int i = blockIdx.x * blockDim.x + threadIdx.x; i < n; i += gridDim.x * blockDim.x) out[i] = 1000.f * (float)(bad + 1);
}
struct ChkEnt { int ph; size_t off; size_t bytes; };
#endif
extern "C" void kernel_launch(void* const* d_in, const int* in_sizes, int n_in, void* d_out, int out_size, void* d_ws, size_t ws_size, hipStream_t stream) {
    static int grid = 0;
    if (grid == 0) {
        if (n_in != 29 || out_size != MX * DM || ws_size < WS_END) { fprintf(stderr, "kernel_launch: unexpected shapes (n_in %d out %d ws %zu)\n", n_in, out_size, ws_size); grid = -1; return; }
        int dev = 0, cus = 0, per_cu = 0;
        if (hipGetDevice(&dev) != hipSuccess || hipDeviceGetAttribute(&cus, hipDeviceAttributeMultiprocessorCount, dev) != hipSuccess) { grid = -1; return; }
        if (hipFuncSetAttribute((const void*)fwd_kernel, hipFuncAttributeMaxDynamicSharedMemorySize, LDS_BYTES) != hipSuccess) { fprintf(stderr, "kernel_launch: hipFuncSetAttribute failed\n"); grid = -1; return; }
        if (hipOccupancyMaxActiveBlocksPerMultiprocessor(&per_cu, (const void*)fwd_kernel, NTHR, LDS_BYTES) != hipSuccess || per_cu < 1) fprintf(stderr, "kernel_launch: occupancy query reports %d\n", per_cu);
        (void)hipGetLastError();
        grid = cus;
    }
    if (grid < 0) return;
    (void)hipMemsetAsync((char*)d_ws + WS_CTL, 0, CTL_BYTES, stream);
    Args a{};
    for (int i = 0; i < 29; ++i) a.in[i] = (const float*)d_in[i];
    a.out = (float*)d_out; a.ws = (unsigned char*)d_ws;
#if MK_SINGLE
#ifdef DBG_TWICE
    a.ph_lo = 0; a.ph_hi = NPH - 1;
    hipLaunchKernelGGL(fwd_kernel, dim3(grid), dim3(NTHR), LDS_BYTES, stream, a);
    (void)hipMemsetAsync((char*)d_ws + WS_CTL, 0, CTL_BYTES, stream);
#endif
    a.ph_lo = 0; a.ph_hi = NPH;
    hipLaunchKernelGGL(fwd_kernel, dim3(grid), dim3(NTHR), LDS_BYTES, stream, a);
#else
#ifdef DBG_STATE
    static const ChkEnt ents[] = { {0, WS_MOD, 122880}, {0, WS_POS, 131072}, {0, WS_HT, 32 * MiB}, {0, WS_WIN, (size_t)NIN * DM * 2}, {0, WS_WOUT, 2 * MiB},
        {1, WS_AIN, 34 * MiB}, {2, WS_QKVG, (size_t)MX * NQ * 2}, {2, WS_HYT, 48 * MiB}, {2, WS_AFB, (size_t)MT * 128},
        {3, WS_ZT, 32 * MiB}, {3, WS_DEC, (size_t)16 * 2 * NCH * 64 * 4}, {3, WS_UCTX, 4 * MiB}, {3, (size_t)-1, 64 * MiB},
        {4, WS_SPREV, 32 * MiB}, {4, WS_YHYT, 32 * MiB}, {5, WS_AOUT, 32 * MiB}, {6, (size_t)-1, 64 * MiB}, {7, WS_HN, 32 * MiB}, {7, WS_AFF, 1 * MiB},
        {8, WS_SLOT, 1 * MiB}, {8, WS_SELT, 131072}, {8, WS_SELV, 131072}, {8, WS_WGU, 64 * MiB}, {8, WS_WD, 32 * MiB}, {9, WS_HID, 64 * MiB}, {10, WS_YSLAB, 64 * MiB}, {11, (size_t)-1, 64 * MiB} };
    unsigned long long* chk = (unsigned long long*)((char*)d_ws + 32768);
    for (int run = 0; run < 2; ++run)
        for (int p = 0; p < NPH; ++p) { a.ph_lo = p; a.ph_hi = p + 1; hipLaunchKernelGGL(fwd_kernel, dim3(grid), dim3(NTHR), LDS_BYTES, stream, a);
            for (const ChkEnt& e : ents) if (e.ph == p) hipLaunchKernelGGL(chk_kernel, dim3(1024), dim3(256), 0, stream, (const unsigned*)(e.off == (size_t)-1 ? (char*)d_out : (char*)d_ws + e.off), e.bytes / 4, chk + run * 32 + (int)(&e - ents)); }
    hipLaunchKernelGGL(report_kernel, dim3(1024), dim3(256), 0, stream, (const unsigned long long*)chk, (float*)d_out, out_size);
#else
    for (int p = 0; p < NPH; ++p) { a.ph_lo = p; a.ph_hi = p + 1; hipLaunchKernelGGL(fwd_kernel, dim3(grid), dim3(NTHR), LDS_BYTES, stream, a); }
#endif
#endif
}
```

```cpp
#include <hip/hip_runtime.h>
#include <cstdio>
#include <cstdint>
#define MK_SINGLE 1
namespace pg8 {
#define PG8_LAS __attribute__((address_space(3)))
typedef unsigned short bf16_t;
typedef short bf16x8 __attribute__((ext_vector_type(8)));
typedef float f32x4 __attribute__((ext_vector_type(4)));
typedef unsigned u32x4 __attribute__((ext_vector_type(4)));
constexpr int BM = 256, BK = 64, HALF = 128, HTB = HALF * BK * 2  , STAGE_BYTES = 8 * HTB, NXCD = 8, WGM = 8;

__host__ __device__ __forceinline__ int lds_byte(int r, int c) { const int st = (r >> 4) * 2 + (c >> 5), rr = r & 15, cc = c & 31, ob = rr * 64 + cc * 2; return st * 1024 + (ob ^ (((ob >> 9) & 1) << 5)); }
__host__ __device__ __forceinline__ void stage_rc(int b, int& R, int& C) { const int st = b / 1024, sb = b % 1024, swz = sb ^ (((sb >> 9) & 1) << 5); R = (st >> 1) * 16 + swz / 64; C = (st & 1) * 32 + (swz % 64) / 2; }
__host__ __device__ __forceinline__ int perm32(int rho) { const int n = rho >> 4, i = rho & 15; return 8 * (i >> 2) + 4 * n + (i & 3); }

struct Unit { int pm, pn; };
struct Gemm { const bf16_t* A; const bf16_t* Bt; int M, N, K; };

struct StaticOrder {
    int nM, nN, nwg, G, c;
    __host__ __device__ void init(int M, int N, int G_, int c_) { nM = M / BM; nN = N / BM; nwg = nM * nN; G = G_; c = c_; }
    __host__ __device__ bool next(int i, Unit& u) const {
        const long L = (long)i * G + c; if (L >= nwg) return false;
        int wgid = (int)L; { const int q = nwg / NXCD, r = nwg % NXCD, xcd = wgid % NXCD, off = wgid / NXCD; wgid = (xcd < r ? xcd * (q + 1) : r * (q + 1) + (xcd - r) * q) + off; }
        const int nig = WGM * nN, gid = wgid / nig, fm = gid * WGM, gsz = (nM - fm) < WGM ? (nM - fm) : WGM;
        u.pm = fm + ((wgid % nig) % gsz); u.pn = (wgid % nig) / gsz; return true;
    }
    __device__ __forceinline__ void a_ready(const Unit&) const {}
    __device__ __forceinline__ void done(const Unit&) const {}
};

__device__ __forceinline__ unsigned cvt_pk_bf16(float lo, float hi) { unsigned r; asm volatile("v_cvt_pk_bf16_f32 %0, %1, %2" : "=v"(r) : "v"(lo), "v"(hi)); return r; }
template <class Epi, class Sched, bool ALIGN_EPI = false, bool SP2 = false>
__device__ __forceinline__ void gemm_phase(PG8_LAS unsigned char* lds, const Gemm g, const Sched& S, const Epi& E) {
    const int tid = threadIdx.x, wid = __builtin_amdgcn_readfirstlane(tid >> 6), lane = tid & 63, wr = wid >> 2, wc = wid & 3, fr = lane & 15, fq = lane >> 4;
    const int K = g.K, nt = K / BK;
    unsigned voffA[2], voffB[2];
#pragma unroll
    for (int i = 0; i < 2; ++i) { int R, C; stage_rc(tid * 16 + i * 8192, R, C); const int Rb = Epi::PERM ? ((R & ~31) + perm32(R & 31)) : R;
        voffA[i] = (unsigned)(R * K + C) * 2u; voffB[i] = (unsigned)(Rb * K + C) * 2u; }
    const size_t kstep = (size_t)(BK * 2);
    const size_t hstep = (size_t)HALF * K * 2;
    const size_t tstep = 2 * hstep;
    const unsigned ldsw = (unsigned)wid * 1024u;
    const int aoff = lds_byte(wr * 64 + fr, fq * 8), boff = lds_byte(wc * 32 + fr, fq * 8);
#define PG8_SA(b, h) (((b) * 2 + (h)) * HTB)
#define PG8_SB(b, h) ((4 + (b) * 2 + (h)) * HTB)
#define PG8_STAGE(bufoff, gbase, voff) do { _Pragma("unroll") for (int _i = 0; _i < 2; ++_i) \
        __builtin_amdgcn_global_load_lds((const unsigned*)((const char*)(gbase) + (voff)[_i]), (PG8_LAS unsigned*)(lds + (bufoff) + ldsw + _i * 8192), 16, 0, 0); } while (0)
#define PG8_LDA(dst, b, h) do { _Pragma("unroll") for (int m = 0; m < 4; ++m) _Pragma("unroll") for (int k = 0; k < 2; ++k) dst[m][k] = *(const PG8_LAS bf16x8*)(lds + PG8_SA(b, h) + aoff + m * 2048 + k * 1024); } while (0)
#define PG8_LDB(dst, b, h) do { _Pragma("unroll") for (int n = 0; n < 2; ++n) _Pragma("unroll") for (int k = 0; k < 2; ++k) dst[n][k] = *(const PG8_LAS bf16x8*)(lds + PG8_SB(b, h) + boff + n * 2048 + k * 1024); } while (0)
#define PG8_MMA(ai, bj, At, Bt) do { __builtin_amdgcn_s_setprio(1); _Pragma("unroll") for (int m = 0; m < 4; ++m) _Pragma("unroll") for (int n = 0; n < 2; ++n) _Pragma("unroll") for (int k = 0; k < 2; ++k) \
        acc[ai][bj][m][n] = __builtin_amdgcn_mfma_f32_16x16x32_bf16(Bt[n][k], At[m][k], acc[ai][bj][m][n], 0, 0, 0); __builtin_amdgcn_s_setprio(0); } while (0)
#define PG8_WAIT_V(n) asm volatile("s_waitcnt vmcnt(" #n ")" ::: "memory")
#define PG8_WAIT_L(n) asm volatile("s_waitcnt lgkmcnt(" #n ")" ::: "memory")
#define PG8_BAR __builtin_amdgcn_s_barrier()
#define PG8_SCHED __builtin_amdgcn_sched_barrier(0)
    Unit cur, nxt; int ui = 0;
    if (!S.next(0, cur)) return;
    f32x4 acc[2][2][4][2];
#pragma unroll
    for (int a = 0; a < 2; ++a)
#pragma unroll
        for (int b = 0; b < 2; ++b)
#pragma unroll
            for (int m = 0; m < 4; ++m)
#pragma unroll
                for (int n = 0; n < 2; ++n) acc[a][b][m][n] = (f32x4){0.f, 0.f, 0.f, 0.f};
    bf16x8 At[4][2], B0[2][2], B1[2][2];
    const char* cA = (const char*)g.A + (size_t)cur.pm * tstep; const char* cB = (const char*)g.Bt + (size_t)cur.pn * tstep;
    S.a_ready(cur);
    if constexpr (SP2) {
        PG8_STAGE(PG8_SB(0, 0), cB, voffB); PG8_STAGE(PG8_SB(0, 1), cB + hstep, voffB); PG8_STAGE(PG8_SA(0, 0), cA, voffA); PG8_STAGE(PG8_SA(0, 1), cA + hstep, voffA);
        if (wr == 1) PG8_BAR;
        PG8_WAIT_V(2); PG8_BAR;
        PG8_STAGE(PG8_SB(1, 0), cB + kstep, voffB); PG8_STAGE(PG8_SA(1, 0), cA + kstep, voffA); PG8_STAGE(PG8_SB(1, 1), cB + hstep + kstep, voffB);
        PG8_WAIT_V(6); PG8_BAR;
    } else {
        PG8_STAGE(PG8_SB(0, 0), cB, voffB); PG8_STAGE(PG8_SA(0, 0), cA, voffA); PG8_STAGE(PG8_SB(0, 1), cB + hstep, voffB); PG8_STAGE(PG8_SA(0, 1), cA + hstep, voffA);
        if (wr == 1) PG8_BAR;
        PG8_WAIT_V(4); PG8_BAR;
        PG8_STAGE(PG8_SB(1, 0), cB + kstep, voffB); PG8_STAGE(PG8_SA(1, 0), cA + kstep, voffA); PG8_STAGE(PG8_SB(1, 1), cB + hstep + kstep, voffB);
        PG8_WAIT_V(6); PG8_BAR;
    }
    for (;;) {
        const bool has_next = S.next(ui + 1, nxt);
        const char* nA = has_next ? (const char*)g.A + (size_t)nxt.pm * tstep : cA; const char* nB = has_next ? (const char*)g.Bt + (size_t)nxt.pn * tstep : cB;
        for (int t = 0; t < nt; t += 2) {
            const bool last = (t == nt - 2);
            const char* a1 = cA + (size_t)(t + 1) * kstep;
            const char* a2 = last ? nA : cA + (size_t)(t + 2) * kstep; const char* b2 = last ? nB : cB + (size_t)(t + 2) * kstep;
            const char* a3 = a2 + kstep; const char* b3 = b2 + kstep;
            if (last && has_next) S.a_ready(nxt);
            if constexpr (SP2) {
            PG8_LDB(B0, 0, 0); PG8_LDB(B1, 0, 1); PG8_SCHED; PG8_LDA(At, 0, 0); PG8_STAGE(PG8_SA(1, 1), a1 + hstep, voffA);
            PG8_WAIT_V(8); PG8_WAIT_L(0); PG8_BAR; PG8_MMA(0, 0, At, B0); PG8_MMA(0, 1, At, B1); PG8_BAR; PG8_SCHED;
            PG8_LDA(At, 0, 1); PG8_STAGE(PG8_SB(0, 0), b2, voffB); PG8_STAGE(PG8_SB(0, 1), b2 + hstep, voffB); PG8_STAGE(PG8_SA(0, 0), a2, voffA);
            PG8_WAIT_V(8); PG8_WAIT_L(0); PG8_BAR; PG8_MMA(1, 0, At, B0); PG8_MMA(1, 1, At, B1); PG8_BAR; PG8_SCHED;
            PG8_LDB(B0, 1, 0); PG8_LDB(B1, 1, 1); PG8_SCHED; PG8_LDA(At, 1, 0); PG8_STAGE(PG8_SA(0, 1), a2 + hstep, voffA);
            PG8_WAIT_V(8); PG8_WAIT_L(0); PG8_BAR; PG8_MMA(0, 0, At, B0); PG8_MMA(0, 1, At, B1); PG8_BAR; PG8_SCHED;
            PG8_LDA(At, 1, 1); PG8_STAGE(PG8_SB(1, 0), b3, voffB); PG8_STAGE(PG8_SB(1, 1), b3 + hstep, voffB); PG8_STAGE(PG8_SA(1, 0), a3, voffA);
            PG8_WAIT_V(8); PG8_WAIT_L(0); PG8_BAR; PG8_MMA(1, 0, At, B0); PG8_MMA(1, 1, At, B1); PG8_BAR; PG8_SCHED;
            } else {
            PG8_LDB(B0, 0, 0); PG8_SCHED; PG8_LDA(At, 0, 0); PG8_STAGE(PG8_SA(1, 1), a1 + hstep, voffA);
            PG8_WAIT_L(8); PG8_BAR; PG8_WAIT_L(0); PG8_MMA(0, 0, At, B0); PG8_BAR; PG8_SCHED;
            PG8_LDB(B1, 0, 1); PG8_STAGE(PG8_SB(0, 0), b2, voffB);
            PG8_BAR; PG8_WAIT_L(0); PG8_MMA(0, 1, At, B1); PG8_BAR;
            PG8_LDA(At, 0, 1); PG8_STAGE(PG8_SA(0, 0), a2, voffA);
            PG8_BAR; PG8_WAIT_L(0); PG8_MMA(1, 0, At, B0); PG8_BAR; PG8_SCHED;
            PG8_STAGE(PG8_SB(0, 1), b2 + hstep, voffB);
            PG8_WAIT_V(6); PG8_BAR; PG8_MMA(1, 1, At, B1); PG8_BAR;
            PG8_LDB(B0, 1, 0); PG8_SCHED; PG8_LDA(At, 1, 0); PG8_STAGE(PG8_SA(0, 1), a2 + hstep, voffA);
            PG8_WAIT_L(8); PG8_BAR; PG8_WAIT_L(0); PG8_MMA(0, 0, At, B0); PG8_BAR; PG8_SCHED;
            PG8_LDB(B1, 1, 1); PG8_STAGE(PG8_SB(1, 0), b3, voffB);
            PG8_BAR; PG8_WAIT_L(0); PG8_MMA(0, 1, At, B1); PG8_BAR;
            PG8_LDA(At, 1, 1); PG8_STAGE(PG8_SA(1, 0), a3, voffA);
            PG8_BAR; PG8_WAIT_L(0); PG8_MMA(1, 0, At, B0); PG8_BAR; PG8_SCHED;
            PG8_STAGE(PG8_SB(1, 1), b3 + hstep, voffB);
            PG8_WAIT_V(6); PG8_BAR; PG8_MMA(1, 1, At, B1); PG8_BAR;
            }
        }
        if constexpr (ALIGN_EPI) { if (wr == 0) PG8_BAR; }
        if constexpr (!Epi::AFTER_DRAIN) { E(acc, cur, wr, wc, fr, fq); S.done(cur); }
        if (!has_next) break;
#pragma unroll
        for (int a = 0; a < 2; ++a)
#pragma unroll
            for (int b = 0; b < 2; ++b)
#pragma unroll
                for (int m = 0; m < 4; ++m)
#pragma unroll
                    for (int n = 0; n < 2; ++n) acc[a][b][m][n] = (f32x4){0.f, 0.f, 0.f, 0.f};
        cur = nxt; cA = nA; cB = nB; ++ui;
        if constexpr (ALIGN_EPI) { if (wr == 1) PG8_BAR; }
    }
    PG8_WAIT_V(0);
    if constexpr (!ALIGN_EPI) { if (wr == 0) PG8_BAR; }
    PG8_BAR;
    if constexpr (Epi::AFTER_DRAIN) { E.fused(acc, cur, wr, wc, fr, fq, lds, wid, lane); S.done(cur); }
#undef PG8_SA
#undef PG8_SB
#undef PG8_STAGE
#undef PG8_LDA
#undef PG8_LDB
#undef PG8_MMA
#undef PG8_WAIT_V
#undef PG8_WAIT_L
#undef PG8_BAR
#undef PG8_SCHED
}
}
namespace pg8 {
template <class Epi, class Sched, bool ALIGN_EPI = false, bool SP2 = false>
__device__ __forceinline__ void gemm_phase_gather(PG8_LAS unsigned char* lds, const Gemm g, const Sched& S, const Epi& E, const int* __restrict__ idx) {
    const int tid = threadIdx.x, wid = __builtin_amdgcn_readfirstlane(tid >> 6), lane = tid & 63, wr = wid >> 2, wc = wid & 3, fr = lane & 15, fq = lane >> 4;
    const int K = g.K, nt = K / BK;
    unsigned voffB[2]; int RA[2], CA[2];
#pragma unroll
    for (int i = 0; i < 2; ++i) { int R, C; stage_rc(tid * 16 + i * 8192, R, C); const int Rb = Epi::PERM ? ((R & ~31) + perm32(R & 31)) : R;
        RA[i] = R; CA[i] = C; voffB[i] = (unsigned)(Rb * K + C) * 2u; }
    unsigned vA[2][2], nvA[2][2];
#define PG8_GOFF(dst, pm) do { _Pragma("unroll") for (int _h = 0; _h < 2; ++_h) _Pragma("unroll") for (int _i = 0; _i < 2; ++_i) { const int _r = (pm) * 256 + _h * 128 + RA[_i]; \
        dst[_h][_i] = (unsigned)((((_r >> 9) & 3) * 4096 + idx[_r]) * K + CA[_i]) * 2u; } } while (0)
    const size_t kstep = (size_t)(BK * 2);
    const size_t hstep = (size_t)HALF * K * 2;
    const size_t tstep = 2 * hstep;
    const unsigned ldsw = (unsigned)wid * 1024u;
    const int aoff = lds_byte(wr * 64 + fr, fq * 8), boff = lds_byte(wc * 32 + fr, fq * 8);
#define PG8_SA(b, h) (((b) * 2 + (h)) * HTB)
#define PG8_SB(b, h) ((4 + (b) * 2 + (h)) * HTB)
#define PG8_STAGE(bufoff, gbase, voff) do { _Pragma("unroll") for (int _i = 0; _i < 2; ++_i) \
        __builtin_amdgcn_global_load_lds((const unsigned*)((const char*)(gbase) + (voff)[_i]), (PG8_LAS unsigned*)(lds + (bufoff) + ldsw + _i * 8192), 16, 0, 0); } while (0)
#define PG8_LDA(dst, b, h) do { _Pragma("unroll") for (int m = 0; m < 4; ++m) _Pragma("unroll") for (int k = 0; k < 2; ++k) dst[m][k] = *(const PG8_LAS bf16x8*)(lds + PG8_SA(b, h) + aoff + m * 2048 + k * 1024); } while (0)
#define PG8_LDB(dst, b, h) do { _Pragma("unroll") for (int n = 0; n < 2; ++n) _Pragma("unroll") for (int k = 0; k < 2; ++k) dst[n][k] = *(const PG8_LAS bf16x8*)(lds + PG8_SB(b, h) + boff + n * 2048 + k * 1024); } while (0)
#define PG8_MMA(ai, bj, At, Bt) do { __builtin_amdgcn_s_setprio(1); _Pragma("unroll") for (int m = 0; m < 4; ++m) _Pragma("unroll") for (int n = 0; n < 2; ++n) _Pragma("unroll") for (int k = 0; k < 2; ++k) \
        acc[ai][bj][m][n] = __builtin_amdgcn_mfma_f32_16x16x32_bf16(Bt[n][k], At[m][k], acc[ai][bj][m][n], 0, 0, 0); __builtin_amdgcn_s_setprio(0); } while (0)
#define PG8_WAIT_V(n) asm volatile("s_waitcnt vmcnt(" #n ")" ::: "memory")
#define PG8_WAIT_L(n) asm volatile("s_waitcnt lgkmcnt(" #n ")" ::: "memory")
#define PG8_BAR __builtin_amdgcn_s_barrier()
#define PG8_SCHED __builtin_amdgcn_sched_barrier(0)
    Unit cur, nxt; int ui = 0;
    if (!S.next(0, cur)) return;
    f32x4 acc[2][2][4][2];
#pragma unroll
    for (int a = 0; a < 2; ++a)
#pragma unroll
        for (int b = 0; b < 2; ++b)
#pragma unroll
            for (int m = 0; m < 4; ++m)
#pragma unroll
                for (int n = 0; n < 2; ++n) acc[a][b][m][n] = (f32x4){0.f, 0.f, 0.f, 0.f};
    bf16x8 At[4][2], B0[2][2], B1[2][2];
    const char* cA = (const char*)g.A; PG8_GOFF(vA, cur.pm); const char* cB = (const char*)g.Bt + (size_t)cur.pn * tstep;
    S.a_ready(cur);
    if constexpr (SP2) {
        PG8_STAGE(PG8_SB(0, 0), cB, voffB); PG8_STAGE(PG8_SB(0, 1), cB + hstep, voffB); PG8_STAGE(PG8_SA(0, 0), cA, vA[0]); PG8_STAGE(PG8_SA(0, 1), cA, vA[1]);
        if (wr == 1) PG8_BAR;
        PG8_WAIT_V(2); PG8_BAR;
        PG8_STAGE(PG8_SB(1, 0), cB + kstep, voffB); PG8_STAGE(PG8_SA(1, 0), cA + kstep, vA[0]); PG8_STAGE(PG8_SB(1, 1), cB + hstep + kstep, voffB);
        PG8_WAIT_V(6); PG8_BAR;
    } else {
        PG8_STAGE(PG8_SB(0, 0), cB, voffB); PG8_STAGE(PG8_SA(0, 0), cA, vA[0]); PG8_STAGE(PG8_SB(0, 1), cB + hstep, voffB); PG8_STAGE(PG8_SA(0, 1), cA, vA[1]);
        if (wr == 1) PG8_BAR;
        PG8_WAIT_V(4); PG8_BAR;
        PG8_STAGE(PG8_SB(1, 0), cB + kstep, voffB); PG8_STAGE(PG8_SA(1, 0), cA + kstep, vA[0]); PG8_STAGE(PG8_SB(1, 1), cB + hstep + kstep, voffB);
        PG8_WAIT_V(6); PG8_BAR;
    }
    for (;;) {
        const bool has_next = S.next(ui + 1, nxt);
        if (has_next) { PG8_GOFF(nvA, nxt.pm); } else { nvA[0][0] = vA[0][0]; nvA[0][1] = vA[0][1]; nvA[1][0] = vA[1][0]; nvA[1][1] = vA[1][1]; } const char* nB = has_next ? (const char*)g.Bt + (size_t)nxt.pn * tstep : cB;
        for (int t = 0; t < nt; t += 2) {
            const bool last = (t == nt - 2);
            const char* a1 = cA + (size_t)(t + 1) * kstep;
            const char* a2 = cA + (last ? (size_t)0 : (size_t)(t + 2) * kstep); unsigned w2[2][2]; w2[0][0] = last ? nvA[0][0] : vA[0][0]; w2[0][1] = last ? nvA[0][1] : vA[0][1]; w2[1][0] = last ? nvA[1][0] : vA[1][0]; w2[1][1] = last ? nvA[1][1] : vA[1][1]; const char* b2 = last ? nB : cB + (size_t)(t + 2) * kstep;
            const char* a3 = a2 + kstep; const char* b3 = b2 + kstep;
            if (last && has_next) S.a_ready(nxt);
            if constexpr (SP2) {
            PG8_LDB(B0, 0, 0); PG8_LDB(B1, 0, 1); PG8_SCHED; PG8_LDA(At, 0, 0); PG8_STAGE(PG8_SA(1, 1), a1, vA[1]);
            PG8_WAIT_V(8); PG8_WAIT_L(0); PG8_BAR; PG8_MMA(0, 0, At, B0); PG8_MMA(0, 1, At, B1); PG8_BAR; PG8_SCHED;
            PG8_LDA(At, 0, 1); PG8_STAGE(PG8_SB(0, 0), b2, voffB); PG8_STAGE(PG8_SB(0, 1), b2 + hstep, voffB); PG8_STAGE(PG8_SA(0, 0), a2, w2[0]);
            PG8_WAIT_V(8); PG8_WAIT_L(0); PG8_BAR; PG8_MMA(1, 0, At, B0); PG8_MMA(1, 1, At, B1); PG8_BAR; PG8_SCHED;
            PG8_LDB(B0, 1, 0); PG8_LDB(B1, 1, 1); PG8_SCHED; PG8_LDA(At, 1, 0); PG8_STAGE(PG8_SA(0, 1), a2, w2[1]);
            PG8_WAIT_V(8); PG8_WAIT_L(0); PG8_BAR; PG8_MMA(0, 0, At, B0); PG8_MMA(0, 1, At, B1); PG8_BAR; PG8_SCHED;
            PG8_LDA(At, 1, 1); PG8_STAGE(PG8_SB(1, 0), b3, voffB); PG8_STAGE(PG8_SB(1, 1), b3 + hstep, voffB); PG8_STAGE(PG8_SA(1, 0), a3, w2[0]);
            PG8_WAIT_V(8); PG8_WAIT_L(0); PG8_BAR; PG8_MMA(1, 0, At, B0); PG8_MMA(1, 1, At, B1); PG8_BAR; PG8_SCHED;
            } else {
            PG8_LDB(B0, 0, 0); PG8_SCHED; PG8_LDA(At, 0, 0); PG8_STAGE(PG8_SA(1, 1), a1, vA[1]);
            PG8_WAIT_L(8); PG8_BAR; PG8_WAIT_L(0); PG8_MMA(0, 0, At, B0); PG8_BAR; PG8_SCHED;
            PG8_LDB(B1, 0, 1); PG8_STAGE(PG8_SB(0, 0), b2, voffB);
            PG8_BAR; PG8_WAIT_L(0); PG8_MMA(0, 1, At, B1); PG8_BAR;
            PG8_LDA(At, 0, 1); PG8_STAGE(PG8_SA(0, 0), a2, w2[0]);
            PG8_BAR; PG8_WAIT_L(0); PG8_MMA(1, 0, At, B0); PG8_BAR; PG8_SCHED;
            PG8_STAGE(PG8_SB(0, 1), b2 + hstep, voffB);
            PG8_WAIT_V(6); PG8_BAR; PG8_MMA(1, 1, At, B1); PG8_BAR;
            PG8_LDB(B0, 1, 0); PG8_SCHED; PG8_LDA(At, 1, 0); PG8_STAGE(PG8_SA(0, 1), a2, w2[1]);
            PG8_WAIT_L(8); PG8_BAR; PG8_WAIT_L(0); PG8_MMA(0, 0, At, B0); PG8_BAR; PG8_SCHED;
            PG8_LDB(B1, 1, 1); PG8_STAGE(PG8_SB(1, 0), b3, voffB);
            PG8_BAR; PG8_WAIT_L(0); PG8_MMA(0, 1, At, B1); PG8_BAR;
            PG8_LDA(At, 1, 1); PG8_STAGE(PG8_SA(1, 0), a3, w2[0]);
            PG8_BAR; PG8_WAIT_L(0); PG8_MMA(1, 0, At, B0); PG8_BAR; PG8_SCHED;
            PG8_STAGE(PG8_SB(1, 1), b3 + hstep, voffB);
            PG8_WAIT_V(6); PG8_BAR; PG8_MMA(1, 1, At, B1); PG8_BAR;
            }
        }
        if constexpr (ALIGN_EPI) { if (wr == 0) PG8_BAR; }
        if constexpr (!Epi::AFTER_DRAIN) { E(acc, cur, wr, wc, fr, fq); S.done(cur); }
        if (!has_next) break;
#pragma unroll
        for (int a = 0; a < 2; ++a)
#pragma unroll
            for (int b = 0; b < 2; ++b)
#pragma unroll
                for (int m = 0; m < 4; ++m)
#pragma unroll
                    for (int n = 0; n < 2; ++n) acc[a][b][m][n] = (f32x4){0.f, 0.f, 0.f, 0.f};
        cur = nxt; cB = nB; ++ui; vA[0][0] = nvA[0][0]; vA[0][1] = nvA[0][1]; vA[1][0] = nvA[1][0]; vA[1][1] = nvA[1][1];
        if constexpr (ALIGN_EPI) { if (wr == 1) PG8_BAR; }
    }
    PG8_WAIT_V(0);
    if constexpr (!ALIGN_EPI) { if (wr == 0) PG8_BAR; }
    PG8_BAR;
    if constexpr (Epi::AFTER_DRAIN) { E.fused(acc, cur, wr, wc, fr, fq, lds, wid, lane); S.done(cur); }
#undef PG8_SA
#undef PG8_SB
#undef PG8_STAGE
#undef PG8_LDA
#undef PG8_LDB
#undef PG8_MMA
#undef PG8_WAIT_V
#undef PG8_WAIT_L
#undef PG8_BAR
#undef PG8_SCHED
#undef PG8_GOFF
}
}

#ifndef DBG_NOMIX
#define DBG_NOMIX 0
#endif
#ifndef DBG_NOMOE
#define DBG_NOMOE 0
#endif
#ifndef DBG_NOPOS
#define DBG_NOPOS 0
#endif
#ifndef DBG_HTCONST
#define DBG_HTCONST 0
#endif
#ifndef DBG_GLA_K
#define DBG_GLA_K 1.0f
#endif
#ifndef DBG_MOE_K
#define DBG_MOE_K 1.0f
#endif
#ifndef MK_SINGLE
#define MK_SINGLE 0
#endif
#define GAS __attribute__((address_space(1)))
#define LAS __attribute__((address_space(3)))
typedef unsigned short bf16;
typedef float f32x4 __attribute__((ext_vector_type(4)));
typedef float f32x16 __attribute__((ext_vector_type(16)));
typedef short bf16x8 __attribute__((ext_vector_type(8)));
typedef unsigned v4u __attribute__((ext_vector_type(4)));
typedef unsigned v2u __attribute__((ext_vector_type(2)));
typedef GAS unsigned gu32;

constexpr int NWAVES = 8, NTHR = 512;
constexpr int NB = 4, SEQ = 4096, DM = 1024, CTXL = 256;
constexpr int MX = NB * SEQ, MC = NB * CTXL, MT = MX + MC;
constexpr int NIN = 3328, NQ = 1536, DIN = 3104;
constexpr int NE = 16, CAP = 512;
constexpr int NCH = 68;
constexpr int NPH = 12;
constexpr float EPS = 1e-6f;

constexpr size_t MiB = 1u << 20;
constexpr size_t WS_CTL = 0, CTL_BYTES = 65536;
constexpr int CW_CNT_D = 8192, CW_CNT_GU = 8192 + 64;
constexpr size_t WS_MOD = 1 * MiB, WS_POS = 1 * MiB + 256 * 1024, WS_DEC = 2 * MiB, WS_AFF = 3 * MiB, WS_SLOT = 4 * MiB, WS_SELT = 5 * MiB, WS_SELV = 5 * MiB + 256 * 1024;
constexpr size_t WS_UCTX = 6 * MiB, WS_AFB = 10 * MiB, WS_WIN = 13 * MiB, WS_WOUT = 20 * MiB;
constexpr size_t WS_R1 = 22 * MiB, WS_R2 = 56 * MiB, WS_R3 = 107 * MiB, WS_R4 = 203 * MiB, WS_R5 = 235 * MiB, WS_R6 = 267 * MiB, WS_END = 299 * MiB;
constexpr size_t WS_AIN = WS_R1, WS_ZT = 155 * MiB, WS_HN = WS_R1;
constexpr size_t WS_QKVG = WS_R2;
constexpr size_t WS_HYT = WS_R3, WS_WD = 171 * MiB;
constexpr size_t WS_WGU = WS_R5;
constexpr size_t WS_HID = WS_R2, WS_YSLAB = WS_R4;
constexpr size_t WS_HT = WS_R4, WS_AOUT = WS_R4;
constexpr size_t WS_X1B = 120 * MiB;
constexpr size_t WS_SPREV = WS_R1;
constexpr int LDS_BYTES = 144 * 1024;
constexpr int LDS_MISC = LDS_BYTES - 256;

struct Args { const float* in[29]; float* out; unsigned char* ws; int ph_lo, ph_hi; };

#define LDS_WAIT() asm volatile("s_waitcnt lgkmcnt(0)" ::: "memory")
#define VM_WAIT() asm volatile("s_waitcnt vmcnt(0)" ::: "memory")
__device__ __forceinline__ unsigned f2bf(float f) { unsigned u = __float_as_uint(f); return (u + 0x7fffu + ((u >> 16) & 1u)) >> 16; }
__device__ __forceinline__ unsigned pk2(float lo, float hi) { return pg8::cvt_pk_bf16(lo, hi); }
__device__ __forceinline__ float bflo(unsigned w) { return __uint_as_float(w << 16); }
__device__ __forceinline__ float bfhi(unsigned w) { return __uint_as_float(w & 0xffff0000u); }
template <int CTRL> __device__ __forceinline__ float dpp_f(float v) { return __builtin_bit_cast(float, __builtin_amdgcn_update_dpp(0, __builtin_bit_cast(int, v), CTRL, 0xf, 0xf, false)); }
__device__ __forceinline__ void swap16(float& a, float& b) { asm("v_nop\n\tv_nop\n\tv_permlane16_swap_b32 %0, %1" : "+v"(a), "+v"(b)); }
__device__ __forceinline__ void swap32(float& a, float& b) { asm("v_nop\n\tv_nop\n\tv_permlane32_swap_b32 %0, %1" : "+v"(a), "+v"(b)); }
__device__ __forceinline__ float row_allsum(float v) { v += dpp_f<0x128>(v); v += dpp_f<0x124>(v); v += dpp_f<0x122>(v); v += dpp_f<0x121>(v); return v; }
__device__ __forceinline__ float x16_sum(float v) { float a = v, b = v; swap16(a, b); return a + b; }
__device__ __forceinline__ float x32_sum(float v) { float a = v, b = v; swap32(a, b); return a + b; }
__device__ __forceinline__ float x16_max(float v) { float a = v, b = v; swap16(a, b); return fmaxf(a, b); }
__device__ __forceinline__ float x32_max(float v) { float a = v, b = v; swap32(a, b); return fmaxf(a, b); }
__device__ __forceinline__ float wave_sum(float v) { return x32_sum(x16_sum(row_allsum(v))); }
__device__ __forceinline__ float silu_f(float v) { return v * __builtin_amdgcn_rcpf(1.f + __expf(-v)); }
__device__ __forceinline__ float logsig_f(float x) { return fminf(x, 0.f) - __logf(1.0f + __expf(-fabsf(x))); }

#define XB_TMO      128
#define XB_XCNT(j)  (256  + 64 * (j))
#define XB_XSUB(j)  (1280 + 64 * (j))
#define XB_XGEN(j)  (2304 + 64 * (j))
#define XB_TOP      3328
#define XB_TOPGEN   3392
#define XCD_BAR_WORDS 3456
#define XB_SPIN_CAP (1u << 22)
__device__ __forceinline__ unsigned xb_ld(unsigned* p)              { return __hip_atomic_load(p, __ATOMIC_RELAXED, __HIP_MEMORY_SCOPE_AGENT); }
__device__ __forceinline__ unsigned xb_add(unsigned* p, unsigned v) { return __hip_atomic_fetch_add(p, v, __ATOMIC_RELAXED, __HIP_MEMORY_SCOPE_AGENT); }
__device__ __forceinline__ unsigned xb_xcc_id() { return (unsigned)__builtin_amdgcn_s_getreg((3 << 11) | 20) & 0xFu; }
#define XB_SPIN(cond, bar) do { unsigned _sp = 0; while (cond) { __builtin_amdgcn_s_sleep(1); \
    if ((++_sp & 255u) == 0u) { if (xb_ld(&(bar)[XB_TMO])) break; if (_sp > XB_SPIN_CAP) { atomicAdd(&(bar)[XB_TMO], 1u); break; } } } } while (0)
struct XcdBarrier { unsigned* bar; unsigned x; volatile LAS unsigned* st; };
__device__ __forceinline__ XcdBarrier xcd_barrier_post(unsigned* bar, volatile LAS unsigned* st) {
    XcdBarrier b; b.bar = bar; b.x = xb_xcc_id(); b.st = st;
    if (threadIdx.x == 0) (void)xb_add(&bar[XB_XCNT(b.x)], 1u);
    return b;
}
__device__ __forceinline__ void xcd_barrier_complete(unsigned* bar, unsigned x, unsigned& nloc, unsigned& nx) {
    const unsigned G = gridDim.x * gridDim.y * gridDim.z;
    unsigned sum, cnt, mine, sp = 0u;
    for (;;) {
        sum = 0u; cnt = 0u; mine = 0u;
#pragma unroll
        for (unsigned j = 0; j < 16; ++j) { const unsigned c = xb_ld(&bar[XB_XCNT(j)]); sum += c; cnt += (c > 0u) ? 1u : 0u; mine = (j == x) ? c : mine; }
        if (sum == G) break;
        __builtin_amdgcn_s_sleep(1);
        if ((++sp & 255u) == 0u) { if (xb_ld(&bar[XB_TMO])) break; if (sp > XB_SPIN_CAP) { atomicAdd(&bar[XB_TMO], 1u); break; } }
    }
    nloc = mine > 0u ? mine : 1u; nx = cnt > 0u ? cnt : 1u;
}
__device__ __forceinline__ void xcd_barrier(const XcdBarrier& b) {
    asm volatile("s_waitcnt vmcnt(0)" ::: "memory");
    __syncthreads();
    if (threadIdx.x == 0) {
        unsigned* bar = b.bar;
        __builtin_amdgcn_s_waitcnt(0);
        unsigned nloc = b.st[0], nx = b.st[1];
        if (nloc == 0u) { xcd_barrier_complete(bar, b.x, nloc, nx); b.st[0] = nloc; b.st[1] = nx; }
        const unsigned old = xb_add(&bar[XB_XSUB(b.x)], 1u);
        const unsigned gen = old / nloc;
        if (old + 1u == (gen + 1u) * nloc) {
            __builtin_amdgcn_fence(__ATOMIC_RELEASE, "agent");
            asm volatile("s_waitcnt vmcnt(0)" ::: "memory");
            const unsigned og = xb_add(&bar[XB_TOP], 1u);
            const unsigned tg = og / nx;
            if (og + 1u == (tg + 1u) * nx) xb_add(&bar[XB_TOPGEN], 1u);
            else XB_SPIN(xb_ld(&bar[XB_TOPGEN]) == tg, bar);
            __builtin_amdgcn_fence(__ATOMIC_ACQUIRE, "agent");
            xb_add(&bar[XB_XGEN(b.x)], 1u);
            asm volatile("s_waitcnt vmcnt(0)" ::: "memory");
        } else {
            XB_SPIN(xb_ld(&bar[XB_XGEN(b.x)]) == gen, bar);
            __builtin_amdgcn_fence(__ATOMIC_ACQUIRE, "agent");
            asm volatile("s_waitcnt vmcnt(0)" ::: "memory");
        }
    }
    __syncthreads();
}

constexpr int TILE_AIN = (int)(WS_AIN / (512 * 1024)), TILE_WIN = (int)(WS_WIN / (512 * 1024));
struct InSched {
    int G, c, part;
    __device__ void init(int G_, int c_, int part_) { G = G_; c = c_; part = part_; }
    __device__ static void qg_unit(int qg, pg8::Unit& u) { const int t = qg >> 6; u.pm = TILE_AIN + (qg & 63); u.pn = TILE_WIN + ((t == 0) ? 0 : 3 + t); }
    __device__ bool next(int i, pg8::Unit& u) const {
        const int L = i * G + c;
        if (part) { const int qg = 112 + L; if (qg >= 192) return false; qg_unit(qg, u); return true; }
        if (L < 384) { u.pm = TILE_WIN + 6 + (L >> 6); u.pn = TILE_AIN + (L & 63); return true; }
        if (L < 640) { const int l = L - 384, q = l >> 6; u.pm = TILE_AIN + (l & 63); u.pn = TILE_WIN + ((q == 3) ? 12 : (1 + q)); return true; }
        if (L < 656) { const int jx = L - 640, q = jx >> 2; u.pm = TILE_AIN + 64 + (jx & 3); u.pn = TILE_WIN + ((q == 3) ? 12 : (1 + q)); return true; }
        if (L >= 768) return false;
        qg_unit(L - 656, u); return true;
    }
    __device__ __forceinline__ void a_ready(const pg8::Unit&) const {}
    __device__ __forceinline__ void done(const pg8::Unit&) const {}
};
template <int NT> struct MoeSched {
    int G, c;
    __device__ void init(int G_, int c_) { G = G_; c = c_; }
    __device__ bool next(int i, pg8::Unit& u) const {
        const int L = i * G + c; if (L >= NE * 8 * NT) return false;
        const int e = L / (8 * NT), l = L % (8 * NT), x = l & 7, y = l >> 3;
        constexpr int HN = NT / 2;
        const int pm = 2 * (x >> 1) + (y / HN), pn = HN * (x & 1) + (y % HN);
        u.pm = e * 8 + pm; u.pn = e * NT + pn; return true;
    }
    __device__ __forceinline__ void a_ready(const pg8::Unit&) const {}
    __device__ __forceinline__ void done(const pg8::Unit&) const {}
};

struct EpiIn {
    static constexpr bool PERM = true, AFTER_DRAIN = false;
    bf16* qkvg; bf16* hyT; float* afb;
    __device__ __forceinline__ void operator()(const f32x4 (&acc)[2][2][4][2], const pg8::Unit& u, int wr, int wc, int fr, int fq) const {
        if (u.pm < TILE_AIN) {
            const int ch0 = (u.pm - TILE_WIN - 6) * 256 + wr * 64 + fr, mt = u.pn - TILE_AIN, b = mt >> 4, t0 = (mt & 15) * 256 + wc * 32 + 8 * fq;
#pragma unroll
            for (int ai = 0; ai < 2; ++ai)
#pragma unroll
                for (int m = 0; m < 4; ++m) { bf16* rowp = hyT + ((size_t)b * 1536 + ch0 + ai * 128 + m * 16) * SEQ + t0;
#pragma unroll
                    for (int bj = 0; bj < 2; ++bj) { const f32x4 v0 = acc[ai][bj][m][0], v1 = acc[ai][bj][m][1];
                        v4u w; w.x = pk2(v0[0], v0[1]); w.y = pk2(v0[2], v0[3]); w.z = pk2(v1[0], v1[1]); w.w = pk2(v1[2], v1[3]);
                        *(v4u*)(rowp + bj * 128) = w; } }
            return;
        }
        const int pm = u.pm - TILE_AIN, pn = u.pn - TILE_WIN;
        const int row0 = pm * 256 + wr * 64 + fr;
        if (pn < 6) {
            const float sc = (pn == 0) ? 0.125f : 1.f;
            const int col0 = pn * 256 + wc * 32 + 8 * fq;
#pragma unroll
            for (int ai = 0; ai < 2; ++ai)
#pragma unroll
                for (int m = 0; m < 4; ++m) { bf16* rowp = qkvg + (size_t)(row0 + ai * 128 + m * 16) * NQ + col0;
#pragma unroll
                    for (int bj = 0; bj < 2; ++bj) { const f32x4 v0 = acc[ai][bj][m][0] * sc, v1 = acc[ai][bj][m][1] * sc;
                        v4u w; w.x = pk2(v0[0], v0[1]); w.y = pk2(v0[2], v0[3]); w.z = pk2(v1[0], v1[1]); w.w = pk2(v1[2], v1[3]);
                        *(v4u*)(rowp + bj * 128) = w; } }
        } else {
            if (wc != 0) return;
#pragma unroll
            for (int ai = 0; ai < 2; ++ai)
#pragma unroll
                for (int m = 0; m < 4; ++m) { float* rowp = afb + (size_t)(row0 + ai * 128 + m * 16) * 32 + 8 * fq;
                    *(f32x4*)(rowp) = acc[ai][0][m][0]; *(f32x4*)(rowp + 4) = acc[ai][0][m][1]; }
        }
    }
};
struct EpiOut {
    static constexpr bool PERM = false, AFTER_DRAIN = false;
    const float* __restrict__ x; const float* __restrict__ postab; const float* __restrict__ modr; bf16* __restrict__ x1;
    __device__ __forceinline__ void operator()(const f32x4 (&acc)[2][2][4][2], const pg8::Unit& u, int wr, int wc, int fr, int fq) const {
        const int row0 = u.pm * 256 + wr * 64 + fr, col0 = u.pn * 256 + wc * 32 + 4 * fq;
        const int b = row0 >> 12;
        f32x4 gv[2][2];
#pragma unroll
        for (int bj = 0; bj < 2; ++bj)
#pragma unroll
            for (int n = 0; n < 2; ++n) gv[bj][n] = *(const f32x4*)(modr + b * 6144 + 2048 + col0 + bj * 128 + n * 16);
#pragma unroll
        for (int ai = 0; ai < 2; ++ai)
#pragma unroll
            for (int m = 0; m < 4; ++m) { const int r = row0 + ai * 128 + m * 16; const int t = r & 4095, rr = t >> 6, cc = t & 63;
                f32x4 xv[2][2], pv[2][2];
#pragma unroll
                for (int bj = 0; bj < 2; ++bj)
#pragma unroll
                    for (int n = 0; n < 2; ++n) { const int c = col0 + bj * 128 + n * 16;
                        xv[bj][n] = *(const f32x4*)(x + (size_t)r * DM + c);
                        pv[bj][n] = *(const f32x4*)(postab + ((c < 512) ? rr * 512 + c : cc * 512 + c - 512)); }
#pragma unroll
                for (int bj = 0; bj < 2; ++bj)
#pragma unroll
                    for (int n = 0; n < 2; ++n) { const int c = col0 + bj * 128 + n * 16;
                        const f32x4 y = xv[bj][n] + (DBG_NOPOS ? pv[bj][n] * 0.f : pv[bj][n]) + (DBG_NOMIX ? gv[bj][n] * 0.f : gv[bj][n] * acc[ai][bj][m][n]);
                        v2u w; w.x = pk2(y[0], y[1]); w.y = pk2(y[2], y[3]);
                        *(v2u*)(x1 + (size_t)r * DM + c) = w; } }
    }
};
struct EpiGU {
    static constexpr bool PERM = true, AFTER_DRAIN = false;
    bf16* hid;
    __device__ __forceinline__ void operator()(const f32x4 (&acc)[2][2][4][2], const pg8::Unit& u, int wr, int wc, int fr, int fq) const {
        const int row0 = u.pm * 256 + wr * 64 + fr, col0 = (u.pn & 7) * 128 + wc * 32 + 8 * fq;
#pragma unroll
        for (int ai = 0; ai < 2; ++ai)
#pragma unroll
            for (int m = 0; m < 4; ++m) { bf16* rowp = hid + (size_t)(row0 + ai * 128 + m * 16) * DM + col0;
                float o[8];
#pragma unroll
                for (int n = 0; n < 2; ++n)
#pragma unroll
                    for (int j = 0; j < 4; ++j) o[n * 4 + j] = silu_f(acc[ai][0][m][n][j]) * acc[ai][1][m][n][j];
                v4u w; w.x = pk2(o[0], o[1]); w.y = pk2(o[2], o[3]); w.z = pk2(o[4], o[5]); w.w = pk2(o[6], o[7]);
                *(v4u*)rowp = w; }
    }
};
struct EpiDown {
    static constexpr bool PERM = true, AFTER_DRAIN = false;
    bf16* __restrict__ ys; const float* __restrict__ selv;
    __device__ __forceinline__ void operator()(const f32x4 (&acc)[2][2][4][2], const pg8::Unit& u, int wr, int wc, int fr, int fq) const {
        const int row0 = u.pm * 256 + wr * 64 + fr, col0 = (u.pn & 3) * 256 + wc * 32 + 8 * fq;
        float scv[2][4];
#pragma unroll
        for (int ai = 0; ai < 2; ++ai)
#pragma unroll
            for (int m = 0; m < 4; ++m) scv[ai][m] = selv[row0 + ai * 128 + m * 16];
#pragma unroll
        for (int ai = 0; ai < 2; ++ai)
#pragma unroll
            for (int m = 0; m < 4; ++m) { const int r = row0 + ai * 128 + m * 16; const float sc = scv[ai][m]; bf16* rowp = ys + (size_t)r * DM + col0;
#pragma unroll
                for (int bj = 0; bj < 2; ++bj) { const f32x4 v0 = acc[ai][bj][m][0] * sc, v1 = acc[ai][bj][m][1] * sc;
                    v4u w; w.x = pk2(v0[0], v0[1]); w.y = pk2(v0[2], v0[3]); w.z = pk2(v1[0], v1[1]); w.w = pk2(v1[2], v1[3]);
                    *(v4u*)(rowp + bj * 128) = w; } }
    }
};

__device__ __forceinline__ void transpose_item(const float* W, int ldw, int k0, int nsrc0, bf16* WT, int K, int drow0, LAS float* scr, int lane, bool zero) {
    float tv[32];
#pragma unroll
    for (int i = 0; i < 32; ++i) { const int kk = 2 * i + (lane >> 5); tv[i] = zero ? 0.f : W[(size_t)(k0 + kk) * ldw + nsrc0 + (lane & 31)]; }
#pragma unroll
    for (int i = 0; i < 32; ++i) { const int kk = 2 * i + (lane >> 5); scr[kk * 33 + (lane & 31)] = tv[i]; }
    LDS_WAIT();
    const int c = lane & 7;
#pragma unroll
    for (int j = 0; j < 4; ++j) { const int n = (lane >> 3) + 8 * j; const LAS float* s = scr + (8 * c) * 33 + n;
        v4u o; o.x = pk2(s[0 * 33], s[1 * 33]); o.y = pk2(s[2 * 33], s[3 * 33]); o.z = pk2(s[4 * 33], s[5 * 33]); o.w = pk2(s[6 * 33], s[7 * 33]);
        *(v4u*)(WT + (size_t)(drow0 + n) * K + k0 + 8 * c) = o; }
    LDS_WAIT();
}

__device__ __forceinline__ void split8(const float (&x)[8], pg8::bf16x8& hi, pg8::bf16x8& lo) {
    v4u h, l;
#pragma unroll
    for (int e = 0; e < 4; ++e) { const unsigned w = pk2(x[2 * e], x[2 * e + 1]); h[e] = w; l[e] = pk2(x[2 * e] - bflo(w), x[2 * e + 1] - bfhi(w)); }
    hi = __builtin_bit_cast(pg8::bf16x8, h); lo = __builtin_bit_cast(pg8::bf16x8, l);
}
__device__ __forceinline__ f32x4 mfma3(pg8::bf16x8 ah, pg8::bf16x8 al, pg8::bf16x8 bh, pg8::bf16x8 bl, f32x4 acc) {
    acc = __builtin_amdgcn_mfma_f32_16x16x32_bf16(al, bh, acc, 0, 0, 0);
    acc = __builtin_amdgcn_mfma_f32_16x16x32_bf16(ah, bl, acc, 0, 0, 0);
    return __builtin_amdgcn_mfma_f32_16x16x32_bf16(ah, bh, acc, 0, 0, 0);
}
__device__ __forceinline__ void sine_layer(const LAS float* in, const LAS float* w, LAS float* out, const float* bias, const float* freq, int wave, int lane) {
    const int m16 = lane & 15, kg = lane >> 4, mt = wave >> 1, nt0 = (wave & 1) * 2;
    pg8::bf16x8 Ah[2], Al[2];
#pragma unroll
    for (int s = 0; s < 2; ++s) { const LAS float* hp = in + (16 * mt + m16) * 68 + 32 * s + 8 * kg; const f32x4 x = *(const LAS f32x4*)hp, y = *(const LAS f32x4*)(hp + 4);
        const float v[8] = {x[0], x[1], x[2], x[3], y[0], y[1], y[2], y[3]}; split8(v, Ah[s], Al[s]); }
#pragma unroll
    for (int t = 0; t < 2; ++t) { const int n = (nt0 + t) * 16 + m16; f32x4 acc = (f32x4){0.f, 0.f, 0.f, 0.f};
#pragma unroll
        for (int s = 0; s < 2; ++s) { float v[8];
#pragma unroll
            for (int jj = 0; jj < 8; ++jj) v[jj] = w[(32 * s + 8 * kg + jj) * 64 + n];
            pg8::bf16x8 Bh, Bl; split8(v, Bh, Bl); acc = mfma3(Ah[s], Al[s], Bh, Bl, acc); }
        const float bn = bias[n], fn = freq[n] * 0.15915494309f;
#pragma unroll
        for (int r = 0; r < 4; ++r) out[(16 * mt + 4 * kg + r) * 68 + n] = __builtin_amdgcn_sinf(fn * (acc[r] + bn)); }
}

__device__ __forceinline__ void phase0(const Args& a, LAS unsigned char* lds) {
    int tid = threadIdx.x; const int wg = blockIdx.x, G = gridDim.x;
    asm volatile("" : "+v"(tid));
    int lane = tid & 63, wave = tid >> 6;
    unsigned char* ws = a.ws;
    for (int it = wg; it < 192; it += G) {
        LAS float* sl = (LAS float*)lds;
        LAS float* red = (LAS float*)(lds + 20480);
        const int col = it * 32 + (lane & 31), kk = wave * 2 + (lane >> 5);
        float acc[5] = {0.f, 0.f, 0.f, 0.f, 0.f};
        const float* wp = a.in[4] + col;
        float wv[64];
#pragma unroll
        for (int j = 0; j < 64; ++j) wv[j] = wp[(size_t)(kk + 16 * j) * 6144];
        for (int i = tid; i < 5 * 1024; i += NTHR) { const int bb = i >> 10, k = i & 1023; const float v = (bb < 4) ? a.in[1][bb * 1024 + k] : a.in[3][k]; sl[i] = silu_f(v); }
        __syncthreads();
#pragma unroll
        for (int j = 0; j < 64; ++j) { const int k = kk + 16 * j;
#pragma unroll
            for (int bb = 0; bb < 5; ++bb) acc[bb] += sl[bb * 1024 + k] * wv[j]; }
#pragma unroll
        for (int bb = 0; bb < 5; ++bb) red[(kk * 5 + bb) * 32 + (lane & 31)] = acc[bb];
        __syncthreads();
        if (tid < 160) { const int bb = tid >> 5, cl = tid & 31; float s = 0.f;
#pragma unroll
            for (int q = 0; q < 16; ++q) s += red[(q * 5 + bb) * 32 + cl];
            ((float*)(ws + WS_MOD))[bb * 6144 + it * 32 + cl] = s + a.in[5][it * 32 + cl]; }
        __syncthreads();
    }
    for (int it = wg; it < 256; it += G) {
        asm volatile("" : "+v"(tid)); lane = tid & 63; wave = tid >> 6;
        const int cg = it >> 6, i0 = (it & 63) * 64, m16 = lane & 15, kg = lane >> 4;
        LAS float* zl = (LAS float*)lds;
        LAS float* h1 = (LAS float*)(lds + 17408);
        LAS float* h2 = (LAS float*)(lds + 2 * 17408);
        LAS float* w1l = (LAS float*)(lds + 3 * 17408);
        LAS float* w2l = (LAS float*)(lds + 3 * 17408 + 16384);
        float braw[4][2][8];
        {   const float* w3 = a.in[19] + cg * 512 + wave * 64 + m16;
#pragma unroll
            for (int nt = 0; nt < 4; ++nt)
#pragma unroll
                for (int s = 0; s < 2; ++s)
#pragma unroll
                    for (int jj = 0; jj < 8; ++jj) braw[nt][s][jj] = w3[(32 * s + 8 * kg + jj) * 2048 + nt * 16]; }
        {   float t1[8], t2[8];
#pragma unroll
            for (int q = 0; q < 8; ++q) { const int o = tid + NTHR * q; t1[q] = (o < 33 * 64) ? a.in[15][o] : 0.f; t2[q] = a.in[17][o]; }
#pragma unroll
            for (int q = 0; q < 8; ++q) { const int o = tid + NTHR * q; w1l[o] = t1[q]; w2l[o] = t2[q]; } }
#pragma unroll
        for (int q = 0; q < 8; ++q) { const int o = tid + NTHR * q, li = o >> 6, j = o & 63; const int i = i0 + li;
            const int jj = (j - 1) & 15; const float f = 1e-4f + (float)jj * ((15.0f - 1e-4f) / 15.0f); const float turns = f * ((float)i * (1.0f / 4096.0f));
            const float v = (j == 0) ? (float)i * (1.0f / 4095.0f) : (j <= 16) ? __builtin_amdgcn_cosf(turns) : (j <= 32) ? -__builtin_amdgcn_sinf(turns) : 0.f;
            zl[li * 68 + j] = v; }
        __syncthreads();
        sine_layer(zl, w1l, h1, a.in[16], a.in[20], wave, lane);
        __syncthreads();
        sine_layer(h1, w2l, h2, a.in[18], a.in[20], wave, lane);
        __syncthreads();
        {
            pg8::bf16x8 Bh[4][2], Bl[4][2];
#pragma unroll
            for (int nt = 0; nt < 4; ++nt)
#pragma unroll
                for (int s = 0; s < 2; ++s) split8(braw[nt][s], Bh[nt][s], Bl[nt][s]);
            float* hT = (float*)(ws + WS_HT);
#pragma unroll
            for (int mt = 0; mt < 4; ++mt) {
                pg8::bf16x8 Ah[2], Al[2];
#pragma unroll
                for (int s = 0; s < 2; ++s) { const LAS float* hp = h2 + (16 * mt + m16) * 68 + 32 * s + 8 * kg; const f32x4 x = *(const LAS f32x4*)hp, y = *(const LAS f32x4*)(hp + 4);
                    const float v[8] = {x[0], x[1], x[2], x[3], y[0], y[1], y[2], y[3]}; split8(v, Ah[s], Al[s]); }
#pragma unroll
                for (int nt = 0; nt < 4; ++nt) { f32x4 acc = (f32x4){0.f, 0.f, 0.f, 0.f};
#pragma unroll
                    for (int s = 0; s < 2; ++s) acc = mfma3(Ah[s], Al[s], Bh[nt][s], Bl[nt][s], acc);
                    const int c = wave * 64 + nt * 16 + m16;
                    const float delta = 3.0701134573f + (float)c * ((15.3505672866f - 3.0701134573f) / 511.0f);
                    f32x4 o;
#pragma unroll
                    for (int r = 0; r < 4; ++r) { const float ti = (float)(i0 + 16 * mt + 4 * kg + r) * (1.0f / 4095.0f); o[r] = acc[r] * __expf(-ti * delta); }
                    *(f32x4*)(hT + ((size_t)cg * 512 + c) * SEQ + i0 + 16 * mt + 4 * kg) = o; } } }
        __syncthreads();
    }
    {
        asm volatile("" : "+v"(tid)); lane = tid & 63; wave = tid >> 6;
        LAS float* scr = (LAS float*)(lds + wave * 8448);
        const int gw = wg * NWAVES + wave, NGW = G * NWAVES;
        constexpr int I_IN = 104 * 16, I_OUT = 32 * 16;
        constexpr int I_ALL = I_IN + I_OUT, I_EXTRA = I_ALL - 2048;
        for (int it = gw; it < I_ALL; it = (G != 256) ? it + NGW : ((it < NGW && gw >= NGW - I_EXTRA) ? it + I_EXTRA : I_ALL)) {
            if (it < I_IN) { const int nb = it >> 4, kb = it & 15, n0 = nb * 32;
                const int ns = (n0 < 1536) ? n0 : (n0 < 3072 ? n0 + 32 : 1536 + (n0 - 3072));
                transpose_item(a.in[7], DIN, kb * 64, (n0 < DIN) ? ns : 0, (bf16*)(ws + WS_WIN), DM, n0, scr, lane, n0 >= DIN);
            } else { const int r = it - I_IN, nb = r >> 4, kb = r & 15;
                transpose_item(a.in[22], DM, kb * 64, nb * 32, (bf16*)(ws + WS_WOUT), DM, nb * 32, scr, lane, false); }
        }
    }
    for (int e = wg * NTHR + tid; e < 64 * 256; e += G * NTHR) { const int i = e >> 8, j = e & 255;
        const float om = 1.0f / powf(10000.0f, (float)j * (1.0f / 256.0f)); const float er = (float)i * om;
        float* pt = (float*)(ws + WS_POS); pt[i * 512 + j] = sinf(er); pt[i * 512 + 256 + j] = cosf(er); }
}

__device__ __forceinline__ void phase1(const Args& a, LAS unsigned char* lds) {
    const int tid = threadIdx.x, lane = tid & 63, wave = tid >> 6, wg = blockIdx.x, G = gridDim.x;
    unsigned char* ws = a.ws;
    const float* modr = (const float*)(ws + WS_MOD); const float* pt = (const float*)(ws + WS_POS); bf16* ain = (bf16*)(ws + WS_AIN);
    const float* gmix = a.in[6];
    const int NGW = G * NWAVES;
    f32x4 gv[4];
#pragma unroll
    for (int j = 0; j < 4; ++j) gv[j] = *(const f32x4*)(gmix + 4 * lane + 256 * j);
#pragma nounroll
    for (int r0 = wg * NWAVES + wave; r0 < MT; r0 += 4 * NGW) {
        f32x4 v[4][4], pv[4][4], shv[2][4], scv[2][4];
#pragma unroll
        for (int k = 0; k < 4; ++k) { const int r = r0 + k * NGW, rc = (r < MT) ? r : r0; const bool lat = rc < MX;
            const float* src = lat ? a.in[0] + (size_t)rc * DM : a.in[2] + (size_t)(rc - MX) * DM; const int t = rc & 4095, rr = t >> 6, cc = t & 63;
#pragma unroll
            for (int j = 0; j < 4; ++j) { const int col = 4 * lane + 256 * j; v[k][j] = *(const f32x4*)(src + col);
                pv[k][j] = *(const f32x4*)(pt + ((j < 2) ? rr * 512 + col : cc * 512 + col - 512)); } }
#pragma unroll
        for (int g = 0; g < 2; ++g) { const int r = r0 + 2 * g * NGW, rc = (r < MT) ? r : r0; const int bb = (rc < MX) ? (rc >> 12) : 4;
#pragma unroll
            for (int j = 0; j < 4; ++j) { const int col = 4 * lane + 256 * j; shv[g][j] = *(const f32x4*)(modr + bb * 6144 + col); scv[g][j] = *(const f32x4*)(modr + bb * 6144 + 1024 + col); } }
#pragma unroll
        for (int k = 0; k < 4; ++k) { const int r = r0 + k * NGW, rc = (r < MT) ? r : r0; const float lat = (rc < MX) ? 1.0f : 0.0f; float ss = 0.f;
#pragma unroll
            for (int j = 0; j < 4; ++j) { v[k][j] += pv[k][j] * lat; ss += v[k][j][0] * v[k][j][0] + v[k][j][1] * v[k][j][1] + v[k][j][2] * v[k][j][2] + v[k][j][3] * v[k][j][3]; }
            const float rs = rsqrtf(wave_sum(ss) * (1.0f / DM) + EPS);
#pragma unroll
            for (int j = 0; j < 4; ++j) { const int col = 4 * lane + 256 * j;
                const f32x4 y = (v[k][j] * rs * gv[j]) * (scv[k >> 1][j] + 1.0f) + shv[k >> 1][j];
                v2u w; w.x = pk2(y[0], y[1]); w.y = pk2(y[2], y[3]);
                if (r < MT) *(v2u*)(ain + (size_t)r * DM + col) = w; } }
    }
}

typedef float cpx __attribute__((ext_vector_type(2)));
__device__ __forceinline__ cpx make_cpx(float x, float y) { cpx r; r.x = x; r.y = y; return r; }
__device__ __forceinline__ cpx cmul(cpx a, cpx b) { cpx r;
    asm("v_pk_mul_f32 %0, %1, %2 op_sel_hi:[1,0]\n\tv_pk_fma_f32 %0, %1, %2, %0 op_sel:[1,1,0] op_sel_hi:[0,1,1] neg_lo:[1,0,0]" : "=&v"(r) : "v"(a), "v"(b));
    return r; }
__device__ __forceinline__ cpx cmul_s(cpx a, cpx b) { cpx r;
    asm("v_pk_mul_f32 %0, %1, %2 op_sel_hi:[1,0]\n\tv_pk_fma_f32 %0, %1, %2, %0 op_sel:[1,1,0] op_sel_hi:[0,1,1] neg_lo:[1,0,0]" : "=&v"(r) : "v"(a), "s"(b));
    return r; }
__device__ __forceinline__ cpx cmulc(cpx a, cpx b) { cpx r;
    asm("v_pk_mul_f32 %0, %1, %2 op_sel_hi:[1,0] neg_hi:[1,0]\n\tv_pk_fma_f32 %0, %1, %2, %0 op_sel:[1,1,0] op_sel_hi:[0,1,1] neg_lo:[1,0,0] neg_hi:[1,0,0]" : "=&v"(r) : "v"(a), "v"(b));
    return r; }
__device__ __forceinline__ cpx cfma(cpx a, cpx b, cpx c) { cpx r;
    asm("v_pk_fma_f32 %0, %1, %2, %3 op_sel_hi:[1,0,1]\n\tv_pk_fma_f32 %0, %1, %2, %0 op_sel:[1,1,0] op_sel_hi:[0,1,1] neg_lo:[1,0,0]" : "=&v"(r) : "v"(a), "v"(b), "v"(c));
    return r; }
__device__ __forceinline__ cpx cadd(cpx a, cpx b) { return a + b; }
__device__ __forceinline__ cpx csub(cpx a, cpx b) { return a - b; }
__device__ __forceinline__ cpx add_mi(cpx a, cpx b) { cpx r; asm("v_pk_add_f32 %0, %1, %2 op_sel:[0,1] op_sel_hi:[1,0] neg_hi:[0,1]" : "=v"(r) : "v"(a), "v"(b)); return r; }
__device__ __forceinline__ cpx add_pi(cpx a, cpx b) { cpx r; asm("v_pk_add_f32 %0, %1, %2 op_sel:[0,1] op_sel_hi:[1,0] neg_lo:[0,1]" : "=v"(r) : "v"(a), "v"(b)); return r; }
__device__ __forceinline__ cpx cconj(cpx a) { return make_cpx(a.x, -a.y); }
__device__ __forceinline__ cpx twid(float turns) { return make_cpx(__builtin_amdgcn_cosf(turns), -__builtin_amdgcn_sinf(turns)); }
__device__ __forceinline__ void dft4(cpx& a0, cpx& a1, cpx& a2, cpx& a3) {
    const cpx t0 = cadd(a0, a2), t1 = csub(a0, a2), t2 = cadd(a1, a3), t3 = csub(a1, a3);
    a0 = cadd(t0, t2); a2 = csub(t0, t2); a1 = add_mi(t1, t3); a3 = add_pi(t1, t3);
}
__device__ __forceinline__ void dft4_r2(cpx& a0, cpx& a1, cpx& a2, cpx& a3) {
    const cpx t0 = add_mi(a0, a2), t1 = add_pi(a0, a2), t2 = cadd(a1, a3), t3 = csub(a1, a3);
    a0 = cadd(t0, t2); a2 = csub(t0, t2); a1 = add_mi(t1, t3); a3 = add_pi(t1, t3);
}
__device__ __forceinline__ void dft16(cpx (&v)[16]) {
    cpx t[16];
#pragma unroll
    for (int j = 0; j < 4; ++j) { cpx b0 = v[j], b1 = v[j + 4], b2 = v[j + 8], b3 = v[j + 12]; dft4(b0, b1, b2, b3); t[4 * j] = b0; t[4 * j + 1] = b1; t[4 * j + 2] = b2; t[4 * j + 3] = b3; }
    const float C1 = 0.92387953251f, S1 = 0.38268343236f, R2 = 0.70710678118f;
    const cpx W1 = make_cpx(C1, -S1), W2 = make_cpx(R2, -R2), W3 = make_cpx(S1, -C1), W6 = make_cpx(-R2, -R2), W9 = make_cpx(-C1, S1);
    {   cpx b0 = t[0], b1 = t[4], b2 = t[8], b3 = t[12]; dft4(b0, b1, b2, b3); v[0] = b0; v[4] = b1; v[8] = b2; v[12] = b3; }
    {   cpx b0 = t[1], b1 = cmul_s(t[5], W1), b2 = cmul_s(t[9], W2), b3 = cmul_s(t[13], W3); dft4(b0, b1, b2, b3); v[1] = b0; v[5] = b1; v[9] = b2; v[13] = b3; }
    {   cpx b0 = t[2], b1 = cmul_s(t[6], W2), b2 = t[10], b3 = cmul_s(t[14], W6); dft4_r2(b0, b1, b2, b3); v[2] = b0; v[6] = b1; v[10] = b2; v[14] = b3; }
    {   cpx b0 = t[3], b1 = cmul_s(t[7], W3), b2 = cmul_s(t[11], W6), b3 = cmul_s(t[15], W9); dft4(b0, b1, b2, b3); v[3] = b0; v[7] = b1; v[11] = b2; v[15] = b3; }
}
#define FPAD(i) ((i) + ((i) >> 4))
constexpr int FFT_STRIDE = 4352;
__device__ __forceinline__ void apply_tw(cpx (&v)[16], cpx w1) {
    asm volatile("" : "+v"(w1.x), "+v"(w1.y));
    const cpx w2 = cmul(w1, w1), w4 = cmul(w2, w2), w8 = cmul(w4, w4), w3 = cmul(w2, w1), w5 = cmul(w4, w1), w6 = cmul(w4, w2), w7 = cmul(w4, w3);
    v[1] = cmul(v[1], w1); v[2] = cmul(v[2], w2); v[3] = cmul(v[3], w3); v[4] = cmul(v[4], w4); v[5] = cmul(v[5], w5); v[6] = cmul(v[6], w6); v[7] = cmul(v[7], w7); v[8] = cmul(v[8], w8);
    v[9] = cmul(v[9], cmul(w8, w1)); v[10] = cmul(v[10], cmul(w8, w2)); v[11] = cmul(v[11], cmul(w8, w3)); v[12] = cmul(v[12], cmul(w8, w4));
    v[13] = cmul(v[13], cmul(w8, w5)); v[14] = cmul(v[14], cmul(w8, w6)); v[15] = cmul(v[15], cmul(w8, w7));
}
__device__ __forceinline__ cpx opaque(cpx w) { asm volatile("" : "+v"(w.x), "+v"(w.y)); return w; }
__device__ __forceinline__ cpx c32(int r) { return make_cpx(__builtin_cosf(0.19634954084936207f * (float)r), -__builtin_sinf(0.19634954084936207f * (float)r)); }

#define HB(x) __uint_as_float(((unsigned)(x)) << 16)
__device__ __forceinline__ void hyena_item(const Args& a, LAS unsigned char* lds, int c, int stage) {
    int tid = threadIdx.x; asm volatile("" : "+v"(tid));
    const int f = tid >> 8, j = tid & 255, blk = j >> 4, jp = j & 15;
    const int fu = __builtin_amdgcn_readfirstlane(f);
    unsigned char* ws = a.ws;
    LAS cpx* buf = (LAS cpx*)lds;
    LAS cpx* bm = buf + f * FFT_STRIDE;
    const int pj = j + blk, p16 = blk * 272 + jp, pc = 17 * j;
    const float* hT = (const float*)(ws + WS_HT);
    const float* hf = hT + ((size_t)(stage * 2 + 0) * 512 + c) * SEQ;
    const float* hb = hT + ((size_t)(stage * 2 + 1) * 512 + c) * SEQ;
    const bf16* hyT = (const bf16*)(ws + WS_HYT);
    const bf16* zT = (const bf16*)(ws + WS_ZT);
    bf16* outp = (bf16*)(ws + WS_HYT);
    const float* cw = a.in[13]; const float* cb = a.in[14];
    const int chu = c, chg = (stage == 0 ? 512 : 1024) + c;
    const float wu0 = cw[chu], wu1 = cw[1536 + chu], wu2 = cw[3072 + chu], bu = cb[chu];
    const float wg0 = cw[chg], wg1 = cw[1536 + chg], wg2 = cw[3072 + chg], bg = cb[chg];
    const float bias = a.in[21][stage * 512 + c];
    const cpx wj = twid((float)j * (1.0f / 4096.0f)), wjp = twid((float)jp * (1.0f / 256.0f)), w8_ = twid((float)j * (1.0f / 8192.0f));
    cpx v[16];
    LAS cpx* Hs = buf + 2 * FFT_STRIDE + f * FFT_STRIDE + pc;
    { const cpx w8 = opaque(w8_);
    float fraw[16], graw[16];
#pragma unroll
    for (int r = 0; r < 16; ++r) { const unsigned n = (unsigned)j + 256u * r; fraw[r] = hf[n]; graw[r] = hb[(SEQ - n) & 4095u]; }
    asm volatile("" : "+v"(fraw[0]), "+v"(fraw[1]), "+v"(fraw[2]), "+v"(fraw[3]), "+v"(fraw[4]), "+v"(fraw[5]), "+v"(fraw[6]), "+v"(fraw[7]), "+v"(fraw[8]), "+v"(fraw[9]), "+v"(fraw[10]), "+v"(fraw[11]), "+v"(fraw[12]), "+v"(fraw[13]), "+v"(fraw[14]), "+v"(fraw[15]));
    asm volatile("" : "+v"(graw[0]), "+v"(graw[1]), "+v"(graw[2]), "+v"(graw[3]), "+v"(graw[4]), "+v"(graw[5]), "+v"(graw[6]), "+v"(graw[7]), "+v"(graw[8]), "+v"(graw[9]), "+v"(graw[10]), "+v"(graw[11]), "+v"(graw[12]), "+v"(graw[13]), "+v"(graw[14]), "+v"(graw[15]));
    if (fu) {
#pragma unroll
        for (int r = 0; r < 16; ++r) { const unsigned n = (unsigned)j + 256u * r; const float gv = n ? graw[r] : 0.f; const cpx wn = cmul_s(w8, c32(r)); const float d = fraw[r] - gv; v[r] = make_cpx(d * wn.x, d * wn.y); }
    } else {
#pragma unroll
        for (int r = 0; r < 16; ++r) { const unsigned n = (unsigned)j + 256u * r; const float gv = n ? graw[r] : 0.f; v[r] = make_cpx(fraw[r] + gv, 0.f); }
    } }
    dft16(v); apply_tw(v, wj);
#pragma unroll
    for (int q = 0; q < 16; ++q) bm[pj + 272 * q] = v[q];
    __syncthreads();
#pragma unroll
    for (int r = 0; r < 16; ++r) v[r] = bm[p16 + 17 * r];
    dft16(v); apply_tw(v, wjp);
#pragma unroll
    for (int q = 0; q < 16; ++q) bm[p16 + 17 * q] = v[q];
    __syncthreads();
#pragma unroll
    for (int r = 0; r < 16; ++r) v[r] = bm[pc + r];
    dft16(v);
#pragma unroll
    for (int q = 0; q < 16; ++q) Hs[q] = v[q];
    __syncthreads();
#pragma nounroll
    for (int bp = 0; bp < 2; ++bp) {
        const int b0 = 2 * bp, b1 = 2 * bp + 1;
        float uk0[8], uk1[8];
        {   float u0[16], u1[16];
            const unsigned uj = (unsigned)j;
            if (stage == 0) {
                const bf16* P0 = hyT + ((size_t)b0 * 1536 + chu) * SEQ; const bf16* P1 = hyT + ((size_t)b1 * 1536 + chu) * SEQ;
#pragma unroll
                for (int r = 0; r < 16; ++r) { const unsigned o = uj + 256u * r; if (r == 4 || r == 8 || r == 12) asm volatile("" ::: "memory");
                    const unsigned ol = (r == 0) ? (j ? uj - 1u : 0u) : o - 1u, orr = (r == 15) ? (j < 255 ? o + 1u : o) : o + 1u;
                    float l0 = HB(P0[ol]), l1 = HB(P1[ol]), r0 = HB(P0[orr]), r1 = HB(P1[orr]);
                    if (r == 0) { l0 = j ? l0 : 0.f; l1 = j ? l1 : 0.f; }
                    if (r == 15) { r0 = (j < 255) ? r0 : 0.f; r1 = (j < 255) ? r1 : 0.f; }
                    u0[r] = wu0 * l0 + wu1 * HB(P0[o]) + wu2 * r0 + bu; u1[r] = wu0 * l1 + wu1 * HB(P1[o]) + wu2 * r1 + bu; }
            } else {
                const bf16* P0 = zT + ((size_t)b0 * 512 + c) * SEQ; const bf16* P1 = zT + ((size_t)b1 * 512 + c) * SEQ;
                unsigned short z0[16], z1[16];
#pragma unroll
                for (int r = 0; r < 16; ++r) { const unsigned o = uj + 256u * r; z0[r] = P0[o]; z1[r] = P1[o]; }
                asm volatile("" :: "v"(z0[0]), "v"(z0[1]), "v"(z0[2]), "v"(z0[3]), "v"(z0[4]), "v"(z0[5]), "v"(z0[6]), "v"(z0[7]), "v"(z0[8]), "v"(z0[9]), "v"(z0[10]), "v"(z0[11]), "v"(z0[12]), "v"(z0[13]), "v"(z0[14]), "v"(z0[15]));
                asm volatile("" :: "v"(z1[0]), "v"(z1[1]), "v"(z1[2]), "v"(z1[3]), "v"(z1[4]), "v"(z1[5]), "v"(z1[6]), "v"(z1[7]), "v"(z1[8]), "v"(z1[9]), "v"(z1[10]), "v"(z1[11]), "v"(z1[12]), "v"(z1[13]), "v"(z1[14]), "v"(z1[15]));
#pragma unroll
                for (int r = 0; r < 16; ++r) { u0[r] = HB(z0[r]); u1[r] = HB(z1[r]); }
            }
#pragma unroll
            for (int i = 0; i < 8; ++i) { uk0[i] = f ? u0[2 * i + 1] : u0[2 * i]; uk1[i] = f ? u1[2 * i + 1] : u1[2 * i]; }
            const cpx w8 = opaque(w8_);
            if (fu) {
#pragma unroll
                for (int r = 0; r < 16; ++r) v[r] = cmul(make_cpx(u0[r], u1[r]), cmul_s(w8, c32(r)));
            } else {
#pragma unroll
                for (int r = 0; r < 16; ++r) v[r] = make_cpx(u0[r], u1[r]);
            }
        }
        dft16(v); apply_tw(v, wj);
#pragma unroll
        for (int q = 0; q < 16; ++q) bm[pj + 272 * q] = v[q];
        __syncthreads();
#pragma unroll
        for (int r = 0; r < 16; ++r) v[r] = bm[p16 + 17 * r];
        dft16(v); apply_tw(v, wjp);
#pragma unroll
        for (int q = 0; q < 16; ++q) bm[p16 + 17 * q] = v[q];
        __syncthreads();
#pragma unroll
        for (int r = 0; r < 16; ++r) v[r] = bm[pc + r];
        dft16(v);
#pragma unroll
        for (int q = 0; q < 16; ++q) v[q] = cmulc(v[q], Hs[q]);
        dft16(v);
#pragma unroll
        for (int q = 0; q < 16; ++q) bm[pc + q] = v[q];
        __syncthreads();
#pragma unroll
        for (int r = 0; r < 16; ++r) v[r] = bm[p16 + 17 * r];
        apply_tw(v, wjp); dft16(v);
#pragma unroll
        for (int q = 0; q < 16; ++q) bm[p16 + 17 * q] = v[q];
        __syncthreads();
        float gg0[8], gg1[8];
        {   unsigned short rg0[8][3], rg1[8][3];
            const bf16* G0 = hyT + ((size_t)b0 * 1536 + chg) * SEQ; const bf16* G1 = hyT + ((size_t)b1 * 1536 + chg) * SEQ;
            const unsigned gj = (unsigned)(j + 256 * f);
#pragma unroll
            for (int i = 0; i < 8; ++i) { const unsigned o = gj + 512u * i;
                const unsigned ol = (i == 0) ? (gj ? gj - 1u : 0u) : o - 1u, orr = (i == 7) ? (o < 4095u ? o + 1u : o) : o + 1u;
                rg0[i][0] = G0[ol]; rg0[i][1] = G0[o]; rg0[i][2] = G0[orr]; rg1[i][0] = G1[ol]; rg1[i][1] = G1[o]; rg1[i][2] = G1[orr]; }
#pragma unroll
            for (int r = 0; r < 16; ++r) v[r] = bm[pj + 272 * r];
            apply_tw(v, wj); dft16(v);
#pragma unroll
            for (int q = 0; q < 16; ++q) bm[pj + 272 * q] = v[q];
#pragma unroll
            for (int i = 0; i < 8; ++i) asm volatile("" :: "v"(rg0[i][0]), "v"(rg0[i][1]), "v"(rg0[i][2]), "v"(rg1[i][0]), "v"(rg1[i][1]), "v"(rg1[i][2]));
#pragma unroll
            for (int i = 0; i < 8; ++i) { const unsigned o = gj + 512u * i;
                float a0 = HB(rg0[i][0]), a1 = HB(rg0[i][1]), a2 = HB(rg0[i][2]), c0 = HB(rg1[i][0]), c1 = HB(rg1[i][1]), c2 = HB(rg1[i][2]);
                if (i == 0) { a0 = gj ? a0 : 0.f; c0 = gj ? c0 : 0.f; }
                if (i == 7) { a2 = (o < 4095u) ? a2 : 0.f; c2 = (o < 4095u) ? c2 : 0.f; }
                gg0[i] = wg0 * a0 + wg1 * a1 + wg2 * a2 + bg; gg1[i] = wg0 * c0 + wg1 * c1 + wg2 * c2 + bg; } }
        __syncthreads();
        const cpx w8f = cmul(opaque(w8_), f ? c32(1) : c32(0));
        bf16* O0 = outp + ((size_t)b0 * 1536 + c) * SEQ; bf16* O1 = outp + ((size_t)b1 * 1536 + c) * SEQ;
        bf16* Z0 = (bf16*)(ws + WS_ZT) + ((size_t)b0 * 512 + c) * SEQ; bf16* Z1 = (bf16*)(ws + WS_ZT) + ((size_t)b1 * 512 + c) * SEQ;
#pragma unroll
        for (int i = 0; i < 8; ++i) { const int rr = f + 2 * i; const unsigned n = (unsigned)(j + 256 * f) + 512u * i;
            const cpx be = buf[pj + 272 * rr], bo = buf[FFT_STRIDE + pj + 272 * rr];
            const cpx wn = cmul_s(w8f, c32(2 * i));
            const cpx z = cfma(bo, wn, be);
            const float y0 = z.x * (1.0f / 8192.0f) + bias * uk0[i], y1 = bias * uk1[i] - z.y * (1.0f / 8192.0f);
                        if (stage == 0) { Z0[n] = (bf16)f2bf(gg0[i] * y0); Z1[n] = (bf16)f2bf(gg1[i] * y1); } else { O0[n] = (bf16)f2bf(gg0[i] * y0); O1[n] = (bf16)f2bf(gg1[i] * y1); } }
        __syncthreads();
    }
}

__device__ __forceinline__ f32x16 mfma32(bf16x8 a, bf16x8 b, f32x16 c) { return __builtin_amdgcn_mfma_f32_32x32x16_bf16(a, b, c, 0, 0, 0); }
typedef short s4v __attribute__((ext_vector_type(4)));
__device__ __forceinline__ bf16x8 tr_frag(const LAS bf16* base, int PT, int k0, int c0, int lane) {
    const int i = lane & 15, q = i >> 2, p = i & 3;
    const LAS bf16* ad = base + (k0 + 8 * (lane >> 5) + q) * PT + c0 + 16 * ((lane >> 4) & 1) + 4 * p;
    const s4v lo = __builtin_amdgcn_ds_read_tr16_b64_v4i16((LAS s4v*)ad);
    const s4v hi = __builtin_amdgcn_ds_read_tr16_b64_v4i16((LAS s4v*)(ad + 4 * PT));
    bf16x8 r; r[0] = lo[0]; r[1] = lo[1]; r[2] = lo[2]; r[3] = lo[3]; r[4] = hi[0]; r[5] = hi[1]; r[6] = hi[2]; r[7] = hi[3]; return r;
}
constexpr int GL_AL = 0, GL_WA = 8192, GL_TOT = 16384, GL_V = 24576, GL_VP = 160;
struct GlaTab { float P[4][2], X[4][2], Ptot[2], Xtot[2], Pref[2], Xref[2]; };
__device__ __forceinline__ void gla_tables(const Args& a, int h, LAS unsigned char* lds, GlaTab& T, int tid) {
    const int d2 = tid & 31, sg = tid >> 5;
    const LAS float* aL = (const LAS float*)(lds + GL_AL); const LAS float* wa = (const LAS float*)(lds + GL_WA); LAS float* tot = (LAS float*)(lds + GL_TOT);
    typedef float f32x2v __attribute__((ext_vector_type(2)));
    const f32x2v bf = *(const f32x2v*)(a.in[9] + h * 64 + 2 * d2), bb = *(const f32x2v*)(a.in[11] + h * 64 + 2 * d2);
    float lf[4][2], lb[4][2];
#pragma unroll
    for (int q = 0; q < 4; ++q) { const int s = sg * 4 + q; float pf0 = bf[0], pf1 = bf[1], pb0 = bb[0], pb1 = bb[1];
#pragma unroll
        for (int j4 = 0; j4 < 4; ++j4) { const f32x4 af = *(const LAS f32x4*)(aL + s * 32 + 4 * j4), ab = *(const LAS f32x4*)(aL + s * 32 + 16 + 4 * j4);
#pragma unroll
            for (int jj = 0; jj < 4; ++jj) { const int j = 4 * j4 + jj; const f32x2v wf = *(const LAS f32x2v*)(wa + j * 64 + 2 * d2), wb = *(const LAS f32x2v*)(wa + 1024 + j * 64 + 2 * d2);
                pf0 += af[jj] * wf[0]; pf1 += af[jj] * wf[1]; pb0 += ab[jj] * wb[0]; pb1 += ab[jj] * wb[1]; } }
        lf[q][0] = logsig_f(pf0) * (1.0f / 16.0f); lf[q][1] = logsig_f(pf1) * (1.0f / 16.0f); lb[q][0] = logsig_f(pb0) * (1.0f / 16.0f); lb[q][1] = logsig_f(pb1) * (1.0f / 16.0f); }
#pragma unroll
    for (int i = 0; i < 2; ++i) { lf[1][i] += lf[0][i]; lf[2][i] += lf[1][i]; lf[3][i] += lf[2][i]; lb[2][i] += lb[3][i]; lb[1][i] += lb[2][i]; lb[0][i] += lb[1][i]; }
    *(LAS f32x2v*)(tot + sg * 64 + 2 * d2) = (f32x2v){lf[3][0], lf[3][1]};
    *(LAS f32x2v*)(tot + 1024 + sg * 64 + 2 * d2) = (f32x2v){lb[0][0], lb[0][1]};
    __syncthreads();
    float of[2] = {0.f, 0.f}, ob[2] = {0.f, 0.f};
    T.Ptot[0] = T.Ptot[1] = T.Xtot[0] = T.Xtot[1] = T.Pref[0] = T.Pref[1] = T.Xref[0] = T.Xref[1] = 0.f;
#pragma unroll
    for (int g = 0; g < 16; ++g) { const f32x2v tf = *(const LAS f32x2v*)(tot + g * 64 + 2 * d2), tb = *(const LAS f32x2v*)(tot + 1024 + g * 64 + 2 * d2);
#pragma unroll
        for (int i = 0; i < 2; ++i) { T.Ptot[i] += tf[i]; T.Xtot[i] += tb[i]; if (g < 8) T.Pref[i] += tf[i]; else T.Xref[i] += tb[i];
            of[i] += (g < sg) ? tf[i] : 0.f; ob[i] += (g > sg) ? tb[i] : 0.f; } }
#pragma unroll
    for (int q = 0; q < 4; ++q)
#pragma unroll
        for (int i = 0; i < 2; ++i) { T.P[q][i] = lf[q][i] + of[i]; T.X[q][i] = lb[q][i] + ob[i]; }
}
struct GlaIn { f32x4 av, wv; unsigned kw[4], qw[4]; };
template <bool OUT>
__device__ __forceinline__ void gla_load(const Args& a, int tid, int bh, int ci, GlaIn& I) {
    const int b = bh >> 2, h = bh & 3, d2 = tid & 31, sg = tid >> 5;
    const size_t rowbase = OUT ? (size_t)b * SEQ + ci * 64 : ((ci < 4) ? (size_t)(MX + b * CTXL + ci * 64) : (size_t)(b * SEQ + (ci - 4) * 64));
    const float* afb = (const float*)(a.ws + WS_AFB); const bf16* qkvg = (const bf16*)(a.ws + WS_QKVG);
    I.av = *(const f32x4*)(afb + (rowbase + (tid >> 3)) * 32 + 4 * (tid & 7));
    const int wdir = tid >> 8, wj = (tid >> 4) & 15, wd4 = (tid & 15) * 4;
    I.wv = *(const f32x4*)((wdir ? a.in[10] : a.in[8]) + wj * 256 + h * 64 + wd4);
#pragma unroll
    for (int q = 0; q < 4; ++q) { const bf16* rp = qkvg + (rowbase + sg * 4 + q) * NQ + h * 64 + 2 * d2; I.kw[q] = *(const unsigned*)(rp + 256); if (OUT) I.qw[q] = *(const unsigned*)rp; }
}
__device__ __forceinline__ void gla_stage_common(const GlaIn& I, LAS unsigned char* lds, int tid) {
    const int wdir = tid >> 8, wj = (tid >> 4) & 15, wd4 = (tid & 15) * 4;
    *(LAS f32x4*)((LAS float*)(lds + GL_AL) + 4 * tid) = I.av;
    *(LAS f32x4*)((LAS float*)(lds + GL_WA) + wdir * 1024 + wj * 64 + wd4) = I.wv;
}

template <bool HASN>
__device__ __forceinline__ void gla_upd_item(const Args& a, LAS unsigned char* lds, int bh, int ci, const GlaIn& I, int nbh, int nci, GlaIn& N) {
    int tid = threadIdx.x; asm volatile("" : "+v"(tid));
    const int lane = tid & 63, wave = tid >> 6, h = bh & 3, d2 = tid & 31, sg = tid >> 5;
    unsigned char* ws = a.ws;
    constexpr int KP = 96;
    LAS bf16* vN = (LAS bf16*)(lds + GL_V); LAS bf16* kUf = (LAS bf16*)(lds + 45056); LAS bf16* kUb = (LAS bf16*)(lds + 57344);
    unsigned kw[4];
#pragma unroll
    for (int q = 0; q < 4; ++q) kw[q] = I.kw[q];
    v4u vv[2];
    { const int b = bh >> 2; const size_t rowbase = (ci < 4) ? (size_t)(MX + b * CTXL + ci * 64) : (size_t)(b * SEQ + (ci - 4) * 64); const bf16* qkvg = (const bf16*)(ws + WS_QKVG);
#pragma unroll
        for (int q = 0; q < 2; ++q) { const int idx = tid + NTHR * q; vv[q] = *(const v4u*)(qkvg + (rowbase + (idx >> 4)) * NQ + 512 + h * 128 + (idx & 15) * 8); } }
    gla_stage_common(I, lds, tid);
    __syncthreads();
    if (HASN) gla_load<false>(a, tid, nbh, nci, N);
    GlaTab T; gla_tables(a, h, lds, T, tid);
#pragma unroll
    for (int q = 0; q < 4; ++q) { const int s = sg * 4 + q; const float k0 = bflo(kw[q]), k1 = bfhi(kw[q]);
        *(LAS unsigned*)(kUf + s * KP + 2 * d2) = pk2(k0 * __expf(T.Ptot[0] - T.P[q][0]), k1 * __expf(T.Ptot[1] - T.P[q][1]));
        *(LAS unsigned*)(kUb + s * KP + 2 * d2) = pk2(k0 * __expf(T.Xtot[0] - T.X[q][0]), k1 * __expf(T.Xtot[1] - T.X[q][1])); }
#pragma unroll
    for (int q = 0; q < 2; ++q) { const int idx = tid + NTHR * q; *(LAS v4u*)(vN + (idx >> 4) * GL_VP + (idx & 15) * 8) = vv[q]; }
    if (tid < 32) { float* dec = (float*)(ws + WS_DEC);
#pragma unroll
        for (int i = 0; i < 2; ++i) { dec[((size_t)(bh * 2 + 0) * NCH + ci) * 64 + 2 * d2 + i] = __expf(T.Ptot[i]); dec[((size_t)(bh * 2 + 1) * NCH + ci) * 64 + 2 * d2 + i] = __expf(T.Xtot[i]); } }
    __syncthreads();
    { const int dir = wave >> 2, e0 = (wave & 3) * 32, l31 = lane & 31, hh = lane >> 5;
        const LAS bf16* kT = dir ? kUb : kUf;
        float* U = (ci < 4) ? (float*)(ws + WS_UCTX) + ((size_t)(bh * 2 + dir) * 4 + ci) * 8192 : a.out + ((size_t)(bh * 2 + dir) * 64 + (ci - 4)) * 8192;
        bf16x8 A[4];
#pragma unroll
        for (int ks = 0; ks < 4; ++ks) A[ks] = tr_frag(vN, GL_VP, 16 * ks, e0, lane);
#pragma unroll
        for (int dt = 0; dt < 2; ++dt) { const int d0 = dt * 32; f32x16 acc;
#pragma unroll
            for (int i = 0; i < 16; ++i) acc[i] = 0.f;
#pragma unroll
            for (int ks = 0; ks < 4; ++ks) acc = mfma32(A[ks], tr_frag(kT, KP, 16 * ks, d0, lane), acc);
#pragma unroll
            for (int r = 0; r < 16; ++r) { const int e = e0 + (r & 3) + 8 * (r >> 2) + 4 * hh; U[e * 64 + d0 + l31] = acc[r]; } } }
    __syncthreads();
}

__device__ __forceinline__ void gla_scan_item(const Args& a, int it) {
    int tid = threadIdx.x; asm volatile("" : "+v"(tid));
    const int bd = it >> 4, dir = bd & 1, el = ((it & 15) * 8 + (tid >> 6)) * 64 + (tid & 63), d = tid & 63;
    unsigned char* ws = a.ws;
    const float* dec = (const float*)(ws + WS_DEC) + (size_t)bd * NCH * 64 + d;
    const float* Uc = (const float*)(ws + WS_UCTX) + (size_t)bd * 4 * 8192 + el;
    const float* U = a.out + (size_t)bd * 64 * 8192 + el;
    bf16* Sp = (bf16*)(ws + WS_SPREV) + (size_t)bd * 64 * 8192 + el;
    float S = 0.f;
#pragma unroll
    for (int c4 = 0; c4 < 4; ++c4) { const int ci = dir ? 3 - c4 : c4; S = dec[ci * 64] * S + Uc[(size_t)ci * 8192]; }
#pragma unroll
    for (int blk = 0; blk < 2; ++blk) { float uu[32], dd[32];
#pragma unroll
        for (int j = 0; j < 32; ++j) { const int n = dir ? 63 - (blk * 32 + j) : blk * 32 + j; uu[j] = U[(size_t)n * 8192]; dd[j] = dec[(4 + n) * 64]; }
#pragma unroll
        for (int j = 0; j < 32; ++j) { const int n = dir ? 63 - (blk * 32 + j) : blk * 32 + j; Sp[(size_t)n * 8192] = (bf16)f2bf(S); S = dd[j] * S + uu[j]; } }
}

template <bool HASN>
__device__ __forceinline__ void gla_out_item(const Args& a, LAS unsigned char* lds, int bh, int n, const GlaIn& I, int nbh, int nn, GlaIn& N) {
    int tid = threadIdx.x; asm volatile("" : "+v"(tid));
    const int lane = tid & 63, wave = tid >> 6, b = bh >> 2, h = bh & 3, l31 = lane & 31, hh = lane >> 5, d2 = tid & 31, sg = tid >> 5;
    unsigned char* ws = a.ws;
    LAS bf16* Scat = (LAS bf16*)lds;
    LAS bf16* vN = (LAS bf16*)(lds + GL_V);
    LAS bf16* qf = (LAS bf16*)(lds + 45056); LAS bf16* qb = qf + 4608; LAS bf16* kf = qf + 2 * 4608; LAS bf16* kb = qf + 3 * 4608;
    LAS float* oS = (LAS float*)(lds + 45056);
    LAS bf16* qS = (LAS bf16*)(lds + 81920);
    LAS bf16* Sp = (LAS bf16*)(lds + 99328);
    const size_t rowbase = (size_t)b * SEQ + n * 64;
    unsigned qw[4], kw[4];
#pragma unroll
    for (int q = 0; q < 4; ++q) { qw[q] = I.qw[q]; kw[q] = I.kw[q]; }
    v4u vv[2], sv[4], g0, g1;
    { const bf16* qkvg = (const bf16*)(ws + WS_QKVG);
        { const bf16* gp = qkvg + (rowbase + (tid >> 3)) * NQ + 1024 + h * 128 + (tid & 7) * 16; g0 = *(const v4u*)gp; g1 = *(const v4u*)(gp + 8); }
#pragma unroll
        for (int q = 0; q < 2; ++q) { const int idx = tid + NTHR * q; vv[q] = *(const v4u*)(qkvg + (rowbase + (idx >> 4)) * NQ + 512 + h * 128 + (idx & 15) * 8); }
        const bf16* spf = (const bf16*)(ws + WS_SPREV) + ((size_t)(bh * 2 + 0) * 64 + n) * 8192; const bf16* spb = (const bf16*)(ws + WS_SPREV) + ((size_t)(bh * 2 + 1) * 64 + n) * 8192;
#pragma unroll
        for (int q = 0; q < 4; ++q) { const int idx = tid + NTHR * q, dir = idx >> 10, e = (idx >> 3) & 127, d8 = (idx & 7) * 8; sv[q] = *(const v4u*)((dir ? spb : spf) + e * 64 + d8); } }
    gla_stage_common(I, lds, tid);
    __syncthreads();
    if (HASN) gla_load<true>(a, tid, nbh, nn, N);
    GlaTab T; gla_tables(a, h, lds, T, tid);
#pragma unroll
    for (int q = 0; q < 4; ++q) { const int s = sg * 4 + q; const float q0 = bflo(qw[q]), q1 = bfhi(qw[q]), k0 = bflo(kw[q]), k1 = bfhi(kw[q]);
        *(LAS unsigned*)(qf + s * 72 + 2 * d2) = pk2(q0 * __expf(T.P[q][0] - T.Pref[0]), q1 * __expf(T.P[q][1] - T.Pref[1]));
        *(LAS unsigned*)(kf + s * 72 + 2 * d2) = pk2(k0 * __expf(T.Pref[0] - T.P[q][0]), k1 * __expf(T.Pref[1] - T.P[q][1]));
        *(LAS unsigned*)(qb + s * 72 + 2 * d2) = pk2(q0 * __expf(T.X[q][0] - T.Xref[0]), q1 * __expf(T.X[q][1] - T.Xref[1]));
        *(LAS unsigned*)(kb + s * 72 + 2 * d2) = pk2(k0 * __expf(T.Xref[0] - T.X[q][0]), k1 * __expf(T.Xref[1] - T.X[q][1]));
        *(LAS unsigned*)(qS + s * 136 + 2 * d2) = pk2(q0 * __expf(T.P[q][0]), q1 * __expf(T.P[q][1]));
        *(LAS unsigned*)(qS + s * 136 + 64 + 2 * d2) = pk2(q0 * __expf(T.X[q][0]), q1 * __expf(T.X[q][1])); }
#pragma unroll
    for (int q = 0; q < 2; ++q) { const int idx = tid + NTHR * q; *(LAS v4u*)(vN + (idx >> 4) * GL_VP + (idx & 15) * 8) = vv[q]; }
#pragma unroll
    for (int q = 0; q < 4; ++q) { const int idx = tid + NTHR * q, dir = idx >> 10, e = (idx >> 3) & 127, d8 = (idx & 7) * 8; *(LAS v4u*)(Sp + e * 136 + dir * 64 + d8) = sv[q]; }
    __syncthreads();
    { const int dir = wave >> 2, c0 = ((wave >> 1) & 1) * 32, s0 = (wave & 1) * 32;
        const LAS bf16* qq = dir ? qb : qf; const LAS bf16* kk = dir ? kb : kf;
        f32x16 acc;
#pragma unroll
        for (int i = 0; i < 16; ++i) acc[i] = 0.f;
#pragma unroll
        for (int ks = 0; ks < 4; ++ks) { const bf16x8 A = *(const LAS bf16x8*)(qq + (c0 + l31) * 72 + 16 * ks + 8 * hh), B = *(const LAS bf16x8*)(kk + (s0 + l31) * 72 + 16 * ks + 8 * hh);
            acc = mfma32(A, B, acc); }
        const int s = s0 + l31;
#pragma unroll
        for (int r = 0; r < 16; ++r) { const int c = c0 + (r & 3) + 8 * (r >> 2) + 4 * hh; const bool keep = dir ? (s >= c) : (s <= c);
            Scat[c * 136 + dir * 64 + s] = (bf16)f2bf(keep ? acc[r] : 0.f); } }
    __syncthreads();
    { const int c0 = (wave >> 2) * 32, e0 = (wave & 3) * 32;
        f32x16 acc;
#pragma unroll
        for (int i = 0; i < 16; ++i) acc[i] = 0.f;
#pragma unroll
        for (int ks = 0; ks < 8; ++ks) { const bf16x8 A = *(const LAS bf16x8*)(Scat + (c0 + l31) * 136 + 16 * ks + 8 * hh);
            acc = mfma32(A, tr_frag(vN, GL_VP, 16 * (ks & 3), e0, lane), acc); }
#pragma unroll
        for (int ks = 0; ks < 8; ++ks) { const bf16x8 A = *(const LAS bf16x8*)(qS + (c0 + l31) * 136 + 16 * ks + 8 * hh), B = *(const LAS bf16x8*)(Sp + (e0 + l31) * 136 + 16 * ks + 8 * hh);
            acc = mfma32(A, B, acc); }
#pragma unroll
        for (int r = 0; r < 16; ++r) { const int c = c0 + (r & 3) + 8 * (r >> 2) + 4 * hh; oS[c * 132 + e0 + l31] = acc[r]; } }
    __syncthreads();
    { const int row = tid >> 3, ec = (tid & 7) * 16; float v[16]; float ss = 0.f;
#pragma unroll
        for (int j = 0; j < 16; ++j) { v[j] = oS[row * 132 + ec + j]; ss += v[j] * v[j]; }
        ss += __shfl_xor(ss, 1); ss += __shfl_xor(ss, 2); ss += __shfl_xor(ss, 4);
        const float rs = rsqrtf(ss * (1.0f / 128.0f) + EPS);
        const float gv[16] = {bflo(g0.x), bfhi(g0.x), bflo(g0.y), bfhi(g0.y), bflo(g0.z), bfhi(g0.z), bflo(g0.w), bfhi(g0.w), bflo(g1.x), bfhi(g1.x), bflo(g1.y), bfhi(g1.y), bflo(g1.z), bfhi(g1.z), bflo(g1.w), bfhi(g1.w)};
        float o[16];
#pragma unroll
        for (int j = 0; j < 16; ++j) o[j] = DBG_GLA_K * v[j] * rs * a.in[12][ec + j] * silu_f(gv[j]);
        bf16* op = (bf16*)(ws + WS_AOUT) + (rowbase + row) * DM + h * 128 + ec;
        *(v4u*)op = (v4u){pk2(o[0], o[1]), pk2(o[2], o[3]), pk2(o[4], o[5]), pk2(o[6], o[7])};
        *(v4u*)(op + 8) = (v4u){pk2(o[8], o[9]), pk2(o[10], o[11]), pk2(o[12], o[13]), pk2(o[14], o[15])}; }
    __syncthreads();
}

__device__ __forceinline__ void hy_transpose_item(const Args& a, LAS unsigned char* lds, int it) {
    const int tid = threadIdx.x, b = it >> 6, t0 = (it & 63) * 64;
    LAS float* tile = (LAS float*)lds;
    const bf16* src = (const bf16*)(a.ws + WS_HYT) + (size_t)b * 1536 * SEQ + t0;
    bf16* dst = (bf16*)(a.ws + WS_AOUT) + ((size_t)b * SEQ + t0) * DM + 512;
    for (int half = 0; half < 2; ++half) {
#pragma unroll 8
        for (int q = 0; q < 32; ++q) { const int idx = tid + NTHR * q, c = idx >> 6, tt = idx & 63; tile[c * 65 + tt] = HB(src[(size_t)(half * 256 + c) * SEQ + tt]); }
        __syncthreads();
#pragma unroll
        for (int q = 0; q < 4; ++q) { const int idx = tid + NTHR * q, t = idx >> 5, c8 = (idx & 31) * 8; const LAS float* s = tile + c8 * 65 + t;
            *(v4u*)(dst + (size_t)t * DM + half * 256 + c8) = (v4u){pk2(s[0], s[65]), pk2(s[2 * 65], s[3 * 65]), pk2(s[4 * 65], s[5 * 65]), pk2(s[6 * 65], s[7 * 65])}; }
        __syncthreads();
    }
}

__device__ __forceinline__ void phase_router(const Args& a, LAS unsigned char* lds) {
    const int tid = threadIdx.x, lane = tid & 63, wave = tid >> 6, wg = blockIdx.x, G = gridDim.x;
    unsigned char* ws = a.ws;
    LAS float* wr = (LAS float*)lds;
    {   f32x4 t[8];
#pragma unroll
        for (int it = 0; it < 8; ++it) t[it] = *(const f32x4*)(a.in[24] + 4 * (tid + NTHR * it));
#pragma unroll
        for (int it = 0; it < 8; ++it) { const int i4 = tid + NTHR * it, c = i4 >> 2, e4 = i4 & 3, l = (c >> 2) & 63, q = c & 3, j = c >> 8;
            *(LAS f32x4*)(wr + 4 * ((((j * 4 + q) * 4 + e4) * 65) + l)) = t[it]; } }
    __syncthreads();
    const float* modr = (const float*)(ws + WS_MOD); const float* gffn = a.in[23];
    bf16* hn = (bf16*)(ws + WS_HN); float* aff = (float*)(ws + WS_AFF); const bf16* x1b = (const bf16*)(ws + WS_X1B);
    const int NGW = G * NWAVES;
    f32x4 gv[4];
#pragma unroll
    for (int j = 0; j < 4; ++j) gv[j] = *(const f32x4*)(gffn + 4 * lane + 256 * j);
#pragma nounroll
    for (int r0 = wg * NWAVES + wave; r0 < MX; r0 += 2 * NGW) {
        const int r1 = r0 + NGW; const bool ok1 = r1 < MX; const int rB = ok1 ? r1 : r0;
        int lane_o = lane; asm volatile("" : "+v"(lane_o));
        f32x4 v[2][4];
#pragma unroll
        for (int j = 0; j < 4; ++j) { const v2u w0 = *(const v2u*)(x1b + (size_t)r0 * DM + 4 * lane + 256 * j), w1 = *(const v2u*)(x1b + (size_t)rB * DM + 4 * lane + 256 * j);
            v[0][j] = (f32x4){bflo(w0.x), bfhi(w0.x), bflo(w0.y), bfhi(w0.y)}; v[1][j] = (f32x4){bflo(w1.x), bfhi(w1.x), bflo(w1.y), bfhi(w1.y)}; }
        float rs[2];
#pragma unroll
        for (int k = 0; k < 2; ++k) { float ss = 0.f;
#pragma unroll
            for (int j = 0; j < 4; ++j) ss += v[k][j][0] * v[k][j][0] + v[k][j][1] * v[k][j][1] + v[k][j][2] * v[k][j][2] + v[k][j][3] * v[k][j][3];
            rs[k] = rsqrtf(wave_sum(ss) * (1.0f / DM) + EPS); }
        float lg[2][16];
#pragma unroll
        for (int k = 0; k < 2; ++k)
#pragma unroll
            for (int e = 0; e < 16; ++e) lg[k][e] = 0.f;
        f32x4 shv[2][4], scv[2][4];
#pragma unroll
        for (int k = 0; k < 2; ++k)
#pragma unroll
            for (int j = 0; j < 4; ++j) { const int b = (k ? rB : r0) >> 12, col = 4 * lane + 256 * j; shv[k][j] = *(const f32x4*)(modr + b * 6144 + 3072 + col); scv[k][j] = *(const f32x4*)(modr + b * 6144 + 4096 + col); }
#pragma unroll
        for (int j = 0; j < 4; ++j) { const int col = 4 * lane + 256 * j; f32x4 y[2];
#pragma unroll
            for (int k = 0; k < 2; ++k) { const int r = k ? rB : r0;
                const f32x4 sh = shv[k][j], sc = scv[k][j];
                y[k] = (v[k][j] * rs[k] * gv[j]) * (sc + 1.0f) + sh;
                v2u w; w.x = pk2(y[k][0], y[k][1]); w.y = pk2(y[k][2], y[k][3]);
                if (k == 0 || ok1) *(v2u*)(hn + (size_t)r * DM + col) = w; }
#pragma unroll
            for (int q = 0; q < 4; ++q) {
#pragma unroll
                for (int e4 = 0; e4 < 4; ++e4) { const f32x4 ww = *(const LAS f32x4*)(wr + 4 * ((((j * 4 + q) * 4 + e4) * 65) + lane_o));
#pragma unroll
                    for (int s = 0; s < 4; ++s) { lg[0][e4 * 4 + s] += y[0][q] * ww[s]; lg[1][e4 * 4 + s] += y[1][q] * ww[s]; } }
#define PIN16(x) asm volatile("" : "+v"(x[0]), "+v"(x[1]), "+v"(x[2]), "+v"(x[3]), "+v"(x[4]), "+v"(x[5]), "+v"(x[6]), "+v"(x[7]), "+v"(x[8]), "+v"(x[9]), "+v"(x[10]), "+v"(x[11]), "+v"(x[12]), "+v"(x[13]), "+v"(x[14]), "+v"(x[15]) :: "memory")
                PIN16(lg[0]); PIN16(lg[1]); } }
#undef PIN16
        const int exb = ((lane >> 5) & 1) * 8 + ((lane >> 4) & 1) * 4, esel = lane & 3;
#pragma unroll
        for (int k = 0; k < 2; ++k) { float k8[8], k4[4];
#pragma unroll
            for (int i = 0; i < 8; ++i) { float x = lg[k][i], y = lg[k][8 + i]; swap32(x, y); k8[i] = x + y; }
#pragma unroll
            for (int i = 0; i < 4; ++i) { float x = k8[i], y = k8[4 + i]; swap16(x, y); k4[i] = row_allsum(x + y); }
            const float mx = x32_max(x16_max(fmaxf(fmaxf(k4[0], k4[1]), fmaxf(k4[2], k4[3]))));
            float pe[4];
#pragma unroll
            for (int i = 0; i < 4; ++i) pe[i] = __expf(k4[i] - mx);
            const float sum = x32_sum(x16_sum((pe[0] + pe[1]) + (pe[2] + pe[3])));
            const float mine = (esel == 0) ? pe[0] : (esel == 1) ? pe[1] : (esel == 2) ? pe[2] : pe[3];
            const int r = k ? rB : r0;
            if ((lane & 12) == 0 && (k == 0 || ok1)) aff[((size_t)(r >> 12) * NE + exb + esel) * SEQ + (r & 4095)] = mine * __builtin_amdgcn_rcpf(sum); }
    }
}

__device__ __forceinline__ void conv_item(const Args& a, LAS float* scr, int lane, bool gu, int it) {
    unsigned char* ws = a.ws;
    if (gu) { const int mat = it >> 9, r = it & 511, nb = r >> 4, kb = r & 15, e = mat >> 1, kind = mat & 1, n0 = nb * 32;
        transpose_item((kind ? a.in[26] : a.in[25]) + (size_t)e * DM * DM, DM, kb * 64, n0, (bf16*)(ws + WS_WGU) + (size_t)e * 2048 * DM, DM, (n0 >> 7) * 256 + kind * 128 + (n0 & 127), scr, lane, false);
    } else { const int e = it >> 9, r = it & 511, nb = r >> 4, kb = r & 15;
        transpose_item(a.in[27] + (size_t)e * DM * DM, DM, kb * 64, nb * 32, (bf16*)(ws + WS_WD) + (size_t)e * DM * DM, DM, nb * 32, scr, lane, false); }
}
__device__ __forceinline__ bool conv_try(const Args& a, LAS unsigned char* lds, bool allow_gu, unsigned& cur) {
    const int lane = threadIdx.x & 63, wave = threadIdx.x >> 6;
    if (wave == 0) return false;
    const int gw = blockIdx.x * (NWAVES - 1) + wave - 1, NGW = gridDim.x * (NWAVES - 1);
    LAS float* scr = (LAS float*)(lds + wave * 8448);
    const int itD = gw + (int)(cur & 0xffffu) * NGW;
    if (itD < NE * 512) { conv_item(a, scr, lane, false, itD); cur += 1u; return true; }
    if (!allow_gu) return false;
    const int itG = gw + (int)(cur >> 16) * NGW;
    if (itG < NE * 1024) { conv_item(a, scr, lane, true, itG); cur += 0x10000u; return true; }
    return false;
}
#ifndef DBG_NOSHADOW
#define DBG_NOSHADOW 0
#endif
#ifndef SHADOW_LIM
#define SHADOW_LIM 2
#endif
__device__ __forceinline__ void seam_barrier(const XcdBarrier& b, const Args& a, LAS unsigned char* lds, volatile LAS unsigned* MISC, unsigned& gen, bool allow_gu, unsigned& cdone) {
    asm volatile("s_waitcnt vmcnt(0)" ::: "memory");
    __syncthreads();
    ++gen;
    if (threadIdx.x < 64) {
        if (threadIdx.x == 0) {
            unsigned* bar = b.bar;
            __builtin_amdgcn_s_waitcnt(0);
            unsigned nloc = b.st[0], nx = b.st[1];
            if (nloc == 0u) { xcd_barrier_complete(bar, b.x, nloc, nx); b.st[0] = nloc; b.st[1] = nx; }
            const unsigned old = xb_add(&bar[XB_XSUB(b.x)], 1u);
            const unsigned g2 = old / nloc;
            if (old + 1u == (g2 + 1u) * nloc) {
                __builtin_amdgcn_fence(__ATOMIC_RELEASE, "agent");
                asm volatile("s_waitcnt vmcnt(0)" ::: "memory");
                const unsigned og = xb_add(&bar[XB_TOP], 1u);
                const unsigned tg = og / nx;
                if (og + 1u == (tg + 1u) * nx) xb_add(&bar[XB_TOPGEN], 1u);
                else XB_SPIN(xb_ld(&bar[XB_TOPGEN]) == tg, bar);
                __builtin_amdgcn_fence(__ATOMIC_ACQUIRE, "agent");
                xb_add(&bar[XB_XGEN(b.x)], 1u);
                asm volatile("s_waitcnt vmcnt(0)" ::: "memory");
            } else {
                XB_SPIN(xb_ld(&bar[XB_XGEN(b.x)]) == g2, bar);
                __builtin_amdgcn_fence(__ATOMIC_ACQUIRE, "agent");
                asm volatile("s_waitcnt vmcnt(0)" ::: "memory");
            }
            MISC[16] = gen;
        }
    } else {
        unsigned spins = 0; int ndone = 0;
        while (MISC[16] != gen) { if (DBG_NOSHADOW || ndone >= SHADOW_LIM || !conv_try(a, lds, allow_gu, cdone)) { __builtin_amdgcn_s_sleep(4); if (++spins > (1u << 22)) break; } else ++ndone; }
    }
    __syncthreads();
}

__device__ __forceinline__ void block_excl_scan2(int& va, int& vb, LAS int* tmp) {
    const int tid = threadIdx.x, lane = tid & 63, wave = tid >> 6;
    int ia = va, ib = vb;
#pragma unroll
    for (int o = 1; o < 64; o <<= 1) { const int ta = __shfl_up(ia, o), tb = __shfl_up(ib, o); if (lane >= o) { ia += ta; ib += tb; } }
    if (lane == 63) { tmp[wave] = ia; tmp[8 + wave] = ib; }
    __syncthreads();
    int oa = 0, ob = 0;
#pragma unroll
    for (int w = 0; w < 8; ++w) { if (w < wave) { oa += tmp[w]; ob += tmp[8 + w]; } }
    va = oa + ia - va; vb = ob + ib - vb;
    __syncthreads();
}
__device__ __forceinline__ void topk_item(const Args& a, LAS unsigned char* lds, int be) {
    const int tid = threadIdx.x, b = be >> 4, e = be & 15;
    unsigned char* ws = a.ws;
    LAS unsigned* keys = (LAS unsigned*)lds;
    LAS unsigned* hist = (LAS unsigned*)(lds + 16384);
    LAS int* ctl = (LAS int*)(lds + 16384 + 1024);
    LAS int* tmp = (LAS int*)(lds + 16384 + 1024 + 64);
    const float* aff = (const float*)(ws + WS_AFF) + (size_t)be * SEQ;
    unsigned my[8];
#pragma unroll
    for (int i = 0; i < 8; ++i) { my[i] = __float_as_uint(aff[tid * 8 + i]); keys[tid * 8 + i] = my[i]; }
    unsigned prefix = 0u, mask = 0u; int need = CAP;
    for (int pass = 0; pass < 4; ++pass) {
        const int shift = 24 - 8 * pass;
        if (tid < 256) hist[tid] = 0u;
        __syncthreads();
#pragma unroll
        for (int i = 0; i < 8; ++i) {
            const bool live = (my[i] & mask) == prefix; const unsigned bin = (my[i] >> shift) & 255u;
            const unsigned long long lm = __ballot(live);
            if (lm != 0ull) { const int leader = (int)__ffsll((long long)lm) - 1; const unsigned lb = (unsigned)__builtin_amdgcn_readlane((int)bin, leader);
                if (__ballot(live && bin != lb) == 0ull) { if ((tid & 63) == leader) atomicAdd((unsigned*)&hist[lb], (unsigned)__popcll(lm)); }
                else if (live) atomicAdd((unsigned*)&hist[bin], 1u); } }
        __syncthreads();
        {
            int hv = (tid < 256) ? (int)hist[255 - tid] : 0, inc = hv;
#pragma unroll
            for (int o = 1; o < 64; o <<= 1) { const int t2 = __shfl_up(inc, o); if ((tid & 63) >= o) inc += t2; }
            if ((tid & 63) == 63) tmp[tid >> 6] = inc;
            __syncthreads();
            int off = 0;
#pragma unroll
            for (int w = 0; w < 4; ++w) if (w < (tid >> 6)) off += tmp[w];
            inc += off;
            if (tid < 256 && inc >= need && inc - hv < need) { ctl[0] = 255 - tid; ctl[1] = need - (inc - hv); }
        }
        __syncthreads();
        prefix |= ((unsigned)ctl[0]) << shift; mask |= 255u << shift; need = ctl[1];
        __syncthreads();
    }
    const unsigned T = prefix;
    int cg = 0, ce = 0;
#pragma unroll
    for (int i = 0; i < 8; ++i) { cg += (my[i] > T) ? 1 : 0; ce += (my[i] == T) ? 1 : 0; }
    int pg = cg, pe = ce;
    block_excl_scan2(pg, pe, tmp);
    int* slot_of = (int*)(ws + WS_SLOT) + (size_t)be * SEQ;
    int* selt = (int*)(ws + WS_SELT) + (e * 4 + b) * CAP; float* selv = (float*)(ws + WS_SELV) + (e * 4 + b) * CAP;
#pragma unroll
    for (int i = 0; i < 8; ++i) { const int t = tid * 8 + i; const bool gt = my[i] > T, eq = my[i] == T; const bool sel = gt || (eq && pe < need);
        const int slot = pg + (pe < need ? pe : need);
        slot_of[t] = sel ? slot : -1;
        if (sel) { selt[slot] = t; selv[slot] = __uint_as_float(my[i]); }
        pg += gt ? 1 : 0; pe += eq ? 1 : 0; }
    __syncthreads();
}
__device__ __forceinline__ void phase_topk(const Args& a, LAS unsigned char* lds, unsigned& cdone) {
    const int tid = threadIdx.x, lane = tid & 63, wave = tid >> 6, wg = blockIdx.x, G = gridDim.x;
    unsigned char* ws = a.ws;
    for (int it = wg; it < NB * NE; it += G) topk_item(a, lds, it);
    __syncthreads();
    while (conv_try(a, lds, true, cdone)) {}
}

__device__ __forceinline__ void phase_final(const Args& a) {
    const int tid = threadIdx.x, lane = tid & 63, wave = tid >> 6, wg = blockIdx.x, G = gridDim.x;
    unsigned char* ws = a.ws;
    const float* modr = (const float*)(ws + WS_MOD); const int* slot_of = (const int*)(ws + WS_SLOT); const bf16* ys = (const bf16*)(ws + WS_YSLAB); const bf16* x1b = (const bf16*)(ws + WS_X1B);
    const int NGW = G * NWAVES;
    f32x4 gf[4];
#pragma unroll
    for (int j = 0; j < 4; ++j) gf[j] = *(const f32x4*)(a.in[28] + 4 * lane + 256 * j);
#pragma nounroll
    for (int r0 = wg * NWAVES + wave; r0 < MX; r0 += 4 * NGW) {
        int sv[4]; unsigned long long mk[4]; f32x4 v[4][4], m[4][4];
#pragma unroll
        for (int k = 0; k < 4; ++k) { const int r = r0 + k * NGW; const bool ok = r < MX; const int rc = ok ? r : r0, b = rc >> 12, t = rc & 4095;
            sv[k] = (lane < NE) ? slot_of[((size_t)b * NE + lane) * SEQ + t] : -1;
#pragma unroll
            for (int j = 0; j < 4; ++j) { const v2u w0 = *(const v2u*)(x1b + (size_t)rc * DM + 4 * lane + 256 * j); v[k][j] = (f32x4){bflo(w0.x), bfhi(w0.x), bflo(w0.y), bfhi(w0.y)}; m[k][j] = (f32x4){0.f, 0.f, 0.f, 0.f}; }
            mk[k] = (ok && !DBG_NOMOE) ? __ballot(sv[k] >= 0) : 0ull; }
        while (mk[0] | mk[1] | mk[2] | mk[3]) {
            v2u w[4][4]; float wt[4];
#pragma unroll
            for (int k = 0; k < 4; ++k) { const bool has = mk[k] != 0ull; const int e = has ? (int)__ffsll((long long)mk[k]) - 1 : 0; mk[k] &= mk[k] - 1ull;
                const int rc = (r0 + k * NGW < MX) ? r0 + k * NGW : r0; const int sl = has ? __builtin_amdgcn_readlane(sv[k], e) : 0;
                const bf16* yp = ys + ((size_t)e * 2048 + (rc >> 12) * CAP + sl) * DM; wt[k] = has ? 1.f : 0.f;
#pragma unroll
                for (int j = 0; j < 4; ++j) w[k][j] = *(const v2u*)(yp + 4 * lane + 256 * j); }
#pragma unroll
            for (int k = 0; k < 4; ++k)
#pragma unroll
                for (int j = 0; j < 4; ++j) { m[k][j][0] += wt[k] * bflo(w[k][j].x); m[k][j][1] += wt[k] * bfhi(w[k][j].x); m[k][j][2] += wt[k] * bflo(w[k][j].y); m[k][j][3] += wt[k] * bfhi(w[k][j].y); }
        }
        f32x4 gt[4][4];
#pragma unroll
        for (int k = 0; k < 4; ++k) { const int r = r0 + k * NGW, b = ((r < MX) ? r : r0) >> 12;
#pragma unroll
            for (int j = 0; j < 4; ++j) gt[k][j] = *(const f32x4*)(modr + b * 6144 + 5120 + 4 * lane + 256 * j); }
#pragma unroll
        for (int k = 0; k < 4; ++k) { const int r = r0 + k * NGW;
            if (r < MX) { float ss = 0.f; float* row = a.out + (size_t)r * DM;
#pragma unroll
                for (int j = 0; j < 4; ++j) { v[k][j] = v[k][j] + gt[k][j] * m[k][j] * DBG_MOE_K;
                    ss += v[k][j][0] * v[k][j][0] + v[k][j][1] * v[k][j][1] + v[k][j][2] * v[k][j][2] + v[k][j][3] * v[k][j][3]; }
                const float rs = rsqrtf(wave_sum(ss) * (1.0f / DM) + EPS);
#pragma unroll
                for (int j = 0; j < 4; ++j) *(f32x4*)(row + 4 * lane + 256 * j) = v[k][j] * rs * gf[j]; } }
    }
}

__global__ void __launch_bounds__(NTHR, 2) fwd_kernel(Args a) {
    extern __shared__ __attribute__((aligned(16))) unsigned char lds_raw[];
    LAS unsigned char* lds = (LAS unsigned char*)lds_raw;
    const int tid = threadIdx.x, wg = blockIdx.x, G = gridDim.x;
    unsigned char* ws = a.ws;
    volatile LAS unsigned* MISC = (volatile LAS unsigned*)(lds + LDS_MISC);
    if (tid < 64) MISC[tid] = 0u;
    __syncthreads();
    unsigned bgen = 0u, cdone = 0u;
    XcdBarrier bar; bar.bar = (unsigned*)(ws + WS_CTL); bar.x = 0; bar.st = nullptr;
    if (a.ph_hi - a.ph_lo > 1) bar = xcd_barrier_post((unsigned*)(ws + WS_CTL), MISC + 8);
#ifndef PH_ONLY
#define PH_ONLY -1
#endif
#define IN(k) ((PH_ONLY < 0 || PH_ONLY == (k)) && a.ph_lo <= (k) && (k) < a.ph_hi)
#ifndef DBG_BAR2
#define DBG_BAR2 0
#endif
#ifndef DBG_TSA
#define DBG_TSA -1
#endif
#ifndef DBG_TSB
#define DBG_TSB -1
#endif
#define STAMP(k) do { if (DBG_TSA >= 0 && wg == 0 && tid == 0) ((unsigned long long*)(ws + WS_CTL + 49152))[k] = __builtin_amdgcn_s_memrealtime(); } while (0)
#define SEAM(k) do { if (IN(k) && IN((k) + 1)) { seam_barrier(bar, a, lds, MISC, bgen, true, cdone); if (DBG_BAR2) xcd_barrier(bar); } STAMP((k) + 1); } while (0)
#ifndef DBG_DUP
#define DBG_DUP -1
#endif
#define REP(k) _Pragma("nounroll") for (int _rep = 0; _rep < ((DBG_DUP == (k)) ? 2 : 1); ++_rep, (void)((DBG_DUP == (k) && _rep == 1) ? (xcd_barrier(bar), 0) : 0))
    STAMP(0);
    if (IN(0)) REP(0) { phase0(a, lds); } SEAM(0);
    if (IN(1)) REP(1) { phase1(a, lds); } SEAM(1);
    if (IN(2)) REP(2) {
        pg8::Gemm g{(const pg8::bf16_t*)ws, (const pg8::bf16_t*)ws, MT, NIN, DM}; InSched S; S.init(G, wg, 0);
        EpiIn E{(bf16*)(ws + WS_QKVG), (bf16*)(ws + WS_HYT), (float*)(ws + WS_AFB)};
        pg8::gemm_phase<EpiIn, InSched, true, true>(lds, g, S, E);
    } SEAM(2);
    if (IN(3)) REP(3) {
        {   pg8::Gemm g{(const pg8::bf16_t*)ws, (const pg8::bf16_t*)ws, MT, NIN, DM}; InSched S; S.init(G, wg, 1);
            EpiIn E{(bf16*)(ws + WS_QKVG), (bf16*)(ws + WS_HYT), (float*)(ws + WS_AFB)};
            pg8::gemm_phase<EpiIn, InSched, true, true>(lds, g, S, E); }
        for (int it = wg; it < 512; it += G) hyena_item(a, lds, it, 0);
        {   GlaIn I, N; bool have = false;
            const bool split = (G == 256);
            const int first = split ? ((wg < 80) ? wg : 80 + wg) : wg, stride = split ? ((wg < 80) ? 80 : 176) : G, limit = split ? ((wg < 80) ? 160 : 16 * NCH) : 16 * NCH;
            for (int r = first; r < limit; r += stride) {
                const int nr = r + stride; const bool hasn = nr < limit;
                if (!have) { int t0 = threadIdx.x; asm volatile("" : "+v"(t0)); gla_load<false>(a, t0, r / NCH, r % NCH, I); have = true; }
                if (hasn) gla_upd_item<true>(a, lds, r / NCH, r % NCH, I, nr / NCH, nr % NCH, N); else gla_upd_item<false>(a, lds, r / NCH, r % NCH, I, 0, 0, N);
                I = N; } }
    } SEAM(3);
    if (IN(4)) REP(4) {
        for (int it = wg; it < 1024; it += G) { if (it < 512) hyena_item(a, lds, it, 1); else gla_scan_item(a, it - 512); }
    } SEAM(4);
    if (IN(5)) REP(5) {
        GlaIn I, N; bool have = false;
        for (int it = wg; it < 1280; it += G) {
            if (it >= 1024) { hy_transpose_item(a, lds, it - 1024); continue; }
            const int nr = it + G; const bool hasn = nr < 1024;
            if (!have) { int t0 = threadIdx.x; asm volatile("" : "+v"(t0)); gla_load<true>(a, t0, it >> 6, it & 63, I); have = true; }
            if (hasn) gla_out_item<true>(a, lds, it >> 6, it & 63, I, nr >> 6, nr & 63, N); else gla_out_item<false>(a, lds, it >> 6, it & 63, I, 0, 0, N);
            I = N; }
    } SEAM(5);
    if (IN(6)) REP(6) {
        pg8::Gemm g{(const pg8::bf16_t*)(ws + WS_AOUT), (const pg8::bf16_t*)(ws + WS_WOUT), MX, DM, DM}; pg8::StaticOrder S; S.init(MX, DM, G, wg);
        EpiOut E{a.in[0], (const float*)(ws + WS_POS), (const float*)(ws + WS_MOD), (bf16*)(ws + WS_X1B)};
        pg8::gemm_phase<EpiOut, pg8::StaticOrder, false, true>(lds, g, S, E);
    } SEAM(6);
    if (IN(7)) REP(7) { phase_router(a, lds); } SEAM(7);
    if (IN(8)) REP(8) { phase_topk(a, lds, cdone); } SEAM(8);
    if (IN(9)) REP(9) {
        pg8::Gemm g{(const pg8::bf16_t*)(ws + WS_HN), (const pg8::bf16_t*)(ws + WS_WGU), NE * 2048, NE * 2048, DM}; MoeSched<8> S; S.init(G, wg);
        EpiGU E{(bf16*)(ws + WS_HID)};
        pg8::gemm_phase_gather<EpiGU, MoeSched<8>, true, true>(lds, g, S, E, (const int*)(ws + WS_SELT));
    } SEAM(9);
    if (IN(10)) REP(10) {
        pg8::Gemm g{(const pg8::bf16_t*)(ws + WS_HID), (const pg8::bf16_t*)(ws + WS_WD), NE * 2048, NE * 1024, DM}; MoeSched<4> S; S.init(G, wg);
        EpiDown E{(bf16*)(ws + WS_YSLAB), (const float*)(ws + WS_SELV)};
        pg8::gemm_phase<EpiDown, MoeSched<4>, true, true>(lds, g, S, E);
    } SEAM(10);
    if (IN(11)) { phase_final(a); }
    if (DBG_TSA >= 0) {
        xcd_barrier(bar); STAMP(12); xcd_barrier(bar);
        const unsigned long long* ts = (const unsigned long long*)(ws + WS_CTL + 49152);
        const float da = (DBG_TSA == 12) ? (float)(ts[12] - ts[0]) * 0.01f : (float)(ts[DBG_TSA + 1] - ts[DBG_TSA]) * 0.01f;
        const float db = (DBG_TSB == 12) ? (float)(ts[12] - ts[0]) * 0.01f : (float)(ts[DBG_TSB + 1] - ts[DBG_TSB]) * 0.01f;
        for (size_t i = (size_t)wg * NTHR + tid; i < (size_t)MX * DM; i += (size_t)G * NTHR) a.out[i] = (i < (size_t)MX * DM / 2) ? da : db;
    }
#undef IN
#undef SEAM
}


#ifdef DBG_STATE
__global__ void chk_kernel(const unsigned* p, size_t nwords, unsigned long long* out) {
    unsigned long long s = 0ull;
    for (size_t i = (size_t)blockIdx.x * blockDim.x + threadIdx.x; i < nwords; i += (size_t)gridDim.x * blockDim.x) s += (unsigned long long)p[i] * (2ull * i + 1ull);
    for (int o = 1; o < 64; o <<= 1) s += __shfl_xor(s, o);
    if ((threadIdx.x & 63) == 0) atomicAdd(out, s);
}
__global__ void report_kernel(const unsigned long long* chk, float* out, int n) {
    int bad = -1;
    for (int p = 0; p < 27; ++p) if (chk[p] != chk[32 + p]) { bad = p; break; }
    if (bad < 0) return;
    for (int i = blockIdx.x * blockDim.x + threadIdx.x; i < n; i += gridDim.x * blockDim.x) out[i] = 1000.f * (float)(bad + 1);
}
struct ChkEnt { int ph; size_t off; size_t bytes; };
#endif
extern "C" void kernel_launch(void* const* d_in, const int* in_sizes, int n_in, void* d_out, int out_size, void* d_ws, size_t ws_size, hipStream_t stream) {
    static int grid = 0;
    if (grid == 0) {
        if (n_in != 29 || out_size != MX * DM || ws_size < WS_END) { fprintf(stderr, "kernel_launch: unexpected shapes (n_in %d out %d ws %zu)\n", n_in, out_size, ws_size); grid = -1; return; }
        int dev = 0, cus = 0, per_cu = 0;
        if (hipGetDevice(&dev) != hipSuccess || hipDeviceGetAttribute(&cus, hipDeviceAttributeMultiprocessorCount, dev) != hipSuccess) { grid = -1; return; }
        if (hipFuncSetAttribute((const void*)fwd_kernel, hipFuncAttributeMaxDynamicSharedMemorySize, LDS_BYTES) != hipSuccess) { fprintf(stderr, "kernel_launch: hipFuncSetAttribute failed\n"); grid = -1; return; }
        if (hipOccupancyMaxActiveBlocksPerMultiprocessor(&per_cu, (const void*)fwd_kernel, NTHR, LDS_BYTES) != hipSuccess || per_cu < 1) fprintf(stderr, "kernel_launch: occupancy query reports %d\n", per_cu);
        (void)hipGetLastError();
        grid = cus;
    }
    if (grid < 0) return;
    (void)hipMemsetAsync((char*)d_ws + WS_CTL, 0, CTL_BYTES, stream);
    Args a{};
    for (int i = 0; i < 29; ++i) a.in[i] = (const float*)d_in[i];
    a.out = (float*)d_out; a.ws = (unsigned char*)d_ws;
#if MK_SINGLE
#ifdef DBG_TWICE
    a.ph_lo = 0; a.ph_hi = NPH - 1;
    hipLaunchKernelGGL(fwd_kernel, dim3(grid), dim3(NTHR), LDS_BYTES, stream, a);
    (void)hipMemsetAsync((char*)d_ws + WS_CTL, 0, CTL_BYTES, stream);
#endif
    a.ph_lo = 0; a.ph_hi = NPH;
    hipLaunchKernelGGL(fwd_kernel, dim3(grid), dim3(NTHR), LDS_BYTES, stream, a);
#else
#ifdef DBG_STATE
    static const ChkEnt ents[] = { {0, WS_MOD, 122880}, {0, WS_POS, 131072}, {0, WS_HT, 32 * MiB}, {0, WS_WIN, (size_t)NIN * DM * 2}, {0, WS_WOUT, 2 * MiB},
        {1, WS_AIN, 34 * MiB}, {2, WS_QKVG, (size_t)MX * NQ * 2}, {2, WS_HYT, 48 * MiB}, {2, WS_AFB, (size_t)MT * 128},
        {3, WS_ZT, 32 * MiB}, {3, WS_DEC, (size_t)16 * 2 * NCH * 64 * 4}, {3, WS_UCTX, 4 * MiB}, {3, (size_t)-1, 64 * MiB},
        {4, WS_SPREV, 32 * MiB}, {4, WS_YHYT, 32 * MiB}, {5, WS_AOUT, 32 * MiB}, {6, (size_t)-1, 64 * MiB}, {7, WS_HN, 32 * MiB}, {7, WS_AFF, 1 * MiB},
        {8, WS_SLOT, 1 * MiB}, {8, WS_SELT, 131072}, {8, WS_SELV, 131072}, {8, WS_WGU, 64 * MiB}, {8, WS_WD, 32 * MiB}, {9, WS_HID, 64 * MiB}, {10, WS_YSLAB, 64 * MiB}, {11, (size_t)-1, 64 * MiB} };
    unsigned long long* chk = (unsigned long long*)((char*)d_ws + 32768);
    for (int run = 0; run < 2; ++run)
        for (int p = 0; p < NPH; ++p) { a.ph_lo = p; a.ph_hi = p + 1; hipLaunchKernelGGL(fwd_kernel, dim3(grid), dim3(NTHR), LDS_BYTES, stream, a);
            for (const ChkEnt& e : ents) if (e.ph == p) hipLaunchKernelGGL(chk_kernel, dim3(1024), dim3(256), 0, stream, (const unsigned*)(e.off == (size_t)-1 ? (char*)d_out : (char*)d_ws + e.off), e.bytes / 4, chk + run * 32 + (int)(&e - ents)); }
    hipLaunchKernelGGL(report_kernel, dim3(1024), dim3(256), 0, stream, (const unsigned long long*)chk, (float*)d_out, out_size);
#else
    for (int p = 0; p < NPH; ++p) { a.ph_lo = p; a.ph_hi = p + 1; hipLaunchKernelGGL(fwd_kernel, dim3(grid), dim3(NTHR), LDS_BYTES, stream, a); }
#endif
#endif
}
```

```cpp
#include <hip/hip_runtime.h>
#include <cstdio>
#include <cstdint>
#define MK_SINGLE 1
namespace pg8 {
#define PG8_LAS __attribute__((address_space(3)))
typedef unsigned short bf16_t;
typedef short bf16x8 __attribute__((ext_vector_type(8)));
typedef float f32x4 __attribute__((ext_vector_type(4)));
typedef unsigned u32x4 __attribute__((ext_vector_type(4)));
constexpr int BM = 256, BK = 64, HALF = 128, HTB = HALF * BK * 2  , STAGE_BYTES = 8 * HTB, NXCD = 8, WGM = 8;

__host__ __device__ __forceinline__ int lds_byte(int r, int c) { const int st = (r >> 4) * 2 + (c >> 5), rr = r & 15, cc = c & 31, ob = rr * 64 + cc * 2; return st * 1024 + (ob ^ (((ob >> 9) & 1) << 5)); }
__host__ __device__ __forceinline__ void stage_rc(int b, int& R, int& C) { const int st = b / 1024, sb = b % 1024, swz = sb ^ (((sb >> 9) & 1) << 5); R = (st >> 1) * 16 + swz / 64; C = (st & 1) * 32 + (swz % 64) / 2; }
__host__ __device__ __forceinline__ int perm32(int rho) { const int n = rho >> 4, i = rho & 15; return 8 * (i >> 2) + 4 * n + (i & 3); }

struct Unit { int pm, pn; };
struct Gemm { const bf16_t* A; const bf16_t* Bt; int M, N, K; };

struct StaticOrder {
    int nM, nN, nwg, G, c;
    __host__ __device__ void init(int M, int N, int G_, int c_) { nM = M / BM; nN = N / BM; nwg = nM * nN; G = G_; c = c_; }
    __host__ __device__ bool next(int i, Unit& u) const {
        const long L = (long)i * G + c; if (L >= nwg) return false;
        int wgid = (int)L; { const int q = nwg / NXCD, r = nwg % NXCD, xcd = wgid % NXCD, off = wgid / NXCD; wgid = (xcd < r ? xcd * (q + 1) : r * (q + 1) + (xcd - r) * q) + off; }
        const int nig = WGM * nN, gid = wgid / nig, fm = gid * WGM, gsz = (nM - fm) < WGM ? (nM - fm) : WGM;
        u.pm = fm + ((wgid % nig) % gsz); u.pn = (wgid % nig) / gsz; return true;
    }
    __device__ __forceinline__ void a_ready(const Unit&) const {}
    __device__ __forceinline__ void done(const Unit&) const {}
};

__device__ __forceinline__ unsigned cvt_pk_bf16(float lo, float hi) { unsigned r; asm volatile("v_cvt_pk_bf16_f32 %0, %1, %2" : "=v"(r) : "v"(lo), "v"(hi)); return r; }
__device__ __forceinline__ int lane_now_() { int l; asm volatile("v_mbcnt_lo_u32_b32 %0, -1, 0\n\tv_mbcnt_hi_u32_b32 %0, -1, %0" : "=v"(l)); return l; }
__device__ __forceinline__ int tid_hw_(PG8_LAS unsigned char* lds) { const int w = ((volatile PG8_LAS int*)(lds + (144 * 1024 - 512)))[(unsigned)__builtin_amdgcn_s_getreg((5 << 11) | 4)]; return (w << 6) | lane_now_(); }
typedef int v4i32 __attribute__((ext_vector_type(4)));
typedef int v8i32 __attribute__((ext_vector_type(8)));
template <class Epi, class Sched, bool ALIGN_EPI = false, bool SP2 = false, bool F8 = false>
__device__ __forceinline__ void gemm_phase(PG8_LAS unsigned char* lds, const Gemm g, const Sched& S, const Epi& E) {
    const int tid = F8 ? tid_hw_(lds) : (int)threadIdx.x, wid = __builtin_amdgcn_readfirstlane(tid >> 6), lane = tid & 63, wr = wid >> 2, wc = wid & 3, fr = lane & 15, fq = lane >> 4;
    const int K = g.K, nt = K / BK;
    unsigned voffA[2], voffB[2];
#pragma unroll
    for (int i = 0; i < 2; ++i) { int R, C; stage_rc(tid * 16 + i * 8192, R, C); const int Rb = Epi::PERM ? ((R & ~31) + perm32(R & 31)) : R;
        voffA[i] = (unsigned)(R * K + C) * 2u; voffB[i] = (unsigned)(Rb * K + C) * 2u; }
    const size_t kstep = (size_t)(BK * 2);
    const size_t hstep = (size_t)HALF * K * 2;
    const size_t tstep = 2 * hstep;
    const unsigned ldsw = (unsigned)wid * 1024u;
    const int aoff = lds_byte(wr * 64 + fr, fq * 8), boff = lds_byte(wc * 32 + fr, fq * 8);
#define PG8_SA(b, h) (((b) * 2 + (h)) * HTB)
#define PG8_SB(b, h) ((4 + (b) * 2 + (h)) * HTB)
#define PG8_STAGE(bufoff, gbase, voff) do { _Pragma("unroll") for (int _i = 0; _i < 2; ++_i) \
        __builtin_amdgcn_global_load_lds((const unsigned*)((const char*)(gbase) + (voff)[_i]), (PG8_LAS unsigned*)(lds + (bufoff) + ldsw + _i * 8192), 16, 0, 0); } while (0)
#define PG8_LDA(dst, b, h) do { if constexpr (F8) { _Pragma("unroll") for (int m = 0; m < 4; ++m) dst##8[m] = __builtin_shufflevector(*(const PG8_LAS v4i32*)(lds + PG8_SA(b, h) + aoff + m * 2048), *(const PG8_LAS v4i32*)(lds + PG8_SA(b, h) + aoff + m * 2048 + 1024), 0, 1, 2, 3, 4, 5, 6, 7); } \
        else { _Pragma("unroll") for (int m = 0; m < 4; ++m) _Pragma("unroll") for (int k = 0; k < 2; ++k) dst[m][k] = *(const PG8_LAS bf16x8*)(lds + PG8_SA(b, h) + aoff + m * 2048 + k * 1024); } } while (0)
#define PG8_LDB(dst, b, h) do { if constexpr (F8) { _Pragma("unroll") for (int n = 0; n < 2; ++n) dst##8[n] = __builtin_shufflevector(*(const PG8_LAS v4i32*)(lds + PG8_SB(b, h) + boff + n * 2048), *(const PG8_LAS v4i32*)(lds + PG8_SB(b, h) + boff + n * 2048 + 1024), 0, 1, 2, 3, 4, 5, 6, 7); } \
        else { _Pragma("unroll") for (int n = 0; n < 2; ++n) _Pragma("unroll") for (int k = 0; k < 2; ++k) dst[n][k] = *(const PG8_LAS bf16x8*)(lds + PG8_SB(b, h) + boff + n * 2048 + k * 1024); } } while (0)
#define PG8_CAT8(x0, x1) __builtin_shufflevector(__builtin_bit_cast(v4i32, x0), __builtin_bit_cast(v4i32, x1), 0, 1, 2, 3, 4, 5, 6, 7)
#define PG8_MMA(ai, bj, At, Bt) do { __builtin_amdgcn_s_setprio(1); \
        if constexpr (F8) { _Pragma("unroll") for (int m = 0; m < 4; ++m) _Pragma("unroll") for (int n = 0; n < 2; ++n) \
            acc[ai][bj][m][n] = __builtin_amdgcn_mfma_scale_f32_16x16x128_f8f6f4(Bt##8[n], At##8[m], acc[ai][bj][m][n], 0, 0, 0, 0, 0, 0); } \
        else { _Pragma("unroll") for (int m = 0; m < 4; ++m) _Pragma("unroll") for (int n = 0; n < 2; ++n) _Pragma("unroll") for (int k = 0; k < 2; ++k) \
            acc[ai][bj][m][n] = __builtin_amdgcn_mfma_f32_16x16x32_bf16(Bt[n][k], At[m][k], acc[ai][bj][m][n], 0, 0, 0); } \
        __builtin_amdgcn_s_setprio(0); } while (0)
#define PG8_WAIT_V(n) asm volatile("s_waitcnt vmcnt(" #n ")" ::: "memory")
#define PG8_WAIT_L(n) asm volatile("s_waitcnt lgkmcnt(" #n ")" ::: "memory")
#define PG8_BAR __builtin_amdgcn_s_barrier()
#define PG8_SCHED __builtin_amdgcn_sched_barrier(0)
    Unit cur, nxt; int ui = 0;
    if (!S.next(0, cur)) return;
    f32x4 acc[2][2][4][2];
#pragma unroll
    for (int a = 0; a < 2; ++a)
#pragma unroll
        for (int b = 0; b < 2; ++b)
#pragma unroll
            for (int m = 0; m < 4; ++m)
#pragma unroll
                for (int n = 0; n < 2; ++n) acc[a][b][m][n] = (f32x4){0.f, 0.f, 0.f, 0.f};
    bf16x8 At[4][2], B0[2][2], B1[2][2]; v8i32 At8[4], B08[2], B18[2];
    const char* cA = (const char*)g.A + (size_t)cur.pm * tstep; const char* cB = (const char*)g.Bt + (size_t)cur.pn * tstep;
    S.a_ready(cur);
    if constexpr (SP2) {
        PG8_STAGE(PG8_SB(0, 0), cB, voffB); PG8_STAGE(PG8_SB(0, 1), cB + hstep, voffB); PG8_STAGE(PG8_SA(0, 0), cA, voffA); PG8_STAGE(PG8_SA(0, 1), cA + hstep, voffA);
        if (wr == 1) PG8_BAR;
        PG8_WAIT_V(2); PG8_BAR;
        PG8_STAGE(PG8_SB(1, 0), cB + kstep, voffB); PG8_STAGE(PG8_SA(1, 0), cA + kstep, voffA); PG8_STAGE(PG8_SB(1, 1), cB + hstep + kstep, voffB);
        PG8_WAIT_V(6); PG8_BAR;
    } else {
        PG8_STAGE(PG8_SB(0, 0), cB, voffB); PG8_STAGE(PG8_SA(0, 0), cA, voffA); PG8_STAGE(PG8_SB(0, 1), cB + hstep, voffB); PG8_STAGE(PG8_SA(0, 1), cA + hstep, voffA);
        if (wr == 1) PG8_BAR;
        PG8_WAIT_V(4); PG8_BAR;
        PG8_STAGE(PG8_SB(1, 0), cB + kstep, voffB); PG8_STAGE(PG8_SA(1, 0), cA + kstep, voffA); PG8_STAGE(PG8_SB(1, 1), cB + hstep + kstep, voffB);
        PG8_WAIT_V(6); PG8_BAR;
    }
    for (;;) {
        const bool has_next = S.next(ui + 1, nxt);
        const char* nA = has_next ? (const char*)g.A + (size_t)nxt.pm * tstep : cA; const char* nB = has_next ? (const char*)g.Bt + (size_t)nxt.pn * tstep : cB;
#pragma nounroll
        for (int t = 0; t < nt; t += 2) {
            const bool last = (t == nt - 2);
            const char* a1 = cA + (size_t)(t + 1) * kstep;
            const char* a2 = last ? nA : cA + (size_t)(t + 2) * kstep; const char* b2 = last ? nB : cB + (size_t)(t + 2) * kstep;
            const char* a3 = a2 + kstep; const char* b3 = b2 + kstep;
            if constexpr (F8) { asm volatile("" : "+s"(a1), "+s"(a2), "+s"(b2), "+s"(a3), "+s"(b3)); }
            if (last && has_next) S.a_ready(nxt);
            if constexpr (SP2) {
            PG8_LDB(B0, 0, 0); PG8_LDB(B1, 0, 1); PG8_SCHED; PG8_LDA(At, 0, 0); PG8_STAGE(PG8_SA(1, 1), a1 + hstep, voffA);
            PG8_WAIT_V(8); PG8_WAIT_L(0); PG8_BAR; PG8_MMA(0, 0, At, B0); PG8_MMA(0, 1, At, B1); PG8_BAR; PG8_SCHED;
            PG8_LDA(At, 0, 1); PG8_STAGE(PG8_SB(0, 0), b2, voffB); PG8_STAGE(PG8_SB(0, 1), b2 + hstep, voffB); PG8_STAGE(PG8_SA(0, 0), a2, voffA);
            PG8_WAIT_V(8); PG8_WAIT_L(0); PG8_BAR; PG8_MMA(1, 0, At, B0); PG8_MMA(1, 1, At, B1); PG8_BAR; PG8_SCHED;
            PG8_LDB(B0, 1, 0); PG8_LDB(B1, 1, 1); PG8_SCHED; PG8_LDA(At, 1, 0); PG8_STAGE(PG8_SA(0, 1), a2 + hstep, voffA);
            PG8_WAIT_V(8); PG8_WAIT_L(0); PG8_BAR; PG8_MMA(0, 0, At, B0); PG8_MMA(0, 1, At, B1); PG8_BAR; PG8_SCHED;
            PG8_LDA(At, 1, 1); PG8_STAGE(PG8_SB(1, 0), b3, voffB); PG8_STAGE(PG8_SB(1, 1), b3 + hstep, voffB); PG8_STAGE(PG8_SA(1, 0), a3, voffA);
            PG8_WAIT_V(8); PG8_WAIT_L(0); PG8_BAR; PG8_MMA(1, 0, At, B0); PG8_MMA(1, 1, At, B1); PG8_BAR; PG8_SCHED;
            } else {
            PG8_LDB(B0, 0, 0); PG8_SCHED; PG8_LDA(At, 0, 0); PG8_STAGE(PG8_SA(1, 1), a1 + hstep, voffA);
            PG8_WAIT_L(8); PG8_BAR; PG8_WAIT_L(0); PG8_MMA(0, 0, At, B0); PG8_BAR; PG8_SCHED;
            PG8_LDB(B1, 0, 1); PG8_STAGE(PG8_SB(0, 0), b2, voffB);
            PG8_BAR; PG8_WAIT_L(0); PG8_MMA(0, 1, At, B1); PG8_BAR;
            PG8_LDA(At, 0, 1); PG8_STAGE(PG8_SA(0, 0), a2, voffA);
            PG8_BAR; PG8_WAIT_L(0); PG8_MMA(1, 0, At, B0); PG8_BAR; PG8_SCHED;
            PG8_STAGE(PG8_SB(0, 1), b2 + hstep, voffB);
            PG8_WAIT_V(6); PG8_BAR; PG8_MMA(1, 1, At, B1); PG8_BAR;
            PG8_LDB(B0, 1, 0); PG8_SCHED; PG8_LDA(At, 1, 0); PG8_STAGE(PG8_SA(0, 1), a2 + hstep, voffA);
            PG8_WAIT_L(8); PG8_BAR; PG8_WAIT_L(0); PG8_MMA(0, 0, At, B0); PG8_BAR; PG8_SCHED;
            PG8_LDB(B1, 1, 1); PG8_STAGE(PG8_SB(1, 0), b3, voffB);
            PG8_BAR; PG8_WAIT_L(0); PG8_MMA(0, 1, At, B1); PG8_BAR;
            PG8_LDA(At, 1, 1); PG8_STAGE(PG8_SA(1, 0), a3, voffA);
            PG8_BAR; PG8_WAIT_L(0); PG8_MMA(1, 0, At, B0); PG8_BAR; PG8_SCHED;
            PG8_STAGE(PG8_SB(1, 1), b3 + hstep, voffB);
            PG8_WAIT_V(6); PG8_BAR; PG8_MMA(1, 1, At, B1); PG8_BAR;
            }
        }
        if constexpr (ALIGN_EPI) { if (wr == 0) PG8_BAR; }
        if constexpr (!Epi::AFTER_DRAIN) { E(acc, cur, wr, wc, fr, fq); S.done(cur); }
        if (!has_next) break;
#pragma unroll
        for (int a = 0; a < 2; ++a)
#pragma unroll
            for (int b = 0; b < 2; ++b)
#pragma unroll
                for (int m = 0; m < 4; ++m)
#pragma unroll
                    for (int n = 0; n < 2; ++n) acc[a][b][m][n] = (f32x4){0.f, 0.f, 0.f, 0.f};
        cur = nxt; cA = nA; cB = nB; ++ui;
        if constexpr (ALIGN_EPI) { if (wr == 1) PG8_BAR; }
    }
    PG8_WAIT_V(0);
    if constexpr (!ALIGN_EPI) { if (wr == 0) PG8_BAR; }
    PG8_BAR;
    if constexpr (Epi::AFTER_DRAIN) { E.fused(acc, cur, wr, wc, fr, fq, lds, wid, lane); S.done(cur); }
#undef PG8_SA
#undef PG8_SB
#undef PG8_STAGE
#undef PG8_LDA
#undef PG8_LDB
#undef PG8_MMA
#undef PG8_CAT8
#undef PG8_WAIT_V
#undef PG8_WAIT_L
#undef PG8_BAR
#undef PG8_SCHED
}
}
namespace pg8 {
template <class Epi, class Sched, bool ALIGN_EPI = false, bool SP2 = false, bool F8 = false>
__device__ __forceinline__ void gemm_phase_gather(PG8_LAS unsigned char* lds, const Gemm g, const Sched& S, const Epi& E, const int* __restrict__ idx) {
    const int tid = F8 ? tid_hw_(lds) : (int)threadIdx.x, wid = __builtin_amdgcn_readfirstlane(tid >> 6), lane = tid & 63, wr = wid >> 2, wc = wid & 3, fr = lane & 15, fq = lane >> 4;
    const int K = g.K, nt = K / BK;
    unsigned voffB[2]; int R0 = 0; unsigned C02 = 0u;
#pragma unroll
    for (int i = 0; i < 2; ++i) { int R, C; stage_rc(tid * 16 + i * 8192, R, C); const int Rb = Epi::PERM ? ((R & ~31) + perm32(R & 31)) : R;
        if (i == 0) { R0 = R; C02 = (unsigned)C * 2u; } voffB[i] = (unsigned)(Rb * K + C) * 2u; }
    struct PackOff { unsigned p, k2, c02; __device__ __forceinline__ unsigned operator[](int i) const { return (i ? (p >> 16) : (p & 0xffffu)) * k2 + c02; } };
    PackOff vA[2], nvA[2];
    vA[0].k2 = vA[1].k2 = nvA[0].k2 = nvA[1].k2 = (unsigned)K * 2u; vA[0].c02 = vA[1].c02 = nvA[0].c02 = nvA[1].c02 = C02; vA[0].p = vA[1].p = nvA[0].p = nvA[1].p = 0u;
#define PG8_GOFF(dst, pm) do { int _R0 = R0; if constexpr (F8) { int _c; stage_rc(tid_hw_(lds) * 16, _R0, _c); } _Pragma("unroll") for (int _h = 0; _h < 2; ++_h) { const int _r0 = (pm) * 256 + _h * 128 + _R0, _r1 = _r0 + 64; \
        dst[_h].p = (unsigned)(((_r0 >> 9) & 3) * 4096 + idx[_r0]) | ((unsigned)(((_r1 >> 9) & 3) * 4096 + idx[_r1]) << 16); } } while (0)
    const size_t kstep = (size_t)(BK * 2);
    const size_t hstep = (size_t)HALF * K * 2;
    const size_t tstep = 2 * hstep;
    const unsigned ldsw = (unsigned)wid * 1024u;
    const int aoff = lds_byte(wr * 64 + fr, fq * 8), boff = lds_byte(wc * 32 + fr, fq * 8);
#define PG8_SA(b, h) (((b) * 2 + (h)) * HTB)
#define PG8_SB(b, h) ((4 + (b) * 2 + (h)) * HTB)
#define PG8_STAGE(bufoff, gbase, voff) do { _Pragma("unroll") for (int _i = 0; _i < 2; ++_i) \
        __builtin_amdgcn_global_load_lds((const unsigned*)((const char*)(gbase) + (voff)[_i]), (PG8_LAS unsigned*)(lds + (bufoff) + ldsw + _i * 8192), 16, 0, 0); } while (0)
#define PG8_LDA(dst, b, h) do { if constexpr (F8) { _Pragma("unroll") for (int m = 0; m < 4; ++m) dst##8[m] = __builtin_shufflevector(*(const PG8_LAS v4i32*)(lds + PG8_SA(b, h) + aoff + m * 2048), *(const PG8_LAS v4i32*)(lds + PG8_SA(b, h) + aoff + m * 2048 + 1024), 0, 1, 2, 3, 4, 5, 6, 7); } \
        else { _Pragma("unroll") for (int m = 0; m < 4; ++m) _Pragma("unroll") for (int k = 0; k < 2; ++k) dst[m][k] = *(const PG8_LAS bf16x8*)(lds + PG8_SA(b, h) + aoff + m * 2048 + k * 1024); } } while (0)
#define PG8_LDB(dst, b, h) do { if constexpr (F8) { _Pragma("unroll") for (int n = 0; n < 2; ++n) dst##8[n] = __builtin_shufflevector(*(const PG8_LAS v4i32*)(lds + PG8_SB(b, h) + boff + n * 2048), *(const PG8_LAS v4i32*)(lds + PG8_SB(b, h) + boff + n * 2048 + 1024), 0, 1, 2, 3, 4, 5, 6, 7); } \
        else { _Pragma("unroll") for (int n = 0; n < 2; ++n) _Pragma("unroll") for (int k = 0; k < 2; ++k) dst[n][k] = *(const PG8_LAS bf16x8*)(lds + PG8_SB(b, h) + boff + n * 2048 + k * 1024); } } while (0)
#define PG8_CAT8(x0, x1) __builtin_shufflevector(__builtin_bit_cast(v4i32, x0), __builtin_bit_cast(v4i32, x1), 0, 1, 2, 3, 4, 5, 6, 7)
#define PG8_MMA(ai, bj, At, Bt) do { __builtin_amdgcn_s_setprio(1); \
        if constexpr (F8) { _Pragma("unroll") for (int m = 0; m < 4; ++m) _Pragma("unroll") for (int n = 0; n < 2; ++n) \
            acc[ai][bj][m][n] = __builtin_amdgcn_mfma_scale_f32_16x16x128_f8f6f4(Bt##8[n], At##8[m], acc[ai][bj][m][n], 0, 0, 0, 0, 0, 0); } \
        else { _Pragma("unroll") for (int m = 0; m < 4; ++m) _Pragma("unroll") for (int n = 0; n < 2; ++n) _Pragma("unroll") for (int k = 0; k < 2; ++k) \
            acc[ai][bj][m][n] = __builtin_amdgcn_mfma_f32_16x16x32_bf16(Bt[n][k], At[m][k], acc[ai][bj][m][n], 0, 0, 0); } \
        __builtin_amdgcn_s_setprio(0); } while (0)
#define PG8_WAIT_V(n) asm volatile("s_waitcnt vmcnt(" #n ")" ::: "memory")
#define PG8_WAIT_L(n) asm volatile("s_waitcnt lgkmcnt(" #n ")" ::: "memory")
#define PG8_BAR __builtin_amdgcn_s_barrier()
#define PG8_SCHED __builtin_amdgcn_sched_barrier(0)
    Unit cur, nxt; int ui = 0;
    if (!S.next(0, cur)) return;
    f32x4 acc[2][2][4][2];
#pragma unroll
    for (int a = 0; a < 2; ++a)
#pragma unroll
        for (int b = 0; b < 2; ++b)
#pragma unroll
            for (int m = 0; m < 4; ++m)
#pragma unroll
                for (int n = 0; n < 2; ++n) acc[a][b][m][n] = (f32x4){0.f, 0.f, 0.f, 0.f};
    bf16x8 At[4][2], B0[2][2], B1[2][2]; v8i32 At8[4], B08[2], B18[2];
    const char* cA = (const char*)g.A; PG8_GOFF(vA, cur.pm); const char* cB = (const char*)g.Bt + (size_t)cur.pn * tstep;
    S.a_ready(cur);
    if constexpr (SP2) {
        PG8_STAGE(PG8_SB(0, 0), cB, voffB); PG8_STAGE(PG8_SB(0, 1), cB + hstep, voffB); PG8_STAGE(PG8_SA(0, 0), cA, vA[0]); PG8_STAGE(PG8_SA(0, 1), cA, vA[1]);
        if (wr == 1) PG8_BAR;
        PG8_WAIT_V(2); PG8_BAR;
        PG8_STAGE(PG8_SB(1, 0), cB + kstep, voffB); PG8_STAGE(PG8_SA(1, 0), cA + kstep, vA[0]); PG8_STAGE(PG8_SB(1, 1), cB + hstep + kstep, voffB);
        PG8_WAIT_V(6); PG8_BAR;
    } else {
        PG8_STAGE(PG8_SB(0, 0), cB, voffB); PG8_STAGE(PG8_SA(0, 0), cA, vA[0]); PG8_STAGE(PG8_SB(0, 1), cB + hstep, voffB); PG8_STAGE(PG8_SA(0, 1), cA, vA[1]);
        if (wr == 1) PG8_BAR;
        PG8_WAIT_V(4); PG8_BAR;
        PG8_STAGE(PG8_SB(1, 0), cB + kstep, voffB); PG8_STAGE(PG8_SA(1, 0), cA + kstep, vA[0]); PG8_STAGE(PG8_SB(1, 1), cB + hstep + kstep, voffB);
        PG8_WAIT_V(6); PG8_BAR;
    }
    for (;;) {
        const bool has_next = S.next(ui + 1, nxt);
        if (has_next) { PG8_GOFF(nvA, nxt.pm); } else { nvA[0].p = vA[0].p; nvA[1].p = vA[1].p; } const char* nB = has_next ? (const char*)g.Bt + (size_t)nxt.pn * tstep : cB;
#pragma nounroll
        for (int t = 0; t < nt; t += 2) {
            const bool last = (t == nt - 2);
            const char* a1 = cA + (size_t)(t + 1) * kstep;
            const char* a2 = cA + (last ? (size_t)0 : (size_t)(t + 2) * kstep); PackOff w2[2]; w2[0] = vA[0]; w2[1] = vA[1]; w2[0].p = last ? nvA[0].p : vA[0].p; w2[1].p = last ? nvA[1].p : vA[1].p; const char* b2 = last ? nB : cB + (size_t)(t + 2) * kstep;
            const char* a3 = a2 + kstep; const char* b3 = b2 + kstep;
            if constexpr (F8) { asm volatile("" : "+s"(a1), "+s"(a2), "+s"(b2), "+s"(a3), "+s"(b3)); }
            if (last && has_next) S.a_ready(nxt);
            if constexpr (SP2) {
            PG8_LDB(B0, 0, 0); PG8_LDB(B1, 0, 1); PG8_SCHED; PG8_LDA(At, 0, 0); PG8_STAGE(PG8_SA(1, 1), a1, vA[1]);
            PG8_WAIT_V(8); PG8_WAIT_L(0); PG8_BAR; PG8_MMA(0, 0, At, B0); PG8_MMA(0, 1, At, B1); PG8_BAR; PG8_SCHED;
            PG8_LDA(At, 0, 1); PG8_STAGE(PG8_SB(0, 0), b2, voffB); PG8_STAGE(PG8_SB(0, 1), b2 + hstep, voffB); PG8_STAGE(PG8_SA(0, 0), a2, w2[0]);
            PG8_WAIT_V(8); PG8_WAIT_L(0); PG8_BAR; PG8_MMA(1, 0, At, B0); PG8_MMA(1, 1, At, B1); PG8_BAR; PG8_SCHED;
            PG8_LDB(B0, 1, 0); PG8_LDB(B1, 1, 1); PG8_SCHED; PG8_LDA(At, 1, 0); PG8_STAGE(PG8_SA(0, 1), a2, w2[1]);
            PG8_WAIT_V(8); PG8_WAIT_L(0); PG8_BAR; PG8_MMA(0, 0, At, B0); PG8_MMA(0, 1, At, B1); PG8_BAR; PG8_SCHED;
            PG8_LDA(At, 1, 1); PG8_STAGE(PG8_SB(1, 0), b3, voffB); PG8_STAGE(PG8_SB(1, 1), b3 + hstep, voffB); PG8_STAGE(PG8_SA(1, 0), a3, w2[0]);
            PG8_WAIT_V(8); PG8_WAIT_L(0); PG8_BAR; PG8_MMA(1, 0, At, B0); PG8_MMA(1, 1, At, B1); PG8_BAR; PG8_SCHED;
            } else {
            PG8_LDB(B0, 0, 0); PG8_SCHED; PG8_LDA(At, 0, 0); PG8_STAGE(PG8_SA(1, 1), a1, vA[1]);
            PG8_WAIT_L(8); PG8_BAR; PG8_WAIT_L(0); PG8_MMA(0, 0, At, B0); PG8_BAR; PG8_SCHED;
            PG8_LDB(B1, 0, 1); PG8_STAGE(PG8_SB(0, 0), b2, voffB);
            PG8_BAR; PG8_WAIT_L(0); PG8_MMA(0, 1, At, B1); PG8_BAR;
            PG8_LDA(At, 0, 1); PG8_STAGE(PG8_SA(0, 0), a2, w2[0]);
            PG8_BAR; PG8_WAIT_L(0); PG8_MMA(1, 0, At, B0); PG8_BAR; PG8_SCHED;
            PG8_STAGE(PG8_SB(0, 1), b2 + hstep, voffB);
            PG8_WAIT_V(6); PG8_BAR; PG8_MMA(1, 1, At, B1); PG8_BAR;
            PG8_LDB(B0, 1, 0); PG8_SCHED; PG8_LDA(At, 1, 0); PG8_STAGE(PG8_SA(0, 1), a2, w2[1]);
            PG8_WAIT_L(8); PG8_BAR; PG8_WAIT_L(0); PG8_MMA(0, 0, At, B0); PG8_BAR; PG8_SCHED;
            PG8_LDB(B1, 1, 1); PG8_STAGE(PG8_SB(1, 0), b3, voffB);
            PG8_BAR; PG8_WAIT_L(0); PG8_MMA(0, 1, At, B1); PG8_BAR;
            PG8_LDA(At, 1, 1); PG8_STAGE(PG8_SA(1, 0), a3, w2[0]);
            PG8_BAR; PG8_WAIT_L(0); PG8_MMA(1, 0, At, B0); PG8_BAR; PG8_SCHED;
            PG8_STAGE(PG8_SB(1, 1), b3 + hstep, voffB);
            PG8_WAIT_V(6); PG8_BAR; PG8_MMA(1, 1, At, B1); PG8_BAR;
            }
        }
        if constexpr (ALIGN_EPI) { if (wr == 0) PG8_BAR; }
        if constexpr (!Epi::AFTER_DRAIN) { E(acc, cur, wr, wc, fr, fq); S.done(cur); }
        if (!has_next) break;
#pragma unroll
        for (int a = 0; a < 2; ++a)
#pragma unroll
            for (int b = 0; b < 2; ++b)
#pragma unroll
                for (int m = 0; m < 4; ++m)
#pragma unroll
                    for (int n = 0; n < 2; ++n) acc[a][b][m][n] = (f32x4){0.f, 0.f, 0.f, 0.f};
        cur = nxt; cB = nB; ++ui; vA[0].p = nvA[0].p; vA[1].p = nvA[1].p;
        if constexpr (ALIGN_EPI) { if (wr == 1) PG8_BAR; }
    }
    PG8_WAIT_V(0);
    if constexpr (!ALIGN_EPI) { if (wr == 0) PG8_BAR; }
    PG8_BAR;
    if constexpr (Epi::AFTER_DRAIN) { E.fused(acc, cur, wr, wc, fr, fq, lds, wid, lane); S.done(cur); }
#undef PG8_SA
#undef PG8_SB
#undef PG8_STAGE
#undef PG8_LDA
#undef PG8_LDB
#undef PG8_MMA
#undef PG8_CAT8
#undef PG8_WAIT_V
#undef PG8_WAIT_L
#undef PG8_BAR
#undef PG8_SCHED
#undef PG8_GOFF
}
}

#ifndef DBG_NOMIX
#define DBG_NOMIX 0
#endif
#ifndef DBG_NOMOE
#define DBG_NOMOE 0
#endif
#ifndef DBG_NOPOS
#define DBG_NOPOS 0
#endif
#ifndef DBG_HTCONST
#define DBG_HTCONST 0
#endif
#ifndef DBG_GLA_K
#define DBG_GLA_K 1.0f
#endif
#ifndef DBG_MOE_K
#define DBG_MOE_K 1.0f
#endif
#ifndef MK_SINGLE
#define MK_SINGLE 0
#endif
#define GAS __attribute__((address_space(1)))
#define LAS __attribute__((address_space(3)))
typedef unsigned short bf16;
typedef float f32x4 __attribute__((ext_vector_type(4)));
typedef float f32x16 __attribute__((ext_vector_type(16)));
typedef short bf16x8 __attribute__((ext_vector_type(8)));
typedef unsigned v4u __attribute__((ext_vector_type(4)));
typedef unsigned v2u __attribute__((ext_vector_type(2)));
typedef GAS unsigned gu32;

constexpr int NWAVES = 8, NTHR = 512;
constexpr int NB = 4, SEQ = 4096, DM = 1024, CTXL = 256;
constexpr int MX = NB * SEQ, MC = NB * CTXL, MT = MX + MC;
constexpr int NIN = 3328, NQ = 1536, DIN = 3104;
constexpr int NE = 16, CAP = 512;
constexpr int NCH = 68;
constexpr int NPH = 12;
constexpr float EPS = 1e-6f;

constexpr size_t MiB = 1u << 20;
constexpr size_t WS_CTL = 0, CTL_BYTES = 65536;
constexpr int CW_CNT_D = 8192, CW_CNT_GU = 8192 + 64;
constexpr size_t WS_MOD = 1 * MiB, WS_POS = 1 * MiB + 256 * 1024, WS_DEC = 2 * MiB, WS_AFF = 3 * MiB, WS_SLOT = 4 * MiB, WS_SELT = 5 * MiB, WS_SELV = 5 * MiB + 256 * 1024;
constexpr size_t WS_UCTX = 6 * MiB, WS_AFB = 10 * MiB, WS_WIN = 13 * MiB, WS_WOUT = 20 * MiB;
constexpr size_t WS_R1 = 22 * MiB, WS_R2 = 56 * MiB, WS_R3 = 107 * MiB, WS_R4 = 203 * MiB, WS_R5 = 235 * MiB, WS_R6 = 267 * MiB, WS_END = 299 * MiB;
constexpr size_t WS_AIN = WS_R1, WS_ZT = 155 * MiB, WS_HN = WS_R1;
constexpr size_t WS_QKVG = WS_R2;
constexpr size_t WS_HYT = WS_R3, WS_WD = 171 * MiB;
constexpr size_t WS_WGU = WS_R5;
constexpr size_t WS_HID = WS_R2, WS_YSLAB = WS_R4;
constexpr size_t WS_HT = WS_R4, WS_AOUT = WS_R4;
constexpr size_t WS_HNG = 203 * MiB;
constexpr size_t WS_X1B = 120 * MiB;
constexpr size_t WS_SPREV = WS_R1;
constexpr int LDS_BYTES = 144 * 1024;
constexpr int LDS_MISC = LDS_BYTES - 256;
constexpr int LDS_MAP = LDS_BYTES - 512;

struct Args { const float* in[29]; float* out; unsigned char* ws; int ph_lo, ph_hi; };

#define LDS_WAIT() asm volatile("s_waitcnt lgkmcnt(0)" ::: "memory")
#define VM_WAIT() asm volatile("s_waitcnt vmcnt(0)" ::: "memory")
__device__ __forceinline__ unsigned f2bf(float f) { unsigned u = __float_as_uint(f); return (u + 0x7fffu + ((u >> 16) & 1u)) >> 16; }
__device__ __forceinline__ unsigned pk2(float lo, float hi) { return pg8::cvt_pk_bf16(lo, hi); }
__device__ __forceinline__ unsigned pk_fp8x4(float a, float b, float c, float d) { unsigned w = 0u; w = (unsigned)__builtin_amdgcn_cvt_pk_fp8_f32(a, b, (int)w, false); w = (unsigned)__builtin_amdgcn_cvt_pk_fp8_f32(c, d, (int)w, true); return w; }
constexpr float F8_YSCALE = 64.0f;
constexpr float F8_WSCALE = 32.0f, F8_HSCALE = 8.0f;
__device__ __forceinline__ int lane_now() { int l; asm volatile("v_mbcnt_lo_u32_b32 %0, -1, 0\n\tv_mbcnt_hi_u32_b32 %0, -1, %0" : "=v"(l)); return l; }
__device__ __forceinline__ unsigned hw_wave_key() { return (unsigned)__builtin_amdgcn_s_getreg((5 << 11) | 4); }
__device__ __forceinline__ int tid_hw(LAS unsigned char* lds) { const int w = ((volatile LAS int*)(lds + LDS_MAP))[hw_wave_key()]; return (w << 6) | lane_now(); }
__device__ __forceinline__ float bflo(unsigned w) { return __uint_as_float(w << 16); }
__device__ __forceinline__ float bfhi(unsigned w) { return __uint_as_float(w & 0xffff0000u); }
template <int CTRL> __device__ __forceinline__ float dpp_f(float v) { return __builtin_bit_cast(float, __builtin_amdgcn_update_dpp(0, __builtin_bit_cast(int, v), CTRL, 0xf, 0xf, false)); }
__device__ __forceinline__ void swap16(float& a, float& b) { asm("v_nop\n\tv_nop\n\tv_permlane16_swap_b32 %0, %1" : "+v"(a), "+v"(b)); }
__device__ __forceinline__ void swap32(float& a, float& b) { asm("v_nop\n\tv_nop\n\tv_permlane32_swap_b32 %0, %1" : "+v"(a), "+v"(b)); }
__device__ __forceinline__ float row_allsum(float v) { v += dpp_f<0x128>(v); v += dpp_f<0x124>(v); v += dpp_f<0x122>(v); v += dpp_f<0x121>(v); return v; }
__device__ __forceinline__ float x16_sum(float v) { float a = v, b = v; swap16(a, b); return a + b; }
__device__ __forceinline__ float x32_sum(float v) { float a = v, b = v; swap32(a, b); return a + b; }
__device__ __forceinline__ float x16_max(float v) { float a = v, b = v; swap16(a, b); return fmaxf(a, b); }
__device__ __forceinline__ float x32_max(float v) { float a = v, b = v; swap32(a, b); return fmaxf(a, b); }
__device__ __forceinline__ float wave_sum(float v) { return x32_sum(x16_sum(row_allsum(v))); }
__device__ __forceinline__ float silu_f(float v) { return v * __builtin_amdgcn_rcpf(1.f + __expf(-v)); }
__device__ __forceinline__ float logsig_f(float x) { return fminf(x, 0.f) - __logf(1.0f + __expf(-fabsf(x))); }

#define XB_TMO      128
#define XB_XCNT(j)  (256  + 64 * (j))
#define XB_XSUB(j)  (1280 + 64 * (j))
#define XB_XGEN(j)  (2304 + 64 * (j))
#define XB_TOP      3328
#define XB_TOPGEN   3392
#define XCD_BAR_WORDS 3456
#define XB_SPIN_CAP (1u << 22)
__device__ __forceinline__ unsigned xb_ld(unsigned* p)              { return __hip_atomic_load(p, __ATOMIC_RELAXED, __HIP_MEMORY_SCOPE_AGENT); }
__device__ __forceinline__ unsigned xb_add(unsigned* p, unsigned v) { return __hip_atomic_fetch_add(p, v, __ATOMIC_RELAXED, __HIP_MEMORY_SCOPE_AGENT); }
__device__ __forceinline__ unsigned xb_xcc_id() { return (unsigned)__builtin_amdgcn_s_getreg((3 << 11) | 20) & 0xFu; }
#define XB_SPIN(cond, bar) do { unsigned _sp = 0; while (cond) { __builtin_amdgcn_s_sleep(1); \
    if ((++_sp & 255u) == 0u) { if (xb_ld(&(bar)[XB_TMO])) break; if (_sp > XB_SPIN_CAP) { atomicAdd(&(bar)[XB_TMO], 1u); break; } } } } while (0)
struct XcdBarrier { unsigned* bar; unsigned x; volatile LAS unsigned* st; };
__device__ __forceinline__ XcdBarrier xcd_barrier_post(unsigned* bar, volatile LAS unsigned* st) {
    XcdBarrier b; b.bar = bar; b.x = xb_xcc_id(); b.st = st;
    if (threadIdx.x == 0) (void)xb_add(&bar[XB_XCNT(b.x)], 1u);
    return b;
}
__device__ __forceinline__ void xcd_barrier_complete(unsigned* bar, unsigned x, unsigned& nloc, unsigned& nx) {
    const unsigned G = gridDim.x * gridDim.y * gridDim.z;
    unsigned sum, cnt, mine, sp = 0u;
    for (;;) {
        sum = 0u; cnt = 0u; mine = 0u;
#pragma unroll
        for (unsigned j = 0; j < 16; ++j) { const unsigned c = xb_ld(&bar[XB_XCNT(j)]); sum += c; cnt += (c > 0u) ? 1u : 0u; mine = (j == x) ? c : mine; }
        if (sum == G) break;
        __builtin_amdgcn_s_sleep(1);
        if ((++sp & 255u) == 0u) { if (xb_ld(&bar[XB_TMO])) break; if (sp > XB_SPIN_CAP) { atomicAdd(&bar[XB_TMO], 1u); break; } }
    }
    nloc = mine > 0u ? mine : 1u; nx = cnt > 0u ? cnt : 1u;
}
__device__ __forceinline__ void xcd_barrier(const XcdBarrier& b) {
    asm volatile("s_waitcnt vmcnt(0)" ::: "memory");
    __syncthreads();
    if (threadIdx.x == 0) {
        unsigned* bar = b.bar;
        __builtin_amdgcn_s_waitcnt(0);
        unsigned nloc = b.st[0], nx = b.st[1];
        if (nloc == 0u) { xcd_barrier_complete(bar, b.x, nloc, nx); b.st[0] = nloc; b.st[1] = nx; }
        const unsigned old = xb_add(&bar[XB_XSUB(b.x)], 1u);
        const unsigned gen = old / nloc;
        if (old + 1u == (gen + 1u) * nloc) {
            __builtin_amdgcn_fence(__ATOMIC_RELEASE, "agent");
            asm volatile("s_waitcnt vmcnt(0)" ::: "memory");
            const unsigned og = xb_add(&bar[XB_TOP], 1u);
            const unsigned tg = og / nx;
            if (og + 1u == (tg + 1u) * nx) xb_add(&bar[XB_TOPGEN], 1u);
            else XB_SPIN(xb_ld(&bar[XB_TOPGEN]) == tg, bar);
            __builtin_amdgcn_fence(__ATOMIC_ACQUIRE, "agent");
            xb_add(&bar[XB_XGEN(b.x)], 1u);
            asm volatile("s_waitcnt vmcnt(0)" ::: "memory");
        } else {
            XB_SPIN(xb_ld(&bar[XB_XGEN(b.x)]) == gen, bar);
            __builtin_amdgcn_fence(__ATOMIC_ACQUIRE, "agent");
            asm volatile("s_waitcnt vmcnt(0)" ::: "memory");
        }
    }
    __syncthreads();
}

constexpr int TILE_AIN = (int)(WS_AIN / (512 * 1024)), TILE_WIN = (int)(WS_WIN / (512 * 1024));
struct InSched {
    int G, c, part;
    __device__ void init(int G_, int c_, int part_) { G = G_; c = c_; part = part_; }
    __device__ static void qg_unit(int qg, pg8::Unit& u) { const int t = qg >> 6; u.pm = TILE_AIN + (qg & 63); u.pn = TILE_WIN + ((t == 0) ? 0 : 3 + t); }
    __device__ bool next(int i, pg8::Unit& u) const {
        const int L = i * G + c;
        if (part) { const int qg = 112 + L; if (qg >= 192) return false; qg_unit(qg, u); return true; }
        if (L < 384) { u.pm = TILE_WIN + 6 + (L >> 6); u.pn = TILE_AIN + (L & 63); return true; }
        if (L < 640) { const int l = L - 384, q = l >> 6; u.pm = TILE_AIN + (l & 63); u.pn = TILE_WIN + ((q == 3) ? 12 : (1 + q)); return true; }
        if (L < 656) { const int jx = L - 640, q = jx >> 2; u.pm = TILE_AIN + 64 + (jx & 3); u.pn = TILE_WIN + ((q == 3) ? 12 : (1 + q)); return true; }
        if (L >= 768) return false;
        qg_unit(L - 656, u); return true;
    }
    __device__ __forceinline__ void a_ready(const pg8::Unit&) const {}
    __device__ __forceinline__ void done(const pg8::Unit&) const {}
};
template <int NT> struct MoeSched {
    int G, c;
    __device__ void init(int G_, int c_) { G = G_; c = c_; }
    __device__ bool next(int i, pg8::Unit& u) const {
        const int L = i * G + c; if (L >= NE * 8 * NT) return false;
        const int e = L / (8 * NT), l = L % (8 * NT), x = l & 7, y = l >> 3;
        constexpr int HN = NT / 2;
        const int pm = 2 * (x >> 1) + (y / HN), pn = HN * (x & 1) + (y % HN);
        u.pm = e * 8 + pm; u.pn = e * NT + pn; return true;
    }
    __device__ __forceinline__ void a_ready(const pg8::Unit&) const {}
    __device__ __forceinline__ void done(const pg8::Unit&) const {}
};

struct EpiIn {
    static constexpr bool PERM = true, AFTER_DRAIN = false;
    bf16* qkvg; bf16* hyT; float* afb;
    __device__ __forceinline__ void operator()(const f32x4 (&acc)[2][2][4][2], const pg8::Unit& u, int wr, int wc, int fr, int fq) const {
        if (u.pm < TILE_AIN) {
            const int ch0 = (u.pm - TILE_WIN - 6) * 256 + wr * 64 + fr, mt = u.pn - TILE_AIN, b = mt >> 4, t0 = (mt & 15) * 256 + wc * 32 + 8 * fq;
#pragma unroll
            for (int ai = 0; ai < 2; ++ai)
#pragma unroll
                for (int m = 0; m < 4; ++m) { bf16* rowp = hyT + ((size_t)b * 1536 + ch0 + ai * 128 + m * 16) * SEQ + t0;
#pragma unroll
                    for (int bj = 0; bj < 2; ++bj) { const f32x4 v0 = acc[ai][bj][m][0], v1 = acc[ai][bj][m][1];
                        v4u w; w.x = pk2(v0[0], v0[1]); w.y = pk2(v0[2], v0[3]); w.z = pk2(v1[0], v1[1]); w.w = pk2(v1[2], v1[3]);
                        *(v4u*)(rowp + bj * 128) = w; } }
            return;
        }
        const int pm = u.pm - TILE_AIN, pn = u.pn - TILE_WIN;
        const int row0 = pm * 256 + wr * 64 + fr;
        if (pn < 6) {
            const float sc = (pn == 0) ? 0.125f : 1.f;
            const int col0 = pn * 256 + wc * 32 + 8 * fq;
#pragma unroll
            for (int ai = 0; ai < 2; ++ai)
#pragma unroll
                for (int m = 0; m < 4; ++m) { bf16* rowp = qkvg + (size_t)(row0 + ai * 128 + m * 16) * NQ + col0;
#pragma unroll
                    for (int bj = 0; bj < 2; ++bj) { const f32x4 v0 = acc[ai][bj][m][0] * sc, v1 = acc[ai][bj][m][1] * sc;
                        v4u w; w.x = pk2(v0[0], v0[1]); w.y = pk2(v0[2], v0[3]); w.z = pk2(v1[0], v1[1]); w.w = pk2(v1[2], v1[3]);
                        *(v4u*)(rowp + bj * 128) = w; } }
        } else {
            if (wc != 0) return;
#pragma unroll
            for (int ai = 0; ai < 2; ++ai)
#pragma unroll
                for (int m = 0; m < 4; ++m) { float* rowp = afb + (size_t)(row0 + ai * 128 + m * 16) * 32 + 8 * fq;
                    *(f32x4*)(rowp) = acc[ai][0][m][0]; *(f32x4*)(rowp + 4) = acc[ai][0][m][1]; }
        }
    }
};
struct EpiOut {
    static constexpr bool PERM = false, AFTER_DRAIN = false;
    const float* __restrict__ x; const float* __restrict__ postab; const float* __restrict__ modr; bf16* __restrict__ x1;
    __device__ __forceinline__ void operator()(const f32x4 (&acc)[2][2][4][2], const pg8::Unit& u, int wr, int wc, int fr, int fq) const {
        const int row0 = u.pm * 256 + wr * 64 + fr, col0 = u.pn * 256 + wc * 32 + 4 * fq;
        const int b = row0 >> 12;
        f32x4 gv[2][2];
#pragma unroll
        for (int bj = 0; bj < 2; ++bj)
#pragma unroll
            for (int n = 0; n < 2; ++n) gv[bj][n] = *(const f32x4*)(modr + b * 6144 + 2048 + col0 + bj * 128 + n * 16);
        f32x4 xv[3][2][2], pv[1][2][2];
#define EPO_ROW(g) (row0 + ((g) >> 2) * 128 + ((g) & 3) * 16)
#define EPO_LDX(g) do { const int r_ = EPO_ROW(g); _Pragma("unroll") for (int bj = 0; bj < 2; ++bj) _Pragma("unroll") for (int n = 0; n < 2; ++n) xv[(g) % 3][bj][n] = *(const f32x4*)(x + (size_t)r_ * DM + col0 + bj * 128 + n * 16); } while (0)
#define EPO_LDP(g) do { const int r_ = EPO_ROW(g), t_ = r_ & 4095, rr_ = t_ >> 6, cc_ = t_ & 63; _Pragma("unroll") for (int bj = 0; bj < 2; ++bj) _Pragma("unroll") for (int n = 0; n < 2; ++n) { const int c_ = col0 + bj * 128 + n * 16; \
            pv[0][bj][n] = *(const f32x4*)(postab + ((c_ < 512) ? rr_ * 512 + c_ : cc_ * 512 + c_ - 512)); } } while (0)
        EPO_LDX(0); EPO_LDX(1);
#pragma unroll
        for (int g = 0; g < 8; ++g) { const int ai = g >> 2, m = g & 3, r = EPO_ROW(g);
            if (g + 2 < 8) EPO_LDX(g + 2);
            EPO_LDP(g);
#pragma unroll
            for (int bj = 0; bj < 2; ++bj)
#pragma unroll
                for (int n = 0; n < 2; ++n) { const int c = col0 + bj * 128 + n * 16;
                    const f32x4 y = xv[g % 3][bj][n] + (DBG_NOPOS ? pv[0][bj][n] * 0.f : pv[0][bj][n]) + (DBG_NOMIX ? gv[bj][n] * 0.f : gv[bj][n] * acc[ai][bj][m][n]);
                    v2u w; w.x = pk2(y[0], y[1]); w.y = pk2(y[2], y[3]);
                    *(v2u*)(x1 + (size_t)r * DM + c) = w; } }
#undef EPO_ROW
#undef EPO_LDX
#undef EPO_LDP
    }
};
struct EpiGU {
    static constexpr bool PERM = true, AFTER_DRAIN = false;
    unsigned char* hid;
    __device__ __forceinline__ void operator()(const f32x4 (&acc)[2][2][4][2], const pg8::Unit& u, int wr, int wc, int fr, int fq) const {
        const int ln = lane_now(); fr = ln & 15; fq = ln >> 4;
        const int row0 = u.pm * 256 + wr * 64 + fr, col0 = (u.pn & 7) * 128 + wc * 32 + 8 * fq;
        constexpr float IW = 1.0f / F8_WSCALE;
#pragma unroll
        for (int ai = 0; ai < 2; ++ai)
#pragma unroll
            for (int m = 0; m < 4; ++m) { unsigned char* rowp = hid + (size_t)(row0 + ai * 128 + m * 16) * DM + col0;
                float o[8];
#pragma unroll
                for (int n = 0; n < 2; ++n)
#pragma unroll
                    for (int j = 0; j < 4; ++j) { const float hv = silu_f(acc[ai][0][m][n][j] * IW) * (acc[ai][1][m][n][j] * (IW * F8_HSCALE)); o[n * 4 + j] = fminf(fmaxf(hv, -440.0f), 440.0f); }
                v2u w; w.x = pk_fp8x4(o[0], o[1], o[2], o[3]); w.y = pk_fp8x4(o[4], o[5], o[6], o[7]);
                *(v2u*)rowp = w; }
    }
};
struct EpiDown {
    static constexpr bool PERM = true, AFTER_DRAIN = false;
    unsigned char* __restrict__ ys; const float* __restrict__ selv;
    __device__ __forceinline__ void operator()(const f32x4 (&acc)[2][2][4][2], const pg8::Unit& u, int wr, int wc, int fr, int fq) const {
        const int ln = lane_now(); fr = ln & 15; fq = ln >> 4;
        const int row0 = u.pm * 256 + wr * 64 + fr, col0 = (u.pn & 3) * 256 + wc * 32 + 8 * fq;
#pragma unroll
        for (int ai = 0; ai < 2; ++ai)
#pragma unroll
            for (int m = 0; m < 4; ++m) { const int r = row0 + ai * 128 + m * 16; const float sc = selv[r] * (F8_YSCALE / (F8_WSCALE * F8_HSCALE)); unsigned char* rowp = ys + (size_t)r * DM + col0;
#pragma unroll
                for (int bj = 0; bj < 2; ++bj) { f32x4 v0 = acc[ai][bj][m][0] * sc, v1 = acc[ai][bj][m][1] * sc;
#pragma unroll
                    for (int q = 0; q < 4; ++q) { v0[q] = fminf(fmaxf(v0[q], -440.0f), 440.0f); v1[q] = fminf(fmaxf(v1[q], -440.0f), 440.0f); }
                    v2u w; w.x = pk_fp8x4(v0[0], v0[1], v0[2], v0[3]); w.y = pk_fp8x4(v1[0], v1[1], v1[2], v1[3]);
                    *(v2u*)(rowp + bj * 128) = w; } }
    }
};

__device__ __forceinline__ void transpose_item(const float* W, int ldw, int k0, int nsrc0, bf16* WT, int K, int drow0, LAS float* scr, int lane, bool zero) {
    float tv[32];
#pragma unroll
    for (int i = 0; i < 32; ++i) { const int kk = 2 * i + (lane >> 5); tv[i] = zero ? 0.f : W[(size_t)(k0 + kk) * ldw + nsrc0 + (lane & 31)]; }
#pragma unroll
    for (int i = 0; i < 32; ++i) { const int kk = 2 * i + (lane >> 5); scr[kk * 33 + (lane & 31)] = tv[i]; }
    LDS_WAIT();
    const int c = lane & 7;
#pragma unroll
    for (int j = 0; j < 4; ++j) { const int n = (lane >> 3) + 8 * j; const LAS float* s = scr + (8 * c) * 33 + n;
        v4u o; o.x = pk2(s[0 * 33], s[1 * 33]); o.y = pk2(s[2 * 33], s[3 * 33]); o.z = pk2(s[4 * 33], s[5 * 33]); o.w = pk2(s[6 * 33], s[7 * 33]);
        *(v4u*)(WT + (size_t)(drow0 + n) * K + k0 + 8 * c) = o; }
    LDS_WAIT();
}

__device__ __forceinline__ void split8(const float (&x)[8], pg8::bf16x8& hi, pg8::bf16x8& lo) {
    v4u h, l;
#pragma unroll
    for (int e = 0; e < 4; ++e) { const unsigned w = pk2(x[2 * e], x[2 * e + 1]); h[e] = w; l[e] = pk2(x[2 * e] - bflo(w), x[2 * e + 1] - bfhi(w)); }
    asm volatile("s_nop 4" : "+v"(h), "+v"(l));
    hi = __builtin_bit_cast(pg8::bf16x8, h); lo = __builtin_bit_cast(pg8::bf16x8, l);
}
__device__ __forceinline__ f32x4 mfma3(pg8::bf16x8 ah, pg8::bf16x8 al, pg8::bf16x8 bh, pg8::bf16x8 bl, f32x4 acc) {
    acc = __builtin_amdgcn_mfma_f32_16x16x32_bf16(al, bh, acc, 0, 0, 0);
    acc = __builtin_amdgcn_mfma_f32_16x16x32_bf16(ah, bl, acc, 0, 0, 0);
    return __builtin_amdgcn_mfma_f32_16x16x32_bf16(ah, bh, acc, 0, 0, 0);
}
__device__ __forceinline__ void sine_layer(const LAS float* in, const LAS float* w, LAS float* out, const float* bias, const float* freq, int wave, int lane) {
    const int m16 = lane & 15, kg = lane >> 4, mt = wave >> 1, nt0 = (wave & 1) * 2;
    pg8::bf16x8 Ah[2], Al[2];
#pragma unroll
    for (int s = 0; s < 2; ++s) { const LAS float* hp = in + (16 * mt + m16) * 68 + 32 * s + 8 * kg; const f32x4 x = *(const LAS f32x4*)hp, y = *(const LAS f32x4*)(hp + 4);
        const float v[8] = {x[0], x[1], x[2], x[3], y[0], y[1], y[2], y[3]}; split8(v, Ah[s], Al[s]); }
#pragma unroll
    for (int t = 0; t < 2; ++t) { const int n = (nt0 + t) * 16 + m16; f32x4 acc = (f32x4){0.f, 0.f, 0.f, 0.f};
#pragma unroll
        for (int s = 0; s < 2; ++s) { float v[8];
#pragma unroll
            for (int jj = 0; jj < 8; ++jj) v[jj] = w[(32 * s + 8 * kg + jj) * 64 + n];
            pg8::bf16x8 Bh, Bl; split8(v, Bh, Bl); acc = mfma3(Ah[s], Al[s], Bh, Bl, acc); }
        const float bn = bias[n], fn = freq[n] * 0.15915494309f;
#pragma unroll
        for (int r = 0; r < 4; ++r) out[(16 * mt + 4 * kg + r) * 68 + n] = __builtin_amdgcn_sinf(fn * (acc[r] + bn)); }
}

__device__ __forceinline__ void phase0(const Args& a, LAS unsigned char* lds) {
    int tid = threadIdx.x; const int wg = blockIdx.x, G = gridDim.x;
    asm volatile("" : "+v"(tid));
    int lane = tid & 63, wave = tid >> 6;
    unsigned char* ws = a.ws;
    for (int it = wg; it < 192; it += G) {
        LAS float* sl = (LAS float*)lds;
        LAS float* red = (LAS float*)(lds + 20480);
        const int col = it * 32 + (lane & 31), kk = wave * 2 + (lane >> 5);
        float acc[5] = {0.f, 0.f, 0.f, 0.f, 0.f};
        const float* wp = a.in[4] + col;
        float wv[64];
#pragma unroll
        for (int j = 0; j < 64; ++j) wv[j] = wp[(size_t)(kk + 16 * j) * 6144];
        for (int i = tid; i < 5 * 1024; i += NTHR) { const int bb = i >> 10, k = i & 1023; const float v = (bb < 4) ? a.in[1][bb * 1024 + k] : a.in[3][k]; sl[i] = silu_f(v); }
        __syncthreads();
#pragma unroll
        for (int j = 0; j < 64; ++j) { const int k = kk + 16 * j;
#pragma unroll
            for (int bb = 0; bb < 5; ++bb) acc[bb] += sl[bb * 1024 + k] * wv[j]; }
#pragma unroll
        for (int bb = 0; bb < 5; ++bb) red[(kk * 5 + bb) * 32 + (lane & 31)] = acc[bb];
        __syncthreads();
        if (tid < 160) { const int bb = tid >> 5, cl = tid & 31; float s = 0.f;
#pragma unroll
            for (int q = 0; q < 16; ++q) s += red[(q * 5 + bb) * 32 + cl];
            ((float*)(ws + WS_MOD))[bb * 6144 + it * 32 + cl] = s + a.in[5][it * 32 + cl]; }
        __syncthreads();
    }
    for (int it = wg; it < 256; it += G) {
        asm volatile("" : "+v"(tid)); lane = tid & 63; wave = tid >> 6;
        const int cg = it >> 6, i0 = (it & 63) * 64, m16 = lane & 15, kg = lane >> 4;
        LAS float* zl = (LAS float*)lds;
        LAS float* h1 = (LAS float*)(lds + 17408);
        LAS float* h2 = (LAS float*)(lds + 2 * 17408);
        LAS float* w1l = (LAS float*)(lds + 3 * 17408);
        LAS float* w2l = (LAS float*)(lds + 3 * 17408 + 16384);
        float braw[4][2][8];
        {   const float* w3 = a.in[19] + cg * 512 + wave * 64 + m16;
#pragma unroll
            for (int nt = 0; nt < 4; ++nt)
#pragma unroll
                for (int s = 0; s < 2; ++s)
#pragma unroll
                    for (int jj = 0; jj < 8; ++jj) braw[nt][s][jj] = w3[(32 * s + 8 * kg + jj) * 2048 + nt * 16]; }
        {   float t1[8], t2[8];
#pragma unroll
            for (int q = 0; q < 8; ++q) { const int o = tid + NTHR * q; t1[q] = (o < 33 * 64) ? a.in[15][o] : 0.f; t2[q] = a.in[17][o]; }
#pragma unroll
            for (int q = 0; q < 8; ++q) { const int o = tid + NTHR * q; w1l[o] = t1[q]; w2l[o] = t2[q]; } }
#pragma unroll
        for (int q = 0; q < 8; ++q) { const int o = tid + NTHR * q, li = o >> 6, j = o & 63; const int i = i0 + li;
            const int jj = (j - 1) & 15; const float f = 1e-4f + (float)jj * ((15.0f - 1e-4f) / 15.0f); const float turns = f * ((float)i * (1.0f / 4096.0f));
            const float v = (j == 0) ? (float)i * (1.0f / 4095.0f) : (j <= 16) ? __builtin_amdgcn_cosf(turns) : (j <= 32) ? -__builtin_amdgcn_sinf(turns) : 0.f;
            zl[li * 68 + j] = v; }
        __syncthreads();
        sine_layer(zl, w1l, h1, a.in[16], a.in[20], wave, lane);
        __syncthreads();
        sine_layer(h1, w2l, h2, a.in[18], a.in[20], wave, lane);
        __syncthreads();
        {
            pg8::bf16x8 Bh[4][2], Bl[4][2];
#pragma unroll
            for (int nt = 0; nt < 4; ++nt)
#pragma unroll
                for (int s = 0; s < 2; ++s) split8(braw[nt][s], Bh[nt][s], Bl[nt][s]);
            float* hT = (float*)(ws + WS_HT);
#pragma unroll
            for (int mt = 0; mt < 4; ++mt) {
                pg8::bf16x8 Ah[2], Al[2];
#pragma unroll
                for (int s = 0; s < 2; ++s) { const LAS float* hp = h2 + (16 * mt + m16) * 68 + 32 * s + 8 * kg; const f32x4 x = *(const LAS f32x4*)hp, y = *(const LAS f32x4*)(hp + 4);
                    const float v[8] = {x[0], x[1], x[2], x[3], y[0], y[1], y[2], y[3]}; split8(v, Ah[s], Al[s]); }
#pragma unroll
                for (int nt = 0; nt < 4; ++nt) { f32x4 acc = (f32x4){0.f, 0.f, 0.f, 0.f};
#pragma unroll
                    for (int s = 0; s < 2; ++s) acc = mfma3(Ah[s], Al[s], Bh[nt][s], Bl[nt][s], acc);
                    const int c = wave * 64 + nt * 16 + m16;
                    const float delta = 3.0701134573f + (float)c * ((15.3505672866f - 3.0701134573f) / 511.0f);
                    f32x4 o;
#pragma unroll
                    for (int r = 0; r < 4; ++r) { const float ti = (float)(i0 + 16 * mt + 4 * kg + r) * (1.0f / 4095.0f); o[r] = acc[r] * __expf(-ti * delta); }
                    *(f32x4*)(hT + ((size_t)cg * 512 + c) * SEQ + i0 + 16 * mt + 4 * kg) = o; } } }
        __syncthreads();
    }
    {
        asm volatile("" : "+v"(tid)); lane = tid & 63; wave = tid >> 6;
        LAS float* scr = (LAS float*)(lds + wave * 8448);
        const int gw = wg * NWAVES + wave, NGW = G * NWAVES;
        constexpr int I_IN = 104 * 16, I_OUT = 32 * 16;
        constexpr int I_ALL = I_IN + I_OUT, I_EXTRA = I_ALL - 2048;
        for (int it = gw; it < I_ALL; it = (G != 256) ? it + NGW : ((it < NGW && gw >= NGW - I_EXTRA) ? it + I_EXTRA : I_ALL)) {
            if (it < I_IN) { const int nb = it >> 4, kb = it & 15, n0 = nb * 32;
                const int ns = (n0 < 1536) ? n0 : (n0 < 3072 ? n0 + 32 : 1536 + (n0 - 3072));
                transpose_item(a.in[7], DIN, kb * 64, (n0 < DIN) ? ns : 0, (bf16*)(ws + WS_WIN), DM, n0, scr, lane, n0 >= DIN);
            } else { const int r = it - I_IN, nb = r >> 4, kb = r & 15;
                transpose_item(a.in[22], DM, kb * 64, nb * 32, (bf16*)(ws + WS_WOUT), DM, nb * 32, scr, lane, false); }
        }
    }
    for (int e = wg * NTHR + tid; e < 64 * 256; e += G * NTHR) { const int i = e >> 8, j = e & 255;
        const float om = 1.0f / powf(10000.0f, (float)j * (1.0f / 256.0f)); const float er = (float)i * om;
        float* pt = (float*)(ws + WS_POS); pt[i * 512 + j] = sinf(er); pt[i * 512 + 256 + j] = cosf(er); }
}

__device__ __forceinline__ void phase1(const Args& a, LAS unsigned char* lds) {
    const int tid = threadIdx.x, lane = tid & 63, wave = tid >> 6, wg = blockIdx.x, G = gridDim.x;
    unsigned char* ws = a.ws;
    const float* modr = (const float*)(ws + WS_MOD); const float* pt = (const float*)(ws + WS_POS); bf16* ain = (bf16*)(ws + WS_AIN);
    const float* gmix = a.in[6];
    const int NGW = G * NWAVES;
    f32x4 gv[4];
#pragma unroll
    for (int j = 0; j < 4; ++j) gv[j] = *(const f32x4*)(gmix + 4 * lane + 256 * j);
#pragma nounroll
    for (int r0 = wg * NWAVES + wave; r0 < MT; r0 += 4 * NGW) {
        f32x4 v[4][4], pv[4][4], shv[2][4], scv[2][4];
#pragma unroll
        for (int k = 0; k < 4; ++k) { const int r = r0 + k * NGW, rc = (r < MT) ? r : r0; const bool lat = rc < MX;
            const float* src = lat ? a.in[0] + (size_t)rc * DM : a.in[2] + (size_t)(rc - MX) * DM; const int t = rc & 4095, rr = t >> 6, cc = t & 63;
#pragma unroll
            for (int j = 0; j < 4; ++j) { const int col = 4 * lane + 256 * j; v[k][j] = *(const f32x4*)(src + col);
                pv[k][j] = *(const f32x4*)(pt + ((j < 2) ? rr * 512 + col : cc * 512 + col - 512)); } }
#pragma unroll
        for (int g = 0; g < 2; ++g) { const int r = r0 + 2 * g * NGW, rc = (r < MT) ? r : r0; const int bb = (rc < MX) ? (rc >> 12) : 4;
#pragma unroll
            for (int j = 0; j < 4; ++j) { const int col = 4 * lane + 256 * j; shv[g][j] = *(const f32x4*)(modr + bb * 6144 + col); scv[g][j] = *(const f32x4*)(modr + bb * 6144 + 1024 + col); } }
#pragma unroll
        for (int k = 0; k < 4; ++k) { const int r = r0 + k * NGW, rc = (r < MT) ? r : r0; const float lat = (rc < MX) ? 1.0f : 0.0f; float ss = 0.f;
#pragma unroll
            for (int j = 0; j < 4; ++j) { v[k][j] += pv[k][j] * lat; ss += v[k][j][0] * v[k][j][0] + v[k][j][1] * v[k][j][1] + v[k][j][2] * v[k][j][2] + v[k][j][3] * v[k][j][3]; }
            const float rs = rsqrtf(wave_sum(ss) * (1.0f / DM) + EPS);
#pragma unroll
            for (int j = 0; j < 4; ++j) { const int col = 4 * lane + 256 * j;
                const f32x4 y = (v[k][j] * rs * gv[j]) * (scv[k >> 1][j] + 1.0f) + shv[k >> 1][j];
                v2u w; w.x = pk2(y[0], y[1]); w.y = pk2(y[2], y[3]);
                if (r < MT) *(v2u*)(ain + (size_t)r * DM + col) = w; } }
    }
}

typedef float cpx __attribute__((ext_vector_type(2)));
__device__ __forceinline__ cpx make_cpx(float x, float y) { cpx r; r.x = x; r.y = y; return r; }
__device__ __forceinline__ cpx cmul(cpx a, cpx b) { cpx r;
    asm("v_pk_mul_f32 %0, %1, %2 op_sel_hi:[1,0]\n\tv_pk_fma_f32 %0, %1, %2, %0 op_sel:[1,1,0] op_sel_hi:[0,1,1] neg_lo:[1,0,0]" : "=&v"(r) : "v"(a), "v"(b));
    return r; }
__device__ __forceinline__ cpx cmul_s(cpx a, cpx b) { cpx r;
    asm("v_pk_mul_f32 %0, %1, %2 op_sel_hi:[1,0]\n\tv_pk_fma_f32 %0, %1, %2, %0 op_sel:[1,1,0] op_sel_hi:[0,1,1] neg_lo:[1,0,0]" : "=&v"(r) : "v"(a), "s"(b));
    return r; }
__device__ __forceinline__ cpx cmulc(cpx a, cpx b) { cpx r;
    asm("v_pk_mul_f32 %0, %1, %2 op_sel_hi:[1,0] neg_hi:[1,0]\n\tv_pk_fma_f32 %0, %1, %2, %0 op_sel:[1,1,0] op_sel_hi:[0,1,1] neg_lo:[1,0,0] neg_hi:[1,0,0]" : "=&v"(r) : "v"(a), "v"(b));
    return r; }
__device__ __forceinline__ cpx cfma(cpx a, cpx b, cpx c) { cpx r;
    asm("v_pk_fma_f32 %0, %1, %2, %3 op_sel_hi:[1,0,1]\n\tv_pk_fma_f32 %0, %1, %2, %0 op_sel:[1,1,0] op_sel_hi:[0,1,1] neg_lo:[1,0,0]" : "=&v"(r) : "v"(a), "v"(b), "v"(c));
    return r; }
__device__ __forceinline__ cpx cadd(cpx a, cpx b) { return a + b; }
__device__ __forceinline__ cpx csub(cpx a, cpx b) { return a - b; }
__device__ __forceinline__ cpx add_mi(cpx a, cpx b) { cpx r; asm("v_pk_add_f32 %0, %1, %2 op_sel:[0,1] op_sel_hi:[1,0] neg_hi:[0,1]" : "=v"(r) : "v"(a), "v"(b)); return r; }
__device__ __forceinline__ cpx add_pi(cpx a, cpx b) { cpx r; asm("v_pk_add_f32 %0, %1, %2 op_sel:[0,1] op_sel_hi:[1,0] neg_lo:[0,1]" : "=v"(r) : "v"(a), "v"(b)); return r; }
__device__ __forceinline__ cpx cconj(cpx a) { return make_cpx(a.x, -a.y); }
__device__ __forceinline__ cpx twid(float turns) { return make_cpx(__builtin_amdgcn_cosf(turns), -__builtin_amdgcn_sinf(turns)); }
__device__ __forceinline__ void dft4(cpx& a0, cpx& a1, cpx& a2, cpx& a3) {
    const cpx t0 = cadd(a0, a2), t1 = csub(a0, a2), t2 = cadd(a1, a3), t3 = csub(a1, a3);
    a0 = cadd(t0, t2); a2 = csub(t0, t2); a1 = add_mi(t1, t3); a3 = add_pi(t1, t3);
}
__device__ __forceinline__ void dft4_r2(cpx& a0, cpx& a1, cpx& a2, cpx& a3) {
    const cpx t0 = add_mi(a0, a2), t1 = add_pi(a0, a2), t2 = cadd(a1, a3), t3 = csub(a1, a3);
    a0 = cadd(t0, t2); a2 = csub(t0, t2); a1 = add_mi(t1, t3); a3 = add_pi(t1, t3);
}
__device__ __forceinline__ void dft16(cpx (&v)[16]) {
    cpx t[16];
#pragma unroll
    for (int j = 0; j < 4; ++j) { cpx b0 = v[j], b1 = v[j + 4], b2 = v[j + 8], b3 = v[j + 12]; dft4(b0, b1, b2, b3); t[4 * j] = b0; t[4 * j + 1] = b1; t[4 * j + 2] = b2; t[4 * j + 3] = b3; }
    const float C1 = 0.92387953251f, S1 = 0.38268343236f, R2 = 0.70710678118f;
    const cpx W1 = make_cpx(C1, -S1), W2 = make_cpx(R2, -R2), W3 = make_cpx(S1, -C1), W6 = make_cpx(-R2, -R2), W9 = make_cpx(-C1, S1);
    {   cpx b0 = t[0], b1 = t[4], b2 = t[8], b3 = t[12]; dft4(b0, b1, b2, b3); v[0] = b0; v[4] = b1; v[8] = b2; v[12] = b3; }
    {   cpx b0 = t[1], b1 = cmul_s(t[5], W1), b2 = cmul_s(t[9], W2), b3 = cmul_s(t[13], W3); dft4(b0, b1, b2, b3); v[1] = b0; v[5] = b1; v[9] = b2; v[13] = b3; }
    {   cpx b0 = t[2], b1 = cmul_s(t[6], W2), b2 = t[10], b3 = cmul_s(t[14], W6); dft4_r2(b0, b1, b2, b3); v[2] = b0; v[6] = b1; v[10] = b2; v[14] = b3; }
    {   cpx b0 = t[3], b1 = cmul_s(t[7], W3), b2 = cmul_s(t[11], W6), b3 = cmul_s(t[15], W9); dft4(b0, b1, b2, b3); v[3] = b0; v[7] = b1; v[11] = b2; v[15] = b3; }
}
#define FPAD(i) ((i) + ((i) >> 4))
constexpr int FFT_STRIDE = 4352;
__device__ __forceinline__ void apply_tw(cpx (&v)[16], cpx w1) {
    asm volatile("" : "+v"(w1.x), "+v"(w1.y));
    const cpx w2 = cmul(w1, w1), w4 = cmul(w2, w2), w8 = cmul(w4, w4), w3 = cmul(w2, w1), w5 = cmul(w4, w1), w6 = cmul(w4, w2), w7 = cmul(w4, w3);
    v[1] = cmul(v[1], w1); v[2] = cmul(v[2], w2); v[3] = cmul(v[3], w3); v[4] = cmul(v[4], w4); v[5] = cmul(v[5], w5); v[6] = cmul(v[6], w6); v[7] = cmul(v[7], w7); v[8] = cmul(v[8], w8);
    v[9] = cmul(v[9], cmul(w8, w1)); v[10] = cmul(v[10], cmul(w8, w2)); v[11] = cmul(v[11], cmul(w8, w3)); v[12] = cmul(v[12], cmul(w8, w4));
    v[13] = cmul(v[13], cmul(w8, w5)); v[14] = cmul(v[14], cmul(w8, w6)); v[15] = cmul(v[15], cmul(w8, w7));
}
__device__ __forceinline__ cpx opaque(cpx w) { asm volatile("" : "+v"(w.x), "+v"(w.y)); return w; }
__device__ __forceinline__ cpx c32(int r) { return make_cpx(__builtin_cosf(0.19634954084936207f * (float)r), -__builtin_sinf(0.19634954084936207f * (float)r)); }

#define HB(x) __uint_as_float(((unsigned)(x)) << 16)
__device__ __forceinline__ void hyena_item(const Args& a, LAS unsigned char* lds, int c, int stage) {
    int tid = threadIdx.x; asm volatile("" : "+v"(tid));
    const int f = tid >> 8, j = tid & 255, blk = j >> 4, jp = j & 15;
    const int fu = __builtin_amdgcn_readfirstlane(f);
    unsigned char* ws = a.ws;
    LAS cpx* buf = (LAS cpx*)lds;
    LAS cpx* bm = buf + f * FFT_STRIDE;
    const int pj = j + blk, p16 = blk * 272 + jp, pc = 17 * j;
    const float* hT = (const float*)(ws + WS_HT);
    const float* hf = hT + ((size_t)(stage * 2 + 0) * 512 + c) * SEQ;
    const float* hb = hT + ((size_t)(stage * 2 + 1) * 512 + c) * SEQ;
    const bf16* hyT = (const bf16*)(ws + WS_HYT);
    const bf16* zT = (const bf16*)(ws + WS_ZT);
    bf16* outp = (bf16*)(ws + WS_HYT);
    const float* cw = a.in[13]; const float* cb = a.in[14];
    const int chu = c, chg = (stage == 0 ? 512 : 1024) + c;
    const float wu0 = cw[chu], wu1 = cw[1536 + chu], wu2 = cw[3072 + chu], bu = cb[chu];
    const float wg0 = cw[chg], wg1 = cw[1536 + chg], wg2 = cw[3072 + chg], bg = cb[chg];
    const float bias = a.in[21][stage * 512 + c];
    const cpx wj = twid((float)j * (1.0f / 4096.0f)), wjp = twid((float)jp * (1.0f / 256.0f)), w8_ = twid((float)j * (1.0f / 8192.0f));
    cpx v[16];
    LAS cpx* Hs = buf + 2 * FFT_STRIDE + f * FFT_STRIDE + pc;
    { const cpx w8 = opaque(w8_);
    float fraw[16], graw[16];
#pragma unroll
    for (int r = 0; r < 16; ++r) { const unsigned n = (unsigned)j + 256u * r; fraw[r] = hf[n]; graw[r] = hb[(SEQ - n) & 4095u]; }
    asm volatile("" : "+v"(fraw[0]), "+v"(fraw[1]), "+v"(fraw[2]), "+v"(fraw[3]), "+v"(fraw[4]), "+v"(fraw[5]), "+v"(fraw[6]), "+v"(fraw[7]), "+v"(fraw[8]), "+v"(fraw[9]), "+v"(fraw[10]), "+v"(fraw[11]), "+v"(fraw[12]), "+v"(fraw[13]), "+v"(fraw[14]), "+v"(fraw[15]));
    asm volatile("" : "+v"(graw[0]), "+v"(graw[1]), "+v"(graw[2]), "+v"(graw[3]), "+v"(graw[4]), "+v"(graw[5]), "+v"(graw[6]), "+v"(graw[7]), "+v"(graw[8]), "+v"(graw[9]), "+v"(graw[10]), "+v"(graw[11]), "+v"(graw[12]), "+v"(graw[13]), "+v"(graw[14]), "+v"(graw[15]));
    if (fu) {
#pragma unroll
        for (int r = 0; r < 16; ++r) { const unsigned n = (unsigned)j + 256u * r; const float gv = n ? graw[r] : 0.f; const cpx wn = cmul_s(w8, c32(r)); const float d = fraw[r] - gv; v[r] = make_cpx(d * wn.x, d * wn.y); }
    } else {
#pragma unroll
        for (int r = 0; r < 16; ++r) { const unsigned n = (unsigned)j + 256u * r; const float gv = n ? graw[r] : 0.f; v[r] = make_cpx(fraw[r] + gv, 0.f); }
    } }
    dft16(v); apply_tw(v, wj);
#pragma unroll
    for (int q = 0; q < 16; ++q) bm[pj + 272 * q] = v[q];
    __syncthreads();
#pragma unroll
    for (int r = 0; r < 16; ++r) v[r] = bm[p16 + 17 * r];
    dft16(v); apply_tw(v, wjp);
#pragma unroll
    for (int q = 0; q < 16; ++q) bm[p16 + 17 * q] = v[q];
    __syncthreads();
#pragma unroll
    for (int r = 0; r < 16; ++r) v[r] = bm[pc + r];
    dft16(v);
#pragma unroll
    for (int q = 0; q < 16; ++q) Hs[q] = v[q];
    __syncthreads();
#pragma nounroll
    for (int bp = 0; bp < 2; ++bp) {
        const int b0 = 2 * bp, b1 = 2 * bp + 1;
        float uk0[8], uk1[8];
        {   float u0[16], u1[16];
            const unsigned uj = (unsigned)j;
            if (stage == 0) {
                const bf16* P0 = hyT + ((size_t)b0 * 1536 + chu) * SEQ; const bf16* P1 = hyT + ((size_t)b1 * 1536 + chu) * SEQ;
#pragma unroll
                for (int r = 0; r < 16; ++r) { const unsigned o = uj + 256u * r; if (r == 4 || r == 8 || r == 12) asm volatile("" ::: "memory");
                    const unsigned ol = (r == 0) ? (j ? uj - 1u : 0u) : o - 1u, orr = (r == 15) ? (j < 255 ? o + 1u : o) : o + 1u;
                    float l0 = HB(P0[ol]), l1 = HB(P1[ol]), r0 = HB(P0[orr]), r1 = HB(P1[orr]);
                    if (r == 0) { l0 = j ? l0 : 0.f; l1 = j ? l1 : 0.f; }
                    if (r == 15) { r0 = (j < 255) ? r0 : 0.f; r1 = (j < 255) ? r1 : 0.f; }
                    u0[r] = wu0 * l0 + wu1 * HB(P0[o]) + wu2 * r0 + bu; u1[r] = wu0 * l1 + wu1 * HB(P1[o]) + wu2 * r1 + bu; }
            } else {
                const bf16* P0 = zT + ((size_t)b0 * 512 + c) * SEQ; const bf16* P1 = zT + ((size_t)b1 * 512 + c) * SEQ;
                unsigned short z0[16], z1[16];
#pragma unroll
                for (int r = 0; r < 16; ++r) { const unsigned o = uj + 256u * r; z0[r] = P0[o]; z1[r] = P1[o]; }
                asm volatile("" :: "v"(z0[0]), "v"(z0[1]), "v"(z0[2]), "v"(z0[3]), "v"(z0[4]), "v"(z0[5]), "v"(z0[6]), "v"(z0[7]), "v"(z0[8]), "v"(z0[9]), "v"(z0[10]), "v"(z0[11]), "v"(z0[12]), "v"(z0[13]), "v"(z0[14]), "v"(z0[15]));
                asm volatile("" :: "v"(z1[0]), "v"(z1[1]), "v"(z1[2]), "v"(z1[3]), "v"(z1[4]), "v"(z1[5]), "v"(z1[6]), "v"(z1[7]), "v"(z1[8]), "v"(z1[9]), "v"(z1[10]), "v"(z1[11]), "v"(z1[12]), "v"(z1[13]), "v"(z1[14]), "v"(z1[15]));
#pragma unroll
                for (int r = 0; r < 16; ++r) { u0[r] = HB(z0[r]); u1[r] = HB(z1[r]); }
            }
#pragma unroll
            for (int i = 0; i < 8; ++i) { uk0[i] = f ? u0[2 * i + 1] : u0[2 * i]; uk1[i] = f ? u1[2 * i + 1] : u1[2 * i]; }
            const cpx w8 = opaque(w8_);
            if (fu) {
#pragma unroll
                for (int r = 0; r < 16; ++r) v[r] = cmul(make_cpx(u0[r], u1[r]), cmul_s(w8, c32(r)));
            } else {
#pragma unroll
                for (int r = 0; r < 16; ++r) v[r] = make_cpx(u0[r], u1[r]);
            }
        }
        dft16(v); apply_tw(v, wj);
#pragma unroll
        for (int q = 0; q < 16; ++q) bm[pj + 272 * q] = v[q];
        __syncthreads();
#pragma unroll
        for (int r = 0; r < 16; ++r) v[r] = bm[p16 + 17 * r];
        dft16(v); apply_tw(v, wjp);
#pragma unroll
        for (int q = 0; q < 16; ++q) bm[p16 + 17 * q] = v[q];
        __syncthreads();
#pragma unroll
        for (int r = 0; r < 16; ++r) v[r] = bm[pc + r];
        dft16(v);
#pragma unroll
        for (int q = 0; q < 16; ++q) v[q] = cmulc(v[q], Hs[q]);
        dft16(v);
#pragma unroll
        for (int q = 0; q < 16; ++q) bm[pc + q] = v[q];
        __syncthreads();
#pragma unroll
        for (int r = 0; r < 16; ++r) v[r] = bm[p16 + 17 * r];
        apply_tw(v, wjp); dft16(v);
#pragma unroll
        for (int q = 0; q < 16; ++q) bm[p16 + 17 * q] = v[q];
        __syncthreads();
        float gg0[8], gg1[8];
        {   unsigned short rg0[8][3], rg1[8][3];
            const bf16* G0 = hyT + ((size_t)b0 * 1536 + chg) * SEQ; const bf16* G1 = hyT + ((size_t)b1 * 1536 + chg) * SEQ;
            const unsigned gj = (unsigned)(j + 256 * f);
#pragma unroll
            for (int i = 0; i < 8; ++i) { const unsigned o = gj + 512u * i;
                const unsigned ol = (i == 0) ? (gj ? gj - 1u : 0u) : o - 1u, orr = (i == 7) ? (o < 4095u ? o + 1u : o) : o + 1u;
                rg0[i][0] = G0[ol]; rg0[i][1] = G0[o]; rg0[i][2] = G0[orr]; rg1[i][0] = G1[ol]; rg1[i][1] = G1[o]; rg1[i][2] = G1[orr]; }
#pragma unroll
            for (int r = 0; r < 16; ++r) v[r] = bm[pj + 272 * r];
            apply_tw(v, wj); dft16(v);
#pragma unroll
            for (int q = 0; q < 16; ++q) bm[pj + 272 * q] = v[q];
#pragma unroll
            for (int i = 0; i < 8; ++i) asm volatile("" :: "v"(rg0[i][0]), "v"(rg0[i][1]), "v"(rg0[i][2]), "v"(rg1[i][0]), "v"(rg1[i][1]), "v"(rg1[i][2]));
#pragma unroll
            for (int i = 0; i < 8; ++i) { const unsigned o = gj + 512u * i;
                float a0 = HB(rg0[i][0]), a1 = HB(rg0[i][1]), a2 = HB(rg0[i][2]), c0 = HB(rg1[i][0]), c1 = HB(rg1[i][1]), c2 = HB(rg1[i][2]);
                if (i == 0) { a0 = gj ? a0 : 0.f; c0 = gj ? c0 : 0.f; }
                if (i == 7) { a2 = (o < 4095u) ? a2 : 0.f; c2 = (o < 4095u) ? c2 : 0.f; }
                gg0[i] = wg0 * a0 + wg1 * a1 + wg2 * a2 + bg; gg1[i] = wg0 * c0 + wg1 * c1 + wg2 * c2 + bg; } }
        __syncthreads();
        const cpx w8f = cmul(opaque(w8_), f ? c32(1) : c32(0));
        bf16* O0 = outp + ((size_t)b0 * 1536 + c) * SEQ; bf16* O1 = outp + ((size_t)b1 * 1536 + c) * SEQ;
        bf16* Z0 = (bf16*)(ws + WS_ZT) + ((size_t)b0 * 512 + c) * SEQ; bf16* Z1 = (bf16*)(ws + WS_ZT) + ((size_t)b1 * 512 + c) * SEQ;
#pragma unroll
        for (int i = 0; i < 8; ++i) { const int rr = f + 2 * i; const unsigned n = (unsigned)(j + 256 * f) + 512u * i;
            const cpx be = buf[pj + 272 * rr], bo = buf[FFT_STRIDE + pj + 272 * rr];
            const cpx wn = cmul_s(w8f, c32(2 * i));
            const cpx z = cfma(bo, wn, be);
            const float y0 = z.x * (1.0f / 8192.0f) + bias * uk0[i], y1 = bias * uk1[i] - z.y * (1.0f / 8192.0f);
                        if (stage == 0) { Z0[n] = (bf16)f2bf(gg0[i] * y0); Z1[n] = (bf16)f2bf(gg1[i] * y1); } else { O0[n] = (bf16)f2bf(gg0[i] * y0); O1[n] = (bf16)f2bf(gg1[i] * y1); } }
        __syncthreads();
    }
}

__device__ __forceinline__ f32x16 mfma32(bf16x8 a, bf16x8 b, f32x16 c) { return __builtin_amdgcn_mfma_f32_32x32x16_bf16(a, b, c, 0, 0, 0); }
typedef short s4v __attribute__((ext_vector_type(4)));
__device__ __forceinline__ bf16x8 tr_frag(const LAS bf16* base, int PT, int k0, int c0, int lane) {
    const int i = lane & 15, q = i >> 2, p = i & 3;
    const LAS bf16* ad = base + (k0 + 8 * (lane >> 5) + q) * PT + c0 + 16 * ((lane >> 4) & 1) + 4 * p;
    const s4v lo = __builtin_amdgcn_ds_read_tr16_b64_v4i16((LAS s4v*)ad);
    const s4v hi = __builtin_amdgcn_ds_read_tr16_b64_v4i16((LAS s4v*)(ad + 4 * PT));
    bf16x8 r; r[0] = lo[0]; r[1] = lo[1]; r[2] = lo[2]; r[3] = lo[3]; r[4] = hi[0]; r[5] = hi[1]; r[6] = hi[2]; r[7] = hi[3]; return r;
}
constexpr int GL_AL = 0, GL_WA = 8192, GL_TOT = 16384, GL_V = 24576, GL_VP = 160;
struct GlaTab { float P[4][2], X[4][2], Ptot[2], Xtot[2], Pref[2], Xref[2]; };
__device__ __forceinline__ void gla_tables(const Args& a, int h, LAS unsigned char* lds, GlaTab& T, int tid) {
    const int d2 = tid & 31, sg = tid >> 5;
    const LAS float* aL = (const LAS float*)(lds + GL_AL); const LAS float* wa = (const LAS float*)(lds + GL_WA); LAS float* tot = (LAS float*)(lds + GL_TOT);
    typedef float f32x2v __attribute__((ext_vector_type(2)));
    float lf[4][2], lb[4][2];
    {
        typedef short bf16x4 __attribute__((ext_vector_type(4)));
        const int wave = tid >> 6, lane = tid & 63, m16 = lane & 15, kg = lane >> 4, dir = wave >> 2, mt = wave & 3;
        LAS float* LF = (LAS float*)(lds + 110592);
        const f32x4 av = *(const LAS f32x4*)(aL + (16 * mt + m16) * 32 + dir * 16 + 4 * kg);
        v2u ahu, alu; ahu.x = pk2(av[0], av[1]); ahu.y = pk2(av[2], av[3]); alu.x = pk2(av[0] - bflo(ahu.x), av[1] - bfhi(ahu.x)); alu.y = pk2(av[2] - bflo(ahu.y), av[3] - bfhi(ahu.y));
        asm volatile("s_nop 4" : "+v"(ahu), "+v"(alu));
        const bf16x4 Ah = __builtin_bit_cast(bf16x4, ahu), Al = __builtin_bit_cast(bf16x4, alu);
        const float* bias = (dir ? a.in[11] : a.in[9]) + h * 64;
#pragma unroll
        for (int nt = 0; nt < 4; ++nt) { const int d = 16 * nt + m16; float w[4];
#pragma unroll
            for (int jj = 0; jj < 4; ++jj) w[jj] = wa[dir * 1024 + (4 * kg + jj) * 64 + d];
            v2u bhu, blu; bhu.x = pk2(w[0], w[1]); bhu.y = pk2(w[2], w[3]); blu.x = pk2(w[0] - bflo(bhu.x), w[1] - bfhi(bhu.x)); blu.y = pk2(w[2] - bflo(bhu.y), w[3] - bfhi(bhu.y));
            asm volatile("s_nop 4" : "+v"(bhu), "+v"(blu));
            const bf16x4 Bh = __builtin_bit_cast(bf16x4, bhu), Bl = __builtin_bit_cast(bf16x4, blu);
            f32x4 acc = (f32x4){0.f, 0.f, 0.f, 0.f};
            acc = __builtin_amdgcn_mfma_f32_16x16x16bf16_1k(Al, Bh, acc, 0, 0, 0);
            acc = __builtin_amdgcn_mfma_f32_16x16x16bf16_1k(Ah, Bl, acc, 0, 0, 0);
            acc = __builtin_amdgcn_mfma_f32_16x16x16bf16_1k(Ah, Bh, acc, 0, 0, 0);
            const float bv = bias[d];
#pragma unroll
            for (int r = 0; r < 4; ++r) LF[dir * 4096 + (16 * mt + 4 * kg + r) * 64 + d] = logsig_f(acc[r] + bv) * (1.0f / 16.0f); }
        __syncthreads();
#pragma unroll
        for (int q = 0; q < 4; ++q) { const int s = sg * 4 + q; const f32x2v vf = *(const LAS f32x2v*)(LF + s * 64 + 2 * d2), vb = *(const LAS f32x2v*)(LF + 4096 + s * 64 + 2 * d2);
            lf[q][0] = vf[0]; lf[q][1] = vf[1]; lb[q][0] = vb[0]; lb[q][1] = vb[1]; } }
#ifdef DBG_OLDTAB
    {   const f32x2v bf = *(const f32x2v*)(a.in[9] + h * 64 + 2 * d2), bb = *(const f32x2v*)(a.in[11] + h * 64 + 2 * d2);
#pragma unroll
    for (int q = 0; q < 4; ++q) { const int s = sg * 4 + q; float pf0 = bf[0], pf1 = bf[1], pb0 = bb[0], pb1 = bb[1];
#pragma unroll
        for (int j4 = 0; j4 < 4; ++j4) { const f32x4 af = *(const LAS f32x4*)(aL + s * 32 + 4 * j4), ab = *(const LAS f32x4*)(aL + s * 32 + 16 + 4 * j4);
#pragma unroll
            for (int jj = 0; jj < 4; ++jj) { const int j = 4 * j4 + jj; const f32x2v wf = *(const LAS f32x2v*)(wa + j * 64 + 2 * d2), wb = *(const LAS f32x2v*)(wa + 1024 + j * 64 + 2 * d2);
                pf0 += af[jj] * wf[0]; pf1 += af[jj] * wf[1]; pb0 += ab[jj] * wb[0]; pb1 += ab[jj] * wb[1]; } }
        lf[q][0] = logsig_f(pf0) * (1.0f / 16.0f); lf[q][1] = logsig_f(pf1) * (1.0f / 16.0f); lb[q][0] = logsig_f(pb0) * (1.0f / 16.0f); lb[q][1] = logsig_f(pb1) * (1.0f / 16.0f); } }
#endif
#pragma unroll
    for (int i = 0; i < 2; ++i) { lf[1][i] += lf[0][i]; lf[2][i] += lf[1][i]; lf[3][i] += lf[2][i]; lb[2][i] += lb[3][i]; lb[1][i] += lb[2][i]; lb[0][i] += lb[1][i]; }
    *(LAS f32x2v*)(tot + sg * 64 + 2 * d2) = (f32x2v){lf[3][0], lf[3][1]};
    *(LAS f32x2v*)(tot + 1024 + sg * 64 + 2 * d2) = (f32x2v){lb[0][0], lb[0][1]};
    __syncthreads();
    float of[2] = {0.f, 0.f}, ob[2] = {0.f, 0.f};
    T.Ptot[0] = T.Ptot[1] = T.Xtot[0] = T.Xtot[1] = T.Pref[0] = T.Pref[1] = T.Xref[0] = T.Xref[1] = 0.f;
#pragma unroll
    for (int g = 0; g < 16; ++g) { const f32x2v tf = *(const LAS f32x2v*)(tot + g * 64 + 2 * d2), tb = *(const LAS f32x2v*)(tot + 1024 + g * 64 + 2 * d2);
#pragma unroll
        for (int i = 0; i < 2; ++i) { T.Ptot[i] += tf[i]; T.Xtot[i] += tb[i]; if (g < 8) T.Pref[i] += tf[i]; else T.Xref[i] += tb[i];
            of[i] += (g < sg) ? tf[i] : 0.f; ob[i] += (g > sg) ? tb[i] : 0.f; } }
#pragma unroll
    for (int q = 0; q < 4; ++q)
#pragma unroll
        for (int i = 0; i < 2; ++i) { T.P[q][i] = lf[q][i] + of[i]; T.X[q][i] = lb[q][i] + ob[i]; }
}
struct GlaIn { f32x4 av, wv; unsigned kw[4], qw[4]; };
template <bool OUT>
__device__ __forceinline__ void gla_load(const Args& a, int tid, int bh, int ci, GlaIn& I) {
    const int b = bh >> 2, h = bh & 3, d2 = tid & 31, sg = tid >> 5;
    const size_t rowbase = OUT ? (size_t)b * SEQ + ci * 64 : ((ci < 4) ? (size_t)(MX + b * CTXL + ci * 64) : (size_t)(b * SEQ + (ci - 4) * 64));
    const float* afb = (const float*)(a.ws + WS_AFB); const bf16* qkvg = (const bf16*)(a.ws + WS_QKVG);
    I.av = *(const f32x4*)(afb + (rowbase + (tid >> 3)) * 32 + 4 * (tid & 7));
    const int wdir = tid >> 8, wj = (tid >> 4) & 15, wd4 = (tid & 15) * 4;
    I.wv = *(const f32x4*)((wdir ? a.in[10] : a.in[8]) + wj * 256 + h * 64 + wd4);
#pragma unroll
    for (int q = 0; q < 4; ++q) { const bf16* rp = qkvg + (rowbase + sg * 4 + q) * NQ + h * 64 + 2 * d2; I.kw[q] = *(const unsigned*)(rp + 256); if (OUT) I.qw[q] = *(const unsigned*)rp; }
}
__device__ __forceinline__ void gla_stage_common(const GlaIn& I, LAS unsigned char* lds, int tid) {
    const int wdir = tid >> 8, wj = (tid >> 4) & 15, wd4 = (tid & 15) * 4;
    *(LAS f32x4*)((LAS float*)(lds + GL_AL) + 4 * tid) = I.av;
    *(LAS f32x4*)((LAS float*)(lds + GL_WA) + wdir * 1024 + wj * 64 + wd4) = I.wv;
}

template <bool HASN>
__device__ __forceinline__ void gla_upd_item(const Args& a, LAS unsigned char* lds, int bh, int ci, const GlaIn& I, int nbh, int nci, GlaIn& N) {
    int tid = threadIdx.x; asm volatile("" : "+v"(tid));
    const int lane = tid & 63, wave = tid >> 6, h = bh & 3, d2 = tid & 31, sg = tid >> 5;
    unsigned char* ws = a.ws;
    constexpr int KP = 96;
    LAS bf16* vN = (LAS bf16*)(lds + GL_V); LAS bf16* kUf = (LAS bf16*)(lds + 45056); LAS bf16* kUb = (LAS bf16*)(lds + 57344);
    unsigned kw[4];
#pragma unroll
    for (int q = 0; q < 4; ++q) kw[q] = I.kw[q];
    v4u vv[2];
    { const int b = bh >> 2; const size_t rowbase = (ci < 4) ? (size_t)(MX + b * CTXL + ci * 64) : (size_t)(b * SEQ + (ci - 4) * 64); const bf16* qkvg = (const bf16*)(ws + WS_QKVG);
#pragma unroll
        for (int q = 0; q < 2; ++q) { const int idx = tid + NTHR * q; vv[q] = *(const v4u*)(qkvg + (rowbase + (idx >> 4)) * NQ + 512 + h * 128 + (idx & 15) * 8); } }
    gla_stage_common(I, lds, tid);
    __syncthreads();
    if (HASN) gla_load<false>(a, tid, nbh, nci, N);
    GlaTab T; gla_tables(a, h, lds, T, tid);
#pragma unroll
    for (int q = 0; q < 4; ++q) { const int s = sg * 4 + q; const float k0 = bflo(kw[q]), k1 = bfhi(kw[q]);
        *(LAS unsigned*)(kUf + s * KP + 2 * d2) = pk2(k0 * __expf(T.Ptot[0] - T.P[q][0]), k1 * __expf(T.Ptot[1] - T.P[q][1]));
        *(LAS unsigned*)(kUb + s * KP + 2 * d2) = pk2(k0 * __expf(T.Xtot[0] - T.X[q][0]), k1 * __expf(T.Xtot[1] - T.X[q][1])); }
#pragma unroll
    for (int q = 0; q < 2; ++q) { const int idx = tid + NTHR * q; *(LAS v4u*)(vN + (idx >> 4) * GL_VP + (idx & 15) * 8) = vv[q]; }
    if (tid < 32) { float* dec = (float*)(ws + WS_DEC);
#pragma unroll
        for (int i = 0; i < 2; ++i) { dec[((size_t)(bh * 2 + 0) * NCH + ci) * 64 + 2 * d2 + i] = __expf(T.Ptot[i]); dec[((size_t)(bh * 2 + 1) * NCH + ci) * 64 + 2 * d2 + i] = __expf(T.Xtot[i]); } }
    __syncthreads();
    { const int dir = wave >> 2, e0 = (wave & 3) * 32, l31 = lane & 31, hh = lane >> 5;
        const LAS bf16* kT = dir ? kUb : kUf;
        float* U = (ci < 4) ? (float*)(ws + WS_UCTX) + ((size_t)(bh * 2 + dir) * 4 + ci) * 8192 : a.out + ((size_t)(bh * 2 + dir) * 64 + (ci - 4)) * 8192;
        bf16x8 A[4];
#pragma unroll
        for (int ks = 0; ks < 4; ++ks) A[ks] = tr_frag(vN, GL_VP, 16 * ks, e0, lane);
#pragma unroll
        for (int dt = 0; dt < 2; ++dt) { const int d0 = dt * 32; f32x16 acc;
#pragma unroll
            for (int i = 0; i < 16; ++i) acc[i] = 0.f;
#pragma unroll
            for (int ks = 0; ks < 4; ++ks) acc = mfma32(A[ks], tr_frag(kT, KP, 16 * ks, d0, lane), acc);
#pragma unroll
            for (int r = 0; r < 16; ++r) { const int e = e0 + (r & 3) + 8 * (r >> 2) + 4 * hh; U[e * 64 + d0 + l31] = acc[r]; } } }
    __syncthreads();
}

__device__ __forceinline__ void gla_scan_item(const Args& a, int it) {
    int tid = threadIdx.x; asm volatile("" : "+v"(tid));
    const int bd = it >> 4, dir = bd & 1, el = ((it & 15) * 8 + (tid >> 6)) * 64 + (tid & 63), d = tid & 63;
    unsigned char* ws = a.ws;
    const float* dec = (const float*)(ws + WS_DEC) + (size_t)bd * NCH * 64 + d;
    const float* Uc = (const float*)(ws + WS_UCTX) + (size_t)bd * 4 * 8192 + el;
    const float* U = a.out + (size_t)bd * 64 * 8192 + el;
    bf16* Sp = (bf16*)(ws + WS_SPREV) + (size_t)bd * 64 * 8192 + el;
    float S = 0.f;
#pragma unroll
    for (int c4 = 0; c4 < 4; ++c4) { const int ci = dir ? 3 - c4 : c4; S = dec[ci * 64] * S + Uc[(size_t)ci * 8192]; }
    {   float uu[64];
#pragma unroll
        for (int j = 0; j < 64; ++j) { const int n = dir ? 63 - j : j; uu[j] = U[(size_t)n * 8192]; }
#pragma unroll
        for (int blk = 0; blk < 2; ++blk) { float dd[32];
#pragma unroll
            for (int j = 0; j < 32; ++j) { const int n = dir ? 63 - (blk * 32 + j) : blk * 32 + j; dd[j] = dec[(4 + n) * 64]; }
#pragma unroll
            for (int j = 0; j < 32; ++j) { const int n = dir ? 63 - (blk * 32 + j) : blk * 32 + j; Sp[(size_t)n * 8192] = (bf16)f2bf(S); S = dd[j] * S + uu[blk * 32 + j]; } } }
}

template <bool HASN>
__device__ __forceinline__ void gla_out_item(const Args& a, LAS unsigned char* lds, int bh, int n, const GlaIn& I, int nbh, int nn, GlaIn& N) {
    int tid = threadIdx.x; asm volatile("" : "+v"(tid));
    const int lane = tid & 63, wave = tid >> 6, b = bh >> 2, h = bh & 3, l31 = lane & 31, hh = lane >> 5, d2 = tid & 31, sg = tid >> 5;
    unsigned char* ws = a.ws;
    LAS bf16* Scat = (LAS bf16*)lds;
    LAS bf16* vN = (LAS bf16*)(lds + GL_V);
    LAS bf16* qf = (LAS bf16*)(lds + 45056); LAS bf16* qb = qf + 4608; LAS bf16* kf = qf + 2 * 4608; LAS bf16* kb = qf + 3 * 4608;
    LAS float* oS = (LAS float*)(lds + 45056);
    LAS bf16* qS = (LAS bf16*)(lds + 81920);
    LAS bf16* Sp = (LAS bf16*)(lds + 99328);
    const size_t rowbase = (size_t)b * SEQ + n * 64;
    unsigned qw[4], kw[4];
#pragma unroll
    for (int q = 0; q < 4; ++q) { qw[q] = I.qw[q]; kw[q] = I.kw[q]; }
    v4u vv[2], sv[4], g0, g1;
    { const bf16* qkvg = (const bf16*)(ws + WS_QKVG);
        { const bf16* gp = qkvg + (rowbase + (tid >> 3)) * NQ + 1024 + h * 128 + (tid & 7) * 16; g0 = *(const v4u*)gp; g1 = *(const v4u*)(gp + 8); }
#pragma unroll
        for (int q = 0; q < 2; ++q) { const int idx = tid + NTHR * q; vv[q] = *(const v4u*)(qkvg + (rowbase + (idx >> 4)) * NQ + 512 + h * 128 + (idx & 15) * 8); }
        const bf16* spf = (const bf16*)(ws + WS_SPREV) + ((size_t)(bh * 2 + 0) * 64 + n) * 8192; const bf16* spb = (const bf16*)(ws + WS_SPREV) + ((size_t)(bh * 2 + 1) * 64 + n) * 8192;
#pragma unroll
        for (int q = 0; q < 4; ++q) { const int idx = tid + NTHR * q, dir = idx >> 10, e = (idx >> 3) & 127, d8 = (idx & 7) * 8; sv[q] = *(const v4u*)((dir ? spb : spf) + e * 64 + d8); } }
    gla_stage_common(I, lds, tid);
    __syncthreads();
    if (HASN) gla_load<true>(a, tid, nbh, nn, N);
    GlaTab T; gla_tables(a, h, lds, T, tid);
#pragma unroll
    for (int q = 0; q < 4; ++q) { const int s = sg * 4 + q; const float q0 = bflo(qw[q]), q1 = bfhi(qw[q]), k0 = bflo(kw[q]), k1 = bfhi(kw[q]);
        *(LAS unsigned*)(qf + s * 72 + 2 * d2) = pk2(q0 * __expf(T.P[q][0] - T.Pref[0]), q1 * __expf(T.P[q][1] - T.Pref[1]));
        *(LAS unsigned*)(kf + s * 72 + 2 * d2) = pk2(k0 * __expf(T.Pref[0] - T.P[q][0]), k1 * __expf(T.Pref[1] - T.P[q][1]));
        *(LAS unsigned*)(qb + s * 72 + 2 * d2) = pk2(q0 * __expf(T.X[q][0] - T.Xref[0]), q1 * __expf(T.X[q][1] - T.Xref[1]));
        *(LAS unsigned*)(kb + s * 72 + 2 * d2) = pk2(k0 * __expf(T.Xref[0] - T.X[q][0]), k1 * __expf(T.Xref[1] - T.X[q][1]));
        *(LAS unsigned*)(qS + s * 136 + 2 * d2) = pk2(q0 * __expf(T.P[q][0]), q1 * __expf(T.P[q][1]));
        *(LAS unsigned*)(qS + s * 136 + 64 + 2 * d2) = pk2(q0 * __expf(T.X[q][0]), q1 * __expf(T.X[q][1])); }
#pragma unroll
    for (int q = 0; q < 2; ++q) { const int idx = tid + NTHR * q; *(LAS v4u*)(vN + (idx >> 4) * GL_VP + (idx & 15) * 8) = vv[q]; }
#pragma unroll
    for (int q = 0; q < 4; ++q) { const int idx = tid + NTHR * q, dir = idx >> 10, e = (idx >> 3) & 127, d8 = (idx & 7) * 8; *(LAS v4u*)(Sp + e * 136 + dir * 64 + d8) = sv[q]; }
    __syncthreads();
    { const int dir = wave >> 2, c0 = ((wave >> 1) & 1) * 32, s0 = (wave & 1) * 32;
        const LAS bf16* qq = dir ? qb : qf; const LAS bf16* kk = dir ? kb : kf;
        f32x16 acc;
#pragma unroll
        for (int i = 0; i < 16; ++i) acc[i] = 0.f;
#pragma unroll
        for (int ks = 0; ks < 4; ++ks) { const bf16x8 A = *(const LAS bf16x8*)(qq + (c0 + l31) * 72 + 16 * ks + 8 * hh), B = *(const LAS bf16x8*)(kk + (s0 + l31) * 72 + 16 * ks + 8 * hh);
            acc = mfma32(A, B, acc); }
        const int s = s0 + l31;
#pragma unroll
        for (int r = 0; r < 16; ++r) { const int c = c0 + (r & 3) + 8 * (r >> 2) + 4 * hh; const bool keep = dir ? (s >= c) : (s <= c);
            Scat[c * 136 + dir * 64 + s] = (bf16)f2bf(keep ? acc[r] : 0.f); } }
    __syncthreads();
    { const int c0 = (wave >> 2) * 32, e0 = (wave & 3) * 32;
        f32x16 acc;
#pragma unroll
        for (int i = 0; i < 16; ++i) acc[i] = 0.f;
#pragma unroll
        for (int ks = 0; ks < 8; ++ks) { const bf16x8 A = *(const LAS bf16x8*)(Scat + (c0 + l31) * 136 + 16 * ks + 8 * hh);
            acc = mfma32(A, tr_frag(vN, GL_VP, 16 * (ks & 3), e0, lane), acc); }
#pragma unroll
        for (int ks = 0; ks < 8; ++ks) { const bf16x8 A = *(const LAS bf16x8*)(qS + (c0 + l31) * 136 + 16 * ks + 8 * hh), B = *(const LAS bf16x8*)(Sp + (e0 + l31) * 136 + 16 * ks + 8 * hh);
            acc = mfma32(A, B, acc); }
#pragma unroll
        for (int r = 0; r < 16; ++r) { const int c = c0 + (r & 3) + 8 * (r >> 2) + 4 * hh; oS[c * 132 + e0 + l31] = acc[r]; } }
    __syncthreads();
    { const int row = tid >> 3, ec = (tid & 7) * 16; float v[16]; float ss = 0.f;
#pragma unroll
        for (int j = 0; j < 16; ++j) { v[j] = oS[row * 132 + ec + j]; ss += v[j] * v[j]; }
        ss += __shfl_xor(ss, 1); ss += __shfl_xor(ss, 2); ss += __shfl_xor(ss, 4);
        const float rs = rsqrtf(ss * (1.0f / 128.0f) + EPS);
        const float gv[16] = {bflo(g0.x), bfhi(g0.x), bflo(g0.y), bfhi(g0.y), bflo(g0.z), bfhi(g0.z), bflo(g0.w), bfhi(g0.w), bflo(g1.x), bfhi(g1.x), bflo(g1.y), bfhi(g1.y), bflo(g1.z), bfhi(g1.z), bflo(g1.w), bfhi(g1.w)};
        float o[16];
#pragma unroll
        for (int j = 0; j < 16; ++j) o[j] = DBG_GLA_K * v[j] * rs * a.in[12][ec + j] * silu_f(gv[j]);
        bf16* op = (bf16*)(ws + WS_AOUT) + (rowbase + row) * DM + h * 128 + ec;
        *(v4u*)op = (v4u){pk2(o[0], o[1]), pk2(o[2], o[3]), pk2(o[4], o[5]), pk2(o[6], o[7])};
        *(v4u*)(op + 8) = (v4u){pk2(o[8], o[9]), pk2(o[10], o[11]), pk2(o[12], o[13]), pk2(o[14], o[15])}; }
    __syncthreads();
}

__device__ __forceinline__ void hy_transpose_item(const Args& a, LAS unsigned char* lds, int it) {
    const int tid = threadIdx.x, b = it >> 6, t0 = (it & 63) * 64;
    LAS float* tile = (LAS float*)lds;
    const bf16* src = (const bf16*)(a.ws + WS_HYT) + (size_t)b * 1536 * SEQ + t0;
    bf16* dst = (bf16*)(a.ws + WS_AOUT) + ((size_t)b * SEQ + t0) * DM + 512;
    v4u raw[2][4];
#pragma unroll
    for (int half = 0; half < 2; ++half)
#pragma unroll
        for (int q = 0; q < 4; ++q) { const int id = tid + NTHR * q, c = id >> 3, p8 = id & 7; raw[half][q] = *(const v4u*)(src + (size_t)(half * 256 + c) * SEQ + 8 * p8); }
#pragma unroll
    for (int half = 0; half < 2; ++half) {
#pragma unroll
        for (int q = 0; q < 4; ++q) { const int id = tid + NTHR * q, c = id >> 3, p8 = id & 7; LAS float* d = tile + c * 65 + 8 * p8; const v4u w = raw[half][q];
            d[0] = bflo(w.x); d[1] = bfhi(w.x); d[2] = bflo(w.y); d[3] = bfhi(w.y); d[4] = bflo(w.z); d[5] = bfhi(w.z); d[6] = bflo(w.w); d[7] = bfhi(w.w); }
        __syncthreads();
#pragma unroll
        for (int q = 0; q < 4; ++q) { const int idx = tid + NTHR * q, t = idx >> 5, c8 = (idx & 31) * 8; const LAS float* s = tile + c8 * 65 + t;
            *(v4u*)(dst + (size_t)t * DM + half * 256 + c8) = (v4u){pk2(s[0], s[65]), pk2(s[2 * 65], s[3 * 65]), pk2(s[4 * 65], s[5 * 65]), pk2(s[6 * 65], s[7 * 65])}; }
        __syncthreads();
    }
}

__device__ __forceinline__ void phase_router(const Args& a, LAS unsigned char* lds) {
    const int tid = threadIdx.x, lane = tid & 63, wave = tid >> 6, wg = blockIdx.x, G = gridDim.x;
    unsigned char* ws = a.ws;
    LAS unsigned short* HT = (LAS unsigned short*)lds;
    LAS float* red = (LAS float*)lds;
    const float* modr = (const float*)(ws + WS_MOD); const float* gffn = a.in[23];
    unsigned char* hn8 = ws + WS_HN; float* aff = (float*)(ws + WS_AFF); const bf16* x1b = (const bf16*)(ws + WS_X1B);
    const int NGW = G * NWAVES, m16 = lane & 15, kg = lane >> 4;
    pg8::bf16x8 Bh[4], Bl[4];
    {   float braw[4][8];
#pragma unroll
        for (int s4 = 0; s4 < 4; ++s4)
#pragma unroll
            for (int jj = 0; jj < 8; ++jj) braw[s4][jj] = a.in[24][(32 * (4 * wave + s4) + 8 * kg + jj) * 16 + m16];
#pragma unroll
        for (int s4 = 0; s4 < 4; ++s4) split8(braw[s4], Bh[s4], Bl[s4]); }
    f32x4 gv[4];
#pragma unroll
    for (int j = 0; j < 4; ++j) gv[j] = *(const f32x4*)(gffn + 4 * lane + 256 * j);
#pragma nounroll
    for (int t = 0; (t * 8) * NGW + wg * NWAVES < MX; ++t) {
#pragma nounroll
        for (int trip = 0; trip < 4; ++trip) {
            const int i0 = 2 * trip, r0q = wg * NWAVES + wave + (t * 8 + i0) * NGW, r1q = r0q + NGW; const bool ok0 = r0q < MX, ok1 = r1q < MX; const int rA = ok0 ? r0q : 0, rB = ok1 ? r1q : rA;
            f32x4 v[2][4];
#pragma unroll
            for (int j = 0; j < 4; ++j) { const v2u w0 = *(const v2u*)(x1b + (size_t)rA * DM + 4 * lane + 256 * j), w1 = *(const v2u*)(x1b + (size_t)rB * DM + 4 * lane + 256 * j);
                v[0][j] = (f32x4){bflo(w0.x), bfhi(w0.x), bflo(w0.y), bfhi(w0.y)}; v[1][j] = (f32x4){bflo(w1.x), bfhi(w1.x), bflo(w1.y), bfhi(w1.y)}; }
            f32x4 shv[2][4], scv[2][4];
#pragma unroll
            for (int k = 0; k < 2; ++k)
#pragma unroll
                for (int j = 0; j < 4; ++j) { const int b = (k ? rB : rA) >> 12, col = 4 * lane + 256 * j; shv[k][j] = *(const f32x4*)(modr + b * 6144 + 3072 + col); scv[k][j] = *(const f32x4*)(modr + b * 6144 + 4096 + col); }
#pragma unroll
            for (int k = 0; k < 2; ++k) { float ss = 0.f; const int r = k ? rB : rA; const bool ok = k ? ok1 : ok0;
#pragma unroll
                for (int j = 0; j < 4; ++j) ss += v[k][j][0] * v[k][j][0] + v[k][j][1] * v[k][j][1] + v[k][j][2] * v[k][j][2] + v[k][j][3] * v[k][j][3];
                const float rs = rsqrtf(wave_sum(ss) * (1.0f / DM) + EPS);
#pragma unroll
                for (int j = 0; j < 4; ++j) { const int col = 4 * lane + 256 * j;
                    const f32x4 y = (v[k][j] * rs * gv[j]) * (scv[k][j] + 1.0f) + shv[k][j];
                    v2u w; w.x = pk2(y[0], y[1]); w.y = pk2(y[2], y[3]);
                    if (ok) *(unsigned*)(hn8 + (size_t)r * DM + col) = pk_fp8x4(y[0], y[1], y[2], y[3]);
                    *(LAS v2u*)(HT + (wave * 8 + i0 + k) * 1032 + col) = w; } } }
        __syncthreads();
        f32x4 acc[4];
#pragma unroll
        for (int mt = 0; mt < 4; ++mt) { acc[mt] = (f32x4){0.f, 0.f, 0.f, 0.f};
#pragma unroll
            for (int s4 = 0; s4 < 4; ++s4) { const pg8::bf16x8 A = *(const LAS pg8::bf16x8*)(HT + (16 * mt + m16) * 1032 + 32 * (4 * wave + s4) + 8 * kg);
                acc[mt] = __builtin_amdgcn_mfma_f32_16x16x32_bf16(A, Bl[s4], acc[mt], 0, 0, 0);
                acc[mt] = __builtin_amdgcn_mfma_f32_16x16x32_bf16(A, Bh[s4], acc[mt], 0, 0, 0); } }
        __syncthreads();
#pragma unroll
        for (int mt = 0; mt < 4; ++mt)
#pragma unroll
            for (int r = 0; r < 4; ++r) red[(wave * 64 + 16 * mt + 4 * kg + r) * 16 + m16] = acc[mt][r];
        __syncthreads();
        {
            const int lr = tid >> 3, k0 = 2 * (tid & 7); float la = 0.f, lb = 0.f;
#pragma unroll
            for (int w = 0; w < 8; ++w) { const LAS float* e = red + (w * 64 + lr) * 16 + k0; la += e[0]; lb += e[1]; }
            float mx = fmaxf(la, lb); mx = fmaxf(mx, dpp_f<0xB1>(mx)); mx = fmaxf(mx, dpp_f<0x4E>(mx)); mx = fmaxf(mx, dpp_f<0x141>(mx));
            const float pa = __expf(la - mx), pb = __expf(lb - mx);
            float sum = pa + pb; sum += dpp_f<0xB1>(sum); sum += dpp_f<0x4E>(sum); sum += dpp_f<0x141>(sum);
            const float inv = __builtin_amdgcn_rcpf(sum);
            const int r = wg * NWAVES + (lr >> 3) + (t * 8 + (lr & 7)) * NGW;
            if (r < MX) { const int b = r >> 12, tok = r & 4095; aff[((size_t)b * NE + k0) * SEQ + tok] = pa * inv; aff[((size_t)b * NE + k0 + 1) * SEQ + tok] = pb * inv; } }
        __syncthreads();
    }
}

__device__ __forceinline__ void transpose_item8(const float* W, int k0, int nsrc0, unsigned char* WT, int drow0, LAS float* scr, int lane) {
    float tv[32];
#pragma unroll
    for (int i = 0; i < 32; ++i) { const int kk = 2 * i + (lane >> 5); tv[i] = W[(size_t)(k0 + kk) * DM + nsrc0 + (lane & 31)]; }
#pragma unroll
    for (int i = 0; i < 32; ++i) { const int kk = 2 * i + (lane >> 5); scr[kk * 33 + (lane & 31)] = tv[i] * F8_WSCALE; }
    LDS_WAIT();
    const int c = lane & 7;
#pragma unroll
    for (int j = 0; j < 4; ++j) { const int n = (lane >> 3) + 8 * j; const LAS float* s = scr + (8 * c) * 33 + n;
        v2u o; o.x = pk_fp8x4(s[0 * 33], s[1 * 33], s[2 * 33], s[3 * 33]); o.y = pk_fp8x4(s[4 * 33], s[5 * 33], s[6 * 33], s[7 * 33]);
        *(v2u*)(WT + (size_t)(drow0 + n) * DM + k0 + 8 * c) = o; }
    LDS_WAIT();
}
__device__ __forceinline__ void conv_item(const Args& a, LAS float* scr, int lane, bool gu, int it) {
    unsigned char* ws = a.ws;
    if (gu) { const int mat = it >> 9, r = it & 511, nb = r >> 4, kb = r & 15, e = mat >> 1, kind = mat & 1, n0 = nb * 32;
        transpose_item8((kind ? a.in[26] : a.in[25]) + (size_t)e * DM * DM, kb * 64, n0, ws + WS_WGU + (size_t)e * 2048 * DM, (n0 >> 7) * 256 + kind * 128 + (n0 & 127), scr, lane);
    } else { const int e = it >> 9, r = it & 511, nb = r >> 4, kb = r & 15;
        transpose_item8(a.in[27] + (size_t)e * DM * DM, kb * 64, nb * 32, ws + WS_WD + (size_t)e * DM * DM, nb * 32, scr, lane); }
}
__device__ __forceinline__ bool conv_try(const Args& a, LAS unsigned char* lds, bool allow_gu, unsigned& cur, int tx) {
    const int lane = tx & 63, wave = tx >> 6;
    if (wave == 0) return false;
    const int gw = blockIdx.x * (NWAVES - 1) + wave - 1, NGW = gridDim.x * (NWAVES - 1);
    LAS float* scr = (LAS float*)(lds + wave * 8448);
    const int itD = gw + (int)(cur & 0xffffu) * NGW;
    if (itD < NE * 512) { conv_item(a, scr, lane, false, itD); cur += 1u; return true; }
    if (!allow_gu) return false;
    const int itG = gw + (int)(cur >> 16) * NGW;
    if (itG < NE * 1024) { conv_item(a, scr, lane, true, itG); cur += 0x10000u; return true; }
    return false;
}
#ifndef DBG_NOSHADOW
#define DBG_NOSHADOW 0
#endif
#ifndef SHADOW_LIM
#define SHADOW_LIM 2
#endif
__device__ __forceinline__ void seam_barrier(const XcdBarrier& b, const Args& a, LAS unsigned char* lds, volatile LAS unsigned* MISC, const unsigned gen, bool allow_gu, unsigned& cdone) {
    asm volatile("s_waitcnt vmcnt(0)" ::: "memory");
    __syncthreads();
    const int tx = tid_hw(lds);
    if (tx < 64) {
        if (tx == 0) {
            unsigned* bar = b.bar;
            __builtin_amdgcn_s_waitcnt(0);
            unsigned nloc = b.st[0], nx = b.st[1];
            if (nloc == 0u) { xcd_barrier_complete(bar, b.x, nloc, nx); b.st[0] = nloc; b.st[1] = nx; }
            const unsigned old = xb_add(&bar[XB_XSUB(b.x)], 1u);
            const unsigned g2 = old / nloc;
            if (old + 1u == (g2 + 1u) * nloc) {
                __builtin_amdgcn_fence(__ATOMIC_RELEASE, "agent");
                asm volatile("s_waitcnt vmcnt(0)" ::: "memory");
                const unsigned og = xb_add(&bar[XB_TOP], 1u);
                const unsigned tg = og / nx;
                if (og + 1u == (tg + 1u) * nx) xb_add(&bar[XB_TOPGEN], 1u);
                else XB_SPIN(xb_ld(&bar[XB_TOPGEN]) == tg, bar);
                __builtin_amdgcn_fence(__ATOMIC_ACQUIRE, "agent");
                xb_add(&bar[XB_XGEN(b.x)], 1u);
                asm volatile("s_waitcnt vmcnt(0)" ::: "memory");
            } else {
                XB_SPIN(xb_ld(&bar[XB_XGEN(b.x)]) == g2, bar);
                __builtin_amdgcn_fence(__ATOMIC_ACQUIRE, "agent");
                asm volatile("s_waitcnt vmcnt(0)" ::: "memory");
            }
            MISC[16] = gen;
        }
    } else {
        unsigned spins = 0; int ndone = 0;
        while (MISC[16] != gen) { if (DBG_NOSHADOW || ndone >= SHADOW_LIM || !conv_try(a, lds, allow_gu, cdone, tx)) { __builtin_amdgcn_s_sleep(4); if (++spins > (1u << 22)) break; } else ++ndone; }
    }
    __syncthreads();
}

__device__ __forceinline__ void block_excl_scan2(int& va, int& vb, LAS int* tmp) {
    const int tid = threadIdx.x, lane = tid & 63, wave = tid >> 6;
    int ia = va, ib = vb;
#pragma unroll
    for (int o = 1; o < 64; o <<= 1) { const int ta = __shfl_up(ia, o), tb = __shfl_up(ib, o); if (lane >= o) { ia += ta; ib += tb; } }
    if (lane == 63) { tmp[wave] = ia; tmp[8 + wave] = ib; }
    __syncthreads();
    int oa = 0, ob = 0;
#pragma unroll
    for (int w = 0; w < 8; ++w) { if (w < wave) { oa += tmp[w]; ob += tmp[8 + w]; } }
    va = oa + ia - va; vb = ob + ib - vb;
    __syncthreads();
}
__device__ __forceinline__ void topk_item(const Args& a, LAS unsigned char* lds, int be) {
    const int tid = threadIdx.x, b = be >> 4, e = be & 15;
    unsigned char* ws = a.ws;
    LAS unsigned* keys = (LAS unsigned*)lds;
    LAS unsigned* hist = (LAS unsigned*)(lds + 16384);
    LAS int* ctl = (LAS int*)(lds + 16384 + 1024);
    LAS int* tmp = (LAS int*)(lds + 16384 + 1024 + 64);
    LAS int* selL = (LAS int*)(lds + 20480);
    const float* aff = (const float*)(ws + WS_AFF) + (size_t)be * SEQ;
    unsigned my[8];
#pragma unroll
    for (int i = 0; i < 8; ++i) { my[i] = __float_as_uint(aff[tid * 8 + i]); keys[tid * 8 + i] = my[i]; }
    unsigned prefix = 0u, mask = 0u; int need = CAP;
    for (int pass = 0; pass < 4; ++pass) {
        const int shift = 24 - 8 * pass;
        if (tid < 256) hist[tid] = 0u;
        __syncthreads();
#pragma unroll
        for (int i = 0; i < 8; ++i) {
            const bool live = (my[i] & mask) == prefix; const unsigned bin = (my[i] >> shift) & 255u;
            const unsigned long long lm = __ballot(live);
            if (lm != 0ull) { const int leader = (int)__ffsll((long long)lm) - 1; const unsigned lb = (unsigned)__builtin_amdgcn_readlane((int)bin, leader);
                if (__ballot(live && bin != lb) == 0ull) { if ((tid & 63) == leader) atomicAdd((unsigned*)&hist[lb], (unsigned)__popcll(lm)); }
                else if (live) atomicAdd((unsigned*)&hist[bin], 1u); } }
        __syncthreads();
        {
            int hv = (tid < 256) ? (int)hist[255 - tid] : 0, inc = hv;
#pragma unroll
            for (int o = 1; o < 64; o <<= 1) { const int t2 = __shfl_up(inc, o); if ((tid & 63) >= o) inc += t2; }
            if ((tid & 63) == 63) tmp[tid >> 6] = inc;
            __syncthreads();
            int off = 0;
#pragma unroll
            for (int w = 0; w < 4; ++w) if (w < (tid >> 6)) off += tmp[w];
            inc += off;
            if (tid < 256 && inc >= need && inc - hv < need) { ctl[0] = 255 - tid; ctl[1] = need - (inc - hv); }
        }
        __syncthreads();
        prefix |= ((unsigned)ctl[0]) << shift; mask |= 255u << shift; need = ctl[1];
        __syncthreads();
    }
    const unsigned T = prefix;
    int cg = 0, ce = 0;
#pragma unroll
    for (int i = 0; i < 8; ++i) { cg += (my[i] > T) ? 1 : 0; ce += (my[i] == T) ? 1 : 0; }
    int pg = cg, pe = ce;
    block_excl_scan2(pg, pe, tmp);
    int* slot_of = (int*)(ws + WS_SLOT) + (size_t)be * SEQ;
    int* selt = (int*)(ws + WS_SELT) + (e * 4 + b) * CAP; float* selv = (float*)(ws + WS_SELV) + (e * 4 + b) * CAP;
#pragma unroll
    for (int i = 0; i < 8; ++i) { const int t = tid * 8 + i; const bool gt = my[i] > T, eq = my[i] == T; const bool sel = gt || (eq && pe < need);
        const int slot = pg + (pe < need ? pe : need);
        slot_of[t] = sel ? slot : -1;
        if (sel) { selt[slot] = t; selv[slot] = __uint_as_float(my[i]); selL[slot] = t; }
        pg += gt ? 1 : 0; pe += eq ? 1 : 0; }
    __syncthreads();
    {
        const int lane = tid & 63, wave = tid >> 6;
        const unsigned char* src = ws + WS_HN + (size_t)b * SEQ * DM + 16 * lane; unsigned char* dst = ws + WS_HNG + (size_t)((e * 4 + b) * CAP) * DM + 16 * lane;
#pragma nounroll
        for (int s0 = wave * 64; s0 < wave * 64 + 64; s0 += 16) { v4u r[16];
#pragma unroll
            for (int q = 0; q < 16; ++q) r[q] = *(const v4u*)(src + (size_t)selL[s0 + q] * DM);
#pragma unroll
            for (int q = 0; q < 16; ++q) *(v4u*)(dst + (size_t)(s0 + q) * DM) = r[q]; } }
    __syncthreads();
}
__device__ __forceinline__ void phase_topk(const Args& a, LAS unsigned char* lds, unsigned& cdone) {
    const int tid = threadIdx.x, lane = tid & 63, wave = tid >> 6, wg = blockIdx.x, G = gridDim.x;
    unsigned char* ws = a.ws;
    for (int it = wg; it < NB * NE; it += G) topk_item(a, lds, it);
    __syncthreads();
    while (conv_try(a, lds, true, cdone, tid)) {}
}

__device__ __forceinline__ void phase_final(const Args& a, LAS unsigned char* lds) {
    const int tid = tid_hw(lds), lane = tid & 63, wave = tid >> 6, wg = blockIdx.x, G = gridDim.x;
    unsigned char* ws = a.ws;
    const float* modr = (const float*)(ws + WS_MOD); const int* slot_of = (const int*)(ws + WS_SLOT); const unsigned char* ys = ws + WS_YSLAB; const bf16* x1b = (const bf16*)(ws + WS_X1B);
    const int NGW = G * NWAVES;
    f32x4 gf[4];
#pragma unroll
    for (int j = 0; j < 4; ++j) gf[j] = *(const f32x4*)(a.in[28] + 4 * lane + 256 * j);
#pragma nounroll
    for (int r0 = wg * NWAVES + wave; r0 < MX; r0 += 4 * NGW) {
        int sv[4]; unsigned long long mk[4]; f32x4 v[4][4], m[4][4];
#pragma unroll
        for (int k = 0; k < 4; ++k) { const int r = r0 + k * NGW; const bool ok = r < MX; const int rc = ok ? r : r0, b = rc >> 12, t = rc & 4095;
            sv[k] = (lane < NE) ? slot_of[((size_t)b * NE + lane) * SEQ + t] : -1;
#pragma unroll
            for (int j = 0; j < 4; ++j) { const v2u w0 = *(const v2u*)(x1b + (size_t)rc * DM + 4 * lane + 256 * j); v[k][j] = (f32x4){bflo(w0.x), bfhi(w0.x), bflo(w0.y), bfhi(w0.y)}; m[k][j] = (f32x4){0.f, 0.f, 0.f, 0.f}; }
            mk[k] = (ok && !DBG_NOMOE) ? __ballot(sv[k] >= 0) : 0ull; }
        while (mk[0] | mk[1] | mk[2] | mk[3]) {
            unsigned w[4][4]; float wt[4];
#pragma unroll
            for (int k = 0; k < 4; ++k) { const bool has = mk[k] != 0ull; const int e = has ? (int)__ffsll((long long)mk[k]) - 1 : 0; mk[k] &= mk[k] - 1ull;
                const int rc = (r0 + k * NGW < MX) ? r0 + k * NGW : r0; const int sl = has ? __builtin_amdgcn_readlane(sv[k], e) : 0;
                const unsigned char* yp = ys + ((size_t)e * 2048 + (rc >> 12) * CAP + sl) * DM; wt[k] = has ? (1.0f / F8_YSCALE) : 0.f;
#pragma unroll
                for (int j = 0; j < 4; ++j) w[k][j] = *(const unsigned*)(yp + 4 * lane + 256 * j); }
#pragma unroll
            for (int k = 0; k < 4; ++k)
#pragma unroll
                for (int j = 0; j < 4; ++j) { typedef float f32x2v_ __attribute__((ext_vector_type(2)));
                    const f32x2v_ lo = __builtin_amdgcn_cvt_pk_f32_fp8((int)w[k][j], false), hi = __builtin_amdgcn_cvt_pk_f32_fp8((int)w[k][j], true);
                    m[k][j][0] += wt[k] * lo[0]; m[k][j][1] += wt[k] * lo[1]; m[k][j][2] += wt[k] * hi[0]; m[k][j][3] += wt[k] * hi[1]; }
        }
        f32x4 gt[4][4];
#pragma unroll
        for (int k = 0; k < 4; ++k) { const int r = r0 + k * NGW, b = ((r < MX) ? r : r0) >> 12;
#pragma unroll
            for (int j = 0; j < 4; ++j) gt[k][j] = *(const f32x4*)(modr + b * 6144 + 5120 + 4 * lane + 256 * j); }
#pragma unroll
        for (int k = 0; k < 4; ++k) { const int r = r0 + k * NGW;
            if (r < MX) { float ss = 0.f; float* row = a.out + (size_t)r * DM;
#pragma unroll
                for (int j = 0; j < 4; ++j) { v[k][j] = v[k][j] + gt[k][j] * m[k][j] * DBG_MOE_K;
                    ss += v[k][j][0] * v[k][j][0] + v[k][j][1] * v[k][j][1] + v[k][j][2] * v[k][j][2] + v[k][j][3] * v[k][j][3]; }
                const float rs = rsqrtf(wave_sum(ss) * (1.0f / DM) + EPS);
#pragma unroll
                for (int j = 0; j < 4; ++j) *(f32x4*)(row + 4 * lane + 256 * j) = v[k][j] * rs * gf[j]; } }
    }
}

__global__ void __launch_bounds__(NTHR, 2) fwd_kernel(Args a) {
    extern __shared__ __attribute__((aligned(16))) unsigned char lds_raw[];
    LAS unsigned char* lds = (LAS unsigned char*)lds_raw;
    const int tid = threadIdx.x, wg = blockIdx.x, G = gridDim.x;
    unsigned char* ws = a.ws;
    volatile LAS unsigned* MISC = (volatile LAS unsigned*)(lds + LDS_MISC);
    if (tid < 64) MISC[tid] = 0u;
    if ((tid & 63) == 0) ((volatile LAS int*)(lds + LDS_MAP))[hw_wave_key()] = tid >> 6;
    __syncthreads();
    unsigned cdone = 0u;
    if (a.ph_hi - a.ph_lo > 1) (void)xcd_barrier_post((unsigned*)(ws + WS_CTL), MISC + 8);
#define bar (XcdBarrier{(unsigned*)(ws + WS_CTL), xb_xcc_id(), MISC + 8})
#ifndef PH_ONLY
#define PH_ONLY -1
#endif
#define IN(k) ((PH_ONLY < 0 || PH_ONLY == (k)) && a.ph_lo <= (k) && (k) < a.ph_hi)
#ifndef DBG_BAR2
#define DBG_BAR2 0
#endif
#ifndef DBG_TSA
#define DBG_TSA -1
#endif
#ifndef DBG_TSB
#define DBG_TSB -1
#endif
#define STAMP(k) do { if (DBG_TSA >= 0 && wg == 0 && tid == 0) ((unsigned long long*)(ws + WS_CTL + 49152))[k] = __builtin_amdgcn_s_memrealtime(); } while (0)
#define SEAM(k) do { if (IN(k) && IN((k) + 1)) { const unsigned sgen = (unsigned)((k) + 1 - a.ph_lo); if ((k) >= 8) { unsigned cnone = 0xffffffffu; seam_barrier(bar, a, lds, MISC, sgen, true, cnone); } else seam_barrier(bar, a, lds, MISC, sgen, true, cdone); if (DBG_BAR2) xcd_barrier(bar); } STAMP((k) + 1); } while (0)
#ifndef DBG_DUP
#define DBG_DUP -1
#endif
#define REP(k) _Pragma("nounroll") for (int _rep = 0; _rep < ((DBG_DUP == (k)) ? 2 : 1); ++_rep, (void)((DBG_DUP == (k) && _rep == 1) ? (xcd_barrier(bar), 0) : 0))
    STAMP(0);
    if (IN(0)) REP(0) { phase0(a, lds); } SEAM(0);
    if (IN(1)) REP(1) { phase1(a, lds); } SEAM(1);
    if (IN(2)) REP(2) {
        pg8::Gemm g{(const pg8::bf16_t*)ws, (const pg8::bf16_t*)ws, MT, NIN, DM}; InSched S; S.init(G, wg, 0);
        EpiIn E{(bf16*)(ws + WS_QKVG), (bf16*)(ws + WS_HYT), (float*)(ws + WS_AFB)};
        pg8::gemm_phase<EpiIn, InSched, true, true>(lds, g, S, E);
    } SEAM(2);
    if (IN(3)) REP(3) {
        {   pg8::Gemm g{(const pg8::bf16_t*)ws, (const pg8::bf16_t*)ws, MT, NIN, DM}; InSched S; S.init(G, wg, 1);
            EpiIn E{(bf16*)(ws + WS_QKVG), (bf16*)(ws + WS_HYT), (float*)(ws + WS_AFB)};
            pg8::gemm_phase<EpiIn, InSched, true, true>(lds, g, S, E); }
        for (int it = wg; it < 512; it += G) hyena_item(a, lds, it, 0);
        {   GlaIn I, N; bool have = false;
            const bool split = (G == 256);
            const int first = split ? ((wg < 80) ? wg : 80 + wg) : wg, stride = split ? ((wg < 80) ? 80 : 176) : G, limit = split ? ((wg < 80) ? 160 : 16 * NCH) : 16 * NCH;
            for (int r = first; r < limit; r += stride) {
                const int nr = r + stride; const bool hasn = nr < limit;
                if (!have) { int t0 = threadIdx.x; asm volatile("" : "+v"(t0)); gla_load<false>(a, t0, r / NCH, r % NCH, I); have = true; }
                if (hasn) gla_upd_item<true>(a, lds, r / NCH, r % NCH, I, nr / NCH, nr % NCH, N); else gla_upd_item<false>(a, lds, r / NCH, r % NCH, I, 0, 0, N);
                I = N; } }
    } SEAM(3);
    if (IN(4)) REP(4) {
        for (int it = wg; it < 1024; it += G) { if (it < 512) hyena_item(a, lds, it, 1); else gla_scan_item(a, it - 512); }
    } SEAM(4);
    if (IN(5)) REP(5) {
        GlaIn I, N; bool have = false;
        for (int it = wg; it < 1280; it += G) {
            if (it >= 1024) { hy_transpose_item(a, lds, it - 1024); continue; }
            const int nr = it + G; const bool hasn = nr < 1024;
            if (!have) { int t0 = threadIdx.x; asm volatile("" : "+v"(t0)); gla_load<true>(a, t0, it >> 6, it & 63, I); have = true; }
            if (hasn) gla_out_item<true>(a, lds, it >> 6, it & 63, I, nr >> 6, nr & 63, N); else gla_out_item<false>(a, lds, it >> 6, it & 63, I, 0, 0, N);
            I = N; }
    } SEAM(5);
    if (IN(6)) REP(6) {
        pg8::Gemm g{(const pg8::bf16_t*)(ws + WS_AOUT), (const pg8::bf16_t*)(ws + WS_WOUT), MX, DM, DM}; pg8::StaticOrder S; S.init(MX, DM, G, wg);
        EpiOut E{a.in[0], (const float*)(ws + WS_POS), (const float*)(ws + WS_MOD), (bf16*)(ws + WS_X1B)};
        pg8::gemm_phase<EpiOut, pg8::StaticOrder, false, true>(lds, g, S, E);
    } SEAM(6);
    if (IN(7)) REP(7) { phase_router(a, lds); } SEAM(7);
    if (IN(8)) REP(8) { phase_topk(a, lds, cdone); } SEAM(8);
    if (IN(9)) REP(9) {
        pg8::Gemm g{(const pg8::bf16_t*)(ws + WS_HNG), (const pg8::bf16_t*)(ws + WS_WGU), NE * 2048, NE * 2048, DM / 2}; MoeSched<8> S; S.init(G, wg);
        EpiGU E{ws + WS_HID};
        pg8::gemm_phase<EpiGU, MoeSched<8>, true, true, true>(lds, g, S, E);
    } SEAM(9);
    if (IN(10)) REP(10) {
        pg8::Gemm g{(const pg8::bf16_t*)(ws + WS_HID), (const pg8::bf16_t*)(ws + WS_WD), NE * 2048, NE * 1024, DM / 2}; MoeSched<4> S; S.init(G, wg);
        EpiDown E{ws + WS_YSLAB, (const float*)(ws + WS_SELV)};
        pg8::gemm_phase<EpiDown, MoeSched<4>, true, true, true>(lds, g, S, E);
    } SEAM(10);
    if (IN(11)) { phase_final(a, lds); }
    if (DBG_TSA >= 0) {
        xcd_barrier(bar); STAMP(12); xcd_barrier(bar);
        const unsigned long long* ts = (const unsigned long long*)(ws + WS_CTL + 49152);
        const float da = (DBG_TSA == 12) ? (float)(ts[12] - ts[0]) * 0.01f : (float)(ts[DBG_TSA + 1] - ts[DBG_TSA]) * 0.01f;
        const float db = (DBG_TSB == 12) ? (float)(ts[12] - ts[0]) * 0.01f : (float)(ts[DBG_TSB + 1] - ts[DBG_TSB]) * 0.01f;
        for (size_t i = (size_t)wg * NTHR + tid; i < (size_t)MX * DM; i += (size_t)G * NTHR) a.out[i] = (i < (size_t)MX * DM / 2) ? da : db;
    }
#undef IN
#undef SEAM
#undef bar
}


#ifdef DBG_STATE
__global__ void chk_kernel(const unsigned* p, size_t nwords, unsigned long long* out) {
    unsigned long long s = 0ull;
    for (size_t i = (size_t)blockIdx.x * blockDim.x + threadIdx.x; i < nwords; i += (size_t)gridDim.x * blockDim.x) s += (unsigned long long)p[i] * (2ull * i + 1ull);
    for (int o = 1; o < 64; o <<= 1) s += __shfl_xor(s, o);
    if ((threadIdx.x & 63) == 0) atomicAdd(out, s);
}
__global__ void report_kernel(const unsigned long long* chk, float* out, int n) {
    int bad = -1;
    for (int p = 0; p < 27; ++p) if (chk[p] != chk[32 + p]) { bad = p; break; }
    if (bad < 0) return;
    for (int i = blockIdx.x * blockDim.x + threadIdx.x; i < n; i += gridDim.x * blockDim.x) out[i] = 1000.f * (float)(bad + 1);
}
struct ChkEnt { int ph; size_t off; size_t bytes; };
#endif
extern "C" void kernel_launch(void* const* d_in, const int* in_sizes, int n_in, void* d_out, int out_size, void* d_ws, size_t ws_size, hipStream_t stream) {
    static int grid = 0;
    if (grid == 0) {
        if (n_in != 29 || out_size != MX * DM || ws_size < WS_END) { fprintf(stderr, "kernel_launch: unexpected shapes (n_in %d out %d ws %zu)\n", n_in, out_size, ws_size); grid = -1; return; }
        int dev = 0, cus = 0, per_cu = 0;
        if (hipGetDevice(&dev) != hipSuccess || hipDeviceGetAttribute(&cus, hipDeviceAttributeMultiprocessorCount, dev) != hipSuccess) { grid = -1; return; }
        if (hipFuncSetAttribute((const void*)fwd_kernel, hipFuncAttributeMaxDynamicSharedMemorySize, LDS_BYTES) != hipSuccess) { fprintf(stderr, "kernel_launch: hipFuncSetAttribute failed\n"); grid = -1; return; }
        if (hipOccupancyMaxActiveBlocksPerMultiprocessor(&per_cu, (const void*)fwd_kernel, NTHR, LDS_BYTES) != hipSuccess || per_cu < 1) fprintf(stderr, "kernel_launch: occupancy query reports %d\n", per_cu);
        (void)hipGetLastError();
        grid = cus;
    }
    if (grid < 0) return;
    (void)hipMemsetAsync((char*)d_ws + WS_CTL, 0, CTL_BYTES, stream);
    Args a{};
    for (int i = 0; i < 29; ++i) a.in[i] = (const float*)d_in[i];
    a.out = (float*)d_out; a.ws = (unsigned char*)d_ws;
#if MK_SINGLE
#ifdef DBG_TWICE
    a.ph_lo = 0; a.ph_hi = NPH - 1;
    hipLaunchKernelGGL(fwd_kernel, dim3(grid), dim3(NTHR), LDS_BYTES, stream, a);
    (void)hipMemsetAsync((char*)d_ws + WS_CTL, 0, CTL_BYTES, stream);
#endif
    a.ph_lo = 0; a.ph_hi = NPH;
    hipLaunchKernelGGL(fwd_kernel, dim3(grid), dim3(NTHR), LDS_BYTES, stream, a);
#else
#ifdef DBG_STATE
    static const ChkEnt ents[] = { {0, WS_MOD, 122880}, {0, WS_POS, 131072}, {0, WS_HT, 32 * MiB}, {0, WS_WIN, (size_t)NIN * DM * 2}, {0, WS_WOUT, 2 * MiB},
        {1, WS_AIN, 34 * MiB}, {2, WS_QKVG, (size_t)MX * NQ * 2}, {2, WS_HYT, 48 * MiB}, {2, WS_AFB, (size_t)MT * 128},
        {3, WS_ZT, 32 * MiB}, {3, WS_DEC, (size_t)16 * 2 * NCH * 64 * 4}, {3, WS_UCTX, 4 * MiB}, {3, (size_t)-1, 64 * MiB},
        {4, WS_SPREV, 32 * MiB}, {4, WS_YHYT, 32 * MiB}, {5, WS_AOUT, 32 * MiB}, {6, (size_t)-1, 64 * MiB}, {7, WS_HN, 32 * MiB}, {7, WS_AFF, 1 * MiB},
        {8, WS_SLOT, 1 * MiB}, {8, WS_SELT, 131072}, {8, WS_SELV, 131072}, {8, WS_WGU, 64 * MiB}, {8, WS_WD, 32 * MiB}, {9, WS_HID, 64 * MiB}, {10, WS_YSLAB, 64 * MiB}, {11, (size_t)-1, 64 * MiB} };
    unsigned long long* chk = (unsigned long long*)((char*)d_ws + 32768);
    for (int run = 0; run < 2; ++run)
        for (int p = 0; p < NPH; ++p) { a.ph_lo = p; a.ph_hi = p + 1; hipLaunchKernelGGL(fwd_kernel, dim3(grid), dim3(NTHR), LDS_BYTES, stream, a);
            for (const ChkEnt& e : ents) if (e.ph == p) hipLaunchKernelGGL(chk_kernel, dim3(1024), dim3(256), 0, stream, (const unsigned*)(e.off == (size_t)-1 ? (char*)d_out : (char*)d_ws + e.off), e.bytes / 4, chk + run * 32 + (int)(&e - ents)); }
    hipLaunchKernelGGL(report_kernel, dim3(1024), dim3(256), 0, stream, (const unsigned long long*)chk, (float*)d_out, out_size);
#else
    for (int p = 0; p < NPH; ++p) { a.ph_lo = p; a.ph_hi = p + 1; hipLaunchKernelGGL(fwd_kernel, dim3(grid), dim3(NTHR), LDS_BYTES, stream, a); }
#endif
#endif
}
```
